# Optimizing an MI355X kernel written in HIP

```python
import jax, jax.numpy as jnp
from jax import lax
import numpy as np

D_MODEL = 1024
BATCH = 4
SEQ = 4096
DEPTH = 4
DEC_BATCH = 8
DEC_SEQ = 8192
PAST_LEN = 128

N_EVEN = (DEPTH + 1) // 2
N_ODD = DEPTH // 2
NORM_EPS = 1e-6
CHUNK = 64
Q_BLOCK = 128

GLA_HEADS = 4
GLA_DK = D_MODEL // 8
GLA_DV = D_MODEL // 4
GLA_LR = 16
GLA_GATE_NORM = 16.0
GLA_K_TOT = GLA_HEADS * GLA_DK
GLA_V_TOT = GLA_HEADS * GLA_DV

POOL_GROUPS = 4
POOL_WINDOWS = (2, 4, 8, 16)
POOL_DG = D_MODEL // 8
POOL_W = POOL_GROUPS * POOL_DG

MLA_HEADS = 8
MLA_NOPE = D_MODEL // 16
MLA_ROPE = D_MODEL // 32
MLA_DV = D_MODEL // 16
MLA_Q_LORA = 3 * D_MODEL // 8
MLA_KV_LORA = D_MODEL // 4
MLA_W = MLA_HEADS * MLA_DV
ROPE_THETA = 10000.0

ML_HEADS = 4
ML_DH = D_MODEL // 8
ML_W = ML_HEADS * ML_DH

E_SPLITS = (GLA_K_TOT, GLA_K_TOT, GLA_V_TOT, GLA_V_TOT, 2 * GLA_LR, POOL_W, POOL_W)
E_COLS = sum(E_SPLITS)
E_OUT = GLA_V_TOT + POOL_W
O_SPLITS = (MLA_Q_LORA, MLA_KV_LORA, MLA_ROPE, MLA_W, ML_W, ML_W, ML_W, ML_W, 4 * ML_HEADS, ML_W)
O_COLS = sum(O_SPLITS)
O_OUT = MLA_W + ML_W

kernel_name = 'hybrid_bidir_gla_pool_mla_mlstm'

F32 = jnp.float32


def rmsnorm(x, g):
    xf = x.astype(F32)
    y = xf * lax.rsqrt(jnp.mean(xf * xf, axis=-1, keepdims=True) + NORM_EPS) * g.astype(F32)
    return y.astype(x.dtype)


def head_rmsnorm(o, g):
    y = o * lax.rsqrt(jnp.mean(o * o, axis=-1, keepdims=True) + NORM_EPS) * g.astype(F32)
    B, H, S, d = y.shape
    return y.transpose(0, 2, 1, 3).reshape(B, S, H * d)


def split_cols(z, sizes):
    idx = [int(i) for i in np.cumsum(sizes)[:-1]]
    return jnp.split(z, idx, axis=-1)


def to_heads(t, n_heads):
    B, S, _ = t.shape
    return t.reshape(B, S, n_heads, -1).transpose(0, 2, 1, 3)


def flip_seq(t):
    return jnp.flip(t, axis=2)


def chunk_first(t):
    B, H, S = t.shape[:3]
    t = t.reshape(B, H, S // CHUNK, CHUNK, *t.shape[3:])
    return jnp.moveaxis(t, 2, 0)


def chunk_last(t):
    t = jnp.moveaxis(t, 0, 2)
    B, H, N, L = t.shape[:4]
    return t.reshape(B, H, N * L, *t.shape[4:])


def gla_scan(q, k, v, log_a, inclusive):
    B, H, S, dk = q.shape
    dv = v.shape[-1]
    mask = jnp.tril(jnp.ones((CHUNK, CHUNK), bool), 0 if inclusive else -1)

    def step(state, inp):
        qc, kc, vc, ac = inp
        b = jnp.cumsum(ac, axis=-2)
        b_last = b[..., -1:, :]
        qe = qc * jnp.exp(b)
        a = jnp.einsum('bhid,bhjd->bhij', qe, kc * jnp.exp(-b))
        a = jnp.where(mask, a, 0.0)
        o = jnp.einsum('bhij,bhjv->bhiv', a, vc) + jnp.einsum('bhid,bhdv->bhiv', qe, state)
        state = (jnp.exp(b_last)[..., 0, :, None] * state
                 + jnp.einsum('bhjd,bhjv->bhdv', kc * jnp.exp(b_last - b), vc))
        return state, o

    init = jnp.zeros((B, H, dk, dv), F32)
    _, o = lax.scan(step, init, (chunk_first(q), chunk_first(k), chunk_first(v), chunk_first(log_a)))
    return chunk_last(o)


def mlstm_scan(q, k, v, log_i, log_f, inclusive):
    B, H, S, dk = q.shape
    dv = v.shape[-1]
    mask = jnp.tril(jnp.ones((CHUNK, CHUNK), bool), 0 if inclusive else -1)

    def step(carry, inp):
        C, n, m = carry
        qc, kc, vc, li, lf = inp
        b = jnp.cumsum(lf, axis=-1)
        g = b[..., -1]
        d = jnp.where(mask, b[..., :, None] - b[..., None, :] + li[..., None, :], -jnp.inf)
        inter = b + m[..., None]
        m_t = jnp.maximum(inter, jnp.max(d, axis=-1))
        s = jnp.einsum('bhid,bhjd->bhij', qc, kc) * jnp.exp(d - m_t[..., None])
        e = jnp.exp(inter - m_t)
        num = jnp.einsum('bhij,bhjv->bhiv', s, vc) + e[..., None] * jnp.einsum('bhid,bhdv->bhiv', qc, C)
        den = jnp.sum(s, axis=-1) + e * jnp.einsum('bhid,bhd->bhi', qc, n)
        h = num / jnp.maximum(jnp.abs(den), jnp.exp(-m_t))[..., None]
        lw = g[..., None] - b + li
        m_new = jnp.maximum(g + m, jnp.max(lw, axis=-1))
        wk = jnp.exp(lw - m_new[..., None])
        decay = jnp.exp(g + m - m_new)
        C = decay[..., None, None] * C + jnp.einsum('bhj,bhjd,bhjv->bhdv', wk, kc, vc)
        n = decay[..., None] * n + jnp.einsum('bhj,bhjd->bhd', wk, kc)
        return (C, n, m_new), h

    init = (jnp.zeros((B, H, dk, dv), F32), jnp.zeros((B, H, dk), F32), jnp.zeros((B, H), F32))
    _, h = lax.scan(step, init, (chunk_first(q), chunk_first(k), chunk_first(v),
                                 chunk_first(log_i), chunk_first(log_f)))
    return chunk_last(h)


def multiscale_pool(u, pool_w, pool_scale):
    B, S, _ = u.shape
    ug = u.astype(F32).reshape(B, S, POOL_GROUPS, POOL_DG)
    cs = jnp.concatenate([jnp.zeros_like(ug[:, :1]), jnp.cumsum(ug, axis=1)], axis=1)
    pos = jnp.arange(S)
    outs = []
    for gi, w in enumerate(POOL_WINDOWS):
        lo = jnp.clip(pos - w // 2, 0, S)
        hi = jnp.clip(pos + w // 2, 0, S)
        csg = cs[:, :, gi]
        win_sum = jnp.take(csg, hi, axis=1) - jnp.take(csg, lo, axis=1)
        cnt = (hi - lo).astype(F32)[None, :, None]
        outs.append(win_sum / cnt - ug[:, :, gi])
    pooled = jnp.stack(outs, axis=2)
    mixed = jnp.einsum('bsgc,gcd->bsgd', pooled, pool_w.astype(F32)).reshape(B, S, POOL_W)
    return mixed * pool_scale.astype(F32)


def rope_tables(S):
    inv = ROPE_THETA ** (-jnp.arange(0, MLA_ROPE, 2, dtype=F32) / MLA_ROPE)
    ang = jnp.arange(S, dtype=F32)[:, None] * inv[None, :]
    return jnp.cos(ang), jnp.sin(ang)


def apply_rope(x, cos, sin):
    xf = x.astype(F32)
    x1, x2 = jnp.split(xf, 2, axis=-1)
    return jnp.concatenate([x1 * cos - x2 * sin, x2 * cos + x1 * sin], axis=-1).astype(x.dtype)


def mla_attention(q_nope, q_rope, k_nope, k_rope, v):
    B, S, H, _ = q_nope.shape
    scale = (MLA_NOPE + MLA_ROPE) ** -0.5
    nb = S // Q_BLOCK

    def blocks(t):
        return jnp.moveaxis(t.reshape(B, nb, Q_BLOCK, *t.shape[2:]), 1, 0)

    def attend(qs):
        qn, qr = qs
        s = (jnp.einsum('bqhd,bkhd->bhqk', qn, k_nope, preferred_element_type=F32)
             + jnp.einsum('bqhr,bkr->bhqk', qr, k_rope, preferred_element_type=F32)) * scale
        p = jax.nn.softmax(s, axis=-1)
        return jnp.einsum('bhqk,bkhd->bqhd', p.astype(v.dtype), v)

    o = lax.map(attend, (blocks(q_nope), blocks(q_rope)))
    return jnp.moveaxis(o, 0, 1).reshape(B, S, H * MLA_DV)


def even_layer(h, w_in, a_up, a_bias, gla_norm_g, pool_w, pool_scale, w_out):
    B, S, _ = h.shape
    z = h @ w_in
    q, k, v, gla_gate, a_lr, pool_u, pool_gate = split_cols(z, E_SPLITS)
    q = to_heads(q, GLA_HEADS).astype(F32) * GLA_DK ** -0.5
    k = to_heads(k, GLA_HEADS).astype(F32)
    v = to_heads(v, GLA_HEADS).astype(F32)
    lr_f, lr_b = jnp.split(a_lr, 2, axis=-1)
    log_a_f = jax.nn.log_sigmoid((lr_f @ a_up[0] + a_bias[0]).astype(F32)) / GLA_GATE_NORM
    log_a_b = jax.nn.log_sigmoid((lr_b @ a_up[1] + a_bias[1]).astype(F32)) / GLA_GATE_NORM
    log_a_f = to_heads(log_a_f, GLA_HEADS)
    log_a_b = to_heads(log_a_b, GLA_HEADS)
    o = (gla_scan(q, k, v, log_a_f, True)
         + flip_seq(gla_scan(flip_seq(q), flip_seq(k), flip_seq(v), flip_seq(log_a_b), False)))
    gla_out = head_rmsnorm(o, gla_norm_g).astype(h.dtype) * jax.nn.silu(gla_gate)
    pool_out = multiscale_pool(pool_u, pool_w, pool_scale).astype(h.dtype) * jax.nn.silu(pool_gate)
    return jnp.concatenate([gla_out, pool_out], axis=-1) @ w_out


def odd_layer(h, cos, sin, w_in, q_norm_g, q_up, kv_norm_g, kv_up, if_bias, ml_norm_g, w_out):
    B, S, _ = h.shape
    z = h @ w_in
    cq, ckv, k_rope, mla_gate, mq, mk, mv, mo, mif, ml_gate = split_cols(z, O_SPLITS)
    qh = (rmsnorm(cq, q_norm_g) @ q_up).reshape(B, S, MLA_HEADS, MLA_NOPE + MLA_ROPE)
    q_nope, q_rope = qh[..., :MLA_NOPE], qh[..., MLA_NOPE:]
    kvh = (rmsnorm(ckv, kv_norm_g) @ kv_up).reshape(B, S, MLA_HEADS, MLA_NOPE + MLA_DV)
    k_nope, v_mla = kvh[..., :MLA_NOPE], kvh[..., MLA_NOPE:]
    q_rope = apply_rope(q_rope, cos[:, None, :], sin[:, None, :])
    k_rope = apply_rope(k_rope, cos, sin)
    mla_out = mla_attention(q_nope, q_rope, k_nope, k_rope, v_mla) * jax.nn.silu(mla_gate)
    q = to_heads(mq, ML_HEADS).astype(F32)
    k = to_heads(mk, ML_HEADS).astype(F32) * ML_DH ** -0.5
    v = to_heads(mv, ML_HEADS).astype(F32)
    gates = (mif.astype(F32) + if_bias.astype(F32)).reshape(B, S, 4, ML_HEADS).transpose(2, 0, 3, 1)
    li_f, li_b = gates[0], gates[1]
    lf_f, lf_b = jax.nn.log_sigmoid(gates[2]), jax.nn.log_sigmoid(gates[3])
    hm = (mlstm_scan(q, k, v, li_f, lf_f, True)
          + flip_seq(mlstm_scan(flip_seq(q), flip_seq(k), flip_seq(v), flip_seq(li_b), flip_seq(lf_b), False)))
    ml_out = head_rmsnorm(hm, ml_norm_g) * jax.nn.sigmoid(mo.astype(F32))
    ml_out = ml_out.astype(h.dtype) * jax.nn.silu(ml_gate)
    return jnp.concatenate([mla_out.astype(h.dtype), ml_out], axis=-1) @ w_out


def trunk(x, norm_g, final_norm_g, e_w_in, e_gla_a_up, e_gla_a_bias, e_gla_norm_g, e_pool_w,
          e_pool_scale, e_w_out, o_w_in, o_q_norm_g, o_q_up, o_kv_norm_g, o_kv_up, o_if_bias,
          o_mlstm_norm_g, o_w_out):
    S = x.shape[1]
    cos, sin = rope_tables(S)
    for layer in range(DEPTH):
        h = rmsnorm(x, norm_g[layer])
        i = layer // 2
        if layer % 2 == 0:
            y = even_layer(h, e_w_in[i], e_gla_a_up[i], e_gla_a_bias[i], e_gla_norm_g[i],
                           e_pool_w[i], e_pool_scale[i], e_w_out[i])
        else:
            y = odd_layer(h, cos, sin, o_w_in[i], o_q_norm_g[i], o_q_up[i], o_kv_norm_g[i], o_kv_up[i],
                          o_if_bias[i], o_mlstm_norm_g[i], o_w_out[i])
        x = x + y.astype(x.dtype)
    return rmsnorm(x, final_norm_g)


def setup_inputs(seed: int = 0) -> dict:
    key = jax.random.key(seed)
    ks = jax.random.split(key, 24)

    def nrm(k, shape, scale):
        return jax.random.normal(k, shape, F32) * scale

    f_bias = jnp.tile(jnp.linspace(3.0, 6.0, ML_HEADS), 2)
    if_bias = jnp.concatenate([
        jnp.broadcast_to(0.1 * jax.random.normal(ks[20], (1, 2 * ML_HEADS), F32), (N_ODD, 2 * ML_HEADS)),
        f_bias[None, :] + 0.1 * jax.random.normal(ks[21], (N_ODD, 2 * ML_HEADS), F32)], axis=-1)
    if_bias = if_bias + 0.01 * jax.random.normal(ks[22], if_bias.shape, F32)
    return {
        'x_prompt': nrm(ks[0], (BATCH, SEQ, D_MODEL), 1.0),
        'x_sample': nrm(ks[1], (DEC_BATCH, DEC_SEQ, D_MODEL), 1.0),
        'norm_g': 1.0 + nrm(ks[2], (DEPTH, D_MODEL), 0.02),
        'final_norm_g': 1.0 + nrm(ks[3], (D_MODEL,), 0.02),
        'e_w_in': nrm(ks[4], (N_EVEN, D_MODEL, E_COLS), D_MODEL ** -0.5),
        'e_gla_a_up': nrm(ks[5], (N_EVEN, 2, GLA_LR, GLA_K_TOT), GLA_LR ** -0.5),
        'e_gla_a_bias': nrm(ks[6], (N_EVEN, 2, GLA_K_TOT), 0.1),
        'e_gla_norm_g': 1.0 + nrm(ks[7], (N_EVEN, GLA_DV), 0.02),
        'e_pool_w': nrm(ks[8], (N_EVEN, POOL_GROUPS, POOL_DG, POOL_DG), POOL_DG ** -0.5),
        'e_pool_scale': 1.0 + nrm(ks[9], (N_EVEN, POOL_W), 0.1),
        'e_w_out': nrm(ks[10], (N_EVEN, E_OUT, D_MODEL), E_OUT ** -0.5),
        'o_w_in': nrm(ks[11], (N_ODD, D_MODEL, O_COLS), D_MODEL ** -0.5),
        'o_q_norm_g': 1.0 + nrm(ks[12], (N_ODD, MLA_Q_LORA), 0.02),
        'o_q_up': nrm(ks[13], (N_ODD, MLA_Q_LORA, MLA_HEADS * (MLA_NOPE + MLA_ROPE)), MLA_Q_LORA ** -0.5),
        'o_kv_norm_g': 1.0 + nrm(ks[14], (N_ODD, MLA_KV_LORA), 0.02),
        'o_kv_up': nrm(ks[15], (N_ODD, MLA_KV_LORA, MLA_HEADS * (MLA_NOPE + MLA_DV)), MLA_KV_LORA ** -0.5),
        'o_if_bias': if_bias,
        'o_mlstm_norm_g': 1.0 + nrm(ks[16], (N_ODD, ML_DH), 0.02),
        'o_w_out': nrm(ks[17], (N_ODD, O_OUT, D_MODEL), O_OUT ** -0.5),
    }


def reference(x_prompt, x_sample, norm_g, final_norm_g, e_w_in, e_gla_a_up, e_gla_a_bias, e_gla_norm_g,
              e_pool_w, e_pool_scale, e_w_out, o_w_in, o_q_norm_g, o_q_up, o_kv_norm_g, o_kv_up,
              o_if_bias, o_mlstm_norm_g, o_w_out):
    y_prompt = trunk(x_prompt, norm_g, final_norm_g, e_w_in, e_gla_a_up, e_gla_a_bias, e_gla_norm_g,
                     e_pool_w, e_pool_scale, e_w_out, o_w_in, o_q_norm_g, o_q_up, o_kv_norm_g, o_kv_up,
                     o_if_bias, o_mlstm_norm_g, o_w_out)
    y_sample = trunk(x_sample, norm_g, final_norm_g, e_w_in, e_gla_a_up, e_gla_a_bias, e_gla_norm_g,
                     e_pool_w, e_pool_scale, e_w_out, o_w_in, o_q_norm_g, o_q_up, o_kv_norm_g, o_kv_up,
                     o_if_bias, o_mlstm_norm_g, o_w_out)
    return (y_prompt, y_sample)
```

```cpp
#include <hip/hip_runtime.h>
#include <hip/hip_cooperative_groups.h>
#include <cstdio>
namespace cg = cooperative_groups;

#ifndef SINGLE_LAUNCH
#define SINGLE_LAUNCH 0
#endif
#ifndef PHMASK
#define PHMASK 0xFFFF
#endif
#define PH_ON(b) ((PHMASK >> (b)) & 1)

typedef unsigned short bf16_t;
typedef __attribute__((ext_vector_type(8))) short bf16x8;
typedef __attribute__((ext_vector_type(4))) float f32x4;
typedef __attribute__((ext_vector_type(4))) unsigned short us4;

constexpr int T_TOK = 81920;
constexpr int T_P = 16384;
constexpr int DM = 1024;
constexpr int NE = 4128, NE_PAD = 4224;
constexpr int NO = 3760, NO_PAD = 3840;
constexpr float EPS = 1e-6f;
constexpr int NPHASE = 20;
constexpr int LDS_BYTES = 72 * 1024;

struct Params {
  const float *x_prompt, *x_sample, *norm_g, *final_norm_g, *e_w_in, *e_a_up, *e_a_bias, *e_gla_norm_g,
      *e_pool_w, *e_pool_scale, *e_w_out, *o_w_in, *o_q_norm_g, *o_q_up, *o_kv_norm_g, *o_kv_up, *o_if_bias,
      *o_ml_norm_g, *o_w_out;
  float* out;
  bf16_t *WinE, *WinO, *WoutE, *WoutO, *QupT, *KVupT, *PoolWT, *AupT;
  int* counters;
  bf16_t *Qb, *Kb, *VtE, *Gb, *LRb, *PUb, *PGb, *TMP;
  bf16_t *TMP2, *CQb, *CKVb, *KRb, *MGb, *MQb, *MKb, *MVt, *MOb, *MLGb, *Qa, *KNb, *VtA;
  float* MIF;
  int ph_lo, ph_hi;
};

__device__ __forceinline__ bf16_t f2bf(float f) {
  unsigned u = __float_as_uint(f);
  u += 0x7fffu + ((u >> 16) & 1u);
  return (bf16_t)(u >> 16);
}
__device__ __forceinline__ float bf2f(bf16_t b) { return __uint_as_float(((unsigned)b) << 16); }
__device__ __forceinline__ f32x4 mfma16(bf16x8 a, bf16x8 b, f32x4 c) {
  return __builtin_amdgcn_mfma_f32_16x16x32_bf16(a, b, c, 0, 0, 0);
}
__device__ __forceinline__ float logsigmoidf_(float x) { return fminf(x, 0.f) - log1pf(__expf(-fabsf(x))); }
__device__ __forceinline__ float siluf_(float x) { return x / (1.f + __expf(-x)); }
__device__ __forceinline__ float sigmoidf_(float x) { return 1.f / (1.f + __expf(-x)); }
__device__ __forceinline__ int otid() { int t = threadIdx.x; asm volatile("" : "+v"(t)); return t; }
__device__ __forceinline__ bf16x8 zero8() { bf16x8 z = {0, 0, 0, 0, 0, 0, 0, 0}; return z; }
__device__ __forceinline__ f32x4 zero4() { f32x4 z = {0.f, 0.f, 0.f, 0.f}; return z; }

__device__ __forceinline__ int seq_pos(int tok) { return tok < T_P ? (tok & 4095) : ((tok - T_P) & 8191); }
__device__ __forceinline__ const float* xrow(const float* xa, const float* xb, int tok) {
  return tok < T_P ? xa + (long)tok * DM : xb + (long)(tok - T_P) * DM;
}

__device__ void prep_weight(const float* __restrict__ W, int K, int N, int Npad, const float* __restrict__ gsc,
                            bf16_t* __restrict__ out, long gtid, long gsize) {
  long total = (long)Npad * K;
  for (long idx = gtid; idx < total; idx += gsize) {
    int k = (int)(idx / Npad);
    int n = (int)(idx % Npad);
    float v = 0.f;
    if (n < N) {
      v = W[(long)k * N + n];
      if (gsc) v *= gsc[k];
    }
    out[(long)n * K + k] = f2bf(v);
  }
}

__device__ void phase_prep(const Params& p) {
  long gtid = (long)blockIdx.x * 256 + otid();
  long gsize = (long)gridDim.x * 256;
  for (int l = 0; l < 2; ++l) {
    prep_weight(p.e_w_in + (long)l * DM * NE, DM, NE, NE_PAD, p.norm_g + (2 * l) * DM, p.WinE + (long)l * NE_PAD * DM, gtid, gsize);
    prep_weight(p.o_w_in + (long)l * DM * NO, DM, NO, NO_PAD, p.norm_g + (2 * l + 1) * DM, p.WinO + (long)l * NO_PAD * DM, gtid, gsize);
    prep_weight(p.e_w_out + (long)l * 1536 * DM, 1536, DM, DM, nullptr, p.WoutE + (long)l * DM * 1536, gtid, gsize);
    prep_weight(p.o_w_out + (long)l * 1024 * DM, 1024, DM, DM, nullptr, p.WoutO + (long)l * DM * 1024, gtid, gsize);
    prep_weight(p.o_q_up + (long)l * 384 * 768, 384, 768, 768, p.o_q_norm_g + l * 384, p.QupT + (long)l * 768 * 384, gtid, gsize);
    prep_weight(p.o_kv_up + (long)l * 256 * 1024, 256, 1024, 1024, p.o_kv_norm_g + l * 256, p.KVupT + (long)l * 1024 * 256, gtid, gsize);
    for (int gi = 0; gi < 4; ++gi)
      prep_weight(p.e_pool_w + (long)(l * 4 + gi) * 128 * 128, 128, 128, 128, nullptr, p.PoolWT + (long)(l * 4 + gi) * 128 * 128, gtid, gsize);
    for (long idx = gtid; idx < 2 * 512 * 32; idx += gsize) {
      int r = (int)(idx & 31);
      int d = (int)((idx >> 5) & 511);
      int dir = (int)(idx >> 14);
      float v = (r < 16) ? p.e_a_up[((long)(l * 2 + dir) * 16 + r) * 512 + d] : 0.f;
      p.AupT[((long)(l * 2 + dir) * 512 + d) * 32 + r] = f2bf(v);
    }
  }
  if (gtid < 16) p.counters[gtid] = 0;
}

constexpr int LDT = 72;
#define GEMM_GLOAD(KT)                                                                         \
  {                                                                                            \
    const int k0_ = (KT) * 64;                                                                 \
    if constexpr (AMODE == 0) {                                                                \
      _Pragma("unroll") for (int i = 0; i < 8; ++i) {                                          \
        int id = tid + 256 * i;                                                                \
        int row = id >> 4, c4 = id & 15;                                                       \
        raf[i] = *(const f32x4*)(xrow(xa, xb, m0 + row) + k0_ + 4 * c4);                       \
      }                                                                                        \
    } else {                                                                                   \
      const bf16_t* base_;                                                                     \
      int ld_;                                                                                 \
      if (k0_ < K1) { base_ = A1 + k0_; ld_ = ld1; } else { base_ = A2 + (k0_ - K1); ld_ = ld2; } \
      _Pragma("unroll") for (int i = 0; i < 4; ++i) {                                          \
        int id = tid + 256 * i;                                                                \
        int row = id >> 3, c8 = id & 7;                                                        \
        rab[i] = *(const bf16x8*)(base_ + (long)(m0 + row) * ld_ + 8 * c8);                     \
      }                                                                                        \
    }                                                                                          \
    _Pragma("unroll") for (int i = 0; i < 4; ++i) {                                            \
      int id = tid + 256 * i;                                                                  \
      int row = id >> 3, c8 = id & 7;                                                          \
      rb[i] = *(const bf16x8*)(Bt + (long)(n0 + row) * K + k0_ + 8 * c8);                       \
    }                                                                                          \
  }

template <int AMODE, class Epi>
__device__ void gemm_phase(int Mtiles, int Ntiles, int K, const bf16_t* __restrict__ Bt, const float* xa, const float* xb,
                           const bf16_t* A1, int ld1, int K1, const bf16_t* A2, int ld2, const Epi& epi, char* smem) {
  bf16_t* sA = (bf16_t*)smem;
  bf16_t* sB = sA + 128 * LDT;
  float* sR = (float*)(sB + 128 * LDT);
  const int tid = otid(), lane = tid & 63, w = tid >> 6, c = lane & 15, g = lane >> 4;
  const int wm = w >> 1, wn = w & 1;
  const int nk = K / 64;
  const int ntiles = Mtiles * Ntiles;
  for (int tile = blockIdx.x; tile < ntiles; tile += gridDim.x) {
    const int mt = tile / Ntiles, nt = tile % Ntiles;
    const int m0 = mt * 128, n0 = nt * 128;
    f32x4 acc[4][4];
#pragma unroll
    for (int i = 0; i < 4; ++i)
#pragma unroll
      for (int j = 0; j < 4; ++j) acc[i][j] = zero4();
    float ss[8];
#pragma unroll
    for (int i = 0; i < 8; ++i) ss[i] = 0.f;
    f32x4 raf[8];
    bf16x8 rab[4];
    bf16x8 rb[4];
    GEMM_GLOAD(0)
    for (int kt = 0; kt < nk; ++kt) {
      __syncthreads();
      if constexpr (AMODE == 0) {
#pragma unroll
        for (int i = 0; i < 8; ++i) {
          int id = tid + 256 * i;
          int row = id >> 4, c4 = id & 15;
          f32x4 v = raf[i];
          ss[i] += v[0] * v[0] + v[1] * v[1] + v[2] * v[2] + v[3] * v[3];
          us4 o;
          o[0] = f2bf(v[0]); o[1] = f2bf(v[1]); o[2] = f2bf(v[2]); o[3] = f2bf(v[3]);
          *(us4*)(sA + row * LDT + 4 * c4) = o;
        }
      } else {
#pragma unroll
        for (int i = 0; i < 4; ++i) {
          int id = tid + 256 * i;
          int row = id >> 3, c8 = id & 7;
          bf16x8 v = rab[i];
          if constexpr (AMODE == 2) {
#pragma unroll
            for (int e = 0; e < 8; ++e) {
              float f = bf2f((bf16_t)v[e]);
              ss[i] += f * f;
            }
          }
          *(bf16x8*)(sA + row * LDT + 8 * c8) = v;
        }
      }
#pragma unroll
      for (int i = 0; i < 4; ++i) {
        int id = tid + 256 * i;
        int row = id >> 3, c8 = id & 7;
        *(bf16x8*)(sB + row * LDT + 8 * c8) = rb[i];
      }
      __syncthreads();
      if (kt + 1 < nk) GEMM_GLOAD(kt + 1)
#pragma unroll
      for (int ks = 0; ks < 2; ++ks) {
        bf16x8 af[4];
#pragma unroll
        for (int mi = 0; mi < 4; ++mi) af[mi] = *(const bf16x8*)(sA + (wm * 64 + mi * 16 + c) * LDT + ks * 32 + g * 8);
#pragma unroll
        for (int ni = 0; ni < 4; ++ni) {
          bf16x8 bfr = *(const bf16x8*)(sB + (wn * 64 + ni * 16 + c) * LDT + ks * 32 + g * 8);
#pragma unroll
          for (int mi = 0; mi < 4; ++mi) acc[mi][ni] = mfma16(af[mi], bfr, acc[mi][ni]);
        }
      }
    }
    if constexpr (AMODE == 0) {
#pragma unroll
      for (int i = 0; i < 8; ++i) {
        float s = ss[i];
        s += __shfl_xor(s, 1); s += __shfl_xor(s, 2); s += __shfl_xor(s, 4); s += __shfl_xor(s, 8);
        if ((tid & 15) == 0) sR[(tid >> 4) + 16 * i] = rsqrtf(s / (float)K + EPS);
      }
      __syncthreads();
    } else if constexpr (AMODE == 2) {
#pragma unroll
      for (int i = 0; i < 4; ++i) {
        float s = ss[i];
        s += __shfl_xor(s, 1); s += __shfl_xor(s, 2); s += __shfl_xor(s, 4);
        if ((tid & 7) == 0) sR[(tid >> 3) + 32 * i] = rsqrtf(s / (float)K + EPS);
      }
      __syncthreads();
    }
    epi(m0, n0, wm, wn, g, c, acc, sR);
  }
}

struct EpiEvenIn {
  bf16_t *Qb, *Kb, *VtE, *Gb, *LRb, *PUb, *PGb;
  __device__ void operator()(int m0, int n0, int wm, int wn, int g, int c, f32x4 (&acc)[4][4], const float* sR) const {
#pragma unroll
    for (int ni = 0; ni < 4; ++ni) {
      const int col0 = n0 + wn * 64 + ni * 16;
      if (col0 >= NE) continue;
      const int col = col0 + c;
#pragma unroll
      for (int mi = 0; mi < 4; ++mi) {
        const int rowb = wm * 64 + mi * 16 + 4 * g;
        const long tok = m0 + rowb;
        float v[4];
#pragma unroll
        for (int j = 0; j < 4; ++j) v[j] = acc[mi][ni][j] * sR[rowb + j];
        if (col0 < 512) {
#pragma unroll
          for (int j = 0; j < 4; ++j) Qb[(tok + j) * 512 + col] = f2bf(v[j]);
        } else if (col0 < 1024) {
#pragma unroll
          for (int j = 0; j < 4; ++j) Kb[(tok + j) * 512 + (col - 512)] = f2bf(v[j]);
        } else if (col0 < 2048) {
          us4 o; o[0] = f2bf(v[0]); o[1] = f2bf(v[1]); o[2] = f2bf(v[2]); o[3] = f2bf(v[3]);
          *(us4*)(VtE + (long)(col - 1024) * T_TOK + tok) = o;
        } else if (col0 < 3072) {
#pragma unroll
          for (int j = 0; j < 4; ++j) Gb[(tok + j) * 1024 + (col - 2048)] = f2bf(v[j]);
        } else if (col0 < 3104) {
#pragma unroll
          for (int j = 0; j < 4; ++j) LRb[(tok + j) * 32 + (col - 3072)] = f2bf(v[j]);
        } else if (col0 < 3616) {
#pragma unroll
          for (int j = 0; j < 4; ++j) PUb[(tok + j) * 512 + (col - 3104)] = f2bf(v[j]);
        } else {
#pragma unroll
          for (int j = 0; j < 4; ++j) PGb[(tok + j) * 512 + (col - 3616)] = f2bf(v[j]);
        }
      }
    }
  }
};

__device__ __forceinline__ void rope_cs(int pos, int i, float& co, float& si) {
  float inv = exp2f(-(float)i * (13.287712379549449f / 16.f));
  float ang = (float)pos * inv;
  double r = (double)ang * 0.15915494309189535;
  r -= rint(r);
  float rf = (float)r;
  si = __builtin_amdgcn_sinf(rf);
  co = __builtin_amdgcn_cosf(rf);
}

struct EpiOddIn {
  bf16_t *CQb, *CKVb, *KRb, *MGb, *MQb, *MKb, *MVt, *MOb, *MLGb;
  float* MIF;
  __device__ void operator()(int m0, int n0, int wm, int wn, int g, int c, f32x4 (&acc)[4][4], const float* sR) const {
#pragma unroll
    for (int ni = 0; ni < 4; ++ni) {
      const int col0 = n0 + wn * 64 + ni * 16;
      if (col0 >= NO) continue;
      if (col0 == 656) continue;
      const int col = col0 + c;
#pragma unroll
      for (int mi = 0; mi < 4; ++mi) {
        const int rowb = wm * 64 + mi * 16 + 4 * g;
        const long tok = m0 + rowb;
        float v[4];
#pragma unroll
        for (int j = 0; j < 4; ++j) v[j] = acc[mi][ni][j] * sR[rowb + j];
        if (col0 < 384) {
#pragma unroll
          for (int j = 0; j < 4; ++j) CQb[(tok + j) * 384 + col] = f2bf(v[j]);
        } else if (col0 < 640) {
#pragma unroll
          for (int j = 0; j < 4; ++j) CKVb[(tok + j) * 256 + (col - 384)] = f2bf(v[j]);
        } else if (col0 == 640) {
          if (ni < 3) {
#pragma unroll
            for (int j = 0; j < 4; ++j) {
              float x1 = v[j];
              float x2 = acc[mi][(ni + 1) & 3][j] * sR[rowb + j];
              float co, si;
              rope_cs(seq_pos((int)tok + j), c, co, si);
              KRb[(tok + j) * 32 + c] = f2bf(x1 * co - x2 * si);
              KRb[(tok + j) * 32 + 16 + c] = f2bf(x2 * co + x1 * si);
            }
          }
        } else if (col0 < 1184) {
#pragma unroll
          for (int j = 0; j < 4; ++j) MGb[(tok + j) * 512 + (col - 672)] = f2bf(v[j]);
        } else if (col0 < 1696) {
#pragma unroll
          for (int j = 0; j < 4; ++j) MQb[(tok + j) * 512 + (col - 1184)] = f2bf(v[j]);
        } else if (col0 < 2208) {
#pragma unroll
          for (int j = 0; j < 4; ++j) MKb[(tok + j) * 512 + (col - 1696)] = f2bf(v[j]);
        } else if (col0 < 2720) {
          us4 o; o[0] = f2bf(v[0]); o[1] = f2bf(v[1]); o[2] = f2bf(v[2]); o[3] = f2bf(v[3]);
          *(us4*)(MVt + (long)(col - 2208) * T_TOK + tok) = o;
        } else if (col0 < 3232) {
#pragma unroll
          for (int j = 0; j < 4; ++j) MOb[(tok + j) * 512 + (col - 2720)] = f2bf(v[j]);
        } else if (col0 < 3248) {
#pragma unroll
          for (int j = 0; j < 4; ++j) MIF[(tok + j) * 16 + (col - 3232)] = v[j];
        } else {
#pragma unroll
          for (int j = 0; j < 4; ++j) MLGb[(tok + j) * 512 + (col - 3248)] = f2bf(v[j]);
        }
      }
    }
  }
};

struct EpiQUp {
  bf16_t* Qa;
  __device__ void operator()(int m0, int n0, int wm, int wn, int g, int c, f32x4 (&acc)[4][4], const float* sR) const {
    const float qs = 0.10206207261596575f;
#pragma unroll
    for (int ni = 0; ni < 4; ++ni) {
      const int col0 = n0 + wn * 64 + ni * 16;
      const int within0 = col0 % 96;
      if (within0 == 80) continue;
      const int col = col0 + c;
#pragma unroll
      for (int mi = 0; mi < 4; ++mi) {
        const int rowb = wm * 64 + mi * 16 + 4 * g;
        const long tok = m0 + rowb;
        if (within0 == 64) {
          if (ni < 3) {
#pragma unroll
            for (int j = 0; j < 4; ++j) {
              float r = sR[rowb + j];
              float x1 = acc[mi][ni][j] * r;
              float x2 = acc[mi][(ni + 1) & 3][j] * r;
              float co, si;
              rope_cs(seq_pos((int)tok + j), c, co, si);
              Qa[(tok + j) * 768 + col] = f2bf((x1 * co - x2 * si) * qs);
              Qa[(tok + j) * 768 + col + 16] = f2bf((x2 * co + x1 * si) * qs);
            }
          }
        } else {
#pragma unroll
          for (int j = 0; j < 4; ++j) Qa[(tok + j) * 768 + col] = f2bf(acc[mi][ni][j] * sR[rowb + j] * qs);
        }
      }
    }
  }
};

struct EpiKVUp {
  bf16_t *KNb, *VtA;
  __device__ void operator()(int m0, int n0, int wm, int wn, int g, int c, f32x4 (&acc)[4][4], const float* sR) const {
#pragma unroll
    for (int ni = 0; ni < 4; ++ni) {
      const int col0 = n0 + wn * 64 + ni * 16;
      const int head = col0 >> 7, within0 = col0 & 127;
#pragma unroll
      for (int mi = 0; mi < 4; ++mi) {
        const int rowb = wm * 64 + mi * 16 + 4 * g;
        const long tok = m0 + rowb;
        float v[4];
#pragma unroll
        for (int j = 0; j < 4; ++j) v[j] = acc[mi][ni][j] * sR[rowb + j];
        if (within0 < 64) {
#pragma unroll
          for (int j = 0; j < 4; ++j) KNb[(tok + j) * 512 + head * 64 + within0 + c] = f2bf(v[j]);
        } else {
          us4 o; o[0] = f2bf(v[0]); o[1] = f2bf(v[1]); o[2] = f2bf(v[2]); o[3] = f2bf(v[3]);
          *(us4*)(VtA + (long)(head * 64 + within0 - 64 + c) * T_TOK + tok) = o;
        }
      }
    }
  }
};

struct EpiOut {
  const float *xa, *xb;
  float* out;
  __device__ void operator()(int m0, int n0, int wm, int wn, int g, int c, f32x4 (&acc)[4][4], const float* sR) const {
#pragma unroll
    for (int ni = 0; ni < 4; ++ni) {
      const int col = n0 + wn * 64 + ni * 16 + c;
#pragma unroll
      for (int mi = 0; mi < 4; ++mi) {
        const int tok = m0 + wm * 64 + mi * 16 + 4 * g;
#pragma unroll
        for (int j = 0; j < 4; ++j) {
          float xo = xrow(xa, xb, tok + j)[col];
          out[(long)(tok + j) * DM + col] = xo + acc[mi][ni][j];
        }
      }
    }
  }
};

__device__ __forceinline__ float scan16(float v, int c) {
  float t;
  t = __shfl_up(v, 1, 16); if (c >= 1) v += t;
  t = __shfl_up(v, 2, 16); if (c >= 2) v += t;
  t = __shfl_up(v, 4, 16); if (c >= 4) v += t;
  t = __shfl_up(v, 8, 16); if (c >= 8) v += t;
  return v;
}

template <int DIR>
__device__ __forceinline__ void gla_chunk(const Params& p, int h, int sl, int tokc, bool second, const bf16x8 (&aup)[2],
                                          const float (&bias)[2][4], f32x4 (&S)[2][2], bf16_t* sQe, bf16_t* sKd,
                                          bf16_t* sKdT, bf16_t* sA, bf16_t* sSt, float* sEb) {
  const int tid = otid(), lane = tid & 63, w = tid >> 6, c = lane & 15, g = lane >> 4;
  const float qscale = 0.08838834764831845f;
  bf16x8 vf[2][2];
#pragma unroll
  for (int vt = 0; vt < 2; ++vt)
#pragma unroll
    for (int k2 = 0; k2 < 2; ++k2)
      vf[vt][k2] = *(const bf16x8*)(p.VtE + (long)(h * 256 + sl * 32 + 16 * vt + c) * T_TOK + tokc + 32 * k2 + 8 * g);
  f32x4 la[2][4];
#pragma unroll
  for (int tt = 0; tt < 4; ++tt) {
    bf16x8 lrf = zero8();
    if (g < 2) lrf = *(const bf16x8*)(p.LRb + (long)(tokc + 16 * tt + c) * 32 + DIR * 16 + 8 * g);
#pragma unroll
    for (int dt = 0; dt < 2; ++dt) la[dt][tt] = mfma16(aup[dt], lrf, zero4());
  }
#pragma unroll
  for (int dt = 0; dt < 2; ++dt)
#pragma unroll
    for (int tt = 0; tt < 4; ++tt)
#pragma unroll
      for (int j = 0; j < 4; ++j) la[dt][tt][j] = logsigmoidf_(la[dt][tt][j] + bias[dt][j]) * (1.f / 16.f);
  f32x4 P[2][4];
  float tot[2][4];
#pragma unroll
  for (int dt = 0; dt < 2; ++dt)
#pragma unroll
    for (int j = 0; j < 4; ++j) {
      float carry = 0.f;
#pragma unroll
      for (int tt = 0; tt < 4; ++tt) {
        float v = scan16(la[dt][tt][j], c) + carry;
        P[dt][tt][j] = v;
        carry = __shfl(v, 15, 16);
      }
      tot[dt][j] = carry;
    }
#pragma unroll
  for (int dt = 0; dt < 2; ++dt)
#pragma unroll
    for (int tt = 0; tt < 4; ++tt) {
      const long off = (long)(tokc + 16 * tt + c) * 512 + h * 128 + 32 * w + 16 * dt + 4 * g;
      us4 q4 = *(const us4*)(p.Qb + off);
      us4 k4 = *(const us4*)(p.Kb + off);
      us4 qo, ko;
#pragma unroll
      for (int j = 0; j < 4; ++j) {
        float b = (DIR == 0) ? P[dt][tt][j] : (tot[dt][j] - P[dt][tt][j] + la[dt][tt][j]);
        float qe = bf2f(q4[j]) * __expf(b) * qscale;
        float kd = bf2f(k4[j]) * __expf(-b);
        qo[j] = f2bf(qe);
        ko[j] = f2bf(kd);
        sKdT[(32 * w + 16 * dt + 4 * g + j) * 72 + 16 * tt + c] = ko[j];
      }
      *(us4*)(sQe + (16 * tt + c) * 136 + 32 * w + 16 * dt + 4 * g) = qo;
      *(us4*)(sKd + (16 * tt + c) * 136 + 32 * w + 16 * dt + 4 * g) = ko;
    }
  if (c == 0) {
#pragma unroll
    for (int dt = 0; dt < 2; ++dt)
#pragma unroll
      for (int j = 0; j < 4; ++j) sEb[32 * w + 16 * dt + 4 * g + j] = __expf(tot[dt][j]);
  }
#pragma unroll
  for (int vt = 0; vt < 2; ++vt)
#pragma unroll
    for (int dt = 0; dt < 2; ++dt)
#pragma unroll
      for (int j = 0; j < 4; ++j) sSt[(16 * vt + 4 * g + j) * 136 + 32 * w + 16 * dt + c] = f2bf(S[vt][dt][j]);
  __syncthreads();
  bf16x8 aq[4];
  f32x4 accA[4];
#pragma unroll
  for (int jt = 0; jt < 4; ++jt) accA[jt] = zero4();
#pragma unroll
  for (int ks = 0; ks < 4; ++ks) {
    aq[ks] = *(const bf16x8*)(sQe + (16 * w + c) * 136 + 32 * ks + 8 * g);
#pragma unroll
    for (int jt = 0; jt < 4; ++jt) {
      bf16x8 bk = *(const bf16x8*)(sKd + (16 * jt + c) * 136 + 32 * ks + 8 * g);
      accA[jt] = mfma16(aq[ks], bk, accA[jt]);
    }
  }
#pragma unroll
  for (int jt = 0; jt < 4; ++jt)
#pragma unroll
    for (int j = 0; j < 4; ++j) {
      const int i = 16 * w + 4 * g + j, jj = 16 * jt + c;
      const bool keep = (DIR == 0) ? (jj <= i) : (jj > i);
      sA[i * 72 + jj] = f2bf(keep ? accA[jt][j] : 0.f);
    }
  __syncthreads();
  f32x4 o[2];
  o[0] = zero4(); o[1] = zero4();
#pragma unroll
  for (int k2 = 0; k2 < 2; ++k2) {
    bf16x8 af = *(const bf16x8*)(sA + (16 * w + c) * 72 + 32 * k2 + 8 * g);
#pragma unroll
    for (int vt = 0; vt < 2; ++vt) o[vt] = mfma16(af, vf[vt][k2], o[vt]);
  }
#pragma unroll
  for (int ks = 0; ks < 4; ++ks)
#pragma unroll
    for (int vt = 0; vt < 2; ++vt) {
      bf16x8 sf = *(const bf16x8*)(sSt + (16 * vt + c) * 136 + 32 * ks + 8 * g);
      o[vt] = mfma16(aq[ks], sf, o[vt]);
    }
#pragma unroll
  for (int vt = 0; vt < 2; ++vt)
#pragma unroll
    for (int j = 0; j < 4; ++j) {
      const long addr = (long)(tokc + 16 * w + 4 * g + j) * 1024 + h * 256 + sl * 32 + 16 * vt + c;
      float val = o[vt][j];
      if (second) val += bf2f(p.TMP[addr]);
      p.TMP[addr] = f2bf(val);
    }
#pragma unroll
  for (int dt = 0; dt < 2; ++dt) {
    const float ebl = sEb[32 * w + 16 * dt + c];
#pragma unroll
    for (int vt = 0; vt < 2; ++vt) {
      f32x4 a = S[vt][dt];
#pragma unroll
      for (int k2 = 0; k2 < 2; ++k2) {
        bf16x8 kf = *(const bf16x8*)(sKdT + (32 * w + 16 * dt + c) * 72 + 32 * k2 + 8 * g);
        a = mfma16(vf[vt][k2], kf, a);
      }
      S[vt][dt] = a * ebl;
    }
  }
  __syncthreads();
}

__device__ void gla_chain_item(const Params& p, int li, int item, char* smem) {
  const int tid = otid(), lane = tid & 63, w = tid >> 6, c = lane & 15, g = lane >> 4;
  int s, rem;
  if (item < 256) { s = 4 + item / 32; rem = item % 32; } else { s = (item - 256) / 32; rem = (item - 256) % 32; }
  const int h = rem >> 3, sl = rem & 7;
  const int tok0 = s < 4 ? s * 4096 : T_P + (s - 4) * 8192;
  const int len = s < 4 ? 4096 : 8192;
  const int N = len / 64;
  bf16_t* sQe = (bf16_t*)smem;
  bf16_t* sKd = sQe + 64 * 136;
  bf16_t* sKdT = sKd + 64 * 136;
  bf16_t* sA = sKdT + 128 * 72;
  bf16_t* sSt = sA + 64 * 72;
  float* sEb = (float*)(sSt + 32 * 136);
  bf16x8 aup[2][2];
  float bias[2][2][4];
#pragma unroll
  for (int dir = 0; dir < 2; ++dir)
#pragma unroll
    for (int dt = 0; dt < 2; ++dt) {
      aup[dir][dt] = zero8();
      if (g < 2) aup[dir][dt] = *(const bf16x8*)(p.AupT + ((long)(li * 2 + dir) * 512 + h * 128 + 32 * w + 16 * dt + c) * 32 + 8 * g);
#pragma unroll
      for (int j = 0; j < 4; ++j) bias[dir][dt][j] = p.e_a_bias[(li * 2 + dir) * 512 + h * 128 + 32 * w + 16 * dt + 4 * g + j];
    }
  f32x4 Sf[2][2], Sb[2][2];
#pragma unroll
  for (int a = 0; a < 2; ++a)
#pragma unroll
    for (int b = 0; b < 2; ++b) { Sf[a][b] = zero4(); Sb[a][b] = zero4(); }
  __syncthreads();
  for (int step = 0; step < N; ++step) {
    const bool second = step >= (N >> 1);
    gla_chunk<0>(p, h, sl, tok0 + step * 64, second, aup[0], bias[0], Sf, sQe, sKd, sKdT, sA, sSt, sEb);
    gla_chunk<1>(p, h, sl, tok0 + (N - 1 - step) * 64, second, aup[1], bias[1], Sb, sQe, sKd, sKdT, sA, sSt, sEb);
  }
}

__device__ void pool_item(const Params& p, int li, int item, char* smem) {
  const int tid = otid(), lane = tid & 63, w = tid >> 6, c = lane & 15, g = lane >> 4;
  const int gi = item & 3;
  const int tile = item >> 2;
  const int tokc = tile * 64;
  const int pos0 = seq_pos(tokc);
  const int len = tokc < T_P ? 4096 : 8192;
  float* sU = (float*)smem;
  bf16_t* sP = (bf16_t*)(sU + 80 * 128);
  __syncthreads();
  for (int idx = tid; idx < 80 * 128; idx += 256) {
    int r = idx >> 7, ch = idx & 127;
    int pos = pos0 - 8 + r;
    float v = 0.f;
    if (pos >= 0 && pos < len) v = bf2f(p.PUb[(long)(tokc - 8 + r) * 512 + gi * 128 + ch]);
    sU[idx] = v;
  }
  __syncthreads();
  {
    const int ch = tid & 127, th = tid >> 7;
    const int half = 1 << gi;
    for (int t = th * 32; t < th * 32 + 32; ++t) {
      int pos = pos0 + t;
      int lo = max(pos - half, 0), hi = min(pos + half, len);
      float s = 0.f;
      for (int q = lo; q < hi; ++q) s += sU[(q - pos0 + 8) * 128 + ch];
      float pooled = s / (float)(hi - lo) - sU[(t + 8) * 128 + ch];
      sP[t * 136 + ch] = f2bf(pooled);
    }
  }
  __syncthreads();
  f32x4 acc[8];
#pragma unroll
  for (int dt = 0; dt < 8; ++dt) acc[dt] = zero4();
  const bf16_t* PW = p.PoolWT + (long)(li * 4 + gi) * 128 * 128;
#pragma unroll
  for (int ks = 0; ks < 4; ++ks) {
    bf16x8 af = *(const bf16x8*)(sP + (16 * w + c) * 136 + 32 * ks + 8 * g);
#pragma unroll
    for (int dt = 0; dt < 8; ++dt) {
      bf16x8 bw = *(const bf16x8*)(PW + (long)(16 * dt + c) * 128 + 32 * ks + 8 * g);
      acc[dt] = mfma16(af, bw, acc[dt]);
    }
  }
#pragma unroll
  for (int dt = 0; dt < 8; ++dt) {
    const int d = gi * 128 + 16 * dt + c;
    const float sc = p.e_pool_scale[li * 512 + d];
#pragma unroll
    for (int j = 0; j < 4; ++j) {
      const long addr = (long)(tokc + 16 * w + 4 * g + j) * 512 + d;
      float gt = bf2f(p.PGb[addr]);
      p.PGb[addr] = f2bf(acc[dt][j] * sc * siluf_(gt));
    }
  }
}

template <int DIR>
__device__ __forceinline__ void ml_chunk(const Params& p, int li, int h, int sl, int tokc, bool second, float& mstate,
                                         f32x4 (&C)[3][2], bf16_t* sKwT, bf16_t* sA, bf16_t* sCt, float* sc) {
  const int tid = otid(), lane = tid & 63, w = tid >> 6, c = lane & 15, g = lane >> 4;
  const float kscale = 0.08838834764831845f;
  float* sRA = sc;
  float* sCB = sc + 64;
  float* sE = sc + 128;
  float* sThr = sc + 192;
  float* sWk = sc + 256;
  float* sMisc = sc + 320;
  if (w == 0) {
    const float bi = p.o_if_bias[li * 16 + DIR * 4 + h];
    const float bff = p.o_if_bias[li * 16 + 8 + DIR * 4 + h];
    const float* mf = p.MIF + (long)(tokc + lane) * 16;
    const float liv = mf[DIR * 4 + h] + bi;
    const float lfv = logsigmoidf_(mf[8 + DIR * 4 + h] + bff);
    float ps = lfv;
#pragma unroll
    for (int d = 1; d < 64; d <<= 1) {
      float t = __shfl_up(ps, d);
      if (lane >= d) ps += t;
    }
    const float total = __shfl(ps, 63);
    const float b = (DIR == 0) ? ps : (total - ps + lfv);
    const float cB = liv - b;
    float pm = cB;
    if (DIR == 0) {
#pragma unroll
      for (int d = 1; d < 64; d <<= 1) {
        float t = __shfl_up(pm, d);
        if (lane >= d) pm = fmaxf(pm, t);
      }
    } else {
#pragma unroll
      for (int d = 1; d < 64; d <<= 1) {
        float t = __shfl_down(pm, d);
        if (lane + d < 64) pm = fmaxf(pm, t);
      }
      float t = __shfl_down(pm, 1);
      pm = (lane < 63) ? t : -1e30f;
    }
    const float m = mstate;
    const float M = fmaxf(m, pm);
    sRA[lane] = -M;
    sCB[lane] = cB;
    sE[lane] = __expf(m - M);
    sThr[lane] = __expf(-b - M);
    float mall = cB;
#pragma unroll
    for (int d = 1; d < 64; d <<= 1) mall = fmaxf(mall, __shfl_xor(mall, d));
    const float Mn = fmaxf(m, mall);
    sWk[lane] = __expf(cB - Mn);
    if (lane == 0) {
      sMisc[0] = __expf(m - Mn);
      sMisc[1] = total + Mn;
    }
  }
#pragma unroll
  for (int vt = 0; vt < 3; ++vt)
#pragma unroll
    for (int dt = 0; dt < 2; ++dt)
#pragma unroll
      for (int j = 0; j < 4; ++j) sCt[(16 * vt + 4 * g + j) * 136 + 32 * w + 16 * dt + c] = f2bf(C[vt][dt][j]);
  bf16x8 vf[2][2];
#pragma unroll
  for (int vt = 0; vt < 2; ++vt)
#pragma unroll
    for (int k2 = 0; k2 < 2; ++k2)
      vf[vt][k2] = *(const bf16x8*)(p.MVt + (long)(h * 128 + sl * 32 + 16 * vt + c) * T_TOK + tokc + 32 * k2 + 8 * g);
  bf16x8 ones = zero8();
  if (c == 0) {
#pragma unroll
    for (int e = 0; e < 8; ++e) ones[e] = (short)0x3F80;
  }
  bf16x8 aq[4];
#pragma unroll
  for (int ks = 0; ks < 4; ++ks) aq[ks] = *(const bf16x8*)(p.MQb + (long)(tokc + 16 * w + c) * 512 + h * 128 + 32 * ks + 8 * g);
  __syncthreads();
  const float decay = sMisc[0];
  mstate = sMisc[1];
#pragma unroll
  for (int i = 0; i < 4; ++i) {
    const int id = tid + 256 * i;
    const int tk = id >> 4, c8 = id & 15;
    bf16x8 kv = *(const bf16x8*)(p.MKb + (long)(tokc + tk) * 512 + h * 128 + 8 * c8);
    const float wk = sWk[tk] * kscale;
#pragma unroll
    for (int e = 0; e < 8; ++e) sKwT[(8 * c8 + e) * 72 + tk] = f2bf(bf2f((bf16_t)kv[e]) * wk);
  }
  f32x4 accA[4];
#pragma unroll
  for (int jt = 0; jt < 4; ++jt) accA[jt] = zero4();
#pragma unroll
  for (int ks = 0; ks < 4; ++ks)
#pragma unroll
    for (int jt = 0; jt < 4; ++jt) {
      bf16x8 bk = *(const bf16x8*)(p.MKb + (long)(tokc + 16 * jt + c) * 512 + h * 128 + 32 * ks + 8 * g);
      accA[jt] = mfma16(aq[ks], bk, accA[jt]);
    }
#pragma unroll
  for (int jt = 0; jt < 4; ++jt)
#pragma unroll
    for (int j = 0; j < 4; ++j) {
      const int i = 16 * w + 4 * g + j, jj = 16 * jt + c;
      const bool keep = (DIR == 0) ? (jj <= i) : (jj > i);
      float sv = keep ? accA[jt][j] * kscale * __expf(sRA[i] + sCB[jj]) : 0.f;
      sA[i * 72 + jj] = f2bf(sv);
    }
  __syncthreads();
  f32x4 o1[3], o2[3];
#pragma unroll
  for (int vt = 0; vt < 3; ++vt) { o1[vt] = zero4(); o2[vt] = zero4(); }
#pragma unroll
  for (int k2 = 0; k2 < 2; ++k2) {
    bf16x8 af = *(const bf16x8*)(sA + (16 * w + c) * 72 + 32 * k2 + 8 * g);
    o1[0] = mfma16(af, vf[0][k2], o1[0]);
    o1[1] = mfma16(af, vf[1][k2], o1[1]);
    o1[2] = mfma16(af, ones, o1[2]);
  }
#pragma unroll
  for (int ks = 0; ks < 4; ++ks)
#pragma unroll
    for (int vt = 0; vt < 3; ++vt) {
      bf16x8 cf = *(const bf16x8*)(sCt + (16 * vt + c) * 136 + 32 * ks + 8 * g);
      o2[vt] = mfma16(aq[ks], cf, o2[vt]);
    }
#pragma unroll
  for (int j = 0; j < 4; ++j) {
    const int i = 16 * w + 4 * g + j;
    const float e = sE[i], thr = sThr[i];
    float den = o1[2][j] + e * o2[2][j];
    den = __shfl(den, lane & 48);
    const float dn = fmaxf(fabsf(den), thr);
#pragma unroll
    for (int vt = 0; vt < 2; ++vt) {
      float hv = (o1[vt][j] + e * o2[vt][j]) / dn;
      const long addr = (long)(tokc + i) * 512 + h * 128 + sl * 32 + 16 * vt + c;
      if (second) hv += bf2f(p.TMP2[addr]);
      p.TMP2[addr] = f2bf(hv);
    }
  }
#pragma unroll
  for (int dt = 0; dt < 2; ++dt)
#pragma unroll
    for (int vt = 0; vt < 3; ++vt) {
      f32x4 a = C[vt][dt] * decay;
#pragma unroll
      for (int k2 = 0; k2 < 2; ++k2) {
        bf16x8 kf = *(const bf16x8*)(sKwT + (32 * w + 16 * dt + c) * 72 + 32 * k2 + 8 * g);
        a = mfma16(vt < 2 ? vf[vt < 2 ? vt : 0][k2] : ones, kf, a);
      }
      C[vt][dt] = a;
    }
  __syncthreads();
}

__device__ void ml_chain_item(const Params& p, int li, int item, char* smem) {
  int s, rem;
  if (item < 128) { s = 4 + item / 16; rem = item % 16; } else { s = (item - 128) / 16; rem = (item - 128) % 16; }
  const int h = rem >> 2, sl = rem & 3;
  const int tok0 = s < 4 ? s * 4096 : T_P + (s - 4) * 8192;
  const int len = s < 4 ? 4096 : 8192;
  const int N = len / 64;
  bf16_t* sKwT = (bf16_t*)smem;
  bf16_t* sA = sKwT + 128 * 72;
  bf16_t* sCt = sA + 64 * 72;
  float* sc = (float*)(sCt + 48 * 136);
  f32x4 Cf[3][2], Cb[3][2];
#pragma unroll
  for (int a = 0; a < 3; ++a)
#pragma unroll
    for (int b = 0; b < 2; ++b) { Cf[a][b] = zero4(); Cb[a][b] = zero4(); }
  float mf = 0.f, mb = 0.f;
  __syncthreads();
  for (int step = 0; step < N; ++step) {
    const bool second = step >= (N >> 1);
    ml_chunk<0>(p, li, h, sl, tok0 + step * 64, second, mf, Cf, sKwT, sA, sCt, sc);
    ml_chunk<1>(p, li, h, sl, tok0 + (N - 1 - step) * 64, second, mb, Cb, sKwT, sA, sCt, sc);
  }
}

#define ATTN_GLOAD(KT)                                                                              \
  {                                                                                                 \
    const long kb = tok0 + (KT) * 64;                                                               \
    rk0 = *(const bf16x8*)(p.KNb + (kb + (tid >> 3)) * 512 + head * 64 + 8 * (tid & 7));            \
    rk1 = *(const bf16x8*)(p.KNb + (kb + 32 + (tid >> 3)) * 512 + head * 64 + 8 * (tid & 7));       \
    rkr = *(const bf16x8*)(p.KRb + (kb + (tid >> 2)) * 32 + 8 * (tid & 3));                          \
    rv0 = *(const bf16x8*)(p.VtA + (long)(head * 64 + (tid >> 3)) * T_TOK + kb + 8 * (tid & 7));     \
    rv1 = *(const bf16x8*)(p.VtA + (long)(head * 64 + 32 + (tid >> 3)) * T_TOK + kb + 8 * (tid & 7)); \
  }
__device__ void attn_item(const Params& p, int item, char* smem) {
  const int tid = otid(), lane = tid & 63, w = tid >> 6, c = lane & 15, g = lane >> 4;
  int s, head, qb;
  if (item < 4096) { s = 4 + item / 512; int rem = item % 512; head = rem / 64; qb = rem % 64; }
  else { int it = item - 4096; s = it / 256; int rem = it % 256; head = rem / 32; qb = rem % 32; }
  const int tok0 = s < 4 ? s * 4096 : T_P + (s - 4) * 8192;
  const int len = s < 4 ? 4096 : 8192;
  const int nkv = len / 64;
  bf16_t* sK = (bf16_t*)smem;
  bf16_t* sVt = sK + 64 * 104;
  const int qrow0 = tok0 + qb * 128 + 32 * w;
  bf16x8 qf[2][3];
#pragma unroll
  for (int nt = 0; nt < 2; ++nt)
#pragma unroll
    for (int ks = 0; ks < 3; ++ks)
      qf[nt][ks] = *(const bf16x8*)(p.Qa + (long)(qrow0 + 16 * nt + c) * 768 + head * 96 + 32 * ks + 8 * g);
  f32x4 ot[4][2];
#pragma unroll
  for (int vt = 0; vt < 4; ++vt) { ot[vt][0] = zero4(); ot[vt][1] = zero4(); }
  float mrun[2] = {-1e30f, -1e30f}, lrun[2] = {0.f, 0.f};
  bf16x8 rk0, rk1, rkr, rv0, rv1;
  ATTN_GLOAD(0)
  for (int kt = 0; kt < nkv; ++kt) {
    __syncthreads();
    *(bf16x8*)(sK + (tid >> 3) * 104 + 8 * (tid & 7)) = rk0;
    *(bf16x8*)(sK + (32 + (tid >> 3)) * 104 + 8 * (tid & 7)) = rk1;
    *(bf16x8*)(sK + (tid >> 2) * 104 + 64 + 8 * (tid & 3)) = rkr;
    *(bf16x8*)(sVt + (tid >> 3) * 72 + 8 * (tid & 7)) = rv0;
    *(bf16x8*)(sVt + (32 + (tid >> 3)) * 72 + 8 * (tid & 7)) = rv1;
    __syncthreads();
    if (kt + 1 < nkv) ATTN_GLOAD(kt + 1)
    f32x4 st[4][2];
#pragma unroll
    for (int k4 = 0; k4 < 4; ++k4) { st[k4][0] = zero4(); st[k4][1] = zero4(); }
#pragma unroll
    for (int ks = 0; ks < 3; ++ks)
#pragma unroll
      for (int k4 = 0; k4 < 4; ++k4) {
        bf16x8 kf = *(const bf16x8*)(sK + (16 * k4 + c) * 104 + 32 * ks + 8 * g);
        st[k4][0] = mfma16(kf, qf[0][ks], st[k4][0]);
        st[k4][1] = mfma16(kf, qf[1][ks], st[k4][1]);
      }
#pragma unroll
    for (int nt = 0; nt < 2; ++nt) {
      float mx = -1e30f;
#pragma unroll
      for (int k4 = 0; k4 < 4; ++k4)
#pragma unroll
        for (int j = 0; j < 4; ++j) mx = fmaxf(mx, st[k4][nt][j]);
      mx = fmaxf(mx, __shfl_xor(mx, 16));
      mx = fmaxf(mx, __shfl_xor(mx, 32));
      const float mn = fmaxf(mrun[nt], mx);
      const float alpha = __expf(mrun[nt] - mn);
      mrun[nt] = mn;
      float psum = 0.f;
#pragma unroll
      for (int k4 = 0; k4 < 4; ++k4)
#pragma unroll
        for (int j = 0; j < 4; ++j) {
          float pv = __expf(st[k4][nt][j] - mn);
          st[k4][nt][j] = pv;
          psum += pv;
        }
      lrun[nt] = lrun[nt] * alpha + psum;
#pragma unroll
      for (int vt = 0; vt < 4; ++vt) ot[vt][nt] = ot[vt][nt] * alpha;
    }
#pragma unroll
    for (int k2 = 0; k2 < 2; ++k2) {
      bf16x8 pb[2];
#pragma unroll
      for (int nt = 0; nt < 2; ++nt)
#pragma unroll
        for (int e = 0; e < 4; ++e) {
          pb[nt][e] = (short)f2bf(st[2 * k2][nt][e]);
          pb[nt][4 + e] = (short)f2bf(st[2 * k2 + 1][nt][e]);
        }
#pragma unroll
      for (int vt = 0; vt < 4; ++vt) {
        us4 lo = *(const us4*)(sVt + (16 * vt + c) * 72 + 32 * k2 + 4 * g);
        us4 hi = *(const us4*)(sVt + (16 * vt + c) * 72 + 32 * k2 + 16 + 4 * g);
        bf16x8 av;
#pragma unroll
        for (int e = 0; e < 4; ++e) { av[e] = (short)lo[e]; av[4 + e] = (short)hi[e]; }
        ot[vt][0] = mfma16(av, pb[0], ot[vt][0]);
        ot[vt][1] = mfma16(av, pb[1], ot[vt][1]);
      }
    }
  }
#pragma unroll
  for (int nt = 0; nt < 2; ++nt) {
    float lt = lrun[nt];
    lt += __shfl_xor(lt, 16);
    lt += __shfl_xor(lt, 32);
    const float inv = 1.f / lt;
    const long tok = qrow0 + 16 * nt + c;
#pragma unroll
    for (int vt = 0; vt < 4; ++vt) {
      bf16_t* gp = p.MGb + tok * 512 + head * 64 + 16 * vt + 4 * g;
      us4 gt = *(const us4*)gp;
      us4 o;
#pragma unroll
      for (int j = 0; j < 4; ++j) o[j] = f2bf(ot[vt][nt][j] * inv * siluf_(bf2f(gt[j])));
      *(us4*)gp = o;
    }
  }
}

__device__ void phase_gla_combine(const Params& p, int li) {
  const int tid_ = otid(); const int lane = tid_ & 63, w = tid_ >> 6;
  for (int tok = blockIdx.x * 4 + w; tok < T_TOK; tok += gridDim.x * 4) {
    const bf16_t* tp = p.TMP + (long)tok * 1024 + 16 * lane;
    bf16_t* gp = p.Gb + (long)tok * 1024 + 16 * lane;
    bf16x8 o0 = *(const bf16x8*)tp, o1 = *(const bf16x8*)(tp + 8);
    bf16x8 g0 = *(const bf16x8*)gp, g1 = *(const bf16x8*)(gp + 8);
    float ov[16], gv[16];
#pragma unroll
    for (int e = 0; e < 8; ++e) {
      ov[e] = bf2f((bf16_t)o0[e]); ov[8 + e] = bf2f((bf16_t)o1[e]);
      gv[e] = bf2f((bf16_t)g0[e]); gv[8 + e] = bf2f((bf16_t)g1[e]);
    }
    float ss = 0.f;
#pragma unroll
    for (int e = 0; e < 16; ++e) ss += ov[e] * ov[e];
    ss += __shfl_xor(ss, 1); ss += __shfl_xor(ss, 2); ss += __shfl_xor(ss, 4); ss += __shfl_xor(ss, 8);
    const float rs = rsqrtf(ss * (1.f / 256.f) + EPS);
    const float* ng = p.e_gla_norm_g + li * 256 + ((16 * lane) & 255);
    bf16x8 r0, r1;
#pragma unroll
    for (int e = 0; e < 8; ++e) {
      r0[e] = (short)f2bf(ov[e] * rs * ng[e] * siluf_(gv[e]));
      r1[e] = (short)f2bf(ov[8 + e] * rs * ng[8 + e] * siluf_(gv[8 + e]));
    }
    *(bf16x8*)gp = r0;
    *(bf16x8*)(gp + 8) = r1;
  }
}

__device__ void phase_ml_combine(const Params& p, int li) {
  const int tid_ = otid(); const int lane = tid_ & 63, w = tid_ >> 6;
  for (int tok = blockIdx.x * 4 + w; tok < T_TOK; tok += gridDim.x * 4) {
    const long off = (long)tok * 512 + 8 * lane;
    bf16x8 hv = *(const bf16x8*)(p.TMP2 + off);
    bf16x8 mo = *(const bf16x8*)(p.MOb + off);
    bf16x8 mg = *(const bf16x8*)(p.MLGb + off);
    float hf[8];
    float ss = 0.f;
#pragma unroll
    for (int e = 0; e < 8; ++e) { hf[e] = bf2f((bf16_t)hv[e]); ss += hf[e] * hf[e]; }
    ss += __shfl_xor(ss, 1); ss += __shfl_xor(ss, 2); ss += __shfl_xor(ss, 4); ss += __shfl_xor(ss, 8);
    const float rs = rsqrtf(ss * (1.f / 128.f) + EPS);
    const float* ng = p.o_ml_norm_g + li * 128 + ((8 * lane) & 127);
    bf16x8 r;
#pragma unroll
    for (int e = 0; e < 8; ++e)
      r[e] = (short)f2bf(hf[e] * rs * ng[e] * sigmoidf_(bf2f((bf16_t)mo[e])) * siluf_(bf2f((bf16_t)mg[e])));
    *(bf16x8*)(p.MLGb + off) = r;
  }
}

__device__ void phase_final(const Params& p) {
  const int tid_ = otid(); const int lane = tid_ & 63, w = tid_ >> 6;
  for (int tok = blockIdx.x * 4 + w; tok < T_TOK; tok += gridDim.x * 4) {
    float* xp = p.out + (long)tok * DM;
    float4 v[4];
    float ss = 0.f;
#pragma unroll
    for (int i = 0; i < 4; ++i) {
      v[i] = *(const float4*)(xp + 4 * lane + 256 * i);
      ss += v[i].x * v[i].x + v[i].y * v[i].y + v[i].z * v[i].z + v[i].w * v[i].w;
    }
#pragma unroll
    for (int d = 1; d < 64; d <<= 1) ss += __shfl_xor(ss, d);
    const float rs = rsqrtf(ss * (1.f / 1024.f) + EPS);
#pragma unroll
    for (int i = 0; i < 4; ++i) {
      float4 gq = *(const float4*)(p.final_norm_g + 4 * lane + 256 * i);
      float4 o;
      o.x = v[i].x * rs * gq.x; o.y = v[i].y * rs * gq.y; o.z = v[i].z * rs * gq.z; o.w = v[i].w * rs * gq.w;
      *(float4*)(xp + 4 * lane + 256 * i) = o;
    }
  }
}

__device__ void run_phase(const Params& p, int ph, char* smem) {
  if (ph == 0) { if (PH_ON(0)) phase_prep(p); return; }
  if (ph == NPHASE - 1) { if (PH_ON(11)) phase_final(p); return; }
  const int q = ph - 1;
  const int layer = (q < 4) ? 0 : (q < 9) ? 1 : (q < 13) ? 2 : 3;
  const int sub = (q < 4) ? q : (q < 9) ? q - 4 : (q < 13) ? q - 9 : q - 13;
  const int li = layer >> 1;
  const float* xa = (layer == 0) ? p.x_prompt : p.out;
  const float* xb = (layer == 0) ? p.x_sample : p.out + (long)T_P * DM;
  if ((layer & 1) == 0) {
    if (sub == 0) {
      EpiEvenIn e{p.Qb, p.Kb, p.VtE, p.Gb, p.LRb, p.PUb, p.PGb};
      if (PH_ON(1)) gemm_phase<0>(T_TOK / 128, NE_PAD / 128, DM, p.WinE + (long)li * NE_PAD * DM, xa, xb, nullptr, 0, 0, nullptr, 0, e, smem);
    } else if (sub == 1) {
      for (int item = blockIdx.x; item < 384 + 5120; item += gridDim.x) {
        if (item < 384) { if (PH_ON(2)) gla_chain_item(p, li, item, smem); }
        else { if (PH_ON(3)) pool_item(p, li, item - 384, smem); }
      }
    } else if (sub == 2) {
      if (PH_ON(4)) phase_gla_combine(p, li);
    } else {
      EpiOut e{xa, xb, p.out};
      if (PH_ON(5)) gemm_phase<1>(T_TOK / 128, DM / 128, 1536, p.WoutE + (long)li * DM * 1536, nullptr, nullptr, p.Gb, 1024, 1024, p.PGb, 512, e, smem);
    }
  } else {
    if (sub == 0) {
      EpiOddIn e{p.CQb, p.CKVb, p.KRb, p.MGb, p.MQb, p.MKb, p.MVt, p.MOb, p.MLGb, p.MIF};
      if (PH_ON(6)) gemm_phase<0>(T_TOK / 128, NO_PAD / 128, DM, p.WinO + (long)li * NO_PAD * DM, xa, xb, nullptr, 0, 0, nullptr, 0, e, smem);
    } else if (sub == 1) {
      EpiQUp eq{p.Qa};
      if (PH_ON(7)) gemm_phase<2>(T_TOK / 128, 768 / 128, 384, p.QupT + (long)li * 768 * 384, nullptr, nullptr, p.CQb, 384, 384, p.CQb, 384, eq, smem);
      EpiKVUp ek{p.KNb, p.VtA};
      if (PH_ON(7)) gemm_phase<2>(T_TOK / 128, 1024 / 128, 256, p.KVupT + (long)li * 1024 * 256, nullptr, nullptr, p.CKVb, 256, 256, p.CKVb, 256, ek, smem);
    } else if (sub == 2) {
      __shared__ int s_item;
      if (PH_ON(8)) if ((int)blockIdx.x < 192) ml_chain_item(p, li, blockIdx.x, smem);
      for (;;) {
        __syncthreads();
        if (threadIdx.x == 0) s_item = atomicAdd(p.counters + li, 1);
        __syncthreads();
        const int item = s_item;
        if (item >= 5120) break;
        if (PH_ON(9)) attn_item(p, item, smem);
      }
    } else if (sub == 3) {
      if (PH_ON(10)) phase_ml_combine(p, li);
    } else {
      EpiOut e{xa, xb, p.out};
      if (PH_ON(5)) gemm_phase<1>(T_TOK / 128, DM / 128, 1024, p.WoutO + (long)li * DM * 1024, nullptr, nullptr, p.MGb, 512, 512, p.MLGb, 512, e, smem);
    }
  }
}

__global__ void __launch_bounds__(256, 2) mega_kernel(Params p) {
  extern __shared__ __attribute__((aligned(16))) char smem[];
  cg::grid_group grid = cg::this_grid();
  for (int ph = p.ph_lo; ph < p.ph_hi; ++ph) {
    if (ph > p.ph_lo) grid.sync();
    run_phase(p, ph, smem);
  }
}

extern "C" void kernel_launch(void* const* d_in, const int* in_sizes, int n_in, void* d_out, int out_size, void* d_ws,
                              size_t ws_size, hipStream_t stream) {
  static int grid_blocks = 0;
  if (!grid_blocks) {
    int dev = 0, cus = 0, per_cu = 0;
    hipGetDevice(&dev);
    hipDeviceGetAttribute(&cus, hipDeviceAttributeMultiprocessorCount, dev);
    hipFuncSetAttribute((const void*)mega_kernel, hipFuncAttributeMaxDynamicSharedMemorySize, LDS_BYTES);
    hipOccupancyMaxActiveBlocksPerMultiprocessor(&per_cu, (const void*)mega_kernel, 256, LDS_BYTES);
    if (per_cu < 1) per_cu = 1;
    if (per_cu > 2) per_cu = 2;
    grid_blocks = cus * per_cu;
    fprintf(stderr, "kernel_launch: cus %d per_cu %d grid %d ws %zu\n", cus, per_cu, grid_blocks, ws_size);
  }
  Params p{};
  const float** pin = (const float**)&p;
  for (int i = 0; i < 19; ++i) pin[i] = (const float*)d_in[i];
  p.out = (float*)d_out;
  char* ws = (char*)d_ws;
  size_t off = 0;
  auto take = [&](size_t bytes) { char* r = ws + off; off += (bytes + 255) & ~(size_t)255; return r; };
  p.WinE = (bf16_t*)take((size_t)2 * NE_PAD * DM * 2);
  p.WinO = (bf16_t*)take((size_t)2 * NO_PAD * DM * 2);
  p.WoutE = (bf16_t*)take((size_t)2 * DM * 1536 * 2);
  p.WoutO = (bf16_t*)take((size_t)2 * DM * 1024 * 2);
  p.QupT = (bf16_t*)take((size_t)2 * 768 * 384 * 2);
  p.KVupT = (bf16_t*)take((size_t)2 * 1024 * 256 * 2);
  p.PoolWT = (bf16_t*)take((size_t)2 * 4 * 128 * 128 * 2);
  p.AupT = (bf16_t*)take((size_t)2 * 2 * 512 * 32 * 2);
  p.counters = (int*)take(256);
  const size_t act0 = off;
  const size_t T = T_TOK;
  p.Qb = (bf16_t*)take(T * 512 * 2);
  p.Kb = (bf16_t*)take(T * 512 * 2);
  p.VtE = (bf16_t*)take(T * 1024 * 2);
  p.Gb = (bf16_t*)take(T * 1024 * 2);
  p.LRb = (bf16_t*)take(T * 32 * 2);
  p.PUb = (bf16_t*)take(T * 512 * 2);
  p.PGb = (bf16_t*)take(T * 512 * 2);
  p.TMP = (bf16_t*)take(T * 1024 * 2);
  const size_t even_end = off;
  off = act0;
  p.TMP2 = (bf16_t*)take(T * 512 * 2);
  p.CQb = (bf16_t*)take(T * 384 * 2);
  p.CKVb = (bf16_t*)take(T * 256 * 2);
  p.KRb = (bf16_t*)take(T * 32 * 2);
  p.MGb = (bf16_t*)take(T * 512 * 2);
  p.MQb = (bf16_t*)take(T * 512 * 2);
  p.MKb = (bf16_t*)take(T * 512 * 2);
  p.MVt = (bf16_t*)take(T * 512 * 2);
  p.MOb = (bf16_t*)take(T * 512 * 2);
  p.MLGb = (bf16_t*)take(T * 512 * 2);
  p.Qa = (bf16_t*)take(T * 768 * 2);
  p.KNb = (bf16_t*)take(T * 512 * 2);
  p.VtA = (bf16_t*)take(T * 512 * 2);
  p.MIF = (float*)take(T * 16 * 4);
  const size_t odd_end = off;
  const size_t need = even_end > odd_end ? even_end : odd_end;
  if (need > ws_size) {
    fprintf(stderr, "kernel_launch: workspace too small: need %zu have %zu\n", need, ws_size);
    return;
  }
#if SINGLE_LAUNCH
  p.ph_lo = 0;
  p.ph_hi = NPHASE;
  void* args[] = {&p};
  hipError_t e = hipLaunchCooperativeKernel((const void*)mega_kernel, dim3(grid_blocks), dim3(256), args, LDS_BYTES, stream);
  if (e != hipSuccess) fprintf(stderr, "cooperative launch failed: %s (grid %d)\n", hipGetErrorString(e), grid_blocks);
#else
  for (int ph = 0; ph < NPHASE; ++ph) {
    p.ph_lo = ph;
    p.ph_hi = ph + 1;
    hipLaunchKernelGGL(mega_kernel, dim3(grid_blocks), dim3(256), LDS_BYTES, stream, p);
  }
#endif
}
```

```cpp
#include <hip/hip_runtime.h>
#include <hip/hip_cooperative_groups.h>
#include <cstdio>
namespace cg = cooperative_groups;

#ifndef SINGLE_LAUNCH
#define SINGLE_LAUNCH 1
#endif
#ifndef PHMASK
#define PHMASK 0xFFFF
#endif
#define PH_ON(b) ((PHMASK >> (b)) & 1)

typedef unsigned short bf16_t;
typedef __attribute__((ext_vector_type(8))) short bf16x8;
typedef __attribute__((ext_vector_type(4))) float f32x4;
typedef __attribute__((ext_vector_type(4))) unsigned short us4;

constexpr int T_TOK = 81920;
constexpr int T_P = 16384;
constexpr int DM = 1024;
constexpr int NE = 4128, NE_PAD = 4224;
constexpr int NO = 3760, NO_PAD = 3840;
constexpr float EPS = 1e-6f;
constexpr int NPHASE = 20;
constexpr int LDS_BYTES = 72 * 1024;

struct Params {
  const float *x_prompt, *x_sample, *norm_g, *final_norm_g, *e_w_in, *e_a_up, *e_a_bias, *e_gla_norm_g,
      *e_pool_w, *e_pool_scale, *e_w_out, *o_w_in, *o_q_norm_g, *o_q_up, *o_kv_norm_g, *o_kv_up, *o_if_bias,
      *o_ml_norm_g, *o_w_out;
  float* out;
  bf16_t *WinE, *WinO, *WoutE, *WoutO, *QupT, *KVupT, *PoolWT, *AupT;
  int* counters;
  bf16_t *Qb, *Kb, *VtE, *Gb, *LRb, *PUb, *PGb, *TMP;
  bf16_t *TMP2, *CQb, *CKVb, *KRb, *MGb, *MQb, *MKb, *MVt, *MOb, *MLGb, *Qa, *KNb, *VtA;
  float* MIF;
  int ph_lo, ph_hi;
};

__device__ __forceinline__ bf16_t f2bf(float f) {
  unsigned u = __float_as_uint(f);
  u += 0x7fffu + ((u >> 16) & 1u);
  return (bf16_t)(u >> 16);
}
__device__ __forceinline__ float bf2f(bf16_t b) { return __uint_as_float(((unsigned)b) << 16); }
__device__ __forceinline__ f32x4 mfma16(bf16x8 a, bf16x8 b, f32x4 c) {
  return __builtin_amdgcn_mfma_f32_16x16x32_bf16(a, b, c, 0, 0, 0);
}
__device__ __forceinline__ float logsigmoidf_(float x) { return fminf(x, 0.f) - log1pf(__expf(-fabsf(x))); }
__device__ __forceinline__ float siluf_(float x) { return x / (1.f + __expf(-x)); }
__device__ __forceinline__ float sigmoidf_(float x) { return 1.f / (1.f + __expf(-x)); }
__device__ __forceinline__ int otid() { int t = threadIdx.x; asm volatile("" : "+v"(t)); return t; }
__device__ __forceinline__ bf16x8 zero8() { bf16x8 z = {0, 0, 0, 0, 0, 0, 0, 0}; return z; }
__device__ __forceinline__ f32x4 zero4() { f32x4 z = {0.f, 0.f, 0.f, 0.f}; return z; }

__device__ __forceinline__ int seq_pos(int tok) { return tok < T_P ? (tok & 4095) : ((tok - T_P) & 8191); }
__device__ __forceinline__ const float* xrow(const float* xa, const float* xb, int tok) {
  return tok < T_P ? xa + (long)tok * DM : xb + (long)(tok - T_P) * DM;
}

__device__ void prep_weight(const float* __restrict__ W, int K, int N, int Npad, const float* __restrict__ gsc,
                            bf16_t* __restrict__ out, long gtid, long gsize) {
  long total = (long)Npad * K;
  for (long idx = gtid; idx < total; idx += gsize) {
    int k = (int)(idx / Npad);
    int n = (int)(idx % Npad);
    float v = 0.f;
    if (n < N) {
      v = W[(long)k * N + n];
      if (gsc) v *= gsc[k];
    }
    out[(long)n * K + k] = f2bf(v);
  }
}

__device__ void phase_prep(const Params& p) {
  long gtid = (long)blockIdx.x * 256 + otid();
  long gsize = (long)gridDim.x * 256;
  for (int l = 0; l < 2; ++l) {
    prep_weight(p.e_w_in + (long)l * DM * NE, DM, NE, NE_PAD, p.norm_g + (2 * l) * DM, p.WinE + (long)l * NE_PAD * DM, gtid, gsize);
    prep_weight(p.o_w_in + (long)l * DM * NO, DM, NO, NO_PAD, p.norm_g + (2 * l + 1) * DM, p.WinO + (long)l * NO_PAD * DM, gtid, gsize);
    prep_weight(p.e_w_out + (long)l * 1536 * DM, 1536, DM, DM, nullptr, p.WoutE + (long)l * DM * 1536, gtid, gsize);
    prep_weight(p.o_w_out + (long)l * 1024 * DM, 1024, DM, DM, nullptr, p.WoutO + (long)l * DM * 1024, gtid, gsize);
    prep_weight(p.o_q_up + (long)l * 384 * 768, 384, 768, 768, p.o_q_norm_g + l * 384, p.QupT + (long)l * 768 * 384, gtid, gsize);
    prep_weight(p.o_kv_up + (long)l * 256 * 1024, 256, 1024, 1024, p.o_kv_norm_g + l * 256, p.KVupT + (long)l * 1024 * 256, gtid, gsize);
    for (int gi = 0; gi < 4; ++gi)
      prep_weight(p.e_pool_w + (long)(l * 4 + gi) * 128 * 128, 128, 128, 128, nullptr, p.PoolWT + (long)(l * 4 + gi) * 128 * 128, gtid, gsize);
    for (long idx = gtid; idx < 2 * 512 * 32; idx += gsize) {
      int r = (int)(idx & 31);
      int d = (int)((idx >> 5) & 511);
      int dir = (int)(idx >> 14);
      float v = (r < 16) ? p.e_a_up[((long)(l * 2 + dir) * 16 + r) * 512 + d] : 0.f;
      p.AupT[((long)(l * 2 + dir) * 512 + d) * 32 + r] = f2bf(v);
    }
  }
  if (gtid < 16) p.counters[gtid] = 0;
}

constexpr int LDT = 72;
#define GEMM_GLOAD(KT)                                                                         \
  {                                                                                            \
    const int k0_ = (KT) * 64;                                                                 \
    if constexpr (AMODE == 0) {                                                                \
      _Pragma("unroll") for (int i = 0; i < 8; ++i) {                                          \
        int id = tid + 256 * i;                                                                \
        int row = id >> 4, c4 = id & 15;                                                       \
        raf[i] = *(const f32x4*)(xrow(xa, xb, m0 + row) + k0_ + 4 * c4);                       \
      }                                                                                        \
    } else {                                                                                   \
      const bf16_t* base_;                                                                     \
      int ld_;                                                                                 \
      if (k0_ < K1) { base_ = A1 + k0_; ld_ = ld1; } else { base_ = A2 + (k0_ - K1); ld_ = ld2; } \
      _Pragma("unroll") for (int i = 0; i < 4; ++i) {                                          \
        int id = tid + 256 * i;                                                                \
        int row = id >> 3, c8 = id & 7;                                                        \
        rab[i] = *(const bf16x8*)(base_ + (long)(m0 + row) * ld_ + 8 * c8);                     \
      }                                                                                        \
    }                                                                                          \
    _Pragma("unroll") for (int i = 0; i < 4; ++i) {                                            \
      int id = tid + 256 * i;                                                                  \
      int row = id >> 3, c8 = id & 7;                                                          \
      rb[i] = *(const bf16x8*)(Bt + (long)(n0 + row) * K + k0_ + 8 * c8);                       \
    }                                                                                          \
  }

template <int AMODE, class Epi>
__device__ void gemm_phase(int Mtiles, int Ntiles, int K, const bf16_t* __restrict__ Bt, const float* xa, const float* xb,
                           const bf16_t* A1, int ld1, int K1, const bf16_t* A2, int ld2, const Epi& epi, char* smem) {
  bf16_t* sA = (bf16_t*)smem;
  bf16_t* sB = sA + 128 * LDT;
  float* sR = (float*)(sB + 128 * LDT);
  const int tid = otid(), lane = tid & 63, w = tid >> 6, c = lane & 15, g = lane >> 4;
  const int wm = w >> 1, wn = w & 1;
  const int nk = K / 64;
  const int ntiles = Mtiles * Ntiles;
  for (int tile = blockIdx.x; tile < ntiles; tile += gridDim.x) {
    const int mt = tile / Ntiles, nt = tile % Ntiles;
    const int m0 = mt * 128, n0 = nt * 128;
    f32x4 acc[4][4];
#pragma unroll
    for (int i = 0; i < 4; ++i)
#pragma unroll
      for (int j = 0; j < 4; ++j) acc[i][j] = zero4();
    float ss[8];
#pragma unroll
    for (int i = 0; i < 8; ++i) ss[i] = 0.f;
    f32x4 raf[8];
    bf16x8 rab[4];
    bf16x8 rb[4];
    GEMM_GLOAD(0)
    for (int kt = 0; kt < nk; ++kt) {
      __syncthreads();
      if constexpr (AMODE == 0) {
#pragma unroll
        for (int i = 0; i < 8; ++i) {
          int id = tid + 256 * i;
          int row = id >> 4, c4 = id & 15;
          f32x4 v = raf[i];
          ss[i] += v[0] * v[0] + v[1] * v[1] + v[2] * v[2] + v[3] * v[3];
          us4 o;
          o[0] = f2bf(v[0]); o[1] = f2bf(v[1]); o[2] = f2bf(v[2]); o[3] = f2bf(v[3]);
          *(us4*)(sA + row * LDT + 4 * c4) = o;
        }
      } else {
#pragma unroll
        for (int i = 0; i < 4; ++i) {
          int id = tid + 256 * i;
          int row = id >> 3, c8 = id & 7;
          bf16x8 v = rab[i];
          if constexpr (AMODE == 2) {
#pragma unroll
            for (int e = 0; e < 8; ++e) {
              float f = bf2f((bf16_t)v[e]);
              ss[i] += f * f;
            }
          }
          *(bf16x8*)(sA + row * LDT + 8 * c8) = v;
        }
      }
#pragma unroll
      for (int i = 0; i < 4; ++i) {
        int id = tid + 256 * i;
        int row = id >> 3, c8 = id & 7;
        *(bf16x8*)(sB + row * LDT + 8 * c8) = rb[i];
      }
      __syncthreads();
      if (kt + 1 < nk) GEMM_GLOAD(kt + 1)
#pragma unroll
      for (int ks = 0; ks < 2; ++ks) {
        bf16x8 af[4];
#pragma unroll
        for (int mi = 0; mi < 4; ++mi) af[mi] = *(const bf16x8*)(sA + (wm * 64 + mi * 16 + c) * LDT + ks * 32 + g * 8);
#pragma unroll
        for (int ni = 0; ni < 4; ++ni) {
          bf16x8 bfr = *(const bf16x8*)(sB + (wn * 64 + ni * 16 + c) * LDT + ks * 32 + g * 8);
#pragma unroll
          for (int mi = 0; mi < 4; ++mi) acc[mi][ni] = mfma16(af[mi], bfr, acc[mi][ni]);
        }
      }
    }
    if constexpr (AMODE == 0) {
#pragma unroll
      for (int i = 0; i < 8; ++i) {
        float s = ss[i];
        s += __shfl_xor(s, 1); s += __shfl_xor(s, 2); s += __shfl_xor(s, 4); s += __shfl_xor(s, 8);
        if ((tid & 15) == 0) sR[(tid >> 4) + 16 * i] = rsqrtf(s / (float)K + EPS);
      }
      __syncthreads();
    } else if constexpr (AMODE == 2) {
#pragma unroll
      for (int i = 0; i < 4; ++i) {
        float s = ss[i];
        s += __shfl_xor(s, 1); s += __shfl_xor(s, 2); s += __shfl_xor(s, 4);
        if ((tid & 7) == 0) sR[(tid >> 3) + 32 * i] = rsqrtf(s / (float)K + EPS);
      }
      __syncthreads();
    }
    epi(m0, n0, wm, wn, g, c, acc, sR);
  }
}

struct EpiEvenIn {
  bf16_t *Qb, *Kb, *VtE, *Gb, *LRb, *PUb, *PGb;
  __device__ void operator()(int m0, int n0, int wm, int wn, int g, int c, f32x4 (&acc)[4][4], const float* sR) const {
#pragma unroll
    for (int ni = 0; ni < 4; ++ni) {
      const int col0 = n0 + wn * 64 + ni * 16;
      if (col0 >= NE) continue;
      const int col = col0 + c;
#pragma unroll
      for (int mi = 0; mi < 4; ++mi) {
        const int rowb = wm * 64 + mi * 16 + 4 * g;
        const long tok = m0 + rowb;
        float v[4];
#pragma unroll
        for (int j = 0; j < 4; ++j) v[j] = acc[mi][ni][j] * sR[rowb + j];
        if (col0 < 512) {
#pragma unroll
          for (int j = 0; j < 4; ++j) Qb[(tok + j) * 512 + col] = f2bf(v[j]);
        } else if (col0 < 1024) {
#pragma unroll
          for (int j = 0; j < 4; ++j) Kb[(tok + j) * 512 + (col - 512)] = f2bf(v[j]);
        } else if (col0 < 2048) {
          us4 o; o[0] = f2bf(v[0]); o[1] = f2bf(v[1]); o[2] = f2bf(v[2]); o[3] = f2bf(v[3]);
          *(us4*)(VtE + (long)(col - 1024) * T_TOK + tok) = o;
        } else if (col0 < 3072) {
#pragma unroll
          for (int j = 0; j < 4; ++j) Gb[(tok + j) * 1024 + (col - 2048)] = f2bf(v[j]);
        } else if (col0 < 3104) {
#pragma unroll
          for (int j = 0; j < 4; ++j) LRb[(tok + j) * 32 + (col - 3072)] = f2bf(v[j]);
        } else if (col0 < 3616) {
#pragma unroll
          for (int j = 0; j < 4; ++j) PUb[(tok + j) * 512 + (col - 3104)] = f2bf(v[j]);
        } else {
#pragma unroll
          for (int j = 0; j < 4; ++j) PGb[(tok + j) * 512 + (col - 3616)] = f2bf(v[j]);
        }
      }
    }
  }
};

__device__ __forceinline__ void rope_cs(int pos, int i, float& co, float& si) {
  float inv = exp2f(-(float)i * (13.287712379549449f / 16.f));
  float ang = (float)pos * inv;
  double r = (double)ang * 0.15915494309189535;
  r -= rint(r);
  float rf = (float)r;
  si = __builtin_amdgcn_sinf(rf);
  co = __builtin_amdgcn_cosf(rf);
}

struct EpiOddIn {
  bf16_t *CQb, *CKVb, *KRb, *MGb, *MQb, *MKb, *MVt, *MOb, *MLGb;
  float* MIF;
  __device__ void operator()(int m0, int n0, int wm, int wn, int g, int c, f32x4 (&acc)[4][4], const float* sR) const {
#pragma unroll
    for (int ni = 0; ni < 4; ++ni) {
      const int col0 = n0 + wn * 64 + ni * 16;
      if (col0 >= NO) continue;
      if (col0 == 656) continue;
      const int col = col0 + c;
#pragma unroll
      for (int mi = 0; mi < 4; ++mi) {
        const int rowb = wm * 64 + mi * 16 + 4 * g;
        const long tok = m0 + rowb;
        float v[4];
#pragma unroll
        for (int j = 0; j < 4; ++j) v[j] = acc[mi][ni][j] * sR[rowb + j];
        if (col0 < 384) {
#pragma unroll
          for (int j = 0; j < 4; ++j) CQb[(tok + j) * 384 + col] = f2bf(v[j]);
        } else if (col0 < 640) {
#pragma unroll
          for (int j = 0; j < 4; ++j) CKVb[(tok + j) * 256 + (col - 384)] = f2bf(v[j]);
        } else if (col0 == 640) {
          if (ni < 3) {
#pragma unroll
            for (int j = 0; j < 4; ++j) {
              float x1 = v[j];
              float x2 = acc[mi][(ni + 1) & 3][j] * sR[rowb + j];
              float co, si;
              rope_cs(seq_pos((int)tok + j), c, co, si);
              KRb[(tok + j) * 32 + c] = f2bf(x1 * co - x2 * si);
              KRb[(tok + j) * 32 + 16 + c] = f2bf(x2 * co + x1 * si);
            }
          }
        } else if (col0 < 1184) {
#pragma unroll
          for (int j = 0; j < 4; ++j) MGb[(tok + j) * 512 + (col - 672)] = f2bf(v[j]);
        } else if (col0 < 1696) {
#pragma unroll
          for (int j = 0; j < 4; ++j) MQb[(tok + j) * 512 + (col - 1184)] = f2bf(v[j]);
        } else if (col0 < 2208) {
#pragma unroll
          for (int j = 0; j < 4; ++j) MKb[(tok + j) * 512 + (col - 1696)] = f2bf(v[j]);
        } else if (col0 < 2720) {
          us4 o; o[0] = f2bf(v[0]); o[1] = f2bf(v[1]); o[2] = f2bf(v[2]); o[3] = f2bf(v[3]);
          *(us4*)(MVt + (long)(col - 2208) * T_TOK + tok) = o;
        } else if (col0 < 3232) {
#pragma unroll
          for (int j = 0; j < 4; ++j) MOb[(tok + j) * 512 + (col - 2720)] = f2bf(v[j]);
        } else if (col0 < 3248) {
#pragma unroll
          for (int j = 0; j < 4; ++j) MIF[(tok + j) * 16 + (col - 3232)] = v[j];
        } else {
#pragma unroll
          for (int j = 0; j < 4; ++j) MLGb[(tok + j) * 512 + (col - 3248)] = f2bf(v[j]);
        }
      }
    }
  }
};

struct EpiQUp {
  bf16_t* Qa;
  __device__ void operator()(int m0, int n0, int wm, int wn, int g, int c, f32x4 (&acc)[4][4], const float* sR) const {
    const float qs = 0.10206207261596575f;
#pragma unroll
    for (int ni = 0; ni < 4; ++ni) {
      const int col0 = n0 + wn * 64 + ni * 16;
      const int within0 = col0 % 96;
      if (within0 == 80) continue;
      const int col = col0 + c;
#pragma unroll
      for (int mi = 0; mi < 4; ++mi) {
        const int rowb = wm * 64 + mi * 16 + 4 * g;
        const long tok = m0 + rowb;
        if (within0 == 64) {
          if (ni < 3) {
#pragma unroll
            for (int j = 0; j < 4; ++j) {
              float r = sR[rowb + j];
              float x1 = acc[mi][ni][j] * r;
              float x2 = acc[mi][(ni + 1) & 3][j] * r;
              float co, si;
              rope_cs(seq_pos((int)tok + j), c, co, si);
              Qa[(tok + j) * 768 + col] = f2bf((x1 * co - x2 * si) * qs);
              Qa[(tok + j) * 768 + col + 16] = f2bf((x2 * co + x1 * si) * qs);
            }
          }
        } else {
#pragma unroll
          for (int j = 0; j < 4; ++j) Qa[(tok + j) * 768 + col] = f2bf(acc[mi][ni][j] * sR[rowb + j] * qs);
        }
      }
    }
  }
};

struct EpiKVUp {
  bf16_t *KNb, *VtA;
  __device__ void operator()(int m0, int n0, int wm, int wn, int g, int c, f32x4 (&acc)[4][4], const float* sR) const {
#pragma unroll
    for (int ni = 0; ni < 4; ++ni) {
      const int col0 = n0 + wn * 64 + ni * 16;
      const int head = col0 >> 7, within0 = col0 & 127;
#pragma unroll
      for (int mi = 0; mi < 4; ++mi) {
        const int rowb = wm * 64 + mi * 16 + 4 * g;
        const long tok = m0 + rowb;
        float v[4];
#pragma unroll
        for (int j = 0; j < 4; ++j) v[j] = acc[mi][ni][j] * sR[rowb + j];
        if (within0 < 64) {
#pragma unroll
          for (int j = 0; j < 4; ++j) KNb[(tok + j) * 512 + head * 64 + within0 + c] = f2bf(v[j]);
        } else {
          us4 o; o[0] = f2bf(v[0]); o[1] = f2bf(v[1]); o[2] = f2bf(v[2]); o[3] = f2bf(v[3]);
          *(us4*)(VtA + (long)(head * 64 + within0 - 64 + c) * T_TOK + tok) = o;
        }
      }
    }
  }
};

struct EpiOut {
  const float *xa, *xb;
  float* out;
  __device__ void operator()(int m0, int n0, int wm, int wn, int g, int c, f32x4 (&acc)[4][4], const float* sR) const {
#pragma unroll
    for (int ni = 0; ni < 4; ++ni) {
      const int col = n0 + wn * 64 + ni * 16 + c;
#pragma unroll
      for (int mi = 0; mi < 4; ++mi) {
        const int tok = m0 + wm * 64 + mi * 16 + 4 * g;
#pragma unroll
        for (int j = 0; j < 4; ++j) {
          float xo = xrow(xa, xb, tok + j)[col];
          out[(long)(tok + j) * DM + col] = xo + acc[mi][ni][j];
        }
      }
    }
  }
};

__device__ __forceinline__ float scan16(float v, int c) {
  float t;
  t = __shfl_up(v, 1, 16); if (c >= 1) v += t;
  t = __shfl_up(v, 2, 16); if (c >= 2) v += t;
  t = __shfl_up(v, 4, 16); if (c >= 4) v += t;
  t = __shfl_up(v, 8, 16); if (c >= 8) v += t;
  return v;
}

template <int DIR>
__device__ __forceinline__ void gla_chunk(const Params& p, int h, int sl, int tokc, bool second, const bf16x8 (&aup)[2],
                                          const float (&bias)[2][4], f32x4 (&S)[2][2], bf16_t* sQe, bf16_t* sKd,
                                          bf16_t* sKdT, bf16_t* sA, bf16_t* sSt, float* sEb) {
  const int tid = otid(), lane = tid & 63, w = tid >> 6, c = lane & 15, g = lane >> 4;
  const float qscale = 0.08838834764831845f;
  bf16x8 vf[2][2];
#pragma unroll
  for (int vt = 0; vt < 2; ++vt)
#pragma unroll
    for (int k2 = 0; k2 < 2; ++k2)
      vf[vt][k2] = *(const bf16x8*)(p.VtE + (long)(h * 256 + sl * 32 + 16 * vt + c) * T_TOK + tokc + 32 * k2 + 8 * g);
  f32x4 la[2][4];
#pragma unroll
  for (int tt = 0; tt < 4; ++tt) {
    bf16x8 lrf = zero8();
    if (g < 2) lrf = *(const bf16x8*)(p.LRb + (long)(tokc + 16 * tt + c) * 32 + DIR * 16 + 8 * g);
#pragma unroll
    for (int dt = 0; dt < 2; ++dt) la[dt][tt] = mfma16(aup[dt], lrf, zero4());
  }
#pragma unroll
  for (int dt = 0; dt < 2; ++dt)
#pragma unroll
    for (int tt = 0; tt < 4; ++tt)
#pragma unroll
      for (int j = 0; j < 4; ++j) la[dt][tt][j] = logsigmoidf_(la[dt][tt][j] + bias[dt][j]) * (1.f / 16.f);
  f32x4 P[2][4];
  float tot[2][4];
#pragma unroll
  for (int dt = 0; dt < 2; ++dt)
#pragma unroll
    for (int j = 0; j < 4; ++j) {
      float carry = 0.f;
#pragma unroll
      for (int tt = 0; tt < 4; ++tt) {
        float v = scan16(la[dt][tt][j], c) + carry;
        P[dt][tt][j] = v;
        carry = __shfl(v, 15, 16);
      }
      tot[dt][j] = carry;
    }
#pragma unroll
  for (int dt = 0; dt < 2; ++dt)
#pragma unroll
    for (int tt = 0; tt < 4; ++tt) {
      const long off = (long)(tokc + 16 * tt + c) * 512 + h * 128 + 32 * w + 16 * dt + 4 * g;
      us4 q4 = *(const us4*)(p.Qb + off);
      us4 k4 = *(const us4*)(p.Kb + off);
      us4 qo, ko;
#pragma unroll
      for (int j = 0; j < 4; ++j) {
        float b = (DIR == 0) ? P[dt][tt][j] : (tot[dt][j] - P[dt][tt][j] + la[dt][tt][j]);
        float qe = bf2f(q4[j]) * __expf(b) * qscale;
        float kd = bf2f(k4[j]) * __expf(-b);
        qo[j] = f2bf(qe);
        ko[j] = f2bf(kd);
        sKdT[(32 * w + 16 * dt + 4 * g + j) * 72 + 16 * tt + c] = ko[j];
      }
      *(us4*)(sQe + (16 * tt + c) * 136 + 32 * w + 16 * dt + 4 * g) = qo;
      *(us4*)(sKd + (16 * tt + c) * 136 + 32 * w + 16 * dt + 4 * g) = ko;
    }
  if (c == 0) {
#pragma unroll
    for (int dt = 0; dt < 2; ++dt)
#pragma unroll
      for (int j = 0; j < 4; ++j) sEb[32 * w + 16 * dt + 4 * g + j] = __expf(tot[dt][j]);
  }
#pragma unroll
  for (int vt = 0; vt < 2; ++vt)
#pragma unroll
    for (int dt = 0; dt < 2; ++dt)
#pragma unroll
      for (int j = 0; j < 4; ++j) sSt[(16 * vt + 4 * g + j) * 136 + 32 * w + 16 * dt + c] = f2bf(S[vt][dt][j]);
  __syncthreads();
  bf16x8 aq[4];
  f32x4 accA[4];
#pragma unroll
  for (int jt = 0; jt < 4; ++jt) accA[jt] = zero4();
#pragma unroll
  for (int ks = 0; ks < 4; ++ks) {
    aq[ks] = *(const bf16x8*)(sQe + (16 * w + c) * 136 + 32 * ks + 8 * g);
#pragma unroll
    for (int jt = 0; jt < 4; ++jt) {
      bf16x8 bk = *(const bf16x8*)(sKd + (16 * jt + c) * 136 + 32 * ks + 8 * g);
      accA[jt] = mfma16(aq[ks], bk, accA[jt]);
    }
  }
#pragma unroll
  for (int jt = 0; jt < 4; ++jt)
#pragma unroll
    for (int j = 0; j < 4; ++j) {
      const int i = 16 * w + 4 * g + j, jj = 16 * jt + c;
      const bool keep = (DIR == 0) ? (jj <= i) : (jj > i);
      sA[i * 72 + jj] = f2bf(keep ? accA[jt][j] : 0.f);
    }
  __syncthreads();
  f32x4 o[2];
  o[0] = zero4(); o[1] = zero4();
#pragma unroll
  for (int k2 = 0; k2 < 2; ++k2) {
    bf16x8 af = *(const bf16x8*)(sA + (16 * w + c) * 72 + 32 * k2 + 8 * g);
#pragma unroll
    for (int vt = 0; vt < 2; ++vt) o[vt] = mfma16(af, vf[vt][k2], o[vt]);
  }
#pragma unroll
  for (int ks = 0; ks < 4; ++ks)
#pragma unroll
    for (int vt = 0; vt < 2; ++vt) {
      bf16x8 sf = *(const bf16x8*)(sSt + (16 * vt + c) * 136 + 32 * ks + 8 * g);
      o[vt] = mfma16(aq[ks], sf, o[vt]);
    }
#pragma unroll
  for (int vt = 0; vt < 2; ++vt)
#pragma unroll
    for (int j = 0; j < 4; ++j) {
      const long addr = (long)(tokc + 16 * w + 4 * g + j) * 1024 + h * 256 + sl * 32 + 16 * vt + c;
      float val = o[vt][j];
      if (second) val += bf2f(p.TMP[addr]);
      p.TMP[addr] = f2bf(val);
    }
#pragma unroll
  for (int dt = 0; dt < 2; ++dt) {
    const float ebl = sEb[32 * w + 16 * dt + c];
#pragma unroll
    for (int vt = 0; vt < 2; ++vt) {
      f32x4 a = S[vt][dt];
#pragma unroll
      for (int k2 = 0; k2 < 2; ++k2) {
        bf16x8 kf = *(const bf16x8*)(sKdT + (32 * w + 16 * dt + c) * 72 + 32 * k2 + 8 * g);
        a = mfma16(vf[vt][k2], kf, a);
      }
      S[vt][dt] = a * ebl;
    }
  }
  __syncthreads();
}

__device__ void gla_chain_item(const Params& p, int li, int item, char* smem) {
  const int tid = otid(), lane = tid & 63, w = tid >> 6, c = lane & 15, g = lane >> 4;
  int s, rem;
  if (item < 256) { s = 4 + item / 32; rem = item % 32; } else { s = (item - 256) / 32; rem = (item - 256) % 32; }
  const int h = rem >> 3, sl = rem & 7;
  const int tok0 = s < 4 ? s * 4096 : T_P + (s - 4) * 8192;
  const int len = s < 4 ? 4096 : 8192;
  const int N = len / 64;
  bf16_t* sQe = (bf16_t*)smem;
  bf16_t* sKd = sQe + 64 * 136;
  bf16_t* sKdT = sKd + 64 * 136;
  bf16_t* sA = sKdT + 128 * 72;
  bf16_t* sSt = sA + 64 * 72;
  float* sEb = (float*)(sSt + 32 * 136);
  bf16x8 aup[2][2];
  float bias[2][2][4];
#pragma unroll
  for (int dir = 0; dir < 2; ++dir)
#pragma unroll
    for (int dt = 0; dt < 2; ++dt) {
      aup[dir][dt] = zero8();
      if (g < 2) aup[dir][dt] = *(const bf16x8*)(p.AupT + ((long)(li * 2 + dir) * 512 + h * 128 + 32 * w + 16 * dt + c) * 32 + 8 * g);
#pragma unroll
      for (int j = 0; j < 4; ++j) bias[dir][dt][j] = p.e_a_bias[(li * 2 + dir) * 512 + h * 128 + 32 * w + 16 * dt + 4 * g + j];
    }
  f32x4 Sf[2][2], Sb[2][2];
#pragma unroll
  for (int a = 0; a < 2; ++a)
#pragma unroll
    for (int b = 0; b < 2; ++b) { Sf[a][b] = zero4(); Sb[a][b] = zero4(); }
  __syncthreads();
  for (int step = 0; step < N; ++step) {
    const bool second = step >= (N >> 1);
    gla_chunk<0>(p, h, sl, tok0 + step * 64, second, aup[0], bias[0], Sf, sQe, sKd, sKdT, sA, sSt, sEb);
    gla_chunk<1>(p, h, sl, tok0 + (N - 1 - step) * 64, second, aup[1], bias[1], Sb, sQe, sKd, sKdT, sA, sSt, sEb);
  }
}

__device__ void pool_item(const Params& p, int li, int item, char* smem) {
  const int tid = otid(), lane = tid & 63, w = tid >> 6, c = lane & 15, g = lane >> 4;
  const int gi = item & 3;
  const int tile = item >> 2;
  const int tokc = tile * 64;
  const int pos0 = seq_pos(tokc);
  const int len = tokc < T_P ? 4096 : 8192;
  float* sU = (float*)smem;
  bf16_t* sP = (bf16_t*)(sU + 80 * 128);
  __syncthreads();
  for (int idx = tid; idx < 80 * 128; idx += 256) {
    int r = idx >> 7, ch = idx & 127;
    int pos = pos0 - 8 + r;
    float v = 0.f;
    if (pos >= 0 && pos < len) v = bf2f(p.PUb[(long)(tokc - 8 + r) * 512 + gi * 128 + ch]);
    sU[idx] = v;
  }
  __syncthreads();
  {
    const int ch = tid & 127, th = tid >> 7;
    const int half = 1 << gi;
    for (int t = th * 32; t < th * 32 + 32; ++t) {
      int pos = pos0 + t;
      int lo = max(pos - half, 0), hi = min(pos + half, len);
      float s = 0.f;
      for (int q = lo; q < hi; ++q) s += sU[(q - pos0 + 8) * 128 + ch];
      float pooled = s / (float)(hi - lo) - sU[(t + 8) * 128 + ch];
      sP[t * 136 + ch] = f2bf(pooled);
    }
  }
  __syncthreads();
  f32x4 acc[8];
#pragma unroll
  for (int dt = 0; dt < 8; ++dt) acc[dt] = zero4();
  const bf16_t* PW = p.PoolWT + (long)(li * 4 + gi) * 128 * 128;
#pragma unroll
  for (int ks = 0; ks < 4; ++ks) {
    bf16x8 af = *(const bf16x8*)(sP + (16 * w + c) * 136 + 32 * ks + 8 * g);
#pragma unroll
    for (int dt = 0; dt < 8; ++dt) {
      bf16x8 bw = *(const bf16x8*)(PW + (long)(16 * dt + c) * 128 + 32 * ks + 8 * g);
      acc[dt] = mfma16(af, bw, acc[dt]);
    }
  }
#pragma unroll
  for (int dt = 0; dt < 8; ++dt) {
    const int d = gi * 128 + 16 * dt + c;
    const float sc = p.e_pool_scale[li * 512 + d];
#pragma unroll
    for (int j = 0; j < 4; ++j) {
      const long addr = (long)(tokc + 16 * w + 4 * g + j) * 512 + d;
      float gt = bf2f(p.PGb[addr]);
      p.PGb[addr] = f2bf(acc[dt][j] * sc * siluf_(gt));
    }
  }
}

template <int DIR>
__device__ __forceinline__ void ml_chunk(const Params& p, int li, int h, int sl, int tokc, bool second, float& mstate,
                                         f32x4 (&C)[3][2], bf16_t* sKwT, bf16_t* sA, bf16_t* sCt, float* sc) {
  const int tid = otid(), lane = tid & 63, w = tid >> 6, c = lane & 15, g = lane >> 4;
  const float kscale = 0.08838834764831845f;
  float* sRA = sc;
  float* sCB = sc + 64;
  float* sE = sc + 128;
  float* sThr = sc + 192;
  float* sWk = sc + 256;
  float* sMisc = sc + 320;
  if (w == 0) {
    const float bi = p.o_if_bias[li * 16 + DIR * 4 + h];
    const float bff = p.o_if_bias[li * 16 + 8 + DIR * 4 + h];
    const float* mf = p.MIF + (long)(tokc + lane) * 16;
    const float liv = mf[DIR * 4 + h] + bi;
    const float lfv = logsigmoidf_(mf[8 + DIR * 4 + h] + bff);
    float ps = lfv;
#pragma unroll
    for (int d = 1; d < 64; d <<= 1) {
      float t = __shfl_up(ps, d);
      if (lane >= d) ps += t;
    }
    const float total = __shfl(ps, 63);
    const float b = (DIR == 0) ? ps : (total - ps + lfv);
    const float cB = liv - b;
    float pm = cB;
    if (DIR == 0) {
#pragma unroll
      for (int d = 1; d < 64; d <<= 1) {
        float t = __shfl_up(pm, d);
        if (lane >= d) pm = fmaxf(pm, t);
      }
    } else {
#pragma unroll
      for (int d = 1; d < 64; d <<= 1) {
        float t = __shfl_down(pm, d);
        if (lane + d < 64) pm = fmaxf(pm, t);
      }
      float t = __shfl_down(pm, 1);
      pm = (lane < 63) ? t : -1e30f;
    }
    const float m = mstate;
    const float M = fmaxf(m, pm);
    sRA[lane] = -M;
    sCB[lane] = cB;
    sE[lane] = __expf(m - M);
    sThr[lane] = __expf(-b - M);
    float mall = cB;
#pragma unroll
    for (int d = 1; d < 64; d <<= 1) mall = fmaxf(mall, __shfl_xor(mall, d));
    const float Mn = fmaxf(m, mall);
    sWk[lane] = __expf(cB - Mn);
    if (lane == 0) {
      sMisc[0] = __expf(m - Mn);
      sMisc[1] = total + Mn;
    }
  }
#pragma unroll
  for (int vt = 0; vt < 3; ++vt)
#pragma unroll
    for (int dt = 0; dt < 2; ++dt)
#pragma unroll
      for (int j = 0; j < 4; ++j) sCt[(16 * vt + 4 * g + j) * 136 + 32 * w + 16 * dt + c] = f2bf(C[vt][dt][j]);
  bf16x8 vf[2][2];
#pragma unroll
  for (int vt = 0; vt < 2; ++vt)
#pragma unroll
    for (int k2 = 0; k2 < 2; ++k2)
      vf[vt][k2] = *(const bf16x8*)(p.MVt + (long)(h * 128 + sl * 32 + 16 * vt + c) * T_TOK + tokc + 32 * k2 + 8 * g);
  bf16x8 ones = zero8();
  if (c == 0) {
#pragma unroll
    for (int e = 0; e < 8; ++e) ones[e] = (short)0x3F80;
  }
  bf16x8 aq[4];
#pragma unroll
  for (int ks = 0; ks < 4; ++ks) aq[ks] = *(const bf16x8*)(p.MQb + (long)(tokc + 16 * w + c) * 512 + h * 128 + 32 * ks + 8 * g);
  __syncthreads();
  const float decay = sMisc[0];
  mstate = sMisc[1];
#pragma unroll
  for (int i = 0; i < 4; ++i) {
    const int id = tid + 256 * i;
    const int tk = id >> 4, c8 = id & 15;
    bf16x8 kv = *(const bf16x8*)(p.MKb + (long)(tokc + tk) * 512 + h * 128 + 8 * c8);
    const float wk = sWk[tk] * kscale;
#pragma unroll
    for (int e = 0; e < 8; ++e) sKwT[(8 * c8 + e) * 72 + tk] = f2bf(bf2f((bf16_t)kv[e]) * wk);
  }
  f32x4 accA[4];
#pragma unroll
  for (int jt = 0; jt < 4; ++jt) accA[jt] = zero4();
#pragma unroll
  for (int ks = 0; ks < 4; ++ks)
#pragma unroll
    for (int jt = 0; jt < 4; ++jt) {
      bf16x8 bk = *(const bf16x8*)(p.MKb + (long)(tokc + 16 * jt + c) * 512 + h * 128 + 32 * ks + 8 * g);
      accA[jt] = mfma16(aq[ks], bk, accA[jt]);
    }
#pragma unroll
  for (int jt = 0; jt < 4; ++jt)
#pragma unroll
    for (int j = 0; j < 4; ++j) {
      const int i = 16 * w + 4 * g + j, jj = 16 * jt + c;
      const bool keep = (DIR == 0) ? (jj <= i) : (jj > i);
      float sv = keep ? accA[jt][j] * kscale * __expf(sRA[i] + sCB[jj]) : 0.f;
      sA[i * 72 + jj] = f2bf(sv);
    }
  __syncthreads();
  f32x4 o1[3], o2[3];
#pragma unroll
  for (int vt = 0; vt < 3; ++vt) { o1[vt] = zero4(); o2[vt] = zero4(); }
#pragma unroll
  for (int k2 = 0; k2 < 2; ++k2) {
    bf16x8 af = *(const bf16x8*)(sA + (16 * w + c) * 72 + 32 * k2 + 8 * g);
    o1[0] = mfma16(af, vf[0][k2], o1[0]);
    o1[1] = mfma16(af, vf[1][k2], o1[1]);
    o1[2] = mfma16(af, ones, o1[2]);
  }
#pragma unroll
  for (int ks = 0; ks < 4; ++ks)
#pragma unroll
    for (int vt = 0; vt < 3; ++vt) {
      bf16x8 cf = *(const bf16x8*)(sCt + (16 * vt + c) * 136 + 32 * ks + 8 * g);
      o2[vt] = mfma16(aq[ks], cf, o2[vt]);
    }
#pragma unroll
  for (int j = 0; j < 4; ++j) {
    const int i = 16 * w + 4 * g + j;
    const float e = sE[i], thr = sThr[i];
    float den = o1[2][j] + e * o2[2][j];
    den = __shfl(den, lane & 48);
    const float dn = fmaxf(fabsf(den), thr);
#pragma unroll
    for (int vt = 0; vt < 2; ++vt) {
      float hv = (o1[vt][j] + e * o2[vt][j]) / dn;
      const long addr = (long)(tokc + i) * 512 + h * 128 + sl * 32 + 16 * vt + c;
      if (second) hv += bf2f(p.TMP2[addr]);
      p.TMP2[addr] = f2bf(hv);
    }
  }
#pragma unroll
  for (int dt = 0; dt < 2; ++dt)
#pragma unroll
    for (int vt = 0; vt < 3; ++vt) {
      f32x4 a = C[vt][dt] * decay;
#pragma unroll
      for (int k2 = 0; k2 < 2; ++k2) {
        bf16x8 kf = *(const bf16x8*)(sKwT + (32 * w + 16 * dt + c) * 72 + 32 * k2 + 8 * g);
        a = mfma16(vt < 2 ? vf[vt < 2 ? vt : 0][k2] : ones, kf, a);
      }
      C[vt][dt] = a;
    }
  __syncthreads();
}

__device__ void ml_chain_item(const Params& p, int li, int item, char* smem) {
  int s, rem;
  if (item < 128) { s = 4 + item / 16; rem = item % 16; } else { s = (item - 128) / 16; rem = (item - 128) % 16; }
  const int h = rem >> 2, sl = rem & 3;
  const int tok0 = s < 4 ? s * 4096 : T_P + (s - 4) * 8192;
  const int len = s < 4 ? 4096 : 8192;
  const int N = len / 64;
  bf16_t* sKwT = (bf16_t*)smem;
  bf16_t* sA = sKwT + 128 * 72;
  bf16_t* sCt = sA + 64 * 72;
  float* sc = (float*)(sCt + 48 * 136);
  f32x4 Cf[3][2], Cb[3][2];
#pragma unroll
  for (int a = 0; a < 3; ++a)
#pragma unroll
    for (int b = 0; b < 2; ++b) { Cf[a][b] = zero4(); Cb[a][b] = zero4(); }
  float mf = 0.f, mb = 0.f;
  __syncthreads();
  for (int step = 0; step < N; ++step) {
    const bool second = step >= (N >> 1);
    ml_chunk<0>(p, li, h, sl, tok0 + step * 64, second, mf, Cf, sKwT, sA, sCt, sc);
    ml_chunk<1>(p, li, h, sl, tok0 + (N - 1 - step) * 64, second, mb, Cb, sKwT, sA, sCt, sc);
  }
}

#define ATTN_GLOAD(KT)                                                                              \
  {                                                                                                 \
    const long kb = tok0 + (KT) * 64;                                                               \
    rk0 = *(const bf16x8*)(p.KNb + (kb + (tid >> 3)) * 512 + head * 64 + 8 * (tid & 7));            \
    rk1 = *(const bf16x8*)(p.KNb + (kb + 32 + (tid >> 3)) * 512 + head * 64 + 8 * (tid & 7));       \
    rkr = *(const bf16x8*)(p.KRb + (kb + (tid >> 2)) * 32 + 8 * (tid & 3));                          \
    rv0 = *(const bf16x8*)(p.VtA + (long)(head * 64 + (tid >> 3)) * T_TOK + kb + 8 * (tid & 7));     \
    rv1 = *(const bf16x8*)(p.VtA + (long)(head * 64 + 32 + (tid >> 3)) * T_TOK + kb + 8 * (tid & 7)); \
  }
__device__ void attn_item(const Params& p, int item, char* smem) {
  const int tid = otid(), lane = tid & 63, w = tid >> 6, c = lane & 15, g = lane >> 4;
  int s, head, qb;
  if (item < 4096) { s = 4 + item / 512; int rem = item % 512; head = rem / 64; qb = rem % 64; }
  else { int it = item - 4096; s = it / 256; int rem = it % 256; head = rem / 32; qb = rem % 32; }
  const int tok0 = s < 4 ? s * 4096 : T_P + (s - 4) * 8192;
  const int len = s < 4 ? 4096 : 8192;
  const int nkv = len / 64;
  bf16_t* sK = (bf16_t*)smem;
  bf16_t* sVt = sK + 64 * 104;
  const int qrow0 = tok0 + qb * 128 + 32 * w;
  bf16x8 qf[2][3];
#pragma unroll
  for (int nt = 0; nt < 2; ++nt)
#pragma unroll
    for (int ks = 0; ks < 3; ++ks)
      qf[nt][ks] = *(const bf16x8*)(p.Qa + (long)(qrow0 + 16 * nt + c) * 768 + head * 96 + 32 * ks + 8 * g);
  f32x4 ot[4][2];
#pragma unroll
  for (int vt = 0; vt < 4; ++vt) { ot[vt][0] = zero4(); ot[vt][1] = zero4(); }
  float mrun[2] = {-1e30f, -1e30f}, lrun[2] = {0.f, 0.f};
  bf16x8 rk0, rk1, rkr, rv0, rv1;
  ATTN_GLOAD(0)
  for (int kt = 0; kt < nkv; ++kt) {
    __syncthreads();
    *(bf16x8*)(sK + (tid >> 3) * 104 + 8 * (tid & 7)) = rk0;
    *(bf16x8*)(sK + (32 + (tid >> 3)) * 104 + 8 * (tid & 7)) = rk1;
    *(bf16x8*)(sK + (tid >> 2) * 104 + 64 + 8 * (tid & 3)) = rkr;
    *(bf16x8*)(sVt + (tid >> 3) * 72 + 8 * (tid & 7)) = rv0;
    *(bf16x8*)(sVt + (32 + (tid >> 3)) * 72 + 8 * (tid & 7)) = rv1;
    __syncthreads();
    if (kt + 1 < nkv) ATTN_GLOAD(kt + 1)
    f32x4 st[4][2];
#pragma unroll
    for (int k4 = 0; k4 < 4; ++k4) { st[k4][0] = zero4(); st[k4][1] = zero4(); }
#pragma unroll
    for (int ks = 0; ks < 3; ++ks)
#pragma unroll
      for (int k4 = 0; k4 < 4; ++k4) {
        bf16x8 kf = *(const bf16x8*)(sK + (16 * k4 + c) * 104 + 32 * ks + 8 * g);
        st[k4][0] = mfma16(kf, qf[0][ks], st[k4][0]);
        st[k4][1] = mfma16(kf, qf[1][ks], st[k4][1]);
      }
#pragma unroll
    for (int nt = 0; nt < 2; ++nt) {
      float mx = -1e30f;
#pragma unroll
      for (int k4 = 0; k4 < 4; ++k4)
#pragma unroll
        for (int j = 0; j < 4; ++j) mx = fmaxf(mx, st[k4][nt][j]);
      mx = fmaxf(mx, __shfl_xor(mx, 16));
      mx = fmaxf(mx, __shfl_xor(mx, 32));
      const float mn = fmaxf(mrun[nt], mx);
      const float alpha = __expf(mrun[nt] - mn);
      mrun[nt] = mn;
      float psum = 0.f;
#pragma unroll
      for (int k4 = 0; k4 < 4; ++k4)
#pragma unroll
        for (int j = 0; j < 4; ++j) {
          float pv = __expf(st[k4][nt][j] - mn);
          st[k4][nt][j] = pv;
          psum += pv;
        }
      lrun[nt] = lrun[nt] * alpha + psum;
#pragma unroll
      for (int vt = 0; vt < 4; ++vt) ot[vt][nt] = ot[vt][nt] * alpha;
    }
#pragma unroll
    for (int k2 = 0; k2 < 2; ++k2) {
      bf16x8 pb[2];
#pragma unroll
      for (int nt = 0; nt < 2; ++nt)
#pragma unroll
        for (int e = 0; e < 4; ++e) {
          pb[nt][e] = (short)f2bf(st[2 * k2][nt][e]);
          pb[nt][4 + e] = (short)f2bf(st[2 * k2 + 1][nt][e]);
        }
#pragma unroll
      for (int vt = 0; vt < 4; ++vt) {
        us4 lo = *(const us4*)(sVt + (16 * vt + c) * 72 + 32 * k2 + 4 * g);
        us4 hi = *(const us4*)(sVt + (16 * vt + c) * 72 + 32 * k2 + 16 + 4 * g);
        bf16x8 av;
#pragma unroll
        for (int e = 0; e < 4; ++e) { av[e] = (short)lo[e]; av[4 + e] = (short)hi[e]; }
        ot[vt][0] = mfma16(av, pb[0], ot[vt][0]);
        ot[vt][1] = mfma16(av, pb[1], ot[vt][1]);
      }
    }
  }
#pragma unroll
  for (int nt = 0; nt < 2; ++nt) {
    float lt = lrun[nt];
    lt += __shfl_xor(lt, 16);
    lt += __shfl_xor(lt, 32);
    const float inv = 1.f / lt;
    const long tok = qrow0 + 16 * nt + c;
#pragma unroll
    for (int vt = 0; vt < 4; ++vt) {
      bf16_t* gp = p.MGb + tok * 512 + head * 64 + 16 * vt + 4 * g;
      us4 gt = *(const us4*)gp;
      us4 o;
#pragma unroll
      for (int j = 0; j < 4; ++j) o[j] = f2bf(ot[vt][nt][j] * inv * siluf_(bf2f(gt[j])));
      *(us4*)gp = o;
    }
  }
}

__device__ void phase_gla_combine(const Params& p, int li) {
  const int tid_ = otid(); const int lane = tid_ & 63, w = tid_ >> 6;
  for (int tok = blockIdx.x * 4 + w; tok < T_TOK; tok += gridDim.x * 4) {
    const bf16_t* tp = p.TMP + (long)tok * 1024 + 16 * lane;
    bf16_t* gp = p.Gb + (long)tok * 1024 + 16 * lane;
    bf16x8 o0 = *(const bf16x8*)tp, o1 = *(const bf16x8*)(tp + 8);
    bf16x8 g0 = *(const bf16x8*)gp, g1 = *(const bf16x8*)(gp + 8);
    float ov[16], gv[16];
#pragma unroll
    for (int e = 0; e < 8; ++e) {
      ov[e] = bf2f((bf16_t)o0[e]); ov[8 + e] = bf2f((bf16_t)o1[e]);
      gv[e] = bf2f((bf16_t)g0[e]); gv[8 + e] = bf2f((bf16_t)g1[e]);
    }
    float ss = 0.f;
#pragma unroll
    for (int e = 0; e < 16; ++e) ss += ov[e] * ov[e];
    ss += __shfl_xor(ss, 1); ss += __shfl_xor(ss, 2); ss += __shfl_xor(ss, 4); ss += __shfl_xor(ss, 8);
    const float rs = rsqrtf(ss * (1.f / 256.f) + EPS);
    const float* ng = p.e_gla_norm_g + li * 256 + ((16 * lane) & 255);
    bf16x8 r0, r1;
#pragma unroll
    for (int e = 0; e < 8; ++e) {
      r0[e] = (short)f2bf(ov[e] * rs * ng[e] * siluf_(gv[e]));
      r1[e] = (short)f2bf(ov[8 + e] * rs * ng[8 + e] * siluf_(gv[8 + e]));
    }
    *(bf16x8*)gp = r0;
    *(bf16x8*)(gp + 8) = r1;
  }
}

__device__ void phase_ml_combine(const Params& p, int li) {
  const int tid_ = otid(); const int lane = tid_ & 63, w = tid_ >> 6;
  for (int tok = blockIdx.x * 4 + w; tok < T_TOK; tok += gridDim.x * 4) {
    const long off = (long)tok * 512 + 8 * lane;
    bf16x8 hv = *(const bf16x8*)(p.TMP2 + off);
    bf16x8 mo = *(const bf16x8*)(p.MOb + off);
    bf16x8 mg = *(const bf16x8*)(p.MLGb + off);
    float hf[8];
    float ss = 0.f;
#pragma unroll
    for (int e = 0; e < 8; ++e) { hf[e] = bf2f((bf16_t)hv[e]); ss += hf[e] * hf[e]; }
    ss += __shfl_xor(ss, 1); ss += __shfl_xor(ss, 2); ss += __shfl_xor(ss, 4); ss += __shfl_xor(ss, 8);
    const float rs = rsqrtf(ss * (1.f / 128.f) + EPS);
    const float* ng = p.o_ml_norm_g + li * 128 + ((8 * lane) & 127);
    bf16x8 r;
#pragma unroll
    for (int e = 0; e < 8; ++e)
      r[e] = (short)f2bf(hf[e] * rs * ng[e] * sigmoidf_(bf2f((bf16_t)mo[e])) * siluf_(bf2f((bf16_t)mg[e])));
    *(bf16x8*)(p.MLGb + off) = r;
  }
}

__device__ void phase_final(const Params& p) {
  const int tid_ = otid(); const int lane = tid_ & 63, w = tid_ >> 6;
  for (int tok = blockIdx.x * 4 + w; tok < T_TOK; tok += gridDim.x * 4) {
    float* xp = p.out + (long)tok * DM;
    float4 v[4];
    float ss = 0.f;
#pragma unroll
    for (int i = 0; i < 4; ++i) {
      v[i] = *(const float4*)(xp + 4 * lane + 256 * i);
      ss += v[i].x * v[i].x + v[i].y * v[i].y + v[i].z * v[i].z + v[i].w * v[i].w;
    }
#pragma unroll
    for (int d = 1; d < 64; d <<= 1) ss += __shfl_xor(ss, d);
    const float rs = rsqrtf(ss * (1.f / 1024.f) + EPS);
#pragma unroll
    for (int i = 0; i < 4; ++i) {
      float4 gq = *(const float4*)(p.final_norm_g + 4 * lane + 256 * i);
      float4 o;
      o.x = v[i].x * rs * gq.x; o.y = v[i].y * rs * gq.y; o.z = v[i].z * rs * gq.z; o.w = v[i].w * rs * gq.w;
      *(float4*)(xp + 4 * lane + 256 * i) = o;
    }
  }
}

__device__ void run_phase(const Params& p, int ph, char* smem) {
  if (ph == 0) { if (PH_ON(0)) phase_prep(p); return; }
  if (ph == NPHASE - 1) { if (PH_ON(11)) phase_final(p); return; }
  const int q = ph - 1;
  const int layer = (q < 4) ? 0 : (q < 9) ? 1 : (q < 13) ? 2 : 3;
  const int sub = (q < 4) ? q : (q < 9) ? q - 4 : (q < 13) ? q - 9 : q - 13;
  const int li = layer >> 1;
  const float* xa = (layer == 0) ? p.x_prompt : p.out;
  const float* xb = (layer == 0) ? p.x_sample : p.out + (long)T_P * DM;
  if ((layer & 1) == 0) {
    if (sub == 0) {
      EpiEvenIn e{p.Qb, p.Kb, p.VtE, p.Gb, p.LRb, p.PUb, p.PGb};
      if (PH_ON(1)) gemm_phase<0>(T_TOK / 128, NE_PAD / 128, DM, p.WinE + (long)li * NE_PAD * DM, xa, xb, nullptr, 0, 0, nullptr, 0, e, smem);
    } else if (sub == 1) {
      for (int item = blockIdx.x; item < 384 + 5120; item += gridDim.x) {
        if (item < 384) { if (PH_ON(2)) gla_chain_item(p, li, item, smem); }
        else { if (PH_ON(3)) pool_item(p, li, item - 384, smem); }
      }
    } else if (sub == 2) {
      if (PH_ON(4)) phase_gla_combine(p, li);
    } else {
      EpiOut e{xa, xb, p.out};
      if (PH_ON(5)) gemm_phase<1>(T_TOK / 128, DM / 128, 1536, p.WoutE + (long)li * DM * 1536, nullptr, nullptr, p.Gb, 1024, 1024, p.PGb, 512, e, smem);
    }
  } else {
    if (sub == 0) {
      EpiOddIn e{p.CQb, p.CKVb, p.KRb, p.MGb, p.MQb, p.MKb, p.MVt, p.MOb, p.MLGb, p.MIF};
      if (PH_ON(6)) gemm_phase<0>(T_TOK / 128, NO_PAD / 128, DM, p.WinO + (long)li * NO_PAD * DM, xa, xb, nullptr, 0, 0, nullptr, 0, e, smem);
    } else if (sub == 1) {
      EpiQUp eq{p.Qa};
      if (PH_ON(7)) gemm_phase<2>(T_TOK / 128, 768 / 128, 384, p.QupT + (long)li * 768 * 384, nullptr, nullptr, p.CQb, 384, 384, p.CQb, 384, eq, smem);
      EpiKVUp ek{p.KNb, p.VtA};
      if (PH_ON(7)) gemm_phase<2>(T_TOK / 128, 1024 / 128, 256, p.KVupT + (long)li * 1024 * 256, nullptr, nullptr, p.CKVb, 256, 256, p.CKVb, 256, ek, smem);
    } else if (sub == 2) {
      __shared__ int s_item;
      if (PH_ON(8)) if ((int)blockIdx.x < 192) ml_chain_item(p, li, blockIdx.x, smem);
      for (;;) {
        __syncthreads();
        if (threadIdx.x == 0) s_item = atomicAdd(p.counters + li, 1);
        __syncthreads();
        const int item = s_item;
        if (item >= 5120) break;
        if (PH_ON(9)) attn_item(p, item, smem);
      }
    } else if (sub == 3) {
      if (PH_ON(10)) phase_ml_combine(p, li);
    } else {
      EpiOut e{xa, xb, p.out};
      if (PH_ON(5)) gemm_phase<1>(T_TOK / 128, DM / 128, 1024, p.WoutO + (long)li * DM * 1024, nullptr, nullptr, p.MGb, 512, 512, p.MLGb, 512, e, smem);
    }
  }
}

__global__ void __launch_bounds__(256, 2) mega_kernel(Params p) {
  extern __shared__ __attribute__((aligned(16))) char smem[];
  cg::grid_group grid = cg::this_grid();
  for (int ph = p.ph_lo; ph < p.ph_hi; ++ph) {
    if (ph > p.ph_lo) grid.sync();
    run_phase(p, ph, smem);
  }
}

extern "C" void kernel_launch(void* const* d_in, const int* in_sizes, int n_in, void* d_out, int out_size, void* d_ws,
                              size_t ws_size, hipStream_t stream) {
  static int grid_blocks = 0;
  if (!grid_blocks) {
    int dev = 0, cus = 0, per_cu = 0;
    hipGetDevice(&dev);
    hipDeviceGetAttribute(&cus, hipDeviceAttributeMultiprocessorCount, dev);
    hipFuncSetAttribute((const void*)mega_kernel, hipFuncAttributeMaxDynamicSharedMemorySize, LDS_BYTES);
    hipOccupancyMaxActiveBlocksPerMultiprocessor(&per_cu, (const void*)mega_kernel, 256, LDS_BYTES);
    if (per_cu < 1) per_cu = 1;
    if (per_cu > 2) per_cu = 2;
    grid_blocks = cus * per_cu;
    fprintf(stderr, "kernel_launch: cus %d per_cu %d grid %d ws %zu\n", cus, per_cu, grid_blocks, ws_size);
  }
  Params p{};
  const float** pin = (const float**)&p;
  for (int i = 0; i < 19; ++i) pin[i] = (const float*)d_in[i];
  p.out = (float*)d_out;
  char* ws = (char*)d_ws;
  size_t off = 0;
  auto take = [&](size_t bytes) { char* r = ws + off; off += (bytes + 255) & ~(size_t)255; return r; };
  p.WinE = (bf16_t*)take((size_t)2 * NE_PAD * DM * 2);
  p.WinO = (bf16_t*)take((size_t)2 * NO_PAD * DM * 2);
  p.WoutE = (bf16_t*)take((size_t)2 * DM * 1536 * 2);
  p.WoutO = (bf16_t*)take((size_t)2 * DM * 1024 * 2);
  p.QupT = (bf16_t*)take((size_t)2 * 768 * 384 * 2);
  p.KVupT = (bf16_t*)take((size_t)2 * 1024 * 256 * 2);
  p.PoolWT = (bf16_t*)take((size_t)2 * 4 * 128 * 128 * 2);
  p.AupT = (bf16_t*)take((size_t)2 * 2 * 512 * 32 * 2);
  p.counters = (int*)take(256);
  const size_t act0 = off;
  const size_t T = T_TOK;
  p.Qb = (bf16_t*)take(T * 512 * 2);
  p.Kb = (bf16_t*)take(T * 512 * 2);
  p.VtE = (bf16_t*)take(T * 1024 * 2);
  p.Gb = (bf16_t*)take(T * 1024 * 2);
  p.LRb = (bf16_t*)take(T * 32 * 2);
  p.PUb = (bf16_t*)take(T * 512 * 2);
  p.PGb = (bf16_t*)take(T * 512 * 2);
  p.TMP = (bf16_t*)take(T * 1024 * 2);
  const size_t even_end = off;
  off = act0;
  p.TMP2 = (bf16_t*)take(T * 512 * 2);
  p.CQb = (bf16_t*)take(T * 384 * 2);
  p.CKVb = (bf16_t*)take(T * 256 * 2);
  p.KRb = (bf16_t*)take(T * 32 * 2);
  p.MGb = (bf16_t*)take(T * 512 * 2);
  p.MQb = (bf16_t*)take(T * 512 * 2);
  p.MKb = (bf16_t*)take(T * 512 * 2);
  p.MVt = (bf16_t*)take(T * 512 * 2);
  p.MOb = (bf16_t*)take(T * 512 * 2);
  p.MLGb = (bf16_t*)take(T * 512 * 2);
  p.Qa = (bf16_t*)take(T * 768 * 2);
  p.KNb = (bf16_t*)take(T * 512 * 2);
  p.VtA = (bf16_t*)take(T * 512 * 2);
  p.MIF = (float*)take(T * 16 * 4);
  const size_t odd_end = off;
  const size_t need = even_end > odd_end ? even_end : odd_end;
  if (need > ws_size) {
    fprintf(stderr, "kernel_launch: workspace too small: need %zu have %zu\n", need, ws_size);
    return;
  }
#if SINGLE_LAUNCH
  p.ph_lo = 0;
  p.ph_hi = NPHASE;
  void* args[] = {&p};
  hipError_t e = hipLaunchCooperativeKernel((const void*)mega_kernel, dim3(grid_blocks), dim3(256), args, LDS_BYTES, stream);
  if (e != hipSuccess) fprintf(stderr, "cooperative launch failed: %s (grid %d)\n", hipGetErrorString(e), grid_blocks);
#else
  for (int ph = 0; ph < NPHASE; ++ph) {
    p.ph_lo = ph;
    p.ph_hi = ph + 1;
    hipLaunchKernelGGL(mega_kernel, dim3(grid_blocks), dim3(256), LDS_BYTES, stream, p);
  }
#endif
}
```

```cpp
#include <hip/hip_runtime.h>
#include <hip/hip_cooperative_groups.h>
#include <cstdio>
namespace cg = cooperative_groups;

#ifndef SINGLE_LAUNCH
#define SINGLE_LAUNCH 1
#endif
#ifndef PHMASK
#define PHMASK 0xFFFF
#endif
#define PH_ON(b) ((PHMASK >> (b)) & 1)
#ifndef PROBE_GEMM
#define PROBE_GEMM 0
#endif
#ifndef PROBE_ATTN
#define PROBE_ATTN 0
#endif
#ifndef PROBE_CHAIN
#define PROBE_CHAIN 0
#endif

typedef unsigned short bf16_t;
typedef __attribute__((ext_vector_type(8))) short bf16x8;
typedef __attribute__((ext_vector_type(4))) float f32x4;
typedef __attribute__((ext_vector_type(4))) unsigned short us4;

constexpr int T_TOK = 81920;
constexpr int T_P = 16384;
constexpr int DM = 1024;
constexpr int NE = 4128, NE_PAD = 4352;
constexpr int NO = 3760, NO_PAD = 3840;
constexpr float EPS = 1e-6f;
constexpr int NPHASE = 22;
constexpr int LDS_BYTES = 72 * 1024;

struct Params {
  const float *x_prompt, *x_sample, *norm_g, *final_norm_g, *e_w_in, *e_a_up, *e_a_bias, *e_gla_norm_g,
      *e_pool_w, *e_pool_scale, *e_w_out, *o_w_in, *o_q_norm_g, *o_q_up, *o_kv_norm_g, *o_kv_up, *o_if_bias,
      *o_ml_norm_g, *o_w_out;
  float* out;
  bf16_t *WinE, *WinO, *WoutE, *WoutO, *QupT, *KVupT, *PoolWT, *AupT;
  int* counters;
  bf16_t *Qb, *Kt, *VtE, *Gb, *LRb, *PUb, *PGb, *TMP, *QEb, *KdTb;
  float* EB;
  bf16_t *TMP2, *CQb, *CKVb, *KRb, *MGb, *MQb, *MKb, *MVt, *MOb, *MLGb, *Qa, *KNb, *VtA;
  float* MIF;
  int ph_lo, ph_hi;
};

typedef __bf16 hbf2 __attribute__((ext_vector_type(2)));
typedef float hf2 __attribute__((ext_vector_type(2)));
__device__ __forceinline__ bf16_t f2bf(float f) {
  __bf16 b = (__bf16)f;
  return __builtin_bit_cast(bf16_t, b);
}
__device__ __forceinline__ unsigned pk2bf(float a, float b) {
  hf2 v = {a, b};
  hbf2 r = __builtin_convertvector(v, hbf2);
  return __builtin_bit_cast(unsigned, r);
}
__device__ __forceinline__ float bf2f(bf16_t b) { return __uint_as_float(((unsigned)b) << 16); }
__device__ __forceinline__ f32x4 mfma16(bf16x8 a, bf16x8 b, f32x4 c) {
  return __builtin_amdgcn_mfma_f32_16x16x32_bf16(a, b, c, 0, 0, 0);
}
__device__ __forceinline__ float logsigmoidf_(float x) { return fminf(x, 0.f) - log1pf(__expf(-fabsf(x))); }
__device__ __forceinline__ float siluf_(float x) { return x / (1.f + __expf(-x)); }
__device__ __forceinline__ float sigmoidf_(float x) { return 1.f / (1.f + __expf(-x)); }
__device__ __forceinline__ int otid() { int t = threadIdx.x; asm volatile("" : "+v"(t)); return t; }
__device__ __forceinline__ bf16x8 zero8() { bf16x8 z = {0, 0, 0, 0, 0, 0, 0, 0}; return z; }
__device__ __forceinline__ f32x4 zero4() { f32x4 z = {0.f, 0.f, 0.f, 0.f}; return z; }

__device__ __forceinline__ int seq_pos(int tok) { return tok < T_P ? (tok & 4095) : ((tok - T_P) & 8191); }
__device__ __forceinline__ const float* xrow(const float* xa, const float* xb, int tok) {
  return tok < T_P ? xa + (long)tok * DM : xb + (long)(tok - T_P) * DM;
}

__device__ __forceinline__ int colmap(int mode, int n) {
  if (mode == 1) {
    if (n < 512) return 2208 + n;
    if (n < 896) return n - 512;
    if (n < 1152) return 384 + (n - 896);
    if (n < 1664) return 672 + (n - 1152);
    if (n < 2176) return 1184 + (n - 1664);
    if (n < 2688) return 1696 + (n - 2176);
    if (n < 3200) return 2720 + (n - 2688);
    if (n < 3712) return 3248 + (n - 3200);
    if (n < 3744) return 640 + (n - 3712);
    return 3232 + (n - 3744);
  }
  if (mode == 2) {
    if (n < 512) return (n >> 6) * 96 + (n & 63);
    const int r = n - 512;
    return (r >> 5) * 96 + 64 + (r & 31);
  }
  if (mode == 3) {
    if (n < 512) return (n >> 6) * 128 + (n & 63);
    const int r = n - 512;
    return (r >> 6) * 128 + 64 + (r & 63);
  }
  return n;
}

__device__ void prep_weight(const float* __restrict__ W, int K, int N, int Npad, const float* __restrict__ gsc,
                            bf16_t* __restrict__ out, long gtid, long gsize, int mode = 0) {
  long total = (long)Npad * K;
  for (long idx = gtid; idx < total; idx += gsize) {
    int k = (int)(idx / Npad);
    int n = (int)(idx % Npad);
    float v = 0.f;
    if (n < N) {
      v = W[(long)k * N + colmap(mode, n)];
      if (gsc) v *= gsc[k];
    }
    out[(long)n * K + k] = f2bf(v);
  }
}

__device__ void phase_prep(const Params& p) {
  long gtid = (long)blockIdx.x * 256 + otid();
  long gsize = (long)gridDim.x * 256;
  for (int l = 0; l < 2; ++l) {
    prep_weight(p.e_w_in + (long)l * DM * NE, DM, NE, NE_PAD, p.norm_g + (2 * l) * DM, p.WinE + (long)l * NE_PAD * DM, gtid, gsize);
    prep_weight(p.o_w_in + (long)l * DM * NO, DM, NO, NO_PAD, p.norm_g + (2 * l + 1) * DM, p.WinO + (long)l * NO_PAD * DM, gtid, gsize, 1);
    prep_weight(p.e_w_out + (long)l * 1536 * DM, 1536, DM, DM, nullptr, p.WoutE + (long)l * DM * 1536, gtid, gsize);
    prep_weight(p.o_w_out + (long)l * 1024 * DM, 1024, DM, DM, nullptr, p.WoutO + (long)l * DM * 1024, gtid, gsize);
    prep_weight(p.o_q_up + (long)l * 384 * 768, 384, 768, 768, p.o_q_norm_g + l * 384, p.QupT + (long)l * 768 * 384, gtid, gsize, 2);
    prep_weight(p.o_kv_up + (long)l * 256 * 1024, 256, 1024, 1024, p.o_kv_norm_g + l * 256, p.KVupT + (long)l * 1024 * 256, gtid, gsize, 3);
    for (int gi = 0; gi < 4; ++gi)
      prep_weight(p.e_pool_w + (long)(l * 4 + gi) * 128 * 128, 128, 128, 128, nullptr, p.PoolWT + (long)(l * 4 + gi) * 128 * 128, gtid, gsize);
    for (long idx = gtid; idx < 2 * 512 * 32; idx += gsize) {
      int r = (int)(idx & 31);
      int d = (int)((idx >> 5) & 511);
      int dir = (int)(idx >> 14);
      float v = (r < 16) ? p.e_a_up[((long)(l * 2 + dir) * 16 + r) * 512 + d] : 0.f;
      p.AupT[((long)(l * 2 + dir) * 512 + d) * 32 + r] = f2bf(v);
    }
  }
  if (gtid < 16) p.counters[gtid] = 0;
}

constexpr int G_LD = 40;
constexpr int G_BUF = (128 + 256) * G_LD;

template <int AMODE, int NI, class Epi>
__device__ void gemm_phase(int Mtiles, int Ntiles, int K, const bf16_t* __restrict__ Bt, const float* xa, const float* xb,
                           const bf16_t* A1, int ld1, int K1, const bf16_t* A2, int ld2, const Epi& epi, char* smem) {
  bf16_t* sbase = (bf16_t*)smem;
  float* sR = (float*)(smem + 70144);
  const int tid = otid(), lane = tid & 63, w = tid >> 6, c = lane & 15, g = lane >> 4;
  const int wm = w >> 1, wn = w & 1;
  const int nk = K / 32;
  const int ntiles = Mtiles * Ntiles;
  for (int tile = blockIdx.x; tile < ntiles; tile += gridDim.x) {
    const int mt = tile / Ntiles, nt = tile % Ntiles;
    constexpr int BN = 32 * NI;
    const int m0 = mt * 128, n0 = nt * BN;
    f32x4 acc[4][NI];
#pragma unroll
    for (int i = 0; i < 4; ++i)
#pragma unroll
      for (int j = 0; j < NI; ++j) acc[i][j] = zero4();
    float ss[4] = {0.f, 0.f, 0.f, 0.f};
    f32x4 raf[4];
    bf16x8 rab[2];
    bf16x8 rb[NI / 2];
    const float* abase_f = (m0 < T_P) ? xa + (size_t)m0 * DM : xb + (size_t)(m0 - T_P) * DM;
    const unsigned aoff_f = (unsigned)(tid >> 3) * DM + 4 * (tid & 7);
    const unsigned boff = (unsigned)(tid >> 2) * K + 8 * (tid & 3);
    const bf16_t* bbase = Bt + (size_t)n0 * K;
#define GEMM_GLOAD(KT)                                                                              \
  {                                                                                                 \
    const int k0_ = (KT) * 32;                                                                      \
    if constexpr (AMODE == 0) {                                                                     \
      _Pragma("unroll") for (int i = 0; i < 4; ++i)                                                 \
        raf[i] = *(const f32x4*)(abase_f + k0_ + aoff_f + (unsigned)(32 * i) * DM);                 \
    } else {                                                                                        \
      const bf16_t* base_;                                                                          \
      int ld_;                                                                                      \
      if (k0_ < K1) { base_ = A1 + (size_t)m0 * ld1 + k0_; ld_ = ld1; }                             \
      else { base_ = A2 + (size_t)m0 * ld2 + (k0_ - K1); ld_ = ld2; }                               \
      _Pragma("unroll") for (int i = 0; i < 2; ++i)                                                 \
        rab[i] = *(const bf16x8*)(base_ + (unsigned)((tid >> 2) + 64 * i) * ld_ + 8 * (tid & 3));   \
    }                                                                                               \
    _Pragma("unroll") for (int i = 0; i < NI / 2; ++i)                                              \
      rb[i] = *(const bf16x8*)(bbase + k0_ + boff + (unsigned)(64 * i) * K);                        \
  }
#define GEMM_LSTORE(BUF)                                                                            \
  {                                                                                                 \
    bf16_t* sA_ = sbase + (BUF) * G_BUF;                                                            \
    bf16_t* sB_ = sA_ + 128 * G_LD;                                                                 \
    if constexpr (AMODE == 0) {                                                                     \
      _Pragma("unroll") for (int i = 0; i < 4; ++i) {                                               \
        f32x4 v = raf[i];                                                                           \
        ss[i] += v[0] * v[0] + v[1] * v[1] + v[2] * v[2] + v[3] * v[3];                             \
        uint2 o;                                                                                    \
        o.x = pk2bf(v[0], v[1]);                                                                    \
        o.y = pk2bf(v[2], v[3]);                                                                    \
        *(uint2*)(sA_ + ((tid >> 3) + 32 * i) * G_LD + 4 * (tid & 7)) = o;                          \
      }                                                                                             \
    } else {                                                                                        \
      _Pragma("unroll") for (int i = 0; i < 2; ++i) {                                               \
        bf16x8 v = rab[i];                                                                          \
        if constexpr (AMODE == 2) {                                                                 \
          _Pragma("unroll") for (int e = 0; e < 8; ++e) {                                           \
            float f = bf2f((bf16_t)v[e]);                                                           \
            ss[i] += f * f;                                                                         \
          }                                                                                         \
        }                                                                                           \
        *(bf16x8*)(sA_ + ((tid >> 2) + 64 * i) * G_LD + 8 * (tid & 3)) = v;                         \
      }                                                                                             \
    }                                                                                               \
    _Pragma("unroll") for (int i = 0; i < NI / 2; ++i)                                              \
      *(bf16x8*)(sB_ + ((tid >> 2) + 64 * i) * G_LD + 8 * (tid & 3)) = rb[i];                       \
  }
    __syncthreads();
    GEMM_GLOAD(0)
    GEMM_LSTORE(0)
    __syncthreads();
    for (int kt = 0; kt < nk; ++kt) {
      if (kt + 1 < nk) GEMM_GLOAD(kt + 1)
      {
        const bf16_t* sA_ = sbase + (kt & 1) * G_BUF;
        const bf16_t* sB_ = sA_ + 128 * G_LD;
        bf16x8 af[4];
#pragma unroll
        for (int mi = 0; mi < 4; ++mi) af[mi] = *(const bf16x8*)(sA_ + (wm * 64 + mi * 16 + c) * G_LD + g * 8);
#pragma unroll
        for (int ni = 0; ni < NI; ++ni) {
          bf16x8 bfr = *(const bf16x8*)(sB_ + (wn * (16 * NI) + ni * 16 + c) * G_LD + g * 8);
#pragma unroll
          for (int mi = 0; mi < 4; ++mi) acc[mi][ni] = mfma16(af[mi], bfr, acc[mi][ni]);
        }
      }
      if (kt + 1 < nk) GEMM_LSTORE((kt + 1) & 1)
      __syncthreads();
    }
    if constexpr (AMODE == 0) {
#pragma unroll
      for (int i = 0; i < 4; ++i) {
        float sv = ss[i];
        sv += __shfl_xor(sv, 1); sv += __shfl_xor(sv, 2); sv += __shfl_xor(sv, 4);
        if ((tid & 7) == 0) sR[(tid >> 3) + 32 * i] = rsqrtf(sv / (float)K + EPS);
      }
      __syncthreads();
    } else if constexpr (AMODE == 2) {
#pragma unroll
      for (int i = 0; i < 2; ++i) {
        float sv = ss[i];
        sv += __shfl_xor(sv, 1); sv += __shfl_xor(sv, 2);
        if ((tid & 3) == 0) sR[(tid >> 2) + 64 * i] = rsqrtf(sv / (float)K + EPS);
      }
      __syncthreads();
    }
    if constexpr (Epi::staged) {
      bf16_t* sT = sbase;
      const float esc = epi.scale();
      const bool tr = epi.transposed(n0);
      if (tr) {
#pragma unroll
        for (int mi = 0; mi < 4; ++mi) {
          const int row = wm * 64 + mi * 16 + 4 * g;
          const float r0 = sR[row] * esc, r1 = sR[row + 1] * esc, r2 = sR[row + 2] * esc, r3 = sR[row + 3] * esc;
#pragma unroll
          for (int ni = 0; ni < NI; ++ni) {
            uint2 o;
            o.x = pk2bf(acc[mi][ni][0] * r0, acc[mi][ni][1] * r1);
            o.y = pk2bf(acc[mi][ni][2] * r2, acc[mi][ni][3] * r3);
            *(uint2*)(sT + (wn * (16 * NI) + ni * 16 + c) * 136 + row) = o;
          }
        }
      } else {
#pragma unroll
        for (int mi = 0; mi < 4; ++mi) {
          const int row = wm * 64 + mi * 16 + 4 * g;
          const float r0 = sR[row] * esc, r1 = sR[row + 1] * esc, r2 = sR[row + 2] * esc, r3 = sR[row + 3] * esc;
#pragma unroll
          for (int ni = 0; ni < NI; ++ni) {
            bf16_t* d = sT + row * (BN + 8) + wn * (16 * NI) + ni * 16 + c;
            d[0] = f2bf(acc[mi][ni][0] * r0);
            d[BN + 8] = f2bf(acc[mi][ni][1] * r1);
            d[2 * (BN + 8)] = f2bf(acc[mi][ni][2] * r2);
            d[3 * (BN + 8)] = f2bf(acc[mi][ni][3] * r3);
          }
        }
      }
      epi.template direct<NI>(m0, n0, wm, wn, g, c, acc, sR);
      __syncthreads();
      if (tr) {
#pragma unroll 4
        for (int i = 0; i < 2 * NI; ++i) {
          const int id = tid + 256 * i;
          const int col = id >> 4, rc = id & 15;
          bf16x8 v = *(const bf16x8*)(sT + col * 136 + 8 * rc);
          epi.store_t(m0 + 8 * rc, n0 + col, v);
        }
      } else {
#pragma unroll 4
        for (int i = 0; i < 2 * NI; ++i) {
          const int id = tid + 256 * i;
          const int row = id / (4 * NI), cc = id % (4 * NI);
          const bf16_t* sp = sT + row * (BN + 8) + 8 * cc;
          bf16x8 v = *(const bf16x8*)sp;
          epi.store_n(m0 + row, n0 + 8 * cc, v, sp);
        }
      }
    } else {
      epi(m0, n0, wm, wn, g, c, acc, sR);
    }
  }
#undef GEMM_GLOAD
#undef GEMM_LSTORE
}

__device__ __forceinline__ void rope_cs(int pos, int i, float& co, float& si) {
  float inv = exp2f(-(float)i * (13.287712379549449f / 16.f));
  float ang = (float)pos * inv;
  float n = rintf(ang * 0.15915494309189535f);
  float r = fmaf(-n, 6.28125f, ang);
  r = fmaf(-n, 0.0019353071795864769f, r);
  float rf = r * 0.15915494309189535f;
  si = __builtin_amdgcn_sinf(rf);
  co = __builtin_amdgcn_cosf(rf);
}

__device__ __forceinline__ void rope_chunk(int pos, int i0, bf16x8 x1, bf16x8 x2, bf16x8& o1, bf16x8& o2) {
#pragma unroll
  for (int e = 0; e < 8; ++e) {
    float co, si;
    rope_cs(pos, i0 + e, co, si);
    float a = bf2f((bf16_t)x1[e]), b = bf2f((bf16_t)x2[e]);
    o1[e] = (short)f2bf(a * co - b * si);
    o2[e] = (short)f2bf(b * co + a * si);
  }
}

struct EpiEvenIn {
  static constexpr bool staged = true;
  bf16_t *Qb, *Kt, *VtE, *Gb, *LRb, *PUb, *PGb;
  __device__ float scale() const { return 1.f; }
  __device__ bool transposed(int n0) const { return n0 >= 512 && n0 < 2048; }
  template <int NI> __device__ void direct(int m0, int n0, int wm, int wn, int g, int c, f32x4 (&acc)[4][NI], const float* sR) const {}
  __device__ void store_t(int tok8, int col, bf16x8 v) const {
    if (col < 1024) *(bf16x8*)(Kt + (size_t)(col - 512) * T_TOK + tok8) = v;
    else *(bf16x8*)(VtE + (size_t)(col - 1024) * T_TOK + tok8) = v;
  }
  __device__ void store_n(int tok, int col, bf16x8 v, const bf16_t* sp) const {
    bf16_t* d;
    if (col < 512) d = Qb + (size_t)tok * 512 + col;
    else if (col < 3072) d = Gb + (size_t)tok * 1024 + (col - 2048);
    else if (col < 3104) d = LRb + (size_t)tok * 32 + (col - 3072);
    else if (col < 3616) d = PUb + (size_t)tok * 512 + (col - 3104);
    else if (col < 4128) d = PGb + (size_t)tok * 512 + (col - 3616);
    else return;
    *(bf16x8*)d = v;
  }
};

struct EpiOddIn {
  static constexpr bool staged = true;
  bf16_t *CQb, *CKVb, *KRb, *MGb, *MQb, *MKb, *MVt, *MOb, *MLGb;
  float* MIF;
  __device__ float scale() const { return 1.f; }
  __device__ bool transposed(int n0) const { return n0 < 512; }
  template <int NI> __device__ void direct(int m0, int n0, int wm, int wn, int g, int c, f32x4 (&acc)[4][NI], const float* sR) const {
    if (n0 == 3584 && wn == 1) {
#pragma unroll
      for (int mi = 0; mi < 4; ++mi)
#pragma unroll
        for (int j = 0; j < 4; ++j) {
          const int row = wm * 64 + mi * 16 + 4 * g + j;
          MIF[(size_t)(m0 + row) * 16 + c] = acc[mi][2][j] * sR[row];
        }
    }
  }
  __device__ void store_t(int tok8, int col, bf16x8 v) const { *(bf16x8*)(MVt + (size_t)col * T_TOK + tok8) = v; }
  __device__ void store_n(int tok, int col, bf16x8 v, const bf16_t* sp) const {
    bf16_t* d;
    if (col < 896) d = CQb + (size_t)tok * 384 + (col - 512);
    else if (col < 1152) d = CKVb + (size_t)tok * 256 + (col - 896);
    else if (col < 1664) d = MGb + (size_t)tok * 512 + (col - 1152);
    else if (col < 2176) d = MQb + (size_t)tok * 512 + (col - 1664);
    else if (col < 2688) d = MKb + (size_t)tok * 512 + (col - 2176);
    else if (col < 3200) d = MOb + (size_t)tok * 512 + (col - 2688);
    else if (col < 3712) d = MLGb + (size_t)tok * 512 + (col - 3200);
    else if (col < 3728) {
      bf16x8 x2 = *(const bf16x8*)(sp + 16);
      bf16x8 o1, o2;
      rope_chunk(seq_pos(tok), col - 3712, v, x2, o1, o2);
      *(bf16x8*)(KRb + (size_t)tok * 32 + (col - 3712)) = o1;
      *(bf16x8*)(KRb + (size_t)tok * 32 + 16 + (col - 3712)) = o2;
      return;
    } else return;
    *(bf16x8*)d = v;
  }
};

struct EpiQUp {
  static constexpr bool staged = true;
  bf16_t* Qa;
  __device__ float scale() const { return 0.10206207261596575f * 1.4426950408889634f; }
  __device__ bool transposed(int n0) const { return false; }
  template <int NI> __device__ void direct(int m0, int n0, int wm, int wn, int g, int c, f32x4 (&acc)[4][NI], const float* sR) const {}
  __device__ void store_t(int tok8, int col, bf16x8 v) const {}
  __device__ void store_n(int tok, int col, bf16x8 v, const bf16_t* sp) const {
    if (col < 512) {
      *(bf16x8*)(Qa + (size_t)tok * 768 + (col >> 6) * 96 + (col & 63)) = v;
    } else {
      const int r = col - 512, head = r >> 5, rr = r & 31;
      if (rr < 16) {
        bf16x8 x2 = *(const bf16x8*)(sp + 16);
        bf16x8 o1, o2;
        rope_chunk(seq_pos(tok), rr, v, x2, o1, o2);
        *(bf16x8*)(Qa + (size_t)tok * 768 + head * 96 + 64 + rr) = o1;
        *(bf16x8*)(Qa + (size_t)tok * 768 + head * 96 + 80 + rr) = o2;
      }
    }
  }
};

struct EpiKVUp {
  static constexpr bool staged = true;
  bf16_t *KNb, *VtA;
  __device__ float scale() const { return 1.f; }
  __device__ bool transposed(int n0) const { return n0 >= 512; }
  template <int NI> __device__ void direct(int m0, int n0, int wm, int wn, int g, int c, f32x4 (&acc)[4][NI], const float* sR) const {}
  __device__ void store_t(int tok8, int col, bf16x8 v) const { *(bf16x8*)(VtA + (size_t)(col - 512) * T_TOK + tok8) = v; }
  __device__ void store_n(int tok, int col, bf16x8 v, const bf16_t* sp) const { *(bf16x8*)(KNb + (size_t)tok * 512 + col) = v; }
};

struct EpiOut {
  static constexpr bool staged = false;
  const float *xa, *xb;
  float* out;
  bool dry;
  __device__ void operator()(int m0, int n0, int wm, int wn, int g, int c, f32x4 (&acc)[4][8], const float* sR) const {
#pragma unroll
    for (int ni = 0; ni < 8; ++ni) {
      __builtin_amdgcn_sched_barrier(0);
      const int col = n0 + wn * 128 + ni * 16 + c;
#pragma unroll
      for (int mi = 0; mi < 4; ++mi) {
        const int tok = m0 + wm * 64 + mi * 16 + 4 * g;
#pragma unroll
        for (int j = 0; j < 4; ++j) {
          float xo = xrow(xa, xb, tok + j)[col];
          if (!dry) out[(long)(tok + j) * DM + col] = xo + acc[mi][ni][j];
        }
      }
    }
  }
};

__device__ __forceinline__ float scan16(float v, int c) {
  float t;
  t = __shfl_up(v, 1, 16); if (c >= 1) v += t;
  t = __shfl_up(v, 2, 16); if (c >= 2) v += t;
  t = __shfl_up(v, 4, 16); if (c >= 4) v += t;
  t = __shfl_up(v, 8, 16); if (c >= 8) v += t;
  return v;
}

__device__ __forceinline__ float logsig_fast(float x) { return fminf(x, 0.f) - __logf(1.f + __expf(-fabsf(x))); }

__device__ void gla_intra_item(const Params& p, int li, int item, char* smem) {
  const int tid = otid(), lane = tid & 63, w = tid >> 6, c = lane & 15, g = lane >> 4;
  const int ci = item >> 2, h = item & 3;
  const int tokc = ci * 64;
  const float qscale = 0.08838834764831845f;
  bf16_t* sQe = (bf16_t*)smem;
  bf16_t* sKd = sQe + 64 * 136;
  bf16_t* sA = sKd + 64 * 136;
  us4 q4[2][4];
  bf16_t kk[2][4][4];
#pragma unroll
  for (int dt = 0; dt < 2; ++dt)
#pragma unroll
    for (int tt = 0; tt < 4; ++tt) {
      q4[dt][tt] = *(const us4*)(p.Qb + (size_t)(tokc + 16 * tt + c) * 512 + h * 128 + 32 * w + 16 * dt + 4 * g);
#pragma unroll
      for (int j = 0; j < 4; ++j)
        kk[dt][tt][j] = p.Kt[(size_t)(h * 128 + 32 * w + 16 * dt + 4 * g + j) * T_TOK + tokc + 16 * tt + c];
    }
  __syncthreads();
#pragma unroll
  for (int dir = 0; dir < 2; ++dir) {
    bf16_t* QEd = dir ? p.QEb : p.Qb;
    bf16_t* KdTd = dir ? p.KdTb : p.Kt;
    bf16x8 aup[2];
    float bias[2][4];
#pragma unroll
    for (int dt = 0; dt < 2; ++dt) {
      aup[dt] = zero8();
      if (g < 2) aup[dt] = *(const bf16x8*)(p.AupT + ((size_t)(li * 2 + dir) * 512 + h * 128 + 32 * w + 16 * dt + c) * 32 + 8 * g);
#pragma unroll
      for (int j = 0; j < 4; ++j) bias[dt][j] = p.e_a_bias[(li * 2 + dir) * 512 + h * 128 + 32 * w + 16 * dt + 4 * g + j];
    }
    f32x4 la[2][4];
#pragma unroll
    for (int tt = 0; tt < 4; ++tt) {
      bf16x8 lrf = zero8();
      if (g < 2) lrf = *(const bf16x8*)(p.LRb + (size_t)(tokc + 16 * tt + c) * 32 + dir * 16 + 8 * g);
#pragma unroll
      for (int dt = 0; dt < 2; ++dt) la[dt][tt] = mfma16(aup[dt], lrf, zero4());
    }
#pragma unroll
    for (int dt = 0; dt < 2; ++dt)
#pragma unroll
      for (int tt = 0; tt < 4; ++tt)
#pragma unroll
        for (int j = 0; j < 4; ++j) la[dt][tt][j] = logsig_fast(la[dt][tt][j] + bias[dt][j]) * (1.f / 16.f);
    f32x4 P[2][4];
    float tot[2][4];
#pragma unroll
    for (int dt = 0; dt < 2; ++dt)
#pragma unroll
      for (int j = 0; j < 4; ++j) {
        float carry = 0.f;
#pragma unroll
        for (int tt = 0; tt < 4; ++tt) {
          float v = scan16(la[dt][tt][j], c) + carry;
          P[dt][tt][j] = v;
          carry = __shfl(v, 15, 16);
        }
        tot[dt][j] = carry;
      }
#pragma unroll
    for (int dt = 0; dt < 2; ++dt)
#pragma unroll
      for (int tt = 0; tt < 4; ++tt) {
        us4 qo, ko;
#pragma unroll
        for (int j = 0; j < 4; ++j) {
          const float b = (dir == 0) ? P[dt][tt][j] : (tot[dt][j] - P[dt][tt][j] + la[dt][tt][j]);
          qo[j] = f2bf(bf2f(q4[dt][tt][j]) * __expf(b) * qscale);
          ko[j] = f2bf(bf2f(kk[dt][tt][j]) * __expf(-b));
          KdTd[(size_t)(h * 128 + 32 * w + 16 * dt + 4 * g + j) * T_TOK + tokc + 16 * tt + c] = ko[j];
        }
        *(us4*)(QEd + (size_t)(tokc + 16 * tt + c) * 512 + h * 128 + 32 * w + 16 * dt + 4 * g) = qo;
        *(us4*)(sQe + (16 * tt + c) * 136 + 32 * w + 16 * dt + 4 * g) = qo;
        *(us4*)(sKd + (16 * tt + c) * 136 + 32 * w + 16 * dt + 4 * g) = ko;
      }
    if (c == 0) {
#pragma unroll
      for (int dt = 0; dt < 2; ++dt)
#pragma unroll
        for (int j = 0; j < 4; ++j)
          p.EB[(size_t)(dir * 1280 + ci) * 512 + h * 128 + 32 * w + 16 * dt + 4 * g + j] = __expf(tot[dt][j]);
    }
    __syncthreads();
    f32x4 accA[4];
#pragma unroll
    for (int jt = 0; jt < 4; ++jt) accA[jt] = zero4();
#pragma unroll
    for (int ks = 0; ks < 4; ++ks) {
      bf16x8 aq = *(const bf16x8*)(sQe + (16 * w + c) * 136 + 32 * ks + 8 * g);
#pragma unroll
      for (int jt = 0; jt < 4; ++jt) {
        bf16x8 bk = *(const bf16x8*)(sKd + (16 * jt + c) * 136 + 32 * ks + 8 * g);
        accA[jt] = mfma16(aq, bk, accA[jt]);
      }
    }
#pragma unroll
    for (int jt = 0; jt < 4; ++jt)
#pragma unroll
      for (int j = 0; j < 4; ++j) {
        const int i = 16 * w + 4 * g + j, jj = 16 * jt + c;
        const bool keep = (dir == 0) ? (jj <= i) : (jj > i);
        sA[dir * 64 * 72 + i * 72 + jj] = f2bf(keep ? accA[jt][j] : 0.f);
      }
    __syncthreads();
  }
  bf16x8 af[2][2];
#pragma unroll
  for (int dir = 0; dir < 2; ++dir)
#pragma unroll
    for (int k2 = 0; k2 < 2; ++k2) af[dir][k2] = *(const bf16x8*)(sA + dir * 64 * 72 + (16 * w + c) * 72 + 32 * k2 + 8 * g);
#pragma unroll 4
  for (int vt = 0; vt < 16; ++vt) {
    f32x4 a = zero4();
#pragma unroll
    for (int k2 = 0; k2 < 2; ++k2) {
      bf16x8 vfr = *(const bf16x8*)(p.VtE + (size_t)(h * 256 + 16 * vt + c) * T_TOK + tokc + 32 * k2 + 8 * g);
      a = mfma16(af[0][k2], vfr, a);
      a = mfma16(af[1][k2], vfr, a);
    }
#pragma unroll
    for (int j = 0; j < 4; ++j) p.TMP[(size_t)(tokc + 16 * w + 4 * g + j) * 1024 + h * 256 + 16 * vt + c] = f2bf(a[j]);
  }
}

struct GlaRegs {
  bf16x8 aq[4];
  bf16x8 vf[2][2];
  bf16x8 kf[2][2];
  float eb[2];
};

template <int DIR>
__device__ __forceinline__ void gla_chain_load(const Params& p, int h, int sl, int tokc, int w, int c, int g, GlaRegs& r) {
  const bf16_t* QE = DIR ? p.QEb : p.Qb;
  const bf16_t* KdT = DIR ? p.KdTb : p.Kt;
#pragma unroll
  for (int ks = 0; ks < 4; ++ks) r.aq[ks] = *(const bf16x8*)(QE + (size_t)(tokc + 16 * w + c) * 512 + h * 128 + 32 * ks + 8 * g);
#pragma unroll
  for (int vt = 0; vt < 2; ++vt)
#pragma unroll
    for (int k2 = 0; k2 < 2; ++k2)
      r.vf[vt][k2] = *(const bf16x8*)(p.VtE + (size_t)(h * 256 + sl * 32 + 16 * vt + c) * T_TOK + tokc + 32 * k2 + 8 * g);
#pragma unroll
  for (int dt = 0; dt < 2; ++dt) {
#pragma unroll
    for (int k2 = 0; k2 < 2; ++k2)
      r.kf[dt][k2] = *(const bf16x8*)(KdT + (size_t)(h * 128 + 32 * w + 16 * dt + c) * T_TOK + tokc + 32 * k2 + 8 * g);
    r.eb[dt] = p.EB[(size_t)(DIR * 1280 + (tokc >> 6)) * 512 + h * 128 + 32 * w + 16 * dt + c];
  }
}

__device__ __forceinline__ void gla_chain_compute(const Params& p, int h, int sl, int tokc, int w, int c, int g, const GlaRegs& r,
                                                  f32x4 (&S)[2][2], bf16_t* sSt) {
  bf16_t told[2][4];
#pragma unroll
  for (int vt = 0; vt < 2; ++vt)
#pragma unroll
    for (int j = 0; j < 4; ++j) told[vt][j] = p.TMP[(size_t)(tokc + 16 * w + 4 * g + j) * 1024 + h * 256 + sl * 32 + 16 * vt + c];
#pragma unroll
  for (int vt = 0; vt < 2; ++vt)
#pragma unroll
    for (int dt = 0; dt < 2; ++dt)
#pragma unroll
      for (int j = 0; j < 4; ++j) sSt[(16 * vt + 4 * g + j) * 136 + 32 * w + 16 * dt + c] = f2bf(S[vt][dt][j]);
  __syncthreads();
  f32x4 o[2];
  o[0] = zero4(); o[1] = zero4();
#pragma unroll
  for (int ks = 0; ks < 4; ++ks)
#pragma unroll
    for (int vt = 0; vt < 2; ++vt) {
      bf16x8 sf = *(const bf16x8*)(sSt + (16 * vt + c) * 136 + 32 * ks + 8 * g);
      o[vt] = mfma16(r.aq[ks], sf, o[vt]);
    }
#pragma unroll
  for (int dt = 0; dt < 2; ++dt)
#pragma unroll
    for (int vt = 0; vt < 2; ++vt) {
      f32x4 a = S[vt][dt];
#pragma unroll
      for (int k2 = 0; k2 < 2; ++k2) a = mfma16(r.vf[vt][k2], r.kf[dt][k2], a);
      S[vt][dt] = a * r.eb[dt];
    }
#pragma unroll
  for (int vt = 0; vt < 2; ++vt)
#pragma unroll
    for (int j = 0; j < 4; ++j)
      p.TMP[(size_t)(tokc + 16 * w + 4 * g + j) * 1024 + h * 256 + sl * 32 + 16 * vt + c] = f2bf(bf2f(told[vt][j]) + o[vt][j]);
}

__device__ void gla_chain_item(const Params& p, int li, int item, char* smem) {
  const int tid = otid(), lane = tid & 63, w = tid >> 6, c = lane & 15, g = lane >> 4;
  int s, rem;
  if (item < 256) { s = 4 + item / 32; rem = item % 32; } else { s = (item - 256) / 32; rem = (item - 256) % 32; }
  const int h = rem >> 3, sl = rem & 7;
  const int tok0 = s < 4 ? s * 4096 : T_P + (s - 4) * 8192;
  const int len = s < 4 ? 4096 : 8192;
  const int N = len / 64;
  bf16_t* sSt0 = (bf16_t*)smem;
  bf16_t* sSt1 = sSt0 + 32 * 136;
  f32x4 Sf[2][2], Sb[2][2];
#pragma unroll
  for (int a = 0; a < 2; ++a)
#pragma unroll
    for (int b = 0; b < 2; ++b) { Sf[a][b] = zero4(); Sb[a][b] = zero4(); }
  GlaRegs rf, rb;
  __syncthreads();
  gla_chain_load<0>(p, h, sl, tok0, w, c, g, rf);
  for (int step = 0; step < N; ++step) {
    const int tf = tok0 + step * 64, tb = tok0 + (N - 1 - step) * 64;
    gla_chain_load<1>(p, h, sl, tb, w, c, g, rb);
    gla_chain_compute(p, h, sl, tf, w, c, g, rf, Sf, sSt0);
    if (step + 1 < N) gla_chain_load<0>(p, h, sl, tf + 64, w, c, g, rf);
    gla_chain_compute(p, h, sl, tb, w, c, g, rb, Sb, sSt1);
  }
}

__device__ void pool_item(const Params& p, int li, int item, char* smem) {
  const int tid = otid(), lane = tid & 63, w = tid >> 6, c = lane & 15, g = lane >> 4;
  const int gi = item & 3;
  const int tile = item >> 2;
  const int tokc = tile * 64;
  const int pos0 = seq_pos(tokc);
  const int len = tokc < T_P ? 4096 : 8192;
  float* sU = (float*)smem;
  bf16_t* sP = (bf16_t*)(sU + 80 * 128);
  __syncthreads();
  for (int idx = tid; idx < 80 * 128; idx += 256) {
    int r = idx >> 7, ch = idx & 127;
    int pos = pos0 - 8 + r;
    float v = 0.f;
    if (pos >= 0 && pos < len) v = bf2f(p.PUb[(long)(tokc - 8 + r) * 512 + gi * 128 + ch]);
    sU[idx] = v;
  }
  __syncthreads();
  {
    const int ch = tid & 127, th = tid >> 7;
    const int half = 1 << gi;
    for (int t = th * 32; t < th * 32 + 32; ++t) {
      int pos = pos0 + t;
      int lo = max(pos - half, 0), hi = min(pos + half, len);
      float s = 0.f;
      for (int q = lo; q < hi; ++q) s += sU[(q - pos0 + 8) * 128 + ch];
      float pooled = s / (float)(hi - lo) - sU[(t + 8) * 128 + ch];
      sP[t * 136 + ch] = f2bf(pooled);
    }
  }
  __syncthreads();
  f32x4 acc[8];
#pragma unroll
  for (int dt = 0; dt < 8; ++dt) acc[dt] = zero4();
  const bf16_t* PW = p.PoolWT + (long)(li * 4 + gi) * 128 * 128;
#pragma unroll
  for (int ks = 0; ks < 4; ++ks) {
    bf16x8 af = *(const bf16x8*)(sP + (16 * w + c) * 136 + 32 * ks + 8 * g);
#pragma unroll
    for (int dt = 0; dt < 8; ++dt) {
      bf16x8 bw = *(const bf16x8*)(PW + (long)(16 * dt + c) * 128 + 32 * ks + 8 * g);
      acc[dt] = mfma16(af, bw, acc[dt]);
    }
  }
#pragma unroll
  for (int dt = 0; dt < 8; ++dt) {
    const int d = gi * 128 + 16 * dt + c;
    const float sc = p.e_pool_scale[li * 512 + d];
#pragma unroll
    for (int j = 0; j < 4; ++j) {
      const long addr = (long)(tokc + 16 * w + 4 * g + j) * 512 + d;
      float gt = bf2f(p.PGb[addr]);
      p.PGb[addr] = f2bf(acc[dt][j] * sc * siluf_(gt));
    }
  }
}

template <int DIR>
__device__ __forceinline__ void ml_chunk(const Params& p, int li, int h, int sl, int tokc, bool second, float& mstate,
                                         f32x4 (&C)[3][2], bf16_t* sKwT, bf16_t* sA, bf16_t* sCt, float* sc) {
  const int tid = otid(), lane = tid & 63, w = tid >> 6, c = lane & 15, g = lane >> 4;
  const float kscale = 0.08838834764831845f;
  float* sRA = sc;
  float* sCB = sc + 64;
  float* sE = sc + 128;
  float* sThr = sc + 192;
  float* sWk = sc + 256;
  float* sMisc = sc + 320;
  if (w == 0) {
    const float bi = p.o_if_bias[li * 16 + DIR * 4 + h];
    const float bff = p.o_if_bias[li * 16 + 8 + DIR * 4 + h];
    const float* mf = p.MIF + (long)(tokc + lane) * 16;
    const float liv = mf[DIR * 4 + h] + bi;
    const float lfv = logsigmoidf_(mf[8 + DIR * 4 + h] + bff);
    float ps = lfv;
#pragma unroll
    for (int d = 1; d < 64; d <<= 1) {
      float t = __shfl_up(ps, d);
      if (lane >= d) ps += t;
    }
    const float total = __shfl(ps, 63);
    const float b = (DIR == 0) ? ps : (total - ps + lfv);
    const float cB = liv - b;
    float pm = cB;
    if (DIR == 0) {
#pragma unroll
      for (int d = 1; d < 64; d <<= 1) {
        float t = __shfl_up(pm, d);
        if (lane >= d) pm = fmaxf(pm, t);
      }
    } else {
#pragma unroll
      for (int d = 1; d < 64; d <<= 1) {
        float t = __shfl_down(pm, d);
        if (lane + d < 64) pm = fmaxf(pm, t);
      }
      float t = __shfl_down(pm, 1);
      pm = (lane < 63) ? t : -1e30f;
    }
    const float m = mstate;
    const float M = fmaxf(m, pm);
    sRA[lane] = -M;
    sCB[lane] = cB;
    sE[lane] = __expf(m - M);
    sThr[lane] = __expf(-b - M);
    float mall = cB;
#pragma unroll
    for (int d = 1; d < 64; d <<= 1) mall = fmaxf(mall, __shfl_xor(mall, d));
    const float Mn = fmaxf(m, mall);
    sWk[lane] = __expf(cB - Mn);
    if (lane == 0) {
      sMisc[0] = __expf(m - Mn);
      sMisc[1] = total + Mn;
    }
  }
#pragma unroll
  for (int vt = 0; vt < 3; ++vt)
#pragma unroll
    for (int dt = 0; dt < 2; ++dt)
#pragma unroll
      for (int j = 0; j < 4; ++j) sCt[(16 * vt + 4 * g + j) * 136 + 32 * w + 16 * dt + c] = f2bf(C[vt][dt][j]);
  bf16x8 vf[2][2];
#pragma unroll
  for (int vt = 0; vt < 2; ++vt)
#pragma unroll
    for (int k2 = 0; k2 < 2; ++k2)
      vf[vt][k2] = *(const bf16x8*)(p.MVt + (long)(h * 128 + sl * 32 + 16 * vt + c) * T_TOK + tokc + 32 * k2 + 8 * g);
  bf16x8 ones = zero8();
  if (c == 0) {
#pragma unroll
    for (int e = 0; e < 8; ++e) ones[e] = (short)0x3F80;
  }
  bf16x8 aq[4];
#pragma unroll
  for (int ks = 0; ks < 4; ++ks) aq[ks] = *(const bf16x8*)(p.MQb + (long)(tokc + 16 * w + c) * 512 + h * 128 + 32 * ks + 8 * g);
  __syncthreads();
  const float decay = sMisc[0];
  mstate = sMisc[1];
#pragma unroll
  for (int i = 0; i < 4; ++i) {
    const int id = tid + 256 * i;
    const int tk = id >> 4, c8 = id & 15;
    bf16x8 kv = *(const bf16x8*)(p.MKb + (long)(tokc + tk) * 512 + h * 128 + 8 * c8);
    const float wk = sWk[tk] * kscale;
#pragma unroll
    for (int e = 0; e < 8; ++e) sKwT[(8 * c8 + e) * 72 + tk] = f2bf(bf2f((bf16_t)kv[e]) * wk);
  }
  f32x4 accA[4];
#pragma unroll
  for (int jt = 0; jt < 4; ++jt) accA[jt] = zero4();
#pragma unroll
  for (int ks = 0; ks < 4; ++ks)
#pragma unroll
    for (int jt = 0; jt < 4; ++jt) {
      bf16x8 bk = *(const bf16x8*)(p.MKb + (long)(tokc + 16 * jt + c) * 512 + h * 128 + 32 * ks + 8 * g);
      accA[jt] = mfma16(aq[ks], bk, accA[jt]);
    }
#pragma unroll
  for (int jt = 0; jt < 4; ++jt)
#pragma unroll
    for (int j = 0; j < 4; ++j) {
      const int i = 16 * w + 4 * g + j, jj = 16 * jt + c;
      const bool keep = (DIR == 0) ? (jj <= i) : (jj > i);
      float sv = keep ? accA[jt][j] * kscale * __expf(sRA[i] + sCB[jj]) : 0.f;
      sA[i * 72 + jj] = f2bf(sv);
    }
  __syncthreads();
  f32x4 o1[3], o2[3];
#pragma unroll
  for (int vt = 0; vt < 3; ++vt) { o1[vt] = zero4(); o2[vt] = zero4(); }
#pragma unroll
  for (int k2 = 0; k2 < 2; ++k2) {
    bf16x8 af = *(const bf16x8*)(sA + (16 * w + c) * 72 + 32 * k2 + 8 * g);
    o1[0] = mfma16(af, vf[0][k2], o1[0]);
    o1[1] = mfma16(af, vf[1][k2], o1[1]);
    o1[2] = mfma16(af, ones, o1[2]);
  }
#pragma unroll
  for (int ks = 0; ks < 4; ++ks)
#pragma unroll
    for (int vt = 0; vt < 3; ++vt) {
      bf16x8 cf = *(const bf16x8*)(sCt + (16 * vt + c) * 136 + 32 * ks + 8 * g);
      o2[vt] = mfma16(aq[ks], cf, o2[vt]);
    }
#pragma unroll
  for (int j = 0; j < 4; ++j) {
    const int i = 16 * w + 4 * g + j;
    const float e = sE[i], thr = sThr[i];
    float den = o1[2][j] + e * o2[2][j];
    den = __shfl(den, lane & 48);
    const float dn = fmaxf(fabsf(den), thr);
#pragma unroll
    for (int vt = 0; vt < 2; ++vt) {
      float hv = (o1[vt][j] + e * o2[vt][j]) / dn;
      const long addr = (long)(tokc + i) * 512 + h * 128 + sl * 32 + 16 * vt + c;
      if (second) hv += bf2f(p.TMP2[addr]);
      p.TMP2[addr] = f2bf(hv);
    }
  }
#pragma unroll
  for (int dt = 0; dt < 2; ++dt)
#pragma unroll
    for (int vt = 0; vt < 3; ++vt) {
      f32x4 a = C[vt][dt] * decay;
#pragma unroll
      for (int k2 = 0; k2 < 2; ++k2) {
        bf16x8 kf = *(const bf16x8*)(sKwT + (32 * w + 16 * dt + c) * 72 + 32 * k2 + 8 * g);
        a = mfma16(vt < 2 ? vf[vt < 2 ? vt : 0][k2] : ones, kf, a);
      }
      C[vt][dt] = a;
    }
  __syncthreads();
}

__device__ void ml_chain_item(const Params& p, int li, int item, char* smem) {
  int s, rem;
  if (item < 128) { s = 4 + item / 16; rem = item % 16; } else { s = (item - 128) / 16; rem = (item - 128) % 16; }
  const int h = rem >> 2, sl = rem & 3;
  const int tok0 = s < 4 ? s * 4096 : T_P + (s - 4) * 8192;
  const int len = s < 4 ? 4096 : 8192;
  const int N = len / 64;
  bf16_t* sKwT = (bf16_t*)smem;
  bf16_t* sA = sKwT + 128 * 72;
  bf16_t* sCt = sA + 64 * 72;
  float* sc = (float*)(sCt + 48 * 136);
  f32x4 Cf[3][2], Cb[3][2];
#pragma unroll
  for (int a = 0; a < 3; ++a)
#pragma unroll
    for (int b = 0; b < 2; ++b) { Cf[a][b] = zero4(); Cb[a][b] = zero4(); }
  float mf = 0.f, mb = 0.f;
  __syncthreads();
  for (int step = 0; step < N; ++step) {
    const bool second = step >= (N >> 1);
    ml_chunk<0>(p, li, h, sl, tok0 + step * 64, second, mf, Cf, sKwT, sA, sCt, sc);
    ml_chunk<1>(p, li, h, sl, tok0 + (N - 1 - step) * 64, second, mb, Cb, sKwT, sA, sCt, sc);
  }
}

#define ATTN_GLOAD(KT)                                                                              \
  {                                                                                                 \
    const long kb = tok0 + (KT) * 64;                                                               \
    rk0 = *(const bf16x8*)(p.KNb + (kb + (tid >> 3)) * 512 + head * 64 + 8 * (tid & 7));            \
    rk1 = *(const bf16x8*)(p.KNb + (kb + 32 + (tid >> 3)) * 512 + head * 64 + 8 * (tid & 7));       \
    rkr = *(const bf16x8*)(p.KRb + (kb + (tid >> 2)) * 32 + 8 * (tid & 3));                          \
    rv0 = *(const bf16x8*)(p.VtA + (long)(head * 64 + (tid >> 3)) * T_TOK + kb + 8 * (tid & 7));     \
    rv1 = *(const bf16x8*)(p.VtA + (long)(head * 64 + 32 + (tid >> 3)) * T_TOK + kb + 8 * (tid & 7)); \
  }
__device__ void attn_item(const Params& p, int item, char* smem, bool dry = false) {
  const int tid = otid(), lane = tid & 63, w = tid >> 6, c = lane & 15, g = lane >> 4;
  int s, head, qb;
  if (item < 4096) { s = 4 + item / 512; int rem = item % 512; head = rem / 64; qb = rem % 64; }
  else { int it = item - 4096; s = it / 256; int rem = it % 256; head = rem / 32; qb = rem % 32; }
  const int tok0 = s < 4 ? s * 4096 : T_P + (s - 4) * 8192;
  const int len = s < 4 ? 4096 : 8192;
  const int nkv = len / 64;
  bf16_t* sK = (bf16_t*)smem;
  bf16_t* sVt = sK + 64 * 104;
  const int qrow0 = tok0 + qb * 128 + 32 * w;
  bf16x8 qf[2][3];
#pragma unroll
  for (int nt = 0; nt < 2; ++nt)
#pragma unroll
    for (int ks = 0; ks < 3; ++ks)
      qf[nt][ks] = *(const bf16x8*)(p.Qa + (long)(qrow0 + 16 * nt + c) * 768 + head * 96 + 32 * ks + 8 * g);
  f32x4 ot[4][2];
#pragma unroll
  for (int vt = 0; vt < 4; ++vt) { ot[vt][0] = zero4(); ot[vt][1] = zero4(); }
  float mrun[2] = {-1e30f, -1e30f}, lrun[2] = {0.f, 0.f};
  bf16x8 rk0, rk1, rkr, rv0, rv1;
  ATTN_GLOAD(0)
  for (int kt = 0; kt < nkv; ++kt) {
    __syncthreads();
    *(bf16x8*)(sK + (tid >> 3) * 104 + 8 * (tid & 7)) = rk0;
    *(bf16x8*)(sK + (32 + (tid >> 3)) * 104 + 8 * (tid & 7)) = rk1;
    *(bf16x8*)(sK + (tid >> 2) * 104 + 64 + 8 * (tid & 3)) = rkr;
    *(bf16x8*)(sVt + (tid >> 3) * 72 + 8 * (tid & 7)) = rv0;
    *(bf16x8*)(sVt + (32 + (tid >> 3)) * 72 + 8 * (tid & 7)) = rv1;
    __syncthreads();
    if (kt + 1 < nkv) ATTN_GLOAD(kt + 1)
    f32x4 st[4][2];
#pragma unroll
    for (int k4 = 0; k4 < 4; ++k4) { st[k4][0] = zero4(); st[k4][1] = zero4(); }
#pragma unroll
    for (int ks = 0; ks < 3; ++ks)
#pragma unroll
      for (int k4 = 0; k4 < 4; ++k4) {
        bf16x8 kf = *(const bf16x8*)(sK + (16 * k4 + c) * 104 + 32 * ks + 8 * g);
        st[k4][0] = mfma16(kf, qf[0][ks], st[k4][0]);
        st[k4][1] = mfma16(kf, qf[1][ks], st[k4][1]);
      }
#pragma unroll
    for (int nt = 0; nt < 2; ++nt) {
      float mx = -1e30f;
#pragma unroll
      for (int k4 = 0; k4 < 4; ++k4)
#pragma unroll
        for (int j = 0; j < 4; ++j) mx = fmaxf(mx, st[k4][nt][j]);
      mx = fmaxf(mx, __shfl_xor(mx, 16));
      mx = fmaxf(mx, __shfl_xor(mx, 32));
      const float mn = fmaxf(mrun[nt], mx);
      const float alpha = __builtin_amdgcn_exp2f(mrun[nt] - mn);
      mrun[nt] = mn;
      float psum = 0.f;
#pragma unroll
      for (int k4 = 0; k4 < 4; ++k4)
#pragma unroll
        for (int j = 0; j < 4; ++j) {
          float pv = __builtin_amdgcn_exp2f(st[k4][nt][j] - mn);
          st[k4][nt][j] = pv;
          psum += pv;
        }
      lrun[nt] = lrun[nt] * alpha + psum;
#pragma unroll
      for (int vt = 0; vt < 4; ++vt) ot[vt][nt] = ot[vt][nt] * alpha;
    }
#pragma unroll
    for (int k2 = 0; k2 < 2; ++k2) {
      bf16x8 pb[2];
#pragma unroll
      for (int nt = 0; nt < 2; ++nt) {
        typedef __attribute__((ext_vector_type(4))) unsigned u32x4;
        u32x4 pk;
        pk[0] = pk2bf(st[2 * k2][nt][0], st[2 * k2][nt][1]);
        pk[1] = pk2bf(st[2 * k2][nt][2], st[2 * k2][nt][3]);
        pk[2] = pk2bf(st[2 * k2 + 1][nt][0], st[2 * k2 + 1][nt][1]);
        pk[3] = pk2bf(st[2 * k2 + 1][nt][2], st[2 * k2 + 1][nt][3]);
        pb[nt] = __builtin_bit_cast(bf16x8, pk);
      }
#pragma unroll
      for (int vt = 0; vt < 4; ++vt) {
        us4 lo = *(const us4*)(sVt + (16 * vt + c) * 72 + 32 * k2 + 4 * g);
        us4 hi = *(const us4*)(sVt + (16 * vt + c) * 72 + 32 * k2 + 16 + 4 * g);
        bf16x8 av;
#pragma unroll
        for (int e = 0; e < 4; ++e) { av[e] = (short)lo[e]; av[4 + e] = (short)hi[e]; }
        ot[vt][0] = mfma16(av, pb[0], ot[vt][0]);
        ot[vt][1] = mfma16(av, pb[1], ot[vt][1]);
      }
    }
  }
#pragma unroll
  for (int nt = 0; nt < 2; ++nt) {
    float lt = lrun[nt];
    lt += __shfl_xor(lt, 16);
    lt += __shfl_xor(lt, 32);
    const float inv = 1.f / lt;
    const long tok = qrow0 + 16 * nt + c;
#pragma unroll
    for (int vt = 0; vt < 4; ++vt) {
      bf16_t* gp = p.MGb + tok * 512 + head * 64 + 16 * vt + 4 * g;
      us4 gt = *(const us4*)gp;
      us4 o;
#pragma unroll
      for (int j = 0; j < 4; ++j) o[j] = f2bf(ot[vt][nt][j] * inv * siluf_(bf2f(gt[j])));
      if (!dry) *(us4*)gp = o;
    }
  }
}

__device__ void phase_gla_combine(const Params& p, int li) {
  const int tid_ = otid(); const int lane = tid_ & 63, w = tid_ >> 6;
  for (int tok = blockIdx.x * 4 + w; tok < T_TOK; tok += gridDim.x * 4) {
    const bf16_t* tp = p.TMP + (long)tok * 1024 + 16 * lane;
    bf16_t* gp = p.Gb + (long)tok * 1024 + 16 * lane;
    bf16x8 o0 = *(const bf16x8*)tp, o1 = *(const bf16x8*)(tp + 8);
    bf16x8 g0 = *(const bf16x8*)gp, g1 = *(const bf16x8*)(gp + 8);
    float ov[16], gv[16];
#pragma unroll
    for (int e = 0; e < 8; ++e) {
      ov[e] = bf2f((bf16_t)o0[e]); ov[8 + e] = bf2f((bf16_t)o1[e]);
      gv[e] = bf2f((bf16_t)g0[e]); gv[8 + e] = bf2f((bf16_t)g1[e]);
    }
    float ss = 0.f;
#pragma unroll
    for (int e = 0; e < 16; ++e) ss += ov[e] * ov[e];
    ss += __shfl_xor(ss, 1); ss += __shfl_xor(ss, 2); ss += __shfl_xor(ss, 4); ss += __shfl_xor(ss, 8);
    const float rs = rsqrtf(ss * (1.f / 256.f) + EPS);
    const float* ng = p.e_gla_norm_g + li * 256 + ((16 * lane) & 255);
    bf16x8 r0, r1;
#pragma unroll
    for (int e = 0; e < 8; ++e) {
      r0[e] = (short)f2bf(ov[e] * rs * ng[e] * siluf_(gv[e]));
      r1[e] = (short)f2bf(ov[8 + e] * rs * ng[8 + e] * siluf_(gv[8 + e]));
    }
    *(bf16x8*)gp = r0;
    *(bf16x8*)(gp + 8) = r1;
  }
}

__device__ void phase_ml_combine(const Params& p, int li) {
  const int tid_ = otid(); const int lane = tid_ & 63, w = tid_ >> 6;
  for (int tok = blockIdx.x * 4 + w; tok < T_TOK; tok += gridDim.x * 4) {
    const long off = (long)tok * 512 + 8 * lane;
    bf16x8 hv = *(const bf16x8*)(p.TMP2 + off);
    bf16x8 mo = *(const bf16x8*)(p.MOb + off);
    bf16x8 mg = *(const bf16x8*)(p.MLGb + off);
    float hf[8];
    float ss = 0.f;
#pragma unroll
    for (int e = 0; e < 8; ++e) { hf[e] = bf2f((bf16_t)hv[e]); ss += hf[e] * hf[e]; }
    ss += __shfl_xor(ss, 1); ss += __shfl_xor(ss, 2); ss += __shfl_xor(ss, 4); ss += __shfl_xor(ss, 8);
    const float rs = rsqrtf(ss * (1.f / 128.f) + EPS);
    const float* ng = p.o_ml_norm_g + li * 128 + ((8 * lane) & 127);
    bf16x8 r;
#pragma unroll
    for (int e = 0; e < 8; ++e)
      r[e] = (short)f2bf(hf[e] * rs * ng[e] * sigmoidf_(bf2f((bf16_t)mo[e])) * siluf_(bf2f((bf16_t)mg[e])));
    *(bf16x8*)(p.MLGb + off) = r;
  }
}

__device__ void phase_final(const Params& p) {
  const int tid_ = otid(); const int lane = tid_ & 63, w = tid_ >> 6;
  for (int tok = blockIdx.x * 4 + w; tok < T_TOK; tok += gridDim.x * 4) {
    float* xp = p.out + (long)tok * DM;
    float4 v[4];
    float ss = 0.f;
#pragma unroll
    for (int i = 0; i < 4; ++i) {
      v[i] = *(const float4*)(xp + 4 * lane + 256 * i);
      ss += v[i].x * v[i].x + v[i].y * v[i].y + v[i].z * v[i].z + v[i].w * v[i].w;
    }
#pragma unroll
    for (int d = 1; d < 64; d <<= 1) ss += __shfl_xor(ss, d);
    const float rs = rsqrtf(ss * (1.f / 1024.f) + EPS);
#pragma unroll
    for (int i = 0; i < 4; ++i) {
      float4 gq = *(const float4*)(p.final_norm_g + 4 * lane + 256 * i);
      float4 o;
      o.x = v[i].x * rs * gq.x; o.y = v[i].y * rs * gq.y; o.z = v[i].z * rs * gq.z; o.w = v[i].w * rs * gq.w;
      *(float4*)(xp + 4 * lane + 256 * i) = o;
    }
  }
}

__device__ void run_phase(const Params& p, int ph, char* smem) {
  if (ph == 0) { if (PH_ON(0)) phase_prep(p); return; }
  if (ph == NPHASE - 1) { if (PH_ON(11)) phase_final(p); return; }
  const int q = ph - 1;
  const int layer = (q < 5) ? 0 : (q < 10) ? 1 : (q < 15) ? 2 : 3;
  const int sub = (q < 5) ? q : (q < 10) ? q - 5 : (q < 15) ? q - 10 : q - 15;
  const int li = layer >> 1;
  const float* xa = (layer == 0) ? p.x_prompt : p.out;
  const float* xb = (layer == 0) ? p.x_sample : p.out + (long)T_P * DM;
  if ((layer & 1) == 0) {
    if (sub == 0) {
      EpiEvenIn e{p.Qb, p.Kt, p.VtE, p.Gb, p.LRb, p.PUb, p.PGb};
      for (int rep = 0; rep < 1 + PROBE_GEMM; ++rep)
      if (PH_ON(1)) gemm_phase<0, 8>(T_TOK / 128, NE_PAD / 256, DM, p.WinE + (long)li * NE_PAD * DM, xa, xb, nullptr, 0, 0, nullptr, 0, e, smem);
    } else if (sub == 1) {
      for (int item = blockIdx.x; item < 5120 + 5120; item += gridDim.x) {
        if (item < 5120) { if (PH_ON(2)) gla_intra_item(p, li, item, smem); }
        else { if (PH_ON(3)) pool_item(p, li, item - 5120, smem); }
      }
    } else if (sub == 2) {
      for (int rep = 0; rep < 1 + PROBE_CHAIN; ++rep)
      for (int item = blockIdx.x; item < 384; item += gridDim.x)
        if (PH_ON(2)) gla_chain_item(p, li, item, smem);
    } else if (sub == 3) {
      if (PH_ON(4)) phase_gla_combine(p, li);
    } else {
      if (PROBE_GEMM) { EpiOut ed{xa, xb, p.out, true}; gemm_phase<1, 8>(T_TOK / 128, DM / 256, 1536, p.WoutE + (long)li * DM * 1536, nullptr, nullptr, p.Gb, 1024, 1024, p.PGb, 512, ed, smem); }
      EpiOut e{xa, xb, p.out, false};
      if (PH_ON(5)) gemm_phase<1, 8>(T_TOK / 128, DM / 256, 1536, p.WoutE + (long)li * DM * 1536, nullptr, nullptr, p.Gb, 1024, 1024, p.PGb, 512, e, smem);
    }
  } else {
    if (sub == 0) {
      EpiOddIn e{p.CQb, p.CKVb, p.KRb, p.MGb, p.MQb, p.MKb, p.MVt, p.MOb, p.MLGb, p.MIF};
      for (int rep = 0; rep < 1 + PROBE_GEMM; ++rep)
      if (PH_ON(6)) gemm_phase<0, 8>(T_TOK / 128, NO_PAD / 256, DM, p.WinO + (long)li * NO_PAD * DM, xa, xb, nullptr, 0, 0, nullptr, 0, e, smem);
    } else if (sub == 1) {
      for (int rep = 0; rep < 1 + PROBE_GEMM; ++rep) {
      EpiQUp eq{p.Qa};
      if (PH_ON(7)) gemm_phase<2, 4>(T_TOK / 128, 768 / 128, 384, p.QupT + (long)li * 768 * 384, nullptr, nullptr, p.CQb, 384, 384, p.CQb, 384, eq, smem);
      EpiKVUp ek{p.KNb, p.VtA};
      if (PH_ON(7)) gemm_phase<2, 4>(T_TOK / 128, 1024 / 128, 256, p.KVupT + (long)li * 1024 * 256, nullptr, nullptr, p.CKVb, 256, 256, p.CKVb, 256, ek, smem);
      }
    } else if (sub == 2) {
      __shared__ int s_item;
      for (int rep = 0; rep < 1 + PROBE_CHAIN; ++rep)
      if (PH_ON(8)) if ((int)blockIdx.x < 192) ml_chain_item(p, li, blockIdx.x, smem);
      for (int rep = PROBE_ATTN ? 0 : 1; rep < 2; ++rep)
      for (;;) {
        __syncthreads();
        if (threadIdx.x == 0) s_item = atomicAdd(p.counters + li + 2 * rep, 1);
        __syncthreads();
        const int item = s_item;
        if (item >= 5120) break;
        if (PH_ON(9)) attn_item(p, item, smem, rep == 0);
      }
    } else if (sub == 3) {
      if (PH_ON(10)) phase_ml_combine(p, li);
    } else {
      if (PROBE_GEMM) { EpiOut ed{xa, xb, p.out, true}; gemm_phase<1, 8>(T_TOK / 128, DM / 256, 1024, p.WoutO + (long)li * DM * 1024, nullptr, nullptr, p.MGb, 512, 512, p.MLGb, 512, ed, smem); }
      EpiOut e{xa, xb, p.out, false};
      if (PH_ON(5)) gemm_phase<1, 8>(T_TOK / 128, DM / 256, 1024, p.WoutO + (long)li * DM * 1024, nullptr, nullptr, p.MGb, 512, 512, p.MLGb, 512, e, smem);
    }
  }
}

__global__ void __launch_bounds__(256, 2) mega_kernel(Params p) {
  extern __shared__ __attribute__((aligned(16))) char smem[];
  cg::grid_group grid = cg::this_grid();
  for (int ph = p.ph_lo; ph < p.ph_hi; ++ph) {
    if (ph > p.ph_lo) grid.sync();
    run_phase(p, ph, smem);
  }
}

extern "C" void kernel_launch(void* const* d_in, const int* in_sizes, int n_in, void* d_out, int out_size, void* d_ws,
                              size_t ws_size, hipStream_t stream) {
  static int grid_blocks = 0;
  if (!grid_blocks) {
    int dev = 0, cus = 0, per_cu = 0;
    hipGetDevice(&dev);
    hipDeviceGetAttribute(&cus, hipDeviceAttributeMultiprocessorCount, dev);
    hipFuncSetAttribute((const void*)mega_kernel, hipFuncAttributeMaxDynamicSharedMemorySize, LDS_BYTES);
    hipOccupancyMaxActiveBlocksPerMultiprocessor(&per_cu, (const void*)mega_kernel, 256, LDS_BYTES);
    if (per_cu < 1) per_cu = 1;
    if (per_cu > 2) per_cu = 2;
    grid_blocks = cus * per_cu;
    fprintf(stderr, "kernel_launch: cus %d per_cu %d grid %d ws %zu\n", cus, per_cu, grid_blocks, ws_size);
  }
  Params p{};
  const float** pin = (const float**)&p;
  for (int i = 0; i < 19; ++i) pin[i] = (const float*)d_in[i];
  p.out = (float*)d_out;
  char* ws = (char*)d_ws;
  size_t off = 0;
  auto take = [&](size_t bytes) { char* r = ws + off; off += (bytes + 255) & ~(size_t)255; return r; };
  p.WinE = (bf16_t*)take((size_t)2 * NE_PAD * DM * 2);
  p.WinO = (bf16_t*)take((size_t)2 * NO_PAD * DM * 2);
  p.WoutE = (bf16_t*)take((size_t)2 * DM * 1536 * 2);
  p.WoutO = (bf16_t*)take((size_t)2 * DM * 1024 * 2);
  p.QupT = (bf16_t*)take((size_t)2 * 768 * 384 * 2);
  p.KVupT = (bf16_t*)take((size_t)2 * 1024 * 256 * 2);
  p.PoolWT = (bf16_t*)take((size_t)2 * 4 * 128 * 128 * 2);
  p.AupT = (bf16_t*)take((size_t)2 * 2 * 512 * 32 * 2);
  p.counters = (int*)take(256);
  const size_t act0 = off;
  const size_t T = T_TOK;
  p.Qb = (bf16_t*)take(T * 512 * 2);
  p.Kt = (bf16_t*)take(T * 512 * 2);
  p.QEb = (bf16_t*)take(T * 512 * 2);
  p.KdTb = (bf16_t*)take(T * 512 * 2);
  p.EB = (float*)take((size_t)2 * 1280 * 512 * 4);
  p.VtE = (bf16_t*)take(T * 1024 * 2);
  p.Gb = (bf16_t*)take(T * 1024 * 2);
  p.LRb = (bf16_t*)take(T * 32 * 2);
  p.PUb = (bf16_t*)take(T * 512 * 2);
  p.PGb = (bf16_t*)take(T * 512 * 2);
  p.TMP = (bf16_t*)take(T * 1024 * 2);
  const size_t even_end = off;
  off = act0;
  p.TMP2 = (bf16_t*)take(T * 512 * 2);
  p.CQb = (bf16_t*)take(T * 384 * 2);
  p.CKVb = (bf16_t*)take(T * 256 * 2);
  p.KRb = (bf16_t*)take(T * 32 * 2);
  p.MGb = (bf16_t*)take(T * 512 * 2);
  p.MQb = (bf16_t*)take(T * 512 * 2);
  p.MKb = (bf16_t*)take(T * 512 * 2);
  p.MVt = (bf16_t*)take(T * 512 * 2);
  p.MOb = (bf16_t*)take(T * 512 * 2);
  p.MLGb = (bf16_t*)take(T * 512 * 2);
  p.Qa = (bf16_t*)take(T * 768 * 2);
  p.KNb = (bf16_t*)take(T * 512 * 2);
  p.VtA = (bf16_t*)take(T * 512 * 2);
  p.MIF = (float*)take(T * 16 * 4);
  const size_t odd_end = off;
  const size_t need = even_end > odd_end ? even_end : odd_end;
  if (need > ws_size) {
    fprintf(stderr, "kernel_launch: workspace too small: need %zu have %zu\n", need, ws_size);
    return;
  }
#if SINGLE_LAUNCH
  p.ph_lo = 0;
  p.ph_hi = NPHASE;
  void* args[] = {&p};
  hipError_t e = hipLaunchCooperativeKernel((const void*)mega_kernel, dim3(grid_blocks), dim3(256), args, LDS_BYTES, stream);
  if (e != hipSuccess) fprintf(stderr, "cooperative launch failed: %s (grid %d)\n", hipGetErrorString(e), grid_blocks);
#else
  for (int ph = 0; ph < NPHASE; ++ph) {
    p.ph_lo = ph;
    p.ph_hi = ph + 1;
    hipLaunchKernelGGL(mega_kernel, dim3(grid_blocks), dim3(256), LDS_BYTES, stream, p);
  }
#endif
}
```

```cpp
#include <hip/hip_runtime.h>
#include <hip/hip_cooperative_groups.h>
#include <cstdio>
namespace cg = cooperative_groups;

#ifndef SINGLE_LAUNCH
#define SINGLE_LAUNCH 1
#endif
#ifndef PHMASK
#define PHMASK 0xFFFF
#endif
#define PH_ON(b) ((PHMASK >> (b)) & 1)
#ifndef PROBE_GEMM
#define PROBE_GEMM 0
#endif
#ifndef PROBE_ATTN
#define PROBE_ATTN 0
#endif
#ifndef PROBE_CHAIN
#define PROBE_CHAIN 0
#endif
#ifndef PROBE_MLCHAIN
#define PROBE_MLCHAIN 0
#endif

typedef unsigned short bf16_t;
typedef __attribute__((ext_vector_type(8))) short bf16x8;
typedef __attribute__((ext_vector_type(4))) float f32x4;
typedef __attribute__((ext_vector_type(4))) unsigned short us4;

constexpr int T_TOK = 81920;
constexpr int T_P = 16384;
constexpr int DM = 1024;
constexpr int NE = 4128, NE_PAD = 4352;
constexpr int NO = 4272, NO_PAD = 4352;
constexpr float EPS = 1e-6f;
constexpr int NPHASE = 26;
constexpr int LDS_BYTES = 72 * 1024;

struct Params {
  const float *x_prompt, *x_sample, *norm_g, *final_norm_g, *e_w_in, *e_a_up, *e_a_bias, *e_gla_norm_g,
      *e_pool_w, *e_pool_scale, *e_w_out, *o_w_in, *o_q_norm_g, *o_q_up, *o_kv_norm_g, *o_kv_up, *o_if_bias,
      *o_ml_norm_g, *o_w_out;
  float* out;
  bf16_t *WinE, *WinO, *WoutE, *WoutO, *QupT, *KVupT, *PoolWT, *AupT;
  int* counters;
  unsigned* bar;
  bf16_t *Qb, *Kt, *VtE, *Gb, *LRb, *PUb, *PGb, *TMP, *QEb, *KdTb;
  float* EB;
  bf16_t *CQb, *CKVb, *KRb, *MGb, *MQb, *MKb, *MKt, *MVt, *MOb, *MLGb, *NUMIf, *NUMIb, *Qa, *KNb, *VtA;
  float *MIF, *EBI, *WKg, *DENI, *DEC;
  int ph_lo, ph_hi;
};

typedef __bf16 hbf2 __attribute__((ext_vector_type(2)));
typedef float hf2 __attribute__((ext_vector_type(2)));
__device__ __forceinline__ bf16_t f2bf(float f) {
  __bf16 b = (__bf16)f;
  return __builtin_bit_cast(bf16_t, b);
}
__device__ __forceinline__ unsigned pk2bf(float a, float b) {
  hf2 v = {a, b};
  hbf2 r = __builtin_convertvector(v, hbf2);
  return __builtin_bit_cast(unsigned, r);
}
__device__ __forceinline__ float bf2f(bf16_t b) { return __uint_as_float(((unsigned)b) << 16); }
__device__ __forceinline__ f32x4 mfma16(bf16x8 a, bf16x8 b, f32x4 c) {
  return __builtin_amdgcn_mfma_f32_16x16x32_bf16(a, b, c, 0, 0, 0);
}
__device__ __forceinline__ float logsigmoidf_(float x) { return fminf(x, 0.f) - log1pf(__expf(-fabsf(x))); }
__device__ __forceinline__ float siluf_(float x) { return x / (1.f + __expf(-x)); }
__device__ __forceinline__ float sigmoidf_(float x) { return 1.f / (1.f + __expf(-x)); }
__device__ __forceinline__ int otid() { int t = threadIdx.x; asm volatile("" : "+v"(t)); return t; }
__device__ __forceinline__ bf16x8 zero8() { bf16x8 z = {0, 0, 0, 0, 0, 0, 0, 0}; return z; }
__device__ __forceinline__ f32x4 zero4() { f32x4 z = {0.f, 0.f, 0.f, 0.f}; return z; }

__device__ __forceinline__ int seq_pos(int tok) { return tok < T_P ? (tok & 4095) : ((tok - T_P) & 8191); }
__device__ __forceinline__ const float* xrow(const float* xa, const float* xb, int tok) {
  return tok < T_P ? xa + (long)tok * DM : xb + (long)(tok - T_P) * DM;
}


#define XB_TMO      128
#define XB_XCNT(j)  (256  + 64 * (j))
#define XB_XSUB(j)  (1280 + 64 * (j))
#define XB_XGEN(j)  (2304 + 64 * (j))
#define XB_TOP      3328
#define XB_TOPGEN   3392
#define XCD_BAR_WORDS 3456
#define XB_SPIN_CAP (1u << 22)
#define LAS __attribute__((address_space(3)))
__device__ __forceinline__ unsigned xb_ld(unsigned* p) { return __hip_atomic_load(p, __ATOMIC_RELAXED, __HIP_MEMORY_SCOPE_AGENT); }
__device__ __forceinline__ unsigned xb_add(unsigned* p, unsigned v) { return __hip_atomic_fetch_add(p, v, __ATOMIC_RELAXED, __HIP_MEMORY_SCOPE_AGENT); }
__device__ __forceinline__ unsigned xb_xcc_id() { return (unsigned)__builtin_amdgcn_s_getreg((3 << 11) | 20) & 0xFu; }
#define XB_SPIN(cond, bar) do { unsigned _sp = 0; while (cond) { __builtin_amdgcn_s_sleep(1); \
    if ((++_sp & 255u) == 0u) { if (xb_ld(&(bar)[XB_TMO])) break; if (_sp > XB_SPIN_CAP) { atomicAdd(&(bar)[XB_TMO], 1u); break; } } } } while (0)
struct XcdBarrier { unsigned* bar; unsigned x; volatile LAS unsigned* st; };
__device__ __forceinline__ XcdBarrier xcd_barrier_post(unsigned* bar, volatile LAS unsigned* st) {
  XcdBarrier b; b.bar = bar; b.x = xb_xcc_id(); b.st = st;
  if (threadIdx.x == 0) (void)xb_add(&bar[XB_XCNT(b.x)], 1u);
  return b;
}
__device__ __forceinline__ void xcd_barrier_complete(unsigned* bar, unsigned x, unsigned& nloc, unsigned& nx) {
  const unsigned G = gridDim.x * gridDim.y * gridDim.z;
  unsigned sum, cnt, mine, sp = 0u;
  for (;;) {
    sum = 0u; cnt = 0u; mine = 0u;
#pragma unroll
    for (unsigned j = 0; j < 16; ++j) { const unsigned cc = xb_ld(&bar[XB_XCNT(j)]); sum += cc; cnt += (cc > 0u) ? 1u : 0u; mine = (j == x) ? cc : mine; }
    if (sum == G) break;
    __builtin_amdgcn_s_sleep(1);
    if ((++sp & 255u) == 0u) { if (xb_ld(&bar[XB_TMO])) break; if (sp > XB_SPIN_CAP) { atomicAdd(&bar[XB_TMO], 1u); break; } }
  }
  nloc = mine > 0u ? mine : 1u; nx = cnt > 0u ? cnt : 1u;
}
__device__ __forceinline__ void xcd_barrier(const XcdBarrier& b) {
  asm volatile("s_waitcnt vmcnt(0)" ::: "memory");
  __syncthreads();
  if (threadIdx.x == 0) {
    unsigned* bar = b.bar;
    __builtin_amdgcn_s_waitcnt(0);
    unsigned nloc = b.st[0], nx = b.st[1];
    if (nloc == 0u) { xcd_barrier_complete(bar, b.x, nloc, nx); b.st[0] = nloc; b.st[1] = nx; }
    const unsigned old = xb_add(&bar[XB_XSUB(b.x)], 1u);
    const unsigned gen = old / nloc;
    if (old + 1u == (gen + 1u) * nloc) {
      __builtin_amdgcn_fence(__ATOMIC_RELEASE, "agent");
      asm volatile("s_waitcnt vmcnt(0)" ::: "memory");
      const unsigned og = xb_add(&bar[XB_TOP], 1u);
      const unsigned tg = og / nx;
      if (og + 1u == (tg + 1u) * nx) xb_add(&bar[XB_TOPGEN], 1u);
      else XB_SPIN(xb_ld(&bar[XB_TOPGEN]) == tg, bar);
      __builtin_amdgcn_fence(__ATOMIC_ACQUIRE, "agent");
      xb_add(&bar[XB_XGEN(b.x)], 1u);
      asm volatile("s_waitcnt vmcnt(0)" ::: "memory");
    } else {
      XB_SPIN(xb_ld(&bar[XB_XGEN(b.x)]) == gen, bar);
      __builtin_amdgcn_fence(__ATOMIC_ACQUIRE, "agent");
      asm volatile("s_waitcnt vmcnt(0)" ::: "memory");
    }
  }
  __syncthreads();
}

__device__ __forceinline__ int colmap(int mode, int n) {
  if (mode == 1) {
    if (n < 512) return 2208 + n;
    if (n < 1024) return 1696 + (n - 512);
    if (n < 1408) return n - 1024;
    if (n < 1664) return 384 + (n - 1408);
    if (n < 2176) return 672 + (n - 1664);
    if (n < 2688) return 1184 + (n - 2176);
    if (n < 3200) return 1696 + (n - 2688);
    if (n < 3712) return 2720 + (n - 3200);
    if (n < 4224) return 3248 + (n - 3712);
    if (n < 4256) return 640 + (n - 4224);
    return 3232 + (n - 4256);
  }
  if (mode == 2) {
    if (n < 512) return (n >> 6) * 96 + (n & 63);
    const int r = n - 512;
    return (r >> 5) * 96 + 64 + (r & 31);
  }
  if (mode == 3) {
    if (n < 512) return (n >> 6) * 128 + (n & 63);
    const int r = n - 512;
    return (r >> 6) * 128 + 64 + (r & 63);
  }
  return n;
}

__device__ void prep_weight(const float* __restrict__ W, int K, int N, int Npad, const float* __restrict__ gsc,
                            bf16_t* __restrict__ out, long gtid, long gsize, int mode = 0, int Nsrc_ = 0) {
  const int Nsrc = Nsrc_ ? Nsrc_ : N;
  long total = (long)Npad * K;
  for (long idx = gtid; idx < total; idx += gsize) {
    int k = (int)(idx / Npad);
    int n = (int)(idx % Npad);
    float v = 0.f;
    if (n < N) {
      v = W[(long)k * Nsrc + colmap(mode, n)];
      if (gsc) v *= gsc[k];
    }
    out[(long)n * K + k] = f2bf(v);
  }
}

__device__ void phase_prep(const Params& p) {
  long gtid = (long)blockIdx.x * 256 + otid();
  long gsize = (long)gridDim.x * 256;
  for (int l = 0; l < 2; ++l) {
    prep_weight(p.e_w_in + (long)l * DM * NE, DM, NE, NE_PAD, p.norm_g + (2 * l) * DM, p.WinE + (long)l * NE_PAD * DM, gtid, gsize);
    prep_weight(p.o_w_in + (long)l * DM * 3760, DM, NO, NO_PAD, p.norm_g + (2 * l + 1) * DM, p.WinO + (long)l * NO_PAD * DM, gtid, gsize, 1, 3760);
    prep_weight(p.e_w_out + (long)l * 1536 * DM, 1536, DM, DM, nullptr, p.WoutE + (long)l * DM * 1536, gtid, gsize);
    prep_weight(p.o_w_out + (long)l * 1024 * DM, 1024, DM, DM, nullptr, p.WoutO + (long)l * DM * 1024, gtid, gsize);
    prep_weight(p.o_q_up + (long)l * 384 * 768, 384, 768, 768, p.o_q_norm_g + l * 384, p.QupT + (long)l * 768 * 384, gtid, gsize, 2);
    prep_weight(p.o_kv_up + (long)l * 256 * 1024, 256, 1024, 1024, p.o_kv_norm_g + l * 256, p.KVupT + (long)l * 1024 * 256, gtid, gsize, 3);
    for (int gi = 0; gi < 4; ++gi)
      prep_weight(p.e_pool_w + (long)(l * 4 + gi) * 128 * 128, 128, 128, 128, nullptr, p.PoolWT + (long)(l * 4 + gi) * 128 * 128, gtid, gsize);
    for (long idx = gtid; idx < 2 * 512 * 32; idx += gsize) {
      int r = (int)(idx & 31);
      int d = (int)((idx >> 5) & 511);
      int dir = (int)(idx >> 14);
      float v = (r < 16) ? p.e_a_up[((long)(l * 2 + dir) * 16 + r) * 512 + d] : 0.f;
      p.AupT[((long)(l * 2 + dir) * 512 + d) * 32 + r] = f2bf(v);
    }
  }
  if (gtid < 16) p.counters[gtid] = 0;
}

constexpr int G_LD = 40;
constexpr int G_BUF = (128 + 256) * G_LD;

template <int AMODE, int NI, class Epi>
__device__ void gemm_phase(int Mtiles, int Ntiles, int K, const bf16_t* __restrict__ Bt, const float* xa, const float* xb,
                           const bf16_t* A1, int ld1, int K1, const bf16_t* A2, int ld2, const Epi& epi, char* smem) {
  bf16_t* sbase = (bf16_t*)smem;
  float* sR = (float*)(smem + 70144);
  const int tid = otid(), lane = tid & 63, w = tid >> 6, c = lane & 15, g = lane >> 4;
  const int wm = w >> 1, wn = w & 1;
  const int nk = K / 32;
  const int ntiles = Mtiles * Ntiles;
  for (int tile = blockIdx.x; tile < ntiles; tile += gridDim.x) {
    const int mt = tile / Ntiles, nt = tile % Ntiles;
    constexpr int BN = 32 * NI;
    const int m0 = mt * 128, n0 = nt * BN;
    f32x4 acc[4][NI];
#pragma unroll
    for (int i = 0; i < 4; ++i)
#pragma unroll
      for (int j = 0; j < NI; ++j) acc[i][j] = zero4();
    float ss[4] = {0.f, 0.f, 0.f, 0.f};
    f32x4 raf[4];
    bf16x8 rab[2];
    bf16x8 rb[NI / 2];
    const float* abase_f = (m0 < T_P) ? xa + (size_t)m0 * DM : xb + (size_t)(m0 - T_P) * DM;
    const unsigned aoff_f = (unsigned)(tid >> 3) * DM + 4 * (tid & 7);
    const unsigned boff = (unsigned)(tid >> 2) * K + 8 * (tid & 3);
    const bf16_t* bbase = Bt + (size_t)n0 * K;
#define GEMM_GLOAD(KT)                                                                              \
  {                                                                                                 \
    const int k0_ = (KT) * 32;                                                                      \
    if constexpr (AMODE == 0) {                                                                     \
      _Pragma("unroll") for (int i = 0; i < 4; ++i)                                                 \
        raf[i] = *(const f32x4*)(abase_f + k0_ + aoff_f + (unsigned)(32 * i) * DM);                 \
    } else {                                                                                        \
      const bf16_t* base_;                                                                          \
      int ld_;                                                                                      \
      if (k0_ < K1) { base_ = A1 + (size_t)m0 * ld1 + k0_; ld_ = ld1; }                             \
      else { base_ = A2 + (size_t)m0 * ld2 + (k0_ - K1); ld_ = ld2; }                               \
      _Pragma("unroll") for (int i = 0; i < 2; ++i)                                                 \
        rab[i] = *(const bf16x8*)(base_ + (unsigned)((tid >> 2) + 64 * i) * ld_ + 8 * (tid & 3));   \
    }                                                                                               \
    _Pragma("unroll") for (int i = 0; i < NI / 2; ++i)                                              \
      rb[i] = *(const bf16x8*)(bbase + k0_ + boff + (unsigned)(64 * i) * K);                        \
  }
#define GEMM_LSTORE(BUF)                                                                            \
  {                                                                                                 \
    bf16_t* sA_ = sbase + (BUF) * G_BUF;                                                            \
    bf16_t* sB_ = sA_ + 128 * G_LD;                                                                 \
    if constexpr (AMODE == 0) {                                                                     \
      _Pragma("unroll") for (int i = 0; i < 4; ++i) {                                               \
        f32x4 v = raf[i];                                                                           \
        ss[i] += v[0] * v[0] + v[1] * v[1] + v[2] * v[2] + v[3] * v[3];                             \
        uint2 o;                                                                                    \
        o.x = pk2bf(v[0], v[1]);                                                                    \
        o.y = pk2bf(v[2], v[3]);                                                                    \
        *(uint2*)(sA_ + ((tid >> 3) + 32 * i) * G_LD + 4 * (tid & 7)) = o;                          \
      }                                                                                             \
    } else {                                                                                        \
      _Pragma("unroll") for (int i = 0; i < 2; ++i) {                                               \
        bf16x8 v = rab[i];                                                                          \
        if constexpr (AMODE == 2) {                                                                 \
          _Pragma("unroll") for (int e = 0; e < 8; ++e) {                                           \
            float f = bf2f((bf16_t)v[e]);                                                           \
            ss[i] += f * f;                                                                         \
          }                                                                                         \
        }                                                                                           \
        *(bf16x8*)(sA_ + ((tid >> 2) + 64 * i) * G_LD + 8 * (tid & 3)) = v;                         \
      }                                                                                             \
    }                                                                                               \
    _Pragma("unroll") for (int i = 0; i < NI / 2; ++i)                                              \
      *(bf16x8*)(sB_ + ((tid >> 2) + 64 * i) * G_LD + 8 * (tid & 3)) = rb[i];                       \
  }
    __syncthreads();
    GEMM_GLOAD(0)
    GEMM_LSTORE(0)
    __syncthreads();
    for (int kt = 0; kt < nk; ++kt) {
      if (kt + 1 < nk) GEMM_GLOAD(kt + 1)
      {
        const bf16_t* sA_ = sbase + (kt & 1) * G_BUF;
        const bf16_t* sB_ = sA_ + 128 * G_LD;
        bf16x8 af[4];
#pragma unroll
        for (int mi = 0; mi < 4; ++mi) af[mi] = *(const bf16x8*)(sA_ + (wm * 64 + mi * 16 + c) * G_LD + g * 8);
#pragma unroll
        for (int ni = 0; ni < NI; ++ni) {
          bf16x8 bfr = *(const bf16x8*)(sB_ + (wn * (16 * NI) + ni * 16 + c) * G_LD + g * 8);
#pragma unroll
          for (int mi = 0; mi < 4; ++mi) acc[mi][ni] = mfma16(af[mi], bfr, acc[mi][ni]);
        }
      }
      if (kt + 1 < nk) GEMM_LSTORE((kt + 1) & 1)
      __syncthreads();
    }
    if constexpr (AMODE == 0) {
#pragma unroll
      for (int i = 0; i < 4; ++i) {
        float sv = ss[i];
        sv += __shfl_xor(sv, 1); sv += __shfl_xor(sv, 2); sv += __shfl_xor(sv, 4);
        if ((tid & 7) == 0) sR[(tid >> 3) + 32 * i] = rsqrtf(sv / (float)K + EPS);
      }
      __syncthreads();
    } else if constexpr (AMODE == 2) {
#pragma unroll
      for (int i = 0; i < 2; ++i) {
        float sv = ss[i];
        sv += __shfl_xor(sv, 1); sv += __shfl_xor(sv, 2);
        if ((tid & 3) == 0) sR[(tid >> 2) + 64 * i] = rsqrtf(sv / (float)K + EPS);
      }
      __syncthreads();
    }
    if constexpr (Epi::staged) {
      bf16_t* sT = sbase;
      const float esc = epi.scale();
      const bool tr = epi.transposed(n0);
      if (tr) {
#pragma unroll
        for (int mi = 0; mi < 4; ++mi) {
          const int row = wm * 64 + mi * 16 + 4 * g;
          const float r0 = sR[row] * esc, r1 = sR[row + 1] * esc, r2 = sR[row + 2] * esc, r3 = sR[row + 3] * esc;
#pragma unroll
          for (int ni = 0; ni < NI; ++ni) {
            uint2 o;
            o.x = pk2bf(acc[mi][ni][0] * r0, acc[mi][ni][1] * r1);
            o.y = pk2bf(acc[mi][ni][2] * r2, acc[mi][ni][3] * r3);
            *(uint2*)(sT + (wn * (16 * NI) + ni * 16 + c) * 136 + row) = o;
          }
        }
      } else {
#pragma unroll
        for (int mi = 0; mi < 4; ++mi) {
          const int row = wm * 64 + mi * 16 + 4 * g;
          const float r0 = sR[row] * esc, r1 = sR[row + 1] * esc, r2 = sR[row + 2] * esc, r3 = sR[row + 3] * esc;
#pragma unroll
          for (int ni = 0; ni < NI; ++ni) {
            bf16_t* d = sT + row * (BN + 8) + wn * (16 * NI) + ni * 16 + c;
            d[0] = f2bf(acc[mi][ni][0] * r0);
            d[BN + 8] = f2bf(acc[mi][ni][1] * r1);
            d[2 * (BN + 8)] = f2bf(acc[mi][ni][2] * r2);
            d[3 * (BN + 8)] = f2bf(acc[mi][ni][3] * r3);
          }
        }
      }
      epi.template direct<NI>(m0, n0, wm, wn, g, c, acc, sR);
      __syncthreads();
      if (tr) {
#pragma unroll 4
        for (int i = 0; i < 2 * NI; ++i) {
          const int id = tid + 256 * i;
          const int col = id >> 4, rc = id & 15;
          bf16x8 v = *(const bf16x8*)(sT + col * 136 + 8 * rc);
          epi.store_t(m0 + 8 * rc, n0 + col, v);
        }
      } else {
#pragma unroll 4
        for (int i = 0; i < 2 * NI; ++i) {
          const int id = tid + 256 * i;
          const int row = id / (4 * NI), cc = id % (4 * NI);
          const bf16_t* sp = sT + row * (BN + 8) + 8 * cc;
          bf16x8 v = *(const bf16x8*)sp;
          epi.store_n(m0 + row, n0 + 8 * cc, v, sp);
        }
      }
    } else {
      epi(m0, n0, wm, wn, g, c, acc, sR);
    }
  }
#undef GEMM_GLOAD
#undef GEMM_LSTORE
}

__device__ __forceinline__ void rope_cs(int pos, int i, float& co, float& si) {
  float inv = exp2f(-(float)i * (13.287712379549449f / 16.f));
  float ang = (float)pos * inv;
  float n = rintf(ang * 0.15915494309189535f);
  float r = fmaf(-n, 6.28125f, ang);
  r = fmaf(-n, 0.0019353071795864769f, r);
  float rf = r * 0.15915494309189535f;
  si = __builtin_amdgcn_sinf(rf);
  co = __builtin_amdgcn_cosf(rf);
}

__device__ __forceinline__ void rope_chunk(int pos, int i0, bf16x8 x1, bf16x8 x2, bf16x8& o1, bf16x8& o2) {
#pragma unroll
  for (int e = 0; e < 8; ++e) {
    float co, si;
    rope_cs(pos, i0 + e, co, si);
    float a = bf2f((bf16_t)x1[e]), b = bf2f((bf16_t)x2[e]);
    o1[e] = (short)f2bf(a * co - b * si);
    o2[e] = (short)f2bf(b * co + a * si);
  }
}

struct EpiEvenIn {
  static constexpr bool staged = true;
  bf16_t *Qb, *Kt, *VtE, *Gb, *LRb, *PUb, *PGb;
  __device__ float scale() const { return 1.f; }
  __device__ bool transposed(int n0) const { return n0 >= 512 && n0 < 2048; }
  template <int NI> __device__ void direct(int m0, int n0, int wm, int wn, int g, int c, f32x4 (&acc)[4][NI], const float* sR) const {}
  __device__ void store_t(int tok8, int col, bf16x8 v) const {
    if (col < 1024) *(bf16x8*)(Kt + (size_t)(col - 512) * T_TOK + tok8) = v;
    else *(bf16x8*)(VtE + (size_t)(col - 1024) * T_TOK + tok8) = v;
  }
  __device__ void store_n(int tok, int col, bf16x8 v, const bf16_t* sp) const {
    bf16_t* d;
    if (col < 512) d = Qb + (size_t)tok * 512 + col;
    else if (col < 3072) d = Gb + (size_t)tok * 1024 + (col - 2048);
    else if (col < 3104) d = LRb + (size_t)tok * 32 + (col - 3072);
    else if (col < 3616) d = PUb + (size_t)tok * 512 + (col - 3104);
    else if (col < 4128) d = PGb + (size_t)tok * 512 + (col - 3616);
    else return;
    *(bf16x8*)d = v;
  }
};

struct EpiOddIn {
  static constexpr bool staged = true;
  bf16_t *CQb, *CKVb, *KRb, *MGb, *MQb, *MKb, *MKt, *MVt, *MOb, *MLGb;
  float* MIF;
  __device__ float scale() const { return 1.f; }
  __device__ bool transposed(int n0) const { return n0 < 1024; }
  template <int NI> __device__ void direct(int m0, int n0, int wm, int wn, int g, int c, f32x4 (&acc)[4][NI], const float* sR) const {
    if (n0 == 4096 && wn == 1) {
#pragma unroll
      for (int mi = 0; mi < 4; ++mi)
#pragma unroll
        for (int j = 0; j < 4; ++j) {
          const int row = wm * 64 + mi * 16 + 4 * g + j;
          MIF[(size_t)(m0 + row) * 16 + c] = acc[mi][2][j] * sR[row];
        }
    }
  }
  __device__ void store_t(int tok8, int col, bf16x8 v) const {
    if (col < 512) *(bf16x8*)(MVt + (size_t)col * T_TOK + tok8) = v;
    else *(bf16x8*)(MKt + (size_t)(col - 512) * T_TOK + tok8) = v;
  }
  __device__ void store_n(int tok, int col, bf16x8 v, const bf16_t* sp) const {
    bf16_t* d;
    if (col < 1408) d = CQb + (size_t)tok * 384 + (col - 1024);
    else if (col < 1664) d = CKVb + (size_t)tok * 256 + (col - 1408);
    else if (col < 2176) d = MGb + (size_t)tok * 512 + (col - 1664);
    else if (col < 2688) d = MQb + (size_t)tok * 512 + (col - 2176);
    else if (col < 3200) d = MKb + (size_t)tok * 512 + (col - 2688);
    else if (col < 3712) d = MOb + (size_t)tok * 512 + (col - 3200);
    else if (col < 4224) d = MLGb + (size_t)tok * 512 + (col - 3712);
    else if (col < 4240) {
      bf16x8 x2 = *(const bf16x8*)(sp + 16);
      bf16x8 o1, o2;
      rope_chunk(seq_pos(tok), col - 4224, v, x2, o1, o2);
      *(bf16x8*)(KRb + (size_t)tok * 32 + (col - 4224)) = o1;
      *(bf16x8*)(KRb + (size_t)tok * 32 + 16 + (col - 4224)) = o2;
      return;
    } else return;
    *(bf16x8*)d = v;
  }
};

struct EpiQUp {
  static constexpr bool staged = true;
  bf16_t* Qa;
  __device__ float scale() const { return 0.10206207261596575f * 1.4426950408889634f; }
  __device__ bool transposed(int n0) const { return false; }
  template <int NI> __device__ void direct(int m0, int n0, int wm, int wn, int g, int c, f32x4 (&acc)[4][NI], const float* sR) const {}
  __device__ void store_t(int tok8, int col, bf16x8 v) const {}
  __device__ void store_n(int tok, int col, bf16x8 v, const bf16_t* sp) const {
    if (col < 512) {
      *(bf16x8*)(Qa + (size_t)tok * 768 + (col >> 6) * 96 + (col & 63)) = v;
    } else {
      const int r = col - 512, head = r >> 5, rr = r & 31;
      if (rr < 16) {
        bf16x8 x2 = *(const bf16x8*)(sp + 16);
        bf16x8 o1, o2;
        rope_chunk(seq_pos(tok), rr, v, x2, o1, o2);
        *(bf16x8*)(Qa + (size_t)tok * 768 + head * 96 + 64 + rr) = o1;
        *(bf16x8*)(Qa + (size_t)tok * 768 + head * 96 + 80 + rr) = o2;
      }
    }
  }
};

struct EpiKVUp {
  static constexpr bool staged = true;
  bf16_t *KNb, *VtA;
  __device__ float scale() const { return 1.f; }
  __device__ bool transposed(int n0) const { return n0 >= 512; }
  template <int NI> __device__ void direct(int m0, int n0, int wm, int wn, int g, int c, f32x4 (&acc)[4][NI], const float* sR) const {}
  __device__ void store_t(int tok8, int col, bf16x8 v) const { *(bf16x8*)(VtA + (size_t)(col - 512) * T_TOK + tok8) = v; }
  __device__ void store_n(int tok, int col, bf16x8 v, const bf16_t* sp) const { *(bf16x8*)(KNb + (size_t)tok * 512 + col) = v; }
};

struct EpiOut {
  static constexpr bool staged = false;
  const float *xa, *xb;
  float* out;
  bool dry;
  __device__ void operator()(int m0, int n0, int wm, int wn, int g, int c, f32x4 (&acc)[4][8], const float* sR) const {
#pragma unroll
    for (int ni = 0; ni < 8; ++ni) {
      __builtin_amdgcn_sched_barrier(0);
      const int col = n0 + wn * 128 + ni * 16 + c;
#pragma unroll
      for (int mi = 0; mi < 4; ++mi) {
        const int tok = m0 + wm * 64 + mi * 16 + 4 * g;
#pragma unroll
        for (int j = 0; j < 4; ++j) {
          float xo = xrow(xa, xb, tok + j)[col];
          if (!dry) out[(long)(tok + j) * DM + col] = xo + acc[mi][ni][j];
        }
      }
    }
  }
};

__device__ __forceinline__ float scan16(float v, int c) {
  float t;
  t = __shfl_up(v, 1, 16); if (c >= 1) v += t;
  t = __shfl_up(v, 2, 16); if (c >= 2) v += t;
  t = __shfl_up(v, 4, 16); if (c >= 4) v += t;
  t = __shfl_up(v, 8, 16); if (c >= 8) v += t;
  return v;
}

__device__ __forceinline__ float logsig_fast(float x) { return fminf(x, 0.f) - __logf(1.f + __expf(-fabsf(x))); }

__device__ void gla_intra_item(const Params& p, int li, int item, char* smem) {
  const int tid = otid(), lane = tid & 63, w = tid >> 6, c = lane & 15, g = lane >> 4;
  const int ci = item >> 2, h = item & 3;
  const int tokc = ci * 64;
  const float qscale = 0.08838834764831845f;
  bf16_t* sQe = (bf16_t*)smem;
  bf16_t* sKd = sQe + 64 * 136;
  bf16_t* sA = sKd + 64 * 136;
  us4 q4[2][4];
  bf16_t kk[2][4][4];
#pragma unroll
  for (int dt = 0; dt < 2; ++dt)
#pragma unroll
    for (int tt = 0; tt < 4; ++tt) {
      q4[dt][tt] = *(const us4*)(p.Qb + (size_t)(tokc + 16 * tt + c) * 512 + h * 128 + 32 * w + 16 * dt + 4 * g);
#pragma unroll
      for (int j = 0; j < 4; ++j)
        kk[dt][tt][j] = p.Kt[(size_t)(h * 128 + 32 * w + 16 * dt + 4 * g + j) * T_TOK + tokc + 16 * tt + c];
    }
  __syncthreads();
#pragma unroll
  for (int dir = 0; dir < 2; ++dir) {
    bf16_t* QEd = dir ? p.QEb : p.Qb;
    bf16_t* KdTd = dir ? p.KdTb : p.Kt;
    bf16x8 aup[2];
    float bias[2][4];
#pragma unroll
    for (int dt = 0; dt < 2; ++dt) {
      aup[dt] = zero8();
      if (g < 2) aup[dt] = *(const bf16x8*)(p.AupT + ((size_t)(li * 2 + dir) * 512 + h * 128 + 32 * w + 16 * dt + c) * 32 + 8 * g);
#pragma unroll
      for (int j = 0; j < 4; ++j) bias[dt][j] = p.e_a_bias[(li * 2 + dir) * 512 + h * 128 + 32 * w + 16 * dt + 4 * g + j];
    }
    f32x4 la[2][4];
#pragma unroll
    for (int tt = 0; tt < 4; ++tt) {
      bf16x8 lrf = zero8();
      if (g < 2) lrf = *(const bf16x8*)(p.LRb + (size_t)(tokc + 16 * tt + c) * 32 + dir * 16 + 8 * g);
#pragma unroll
      for (int dt = 0; dt < 2; ++dt) la[dt][tt] = mfma16(aup[dt], lrf, zero4());
    }
#pragma unroll
    for (int dt = 0; dt < 2; ++dt)
#pragma unroll
      for (int tt = 0; tt < 4; ++tt)
#pragma unroll
        for (int j = 0; j < 4; ++j) la[dt][tt][j] = logsig_fast(la[dt][tt][j] + bias[dt][j]) * (1.f / 16.f);
    f32x4 P[2][4];
    float tot[2][4];
#pragma unroll
    for (int dt = 0; dt < 2; ++dt)
#pragma unroll
      for (int j = 0; j < 4; ++j) {
        float carry = 0.f;
#pragma unroll
        for (int tt = 0; tt < 4; ++tt) {
          float v = scan16(la[dt][tt][j], c) + carry;
          P[dt][tt][j] = v;
          carry = __shfl(v, 15, 16);
        }
        tot[dt][j] = carry;
      }
#pragma unroll
    for (int dt = 0; dt < 2; ++dt)
#pragma unroll
      for (int tt = 0; tt < 4; ++tt) {
        us4 qo, ko;
#pragma unroll
        for (int j = 0; j < 4; ++j) {
          const float b = (dir == 0) ? P[dt][tt][j] : (tot[dt][j] - P[dt][tt][j] + la[dt][tt][j]);
          qo[j] = f2bf(bf2f(q4[dt][tt][j]) * __expf(b) * qscale);
          ko[j] = f2bf(bf2f(kk[dt][tt][j]) * __expf(-b));
          KdTd[(size_t)(h * 128 + 32 * w + 16 * dt + 4 * g + j) * T_TOK + tokc + 16 * tt + c] = ko[j];
        }
        *(us4*)(QEd + (size_t)(tokc + 16 * tt + c) * 512 + h * 128 + 32 * w + 16 * dt + 4 * g) = qo;
        *(us4*)(sQe + (16 * tt + c) * 136 + 32 * w + 16 * dt + 4 * g) = qo;
        *(us4*)(sKd + (16 * tt + c) * 136 + 32 * w + 16 * dt + 4 * g) = ko;
      }
    if (c == 0) {
#pragma unroll
      for (int dt = 0; dt < 2; ++dt)
#pragma unroll
        for (int j = 0; j < 4; ++j)
          p.EB[(size_t)(dir * 1280 + ci) * 512 + h * 128 + 32 * w + 16 * dt + 4 * g + j] = __expf(tot[dt][j]);
    }
    __syncthreads();
    f32x4 accA[4];
#pragma unroll
    for (int jt = 0; jt < 4; ++jt) accA[jt] = zero4();
#pragma unroll
    for (int ks = 0; ks < 4; ++ks) {
      bf16x8 aq = *(const bf16x8*)(sQe + (16 * w + c) * 136 + 32 * ks + 8 * g);
#pragma unroll
      for (int jt = 0; jt < 4; ++jt) {
        bf16x8 bk = *(const bf16x8*)(sKd + (16 * jt + c) * 136 + 32 * ks + 8 * g);
        accA[jt] = mfma16(aq, bk, accA[jt]);
      }
    }
#pragma unroll
    for (int jt = 0; jt < 4; ++jt)
#pragma unroll
      for (int j = 0; j < 4; ++j) {
        const int i = 16 * w + 4 * g + j, jj = 16 * jt + c;
        const bool keep = (dir == 0) ? (jj <= i) : (jj > i);
        sA[dir * 64 * 72 + i * 72 + jj] = f2bf(keep ? accA[jt][j] : 0.f);
      }
    __syncthreads();
  }
  bf16x8 af[2][2];
#pragma unroll
  for (int dir = 0; dir < 2; ++dir)
#pragma unroll
    for (int k2 = 0; k2 < 2; ++k2) af[dir][k2] = *(const bf16x8*)(sA + dir * 64 * 72 + (16 * w + c) * 72 + 32 * k2 + 8 * g);
#pragma unroll 4
  for (int vt = 0; vt < 16; ++vt) {
    f32x4 a = zero4();
#pragma unroll
    for (int k2 = 0; k2 < 2; ++k2) {
      bf16x8 vfr = *(const bf16x8*)(p.VtE + (size_t)(h * 256 + 16 * vt + c) * T_TOK + tokc + 32 * k2 + 8 * g);
      a = mfma16(af[0][k2], vfr, a);
      a = mfma16(af[1][k2], vfr, a);
    }
#pragma unroll
    for (int j = 0; j < 4; ++j) p.TMP[(size_t)(tokc + 16 * w + 4 * g + j) * 1024 + h * 256 + 16 * vt + c] = f2bf(a[j]);
  }
}

struct GlaRegs {
  bf16x8 aq[4];
  bf16x8 vf[2][2];
  bf16x8 kf[2][2];
  float eb[2];
};

template <int DIR>
__device__ __forceinline__ void gla_chain_load(const Params& p, int h, int sl, int tokc, int w, int c, int g, GlaRegs& r) {
  const bf16_t* QE = DIR ? p.QEb : p.Qb;
  const bf16_t* KdT = DIR ? p.KdTb : p.Kt;
#pragma unroll
  for (int ks = 0; ks < 4; ++ks) r.aq[ks] = *(const bf16x8*)(QE + (size_t)(tokc + 16 * w + c) * 512 + h * 128 + 32 * ks + 8 * g);
#pragma unroll
  for (int vt = 0; vt < 2; ++vt)
#pragma unroll
    for (int k2 = 0; k2 < 2; ++k2)
      r.vf[vt][k2] = *(const bf16x8*)(p.VtE + (size_t)(h * 256 + sl * 32 + 16 * vt + c) * T_TOK + tokc + 32 * k2 + 8 * g);
#pragma unroll
  for (int dt = 0; dt < 2; ++dt) {
#pragma unroll
    for (int k2 = 0; k2 < 2; ++k2)
      r.kf[dt][k2] = *(const bf16x8*)(KdT + (size_t)(h * 128 + 32 * w + 16 * dt + c) * T_TOK + tokc + 32 * k2 + 8 * g);
    r.eb[dt] = p.EB[(size_t)(DIR * 1280 + (tokc >> 6)) * 512 + h * 128 + 32 * w + 16 * dt + c];
  }
}

__device__ __forceinline__ void gla_chain_compute(const Params& p, int h, int sl, int tokc, int w, int c, int g, const GlaRegs& r,
                                                  f32x4 (&S)[2][2], bf16_t* sSt, bool dry) {
  bf16_t told[2][4];
#pragma unroll
  for (int vt = 0; vt < 2; ++vt)
#pragma unroll
    for (int j = 0; j < 4; ++j) told[vt][j] = p.TMP[(size_t)(tokc + 16 * w + 4 * g + j) * 1024 + h * 256 + sl * 32 + 16 * vt + c];
#pragma unroll
  for (int vt = 0; vt < 2; ++vt)
#pragma unroll
    for (int dt = 0; dt < 2; ++dt)
#pragma unroll
      for (int j = 0; j < 4; ++j) sSt[(16 * vt + 4 * g + j) * 136 + 32 * w + 16 * dt + c] = f2bf(S[vt][dt][j]);
  __syncthreads();
  f32x4 o[2];
  o[0] = zero4(); o[1] = zero4();
#pragma unroll
  for (int ks = 0; ks < 4; ++ks)
#pragma unroll
    for (int vt = 0; vt < 2; ++vt) {
      bf16x8 sf = *(const bf16x8*)(sSt + (16 * vt + c) * 136 + 32 * ks + 8 * g);
      o[vt] = mfma16(r.aq[ks], sf, o[vt]);
    }
#pragma unroll
  for (int dt = 0; dt < 2; ++dt)
#pragma unroll
    for (int vt = 0; vt < 2; ++vt) {
      f32x4 a = S[vt][dt];
#pragma unroll
      for (int k2 = 0; k2 < 2; ++k2) a = mfma16(r.vf[vt][k2], r.kf[dt][k2], a);
      S[vt][dt] = a * r.eb[dt];
    }
#pragma unroll
  for (int vt = 0; vt < 2; ++vt)
#pragma unroll
    for (int j = 0; j < 4; ++j)
      if (!dry) p.TMP[(size_t)(tokc + 16 * w + 4 * g + j) * 1024 + h * 256 + sl * 32 + 16 * vt + c] = f2bf(bf2f(told[vt][j]) + o[vt][j]);
}

__device__ void gla_chain_item(const Params& p, int li, int item, char* smem, bool dry = false) {
  const int tid = otid(), lane = tid & 63, w = tid >> 6, c = lane & 15, g = lane >> 4;
  int s, rem;
  if (item < 256) { s = 4 + item / 32; rem = item % 32; } else { s = (item - 256) / 32; rem = (item - 256) % 32; }
  const int h = rem >> 3, sl = rem & 7;
  const int tok0 = s < 4 ? s * 4096 : T_P + (s - 4) * 8192;
  const int len = s < 4 ? 4096 : 8192;
  const int N = len / 64;
  bf16_t* sSt0 = (bf16_t*)smem;
  bf16_t* sSt1 = sSt0 + 32 * 136;
  f32x4 Sf[2][2], Sb[2][2];
#pragma unroll
  for (int a = 0; a < 2; ++a)
#pragma unroll
    for (int b = 0; b < 2; ++b) { Sf[a][b] = zero4(); Sb[a][b] = zero4(); }
  GlaRegs rf, rb;
  __syncthreads();
  gla_chain_load<0>(p, h, sl, tok0, w, c, g, rf);
  for (int step = 0; step < N; ++step) {
    const int tf = tok0 + step * 64, tb = tok0 + (N - 1 - step) * 64;
    gla_chain_load<1>(p, h, sl, tb, w, c, g, rb);
    gla_chain_compute(p, h, sl, tf, w, c, g, rf, Sf, sSt0, dry);
    if (step + 1 < N) gla_chain_load<0>(p, h, sl, tf + 64, w, c, g, rf);
    gla_chain_compute(p, h, sl, tb, w, c, g, rb, Sb, sSt1, dry);
  }
}

__device__ void pool_item(const Params& p, int li, int item, char* smem) {
  const int tid = otid(), lane = tid & 63, w = tid >> 6, c = lane & 15, g = lane >> 4;
  const int gi = item & 3;
  const int tile = item >> 2;
  const int tokc = tile * 64;
  const int pos0 = seq_pos(tokc);
  const int len = tokc < T_P ? 4096 : 8192;
  float* sU = (float*)smem;
  bf16_t* sP = (bf16_t*)(sU + 80 * 128);
  __syncthreads();
  for (int idx = tid; idx < 80 * 128; idx += 256) {
    int r = idx >> 7, ch = idx & 127;
    int pos = pos0 - 8 + r;
    float v = 0.f;
    if (pos >= 0 && pos < len) v = bf2f(p.PUb[(long)(tokc - 8 + r) * 512 + gi * 128 + ch]);
    sU[idx] = v;
  }
  __syncthreads();
  {
    const int ch = tid & 127, th = tid >> 7;
    const int half = 1 << gi;
    for (int t = th * 32; t < th * 32 + 32; ++t) {
      int pos = pos0 + t;
      int lo = max(pos - half, 0), hi = min(pos + half, len);
      float s = 0.f;
      for (int q = lo; q < hi; ++q) s += sU[(q - pos0 + 8) * 128 + ch];
      float pooled = s / (float)(hi - lo) - sU[(t + 8) * 128 + ch];
      sP[t * 136 + ch] = f2bf(pooled);
    }
  }
  __syncthreads();
  f32x4 acc[8];
#pragma unroll
  for (int dt = 0; dt < 8; ++dt) acc[dt] = zero4();
  const bf16_t* PW = p.PoolWT + (long)(li * 4 + gi) * 128 * 128;
#pragma unroll
  for (int ks = 0; ks < 4; ++ks) {
    bf16x8 af = *(const bf16x8*)(sP + (16 * w + c) * 136 + 32 * ks + 8 * g);
#pragma unroll
    for (int dt = 0; dt < 8; ++dt) {
      bf16x8 bw = *(const bf16x8*)(PW + (long)(16 * dt + c) * 128 + 32 * ks + 8 * g);
      acc[dt] = mfma16(af, bw, acc[dt]);
    }
  }
#pragma unroll
  for (int dt = 0; dt < 8; ++dt) {
    const int d = gi * 128 + 16 * dt + c;
    const float sc = p.e_pool_scale[li * 512 + d];
#pragma unroll
    for (int j = 0; j < 4; ++j) {
      const long addr = (long)(tokc + 16 * w + 4 * g + j) * 512 + d;
      float gt = bf2f(p.PGb[addr]);
      p.PGb[addr] = f2bf(acc[dt][j] * sc * siluf_(gt));
    }
  }
}

__device__ void ml_intra_item(const Params& p, int li, int item, char* smem) {
  const int tid = otid(), lane = tid & 63, w = tid >> 6, c = lane & 15, g = lane >> 4;
  const int ci = item >> 2, h = item & 3;
  const int tokc = ci * 64;
  const float kscale = 0.08838834764831845f;
  bf16_t* sA = (bf16_t*)smem;
  float* sBv = (float*)(sA + 2 * 64 * 72);
  float* sCB = sBv + 128;
  __syncthreads();
  if (w < 2) {
    const int dir = w;
    const float bi = p.o_if_bias[li * 16 + dir * 4 + h];
    const float bff = p.o_if_bias[li * 16 + 8 + dir * 4 + h];
    const float* mf = p.MIF + (size_t)(tokc + lane) * 16;
    const float liv = mf[dir * 4 + h] + bi;
    const float lfv = logsig_fast(mf[8 + dir * 4 + h] + bff);
    float ps = lfv;
#pragma unroll
    for (int d = 1; d < 64; d <<= 1) {
      float t = __shfl_up(ps, d);
      if (lane >= d) ps += t;
    }
    const float total = __shfl(ps, 63);
    const float b = (dir == 0) ? ps : (total - ps + lfv);
    const float cB = liv - b;
    sBv[dir * 64 + lane] = b;
    sCB[dir * 64 + lane] = cB;
    const size_t so = (size_t)(dir * 4 + h) * T_TOK + tokc + lane;
    p.EBI[so] = __expf(b);
    p.WKg[so] = __expf(total + cB) * kscale;
    if (lane == 0) p.DEC[(dir * 4 + h) * 1280 + ci] = __expf(total);
  }
  f32x4 accA[4];
#pragma unroll
  for (int jt = 0; jt < 4; ++jt) accA[jt] = zero4();
#pragma unroll
  for (int ks = 0; ks < 4; ++ks) {
    bf16x8 aq = *(const bf16x8*)(p.MQb + (size_t)(tokc + 16 * w + c) * 512 + h * 128 + 32 * ks + 8 * g);
#pragma unroll
    for (int jt = 0; jt < 4; ++jt) {
      bf16x8 bk = *(const bf16x8*)(p.MKb + (size_t)(tokc + 16 * jt + c) * 512 + h * 128 + 32 * ks + 8 * g);
      accA[jt] = mfma16(aq, bk, accA[jt]);
    }
  }
  __syncthreads();
#pragma unroll
  for (int dir = 0; dir < 2; ++dir)
#pragma unroll
    for (int jt = 0; jt < 4; ++jt)
#pragma unroll
      for (int j = 0; j < 4; ++j) {
        const int i = 16 * w + 4 * g + j, jj = 16 * jt + c;
        const bool keep = (dir == 0) ? (jj <= i) : (jj > i);
        const float sv = keep ? accA[jt][j] * kscale * __expf(sBv[dir * 64 + i] + sCB[dir * 64 + jj]) : 0.f;
        sA[dir * 64 * 72 + i * 72 + jj] = f2bf(sv);
      }
  __syncthreads();
  bf16x8 ones = zero8();
  if (c == 0) {
#pragma unroll
    for (int e = 0; e < 8; ++e) ones[e] = (short)0x3F80;
  }
#pragma unroll
  for (int dir = 0; dir < 2; ++dir) {
    bf16_t* NUMI = dir ? p.NUMIb : p.NUMIf;
    bf16x8 af[2];
#pragma unroll
    for (int k2 = 0; k2 < 2; ++k2) af[k2] = *(const bf16x8*)(sA + dir * 64 * 72 + (16 * w + c) * 72 + 32 * k2 + 8 * g);
    f32x4 dn = zero4();
    dn = mfma16(af[0], ones, dn);
    dn = mfma16(af[1], ones, dn);
    if (c == 0) {
#pragma unroll
      for (int j = 0; j < 4; ++j) p.DENI[(size_t)(dir * 4 + h) * T_TOK + tokc + 16 * w + 4 * g + j] = dn[j];
    }
#pragma unroll 4
    for (int vt = 0; vt < 8; ++vt) {
      f32x4 a = zero4();
#pragma unroll
      for (int k2 = 0; k2 < 2; ++k2) {
        bf16x8 vfr = *(const bf16x8*)(p.MVt + (size_t)(h * 128 + 16 * vt + c) * T_TOK + tokc + 32 * k2 + 8 * g);
        a = mfma16(af[k2], vfr, a);
      }
#pragma unroll
      for (int j = 0; j < 4; ++j) NUMI[(size_t)(tokc + 16 * w + 4 * g + j) * 512 + h * 128 + 16 * vt + c] = f2bf(a[j]);
    }
  }
}

struct MlRegs {
  bf16x8 aq[4];
  bf16x8 vf[2];
  bf16x8 kf[2][2];
  f32x4 wk[2][2];
  f32x4 ebi, deni;
  float dec;
};

template <int DIR>
__device__ __forceinline__ void ml_chain_load(const Params& p, int h, int sl, int tokc, int w, int c, int g, MlRegs& r) {
#pragma unroll
  for (int ks = 0; ks < 4; ++ks) r.aq[ks] = *(const bf16x8*)(p.MQb + (size_t)(tokc + 16 * w + c) * 512 + h * 128 + 32 * ks + 8 * g);
#pragma unroll
  for (int k2 = 0; k2 < 2; ++k2)
    r.vf[k2] = *(const bf16x8*)(p.MVt + (size_t)(h * 128 + sl * 16 + c) * T_TOK + tokc + 32 * k2 + 8 * g);
#pragma unroll
  for (int dt = 0; dt < 2; ++dt)
#pragma unroll
    for (int k2 = 0; k2 < 2; ++k2)
      r.kf[dt][k2] = *(const bf16x8*)(p.MKt + (size_t)(h * 128 + 32 * w + 16 * dt + c) * T_TOK + tokc + 32 * k2 + 8 * g);
  const size_t so = (size_t)(DIR * 4 + h) * T_TOK + tokc;
#pragma unroll
  for (int k2 = 0; k2 < 2; ++k2) {
    r.wk[k2][0] = *(const f32x4*)(p.WKg + so + 32 * k2 + 8 * g);
    r.wk[k2][1] = *(const f32x4*)(p.WKg + so + 32 * k2 + 8 * g + 4);
  }
  r.ebi = *(const f32x4*)(p.EBI + so + 16 * w + 4 * g);
  r.deni = *(const f32x4*)(p.DENI + so + 16 * w + 4 * g);
  r.dec = p.DEC[(DIR * 4 + h) * 1280 + (tokc >> 6)];
}

template <int DIR>
__device__ __forceinline__ void ml_chain_compute(const Params& p, int h, int sl, int tokc, int lane, int w, int c, int g, const MlRegs& r,
                                                 f32x4 (&C)[2][2], bf16_t* sCt, bool dry) {
  bf16_t* NUMI = DIR ? p.NUMIb : p.NUMIf;
  bf16_t numi[4];
#pragma unroll
  for (int j = 0; j < 4; ++j) numi[j] = NUMI[(size_t)(tokc + 16 * w + 4 * g + j) * 512 + h * 128 + sl * 16 + c];
#pragma unroll
  for (int vt = 0; vt < 2; ++vt)
#pragma unroll
    for (int dt = 0; dt < 2; ++dt)
#pragma unroll
      for (int j = 0; j < 4; ++j) sCt[(16 * vt + 4 * g + j) * 136 + 32 * w + 16 * dt + c] = f2bf(C[vt][dt][j]);
  bf16x8 vfw[2][2];
#pragma unroll
  for (int k2 = 0; k2 < 2; ++k2) {
    float wv[8];
#pragma unroll
    for (int e = 0; e < 4; ++e) { wv[e] = r.wk[k2][0][e]; wv[4 + e] = r.wk[k2][1][e]; }
#pragma unroll
    for (int e = 0; e < 8; ++e) vfw[0][k2][e] = (short)f2bf(bf2f((bf16_t)r.vf[k2][e]) * wv[e]);
#pragma unroll
    for (int e = 0; e < 8; ++e) vfw[1][k2][e] = (c == 0) ? (short)f2bf(wv[e]) : (short)0;
  }
  __syncthreads();
  f32x4 o2[2];
  o2[0] = zero4(); o2[1] = zero4();
#pragma unroll
  for (int ks = 0; ks < 4; ++ks)
#pragma unroll
    for (int vt = 0; vt < 2; ++vt) {
      bf16x8 cf = *(const bf16x8*)(sCt + (16 * vt + c) * 136 + 32 * ks + 8 * g);
      o2[vt] = mfma16(r.aq[ks], cf, o2[vt]);
    }
#pragma unroll
  for (int dt = 0; dt < 2; ++dt)
#pragma unroll
    for (int vt = 0; vt < 2; ++vt) {
      f32x4 a = C[vt][dt] * r.dec;
#pragma unroll
      for (int k2 = 0; k2 < 2; ++k2) a = mfma16(vfw[vt][k2], r.kf[dt][k2], a);
      C[vt][dt] = a;
    }
#pragma unroll
  for (int j = 0; j < 4; ++j) {
    const float e = r.ebi[j];
    float den = e * o2[1][j];
    den = __shfl(den, lane & 48) + r.deni[j];
    const float inv = 1.f / fmaxf(fabsf(den), 1.f);
    const float hv = (bf2f(numi[j]) + e * o2[0][j]) * inv;
    if (!dry) NUMI[(size_t)(tokc + 16 * w + 4 * g + j) * 512 + h * 128 + sl * 16 + c] = f2bf(hv);
  }
}

__device__ void ml_chain_item(const Params& p, int li, int item, char* smem, bool dry = false) {
  const int tid = otid(), lane = tid & 63, w = tid >> 6, c = lane & 15, g = lane >> 4;
  int s, rem;
  if (item < 256) { s = 4 + item / 32; rem = item % 32; } else { s = (item - 256) / 32; rem = (item - 256) % 32; }
  const int h = rem >> 3, sl = rem & 7;
  const int tok0 = s < 4 ? s * 4096 : T_P + (s - 4) * 8192;
  const int len = s < 4 ? 4096 : 8192;
  const int N = len / 64;
  bf16_t* sCt0 = (bf16_t*)smem;
  bf16_t* sCt1 = sCt0 + 32 * 136;
  f32x4 Cf[2][2], Cb[2][2];
#pragma unroll
  for (int a = 0; a < 2; ++a)
#pragma unroll
    for (int b = 0; b < 2; ++b) { Cf[a][b] = zero4(); Cb[a][b] = zero4(); }
  MlRegs rf, rb;
  __syncthreads();
  ml_chain_load<0>(p, h, sl, tok0, w, c, g, rf);
  for (int step = 0; step < N; ++step) {
    const int tf = tok0 + step * 64, tb = tok0 + (N - 1 - step) * 64;
    ml_chain_load<1>(p, h, sl, tb, w, c, g, rb);
    ml_chain_compute<0>(p, h, sl, tf, lane, w, c, g, rf, Cf, sCt0, dry);
    if (step + 1 < N) ml_chain_load<0>(p, h, sl, tf + 64, w, c, g, rf);
    ml_chain_compute<1>(p, h, sl, tb, lane, w, c, g, rb, Cb, sCt1, dry);
  }
}

#define ATTN_GLOAD(KT)                                                                              \
  {                                                                                                 \
    const long kb = tok0 + (KT) * 64;                                                               \
    rk0 = *(const bf16x8*)(p.KNb + (kb + (tid >> 3)) * 512 + head * 64 + 8 * (tid & 7));            \
    rk1 = *(const bf16x8*)(p.KNb + (kb + 32 + (tid >> 3)) * 512 + head * 64 + 8 * (tid & 7));       \
    rkr = *(const bf16x8*)(p.KRb + (kb + (tid >> 2)) * 32 + 8 * (tid & 3));                          \
    rv0 = *(const bf16x8*)(p.VtA + (long)(head * 64 + (tid >> 3)) * T_TOK + kb + 8 * (tid & 7));     \
    rv1 = *(const bf16x8*)(p.VtA + (long)(head * 64 + 32 + (tid >> 3)) * T_TOK + kb + 8 * (tid & 7)); \
  }
__device__ void attn_item(const Params& p, int item, char* smem, bool dry = false) {
  const int tid = otid(), lane = tid & 63, w = tid >> 6, c = lane & 15, g = lane >> 4;
  int s, head, qb;
  if (item < 4096) { s = 4 + item / 512; int rem = item % 512; head = rem / 64; qb = rem % 64; }
  else { int it = item - 4096; s = it / 256; int rem = it % 256; head = rem / 32; qb = rem % 32; }
  const int tok0 = s < 4 ? s * 4096 : T_P + (s - 4) * 8192;
  const int len = s < 4 ? 4096 : 8192;
  const int nkv = len / 64;
  bf16_t* sK = (bf16_t*)smem;
  bf16_t* sVt = sK + 64 * 104;
  const int qrow0 = tok0 + qb * 128 + 32 * w;
  bf16x8 qf[2][3];
#pragma unroll
  for (int nt = 0; nt < 2; ++nt)
#pragma unroll
    for (int ks = 0; ks < 3; ++ks)
      qf[nt][ks] = *(const bf16x8*)(p.Qa + (long)(qrow0 + 16 * nt + c) * 768 + head * 96 + 32 * ks + 8 * g);
  f32x4 ot[4][2];
#pragma unroll
  for (int vt = 0; vt < 4; ++vt) { ot[vt][0] = zero4(); ot[vt][1] = zero4(); }
  float mrun[2] = {-1e30f, -1e30f}, lrun[2] = {0.f, 0.f};
  bf16x8 rk0, rk1, rkr, rv0, rv1;
  ATTN_GLOAD(0)
  for (int kt = 0; kt < nkv; ++kt) {
    __syncthreads();
    *(bf16x8*)(sK + (tid >> 3) * 104 + 8 * (tid & 7)) = rk0;
    *(bf16x8*)(sK + (32 + (tid >> 3)) * 104 + 8 * (tid & 7)) = rk1;
    *(bf16x8*)(sK + (tid >> 2) * 104 + 64 + 8 * (tid & 3)) = rkr;
    *(bf16x8*)(sVt + (tid >> 3) * 72 + 8 * (tid & 7)) = rv0;
    *(bf16x8*)(sVt + (32 + (tid >> 3)) * 72 + 8 * (tid & 7)) = rv1;
    __syncthreads();
    if (kt + 1 < nkv) ATTN_GLOAD(kt + 1)
    f32x4 st[4][2];
#pragma unroll
    for (int k4 = 0; k4 < 4; ++k4) { st[k4][0] = zero4(); st[k4][1] = zero4(); }
#pragma unroll
    for (int ks = 0; ks < 3; ++ks)
#pragma unroll
      for (int k4 = 0; k4 < 4; ++k4) {
        bf16x8 kf = *(const bf16x8*)(sK + (16 * k4 + c) * 104 + 32 * ks + 8 * g);
        st[k4][0] = mfma16(kf, qf[0][ks], st[k4][0]);
        st[k4][1] = mfma16(kf, qf[1][ks], st[k4][1]);
      }
#pragma unroll
    for (int nt = 0; nt < 2; ++nt) {
      float mx = -1e30f;
#pragma unroll
      for (int k4 = 0; k4 < 4; ++k4)
#pragma unroll
        for (int j = 0; j < 4; ++j) mx = fmaxf(mx, st[k4][nt][j]);
      mx = fmaxf(mx, __shfl_xor(mx, 16));
      mx = fmaxf(mx, __shfl_xor(mx, 32));
      const float mn = fmaxf(mrun[nt], mx);
      const float alpha = __builtin_amdgcn_exp2f(mrun[nt] - mn);
      mrun[nt] = mn;
      float psum = 0.f;
#pragma unroll
      for (int k4 = 0; k4 < 4; ++k4)
#pragma unroll
        for (int j = 0; j < 4; ++j) {
          float pv = __builtin_amdgcn_exp2f(st[k4][nt][j] - mn);
          st[k4][nt][j] = pv;
          psum += pv;
        }
      lrun[nt] = lrun[nt] * alpha + psum;
#pragma unroll
      for (int vt = 0; vt < 4; ++vt) ot[vt][nt] = ot[vt][nt] * alpha;
    }
#pragma unroll
    for (int k2 = 0; k2 < 2; ++k2) {
      bf16x8 pb[2];
#pragma unroll
      for (int nt = 0; nt < 2; ++nt) {
        typedef __attribute__((ext_vector_type(4))) unsigned u32x4;
        u32x4 pk;
        pk[0] = pk2bf(st[2 * k2][nt][0], st[2 * k2][nt][1]);
        pk[1] = pk2bf(st[2 * k2][nt][2], st[2 * k2][nt][3]);
        pk[2] = pk2bf(st[2 * k2 + 1][nt][0], st[2 * k2 + 1][nt][1]);
        pk[3] = pk2bf(st[2 * k2 + 1][nt][2], st[2 * k2 + 1][nt][3]);
        pb[nt] = __builtin_bit_cast(bf16x8, pk);
      }
#pragma unroll
      for (int vt = 0; vt < 4; ++vt) {
        us4 lo = *(const us4*)(sVt + (16 * vt + c) * 72 + 32 * k2 + 4 * g);
        us4 hi = *(const us4*)(sVt + (16 * vt + c) * 72 + 32 * k2 + 16 + 4 * g);
        bf16x8 av;
#pragma unroll
        for (int e = 0; e < 4; ++e) { av[e] = (short)lo[e]; av[4 + e] = (short)hi[e]; }
        ot[vt][0] = mfma16(av, pb[0], ot[vt][0]);
        ot[vt][1] = mfma16(av, pb[1], ot[vt][1]);
      }
    }
  }
#pragma unroll
  for (int nt = 0; nt < 2; ++nt) {
    float lt = lrun[nt];
    lt += __shfl_xor(lt, 16);
    lt += __shfl_xor(lt, 32);
    const float inv = 1.f / lt;
    const long tok = qrow0 + 16 * nt + c;
#pragma unroll
    for (int vt = 0; vt < 4; ++vt) {
      bf16_t* gp = p.MGb + tok * 512 + head * 64 + 16 * vt + 4 * g;
      us4 gt = *(const us4*)gp;
      us4 o;
#pragma unroll
      for (int j = 0; j < 4; ++j) o[j] = f2bf(ot[vt][nt][j] * inv * siluf_(bf2f(gt[j])));
      if (!dry) *(us4*)gp = o;
    }
  }
}

__device__ void phase_gla_combine(const Params& p, int li) {
  const int tid_ = otid(); const int lane = tid_ & 63, w = tid_ >> 6;
  for (int tok = blockIdx.x * 4 + w; tok < T_TOK; tok += gridDim.x * 4) {
    const bf16_t* tp = p.TMP + (long)tok * 1024 + 16 * lane;
    bf16_t* gp = p.Gb + (long)tok * 1024 + 16 * lane;
    bf16x8 o0 = *(const bf16x8*)tp, o1 = *(const bf16x8*)(tp + 8);
    bf16x8 g0 = *(const bf16x8*)gp, g1 = *(const bf16x8*)(gp + 8);
    float ov[16], gv[16];
#pragma unroll
    for (int e = 0; e < 8; ++e) {
      ov[e] = bf2f((bf16_t)o0[e]); ov[8 + e] = bf2f((bf16_t)o1[e]);
      gv[e] = bf2f((bf16_t)g0[e]); gv[8 + e] = bf2f((bf16_t)g1[e]);
    }
    float ss = 0.f;
#pragma unroll
    for (int e = 0; e < 16; ++e) ss += ov[e] * ov[e];
    ss += __shfl_xor(ss, 1); ss += __shfl_xor(ss, 2); ss += __shfl_xor(ss, 4); ss += __shfl_xor(ss, 8);
    const float rs = rsqrtf(ss * (1.f / 256.f) + EPS);
    const float* ng = p.e_gla_norm_g + li * 256 + ((16 * lane) & 255);
    bf16x8 r0, r1;
#pragma unroll
    for (int e = 0; e < 8; ++e) {
      r0[e] = (short)f2bf(ov[e] * rs * ng[e] * siluf_(gv[e]));
      r1[e] = (short)f2bf(ov[8 + e] * rs * ng[8 + e] * siluf_(gv[8 + e]));
    }
    *(bf16x8*)gp = r0;
    *(bf16x8*)(gp + 8) = r1;
  }
}

__device__ void phase_ml_combine(const Params& p, int li) {
  const int tid_ = otid(); const int lane = tid_ & 63, w = tid_ >> 6;
  for (int tok = blockIdx.x * 4 + w; tok < T_TOK; tok += gridDim.x * 4) {
    const long off = (long)tok * 512 + 8 * lane;
    bf16x8 hv = *(const bf16x8*)(p.NUMIf + off);
    bf16x8 hb = *(const bf16x8*)(p.NUMIb + off);
    bf16x8 mo = *(const bf16x8*)(p.MOb + off);
    bf16x8 mg = *(const bf16x8*)(p.MLGb + off);
    float hf[8];
    float ss = 0.f;
#pragma unroll
    for (int e = 0; e < 8; ++e) { hf[e] = bf2f((bf16_t)hv[e]) + bf2f((bf16_t)hb[e]); ss += hf[e] * hf[e]; }
    ss += __shfl_xor(ss, 1); ss += __shfl_xor(ss, 2); ss += __shfl_xor(ss, 4); ss += __shfl_xor(ss, 8);
    const float rs = rsqrtf(ss * (1.f / 128.f) + EPS);
    const float* ng = p.o_ml_norm_g + li * 128 + ((8 * lane) & 127);
    bf16x8 r;
#pragma unroll
    for (int e = 0; e < 8; ++e)
      r[e] = (short)f2bf(hf[e] * rs * ng[e] * sigmoidf_(bf2f((bf16_t)mo[e])) * siluf_(bf2f((bf16_t)mg[e])));
    *(bf16x8*)(p.MLGb + off) = r;
  }
}

__device__ void phase_final(const Params& p) {
  const int tid_ = otid(); const int lane = tid_ & 63, w = tid_ >> 6;
  for (int tok = blockIdx.x * 4 + w; tok < T_TOK; tok += gridDim.x * 4) {
    float* xp = p.out + (long)tok * DM;
    float4 v[4];
    float ss = 0.f;
#pragma unroll
    for (int i = 0; i < 4; ++i) {
      v[i] = *(const float4*)(xp + 4 * lane + 256 * i);
      ss += v[i].x * v[i].x + v[i].y * v[i].y + v[i].z * v[i].z + v[i].w * v[i].w;
    }
#pragma unroll
    for (int d = 1; d < 64; d <<= 1) ss += __shfl_xor(ss, d);
    const float rs = rsqrtf(ss * (1.f / 1024.f) + EPS);
#pragma unroll
    for (int i = 0; i < 4; ++i) {
      float4 gq = *(const float4*)(p.final_norm_g + 4 * lane + 256 * i);
      float4 o;
      o.x = v[i].x * rs * gq.x; o.y = v[i].y * rs * gq.y; o.z = v[i].z * rs * gq.z; o.w = v[i].w * rs * gq.w;
      *(float4*)(xp + 4 * lane + 256 * i) = o;
    }
  }
}

__device__ void run_phase(const Params& p, int ph, char* smem) {
  if (ph == 0) { if (PH_ON(0)) phase_prep(p); return; }
  if (ph == NPHASE - 1) { if (PH_ON(11)) phase_final(p); return; }
  const int q = ph - 1;
  const int layer = (q < 5) ? 0 : (q < 12) ? 1 : (q < 17) ? 2 : 3;
  const int sub = (q < 5) ? q : (q < 12) ? q - 5 : (q < 17) ? q - 12 : q - 17;
  const int li = layer >> 1;
  const float* xa = (layer == 0) ? p.x_prompt : p.out;
  const float* xb = (layer == 0) ? p.x_sample : p.out + (long)T_P * DM;
  if ((layer & 1) == 0) {
    if (sub == 0) {
      EpiEvenIn e{p.Qb, p.Kt, p.VtE, p.Gb, p.LRb, p.PUb, p.PGb};
      for (int rep = 0; rep < 1 + PROBE_GEMM; ++rep)
      if (PH_ON(1)) gemm_phase<0, 8>(T_TOK / 128, NE_PAD / 256, DM, p.WinE + (long)li * NE_PAD * DM, xa, xb, nullptr, 0, 0, nullptr, 0, e, smem);
    } else if (sub == 1) {
      for (int item = blockIdx.x; item < 5120 + 5120; item += gridDim.x) {
        if (item < 5120) { if (PH_ON(2)) gla_intra_item(p, li, item, smem); }
        else { if (PH_ON(3)) pool_item(p, li, item - 5120, smem); }
      }
    } else if (sub == 2) {
      for (int rep = PROBE_CHAIN ? 0 : 1; rep < 2; ++rep)
      for (int item = blockIdx.x; item < 384; item += gridDim.x)
        if (PH_ON(2)) gla_chain_item(p, li, item, smem, rep == 0);
    } else if (sub == 3) {
      if (PH_ON(4)) phase_gla_combine(p, li);
    } else {
      if (PROBE_GEMM) { EpiOut ed{xa, xb, p.out, true}; gemm_phase<1, 8>(T_TOK / 128, DM / 256, 1536, p.WoutE + (long)li * DM * 1536, nullptr, nullptr, p.Gb, 1024, 1024, p.PGb, 512, ed, smem); }
      EpiOut e{xa, xb, p.out, false};
      if (PH_ON(5)) gemm_phase<1, 8>(T_TOK / 128, DM / 256, 1536, p.WoutE + (long)li * DM * 1536, nullptr, nullptr, p.Gb, 1024, 1024, p.PGb, 512, e, smem);
    }
  } else {
    if (sub == 0) {
      EpiOddIn e{p.CQb, p.CKVb, p.KRb, p.MGb, p.MQb, p.MKb, p.MKt, p.MVt, p.MOb, p.MLGb, p.MIF};
      for (int rep = 0; rep < 1 + PROBE_GEMM; ++rep)
      if (PH_ON(6)) gemm_phase<0, 8>(T_TOK / 128, NO_PAD / 256, DM, p.WinO + (long)li * NO_PAD * DM, xa, xb, nullptr, 0, 0, nullptr, 0, e, smem);
    } else if (sub == 1) {
      for (int item = blockIdx.x; item < 5120; item += gridDim.x)
        if (PH_ON(8)) ml_intra_item(p, li, item, smem);
    } else if (sub == 2) {
      for (int rep = PROBE_MLCHAIN ? 0 : 1; rep < 2; ++rep)
      for (int item = blockIdx.x; item < 384; item += gridDim.x)
        if (PH_ON(8)) ml_chain_item(p, li, item, smem, rep == 0);
    } else if (sub == 3) {
      if (PH_ON(10)) phase_ml_combine(p, li);
    } else if (sub == 4) {
      EpiQUp eq{p.Qa};
      if (PH_ON(7)) gemm_phase<2, 4>(T_TOK / 128, 768 / 128, 384, p.QupT + (long)li * 768 * 384, nullptr, nullptr, p.CQb, 384, 384, p.CQb, 384, eq, smem);
      EpiKVUp ek{p.KNb, p.VtA};
      if (PH_ON(7)) gemm_phase<2, 4>(T_TOK / 128, 1024 / 128, 256, p.KVupT + (long)li * 1024 * 256, nullptr, nullptr, p.CKVb, 256, 256, p.CKVb, 256, ek, smem);
    } else if (sub == 5) {
      __shared__ int s_item;
      for (;;) {
        __syncthreads();
        if (threadIdx.x == 0) s_item = atomicAdd(p.counters + li, 1);
        __syncthreads();
        const int item = s_item;
        if (item >= 5120) break;
        if (PH_ON(9)) attn_item(p, item, smem);
      }
    } else {
      EpiOut e{xa, xb, p.out, false};
      if (PH_ON(5)) gemm_phase<1, 8>(T_TOK / 128, DM / 256, 1024, p.WoutO + (long)li * DM * 1024, nullptr, nullptr, p.MGb, 512, 512, p.MLGb, 512, e, smem);
    }
  }
}

__global__ void __launch_bounds__(256, 2) mega_kernel(Params p) {
  extern __shared__ __attribute__((aligned(16))) char smem[];
  cg::grid_group grid = cg::this_grid();
  __shared__ uint4 xb_words;
  if (threadIdx.x == 0) xb_words = make_uint4(0u, 0u, 0u, 0u);
  __syncthreads();
  XcdBarrier xb = xcd_barrier_post(p.bar, (volatile LAS unsigned*)&xb_words);
  for (int ph = p.ph_lo; ph < p.ph_hi; ++ph) {
    if (ph > p.ph_lo) {
      if (ph == p.ph_lo + 1) grid.sync();
      else xcd_barrier(xb);
    }
    run_phase(p, ph, smem);
  }
}

extern "C" void kernel_launch(void* const* d_in, const int* in_sizes, int n_in, void* d_out, int out_size, void* d_ws,
                              size_t ws_size, hipStream_t stream) {
  static int grid_blocks = 0;
  if (!grid_blocks) {
    int dev = 0, cus = 0, per_cu = 0;
    hipGetDevice(&dev);
    hipDeviceGetAttribute(&cus, hipDeviceAttributeMultiprocessorCount, dev);
    hipFuncSetAttribute((const void*)mega_kernel, hipFuncAttributeMaxDynamicSharedMemorySize, LDS_BYTES);
    hipOccupancyMaxActiveBlocksPerMultiprocessor(&per_cu, (const void*)mega_kernel, 256, LDS_BYTES);
    if (per_cu < 1) per_cu = 1;
    if (per_cu > 2) per_cu = 2;
    grid_blocks = cus * per_cu;
    fprintf(stderr, "kernel_launch: cus %d per_cu %d grid %d ws %zu\n", cus, per_cu, grid_blocks, ws_size);
  }
  Params p{};
  const float** pin = (const float**)&p;
  for (int i = 0; i < 19; ++i) pin[i] = (const float*)d_in[i];
  p.out = (float*)d_out;
  char* ws = (char*)d_ws;
  size_t off = 0;
  auto take = [&](size_t bytes) { char* r = ws + off; off += (bytes + 255) & ~(size_t)255; return r; };
  p.WinE = (bf16_t*)take((size_t)2 * NE_PAD * DM * 2);
  p.WinO = (bf16_t*)take((size_t)2 * NO_PAD * DM * 2);
  p.WoutE = (bf16_t*)take((size_t)2 * DM * 1536 * 2);
  p.WoutO = (bf16_t*)take((size_t)2 * DM * 1024 * 2);
  p.QupT = (bf16_t*)take((size_t)2 * 768 * 384 * 2);
  p.KVupT = (bf16_t*)take((size_t)2 * 1024 * 256 * 2);
  p.PoolWT = (bf16_t*)take((size_t)2 * 4 * 128 * 128 * 2);
  p.AupT = (bf16_t*)take((size_t)2 * 2 * 512 * 32 * 2);
  p.counters = (int*)take(256);
  p.bar = (unsigned*)take((size_t)XCD_BAR_WORDS * 4);
  const size_t act0 = off;
  const size_t T = T_TOK;
  p.Qb = (bf16_t*)take(T * 512 * 2);
  p.Kt = (bf16_t*)take(T * 512 * 2);
  p.QEb = (bf16_t*)take(T * 512 * 2);
  p.KdTb = (bf16_t*)take(T * 512 * 2);
  p.EB = (float*)take((size_t)2 * 1280 * 512 * 4);
  p.VtE = (bf16_t*)take(T * 1024 * 2);
  p.Gb = (bf16_t*)take(T * 1024 * 2);
  p.LRb = (bf16_t*)take(T * 32 * 2);
  p.PUb = (bf16_t*)take(T * 512 * 2);
  p.PGb = (bf16_t*)take(T * 512 * 2);
  p.TMP = (bf16_t*)take(T * 1024 * 2);
  const size_t even_end = off;
  off = act0;
  p.MGb = (bf16_t*)take(T * 512 * 2);
  p.MLGb = (bf16_t*)take(T * 512 * 2);
  p.CQb = (bf16_t*)take(T * 384 * 2);
  p.CKVb = (bf16_t*)take(T * 256 * 2);
  p.KRb = (bf16_t*)take(T * 32 * 2);
  const size_t r2 = off;
  p.MQb = (bf16_t*)take(T * 512 * 2);
  p.MKb = (bf16_t*)take(T * 512 * 2);
  p.MKt = (bf16_t*)take(T * 512 * 2);
  p.MVt = (bf16_t*)take(T * 512 * 2);
  p.MOb = (bf16_t*)take(T * 512 * 2);
  p.NUMIf = (bf16_t*)take(T * 512 * 2);
  p.NUMIb = (bf16_t*)take(T * 512 * 2);
  p.MIF = (float*)take(T * 16 * 4);
  p.EBI = (float*)take(T * 8 * 4);
  p.WKg = (float*)take(T * 8 * 4);
  p.DENI = (float*)take(T * 8 * 4);
  p.DEC = (float*)take((size_t)8 * 1280 * 4);
  const size_t r2_end = off;
  off = r2;
  p.Qa = (bf16_t*)take(T * 768 * 2);
  p.KNb = (bf16_t*)take(T * 512 * 2);
  p.VtA = (bf16_t*)take(T * 512 * 2);
  if (off < r2_end) off = r2_end;
  const size_t odd_end = off;
  const size_t need = even_end > odd_end ? even_end : odd_end;
  if (need > ws_size) {
    fprintf(stderr, "kernel_launch: workspace too small: need %zu have %zu\n", need, ws_size);
    return;
  }
  hipMemsetAsync(p.bar, 0, (size_t)XCD_BAR_WORDS * 4, stream);
#if SINGLE_LAUNCH
  p.ph_lo = 0;
  p.ph_hi = NPHASE;
  void* args[] = {&p};
  hipError_t e = hipLaunchCooperativeKernel((const void*)mega_kernel, dim3(grid_blocks), dim3(256), args, LDS_BYTES, stream);
  if (e != hipSuccess) fprintf(stderr, "cooperative launch failed: %s (grid %d)\n", hipGetErrorString(e), grid_blocks);
#else
  for (int ph = 0; ph < NPHASE; ++ph) {
    p.ph_lo = ph;
    p.ph_hi = ph + 1;
    hipLaunchKernelGGL(mega_kernel, dim3(grid_blocks), dim3(256), LDS_BYTES, stream, p);
  }
#endif
}
```

```cpp
#include <hip/hip_runtime.h>
#include <hip/hip_cooperative_groups.h>
#include <cstdio>
namespace cg = cooperative_groups;

#ifndef SINGLE_LAUNCH
#define SINGLE_LAUNCH 1
#endif
#ifndef PHMASK
#define PHMASK 0xFFFF
#endif
#define PH_ON(b) ((PHMASK >> (b)) & 1)
#ifndef PROBE_GEMM
#define PROBE_GEMM 0
#endif
#ifndef PROBE_ATTN
#define PROBE_ATTN 0
#endif
#ifndef PROBE_CHAIN
#define PROBE_CHAIN 0
#endif
#ifndef PROBE_A
#define PROBE_A 0
#endif
#ifndef PROBE_B
#define PROBE_B 0
#endif
#ifndef PROBE_MLCHAIN
#define PROBE_MLCHAIN 0
#endif

typedef unsigned short bf16_t;
typedef __attribute__((ext_vector_type(8))) short bf16x8;
typedef __attribute__((ext_vector_type(4))) float f32x4;
typedef __attribute__((ext_vector_type(4))) unsigned short us4;

constexpr int T_TOK = 81920;
constexpr int T_P = 16384;
constexpr int DM = 1024;
constexpr int NE = 4128, NE_PAD = 4352;
constexpr int NO = 4272, NO_PAD = 4352;
constexpr float EPS = 1e-6f;
constexpr int NPHASE = 26;
constexpr int LDS_BYTES = 72 * 1024;

struct Params {
  const float *x_prompt, *x_sample, *norm_g, *final_norm_g, *e_w_in, *e_a_up, *e_a_bias, *e_gla_norm_g,
      *e_pool_w, *e_pool_scale, *e_w_out, *o_w_in, *o_q_norm_g, *o_q_up, *o_kv_norm_g, *o_kv_up, *o_if_bias,
      *o_ml_norm_g, *o_w_out;
  float* out;
  bf16_t *WinE, *WinO, *WoutE, *WoutO, *QupT, *KVupT, *PoolWT, *AupT;
  int* counters;
  unsigned* bar;
  bf16_t *Qb, *Kt, *VtE, *Gb, *LRb, *PUb, *PGb, *TMP, *QEb, *KdTb;
  float* EB;
  bf16_t *CQb, *CKVb, *KRb, *MGb, *MQb, *MKb, *MKt, *MVt, *MOb, *MLGb, *NUMIf, *NUMIb, *Qa, *KNb, *VtA;
  float *MIF, *EBI, *WKg, *DENI, *DEC;
  int ph_lo, ph_hi;
};

typedef __bf16 hbf2 __attribute__((ext_vector_type(2)));
typedef float hf2 __attribute__((ext_vector_type(2)));
__device__ __forceinline__ bf16_t f2bf(float f) {
  __bf16 b = (__bf16)f;
  return __builtin_bit_cast(bf16_t, b);
}
__device__ __forceinline__ unsigned pk2bf(float a, float b) {
  hf2 v = {a, b};
  hbf2 r = __builtin_convertvector(v, hbf2);
  return __builtin_bit_cast(unsigned, r);
}
__device__ __forceinline__ float bf2f(bf16_t b) { return __uint_as_float(((unsigned)b) << 16); }
__device__ __forceinline__ f32x4 mfma16(bf16x8 a, bf16x8 b, f32x4 c) {
  return __builtin_amdgcn_mfma_f32_16x16x32_bf16(a, b, c, 0, 0, 0);
}
__device__ __forceinline__ float logsigmoidf_(float x) { return fminf(x, 0.f) - log1pf(__expf(-fabsf(x))); }
__device__ __forceinline__ float siluf_(float x) { return x / (1.f + __expf(-x)); }
__device__ __forceinline__ float sigmoidf_(float x) { return 1.f / (1.f + __expf(-x)); }
__device__ __forceinline__ int otid() { int t = threadIdx.x; asm volatile("" : "+v"(t)); return t; }
__device__ __forceinline__ bf16x8 zero8() { bf16x8 z = {0, 0, 0, 0, 0, 0, 0, 0}; return z; }
__device__ __forceinline__ f32x4 zero4() { f32x4 z = {0.f, 0.f, 0.f, 0.f}; return z; }

__device__ __forceinline__ int seq_pos(int tok) { return tok < T_P ? (tok & 4095) : ((tok - T_P) & 8191); }
__device__ __forceinline__ const float* xrow(const float* xa, const float* xb, int tok) {
  return tok < T_P ? xa + (long)tok * DM : xb + (long)(tok - T_P) * DM;
}


#define XB_TMO      128
#define XB_XCNT(j)  (256  + 64 * (j))
#define XB_XSUB(j)  (1280 + 64 * (j))
#define XB_XGEN(j)  (2304 + 64 * (j))
#define XB_TOP      3328
#define XB_TOPGEN   3392
#define XCD_BAR_WORDS 3456
#define XB_SPIN_CAP (1u << 22)
#define LAS __attribute__((address_space(3)))
__device__ __forceinline__ unsigned xb_ld(unsigned* p) { return __hip_atomic_load(p, __ATOMIC_RELAXED, __HIP_MEMORY_SCOPE_AGENT); }
__device__ __forceinline__ unsigned xb_add(unsigned* p, unsigned v) { return __hip_atomic_fetch_add(p, v, __ATOMIC_RELAXED, __HIP_MEMORY_SCOPE_AGENT); }
__device__ __forceinline__ unsigned xb_xcc_id() { return (unsigned)__builtin_amdgcn_s_getreg((3 << 11) | 20) & 0xFu; }
#define XB_SPIN(cond, bar) do { unsigned _sp = 0; while (cond) { __builtin_amdgcn_s_sleep(1); \
    if ((++_sp & 255u) == 0u) { if (xb_ld(&(bar)[XB_TMO])) break; if (_sp > XB_SPIN_CAP) { atomicAdd(&(bar)[XB_TMO], 1u); break; } } } } while (0)
struct XcdBarrier { unsigned* bar; unsigned x; volatile LAS unsigned* st; };
__device__ __forceinline__ XcdBarrier xcd_barrier_post(unsigned* bar, volatile LAS unsigned* st) {
  XcdBarrier b; b.bar = bar; b.x = xb_xcc_id(); b.st = st;
  if (threadIdx.x == 0) (void)xb_add(&bar[XB_XCNT(b.x)], 1u);
  return b;
}
__device__ __forceinline__ void xcd_barrier_complete(unsigned* bar, unsigned x, unsigned& nloc, unsigned& nx) {
  const unsigned G = gridDim.x * gridDim.y * gridDim.z;
  unsigned sum, cnt, mine, sp = 0u;
  for (;;) {
    sum = 0u; cnt = 0u; mine = 0u;
#pragma unroll
    for (unsigned j = 0; j < 16; ++j) { const unsigned cc = xb_ld(&bar[XB_XCNT(j)]); sum += cc; cnt += (cc > 0u) ? 1u : 0u; mine = (j == x) ? cc : mine; }
    if (sum == G) break;
    __builtin_amdgcn_s_sleep(1);
    if ((++sp & 255u) == 0u) { if (xb_ld(&bar[XB_TMO])) break; if (sp > XB_SPIN_CAP) { atomicAdd(&bar[XB_TMO], 1u); break; } }
  }
  nloc = mine > 0u ? mine : 1u; nx = cnt > 0u ? cnt : 1u;
}
__device__ __forceinline__ void xcd_barrier(const XcdBarrier& b) {
  asm volatile("s_waitcnt vmcnt(0)" ::: "memory");
  __syncthreads();
  if (threadIdx.x == 0) {
    unsigned* bar = b.bar;
    __builtin_amdgcn_s_waitcnt(0);
    unsigned nloc = b.st[0], nx = b.st[1];
    if (nloc == 0u) { xcd_barrier_complete(bar, b.x, nloc, nx); b.st[0] = nloc; b.st[1] = nx; }
    const unsigned old = xb_add(&bar[XB_XSUB(b.x)], 1u);
    const unsigned gen = old / nloc;
    if (old + 1u == (gen + 1u) * nloc) {
      __builtin_amdgcn_fence(__ATOMIC_RELEASE, "agent");
      asm volatile("s_waitcnt vmcnt(0)" ::: "memory");
      const unsigned og = xb_add(&bar[XB_TOP], 1u);
      const unsigned tg = og / nx;
      if (og + 1u == (tg + 1u) * nx) xb_add(&bar[XB_TOPGEN], 1u);
      else XB_SPIN(xb_ld(&bar[XB_TOPGEN]) == tg, bar);
      __builtin_amdgcn_fence(__ATOMIC_ACQUIRE, "agent");
      xb_add(&bar[XB_XGEN(b.x)], 1u);
      asm volatile("s_waitcnt vmcnt(0)" ::: "memory");
    } else {
      XB_SPIN(xb_ld(&bar[XB_XGEN(b.x)]) == gen, bar);
      __builtin_amdgcn_fence(__ATOMIC_ACQUIRE, "agent");
      asm volatile("s_waitcnt vmcnt(0)" ::: "memory");
    }
  }
  __syncthreads();
}

__device__ __forceinline__ int colmap(int mode, int n) {
  if (mode == 1) {
    if (n < 512) return 2208 + n;
    if (n < 1024) return 1696 + (n - 512);
    if (n < 1408) return n - 1024;
    if (n < 1664) return 384 + (n - 1408);
    if (n < 2176) return 672 + (n - 1664);
    if (n < 2688) return 1184 + (n - 2176);
    if (n < 3200) return 1696 + (n - 2688);
    if (n < 3712) return 2720 + (n - 3200);
    if (n < 4224) return 3248 + (n - 3712);
    if (n < 4256) return 640 + (n - 4224);
    return 3232 + (n - 4256);
  }
  if (mode == 2) {
    if (n < 512) return (n >> 6) * 96 + (n & 63);
    const int r = n - 512;
    return (r >> 5) * 96 + 64 + (r & 31);
  }
  if (mode == 3) {
    if (n < 512) return (n >> 6) * 128 + (n & 63);
    const int r = n - 512;
    return (r >> 6) * 128 + 64 + (r & 63);
  }
  return n;
}

__device__ void prep_weight(const float* __restrict__ W, int K, int N, int Npad, const float* __restrict__ gsc,
                            bf16_t* __restrict__ out, long gtid, long gsize, int mode = 0, int Nsrc_ = 0) {
  const int Nsrc = Nsrc_ ? Nsrc_ : N;
  long total = (long)Npad * K;
  for (long idx = gtid; idx < total; idx += gsize) {
    int k = (int)(idx / Npad);
    int n = (int)(idx % Npad);
    float v = 0.f;
    if (n < N) {
      v = W[(long)k * Nsrc + colmap(mode, n)];
      if (gsc) v *= gsc[k];
    }
    out[(long)n * K + k] = f2bf(v);
  }
}

__device__ void phase_prep(const Params& p) {
  long gtid = (long)blockIdx.x * 256 + otid();
  long gsize = (long)gridDim.x * 256;
  for (int l = 0; l < 2; ++l) {
    prep_weight(p.e_w_in + (long)l * DM * NE, DM, NE, NE_PAD, p.norm_g + (2 * l) * DM, p.WinE + (long)l * NE_PAD * DM, gtid, gsize);
    prep_weight(p.o_w_in + (long)l * DM * 3760, DM, NO, NO_PAD, p.norm_g + (2 * l + 1) * DM, p.WinO + (long)l * NO_PAD * DM, gtid, gsize, 1, 3760);
    prep_weight(p.e_w_out + (long)l * 1536 * DM, 1536, DM, DM, nullptr, p.WoutE + (long)l * DM * 1536, gtid, gsize);
    prep_weight(p.o_w_out + (long)l * 1024 * DM, 1024, DM, DM, nullptr, p.WoutO + (long)l * DM * 1024, gtid, gsize);
    prep_weight(p.o_q_up + (long)l * 384 * 768, 384, 768, 768, p.o_q_norm_g + l * 384, p.QupT + (long)l * 768 * 384, gtid, gsize, 2);
    prep_weight(p.o_kv_up + (long)l * 256 * 1024, 256, 1024, 1024, p.o_kv_norm_g + l * 256, p.KVupT + (long)l * 1024 * 256, gtid, gsize, 3);
    for (int gi = 0; gi < 4; ++gi)
      prep_weight(p.e_pool_w + (long)(l * 4 + gi) * 128 * 128, 128, 128, 128, nullptr, p.PoolWT + (long)(l * 4 + gi) * 128 * 128, gtid, gsize);
    for (long idx = gtid; idx < 2 * 512 * 32; idx += gsize) {
      int r = (int)(idx & 31);
      int d = (int)((idx >> 5) & 511);
      int dir = (int)(idx >> 14);
      float v = (r < 16) ? p.e_a_up[((long)(l * 2 + dir) * 16 + r) * 512 + d] : 0.f;
      p.AupT[((long)(l * 2 + dir) * 512 + d) * 32 + r] = f2bf(v);
    }
  }
  if (gtid < 16) p.counters[gtid] = 0;
}

constexpr int G_LD = 40;
constexpr int G_BUF = (128 + 256) * G_LD;

template <int AMODE, int NI, class Epi>
__device__ void gemm_phase(int Mtiles, int Ntiles, int K, const bf16_t* __restrict__ Bt, const float* xa, const float* xb,
                           const bf16_t* A1, int ld1, int K1, const bf16_t* A2, int ld2, const Epi& epi, char* smem) {
  bf16_t* sbase = (bf16_t*)smem;
  float* sR = (float*)(smem + 70144);
  const int tid = otid(), lane = tid & 63, w = tid >> 6, c = lane & 15, g = lane >> 4;
  const int wm = w >> 1, wn = w & 1;
  const int nk = K / 32;
  const int ntiles = Mtiles * Ntiles;
  for (int tile = blockIdx.x; tile < ntiles; tile += gridDim.x) {
    const int mt = tile / Ntiles, nt = tile % Ntiles;
    constexpr int BN = 32 * NI;
    const int m0 = mt * 128, n0 = nt * BN;
    f32x4 acc[4][NI];
#pragma unroll
    for (int i = 0; i < 4; ++i)
#pragma unroll
      for (int j = 0; j < NI; ++j) acc[i][j] = zero4();
    float ss[4] = {0.f, 0.f, 0.f, 0.f};
    f32x4 raf[4];
    bf16x8 rab[2];
    bf16x8 rb[NI / 2];
    const float* abase_f = (m0 < T_P) ? xa + (size_t)m0 * DM : xb + (size_t)(m0 - T_P) * DM;
    const unsigned aoff_f = (unsigned)(tid >> 3) * DM + 4 * (tid & 7);
    const unsigned boff = (unsigned)(tid >> 2) * K + 8 * (tid & 3);
    const bf16_t* bbase = Bt + (size_t)n0 * K;
#define GEMM_GLOAD(KT)                                                                              \
  {                                                                                                 \
    const int k0_ = (KT) * 32;                                                                      \
    if constexpr (AMODE == 0) {                                                                     \
      _Pragma("unroll") for (int i = 0; i < 4; ++i)                                                 \
        raf[i] = *(const f32x4*)(abase_f + k0_ + aoff_f + (unsigned)(32 * i) * DM);                 \
    } else {                                                                                        \
      const bf16_t* base_;                                                                          \
      int ld_;                                                                                      \
      if (k0_ < K1) { base_ = A1 + (size_t)m0 * ld1 + k0_; ld_ = ld1; }                             \
      else { base_ = A2 + (size_t)m0 * ld2 + (k0_ - K1); ld_ = ld2; }                               \
      _Pragma("unroll") for (int i = 0; i < 2; ++i)                                                 \
        rab[i] = *(const bf16x8*)(base_ + (unsigned)((tid >> 2) + 64 * i) * ld_ + 8 * (tid & 3));   \
    }                                                                                               \
    _Pragma("unroll") for (int i = 0; i < NI / 2; ++i)                                              \
      rb[i] = *(const bf16x8*)(bbase + k0_ + boff + (unsigned)(64 * i) * K);                        \
  }
#define GEMM_LSTORE(BUF)                                                                            \
  {                                                                                                 \
    bf16_t* sA_ = sbase + (BUF) * G_BUF;                                                            \
    bf16_t* sB_ = sA_ + 128 * G_LD;                                                                 \
    if constexpr (AMODE == 0) {                                                                     \
      _Pragma("unroll") for (int i = 0; i < 4; ++i) {                                               \
        f32x4 v = raf[i];                                                                           \
        ss[i] += v[0] * v[0] + v[1] * v[1] + v[2] * v[2] + v[3] * v[3];                             \
        uint2 o;                                                                                    \
        o.x = pk2bf(v[0], v[1]);                                                                    \
        o.y = pk2bf(v[2], v[3]);                                                                    \
        *(uint2*)(sA_ + ((tid >> 3) + 32 * i) * G_LD + 4 * (tid & 7)) = o;                          \
      }                                                                                             \
    } else {                                                                                        \
      _Pragma("unroll") for (int i = 0; i < 2; ++i) {                                               \
        bf16x8 v = rab[i];                                                                          \
        if constexpr (AMODE == 2) {                                                                 \
          _Pragma("unroll") for (int e = 0; e < 8; ++e) {                                           \
            float f = bf2f((bf16_t)v[e]);                                                           \
            ss[i] += f * f;                                                                         \
          }                                                                                         \
        }                                                                                           \
        *(bf16x8*)(sA_ + ((tid >> 2) + 64 * i) * G_LD + 8 * (tid & 3)) = v;                         \
      }                                                                                             \
    }                                                                                               \
    _Pragma("unroll") for (int i = 0; i < NI / 2; ++i)                                              \
      *(bf16x8*)(sB_ + ((tid >> 2) + 64 * i) * G_LD + 8 * (tid & 3)) = rb[i];                       \
  }
    __syncthreads();
    GEMM_GLOAD(0)
    GEMM_LSTORE(0)
    __syncthreads();
    for (int kt = 0; kt < nk; ++kt) {
      if (kt + 1 < nk) GEMM_GLOAD(kt + 1)
      {
        const bf16_t* sA_ = sbase + (kt & 1) * G_BUF;
        const bf16_t* sB_ = sA_ + 128 * G_LD;
        bf16x8 af[4];
#pragma unroll
        for (int mi = 0; mi < 4; ++mi) af[mi] = *(const bf16x8*)(sA_ + (wm * 64 + mi * 16 + c) * G_LD + g * 8);
#pragma unroll
        for (int ni = 0; ni < NI; ++ni) {
          bf16x8 bfr = *(const bf16x8*)(sB_ + (wn * (16 * NI) + ni * 16 + c) * G_LD + g * 8);
#pragma unroll
          for (int mi = 0; mi < 4; ++mi) acc[mi][ni] = mfma16(af[mi], bfr, acc[mi][ni]);
        }
      }
      if (kt + 1 < nk) GEMM_LSTORE((kt + 1) & 1)
      __syncthreads();
    }
    if constexpr (AMODE == 0) {
#pragma unroll
      for (int i = 0; i < 4; ++i) {
        float sv = ss[i];
        sv += __shfl_xor(sv, 1); sv += __shfl_xor(sv, 2); sv += __shfl_xor(sv, 4);
        if ((tid & 7) == 0) sR[(tid >> 3) + 32 * i] = rsqrtf(sv / (float)K + EPS);
      }
      __syncthreads();
    } else if constexpr (AMODE == 2) {
#pragma unroll
      for (int i = 0; i < 2; ++i) {
        float sv = ss[i];
        sv += __shfl_xor(sv, 1); sv += __shfl_xor(sv, 2);
        if ((tid & 3) == 0) sR[(tid >> 2) + 64 * i] = rsqrtf(sv / (float)K + EPS);
      }
      __syncthreads();
    }
    if constexpr (Epi::staged) {
      bf16_t* sT = sbase;
      const float esc = epi.scale();
      const bool tr = epi.transposed(n0);
      if (tr) {
#pragma unroll
        for (int mi = 0; mi < 4; ++mi) {
          const int row = wm * 64 + mi * 16 + 4 * g;
          const float r0 = sR[row] * esc, r1 = sR[row + 1] * esc, r2 = sR[row + 2] * esc, r3 = sR[row + 3] * esc;
#pragma unroll
          for (int ni = 0; ni < NI; ++ni) {
            uint2 o;
            o.x = pk2bf(acc[mi][ni][0] * r0, acc[mi][ni][1] * r1);
            o.y = pk2bf(acc[mi][ni][2] * r2, acc[mi][ni][3] * r3);
            *(uint2*)(sT + (wn * (16 * NI) + ni * 16 + c) * 136 + row) = o;
          }
        }
      } else {
#pragma unroll
        for (int mi = 0; mi < 4; ++mi) {
          const int row = wm * 64 + mi * 16 + 4 * g;
          const float r0 = sR[row] * esc, r1 = sR[row + 1] * esc, r2 = sR[row + 2] * esc, r3 = sR[row + 3] * esc;
#pragma unroll
          for (int ni = 0; ni < NI; ++ni) {
            bf16_t* d = sT + row * (BN + 8) + wn * (16 * NI) + ni * 16 + c;
            d[0] = f2bf(acc[mi][ni][0] * r0);
            d[BN + 8] = f2bf(acc[mi][ni][1] * r1);
            d[2 * (BN + 8)] = f2bf(acc[mi][ni][2] * r2);
            d[3 * (BN + 8)] = f2bf(acc[mi][ni][3] * r3);
          }
        }
      }
      epi.template direct<NI>(m0, n0, wm, wn, g, c, acc, sR);
      __syncthreads();
      if (tr) {
#pragma unroll 4
        for (int i = 0; i < 2 * NI; ++i) {
          const int id = tid + 256 * i;
          const int col = id >> 4, rc = id & 15;
          bf16x8 v = *(const bf16x8*)(sT + col * 136 + 8 * rc);
          epi.store_t(m0 + 8 * rc, n0 + col, v);
        }
      } else {
#pragma unroll 4
        for (int i = 0; i < 2 * NI; ++i) {
          const int id = tid + 256 * i;
          const int row = id / (4 * NI), cc = id % (4 * NI);
          const bf16_t* sp = sT + row * (BN + 8) + 8 * cc;
          bf16x8 v = *(const bf16x8*)sp;
          epi.store_n(m0 + row, n0 + 8 * cc, v, sp);
        }
      }
    } else {
      epi(m0, n0, wm, wn, g, c, acc, sR);
    }
  }
#undef GEMM_GLOAD
#undef GEMM_LSTORE
}

__device__ __forceinline__ void rope_cs(int pos, int i, float& co, float& si) {
  float inv = exp2f(-(float)i * (13.287712379549449f / 16.f));
  float ang = (float)pos * inv;
  float n = rintf(ang * 0.15915494309189535f);
  float r = fmaf(-n, 6.28125f, ang);
  r = fmaf(-n, 0.0019353071795864769f, r);
  float rf = r * 0.15915494309189535f;
  si = __builtin_amdgcn_sinf(rf);
  co = __builtin_amdgcn_cosf(rf);
}

__device__ __forceinline__ void rope_chunk(int pos, int i0, bf16x8 x1, bf16x8 x2, bf16x8& o1, bf16x8& o2) {
#pragma unroll
  for (int e = 0; e < 8; ++e) {
    float co, si;
    rope_cs(pos, i0 + e, co, si);
    float a = bf2f((bf16_t)x1[e]), b = bf2f((bf16_t)x2[e]);
    o1[e] = (short)f2bf(a * co - b * si);
    o2[e] = (short)f2bf(b * co + a * si);
  }
}

struct EpiEvenIn {
  static constexpr bool staged = true;
  bf16_t *Qb, *Kt, *VtE, *Gb, *LRb, *PUb, *PGb;
  __device__ float scale() const { return 1.f; }
  __device__ bool transposed(int n0) const { return n0 >= 512 && n0 < 2048; }
  template <int NI> __device__ void direct(int m0, int n0, int wm, int wn, int g, int c, f32x4 (&acc)[4][NI], const float* sR) const {}
  __device__ void store_t(int tok8, int col, bf16x8 v) const {
    if (col < 1024) *(bf16x8*)(Kt + (size_t)(col - 512) * T_TOK + tok8) = v;
    else *(bf16x8*)(VtE + (size_t)(col - 1024) * T_TOK + tok8) = v;
  }
  __device__ void store_n(int tok, int col, bf16x8 v, const bf16_t* sp) const {
    bf16_t* d;
    if (col < 512) d = Qb + (size_t)tok * 512 + col;
    else if (col < 3072) d = Gb + (size_t)tok * 1024 + (col - 2048);
    else if (col < 3104) d = LRb + (size_t)tok * 32 + (col - 3072);
    else if (col < 3616) d = PUb + (size_t)tok * 512 + (col - 3104);
    else if (col < 4128) d = PGb + (size_t)tok * 512 + (col - 3616);
    else return;
    *(bf16x8*)d = v;
  }
};

struct EpiOddIn {
  static constexpr bool staged = true;
  bf16_t *CQb, *CKVb, *KRb, *MGb, *MQb, *MKb, *MKt, *MVt, *MOb, *MLGb;
  float* MIF;
  __device__ float scale() const { return 1.f; }
  __device__ bool transposed(int n0) const { return n0 < 1024; }
  template <int NI> __device__ void direct(int m0, int n0, int wm, int wn, int g, int c, f32x4 (&acc)[4][NI], const float* sR) const {
    if (n0 == 4096 && wn == 1) {
#pragma unroll
      for (int mi = 0; mi < 4; ++mi)
#pragma unroll
        for (int j = 0; j < 4; ++j) {
          const int row = wm * 64 + mi * 16 + 4 * g + j;
          MIF[(size_t)(m0 + row) * 16 + c] = acc[mi][2][j] * sR[row];
        }
    }
  }
  __device__ void store_t(int tok8, int col, bf16x8 v) const {
    if (col < 512) *(bf16x8*)(MVt + (size_t)col * T_TOK + tok8) = v;
    else *(bf16x8*)(MKt + (size_t)(col - 512) * T_TOK + tok8) = v;
  }
  __device__ void store_n(int tok, int col, bf16x8 v, const bf16_t* sp) const {
    bf16_t* d;
    if (col < 1408) d = CQb + (size_t)tok * 384 + (col - 1024);
    else if (col < 1664) d = CKVb + (size_t)tok * 256 + (col - 1408);
    else if (col < 2176) d = MGb + (size_t)tok * 512 + (col - 1664);
    else if (col < 2688) d = MQb + (size_t)tok * 512 + (col - 2176);
    else if (col < 3200) d = MKb + (size_t)tok * 512 + (col - 2688);
    else if (col < 3712) d = MOb + (size_t)tok * 512 + (col - 3200);
    else if (col < 4224) d = MLGb + (size_t)tok * 512 + (col - 3712);
    else if (col < 4240) {
      bf16x8 x2 = *(const bf16x8*)(sp + 16);
      bf16x8 o1, o2;
      rope_chunk(seq_pos(tok), col - 4224, v, x2, o1, o2);
      *(bf16x8*)(KRb + (size_t)tok * 32 + (col - 4224)) = o1;
      *(bf16x8*)(KRb + (size_t)tok * 32 + 16 + (col - 4224)) = o2;
      return;
    } else return;
    *(bf16x8*)d = v;
  }
};

struct EpiQUp {
  static constexpr bool staged = true;
  bf16_t* Qa;
  __device__ float scale() const { return 0.10206207261596575f * 1.4426950408889634f; }
  __device__ bool transposed(int n0) const { return false; }
  template <int NI> __device__ void direct(int m0, int n0, int wm, int wn, int g, int c, f32x4 (&acc)[4][NI], const float* sR) const {}
  __device__ void store_t(int tok8, int col, bf16x8 v) const {}
  __device__ void store_n(int tok, int col, bf16x8 v, const bf16_t* sp) const {
    if (col < 512) {
      *(bf16x8*)(Qa + (size_t)tok * 768 + (col >> 6) * 96 + (col & 63)) = v;
    } else {
      const int r = col - 512, head = r >> 5, rr = r & 31;
      if (rr < 16) {
        bf16x8 x2 = *(const bf16x8*)(sp + 16);
        bf16x8 o1, o2;
        rope_chunk(seq_pos(tok), rr, v, x2, o1, o2);
        *(bf16x8*)(Qa + (size_t)tok * 768 + head * 96 + 64 + rr) = o1;
        *(bf16x8*)(Qa + (size_t)tok * 768 + head * 96 + 80 + rr) = o2;
      }
    }
  }
};

struct EpiKVUp {
  static constexpr bool staged = true;
  bf16_t *KNb, *VtA;
  __device__ float scale() const { return 1.f; }
  __device__ bool transposed(int n0) const { return n0 >= 512; }
  template <int NI> __device__ void direct(int m0, int n0, int wm, int wn, int g, int c, f32x4 (&acc)[4][NI], const float* sR) const {}
  __device__ void store_t(int tok8, int col, bf16x8 v) const { *(bf16x8*)(VtA + (size_t)(col - 512) * T_TOK + tok8) = v; }
  __device__ void store_n(int tok, int col, bf16x8 v, const bf16_t* sp) const { *(bf16x8*)(KNb + (size_t)tok * 512 + col) = v; }
};

struct EpiOut {
  static constexpr bool staged = false;
  const float *xa, *xb;
  float* out;
  bool dry;
  __device__ void operator()(int m0, int n0, int wm, int wn, int g, int c, f32x4 (&acc)[4][8], const float* sR) const {
#pragma unroll
    for (int ni = 0; ni < 8; ++ni) {
      __builtin_amdgcn_sched_barrier(0);
      const int col = n0 + wn * 128 + ni * 16 + c;
#pragma unroll
      for (int mi = 0; mi < 4; ++mi) {
        const int tok = m0 + wm * 64 + mi * 16 + 4 * g;
#pragma unroll
        for (int j = 0; j < 4; ++j) {
          float xo = xrow(xa, xb, tok + j)[col];
          if (!dry) out[(long)(tok + j) * DM + col] = xo + acc[mi][ni][j];
        }
      }
    }
  }
};

__device__ __forceinline__ float scan16(float v, int c) {
  float t;
  t = __shfl_up(v, 1, 16); if (c >= 1) v += t;
  t = __shfl_up(v, 2, 16); if (c >= 2) v += t;
  t = __shfl_up(v, 4, 16); if (c >= 4) v += t;
  t = __shfl_up(v, 8, 16); if (c >= 8) v += t;
  return v;
}

__device__ __forceinline__ float logsig_fast(float x) { return fminf(x, 0.f) - __logf(1.f + __expf(-fabsf(x))); }

__device__ void gla_intra_item(const Params& p, int li, int item, char* smem, bool dry = false) {
  const int tid = otid(), lane = tid & 63, w = tid >> 6, c = lane & 15, g = lane >> 4;
  const int ci = item >> 2, h = item & 3;
  const int tokc = ci * 64;
  const float qscale = 0.08838834764831845f;
  bf16_t* sQe = (bf16_t*)smem;
  bf16_t* sKd = sQe + 64 * 136;
  bf16_t* sA = sKd + 64 * 136;
  us4 q4[2][4];
  bf16_t kk[2][4][4];
#pragma unroll
  for (int dt = 0; dt < 2; ++dt)
#pragma unroll
    for (int tt = 0; tt < 4; ++tt) {
      q4[dt][tt] = *(const us4*)(p.Qb + (size_t)(tokc + 16 * tt + c) * 512 + h * 128 + 32 * w + 16 * dt + 4 * g);
#pragma unroll
      for (int j = 0; j < 4; ++j)
        kk[dt][tt][j] = p.Kt[(size_t)(h * 128 + 32 * w + 16 * dt + 4 * g + j) * T_TOK + tokc + 16 * tt + c];
    }
  __syncthreads();
#pragma unroll
  for (int dir = 0; dir < 2; ++dir) {
    bf16_t* QEd = (dir || dry) ? p.QEb : p.Qb;
    bf16_t* KdTd = (dir || dry) ? p.KdTb : p.Kt;
    bf16x8 aup[2];
    float bias[2][4];
#pragma unroll
    for (int dt = 0; dt < 2; ++dt) {
      aup[dt] = zero8();
      if (g < 2) aup[dt] = *(const bf16x8*)(p.AupT + ((size_t)(li * 2 + dir) * 512 + h * 128 + 32 * w + 16 * dt + c) * 32 + 8 * g);
#pragma unroll
      for (int j = 0; j < 4; ++j) bias[dt][j] = p.e_a_bias[(li * 2 + dir) * 512 + h * 128 + 32 * w + 16 * dt + 4 * g + j];
    }
    f32x4 la[2][4];
#pragma unroll
    for (int tt = 0; tt < 4; ++tt) {
      bf16x8 lrf = zero8();
      if (g < 2) lrf = *(const bf16x8*)(p.LRb + (size_t)(tokc + 16 * tt + c) * 32 + dir * 16 + 8 * g);
#pragma unroll
      for (int dt = 0; dt < 2; ++dt) la[dt][tt] = mfma16(aup[dt], lrf, zero4());
    }
#pragma unroll
    for (int dt = 0; dt < 2; ++dt)
#pragma unroll
      for (int tt = 0; tt < 4; ++tt)
#pragma unroll
        for (int j = 0; j < 4; ++j) la[dt][tt][j] = logsig_fast(la[dt][tt][j] + bias[dt][j]) * (1.f / 16.f);
    f32x4 P[2][4];
    float tot[2][4];
#pragma unroll
    for (int dt = 0; dt < 2; ++dt)
#pragma unroll
      for (int j = 0; j < 4; ++j) {
        float carry = 0.f;
#pragma unroll
        for (int tt = 0; tt < 4; ++tt) {
          float v = scan16(la[dt][tt][j], c) + carry;
          P[dt][tt][j] = v;
          carry = __shfl(v, 15, 16);
        }
        tot[dt][j] = carry;
      }
#pragma unroll
    for (int dt = 0; dt < 2; ++dt)
#pragma unroll
      for (int tt = 0; tt < 4; ++tt) {
        us4 qo, ko;
#pragma unroll
        for (int j = 0; j < 4; ++j) {
          const float b = (dir == 0) ? P[dt][tt][j] : (tot[dt][j] - P[dt][tt][j] + la[dt][tt][j]);
          qo[j] = f2bf(bf2f(q4[dt][tt][j]) * __expf(b) * qscale);
          ko[j] = f2bf(bf2f(kk[dt][tt][j]) * __expf(-b));
          KdTd[(size_t)(h * 128 + 32 * w + 16 * dt + 4 * g + j) * T_TOK + tokc + 16 * tt + c] = ko[j];
        }
        *(us4*)(QEd + (size_t)(tokc + 16 * tt + c) * 512 + h * 128 + 32 * w + 16 * dt + 4 * g) = qo;
        *(us4*)(sQe + (16 * tt + c) * 136 + 32 * w + 16 * dt + 4 * g) = qo;
        *(us4*)(sKd + (16 * tt + c) * 136 + 32 * w + 16 * dt + 4 * g) = ko;
      }
    if (c == 0) {
#pragma unroll
      for (int dt = 0; dt < 2; ++dt)
#pragma unroll
        for (int j = 0; j < 4; ++j)
          p.EB[(size_t)(dir * 1280 + ci) * 512 + h * 128 + 32 * w + 16 * dt + 4 * g + j] = __expf(tot[dt][j]);
    }
    __syncthreads();
    f32x4 accA[4];
#pragma unroll
    for (int jt = 0; jt < 4; ++jt) accA[jt] = zero4();
#pragma unroll
    for (int ks = 0; ks < 4; ++ks) {
      bf16x8 aq = *(const bf16x8*)(sQe + (16 * w + c) * 136 + 32 * ks + 8 * g);
#pragma unroll
      for (int jt = 0; jt < 4; ++jt) {
        bf16x8 bk = *(const bf16x8*)(sKd + (16 * jt + c) * 136 + 32 * ks + 8 * g);
        accA[jt] = mfma16(aq, bk, accA[jt]);
      }
    }
#pragma unroll
    for (int jt = 0; jt < 4; ++jt)
#pragma unroll
      for (int j = 0; j < 4; ++j) {
        const int i = 16 * w + 4 * g + j, jj = 16 * jt + c;
        const bool keep = (dir == 0) ? (jj <= i) : (jj > i);
        sA[dir * 64 * 72 + i * 72 + jj] = f2bf(keep ? accA[jt][j] : 0.f);
      }
    __syncthreads();
  }
  bf16x8 af[2][2];
#pragma unroll
  for (int dir = 0; dir < 2; ++dir)
#pragma unroll
    for (int k2 = 0; k2 < 2; ++k2) af[dir][k2] = *(const bf16x8*)(sA + dir * 64 * 72 + (16 * w + c) * 72 + 32 * k2 + 8 * g);
#pragma unroll 4
  for (int vt = 0; vt < 16; ++vt) {
    f32x4 a = zero4();
#pragma unroll
    for (int k2 = 0; k2 < 2; ++k2) {
      bf16x8 vfr = *(const bf16x8*)(p.VtE + (size_t)(h * 256 + 16 * vt + c) * T_TOK + tokc + 32 * k2 + 8 * g);
      a = mfma16(af[0][k2], vfr, a);
      a = mfma16(af[1][k2], vfr, a);
    }
#pragma unroll
    for (int j = 0; j < 4; ++j) p.TMP[(size_t)(tokc + 16 * w + 4 * g + j) * 1024 + h * 256 + 16 * vt + c] = f2bf(a[j]);
  }
}

__device__ __forceinline__ void lds_barrier() { asm volatile("s_waitcnt lgkmcnt(0)\n\ts_barrier" ::: "memory"); }

struct GlaRegs {
  bf16x8 aq[4];
  bf16x8 vf[2][2];
  bf16x8 kf[2][2];
  float eb[2];
  unsigned told[2][4];
};

template <int DIR>
__device__ __forceinline__ void gla_chain_load(const Params& p, int h, int sl, int tokc, int w, int c, int g, GlaRegs& r) {
  const bf16_t* QE = DIR ? p.QEb : p.Qb;
  const bf16_t* KdT = DIR ? p.KdTb : p.Kt;
#pragma unroll
  for (int ks = 0; ks < 4; ++ks) r.aq[ks] = *(const bf16x8*)(QE + (size_t)(tokc + 16 * w + c) * 512 + h * 128 + 32 * ks + 8 * g);
#pragma unroll
  for (int vt = 0; vt < 2; ++vt)
#pragma unroll
    for (int k2 = 0; k2 < 2; ++k2)
      r.vf[vt][k2] = *(const bf16x8*)(p.VtE + (size_t)(h * 256 + sl * 32 + 16 * vt + c) * T_TOK + tokc + 32 * k2 + 8 * g);
#pragma unroll
  for (int dt = 0; dt < 2; ++dt) {
#pragma unroll
    for (int k2 = 0; k2 < 2; ++k2)
      r.kf[dt][k2] = *(const bf16x8*)(KdT + (size_t)(h * 128 + 32 * w + 16 * dt + c) * T_TOK + tokc + 32 * k2 + 8 * g);
    r.eb[dt] = p.EB[(size_t)(DIR * 1280 + (tokc >> 6)) * 512 + h * 128 + 32 * w + 16 * dt + c];
  }
#pragma unroll
  for (int vt = 0; vt < 2; ++vt)
#pragma unroll
    for (int j = 0; j < 4; ++j) r.told[vt][j] = p.TMP[(size_t)(tokc + 16 * w + 4 * g + j) * 1024 + h * 256 + sl * 32 + 16 * vt + c];
}

__device__ __forceinline__ void gla_chain_compute(const Params& p, int h, int sl, int tokc, int w, int c, int g, const GlaRegs& r,
                                                  f32x4 (&S)[2][2], bf16_t* sSt, bool dry, bool reload) {
  unsigned told[2][4];
#pragma unroll
  for (int vt = 0; vt < 2; ++vt)
#pragma unroll
    for (int j = 0; j < 4; ++j) told[vt][j] = r.told[vt][j];
  if (reload) {
#pragma unroll
    for (int vt = 0; vt < 2; ++vt)
#pragma unroll
      for (int j = 0; j < 4; ++j) told[vt][j] = p.TMP[(size_t)(tokc + 16 * w + 4 * g + j) * 1024 + h * 256 + sl * 32 + 16 * vt + c];
  }
#pragma unroll
  for (int vt = 0; vt < 2; ++vt)
#pragma unroll
    for (int dt = 0; dt < 2; ++dt)
#pragma unroll
      for (int j = 0; j < 4; ++j) sSt[(16 * vt + 4 * g + j) * 136 + 32 * w + 16 * dt + c] = f2bf(S[vt][dt][j]);
  lds_barrier();
  f32x4 o[2];
  o[0] = zero4(); o[1] = zero4();
#pragma unroll
  for (int ks = 0; ks < 4; ++ks)
#pragma unroll
    for (int vt = 0; vt < 2; ++vt) {
      bf16x8 sf = *(const bf16x8*)(sSt + (16 * vt + c) * 136 + 32 * ks + 8 * g);
      o[vt] = mfma16(r.aq[ks], sf, o[vt]);
    }
#pragma unroll
  for (int dt = 0; dt < 2; ++dt)
#pragma unroll
    for (int vt = 0; vt < 2; ++vt) {
      f32x4 a = S[vt][dt];
#pragma unroll
      for (int k2 = 0; k2 < 2; ++k2) a = mfma16(r.vf[vt][k2], r.kf[dt][k2], a);
      S[vt][dt] = a * r.eb[dt];
    }
#pragma unroll
  for (int vt = 0; vt < 2; ++vt)
#pragma unroll
    for (int j = 0; j < 4; ++j)
      if (!dry) p.TMP[(size_t)(tokc + 16 * w + 4 * g + j) * 1024 + h * 256 + sl * 32 + 16 * vt + c] = f2bf(bf2f((bf16_t)told[vt][j]) + o[vt][j]);
}

__device__ void gla_chain_item(const Params& p, int li, int item, char* smem, bool dry = false) {
  const int tid = otid(), lane = tid & 63, w = tid >> 6, c = lane & 15, g = lane >> 4;
  int s, rem;
  if (item < 256) { s = 4 + item / 32; rem = item % 32; } else { s = (item - 256) / 32; rem = (item - 256) % 32; }
  const int h = rem >> 3, sl = rem & 7;
  const int tok0 = s < 4 ? s * 4096 : T_P + (s - 4) * 8192;
  const int len = s < 4 ? 4096 : 8192;
  const int N = len / 64;
  bf16_t* sSt0 = (bf16_t*)smem;
  bf16_t* sSt1 = sSt0 + 32 * 136;
  f32x4 Sf[2][2], Sb[2][2];
#pragma unroll
  for (int a = 0; a < 2; ++a)
#pragma unroll
    for (int b = 0; b < 2; ++b) { Sf[a][b] = zero4(); Sb[a][b] = zero4(); }
  GlaRegs rf, rb;
  __syncthreads();
  gla_chain_load<0>(p, h, sl, tok0, w, c, g, rf);
  for (int step = 0; step < N; ++step) {
    const int tf = tok0 + step * 64, tb = tok0 + (N - 1 - step) * 64;
    gla_chain_load<1>(p, h, sl, tb, w, c, g, rb);
    gla_chain_compute(p, h, sl, tf, w, c, g, rf, Sf, sSt0, dry, step == (N >> 1));
    if (step + 1 < N) gla_chain_load<0>(p, h, sl, tf + 64, w, c, g, rf);
    gla_chain_compute(p, h, sl, tb, w, c, g, rb, Sb, sSt1, dry, false);
  }
}

__device__ void pool_item(const Params& p, int li, int item, char* smem, bool dry = false) {
  const int tid = otid(), lane = tid & 63, w = tid >> 6, c = lane & 15, g = lane >> 4;
  const int gi = item & 3;
  const int tile = item >> 2;
  const int tokc = tile * 64;
  const int pos0 = seq_pos(tokc);
  const int len = tokc < T_P ? 4096 : 8192;
  float* sU = (float*)smem;
  bf16_t* sP = (bf16_t*)(sU + 80 * 128);
  __syncthreads();
  for (int idx = tid; idx < 80 * 128; idx += 256) {
    int r = idx >> 7, ch = idx & 127;
    int pos = pos0 - 8 + r;
    float v = 0.f;
    if (pos >= 0 && pos < len) v = bf2f(p.PUb[(long)(tokc - 8 + r) * 512 + gi * 128 + ch]);
    sU[idx] = v;
  }
  __syncthreads();
  {
    const int ch = tid & 127, th = tid >> 7;
    const int half = 1 << gi;
    for (int t = th * 32; t < th * 32 + 32; ++t) {
      int pos = pos0 + t;
      int lo = max(pos - half, 0), hi = min(pos + half, len);
      float s = 0.f;
      for (int q = lo; q < hi; ++q) s += sU[(q - pos0 + 8) * 128 + ch];
      float pooled = s / (float)(hi - lo) - sU[(t + 8) * 128 + ch];
      sP[t * 136 + ch] = f2bf(pooled);
    }
  }
  __syncthreads();
  f32x4 acc[8];
#pragma unroll
  for (int dt = 0; dt < 8; ++dt) acc[dt] = zero4();
  const bf16_t* PW = p.PoolWT + (long)(li * 4 + gi) * 128 * 128;
#pragma unroll
  for (int ks = 0; ks < 4; ++ks) {
    bf16x8 af = *(const bf16x8*)(sP + (16 * w + c) * 136 + 32 * ks + 8 * g);
#pragma unroll
    for (int dt = 0; dt < 8; ++dt) {
      bf16x8 bw = *(const bf16x8*)(PW + (long)(16 * dt + c) * 128 + 32 * ks + 8 * g);
      acc[dt] = mfma16(af, bw, acc[dt]);
    }
  }
#pragma unroll
  for (int dt = 0; dt < 8; ++dt) {
    const int d = gi * 128 + 16 * dt + c;
    const float sc = p.e_pool_scale[li * 512 + d];
#pragma unroll
    for (int j = 0; j < 4; ++j) {
      const long addr = (long)(tokc + 16 * w + 4 * g + j) * 512 + d;
      float gt = bf2f(p.PGb[addr]);
      if (!dry) p.PGb[addr] = f2bf(acc[dt][j] * sc * siluf_(gt));
    }
  }
}

__device__ void ml_intra_item(const Params& p, int li, int item, char* smem) {
  const int tid = otid(), lane = tid & 63, w = tid >> 6, c = lane & 15, g = lane >> 4;
  const int ci = item >> 2, h = item & 3;
  const int tokc = ci * 64;
  const float kscale = 0.08838834764831845f;
  bf16_t* sA = (bf16_t*)smem;
  float* sBv = (float*)(sA + 2 * 64 * 72);
  float* sCB = sBv + 128;
  __syncthreads();
  if (w < 2) {
    const int dir = w;
    const float bi = p.o_if_bias[li * 16 + dir * 4 + h];
    const float bff = p.o_if_bias[li * 16 + 8 + dir * 4 + h];
    const float* mf = p.MIF + (size_t)(tokc + lane) * 16;
    const float liv = mf[dir * 4 + h] + bi;
    const float lfv = logsig_fast(mf[8 + dir * 4 + h] + bff);
    float ps = lfv;
#pragma unroll
    for (int d = 1; d < 64; d <<= 1) {
      float t = __shfl_up(ps, d);
      if (lane >= d) ps += t;
    }
    const float total = __int_as_float(__builtin_amdgcn_readlane(__float_as_int(ps), 63));
    const float b = (dir == 0) ? ps : (total - ps + lfv);
    const float cB = liv - b;
    sBv[dir * 64 + lane] = b;
    sCB[dir * 64 + lane] = cB;
    const size_t so = (size_t)(dir * 4 + h) * T_TOK + tokc + lane;
    p.EBI[so] = __expf(b);
    p.WKg[so] = __expf(total + cB) * kscale;
    if (lane == 0) p.DEC[(dir * 4 + h) * 1280 + ci] = __expf(total);
  }
  f32x4 accA[4];
#pragma unroll
  for (int jt = 0; jt < 4; ++jt) accA[jt] = zero4();
#pragma unroll
  for (int ks = 0; ks < 4; ++ks) {
    bf16x8 aq = *(const bf16x8*)(p.MQb + (size_t)(tokc + 16 * w + c) * 512 + h * 128 + 32 * ks + 8 * g);
#pragma unroll
    for (int jt = 0; jt < 4; ++jt) {
      bf16x8 bk = *(const bf16x8*)(p.MKb + (size_t)(tokc + 16 * jt + c) * 512 + h * 128 + 32 * ks + 8 * g);
      accA[jt] = mfma16(aq, bk, accA[jt]);
    }
  }
  __syncthreads();
#pragma unroll
  for (int dir = 0; dir < 2; ++dir)
#pragma unroll
    for (int jt = 0; jt < 4; ++jt)
#pragma unroll
      for (int j = 0; j < 4; ++j) {
        const int i = 16 * w + 4 * g + j, jj = 16 * jt + c;
        const bool keep = (dir == 0) ? (jj <= i) : (jj > i);
        const float sv = keep ? accA[jt][j] * kscale * __expf(sBv[dir * 64 + i] + sCB[dir * 64 + jj]) : 0.f;
        sA[dir * 64 * 72 + i * 72 + jj] = f2bf(sv);
      }
  __syncthreads();
  bf16x8 ones = zero8();
  if (c == 0) {
#pragma unroll
    for (int e = 0; e < 8; ++e) ones[e] = (short)0x3F80;
  }
#pragma unroll
  for (int dir = 0; dir < 2; ++dir) {
    bf16_t* NUMI = dir ? p.NUMIb : p.NUMIf;
    bf16x8 af[2];
#pragma unroll
    for (int k2 = 0; k2 < 2; ++k2) af[k2] = *(const bf16x8*)(sA + dir * 64 * 72 + (16 * w + c) * 72 + 32 * k2 + 8 * g);
    f32x4 dn = zero4();
    dn = mfma16(af[0], ones, dn);
    dn = mfma16(af[1], ones, dn);
    if (c == 0) {
#pragma unroll
      for (int j = 0; j < 4; ++j) p.DENI[(size_t)(dir * 4 + h) * T_TOK + tokc + 16 * w + 4 * g + j] = dn[j];
    }
#pragma unroll 4
    for (int vt = 0; vt < 8; ++vt) {
      f32x4 a = zero4();
#pragma unroll
      for (int k2 = 0; k2 < 2; ++k2) {
        bf16x8 vfr = *(const bf16x8*)(p.MVt + (size_t)(h * 128 + 16 * vt + c) * T_TOK + tokc + 32 * k2 + 8 * g);
        a = mfma16(af[k2], vfr, a);
      }
#pragma unroll
      for (int j = 0; j < 4; ++j) NUMI[(size_t)(tokc + 16 * w + 4 * g + j) * 512 + h * 128 + 16 * vt + c] = f2bf(a[j]);
    }
  }
}

struct MlRegs {
  bf16x8 aq[4];
  bf16x8 vf[2];
  bf16x8 kf[2][2];
  f32x4 wk[2][2];
  f32x4 ebi, deni;
  float dec;
  unsigned numi[4];
};

template <int DIR>
__device__ __forceinline__ void ml_chain_load(const Params& p, int h, int sl, int tokc, int w, int c, int g, MlRegs& r) {
#pragma unroll
  for (int ks = 0; ks < 4; ++ks) r.aq[ks] = *(const bf16x8*)(p.MQb + (size_t)(tokc + 16 * w + c) * 512 + h * 128 + 32 * ks + 8 * g);
#pragma unroll
  for (int k2 = 0; k2 < 2; ++k2)
    r.vf[k2] = *(const bf16x8*)(p.MVt + (size_t)(h * 128 + sl * 16 + c) * T_TOK + tokc + 32 * k2 + 8 * g);
#pragma unroll
  for (int dt = 0; dt < 2; ++dt)
#pragma unroll
    for (int k2 = 0; k2 < 2; ++k2)
      r.kf[dt][k2] = *(const bf16x8*)(p.MKt + (size_t)(h * 128 + 32 * w + 16 * dt + c) * T_TOK + tokc + 32 * k2 + 8 * g);
  const size_t so = (size_t)(DIR * 4 + h) * T_TOK + tokc;
#pragma unroll
  for (int k2 = 0; k2 < 2; ++k2) {
    r.wk[k2][0] = *(const f32x4*)(p.WKg + so + 32 * k2 + 8 * g);
    r.wk[k2][1] = *(const f32x4*)(p.WKg + so + 32 * k2 + 8 * g + 4);
  }
  r.ebi = *(const f32x4*)(p.EBI + so + 16 * w + 4 * g);
  r.deni = *(const f32x4*)(p.DENI + so + 16 * w + 4 * g);
  r.dec = p.DEC[(DIR * 4 + h) * 1280 + (tokc >> 6)];
  const bf16_t* NUMI = DIR ? p.NUMIb : p.NUMIf;
#pragma unroll
  for (int j = 0; j < 4; ++j) r.numi[j] = NUMI[(size_t)(tokc + 16 * w + 4 * g + j) * 512 + h * 128 + sl * 16 + c];
}

template <int DIR>
__device__ __forceinline__ void ml_chain_compute(const Params& p, int h, int sl, int tokc, int lane, int w, int c, int g, const MlRegs& r,
                                                 f32x4 (&C)[2][2], bf16_t* sCt, bool dry) {
  bf16_t* NUMI = DIR ? p.NUMIb : p.NUMIf;
  unsigned numi[4];
#pragma unroll
  for (int j = 0; j < 4; ++j) numi[j] = r.numi[j];
#pragma unroll
  for (int vt = 0; vt < 2; ++vt)
#pragma unroll
    for (int dt = 0; dt < 2; ++dt)
#pragma unroll
      for (int j = 0; j < 4; ++j) sCt[(16 * vt + 4 * g + j) * 136 + 32 * w + 16 * dt + c] = f2bf(C[vt][dt][j]);
  bf16x8 vfw[2][2];
#pragma unroll
  for (int k2 = 0; k2 < 2; ++k2) {
    float wv[8];
#pragma unroll
    for (int e = 0; e < 4; ++e) { wv[e] = r.wk[k2][0][e]; wv[4 + e] = r.wk[k2][1][e]; }
#pragma unroll
    for (int e = 0; e < 8; ++e) vfw[0][k2][e] = (short)f2bf(bf2f((bf16_t)r.vf[k2][e]) * wv[e]);
#pragma unroll
    for (int e = 0; e < 8; ++e) vfw[1][k2][e] = (c == 0) ? (short)f2bf(wv[e]) : (short)0;
  }
  lds_barrier();
  f32x4 o2[2];
  o2[0] = zero4(); o2[1] = zero4();
#pragma unroll
  for (int ks = 0; ks < 4; ++ks)
#pragma unroll
    for (int vt = 0; vt < 2; ++vt) {
      bf16x8 cf = *(const bf16x8*)(sCt + (16 * vt + c) * 136 + 32 * ks + 8 * g);
      o2[vt] = mfma16(r.aq[ks], cf, o2[vt]);
    }
#pragma unroll
  for (int dt = 0; dt < 2; ++dt)
#pragma unroll
    for (int vt = 0; vt < 2; ++vt) {
      f32x4 a = C[vt][dt] * r.dec;
#pragma unroll
      for (int k2 = 0; k2 < 2; ++k2) a = mfma16(vfw[vt][k2], r.kf[dt][k2], a);
      C[vt][dt] = a;
    }
#pragma unroll
  for (int j = 0; j < 4; ++j) {
    const float e = r.ebi[j];
    float den = e * o2[1][j];
    den = __shfl(den, lane & 48) + r.deni[j];
    const float inv = 1.f / fmaxf(fabsf(den), 1.f);
    const float hv = (bf2f((bf16_t)numi[j]) + e * o2[0][j]) * inv;
    if (!dry) NUMI[(size_t)(tokc + 16 * w + 4 * g + j) * 512 + h * 128 + sl * 16 + c] = f2bf(hv);
  }
}

__device__ void ml_chain_item(const Params& p, int li, int item, char* smem, bool dry = false) {
  const int tid = otid(), lane = tid & 63, w = tid >> 6, c = lane & 15, g = lane >> 4;
  int s, rem;
  if (item < 256) { s = 4 + item / 32; rem = item % 32; } else { s = (item - 256) / 32; rem = (item - 256) % 32; }
  const int h = rem >> 3, sl = rem & 7;
  const int tok0 = s < 4 ? s * 4096 : T_P + (s - 4) * 8192;
  const int len = s < 4 ? 4096 : 8192;
  const int N = len / 64;
  bf16_t* sCt0 = (bf16_t*)smem;
  bf16_t* sCt1 = sCt0 + 32 * 136;
  f32x4 Cf[2][2], Cb[2][2];
#pragma unroll
  for (int a = 0; a < 2; ++a)
#pragma unroll
    for (int b = 0; b < 2; ++b) { Cf[a][b] = zero4(); Cb[a][b] = zero4(); }
  MlRegs rf, rb;
  __syncthreads();
  ml_chain_load<0>(p, h, sl, tok0, w, c, g, rf);
  for (int step = 0; step < N; ++step) {
    const int tf = tok0 + step * 64, tb = tok0 + (N - 1 - step) * 64;
    ml_chain_load<1>(p, h, sl, tb, w, c, g, rb);
    ml_chain_compute<0>(p, h, sl, tf, lane, w, c, g, rf, Cf, sCt0, dry);
    if (step + 1 < N) ml_chain_load<0>(p, h, sl, tf + 64, w, c, g, rf);
    ml_chain_compute<1>(p, h, sl, tb, lane, w, c, g, rb, Cb, sCt1, dry);
  }
}

#define ATTN_GLOAD(KT)                                                                              \
  {                                                                                                 \
    const long kb = tok0 + (KT) * 64;                                                               \
    rk0 = *(const bf16x8*)(p.KNb + (kb + (tid >> 3)) * 512 + head * 64 + 8 * (tid & 7));            \
    rk1 = *(const bf16x8*)(p.KNb + (kb + 32 + (tid >> 3)) * 512 + head * 64 + 8 * (tid & 7));       \
    rkr = *(const bf16x8*)(p.KRb + (kb + (tid >> 2)) * 32 + 8 * (tid & 3));                          \
    rv0 = *(const bf16x8*)(p.VtA + (long)(head * 64 + (tid >> 3)) * T_TOK + kb + 8 * (tid & 7));     \
    rv1 = *(const bf16x8*)(p.VtA + (long)(head * 64 + 32 + (tid >> 3)) * T_TOK + kb + 8 * (tid & 7)); \
  }
__device__ void attn_item(const Params& p, int item, char* smem, bool dry = false) {
  const int tid = otid(), lane = tid & 63, w = tid >> 6, c = lane & 15, g = lane >> 4;
  int s, head, qb;
  if (item < 4096) { s = 4 + item / 512; int rem = item % 512; head = rem / 64; qb = rem % 64; }
  else { int it = item - 4096; s = it / 256; int rem = it % 256; head = rem / 32; qb = rem % 32; }
  const int tok0 = s < 4 ? s * 4096 : T_P + (s - 4) * 8192;
  const int len = s < 4 ? 4096 : 8192;
  const int nkv = len / 64;
  bf16_t* sK = (bf16_t*)smem;
  bf16_t* sVt = sK + 64 * 104;
  const int qrow0 = tok0 + qb * 128 + 32 * w;
  bf16x8 qf[2][3];
#pragma unroll
  for (int nt = 0; nt < 2; ++nt)
#pragma unroll
    for (int ks = 0; ks < 3; ++ks)
      qf[nt][ks] = *(const bf16x8*)(p.Qa + (long)(qrow0 + 16 * nt + c) * 768 + head * 96 + 32 * ks + 8 * g);
  f32x4 ot[4][2];
#pragma unroll
  for (int vt = 0; vt < 4; ++vt) { ot[vt][0] = zero4(); ot[vt][1] = zero4(); }
  float mrun[2] = {-1e30f, -1e30f}, lrun[2] = {0.f, 0.f};
  bf16x8 rk0, rk1, rkr, rv0, rv1;
  ATTN_GLOAD(0)
  for (int kt = 0; kt < nkv; ++kt) {
    __syncthreads();
    *(bf16x8*)(sK + (tid >> 3) * 104 + 8 * (tid & 7)) = rk0;
    *(bf16x8*)(sK + (32 + (tid >> 3)) * 104 + 8 * (tid & 7)) = rk1;
    *(bf16x8*)(sK + (tid >> 2) * 104 + 64 + 8 * (tid & 3)) = rkr;
    *(bf16x8*)(sVt + (tid >> 3) * 72 + 8 * (tid & 7)) = rv0;
    *(bf16x8*)(sVt + (32 + (tid >> 3)) * 72 + 8 * (tid & 7)) = rv1;
    __syncthreads();
    if (kt + 1 < nkv) ATTN_GLOAD(kt + 1)
    f32x4 st[4][2];
#pragma unroll
    for (int k4 = 0; k4 < 4; ++k4) { st[k4][0] = zero4(); st[k4][1] = zero4(); }
#pragma unroll
    for (int ks = 0; ks < 3; ++ks)
#pragma unroll
      for (int k4 = 0; k4 < 4; ++k4) {
        bf16x8 kf = *(const bf16x8*)(sK + (16 * k4 + c) * 104 + 32 * ks + 8 * g);
        st[k4][0] = mfma16(kf, qf[0][ks], st[k4][0]);
        st[k4][1] = mfma16(kf, qf[1][ks], st[k4][1]);
      }
#pragma unroll
    for (int nt = 0; nt < 2; ++nt) {
      float mx = -1e30f;
#pragma unroll
      for (int k4 = 0; k4 < 4; ++k4)
#pragma unroll
        for (int j = 0; j < 4; ++j) mx = fmaxf(mx, st[k4][nt][j]);
      mx = fmaxf(mx, __shfl_xor(mx, 16));
      mx = fmaxf(mx, __shfl_xor(mx, 32));
      const float mn = fmaxf(mrun[nt], mx);
      const float alpha = __builtin_amdgcn_exp2f(mrun[nt] - mn);
      mrun[nt] = mn;
      float psum = 0.f;
#pragma unroll
      for (int k4 = 0; k4 < 4; ++k4)
#pragma unroll
        for (int j = 0; j < 4; ++j) {
          float pv = __builtin_amdgcn_exp2f(st[k4][nt][j] - mn);
          st[k4][nt][j] = pv;
          psum += pv;
        }
      lrun[nt] = lrun[nt] * alpha + psum;
#pragma unroll
      for (int vt = 0; vt < 4; ++vt) ot[vt][nt] = ot[vt][nt] * alpha;
    }
#pragma unroll
    for (int k2 = 0; k2 < 2; ++k2) {
      bf16x8 pb[2];
#pragma unroll
      for (int nt = 0; nt < 2; ++nt) {
        typedef __attribute__((ext_vector_type(4))) unsigned u32x4;
        u32x4 pk;
        pk[0] = pk2bf(st[2 * k2][nt][0], st[2 * k2][nt][1]);
        pk[1] = pk2bf(st[2 * k2][nt][2], st[2 * k2][nt][3]);
        pk[2] = pk2bf(st[2 * k2 + 1][nt][0], st[2 * k2 + 1][nt][1]);
        pk[3] = pk2bf(st[2 * k2 + 1][nt][2], st[2 * k2 + 1][nt][3]);
        pb[nt] = __builtin_bit_cast(bf16x8, pk);
      }
#pragma unroll
      for (int vt = 0; vt < 4; ++vt) {
        us4 lo = *(const us4*)(sVt + (16 * vt + c) * 72 + 32 * k2 + 4 * g);
        us4 hi = *(const us4*)(sVt + (16 * vt + c) * 72 + 32 * k2 + 16 + 4 * g);
        bf16x8 av;
#pragma unroll
        for (int e = 0; e < 4; ++e) { av[e] = (short)lo[e]; av[4 + e] = (short)hi[e]; }
        ot[vt][0] = mfma16(av, pb[0], ot[vt][0]);
        ot[vt][1] = mfma16(av, pb[1], ot[vt][1]);
      }
    }
  }
#pragma unroll
  for (int nt = 0; nt < 2; ++nt) {
    float lt = lrun[nt];
    lt += __shfl_xor(lt, 16);
    lt += __shfl_xor(lt, 32);
    const float inv = 1.f / lt;
    const long tok = qrow0 + 16 * nt + c;
#pragma unroll
    for (int vt = 0; vt < 4; ++vt) {
      bf16_t* gp = p.MGb + tok * 512 + head * 64 + 16 * vt + 4 * g;
      us4 gt = *(const us4*)gp;
      us4 o;
#pragma unroll
      for (int j = 0; j < 4; ++j) o[j] = f2bf(ot[vt][nt][j] * inv * siluf_(bf2f(gt[j])));
      if (!dry) *(us4*)gp = o;
    }
  }
}

__device__ void phase_gla_combine(const Params& p, int li, bool dry = false) {
  const int tid_ = otid(); const int lane = tid_ & 63, w = tid_ >> 6;
  for (int tok = blockIdx.x * 4 + w; tok < T_TOK; tok += gridDim.x * 4) {
    const bf16_t* tp = p.TMP + (long)tok * 1024 + 16 * lane;
    bf16_t* gp = p.Gb + (long)tok * 1024 + 16 * lane;
    bf16x8 o0 = *(const bf16x8*)tp, o1 = *(const bf16x8*)(tp + 8);
    bf16x8 g0 = *(const bf16x8*)gp, g1 = *(const bf16x8*)(gp + 8);
    float ov[16], gv[16];
#pragma unroll
    for (int e = 0; e < 8; ++e) {
      ov[e] = bf2f((bf16_t)o0[e]); ov[8 + e] = bf2f((bf16_t)o1[e]);
      gv[e] = bf2f((bf16_t)g0[e]); gv[8 + e] = bf2f((bf16_t)g1[e]);
    }
    float ss = 0.f;
#pragma unroll
    for (int e = 0; e < 16; ++e) ss += ov[e] * ov[e];
    ss += __shfl_xor(ss, 1); ss += __shfl_xor(ss, 2); ss += __shfl_xor(ss, 4); ss += __shfl_xor(ss, 8);
    const float rs = rsqrtf(ss * (1.f / 256.f) + EPS);
    const float* ng = p.e_gla_norm_g + li * 256 + ((16 * lane) & 255);
    bf16x8 r0, r1;
#pragma unroll
    for (int e = 0; e < 8; ++e) {
      r0[e] = (short)f2bf(ov[e] * rs * ng[e] * siluf_(gv[e]));
      r1[e] = (short)f2bf(ov[8 + e] * rs * ng[8 + e] * siluf_(gv[8 + e]));
    }
    if (!dry) { *(bf16x8*)gp = r0;
    *(bf16x8*)(gp + 8) = r1; }
  }
}

__device__ void phase_ml_combine(const Params& p, int li, bool dry = false) {
  const int tid_ = otid(); const int lane = tid_ & 63, w = tid_ >> 6;
  for (int tok = blockIdx.x * 4 + w; tok < T_TOK; tok += gridDim.x * 4) {
    const long off = (long)tok * 512 + 8 * lane;
    bf16x8 hv = *(const bf16x8*)(p.NUMIf + off);
    bf16x8 hb = *(const bf16x8*)(p.NUMIb + off);
    bf16x8 mo = *(const bf16x8*)(p.MOb + off);
    bf16x8 mg = *(const bf16x8*)(p.MLGb + off);
    float hf[8];
    float ss = 0.f;
#pragma unroll
    for (int e = 0; e < 8; ++e) { hf[e] = bf2f((bf16_t)hv[e]) + bf2f((bf16_t)hb[e]); ss += hf[e] * hf[e]; }
    ss += __shfl_xor(ss, 1); ss += __shfl_xor(ss, 2); ss += __shfl_xor(ss, 4); ss += __shfl_xor(ss, 8);
    const float rs = rsqrtf(ss * (1.f / 128.f) + EPS);
    const float* ng = p.o_ml_norm_g + li * 128 + ((8 * lane) & 127);
    bf16x8 r;
#pragma unroll
    for (int e = 0; e < 8; ++e)
      r[e] = (short)f2bf(hf[e] * rs * ng[e] * sigmoidf_(bf2f((bf16_t)mo[e])) * siluf_(bf2f((bf16_t)mg[e])));
    if (!dry) *(bf16x8*)(p.MLGb + off) = r;
  }
}

__device__ void phase_final(const Params& p, bool dry = false) {
  const int tid_ = otid(); const int lane = tid_ & 63, w = tid_ >> 6;
  for (int tok = blockIdx.x * 4 + w; tok < T_TOK; tok += gridDim.x * 4) {
    float* xp = p.out + (long)tok * DM;
    float4 v[4];
    float ss = 0.f;
#pragma unroll
    for (int i = 0; i < 4; ++i) {
      v[i] = *(const float4*)(xp + 4 * lane + 256 * i);
      ss += v[i].x * v[i].x + v[i].y * v[i].y + v[i].z * v[i].z + v[i].w * v[i].w;
    }
#pragma unroll
    for (int d = 1; d < 64; d <<= 1) ss += __shfl_xor(ss, d);
    const float rs = rsqrtf(ss * (1.f / 1024.f) + EPS);
#pragma unroll
    for (int i = 0; i < 4; ++i) {
      float4 gq = *(const float4*)(p.final_norm_g + 4 * lane + 256 * i);
      float4 o;
      o.x = v[i].x * rs * gq.x; o.y = v[i].y * rs * gq.y; o.z = v[i].z * rs * gq.z; o.w = v[i].w * rs * gq.w;
      if (!dry) *(float4*)(xp + 4 * lane + 256 * i) = o;
    }
  }
}

__device__ void run_phase(const Params& p, int ph, char* smem) {
  if (ph == 0) { if (PH_ON(0)) phase_prep(p); return; }
  if (ph == NPHASE - 1) { if (PROBE_B) phase_final(p, true); if (PH_ON(11)) phase_final(p); return; }
  const int q = ph - 1;
  const int layer = (q < 5) ? 0 : (q < 12) ? 1 : (q < 17) ? 2 : 3;
  const int sub = (q < 5) ? q : (q < 12) ? q - 5 : (q < 17) ? q - 12 : q - 17;
  const int li = layer >> 1;
  const float* xa = (layer == 0) ? p.x_prompt : p.out;
  const float* xb = (layer == 0) ? p.x_sample : p.out + (long)T_P * DM;
  if ((layer & 1) == 0) {
    if (sub == 0) {
      EpiEvenIn e{p.Qb, p.Kt, p.VtE, p.Gb, p.LRb, p.PUb, p.PGb};
      for (int rep = 0; rep < 1 + PROBE_GEMM; ++rep)
      if (PH_ON(1)) gemm_phase<0, 8>(T_TOK / 128, NE_PAD / 256, DM, p.WinE + (long)li * NE_PAD * DM, xa, xb, nullptr, 0, 0, nullptr, 0, e, smem);
    } else if (sub == 1) {
#if PROBE_A
      for (int item = blockIdx.x; item < 5120; item += gridDim.x) gla_intra_item(p, li, item, smem, true);
#endif
#if PROBE_B
      for (int item = blockIdx.x; item < 5120; item += gridDim.x) pool_item(p, li, item, smem, true);
#endif
      for (int item = blockIdx.x; item < 5120 + 5120; item += gridDim.x) {
        if (item < 5120) { if (PH_ON(2)) gla_intra_item(p, li, item, smem); }
        else { if (PH_ON(3)) pool_item(p, li, item - 5120, smem); }
      }
    } else if (sub == 2) {
      for (int rep = PROBE_CHAIN ? 0 : 1; rep < 2; ++rep)
      for (int item = blockIdx.x; item < 384; item += gridDim.x)
        if (PH_ON(2)) gla_chain_item(p, li, item, smem, rep == 0);
    } else if (sub == 3) {
      if (PROBE_B) phase_gla_combine(p, li, true);
      if (PH_ON(4)) phase_gla_combine(p, li);
    } else {
      if (PROBE_GEMM) { EpiOut ed{xa, xb, p.out, true}; gemm_phase<1, 8>(T_TOK / 128, DM / 256, 1536, p.WoutE + (long)li * DM * 1536, nullptr, nullptr, p.Gb, 1024, 1024, p.PGb, 512, ed, smem); }
      EpiOut e{xa, xb, p.out, false};
      if (PH_ON(5)) gemm_phase<1, 8>(T_TOK / 128, DM / 256, 1536, p.WoutE + (long)li * DM * 1536, nullptr, nullptr, p.Gb, 1024, 1024, p.PGb, 512, e, smem);
    }
  } else {
    if (sub == 0) {
      EpiOddIn e{p.CQb, p.CKVb, p.KRb, p.MGb, p.MQb, p.MKb, p.MKt, p.MVt, p.MOb, p.MLGb, p.MIF};
      for (int rep = 0; rep < 1 + PROBE_GEMM; ++rep)
      if (PH_ON(6)) gemm_phase<0, 8>(T_TOK / 128, NO_PAD / 256, DM, p.WinO + (long)li * NO_PAD * DM, xa, xb, nullptr, 0, 0, nullptr, 0, e, smem);
    } else if (sub == 1) {
      for (int rep = 0; rep < 1 + PROBE_A; ++rep)
      for (int item = blockIdx.x; item < 5120; item += gridDim.x)
        if (PH_ON(8)) ml_intra_item(p, li, item, smem);
    } else if (sub == 2) {
      for (int rep = PROBE_MLCHAIN ? 0 : 1; rep < 2; ++rep)
      for (int item = blockIdx.x; item < 384; item += gridDim.x)
        if (PH_ON(8)) ml_chain_item(p, li, item, smem, rep == 0);
    } else if (sub == 3) {
      if (PROBE_B) phase_ml_combine(p, li, true);
      if (PH_ON(10)) phase_ml_combine(p, li);
    } else if (sub == 4) {
      EpiQUp eq{p.Qa};
      if (PH_ON(7)) gemm_phase<2, 4>(T_TOK / 128, 768 / 128, 384, p.QupT + (long)li * 768 * 384, nullptr, nullptr, p.CQb, 384, 384, p.CQb, 384, eq, smem);
      EpiKVUp ek{p.KNb, p.VtA};
      if (PH_ON(7)) gemm_phase<2, 4>(T_TOK / 128, 1024 / 128, 256, p.KVupT + (long)li * 1024 * 256, nullptr, nullptr, p.CKVb, 256, 256, p.CKVb, 256, ek, smem);
    } else if (sub == 5) {
      __shared__ int s_item;
      for (;;) {
        __syncthreads();
        if (threadIdx.x == 0) s_item = atomicAdd(p.counters + li, 1);
        __syncthreads();
        const int item = s_item;
        if (item >= 5120) break;
        if (PH_ON(9)) attn_item(p, item, smem);
      }
    } else {
      EpiOut e{xa, xb, p.out, false};
      if (PH_ON(5)) gemm_phase<1, 8>(T_TOK / 128, DM / 256, 1024, p.WoutO + (long)li * DM * 1024, nullptr, nullptr, p.MGb, 512, 512, p.MLGb, 512, e, smem);
    }
  }
}

__global__ void __launch_bounds__(256, 2) mega_kernel(Params p) {
  extern __shared__ __attribute__((aligned(16))) char smem[];
  cg::grid_group grid = cg::this_grid();
  __shared__ uint4 xb_words;
  if (threadIdx.x == 0) xb_words = make_uint4(0u, 0u, 0u, 0u);
  __syncthreads();
  XcdBarrier xb = xcd_barrier_post(p.bar, (volatile LAS unsigned*)&xb_words);
  for (int ph = p.ph_lo; ph < p.ph_hi; ++ph) {
    if (ph > p.ph_lo) {
      if (ph == p.ph_lo + 1) grid.sync();
      else xcd_barrier(xb);
    }
    run_phase(p, ph, smem);
  }
}

extern "C" void kernel_launch(void* const* d_in, const int* in_sizes, int n_in, void* d_out, int out_size, void* d_ws,
                              size_t ws_size, hipStream_t stream) {
  static int grid_blocks = 0;
  if (!grid_blocks) {
    int dev = 0, cus = 0, per_cu = 0;
    hipGetDevice(&dev);
    hipDeviceGetAttribute(&cus, hipDeviceAttributeMultiprocessorCount, dev);
    hipFuncSetAttribute((const void*)mega_kernel, hipFuncAttributeMaxDynamicSharedMemorySize, LDS_BYTES);
    hipOccupancyMaxActiveBlocksPerMultiprocessor(&per_cu, (const void*)mega_kernel, 256, LDS_BYTES);
    if (per_cu < 1) per_cu = 1;
    if (per_cu > 2) per_cu = 2;
    grid_blocks = cus * per_cu;
    fprintf(stderr, "kernel_launch: cus %d per_cu %d grid %d ws %zu\n", cus, per_cu, grid_blocks, ws_size);
  }
  Params p{};
  const float** pin = (const float**)&p;
  for (int i = 0; i < 19; ++i) pin[i] = (const float*)d_in[i];
  p.out = (float*)d_out;
  char* ws = (char*)d_ws;
  size_t off = 0;
  auto take = [&](size_t bytes) { char* r = ws + off; off += (bytes + 255) & ~(size_t)255; return r; };
  p.WinE = (bf16_t*)take((size_t)2 * NE_PAD * DM * 2);
  p.WinO = (bf16_t*)take((size_t)2 * NO_PAD * DM * 2);
  p.WoutE = (bf16_t*)take((size_t)2 * DM * 1536 * 2);
  p.WoutO = (bf16_t*)take((size_t)2 * DM * 1024 * 2);
  p.QupT = (bf16_t*)take((size_t)2 * 768 * 384 * 2);
  p.KVupT = (bf16_t*)take((size_t)2 * 1024 * 256 * 2);
  p.PoolWT = (bf16_t*)take((size_t)2 * 4 * 128 * 128 * 2);
  p.AupT = (bf16_t*)take((size_t)2 * 2 * 512 * 32 * 2);
  p.counters = (int*)take(256);
  p.bar = (unsigned*)take((size_t)XCD_BAR_WORDS * 4);
  const size_t act0 = off;
  const size_t T = T_TOK;
  p.Qb = (bf16_t*)take(T * 512 * 2);
  p.Kt = (bf16_t*)take(T * 512 * 2);
  p.QEb = (bf16_t*)take(T * 512 * 2);
  p.KdTb = (bf16_t*)take(T * 512 * 2);
  p.EB = (float*)take((size_t)2 * 1280 * 512 * 4);
  p.VtE = (bf16_t*)take(T * 1024 * 2);
  p.Gb = (bf16_t*)take(T * 1024 * 2);
  p.LRb = (bf16_t*)take(T * 32 * 2);
  p.PUb = (bf16_t*)take(T * 512 * 2);
  p.PGb = (bf16_t*)take(T * 512 * 2);
  p.TMP = (bf16_t*)take(T * 1024 * 2);
  const size_t even_end = off;
  off = act0;
  p.MGb = (bf16_t*)take(T * 512 * 2);
  p.MLGb = (bf16_t*)take(T * 512 * 2);
  p.CQb = (bf16_t*)take(T * 384 * 2);
  p.CKVb = (bf16_t*)take(T * 256 * 2);
  p.KRb = (bf16_t*)take(T * 32 * 2);
  const size_t r2 = off;
  p.MQb = (bf16_t*)take(T * 512 * 2);
  p.MKb = (bf16_t*)take(T * 512 * 2);
  p.MKt = (bf16_t*)take(T * 512 * 2);
  p.MVt = (bf16_t*)take(T * 512 * 2);
  p.MOb = (bf16_t*)take(T * 512 * 2);
  p.NUMIf = (bf16_t*)take(T * 512 * 2);
  p.NUMIb = (bf16_t*)take(T * 512 * 2);
  p.MIF = (float*)take(T * 16 * 4);
  p.EBI = (float*)take(T * 8 * 4);
  p.WKg = (float*)take(T * 8 * 4);
  p.DENI = (float*)take(T * 8 * 4);
  p.DEC = (float*)take((size_t)8 * 1280 * 4);
  const size_t r2_end = off;
  off = r2;
  p.Qa = (bf16_t*)take(T * 768 * 2);
  p.KNb = (bf16_t*)take(T * 512 * 2);
  p.VtA = (bf16_t*)take(T * 512 * 2);
  if (off < r2_end) off = r2_end;
  const size_t odd_end = off;
  const size_t need = even_end > odd_end ? even_end : odd_end;
  if (need > ws_size) {
    fprintf(stderr, "kernel_launch: workspace too small: need %zu have %zu\n", need, ws_size);
    return;
  }
  hipMemsetAsync(p.bar, 0, (size_t)XCD_BAR_WORDS * 4, stream);
#if SINGLE_LAUNCH
  p.ph_lo = 0;
  p.ph_hi = NPHASE;
  void* args[] = {&p};
  hipError_t e = hipLaunchCooperativeKernel((const void*)mega_kernel, dim3(grid_blocks), dim3(256), args, LDS_BYTES, stream);
  if (e != hipSuccess) fprintf(stderr, "cooperative launch failed: %s (grid %d)\n", hipGetErrorString(e), grid_blocks);
#else
  for (int ph = 0; ph < NPHASE; ++ph) {
    p.ph_lo = ph;
    p.ph_hi = ph + 1;
    hipLaunchKernelGGL(mega_kernel, dim3(grid_blocks), dim3(256), LDS_BYTES, stream, p);
  }
#endif
}
```

```cpp
#include <hip/hip_runtime.h>
#include <hip/hip_cooperative_groups.h>
#include <cstdio>
namespace cg = cooperative_groups;

#ifndef SINGLE_LAUNCH
#define SINGLE_LAUNCH 1
#endif
#ifndef PHMASK
#define PHMASK 0xFFFF
#endif
#define PH_ON(b) ((PHMASK >> (b)) & 1)
#ifndef PROBE_GEMM
#define PROBE_GEMM 0
#endif
#ifndef PROBE_ATTN
#define PROBE_ATTN 0
#endif
#ifndef PROBE_CHAIN
#define PROBE_CHAIN 0
#endif
#ifndef PROBE_A
#define PROBE_A 0
#endif
#ifndef PROBE_B
#define PROBE_B 0
#endif
#ifndef PROBE_MLCHAIN
#define PROBE_MLCHAIN 0
#endif

typedef unsigned short bf16_t;
typedef __attribute__((ext_vector_type(8))) short bf16x8;
typedef __attribute__((ext_vector_type(4))) float f32x4;
typedef __attribute__((ext_vector_type(4))) unsigned short us4;

constexpr int T_TOK = 81920;
constexpr int T_P = 16384;
constexpr int DM = 1024;
constexpr int NE = 4128, NE_PAD = 4352;
constexpr int NO = 4272, NO_PAD = 4352;
constexpr float EPS = 1e-6f;
constexpr int NPHASE = 26;
constexpr int LDS_BYTES = 72 * 1024;

struct Params {
  const float *x_prompt, *x_sample, *norm_g, *final_norm_g, *e_w_in, *e_a_up, *e_a_bias, *e_gla_norm_g,
      *e_pool_w, *e_pool_scale, *e_w_out, *o_w_in, *o_q_norm_g, *o_q_up, *o_kv_norm_g, *o_kv_up, *o_if_bias,
      *o_ml_norm_g, *o_w_out;
  float* out;
  bf16_t *WinE, *WinO, *WoutE, *WoutO, *QupT, *KVupT, *PoolWT, *AupT;
  int* counters;
  unsigned* bar;
  bf16_t *Qb, *Kt, *VtE, *Gb, *LRb, *PUb, *PGb, *TMP, *QEb, *KdTb;
  float* EB;
  bf16_t *CQb, *CKVb, *KRb, *MGb, *MQb, *MKb, *MKt, *MVt, *MOb, *MLGb, *NUMIf, *NUMIb, *Qa, *KNb, *VtA;
  float *MIF, *EBI, *WKg, *DENI, *DEC;
  int ph_lo, ph_hi;
};

typedef __bf16 hbf2 __attribute__((ext_vector_type(2)));
typedef float hf2 __attribute__((ext_vector_type(2)));
__device__ __forceinline__ bf16_t f2bf(float f) {
  __bf16 b = (__bf16)f;
  return __builtin_bit_cast(bf16_t, b);
}
__device__ __forceinline__ unsigned pk2bf(float a, float b) {
  hf2 v = {a, b};
  hbf2 r = __builtin_convertvector(v, hbf2);
  return __builtin_bit_cast(unsigned, r);
}
__device__ __forceinline__ float bf2f(bf16_t b) { return __uint_as_float(((unsigned)b) << 16); }
__device__ __forceinline__ f32x4 mfma16(bf16x8 a, bf16x8 b, f32x4 c) {
  return __builtin_amdgcn_mfma_f32_16x16x32_bf16(a, b, c, 0, 0, 0);
}
__device__ __forceinline__ float logsigmoidf_(float x) { return fminf(x, 0.f) - log1pf(__expf(-fabsf(x))); }
__device__ __forceinline__ float siluf_(float x) { return x / (1.f + __expf(-x)); }
__device__ __forceinline__ float sigmoidf_(float x) { return 1.f / (1.f + __expf(-x)); }
__device__ __forceinline__ int otid() { int t = threadIdx.x; asm volatile("" : "+v"(t)); return t; }
__device__ __forceinline__ float bperm(int srclane, float v) { return __int_as_float(__builtin_amdgcn_ds_bpermute(srclane << 2, __float_as_int(v))); }
__device__ __forceinline__ float sxor(float v, int m, int lane) { return bperm(lane ^ m, v); }
__device__ __forceinline__ bf16x8 zero8() { bf16x8 z = {0, 0, 0, 0, 0, 0, 0, 0}; return z; }
__device__ __forceinline__ f32x4 zero4() { f32x4 z = {0.f, 0.f, 0.f, 0.f}; return z; }

__device__ __forceinline__ int seq_pos(int tok) { return tok < T_P ? (tok & 4095) : ((tok - T_P) & 8191); }
__device__ __forceinline__ const float* xrow(const float* xa, const float* xb, int tok) {
  return tok < T_P ? xa + (long)tok * DM : xb + (long)(tok - T_P) * DM;
}


#define XB_TMO      128
#define XB_XCNT(j)  (256  + 64 * (j))
#define XB_XSUB(j)  (1280 + 64 * (j))
#define XB_XGEN(j)  (2304 + 64 * (j))
#define XB_TOP      3328
#define XB_TOPGEN   3392
#define XCD_BAR_WORDS 3456
#define XB_SPIN_CAP (1u << 22)
#define LAS __attribute__((address_space(3)))
__device__ __forceinline__ unsigned xb_ld(unsigned* p) { return __hip_atomic_load(p, __ATOMIC_RELAXED, __HIP_MEMORY_SCOPE_AGENT); }
__device__ __forceinline__ unsigned xb_add(unsigned* p, unsigned v) { return __hip_atomic_fetch_add(p, v, __ATOMIC_RELAXED, __HIP_MEMORY_SCOPE_AGENT); }
__device__ __forceinline__ unsigned xb_xcc_id() { return (unsigned)__builtin_amdgcn_s_getreg((3 << 11) | 20) & 0xFu; }
#define XB_SPIN(cond, bar) do { unsigned _sp = 0; while (cond) { __builtin_amdgcn_s_sleep(1); \
    if ((++_sp & 255u) == 0u) { if (xb_ld(&(bar)[XB_TMO])) break; if (_sp > XB_SPIN_CAP) { atomicAdd(&(bar)[XB_TMO], 1u); break; } } } } while (0)
struct XcdBarrier { unsigned* bar; unsigned x; volatile LAS unsigned* st; };
__device__ __forceinline__ XcdBarrier xcd_barrier_post(unsigned* bar, volatile LAS unsigned* st) {
  XcdBarrier b; b.bar = bar; b.x = xb_xcc_id(); b.st = st;
  if (threadIdx.x == 0) (void)xb_add(&bar[XB_XCNT(b.x)], 1u);
  return b;
}
__device__ __forceinline__ void xcd_barrier_complete(unsigned* bar, unsigned x, unsigned& nloc, unsigned& nx) {
  const unsigned G = gridDim.x * gridDim.y * gridDim.z;
  unsigned sum, cnt, mine, sp = 0u;
  for (;;) {
    sum = 0u; cnt = 0u; mine = 0u;
#pragma unroll
    for (unsigned j = 0; j < 16; ++j) { const unsigned cc = xb_ld(&bar[XB_XCNT(j)]); sum += cc; cnt += (cc > 0u) ? 1u : 0u; mine = (j == x) ? cc : mine; }
    if (sum == G) break;
    __builtin_amdgcn_s_sleep(1);
    if ((++sp & 255u) == 0u) { if (xb_ld(&bar[XB_TMO])) break; if (sp > XB_SPIN_CAP) { atomicAdd(&bar[XB_TMO], 1u); break; } }
  }
  nloc = mine > 0u ? mine : 1u; nx = cnt > 0u ? cnt : 1u;
}
__device__ __forceinline__ void xcd_barrier(const XcdBarrier& b) {
  asm volatile("s_waitcnt vmcnt(0)" ::: "memory");
  __syncthreads();
  if (threadIdx.x == 0) {
    unsigned* bar = b.bar;
    __builtin_amdgcn_s_waitcnt(0);
    unsigned nloc = b.st[0], nx = b.st[1];
    if (nloc == 0u) { xcd_barrier_complete(bar, b.x, nloc, nx); b.st[0] = nloc; b.st[1] = nx; }
    const unsigned old = xb_add(&bar[XB_XSUB(b.x)], 1u);
    const unsigned gen = old / nloc;
    if (old + 1u == (gen + 1u) * nloc) {
      __builtin_amdgcn_fence(__ATOMIC_RELEASE, "agent");
      asm volatile("s_waitcnt vmcnt(0)" ::: "memory");
      const unsigned og = xb_add(&bar[XB_TOP], 1u);
      const unsigned tg = og / nx;
      if (og + 1u == (tg + 1u) * nx) xb_add(&bar[XB_TOPGEN], 1u);
      else XB_SPIN(xb_ld(&bar[XB_TOPGEN]) == tg, bar);
      __builtin_amdgcn_fence(__ATOMIC_ACQUIRE, "agent");
      xb_add(&bar[XB_XGEN(b.x)], 1u);
      asm volatile("s_waitcnt vmcnt(0)" ::: "memory");
    } else {
      XB_SPIN(xb_ld(&bar[XB_XGEN(b.x)]) == gen, bar);
      __builtin_amdgcn_fence(__ATOMIC_ACQUIRE, "agent");
      asm volatile("s_waitcnt vmcnt(0)" ::: "memory");
    }
  }
  __syncthreads();
}

__device__ __forceinline__ int colmap(int mode, int n) {
  if (mode == 1) {
    if (n < 512) return 2208 + n;
    if (n < 1024) return 1696 + (n - 512);
    if (n < 1408) return n - 1024;
    if (n < 1664) return 384 + (n - 1408);
    if (n < 2176) return 672 + (n - 1664);
    if (n < 2688) return 1184 + (n - 2176);
    if (n < 3200) return 1696 + (n - 2688);
    if (n < 3712) return 2720 + (n - 3200);
    if (n < 4224) return 3248 + (n - 3712);
    if (n < 4256) return 640 + (n - 4224);
    return 3232 + (n - 4256);
  }
  if (mode == 2) {
    if (n < 512) return (n >> 6) * 96 + (n & 63);
    const int r = n - 512;
    return (r >> 5) * 96 + 64 + (r & 31);
  }
  if (mode == 3) {
    if (n < 512) return (n >> 6) * 128 + (n & 63);
    const int r = n - 512;
    return (r >> 6) * 128 + 64 + (r & 63);
  }
  return n;
}

__device__ void prep_weight(const float* __restrict__ W, int K, int N, int Npad, const float* __restrict__ gsc,
                            bf16_t* __restrict__ out, long gtid, long gsize, int mode = 0, int Nsrc_ = 0) {
  const int Nsrc = Nsrc_ ? Nsrc_ : N;
  long total = (long)Npad * K;
  for (long idx = gtid; idx < total; idx += gsize) {
    int k = (int)(idx / Npad);
    int n = (int)(idx % Npad);
    float v = 0.f;
    if (n < N) {
      v = W[(long)k * Nsrc + colmap(mode, n)];
      if (gsc) v *= gsc[k];
    }
    out[(long)n * K + k] = f2bf(v);
  }
}

__device__ void phase_prep(const Params& p) {
  long gtid = (long)blockIdx.x * 256 + otid();
  long gsize = (long)gridDim.x * 256;
  for (int l = 0; l < 2; ++l) {
    prep_weight(p.e_w_in + (long)l * DM * NE, DM, NE, NE_PAD, p.norm_g + (2 * l) * DM, p.WinE + (long)l * NE_PAD * DM, gtid, gsize);
    prep_weight(p.o_w_in + (long)l * DM * 3760, DM, NO, NO_PAD, p.norm_g + (2 * l + 1) * DM, p.WinO + (long)l * NO_PAD * DM, gtid, gsize, 1, 3760);
    prep_weight(p.e_w_out + (long)l * 1536 * DM, 1536, DM, DM, nullptr, p.WoutE + (long)l * DM * 1536, gtid, gsize);
    prep_weight(p.o_w_out + (long)l * 1024 * DM, 1024, DM, DM, nullptr, p.WoutO + (long)l * DM * 1024, gtid, gsize);
    prep_weight(p.o_q_up + (long)l * 384 * 768, 384, 768, 768, p.o_q_norm_g + l * 384, p.QupT + (long)l * 768 * 384, gtid, gsize, 2);
    prep_weight(p.o_kv_up + (long)l * 256 * 1024, 256, 1024, 1024, p.o_kv_norm_g + l * 256, p.KVupT + (long)l * 1024 * 256, gtid, gsize, 3);
    for (int gi = 0; gi < 4; ++gi)
      prep_weight(p.e_pool_w + (long)(l * 4 + gi) * 128 * 128, 128, 128, 128, nullptr, p.PoolWT + (long)(l * 4 + gi) * 128 * 128, gtid, gsize);
    for (long idx = gtid; idx < 2 * 512 * 32; idx += gsize) {
      int r = (int)(idx & 31);
      int d = (int)((idx >> 5) & 511);
      int dir = (int)(idx >> 14);
      float v = (r < 16) ? p.e_a_up[((long)(l * 2 + dir) * 16 + r) * 512 + d] : 0.f;
      p.AupT[((long)(l * 2 + dir) * 512 + d) * 32 + r] = f2bf(v);
    }
  }
  if (gtid < 16) p.counters[gtid] = 0;
}

constexpr int G_LD = 40;
constexpr int G_BUF = (128 + 256) * G_LD;

template <int AMODE, int NI, class Epi>
__device__ void gemm_phase(int Mtiles, int Ntiles, int K, const bf16_t* __restrict__ Bt, const float* xa, const float* xb,
                           const bf16_t* A1, int ld1, int K1, const bf16_t* A2, int ld2, const Epi& epi, char* smem) {
  bf16_t* sbase = (bf16_t*)smem;
  float* sR = (float*)(smem + 70144);
  const int tid = otid(), lane = tid & 63, w = tid >> 6, c = lane & 15, g = lane >> 4;
  const int wm = w >> 1, wn = w & 1;
  const int nk = K / 32;
  const int xcd = blockIdx.x & 7, lb0 = blockIdx.x >> 3, nlb = gridDim.x >> 3;
  const int mper = Mtiles >> 3;
  for (int lt = lb0; lt < mper * Ntiles; lt += nlb) {
    const int mt = xcd * mper + lt / Ntiles, nt = lt % Ntiles;
    constexpr int BN = 32 * NI;
    const int m0 = mt * 128, n0 = nt * BN;
    f32x4 acc[4][NI];
#pragma unroll
    for (int i = 0; i < 4; ++i)
#pragma unroll
      for (int j = 0; j < NI; ++j) acc[i][j] = zero4();
    float ss[4] = {0.f, 0.f, 0.f, 0.f};
    f32x4 raf[4];
    bf16x8 rab[2];
    bf16x8 rb[NI / 2];
    const float* abase_f = (m0 < T_P) ? xa + (size_t)m0 * DM : xb + (size_t)(m0 - T_P) * DM;
    const unsigned aoff_f = (unsigned)(tid >> 3) * DM + 4 * (tid & 7);
    const unsigned boff = (unsigned)(tid >> 2) * K + 8 * (tid & 3);
    const bf16_t* bbase = Bt + (size_t)n0 * K;
#define GEMM_GLOAD(KT)                                                                              \
  {                                                                                                 \
    const int k0_ = (KT) * 32;                                                                      \
    if constexpr (AMODE == 0) {                                                                     \
      _Pragma("unroll") for (int i = 0; i < 4; ++i)                                                 \
        raf[i] = *(const f32x4*)(abase_f + k0_ + aoff_f + (unsigned)(32 * i) * DM);                 \
    } else {                                                                                        \
      const bf16_t* base_;                                                                          \
      int ld_;                                                                                      \
      if (k0_ < K1) { base_ = A1 + (size_t)m0 * ld1 + k0_; ld_ = ld1; }                             \
      else { base_ = A2 + (size_t)m0 * ld2 + (k0_ - K1); ld_ = ld2; }                               \
      _Pragma("unroll") for (int i = 0; i < 2; ++i)                                                 \
        rab[i] = *(const bf16x8*)(base_ + (unsigned)((tid >> 2) + 64 * i) * ld_ + 8 * (tid & 3));   \
    }                                                                                               \
    _Pragma("unroll") for (int i = 0; i < NI / 2; ++i)                                              \
      rb[i] = *(const bf16x8*)(bbase + k0_ + boff + (unsigned)(64 * i) * K);                        \
  }
#define GEMM_LSTORE(BUF)                                                                            \
  {                                                                                                 \
    bf16_t* sA_ = sbase + (BUF) * G_BUF;                                                            \
    bf16_t* sB_ = sA_ + 128 * G_LD;                                                                 \
    if constexpr (AMODE == 0) {                                                                     \
      _Pragma("unroll") for (int i = 0; i < 4; ++i) {                                               \
        f32x4 v = raf[i];                                                                           \
        ss[i] += v[0] * v[0] + v[1] * v[1] + v[2] * v[2] + v[3] * v[3];                             \
        uint2 o;                                                                                    \
        o.x = pk2bf(v[0], v[1]);                                                                    \
        o.y = pk2bf(v[2], v[3]);                                                                    \
        *(uint2*)(sA_ + ((tid >> 3) + 32 * i) * G_LD + 4 * (tid & 7)) = o;                          \
      }                                                                                             \
    } else {                                                                                        \
      _Pragma("unroll") for (int i = 0; i < 2; ++i) {                                               \
        bf16x8 v = rab[i];                                                                          \
        if constexpr (AMODE == 2) {                                                                 \
          _Pragma("unroll") for (int e = 0; e < 8; ++e) {                                           \
            float f = bf2f((bf16_t)v[e]);                                                           \
            ss[i] += f * f;                                                                         \
          }                                                                                         \
        }                                                                                           \
        *(bf16x8*)(sA_ + ((tid >> 2) + 64 * i) * G_LD + 8 * (tid & 3)) = v;                         \
      }                                                                                             \
    }                                                                                               \
    _Pragma("unroll") for (int i = 0; i < NI / 2; ++i)                                              \
      *(bf16x8*)(sB_ + ((tid >> 2) + 64 * i) * G_LD + 8 * (tid & 3)) = rb[i];                       \
  }
    __syncthreads();
    GEMM_GLOAD(0)
    GEMM_LSTORE(0)
    __syncthreads();
    for (int kt = 0; kt < nk; ++kt) {
      if (kt + 1 < nk) GEMM_GLOAD(kt + 1)
      {
        const bf16_t* sA_ = sbase + (kt & 1) * G_BUF;
        const bf16_t* sB_ = sA_ + 128 * G_LD;
        bf16x8 af[4];
#pragma unroll
        for (int mi = 0; mi < 4; ++mi) af[mi] = *(const bf16x8*)(sA_ + (wm * 64 + mi * 16 + c) * G_LD + g * 8);
#pragma unroll
        for (int ni = 0; ni < NI; ++ni) {
          bf16x8 bfr = *(const bf16x8*)(sB_ + (wn * (16 * NI) + ni * 16 + c) * G_LD + g * 8);
#pragma unroll
          for (int mi = 0; mi < 4; ++mi) acc[mi][ni] = mfma16(af[mi], bfr, acc[mi][ni]);
        }
      }
      if (kt + 1 < nk) GEMM_LSTORE((kt + 1) & 1)
      __syncthreads();
    }
    if constexpr (AMODE == 0) {
#pragma unroll
      for (int i = 0; i < 4; ++i) {
        float sv = ss[i];
        sv += sxor(sv, 1, lane); sv += sxor(sv, 2, lane); sv += sxor(sv, 4, lane);
        if ((tid & 7) == 0) sR[(tid >> 3) + 32 * i] = rsqrtf(sv / (float)K + EPS);
      }
      __syncthreads();
    } else if constexpr (AMODE == 2) {
#pragma unroll
      for (int i = 0; i < 2; ++i) {
        float sv = ss[i];
        sv += sxor(sv, 1, lane); sv += sxor(sv, 2, lane);
        if ((tid & 3) == 0) sR[(tid >> 2) + 64 * i] = rsqrtf(sv / (float)K + EPS);
      }
      __syncthreads();
    }
    if constexpr (Epi::staged) {
      bf16_t* sT = sbase;
      const float esc = epi.scale();
      const bool tr = epi.transposed(n0);
      if (tr) {
#pragma unroll
        for (int mi = 0; mi < 4; ++mi) {
          const int row = wm * 64 + mi * 16 + 4 * g;
          const float r0 = sR[row] * esc, r1 = sR[row + 1] * esc, r2 = sR[row + 2] * esc, r3 = sR[row + 3] * esc;
#pragma unroll
          for (int ni = 0; ni < NI; ++ni) {
            uint2 o;
            o.x = pk2bf(acc[mi][ni][0] * r0, acc[mi][ni][1] * r1);
            o.y = pk2bf(acc[mi][ni][2] * r2, acc[mi][ni][3] * r3);
            *(uint2*)(sT + (wn * (16 * NI) + ni * 16 + c) * 136 + row) = o;
          }
        }
      } else {
#pragma unroll
        for (int mi = 0; mi < 4; ++mi) {
          const int row = wm * 64 + mi * 16 + 4 * g;
          const float r0 = sR[row] * esc, r1 = sR[row + 1] * esc, r2 = sR[row + 2] * esc, r3 = sR[row + 3] * esc;
#pragma unroll
          for (int ni = 0; ni < NI; ++ni) {
            bf16_t* d = sT + row * (BN + 8) + wn * (16 * NI) + ni * 16 + c;
            d[0] = f2bf(acc[mi][ni][0] * r0);
            d[BN + 8] = f2bf(acc[mi][ni][1] * r1);
            d[2 * (BN + 8)] = f2bf(acc[mi][ni][2] * r2);
            d[3 * (BN + 8)] = f2bf(acc[mi][ni][3] * r3);
          }
        }
      }
      epi.template direct<NI>(m0, n0, wm, wn, g, c, acc, sR);
      __syncthreads();
      if (tr) {
#pragma unroll 4
        for (int i = 0; i < 2 * NI; ++i) {
          const int id = tid + 256 * i;
          const int col = id >> 4, rc = id & 15;
          bf16x8 v = *(const bf16x8*)(sT + col * 136 + 8 * rc);
          epi.store_t(m0 + 8 * rc, n0 + col, v);
        }
      } else {
#pragma unroll 4
        for (int i = 0; i < 2 * NI; ++i) {
          const int id = tid + 256 * i;
          const int row = id / (4 * NI), cc = id % (4 * NI);
          const bf16_t* sp = sT + row * (BN + 8) + 8 * cc;
          bf16x8 v = *(const bf16x8*)sp;
          epi.store_n(m0 + row, n0 + 8 * cc, v, sp);
        }
      }
    } else {
      epi(m0, n0, wm, wn, g, c, acc, sR);
    }
  }
#undef GEMM_GLOAD
#undef GEMM_LSTORE
}

__device__ __forceinline__ void rope_cs(int pos, int i, float& co, float& si) {
  float inv = exp2f(-(float)i * (13.287712379549449f / 16.f));
  float ang = (float)pos * inv;
  float n = rintf(ang * 0.15915494309189535f);
  float r = fmaf(-n, 6.28125f, ang);
  r = fmaf(-n, 0.0019353071795864769f, r);
  float rf = r * 0.15915494309189535f;
  si = __builtin_amdgcn_sinf(rf);
  co = __builtin_amdgcn_cosf(rf);
}

__device__ __forceinline__ void rope_chunk(int pos, int i0, bf16x8 x1, bf16x8 x2, bf16x8& o1, bf16x8& o2) {
#pragma unroll
  for (int e = 0; e < 8; ++e) {
    float co, si;
    rope_cs(pos, i0 + e, co, si);
    float a = bf2f((bf16_t)x1[e]), b = bf2f((bf16_t)x2[e]);
    o1[e] = (short)f2bf(a * co - b * si);
    o2[e] = (short)f2bf(b * co + a * si);
  }
}

struct EpiEvenIn {
  static constexpr bool staged = true;
  bf16_t *Qb, *Kt, *VtE, *Gb, *LRb, *PUb, *PGb;
  __device__ float scale() const { return 1.f; }
  __device__ bool transposed(int n0) const { return n0 >= 512 && n0 < 2048; }
  template <int NI> __device__ void direct(int m0, int n0, int wm, int wn, int g, int c, f32x4 (&acc)[4][NI], const float* sR) const {}
  __device__ void store_t(int tok8, int col, bf16x8 v) const {
    if (col < 1024) *(bf16x8*)(Kt + (size_t)(col - 512) * T_TOK + tok8) = v;
    else *(bf16x8*)(VtE + (size_t)(col - 1024) * T_TOK + tok8) = v;
  }
  __device__ void store_n(int tok, int col, bf16x8 v, const bf16_t* sp) const {
    bf16_t* d;
    if (col < 512) d = Qb + (size_t)tok * 512 + col;
    else if (col < 3072) d = Gb + (size_t)tok * 1024 + (col - 2048);
    else if (col < 3104) d = LRb + (size_t)tok * 32 + (col - 3072);
    else if (col < 3616) d = PUb + (size_t)tok * 512 + (col - 3104);
    else if (col < 4128) d = PGb + (size_t)tok * 512 + (col - 3616);
    else return;
    *(bf16x8*)d = v;
  }
};

struct EpiOddIn {
  static constexpr bool staged = true;
  bf16_t *CQb, *CKVb, *KRb, *MGb, *MQb, *MKb, *MKt, *MVt, *MOb, *MLGb;
  float* MIF;
  __device__ float scale() const { return 1.f; }
  __device__ bool transposed(int n0) const { return n0 < 1024; }
  template <int NI> __device__ void direct(int m0, int n0, int wm, int wn, int g, int c, f32x4 (&acc)[4][NI], const float* sR) const {
    if (n0 == 4096 && wn == 1) {
#pragma unroll
      for (int mi = 0; mi < 4; ++mi)
#pragma unroll
        for (int j = 0; j < 4; ++j) {
          const int row = wm * 64 + mi * 16 + 4 * g + j;
          MIF[(size_t)(m0 + row) * 16 + c] = acc[mi][2][j] * sR[row];
        }
    }
  }
  __device__ void store_t(int tok8, int col, bf16x8 v) const {
    if (col < 512) *(bf16x8*)(MVt + (size_t)col * T_TOK + tok8) = v;
    else *(bf16x8*)(MKt + (size_t)(col - 512) * T_TOK + tok8) = v;
  }
  __device__ void store_n(int tok, int col, bf16x8 v, const bf16_t* sp) const {
    bf16_t* d;
    if (col < 1408) d = CQb + (size_t)tok * 384 + (col - 1024);
    else if (col < 1664) d = CKVb + (size_t)tok * 256 + (col - 1408);
    else if (col < 2176) d = MGb + (size_t)tok * 512 + (col - 1664);
    else if (col < 2688) d = MQb + (size_t)tok * 512 + (col - 2176);
    else if (col < 3200) d = MKb + (size_t)tok * 512 + (col - 2688);
    else if (col < 3712) d = MOb + (size_t)tok * 512 + (col - 3200);
    else if (col < 4224) d = MLGb + (size_t)tok * 512 + (col - 3712);
    else if (col < 4240) {
      bf16x8 x2 = *(const bf16x8*)(sp + 16);
      bf16x8 o1, o2;
      rope_chunk(seq_pos(tok), col - 4224, v, x2, o1, o2);
      *(bf16x8*)(KRb + (size_t)tok * 32 + (col - 4224)) = o1;
      *(bf16x8*)(KRb + (size_t)tok * 32 + 16 + (col - 4224)) = o2;
      return;
    } else return;
    *(bf16x8*)d = v;
  }
};

struct EpiQUp {
  static constexpr bool staged = true;
  bf16_t* Qa;
  __device__ float scale() const { return 0.10206207261596575f * 1.4426950408889634f; }
  __device__ bool transposed(int n0) const { return false; }
  template <int NI> __device__ void direct(int m0, int n0, int wm, int wn, int g, int c, f32x4 (&acc)[4][NI], const float* sR) const {}
  __device__ void store_t(int tok8, int col, bf16x8 v) const {}
  __device__ void store_n(int tok, int col, bf16x8 v, const bf16_t* sp) const {
    if (col < 512) {
      *(bf16x8*)(Qa + (size_t)tok * 768 + (col >> 6) * 96 + (col & 63)) = v;
    } else {
      const int r = col - 512, head = r >> 5, rr = r & 31;
      if (rr < 16) {
        bf16x8 x2 = *(const bf16x8*)(sp + 16);
        bf16x8 o1, o2;
        rope_chunk(seq_pos(tok), rr, v, x2, o1, o2);
        *(bf16x8*)(Qa + (size_t)tok * 768 + head * 96 + 64 + rr) = o1;
        *(bf16x8*)(Qa + (size_t)tok * 768 + head * 96 + 80 + rr) = o2;
      }
    }
  }
};

struct EpiKVUp {
  static constexpr bool staged = true;
  bf16_t *KNb, *VtA;
  __device__ float scale() const { return 1.f; }
  __device__ bool transposed(int n0) const { return n0 >= 512; }
  template <int NI> __device__ void direct(int m0, int n0, int wm, int wn, int g, int c, f32x4 (&acc)[4][NI], const float* sR) const {}
  __device__ void store_t(int tok8, int col, bf16x8 v) const { *(bf16x8*)(VtA + (size_t)(col - 512) * T_TOK + tok8) = v; }
  __device__ void store_n(int tok, int col, bf16x8 v, const bf16_t* sp) const { *(bf16x8*)(KNb + (size_t)tok * 512 + col) = v; }
};

struct EpiOut {
  static constexpr bool staged = false;
  const float *xa, *xb;
  float* out;
  bool dry;
  __device__ void operator()(int m0, int n0, int wm, int wn, int g, int c, f32x4 (&acc)[4][8], const float* sR) const {
#pragma unroll
    for (int ni = 0; ni < 8; ++ni) {
      __builtin_amdgcn_sched_barrier(0);
      const int col = n0 + wn * 128 + ni * 16 + c;
#pragma unroll
      for (int mi = 0; mi < 4; ++mi) {
        const int tok = m0 + wm * 64 + mi * 16 + 4 * g;
#pragma unroll
        for (int j = 0; j < 4; ++j) {
          float xo = xrow(xa, xb, tok + j)[col];
          if (!dry) out[(long)(tok + j) * DM + col] = xo + acc[mi][ni][j];
        }
      }
    }
  }
};

__device__ __forceinline__ float scan16(float v, int c, int lane) {
  float t;
  t = bperm(lane - 1, v); if (c >= 1) v += t;
  t = bperm(lane - 2, v); if (c >= 2) v += t;
  t = bperm(lane - 4, v); if (c >= 4) v += t;
  t = bperm(lane - 8, v); if (c >= 8) v += t;
  return v;
}

__device__ __forceinline__ float logsig_fast(float x) { return fminf(x, 0.f) - __logf(1.f + __expf(-fabsf(x))); }

__device__ void gla_intra_item(const Params& p, int li, int item, char* smem, bool dry = false) {
  const int tid = otid(), lane = tid & 63, w = tid >> 6, c = lane & 15, g = lane >> 4;
  const int ci = item >> 2, h = item & 3;
  const int tokc = ci * 64;
  const float qscale = 0.08838834764831845f;
  bf16_t* sQe = (bf16_t*)smem;
  bf16_t* sKd = sQe + 64 * 136;
  bf16_t* sA = sKd + 64 * 136;
  us4 q4[2][4];
  bf16_t kk[2][4][4];
#pragma unroll
  for (int dt = 0; dt < 2; ++dt)
#pragma unroll
    for (int tt = 0; tt < 4; ++tt) {
      q4[dt][tt] = *(const us4*)(p.Qb + (size_t)(tokc + 16 * tt + c) * 512 + h * 128 + 32 * w + 16 * dt + 4 * g);
#pragma unroll
      for (int j = 0; j < 4; ++j)
        kk[dt][tt][j] = p.Kt[(size_t)(h * 128 + 32 * w + 16 * dt + 4 * g + j) * T_TOK + tokc + 16 * tt + c];
    }
  __syncthreads();
#pragma unroll
  for (int dir = 0; dir < 2; ++dir) {
    bf16_t* QEd = (dir || dry) ? p.QEb : p.Qb;
    bf16_t* KdTd = (dir || dry) ? p.KdTb : p.Kt;
    bf16x8 aup[2];
    float bias[2][4];
#pragma unroll
    for (int dt = 0; dt < 2; ++dt) {
      aup[dt] = zero8();
      if (g < 2) aup[dt] = *(const bf16x8*)(p.AupT + ((size_t)(li * 2 + dir) * 512 + h * 128 + 32 * w + 16 * dt + c) * 32 + 8 * g);
#pragma unroll
      for (int j = 0; j < 4; ++j) bias[dt][j] = p.e_a_bias[(li * 2 + dir) * 512 + h * 128 + 32 * w + 16 * dt + 4 * g + j];
    }
    f32x4 la[2][4];
#pragma unroll
    for (int tt = 0; tt < 4; ++tt) {
      bf16x8 lrf = zero8();
      if (g < 2) lrf = *(const bf16x8*)(p.LRb + (size_t)(tokc + 16 * tt + c) * 32 + dir * 16 + 8 * g);
#pragma unroll
      for (int dt = 0; dt < 2; ++dt) la[dt][tt] = mfma16(aup[dt], lrf, zero4());
    }
#pragma unroll
    for (int dt = 0; dt < 2; ++dt)
#pragma unroll
      for (int tt = 0; tt < 4; ++tt)
#pragma unroll
        for (int j = 0; j < 4; ++j) la[dt][tt][j] = logsig_fast(la[dt][tt][j] + bias[dt][j]) * (1.f / 16.f);
    f32x4 P[2][4];
    float tot[2][4];
#pragma unroll
    for (int dt = 0; dt < 2; ++dt)
#pragma unroll
      for (int j = 0; j < 4; ++j) {
        float carry = 0.f;
#pragma unroll
        for (int tt = 0; tt < 4; ++tt) {
          float v = scan16(la[dt][tt][j], c, lane) + carry;
          P[dt][tt][j] = v;
          carry = bperm(lane | 15, v);
        }
        tot[dt][j] = carry;
      }
#pragma unroll
    for (int dt = 0; dt < 2; ++dt)
#pragma unroll
      for (int tt = 0; tt < 4; ++tt) {
        us4 qo, ko;
#pragma unroll
        for (int j = 0; j < 4; ++j) {
          const float b = (dir == 0) ? P[dt][tt][j] : (tot[dt][j] - P[dt][tt][j] + la[dt][tt][j]);
          qo[j] = f2bf(bf2f(q4[dt][tt][j]) * __expf(b) * qscale);
          ko[j] = f2bf(bf2f(kk[dt][tt][j]) * __expf(-b));
          KdTd[(size_t)(h * 128 + 32 * w + 16 * dt + 4 * g + j) * T_TOK + tokc + 16 * tt + c] = ko[j];
        }
        *(us4*)(QEd + (size_t)(tokc + 16 * tt + c) * 512 + h * 128 + 32 * w + 16 * dt + 4 * g) = qo;
        *(us4*)(sQe + (16 * tt + c) * 136 + 32 * w + 16 * dt + 4 * g) = qo;
        *(us4*)(sKd + (16 * tt + c) * 136 + 32 * w + 16 * dt + 4 * g) = ko;
      }
    if (c == 0) {
#pragma unroll
      for (int dt = 0; dt < 2; ++dt)
#pragma unroll
        for (int j = 0; j < 4; ++j)
          p.EB[(size_t)(dir * 1280 + ci) * 512 + h * 128 + 32 * w + 16 * dt + 4 * g + j] = __expf(tot[dt][j]);
    }
    __syncthreads();
    f32x4 accA[4];
#pragma unroll
    for (int jt = 0; jt < 4; ++jt) accA[jt] = zero4();
#pragma unroll
    for (int ks = 0; ks < 4; ++ks) {
      bf16x8 aq = *(const bf16x8*)(sQe + (16 * w + c) * 136 + 32 * ks + 8 * g);
#pragma unroll
      for (int jt = 0; jt < 4; ++jt) {
        bf16x8 bk = *(const bf16x8*)(sKd + (16 * jt + c) * 136 + 32 * ks + 8 * g);
        accA[jt] = mfma16(aq, bk, accA[jt]);
      }
    }
#pragma unroll
    for (int jt = 0; jt < 4; ++jt)
#pragma unroll
      for (int j = 0; j < 4; ++j) {
        const int i = 16 * w + 4 * g + j, jj = 16 * jt + c;
        const bool keep = (dir == 0) ? (jj <= i) : (jj > i);
        sA[dir * 64 * 72 + i * 72 + jj] = f2bf(keep ? accA[jt][j] : 0.f);
      }
    __syncthreads();
  }
  bf16x8 af[2][2];
#pragma unroll
  for (int dir = 0; dir < 2; ++dir)
#pragma unroll
    for (int k2 = 0; k2 < 2; ++k2) af[dir][k2] = *(const bf16x8*)(sA + dir * 64 * 72 + (16 * w + c) * 72 + 32 * k2 + 8 * g);
#pragma unroll 4
  for (int vt = 0; vt < 16; ++vt) {
    f32x4 a = zero4();
#pragma unroll
    for (int k2 = 0; k2 < 2; ++k2) {
      bf16x8 vfr = *(const bf16x8*)(p.VtE + (size_t)(h * 256 + 16 * vt + c) * T_TOK + tokc + 32 * k2 + 8 * g);
      a = mfma16(af[0][k2], vfr, a);
      a = mfma16(af[1][k2], vfr, a);
    }
#pragma unroll
    for (int j = 0; j < 4; ++j) p.TMP[(size_t)(tokc + 16 * w + 4 * g + j) * 1024 + h * 256 + 16 * vt + c] = f2bf(a[j]);
  }
}

__device__ __forceinline__ void lds_barrier() { asm volatile("s_waitcnt lgkmcnt(0)\n\ts_barrier" ::: "memory"); }

struct GlaRegs {
  bf16x8 aq[4];
  bf16x8 vf[2][2];
  bf16x8 kf[2][2];
  float eb[2];
  unsigned told[2][4];
};

template <int DIR>
__device__ __forceinline__ void gla_chain_load(const Params& p, int h, int sl, int tokc, int w, int c, int g, GlaRegs& r) {
  const bf16_t* QE = DIR ? p.QEb : p.Qb;
  const bf16_t* KdT = DIR ? p.KdTb : p.Kt;
#pragma unroll
  for (int ks = 0; ks < 4; ++ks) r.aq[ks] = *(const bf16x8*)(QE + (size_t)(tokc + 16 * w + c) * 512 + h * 128 + 32 * ks + 8 * g);
#pragma unroll
  for (int vt = 0; vt < 2; ++vt)
#pragma unroll
    for (int k2 = 0; k2 < 2; ++k2)
      r.vf[vt][k2] = *(const bf16x8*)(p.VtE + (size_t)(h * 256 + sl * 32 + 16 * vt + c) * T_TOK + tokc + 32 * k2 + 8 * g);
#pragma unroll
  for (int dt = 0; dt < 2; ++dt) {
#pragma unroll
    for (int k2 = 0; k2 < 2; ++k2)
      r.kf[dt][k2] = *(const bf16x8*)(KdT + (size_t)(h * 128 + 32 * w + 16 * dt + c) * T_TOK + tokc + 32 * k2 + 8 * g);
    r.eb[dt] = p.EB[(size_t)(DIR * 1280 + (tokc >> 6)) * 512 + h * 128 + 32 * w + 16 * dt + c];
  }
#pragma unroll
  for (int vt = 0; vt < 2; ++vt)
#pragma unroll
    for (int j = 0; j < 4; ++j) r.told[vt][j] = p.TMP[(size_t)(tokc + 16 * w + 4 * g + j) * 1024 + h * 256 + sl * 32 + 16 * vt + c];
}

__device__ __forceinline__ void gla_chain_compute(const Params& p, int h, int sl, int tokc, int w, int c, int g, const GlaRegs& r,
                                                  f32x4 (&S)[2][2], bf16_t* sSt, bool dry, bool reload) {
  unsigned told[2][4];
#pragma unroll
  for (int vt = 0; vt < 2; ++vt)
#pragma unroll
    for (int j = 0; j < 4; ++j) told[vt][j] = r.told[vt][j];
  if (reload) {
#pragma unroll
    for (int vt = 0; vt < 2; ++vt)
#pragma unroll
      for (int j = 0; j < 4; ++j) told[vt][j] = p.TMP[(size_t)(tokc + 16 * w + 4 * g + j) * 1024 + h * 256 + sl * 32 + 16 * vt + c];
  }
#pragma unroll
  for (int vt = 0; vt < 2; ++vt)
#pragma unroll
    for (int dt = 0; dt < 2; ++dt)
#pragma unroll
      for (int j = 0; j < 4; ++j) sSt[(16 * vt + 4 * g + j) * 136 + 32 * w + 16 * dt + c] = f2bf(S[vt][dt][j]);
  lds_barrier();
  f32x4 o[2];
  o[0] = zero4(); o[1] = zero4();
#pragma unroll
  for (int ks = 0; ks < 4; ++ks)
#pragma unroll
    for (int vt = 0; vt < 2; ++vt) {
      bf16x8 sf = *(const bf16x8*)(sSt + (16 * vt + c) * 136 + 32 * ks + 8 * g);
      o[vt] = mfma16(r.aq[ks], sf, o[vt]);
    }
#pragma unroll
  for (int dt = 0; dt < 2; ++dt)
#pragma unroll
    for (int vt = 0; vt < 2; ++vt) {
      f32x4 a = S[vt][dt];
#pragma unroll
      for (int k2 = 0; k2 < 2; ++k2) a = mfma16(r.vf[vt][k2], r.kf[dt][k2], a);
      S[vt][dt] = a * r.eb[dt];
    }
#pragma unroll
  for (int vt = 0; vt < 2; ++vt)
#pragma unroll
    for (int j = 0; j < 4; ++j)
      if (!dry) p.TMP[(size_t)(tokc + 16 * w + 4 * g + j) * 1024 + h * 256 + sl * 32 + 16 * vt + c] = f2bf(bf2f((bf16_t)told[vt][j]) + o[vt][j]);
}

__device__ void gla_chain_item(const Params& p, int li, int item, char* smem, bool dry = false) {
  const int tid = otid(), lane = tid & 63, w = tid >> 6, c = lane & 15, g = lane >> 4;
  const int xr = item >> 3;
  const int pair = (item & 7) + 8 * (xr >> 3), sl = xr & 7;
  const int s = pair < 32 ? 4 + (pair >> 2) : ((pair - 32) >> 2);
  const int h = pair & 3;
  const int tok0 = s < 4 ? s * 4096 : T_P + (s - 4) * 8192;
  const int len = s < 4 ? 4096 : 8192;
  const int N = len / 64;
  bf16_t* sSt0 = (bf16_t*)smem;
  bf16_t* sSt1 = sSt0 + 32 * 136;
  f32x4 Sf[2][2], Sb[2][2];
#pragma unroll
  for (int a = 0; a < 2; ++a)
#pragma unroll
    for (int b = 0; b < 2; ++b) { Sf[a][b] = zero4(); Sb[a][b] = zero4(); }
  GlaRegs rf, rb;
  __syncthreads();
  gla_chain_load<0>(p, h, sl, tok0, w, c, g, rf);
  for (int step = 0; step < N; ++step) {
    const int tf = tok0 + step * 64, tb = tok0 + (N - 1 - step) * 64;
    gla_chain_load<1>(p, h, sl, tb, w, c, g, rb);
    gla_chain_compute(p, h, sl, tf, w, c, g, rf, Sf, sSt0, dry, step == (N >> 1));
    if (step + 1 < N) gla_chain_load<0>(p, h, sl, tf + 64, w, c, g, rf);
    gla_chain_compute(p, h, sl, tb, w, c, g, rb, Sb, sSt1, dry, false);
  }
}

__device__ void pool_item(const Params& p, int li, int item, char* smem, bool dry = false) {
  const int tid = otid(), lane = tid & 63, w = tid >> 6, c = lane & 15, g = lane >> 4;
  const int gi = item & 3;
  const int tile = item >> 2;
  const int tokc = tile * 64;
  const int pos0 = seq_pos(tokc);
  const int len = tokc < T_P ? 4096 : 8192;
  float* sU = (float*)smem;
  bf16_t* sP = (bf16_t*)(sU + 80 * 128);
  __syncthreads();
  for (int idx = tid; idx < 80 * 128; idx += 256) {
    int r = idx >> 7, ch = idx & 127;
    int pos = pos0 - 8 + r;
    float v = 0.f;
    if (pos >= 0 && pos < len) v = bf2f(p.PUb[(long)(tokc - 8 + r) * 512 + gi * 128 + ch]);
    sU[idx] = v;
  }
  __syncthreads();
  {
    const int ch = tid & 127, th = tid >> 7;
    const int half = 1 << gi;
    for (int t = th * 32; t < th * 32 + 32; ++t) {
      int pos = pos0 + t;
      int lo = max(pos - half, 0), hi = min(pos + half, len);
      float s = 0.f;
      for (int q = lo; q < hi; ++q) s += sU[(q - pos0 + 8) * 128 + ch];
      float pooled = s / (float)(hi - lo) - sU[(t + 8) * 128 + ch];
      sP[t * 136 + ch] = f2bf(pooled);
    }
  }
  __syncthreads();
  f32x4 acc[8];
#pragma unroll
  for (int dt = 0; dt < 8; ++dt) acc[dt] = zero4();
  const bf16_t* PW = p.PoolWT + (long)(li * 4 + gi) * 128 * 128;
#pragma unroll
  for (int ks = 0; ks < 4; ++ks) {
    bf16x8 af = *(const bf16x8*)(sP + (16 * w + c) * 136 + 32 * ks + 8 * g);
#pragma unroll
    for (int dt = 0; dt < 8; ++dt) {
      bf16x8 bw = *(const bf16x8*)(PW + (long)(16 * dt + c) * 128 + 32 * ks + 8 * g);
      acc[dt] = mfma16(af, bw, acc[dt]);
    }
  }
#pragma unroll
  for (int dt = 0; dt < 8; ++dt) {
    const int d = gi * 128 + 16 * dt + c;
    const float sc = p.e_pool_scale[li * 512 + d];
#pragma unroll
    for (int j = 0; j < 4; ++j) {
      const long addr = (long)(tokc + 16 * w + 4 * g + j) * 512 + d;
      float gt = bf2f(p.PGb[addr]);
      if (!dry) p.PGb[addr] = f2bf(acc[dt][j] * sc * siluf_(gt));
    }
  }
}

__device__ void ml_intra_item(const Params& p, int li, int item, char* smem) {
  const int tid = otid(), lane = tid & 63, w = tid >> 6, c = lane & 15, g = lane >> 4;
  const int ci = item >> 2, h = item & 3;
  const int tokc = ci * 64;
  const float kscale = 0.08838834764831845f;
  bf16_t* sA = (bf16_t*)smem;
  float* sBv = (float*)(sA + 2 * 64 * 72);
  float* sCB = sBv + 128;
  __syncthreads();
  if (w < 2) {
    const int dir = w;
    const float bi = p.o_if_bias[li * 16 + dir * 4 + h];
    const float bff = p.o_if_bias[li * 16 + 8 + dir * 4 + h];
    const float* mf = p.MIF + (size_t)(tokc + lane) * 16;
    const float liv = mf[dir * 4 + h] + bi;
    const float lfv = logsig_fast(mf[8 + dir * 4 + h] + bff);
    float ps = lfv;
#pragma unroll
    for (int d = 1; d < 64; d <<= 1) {
      float t = bperm(lane - d, ps);
      if (lane >= d) ps += t;
    }
    const float total = __int_as_float(__builtin_amdgcn_readlane(__float_as_int(ps), 63));
    const float b = (dir == 0) ? ps : (total - ps + lfv);
    const float cB = liv - b;
    sBv[dir * 64 + lane] = b;
    sCB[dir * 64 + lane] = cB;
    const size_t so = (size_t)(dir * 4 + h) * T_TOK + tokc + lane;
    p.EBI[so] = __expf(b);
    p.WKg[so] = __expf(total + cB) * kscale;
    if (lane == 0) p.DEC[(dir * 4 + h) * 1280 + ci] = __expf(total);
  }
  f32x4 accA[4];
#pragma unroll
  for (int jt = 0; jt < 4; ++jt) accA[jt] = zero4();
#pragma unroll
  for (int ks = 0; ks < 4; ++ks) {
    bf16x8 aq = *(const bf16x8*)(p.MQb + (size_t)(tokc + 16 * w + c) * 512 + h * 128 + 32 * ks + 8 * g);
#pragma unroll
    for (int jt = 0; jt < 4; ++jt) {
      bf16x8 bk = *(const bf16x8*)(p.MKb + (size_t)(tokc + 16 * jt + c) * 512 + h * 128 + 32 * ks + 8 * g);
      accA[jt] = mfma16(aq, bk, accA[jt]);
    }
  }
  __syncthreads();
#pragma unroll
  for (int dir = 0; dir < 2; ++dir)
#pragma unroll
    for (int jt = 0; jt < 4; ++jt)
#pragma unroll
      for (int j = 0; j < 4; ++j) {
        const int i = 16 * w + 4 * g + j, jj = 16 * jt + c;
        const bool keep = (dir == 0) ? (jj <= i) : (jj > i);
        const float sv = keep ? accA[jt][j] * kscale * __expf(sBv[dir * 64 + i] + sCB[dir * 64 + jj]) : 0.f;
        sA[dir * 64 * 72 + i * 72 + jj] = f2bf(sv);
      }
  __syncthreads();
  bf16x8 ones = zero8();
  if (c == 0) {
#pragma unroll
    for (int e = 0; e < 8; ++e) ones[e] = (short)0x3F80;
  }
#pragma unroll
  for (int dir = 0; dir < 2; ++dir) {
    bf16_t* NUMI = dir ? p.NUMIb : p.NUMIf;
    bf16x8 af[2];
#pragma unroll
    for (int k2 = 0; k2 < 2; ++k2) af[k2] = *(const bf16x8*)(sA + dir * 64 * 72 + (16 * w + c) * 72 + 32 * k2 + 8 * g);
    f32x4 dn = zero4();
    dn = mfma16(af[0], ones, dn);
    dn = mfma16(af[1], ones, dn);
    if (c == 0) {
#pragma unroll
      for (int j = 0; j < 4; ++j) p.DENI[(size_t)(dir * 4 + h) * T_TOK + tokc + 16 * w + 4 * g + j] = dn[j];
    }
#pragma unroll 4
    for (int vt = 0; vt < 8; ++vt) {
      f32x4 a = zero4();
#pragma unroll
      for (int k2 = 0; k2 < 2; ++k2) {
        bf16x8 vfr = *(const bf16x8*)(p.MVt + (size_t)(h * 128 + 16 * vt + c) * T_TOK + tokc + 32 * k2 + 8 * g);
        a = mfma16(af[k2], vfr, a);
      }
#pragma unroll
      for (int j = 0; j < 4; ++j) NUMI[(size_t)(tokc + 16 * w + 4 * g + j) * 512 + h * 128 + 16 * vt + c] = f2bf(a[j]);
    }
  }
}

struct MlRegs {
  bf16x8 aq[4];
  bf16x8 vf[2];
  bf16x8 kf[2][2];
  f32x4 wk[2][2];
  f32x4 ebi, deni;
  float dec;
  unsigned numi[4];
};

template <int DIR>
__device__ __forceinline__ void ml_chain_load(const Params& p, int h, int sl, int tokc, int w, int c, int g, MlRegs& r) {
#pragma unroll
  for (int ks = 0; ks < 4; ++ks) r.aq[ks] = *(const bf16x8*)(p.MQb + (size_t)(tokc + 16 * w + c) * 512 + h * 128 + 32 * ks + 8 * g);
#pragma unroll
  for (int k2 = 0; k2 < 2; ++k2)
    r.vf[k2] = *(const bf16x8*)(p.MVt + (size_t)(h * 128 + sl * 16 + c) * T_TOK + tokc + 32 * k2 + 8 * g);
#pragma unroll
  for (int dt = 0; dt < 2; ++dt)
#pragma unroll
    for (int k2 = 0; k2 < 2; ++k2)
      r.kf[dt][k2] = *(const bf16x8*)(p.MKt + (size_t)(h * 128 + 32 * w + 16 * dt + c) * T_TOK + tokc + 32 * k2 + 8 * g);
  const size_t so = (size_t)(DIR * 4 + h) * T_TOK + tokc;
#pragma unroll
  for (int k2 = 0; k2 < 2; ++k2) {
    r.wk[k2][0] = *(const f32x4*)(p.WKg + so + 32 * k2 + 8 * g);
    r.wk[k2][1] = *(const f32x4*)(p.WKg + so + 32 * k2 + 8 * g + 4);
  }
  r.ebi = *(const f32x4*)(p.EBI + so + 16 * w + 4 * g);
  r.deni = *(const f32x4*)(p.DENI + so + 16 * w + 4 * g);
  r.dec = p.DEC[(DIR * 4 + h) * 1280 + (tokc >> 6)];
  const bf16_t* NUMI = DIR ? p.NUMIb : p.NUMIf;
#pragma unroll
  for (int j = 0; j < 4; ++j) r.numi[j] = NUMI[(size_t)(tokc + 16 * w + 4 * g + j) * 512 + h * 128 + sl * 16 + c];
}

template <int DIR>
__device__ __forceinline__ void ml_chain_compute(const Params& p, int h, int sl, int tokc, int lane, int w, int c, int g, const MlRegs& r,
                                                 f32x4 (&C)[2][2], bf16_t* sCt, bool dry) {
  bf16_t* NUMI = DIR ? p.NUMIb : p.NUMIf;
  unsigned numi[4];
#pragma unroll
  for (int j = 0; j < 4; ++j) numi[j] = r.numi[j];
#pragma unroll
  for (int vt = 0; vt < 2; ++vt)
#pragma unroll
    for (int dt = 0; dt < 2; ++dt)
#pragma unroll
      for (int j = 0; j < 4; ++j) sCt[(16 * vt + 4 * g + j) * 136 + 32 * w + 16 * dt + c] = f2bf(C[vt][dt][j]);
  bf16x8 vfw[2][2];
#pragma unroll
  for (int k2 = 0; k2 < 2; ++k2) {
    float wv[8];
#pragma unroll
    for (int e = 0; e < 4; ++e) { wv[e] = r.wk[k2][0][e]; wv[4 + e] = r.wk[k2][1][e]; }
#pragma unroll
    for (int e = 0; e < 8; ++e) vfw[0][k2][e] = (short)f2bf(bf2f((bf16_t)r.vf[k2][e]) * wv[e]);
#pragma unroll
    for (int e = 0; e < 8; ++e) vfw[1][k2][e] = (c == 0) ? (short)f2bf(wv[e]) : (short)0;
  }
  lds_barrier();
  f32x4 o2[2];
  o2[0] = zero4(); o2[1] = zero4();
#pragma unroll
  for (int ks = 0; ks < 4; ++ks)
#pragma unroll
    for (int vt = 0; vt < 2; ++vt) {
      bf16x8 cf = *(const bf16x8*)(sCt + (16 * vt + c) * 136 + 32 * ks + 8 * g);
      o2[vt] = mfma16(r.aq[ks], cf, o2[vt]);
    }
#pragma unroll
  for (int dt = 0; dt < 2; ++dt)
#pragma unroll
    for (int vt = 0; vt < 2; ++vt) {
      f32x4 a = C[vt][dt] * r.dec;
#pragma unroll
      for (int k2 = 0; k2 < 2; ++k2) a = mfma16(vfw[vt][k2], r.kf[dt][k2], a);
      C[vt][dt] = a;
    }
#pragma unroll
  for (int j = 0; j < 4; ++j) {
    const float e = r.ebi[j];
    float den = e * o2[1][j];
    den = bperm(lane & 48, den) + r.deni[j];
    const float inv = 1.f / fmaxf(fabsf(den), 1.f);
    const float hv = (bf2f((bf16_t)numi[j]) + e * o2[0][j]) * inv;
    if (!dry) NUMI[(size_t)(tokc + 16 * w + 4 * g + j) * 512 + h * 128 + sl * 16 + c] = f2bf(hv);
  }
}

__device__ void ml_chain_item(const Params& p, int li, int item, char* smem, bool dry = false) {
  const int tid = otid(), lane = tid & 63, w = tid >> 6, c = lane & 15, g = lane >> 4;
  const int xr = item >> 3;
  const int pair = (item & 7) + 8 * (xr >> 3), sl = xr & 7;
  const int s = pair < 32 ? 4 + (pair >> 2) : ((pair - 32) >> 2);
  const int h = pair & 3;
  const int tok0 = s < 4 ? s * 4096 : T_P + (s - 4) * 8192;
  const int len = s < 4 ? 4096 : 8192;
  const int N = len / 64;
  bf16_t* sCt0 = (bf16_t*)smem;
  bf16_t* sCt1 = sCt0 + 32 * 136;
  f32x4 Cf[2][2], Cb[2][2];
#pragma unroll
  for (int a = 0; a < 2; ++a)
#pragma unroll
    for (int b = 0; b < 2; ++b) { Cf[a][b] = zero4(); Cb[a][b] = zero4(); }
  MlRegs rf, rb;
  __syncthreads();
  ml_chain_load<0>(p, h, sl, tok0, w, c, g, rf);
  for (int step = 0; step < N; ++step) {
    const int tf = tok0 + step * 64, tb = tok0 + (N - 1 - step) * 64;
    ml_chain_load<1>(p, h, sl, tb, w, c, g, rb);
    ml_chain_compute<0>(p, h, sl, tf, lane, w, c, g, rf, Cf, sCt0, dry);
    if (step + 1 < N) ml_chain_load<0>(p, h, sl, tf + 64, w, c, g, rf);
    ml_chain_compute<1>(p, h, sl, tb, lane, w, c, g, rb, Cb, sCt1, dry);
  }
}

#define ATTN_GLOAD(KT)                                                                              \
  {                                                                                                 \
    const long kb = tok0 + (KT) * 64;                                                               \
    rk0 = *(const bf16x8*)(p.KNb + (kb + (tid >> 3)) * 512 + head * 64 + 8 * (tid & 7));            \
    rk1 = *(const bf16x8*)(p.KNb + (kb + 32 + (tid >> 3)) * 512 + head * 64 + 8 * (tid & 7));       \
    rkr = *(const bf16x8*)(p.KRb + (kb + (tid >> 2)) * 32 + 8 * (tid & 3));                          \
    rv0 = *(const bf16x8*)(p.VtA + (long)(head * 64 + (tid >> 3)) * T_TOK + kb + 8 * (tid & 7));     \
    rv1 = *(const bf16x8*)(p.VtA + (long)(head * 64 + 32 + (tid >> 3)) * T_TOK + kb + 8 * (tid & 7)); \
  }
__device__ void attn_item(const Params& p, int item, char* smem, bool dry = false) {
  const int tid = otid(), lane = tid & 63, w = tid >> 6, c = lane & 15, g = lane >> 4;
  int s, head, qb;
  if (item < 4096) { s = 4 + item / 512; int rem = item % 512; head = rem / 64; qb = rem % 64; }
  else { int it = item - 4096; s = it / 256; int rem = it % 256; head = rem / 32; qb = rem % 32; }
  const int tok0 = s < 4 ? s * 4096 : T_P + (s - 4) * 8192;
  const int len = s < 4 ? 4096 : 8192;
  const int nkv = len / 64;
  bf16_t* sK = (bf16_t*)smem;
  bf16_t* sVt = sK + 64 * 104;
  const int qrow0 = tok0 + qb * 128 + 32 * w;
  bf16x8 qf[2][3];
#pragma unroll
  for (int nt = 0; nt < 2; ++nt)
#pragma unroll
    for (int ks = 0; ks < 3; ++ks)
      qf[nt][ks] = *(const bf16x8*)(p.Qa + (long)(qrow0 + 16 * nt + c) * 768 + head * 96 + 32 * ks + 8 * g);
  f32x4 ot[4][2];
#pragma unroll
  for (int vt = 0; vt < 4; ++vt) { ot[vt][0] = zero4(); ot[vt][1] = zero4(); }
  float mrun[2] = {-1e30f, -1e30f}, lrun[2] = {0.f, 0.f};
  bf16x8 rk0, rk1, rkr, rv0, rv1;
  ATTN_GLOAD(0)
  for (int kt = 0; kt < nkv; ++kt) {
    __syncthreads();
    *(bf16x8*)(sK + (tid >> 3) * 104 + 8 * (tid & 7)) = rk0;
    *(bf16x8*)(sK + (32 + (tid >> 3)) * 104 + 8 * (tid & 7)) = rk1;
    *(bf16x8*)(sK + (tid >> 2) * 104 + 64 + 8 * (tid & 3)) = rkr;
    *(bf16x8*)(sVt + (tid >> 3) * 72 + 8 * (tid & 7)) = rv0;
    *(bf16x8*)(sVt + (32 + (tid >> 3)) * 72 + 8 * (tid & 7)) = rv1;
    __syncthreads();
    if (kt + 1 < nkv) ATTN_GLOAD(kt + 1)
    f32x4 st[4][2];
#pragma unroll
    for (int k4 = 0; k4 < 4; ++k4) { st[k4][0] = zero4(); st[k4][1] = zero4(); }
#pragma unroll
    for (int ks = 0; ks < 3; ++ks)
#pragma unroll
      for (int k4 = 0; k4 < 4; ++k4) {
        bf16x8 kf = *(const bf16x8*)(sK + (16 * k4 + c) * 104 + 32 * ks + 8 * g);
        st[k4][0] = mfma16(kf, qf[0][ks], st[k4][0]);
        st[k4][1] = mfma16(kf, qf[1][ks], st[k4][1]);
      }
#pragma unroll
    for (int nt = 0; nt < 2; ++nt) {
      float mx = -1e30f;
#pragma unroll
      for (int k4 = 0; k4 < 4; ++k4)
#pragma unroll
        for (int j = 0; j < 4; ++j) mx = fmaxf(mx, st[k4][nt][j]);
      mx = fmaxf(mx, sxor(mx, 16, lane));
      mx = fmaxf(mx, sxor(mx, 32, lane));
      const float mn = fmaxf(mrun[nt], mx);
      const float alpha = __builtin_amdgcn_exp2f(mrun[nt] - mn);
      mrun[nt] = mn;
      float psum = 0.f;
#pragma unroll
      for (int k4 = 0; k4 < 4; ++k4)
#pragma unroll
        for (int j = 0; j < 4; ++j) {
          float pv = __builtin_amdgcn_exp2f(st[k4][nt][j] - mn);
          st[k4][nt][j] = pv;
          psum += pv;
        }
      lrun[nt] = lrun[nt] * alpha + psum;
#pragma unroll
      for (int vt = 0; vt < 4; ++vt) ot[vt][nt] = ot[vt][nt] * alpha;
    }
#pragma unroll
    for (int k2 = 0; k2 < 2; ++k2) {
      bf16x8 pb[2];
#pragma unroll
      for (int nt = 0; nt < 2; ++nt) {
        typedef __attribute__((ext_vector_type(4))) unsigned u32x4;
        u32x4 pk;
        pk[0] = pk2bf(st[2 * k2][nt][0], st[2 * k2][nt][1]);
        pk[1] = pk2bf(st[2 * k2][nt][2], st[2 * k2][nt][3]);
        pk[2] = pk2bf(st[2 * k2 + 1][nt][0], st[2 * k2 + 1][nt][1]);
        pk[3] = pk2bf(st[2 * k2 + 1][nt][2], st[2 * k2 + 1][nt][3]);
        pb[nt] = __builtin_bit_cast(bf16x8, pk);
      }
#pragma unroll
      for (int vt = 0; vt < 4; ++vt) {
        us4 lo = *(const us4*)(sVt + (16 * vt + c) * 72 + 32 * k2 + 4 * g);
        us4 hi = *(const us4*)(sVt + (16 * vt + c) * 72 + 32 * k2 + 16 + 4 * g);
        bf16x8 av;
#pragma unroll
        for (int e = 0; e < 4; ++e) { av[e] = (short)lo[e]; av[4 + e] = (short)hi[e]; }
        ot[vt][0] = mfma16(av, pb[0], ot[vt][0]);
        ot[vt][1] = mfma16(av, pb[1], ot[vt][1]);
      }
    }
  }
#pragma unroll
  for (int nt = 0; nt < 2; ++nt) {
    float lt = lrun[nt];
    lt += sxor(lt, 16, lane);
    lt += sxor(lt, 32, lane);
    const float inv = 1.f / lt;
    const long tok = qrow0 + 16 * nt + c;
#pragma unroll
    for (int vt = 0; vt < 4; ++vt) {
      bf16_t* gp = p.MGb + tok * 512 + head * 64 + 16 * vt + 4 * g;
      us4 gt = *(const us4*)gp;
      us4 o;
#pragma unroll
      for (int j = 0; j < 4; ++j) o[j] = f2bf(ot[vt][nt][j] * inv * siluf_(bf2f(gt[j])));
      if (!dry) *(us4*)gp = o;
    }
  }
}

__device__ void phase_gla_combine(const Params& p, int li, bool dry = false) {
  const int tid_ = otid(); const int lane = tid_ & 63, w = tid_ >> 6;
  for (int tok = blockIdx.x * 4 + w; tok < T_TOK; tok += gridDim.x * 4) {
    const bf16_t* tp = p.TMP + (long)tok * 1024 + 16 * lane;
    bf16_t* gp = p.Gb + (long)tok * 1024 + 16 * lane;
    bf16x8 o0 = *(const bf16x8*)tp, o1 = *(const bf16x8*)(tp + 8);
    bf16x8 g0 = *(const bf16x8*)gp, g1 = *(const bf16x8*)(gp + 8);
    float ov[16], gv[16];
#pragma unroll
    for (int e = 0; e < 8; ++e) {
      ov[e] = bf2f((bf16_t)o0[e]); ov[8 + e] = bf2f((bf16_t)o1[e]);
      gv[e] = bf2f((bf16_t)g0[e]); gv[8 + e] = bf2f((bf16_t)g1[e]);
    }
    float ss = 0.f;
#pragma unroll
    for (int e = 0; e < 16; ++e) ss += ov[e] * ov[e];
    ss += sxor(ss, 1, lane); ss += sxor(ss, 2, lane); ss += sxor(ss, 4, lane); ss += sxor(ss, 8, lane);
    const float rs = rsqrtf(ss * (1.f / 256.f) + EPS);
    const float* ng = p.e_gla_norm_g + li * 256 + ((16 * lane) & 255);
    bf16x8 r0, r1;
#pragma unroll
    for (int e = 0; e < 8; ++e) {
      r0[e] = (short)f2bf(ov[e] * rs * ng[e] * siluf_(gv[e]));
      r1[e] = (short)f2bf(ov[8 + e] * rs * ng[8 + e] * siluf_(gv[8 + e]));
    }
    if (!dry) { *(bf16x8*)gp = r0;
    *(bf16x8*)(gp + 8) = r1; }
  }
}

__device__ void phase_ml_combine(const Params& p, int li, bool dry = false) {
  const int tid_ = otid(); const int lane = tid_ & 63, w = tid_ >> 6;
  for (int tok = blockIdx.x * 4 + w; tok < T_TOK; tok += gridDim.x * 4) {
    const long off = (long)tok * 512 + 8 * lane;
    bf16x8 hv = *(const bf16x8*)(p.NUMIf + off);
    bf16x8 hb = *(const bf16x8*)(p.NUMIb + off);
    bf16x8 mo = *(const bf16x8*)(p.MOb + off);
    bf16x8 mg = *(const bf16x8*)(p.MLGb + off);
    float hf[8];
    float ss = 0.f;
#pragma unroll
    for (int e = 0; e < 8; ++e) { hf[e] = bf2f((bf16_t)hv[e]) + bf2f((bf16_t)hb[e]); ss += hf[e] * hf[e]; }
    ss += sxor(ss, 1, lane); ss += sxor(ss, 2, lane); ss += sxor(ss, 4, lane); ss += sxor(ss, 8, lane);
    const float rs = rsqrtf(ss * (1.f / 128.f) + EPS);
    const float* ng = p.o_ml_norm_g + li * 128 + ((8 * lane) & 127);
    bf16x8 r;
#pragma unroll
    for (int e = 0; e < 8; ++e)
      r[e] = (short)f2bf(hf[e] * rs * ng[e] * sigmoidf_(bf2f((bf16_t)mo[e])) * siluf_(bf2f((bf16_t)mg[e])));
    if (!dry) *(bf16x8*)(p.MLGb + off) = r;
  }
}

__device__ void phase_final(const Params& p, bool dry = false) {
  const int tid_ = otid(); const int lane = tid_ & 63, w = tid_ >> 6;
  for (int tok = blockIdx.x * 4 + w; tok < T_TOK; tok += gridDim.x * 4) {
    float* xp = p.out + (long)tok * DM;
    float4 v[4];
    float ss = 0.f;
#pragma unroll
    for (int i = 0; i < 4; ++i) {
      v[i] = *(const float4*)(xp + 4 * lane + 256 * i);
      ss += v[i].x * v[i].x + v[i].y * v[i].y + v[i].z * v[i].z + v[i].w * v[i].w;
    }
#pragma unroll
    for (int d = 1; d < 64; d <<= 1) ss += sxor(ss, d, lane);
    const float rs = rsqrtf(ss * (1.f / 1024.f) + EPS);
#pragma unroll
    for (int i = 0; i < 4; ++i) {
      float4 gq = *(const float4*)(p.final_norm_g + 4 * lane + 256 * i);
      float4 o;
      o.x = v[i].x * rs * gq.x; o.y = v[i].y * rs * gq.y; o.z = v[i].z * rs * gq.z; o.w = v[i].w * rs * gq.w;
      if (!dry) *(float4*)(xp + 4 * lane + 256 * i) = o;
    }
  }
}

__device__ void run_phase(const Params& p, int ph, char* smem) {
  if (ph == 0) { if (PH_ON(0)) phase_prep(p); return; }
  if (ph == NPHASE - 1) { if (PROBE_B) phase_final(p, true); if (PH_ON(11)) phase_final(p); return; }
  const int q = ph - 1;
  const int layer = (q < 5) ? 0 : (q < 12) ? 1 : (q < 17) ? 2 : 3;
  const int sub = (q < 5) ? q : (q < 12) ? q - 5 : (q < 17) ? q - 12 : q - 17;
  const int li = layer >> 1;
  const float* xa = (layer == 0) ? p.x_prompt : p.out;
  const float* xb = (layer == 0) ? p.x_sample : p.out + (long)T_P * DM;
  if ((layer & 1) == 0) {
    if (sub == 0) {
      EpiEvenIn e{p.Qb, p.Kt, p.VtE, p.Gb, p.LRb, p.PUb, p.PGb};
      for (int rep = 0; rep < 1 + PROBE_GEMM; ++rep)
      if (PH_ON(1)) gemm_phase<0, 8>(T_TOK / 128, NE_PAD / 256, DM, p.WinE + (long)li * NE_PAD * DM, xa, xb, nullptr, 0, 0, nullptr, 0, e, smem);
    } else if (sub == 1) {
#if PROBE_A
      for (int item = blockIdx.x; item < 5120; item += gridDim.x) gla_intra_item(p, li, item, smem, true);
#endif
#if PROBE_B
      for (int item = blockIdx.x; item < 5120; item += gridDim.x) pool_item(p, li, item, smem, true);
#endif
      for (int item = blockIdx.x; item < 5120 + 5120; item += gridDim.x) {
        if (item < 5120) { if (PH_ON(2)) gla_intra_item(p, li, item, smem); }
        else { if (PH_ON(3)) pool_item(p, li, item - 5120, smem); }
      }
    } else if (sub == 2) {
      for (int rep = PROBE_CHAIN ? 0 : 1; rep < 2; ++rep)
      for (int item = blockIdx.x; item < 384; item += gridDim.x)
        if (PH_ON(2)) gla_chain_item(p, li, item, smem, rep == 0);
    } else if (sub == 3) {
      if (PROBE_B) phase_gla_combine(p, li, true);
      if (PH_ON(4)) phase_gla_combine(p, li);
    } else {
      if (PROBE_GEMM) { EpiOut ed{xa, xb, p.out, true}; gemm_phase<1, 8>(T_TOK / 128, DM / 256, 1536, p.WoutE + (long)li * DM * 1536, nullptr, nullptr, p.Gb, 1024, 1024, p.PGb, 512, ed, smem); }
      EpiOut e{xa, xb, p.out, false};
      if (PH_ON(5)) gemm_phase<1, 8>(T_TOK / 128, DM / 256, 1536, p.WoutE + (long)li * DM * 1536, nullptr, nullptr, p.Gb, 1024, 1024, p.PGb, 512, e, smem);
    }
  } else {
    if (sub == 0) {
      EpiOddIn e{p.CQb, p.CKVb, p.KRb, p.MGb, p.MQb, p.MKb, p.MKt, p.MVt, p.MOb, p.MLGb, p.MIF};
      for (int rep = 0; rep < 1 + PROBE_GEMM; ++rep)
      if (PH_ON(6)) gemm_phase<0, 8>(T_TOK / 128, NO_PAD / 256, DM, p.WinO + (long)li * NO_PAD * DM, xa, xb, nullptr, 0, 0, nullptr, 0, e, smem);
    } else if (sub == 1) {
      for (int rep = 0; rep < 1 + PROBE_A; ++rep)
      for (int item = blockIdx.x; item < 5120; item += gridDim.x)
        if (PH_ON(8)) ml_intra_item(p, li, item, smem);
    } else if (sub == 2) {
      for (int rep = PROBE_MLCHAIN ? 0 : 1; rep < 2; ++rep)
      for (int item = blockIdx.x; item < 384; item += gridDim.x)
        if (PH_ON(8)) ml_chain_item(p, li, item, smem, rep == 0);
    } else if (sub == 3) {
      if (PROBE_B) phase_ml_combine(p, li, true);
      if (PH_ON(10)) phase_ml_combine(p, li);
    } else if (sub == 4) {
      EpiQUp eq{p.Qa};
      if (PH_ON(7)) gemm_phase<2, 4>(T_TOK / 128, 768 / 128, 384, p.QupT + (long)li * 768 * 384, nullptr, nullptr, p.CQb, 384, 384, p.CQb, 384, eq, smem);
      EpiKVUp ek{p.KNb, p.VtA};
      if (PH_ON(7)) gemm_phase<2, 4>(T_TOK / 128, 1024 / 128, 256, p.KVupT + (long)li * 1024 * 256, nullptr, nullptr, p.CKVb, 256, 256, p.CKVb, 256, ek, smem);
    } else if (sub == 5) {
      __shared__ int s_item;
      for (;;) {
        __syncthreads();
        if (threadIdx.x == 0) s_item = atomicAdd(p.counters + li, 1);
        __syncthreads();
        const int item = s_item;
        if (item >= 5120) break;
        if (PH_ON(9)) attn_item(p, item, smem);
      }
    } else {
      EpiOut e{xa, xb, p.out, false};
      if (PH_ON(5)) gemm_phase<1, 8>(T_TOK / 128, DM / 256, 1024, p.WoutO + (long)li * DM * 1024, nullptr, nullptr, p.MGb, 512, 512, p.MLGb, 512, e, smem);
    }
  }
}

__global__ void __launch_bounds__(256, 2) mega_kernel(Params p) {
  extern __shared__ __attribute__((aligned(16))) char smem[];
  cg::grid_group grid = cg::this_grid();
  __shared__ uint4 xb_words;
  if (threadIdx.x == 0) xb_words = make_uint4(0u, 0u, 0u, 0u);
  __syncthreads();
  XcdBarrier xb = xcd_barrier_post(p.bar, (volatile LAS unsigned*)&xb_words);
  for (int ph = p.ph_lo; ph < p.ph_hi; ++ph) {
    if (ph > p.ph_lo) {
      if (ph == p.ph_lo + 1) grid.sync();
      else xcd_barrier(xb);
    }
    run_phase(p, ph, smem);
  }
}

extern "C" void kernel_launch(void* const* d_in, const int* in_sizes, int n_in, void* d_out, int out_size, void* d_ws,
                              size_t ws_size, hipStream_t stream) {
  static int grid_blocks = 0;
  if (!grid_blocks) {
    int dev = 0, cus = 0, per_cu = 0;
    hipGetDevice(&dev);
    hipDeviceGetAttribute(&cus, hipDeviceAttributeMultiprocessorCount, dev);
    hipFuncSetAttribute((const void*)mega_kernel, hipFuncAttributeMaxDynamicSharedMemorySize, LDS_BYTES);
    hipOccupancyMaxActiveBlocksPerMultiprocessor(&per_cu, (const void*)mega_kernel, 256, LDS_BYTES);
    if (per_cu < 1) per_cu = 1;
    if (per_cu > 2) per_cu = 2;
    grid_blocks = cus * per_cu;
    fprintf(stderr, "kernel_launch: cus %d per_cu %d grid %d ws %zu\n", cus, per_cu, grid_blocks, ws_size);
  }
  Params p{};
  const float** pin = (const float**)&p;
  for (int i = 0; i < 19; ++i) pin[i] = (const float*)d_in[i];
  p.out = (float*)d_out;
  char* ws = (char*)d_ws;
  size_t off = 0;
  auto take = [&](size_t bytes) { char* r = ws + off; off += (bytes + 255) & ~(size_t)255; return r; };
  p.WinE = (bf16_t*)take((size_t)2 * NE_PAD * DM * 2);
  p.WinO = (bf16_t*)take((size_t)2 * NO_PAD * DM * 2);
  p.WoutE = (bf16_t*)take((size_t)2 * DM * 1536 * 2);
  p.WoutO = (bf16_t*)take((size_t)2 * DM * 1024 * 2);
  p.QupT = (bf16_t*)take((size_t)2 * 768 * 384 * 2);
  p.KVupT = (bf16_t*)take((size_t)2 * 1024 * 256 * 2);
  p.PoolWT = (bf16_t*)take((size_t)2 * 4 * 128 * 128 * 2);
  p.AupT = (bf16_t*)take((size_t)2 * 2 * 512 * 32 * 2);
  p.counters = (int*)take(256);
  p.bar = (unsigned*)take((size_t)XCD_BAR_WORDS * 4);
  const size_t act0 = off;
  const size_t T = T_TOK;
  p.Qb = (bf16_t*)take(T * 512 * 2);
  p.Kt = (bf16_t*)take(T * 512 * 2);
  p.QEb = (bf16_t*)take(T * 512 * 2);
  p.KdTb = (bf16_t*)take(T * 512 * 2);
  p.EB = (float*)take((size_t)2 * 1280 * 512 * 4);
  p.VtE = (bf16_t*)take(T * 1024 * 2);
  p.Gb = (bf16_t*)take(T * 1024 * 2);
  p.LRb = (bf16_t*)take(T * 32 * 2);
  p.PUb = (bf16_t*)take(T * 512 * 2);
  p.PGb = (bf16_t*)take(T * 512 * 2);
  p.TMP = (bf16_t*)take(T * 1024 * 2);
  const size_t even_end = off;
  off = act0;
  p.MGb = (bf16_t*)take(T * 512 * 2);
  p.MLGb = (bf16_t*)take(T * 512 * 2);
  p.CQb = (bf16_t*)take(T * 384 * 2);
  p.CKVb = (bf16_t*)take(T * 256 * 2);
  p.KRb = (bf16_t*)take(T * 32 * 2);
  const size_t r2 = off;
  p.MQb = (bf16_t*)take(T * 512 * 2);
  p.MKb = (bf16_t*)take(T * 512 * 2);
  p.MKt = (bf16_t*)take(T * 512 * 2);
  p.MVt = (bf16_t*)take(T * 512 * 2);
  p.MOb = (bf16_t*)take(T * 512 * 2);
  p.NUMIf = (bf16_t*)take(T * 512 * 2);
  p.NUMIb = (bf16_t*)take(T * 512 * 2);
  p.MIF = (float*)take(T * 16 * 4);
  p.EBI = (float*)take(T * 8 * 4);
  p.WKg = (float*)take(T * 8 * 4);
  p.DENI = (float*)take(T * 8 * 4);
  p.DEC = (float*)take((size_t)8 * 1280 * 4);
  const size_t r2_end = off;
  off = r2;
  p.Qa = (bf16_t*)take(T * 768 * 2);
  p.KNb = (bf16_t*)take(T * 512 * 2);
  p.VtA = (bf16_t*)take(T * 512 * 2);
  if (off < r2_end) off = r2_end;
  const size_t odd_end = off;
  const size_t need = even_end > odd_end ? even_end : odd_end;
  if (need > ws_size) {
    fprintf(stderr, "kernel_launch: workspace too small: need %zu have %zu\n", need, ws_size);
    return;
  }
  hipMemsetAsync(p.bar, 0, (size_t)XCD_BAR_WORDS * 4, stream);
#if SINGLE_LAUNCH
  p.ph_lo = 0;
  p.ph_hi = NPHASE;
  void* args[] = {&p};
  hipError_t e = hipLaunchCooperativeKernel((const void*)mega_kernel, dim3(grid_blocks), dim3(256), args, LDS_BYTES, stream);
  if (e != hipSuccess) fprintf(stderr, "cooperative launch failed: %s (grid %d)\n", hipGetErrorString(e), grid_blocks);
#else
  for (int ph = 0; ph < NPHASE; ++ph) {
    p.ph_lo = ph;
    p.ph_hi = ph + 1;
    hipLaunchKernelGGL(mega_kernel, dim3(grid_blocks), dim3(256), LDS_BYTES, stream, p);
  }
#endif
}
```

```cpp
#include <hip/hip_runtime.h>
#include <hip/hip_cooperative_groups.h>
#include <cstdio>
namespace cg = cooperative_groups;

#ifndef SINGLE_LAUNCH
#define SINGLE_LAUNCH 1
#endif
#ifndef PHMASK
#define PHMASK 0xFFFF
#endif
#define PH_ON(b) ((PHMASK >> (b)) & 1)
#ifndef PROBE_GEMM
#define PROBE_GEMM 0
#endif
#ifndef PROBE_ATTN
#define PROBE_ATTN 0
#endif
#ifndef PROBE_CHAIN
#define PROBE_CHAIN 0
#endif
#ifndef PROBE_A
#define PROBE_A 0
#endif
#ifndef PROBE_B
#define PROBE_B 0
#endif
#ifndef PROBE_MLCHAIN
#define PROBE_MLCHAIN 0
#endif

typedef unsigned short bf16_t;
typedef __attribute__((ext_vector_type(8))) short bf16x8;
typedef __attribute__((ext_vector_type(4))) float f32x4;
typedef __attribute__((ext_vector_type(4))) unsigned short us4;

constexpr int T_TOK = 81920;
constexpr int T_P = 16384;
constexpr int DM = 1024;
constexpr int NE = 4128, NE_PAD = 4352;
constexpr int NO = 4272, NO_PAD = 4352;
constexpr float EPS = 1e-6f;
constexpr int NPHASE = 26;
constexpr int LDS_BYTES = 72 * 1024;

struct Params {
  const float *x_prompt, *x_sample, *norm_g, *final_norm_g, *e_w_in, *e_a_up, *e_a_bias, *e_gla_norm_g,
      *e_pool_w, *e_pool_scale, *e_w_out, *o_w_in, *o_q_norm_g, *o_q_up, *o_kv_norm_g, *o_kv_up, *o_if_bias,
      *o_ml_norm_g, *o_w_out;
  float* out;
  bf16_t *WinE, *WinO, *WoutE, *WoutO, *QupT, *KVupT, *PoolWT, *AupT;
  int* counters;
  unsigned* bar;
  float* SSQ;
  bf16_t *Qb, *Kt, *VtE, *Gb, *LRb, *PUb, *PGb, *TMP, *QEb, *KdTb;
  float* EB;
  bf16_t *CQb, *CKVb, *KRb, *MGb, *MQb, *MKb, *MKt, *MVt, *MOb, *MLGb, *NUMIf, *NUMIb, *Qa, *KNb, *VtA;
  float *MIF, *EBI, *WKg, *DENI, *DEC;
  int ph_lo, ph_hi;
};

typedef __bf16 hbf2 __attribute__((ext_vector_type(2)));
typedef float hf2 __attribute__((ext_vector_type(2)));
__device__ __forceinline__ bf16_t f2bf(float f) {
  __bf16 b = (__bf16)f;
  return __builtin_bit_cast(bf16_t, b);
}
__device__ __forceinline__ unsigned pk2bf(float a, float b) {
  hf2 v = {a, b};
  hbf2 r = __builtin_convertvector(v, hbf2);
  return __builtin_bit_cast(unsigned, r);
}
__device__ __forceinline__ float bf2f(bf16_t b) { return __uint_as_float(((unsigned)b) << 16); }
__device__ __forceinline__ f32x4 mfma16(bf16x8 a, bf16x8 b, f32x4 c) {
  return __builtin_amdgcn_mfma_f32_16x16x32_bf16(a, b, c, 0, 0, 0);
}
__device__ __forceinline__ float logsigmoidf_(float x) { return fminf(x, 0.f) - log1pf(__expf(-fabsf(x))); }
__device__ __forceinline__ float siluf_(float x) { return x / (1.f + __expf(-x)); }
__device__ __forceinline__ float sigmoidf_(float x) { return 1.f / (1.f + __expf(-x)); }
__device__ __forceinline__ int otid() { int t = threadIdx.x; asm volatile("" : "+v"(t)); return t; }
__device__ __forceinline__ float bperm(int srclane, float v) { return __int_as_float(__builtin_amdgcn_ds_bpermute(srclane << 2, __float_as_int(v))); }
__device__ __forceinline__ float sxor(float v, int m, int lane) { return bperm(lane ^ m, v); }
__device__ __forceinline__ bf16x8 zero8() { bf16x8 z = {0, 0, 0, 0, 0, 0, 0, 0}; return z; }
__device__ __forceinline__ f32x4 zero4() { f32x4 z = {0.f, 0.f, 0.f, 0.f}; return z; }

__device__ __forceinline__ int seq_pos(int tok) { return tok < T_P ? (tok & 4095) : ((tok - T_P) & 8191); }
__device__ __forceinline__ const float* xrow(const float* xa, const float* xb, int tok) {
  return tok < T_P ? xa + (long)tok * DM : xb + (long)(tok - T_P) * DM;
}


#define XB_TMO      128
#define XB_XCNT(j)  (256  + 64 * (j))
#define XB_XSUB(j)  (1280 + 64 * (j))
#define XB_XGEN(j)  (2304 + 64 * (j))
#define XB_TOP      3328
#define XB_TOPGEN   3392
#define XCD_BAR_WORDS 3456
#define XB_SPIN_CAP (1u << 22)
#define LAS __attribute__((address_space(3)))
__device__ __forceinline__ unsigned xb_ld(unsigned* p) { return __hip_atomic_load(p, __ATOMIC_RELAXED, __HIP_MEMORY_SCOPE_AGENT); }
__device__ __forceinline__ unsigned xb_add(unsigned* p, unsigned v) { return __hip_atomic_fetch_add(p, v, __ATOMIC_RELAXED, __HIP_MEMORY_SCOPE_AGENT); }
__device__ __forceinline__ unsigned xb_xcc_id() { return (unsigned)__builtin_amdgcn_s_getreg((3 << 11) | 20) & 0xFu; }
#define XB_SPIN(cond, bar) do { unsigned _sp = 0; while (cond) { __builtin_amdgcn_s_sleep(1); \
    if ((++_sp & 255u) == 0u) { if (xb_ld(&(bar)[XB_TMO])) break; if (_sp > XB_SPIN_CAP) { atomicAdd(&(bar)[XB_TMO], 1u); break; } } } } while (0)
struct XcdBarrier { unsigned* bar; unsigned x; volatile LAS unsigned* st; };
__device__ __forceinline__ XcdBarrier xcd_barrier_post(unsigned* bar, volatile LAS unsigned* st) {
  XcdBarrier b; b.bar = bar; b.x = xb_xcc_id(); b.st = st;
  if (threadIdx.x == 0) (void)xb_add(&bar[XB_XCNT(b.x)], 1u);
  return b;
}
__device__ __forceinline__ void xcd_barrier_complete(unsigned* bar, unsigned x, unsigned& nloc, unsigned& nx) {
  const unsigned G = gridDim.x * gridDim.y * gridDim.z;
  unsigned sum, cnt, mine, sp = 0u;
  for (;;) {
    sum = 0u; cnt = 0u; mine = 0u;
#pragma unroll
    for (unsigned j = 0; j < 16; ++j) { const unsigned cc = xb_ld(&bar[XB_XCNT(j)]); sum += cc; cnt += (cc > 0u) ? 1u : 0u; mine = (j == x) ? cc : mine; }
    if (sum == G) break;
    __builtin_amdgcn_s_sleep(1);
    if ((++sp & 255u) == 0u) { if (xb_ld(&bar[XB_TMO])) break; if (sp > XB_SPIN_CAP) { atomicAdd(&bar[XB_TMO], 1u); break; } }
  }
  nloc = mine > 0u ? mine : 1u; nx = cnt > 0u ? cnt : 1u;
}
__device__ __forceinline__ void xcd_barrier(const XcdBarrier& b) {
  asm volatile("s_waitcnt vmcnt(0)" ::: "memory");
  __syncthreads();
  if (threadIdx.x == 0) {
    unsigned* bar = b.bar;
    __builtin_amdgcn_s_waitcnt(0);
    unsigned nloc = b.st[0], nx = b.st[1];
    if (nloc == 0u) { xcd_barrier_complete(bar, b.x, nloc, nx); b.st[0] = nloc; b.st[1] = nx; }
    const unsigned old = xb_add(&bar[XB_XSUB(b.x)], 1u);
    const unsigned gen = old / nloc;
    if (old + 1u == (gen + 1u) * nloc) {
      __builtin_amdgcn_fence(__ATOMIC_RELEASE, "agent");
      asm volatile("s_waitcnt vmcnt(0)" ::: "memory");
      const unsigned og = xb_add(&bar[XB_TOP], 1u);
      const unsigned tg = og / nx;
      if (og + 1u == (tg + 1u) * nx) xb_add(&bar[XB_TOPGEN], 1u);
      else XB_SPIN(xb_ld(&bar[XB_TOPGEN]) == tg, bar);
      __builtin_amdgcn_fence(__ATOMIC_ACQUIRE, "agent");
      xb_add(&bar[XB_XGEN(b.x)], 1u);
      asm volatile("s_waitcnt vmcnt(0)" ::: "memory");
    } else {
      XB_SPIN(xb_ld(&bar[XB_XGEN(b.x)]) == gen, bar);
      __builtin_amdgcn_fence(__ATOMIC_ACQUIRE, "agent");
      asm volatile("s_waitcnt vmcnt(0)" ::: "memory");
    }
  }
  __syncthreads();
}

__device__ __forceinline__ int colmap(int mode, int n) {
  if (mode == 1) {
    if (n < 512) return 2208 + n;
    if (n < 1024) return 1696 + (n - 512);
    if (n < 1408) return n - 1024;
    if (n < 1664) return 384 + (n - 1408);
    if (n < 2176) return 672 + (n - 1664);
    if (n < 2688) return 1184 + (n - 2176);
    if (n < 3200) return 1696 + (n - 2688);
    if (n < 3712) return 2720 + (n - 3200);
    if (n < 4224) return 3248 + (n - 3712);
    if (n < 4256) return 640 + (n - 4224);
    return 3232 + (n - 4256);
  }
  if (mode == 2) {
    if (n < 512) return (n >> 6) * 96 + (n & 63);
    const int r = n - 512;
    return (r >> 5) * 96 + 64 + (r & 31);
  }
  if (mode == 3) {
    if (n < 512) return (n >> 6) * 128 + (n & 63);
    const int r = n - 512;
    return (r >> 6) * 128 + 64 + (r & 63);
  }
  return n;
}

__device__ void prep_weight(const float* __restrict__ W, int K, int N, int Npad, const float* __restrict__ gsc,
                            bf16_t* __restrict__ out, long gtid, long gsize, int mode = 0, int Nsrc_ = 0) {
  const int Nsrc = Nsrc_ ? Nsrc_ : N;
  long total = (long)Npad * K;
  for (long idx = gtid; idx < total; idx += gsize) {
    int k = (int)(idx / Npad);
    int n = (int)(idx % Npad);
    float v = 0.f;
    if (n < N) {
      v = W[(long)k * Nsrc + colmap(mode, n)];
      if (gsc) v *= gsc[k];
    }
    out[(long)n * K + k] = f2bf(v);
  }
}

__device__ void phase_prep(const Params& p) {
  long gtid = (long)blockIdx.x * 256 + otid();
  long gsize = (long)gridDim.x * 256;
  for (int l = 0; l < 2; ++l) {
    prep_weight(p.e_w_in + (long)l * DM * NE, DM, NE, NE_PAD, p.norm_g + (2 * l) * DM, p.WinE + (long)l * NE_PAD * DM, gtid, gsize);
    prep_weight(p.o_w_in + (long)l * DM * 3760, DM, NO, NO_PAD, p.norm_g + (2 * l + 1) * DM, p.WinO + (long)l * NO_PAD * DM, gtid, gsize, 1, 3760);
    prep_weight(p.e_w_out + (long)l * 1536 * DM, 1536, DM, DM, nullptr, p.WoutE + (long)l * DM * 1536, gtid, gsize);
    prep_weight(p.o_w_out + (long)l * 1024 * DM, 1024, DM, DM, nullptr, p.WoutO + (long)l * DM * 1024, gtid, gsize);
    prep_weight(p.o_q_up + (long)l * 384 * 768, 384, 768, 768, p.o_q_norm_g + l * 384, p.QupT + (long)l * 768 * 384, gtid, gsize, 2);
    prep_weight(p.o_kv_up + (long)l * 256 * 1024, 256, 1024, 1024, p.o_kv_norm_g + l * 256, p.KVupT + (long)l * 1024 * 256, gtid, gsize, 3);
    for (int gi = 0; gi < 4; ++gi)
      prep_weight(p.e_pool_w + (long)(l * 4 + gi) * 128 * 128, 128, 128, 128, nullptr, p.PoolWT + (long)(l * 4 + gi) * 128 * 128, gtid, gsize);
    for (long idx = gtid; idx < 2 * 512 * 32; idx += gsize) {
      int r = (int)(idx & 31);
      int d = (int)((idx >> 5) & 511);
      int dir = (int)(idx >> 14);
      float v = (r < 16) ? p.e_a_up[((long)(l * 2 + dir) * 16 + r) * 512 + d] : 0.f;
      p.AupT[((long)(l * 2 + dir) * 512 + d) * 32 + r] = f2bf(v);
    }
  }
  if (gtid < 16) p.counters[gtid] = 0;
  {
    const int tid_ = otid();
    const int lane = tid_ & 63, w = tid_ >> 6;
    for (int tok = blockIdx.x * 4 + w; tok < T_TOK; tok += gridDim.x * 4) {
      const float* xp = xrow(p.x_prompt, p.x_sample, tok) + 16 * lane;
      float ssv = 0.f;
      unsigned pk[8];
#pragma unroll
      for (int i = 0; i < 4; ++i) {
        const f32x4 v = *(const f32x4*)(xp + 4 * i);
        ssv += v[0] * v[0] + v[1] * v[1] + v[2] * v[2] + v[3] * v[3];
        pk[2 * i] = pk2bf(v[0], v[1]);
        pk[2 * i + 1] = pk2bf(v[2], v[3]);
      }
      uint4 o0, o1;
      o0.x = pk[0]; o0.y = pk[1]; o0.z = pk[2]; o0.w = pk[3];
      o1.x = pk[4]; o1.y = pk[5]; o1.z = pk[6]; o1.w = pk[7];
      *(uint4*)(p.TMP + (size_t)tok * DM + 16 * lane) = o0;
      *(uint4*)(p.TMP + (size_t)tok * DM + 16 * lane + 8) = o1;
#pragma unroll
      for (int d = 1; d < 64; d <<= 1) ssv += sxor(ssv, d, lane);
      if (lane < 8) p.SSQ[(size_t)tok * 8 + lane] = (lane == 0) ? ssv : 0.f;
    }
  }
}

constexpr int G_LD = 40;
constexpr int G_BUF = (128 + 256) * G_LD;

template <int AMODE, int NI, class Epi>
__device__ __forceinline__ void gemm_phase(int Mtiles, int Ntiles, int K, const bf16_t* __restrict__ Bt, const float* ssq, const float* unused_,
                           const bf16_t* A1, int ld1, int K1, const bf16_t* A2, int ld2, const Epi& epi, char* smem) {
  bf16_t* sbase = (bf16_t*)smem;
  float* sR = (float*)(smem + 70144);
  const int tid = otid(), lane = tid & 63, w = tid >> 6, c = lane & 15, g = lane >> 4;
  const int wm = w >> 1, wn = w & 1;
  const int nk = K / 32;
  const int xcd = blockIdx.x & 7, lb0 = blockIdx.x >> 3, nlb = gridDim.x >> 3;
  const int mper = Mtiles >> 3;
  for (int lt = lb0; lt < mper * Ntiles; lt += nlb) {
    const int mt = xcd * mper + lt / Ntiles, nt = lt % Ntiles;
    constexpr int BN = 32 * NI;
    const int m0 = mt * 128, n0 = nt * BN;
    f32x4 acc[4][NI];
#pragma unroll
    for (int i = 0; i < 4; ++i)
#pragma unroll
      for (int j = 0; j < NI; ++j) acc[i][j] = zero4();
    float ss[2] = {0.f, 0.f};
    bf16x8 ra0[2], ra1[2];
    bf16x8 rb0[NI / 2], rb1[NI / 2];
    const unsigned boff = (unsigned)(tid >> 2) * K + 8 * (tid & 3);
    const bf16_t* bbase = Bt + (size_t)n0 * K;
#define G_LOAD(RA, RB, KT)                                                                          \
  {                                                                                                 \
    const int k0_ = (KT) * 32;                                                                      \
    const bf16_t* base_;                                                                            \
    int ld_;                                                                                        \
    if (k0_ < K1) { base_ = A1 + (size_t)m0 * ld1 + k0_; ld_ = ld1; }                               \
    else { base_ = A2 + (size_t)m0 * ld2 + (k0_ - K1); ld_ = ld2; }                                 \
    _Pragma("unroll") for (int i = 0; i < 2; ++i)                                                   \
      RA[i] = *(const bf16x8*)(base_ + (unsigned)((tid >> 2) + 64 * i) * ld_ + 8 * (tid & 3));      \
    _Pragma("unroll") for (int i = 0; i < NI / 2; ++i)                                              \
      RB[i] = *(const bf16x8*)(bbase + k0_ + boff + (unsigned)(64 * i) * K);                        \
  }
#define G_STORE(RA, RB, BUF)                                                                        \
  {                                                                                                 \
    bf16_t* sA_ = sbase + (BUF) * G_BUF;                                                            \
    bf16_t* sB_ = sA_ + 128 * G_LD;                                                                 \
    _Pragma("unroll") for (int i = 0; i < 2; ++i) {                                                 \
      bf16x8 v = RA[i];                                                                             \
      if constexpr (AMODE == 2) {                                                                   \
        _Pragma("unroll") for (int e = 0; e < 8; ++e) {                                             \
          float f = bf2f((bf16_t)v[e]);                                                             \
          ss[i] += f * f;                                                                           \
        }                                                                                           \
      }                                                                                             \
      *(bf16x8*)(sA_ + ((tid >> 2) + 64 * i) * G_LD + 8 * (tid & 3)) = v;                           \
    }                                                                                               \
    _Pragma("unroll") for (int i = 0; i < NI / 2; ++i)                                              \
      *(bf16x8*)(sB_ + ((tid >> 2) + 64 * i) * G_LD + 8 * (tid & 3)) = RB[i];                       \
  }
#define G_COMPUTE(BUF)                                                                              \
  {                                                                                                 \
    const bf16_t* sA_ = sbase + (BUF) * G_BUF;                                                      \
    const bf16_t* sB_ = sA_ + 128 * G_LD;                                                           \
    bf16x8 af[4];                                                                                   \
    _Pragma("unroll") for (int mi = 0; mi < 4; ++mi)                                                \
      af[mi] = *(const bf16x8*)(sA_ + (wm * 64 + mi * 16 + c) * G_LD + g * 8);                      \
    _Pragma("unroll") for (int ni = 0; ni < NI; ++ni) {                                             \
      bf16x8 bfr = *(const bf16x8*)(sB_ + (wn * (16 * NI) + ni * 16 + c) * G_LD + g * 8);           \
      _Pragma("unroll") for (int mi = 0; mi < 4; ++mi) acc[mi][ni] = mfma16(af[mi], bfr, acc[mi][ni]); \
    }                                                                                               \
  }
    __syncthreads();
    if constexpr (AMODE == 3) {
      if (tid < 128) {
        const f32x4 p0 = *(const f32x4*)(ssq + (size_t)(m0 + tid) * 8);
        const f32x4 p1 = *(const f32x4*)(ssq + (size_t)(m0 + tid) * 8 + 4);
        const float sv = (p0[0] + p0[1]) + (p0[2] + p0[3]) + (p1[0] + p1[1]) + (p1[2] + p1[3]);
        sR[tid] = rsqrtf(sv * (1.f / 1024.f) + EPS);
      }
    }
    G_LOAD(ra0, rb0, 0)
    if (nk > 1) G_LOAD(ra1, rb1, 1)
    G_STORE(ra0, rb0, 0)
    __syncthreads();
    for (int kt = 0; kt < nk; kt += 2) {
      if (kt + 2 < nk) G_LOAD(ra0, rb0, kt + 2)
      G_COMPUTE(0)
      if (kt + 1 < nk) G_STORE(ra1, rb1, 1)
      __syncthreads();
      if (kt + 1 < nk) {
        if (kt + 3 < nk) G_LOAD(ra1, rb1, kt + 3)
        G_COMPUTE(1)
        if (kt + 2 < nk) G_STORE(ra0, rb0, 0)
        __syncthreads();
      }
    }
    if constexpr (AMODE == 2) {
#pragma unroll
      for (int i = 0; i < 2; ++i) {
        float sv = ss[i];
        sv += sxor(sv, 1, lane); sv += sxor(sv, 2, lane);
        if ((tid & 3) == 0) sR[(tid >> 2) + 64 * i] = rsqrtf(sv / (float)K + EPS);
      }
      __syncthreads();
    }
    if constexpr (Epi::staged) {
      bf16_t* sT = sbase;
      const float esc = epi.scale();
      const bool tr = epi.transposed(n0);
      if (tr) {
#pragma unroll
        for (int mi = 0; mi < 4; ++mi) {
          const int row = wm * 64 + mi * 16 + 4 * g;
          const float r0 = sR[row] * esc, r1 = sR[row + 1] * esc, r2 = sR[row + 2] * esc, r3 = sR[row + 3] * esc;
#pragma unroll
          for (int ni = 0; ni < NI; ++ni) {
            uint2 o;
            o.x = pk2bf(acc[mi][ni][0] * r0, acc[mi][ni][1] * r1);
            o.y = pk2bf(acc[mi][ni][2] * r2, acc[mi][ni][3] * r3);
            *(uint2*)(sT + (wn * (16 * NI) + ni * 16 + c) * 136 + row) = o;
          }
        }
      } else {
#pragma unroll
        for (int mi = 0; mi < 4; ++mi) {
          const int row = wm * 64 + mi * 16 + 4 * g;
          const float r0 = sR[row] * esc, r1 = sR[row + 1] * esc, r2 = sR[row + 2] * esc, r3 = sR[row + 3] * esc;
#pragma unroll
          for (int ni = 0; ni < NI; ++ni) {
            bf16_t* d = sT + row * (BN + 8) + wn * (16 * NI) + ni * 16 + c;
            d[0] = f2bf(acc[mi][ni][0] * r0);
            d[BN + 8] = f2bf(acc[mi][ni][1] * r1);
            d[2 * (BN + 8)] = f2bf(acc[mi][ni][2] * r2);
            d[3 * (BN + 8)] = f2bf(acc[mi][ni][3] * r3);
          }
        }
      }
      epi.template direct<NI>(m0, n0, wm, wn, g, c, acc, sR);
      __syncthreads();
      if (tr) {
#pragma unroll 4
        for (int i = 0; i < 2 * NI; ++i) {
          const int id = tid + 256 * i;
          const int col = id >> 4, rc = id & 15;
          bf16x8 v = *(const bf16x8*)(sT + col * 136 + 8 * rc);
          epi.store_t(m0 + 8 * rc, n0 + col, v);
        }
      } else {
#pragma unroll 4
        for (int i = 0; i < 2 * NI; ++i) {
          const int id = tid + 256 * i;
          const int row = id / (4 * NI), cc = id % (4 * NI);
          const bf16_t* sp = sT + row * (BN + 8) + 8 * cc;
          bf16x8 v = *(const bf16x8*)sp;
          epi.store_n(m0 + row, n0 + 8 * cc, v, sp);
        }
      }
    } else {
      epi(m0, n0, wm, wn, g, c, acc, sR);
    }
  }
#undef G_LOAD
#undef G_STORE
#undef G_COMPUTE
}

__device__ __forceinline__ void rope_cs(int pos, int i, float& co, float& si) {
  float inv = exp2f(-(float)i * (13.287712379549449f / 16.f));
  float ang = (float)pos * inv;
  float n = rintf(ang * 0.15915494309189535f);
  float r = fmaf(-n, 6.28125f, ang);
  r = fmaf(-n, 0.0019353071795864769f, r);
  float rf = r * 0.15915494309189535f;
  si = __builtin_amdgcn_sinf(rf);
  co = __builtin_amdgcn_cosf(rf);
}

__device__ __forceinline__ void rope_chunk(int pos, int i0, bf16x8 x1, bf16x8 x2, bf16x8& o1, bf16x8& o2) {
#pragma unroll
  for (int e = 0; e < 8; ++e) {
    float co, si;
    rope_cs(pos, i0 + e, co, si);
    float a = bf2f((bf16_t)x1[e]), b = bf2f((bf16_t)x2[e]);
    o1[e] = (short)f2bf(a * co - b * si);
    o2[e] = (short)f2bf(b * co + a * si);
  }
}

struct EpiEvenIn {
  static constexpr bool staged = true;
  bf16_t *Qb, *Kt, *VtE, *Gb, *LRb, *PUb, *PGb;
  __device__ float scale() const { return 1.f; }
  __device__ bool transposed(int n0) const { return n0 >= 512 && n0 < 2048; }
  template <int NI> __device__ void direct(int m0, int n0, int wm, int wn, int g, int c, f32x4 (&acc)[4][NI], const float* sR) const {}
  __device__ void store_t(int tok8, int col, bf16x8 v) const {
    if (col < 1024) *(bf16x8*)(Kt + (size_t)(col - 512) * T_TOK + tok8) = v;
    else *(bf16x8*)(VtE + (size_t)(col - 1024) * T_TOK + tok8) = v;
  }
  __device__ void store_n(int tok, int col, bf16x8 v, const bf16_t* sp) const {
    bf16_t* d;
    if (col < 512) d = Qb + (size_t)tok * 512 + col;
    else if (col < 3072) d = Gb + (size_t)tok * 1024 + (col - 2048);
    else if (col < 3104) d = LRb + (size_t)tok * 32 + (col - 3072);
    else if (col < 3616) d = PUb + (size_t)tok * 512 + (col - 3104);
    else if (col < 4128) d = PGb + (size_t)tok * 512 + (col - 3616);
    else return;
    *(bf16x8*)d = v;
  }
};

struct EpiOddIn {
  static constexpr bool staged = true;
  bf16_t *CQb, *CKVb, *KRb, *MGb, *MQb, *MKb, *MKt, *MVt, *MOb, *MLGb;
  float* MIF;
  __device__ float scale() const { return 1.f; }
  __device__ bool transposed(int n0) const { return n0 < 1024; }
  template <int NI> __device__ void direct(int m0, int n0, int wm, int wn, int g, int c, f32x4 (&acc)[4][NI], const float* sR) const {
    if (n0 == 4096 && wn == 1) {
#pragma unroll
      for (int mi = 0; mi < 4; ++mi)
#pragma unroll
        for (int j = 0; j < 4; ++j) {
          const int row = wm * 64 + mi * 16 + 4 * g + j;
          MIF[(size_t)(m0 + row) * 16 + c] = acc[mi][2][j] * sR[row];
        }
    }
  }
  __device__ void store_t(int tok8, int col, bf16x8 v) const {
    if (col < 512) *(bf16x8*)(MVt + (size_t)col * T_TOK + tok8) = v;
    else *(bf16x8*)(MKt + (size_t)(col - 512) * T_TOK + tok8) = v;
  }
  __device__ void store_n(int tok, int col, bf16x8 v, const bf16_t* sp) const {
    bf16_t* d;
    if (col < 1408) d = CQb + (size_t)tok * 384 + (col - 1024);
    else if (col < 1664) d = CKVb + (size_t)tok * 256 + (col - 1408);
    else if (col < 2176) d = MGb + (size_t)tok * 512 + (col - 1664);
    else if (col < 2688) d = MQb + (size_t)tok * 512 + (col - 2176);
    else if (col < 3200) d = MKb + (size_t)tok * 512 + (col - 2688);
    else if (col < 3712) d = MOb + (size_t)tok * 512 + (col - 3200);
    else if (col < 4224) d = MLGb + (size_t)tok * 512 + (col - 3712);
    else if (col < 4240) {
      bf16x8 x2 = *(const bf16x8*)(sp + 16);
      bf16x8 o1, o2;
      rope_chunk(seq_pos(tok), col - 4224, v, x2, o1, o2);
      *(bf16x8*)(KRb + (size_t)tok * 32 + (col - 4224)) = o1;
      *(bf16x8*)(KRb + (size_t)tok * 32 + 16 + (col - 4224)) = o2;
      return;
    } else return;
    *(bf16x8*)d = v;
  }
};

struct EpiQUp {
  static constexpr bool staged = true;
  bf16_t* Qa;
  __device__ float scale() const { return 0.10206207261596575f * 1.4426950408889634f; }
  __device__ bool transposed(int n0) const { return false; }
  template <int NI> __device__ void direct(int m0, int n0, int wm, int wn, int g, int c, f32x4 (&acc)[4][NI], const float* sR) const {}
  __device__ void store_t(int tok8, int col, bf16x8 v) const {}
  __device__ void store_n(int tok, int col, bf16x8 v, const bf16_t* sp) const {
    if (col < 512) {
      *(bf16x8*)(Qa + (size_t)tok * 768 + (col >> 6) * 96 + (col & 63)) = v;
    } else {
      const int r = col - 512, head = r >> 5, rr = r & 31;
      if (rr < 16) {
        bf16x8 x2 = *(const bf16x8*)(sp + 16);
        bf16x8 o1, o2;
        rope_chunk(seq_pos(tok), rr, v, x2, o1, o2);
        *(bf16x8*)(Qa + (size_t)tok * 768 + head * 96 + 64 + rr) = o1;
        *(bf16x8*)(Qa + (size_t)tok * 768 + head * 96 + 80 + rr) = o2;
      }
    }
  }
};

struct EpiKVUp {
  static constexpr bool staged = true;
  bf16_t *KNb, *VtA;
  __device__ float scale() const { return 1.f; }
  __device__ bool transposed(int n0) const { return n0 >= 512; }
  template <int NI> __device__ void direct(int m0, int n0, int wm, int wn, int g, int c, f32x4 (&acc)[4][NI], const float* sR) const {}
  __device__ void store_t(int tok8, int col, bf16x8 v) const { *(bf16x8*)(VtA + (size_t)(col - 512) * T_TOK + tok8) = v; }
  __device__ void store_n(int tok, int col, bf16x8 v, const bf16_t* sp) const { *(bf16x8*)(KNb + (size_t)tok * 512 + col) = v; }
};

struct EpiOut {
  static constexpr bool staged = false;
  const float *xa, *xb;
  float* out;
  bool dry;
  bf16_t* hb;
  float* ssq;
  __device__ void operator()(int m0, int n0, int wm, int wn, int g, int c, f32x4 (&acc)[4][8], const float* sR) const {
    const int lane = g * 16 + c;
#pragma unroll
    for (int mi = 0; mi < 4; ++mi) {
      const int tok = m0 + wm * 64 + mi * 16 + 4 * g;
      float rs[4] = {0.f, 0.f, 0.f, 0.f};
#pragma unroll
      for (int ni = 0; ni < 8; ++ni) {
        __builtin_amdgcn_sched_barrier(0);
        const int col = n0 + wn * 128 + ni * 16 + c;
#pragma unroll
        for (int j = 0; j < 4; ++j) {
          const float xn = xrow(xa, xb, tok + j)[col] + acc[mi][ni][j];
          rs[j] += xn * xn;
          if (!dry) {
            out[(long)(tok + j) * DM + col] = xn;
            if (hb) hb[(long)(tok + j) * DM + col] = f2bf(xn);
          }
        }
      }
      __builtin_amdgcn_sched_barrier(0);
#pragma unroll
      for (int j = 0; j < 4; ++j) {
        float v = rs[j];
        v += sxor(v, 1, lane); v += sxor(v, 2, lane); v += sxor(v, 4, lane); v += sxor(v, 8, lane);
        if (c == 0 && !dry) ssq[(size_t)(tok + j) * 8 + (n0 >> 8) * 2 + wn] = v;
      }
    }
  }
};

__device__ __forceinline__ float scan16(float v, int c, int lane) {
  float t;
  t = bperm(lane - 1, v); if (c >= 1) v += t;
  t = bperm(lane - 2, v); if (c >= 2) v += t;
  t = bperm(lane - 4, v); if (c >= 4) v += t;
  t = bperm(lane - 8, v); if (c >= 8) v += t;
  return v;
}

__device__ __forceinline__ float logsig_fast(float x) { return fminf(x, 0.f) - __logf(1.f + __expf(-fabsf(x))); }

__device__ void gla_intra_item(const Params& p, int li, int item, char* smem, bool dry = false) {
  const int tid = otid(), lane = tid & 63, w = tid >> 6, c = lane & 15, g = lane >> 4;
  const int ci = item >> 2, h = item & 3;
  const int tokc = ci * 64;
  const float qscale = 0.08838834764831845f;
  bf16_t* sQe = (bf16_t*)smem;
  bf16_t* sKd = sQe + 64 * 136;
  bf16_t* sA = sKd + 64 * 136;
  us4 q4[2][4];
  bf16_t kk[2][4][4];
#pragma unroll
  for (int dt = 0; dt < 2; ++dt)
#pragma unroll
    for (int tt = 0; tt < 4; ++tt) {
      q4[dt][tt] = *(const us4*)(p.Qb + (size_t)(tokc + 16 * tt + c) * 512 + h * 128 + 32 * w + 16 * dt + 4 * g);
#pragma unroll
      for (int j = 0; j < 4; ++j)
        kk[dt][tt][j] = p.Kt[(size_t)(h * 128 + 32 * w + 16 * dt + 4 * g + j) * T_TOK + tokc + 16 * tt + c];
    }
  __syncthreads();
#pragma unroll
  for (int dir = 0; dir < 2; ++dir) {
    bf16_t* QEd = (dir || dry) ? p.QEb : p.Qb;
    bf16_t* KdTd = (dir || dry) ? p.KdTb : p.Kt;
    bf16x8 aup[2];
    float bias[2][4];
#pragma unroll
    for (int dt = 0; dt < 2; ++dt) {
      aup[dt] = zero8();
      if (g < 2) aup[dt] = *(const bf16x8*)(p.AupT + ((size_t)(li * 2 + dir) * 512 + h * 128 + 32 * w + 16 * dt + c) * 32 + 8 * g);
#pragma unroll
      for (int j = 0; j < 4; ++j) bias[dt][j] = p.e_a_bias[(li * 2 + dir) * 512 + h * 128 + 32 * w + 16 * dt + 4 * g + j];
    }
    f32x4 la[2][4];
#pragma unroll
    for (int tt = 0; tt < 4; ++tt) {
      bf16x8 lrf = zero8();
      if (g < 2) lrf = *(const bf16x8*)(p.LRb + (size_t)(tokc + 16 * tt + c) * 32 + dir * 16 + 8 * g);
#pragma unroll
      for (int dt = 0; dt < 2; ++dt) la[dt][tt] = mfma16(aup[dt], lrf, zero4());
    }
#pragma unroll
    for (int dt = 0; dt < 2; ++dt)
#pragma unroll
      for (int tt = 0; tt < 4; ++tt)
#pragma unroll
        for (int j = 0; j < 4; ++j) la[dt][tt][j] = logsig_fast(la[dt][tt][j] + bias[dt][j]) * (1.f / 16.f);
    f32x4 P[2][4];
    float tot[2][4];
#pragma unroll
    for (int dt = 0; dt < 2; ++dt)
#pragma unroll
      for (int j = 0; j < 4; ++j) {
        float carry = 0.f;
#pragma unroll
        for (int tt = 0; tt < 4; ++tt) {
          float v = scan16(la[dt][tt][j], c, lane) + carry;
          P[dt][tt][j] = v;
          carry = bperm(lane | 15, v);
        }
        tot[dt][j] = carry;
      }
#pragma unroll
    for (int dt = 0; dt < 2; ++dt)
#pragma unroll
      for (int tt = 0; tt < 4; ++tt) {
        us4 qo, ko;
#pragma unroll
        for (int j = 0; j < 4; ++j) {
          const float b = (dir == 0) ? P[dt][tt][j] : (tot[dt][j] - P[dt][tt][j] + la[dt][tt][j]);
          qo[j] = f2bf(bf2f(q4[dt][tt][j]) * __expf(b) * qscale);
          ko[j] = f2bf(bf2f(kk[dt][tt][j]) * __expf(-b));
          KdTd[(size_t)(h * 128 + 32 * w + 16 * dt + 4 * g + j) * T_TOK + tokc + 16 * tt + c] = ko[j];
        }
        *(us4*)(QEd + (size_t)(tokc + 16 * tt + c) * 512 + h * 128 + 32 * w + 16 * dt + 4 * g) = qo;
        *(us4*)(sQe + (16 * tt + c) * 136 + 32 * w + 16 * dt + 4 * g) = qo;
        *(us4*)(sKd + (16 * tt + c) * 136 + 32 * w + 16 * dt + 4 * g) = ko;
      }
    if (c == 0) {
#pragma unroll
      for (int dt = 0; dt < 2; ++dt)
#pragma unroll
        for (int j = 0; j < 4; ++j)
          p.EB[(size_t)(dir * 1280 + ci) * 512 + h * 128 + 32 * w + 16 * dt + 4 * g + j] = __expf(tot[dt][j]);
    }
    __syncthreads();
    f32x4 accA[4];
#pragma unroll
    for (int jt = 0; jt < 4; ++jt) accA[jt] = zero4();
#pragma unroll
    for (int ks = 0; ks < 4; ++ks) {
      bf16x8 aq = *(const bf16x8*)(sQe + (16 * w + c) * 136 + 32 * ks + 8 * g);
#pragma unroll
      for (int jt = 0; jt < 4; ++jt) {
        bf16x8 bk = *(const bf16x8*)(sKd + (16 * jt + c) * 136 + 32 * ks + 8 * g);
        accA[jt] = mfma16(aq, bk, accA[jt]);
      }
    }
#pragma unroll
    for (int jt = 0; jt < 4; ++jt)
#pragma unroll
      for (int j = 0; j < 4; ++j) {
        const int i = 16 * w + 4 * g + j, jj = 16 * jt + c;
        const bool keep = (dir == 0) ? (jj <= i) : (jj > i);
        sA[dir * 64 * 72 + i * 72 + jj] = f2bf(keep ? accA[jt][j] : 0.f);
      }
    __syncthreads();
  }
  bf16x8 af[2][2];
#pragma unroll
  for (int dir = 0; dir < 2; ++dir)
#pragma unroll
    for (int k2 = 0; k2 < 2; ++k2) af[dir][k2] = *(const bf16x8*)(sA + dir * 64 * 72 + (16 * w + c) * 72 + 32 * k2 + 8 * g);
#pragma unroll 4
  for (int vt = 0; vt < 16; ++vt) {
    f32x4 a = zero4();
#pragma unroll
    for (int k2 = 0; k2 < 2; ++k2) {
      bf16x8 vfr = *(const bf16x8*)(p.VtE + (size_t)(h * 256 + 16 * vt + c) * T_TOK + tokc + 32 * k2 + 8 * g);
      a = mfma16(af[0][k2], vfr, a);
      a = mfma16(af[1][k2], vfr, a);
    }
#pragma unroll
    for (int j = 0; j < 4; ++j) p.TMP[(size_t)(tokc + 16 * w + 4 * g + j) * 1024 + h * 256 + 16 * vt + c] = f2bf(a[j]);
  }
}

__device__ __forceinline__ void lds_barrier() { asm volatile("s_waitcnt lgkmcnt(0)\n\ts_barrier" ::: "memory"); }

struct GlaRegs {
  bf16x8 aq[4];
  bf16x8 vf[2][2];
  bf16x8 kf[2][2];
  float eb[2];
  unsigned told[2][4];
};

template <int DIR>
__device__ __forceinline__ void gla_chain_load(const Params& p, int h, int sl, int tokc, int w, int c, int g, GlaRegs& r) {
  const bf16_t* QE = DIR ? p.QEb : p.Qb;
  const bf16_t* KdT = DIR ? p.KdTb : p.Kt;
#pragma unroll
  for (int ks = 0; ks < 4; ++ks) r.aq[ks] = *(const bf16x8*)(QE + (size_t)(tokc + 16 * w + c) * 512 + h * 128 + 32 * ks + 8 * g);
#pragma unroll
  for (int vt = 0; vt < 2; ++vt)
#pragma unroll
    for (int k2 = 0; k2 < 2; ++k2)
      r.vf[vt][k2] = *(const bf16x8*)(p.VtE + (size_t)(h * 256 + sl * 32 + 16 * vt + c) * T_TOK + tokc + 32 * k2 + 8 * g);
#pragma unroll
  for (int dt = 0; dt < 2; ++dt) {
#pragma unroll
    for (int k2 = 0; k2 < 2; ++k2)
      r.kf[dt][k2] = *(const bf16x8*)(KdT + (size_t)(h * 128 + 32 * w + 16 * dt + c) * T_TOK + tokc + 32 * k2 + 8 * g);
    r.eb[dt] = p.EB[(size_t)(DIR * 1280 + (tokc >> 6)) * 512 + h * 128 + 32 * w + 16 * dt + c];
  }
#pragma unroll
  for (int vt = 0; vt < 2; ++vt)
#pragma unroll
    for (int j = 0; j < 4; ++j) r.told[vt][j] = p.TMP[(size_t)(tokc + 16 * w + 4 * g + j) * 1024 + h * 256 + sl * 32 + 16 * vt + c];
}

__device__ __forceinline__ void gla_chain_compute(const Params& p, int h, int sl, int tokc, int w, int c, int g, const GlaRegs& r,
                                                  f32x4 (&S)[2][2], bf16_t* sSt, bool dry, bool reload) {
  unsigned told[2][4];
#pragma unroll
  for (int vt = 0; vt < 2; ++vt)
#pragma unroll
    for (int j = 0; j < 4; ++j) told[vt][j] = r.told[vt][j];
  if (reload) {
#pragma unroll
    for (int vt = 0; vt < 2; ++vt)
#pragma unroll
      for (int j = 0; j < 4; ++j) told[vt][j] = p.TMP[(size_t)(tokc + 16 * w + 4 * g + j) * 1024 + h * 256 + sl * 32 + 16 * vt + c];
  }
#pragma unroll
  for (int vt = 0; vt < 2; ++vt)
#pragma unroll
    for (int dt = 0; dt < 2; ++dt)
#pragma unroll
      for (int j = 0; j < 4; ++j) sSt[(16 * vt + 4 * g + j) * 136 + 32 * w + 16 * dt + c] = f2bf(S[vt][dt][j]);
  lds_barrier();
  f32x4 o[2];
  o[0] = zero4(); o[1] = zero4();
#pragma unroll
  for (int ks = 0; ks < 4; ++ks)
#pragma unroll
    for (int vt = 0; vt < 2; ++vt) {
      bf16x8 sf = *(const bf16x8*)(sSt + (16 * vt + c) * 136 + 32 * ks + 8 * g);
      o[vt] = mfma16(r.aq[ks], sf, o[vt]);
    }
#pragma unroll
  for (int dt = 0; dt < 2; ++dt)
#pragma unroll
    for (int vt = 0; vt < 2; ++vt) {
      f32x4 a = S[vt][dt];
#pragma unroll
      for (int k2 = 0; k2 < 2; ++k2) a = mfma16(r.vf[vt][k2], r.kf[dt][k2], a);
      S[vt][dt] = a * r.eb[dt];
    }
#pragma unroll
  for (int vt = 0; vt < 2; ++vt)
#pragma unroll
    for (int j = 0; j < 4; ++j)
      if (!dry) p.TMP[(size_t)(tokc + 16 * w + 4 * g + j) * 1024 + h * 256 + sl * 32 + 16 * vt + c] = f2bf(bf2f((bf16_t)told[vt][j]) + o[vt][j]);
}

__device__ void gla_chain_item(const Params& p, int li, int item, char* smem, bool dry = false) {
  const int tid = otid(), lane = tid & 63, w = tid >> 6, c = lane & 15, g = lane >> 4;
  const int xr = item >> 3;
  const int pair = (item & 7) + 8 * (xr >> 3), sl = xr & 7;
  const int s = pair < 32 ? 4 + (pair >> 2) : ((pair - 32) >> 2);
  const int h = pair & 3;
  const int tok0 = s < 4 ? s * 4096 : T_P + (s - 4) * 8192;
  const int len = s < 4 ? 4096 : 8192;
  const int N = len / 64;
  bf16_t* sSt0 = (bf16_t*)smem;
  bf16_t* sSt1 = sSt0 + 32 * 136;
  f32x4 Sf[2][2], Sb[2][2];
#pragma unroll
  for (int a = 0; a < 2; ++a)
#pragma unroll
    for (int b = 0; b < 2; ++b) { Sf[a][b] = zero4(); Sb[a][b] = zero4(); }
  GlaRegs rf, rb;
  __syncthreads();
  gla_chain_load<0>(p, h, sl, tok0, w, c, g, rf);
  for (int step = 0; step < N; ++step) {
    const int tf = tok0 + step * 64, tb = tok0 + (N - 1 - step) * 64;
    gla_chain_load<1>(p, h, sl, tb, w, c, g, rb);
    gla_chain_compute(p, h, sl, tf, w, c, g, rf, Sf, sSt0, dry, step == (N >> 1));
    if (step + 1 < N) gla_chain_load<0>(p, h, sl, tf + 64, w, c, g, rf);
    gla_chain_compute(p, h, sl, tb, w, c, g, rb, Sb, sSt1, dry, false);
  }
}

__device__ void pool_item(const Params& p, int li, int item, char* smem, bool dry = false) {
  const int tid = otid(), lane = tid & 63, w = tid >> 6, c = lane & 15, g = lane >> 4;
  const int gi = item & 3;
  const int tile = item >> 2;
  const int tokc = tile * 64;
  const int pos0 = seq_pos(tokc);
  const int len = tokc < T_P ? 4096 : 8192;
  float* sU = (float*)smem;
  bf16_t* sP = (bf16_t*)(sU + 80 * 128);
  __syncthreads();
  for (int idx = tid; idx < 80 * 128; idx += 256) {
    int r = idx >> 7, ch = idx & 127;
    int pos = pos0 - 8 + r;
    float v = 0.f;
    if (pos >= 0 && pos < len) v = bf2f(p.PUb[(long)(tokc - 8 + r) * 512 + gi * 128 + ch]);
    sU[idx] = v;
  }
  __syncthreads();
  {
    const int ch = tid & 127, th = tid >> 7;
    const int half = 1 << gi;
    for (int t = th * 32; t < th * 32 + 32; ++t) {
      int pos = pos0 + t;
      int lo = max(pos - half, 0), hi = min(pos + half, len);
      float s = 0.f;
      for (int q = lo; q < hi; ++q) s += sU[(q - pos0 + 8) * 128 + ch];
      float pooled = s / (float)(hi - lo) - sU[(t + 8) * 128 + ch];
      sP[t * 136 + ch] = f2bf(pooled);
    }
  }
  __syncthreads();
  f32x4 acc[8];
#pragma unroll
  for (int dt = 0; dt < 8; ++dt) acc[dt] = zero4();
  const bf16_t* PW = p.PoolWT + (long)(li * 4 + gi) * 128 * 128;
#pragma unroll
  for (int ks = 0; ks < 4; ++ks) {
    bf16x8 af = *(const bf16x8*)(sP + (16 * w + c) * 136 + 32 * ks + 8 * g);
#pragma unroll
    for (int dt = 0; dt < 8; ++dt) {
      bf16x8 bw = *(const bf16x8*)(PW + (long)(16 * dt + c) * 128 + 32 * ks + 8 * g);
      acc[dt] = mfma16(af, bw, acc[dt]);
    }
  }
#pragma unroll
  for (int dt = 0; dt < 8; ++dt) {
    const int d = gi * 128 + 16 * dt + c;
    const float sc = p.e_pool_scale[li * 512 + d];
#pragma unroll
    for (int j = 0; j < 4; ++j) {
      const long addr = (long)(tokc + 16 * w + 4 * g + j) * 512 + d;
      float gt = bf2f(p.PGb[addr]);
      if (!dry) p.PGb[addr] = f2bf(acc[dt][j] * sc * siluf_(gt));
    }
  }
}

__device__ void ml_intra_item(const Params& p, int li, int item, char* smem) {
  const int tid = otid(), lane = tid & 63, w = tid >> 6, c = lane & 15, g = lane >> 4;
  const int ci = item >> 2, h = item & 3;
  const int tokc = ci * 64;
  const float kscale = 0.08838834764831845f;
  bf16_t* sA = (bf16_t*)smem;
  float* sBv = (float*)(sA + 2 * 64 * 72);
  float* sCB = sBv + 128;
  __syncthreads();
  if (w < 2) {
    const int dir = w;
    const float bi = p.o_if_bias[li * 16 + dir * 4 + h];
    const float bff = p.o_if_bias[li * 16 + 8 + dir * 4 + h];
    const float* mf = p.MIF + (size_t)(tokc + lane) * 16;
    const float liv = mf[dir * 4 + h] + bi;
    const float lfv = logsig_fast(mf[8 + dir * 4 + h] + bff);
    float ps = lfv;
#pragma unroll
    for (int d = 1; d < 64; d <<= 1) {
      float t = bperm(lane - d, ps);
      if (lane >= d) ps += t;
    }
    const float total = __int_as_float(__builtin_amdgcn_readlane(__float_as_int(ps), 63));
    const float b = (dir == 0) ? ps : (total - ps + lfv);
    const float cB = liv - b;
    sBv[dir * 64 + lane] = b;
    sCB[dir * 64 + lane] = cB;
    const size_t so = (size_t)(dir * 4 + h) * T_TOK + tokc + lane;
    p.EBI[so] = __expf(b);
    p.WKg[so] = __expf(total + cB) * kscale;
    if (lane == 0) p.DEC[(dir * 4 + h) * 1280 + ci] = __expf(total);
  }
  f32x4 accA[4];
#pragma unroll
  for (int jt = 0; jt < 4; ++jt) accA[jt] = zero4();
#pragma unroll
  for (int ks = 0; ks < 4; ++ks) {
    bf16x8 aq = *(const bf16x8*)(p.MQb + (size_t)(tokc + 16 * w + c) * 512 + h * 128 + 32 * ks + 8 * g);
#pragma unroll
    for (int jt = 0; jt < 4; ++jt) {
      bf16x8 bk = *(const bf16x8*)(p.MKb + (size_t)(tokc + 16 * jt + c) * 512 + h * 128 + 32 * ks + 8 * g);
      accA[jt] = mfma16(aq, bk, accA[jt]);
    }
  }
  __syncthreads();
#pragma unroll
  for (int dir = 0; dir < 2; ++dir)
#pragma unroll
    for (int jt = 0; jt < 4; ++jt)
#pragma unroll
      for (int j = 0; j < 4; ++j) {
        const int i = 16 * w + 4 * g + j, jj = 16 * jt + c;
        const bool keep = (dir == 0) ? (jj <= i) : (jj > i);
        const float sv = keep ? accA[jt][j] * kscale * __expf(sBv[dir * 64 + i] + sCB[dir * 64 + jj]) : 0.f;
        sA[dir * 64 * 72 + i * 72 + jj] = f2bf(sv);
      }
  __syncthreads();
  bf16x8 ones = zero8();
  if (c == 0) {
#pragma unroll
    for (int e = 0; e < 8; ++e) ones[e] = (short)0x3F80;
  }
#pragma unroll
  for (int dir = 0; dir < 2; ++dir) {
    bf16_t* NUMI = dir ? p.NUMIb : p.NUMIf;
    bf16x8 af[2];
#pragma unroll
    for (int k2 = 0; k2 < 2; ++k2) af[k2] = *(const bf16x8*)(sA + dir * 64 * 72 + (16 * w + c) * 72 + 32 * k2 + 8 * g);
    f32x4 dn = zero4();
    dn = mfma16(af[0], ones, dn);
    dn = mfma16(af[1], ones, dn);
    if (c == 0) {
#pragma unroll
      for (int j = 0; j < 4; ++j) p.DENI[(size_t)(dir * 4 + h) * T_TOK + tokc + 16 * w + 4 * g + j] = dn[j];
    }
#pragma unroll 4
    for (int vt = 0; vt < 8; ++vt) {
      f32x4 a = zero4();
#pragma unroll
      for (int k2 = 0; k2 < 2; ++k2) {
        bf16x8 vfr = *(const bf16x8*)(p.MVt + (size_t)(h * 128 + 16 * vt + c) * T_TOK + tokc + 32 * k2 + 8 * g);
        a = mfma16(af[k2], vfr, a);
      }
#pragma unroll
      for (int j = 0; j < 4; ++j) NUMI[(size_t)(tokc + 16 * w + 4 * g + j) * 512 + h * 128 + 16 * vt + c] = f2bf(a[j]);
    }
  }
}

struct MlRegs {
  bf16x8 aq[4];
  bf16x8 vf[2];
  bf16x8 kf[2][2];
  f32x4 wk[2][2];
  f32x4 ebi, deni;
  float dec;
  unsigned numi[4];
};

template <int DIR>
__device__ __forceinline__ void ml_chain_load(const Params& p, int h, int sl, int tokc, int w, int c, int g, MlRegs& r) {
#pragma unroll
  for (int ks = 0; ks < 4; ++ks) r.aq[ks] = *(const bf16x8*)(p.MQb + (size_t)(tokc + 16 * w + c) * 512 + h * 128 + 32 * ks + 8 * g);
#pragma unroll
  for (int k2 = 0; k2 < 2; ++k2)
    r.vf[k2] = *(const bf16x8*)(p.MVt + (size_t)(h * 128 + sl * 16 + c) * T_TOK + tokc + 32 * k2 + 8 * g);
#pragma unroll
  for (int dt = 0; dt < 2; ++dt)
#pragma unroll
    for (int k2 = 0; k2 < 2; ++k2)
      r.kf[dt][k2] = *(const bf16x8*)(p.MKt + (size_t)(h * 128 + 32 * w + 16 * dt + c) * T_TOK + tokc + 32 * k2 + 8 * g);
  const size_t so = (size_t)(DIR * 4 + h) * T_TOK + tokc;
#pragma unroll
  for (int k2 = 0; k2 < 2; ++k2) {
    r.wk[k2][0] = *(const f32x4*)(p.WKg + so + 32 * k2 + 8 * g);
    r.wk[k2][1] = *(const f32x4*)(p.WKg + so + 32 * k2 + 8 * g + 4);
  }
  r.ebi = *(const f32x4*)(p.EBI + so + 16 * w + 4 * g);
  r.deni = *(const f32x4*)(p.DENI + so + 16 * w + 4 * g);
  r.dec = p.DEC[(DIR * 4 + h) * 1280 + (tokc >> 6)];
  const bf16_t* NUMI = DIR ? p.NUMIb : p.NUMIf;
#pragma unroll
  for (int j = 0; j < 4; ++j) r.numi[j] = NUMI[(size_t)(tokc + 16 * w + 4 * g + j) * 512 + h * 128 + sl * 16 + c];
}

template <int DIR>
__device__ __forceinline__ void ml_chain_compute(const Params& p, int h, int sl, int tokc, int lane, int w, int c, int g, const MlRegs& r,
                                                 f32x4 (&C)[2][2], bf16_t* sCt, bool dry) {
  bf16_t* NUMI = DIR ? p.NUMIb : p.NUMIf;
  unsigned numi[4];
#pragma unroll
  for (int j = 0; j < 4; ++j) numi[j] = r.numi[j];
#pragma unroll
  for (int vt = 0; vt < 2; ++vt)
#pragma unroll
    for (int dt = 0; dt < 2; ++dt)
#pragma unroll
      for (int j = 0; j < 4; ++j) sCt[(16 * vt + 4 * g + j) * 136 + 32 * w + 16 * dt + c] = f2bf(C[vt][dt][j]);
  bf16x8 vfw[2][2];
#pragma unroll
  for (int k2 = 0; k2 < 2; ++k2) {
    float wv[8];
#pragma unroll
    for (int e = 0; e < 4; ++e) { wv[e] = r.wk[k2][0][e]; wv[4 + e] = r.wk[k2][1][e]; }
#pragma unroll
    for (int e = 0; e < 8; ++e) vfw[0][k2][e] = (short)f2bf(bf2f((bf16_t)r.vf[k2][e]) * wv[e]);
#pragma unroll
    for (int e = 0; e < 8; ++e) vfw[1][k2][e] = (c == 0) ? (short)f2bf(wv[e]) : (short)0;
  }
  lds_barrier();
  f32x4 o2[2];
  o2[0] = zero4(); o2[1] = zero4();
#pragma unroll
  for (int ks = 0; ks < 4; ++ks)
#pragma unroll
    for (int vt = 0; vt < 2; ++vt) {
      bf16x8 cf = *(const bf16x8*)(sCt + (16 * vt + c) * 136 + 32 * ks + 8 * g);
      o2[vt] = mfma16(r.aq[ks], cf, o2[vt]);
    }
#pragma unroll
  for (int dt = 0; dt < 2; ++dt)
#pragma unroll
    for (int vt = 0; vt < 2; ++vt) {
      f32x4 a = C[vt][dt] * r.dec;
#pragma unroll
      for (int k2 = 0; k2 < 2; ++k2) a = mfma16(vfw[vt][k2], r.kf[dt][k2], a);
      C[vt][dt] = a;
    }
#pragma unroll
  for (int j = 0; j < 4; ++j) {
    const float e = r.ebi[j];
    float den = e * o2[1][j];
    den = bperm(lane & 48, den) + r.deni[j];
    const float inv = 1.f / fmaxf(fabsf(den), 1.f);
    const float hv = (bf2f((bf16_t)numi[j]) + e * o2[0][j]) * inv;
    if (!dry) NUMI[(size_t)(tokc + 16 * w + 4 * g + j) * 512 + h * 128 + sl * 16 + c] = f2bf(hv);
  }
}

__device__ void ml_chain_item(const Params& p, int li, int item, char* smem, bool dry = false) {
  const int tid = otid(), lane = tid & 63, w = tid >> 6, c = lane & 15, g = lane >> 4;
  const int xr = item >> 3;
  const int pair = (item & 7) + 8 * (xr >> 3), sl = xr & 7;
  const int s = pair < 32 ? 4 + (pair >> 2) : ((pair - 32) >> 2);
  const int h = pair & 3;
  const int tok0 = s < 4 ? s * 4096 : T_P + (s - 4) * 8192;
  const int len = s < 4 ? 4096 : 8192;
  const int N = len / 64;
  bf16_t* sCt0 = (bf16_t*)smem;
  bf16_t* sCt1 = sCt0 + 32 * 136;
  f32x4 Cf[2][2], Cb[2][2];
#pragma unroll
  for (int a = 0; a < 2; ++a)
#pragma unroll
    for (int b = 0; b < 2; ++b) { Cf[a][b] = zero4(); Cb[a][b] = zero4(); }
  MlRegs rf, rb;
  __syncthreads();
  ml_chain_load<0>(p, h, sl, tok0, w, c, g, rf);
  for (int step = 0; step < N; ++step) {
    const int tf = tok0 + step * 64, tb = tok0 + (N - 1 - step) * 64;
    ml_chain_load<1>(p, h, sl, tb, w, c, g, rb);
    ml_chain_compute<0>(p, h, sl, tf, lane, w, c, g, rf, Cf, sCt0, dry);
    if (step + 1 < N) ml_chain_load<0>(p, h, sl, tf + 64, w, c, g, rf);
    ml_chain_compute<1>(p, h, sl, tb, lane, w, c, g, rb, Cb, sCt1, dry);
  }
}

#define ATTN_GLOAD(KT)                                                                              \
  {                                                                                                 \
    const long kb = tok0 + (KT) * 64;                                                               \
    rk0 = *(const bf16x8*)(p.KNb + (kb + (tid >> 3)) * 512 + head * 64 + 8 * (tid & 7));            \
    rk1 = *(const bf16x8*)(p.KNb + (kb + 32 + (tid >> 3)) * 512 + head * 64 + 8 * (tid & 7));       \
    rkr = *(const bf16x8*)(p.KRb + (kb + (tid >> 2)) * 32 + 8 * (tid & 3));                          \
    rv0 = *(const bf16x8*)(p.VtA + (long)(head * 64 + (tid >> 3)) * T_TOK + kb + 8 * (tid & 7));     \
    rv1 = *(const bf16x8*)(p.VtA + (long)(head * 64 + 32 + (tid >> 3)) * T_TOK + kb + 8 * (tid & 7)); \
  }
__device__ void attn_item(const Params& p, int item, char* smem, bool dry = false) {
  const int tid = otid(), lane = tid & 63, w = tid >> 6, c = lane & 15, g = lane >> 4;
  int s, head, qb;
  if (item < 2048) { s = 4 + item / 256; int rem = item % 256; head = rem / 32; qb = rem % 32; }
  else { int it = item - 2048; s = it / 128; int rem = it % 128; head = rem / 16; qb = rem % 16; }
  const int tok0 = s < 4 ? s * 4096 : T_P + (s - 4) * 8192;
  const int len = s < 4 ? 4096 : 8192;
  const int nkv = len / 64;
  bf16_t* sK = (bf16_t*)smem;
  bf16_t* sVt = sK + 64 * 104;
  const int qrow0 = tok0 + qb * 256 + 64 * w;
  bf16_t* sQr = sVt + 64 * 72;
  bf16x8 qf[4][2];
#pragma unroll
  for (int nt = 0; nt < 4; ++nt) {
#pragma unroll
    for (int ks = 0; ks < 2; ++ks)
      qf[nt][ks] = *(const bf16x8*)(p.Qa + (long)(qrow0 + 16 * nt + c) * 768 + head * 96 + 32 * ks + 8 * g);
    bf16x8 qr = *(const bf16x8*)(p.Qa + (long)(qrow0 + 16 * nt + c) * 768 + head * 96 + 64 + 8 * g);
    *(bf16x8*)(sQr + ((w * 4 + nt) * 64 + lane) * 8) = qr;
  }
  f32x4 ot[4][4];
#pragma unroll
  for (int vt = 0; vt < 4; ++vt)
#pragma unroll
    for (int nt = 0; nt < 4; ++nt) ot[vt][nt] = zero4();
  float mrun[4] = {-1e30f, -1e30f, -1e30f, -1e30f}, lrun[4] = {0.f, 0.f, 0.f, 0.f};
  bf16x8 rk0, rk1, rkr, rv0, rv1;
  ATTN_GLOAD(0)
  for (int kt = 0; kt < nkv; ++kt) {
    __syncthreads();
    *(bf16x8*)(sK + (tid >> 3) * 104 + 8 * (tid & 7)) = rk0;
    *(bf16x8*)(sK + (32 + (tid >> 3)) * 104 + 8 * (tid & 7)) = rk1;
    *(bf16x8*)(sK + (tid >> 2) * 104 + 64 + 8 * (tid & 3)) = rkr;
    *(bf16x8*)(sVt + (tid >> 3) * 72 + 8 * (tid & 7)) = rv0;
    *(bf16x8*)(sVt + (32 + (tid >> 3)) * 72 + 8 * (tid & 7)) = rv1;
    __syncthreads();
    if (kt + 1 < nkv) ATTN_GLOAD(kt + 1)
#pragma unroll 1
    for (int half = 0; half < 2; ++half) {
      f32x4 st[2][4];
#pragma unroll
      for (int k4 = 0; k4 < 2; ++k4)
#pragma unroll
        for (int nt = 0; nt < 4; ++nt) st[k4][nt] = zero4();
#pragma unroll
      for (int ks = 0; ks < 2; ++ks)
#pragma unroll
        for (int k4 = 0; k4 < 2; ++k4) {
          bf16x8 kf = *(const bf16x8*)(sK + (32 * half + 16 * k4 + c) * 104 + 32 * ks + 8 * g);
#pragma unroll
          for (int nt = 0; nt < 4; ++nt) st[k4][nt] = mfma16(kf, qf[nt][ks], st[k4][nt]);
        }
      {
        bf16x8 kr0 = *(const bf16x8*)(sK + (32 * half + c) * 104 + 64 + 8 * g);
        bf16x8 kr1 = *(const bf16x8*)(sK + (32 * half + 16 + c) * 104 + 64 + 8 * g);
#pragma unroll
        for (int nt = 0; nt < 4; ++nt) {
          bf16x8 qr = *(const bf16x8*)(sQr + ((w * 4 + nt) * 64 + lane) * 8);
          st[0][nt] = mfma16(kr0, qr, st[0][nt]);
          st[1][nt] = mfma16(kr1, qr, st[1][nt]);
        }
      }
      __builtin_amdgcn_sched_barrier(0);
      bf16x8 pb[4];
#pragma unroll
      for (int nt = 0; nt < 4; ++nt) {
        float mx = -1e30f;
#pragma unroll
        for (int k4 = 0; k4 < 2; ++k4)
#pragma unroll
          for (int j = 0; j < 4; ++j) mx = fmaxf(mx, st[k4][nt][j]);
        mx = fmaxf(mx, sxor(mx, 16, lane));
        mx = fmaxf(mx, sxor(mx, 32, lane));
        const float mn = fmaxf(mrun[nt], mx);
        const float alpha = __builtin_amdgcn_exp2f(mrun[nt] - mn);
        mrun[nt] = mn;
        float psum = 0.f;
#pragma unroll
        for (int k4 = 0; k4 < 2; ++k4)
#pragma unroll
          for (int j = 0; j < 4; ++j) {
            float pv = __builtin_amdgcn_exp2f(st[k4][nt][j] - mn);
            st[k4][nt][j] = pv;
            psum += pv;
          }
        lrun[nt] = lrun[nt] * alpha + psum;
#pragma unroll
        for (int vt = 0; vt < 4; ++vt) ot[vt][nt] = ot[vt][nt] * alpha;
        typedef __attribute__((ext_vector_type(4))) unsigned u32x4;
        u32x4 pk;
        pk[0] = pk2bf(st[0][nt][0], st[0][nt][1]);
        pk[1] = pk2bf(st[0][nt][2], st[0][nt][3]);
        pk[2] = pk2bf(st[1][nt][0], st[1][nt][1]);
        pk[3] = pk2bf(st[1][nt][2], st[1][nt][3]);
        pb[nt] = __builtin_bit_cast(bf16x8, pk);
      }
      __builtin_amdgcn_sched_barrier(0);
#pragma unroll
      for (int vt = 0; vt < 4; ++vt) {
        us4 lo = *(const us4*)(sVt + (16 * vt + c) * 72 + 32 * half + 4 * g);
        us4 hi = *(const us4*)(sVt + (16 * vt + c) * 72 + 32 * half + 16 + 4 * g);
        bf16x8 av;
#pragma unroll
        for (int e = 0; e < 4; ++e) { av[e] = (short)lo[e]; av[4 + e] = (short)hi[e]; }
#pragma unroll
        for (int nt = 0; nt < 4; ++nt) ot[vt][nt] = mfma16(av, pb[nt], ot[vt][nt]);
      }
    }
  }
#pragma unroll
  for (int nt = 0; nt < 4; ++nt) {
    float lt = lrun[nt];
    lt += sxor(lt, 16, lane);
    lt += sxor(lt, 32, lane);
    const float inv = 1.f / lt;
    const long tok = qrow0 + 16 * nt + c;
#pragma unroll
    for (int vt = 0; vt < 4; ++vt) {
      bf16_t* gp = p.MGb + tok * 512 + head * 64 + 16 * vt + 4 * g;
      us4 gt = *(const us4*)gp;
      us4 o;
#pragma unroll
      for (int j = 0; j < 4; ++j) o[j] = f2bf(ot[vt][nt][j] * inv * siluf_(bf2f(gt[j])));
      if (!dry) *(us4*)gp = o;
    }
  }
}

__device__ void phase_gla_combine(const Params& p, int li, bool dry = false) {
  const int tid_ = otid(); const int lane = tid_ & 63, w = tid_ >> 6;
  for (int tok = blockIdx.x * 4 + w; tok < T_TOK; tok += gridDim.x * 4) {
    const bf16_t* tp = p.TMP + (long)tok * 1024 + 16 * lane;
    bf16_t* gp = p.Gb + (long)tok * 1024 + 16 * lane;
    bf16x8 o0 = *(const bf16x8*)tp, o1 = *(const bf16x8*)(tp + 8);
    bf16x8 g0 = *(const bf16x8*)gp, g1 = *(const bf16x8*)(gp + 8);
    float ov[16], gv[16];
#pragma unroll
    for (int e = 0; e < 8; ++e) {
      ov[e] = bf2f((bf16_t)o0[e]); ov[8 + e] = bf2f((bf16_t)o1[e]);
      gv[e] = bf2f((bf16_t)g0[e]); gv[8 + e] = bf2f((bf16_t)g1[e]);
    }
    float ss = 0.f;
#pragma unroll
    for (int e = 0; e < 16; ++e) ss += ov[e] * ov[e];
    ss += sxor(ss, 1, lane); ss += sxor(ss, 2, lane); ss += sxor(ss, 4, lane); ss += sxor(ss, 8, lane);
    const float rs = rsqrtf(ss * (1.f / 256.f) + EPS);
    const float* ng = p.e_gla_norm_g + li * 256 + ((16 * lane) & 255);
    bf16x8 r0, r1;
#pragma unroll
    for (int e = 0; e < 8; ++e) {
      r0[e] = (short)f2bf(ov[e] * rs * ng[e] * siluf_(gv[e]));
      r1[e] = (short)f2bf(ov[8 + e] * rs * ng[8 + e] * siluf_(gv[8 + e]));
    }
    if (!dry) { *(bf16x8*)gp = r0;
    *(bf16x8*)(gp + 8) = r1; }
  }
}

__device__ void phase_ml_combine(const Params& p, int li, bool dry = false) {
  const int tid_ = otid(); const int lane = tid_ & 63, w = tid_ >> 6;
  for (int tok = blockIdx.x * 4 + w; tok < T_TOK; tok += gridDim.x * 4) {
    const long off = (long)tok * 512 + 8 * lane;
    bf16x8 hv = *(const bf16x8*)(p.NUMIf + off);
    bf16x8 hb = *(const bf16x8*)(p.NUMIb + off);
    bf16x8 mo = *(const bf16x8*)(p.MOb + off);
    bf16x8 mg = *(const bf16x8*)(p.MLGb + off);
    float hf[8];
    float ss = 0.f;
#pragma unroll
    for (int e = 0; e < 8; ++e) { hf[e] = bf2f((bf16_t)hv[e]) + bf2f((bf16_t)hb[e]); ss += hf[e] * hf[e]; }
    ss += sxor(ss, 1, lane); ss += sxor(ss, 2, lane); ss += sxor(ss, 4, lane); ss += sxor(ss, 8, lane);
    const float rs = rsqrtf(ss * (1.f / 128.f) + EPS);
    const float* ng = p.o_ml_norm_g + li * 128 + ((8 * lane) & 127);
    bf16x8 r;
#pragma unroll
    for (int e = 0; e < 8; ++e)
      r[e] = (short)f2bf(hf[e] * rs * ng[e] * sigmoidf_(bf2f((bf16_t)mo[e])) * siluf_(bf2f((bf16_t)mg[e])));
    if (!dry) *(bf16x8*)(p.MLGb + off) = r;
  }
}

__device__ void phase_final(const Params& p, bool dry = false) {
  const int tid_ = otid(); const int lane = tid_ & 63, w = tid_ >> 6;
  for (int tok = blockIdx.x * 4 + w; tok < T_TOK; tok += gridDim.x * 4) {
    float* xp = p.out + (long)tok * DM;
    float4 v[4];
    float ss = 0.f;
#pragma unroll
    for (int i = 0; i < 4; ++i) {
      v[i] = *(const float4*)(xp + 4 * lane + 256 * i);
      ss += v[i].x * v[i].x + v[i].y * v[i].y + v[i].z * v[i].z + v[i].w * v[i].w;
    }
#pragma unroll
    for (int d = 1; d < 64; d <<= 1) ss += sxor(ss, d, lane);
    const float rs = rsqrtf(ss * (1.f / 1024.f) + EPS);
#pragma unroll
    for (int i = 0; i < 4; ++i) {
      float4 gq = *(const float4*)(p.final_norm_g + 4 * lane + 256 * i);
      float4 o;
      o.x = v[i].x * rs * gq.x; o.y = v[i].y * rs * gq.y; o.z = v[i].z * rs * gq.z; o.w = v[i].w * rs * gq.w;
      if (!dry) *(float4*)(xp + 4 * lane + 256 * i) = o;
    }
  }
}

__device__ void run_phase(const Params& p, int ph, char* smem) {
  if (ph == 0) { if (PH_ON(0)) phase_prep(p); return; }
  if (ph == NPHASE - 1) { if (PROBE_B) phase_final(p, true); if (PH_ON(11)) phase_final(p); return; }
  const int q = ph - 1;
  const int layer = (q < 5) ? 0 : (q < 12) ? 1 : (q < 17) ? 2 : 3;
  const int sub = (q < 5) ? q : (q < 12) ? q - 5 : (q < 17) ? q - 12 : q - 17;
  const int li = layer >> 1;
  const float* xa = (layer == 0) ? p.x_prompt : p.out;
  const float* xb = (layer == 0) ? p.x_sample : p.out + (long)T_P * DM;
  if ((layer & 1) == 0) {
    if (sub == 0) {
      EpiEvenIn e{p.Qb, p.Kt, p.VtE, p.Gb, p.LRb, p.PUb, p.PGb};
      if (PH_ON(1)) gemm_phase<3, 8>(T_TOK / 128, NE_PAD / 256, DM, p.WinE + (long)li * NE_PAD * DM, p.SSQ, nullptr, p.TMP, DM, DM, p.TMP, DM, e, smem);
    } else if (sub == 1) {
#if PROBE_A
      for (int item = blockIdx.x; item < 5120; item += gridDim.x) gla_intra_item(p, li, item, smem, true);
#endif
#if PROBE_B
      for (int item = blockIdx.x; item < 5120; item += gridDim.x) pool_item(p, li, item, smem, true);
#endif
      for (int item = blockIdx.x; item < 5120 + 5120; item += gridDim.x) {
        if (item < 5120) { if (PH_ON(2)) gla_intra_item(p, li, item, smem); }
        else { if (PH_ON(3)) pool_item(p, li, item - 5120, smem); }
      }
    } else if (sub == 2) {
      for (int rep = PROBE_CHAIN ? 0 : 1; rep < 2; ++rep)
      for (int item = blockIdx.x; item < 384; item += gridDim.x)
        if (PH_ON(2)) gla_chain_item(p, li, item, smem, rep == 0);
    } else if (sub == 3) {
      if (PROBE_B) phase_gla_combine(p, li, true);
      if (PH_ON(4)) phase_gla_combine(p, li);
    } else {
      EpiOut e{xa, xb, p.out, false, p.NUMIf, p.SSQ};
      if (PH_ON(5)) gemm_phase<1, 8>(T_TOK / 128, DM / 256, 1536, p.WoutE + (long)li * DM * 1536, nullptr, nullptr, p.Gb, 1024, 1024, p.PGb, 512, e, smem);
    }
  } else {
    if (sub == 0) {
      EpiOddIn e{p.CQb, p.CKVb, p.KRb, p.MGb, p.MQb, p.MKb, p.MKt, p.MVt, p.MOb, p.MLGb, p.MIF};
      if (PH_ON(6)) gemm_phase<3, 8>(T_TOK / 128, NO_PAD / 256, DM, p.WinO + (long)li * NO_PAD * DM, p.SSQ, nullptr, p.NUMIf, DM, DM, p.NUMIf, DM, e, smem);
    } else if (sub == 1) {
      for (int rep = 0; rep < 1 + PROBE_A; ++rep)
      for (int item = blockIdx.x; item < 5120; item += gridDim.x)
        if (PH_ON(8)) ml_intra_item(p, li, item, smem);
    } else if (sub == 2) {
      for (int rep = PROBE_MLCHAIN ? 0 : 1; rep < 2; ++rep)
      for (int item = blockIdx.x; item < 384; item += gridDim.x)
        if (PH_ON(8)) ml_chain_item(p, li, item, smem, rep == 0);
    } else if (sub == 3) {
      if (PROBE_B) phase_ml_combine(p, li, true);
      if (PH_ON(10)) phase_ml_combine(p, li);
    } else if (sub == 4) {
      EpiQUp eq{p.Qa};
      if (PH_ON(7)) gemm_phase<2, 4>(T_TOK / 128, 768 / 128, 384, p.QupT + (long)li * 768 * 384, nullptr, nullptr, p.CQb, 384, 384, p.CQb, 384, eq, smem);
      EpiKVUp ek{p.KNb, p.VtA};
      if (PH_ON(7)) gemm_phase<2, 4>(T_TOK / 128, 1024 / 128, 256, p.KVupT + (long)li * 1024 * 256, nullptr, nullptr, p.CKVb, 256, 256, p.CKVb, 256, ek, smem);
    } else if (sub == 5) {
      __shared__ int s_item;
      for (;;) {
        __syncthreads();
        if (threadIdx.x == 0) s_item = atomicAdd(p.counters + li, 1);
        __syncthreads();
        const int item = s_item;
        if (item >= 2560) break;
        if (PH_ON(9)) attn_item(p, item, smem);
      }
    } else {
      EpiOut e{xa, xb, p.out, false, (layer == 3) ? nullptr : p.TMP, p.SSQ};
      if (PH_ON(5)) gemm_phase<1, 8>(T_TOK / 128, DM / 256, 1024, p.WoutO + (long)li * DM * 1024, nullptr, nullptr, p.MGb, 512, 512, p.MLGb, 512, e, smem);
    }
  }
}

__global__ void __launch_bounds__(256, 2) mega_kernel(Params p) {
  extern __shared__ __attribute__((aligned(16))) char smem[];
  cg::grid_group grid = cg::this_grid();
  __shared__ uint4 xb_words;
  if (threadIdx.x == 0) xb_words = make_uint4(0u, 0u, 0u, 0u);
  __syncthreads();
  XcdBarrier xb = xcd_barrier_post(p.bar, (volatile LAS unsigned*)&xb_words);
  for (int ph = p.ph_lo; ph < p.ph_hi; ++ph) {
    if (ph > p.ph_lo) {
      if (ph == p.ph_lo + 1) grid.sync();
      else xcd_barrier(xb);
    }
    run_phase(p, ph, smem);
  }
}

extern "C" void kernel_launch(void* const* d_in, const int* in_sizes, int n_in, void* d_out, int out_size, void* d_ws,
                              size_t ws_size, hipStream_t stream) {
  static int grid_blocks = 0;
  if (!grid_blocks) {
    int dev = 0, cus = 0, per_cu = 0;
    hipGetDevice(&dev);
    hipDeviceGetAttribute(&cus, hipDeviceAttributeMultiprocessorCount, dev);
    hipFuncSetAttribute((const void*)mega_kernel, hipFuncAttributeMaxDynamicSharedMemorySize, LDS_BYTES);
    hipOccupancyMaxActiveBlocksPerMultiprocessor(&per_cu, (const void*)mega_kernel, 256, LDS_BYTES);
    if (per_cu < 1) per_cu = 1;
    if (per_cu > 2) per_cu = 2;
    grid_blocks = cus * per_cu;
    fprintf(stderr, "kernel_launch: cus %d per_cu %d grid %d ws %zu\n", cus, per_cu, grid_blocks, ws_size);
  }
  Params p{};
  const float** pin = (const float**)&p;
  for (int i = 0; i < 19; ++i) pin[i] = (const float*)d_in[i];
  p.out = (float*)d_out;
  char* ws = (char*)d_ws;
  size_t off = 0;
  auto take = [&](size_t bytes) { char* r = ws + off; off += (bytes + 255) & ~(size_t)255; return r; };
  p.WinE = (bf16_t*)take((size_t)2 * NE_PAD * DM * 2);
  p.WinO = (bf16_t*)take((size_t)2 * NO_PAD * DM * 2);
  p.WoutE = (bf16_t*)take((size_t)2 * DM * 1536 * 2);
  p.WoutO = (bf16_t*)take((size_t)2 * DM * 1024 * 2);
  p.QupT = (bf16_t*)take((size_t)2 * 768 * 384 * 2);
  p.KVupT = (bf16_t*)take((size_t)2 * 1024 * 256 * 2);
  p.PoolWT = (bf16_t*)take((size_t)2 * 4 * 128 * 128 * 2);
  p.AupT = (bf16_t*)take((size_t)2 * 2 * 512 * 32 * 2);
  p.counters = (int*)take(256);
  p.bar = (unsigned*)take((size_t)XCD_BAR_WORDS * 4);
  p.SSQ = (float*)take((size_t)T_TOK * 8 * 4);
  const size_t act0 = off;
  const size_t T = T_TOK;
  p.Gb = (bf16_t*)take(T * 1024 * 2);
  p.PGb = (bf16_t*)take(T * 512 * 2);
  p.Qb = (bf16_t*)take(T * 512 * 2);
  p.Kt = (bf16_t*)take(T * 512 * 2);
  p.QEb = (bf16_t*)take(T * 512 * 2);
  p.KdTb = (bf16_t*)take(T * 512 * 2);
  p.EB = (float*)take((size_t)2 * 1280 * 512 * 4);
  p.VtE = (bf16_t*)take(T * 1024 * 2);
  p.LRb = (bf16_t*)take(T * 32 * 2);
  p.PUb = (bf16_t*)take(T * 512 * 2);
  p.TMP = (bf16_t*)take(T * 1024 * 2);
  const size_t even_end = off;
  off = act0;
  p.MGb = (bf16_t*)take(T * 512 * 2);
  p.MLGb = (bf16_t*)take(T * 512 * 2);
  p.CQb = (bf16_t*)take(T * 384 * 2);
  p.CKVb = (bf16_t*)take(T * 256 * 2);
  p.KRb = (bf16_t*)take(T * 32 * 2);
  const size_t r2 = off;
  p.MQb = (bf16_t*)take(T * 512 * 2);
  p.MKb = (bf16_t*)take(T * 512 * 2);
  p.MKt = (bf16_t*)take(T * 512 * 2);
  p.MVt = (bf16_t*)take(T * 512 * 2);
  p.MOb = (bf16_t*)take(T * 512 * 2);
  p.NUMIf = (bf16_t*)take(T * 512 * 2);
  p.NUMIb = (bf16_t*)take(T * 512 * 2);
  p.MIF = (float*)take(T * 16 * 4);
  p.EBI = (float*)take(T * 8 * 4);
  p.WKg = (float*)take(T * 8 * 4);
  p.DENI = (float*)take(T * 8 * 4);
  p.DEC = (float*)take((size_t)8 * 1280 * 4);
  const size_t r2_end = off;
  off = r2;
  p.Qa = (bf16_t*)take(T * 768 * 2);
  p.KNb = (bf16_t*)take(T * 512 * 2);
  p.VtA = (bf16_t*)take(T * 512 * 2);
  if (off < r2_end) off = r2_end;
  const size_t odd_end = off;
  const size_t need = even_end > odd_end ? even_end : odd_end;
  if (need > ws_size) {
    fprintf(stderr, "kernel_launch: workspace too small: need %zu have %zu\n", need, ws_size);
    return;
  }
  hipMemsetAsync(p.bar, 0, (size_t)XCD_BAR_WORDS * 4, stream);
#if SINGLE_LAUNCH
  p.ph_lo = 0;
  p.ph_hi = NPHASE;
  void* args[] = {&p};
  hipError_t e = hipLaunchCooperativeKernel((const void*)mega_kernel, dim3(grid_blocks), dim3(256), args, LDS_BYTES, stream);
  if (e != hipSuccess) fprintf(stderr, "cooperative launch failed: %s (grid %d)\n", hipGetErrorString(e), grid_blocks);
#else
  for (int ph = 0; ph < NPHASE; ++ph) {
    p.ph_lo = ph;
    p.ph_hi = ph + 1;
    hipLaunchKernelGGL(mega_kernel, dim3(grid_blocks), dim3(256), LDS_BYTES, stream, p);
  }
#endif
}
```

```cpp
#include <hip/hip_runtime.h>
#include <hip/hip_cooperative_groups.h>
#include <cstdio>
namespace cg = cooperative_groups;

#ifndef SINGLE_LAUNCH
#define SINGLE_LAUNCH 1
#endif
#ifndef PHMASK
#define PHMASK 0xFFFF
#endif
#define PH_ON(b) ((PHMASK >> (b)) & 1)
#ifndef PROBE_GEMM
#define PROBE_GEMM 0
#endif
#ifndef PROBE_ATTN
#define PROBE_ATTN 0
#endif
#ifndef PROBE_CHAIN
#define PROBE_CHAIN 0
#endif
#ifndef PROBE_A
#define PROBE_A 0
#endif
#ifndef PROBE_B
#define PROBE_B 0
#endif
#ifndef PROBE_MLCHAIN
#define PROBE_MLCHAIN 0
#endif

typedef unsigned short bf16_t;
typedef __attribute__((ext_vector_type(8))) short bf16x8;
typedef __attribute__((ext_vector_type(4))) float f32x4;
typedef __attribute__((ext_vector_type(4))) unsigned short us4;

constexpr int T_TOK = 81920;
constexpr int T_P = 16384;
constexpr int DM = 1024;
constexpr int NE = 4128, NE_PAD = 4352;
constexpr int NO = 4272, NO_PAD = 4352;
constexpr float EPS = 1e-6f;
constexpr int NPHASE = 26;
constexpr int LDS_BYTES = 72 * 1024;

struct Params {
  const float *x_prompt, *x_sample, *norm_g, *final_norm_g, *e_w_in, *e_a_up, *e_a_bias, *e_gla_norm_g,
      *e_pool_w, *e_pool_scale, *e_w_out, *o_w_in, *o_q_norm_g, *o_q_up, *o_kv_norm_g, *o_kv_up, *o_if_bias,
      *o_ml_norm_g, *o_w_out;
  float* out;
  bf16_t *WinE, *WinO, *WoutE, *WoutO, *QupT, *KVupT, *PoolWT, *AupT;
  int* counters;
  unsigned* bar;
  float* SSQ;
  bf16_t *Qb, *Kt, *VtE, *Gb, *LRb, *PUb, *PGb, *TMP, *QEb, *KdTb;
  float* EB;
  bf16_t *CQb, *CKVb, *KRb, *MGb, *MQb, *MKb, *MKt, *MVt, *MOb, *MLGb, *NUMIf, *NUMIb, *Qa, *KNb, *VtA;
  float *MIF, *EBI, *WKg, *DENI, *DEC;
  int ph_lo, ph_hi;
};

typedef __bf16 hbf2 __attribute__((ext_vector_type(2)));
typedef float hf2 __attribute__((ext_vector_type(2)));
__device__ __forceinline__ bf16_t f2bf(float f) {
  __bf16 b = (__bf16)f;
  return __builtin_bit_cast(bf16_t, b);
}
__device__ __forceinline__ unsigned pk2bf(float a, float b) {
  hf2 v = {a, b};
  hbf2 r = __builtin_convertvector(v, hbf2);
  return __builtin_bit_cast(unsigned, r);
}
__device__ __forceinline__ float bf2f(bf16_t b) { return __uint_as_float(((unsigned)b) << 16); }
__device__ __forceinline__ f32x4 mfma16(bf16x8 a, bf16x8 b, f32x4 c) {
  return __builtin_amdgcn_mfma_f32_16x16x32_bf16(a, b, c, 0, 0, 0);
}
__device__ __forceinline__ float logsigmoidf_(float x) { return fminf(x, 0.f) - log1pf(__expf(-fabsf(x))); }
__device__ __forceinline__ float siluf_(float x) { return x / (1.f + __expf(-x)); }
__device__ __forceinline__ float sigmoidf_(float x) { return 1.f / (1.f + __expf(-x)); }
__device__ __forceinline__ int otid() { int t = threadIdx.x; asm volatile("" : "+v"(t)); return t; }
__device__ __forceinline__ float bperm(int srclane, float v) { return __int_as_float(__builtin_amdgcn_ds_bpermute(srclane << 2, __float_as_int(v))); }
__device__ __forceinline__ float sxor(float v, int m, int lane) { return bperm(lane ^ m, v); }
__device__ __forceinline__ bf16x8 zero8() { bf16x8 z = {0, 0, 0, 0, 0, 0, 0, 0}; return z; }
__device__ __forceinline__ f32x4 zero4() { f32x4 z = {0.f, 0.f, 0.f, 0.f}; return z; }

__device__ __forceinline__ int seq_pos(int tok) { return tok < T_P ? (tok & 4095) : ((tok - T_P) & 8191); }
__device__ __forceinline__ const float* xrow(const float* xa, const float* xb, int tok) {
  return tok < T_P ? xa + (long)tok * DM : xb + (long)(tok - T_P) * DM;
}


#define XB_TMO      128
#define XB_XCNT(j)  (256  + 64 * (j))
#define XB_XSUB(j)  (1280 + 64 * (j))
#define XB_XGEN(j)  (2304 + 64 * (j))
#define XB_TOP      3328
#define XB_TOPGEN   3392
#define XCD_BAR_WORDS 3456
#define XB_SPIN_CAP (1u << 22)
#define LAS __attribute__((address_space(3)))
__device__ __forceinline__ unsigned xb_ld(unsigned* p) { return __hip_atomic_load(p, __ATOMIC_RELAXED, __HIP_MEMORY_SCOPE_AGENT); }
__device__ __forceinline__ unsigned xb_add(unsigned* p, unsigned v) { return __hip_atomic_fetch_add(p, v, __ATOMIC_RELAXED, __HIP_MEMORY_SCOPE_AGENT); }
__device__ __forceinline__ unsigned xb_xcc_id() { return (unsigned)__builtin_amdgcn_s_getreg((3 << 11) | 20) & 0xFu; }
#define XB_SPIN(cond, bar) do { unsigned _sp = 0; while (cond) { __builtin_amdgcn_s_sleep(1); \
    if ((++_sp & 255u) == 0u) { if (xb_ld(&(bar)[XB_TMO])) break; if (_sp > XB_SPIN_CAP) { atomicAdd(&(bar)[XB_TMO], 1u); break; } } } } while (0)
struct XcdBarrier { unsigned* bar; unsigned x; volatile LAS unsigned* st; };
__device__ __forceinline__ XcdBarrier xcd_barrier_post(unsigned* bar, volatile LAS unsigned* st) {
  XcdBarrier b; b.bar = bar; b.x = xb_xcc_id(); b.st = st;
  if (threadIdx.x == 0) (void)xb_add(&bar[XB_XCNT(b.x)], 1u);
  return b;
}
__device__ __forceinline__ void xcd_barrier_complete(unsigned* bar, unsigned x, unsigned& nloc, unsigned& nx) {
  const unsigned G = gridDim.x * gridDim.y * gridDim.z;
  unsigned sum, cnt, mine, sp = 0u;
  for (;;) {
    sum = 0u; cnt = 0u; mine = 0u;
#pragma unroll
    for (unsigned j = 0; j < 16; ++j) { const unsigned cc = xb_ld(&bar[XB_XCNT(j)]); sum += cc; cnt += (cc > 0u) ? 1u : 0u; mine = (j == x) ? cc : mine; }
    if (sum == G) break;
    __builtin_amdgcn_s_sleep(1);
    if ((++sp & 255u) == 0u) { if (xb_ld(&bar[XB_TMO])) break; if (sp > XB_SPIN_CAP) { atomicAdd(&bar[XB_TMO], 1u); break; } }
  }
  nloc = mine > 0u ? mine : 1u; nx = cnt > 0u ? cnt : 1u;
}
__device__ __forceinline__ void xcd_barrier(const XcdBarrier& b) {
  asm volatile("s_waitcnt vmcnt(0)" ::: "memory");
  __syncthreads();
  if (threadIdx.x == 0) {
    unsigned* bar = b.bar;
    __builtin_amdgcn_s_waitcnt(0);
    unsigned nloc = b.st[0], nx = b.st[1];
    if (nloc == 0u) { xcd_barrier_complete(bar, b.x, nloc, nx); b.st[0] = nloc; b.st[1] = nx; }
    const unsigned old = xb_add(&bar[XB_XSUB(b.x)], 1u);
    const unsigned gen = old / nloc;
    if (old + 1u == (gen + 1u) * nloc) {
      __builtin_amdgcn_fence(__ATOMIC_RELEASE, "agent");
      asm volatile("s_waitcnt vmcnt(0)" ::: "memory");
      const unsigned og = xb_add(&bar[XB_TOP], 1u);
      const unsigned tg = og / nx;
      if (og + 1u == (tg + 1u) * nx) xb_add(&bar[XB_TOPGEN], 1u);
      else XB_SPIN(xb_ld(&bar[XB_TOPGEN]) == tg, bar);
      __builtin_amdgcn_fence(__ATOMIC_ACQUIRE, "agent");
      xb_add(&bar[XB_XGEN(b.x)], 1u);
      asm volatile("s_waitcnt vmcnt(0)" ::: "memory");
    } else {
      XB_SPIN(xb_ld(&bar[XB_XGEN(b.x)]) == gen, bar);
      __builtin_amdgcn_fence(__ATOMIC_ACQUIRE, "agent");
      asm volatile("s_waitcnt vmcnt(0)" ::: "memory");
    }
  }
  __syncthreads();
}

__device__ __forceinline__ int colmap(int mode, int n) {
  if (mode == 1) {
    if (n < 512) return 2208 + n;
    if (n < 1024) return 1696 + (n - 512);
    if (n < 1408) return n - 1024;
    if (n < 1664) return 384 + (n - 1408);
    if (n < 2176) return 672 + (n - 1664);
    if (n < 2688) return 1184 + (n - 2176);
    if (n < 3200) return 1696 + (n - 2688);
    if (n < 3712) return 2720 + (n - 3200);
    if (n < 4224) return 3248 + (n - 3712);
    if (n < 4256) return 640 + (n - 4224);
    return 3232 + (n - 4256);
  }
  if (mode == 2) {
    if (n < 512) return (n >> 6) * 96 + (n & 63);
    const int r = n - 512;
    return (r >> 5) * 96 + 64 + (r & 31);
  }
  if (mode == 3) {
    if (n < 512) return (n >> 6) * 128 + (n & 63);
    const int r = n - 512;
    return (r >> 6) * 128 + 64 + (r & 63);
  }
  return n;
}

__device__ void prep_weight(const float* __restrict__ W, int K, int N, int Npad, const float* __restrict__ gsc,
                            bf16_t* __restrict__ out, long gtid, long gsize, int mode = 0, int Nsrc_ = 0) {
  const int Nsrc = Nsrc_ ? Nsrc_ : N;
  long total = (long)Npad * K;
  for (long idx = gtid; idx < total; idx += gsize) {
    int k = (int)(idx / Npad);
    int n = (int)(idx % Npad);
    float v = 0.f;
    if (n < N) {
      v = W[(long)k * Nsrc + colmap(mode, n)];
      if (gsc) v *= gsc[k];
    }
    out[(long)n * K + k] = f2bf(v);
  }
}

__device__ void phase_prep(const Params& p) {
  long gtid = (long)blockIdx.x * 256 + otid();
  long gsize = (long)gridDim.x * 256;
  for (int l = 0; l < 2; ++l) {
    prep_weight(p.e_w_in + (long)l * DM * NE, DM, NE, NE_PAD, p.norm_g + (2 * l) * DM, p.WinE + (long)l * NE_PAD * DM, gtid, gsize);
    prep_weight(p.o_w_in + (long)l * DM * 3760, DM, NO, NO_PAD, p.norm_g + (2 * l + 1) * DM, p.WinO + (long)l * NO_PAD * DM, gtid, gsize, 1, 3760);
    prep_weight(p.e_w_out + (long)l * 1536 * DM, 1536, DM, DM, nullptr, p.WoutE + (long)l * DM * 1536, gtid, gsize);
    prep_weight(p.o_w_out + (long)l * 1024 * DM, 1024, DM, DM, nullptr, p.WoutO + (long)l * DM * 1024, gtid, gsize);
    prep_weight(p.o_q_up + (long)l * 384 * 768, 384, 768, 768, p.o_q_norm_g + l * 384, p.QupT + (long)l * 768 * 384, gtid, gsize, 2);
    prep_weight(p.o_kv_up + (long)l * 256 * 1024, 256, 1024, 1024, p.o_kv_norm_g + l * 256, p.KVupT + (long)l * 1024 * 256, gtid, gsize, 3);
    for (int gi = 0; gi < 4; ++gi)
      prep_weight(p.e_pool_w + (long)(l * 4 + gi) * 128 * 128, 128, 128, 128, nullptr, p.PoolWT + (long)(l * 4 + gi) * 128 * 128, gtid, gsize);
    for (long idx = gtid; idx < 2 * 512 * 32; idx += gsize) {
      int r = (int)(idx & 31);
      int d = (int)((idx >> 5) & 511);
      int dir = (int)(idx >> 14);
      float v = (r < 16) ? p.e_a_up[((long)(l * 2 + dir) * 16 + r) * 512 + d] : 0.f;
      p.AupT[((long)(l * 2 + dir) * 512 + d) * 32 + r] = f2bf(v);
    }
  }
  if (gtid < 16) p.counters[gtid] = 0;
  {
    const int tid_ = otid();
    const int lane = tid_ & 63, w = tid_ >> 6;
    for (int tok = blockIdx.x * 4 + w; tok < T_TOK; tok += gridDim.x * 4) {
      const float* xp = xrow(p.x_prompt, p.x_sample, tok) + 16 * lane;
      float ssv = 0.f;
      unsigned pk[8];
#pragma unroll
      for (int i = 0; i < 4; ++i) {
        const f32x4 v = *(const f32x4*)(xp + 4 * i);
        ssv += v[0] * v[0] + v[1] * v[1] + v[2] * v[2] + v[3] * v[3];
        pk[2 * i] = pk2bf(v[0], v[1]);
        pk[2 * i + 1] = pk2bf(v[2], v[3]);
      }
      uint4 o0, o1;
      o0.x = pk[0]; o0.y = pk[1]; o0.z = pk[2]; o0.w = pk[3];
      o1.x = pk[4]; o1.y = pk[5]; o1.z = pk[6]; o1.w = pk[7];
      *(uint4*)(p.TMP + (size_t)tok * DM + 16 * lane) = o0;
      *(uint4*)(p.TMP + (size_t)tok * DM + 16 * lane + 8) = o1;
#pragma unroll
      for (int d = 1; d < 64; d <<= 1) ssv += sxor(ssv, d, lane);
      if (lane < 8) p.SSQ[(size_t)tok * 8 + lane] = (lane == 0) ? ssv : 0.f;
    }
  }
}

constexpr int G_LD = 40;
constexpr int G_BUF = (128 + 256) * G_LD;

template <int AMODE, int NI, class Epi>
__device__ __forceinline__ void gemm_phase(int Mtiles, int Ntiles, int K, const bf16_t* __restrict__ Bt, const float* ssq, const float* unused_,
                           const bf16_t* A1, int ld1, int K1, const bf16_t* A2, int ld2, const Epi& epi, char* smem) {
  bf16_t* sbase = (bf16_t*)smem;
  float* sR = (float*)(smem + 70144);
  const int tid = otid(), lane = tid & 63, w = tid >> 6, c = lane & 15, g = lane >> 4;
  const int wm = w >> 1, wn = w & 1;
  const int nk = K / 32;
  const int xcd = blockIdx.x & 7, lb0 = blockIdx.x >> 3, nlb = gridDim.x >> 3;
  const int mper = Mtiles >> 3;
  for (int lt = lb0; lt < mper * Ntiles; lt += nlb) {
    const int mt = xcd * mper + lt / Ntiles, nt = lt % Ntiles;
    constexpr int BN = 32 * NI;
    const int m0 = mt * 128, n0 = nt * BN;
    f32x4 acc[4][NI];
#pragma unroll
    for (int i = 0; i < 4; ++i)
#pragma unroll
      for (int j = 0; j < NI; ++j) acc[i][j] = zero4();
    float ss[2] = {0.f, 0.f};
    bf16x8 ra0[2], ra1[2];
    bf16x8 rb0[NI / 2], rb1[NI / 2];
    const unsigned boff = (unsigned)(tid >> 2) * K + 8 * (tid & 3);
    const bf16_t* bbase = Bt + (size_t)n0 * K;
#define G_LOAD(RA, RB, KT)                                                                          \
  {                                                                                                 \
    const int k0_ = (KT) * 32;                                                                      \
    const bf16_t* base_;                                                                            \
    int ld_;                                                                                        \
    if (k0_ < K1) { base_ = A1 + (size_t)m0 * ld1 + k0_; ld_ = ld1; }                               \
    else { base_ = A2 + (size_t)m0 * ld2 + (k0_ - K1); ld_ = ld2; }                                 \
    _Pragma("unroll") for (int i = 0; i < 2; ++i)                                                   \
      RA[i] = *(const bf16x8*)(base_ + (unsigned)((tid >> 2) + 64 * i) * ld_ + 8 * (tid & 3));      \
    _Pragma("unroll") for (int i = 0; i < NI / 2; ++i)                                              \
      RB[i] = *(const bf16x8*)(bbase + k0_ + boff + (unsigned)(64 * i) * K);                        \
  }
#define G_STORE(RA, RB, BUF)                                                                        \
  {                                                                                                 \
    bf16_t* sA_ = sbase + (BUF) * G_BUF;                                                            \
    bf16_t* sB_ = sA_ + 128 * G_LD;                                                                 \
    _Pragma("unroll") for (int i = 0; i < 2; ++i) {                                                 \
      bf16x8 v = RA[i];                                                                             \
      if constexpr (AMODE == 2) {                                                                   \
        _Pragma("unroll") for (int e = 0; e < 8; ++e) {                                             \
          float f = bf2f((bf16_t)v[e]);                                                             \
          ss[i] += f * f;                                                                           \
        }                                                                                           \
      }                                                                                             \
      *(bf16x8*)(sA_ + ((tid >> 2) + 64 * i) * G_LD + 8 * (tid & 3)) = v;                           \
    }                                                                                               \
    _Pragma("unroll") for (int i = 0; i < NI / 2; ++i)                                              \
      *(bf16x8*)(sB_ + ((tid >> 2) + 64 * i) * G_LD + 8 * (tid & 3)) = RB[i];                       \
  }
#define G_COMPUTE(BUF)                                                                              \
  {                                                                                                 \
    const bf16_t* sA_ = sbase + (BUF) * G_BUF;                                                      \
    const bf16_t* sB_ = sA_ + 128 * G_LD;                                                           \
    bf16x8 af[4];                                                                                   \
    _Pragma("unroll") for (int mi = 0; mi < 4; ++mi)                                                \
      af[mi] = *(const bf16x8*)(sA_ + (wm * 64 + mi * 16 + c) * G_LD + g * 8);                      \
    _Pragma("unroll") for (int ni = 0; ni < NI; ++ni) {                                             \
      bf16x8 bfr = *(const bf16x8*)(sB_ + (wn * (16 * NI) + ni * 16 + c) * G_LD + g * 8);           \
      _Pragma("unroll") for (int mi = 0; mi < 4; ++mi) acc[mi][ni] = mfma16(af[mi], bfr, acc[mi][ni]); \
    }                                                                                               \
  }
    __syncthreads();
    if constexpr (AMODE == 3) {
      if (tid < 128) {
        const f32x4 p0 = *(const f32x4*)(ssq + (size_t)(m0 + tid) * 8);
        const f32x4 p1 = *(const f32x4*)(ssq + (size_t)(m0 + tid) * 8 + 4);
        const float sv = (p0[0] + p0[1]) + (p0[2] + p0[3]) + (p1[0] + p1[1]) + (p1[2] + p1[3]);
        sR[tid] = rsqrtf(sv * (1.f / 1024.f) + EPS);
      }
    }
    G_LOAD(ra0, rb0, 0)
    if (nk > 1) G_LOAD(ra1, rb1, 1)
    G_STORE(ra0, rb0, 0)
    __syncthreads();
    for (int kt = 0; kt < nk; kt += 2) {
      if (kt + 2 < nk) G_LOAD(ra0, rb0, kt + 2)
      G_COMPUTE(0)
      if (kt + 1 < nk) G_STORE(ra1, rb1, 1)
      __syncthreads();
      if (kt + 1 < nk) {
        if (kt + 3 < nk) G_LOAD(ra1, rb1, kt + 3)
        G_COMPUTE(1)
        if (kt + 2 < nk) G_STORE(ra0, rb0, 0)
        __syncthreads();
      }
    }
    if constexpr (AMODE == 2) {
#pragma unroll
      for (int i = 0; i < 2; ++i) {
        float sv = ss[i];
        sv += sxor(sv, 1, lane); sv += sxor(sv, 2, lane);
        if ((tid & 3) == 0) sR[(tid >> 2) + 64 * i] = rsqrtf(sv / (float)K + EPS);
      }
      __syncthreads();
    }
    if constexpr (Epi::staged) {
      bf16_t* sT = sbase;
      const float esc = epi.scale();
      const bool tr = epi.transposed(n0);
      if (tr) {
#pragma unroll
        for (int mi = 0; mi < 4; ++mi) {
          const int row = wm * 64 + mi * 16 + 4 * g;
          const float r0 = sR[row] * esc, r1 = sR[row + 1] * esc, r2 = sR[row + 2] * esc, r3 = sR[row + 3] * esc;
#pragma unroll
          for (int ni = 0; ni < NI; ++ni) {
            uint2 o;
            o.x = pk2bf(acc[mi][ni][0] * r0, acc[mi][ni][1] * r1);
            o.y = pk2bf(acc[mi][ni][2] * r2, acc[mi][ni][3] * r3);
            *(uint2*)(sT + (wn * (16 * NI) + ni * 16 + c) * 136 + row) = o;
          }
        }
      } else {
#pragma unroll
        for (int mi = 0; mi < 4; ++mi) {
          const int row = wm * 64 + mi * 16 + 4 * g;
          const float r0 = sR[row] * esc, r1 = sR[row + 1] * esc, r2 = sR[row + 2] * esc, r3 = sR[row + 3] * esc;
#pragma unroll
          for (int ni = 0; ni < NI; ++ni) {
            bf16_t* d = sT + row * (BN + 8) + wn * (16 * NI) + ni * 16 + c;
            d[0] = f2bf(acc[mi][ni][0] * r0);
            d[BN + 8] = f2bf(acc[mi][ni][1] * r1);
            d[2 * (BN + 8)] = f2bf(acc[mi][ni][2] * r2);
            d[3 * (BN + 8)] = f2bf(acc[mi][ni][3] * r3);
          }
        }
      }
      epi.template direct<NI>(m0, n0, wm, wn, g, c, acc, sR);
      __syncthreads();
      if (tr) {
#pragma unroll 4
        for (int i = 0; i < 2 * NI; ++i) {
          const int id = tid + 256 * i;
          const int col = id >> 4, rc = id & 15;
          bf16x8 v = *(const bf16x8*)(sT + col * 136 + 8 * rc);
          epi.store_t(m0 + 8 * rc, n0 + col, v);
        }
      } else {
#pragma unroll 4
        for (int i = 0; i < 2 * NI; ++i) {
          const int id = tid + 256 * i;
          const int row = id / (4 * NI), cc = id % (4 * NI);
          const bf16_t* sp = sT + row * (BN + 8) + 8 * cc;
          bf16x8 v = *(const bf16x8*)sp;
          epi.store_n(m0 + row, n0 + 8 * cc, v, sp);
        }
      }
    } else {
      float* sF = (float*)smem;
#pragma unroll 1
      for (int half = 0; half < 2; ++half) {
        if (half) __syncthreads();
        if (wm == half) {
#pragma unroll
          for (int mi = 0; mi < 4; ++mi)
#pragma unroll
            for (int ni = 0; ni < NI; ++ni)
#pragma unroll
              for (int j = 0; j < 4; ++j) sF[(mi * 16 + 4 * g + j) * 260 + wn * (16 * NI) + ni * 16 + c] = acc[mi][ni][j];
        }
        __syncthreads();
#pragma unroll 4
        for (int i = 0; i < 16; ++i) {
          const int row = w * 16 + i;
          const int tok = m0 + half * 64 + row;
          const int col = n0 + 4 * lane;
          const f32x4 a = *(const f32x4*)(sF + row * 260 + 4 * lane);
          const f32x4 xo = *(const f32x4*)(xrow(epi.xa, epi.xb, tok) + col);
          f32x4 xn;
          xn[0] = xo[0] + a[0]; xn[1] = xo[1] + a[1]; xn[2] = xo[2] + a[2]; xn[3] = xo[3] + a[3];
          float sv = xn[0] * xn[0] + xn[1] * xn[1] + xn[2] * xn[2] + xn[3] * xn[3];
#pragma unroll
          for (int d = 1; d < 64; d <<= 1) sv += sxor(sv, d, lane);
          if (!epi.dry) {
            *(f32x4*)(epi.out + (size_t)tok * DM + col) = xn;
            if (epi.hb) {
              uint2 o;
              o.x = pk2bf(xn[0], xn[1]);
              o.y = pk2bf(xn[2], xn[3]);
              *(uint2*)(epi.hb + (size_t)tok * DM + col) = o;
            }
            if (lane == 0) epi.ssq[(size_t)tok * 8 + (n0 >> 8)] = sv;
          }
        }
      }
    }
  }
#undef G_LOAD
#undef G_STORE
#undef G_COMPUTE
}

__device__ __forceinline__ void rope_cs(int pos, int i, float& co, float& si) {
  float inv = exp2f(-(float)i * (13.287712379549449f / 16.f));
  float ang = (float)pos * inv;
  float n = rintf(ang * 0.15915494309189535f);
  float r = fmaf(-n, 6.28125f, ang);
  r = fmaf(-n, 0.0019353071795864769f, r);
  float rf = r * 0.15915494309189535f;
  si = __builtin_amdgcn_sinf(rf);
  co = __builtin_amdgcn_cosf(rf);
}

__device__ __forceinline__ void rope_chunk(int pos, int i0, bf16x8 x1, bf16x8 x2, bf16x8& o1, bf16x8& o2) {
#pragma unroll
  for (int e = 0; e < 8; ++e) {
    float co, si;
    rope_cs(pos, i0 + e, co, si);
    float a = bf2f((bf16_t)x1[e]), b = bf2f((bf16_t)x2[e]);
    o1[e] = (short)f2bf(a * co - b * si);
    o2[e] = (short)f2bf(b * co + a * si);
  }
}

struct EpiEvenIn {
  static constexpr bool staged = true;
  bf16_t *Qb, *Kt, *VtE, *Gb, *LRb, *PUb, *PGb;
  __device__ float scale() const { return 1.f; }
  __device__ bool transposed(int n0) const { return n0 >= 512 && n0 < 2048; }
  template <int NI> __device__ void direct(int m0, int n0, int wm, int wn, int g, int c, f32x4 (&acc)[4][NI], const float* sR) const {}
  __device__ void store_t(int tok8, int col, bf16x8 v) const {
    if (col < 1024) *(bf16x8*)(Kt + (size_t)(col - 512) * T_TOK + tok8) = v;
    else *(bf16x8*)(VtE + (size_t)(col - 1024) * T_TOK + tok8) = v;
  }
  __device__ void store_n(int tok, int col, bf16x8 v, const bf16_t* sp) const {
    bf16_t* d;
    if (col < 512) d = Qb + (size_t)tok * 512 + col;
    else if (col < 3072) d = Gb + (size_t)tok * 1024 + (col - 2048);
    else if (col < 3104) d = LRb + (size_t)tok * 32 + (col - 3072);
    else if (col < 3616) d = PUb + (size_t)tok * 512 + (col - 3104);
    else if (col < 4128) d = PGb + (size_t)tok * 512 + (col - 3616);
    else return;
    *(bf16x8*)d = v;
  }
};

struct EpiOddIn {
  static constexpr bool staged = true;
  bf16_t *CQb, *CKVb, *KRb, *MGb, *MQb, *MKb, *MKt, *MVt, *MOb, *MLGb;
  float* MIF;
  __device__ float scale() const { return 1.f; }
  __device__ bool transposed(int n0) const { return n0 < 1024; }
  template <int NI> __device__ void direct(int m0, int n0, int wm, int wn, int g, int c, f32x4 (&acc)[4][NI], const float* sR) const {
    if (n0 == 4096 && wn == 1) {
#pragma unroll
      for (int mi = 0; mi < 4; ++mi)
#pragma unroll
        for (int j = 0; j < 4; ++j) {
          const int row = wm * 64 + mi * 16 + 4 * g + j;
          MIF[(size_t)(m0 + row) * 16 + c] = acc[mi][2][j] * sR[row];
        }
    }
  }
  __device__ void store_t(int tok8, int col, bf16x8 v) const {
    if (col < 512) *(bf16x8*)(MVt + (size_t)col * T_TOK + tok8) = v;
    else *(bf16x8*)(MKt + (size_t)(col - 512) * T_TOK + tok8) = v;
  }
  __device__ void store_n(int tok, int col, bf16x8 v, const bf16_t* sp) const {
    bf16_t* d;
    if (col < 1408) d = CQb + (size_t)tok * 384 + (col - 1024);
    else if (col < 1664) d = CKVb + (size_t)tok * 256 + (col - 1408);
    else if (col < 2176) d = MGb + (size_t)tok * 512 + (col - 1664);
    else if (col < 2688) d = MQb + (size_t)tok * 512 + (col - 2176);
    else if (col < 3200) d = MKb + (size_t)tok * 512 + (col - 2688);
    else if (col < 3712) d = MOb + (size_t)tok * 512 + (col - 3200);
    else if (col < 4224) d = MLGb + (size_t)tok * 512 + (col - 3712);
    else if (col < 4240) {
      bf16x8 x2 = *(const bf16x8*)(sp + 16);
      bf16x8 o1, o2;
      rope_chunk(seq_pos(tok), col - 4224, v, x2, o1, o2);
      *(bf16x8*)(KRb + (size_t)tok * 32 + (col - 4224)) = o1;
      *(bf16x8*)(KRb + (size_t)tok * 32 + 16 + (col - 4224)) = o2;
      return;
    } else return;
    *(bf16x8*)d = v;
  }
};

struct EpiQUp {
  static constexpr bool staged = true;
  bf16_t* Qa;
  __device__ float scale() const { return 0.10206207261596575f * 1.4426950408889634f; }
  __device__ bool transposed(int n0) const { return false; }
  template <int NI> __device__ void direct(int m0, int n0, int wm, int wn, int g, int c, f32x4 (&acc)[4][NI], const float* sR) const {}
  __device__ void store_t(int tok8, int col, bf16x8 v) const {}
  __device__ void store_n(int tok, int col, bf16x8 v, const bf16_t* sp) const {
    if (col < 512) {
      *(bf16x8*)(Qa + (size_t)tok * 768 + (col >> 6) * 96 + (col & 63)) = v;
    } else {
      const int r = col - 512, head = r >> 5, rr = r & 31;
      if (rr < 16) {
        bf16x8 x2 = *(const bf16x8*)(sp + 16);
        bf16x8 o1, o2;
        rope_chunk(seq_pos(tok), rr, v, x2, o1, o2);
        *(bf16x8*)(Qa + (size_t)tok * 768 + head * 96 + 64 + rr) = o1;
        *(bf16x8*)(Qa + (size_t)tok * 768 + head * 96 + 80 + rr) = o2;
      }
    }
  }
};

struct EpiKVUp {
  static constexpr bool staged = true;
  bf16_t *KNb, *VtA;
  __device__ float scale() const { return 1.f; }
  __device__ bool transposed(int n0) const { return n0 >= 512; }
  template <int NI> __device__ void direct(int m0, int n0, int wm, int wn, int g, int c, f32x4 (&acc)[4][NI], const float* sR) const {}
  __device__ void store_t(int tok8, int col, bf16x8 v) const { *(bf16x8*)(VtA + (size_t)(col - 512) * T_TOK + tok8) = v; }
  __device__ void store_n(int tok, int col, bf16x8 v, const bf16_t* sp) const { *(bf16x8*)(KNb + (size_t)tok * 512 + col) = v; }
};

struct EpiOut {
  static constexpr bool staged = false;
  const float *xa, *xb;
  float* out;
  bool dry;
  bf16_t* hb;
  float* ssq;
};

__device__ __forceinline__ float scan16(float v, int c, int lane) {
  float t;
  t = bperm(lane - 1, v); if (c >= 1) v += t;
  t = bperm(lane - 2, v); if (c >= 2) v += t;
  t = bperm(lane - 4, v); if (c >= 4) v += t;
  t = bperm(lane - 8, v); if (c >= 8) v += t;
  return v;
}

__device__ __forceinline__ float logsig_fast(float x) { return fminf(x, 0.f) - __logf(1.f + __expf(-fabsf(x))); }

__device__ void gla_intra_item(const Params& p, int li, int item, char* smem, bool dry = false) {
  const int tid = otid(), lane = tid & 63, w = tid >> 6, c = lane & 15, g = lane >> 4;
  const int ci = item >> 2, h = item & 3;
  const int tokc = ci * 64;
  const float qscale = 0.08838834764831845f;
  bf16_t* sQe = (bf16_t*)smem;
  bf16_t* sKd = sQe + 64 * 136;
  bf16_t* sA = sKd + 64 * 136;
  us4 q4[2][4];
  bf16_t kk[2][4][4];
#pragma unroll
  for (int dt = 0; dt < 2; ++dt)
#pragma unroll
    for (int tt = 0; tt < 4; ++tt) {
      q4[dt][tt] = *(const us4*)(p.Qb + (size_t)(tokc + 16 * tt + c) * 512 + h * 128 + 32 * w + 16 * dt + 4 * g);
#pragma unroll
      for (int j = 0; j < 4; ++j)
        kk[dt][tt][j] = p.Kt[(size_t)(h * 128 + 32 * w + 16 * dt + 4 * g + j) * T_TOK + tokc + 16 * tt + c];
    }
  __syncthreads();
#pragma unroll
  for (int dir = 0; dir < 2; ++dir) {
    bf16_t* QEd = (dir || dry) ? p.QEb : p.Qb;
    bf16_t* KdTd = (dir || dry) ? p.KdTb : p.Kt;
    bf16x8 aup[2];
    float bias[2][4];
#pragma unroll
    for (int dt = 0; dt < 2; ++dt) {
      aup[dt] = zero8();
      if (g < 2) aup[dt] = *(const bf16x8*)(p.AupT + ((size_t)(li * 2 + dir) * 512 + h * 128 + 32 * w + 16 * dt + c) * 32 + 8 * g);
#pragma unroll
      for (int j = 0; j < 4; ++j) bias[dt][j] = p.e_a_bias[(li * 2 + dir) * 512 + h * 128 + 32 * w + 16 * dt + 4 * g + j];
    }
    f32x4 la[2][4];
#pragma unroll
    for (int tt = 0; tt < 4; ++tt) {
      bf16x8 lrf = zero8();
      if (g < 2) lrf = *(const bf16x8*)(p.LRb + (size_t)(tokc + 16 * tt + c) * 32 + dir * 16 + 8 * g);
#pragma unroll
      for (int dt = 0; dt < 2; ++dt) la[dt][tt] = mfma16(aup[dt], lrf, zero4());
    }
#pragma unroll
    for (int dt = 0; dt < 2; ++dt)
#pragma unroll
      for (int tt = 0; tt < 4; ++tt)
#pragma unroll
        for (int j = 0; j < 4; ++j) la[dt][tt][j] = logsig_fast(la[dt][tt][j] + bias[dt][j]) * (1.f / 16.f);
    f32x4 P[2][4];
    float tot[2][4];
#pragma unroll
    for (int dt = 0; dt < 2; ++dt)
#pragma unroll
      for (int j = 0; j < 4; ++j) {
        float carry = 0.f;
#pragma unroll
        for (int tt = 0; tt < 4; ++tt) {
          float v = scan16(la[dt][tt][j], c, lane) + carry;
          P[dt][tt][j] = v;
          carry = bperm(lane | 15, v);
        }
        tot[dt][j] = carry;
      }
#pragma unroll
    for (int dt = 0; dt < 2; ++dt)
#pragma unroll
      for (int tt = 0; tt < 4; ++tt) {
        us4 qo, ko;
#pragma unroll
        for (int j = 0; j < 4; ++j) {
          const float b = (dir == 0) ? P[dt][tt][j] : (tot[dt][j] - P[dt][tt][j] + la[dt][tt][j]);
          qo[j] = f2bf(bf2f(q4[dt][tt][j]) * __expf(b) * qscale);
          ko[j] = f2bf(bf2f(kk[dt][tt][j]) * __expf(-b));
          KdTd[(size_t)(h * 128 + 32 * w + 16 * dt + 4 * g + j) * T_TOK + tokc + 16 * tt + c] = ko[j];
        }
        *(us4*)(QEd + (size_t)(tokc + 16 * tt + c) * 512 + h * 128 + 32 * w + 16 * dt + 4 * g) = qo;
        *(us4*)(sQe + (16 * tt + c) * 136 + 32 * w + 16 * dt + 4 * g) = qo;
        *(us4*)(sKd + (16 * tt + c) * 136 + 32 * w + 16 * dt + 4 * g) = ko;
      }
    if (c == 0) {
#pragma unroll
      for (int dt = 0; dt < 2; ++dt)
#pragma unroll
        for (int j = 0; j < 4; ++j)
          p.EB[(size_t)(dir * 1280 + ci) * 512 + h * 128 + 32 * w + 16 * dt + 4 * g + j] = __expf(tot[dt][j]);
    }
    __syncthreads();
    f32x4 accA[4];
#pragma unroll
    for (int jt = 0; jt < 4; ++jt) accA[jt] = zero4();
#pragma unroll
    for (int ks = 0; ks < 4; ++ks) {
      bf16x8 aq = *(const bf16x8*)(sQe + (16 * w + c) * 136 + 32 * ks + 8 * g);
#pragma unroll
      for (int jt = 0; jt < 4; ++jt) {
        bf16x8 bk = *(const bf16x8*)(sKd + (16 * jt + c) * 136 + 32 * ks + 8 * g);
        accA[jt] = mfma16(aq, bk, accA[jt]);
      }
    }
#pragma unroll
    for (int jt = 0; jt < 4; ++jt)
#pragma unroll
      for (int j = 0; j < 4; ++j) {
        const int i = 16 * w + 4 * g + j, jj = 16 * jt + c;
        const bool keep = (dir == 0) ? (jj <= i) : (jj > i);
        sA[dir * 64 * 72 + i * 72 + jj] = f2bf(keep ? accA[jt][j] : 0.f);
      }
    __syncthreads();
  }
  bf16x8 af[2][2];
#pragma unroll
  for (int dir = 0; dir < 2; ++dir)
#pragma unroll
    for (int k2 = 0; k2 < 2; ++k2) af[dir][k2] = *(const bf16x8*)(sA + dir * 64 * 72 + (16 * w + c) * 72 + 32 * k2 + 8 * g);
#pragma unroll 4
  for (int vt = 0; vt < 16; ++vt) {
    f32x4 a = zero4();
#pragma unroll
    for (int k2 = 0; k2 < 2; ++k2) {
      bf16x8 vfr = *(const bf16x8*)(p.VtE + (size_t)(h * 256 + 16 * vt + c) * T_TOK + tokc + 32 * k2 + 8 * g);
      a = mfma16(af[0][k2], vfr, a);
      a = mfma16(af[1][k2], vfr, a);
    }
#pragma unroll
    for (int j = 0; j < 4; ++j) p.TMP[(size_t)(tokc + 16 * w + 4 * g + j) * 1024 + h * 256 + 16 * vt + c] = f2bf(a[j]);
  }
}

__device__ __forceinline__ void lds_barrier() { asm volatile("s_waitcnt lgkmcnt(0)\n\ts_barrier" ::: "memory"); }

struct GlaRegs {
  bf16x8 aq[4];
  bf16x8 vf[2][2];
  bf16x8 kf[2][2];
  float eb[2];
  unsigned told[2][4];
};

template <int DIR>
__device__ __forceinline__ void gla_chain_load(const Params& p, int h, int sl, int tokc, int w, int c, int g, GlaRegs& r) {
  const bf16_t* QE = DIR ? p.QEb : p.Qb;
  const bf16_t* KdT = DIR ? p.KdTb : p.Kt;
#pragma unroll
  for (int ks = 0; ks < 4; ++ks) r.aq[ks] = *(const bf16x8*)(QE + (size_t)(tokc + 16 * w + c) * 512 + h * 128 + 32 * ks + 8 * g);
#pragma unroll
  for (int vt = 0; vt < 2; ++vt)
#pragma unroll
    for (int k2 = 0; k2 < 2; ++k2)
      r.vf[vt][k2] = *(const bf16x8*)(p.VtE + (size_t)(h * 256 + sl * 32 + 16 * vt + c) * T_TOK + tokc + 32 * k2 + 8 * g);
#pragma unroll
  for (int dt = 0; dt < 2; ++dt) {
#pragma unroll
    for (int k2 = 0; k2 < 2; ++k2)
      r.kf[dt][k2] = *(const bf16x8*)(KdT + (size_t)(h * 128 + 32 * w + 16 * dt + c) * T_TOK + tokc + 32 * k2 + 8 * g);
    r.eb[dt] = p.EB[(size_t)(DIR * 1280 + (tokc >> 6)) * 512 + h * 128 + 32 * w + 16 * dt + c];
  }
#pragma unroll
  for (int vt = 0; vt < 2; ++vt)
#pragma unroll
    for (int j = 0; j < 4; ++j) r.told[vt][j] = p.TMP[(size_t)(tokc + 16 * w + 4 * g + j) * 1024 + h * 256 + sl * 32 + 16 * vt + c];
}

__device__ __forceinline__ void gla_chain_compute(const Params& p, int h, int sl, int tokc, int w, int c, int g, const GlaRegs& r,
                                                  f32x4 (&S)[2][2], bf16_t* sSt, bool dry, bool reload) {
  unsigned told[2][4];
#pragma unroll
  for (int vt = 0; vt < 2; ++vt)
#pragma unroll
    for (int j = 0; j < 4; ++j) told[vt][j] = r.told[vt][j];
  if (reload) {
#pragma unroll
    for (int vt = 0; vt < 2; ++vt)
#pragma unroll
      for (int j = 0; j < 4; ++j) told[vt][j] = p.TMP[(size_t)(tokc + 16 * w + 4 * g + j) * 1024 + h * 256 + sl * 32 + 16 * vt + c];
  }
#pragma unroll
  for (int vt = 0; vt < 2; ++vt)
#pragma unroll
    for (int dt = 0; dt < 2; ++dt)
#pragma unroll
      for (int j = 0; j < 4; ++j) sSt[(16 * vt + 4 * g + j) * 136 + 32 * w + 16 * dt + c] = f2bf(S[vt][dt][j]);
  lds_barrier();
  f32x4 o[2];
  o[0] = zero4(); o[1] = zero4();
#pragma unroll
  for (int ks = 0; ks < 4; ++ks)
#pragma unroll
    for (int vt = 0; vt < 2; ++vt) {
      bf16x8 sf = *(const bf16x8*)(sSt + (16 * vt + c) * 136 + 32 * ks + 8 * g);
      o[vt] = mfma16(r.aq[ks], sf, o[vt]);
    }
#pragma unroll
  for (int dt = 0; dt < 2; ++dt)
#pragma unroll
    for (int vt = 0; vt < 2; ++vt) {
      f32x4 a = S[vt][dt];
#pragma unroll
      for (int k2 = 0; k2 < 2; ++k2) a = mfma16(r.vf[vt][k2], r.kf[dt][k2], a);
      S[vt][dt] = a * r.eb[dt];
    }
#pragma unroll
  for (int vt = 0; vt < 2; ++vt)
#pragma unroll
    for (int j = 0; j < 4; ++j)
      if (!dry) p.TMP[(size_t)(tokc + 16 * w + 4 * g + j) * 1024 + h * 256 + sl * 32 + 16 * vt + c] = f2bf(bf2f((bf16_t)told[vt][j]) + o[vt][j]);
}

__device__ void gla_chain_item(const Params& p, int li, int item, char* smem, bool dry = false) {
  const int tid = otid(), lane = tid & 63, w = tid >> 6, c = lane & 15, g = lane >> 4;
  const int xr = item >> 3;
  const int pair = (item & 7) + 8 * (xr >> 3), sl = xr & 7;
  const int s = pair < 32 ? 4 + (pair >> 2) : ((pair - 32) >> 2);
  const int h = pair & 3;
  const int tok0 = s < 4 ? s * 4096 : T_P + (s - 4) * 8192;
  const int len = s < 4 ? 4096 : 8192;
  const int N = len / 64;
  bf16_t* sSt0 = (bf16_t*)smem;
  bf16_t* sSt1 = sSt0 + 32 * 136;
  f32x4 Sf[2][2], Sb[2][2];
#pragma unroll
  for (int a = 0; a < 2; ++a)
#pragma unroll
    for (int b = 0; b < 2; ++b) { Sf[a][b] = zero4(); Sb[a][b] = zero4(); }
  GlaRegs rf, rb;
  __syncthreads();
  gla_chain_load<0>(p, h, sl, tok0, w, c, g, rf);
  for (int step = 0; step < N; ++step) {
    const int tf = tok0 + step * 64, tb = tok0 + (N - 1 - step) * 64;
    gla_chain_load<1>(p, h, sl, tb, w, c, g, rb);
    gla_chain_compute(p, h, sl, tf, w, c, g, rf, Sf, sSt0, dry, step == (N >> 1));
    if (step + 1 < N) gla_chain_load<0>(p, h, sl, tf + 64, w, c, g, rf);
    gla_chain_compute(p, h, sl, tb, w, c, g, rb, Sb, sSt1, dry, false);
  }
}

__device__ void pool_item(const Params& p, int li, int item, char* smem, bool dry = false) {
  const int tid = otid(), lane = tid & 63, w = tid >> 6, c = lane & 15, g = lane >> 4;
  const int gi = item & 3;
  const int tile = item >> 2;
  const int tokc = tile * 64;
  const int pos0 = seq_pos(tokc);
  const int len = tokc < T_P ? 4096 : 8192;
  float* sU = (float*)smem;
  bf16_t* sP = (bf16_t*)(sU + 80 * 128);
  __syncthreads();
  for (int idx = tid; idx < 80 * 128; idx += 256) {
    int r = idx >> 7, ch = idx & 127;
    int pos = pos0 - 8 + r;
    float v = 0.f;
    if (pos >= 0 && pos < len) v = bf2f(p.PUb[(long)(tokc - 8 + r) * 512 + gi * 128 + ch]);
    sU[idx] = v;
  }
  __syncthreads();
  {
    const int ch = tid & 127, th = tid >> 7;
    const int half = 1 << gi;
    for (int t = th * 32; t < th * 32 + 32; ++t) {
      int pos = pos0 + t;
      int lo = max(pos - half, 0), hi = min(pos + half, len);
      float s = 0.f;
      for (int q = lo; q < hi; ++q) s += sU[(q - pos0 + 8) * 128 + ch];
      float pooled = s / (float)(hi - lo) - sU[(t + 8) * 128 + ch];
      sP[t * 136 + ch] = f2bf(pooled);
    }
  }
  __syncthreads();
  f32x4 acc[8];
#pragma unroll
  for (int dt = 0; dt < 8; ++dt) acc[dt] = zero4();
  const bf16_t* PW = p.PoolWT + (long)(li * 4 + gi) * 128 * 128;
#pragma unroll
  for (int ks = 0; ks < 4; ++ks) {
    bf16x8 af = *(const bf16x8*)(sP + (16 * w + c) * 136 + 32 * ks + 8 * g);
#pragma unroll
    for (int dt = 0; dt < 8; ++dt) {
      bf16x8 bw = *(const bf16x8*)(PW + (long)(16 * dt + c) * 128 + 32 * ks + 8 * g);
      acc[dt] = mfma16(af, bw, acc[dt]);
    }
  }
#pragma unroll
  for (int dt = 0; dt < 8; ++dt) {
    const int d = gi * 128 + 16 * dt + c;
    const float sc = p.e_pool_scale[li * 512 + d];
#pragma unroll
    for (int j = 0; j < 4; ++j) {
      const long addr = (long)(tokc + 16 * w + 4 * g + j) * 512 + d;
      float gt = bf2f(p.PGb[addr]);
      if (!dry) p.PGb[addr] = f2bf(acc[dt][j] * sc * siluf_(gt));
    }
  }
}

__device__ void ml_intra_item(const Params& p, int li, int item, char* smem) {
  const int tid = otid(), lane = tid & 63, w = tid >> 6, c = lane & 15, g = lane >> 4;
  const int ci = item >> 2, h = item & 3;
  const int tokc = ci * 64;
  const float kscale = 0.08838834764831845f;
  bf16_t* sA = (bf16_t*)smem;
  float* sBv = (float*)(sA + 2 * 64 * 72);
  float* sCB = sBv + 128;
  __syncthreads();
  if (w < 2) {
    const int dir = w;
    const float bi = p.o_if_bias[li * 16 + dir * 4 + h];
    const float bff = p.o_if_bias[li * 16 + 8 + dir * 4 + h];
    const float* mf = p.MIF + (size_t)(tokc + lane) * 16;
    const float liv = mf[dir * 4 + h] + bi;
    const float lfv = logsig_fast(mf[8 + dir * 4 + h] + bff);
    float ps = lfv;
#pragma unroll
    for (int d = 1; d < 64; d <<= 1) {
      float t = bperm(lane - d, ps);
      if (lane >= d) ps += t;
    }
    const float total = __int_as_float(__builtin_amdgcn_readlane(__float_as_int(ps), 63));
    const float b = (dir == 0) ? ps : (total - ps + lfv);
    const float cB = liv - b;
    sBv[dir * 64 + lane] = b;
    sCB[dir * 64 + lane] = cB;
    const size_t so = (size_t)(dir * 4 + h) * T_TOK + tokc + lane;
    p.EBI[so] = __expf(b);
    p.WKg[so] = __expf(total + cB) * kscale;
    if (lane == 0) p.DEC[(dir * 4 + h) * 1280 + ci] = __expf(total);
  }
  f32x4 accA[4];
#pragma unroll
  for (int jt = 0; jt < 4; ++jt) accA[jt] = zero4();
#pragma unroll
  for (int ks = 0; ks < 4; ++ks) {
    bf16x8 aq = *(const bf16x8*)(p.MQb + (size_t)(tokc + 16 * w + c) * 512 + h * 128 + 32 * ks + 8 * g);
#pragma unroll
    for (int jt = 0; jt < 4; ++jt) {
      bf16x8 bk = *(const bf16x8*)(p.MKb + (size_t)(tokc + 16 * jt + c) * 512 + h * 128 + 32 * ks + 8 * g);
      accA[jt] = mfma16(aq, bk, accA[jt]);
    }
  }
  __syncthreads();
#pragma unroll
  for (int dir = 0; dir < 2; ++dir)
#pragma unroll
    for (int jt = 0; jt < 4; ++jt)
#pragma unroll
      for (int j = 0; j < 4; ++j) {
        const int i = 16 * w + 4 * g + j, jj = 16 * jt + c;
        const bool keep = (dir == 0) ? (jj <= i) : (jj > i);
        const float sv = keep ? accA[jt][j] * kscale * __expf(sBv[dir * 64 + i] + sCB[dir * 64 + jj]) : 0.f;
        sA[dir * 64 * 72 + i * 72 + jj] = f2bf(sv);
      }
  __syncthreads();
  bf16x8 ones = zero8();
  if (c == 0) {
#pragma unroll
    for (int e = 0; e < 8; ++e) ones[e] = (short)0x3F80;
  }
#pragma unroll
  for (int dir = 0; dir < 2; ++dir) {
    bf16_t* NUMI = dir ? p.NUMIb : p.NUMIf;
    bf16x8 af[2];
#pragma unroll
    for (int k2 = 0; k2 < 2; ++k2) af[k2] = *(const bf16x8*)(sA + dir * 64 * 72 + (16 * w + c) * 72 + 32 * k2 + 8 * g);
    f32x4 dn = zero4();
    dn = mfma16(af[0], ones, dn);
    dn = mfma16(af[1], ones, dn);
    if (c == 0) {
#pragma unroll
      for (int j = 0; j < 4; ++j) p.DENI[(size_t)(dir * 4 + h) * T_TOK + tokc + 16 * w + 4 * g + j] = dn[j];
    }
#pragma unroll 4
    for (int vt = 0; vt < 8; ++vt) {
      f32x4 a = zero4();
#pragma unroll
      for (int k2 = 0; k2 < 2; ++k2) {
        bf16x8 vfr = *(const bf16x8*)(p.MVt + (size_t)(h * 128 + 16 * vt + c) * T_TOK + tokc + 32 * k2 + 8 * g);
        a = mfma16(af[k2], vfr, a);
      }
#pragma unroll
      for (int j = 0; j < 4; ++j) NUMI[(size_t)(tokc + 16 * w + 4 * g + j) * 512 + h * 128 + 16 * vt + c] = f2bf(a[j]);
    }
  }
}

struct MlRegs {
  bf16x8 aq[4];
  bf16x8 vf[2];
  bf16x8 kf[2][2];
  f32x4 wk[2][2];
  f32x4 ebi, deni;
  float dec;
  unsigned numi[4];
};

template <int DIR>
__device__ __forceinline__ void ml_chain_load(const Params& p, int h, int sl, int tokc, int w, int c, int g, MlRegs& r) {
#pragma unroll
  for (int ks = 0; ks < 4; ++ks) r.aq[ks] = *(const bf16x8*)(p.MQb + (size_t)(tokc + 16 * w + c) * 512 + h * 128 + 32 * ks + 8 * g);
#pragma unroll
  for (int k2 = 0; k2 < 2; ++k2)
    r.vf[k2] = *(const bf16x8*)(p.MVt + (size_t)(h * 128 + sl * 16 + c) * T_TOK + tokc + 32 * k2 + 8 * g);
#pragma unroll
  for (int dt = 0; dt < 2; ++dt)
#pragma unroll
    for (int k2 = 0; k2 < 2; ++k2)
      r.kf[dt][k2] = *(const bf16x8*)(p.MKt + (size_t)(h * 128 + 32 * w + 16 * dt + c) * T_TOK + tokc + 32 * k2 + 8 * g);
  const size_t so = (size_t)(DIR * 4 + h) * T_TOK + tokc;
#pragma unroll
  for (int k2 = 0; k2 < 2; ++k2) {
    r.wk[k2][0] = *(const f32x4*)(p.WKg + so + 32 * k2 + 8 * g);
    r.wk[k2][1] = *(const f32x4*)(p.WKg + so + 32 * k2 + 8 * g + 4);
  }
  r.ebi = *(const f32x4*)(p.EBI + so + 16 * w + 4 * g);
  r.deni = *(const f32x4*)(p.DENI + so + 16 * w + 4 * g);
  r.dec = p.DEC[(DIR * 4 + h) * 1280 + (tokc >> 6)];
  const bf16_t* NUMI = DIR ? p.NUMIb : p.NUMIf;
#pragma unroll
  for (int j = 0; j < 4; ++j) r.numi[j] = NUMI[(size_t)(tokc + 16 * w + 4 * g + j) * 512 + h * 128 + sl * 16 + c];
}

template <int DIR>
__device__ __forceinline__ void ml_chain_compute(const Params& p, int h, int sl, int tokc, int lane, int w, int c, int g, const MlRegs& r,
                                                 f32x4 (&C)[2][2], bf16_t* sCt, bool dry) {
  bf16_t* NUMI = DIR ? p.NUMIb : p.NUMIf;
  unsigned numi[4];
#pragma unroll
  for (int j = 0; j < 4; ++j) numi[j] = r.numi[j];
#pragma unroll
  for (int vt = 0; vt < 2; ++vt)
#pragma unroll
    for (int dt = 0; dt < 2; ++dt)
#pragma unroll
      for (int j = 0; j < 4; ++j) sCt[(16 * vt + 4 * g + j) * 136 + 32 * w + 16 * dt + c] = f2bf(C[vt][dt][j]);
  bf16x8 vfw[2][2];
#pragma unroll
  for (int k2 = 0; k2 < 2; ++k2) {
    float wv[8];
#pragma unroll
    for (int e = 0; e < 4; ++e) { wv[e] = r.wk[k2][0][e]; wv[4 + e] = r.wk[k2][1][e]; }
#pragma unroll
    for (int e = 0; e < 8; ++e) vfw[0][k2][e] = (short)f2bf(bf2f((bf16_t)r.vf[k2][e]) * wv[e]);
#pragma unroll
    for (int e = 0; e < 8; ++e) vfw[1][k2][e] = (c == 0) ? (short)f2bf(wv[e]) : (short)0;
  }
  lds_barrier();
  f32x4 o2[2];
  o2[0] = zero4(); o2[1] = zero4();
#pragma unroll
  for (int ks = 0; ks < 4; ++ks)
#pragma unroll
    for (int vt = 0; vt < 2; ++vt) {
      bf16x8 cf = *(const bf16x8*)(sCt + (16 * vt + c) * 136 + 32 * ks + 8 * g);
      o2[vt] = mfma16(r.aq[ks], cf, o2[vt]);
    }
#pragma unroll
  for (int dt = 0; dt < 2; ++dt)
#pragma unroll
    for (int vt = 0; vt < 2; ++vt) {
      f32x4 a = C[vt][dt] * r.dec;
#pragma unroll
      for (int k2 = 0; k2 < 2; ++k2) a = mfma16(vfw[vt][k2], r.kf[dt][k2], a);
      C[vt][dt] = a;
    }
#pragma unroll
  for (int j = 0; j < 4; ++j) {
    const float e = r.ebi[j];
    float den = e * o2[1][j];
    den = bperm(lane & 48, den) + r.deni[j];
    const float inv = 1.f / fmaxf(fabsf(den), 1.f);
    const float hv = (bf2f((bf16_t)numi[j]) + e * o2[0][j]) * inv;
    if (!dry) NUMI[(size_t)(tokc + 16 * w + 4 * g + j) * 512 + h * 128 + sl * 16 + c] = f2bf(hv);
  }
}

__device__ void ml_chain_item(const Params& p, int li, int item, char* smem, bool dry = false) {
  const int tid = otid(), lane = tid & 63, w = tid >> 6, c = lane & 15, g = lane >> 4;
  const int xr = item >> 3;
  const int pair = (item & 7) + 8 * (xr >> 3), sl = xr & 7;
  const int s = pair < 32 ? 4 + (pair >> 2) : ((pair - 32) >> 2);
  const int h = pair & 3;
  const int tok0 = s < 4 ? s * 4096 : T_P + (s - 4) * 8192;
  const int len = s < 4 ? 4096 : 8192;
  const int N = len / 64;
  bf16_t* sCt0 = (bf16_t*)smem;
  bf16_t* sCt1 = sCt0 + 32 * 136;
  f32x4 Cf[2][2], Cb[2][2];
#pragma unroll
  for (int a = 0; a < 2; ++a)
#pragma unroll
    for (int b = 0; b < 2; ++b) { Cf[a][b] = zero4(); Cb[a][b] = zero4(); }
  MlRegs rf, rb;
  __syncthreads();
  ml_chain_load<0>(p, h, sl, tok0, w, c, g, rf);
  for (int step = 0; step < N; ++step) {
    const int tf = tok0 + step * 64, tb = tok0 + (N - 1 - step) * 64;
    ml_chain_load<1>(p, h, sl, tb, w, c, g, rb);
    ml_chain_compute<0>(p, h, sl, tf, lane, w, c, g, rf, Cf, sCt0, dry);
    if (step + 1 < N) ml_chain_load<0>(p, h, sl, tf + 64, w, c, g, rf);
    ml_chain_compute<1>(p, h, sl, tb, lane, w, c, g, rb, Cb, sCt1, dry);
  }
}

#define ATTN_GLOAD(KT)                                                                              \
  {                                                                                                 \
    const long kb = tok0 + (KT) * 64;                                                               \
    rk0 = *(const bf16x8*)(p.KNb + (kb + (tid >> 3)) * 512 + head * 64 + 8 * (tid & 7));            \
    rk1 = *(const bf16x8*)(p.KNb + (kb + 32 + (tid >> 3)) * 512 + head * 64 + 8 * (tid & 7));       \
    rkr = *(const bf16x8*)(p.KRb + (kb + (tid >> 2)) * 32 + 8 * (tid & 3));                          \
    rv0 = *(const bf16x8*)(p.VtA + (long)(head * 64 + (tid >> 3)) * T_TOK + kb + 8 * (tid & 7));     \
    rv1 = *(const bf16x8*)(p.VtA + (long)(head * 64 + 32 + (tid >> 3)) * T_TOK + kb + 8 * (tid & 7)); \
  }
__device__ void attn_item(const Params& p, int item, char* smem, bool dry = false) {
  const int tid = otid(), lane = tid & 63, w = tid >> 6, c = lane & 15, g = lane >> 4;
  int s, head, qb;
  {
    const int x = item / 320, t = item % 320;
    if (t < 256) { const int pair = x + 8 * (t >> 5); qb = t & 31; s = 4 + (pair >> 3); head = pair & 7; }
    else { const int t2 = t - 256; const int pair = x + 8 * (t2 >> 4); qb = t2 & 15; s = pair >> 3; head = pair & 7; }
  }
  const int tok0 = s < 4 ? s * 4096 : T_P + (s - 4) * 8192;
  const int len = s < 4 ? 4096 : 8192;
  const int nkv = len / 64;
  bf16_t* sK = (bf16_t*)smem;
  bf16_t* sVt = sK + 64 * 104;
  const int qrow0 = tok0 + qb * 256 + 64 * w;
  bf16_t* sQr = sVt + 64 * 72;
  bf16x8 qf[4][2];
#pragma unroll
  for (int nt = 0; nt < 4; ++nt) {
#pragma unroll
    for (int ks = 0; ks < 2; ++ks)
      qf[nt][ks] = *(const bf16x8*)(p.Qa + (long)(qrow0 + 16 * nt + c) * 768 + head * 96 + 32 * ks + 8 * g);
    bf16x8 qr = *(const bf16x8*)(p.Qa + (long)(qrow0 + 16 * nt + c) * 768 + head * 96 + 64 + 8 * g);
    *(bf16x8*)(sQr + ((w * 4 + nt) * 64 + lane) * 8) = qr;
  }
  f32x4 ot[4][4];
#pragma unroll
  for (int vt = 0; vt < 4; ++vt)
#pragma unroll
    for (int nt = 0; nt < 4; ++nt) ot[vt][nt] = zero4();
  float mrun[4] = {-1e30f, -1e30f, -1e30f, -1e30f}, lrun[4] = {0.f, 0.f, 0.f, 0.f};
  bf16x8 rk0, rk1, rkr, rv0, rv1;
  ATTN_GLOAD(0)
  for (int kt = 0; kt < nkv; ++kt) {
    __syncthreads();
    *(bf16x8*)(sK + (tid >> 3) * 104 + 8 * (tid & 7)) = rk0;
    *(bf16x8*)(sK + (32 + (tid >> 3)) * 104 + 8 * (tid & 7)) = rk1;
    *(bf16x8*)(sK + (tid >> 2) * 104 + 64 + 8 * (tid & 3)) = rkr;
    *(bf16x8*)(sVt + (tid >> 3) * 72 + 8 * (tid & 7)) = rv0;
    *(bf16x8*)(sVt + (32 + (tid >> 3)) * 72 + 8 * (tid & 7)) = rv1;
    __syncthreads();
    if (kt + 1 < nkv) ATTN_GLOAD(kt + 1)
#pragma unroll 1
    for (int half = 0; half < 2; ++half) {
      f32x4 st[2][4];
#pragma unroll
      for (int k4 = 0; k4 < 2; ++k4)
#pragma unroll
        for (int nt = 0; nt < 4; ++nt) st[k4][nt] = zero4();
#pragma unroll
      for (int ks = 0; ks < 2; ++ks)
#pragma unroll
        for (int k4 = 0; k4 < 2; ++k4) {
          bf16x8 kf = *(const bf16x8*)(sK + (32 * half + 16 * k4 + c) * 104 + 32 * ks + 8 * g);
#pragma unroll
          for (int nt = 0; nt < 4; ++nt) st[k4][nt] = mfma16(kf, qf[nt][ks], st[k4][nt]);
        }
      {
        bf16x8 kr0 = *(const bf16x8*)(sK + (32 * half + c) * 104 + 64 + 8 * g);
        bf16x8 kr1 = *(const bf16x8*)(sK + (32 * half + 16 + c) * 104 + 64 + 8 * g);
#pragma unroll
        for (int nt = 0; nt < 4; ++nt) {
          bf16x8 qr = *(const bf16x8*)(sQr + ((w * 4 + nt) * 64 + lane) * 8);
          st[0][nt] = mfma16(kr0, qr, st[0][nt]);
          st[1][nt] = mfma16(kr1, qr, st[1][nt]);
        }
      }
      __builtin_amdgcn_sched_barrier(0);
      bf16x8 pb[4];
#pragma unroll
      for (int nt = 0; nt < 4; ++nt) {
        float mx = -1e30f;
#pragma unroll
        for (int k4 = 0; k4 < 2; ++k4)
#pragma unroll
          for (int j = 0; j < 4; ++j) mx = fmaxf(mx, st[k4][nt][j]);
        mx = fmaxf(mx, sxor(mx, 16, lane));
        mx = fmaxf(mx, sxor(mx, 32, lane));
        const float mn = fmaxf(mrun[nt], mx);
        const float alpha = __builtin_amdgcn_exp2f(mrun[nt] - mn);
        mrun[nt] = mn;
        float psum = 0.f;
#pragma unroll
        for (int k4 = 0; k4 < 2; ++k4)
#pragma unroll
          for (int j = 0; j < 4; ++j) {
            float pv = __builtin_amdgcn_exp2f(st[k4][nt][j] - mn);
            st[k4][nt][j] = pv;
            psum += pv;
          }
        lrun[nt] = lrun[nt] * alpha + psum;
#pragma unroll
        for (int vt = 0; vt < 4; ++vt) ot[vt][nt] = ot[vt][nt] * alpha;
        typedef __attribute__((ext_vector_type(4))) unsigned u32x4;
        u32x4 pk;
        pk[0] = pk2bf(st[0][nt][0], st[0][nt][1]);
        pk[1] = pk2bf(st[0][nt][2], st[0][nt][3]);
        pk[2] = pk2bf(st[1][nt][0], st[1][nt][1]);
        pk[3] = pk2bf(st[1][nt][2], st[1][nt][3]);
        pb[nt] = __builtin_bit_cast(bf16x8, pk);
      }
      __builtin_amdgcn_sched_barrier(0);
#pragma unroll
      for (int vt = 0; vt < 4; ++vt) {
        us4 lo = *(const us4*)(sVt + (16 * vt + c) * 72 + 32 * half + 4 * g);
        us4 hi = *(const us4*)(sVt + (16 * vt + c) * 72 + 32 * half + 16 + 4 * g);
        bf16x8 av;
#pragma unroll
        for (int e = 0; e < 4; ++e) { av[e] = (short)lo[e]; av[4 + e] = (short)hi[e]; }
#pragma unroll
        for (int nt = 0; nt < 4; ++nt) ot[vt][nt] = mfma16(av, pb[nt], ot[vt][nt]);
      }
    }
  }
#pragma unroll
  for (int nt = 0; nt < 4; ++nt) {
    float lt = lrun[nt];
    lt += sxor(lt, 16, lane);
    lt += sxor(lt, 32, lane);
    const float inv = 1.f / lt;
    const long tok = qrow0 + 16 * nt + c;
#pragma unroll
    for (int vt = 0; vt < 4; ++vt) {
      bf16_t* gp = p.MGb + tok * 512 + head * 64 + 16 * vt + 4 * g;
      us4 gt = *(const us4*)gp;
      us4 o;
#pragma unroll
      for (int j = 0; j < 4; ++j) o[j] = f2bf(ot[vt][nt][j] * inv * siluf_(bf2f(gt[j])));
      if (!dry) *(us4*)gp = o;
    }
  }
}

__device__ void phase_gla_combine(const Params& p, int li, bool dry = false) {
  const int tid_ = otid(); const int lane = tid_ & 63, w = tid_ >> 6;
  for (int tok = blockIdx.x * 4 + w; tok < T_TOK; tok += gridDim.x * 4) {
    const bf16_t* tp = p.TMP + (long)tok * 1024 + 16 * lane;
    bf16_t* gp = p.Gb + (long)tok * 1024 + 16 * lane;
    bf16x8 o0 = *(const bf16x8*)tp, o1 = *(const bf16x8*)(tp + 8);
    bf16x8 g0 = *(const bf16x8*)gp, g1 = *(const bf16x8*)(gp + 8);
    float ov[16], gv[16];
#pragma unroll
    for (int e = 0; e < 8; ++e) {
      ov[e] = bf2f((bf16_t)o0[e]); ov[8 + e] = bf2f((bf16_t)o1[e]);
      gv[e] = bf2f((bf16_t)g0[e]); gv[8 + e] = bf2f((bf16_t)g1[e]);
    }
    float ss = 0.f;
#pragma unroll
    for (int e = 0; e < 16; ++e) ss += ov[e] * ov[e];
    ss += sxor(ss, 1, lane); ss += sxor(ss, 2, lane); ss += sxor(ss, 4, lane); ss += sxor(ss, 8, lane);
    const float rs = rsqrtf(ss * (1.f / 256.f) + EPS);
    const float* ng = p.e_gla_norm_g + li * 256 + ((16 * lane) & 255);
    bf16x8 r0, r1;
#pragma unroll
    for (int e = 0; e < 8; ++e) {
      r0[e] = (short)f2bf(ov[e] * rs * ng[e] * siluf_(gv[e]));
      r1[e] = (short)f2bf(ov[8 + e] * rs * ng[8 + e] * siluf_(gv[8 + e]));
    }
    if (!dry) { *(bf16x8*)gp = r0;
    *(bf16x8*)(gp + 8) = r1; }
  }
}

__device__ void phase_ml_combine(const Params& p, int li, bool dry = false) {
  const int tid_ = otid(); const int lane = tid_ & 63, w = tid_ >> 6;
  for (int tok = blockIdx.x * 4 + w; tok < T_TOK; tok += gridDim.x * 4) {
    const long off = (long)tok * 512 + 8 * lane;
    bf16x8 hv = *(const bf16x8*)(p.NUMIf + off);
    bf16x8 hb = *(const bf16x8*)(p.NUMIb + off);
    bf16x8 mo = *(const bf16x8*)(p.MOb + off);
    bf16x8 mg = *(const bf16x8*)(p.MLGb + off);
    float hf[8];
    float ss = 0.f;
#pragma unroll
    for (int e = 0; e < 8; ++e) { hf[e] = bf2f((bf16_t)hv[e]) + bf2f((bf16_t)hb[e]); ss += hf[e] * hf[e]; }
    ss += sxor(ss, 1, lane); ss += sxor(ss, 2, lane); ss += sxor(ss, 4, lane); ss += sxor(ss, 8, lane);
    const float rs = rsqrtf(ss * (1.f / 128.f) + EPS);
    const float* ng = p.o_ml_norm_g + li * 128 + ((8 * lane) & 127);
    bf16x8 r;
#pragma unroll
    for (int e = 0; e < 8; ++e)
      r[e] = (short)f2bf(hf[e] * rs * ng[e] * sigmoidf_(bf2f((bf16_t)mo[e])) * siluf_(bf2f((bf16_t)mg[e])));
    if (!dry) *(bf16x8*)(p.MLGb + off) = r;
  }
}

__device__ void phase_final(const Params& p, bool dry = false) {
  const int tid_ = otid(); const int lane = tid_ & 63, w = tid_ >> 6;
  for (int tok = blockIdx.x * 4 + w; tok < T_TOK; tok += gridDim.x * 4) {
    float* xp = p.out + (long)tok * DM;
    float4 v[4];
    float ss = 0.f;
#pragma unroll
    for (int i = 0; i < 4; ++i) {
      v[i] = *(const float4*)(xp + 4 * lane + 256 * i);
      ss += v[i].x * v[i].x + v[i].y * v[i].y + v[i].z * v[i].z + v[i].w * v[i].w;
    }
#pragma unroll
    for (int d = 1; d < 64; d <<= 1) ss += sxor(ss, d, lane);
    const float rs = rsqrtf(ss * (1.f / 1024.f) + EPS);
#pragma unroll
    for (int i = 0; i < 4; ++i) {
      float4 gq = *(const float4*)(p.final_norm_g + 4 * lane + 256 * i);
      float4 o;
      o.x = v[i].x * rs * gq.x; o.y = v[i].y * rs * gq.y; o.z = v[i].z * rs * gq.z; o.w = v[i].w * rs * gq.w;
      if (!dry) *(float4*)(xp + 4 * lane + 256 * i) = o;
    }
  }
}

__device__ void run_phase(const Params& p, int ph, char* smem) {
  if (ph == 0) { if (PH_ON(0)) phase_prep(p); return; }
  if (ph == NPHASE - 1) { if (PROBE_B) phase_final(p, true); if (PH_ON(11)) phase_final(p); return; }
  const int q = ph - 1;
  const int layer = (q < 5) ? 0 : (q < 12) ? 1 : (q < 17) ? 2 : 3;
  const int sub = (q < 5) ? q : (q < 12) ? q - 5 : (q < 17) ? q - 12 : q - 17;
  const int li = layer >> 1;
  const float* xa = (layer == 0) ? p.x_prompt : p.out;
  const float* xb = (layer == 0) ? p.x_sample : p.out + (long)T_P * DM;
  if ((layer & 1) == 0) {
    if (sub == 0) {
      EpiEvenIn e{p.Qb, p.Kt, p.VtE, p.Gb, p.LRb, p.PUb, p.PGb};
      if (PH_ON(1)) gemm_phase<3, 8>(T_TOK / 128, NE_PAD / 256, DM, p.WinE + (long)li * NE_PAD * DM, p.SSQ, nullptr, p.TMP, DM, DM, p.TMP, DM, e, smem);
    } else if (sub == 1) {
#if PROBE_A
      for (int item = blockIdx.x; item < 5120; item += gridDim.x) gla_intra_item(p, li, item, smem, true);
#endif
#if PROBE_B
      for (int item = blockIdx.x; item < 5120; item += gridDim.x) pool_item(p, li, item, smem, true);
#endif
      for (int item = blockIdx.x; item < 5120 + 5120; item += gridDim.x) {
        if (item < 5120) { if (PH_ON(2)) gla_intra_item(p, li, item, smem); }
        else { if (PH_ON(3)) pool_item(p, li, item - 5120, smem); }
      }
    } else if (sub == 2) {
      for (int rep = PROBE_CHAIN ? 0 : 1; rep < 2; ++rep)
      for (int item = blockIdx.x; item < 384; item += gridDim.x)
        if (PH_ON(2)) gla_chain_item(p, li, item, smem, rep == 0);
    } else if (sub == 3) {
      if (PROBE_B) phase_gla_combine(p, li, true);
      if (PH_ON(4)) phase_gla_combine(p, li);
    } else {
      EpiOut e{xa, xb, p.out, false, p.NUMIf, p.SSQ};
      if (PH_ON(5)) gemm_phase<1, 8>(T_TOK / 128, DM / 256, 1536, p.WoutE + (long)li * DM * 1536, nullptr, nullptr, p.Gb, 1024, 1024, p.PGb, 512, e, smem);
    }
  } else {
    if (sub == 0) {
      EpiOddIn e{p.CQb, p.CKVb, p.KRb, p.MGb, p.MQb, p.MKb, p.MKt, p.MVt, p.MOb, p.MLGb, p.MIF};
      if (PH_ON(6)) gemm_phase<3, 8>(T_TOK / 128, NO_PAD / 256, DM, p.WinO + (long)li * NO_PAD * DM, p.SSQ, nullptr, p.NUMIf, DM, DM, p.NUMIf, DM, e, smem);
    } else if (sub == 1) {
      for (int rep = 0; rep < 1 + PROBE_A; ++rep)
      for (int item = blockIdx.x; item < 5120; item += gridDim.x)
        if (PH_ON(8)) ml_intra_item(p, li, item, smem);
    } else if (sub == 2) {
      for (int rep = PROBE_MLCHAIN ? 0 : 1; rep < 2; ++rep)
      for (int item = blockIdx.x; item < 384; item += gridDim.x)
        if (PH_ON(8)) ml_chain_item(p, li, item, smem, rep == 0);
    } else if (sub == 3) {
      if (PROBE_B) phase_ml_combine(p, li, true);
      if (PH_ON(10)) phase_ml_combine(p, li);
    } else if (sub == 4) {
      EpiQUp eq{p.Qa};
      if (PH_ON(7)) gemm_phase<2, 4>(T_TOK / 128, 768 / 128, 384, p.QupT + (long)li * 768 * 384, nullptr, nullptr, p.CQb, 384, 384, p.CQb, 384, eq, smem);
      EpiKVUp ek{p.KNb, p.VtA};
      if (PH_ON(7)) gemm_phase<2, 4>(T_TOK / 128, 1024 / 128, 256, p.KVupT + (long)li * 1024 * 256, nullptr, nullptr, p.CKVb, 256, 256, p.CKVb, 256, ek, smem);
    } else if (sub == 5) {
      __shared__ int s_item;
      for (;;) {
        __syncthreads();
        if (threadIdx.x == 0) s_item = atomicAdd(p.counters + li * 8 + (blockIdx.x & 7), 1);
        __syncthreads();
        const int item = s_item;
        if (item >= 320) break;
        if (PH_ON(9)) attn_item(p, (blockIdx.x & 7) * 320 + item, smem);
      }
    } else {
      EpiOut e{xa, xb, p.out, false, (layer == 3) ? nullptr : p.TMP, p.SSQ};
      if (PH_ON(5)) gemm_phase<1, 8>(T_TOK / 128, DM / 256, 1024, p.WoutO + (long)li * DM * 1024, nullptr, nullptr, p.MGb, 512, 512, p.MLGb, 512, e, smem);
    }
  }
}

__global__ void __launch_bounds__(256, 2) mega_kernel(Params p) {
  extern __shared__ __attribute__((aligned(16))) char smem[];
  cg::grid_group grid = cg::this_grid();
  __shared__ uint4 xb_words;
  if (threadIdx.x == 0) xb_words = make_uint4(0u, 0u, 0u, 0u);
  __syncthreads();
  XcdBarrier xb = xcd_barrier_post(p.bar, (volatile LAS unsigned*)&xb_words);
  for (int ph = p.ph_lo; ph < p.ph_hi; ++ph) {
    if (ph > p.ph_lo) {
      if (ph == p.ph_lo + 1) grid.sync();
      else xcd_barrier(xb);
    }
    run_phase(p, ph, smem);
  }
}

extern "C" void kernel_launch(void* const* d_in, const int* in_sizes, int n_in, void* d_out, int out_size, void* d_ws,
                              size_t ws_size, hipStream_t stream) {
  static int grid_blocks = 0;
  if (!grid_blocks) {
    int dev = 0, cus = 0, per_cu = 0;
    hipGetDevice(&dev);
    hipDeviceGetAttribute(&cus, hipDeviceAttributeMultiprocessorCount, dev);
    hipFuncSetAttribute((const void*)mega_kernel, hipFuncAttributeMaxDynamicSharedMemorySize, LDS_BYTES);
    hipOccupancyMaxActiveBlocksPerMultiprocessor(&per_cu, (const void*)mega_kernel, 256, LDS_BYTES);
    if (per_cu < 1) per_cu = 1;
    if (per_cu > 2) per_cu = 2;
    grid_blocks = cus * per_cu;
    fprintf(stderr, "kernel_launch: cus %d per_cu %d grid %d ws %zu\n", cus, per_cu, grid_blocks, ws_size);
  }
  Params p{};
  const float** pin = (const float**)&p;
  for (int i = 0; i < 19; ++i) pin[i] = (const float*)d_in[i];
  p.out = (float*)d_out;
  char* ws = (char*)d_ws;
  size_t off = 0;
  auto take = [&](size_t bytes) { char* r = ws + off; off += (bytes + 255) & ~(size_t)255; return r; };
  p.WinE = (bf16_t*)take((size_t)2 * NE_PAD * DM * 2);
  p.WinO = (bf16_t*)take((size_t)2 * NO_PAD * DM * 2);
  p.WoutE = (bf16_t*)take((size_t)2 * DM * 1536 * 2);
  p.WoutO = (bf16_t*)take((size_t)2 * DM * 1024 * 2);
  p.QupT = (bf16_t*)take((size_t)2 * 768 * 384 * 2);
  p.KVupT = (bf16_t*)take((size_t)2 * 1024 * 256 * 2);
  p.PoolWT = (bf16_t*)take((size_t)2 * 4 * 128 * 128 * 2);
  p.AupT = (bf16_t*)take((size_t)2 * 2 * 512 * 32 * 2);
  p.counters = (int*)take(256);
  p.bar = (unsigned*)take((size_t)XCD_BAR_WORDS * 4);
  p.SSQ = (float*)take((size_t)T_TOK * 8 * 4);
  const size_t act0 = off;
  const size_t T = T_TOK;
  p.Gb = (bf16_t*)take(T * 1024 * 2);
  p.PGb = (bf16_t*)take(T * 512 * 2);
  p.Qb = (bf16_t*)take(T * 512 * 2);
  p.Kt = (bf16_t*)take(T * 512 * 2);
  p.QEb = (bf16_t*)take(T * 512 * 2);
  p.KdTb = (bf16_t*)take(T * 512 * 2);
  p.EB = (float*)take((size_t)2 * 1280 * 512 * 4);
  p.VtE = (bf16_t*)take(T * 1024 * 2);
  p.LRb = (bf16_t*)take(T * 32 * 2);
  p.PUb = (bf16_t*)take(T * 512 * 2);
  p.TMP = (bf16_t*)take(T * 1024 * 2);
  const size_t even_end = off;
  off = act0;
  p.MGb = (bf16_t*)take(T * 512 * 2);
  p.MLGb = (bf16_t*)take(T * 512 * 2);
  p.CQb = (bf16_t*)take(T * 384 * 2);
  p.CKVb = (bf16_t*)take(T * 256 * 2);
  p.KRb = (bf16_t*)take(T * 32 * 2);
  const size_t r2 = off;
  p.MQb = (bf16_t*)take(T * 512 * 2);
  p.MKb = (bf16_t*)take(T * 512 * 2);
  p.MKt = (bf16_t*)take(T * 512 * 2);
  p.MVt = (bf16_t*)take(T * 512 * 2);
  p.MOb = (bf16_t*)take(T * 512 * 2);
  p.NUMIf = (bf16_t*)take(T * 512 * 2);
  p.NUMIb = (bf16_t*)take(T * 512 * 2);
  p.MIF = (float*)take(T * 16 * 4);
  p.EBI = (float*)take(T * 8 * 4);
  p.WKg = (float*)take(T * 8 * 4);
  p.DENI = (float*)take(T * 8 * 4);
  p.DEC = (float*)take((size_t)8 * 1280 * 4);
  const size_t r2_end = off;
  off = r2;
  p.Qa = (bf16_t*)take(T * 768 * 2);
  p.KNb = (bf16_t*)take(T * 512 * 2);
  p.VtA = (bf16_t*)take(T * 512 * 2);
  if (off < r2_end) off = r2_end;
  const size_t odd_end = off;
  const size_t need = even_end > odd_end ? even_end : odd_end;
  if (need > ws_size) {
    fprintf(stderr, "kernel_launch: workspace too small: need %zu have %zu\n", need, ws_size);
    return;
  }
  hipMemsetAsync(p.bar, 0, (size_t)XCD_BAR_WORDS * 4, stream);
#if SINGLE_LAUNCH
  p.ph_lo = 0;
  p.ph_hi = NPHASE;
  void* args[] = {&p};
  hipError_t e = hipLaunchCooperativeKernel((const void*)mega_kernel, dim3(grid_blocks), dim3(256), args, LDS_BYTES, stream);
  if (e != hipSuccess) fprintf(stderr, "cooperative launch failed: %s (grid %d)\n", hipGetErrorString(e), grid_blocks);
#else
  for (int ph = 0; ph < NPHASE; ++ph) {
    p.ph_lo = ph;
    p.ph_hi = ph + 1;
    hipLaunchKernelGGL(mega_kernel, dim3(grid_blocks), dim3(256), LDS_BYTES, stream, p);
  }
#endif
}
```

```cpp
#include <hip/hip_runtime.h>
#include <hip/hip_cooperative_groups.h>
#include <cstdio>
namespace cg = cooperative_groups;

#ifndef SINGLE_LAUNCH
#define SINGLE_LAUNCH 1
#endif
#ifndef PHMASK
#define PHMASK 0xFFFF
#endif
#define PH_ON(b) ((PHMASK >> (b)) & 1)
#ifndef PROBE_GEMM
#define PROBE_GEMM 0
#endif
#ifndef PROBE_ATTN
#define PROBE_ATTN 0
#endif
#ifndef PROBE_CHAIN
#define PROBE_CHAIN 0
#endif
#ifndef PROBE_A
#define PROBE_A 0
#endif
#ifndef PROBE_B
#define PROBE_B 0
#endif
#ifndef PROBE_MLCHAIN
#define PROBE_MLCHAIN 0
#endif

typedef unsigned short bf16_t;
typedef __attribute__((ext_vector_type(8))) short bf16x8;
typedef __attribute__((ext_vector_type(4))) float f32x4;
typedef __attribute__((ext_vector_type(4))) unsigned short us4;

constexpr int T_TOK = 81920;
constexpr int T_P = 16384;
constexpr int DM = 1024;
constexpr int NE = 4128, NE_PAD = 4352;
constexpr int NO = 4272, NO_PAD = 4352;
constexpr float EPS = 1e-6f;
constexpr int NPHASE = 26;
constexpr int LDS_BYTES = 72 * 1024;

struct Params {
  const float *x_prompt, *x_sample, *norm_g, *final_norm_g, *e_w_in, *e_a_up, *e_a_bias, *e_gla_norm_g,
      *e_pool_w, *e_pool_scale, *e_w_out, *o_w_in, *o_q_norm_g, *o_q_up, *o_kv_norm_g, *o_kv_up, *o_if_bias,
      *o_ml_norm_g, *o_w_out;
  float* out;
  bf16_t *WinE, *WinO, *WoutE, *WoutO, *QupT, *KVupT, *PoolWT, *AupT;
  int* counters;
  unsigned* bar;
  float* SSQ;
  bf16_t *Qb, *Kt, *VtE, *Gb, *LRb, *PUb, *PGb, *TMP, *QEb, *KdTb;
  float* EB;
  bf16_t *CQb, *CKVb, *KRb, *MGb, *MQb, *MKb, *MKt, *MVt, *MOb, *MLGb, *NUMIf, *NUMIb, *Qa, *KNb, *VtA;
  float *MIF, *EBI, *WKg, *DENI, *DEC;
  int ph_lo, ph_hi;
};

typedef __bf16 hbf2 __attribute__((ext_vector_type(2)));
typedef float hf2 __attribute__((ext_vector_type(2)));
__device__ __forceinline__ bf16_t f2bf(float f) {
  __bf16 b = (__bf16)f;
  return __builtin_bit_cast(bf16_t, b);
}
__device__ __forceinline__ unsigned pk2bf(float a, float b) {
  hf2 v = {a, b};
  hbf2 r = __builtin_convertvector(v, hbf2);
  return __builtin_bit_cast(unsigned, r);
}
__device__ __forceinline__ float bf2f(bf16_t b) { return __uint_as_float(((unsigned)b) << 16); }
__device__ __forceinline__ f32x4 mfma16(bf16x8 a, bf16x8 b, f32x4 c) {
  return __builtin_amdgcn_mfma_f32_16x16x32_bf16(a, b, c, 0, 0, 0);
}
__device__ __forceinline__ float logsigmoidf_(float x) { return fminf(x, 0.f) - log1pf(__expf(-fabsf(x))); }
__device__ __forceinline__ float siluf_(float x) { return x / (1.f + __expf(-x)); }
__device__ __forceinline__ float sigmoidf_(float x) { return 1.f / (1.f + __expf(-x)); }
__device__ __forceinline__ int otid() { int t = threadIdx.x; asm volatile("" : "+v"(t)); return t; }
__device__ __forceinline__ float bperm(int srclane, float v) { return __int_as_float(__builtin_amdgcn_ds_bpermute(srclane << 2, __float_as_int(v))); }
__device__ __forceinline__ float sxor(float v, int m, int lane) { return bperm(lane ^ m, v); }
typedef unsigned u32x2_t __attribute__((ext_vector_type(2)));
__device__ __forceinline__ float rowmax4(float v) {
  u32x2_t r = __builtin_amdgcn_permlane16_swap(__float_as_uint(v), __float_as_uint(v), false, false);
  v = fmaxf(__uint_as_float(r[0]), __uint_as_float(r[1]));
  r = __builtin_amdgcn_permlane32_swap(__float_as_uint(v), __float_as_uint(v), false, false);
  return fmaxf(__uint_as_float(r[0]), __uint_as_float(r[1]));
}
__device__ __forceinline__ bf16x8 zero8() { bf16x8 z = {0, 0, 0, 0, 0, 0, 0, 0}; return z; }
__device__ __forceinline__ f32x4 zero4() { f32x4 z = {0.f, 0.f, 0.f, 0.f}; return z; }

__device__ __forceinline__ int seq_pos(int tok) { return tok < T_P ? (tok & 4095) : ((tok - T_P) & 8191); }
__device__ __forceinline__ const float* xrow(const float* xa, const float* xb, int tok) {
  return tok < T_P ? xa + (long)tok * DM : xb + (long)(tok - T_P) * DM;
}


#define XB_TMO      128
#define XB_XCNT(j)  (256  + 64 * (j))
#define XB_XSUB(j)  (1280 + 64 * (j))
#define XB_XGEN(j)  (2304 + 64 * (j))
#define XB_TOP      3328
#define XB_TOPGEN   3392
#define XCD_BAR_WORDS 3456
#define XB_SPIN_CAP (1u << 22)
#define LAS __attribute__((address_space(3)))
__device__ __forceinline__ unsigned xb_ld(unsigned* p) { return __hip_atomic_load(p, __ATOMIC_RELAXED, __HIP_MEMORY_SCOPE_AGENT); }
__device__ __forceinline__ unsigned xb_add(unsigned* p, unsigned v) { return __hip_atomic_fetch_add(p, v, __ATOMIC_RELAXED, __HIP_MEMORY_SCOPE_AGENT); }
__device__ __forceinline__ unsigned xb_xcc_id() { return (unsigned)__builtin_amdgcn_s_getreg((3 << 11) | 20) & 0xFu; }
#define XB_SPIN(cond, bar) do { unsigned _sp = 0; while (cond) { __builtin_amdgcn_s_sleep(1); \
    if ((++_sp & 255u) == 0u) { if (xb_ld(&(bar)[XB_TMO])) break; if (_sp > XB_SPIN_CAP) { atomicAdd(&(bar)[XB_TMO], 1u); break; } } } } while (0)
struct XcdBarrier { unsigned* bar; unsigned x; volatile LAS unsigned* st; };
__device__ __forceinline__ XcdBarrier xcd_barrier_post(unsigned* bar, volatile LAS unsigned* st) {
  XcdBarrier b; b.bar = bar; b.x = xb_xcc_id(); b.st = st;
  if (threadIdx.x == 0) (void)xb_add(&bar[XB_XCNT(b.x)], 1u);
  return b;
}
__device__ __forceinline__ void xcd_barrier_complete(unsigned* bar, unsigned x, unsigned& nloc, unsigned& nx) {
  const unsigned G = gridDim.x * gridDim.y * gridDim.z;
  unsigned sum, cnt, mine, sp = 0u;
  for (;;) {
    sum = 0u; cnt = 0u; mine = 0u;
#pragma unroll
    for (unsigned j = 0; j < 16; ++j) { const unsigned cc = xb_ld(&bar[XB_XCNT(j)]); sum += cc; cnt += (cc > 0u) ? 1u : 0u; mine = (j == x) ? cc : mine; }
    if (sum == G) break;
    __builtin_amdgcn_s_sleep(1);
    if ((++sp & 255u) == 0u) { if (xb_ld(&bar[XB_TMO])) break; if (sp > XB_SPIN_CAP) { atomicAdd(&bar[XB_TMO], 1u); break; } }
  }
  nloc = mine > 0u ? mine : 1u; nx = cnt > 0u ? cnt : 1u;
}
__device__ __forceinline__ void xcd_barrier(const XcdBarrier& b) {
  asm volatile("s_waitcnt vmcnt(0)" ::: "memory");
  __syncthreads();
  if (threadIdx.x == 0) {
    unsigned* bar = b.bar;
    __builtin_amdgcn_s_waitcnt(0);
    unsigned nloc = b.st[0], nx = b.st[1];
    if (nloc == 0u) { xcd_barrier_complete(bar, b.x, nloc, nx); b.st[0] = nloc; b.st[1] = nx; }
    const unsigned old = xb_add(&bar[XB_XSUB(b.x)], 1u);
    const unsigned gen = old / nloc;
    if (old + 1u == (gen + 1u) * nloc) {
      __builtin_amdgcn_fence(__ATOMIC_RELEASE, "agent");
      asm volatile("s_waitcnt vmcnt(0)" ::: "memory");
      const unsigned og = xb_add(&bar[XB_TOP], 1u);
      const unsigned tg = og / nx;
      if (og + 1u == (tg + 1u) * nx) xb_add(&bar[XB_TOPGEN], 1u);
      else XB_SPIN(xb_ld(&bar[XB_TOPGEN]) == tg, bar);
      __builtin_amdgcn_fence(__ATOMIC_ACQUIRE, "agent");
      xb_add(&bar[XB_XGEN(b.x)], 1u);
      asm volatile("s_waitcnt vmcnt(0)" ::: "memory");
    } else {
      XB_SPIN(xb_ld(&bar[XB_XGEN(b.x)]) == gen, bar);
      __builtin_amdgcn_fence(__ATOMIC_ACQUIRE, "agent");
      asm volatile("s_waitcnt vmcnt(0)" ::: "memory");
    }
  }
  __syncthreads();
}

__device__ __forceinline__ int colmap(int mode, int n) {
  if (mode == 1) {
    if (n < 512) return 2208 + n;
    if (n < 1024) return 1696 + (n - 512);
    if (n < 1408) return n - 1024;
    if (n < 1664) return 384 + (n - 1408);
    if (n < 2176) return 672 + (n - 1664);
    if (n < 2688) return 1184 + (n - 2176);
    if (n < 3200) return 1696 + (n - 2688);
    if (n < 3712) return 2720 + (n - 3200);
    if (n < 4224) return 3248 + (n - 3712);
    if (n < 4256) return 640 + (n - 4224);
    return 3232 + (n - 4256);
  }
  if (mode == 2) {
    if (n < 512) return (n >> 6) * 96 + (n & 63);
    const int r = n - 512;
    return (r >> 5) * 96 + 64 + (r & 31);
  }
  if (mode == 3) {
    if (n < 512) return (n >> 6) * 128 + (n & 63);
    const int r = n - 512;
    return (r >> 6) * 128 + 64 + (r & 63);
  }
  return n;
}

__device__ void prep_weight(const float* __restrict__ W, int K, int N, int Npad, const float* __restrict__ gsc,
                            bf16_t* __restrict__ out, long gtid, long gsize, int mode = 0, int Nsrc_ = 0) {
  const int Nsrc = Nsrc_ ? Nsrc_ : N;
  long total = (long)Npad * K;
  for (long idx = gtid; idx < total; idx += gsize) {
    int k = (int)(idx / Npad);
    int n = (int)(idx % Npad);
    float v = 0.f;
    if (n < N) {
      v = W[(long)k * Nsrc + colmap(mode, n)];
      if (gsc) v *= gsc[k];
    }
    out[(long)n * K + k] = f2bf(v);
  }
}

__device__ void phase_prep(const Params& p) {
  long gtid = (long)blockIdx.x * 256 + otid();
  long gsize = (long)gridDim.x * 256;
  for (int l = 0; l < 2; ++l) {
    prep_weight(p.e_w_in + (long)l * DM * NE, DM, NE, NE_PAD, p.norm_g + (2 * l) * DM, p.WinE + (long)l * NE_PAD * DM, gtid, gsize);
    prep_weight(p.o_w_in + (long)l * DM * 3760, DM, NO, NO_PAD, p.norm_g + (2 * l + 1) * DM, p.WinO + (long)l * NO_PAD * DM, gtid, gsize, 1, 3760);
    prep_weight(p.e_w_out + (long)l * 1536 * DM, 1536, DM, DM, nullptr, p.WoutE + (long)l * DM * 1536, gtid, gsize);
    prep_weight(p.o_w_out + (long)l * 1024 * DM, 1024, DM, DM, nullptr, p.WoutO + (long)l * DM * 1024, gtid, gsize);
    prep_weight(p.o_q_up + (long)l * 384 * 768, 384, 768, 768, p.o_q_norm_g + l * 384, p.QupT + (long)l * 768 * 384, gtid, gsize, 2);
    prep_weight(p.o_kv_up + (long)l * 256 * 1024, 256, 1024, 1024, p.o_kv_norm_g + l * 256, p.KVupT + (long)l * 1024 * 256, gtid, gsize, 3);
    for (int gi = 0; gi < 4; ++gi)
      prep_weight(p.e_pool_w + (long)(l * 4 + gi) * 128 * 128, 128, 128, 128, nullptr, p.PoolWT + (long)(l * 4 + gi) * 128 * 128, gtid, gsize);
    for (long idx = gtid; idx < 2 * 512 * 32; idx += gsize) {
      int r = (int)(idx & 31);
      int d = (int)((idx >> 5) & 511);
      int dir = (int)(idx >> 14);
      float v = (r < 16) ? p.e_a_up[((long)(l * 2 + dir) * 16 + r) * 512 + d] : 0.f;
      p.AupT[((long)(l * 2 + dir) * 512 + d) * 32 + r] = f2bf(v);
    }
  }
  if (gtid < 16) p.counters[gtid] = 0;
  {
    const int tid_ = otid();
    const int lane = tid_ & 63, w = tid_ >> 6;
    for (int tok = blockIdx.x * 4 + w; tok < T_TOK; tok += gridDim.x * 4) {
      const float* xp = xrow(p.x_prompt, p.x_sample, tok) + 16 * lane;
      float ssv = 0.f;
      unsigned pk[8];
#pragma unroll
      for (int i = 0; i < 4; ++i) {
        const f32x4 v = *(const f32x4*)(xp + 4 * i);
        ssv += v[0] * v[0] + v[1] * v[1] + v[2] * v[2] + v[3] * v[3];
        pk[2 * i] = pk2bf(v[0], v[1]);
        pk[2 * i + 1] = pk2bf(v[2], v[3]);
      }
      uint4 o0, o1;
      o0.x = pk[0]; o0.y = pk[1]; o0.z = pk[2]; o0.w = pk[3];
      o1.x = pk[4]; o1.y = pk[5]; o1.z = pk[6]; o1.w = pk[7];
      *(uint4*)(p.TMP + (size_t)tok * DM + 16 * lane) = o0;
      *(uint4*)(p.TMP + (size_t)tok * DM + 16 * lane + 8) = o1;
#pragma unroll
      for (int d = 1; d < 64; d <<= 1) ssv += sxor(ssv, d, lane);
      if (lane < 8) p.SSQ[(size_t)tok * 8 + lane] = (lane == 0) ? ssv : 0.f;
    }
  }
}

constexpr int G_LD = 40;
constexpr int G_BUF = (128 + 256) * G_LD;

template <int AMODE, int NI, class Epi>
__device__ __forceinline__ void gemm_phase(int Mtiles, int Ntiles, int K, const bf16_t* __restrict__ Bt, const float* ssq, const float* unused_,
                           const bf16_t* A1, int ld1, int K1, const bf16_t* A2, int ld2, const Epi& epi, char* smem) {
  bf16_t* sbase = (bf16_t*)smem;
  float* sR = (float*)(smem + 70144);
  const int tid = otid(), lane = tid & 63, w = tid >> 6, c = lane & 15, g = lane >> 4;
  const int wm = w >> 1, wn = w & 1;
  const int nk = K / 32;
  const int xcd = blockIdx.x & 7, lb0 = blockIdx.x >> 3, nlb = gridDim.x >> 3;
  const int mper = Mtiles >> 3;
  for (int lt = lb0; lt < mper * Ntiles; lt += nlb) {
    const int mt = xcd * mper + lt / Ntiles, nt = lt % Ntiles;
    constexpr int BN = 32 * NI;
    const int m0 = mt * 128, n0 = nt * BN;
    f32x4 acc[4][NI];
#pragma unroll
    for (int i = 0; i < 4; ++i)
#pragma unroll
      for (int j = 0; j < NI; ++j) acc[i][j] = zero4();
    float ss[2] = {0.f, 0.f};
    bf16x8 ra0[2], ra1[2];
    bf16x8 rb0[NI / 2], rb1[NI / 2];
    const unsigned boff = (unsigned)(tid >> 2) * K + 8 * (tid & 3);
    const bf16_t* bbase = Bt + (size_t)n0 * K;
#define G_LOAD(RA, RB, KT)                                                                          \
  {                                                                                                 \
    const int k0_ = (KT) * 32;                                                                      \
    const bf16_t* base_;                                                                            \
    int ld_;                                                                                        \
    if (k0_ < K1) { base_ = A1 + (size_t)m0 * ld1 + k0_; ld_ = ld1; }                               \
    else { base_ = A2 + (size_t)m0 * ld2 + (k0_ - K1); ld_ = ld2; }                                 \
    _Pragma("unroll") for (int i = 0; i < 2; ++i)                                                   \
      RA[i] = *(const bf16x8*)(base_ + (unsigned)((tid >> 2) + 64 * i) * ld_ + 8 * (tid & 3));      \
    _Pragma("unroll") for (int i = 0; i < NI / 2; ++i)                                              \
      RB[i] = *(const bf16x8*)(bbase + k0_ + boff + (unsigned)(64 * i) * K);                        \
  }
#define G_STORE(RA, RB, BUF)                                                                        \
  {                                                                                                 \
    bf16_t* sA_ = sbase + (BUF) * G_BUF;                                                            \
    bf16_t* sB_ = sA_ + 128 * G_LD;                                                                 \
    _Pragma("unroll") for (int i = 0; i < 2; ++i) {                                                 \
      bf16x8 v = RA[i];                                                                             \
      if constexpr (AMODE == 2) {                                                                   \
        _Pragma("unroll") for (int e = 0; e < 8; ++e) {                                             \
          float f = bf2f((bf16_t)v[e]);                                                             \
          ss[i] += f * f;                                                                           \
        }                                                                                           \
      }                                                                                             \
      *(bf16x8*)(sA_ + ((tid >> 2) + 64 * i) * G_LD + 8 * (tid & 3)) = v;                           \
    }                                                                                               \
    _Pragma("unroll") for (int i = 0; i < NI / 2; ++i)                                              \
      *(bf16x8*)(sB_ + ((tid >> 2) + 64 * i) * G_LD + 8 * (tid & 3)) = RB[i];                       \
  }
#define G_COMPUTE(BUF)                                                                              \
  {                                                                                                 \
    const bf16_t* sA_ = sbase + (BUF) * G_BUF;                                                      \
    const bf16_t* sB_ = sA_ + 128 * G_LD;                                                           \
    bf16x8 af[4];                                                                                   \
    _Pragma("unroll") for (int mi = 0; mi < 4; ++mi)                                                \
      af[mi] = *(const bf16x8*)(sA_ + (wm * 64 + mi * 16 + c) * G_LD + g * 8);                      \
    bf16x8 bq[2];                                                                                   \
    bq[0] = *(const bf16x8*)(sB_ + (wn * (16 * NI) + c) * G_LD + g * 8);                            \
    _Pragma("unroll") for (int ni = 0; ni < NI; ++ni) {                                             \
      if (ni + 1 < NI)                                                                              \
        bq[(ni + 1) & 1] = *(const bf16x8*)(sB_ + (wn * (16 * NI) + (ni + 1) * 16 + c) * G_LD + g * 8); \
      _Pragma("unroll") for (int mi = 0; mi < 4; ++mi) acc[mi][ni] = mfma16(af[mi], bq[ni & 1], acc[mi][ni]); \
    }                                                                                               \
  }
    __syncthreads();
    if constexpr (AMODE == 3) {
      if (tid < 128) {
        const f32x4 p0 = *(const f32x4*)(ssq + (size_t)(m0 + tid) * 8);
        const f32x4 p1 = *(const f32x4*)(ssq + (size_t)(m0 + tid) * 8 + 4);
        const float sv = (p0[0] + p0[1]) + (p0[2] + p0[3]) + (p1[0] + p1[1]) + (p1[2] + p1[3]);
        sR[tid] = rsqrtf(sv * (1.f / 1024.f) + EPS);
      }
    }
    G_LOAD(ra0, rb0, 0)
    G_LOAD(ra1, rb1, 1)
    G_STORE(ra0, rb0, 0)
    __syncthreads();
    for (int kt = 0; kt < nk; kt += 2) {
      G_LOAD(ra0, rb0, min(kt + 2, nk - 1))
      G_COMPUTE(0)
      G_STORE(ra1, rb1, 1)
      __syncthreads();
      G_LOAD(ra1, rb1, min(kt + 3, nk - 1))
      G_COMPUTE(1)
      if (kt + 2 < nk) G_STORE(ra0, rb0, 0)
      __syncthreads();
    }
    if constexpr (AMODE == 2) {
#pragma unroll
      for (int i = 0; i < 2; ++i) {
        float sv = ss[i];
        sv += sxor(sv, 1, lane); sv += sxor(sv, 2, lane);
        if ((tid & 3) == 0) sR[(tid >> 2) + 64 * i] = rsqrtf(sv / (float)K + EPS);
      }
      __syncthreads();
    }
    if constexpr (Epi::staged) {
      bf16_t* sT = sbase;
      const float esc = epi.scale();
      const bool tr = epi.transposed(n0);
      if (tr) {
#pragma unroll
        for (int mi = 0; mi < 4; ++mi) {
          const int row = wm * 64 + mi * 16 + 4 * g;
          const float r0 = sR[row] * esc, r1 = sR[row + 1] * esc, r2 = sR[row + 2] * esc, r3 = sR[row + 3] * esc;
#pragma unroll
          for (int ni = 0; ni < NI; ++ni) {
            uint2 o;
            o.x = pk2bf(acc[mi][ni][0] * r0, acc[mi][ni][1] * r1);
            o.y = pk2bf(acc[mi][ni][2] * r2, acc[mi][ni][3] * r3);
            *(uint2*)(sT + (wn * (16 * NI) + ni * 16 + c) * 136 + row) = o;
          }
        }
      } else {
#pragma unroll
        for (int mi = 0; mi < 4; ++mi) {
          const int row = wm * 64 + mi * 16 + 4 * g;
          const float r0 = sR[row] * esc, r1 = sR[row + 1] * esc, r2 = sR[row + 2] * esc, r3 = sR[row + 3] * esc;
#pragma unroll
          for (int ni = 0; ni < NI; ++ni) {
            bf16_t* d = sT + row * (BN + 8) + wn * (16 * NI) + ni * 16 + c;
            d[0] = f2bf(acc[mi][ni][0] * r0);
            d[BN + 8] = f2bf(acc[mi][ni][1] * r1);
            d[2 * (BN + 8)] = f2bf(acc[mi][ni][2] * r2);
            d[3 * (BN + 8)] = f2bf(acc[mi][ni][3] * r3);
          }
        }
      }
      epi.template direct<NI>(m0, n0, wm, wn, g, c, acc, sR);
      __syncthreads();
      if (tr) {
#pragma unroll 4
        for (int i = 0; i < 2 * NI; ++i) {
          const int id = tid + 256 * i;
          const int col = id >> 4, rc = id & 15;
          bf16x8 v = *(const bf16x8*)(sT + col * 136 + 8 * rc);
          epi.store_t(m0 + 8 * rc, n0 + col, v);
        }
      } else {
#pragma unroll 4
        for (int i = 0; i < 2 * NI; ++i) {
          const int id = tid + 256 * i;
          const int row = id / (4 * NI), cc = id % (4 * NI);
          const bf16_t* sp = sT + row * (BN + 8) + 8 * cc;
          bf16x8 v = *(const bf16x8*)sp;
          epi.store_n(m0 + row, n0 + 8 * cc, v, sp);
        }
      }
    } else {
      float* sF = (float*)smem;
#pragma unroll 1
      for (int half = 0; half < 2; ++half) {
        if (half) __syncthreads();
        if (wm == half) {
#pragma unroll
          for (int mi = 0; mi < 4; ++mi)
#pragma unroll
            for (int ni = 0; ni < NI; ++ni)
#pragma unroll
              for (int j = 0; j < 4; ++j) sF[(mi * 16 + 4 * g + j) * 260 + wn * (16 * NI) + ni * 16 + c] = acc[mi][ni][j];
        }
        __syncthreads();
#pragma unroll 4
        for (int i = 0; i < 16; ++i) {
          const int row = w * 16 + i;
          const int tok = m0 + half * 64 + row;
          const int col = n0 + 4 * lane;
          const f32x4 a = *(const f32x4*)(sF + row * 260 + 4 * lane);
          const f32x4 xo = *(const f32x4*)(xrow(epi.xa, epi.xb, tok) + col);
          f32x4 xn;
          xn[0] = xo[0] + a[0]; xn[1] = xo[1] + a[1]; xn[2] = xo[2] + a[2]; xn[3] = xo[3] + a[3];
          float sv = xn[0] * xn[0] + xn[1] * xn[1] + xn[2] * xn[2] + xn[3] * xn[3];
#pragma unroll
          for (int d = 1; d < 64; d <<= 1) sv += sxor(sv, d, lane);
          if (!epi.dry) {
            *(f32x4*)(epi.out + (size_t)tok * DM + col) = xn;
            if (epi.hb) {
              uint2 o;
              o.x = pk2bf(xn[0], xn[1]);
              o.y = pk2bf(xn[2], xn[3]);
              *(uint2*)(epi.hb + (size_t)tok * DM + col) = o;
            }
            if (lane == 0) epi.ssq[(size_t)tok * 8 + (n0 >> 8)] = sv;
          }
        }
      }
    }
  }
#undef G_LOAD
#undef G_STORE
#undef G_COMPUTE
}

__device__ __forceinline__ void rope_cs(int pos, int i, float& co, float& si) {
  float inv = exp2f(-(float)i * (13.287712379549449f / 16.f));
  float ang = (float)pos * inv;
  float n = rintf(ang * 0.15915494309189535f);
  float r = fmaf(-n, 6.28125f, ang);
  r = fmaf(-n, 0.0019353071795864769f, r);
  float rf = r * 0.15915494309189535f;
  si = __builtin_amdgcn_sinf(rf);
  co = __builtin_amdgcn_cosf(rf);
}

__device__ __forceinline__ void rope_chunk(int pos, int i0, bf16x8 x1, bf16x8 x2, bf16x8& o1, bf16x8& o2) {
#pragma unroll
  for (int e = 0; e < 8; ++e) {
    float co, si;
    rope_cs(pos, i0 + e, co, si);
    float a = bf2f((bf16_t)x1[e]), b = bf2f((bf16_t)x2[e]);
    o1[e] = (short)f2bf(a * co - b * si);
    o2[e] = (short)f2bf(b * co + a * si);
  }
}

struct EpiEvenIn {
  static constexpr bool staged = true;
  bf16_t *Qb, *Kt, *VtE, *Gb, *LRb, *PUb, *PGb;
  __device__ float scale() const { return 1.f; }
  __device__ bool transposed(int n0) const { return n0 >= 512 && n0 < 2048; }
  template <int NI> __device__ void direct(int m0, int n0, int wm, int wn, int g, int c, f32x4 (&acc)[4][NI], const float* sR) const {}
  __device__ void store_t(int tok8, int col, bf16x8 v) const {
    if (col < 1024) *(bf16x8*)(Kt + (size_t)(col - 512) * T_TOK + tok8) = v;
    else *(bf16x8*)(VtE + (size_t)(col - 1024) * T_TOK + tok8) = v;
  }
  __device__ void store_n(int tok, int col, bf16x8 v, const bf16_t* sp) const {
    bf16_t* d;
    if (col < 512) d = Qb + (size_t)tok * 512 + col;
    else if (col < 3072) d = Gb + (size_t)tok * 1024 + (col - 2048);
    else if (col < 3104) d = LRb + (size_t)tok * 32 + (col - 3072);
    else if (col < 3616) d = PUb + (size_t)tok * 512 + (col - 3104);
    else if (col < 4128) d = PGb + (size_t)tok * 512 + (col - 3616);
    else return;
    *(bf16x8*)d = v;
  }
};

struct EpiOddIn {
  static constexpr bool staged = true;
  bf16_t *CQb, *CKVb, *KRb, *MGb, *MQb, *MKb, *MKt, *MVt, *MOb, *MLGb;
  float* MIF;
  __device__ float scale() const { return 1.f; }
  __device__ bool transposed(int n0) const { return n0 < 1024; }
  template <int NI> __device__ void direct(int m0, int n0, int wm, int wn, int g, int c, f32x4 (&acc)[4][NI], const float* sR) const {
    if (n0 == 4096 && wn == 1) {
#pragma unroll
      for (int mi = 0; mi < 4; ++mi)
#pragma unroll
        for (int j = 0; j < 4; ++j) {
          const int row = wm * 64 + mi * 16 + 4 * g + j;
          MIF[(size_t)(m0 + row) * 16 + c] = acc[mi][2][j] * sR[row];
        }
    }
  }
  __device__ void store_t(int tok8, int col, bf16x8 v) const {
    if (col < 512) *(bf16x8*)(MVt + (size_t)col * T_TOK + tok8) = v;
    else *(bf16x8*)(MKt + (size_t)(col - 512) * T_TOK + tok8) = v;
  }
  __device__ void store_n(int tok, int col, bf16x8 v, const bf16_t* sp) const {
    bf16_t* d;
    if (col < 1408) d = CQb + (size_t)tok * 384 + (col - 1024);
    else if (col < 1664) d = CKVb + (size_t)tok * 256 + (col - 1408);
    else if (col < 2176) d = MGb + (size_t)tok * 512 + (col - 1664);
    else if (col < 2688) d = MQb + (size_t)tok * 512 + (col - 2176);
    else if (col < 3200) d = MKb + (size_t)tok * 512 + (col - 2688);
    else if (col < 3712) d = MOb + (size_t)tok * 512 + (col - 3200);
    else if (col < 4224) d = MLGb + (size_t)tok * 512 + (col - 3712);
    else if (col < 4240) {
      bf16x8 x2 = *(const bf16x8*)(sp + 16);
      bf16x8 o1, o2;
      rope_chunk(seq_pos(tok), col - 4224, v, x2, o1, o2);
      *(bf16x8*)(KRb + (size_t)tok * 32 + (col - 4224)) = o1;
      *(bf16x8*)(KRb + (size_t)tok * 32 + 16 + (col - 4224)) = o2;
      return;
    } else return;
    *(bf16x8*)d = v;
  }
};

struct EpiQUp {
  static constexpr bool staged = true;
  bf16_t* Qa;
  __device__ float scale() const { return 0.10206207261596575f * 1.4426950408889634f; }
  __device__ bool transposed(int n0) const { return false; }
  template <int NI> __device__ void direct(int m0, int n0, int wm, int wn, int g, int c, f32x4 (&acc)[4][NI], const float* sR) const {}
  __device__ void store_t(int tok8, int col, bf16x8 v) const {}
  __device__ void store_n(int tok, int col, bf16x8 v, const bf16_t* sp) const {
    if (col < 512) {
      *(bf16x8*)(Qa + (size_t)tok * 768 + (col >> 6) * 96 + (col & 63)) = v;
    } else {
      const int r = col - 512, head = r >> 5, rr = r & 31;
      if (rr < 16) {
        bf16x8 x2 = *(const bf16x8*)(sp + 16);
        bf16x8 o1, o2;
        rope_chunk(seq_pos(tok), rr, v, x2, o1, o2);
        *(bf16x8*)(Qa + (size_t)tok * 768 + head * 96 + 64 + rr) = o1;
        *(bf16x8*)(Qa + (size_t)tok * 768 + head * 96 + 80 + rr) = o2;
      }
    }
  }
};

struct EpiKVUp {
  static constexpr bool staged = true;
  bf16_t *KNb, *VtA;
  __device__ float scale() const { return 1.f; }
  __device__ bool transposed(int n0) const { return n0 >= 512; }
  template <int NI> __device__ void direct(int m0, int n0, int wm, int wn, int g, int c, f32x4 (&acc)[4][NI], const float* sR) const {}
  __device__ void store_t(int tok8, int col, bf16x8 v) const { *(bf16x8*)(VtA + (size_t)(col - 512) * T_TOK + tok8) = v; }
  __device__ void store_n(int tok, int col, bf16x8 v, const bf16_t* sp) const { *(bf16x8*)(KNb + (size_t)tok * 512 + col) = v; }
};

struct EpiOut {
  static constexpr bool staged = false;
  const float *xa, *xb;
  float* out;
  bool dry;
  bf16_t* hb;
  float* ssq;
};

__device__ __forceinline__ float scan16(float v, int c, int lane) {
  float t;
  t = bperm(lane - 1, v); if (c >= 1) v += t;
  t = bperm(lane - 2, v); if (c >= 2) v += t;
  t = bperm(lane - 4, v); if (c >= 4) v += t;
  t = bperm(lane - 8, v); if (c >= 8) v += t;
  return v;
}

__device__ __forceinline__ float logsig_fast(float x) { return fminf(x, 0.f) - __logf(1.f + __expf(-fabsf(x))); }

__device__ void gla_intra_item(const Params& p, int li, int item, char* smem, bool dry = false) {
  const int tid = otid(), lane = tid & 63, w = tid >> 6, c = lane & 15, g = lane >> 4;
  const int ci = item >> 2, h = item & 3;
  const int tokc = ci * 64;
  const float qscale = 0.08838834764831845f;
  bf16_t* sQe = (bf16_t*)smem;
  bf16_t* sKd = sQe + 64 * 136;
  bf16_t* sA = sKd + 64 * 136;
  us4 q4[2][4];
  bf16_t kk[2][4][4];
#pragma unroll
  for (int dt = 0; dt < 2; ++dt)
#pragma unroll
    for (int tt = 0; tt < 4; ++tt) {
      q4[dt][tt] = *(const us4*)(p.Qb + (size_t)(tokc + 16 * tt + c) * 512 + h * 128 + 32 * w + 16 * dt + 4 * g);
#pragma unroll
      for (int j = 0; j < 4; ++j)
        kk[dt][tt][j] = p.Kt[(size_t)(h * 128 + 32 * w + 16 * dt + 4 * g + j) * T_TOK + tokc + 16 * tt + c];
    }
  __syncthreads();
#pragma unroll
  for (int dir = 0; dir < 2; ++dir) {
    bf16_t* QEd = (dir || dry) ? p.QEb : p.Qb;
    bf16_t* KdTd = (dir || dry) ? p.KdTb : p.Kt;
    bf16x8 aup[2];
    float bias[2][4];
#pragma unroll
    for (int dt = 0; dt < 2; ++dt) {
      aup[dt] = zero8();
      if (g < 2) aup[dt] = *(const bf16x8*)(p.AupT + ((size_t)(li * 2 + dir) * 512 + h * 128 + 32 * w + 16 * dt + c) * 32 + 8 * g);
#pragma unroll
      for (int j = 0; j < 4; ++j) bias[dt][j] = p.e_a_bias[(li * 2 + dir) * 512 + h * 128 + 32 * w + 16 * dt + 4 * g + j];
    }
    f32x4 la[2][4];
#pragma unroll
    for (int tt = 0; tt < 4; ++tt) {
      bf16x8 lrf = zero8();
      if (g < 2) lrf = *(const bf16x8*)(p.LRb + (size_t)(tokc + 16 * tt + c) * 32 + dir * 16 + 8 * g);
#pragma unroll
      for (int dt = 0; dt < 2; ++dt) la[dt][tt] = mfma16(aup[dt], lrf, zero4());
    }
#pragma unroll
    for (int dt = 0; dt < 2; ++dt)
#pragma unroll
      for (int tt = 0; tt < 4; ++tt)
#pragma unroll
        for (int j = 0; j < 4; ++j) la[dt][tt][j] = logsig_fast(la[dt][tt][j] + bias[dt][j]) * (1.f / 16.f);
    f32x4 P[2][4];
    float tot[2][4];
#pragma unroll
    for (int dt = 0; dt < 2; ++dt)
#pragma unroll
      for (int j = 0; j < 4; ++j) {
        float carry = 0.f;
#pragma unroll
        for (int tt = 0; tt < 4; ++tt) {
          float v = scan16(la[dt][tt][j], c, lane) + carry;
          P[dt][tt][j] = v;
          carry = bperm(lane | 15, v);
        }
        tot[dt][j] = carry;
      }
#pragma unroll
    for (int dt = 0; dt < 2; ++dt)
#pragma unroll
      for (int tt = 0; tt < 4; ++tt) {
        us4 qo, ko;
#pragma unroll
        for (int j = 0; j < 4; ++j) {
          const float b = (dir == 0) ? P[dt][tt][j] : (tot[dt][j] - P[dt][tt][j] + la[dt][tt][j]);
          qo[j] = f2bf(bf2f(q4[dt][tt][j]) * __expf(b) * qscale);
          ko[j] = f2bf(bf2f(kk[dt][tt][j]) * __expf(-b));
        }
        *(us4*)(QEd + (size_t)(tokc + 16 * tt + c) * 512 + h * 128 + 32 * w + 16 * dt + 4 * g) = qo;
        *(us4*)(sQe + (16 * tt + c) * 136 + 32 * w + 16 * dt + 4 * g) = qo;
        *(us4*)(sKd + (16 * tt + c) * 136 + 32 * w + 16 * dt + 4 * g) = ko;
      }
    if (c == 0) {
#pragma unroll
      for (int dt = 0; dt < 2; ++dt)
#pragma unroll
        for (int j = 0; j < 4; ++j)
          p.EB[(size_t)(dir * 1280 + ci) * 512 + h * 128 + 32 * w + 16 * dt + 4 * g + j] = __expf(tot[dt][j]);
    }
    __syncthreads();
#pragma unroll
    for (int i = 0; i < 4; ++i) {
      const int id = tid + 256 * i;
      const int d = id & 127, c8 = id >> 7;
      bf16x8 v;
#pragma unroll
      for (int e = 0; e < 8; ++e) v[e] = (short)sKd[(8 * c8 + e) * 136 + d];
      *(bf16x8*)(KdTd + (size_t)(h * 128 + d) * T_TOK + tokc + 8 * c8) = v;
    }
    f32x4 accA[4];
#pragma unroll
    for (int jt = 0; jt < 4; ++jt) accA[jt] = zero4();
#pragma unroll
    for (int ks = 0; ks < 4; ++ks) {
      bf16x8 aq = *(const bf16x8*)(sQe + (16 * w + c) * 136 + 32 * ks + 8 * g);
#pragma unroll
      for (int jt = 0; jt < 4; ++jt) {
        bf16x8 bk = *(const bf16x8*)(sKd + (16 * jt + c) * 136 + 32 * ks + 8 * g);
        accA[jt] = mfma16(aq, bk, accA[jt]);
      }
    }
#pragma unroll
    for (int jt = 0; jt < 4; ++jt)
#pragma unroll
      for (int j = 0; j < 4; ++j) {
        const int i = 16 * w + 4 * g + j, jj = 16 * jt + c;
        const bool keep = (dir == 0) ? (jj <= i) : (jj > i);
        sA[dir * 64 * 72 + i * 72 + jj] = f2bf(keep ? accA[jt][j] : 0.f);
      }
    __syncthreads();
  }
  bf16x8 af[2][2];
#pragma unroll
  for (int dir = 0; dir < 2; ++dir)
#pragma unroll
    for (int k2 = 0; k2 < 2; ++k2) af[dir][k2] = *(const bf16x8*)(sA + dir * 64 * 72 + (16 * w + c) * 72 + 32 * k2 + 8 * g);
  bf16_t* sO = (bf16_t*)smem;
#pragma unroll 4
  for (int vt = 0; vt < 16; ++vt) {
    f32x4 a = zero4();
#pragma unroll
    for (int k2 = 0; k2 < 2; ++k2) {
      bf16x8 vfr = *(const bf16x8*)(p.VtE + (size_t)(h * 256 + 16 * vt + c) * T_TOK + tokc + 32 * k2 + 8 * g);
      a = mfma16(af[0][k2], vfr, a);
      a = mfma16(af[1][k2], vfr, a);
    }
#pragma unroll
    for (int j = 0; j < 4; ++j) sO[(16 * w + 4 * g + j) * 264 + 16 * vt + c] = f2bf(a[j]);
  }
  __syncthreads();
#pragma unroll
  for (int i = 0; i < 8; ++i) {
    const int id = tid + 256 * i;
    const int row = id >> 5, c8 = id & 31;
    *(bf16x8*)(p.TMP + (size_t)(tokc + row) * 1024 + h * 256 + 8 * c8) = *(const bf16x8*)(sO + row * 264 + 8 * c8);
  }
}

__device__ __forceinline__ void lds_barrier() { asm volatile("s_waitcnt lgkmcnt(0)\n\ts_barrier" ::: "memory"); }

struct GlaRegs {
  bf16x8 aq[4];
  bf16x8 vf[2][2];
  bf16x8 kf[2][2];
  float eb[2];
  unsigned told[2][4];
};

template <int DIR>
__device__ __forceinline__ void gla_chain_load(const Params& p, int h, int sl, int tokc, int w, int c, int g, GlaRegs& r) {
  const bf16_t* QE = DIR ? p.QEb : p.Qb;
  const bf16_t* KdT = DIR ? p.KdTb : p.Kt;
#pragma unroll
  for (int ks = 0; ks < 4; ++ks) r.aq[ks] = *(const bf16x8*)(QE + (size_t)(tokc + 16 * w + c) * 512 + h * 128 + 32 * ks + 8 * g);
#pragma unroll
  for (int vt = 0; vt < 2; ++vt)
#pragma unroll
    for (int k2 = 0; k2 < 2; ++k2)
      r.vf[vt][k2] = *(const bf16x8*)(p.VtE + (size_t)(h * 256 + sl * 32 + 16 * vt + c) * T_TOK + tokc + 32 * k2 + 8 * g);
#pragma unroll
  for (int dt = 0; dt < 2; ++dt) {
#pragma unroll
    for (int k2 = 0; k2 < 2; ++k2)
      r.kf[dt][k2] = *(const bf16x8*)(KdT + (size_t)(h * 128 + 32 * w + 16 * dt + c) * T_TOK + tokc + 32 * k2 + 8 * g);
    r.eb[dt] = p.EB[(size_t)(DIR * 1280 + (tokc >> 6)) * 512 + h * 128 + 32 * w + 16 * dt + c];
  }
#pragma unroll
  for (int vt = 0; vt < 2; ++vt)
#pragma unroll
    for (int j = 0; j < 4; ++j) r.told[vt][j] = p.TMP[(size_t)(tokc + 16 * w + 4 * g + j) * 1024 + h * 256 + sl * 32 + 16 * vt + c];
}

__device__ __forceinline__ void gla_chain_compute(const Params& p, int h, int sl, int tokc, int w, int c, int g, const GlaRegs& r,
                                                  f32x4 (&S)[2][2], bf16_t* sSt, bool dry, bool reload) {
  unsigned told[2][4];
#pragma unroll
  for (int vt = 0; vt < 2; ++vt)
#pragma unroll
    for (int j = 0; j < 4; ++j) told[vt][j] = r.told[vt][j];
  if (reload) {
#pragma unroll
    for (int vt = 0; vt < 2; ++vt)
#pragma unroll
      for (int j = 0; j < 4; ++j) told[vt][j] = p.TMP[(size_t)(tokc + 16 * w + 4 * g + j) * 1024 + h * 256 + sl * 32 + 16 * vt + c];
  }
#pragma unroll
  for (int vt = 0; vt < 2; ++vt)
#pragma unroll
    for (int dt = 0; dt < 2; ++dt)
#pragma unroll
      for (int j = 0; j < 4; ++j) sSt[(16 * vt + 4 * g + j) * 136 + 32 * w + 16 * dt + c] = f2bf(S[vt][dt][j]);
  lds_barrier();
  f32x4 o[2];
  o[0] = zero4(); o[1] = zero4();
#pragma unroll
  for (int ks = 0; ks < 4; ++ks)
#pragma unroll
    for (int vt = 0; vt < 2; ++vt) {
      bf16x8 sf = *(const bf16x8*)(sSt + (16 * vt + c) * 136 + 32 * ks + 8 * g);
      o[vt] = mfma16(r.aq[ks], sf, o[vt]);
    }
#pragma unroll
  for (int dt = 0; dt < 2; ++dt)
#pragma unroll
    for (int vt = 0; vt < 2; ++vt) {
      f32x4 a = S[vt][dt];
#pragma unroll
      for (int k2 = 0; k2 < 2; ++k2) a = mfma16(r.vf[vt][k2], r.kf[dt][k2], a);
      S[vt][dt] = a * r.eb[dt];
    }
#pragma unroll
  for (int vt = 0; vt < 2; ++vt)
#pragma unroll
    for (int j = 0; j < 4; ++j)
      if (!dry) p.TMP[(size_t)(tokc + 16 * w + 4 * g + j) * 1024 + h * 256 + sl * 32 + 16 * vt + c] = f2bf(bf2f((bf16_t)told[vt][j]) + o[vt][j]);
}

__device__ void gla_chain_item(const Params& p, int li, int item, char* smem, bool dry = false) {
  const int tid = otid(), lane = tid & 63, w = tid >> 6, c = lane & 15, g = lane >> 4;
  const int xr = item >> 3;
  const int pair = (item & 7) + 8 * (xr >> 3), sl = xr & 7;
  const int s = pair < 32 ? 4 + (pair >> 2) : ((pair - 32) >> 2);
  const int h = pair & 3;
  const int tok0 = s < 4 ? s * 4096 : T_P + (s - 4) * 8192;
  const int len = s < 4 ? 4096 : 8192;
  const int N = len / 64;
  bf16_t* sSt0 = (bf16_t*)smem;
  bf16_t* sSt1 = sSt0 + 32 * 136;
  f32x4 Sf[2][2], Sb[2][2];
#pragma unroll
  for (int a = 0; a < 2; ++a)
#pragma unroll
    for (int b = 0; b < 2; ++b) { Sf[a][b] = zero4(); Sb[a][b] = zero4(); }
  GlaRegs rf, rb;
  __syncthreads();
  gla_chain_load<0>(p, h, sl, tok0, w, c, g, rf);
  for (int step = 0; step < N; ++step) {
    const int tf = tok0 + step * 64, tb = tok0 + (N - 1 - step) * 64;
    gla_chain_load<1>(p, h, sl, tb, w, c, g, rb);
    gla_chain_compute(p, h, sl, tf, w, c, g, rf, Sf, sSt0, dry, step == (N >> 1));
    if (step + 1 < N) gla_chain_load<0>(p, h, sl, tf + 64, w, c, g, rf);
    gla_chain_compute(p, h, sl, tb, w, c, g, rb, Sb, sSt1, dry, false);
  }
}

__device__ void pool_item(const Params& p, int li, int item, char* smem, bool dry = false) {
  const int tid = otid(), lane = tid & 63, w = tid >> 6, c = lane & 15, g = lane >> 4;
  const int gi = item & 3;
  const int tile = item >> 2;
  const int tokc = tile * 64;
  const int pos0 = seq_pos(tokc);
  const int len = tokc < T_P ? 4096 : 8192;
  float* sU = (float*)smem;
  bf16_t* sP = (bf16_t*)(sU + 80 * 128);
  __syncthreads();
  for (int idx = tid; idx < 80 * 128; idx += 256) {
    int r = idx >> 7, ch = idx & 127;
    int pos = pos0 - 8 + r;
    float v = 0.f;
    if (pos >= 0 && pos < len) v = bf2f(p.PUb[(long)(tokc - 8 + r) * 512 + gi * 128 + ch]);
    sU[idx] = v;
  }
  __syncthreads();
  {
    const int ch = tid & 127, th = tid >> 7;
    const int half = 1 << gi;
    for (int t = th * 32; t < th * 32 + 32; ++t) {
      int pos = pos0 + t;
      int lo = max(pos - half, 0), hi = min(pos + half, len);
      float s = 0.f;
      for (int q = lo; q < hi; ++q) s += sU[(q - pos0 + 8) * 128 + ch];
      float pooled = s / (float)(hi - lo) - sU[(t + 8) * 128 + ch];
      sP[t * 136 + ch] = f2bf(pooled);
    }
  }
  __syncthreads();
  f32x4 acc[8];
#pragma unroll
  for (int dt = 0; dt < 8; ++dt) acc[dt] = zero4();
  const bf16_t* PW = p.PoolWT + (long)(li * 4 + gi) * 128 * 128;
#pragma unroll
  for (int ks = 0; ks < 4; ++ks) {
    bf16x8 af = *(const bf16x8*)(sP + (16 * w + c) * 136 + 32 * ks + 8 * g);
#pragma unroll
    for (int dt = 0; dt < 8; ++dt) {
      bf16x8 bw = *(const bf16x8*)(PW + (long)(16 * dt + c) * 128 + 32 * ks + 8 * g);
      acc[dt] = mfma16(af, bw, acc[dt]);
    }
  }
#pragma unroll
  for (int dt = 0; dt < 8; ++dt) {
    const int d = gi * 128 + 16 * dt + c;
    const float sc = p.e_pool_scale[li * 512 + d];
#pragma unroll
    for (int j = 0; j < 4; ++j) {
      const long addr = (long)(tokc + 16 * w + 4 * g + j) * 512 + d;
      float gt = bf2f(p.PGb[addr]);
      if (!dry) p.PGb[addr] = f2bf(acc[dt][j] * sc * siluf_(gt));
    }
  }
}

__device__ void ml_intra_item(const Params& p, int li, int item, char* smem) {
  const int tid = otid(), lane = tid & 63, w = tid >> 6, c = lane & 15, g = lane >> 4;
  const int ci = item >> 2, h = item & 3;
  const int tokc = ci * 64;
  const float kscale = 0.08838834764831845f;
  bf16_t* sA = (bf16_t*)smem;
  float* sBv = (float*)(sA + 2 * 64 * 72);
  float* sCB = sBv + 128;
  __syncthreads();
  if (w < 2) {
    const int dir = w;
    const float bi = p.o_if_bias[li * 16 + dir * 4 + h];
    const float bff = p.o_if_bias[li * 16 + 8 + dir * 4 + h];
    const float* mf = p.MIF + (size_t)(tokc + lane) * 16;
    const float liv = mf[dir * 4 + h] + bi;
    const float lfv = logsig_fast(mf[8 + dir * 4 + h] + bff);
    float ps = lfv;
#pragma unroll
    for (int d = 1; d < 64; d <<= 1) {
      float t = bperm(lane - d, ps);
      if (lane >= d) ps += t;
    }
    const float total = __int_as_float(__builtin_amdgcn_readlane(__float_as_int(ps), 63));
    const float b = (dir == 0) ? ps : (total - ps + lfv);
    const float cB = liv - b;
    sBv[dir * 64 + lane] = b;
    sCB[dir * 64 + lane] = cB;
    const size_t so = (size_t)(dir * 4 + h) * T_TOK + tokc + lane;
    p.EBI[so] = __expf(b);
    p.WKg[so] = __expf(total + cB) * kscale;
    if (lane == 0) p.DEC[(dir * 4 + h) * 1280 + ci] = __expf(total);
  }
  f32x4 accA[4];
#pragma unroll
  for (int jt = 0; jt < 4; ++jt) accA[jt] = zero4();
#pragma unroll
  for (int ks = 0; ks < 4; ++ks) {
    bf16x8 aq = *(const bf16x8*)(p.MQb + (size_t)(tokc + 16 * w + c) * 512 + h * 128 + 32 * ks + 8 * g);
#pragma unroll
    for (int jt = 0; jt < 4; ++jt) {
      bf16x8 bk = *(const bf16x8*)(p.MKb + (size_t)(tokc + 16 * jt + c) * 512 + h * 128 + 32 * ks + 8 * g);
      accA[jt] = mfma16(aq, bk, accA[jt]);
    }
  }
  __syncthreads();
#pragma unroll
  for (int dir = 0; dir < 2; ++dir)
#pragma unroll
    for (int jt = 0; jt < 4; ++jt)
#pragma unroll
      for (int j = 0; j < 4; ++j) {
        const int i = 16 * w + 4 * g + j, jj = 16 * jt + c;
        const bool keep = (dir == 0) ? (jj <= i) : (jj > i);
        const float sv = keep ? accA[jt][j] * kscale * __expf(sBv[dir * 64 + i] + sCB[dir * 64 + jj]) : 0.f;
        sA[dir * 64 * 72 + i * 72 + jj] = f2bf(sv);
      }
  __syncthreads();
  bf16x8 ones = zero8();
  if (c == 0) {
#pragma unroll
    for (int e = 0; e < 8; ++e) ones[e] = (short)0x3F80;
  }
#pragma unroll
  for (int dir = 0; dir < 2; ++dir) {
    bf16_t* NUMI = dir ? p.NUMIb : p.NUMIf;
    bf16x8 af[2];
#pragma unroll
    for (int k2 = 0; k2 < 2; ++k2) af[k2] = *(const bf16x8*)(sA + dir * 64 * 72 + (16 * w + c) * 72 + 32 * k2 + 8 * g);
    f32x4 dn = zero4();
    dn = mfma16(af[0], ones, dn);
    dn = mfma16(af[1], ones, dn);
    if (c == 0) {
#pragma unroll
      for (int j = 0; j < 4; ++j) p.DENI[(size_t)(dir * 4 + h) * T_TOK + tokc + 16 * w + 4 * g + j] = dn[j];
    }
    bf16_t* sO = sA + 2 * 64 * 72 + 512;
#pragma unroll 4
    for (int vt = 0; vt < 8; ++vt) {
      f32x4 a = zero4();
#pragma unroll
      for (int k2 = 0; k2 < 2; ++k2) {
        bf16x8 vfr = *(const bf16x8*)(p.MVt + (size_t)(h * 128 + 16 * vt + c) * T_TOK + tokc + 32 * k2 + 8 * g);
        a = mfma16(af[k2], vfr, a);
      }
#pragma unroll
      for (int j = 0; j < 4; ++j) sO[(16 * w + 4 * g + j) * 136 + 16 * vt + c] = f2bf(a[j]);
    }
    __syncthreads();
#pragma unroll
    for (int i = 0; i < 4; ++i) {
      const int id = tid + 256 * i;
      const int row = id >> 4, c8 = id & 15;
      *(bf16x8*)(NUMI + (size_t)(tokc + row) * 512 + h * 128 + 8 * c8) = *(const bf16x8*)(sO + row * 136 + 8 * c8);
    }
    __syncthreads();
  }
}

struct MlRegs {
  bf16x8 aq[4];
  bf16x8 vf[2];
  bf16x8 kf[2][2];
  f32x4 wk[2][2];
  f32x4 ebi, deni;
  float dec;
  unsigned numi[4];
};

template <int DIR>
__device__ __forceinline__ void ml_chain_load(const Params& p, int h, int sl, int tokc, int w, int c, int g, MlRegs& r) {
#pragma unroll
  for (int ks = 0; ks < 4; ++ks) r.aq[ks] = *(const bf16x8*)(p.MQb + (size_t)(tokc + 16 * w + c) * 512 + h * 128 + 32 * ks + 8 * g);
#pragma unroll
  for (int k2 = 0; k2 < 2; ++k2)
    r.vf[k2] = *(const bf16x8*)(p.MVt + (size_t)(h * 128 + sl * 16 + c) * T_TOK + tokc + 32 * k2 + 8 * g);
#pragma unroll
  for (int dt = 0; dt < 2; ++dt)
#pragma unroll
    for (int k2 = 0; k2 < 2; ++k2)
      r.kf[dt][k2] = *(const bf16x8*)(p.MKt + (size_t)(h * 128 + 32 * w + 16 * dt + c) * T_TOK + tokc + 32 * k2 + 8 * g);
  const size_t so = (size_t)(DIR * 4 + h) * T_TOK + tokc;
#pragma unroll
  for (int k2 = 0; k2 < 2; ++k2) {
    r.wk[k2][0] = *(const f32x4*)(p.WKg + so + 32 * k2 + 8 * g);
    r.wk[k2][1] = *(const f32x4*)(p.WKg + so + 32 * k2 + 8 * g + 4);
  }
  r.ebi = *(const f32x4*)(p.EBI + so + 16 * w + 4 * g);
  r.deni = *(const f32x4*)(p.DENI + so + 16 * w + 4 * g);
  r.dec = p.DEC[(DIR * 4 + h) * 1280 + (tokc >> 6)];
  const bf16_t* NUMI = DIR ? p.NUMIb : p.NUMIf;
#pragma unroll
  for (int j = 0; j < 4; ++j) r.numi[j] = NUMI[(size_t)(tokc + 16 * w + 4 * g + j) * 512 + h * 128 + sl * 16 + c];
}

template <int DIR>
__device__ __forceinline__ void ml_chain_compute(const Params& p, int h, int sl, int tokc, int lane, int w, int c, int g, const MlRegs& r,
                                                 f32x4 (&C)[2][2], bf16_t* sCt, bool dry) {
  bf16_t* NUMI = DIR ? p.NUMIb : p.NUMIf;
  unsigned numi[4];
#pragma unroll
  for (int j = 0; j < 4; ++j) numi[j] = r.numi[j];
#pragma unroll
  for (int vt = 0; vt < 2; ++vt)
#pragma unroll
    for (int dt = 0; dt < 2; ++dt)
#pragma unroll
      for (int j = 0; j < 4; ++j) sCt[(16 * vt + 4 * g + j) * 136 + 32 * w + 16 * dt + c] = f2bf(C[vt][dt][j]);
  bf16x8 vfw[2][2];
#pragma unroll
  for (int k2 = 0; k2 < 2; ++k2) {
    float wv[8];
#pragma unroll
    for (int e = 0; e < 4; ++e) { wv[e] = r.wk[k2][0][e]; wv[4 + e] = r.wk[k2][1][e]; }
#pragma unroll
    for (int e = 0; e < 8; ++e) vfw[0][k2][e] = (short)f2bf(bf2f((bf16_t)r.vf[k2][e]) * wv[e]);
#pragma unroll
    for (int e = 0; e < 8; ++e) vfw[1][k2][e] = (c == 0) ? (short)f2bf(wv[e]) : (short)0;
  }
  lds_barrier();
  f32x4 o2[2];
  o2[0] = zero4(); o2[1] = zero4();
#pragma unroll
  for (int ks = 0; ks < 4; ++ks)
#pragma unroll
    for (int vt = 0; vt < 2; ++vt) {
      bf16x8 cf = *(const bf16x8*)(sCt + (16 * vt + c) * 136 + 32 * ks + 8 * g);
      o2[vt] = mfma16(r.aq[ks], cf, o2[vt]);
    }
#pragma unroll
  for (int dt = 0; dt < 2; ++dt)
#pragma unroll
    for (int vt = 0; vt < 2; ++vt) {
      f32x4 a = C[vt][dt] * r.dec;
#pragma unroll
      for (int k2 = 0; k2 < 2; ++k2) a = mfma16(vfw[vt][k2], r.kf[dt][k2], a);
      C[vt][dt] = a;
    }
#pragma unroll
  for (int j = 0; j < 4; ++j) {
    const float e = r.ebi[j];
    float den = e * o2[1][j];
    den = bperm(lane & 48, den) + r.deni[j];
    const float inv = 1.f / fmaxf(fabsf(den), 1.f);
    const float hv = (bf2f((bf16_t)numi[j]) + e * o2[0][j]) * inv;
    if (!dry) NUMI[(size_t)(tokc + 16 * w + 4 * g + j) * 512 + h * 128 + sl * 16 + c] = f2bf(hv);
  }
}

__device__ void ml_chain_item(const Params& p, int li, int item, char* smem, bool dry = false) {
  const int tid = otid(), lane = tid & 63, w = tid >> 6, c = lane & 15, g = lane >> 4;
  const int xr = item >> 3;
  const int pair = (item & 7) + 8 * (xr >> 3), sl = xr & 7;
  const int s = pair < 32 ? 4 + (pair >> 2) : ((pair - 32) >> 2);
  const int h = pair & 3;
  const int tok0 = s < 4 ? s * 4096 : T_P + (s - 4) * 8192;
  const int len = s < 4 ? 4096 : 8192;
  const int N = len / 64;
  bf16_t* sCt0 = (bf16_t*)smem;
  bf16_t* sCt1 = sCt0 + 32 * 136;
  f32x4 Cf[2][2], Cb[2][2];
#pragma unroll
  for (int a = 0; a < 2; ++a)
#pragma unroll
    for (int b = 0; b < 2; ++b) { Cf[a][b] = zero4(); Cb[a][b] = zero4(); }
  MlRegs rf, rb;
  __syncthreads();
  ml_chain_load<0>(p, h, sl, tok0, w, c, g, rf);
  for (int step = 0; step < N; ++step) {
    const int tf = tok0 + step * 64, tb = tok0 + (N - 1 - step) * 64;
    ml_chain_load<1>(p, h, sl, tb, w, c, g, rb);
    ml_chain_compute<0>(p, h, sl, tf, lane, w, c, g, rf, Cf, sCt0, dry);
    if (step + 1 < N) ml_chain_load<0>(p, h, sl, tf + 64, w, c, g, rf);
    ml_chain_compute<1>(p, h, sl, tb, lane, w, c, g, rb, Cb, sCt1, dry);
  }
}

#define ATTN_GLOAD(KT)                                                                              \
  {                                                                                                 \
    const long kb = tok0 + (KT) * 64;                                                               \
    rk0 = *(const bf16x8*)(p.KNb + (kb + (tid >> 3)) * 512 + head * 64 + 8 * (tid & 7));            \
    rk1 = *(const bf16x8*)(p.KNb + (kb + 32 + (tid >> 3)) * 512 + head * 64 + 8 * (tid & 7));       \
    rkr = *(const bf16x8*)(p.KRb + (kb + (tid >> 2)) * 32 + 8 * (tid & 3));                          \
    rv0 = *(const bf16x8*)(p.VtA + (long)(head * 64 + (tid >> 3)) * T_TOK + kb + 8 * (tid & 7));     \
    rv1 = *(const bf16x8*)(p.VtA + (long)(head * 64 + 32 + (tid >> 3)) * T_TOK + kb + 8 * (tid & 7)); \
  }
__device__ void attn_item(const Params& p, int item, char* smem, bool dry = false) {
  const int tid = otid(), lane = tid & 63, w = tid >> 6, c = lane & 15, g = lane >> 4;
  int s, head, qb;
  {
    const int x = item / 320, t = item % 320;
    if (t < 256) { const int pair = x + 8 * (t >> 5); qb = t & 31; s = 4 + (pair >> 3); head = pair & 7; }
    else { const int t2 = t - 256; const int pair = x + 8 * (t2 >> 4); qb = t2 & 15; s = pair >> 3; head = pair & 7; }
  }
  const int tok0 = s < 4 ? s * 4096 : T_P + (s - 4) * 8192;
  const int len = s < 4 ? 4096 : 8192;
  const int nkv = len / 64;
  bf16_t* sK = (bf16_t*)smem;
  bf16_t* sVt = sK + 64 * 104;
  const int qrow0 = tok0 + qb * 256 + 64 * w;
  bf16_t* sQr = sVt + 64 * 72;
  bf16x8 qf[4][2];
#pragma unroll
  for (int nt = 0; nt < 4; ++nt) {
#pragma unroll
    for (int ks = 0; ks < 2; ++ks)
      qf[nt][ks] = *(const bf16x8*)(p.Qa + (long)(qrow0 + 16 * nt + c) * 768 + head * 96 + 32 * ks + 8 * g);
    bf16x8 qr = *(const bf16x8*)(p.Qa + (long)(qrow0 + 16 * nt + c) * 768 + head * 96 + 64 + 8 * g);
    *(bf16x8*)(sQr + ((w * 4 + nt) * 64 + lane) * 8) = qr;
  }
  f32x4 ot[4][4];
#pragma unroll
  for (int vt = 0; vt < 4; ++vt)
#pragma unroll
    for (int nt = 0; nt < 4; ++nt) ot[vt][nt] = zero4();
  float mrun[4] = {-1e30f, -1e30f, -1e30f, -1e30f}, lrun[4] = {0.f, 0.f, 0.f, 0.f};
  bf16x8 rk0, rk1, rkr, rv0, rv1;
  ATTN_GLOAD(0)
  for (int kt = 0; kt < nkv; ++kt) {
    __syncthreads();
    *(bf16x8*)(sK + (tid >> 3) * 104 + 8 * (tid & 7)) = rk0;
    *(bf16x8*)(sK + (32 + (tid >> 3)) * 104 + 8 * (tid & 7)) = rk1;
    *(bf16x8*)(sK + (tid >> 2) * 104 + 64 + 8 * (tid & 3)) = rkr;
    *(bf16x8*)(sVt + (tid >> 3) * 72 + 8 * (tid & 7)) = rv0;
    *(bf16x8*)(sVt + (32 + (tid >> 3)) * 72 + 8 * (tid & 7)) = rv1;
    __syncthreads();
    if (kt + 1 < nkv) ATTN_GLOAD(kt + 1)
#pragma unroll 1
    for (int half = 0; half < 2; ++half) {
      f32x4 st[2][4];
#pragma unroll
      for (int k4 = 0; k4 < 2; ++k4)
#pragma unroll
        for (int nt = 0; nt < 4; ++nt) st[k4][nt] = zero4();
#pragma unroll
      for (int ks = 0; ks < 2; ++ks)
#pragma unroll
        for (int k4 = 0; k4 < 2; ++k4) {
          bf16x8 kf = *(const bf16x8*)(sK + (32 * half + 16 * k4 + c) * 104 + 32 * ks + 8 * g);
#pragma unroll
          for (int nt = 0; nt < 4; ++nt) st[k4][nt] = mfma16(kf, qf[nt][ks], st[k4][nt]);
        }
      {
        bf16x8 kr0 = *(const bf16x8*)(sK + (32 * half + c) * 104 + 64 + 8 * g);
        bf16x8 kr1 = *(const bf16x8*)(sK + (32 * half + 16 + c) * 104 + 64 + 8 * g);
#pragma unroll
        for (int nt = 0; nt < 4; ++nt) {
          bf16x8 qr = *(const bf16x8*)(sQr + ((w * 4 + nt) * 64 + lane) * 8);
          st[0][nt] = mfma16(kr0, qr, st[0][nt]);
          st[1][nt] = mfma16(kr1, qr, st[1][nt]);
        }
      }
      __builtin_amdgcn_sched_barrier(0);
      bf16x8 pb[4];
#pragma unroll
      for (int nt = 0; nt < 4; ++nt) {
        float mx = -1e30f;
#pragma unroll
        for (int k4 = 0; k4 < 2; ++k4)
#pragma unroll
          for (int j = 0; j < 4; ++j) mx = fmaxf(mx, st[k4][nt][j]);
        mx = rowmax4(mx);
        const float mn = fmaxf(mrun[nt], mx);
        const float alpha = __builtin_amdgcn_exp2f(mrun[nt] - mn);
        mrun[nt] = mn;
        float psum = 0.f;
#pragma unroll
        for (int k4 = 0; k4 < 2; ++k4)
#pragma unroll
          for (int j = 0; j < 4; ++j) {
            float pv = __builtin_amdgcn_exp2f(st[k4][nt][j] - mn);
            st[k4][nt][j] = pv;
            psum += pv;
          }
        lrun[nt] = lrun[nt] * alpha + psum;
#pragma unroll
        for (int vt = 0; vt < 4; ++vt) ot[vt][nt] = ot[vt][nt] * alpha;
        typedef __attribute__((ext_vector_type(4))) unsigned u32x4;
        u32x4 pk;
        pk[0] = pk2bf(st[0][nt][0], st[0][nt][1]);
        pk[1] = pk2bf(st[0][nt][2], st[0][nt][3]);
        pk[2] = pk2bf(st[1][nt][0], st[1][nt][1]);
        pk[3] = pk2bf(st[1][nt][2], st[1][nt][3]);
        pb[nt] = __builtin_bit_cast(bf16x8, pk);
      }
      __builtin_amdgcn_sched_barrier(0);
#pragma unroll
      for (int vt = 0; vt < 4; ++vt) {
        us4 lo = *(const us4*)(sVt + (16 * vt + c) * 72 + 32 * half + 4 * g);
        us4 hi = *(const us4*)(sVt + (16 * vt + c) * 72 + 32 * half + 16 + 4 * g);
        bf16x8 av;
#pragma unroll
        for (int e = 0; e < 4; ++e) { av[e] = (short)lo[e]; av[4 + e] = (short)hi[e]; }
#pragma unroll
        for (int nt = 0; nt < 4; ++nt) ot[vt][nt] = mfma16(av, pb[nt], ot[vt][nt]);
      }
    }
  }
#pragma unroll
  for (int nt = 0; nt < 4; ++nt) {
    float lt = lrun[nt];
    lt += sxor(lt, 16, lane);
    lt += sxor(lt, 32, lane);
    const float inv = 1.f / lt;
    const long tok = qrow0 + 16 * nt + c;
#pragma unroll
    for (int vt = 0; vt < 4; ++vt) {
      bf16_t* gp = p.MGb + tok * 512 + head * 64 + 16 * vt + 4 * g;
      us4 gt = *(const us4*)gp;
      us4 o;
#pragma unroll
      for (int j = 0; j < 4; ++j) o[j] = f2bf(ot[vt][nt][j] * inv * siluf_(bf2f(gt[j])));
      if (!dry) *(us4*)gp = o;
    }
  }
}

__device__ void phase_gla_combine(const Params& p, int li, bool dry = false) {
  const int tid_ = otid(); const int lane = tid_ & 63, w = tid_ >> 6;
  for (int tok = blockIdx.x * 4 + w; tok < T_TOK; tok += gridDim.x * 4) {
    const bf16_t* tp = p.TMP + (long)tok * 1024 + 16 * lane;
    bf16_t* gp = p.Gb + (long)tok * 1024 + 16 * lane;
    bf16x8 o0 = *(const bf16x8*)tp, o1 = *(const bf16x8*)(tp + 8);
    bf16x8 g0 = *(const bf16x8*)gp, g1 = *(const bf16x8*)(gp + 8);
    float ov[16], gv[16];
#pragma unroll
    for (int e = 0; e < 8; ++e) {
      ov[e] = bf2f((bf16_t)o0[e]); ov[8 + e] = bf2f((bf16_t)o1[e]);
      gv[e] = bf2f((bf16_t)g0[e]); gv[8 + e] = bf2f((bf16_t)g1[e]);
    }
    float ss = 0.f;
#pragma unroll
    for (int e = 0; e < 16; ++e) ss += ov[e] * ov[e];
    ss += sxor(ss, 1, lane); ss += sxor(ss, 2, lane); ss += sxor(ss, 4, lane); ss += sxor(ss, 8, lane);
    const float rs = rsqrtf(ss * (1.f / 256.f) + EPS);
    const float* ng = p.e_gla_norm_g + li * 256 + ((16 * lane) & 255);
    bf16x8 r0, r1;
#pragma unroll
    for (int e = 0; e < 8; ++e) {
      r0[e] = (short)f2bf(ov[e] * rs * ng[e] * siluf_(gv[e]));
      r1[e] = (short)f2bf(ov[8 + e] * rs * ng[8 + e] * siluf_(gv[8 + e]));
    }
    if (!dry) { *(bf16x8*)gp = r0;
    *(bf16x8*)(gp + 8) = r1; }
  }
}

__device__ void phase_ml_combine(const Params& p, int li, bool dry = false) {
  const int tid_ = otid(); const int lane = tid_ & 63, w = tid_ >> 6;
  for (int tok = blockIdx.x * 4 + w; tok < T_TOK; tok += gridDim.x * 4) {
    const long off = (long)tok * 512 + 8 * lane;
    bf16x8 hv = *(const bf16x8*)(p.NUMIf + off);
    bf16x8 hb = *(const bf16x8*)(p.NUMIb + off);
    bf16x8 mo = *(const bf16x8*)(p.MOb + off);
    bf16x8 mg = *(const bf16x8*)(p.MLGb + off);
    float hf[8];
    float ss = 0.f;
#pragma unroll
    for (int e = 0; e < 8; ++e) { hf[e] = bf2f((bf16_t)hv[e]) + bf2f((bf16_t)hb[e]); ss += hf[e] * hf[e]; }
    ss += sxor(ss, 1, lane); ss += sxor(ss, 2, lane); ss += sxor(ss, 4, lane); ss += sxor(ss, 8, lane);
    const float rs = rsqrtf(ss * (1.f / 128.f) + EPS);
    const float* ng = p.o_ml_norm_g + li * 128 + ((8 * lane) & 127);
    bf16x8 r;
#pragma unroll
    for (int e = 0; e < 8; ++e)
      r[e] = (short)f2bf(hf[e] * rs * ng[e] * sigmoidf_(bf2f((bf16_t)mo[e])) * siluf_(bf2f((bf16_t)mg[e])));
    if (!dry) *(bf16x8*)(p.MLGb + off) = r;
  }
}

__device__ void phase_final(const Params& p, bool dry = false) {
  const int tid_ = otid(); const int lane = tid_ & 63, w = tid_ >> 6;
  for (int tok = blockIdx.x * 4 + w; tok < T_TOK; tok += gridDim.x * 4) {
    float* xp = p.out + (long)tok * DM;
    float4 v[4];
    float ss = 0.f;
#pragma unroll
    for (int i = 0; i < 4; ++i) {
      v[i] = *(const float4*)(xp + 4 * lane + 256 * i);
      ss += v[i].x * v[i].x + v[i].y * v[i].y + v[i].z * v[i].z + v[i].w * v[i].w;
    }
#pragma unroll
    for (int d = 1; d < 64; d <<= 1) ss += sxor(ss, d, lane);
    const float rs = rsqrtf(ss * (1.f / 1024.f) + EPS);
#pragma unroll
    for (int i = 0; i < 4; ++i) {
      float4 gq = *(const float4*)(p.final_norm_g + 4 * lane + 256 * i);
      float4 o;
      o.x = v[i].x * rs * gq.x; o.y = v[i].y * rs * gq.y; o.z = v[i].z * rs * gq.z; o.w = v[i].w * rs * gq.w;
      if (!dry) *(float4*)(xp + 4 * lane + 256 * i) = o;
    }
  }
}

__device__ void run_phase(const Params& p, int ph, char* smem) {
  if (ph == 0) { if (PH_ON(0)) phase_prep(p); return; }
  if (ph == NPHASE - 1) { if (PROBE_B) phase_final(p, true); if (PH_ON(11)) phase_final(p); return; }
  const int q = ph - 1;
  const int layer = (q < 5) ? 0 : (q < 12) ? 1 : (q < 17) ? 2 : 3;
  const int sub = (q < 5) ? q : (q < 12) ? q - 5 : (q < 17) ? q - 12 : q - 17;
  const int li = layer >> 1;
  const float* xa = (layer == 0) ? p.x_prompt : p.out;
  const float* xb = (layer == 0) ? p.x_sample : p.out + (long)T_P * DM;
  if ((layer & 1) == 0) {
    if (sub == 0) {
      EpiEvenIn e{p.Qb, p.Kt, p.VtE, p.Gb, p.LRb, p.PUb, p.PGb};
      if (PH_ON(1)) gemm_phase<3, 8>(T_TOK / 128, NE_PAD / 256, DM, p.WinE + (long)li * NE_PAD * DM, p.SSQ, nullptr, p.TMP, DM, DM, p.TMP, DM, e, smem);
    } else if (sub == 1) {
#if PROBE_A
      for (int item = blockIdx.x; item < 5120; item += gridDim.x) gla_intra_item(p, li, item, smem, true);
#endif
#if PROBE_B
      for (int item = blockIdx.x; item < 5120; item += gridDim.x) pool_item(p, li, item, smem, true);
#endif
      for (int item = blockIdx.x; item < 5120 + 5120; item += gridDim.x) {
        if (item < 5120) { if (PH_ON(2)) gla_intra_item(p, li, item, smem); }
        else { if (PH_ON(3)) pool_item(p, li, item - 5120, smem); }
      }
    } else if (sub == 2) {
      for (int rep = PROBE_CHAIN ? 0 : 1; rep < 2; ++rep)
      for (int item = blockIdx.x; item < 384; item += gridDim.x)
        if (PH_ON(2)) gla_chain_item(p, li, item, smem, rep == 0);
    } else if (sub == 3) {
      if (PROBE_B) phase_gla_combine(p, li, true);
      if (PH_ON(4)) phase_gla_combine(p, li);
    } else {
      EpiOut e{xa, xb, p.out, false, p.NUMIf, p.SSQ};
      if (PH_ON(5)) gemm_phase<1, 8>(T_TOK / 128, DM / 256, 1536, p.WoutE + (long)li * DM * 1536, nullptr, nullptr, p.Gb, 1024, 1024, p.PGb, 512, e, smem);
    }
  } else {
    if (sub == 0) {
      EpiOddIn e{p.CQb, p.CKVb, p.KRb, p.MGb, p.MQb, p.MKb, p.MKt, p.MVt, p.MOb, p.MLGb, p.MIF};
      if (PH_ON(6)) gemm_phase<3, 8>(T_TOK / 128, NO_PAD / 256, DM, p.WinO + (long)li * NO_PAD * DM, p.SSQ, nullptr, p.NUMIf, DM, DM, p.NUMIf, DM, e, smem);
    } else if (sub == 1) {
      for (int rep = 0; rep < 1 + PROBE_A; ++rep)
      for (int item = blockIdx.x; item < 5120; item += gridDim.x)
        if (PH_ON(8)) ml_intra_item(p, li, item, smem);
    } else if (sub == 2) {
      for (int rep = PROBE_MLCHAIN ? 0 : 1; rep < 2; ++rep)
      for (int item = blockIdx.x; item < 384; item += gridDim.x)
        if (PH_ON(8)) ml_chain_item(p, li, item, smem, rep == 0);
    } else if (sub == 3) {
      if (PROBE_B) phase_ml_combine(p, li, true);
      if (PH_ON(10)) phase_ml_combine(p, li);
    } else if (sub == 4) {
      EpiQUp eq{p.Qa};
      if (PH_ON(7)) gemm_phase<2, 4>(T_TOK / 128, 768 / 128, 384, p.QupT + (long)li * 768 * 384, nullptr, nullptr, p.CQb, 384, 384, p.CQb, 384, eq, smem);
      EpiKVUp ek{p.KNb, p.VtA};
      if (PH_ON(7)) gemm_phase<2, 4>(T_TOK / 128, 1024 / 128, 256, p.KVupT + (long)li * 1024 * 256, nullptr, nullptr, p.CKVb, 256, 256, p.CKVb, 256, ek, smem);
    } else if (sub == 5) {
      __shared__ int s_item;
      for (;;) {
        __syncthreads();
        if (threadIdx.x == 0) s_item = atomicAdd(p.counters + li * 8 + (blockIdx.x & 7), 1);
        __syncthreads();
        const int item = s_item;
        if (item >= 320) break;
        if (PH_ON(9)) attn_item(p, (blockIdx.x & 7) * 320 + item, smem);
      }
    } else {
      EpiOut e{xa, xb, p.out, false, (layer == 3) ? nullptr : p.TMP, p.SSQ};
      if (PH_ON(5)) gemm_phase<1, 8>(T_TOK / 128, DM / 256, 1024, p.WoutO + (long)li * DM * 1024, nullptr, nullptr, p.MGb, 512, 512, p.MLGb, 512, e, smem);
    }
  }
}

__global__ void __launch_bounds__(256, 2) mega_kernel(Params p) {
  extern __shared__ __attribute__((aligned(16))) char smem[];
  cg::grid_group grid = cg::this_grid();
  __shared__ uint4 xb_words;
  if (threadIdx.x == 0) xb_words = make_uint4(0u, 0u, 0u, 0u);
  __syncthreads();
  XcdBarrier xb = xcd_barrier_post(p.bar, (volatile LAS unsigned*)&xb_words);
  for (int ph = p.ph_lo; ph < p.ph_hi; ++ph) {
    if (ph > p.ph_lo) {
      if (ph == p.ph_lo + 1) grid.sync();
      else xcd_barrier(xb);
    }
    run_phase(p, ph, smem);
  }
}

extern "C" void kernel_launch(void* const* d_in, const int* in_sizes, int n_in, void* d_out, int out_size, void* d_ws,
                              size_t ws_size, hipStream_t stream) {
  static int grid_blocks = 0;
  if (!grid_blocks) {
    int dev = 0, cus = 0, per_cu = 0;
    hipGetDevice(&dev);
    hipDeviceGetAttribute(&cus, hipDeviceAttributeMultiprocessorCount, dev);
    hipFuncSetAttribute((const void*)mega_kernel, hipFuncAttributeMaxDynamicSharedMemorySize, LDS_BYTES);
    hipOccupancyMaxActiveBlocksPerMultiprocessor(&per_cu, (const void*)mega_kernel, 256, LDS_BYTES);
    if (per_cu < 1) per_cu = 1;
    if (per_cu > 2) per_cu = 2;
    grid_blocks = cus * per_cu;
    fprintf(stderr, "kernel_launch: cus %d per_cu %d grid %d ws %zu\n", cus, per_cu, grid_blocks, ws_size);
  }
  Params p{};
  const float** pin = (const float**)&p;
  for (int i = 0; i < 19; ++i) pin[i] = (const float*)d_in[i];
  p.out = (float*)d_out;
  char* ws = (char*)d_ws;
  size_t off = 0;
  auto take = [&](size_t bytes) { char* r = ws + off; off += (bytes + 255) & ~(size_t)255; return r; };
  p.WinE = (bf16_t*)take((size_t)2 * NE_PAD * DM * 2);
  p.WinO = (bf16_t*)take((size_t)2 * NO_PAD * DM * 2);
  p.WoutE = (bf16_t*)take((size_t)2 * DM * 1536 * 2);
  p.WoutO = (bf16_t*)take((size_t)2 * DM * 1024 * 2);
  p.QupT = (bf16_t*)take((size_t)2 * 768 * 384 * 2);
  p.KVupT = (bf16_t*)take((size_t)2 * 1024 * 256 * 2);
  p.PoolWT = (bf16_t*)take((size_t)2 * 4 * 128 * 128 * 2);
  p.AupT = (bf16_t*)take((size_t)2 * 2 * 512 * 32 * 2);
  p.counters = (int*)take(256);
  p.bar = (unsigned*)take((size_t)XCD_BAR_WORDS * 4);
  p.SSQ = (float*)take((size_t)T_TOK * 8 * 4);
  const size_t act0 = off;
  const size_t T = T_TOK;
  p.Gb = (bf16_t*)take(T * 1024 * 2);
  p.PGb = (bf16_t*)take(T * 512 * 2);
  p.Qb = (bf16_t*)take(T * 512 * 2);
  p.Kt = (bf16_t*)take(T * 512 * 2);
  p.QEb = (bf16_t*)take(T * 512 * 2);
  p.KdTb = (bf16_t*)take(T * 512 * 2);
  p.EB = (float*)take((size_t)2 * 1280 * 512 * 4);
  p.VtE = (bf16_t*)take(T * 1024 * 2);
  p.LRb = (bf16_t*)take(T * 32 * 2);
  p.PUb = (bf16_t*)take(T * 512 * 2);
  p.TMP = (bf16_t*)take(T * 1024 * 2);
  const size_t even_end = off;
  off = act0;
  p.MGb = (bf16_t*)take(T * 512 * 2);
  p.MLGb = (bf16_t*)take(T * 512 * 2);
  p.CQb = (bf16_t*)take(T * 384 * 2);
  p.CKVb = (bf16_t*)take(T * 256 * 2);
  p.KRb = (bf16_t*)take(T * 32 * 2);
  const size_t r2 = off;
  p.MQb = (bf16_t*)take(T * 512 * 2);
  p.MKb = (bf16_t*)take(T * 512 * 2);
  p.MKt = (bf16_t*)take(T * 512 * 2);
  p.MVt = (bf16_t*)take(T * 512 * 2);
  p.MOb = (bf16_t*)take(T * 512 * 2);
  p.NUMIf = (bf16_t*)take(T * 512 * 2);
  p.NUMIb = (bf16_t*)take(T * 512 * 2);
  p.MIF = (float*)take(T * 16 * 4);
  p.EBI = (float*)take(T * 8 * 4);
  p.WKg = (float*)take(T * 8 * 4);
  p.DENI = (float*)take(T * 8 * 4);
  p.DEC = (float*)take((size_t)8 * 1280 * 4);
  const size_t r2_end = off;
  off = r2;
  p.Qa = (bf16_t*)take(T * 768 * 2);
  p.KNb = (bf16_t*)take(T * 512 * 2);
  p.VtA = (bf16_t*)take(T * 512 * 2);
  if (off < r2_end) off = r2_end;
  const size_t odd_end = off;
  const size_t need = even_end > odd_end ? even_end : odd_end;
  if (need > ws_size) {
    fprintf(stderr, "kernel_launch: workspace too small: need %zu have %zu\n", need, ws_size);
    return;
  }
  hipMemsetAsync(p.bar, 0, (size_t)XCD_BAR_WORDS * 4, stream);
#if SINGLE_LAUNCH
  p.ph_lo = 0;
  p.ph_hi = NPHASE;
  void* args[] = {&p};
  hipError_t e = hipLaunchCooperativeKernel((const void*)mega_kernel, dim3(grid_blocks), dim3(256), args, LDS_BYTES, stream);
  if (e != hipSuccess) fprintf(stderr, "cooperative launch failed: %s (grid %d)\n", hipGetErrorString(e), grid_blocks);
#else
  for (int ph = 0; ph < NPHASE; ++ph) {
    p.ph_lo = ph;
    p.ph_hi = ph + 1;
    hipLaunchKernelGGL(mega_kernel, dim3(grid_blocks), dim3(256), LDS_BYTES, stream, p);
  }
#endif
}
```

```cpp
#include <hip/hip_runtime.h>
#include <hip/hip_cooperative_groups.h>
#include <cstdio>
namespace cg = cooperative_groups;

#ifndef SINGLE_LAUNCH
#define SINGLE_LAUNCH 1
#endif
#ifndef PHMASK
#define PHMASK 0xFFFF
#endif
#define PH_ON(b) ((PHMASK >> (b)) & 1)
#ifndef PROBE_GEMM
#define PROBE_GEMM 0
#endif
#ifndef PROBE_ATTN
#define PROBE_ATTN 0
#endif
#ifndef PROBE_CHAIN
#define PROBE_CHAIN 0
#endif
#ifndef PROBE_A
#define PROBE_A 0
#endif
#ifndef PROBE_B
#define PROBE_B 0
#endif
#ifndef PROBE_MLCHAIN
#define PROBE_MLCHAIN 0
#endif

typedef unsigned short bf16_t;
typedef __attribute__((ext_vector_type(8))) short bf16x8;
typedef __attribute__((ext_vector_type(4))) float f32x4;
typedef __attribute__((ext_vector_type(4))) unsigned short us4;

constexpr int T_TOK = 81920;
constexpr int T_P = 16384;
constexpr int DM = 1024;
constexpr int NE = 4128, NE_PAD = 4352;
constexpr int NO = 4272, NO_PAD = 4352;
constexpr float EPS = 1e-6f;
constexpr int NPHASE = 26;
constexpr int LDS_BYTES = 72 * 1024;

struct Params {
  const float *x_prompt, *x_sample, *norm_g, *final_norm_g, *e_w_in, *e_a_up, *e_a_bias, *e_gla_norm_g,
      *e_pool_w, *e_pool_scale, *e_w_out, *o_w_in, *o_q_norm_g, *o_q_up, *o_kv_norm_g, *o_kv_up, *o_if_bias,
      *o_ml_norm_g, *o_w_out;
  float* out;
  bf16_t *WinE, *WinO, *WoutE, *WoutO, *QupT, *KVupT, *PoolWT, *AupT;
  int* counters;
  unsigned* bar;
  float* SSQ;
  bf16_t *Qb, *Kt, *VtE, *Gb, *LRb, *PUb, *PGb, *TMP, *QEb, *KdTb;
  float* EB;
  bf16_t *CQb, *CKVb, *KRb, *MGb, *MQb, *MKb, *MKt, *MVt, *MOb, *MLGb, *NUMIf, *NUMIb, *Qa, *KNb, *VtA;
  float *MIF, *EBI, *WKg, *DENI, *DEC;
  int ph_lo, ph_hi;
};

typedef __bf16 hbf2 __attribute__((ext_vector_type(2)));
typedef float hf2 __attribute__((ext_vector_type(2)));
__device__ __forceinline__ bf16_t f2bf(float f) {
  __bf16 b = (__bf16)f;
  return __builtin_bit_cast(bf16_t, b);
}
__device__ __forceinline__ unsigned pk2bf(float a, float b) {
  hf2 v = {a, b};
  hbf2 r = __builtin_convertvector(v, hbf2);
  return __builtin_bit_cast(unsigned, r);
}
__device__ __forceinline__ float bf2f(bf16_t b) { return __uint_as_float(((unsigned)b) << 16); }
__device__ __forceinline__ f32x4 mfma16(bf16x8 a, bf16x8 b, f32x4 c) {
  return __builtin_amdgcn_mfma_f32_16x16x32_bf16(a, b, c, 0, 0, 0);
}
__device__ __forceinline__ float logsigmoidf_(float x) { return fminf(x, 0.f) - log1pf(__expf(-fabsf(x))); }
__device__ __forceinline__ float siluf_(float x) { return x / (1.f + __expf(-x)); }
__device__ __forceinline__ float sigmoidf_(float x) { return 1.f / (1.f + __expf(-x)); }
__device__ __forceinline__ int otid() { int t = threadIdx.x; asm volatile("" : "+v"(t)); return t; }
__device__ __forceinline__ float bperm(int srclane, float v) { return __int_as_float(__builtin_amdgcn_ds_bpermute(srclane << 2, __float_as_int(v))); }
__device__ __forceinline__ float sxor(float v, int m, int lane) { return bperm(lane ^ m, v); }
typedef unsigned u32x2_t __attribute__((ext_vector_type(2)));
__device__ __forceinline__ float rowmax4(float v) {
  u32x2_t r = __builtin_amdgcn_permlane16_swap(__float_as_uint(v), __float_as_uint(v), false, false);
  v = fmaxf(__uint_as_float(r[0]), __uint_as_float(r[1]));
  r = __builtin_amdgcn_permlane32_swap(__float_as_uint(v), __float_as_uint(v), false, false);
  return fmaxf(__uint_as_float(r[0]), __uint_as_float(r[1]));
}
__device__ __forceinline__ bf16x8 zero8() { bf16x8 z = {0, 0, 0, 0, 0, 0, 0, 0}; return z; }
__device__ __forceinline__ f32x4 zero4() { f32x4 z = {0.f, 0.f, 0.f, 0.f}; return z; }

__device__ __forceinline__ int seq_pos(int tok) { return tok < T_P ? (tok & 4095) : ((tok - T_P) & 8191); }
__device__ __forceinline__ const float* xrow(const float* xa, const float* xb, int tok) {
  return tok < T_P ? xa + (long)tok * DM : xb + (long)(tok - T_P) * DM;
}


#define XB_TMO      128
#define XB_XCNT(j)  (256  + 64 * (j))
#define XB_XSUB(j)  (1280 + 64 * (j))
#define XB_XGEN(j)  (2304 + 64 * (j))
#define XB_TOP      3328
#define XB_TOPGEN   3392
#define XCD_BAR_WORDS 3456
#define XB_SPIN_CAP (1u << 22)
#define LAS __attribute__((address_space(3)))
__device__ __forceinline__ unsigned xb_ld(unsigned* p) { return __hip_atomic_load(p, __ATOMIC_RELAXED, __HIP_MEMORY_SCOPE_AGENT); }
__device__ __forceinline__ unsigned xb_add(unsigned* p, unsigned v) { return __hip_atomic_fetch_add(p, v, __ATOMIC_RELAXED, __HIP_MEMORY_SCOPE_AGENT); }
__device__ __forceinline__ unsigned xb_xcc_id() { return (unsigned)__builtin_amdgcn_s_getreg((3 << 11) | 20) & 0xFu; }
#define XB_SPIN(cond, bar) do { unsigned _sp = 0; while (cond) { __builtin_amdgcn_s_sleep(1); \
    if ((++_sp & 255u) == 0u) { if (xb_ld(&(bar)[XB_TMO])) break; if (_sp > XB_SPIN_CAP) { atomicAdd(&(bar)[XB_TMO], 1u); break; } } } } while (0)
struct XcdBarrier { unsigned* bar; unsigned x; volatile LAS unsigned* st; };
__device__ __forceinline__ XcdBarrier xcd_barrier_post(unsigned* bar, volatile LAS unsigned* st) {
  XcdBarrier b; b.bar = bar; b.x = xb_xcc_id(); b.st = st;
  if (threadIdx.x == 0) (void)xb_add(&bar[XB_XCNT(b.x)], 1u);
  return b;
}
__device__ __forceinline__ void xcd_barrier_complete(unsigned* bar, unsigned x, unsigned& nloc, unsigned& nx) {
  const unsigned G = gridDim.x * gridDim.y * gridDim.z;
  unsigned sum, cnt, mine, sp = 0u;
  for (;;) {
    sum = 0u; cnt = 0u; mine = 0u;
#pragma unroll
    for (unsigned j = 0; j < 16; ++j) { const unsigned cc = xb_ld(&bar[XB_XCNT(j)]); sum += cc; cnt += (cc > 0u) ? 1u : 0u; mine = (j == x) ? cc : mine; }
    if (sum == G) break;
    __builtin_amdgcn_s_sleep(1);
    if ((++sp & 255u) == 0u) { if (xb_ld(&bar[XB_TMO])) break; if (sp > XB_SPIN_CAP) { atomicAdd(&bar[XB_TMO], 1u); break; } }
  }
  nloc = mine > 0u ? mine : 1u; nx = cnt > 0u ? cnt : 1u;
}
__device__ __forceinline__ void xcd_barrier(const XcdBarrier& b) {
  asm volatile("s_waitcnt vmcnt(0)" ::: "memory");
  __syncthreads();
  if (threadIdx.x == 0) {
    unsigned* bar = b.bar;
    __builtin_amdgcn_s_waitcnt(0);
    unsigned nloc = b.st[0], nx = b.st[1];
    if (nloc == 0u) { xcd_barrier_complete(bar, b.x, nloc, nx); b.st[0] = nloc; b.st[1] = nx; }
    const unsigned old = xb_add(&bar[XB_XSUB(b.x)], 1u);
    const unsigned gen = old / nloc;
    if (old + 1u == (gen + 1u) * nloc) {
      __builtin_amdgcn_fence(__ATOMIC_RELEASE, "agent");
      asm volatile("s_waitcnt vmcnt(0)" ::: "memory");
      const unsigned og = xb_add(&bar[XB_TOP], 1u);
      const unsigned tg = og / nx;
      if (og + 1u == (tg + 1u) * nx) xb_add(&bar[XB_TOPGEN], 1u);
      else XB_SPIN(xb_ld(&bar[XB_TOPGEN]) == tg, bar);
      __builtin_amdgcn_fence(__ATOMIC_ACQUIRE, "agent");
      xb_add(&bar[XB_XGEN(b.x)], 1u);
      asm volatile("s_waitcnt vmcnt(0)" ::: "memory");
    } else {
      XB_SPIN(xb_ld(&bar[XB_XGEN(b.x)]) == gen, bar);
      __builtin_amdgcn_fence(__ATOMIC_ACQUIRE, "agent");
      asm volatile("s_waitcnt vmcnt(0)" ::: "memory");
    }
  }
  __syncthreads();
}

__device__ __forceinline__ int colmap(int mode, int n) {
  if (mode == 1) {
    if (n < 512) return 2208 + n;
    if (n < 1024) return 1696 + (n - 512);
    if (n < 1408) return n - 1024;
    if (n < 1664) return 384 + (n - 1408);
    if (n < 2176) return 672 + (n - 1664);
    if (n < 2688) return 1184 + (n - 2176);
    if (n < 3200) return 1696 + (n - 2688);
    if (n < 3712) return 2720 + (n - 3200);
    if (n < 4224) return 3248 + (n - 3712);
    if (n < 4256) return 640 + (n - 4224);
    return 3232 + (n - 4256);
  }
  if (mode == 2) {
    if (n < 512) return (n >> 6) * 96 + (n & 63);
    const int r = n - 512;
    return (r >> 5) * 96 + 64 + (r & 31);
  }
  if (mode == 3) {
    if (n < 512) return (n >> 6) * 128 + (n & 63);
    const int r = n - 512;
    return (r >> 6) * 128 + 64 + (r & 63);
  }
  return n;
}

__device__ void prep_weight(const float* __restrict__ W, int K, int N, int Npad, const float* __restrict__ gsc,
                            bf16_t* __restrict__ out, char* smem, int mode = 0, int Nsrc_ = 0) {
  const int Nsrc = Nsrc_ ? Nsrc_ : N;
  const int tid = otid();
  float* sT = (float*)smem;
  const int tn = Npad >> 6, tk = K >> 6;
  for (int tile = blockIdx.x; tile < tn * tk; tile += gridDim.x) {
    const int n0 = (tile / tk) << 6, k0 = (tile % tk) << 6;
    __syncthreads();
#pragma unroll 4
    for (int i = 0; i < 16; ++i) {
      const int idx = tid + 256 * i;
      const int kk = idx >> 6, nn = idx & 63;
      float v = 0.f;
      if (n0 + nn < N) {
        v = W[(size_t)(k0 + kk) * Nsrc + colmap(mode, n0 + nn)];
        if (gsc) v *= gsc[k0 + kk];
      }
      sT[nn * 65 + kk] = v;
    }
    __syncthreads();
#pragma unroll 4
    for (int i = 0; i < 16; ++i) {
      const int idx = tid + 256 * i;
      const int nn = idx >> 6, kk = idx & 63;
      out[(size_t)(n0 + nn) * K + k0 + kk] = f2bf(sT[nn * 65 + kk]);
    }
  }
}

__device__ void phase_prep(const Params& p, char* smem) {
  long gtid = (long)blockIdx.x * 256 + otid();
  long gsize = (long)gridDim.x * 256;
  for (int l = 0; l < 2; ++l) {
    prep_weight(p.e_w_in + (long)l * DM * NE, DM, NE, NE_PAD, p.norm_g + (2 * l) * DM, p.WinE + (long)l * NE_PAD * DM, smem);
    prep_weight(p.o_w_in + (long)l * DM * 3760, DM, NO, NO_PAD, p.norm_g + (2 * l + 1) * DM, p.WinO + (long)l * NO_PAD * DM, smem, 1, 3760);
    prep_weight(p.e_w_out + (long)l * 1536 * DM, 1536, DM, DM, nullptr, p.WoutE + (long)l * DM * 1536, smem);
    prep_weight(p.o_w_out + (long)l * 1024 * DM, 1024, DM, DM, nullptr, p.WoutO + (long)l * DM * 1024, smem);
    prep_weight(p.o_q_up + (long)l * 384 * 768, 384, 768, 768, p.o_q_norm_g + l * 384, p.QupT + (long)l * 768 * 384, smem, 2);
    prep_weight(p.o_kv_up + (long)l * 256 * 1024, 256, 1024, 1024, p.o_kv_norm_g + l * 256, p.KVupT + (long)l * 1024 * 256, smem, 3);
    for (int gi = 0; gi < 4; ++gi)
      prep_weight(p.e_pool_w + (long)(l * 4 + gi) * 128 * 128, 128, 128, 128, nullptr, p.PoolWT + (long)(l * 4 + gi) * 128 * 128, smem);
    for (long idx = gtid; idx < 2 * 512 * 32; idx += gsize) {
      int r = (int)(idx & 31);
      int d = (int)((idx >> 5) & 511);
      int dir = (int)(idx >> 14);
      float v = (r < 16) ? p.e_a_up[((long)(l * 2 + dir) * 16 + r) * 512 + d] : 0.f;
      p.AupT[((long)(l * 2 + dir) * 512 + d) * 32 + r] = f2bf(v);
    }
  }
  if (gtid < 32) p.counters[gtid] = 0;
  {
    const int tid_ = otid();
    const int lane = tid_ & 63, w = tid_ >> 6;
    for (int tok = blockIdx.x * 4 + w; tok < T_TOK; tok += gridDim.x * 4) {
      const float* xp = xrow(p.x_prompt, p.x_sample, tok) + 16 * lane;
      float ssv = 0.f;
      unsigned pk[8];
#pragma unroll
      for (int i = 0; i < 4; ++i) {
        const f32x4 v = *(const f32x4*)(xp + 4 * i);
        ssv += v[0] * v[0] + v[1] * v[1] + v[2] * v[2] + v[3] * v[3];
        pk[2 * i] = pk2bf(v[0], v[1]);
        pk[2 * i + 1] = pk2bf(v[2], v[3]);
      }
      uint4 o0, o1;
      o0.x = pk[0]; o0.y = pk[1]; o0.z = pk[2]; o0.w = pk[3];
      o1.x = pk[4]; o1.y = pk[5]; o1.z = pk[6]; o1.w = pk[7];
      *(uint4*)(p.TMP + (size_t)tok * DM + 16 * lane) = o0;
      *(uint4*)(p.TMP + (size_t)tok * DM + 16 * lane + 8) = o1;
#pragma unroll
      for (int d = 1; d < 64; d <<= 1) ssv += sxor(ssv, d, lane);
      if (lane < 8) p.SSQ[(size_t)tok * 8 + lane] = (lane == 0) ? ssv : 0.f;
    }
  }
}

constexpr int G_LD = 40;
constexpr int G_BUF = (128 + 256) * G_LD;

template <int AMODE, int NI, class Epi>
__device__ __forceinline__ void gemm_phase(int Mtiles, int Ntiles, int K, const bf16_t* __restrict__ Bt, const float* ssq, const float* unused_,
                           const bf16_t* A1, int ld1, int K1, const bf16_t* A2, int ld2, const Epi& epi, char* smem) {
  bf16_t* sbase = (bf16_t*)smem;
  float* sR = (float*)(smem + 70144);
  const int tid = otid(), lane = tid & 63, w = tid >> 6, c = lane & 15, g = lane >> 4;
  const int wm = w >> 1, wn = w & 1;
  const int nk = K / 32;
  const int xcd = blockIdx.x & 7, lb0 = blockIdx.x >> 3, nlb = gridDim.x >> 3;
  const int mper = Mtiles >> 3;
  for (int lt = lb0; lt < mper * Ntiles; lt += nlb) {
    const int mt = xcd * mper + lt / Ntiles, nt = lt % Ntiles;
    constexpr int BN = 32 * NI;
    const int m0 = mt * 128, n0 = nt * BN;
    f32x4 acc[4][NI];
#pragma unroll
    for (int i = 0; i < 4; ++i)
#pragma unroll
      for (int j = 0; j < NI; ++j) acc[i][j] = zero4();
    float ss[2] = {0.f, 0.f};
    bf16x8 ra0[2], ra1[2];
    bf16x8 rb0[NI / 2], rb1[NI / 2];
    const unsigned boff = (unsigned)(tid >> 2) * K + 8 * (tid & 3);
    const bf16_t* bbase = Bt + (size_t)n0 * K;
#define G_LOAD(RA, RB, KT)                                                                          \
  {                                                                                                 \
    const int k0_ = (KT) * 32;                                                                      \
    const bf16_t* base_;                                                                            \
    int ld_;                                                                                        \
    if (k0_ < K1) { base_ = A1 + (size_t)m0 * ld1 + k0_; ld_ = ld1; }                               \
    else { base_ = A2 + (size_t)m0 * ld2 + (k0_ - K1); ld_ = ld2; }                                 \
    _Pragma("unroll") for (int i = 0; i < 2; ++i)                                                   \
      RA[i] = *(const bf16x8*)(base_ + (unsigned)((tid >> 2) + 64 * i) * ld_ + 8 * (tid & 3));      \
    _Pragma("unroll") for (int i = 0; i < NI / 2; ++i)                                              \
      RB[i] = *(const bf16x8*)(bbase + k0_ + boff + (unsigned)(64 * i) * K);                        \
  }
#define G_STORE(RA, RB, BUF)                                                                        \
  {                                                                                                 \
    bf16_t* sA_ = sbase + (BUF) * G_BUF;                                                            \
    bf16_t* sB_ = sA_ + 128 * G_LD;                                                                 \
    _Pragma("unroll") for (int i = 0; i < 2; ++i) {                                                 \
      bf16x8 v = RA[i];                                                                             \
      if constexpr (AMODE == 2) {                                                                   \
        _Pragma("unroll") for (int e = 0; e < 8; ++e) {                                             \
          float f = bf2f((bf16_t)v[e]);                                                             \
          ss[i] += f * f;                                                                           \
        }                                                                                           \
      }                                                                                             \
      *(bf16x8*)(sA_ + ((tid >> 2) + 64 * i) * G_LD + 8 * (tid & 3)) = v;                           \
    }                                                                                               \
    _Pragma("unroll") for (int i = 0; i < NI / 2; ++i)                                              \
      *(bf16x8*)(sB_ + ((tid >> 2) + 64 * i) * G_LD + 8 * (tid & 3)) = RB[i];                       \
  }
#define G_COMPUTE(BUF)                                                                              \
  {                                                                                                 \
    const bf16_t* sA_ = sbase + (BUF) * G_BUF;                                                      \
    const bf16_t* sB_ = sA_ + 128 * G_LD;                                                           \
    bf16x8 af[4];                                                                                   \
    _Pragma("unroll") for (int mi = 0; mi < 4; ++mi)                                                \
      af[mi] = *(const bf16x8*)(sA_ + (wm * 64 + mi * 16 + c) * G_LD + g * 8);                      \
    bf16x8 bq[2];                                                                                   \
    bq[0] = *(const bf16x8*)(sB_ + (wn * (16 * NI) + c) * G_LD + g * 8);                            \
    _Pragma("unroll") for (int ni = 0; ni < NI; ++ni) {                                             \
      if (ni + 1 < NI)                                                                              \
        bq[(ni + 1) & 1] = *(const bf16x8*)(sB_ + (wn * (16 * NI) + (ni + 1) * 16 + c) * G_LD + g * 8); \
      _Pragma("unroll") for (int mi = 0; mi < 4; ++mi) acc[mi][ni] = mfma16(af[mi], bq[ni & 1], acc[mi][ni]); \
    }                                                                                               \
  }
    __syncthreads();
    if constexpr (AMODE == 3) {
      if (tid < 128) {
        const f32x4 p0 = *(const f32x4*)(ssq + (size_t)(m0 + tid) * 8);
        const f32x4 p1 = *(const f32x4*)(ssq + (size_t)(m0 + tid) * 8 + 4);
        const float sv = (p0[0] + p0[1]) + (p0[2] + p0[3]) + (p1[0] + p1[1]) + (p1[2] + p1[3]);
        sR[tid] = rsqrtf(sv * (1.f / 1024.f) + EPS);
      }
    }
    G_LOAD(ra0, rb0, 0)
    G_LOAD(ra1, rb1, 1)
    G_STORE(ra0, rb0, 0)
    __syncthreads();
    for (int kt = 0; kt < nk; kt += 2) {
      G_LOAD(ra0, rb0, min(kt + 2, nk - 1))
      G_COMPUTE(0)
      G_STORE(ra1, rb1, 1)
      __syncthreads();
      G_LOAD(ra1, rb1, min(kt + 3, nk - 1))
      G_COMPUTE(1)
      if (kt + 2 < nk) G_STORE(ra0, rb0, 0)
      __syncthreads();
    }
    if constexpr (AMODE == 2) {
#pragma unroll
      for (int i = 0; i < 2; ++i) {
        float sv = ss[i];
        sv += sxor(sv, 1, lane); sv += sxor(sv, 2, lane);
        if ((tid & 3) == 0) sR[(tid >> 2) + 64 * i] = rsqrtf(sv / (float)K + EPS);
      }
      __syncthreads();
    }
    if constexpr (Epi::staged) {
      bf16_t* sT = sbase;
      const float esc = epi.scale();
      const bool tr = epi.transposed(n0);
      if (tr) {
#pragma unroll
        for (int mi = 0; mi < 4; ++mi) {
          const int row = wm * 64 + mi * 16 + 4 * g;
          const float r0 = sR[row] * esc, r1 = sR[row + 1] * esc, r2 = sR[row + 2] * esc, r3 = sR[row + 3] * esc;
#pragma unroll
          for (int ni = 0; ni < NI; ++ni) {
            uint2 o;
            o.x = pk2bf(acc[mi][ni][0] * r0, acc[mi][ni][1] * r1);
            o.y = pk2bf(acc[mi][ni][2] * r2, acc[mi][ni][3] * r3);
            *(uint2*)(sT + (wn * (16 * NI) + ni * 16 + c) * 136 + row) = o;
          }
        }
      } else {
#pragma unroll
        for (int mi = 0; mi < 4; ++mi) {
          const int row = wm * 64 + mi * 16 + 4 * g;
          const float r0 = sR[row] * esc, r1 = sR[row + 1] * esc, r2 = sR[row + 2] * esc, r3 = sR[row + 3] * esc;
#pragma unroll
          for (int ni = 0; ni < NI; ++ni) {
            bf16_t* d = sT + row * (BN + 8) + wn * (16 * NI) + ni * 16 + c;
            d[0] = f2bf(acc[mi][ni][0] * r0);
            d[BN + 8] = f2bf(acc[mi][ni][1] * r1);
            d[2 * (BN + 8)] = f2bf(acc[mi][ni][2] * r2);
            d[3 * (BN + 8)] = f2bf(acc[mi][ni][3] * r3);
          }
        }
      }
      epi.template direct<NI>(m0, n0, wm, wn, g, c, acc, sR);
      __syncthreads();
      if (tr) {
#pragma unroll 4
        for (int i = 0; i < 2 * NI; ++i) {
          const int id = tid + 256 * i;
          const int col = id >> 4, rc = id & 15;
          bf16x8 v = *(const bf16x8*)(sT + col * 136 + 8 * rc);
          epi.store_t(m0 + 8 * rc, n0 + col, v);
        }
      } else {
#pragma unroll 4
        for (int i = 0; i < 2 * NI; ++i) {
          const int id = tid + 256 * i;
          const int row = id / (4 * NI), cc = id % (4 * NI);
          const bf16_t* sp = sT + row * (BN + 8) + 8 * cc;
          bf16x8 v = *(const bf16x8*)sp;
          epi.store_n(m0 + row, n0 + 8 * cc, v, sp);
        }
      }
    } else {
      float* sF = (float*)smem;
#pragma unroll 1
      for (int half = 0; half < 2; ++half) {
        if (half) __syncthreads();
        if (wm == half) {
#pragma unroll
          for (int mi = 0; mi < 4; ++mi)
#pragma unroll
            for (int ni = 0; ni < NI; ++ni)
#pragma unroll
              for (int j = 0; j < 4; ++j) sF[(mi * 16 + 4 * g + j) * 260 + wn * (16 * NI) + ni * 16 + c] = acc[mi][ni][j];
        }
        __syncthreads();
#pragma unroll 4
        for (int i = 0; i < 16; ++i) {
          const int row = w * 16 + i;
          const int tok = m0 + half * 64 + row;
          const int col = n0 + 4 * lane;
          const f32x4 a = *(const f32x4*)(sF + row * 260 + 4 * lane);
          const f32x4 xo = *(const f32x4*)(xrow(epi.xa, epi.xb, tok) + col);
          f32x4 xn;
          xn[0] = xo[0] + a[0]; xn[1] = xo[1] + a[1]; xn[2] = xo[2] + a[2]; xn[3] = xo[3] + a[3];
          float sv = xn[0] * xn[0] + xn[1] * xn[1] + xn[2] * xn[2] + xn[3] * xn[3];
#pragma unroll
          for (int d = 1; d < 64; d <<= 1) sv += sxor(sv, d, lane);
          if (!epi.dry) {
            *(f32x4*)(epi.out + (size_t)tok * DM + col) = xn;
            if (epi.hb) {
              uint2 o;
              o.x = pk2bf(xn[0], xn[1]);
              o.y = pk2bf(xn[2], xn[3]);
              *(uint2*)(epi.hb + (size_t)tok * DM + col) = o;
            }
            if (lane == 0) epi.ssq[(size_t)tok * 8 + (n0 >> 8)] = sv;
          }
        }
      }
    }
  }
#undef G_LOAD
#undef G_STORE
#undef G_COMPUTE
}

__device__ __forceinline__ void rope_cs(int pos, int i, float& co, float& si) {
  float inv = exp2f(-(float)i * (13.287712379549449f / 16.f));
  float ang = (float)pos * inv;
  float n = rintf(ang * 0.15915494309189535f);
  float r = fmaf(-n, 6.28125f, ang);
  r = fmaf(-n, 0.0019353071795864769f, r);
  float rf = r * 0.15915494309189535f;
  si = __builtin_amdgcn_sinf(rf);
  co = __builtin_amdgcn_cosf(rf);
}

__device__ __forceinline__ void rope_chunk(int pos, int i0, bf16x8 x1, bf16x8 x2, bf16x8& o1, bf16x8& o2) {
#pragma unroll
  for (int e = 0; e < 8; ++e) {
    float co, si;
    rope_cs(pos, i0 + e, co, si);
    float a = bf2f((bf16_t)x1[e]), b = bf2f((bf16_t)x2[e]);
    o1[e] = (short)f2bf(a * co - b * si);
    o2[e] = (short)f2bf(b * co + a * si);
  }
}

struct EpiEvenIn {
  static constexpr bool staged = true;
  bf16_t *Qb, *Kt, *VtE, *Gb, *LRb, *PUb, *PGb;
  __device__ float scale() const { return 1.f; }
  __device__ bool transposed(int n0) const { return n0 >= 512 && n0 < 2048; }
  template <int NI> __device__ void direct(int m0, int n0, int wm, int wn, int g, int c, f32x4 (&acc)[4][NI], const float* sR) const {}
  __device__ void store_t(int tok8, int col, bf16x8 v) const {
    if (col < 1024) *(bf16x8*)(Kt + (size_t)(col - 512) * T_TOK + tok8) = v;
    else *(bf16x8*)(VtE + (size_t)(col - 1024) * T_TOK + tok8) = v;
  }
  __device__ void store_n(int tok, int col, bf16x8 v, const bf16_t* sp) const {
    bf16_t* d;
    if (col < 512) d = Qb + (size_t)tok * 512 + col;
    else if (col < 3072) d = Gb + (size_t)tok * 1024 + (col - 2048);
    else if (col < 3104) d = LRb + (size_t)tok * 32 + (col - 3072);
    else if (col < 3616) d = PUb + (size_t)tok * 512 + (col - 3104);
    else if (col < 4128) d = PGb + (size_t)tok * 512 + (col - 3616);
    else return;
    *(bf16x8*)d = v;
  }
};

struct EpiOddIn {
  static constexpr bool staged = true;
  bf16_t *CQb, *CKVb, *KRb, *MGb, *MQb, *MKb, *MKt, *MVt, *MOb, *MLGb;
  float* MIF;
  __device__ float scale() const { return 1.f; }
  __device__ bool transposed(int n0) const { return n0 < 1024; }
  template <int NI> __device__ void direct(int m0, int n0, int wm, int wn, int g, int c, f32x4 (&acc)[4][NI], const float* sR) const {
    if (n0 == 4096 && wn == 1) {
#pragma unroll
      for (int mi = 0; mi < 4; ++mi)
#pragma unroll
        for (int j = 0; j < 4; ++j) {
          const int row = wm * 64 + mi * 16 + 4 * g + j;
          MIF[(size_t)(m0 + row) * 16 + c] = acc[mi][2][j] * sR[row];
        }
    }
  }
  __device__ void store_t(int tok8, int col, bf16x8 v) const {
    if (col < 512) *(bf16x8*)(MVt + (size_t)col * T_TOK + tok8) = v;
    else *(bf16x8*)(MKt + (size_t)(col - 512) * T_TOK + tok8) = v;
  }
  __device__ void store_n(int tok, int col, bf16x8 v, const bf16_t* sp) const {
    bf16_t* d;
    if (col < 1408) d = CQb + (size_t)tok * 384 + (col - 1024);
    else if (col < 1664) d = CKVb + (size_t)tok * 256 + (col - 1408);
    else if (col < 2176) d = MGb + (size_t)tok * 512 + (col - 1664);
    else if (col < 2688) d = MQb + (size_t)tok * 512 + (col - 2176);
    else if (col < 3200) d = MKb + (size_t)tok * 512 + (col - 2688);
    else if (col < 3712) d = MOb + (size_t)tok * 512 + (col - 3200);
    else if (col < 4224) d = MLGb + (size_t)tok * 512 + (col - 3712);
    else if (col < 4240) {
      bf16x8 x2 = *(const bf16x8*)(sp + 16);
      bf16x8 o1, o2;
      rope_chunk(seq_pos(tok), col - 4224, v, x2, o1, o2);
      *(bf16x8*)(KRb + (size_t)tok * 32 + (col - 4224)) = o1;
      *(bf16x8*)(KRb + (size_t)tok * 32 + 16 + (col - 4224)) = o2;
      return;
    } else return;
    *(bf16x8*)d = v;
  }
};

struct EpiQUp {
  static constexpr bool staged = true;
  bf16_t* Qa;
  __device__ float scale() const { return 0.10206207261596575f * 1.4426950408889634f; }
  __device__ bool transposed(int n0) const { return false; }
  template <int NI> __device__ void direct(int m0, int n0, int wm, int wn, int g, int c, f32x4 (&acc)[4][NI], const float* sR) const {}
  __device__ void store_t(int tok8, int col, bf16x8 v) const {}
  __device__ void store_n(int tok, int col, bf16x8 v, const bf16_t* sp) const {
    if (col < 512) {
      *(bf16x8*)(Qa + (size_t)tok * 768 + (col >> 6) * 96 + (col & 63)) = v;
    } else {
      const int r = col - 512, head = r >> 5, rr = r & 31;
      if (rr < 16) {
        bf16x8 x2 = *(const bf16x8*)(sp + 16);
        bf16x8 o1, o2;
        rope_chunk(seq_pos(tok), rr, v, x2, o1, o2);
        *(bf16x8*)(Qa + (size_t)tok * 768 + head * 96 + 64 + rr) = o1;
        *(bf16x8*)(Qa + (size_t)tok * 768 + head * 96 + 80 + rr) = o2;
      }
    }
  }
};

struct EpiKVUp {
  static constexpr bool staged = true;
  bf16_t *KNb, *VtA;
  __device__ float scale() const { return 1.f; }
  __device__ bool transposed(int n0) const { return n0 >= 512; }
  template <int NI> __device__ void direct(int m0, int n0, int wm, int wn, int g, int c, f32x4 (&acc)[4][NI], const float* sR) const {}
  __device__ void store_t(int tok8, int col, bf16x8 v) const { *(bf16x8*)(VtA + (size_t)(col - 512) * T_TOK + tok8) = v; }
  __device__ void store_n(int tok, int col, bf16x8 v, const bf16_t* sp) const { *(bf16x8*)(KNb + (size_t)tok * 512 + col) = v; }
};

struct EpiOut {
  static constexpr bool staged = false;
  const float *xa, *xb;
  float* out;
  bool dry;
  bf16_t* hb;
  float* ssq;
};

__device__ __forceinline__ float scan16(float v, int c, int lane) {
  float t;
  t = bperm(lane - 1, v); if (c >= 1) v += t;
  t = bperm(lane - 2, v); if (c >= 2) v += t;
  t = bperm(lane - 4, v); if (c >= 4) v += t;
  t = bperm(lane - 8, v); if (c >= 8) v += t;
  return v;
}

__device__ __forceinline__ float logsig_fast(float x) { return fminf(x, 0.f) - __logf(1.f + __expf(-fabsf(x))); }

__device__ void gla_intra_item(const Params& p, int li, int item, char* smem, bool dry = false) {
  const int tid = otid(), lane = tid & 63, w = tid >> 6, c = lane & 15, g = lane >> 4;
  const int ci = item >> 2, h = item & 3;
  const int tokc = ci * 64;
  const float qscale = 0.08838834764831845f;
  bf16_t* sQe = (bf16_t*)smem;
  bf16_t* sKd = sQe + 64 * 136;
  bf16_t* sA = sKd + 64 * 136;
  us4 q4[2][4];
  bf16_t kk[2][4][4];
#pragma unroll
  for (int dt = 0; dt < 2; ++dt)
#pragma unroll
    for (int tt = 0; tt < 4; ++tt) {
      q4[dt][tt] = *(const us4*)(p.Qb + (size_t)(tokc + 16 * tt + c) * 512 + h * 128 + 32 * w + 16 * dt + 4 * g);
#pragma unroll
      for (int j = 0; j < 4; ++j)
        kk[dt][tt][j] = p.Kt[(size_t)(h * 128 + 32 * w + 16 * dt + 4 * g + j) * T_TOK + tokc + 16 * tt + c];
    }
  __syncthreads();
#pragma unroll
  for (int dir = 0; dir < 2; ++dir) {
    bf16_t* QEd = (dir || dry) ? p.QEb : p.Qb;
    bf16_t* KdTd = (dir || dry) ? p.KdTb : p.Kt;
    bf16x8 aup[2];
    float bias[2][4];
#pragma unroll
    for (int dt = 0; dt < 2; ++dt) {
      aup[dt] = zero8();
      if (g < 2) aup[dt] = *(const bf16x8*)(p.AupT + ((size_t)(li * 2 + dir) * 512 + h * 128 + 32 * w + 16 * dt + c) * 32 + 8 * g);
#pragma unroll
      for (int j = 0; j < 4; ++j) bias[dt][j] = p.e_a_bias[(li * 2 + dir) * 512 + h * 128 + 32 * w + 16 * dt + 4 * g + j];
    }
    f32x4 la[2][4];
#pragma unroll
    for (int tt = 0; tt < 4; ++tt) {
      bf16x8 lrf = zero8();
      if (g < 2) lrf = *(const bf16x8*)(p.LRb + (size_t)(tokc + 16 * tt + c) * 32 + dir * 16 + 8 * g);
#pragma unroll
      for (int dt = 0; dt < 2; ++dt) la[dt][tt] = mfma16(aup[dt], lrf, zero4());
    }
#pragma unroll
    for (int dt = 0; dt < 2; ++dt)
#pragma unroll
      for (int tt = 0; tt < 4; ++tt)
#pragma unroll
        for (int j = 0; j < 4; ++j) la[dt][tt][j] = logsig_fast(la[dt][tt][j] + bias[dt][j]) * (1.f / 16.f);
    f32x4 P[2][4];
    float tot[2][4];
#pragma unroll
    for (int dt = 0; dt < 2; ++dt)
#pragma unroll
      for (int j = 0; j < 4; ++j) {
        float carry = 0.f;
#pragma unroll
        for (int tt = 0; tt < 4; ++tt) {
          float v = scan16(la[dt][tt][j], c, lane) + carry;
          P[dt][tt][j] = v;
          carry = bperm(lane | 15, v);
        }
        tot[dt][j] = carry;
      }
#pragma unroll
    for (int dt = 0; dt < 2; ++dt)
#pragma unroll
      for (int tt = 0; tt < 4; ++tt) {
        us4 qo, ko;
#pragma unroll
        for (int j = 0; j < 4; ++j) {
          const float b = (dir == 0) ? P[dt][tt][j] : (tot[dt][j] - P[dt][tt][j] + la[dt][tt][j]);
          qo[j] = f2bf(bf2f(q4[dt][tt][j]) * __expf(b) * qscale);
          ko[j] = f2bf(bf2f(kk[dt][tt][j]) * __expf(-b));
        }
        *(us4*)(QEd + (size_t)(tokc + 16 * tt + c) * 512 + h * 128 + 32 * w + 16 * dt + 4 * g) = qo;
        *(us4*)(sQe + (16 * tt + c) * 136 + 32 * w + 16 * dt + 4 * g) = qo;
        *(us4*)(sKd + (16 * tt + c) * 136 + 32 * w + 16 * dt + 4 * g) = ko;
      }
    if (c == 0) {
#pragma unroll
      for (int dt = 0; dt < 2; ++dt)
#pragma unroll
        for (int j = 0; j < 4; ++j)
          p.EB[(size_t)(dir * 1280 + ci) * 512 + h * 128 + 32 * w + 16 * dt + 4 * g + j] = __expf(tot[dt][j]);
    }
    __syncthreads();
#pragma unroll
    for (int i = 0; i < 4; ++i) {
      const int id = tid + 256 * i;
      const int d = id & 127, c8 = id >> 7;
      bf16x8 v;
#pragma unroll
      for (int e = 0; e < 8; ++e) v[e] = (short)sKd[(8 * c8 + e) * 136 + d];
      *(bf16x8*)(KdTd + (size_t)(h * 128 + d) * T_TOK + tokc + 8 * c8) = v;
    }
    f32x4 accA[4];
#pragma unroll
    for (int jt = 0; jt < 4; ++jt) accA[jt] = zero4();
#pragma unroll
    for (int ks = 0; ks < 4; ++ks) {
      bf16x8 aq = *(const bf16x8*)(sQe + (16 * w + c) * 136 + 32 * ks + 8 * g);
#pragma unroll
      for (int jt = 0; jt < 4; ++jt) {
        bf16x8 bk = *(const bf16x8*)(sKd + (16 * jt + c) * 136 + 32 * ks + 8 * g);
        accA[jt] = mfma16(aq, bk, accA[jt]);
      }
    }
#pragma unroll
    for (int jt = 0; jt < 4; ++jt)
#pragma unroll
      for (int j = 0; j < 4; ++j) {
        const int i = 16 * w + 4 * g + j, jj = 16 * jt + c;
        const bool keep = (dir == 0) ? (jj <= i) : (jj > i);
        sA[dir * 64 * 72 + i * 72 + jj] = f2bf(keep ? accA[jt][j] : 0.f);
      }
    __syncthreads();
  }
  bf16x8 af[2][2];
#pragma unroll
  for (int dir = 0; dir < 2; ++dir)
#pragma unroll
    for (int k2 = 0; k2 < 2; ++k2) af[dir][k2] = *(const bf16x8*)(sA + dir * 64 * 72 + (16 * w + c) * 72 + 32 * k2 + 8 * g);
  bf16_t* sO = (bf16_t*)smem;
#pragma unroll 4
  for (int vt = 0; vt < 16; ++vt) {
    f32x4 a = zero4();
#pragma unroll
    for (int k2 = 0; k2 < 2; ++k2) {
      bf16x8 vfr = *(const bf16x8*)(p.VtE + (size_t)(h * 256 + 16 * vt + c) * T_TOK + tokc + 32 * k2 + 8 * g);
      a = mfma16(af[0][k2], vfr, a);
      a = mfma16(af[1][k2], vfr, a);
    }
#pragma unroll
    for (int j = 0; j < 4; ++j) sO[(16 * w + 4 * g + j) * 264 + 16 * vt + c] = f2bf(a[j]);
  }
  __syncthreads();
#pragma unroll
  for (int i = 0; i < 8; ++i) {
    const int id = tid + 256 * i;
    const int row = id >> 5, c8 = id & 31;
    *(bf16x8*)(p.TMP + (size_t)(tokc + row) * 1024 + h * 256 + 8 * c8) = *(const bf16x8*)(sO + row * 264 + 8 * c8);
  }
}

__device__ __forceinline__ void lds_barrier() { asm volatile("s_waitcnt lgkmcnt(0)\n\ts_barrier" ::: "memory"); }

struct GlaRegs {
  bf16x8 aq[4];
  bf16x8 vf[2][2];
  bf16x8 kf[2][2];
  float eb[2];
  unsigned told[2][4];
};

template <int DIR>
__device__ __forceinline__ void gla_chain_load(const Params& p, int h, int sl, int tokc, int w, int c, int g, GlaRegs& r) {
  const bf16_t* QE = DIR ? p.QEb : p.Qb;
  const bf16_t* KdT = DIR ? p.KdTb : p.Kt;
#pragma unroll
  for (int ks = 0; ks < 4; ++ks) r.aq[ks] = *(const bf16x8*)(QE + (size_t)(tokc + 16 * w + c) * 512 + h * 128 + 32 * ks + 8 * g);
#pragma unroll
  for (int vt = 0; vt < 2; ++vt)
#pragma unroll
    for (int k2 = 0; k2 < 2; ++k2)
      r.vf[vt][k2] = *(const bf16x8*)(p.VtE + (size_t)(h * 256 + sl * 32 + 16 * vt + c) * T_TOK + tokc + 32 * k2 + 8 * g);
#pragma unroll
  for (int dt = 0; dt < 2; ++dt) {
#pragma unroll
    for (int k2 = 0; k2 < 2; ++k2)
      r.kf[dt][k2] = *(const bf16x8*)(KdT + (size_t)(h * 128 + 32 * w + 16 * dt + c) * T_TOK + tokc + 32 * k2 + 8 * g);
    r.eb[dt] = p.EB[(size_t)(DIR * 1280 + (tokc >> 6)) * 512 + h * 128 + 32 * w + 16 * dt + c];
  }
#pragma unroll
  for (int vt = 0; vt < 2; ++vt)
#pragma unroll
    for (int j = 0; j < 4; ++j) r.told[vt][j] = p.TMP[(size_t)(tokc + 16 * w + 4 * g + j) * 1024 + h * 256 + sl * 32 + 16 * vt + c];
}

__device__ __forceinline__ void gla_chain_compute(const Params& p, int h, int sl, int tokc, int w, int c, int g, const GlaRegs& r,
                                                  f32x4 (&S)[2][2], bf16_t* sSt, bool dry, bool reload) {
  unsigned told[2][4];
#pragma unroll
  for (int vt = 0; vt < 2; ++vt)
#pragma unroll
    for (int j = 0; j < 4; ++j) told[vt][j] = r.told[vt][j];
  if (reload) {
#pragma unroll
    for (int vt = 0; vt < 2; ++vt)
#pragma unroll
      for (int j = 0; j < 4; ++j) told[vt][j] = p.TMP[(size_t)(tokc + 16 * w + 4 * g + j) * 1024 + h * 256 + sl * 32 + 16 * vt + c];
  }
#pragma unroll
  for (int vt = 0; vt < 2; ++vt)
#pragma unroll
    for (int dt = 0; dt < 2; ++dt)
#pragma unroll
      for (int j = 0; j < 4; ++j) sSt[(16 * vt + 4 * g + j) * 136 + 32 * w + 16 * dt + c] = f2bf(S[vt][dt][j]);
  lds_barrier();
  f32x4 o[2];
  o[0] = zero4(); o[1] = zero4();
#pragma unroll
  for (int ks = 0; ks < 4; ++ks)
#pragma unroll
    for (int vt = 0; vt < 2; ++vt) {
      bf16x8 sf = *(const bf16x8*)(sSt + (16 * vt + c) * 136 + 32 * ks + 8 * g);
      o[vt] = mfma16(r.aq[ks], sf, o[vt]);
    }
#pragma unroll
  for (int dt = 0; dt < 2; ++dt)
#pragma unroll
    for (int vt = 0; vt < 2; ++vt) {
      f32x4 a = S[vt][dt];
#pragma unroll
      for (int k2 = 0; k2 < 2; ++k2) a = mfma16(r.vf[vt][k2], r.kf[dt][k2], a);
      S[vt][dt] = a * r.eb[dt];
    }
#pragma unroll
  for (int vt = 0; vt < 2; ++vt)
#pragma unroll
    for (int j = 0; j < 4; ++j)
      if (!dry) p.TMP[(size_t)(tokc + 16 * w + 4 * g + j) * 1024 + h * 256 + sl * 32 + 16 * vt + c] = f2bf(bf2f((bf16_t)told[vt][j]) + o[vt][j]);
}

__device__ void gla_chain_item(const Params& p, int li, int item, char* smem, bool dry = false) {
  const int tid = otid(), lane = tid & 63, w = tid >> 6, c = lane & 15, g = lane >> 4;
  const int xr = item >> 3;
  const int pair = (item & 7) + 8 * (xr >> 3), sl = xr & 7;
  const int s = pair < 32 ? 4 + (pair >> 2) : ((pair - 32) >> 2);
  const int h = pair & 3;
  const int tok0 = s < 4 ? s * 4096 : T_P + (s - 4) * 8192;
  const int len = s < 4 ? 4096 : 8192;
  const int N = len / 64;
  bf16_t* sSt0 = (bf16_t*)smem;
  bf16_t* sSt1 = sSt0 + 32 * 136;
  f32x4 Sf[2][2], Sb[2][2];
#pragma unroll
  for (int a = 0; a < 2; ++a)
#pragma unroll
    for (int b = 0; b < 2; ++b) { Sf[a][b] = zero4(); Sb[a][b] = zero4(); }
  GlaRegs rf, rb;
  __syncthreads();
  gla_chain_load<0>(p, h, sl, tok0, w, c, g, rf);
  for (int step = 0; step < N; ++step) {
    const int tf = tok0 + step * 64, tb = tok0 + (N - 1 - step) * 64;
    gla_chain_load<1>(p, h, sl, tb, w, c, g, rb);
    gla_chain_compute(p, h, sl, tf, w, c, g, rf, Sf, sSt0, dry, step == (N >> 1));
    if (step + 1 < N) gla_chain_load<0>(p, h, sl, tf + 64, w, c, g, rf);
    gla_chain_compute(p, h, sl, tb, w, c, g, rb, Sb, sSt1, dry, false);
  }
}

__device__ void pool_item(const Params& p, int li, int item, char* smem, bool dry = false) {
  const int tid = otid(), lane = tid & 63, w = tid >> 6, c = lane & 15, g = lane >> 4;
  const int gi = item & 3;
  const int tile = item >> 2;
  const int tokc = tile * 64;
  const int pos0 = seq_pos(tokc);
  const int len = tokc < T_P ? 4096 : 8192;
  float* sU = (float*)smem;
  bf16_t* sP = (bf16_t*)(sU + 80 * 128);
  __syncthreads();
  for (int idx = tid; idx < 80 * 128; idx += 256) {
    int r = idx >> 7, ch = idx & 127;
    int pos = pos0 - 8 + r;
    float v = 0.f;
    if (pos >= 0 && pos < len) v = bf2f(p.PUb[(long)(tokc - 8 + r) * 512 + gi * 128 + ch]);
    sU[idx] = v;
  }
  __syncthreads();
  {
    const int ch = tid & 127, th = tid >> 7;
    const int half = 1 << gi;
    for (int t = th * 32; t < th * 32 + 32; ++t) {
      int pos = pos0 + t;
      int lo = max(pos - half, 0), hi = min(pos + half, len);
      float s = 0.f;
      for (int q = lo; q < hi; ++q) s += sU[(q - pos0 + 8) * 128 + ch];
      float pooled = s / (float)(hi - lo) - sU[(t + 8) * 128 + ch];
      sP[t * 136 + ch] = f2bf(pooled);
    }
  }
  __syncthreads();
  f32x4 acc[8];
#pragma unroll
  for (int dt = 0; dt < 8; ++dt) acc[dt] = zero4();
  const bf16_t* PW = p.PoolWT + (long)(li * 4 + gi) * 128 * 128;
#pragma unroll
  for (int ks = 0; ks < 4; ++ks) {
    bf16x8 af = *(const bf16x8*)(sP + (16 * w + c) * 136 + 32 * ks + 8 * g);
#pragma unroll
    for (int dt = 0; dt < 8; ++dt) {
      bf16x8 bw = *(const bf16x8*)(PW + (long)(16 * dt + c) * 128 + 32 * ks + 8 * g);
      acc[dt] = mfma16(af, bw, acc[dt]);
    }
  }
#pragma unroll
  for (int dt = 0; dt < 8; ++dt) {
    const int d = gi * 128 + 16 * dt + c;
    const float sc = p.e_pool_scale[li * 512 + d];
#pragma unroll
    for (int j = 0; j < 4; ++j) {
      const long addr = (long)(tokc + 16 * w + 4 * g + j) * 512 + d;
      float gt = bf2f(p.PGb[addr]);
      if (!dry) p.PGb[addr] = f2bf(acc[dt][j] * sc * siluf_(gt));
    }
  }
}

__device__ void ml_intra_item(const Params& p, int li, int item, char* smem) {
  const int tid = otid(), lane = tid & 63, w = tid >> 6, c = lane & 15, g = lane >> 4;
  const int ci = item >> 2, h = item & 3;
  const int tokc = ci * 64;
  const float kscale = 0.08838834764831845f;
  bf16_t* sA = (bf16_t*)smem;
  float* sBv = (float*)(sA + 2 * 64 * 72);
  float* sCB = sBv + 128;
  __syncthreads();
  if (w < 2) {
    const int dir = w;
    const float bi = p.o_if_bias[li * 16 + dir * 4 + h];
    const float bff = p.o_if_bias[li * 16 + 8 + dir * 4 + h];
    const float* mf = p.MIF + (size_t)(tokc + lane) * 16;
    const float liv = mf[dir * 4 + h] + bi;
    const float lfv = logsig_fast(mf[8 + dir * 4 + h] + bff);
    float ps = lfv;
#pragma unroll
    for (int d = 1; d < 64; d <<= 1) {
      float t = bperm(lane - d, ps);
      if (lane >= d) ps += t;
    }
    const float total = __int_as_float(__builtin_amdgcn_readlane(__float_as_int(ps), 63));
    const float b = (dir == 0) ? ps : (total - ps + lfv);
    const float cB = liv - b;
    sBv[dir * 64 + lane] = b;
    sCB[dir * 64 + lane] = cB;
    const size_t so = (size_t)(dir * 4 + h) * T_TOK + tokc + lane;
    p.EBI[so] = __expf(b);
    p.WKg[so] = __expf(total + cB) * kscale;
    if (lane == 0) p.DEC[(dir * 4 + h) * 1280 + ci] = __expf(total);
  }
  f32x4 accA[4];
#pragma unroll
  for (int jt = 0; jt < 4; ++jt) accA[jt] = zero4();
#pragma unroll
  for (int ks = 0; ks < 4; ++ks) {
    bf16x8 aq = *(const bf16x8*)(p.MQb + (size_t)(tokc + 16 * w + c) * 512 + h * 128 + 32 * ks + 8 * g);
#pragma unroll
    for (int jt = 0; jt < 4; ++jt) {
      bf16x8 bk = *(const bf16x8*)(p.MKb + (size_t)(tokc + 16 * jt + c) * 512 + h * 128 + 32 * ks + 8 * g);
      accA[jt] = mfma16(aq, bk, accA[jt]);
    }
  }
  __syncthreads();
#pragma unroll
  for (int dir = 0; dir < 2; ++dir)
#pragma unroll
    for (int jt = 0; jt < 4; ++jt)
#pragma unroll
      for (int j = 0; j < 4; ++j) {
        const int i = 16 * w + 4 * g + j, jj = 16 * jt + c;
        const bool keep = (dir == 0) ? (jj <= i) : (jj > i);
        const float sv = keep ? accA[jt][j] * kscale * __expf(sBv[dir * 64 + i] + sCB[dir * 64 + jj]) : 0.f;
        sA[dir * 64 * 72 + i * 72 + jj] = f2bf(sv);
      }
  __syncthreads();
  bf16x8 ones = zero8();
  if (c == 0) {
#pragma unroll
    for (int e = 0; e < 8; ++e) ones[e] = (short)0x3F80;
  }
#pragma unroll
  for (int dir = 0; dir < 2; ++dir) {
    bf16_t* NUMI = dir ? p.NUMIb : p.NUMIf;
    bf16x8 af[2];
#pragma unroll
    for (int k2 = 0; k2 < 2; ++k2) af[k2] = *(const bf16x8*)(sA + dir * 64 * 72 + (16 * w + c) * 72 + 32 * k2 + 8 * g);
    f32x4 dn = zero4();
    dn = mfma16(af[0], ones, dn);
    dn = mfma16(af[1], ones, dn);
    if (c == 0) {
#pragma unroll
      for (int j = 0; j < 4; ++j) p.DENI[(size_t)(dir * 4 + h) * T_TOK + tokc + 16 * w + 4 * g + j] = dn[j];
    }
    bf16_t* sO = sA + 2 * 64 * 72 + 512;
#pragma unroll 4
    for (int vt = 0; vt < 8; ++vt) {
      f32x4 a = zero4();
#pragma unroll
      for (int k2 = 0; k2 < 2; ++k2) {
        bf16x8 vfr = *(const bf16x8*)(p.MVt + (size_t)(h * 128 + 16 * vt + c) * T_TOK + tokc + 32 * k2 + 8 * g);
        a = mfma16(af[k2], vfr, a);
      }
#pragma unroll
      for (int j = 0; j < 4; ++j) sO[(16 * w + 4 * g + j) * 136 + 16 * vt + c] = f2bf(a[j]);
    }
    __syncthreads();
#pragma unroll
    for (int i = 0; i < 4; ++i) {
      const int id = tid + 256 * i;
      const int row = id >> 4, c8 = id & 15;
      *(bf16x8*)(NUMI + (size_t)(tokc + row) * 512 + h * 128 + 8 * c8) = *(const bf16x8*)(sO + row * 136 + 8 * c8);
    }
    __syncthreads();
  }
}

struct MlRegs {
  bf16x8 aq[4];
  bf16x8 vf[2];
  bf16x8 kf[2][2];
  f32x4 wk[2][2];
  f32x4 ebi, deni;
  float dec;
  unsigned numi[4];
};

template <int DIR>
__device__ __forceinline__ void ml_chain_load(const Params& p, int h, int sl, int tokc, int w, int c, int g, MlRegs& r) {
#pragma unroll
  for (int ks = 0; ks < 4; ++ks) r.aq[ks] = *(const bf16x8*)(p.MQb + (size_t)(tokc + 16 * w + c) * 512 + h * 128 + 32 * ks + 8 * g);
#pragma unroll
  for (int k2 = 0; k2 < 2; ++k2)
    r.vf[k2] = *(const bf16x8*)(p.MVt + (size_t)(h * 128 + sl * 16 + c) * T_TOK + tokc + 32 * k2 + 8 * g);
#pragma unroll
  for (int dt = 0; dt < 2; ++dt)
#pragma unroll
    for (int k2 = 0; k2 < 2; ++k2)
      r.kf[dt][k2] = *(const bf16x8*)(p.MKt + (size_t)(h * 128 + 32 * w + 16 * dt + c) * T_TOK + tokc + 32 * k2 + 8 * g);
  const size_t so = (size_t)(DIR * 4 + h) * T_TOK + tokc;
#pragma unroll
  for (int k2 = 0; k2 < 2; ++k2) {
    r.wk[k2][0] = *(const f32x4*)(p.WKg + so + 32 * k2 + 8 * g);
    r.wk[k2][1] = *(const f32x4*)(p.WKg + so + 32 * k2 + 8 * g + 4);
  }
  r.ebi = *(const f32x4*)(p.EBI + so + 16 * w + 4 * g);
  r.deni = *(const f32x4*)(p.DENI + so + 16 * w + 4 * g);
  r.dec = p.DEC[(DIR * 4 + h) * 1280 + (tokc >> 6)];
  const bf16_t* NUMI = DIR ? p.NUMIb : p.NUMIf;
#pragma unroll
  for (int j = 0; j < 4; ++j) r.numi[j] = NUMI[(size_t)(tokc + 16 * w + 4 * g + j) * 512 + h * 128 + sl * 16 + c];
}

template <int DIR>
__device__ __forceinline__ void ml_chain_compute(const Params& p, int h, int sl, int tokc, int lane, int w, int c, int g, const MlRegs& r,
                                                 f32x4 (&C)[2][2], bf16_t* sCt, bool dry) {
  bf16_t* NUMI = DIR ? p.NUMIb : p.NUMIf;
  unsigned numi[4];
#pragma unroll
  for (int j = 0; j < 4; ++j) numi[j] = r.numi[j];
#pragma unroll
  for (int vt = 0; vt < 2; ++vt)
#pragma unroll
    for (int dt = 0; dt < 2; ++dt)
#pragma unroll
      for (int j = 0; j < 4; ++j) sCt[(16 * vt + 4 * g + j) * 136 + 32 * w + 16 * dt + c] = f2bf(C[vt][dt][j]);
  bf16x8 vfw[2][2];
#pragma unroll
  for (int k2 = 0; k2 < 2; ++k2) {
    float wv[8];
#pragma unroll
    for (int e = 0; e < 4; ++e) { wv[e] = r.wk[k2][0][e]; wv[4 + e] = r.wk[k2][1][e]; }
#pragma unroll
    for (int e = 0; e < 8; ++e) vfw[0][k2][e] = (short)f2bf(bf2f((bf16_t)r.vf[k2][e]) * wv[e]);
#pragma unroll
    for (int e = 0; e < 8; ++e) vfw[1][k2][e] = (c == 0) ? (short)f2bf(wv[e]) : (short)0;
  }
  lds_barrier();
  f32x4 o2[2];
  o2[0] = zero4(); o2[1] = zero4();
#pragma unroll
  for (int ks = 0; ks < 4; ++ks)
#pragma unroll
    for (int vt = 0; vt < 2; ++vt) {
      bf16x8 cf = *(const bf16x8*)(sCt + (16 * vt + c) * 136 + 32 * ks + 8 * g);
      o2[vt] = mfma16(r.aq[ks], cf, o2[vt]);
    }
#pragma unroll
  for (int dt = 0; dt < 2; ++dt)
#pragma unroll
    for (int vt = 0; vt < 2; ++vt) {
      f32x4 a = C[vt][dt] * r.dec;
#pragma unroll
      for (int k2 = 0; k2 < 2; ++k2) a = mfma16(vfw[vt][k2], r.kf[dt][k2], a);
      C[vt][dt] = a;
    }
#pragma unroll
  for (int j = 0; j < 4; ++j) {
    const float e = r.ebi[j];
    float den = e * o2[1][j];
    den = bperm(lane & 48, den) + r.deni[j];
    const float inv = 1.f / fmaxf(fabsf(den), 1.f);
    const float hv = (bf2f((bf16_t)numi[j]) + e * o2[0][j]) * inv;
    if (!dry) NUMI[(size_t)(tokc + 16 * w + 4 * g + j) * 512 + h * 128 + sl * 16 + c] = f2bf(hv);
  }
}

__device__ void ml_chain_item(const Params& p, int li, int item, char* smem, bool dry = false) {
  const int tid = otid(), lane = tid & 63, w = tid >> 6, c = lane & 15, g = lane >> 4;
  const int xr = item >> 3;
  const int pair = (item & 7) + 8 * (xr >> 3), sl = xr & 7;
  const int s = pair < 32 ? 4 + (pair >> 2) : ((pair - 32) >> 2);
  const int h = pair & 3;
  const int tok0 = s < 4 ? s * 4096 : T_P + (s - 4) * 8192;
  const int len = s < 4 ? 4096 : 8192;
  const int N = len / 64;
  bf16_t* sCt0 = (bf16_t*)smem;
  bf16_t* sCt1 = sCt0 + 32 * 136;
  f32x4 Cf[2][2], Cb[2][2];
#pragma unroll
  for (int a = 0; a < 2; ++a)
#pragma unroll
    for (int b = 0; b < 2; ++b) { Cf[a][b] = zero4(); Cb[a][b] = zero4(); }
  MlRegs rf, rb;
  __syncthreads();
  ml_chain_load<0>(p, h, sl, tok0, w, c, g, rf);
  for (int step = 0; step < N; ++step) {
    const int tf = tok0 + step * 64, tb = tok0 + (N - 1 - step) * 64;
    ml_chain_load<1>(p, h, sl, tb, w, c, g, rb);
    ml_chain_compute<0>(p, h, sl, tf, lane, w, c, g, rf, Cf, sCt0, dry);
    if (step + 1 < N) ml_chain_load<0>(p, h, sl, tf + 64, w, c, g, rf);
    ml_chain_compute<1>(p, h, sl, tb, lane, w, c, g, rb, Cb, sCt1, dry);
  }
}

#define ATTN_GLOAD(KT)                                                                              \
  {                                                                                                 \
    const long kb = tok0 + (KT) * 64;                                                               \
    rk0 = *(const bf16x8*)(p.KNb + (kb + (tid >> 3)) * 512 + head * 64 + 8 * (tid & 7));            \
    rk1 = *(const bf16x8*)(p.KNb + (kb + 32 + (tid >> 3)) * 512 + head * 64 + 8 * (tid & 7));       \
    rkr = *(const bf16x8*)(p.KRb + (kb + (tid >> 2)) * 32 + 8 * (tid & 3));                          \
    rv0 = *(const bf16x8*)(p.VtA + (long)(head * 64 + (tid >> 3)) * T_TOK + kb + 8 * (tid & 7));     \
    rv1 = *(const bf16x8*)(p.VtA + (long)(head * 64 + 32 + (tid >> 3)) * T_TOK + kb + 8 * (tid & 7)); \
  }
__device__ void attn_item(const Params& p, int item, char* smem, bool dry = false) {
  const int tid = otid(), lane = tid & 63, w = tid >> 6, c = lane & 15, g = lane >> 4;
  int s, head, qb;
  {
    const int x = item / 320, t = item % 320;
    if (t < 256) { const int pair = x + 8 * (t >> 5); qb = t & 31; s = 4 + (pair >> 3); head = pair & 7; }
    else { const int t2 = t - 256; const int pair = x + 8 * (t2 >> 4); qb = t2 & 15; s = pair >> 3; head = pair & 7; }
  }
  const int tok0 = s < 4 ? s * 4096 : T_P + (s - 4) * 8192;
  const int len = s < 4 ? 4096 : 8192;
  const int nkv = len / 64;
  bf16_t* sK = (bf16_t*)smem;
  bf16_t* sVt = sK + 64 * 104;
  const int qrow0 = tok0 + qb * 256 + 64 * w;
  bf16_t* sQr = sVt + 64 * 72;
  bf16x8 qf[4][2];
#pragma unroll
  for (int nt = 0; nt < 4; ++nt) {
#pragma unroll
    for (int ks = 0; ks < 2; ++ks)
      qf[nt][ks] = *(const bf16x8*)(p.Qa + (long)(qrow0 + 16 * nt + c) * 768 + head * 96 + 32 * ks + 8 * g);
    bf16x8 qr = *(const bf16x8*)(p.Qa + (long)(qrow0 + 16 * nt + c) * 768 + head * 96 + 64 + 8 * g);
    *(bf16x8*)(sQr + ((w * 4 + nt) * 64 + lane) * 8) = qr;
  }
  f32x4 ot[4][4];
#pragma unroll
  for (int vt = 0; vt < 4; ++vt)
#pragma unroll
    for (int nt = 0; nt < 4; ++nt) ot[vt][nt] = zero4();
  float mrun[4] = {-1e30f, -1e30f, -1e30f, -1e30f}, lrun[4] = {0.f, 0.f, 0.f, 0.f};
  bf16x8 rk0, rk1, rkr, rv0, rv1;
  ATTN_GLOAD(0)
  for (int kt = 0; kt < nkv; ++kt) {
    __syncthreads();
    *(bf16x8*)(sK + (tid >> 3) * 104 + 8 * (tid & 7)) = rk0;
    *(bf16x8*)(sK + (32 + (tid >> 3)) * 104 + 8 * (tid & 7)) = rk1;
    *(bf16x8*)(sK + (tid >> 2) * 104 + 64 + 8 * (tid & 3)) = rkr;
    *(bf16x8*)(sVt + (tid >> 3) * 72 + 8 * (tid & 7)) = rv0;
    *(bf16x8*)(sVt + (32 + (tid >> 3)) * 72 + 8 * (tid & 7)) = rv1;
    __syncthreads();
    if (kt + 1 < nkv) ATTN_GLOAD(kt + 1)
#pragma unroll 1
    for (int half = 0; half < 2; ++half) {
      f32x4 st[2][4];
#pragma unroll
      for (int k4 = 0; k4 < 2; ++k4)
#pragma unroll
        for (int nt = 0; nt < 4; ++nt) st[k4][nt] = zero4();
#pragma unroll
      for (int ks = 0; ks < 2; ++ks)
#pragma unroll
        for (int k4 = 0; k4 < 2; ++k4) {
          bf16x8 kf = *(const bf16x8*)(sK + (32 * half + 16 * k4 + c) * 104 + 32 * ks + 8 * g);
#pragma unroll
          for (int nt = 0; nt < 4; ++nt) st[k4][nt] = mfma16(kf, qf[nt][ks], st[k4][nt]);
        }
      {
        bf16x8 kr0 = *(const bf16x8*)(sK + (32 * half + c) * 104 + 64 + 8 * g);
        bf16x8 kr1 = *(const bf16x8*)(sK + (32 * half + 16 + c) * 104 + 64 + 8 * g);
#pragma unroll
        for (int nt = 0; nt < 4; ++nt) {
          bf16x8 qr = *(const bf16x8*)(sQr + ((w * 4 + nt) * 64 + lane) * 8);
          st[0][nt] = mfma16(kr0, qr, st[0][nt]);
          st[1][nt] = mfma16(kr1, qr, st[1][nt]);
        }
      }
      __builtin_amdgcn_sched_barrier(0);
      bf16x8 pb[4];
#pragma unroll
      for (int nt = 0; nt < 4; ++nt) {
        float mx = -1e30f;
#pragma unroll
        for (int k4 = 0; k4 < 2; ++k4)
#pragma unroll
          for (int j = 0; j < 4; ++j) mx = fmaxf(mx, st[k4][nt][j]);
        mx = rowmax4(mx);
        const float mn = fmaxf(mrun[nt], mx);
        const float alpha = __builtin_amdgcn_exp2f(mrun[nt] - mn);
        mrun[nt] = mn;
        float psum = 0.f;
#pragma unroll
        for (int k4 = 0; k4 < 2; ++k4)
#pragma unroll
          for (int j = 0; j < 4; ++j) {
            float pv = __builtin_amdgcn_exp2f(st[k4][nt][j] - mn);
            st[k4][nt][j] = pv;
            psum += pv;
          }
        lrun[nt] = lrun[nt] * alpha + psum;
#pragma unroll
        for (int vt = 0; vt < 4; ++vt) ot[vt][nt] = ot[vt][nt] * alpha;
        typedef __attribute__((ext_vector_type(4))) unsigned u32x4;
        u32x4 pk;
        pk[0] = pk2bf(st[0][nt][0], st[0][nt][1]);
        pk[1] = pk2bf(st[0][nt][2], st[0][nt][3]);
        pk[2] = pk2bf(st[1][nt][0], st[1][nt][1]);
        pk[3] = pk2bf(st[1][nt][2], st[1][nt][3]);
        pb[nt] = __builtin_bit_cast(bf16x8, pk);
      }
      __builtin_amdgcn_sched_barrier(0);
#pragma unroll
      for (int vt = 0; vt < 4; ++vt) {
        us4 lo = *(const us4*)(sVt + (16 * vt + c) * 72 + 32 * half + 4 * g);
        us4 hi = *(const us4*)(sVt + (16 * vt + c) * 72 + 32 * half + 16 + 4 * g);
        bf16x8 av;
#pragma unroll
        for (int e = 0; e < 4; ++e) { av[e] = (short)lo[e]; av[4 + e] = (short)hi[e]; }
#pragma unroll
        for (int nt = 0; nt < 4; ++nt) ot[vt][nt] = mfma16(av, pb[nt], ot[vt][nt]);
      }
    }
  }
#pragma unroll
  for (int nt = 0; nt < 4; ++nt) {
    float lt = lrun[nt];
    lt += sxor(lt, 16, lane);
    lt += sxor(lt, 32, lane);
    const float inv = 1.f / lt;
    const long tok = qrow0 + 16 * nt + c;
#pragma unroll
    for (int vt = 0; vt < 4; ++vt) {
      bf16_t* gp = p.MGb + tok * 512 + head * 64 + 16 * vt + 4 * g;
      us4 gt = *(const us4*)gp;
      us4 o;
#pragma unroll
      for (int j = 0; j < 4; ++j) o[j] = f2bf(ot[vt][nt][j] * inv * siluf_(bf2f(gt[j])));
      if (!dry) *(us4*)gp = o;
    }
  }
}

__device__ void phase_gla_combine(const Params& p, int li, bool dry = false) {
  const int tid_ = otid(); const int lane = tid_ & 63, w = tid_ >> 6;
  for (int tok = blockIdx.x * 4 + w; tok < T_TOK; tok += gridDim.x * 4) {
    const bf16_t* tp = p.TMP + (long)tok * 1024 + 16 * lane;
    bf16_t* gp = p.Gb + (long)tok * 1024 + 16 * lane;
    bf16x8 o0 = *(const bf16x8*)tp, o1 = *(const bf16x8*)(tp + 8);
    bf16x8 g0 = *(const bf16x8*)gp, g1 = *(const bf16x8*)(gp + 8);
    float ov[16], gv[16];
#pragma unroll
    for (int e = 0; e < 8; ++e) {
      ov[e] = bf2f((bf16_t)o0[e]); ov[8 + e] = bf2f((bf16_t)o1[e]);
      gv[e] = bf2f((bf16_t)g0[e]); gv[8 + e] = bf2f((bf16_t)g1[e]);
    }
    float ss = 0.f;
#pragma unroll
    for (int e = 0; e < 16; ++e) ss += ov[e] * ov[e];
    ss += sxor(ss, 1, lane); ss += sxor(ss, 2, lane); ss += sxor(ss, 4, lane); ss += sxor(ss, 8, lane);
    const float rs = rsqrtf(ss * (1.f / 256.f) + EPS);
    const float* ng = p.e_gla_norm_g + li * 256 + ((16 * lane) & 255);
    bf16x8 r0, r1;
#pragma unroll
    for (int e = 0; e < 8; ++e) {
      r0[e] = (short)f2bf(ov[e] * rs * ng[e] * siluf_(gv[e]));
      r1[e] = (short)f2bf(ov[8 + e] * rs * ng[8 + e] * siluf_(gv[8 + e]));
    }
    if (!dry) { *(bf16x8*)gp = r0;
    *(bf16x8*)(gp + 8) = r1; }
  }
}

__device__ void phase_ml_combine(const Params& p, int li, bool dry = false) {
  const int tid_ = otid(); const int lane = tid_ & 63, w = tid_ >> 6;
  for (int tok = blockIdx.x * 4 + w; tok < T_TOK; tok += gridDim.x * 4) {
    const long off = (long)tok * 512 + 8 * lane;
    bf16x8 hv = *(const bf16x8*)(p.NUMIf + off);
    bf16x8 hb = *(const bf16x8*)(p.NUMIb + off);
    bf16x8 mo = *(const bf16x8*)(p.MOb + off);
    bf16x8 mg = *(const bf16x8*)(p.MLGb + off);
    float hf[8];
    float ss = 0.f;
#pragma unroll
    for (int e = 0; e < 8; ++e) { hf[e] = bf2f((bf16_t)hv[e]) + bf2f((bf16_t)hb[e]); ss += hf[e] * hf[e]; }
    ss += sxor(ss, 1, lane); ss += sxor(ss, 2, lane); ss += sxor(ss, 4, lane); ss += sxor(ss, 8, lane);
    const float rs = rsqrtf(ss * (1.f / 128.f) + EPS);
    const float* ng = p.o_ml_norm_g + li * 128 + ((8 * lane) & 127);
    bf16x8 r;
#pragma unroll
    for (int e = 0; e < 8; ++e)
      r[e] = (short)f2bf(hf[e] * rs * ng[e] * sigmoidf_(bf2f((bf16_t)mo[e])) * siluf_(bf2f((bf16_t)mg[e])));
    if (!dry) *(bf16x8*)(p.MLGb + off) = r;
  }
}

__device__ void phase_final(const Params& p, bool dry = false) {
  const int tid_ = otid(); const int lane = tid_ & 63, w = tid_ >> 6;
  for (int tok = blockIdx.x * 4 + w; tok < T_TOK; tok += gridDim.x * 4) {
    float* xp = p.out + (long)tok * DM;
    float4 v[4];
    float ss = 0.f;
#pragma unroll
    for (int i = 0; i < 4; ++i) {
      v[i] = *(const float4*)(xp + 4 * lane + 256 * i);
      ss += v[i].x * v[i].x + v[i].y * v[i].y + v[i].z * v[i].z + v[i].w * v[i].w;
    }
#pragma unroll
    for (int d = 1; d < 64; d <<= 1) ss += sxor(ss, d, lane);
    const float rs = rsqrtf(ss * (1.f / 1024.f) + EPS);
#pragma unroll
    for (int i = 0; i < 4; ++i) {
      float4 gq = *(const float4*)(p.final_norm_g + 4 * lane + 256 * i);
      float4 o;
      o.x = v[i].x * rs * gq.x; o.y = v[i].y * rs * gq.y; o.z = v[i].z * rs * gq.z; o.w = v[i].w * rs * gq.w;
      if (!dry) *(float4*)(xp + 4 * lane + 256 * i) = o;
    }
  }
}

__device__ void run_phase(const Params& p, int ph, char* smem) {
  if (ph == 0) { if (PH_ON(0)) phase_prep(p, smem); return; }
  if (ph == NPHASE - 1) { if (PROBE_B) phase_final(p, true); if (PH_ON(11)) phase_final(p); return; }
  const int q = ph - 1;
  const int layer = (q < 5) ? 0 : (q < 12) ? 1 : (q < 17) ? 2 : 3;
  const int sub = (q < 5) ? q : (q < 12) ? q - 5 : (q < 17) ? q - 12 : q - 17;
  const int li = layer >> 1;
  const float* xa = (layer == 0) ? p.x_prompt : p.out;
  const float* xb = (layer == 0) ? p.x_sample : p.out + (long)T_P * DM;
  if ((layer & 1) == 0) {
    if (sub == 0) {
      EpiEvenIn e{p.Qb, p.Kt, p.VtE, p.Gb, p.LRb, p.PUb, p.PGb};
      if (PH_ON(1)) gemm_phase<3, 8>(T_TOK / 128, NE_PAD / 256, DM, p.WinE + (long)li * NE_PAD * DM, p.SSQ, nullptr, p.TMP, DM, DM, p.TMP, DM, e, smem);
    } else if (sub == 1) {
      for (int item = blockIdx.x; item < 5120; item += gridDim.x)
        if (PH_ON(2)) gla_intra_item(p, li, item, smem);
    } else if (sub == 2) {
      __shared__ int s_pitem;
      if ((int)blockIdx.x < 384) { if (PH_ON(2)) gla_chain_item(p, li, blockIdx.x, smem, false); }
      for (;;) {
        __syncthreads();
        if (threadIdx.x == 0) s_pitem = atomicAdd(p.counters + 16 + li, 1);
        __syncthreads();
        const int item = s_pitem;
        if (item >= 5120) break;
        if (PH_ON(3)) pool_item(p, li, item, smem);
      }
    } else if (sub == 3) {
      if (PROBE_B) phase_gla_combine(p, li, true);
      if (PH_ON(4)) phase_gla_combine(p, li);
    } else {
      EpiOut e{xa, xb, p.out, false, p.NUMIf, p.SSQ};
      if (PH_ON(5)) gemm_phase<1, 8>(T_TOK / 128, DM / 256, 1536, p.WoutE + (long)li * DM * 1536, nullptr, nullptr, p.Gb, 1024, 1024, p.PGb, 512, e, smem);
    }
  } else {
    if (sub == 0) {
      EpiOddIn e{p.CQb, p.CKVb, p.KRb, p.MGb, p.MQb, p.MKb, p.MKt, p.MVt, p.MOb, p.MLGb, p.MIF};
      if (PH_ON(6)) gemm_phase<3, 8>(T_TOK / 128, NO_PAD / 256, DM, p.WinO + (long)li * NO_PAD * DM, p.SSQ, nullptr, p.NUMIf, DM, DM, p.NUMIf, DM, e, smem);
    } else if (sub == 1) {
      for (int rep = 0; rep < 1 + PROBE_A; ++rep)
      for (int item = blockIdx.x; item < 5120; item += gridDim.x)
        if (PH_ON(8)) ml_intra_item(p, li, item, smem);
    } else if (sub == 2) {
      for (int rep = PROBE_MLCHAIN ? 0 : 1; rep < 2; ++rep)
      for (int item = blockIdx.x; item < 384; item += gridDim.x)
        if (PH_ON(8)) ml_chain_item(p, li, item, smem, rep == 0);
    } else if (sub == 3) {
      if (PROBE_B) phase_ml_combine(p, li, true);
      if (PH_ON(10)) phase_ml_combine(p, li);
    } else if (sub == 4) {
      EpiQUp eq{p.Qa};
      if (PH_ON(7)) gemm_phase<2, 4>(T_TOK / 128, 768 / 128, 384, p.QupT + (long)li * 768 * 384, nullptr, nullptr, p.CQb, 384, 384, p.CQb, 384, eq, smem);
      EpiKVUp ek{p.KNb, p.VtA};
      if (PH_ON(7)) gemm_phase<2, 4>(T_TOK / 128, 1024 / 128, 256, p.KVupT + (long)li * 1024 * 256, nullptr, nullptr, p.CKVb, 256, 256, p.CKVb, 256, ek, smem);
    } else if (sub == 5) {
      __shared__ int s_item;
      for (;;) {
        __syncthreads();
        if (threadIdx.x == 0) s_item = atomicAdd(p.counters + li * 8 + (blockIdx.x & 7), 1);
        __syncthreads();
        const int item = s_item;
        if (item >= 320) break;
        if (PH_ON(9)) attn_item(p, (blockIdx.x & 7) * 320 + item, smem);
      }
    } else {
      EpiOut e{xa, xb, p.out, false, (layer == 3) ? nullptr : p.TMP, p.SSQ};
      if (PH_ON(5)) gemm_phase<1, 8>(T_TOK / 128, DM / 256, 1024, p.WoutO + (long)li * DM * 1024, nullptr, nullptr, p.MGb, 512, 512, p.MLGb, 512, e, smem);
    }
  }
}

__global__ void __launch_bounds__(256, 2) mega_kernel(Params p) {
  extern __shared__ __attribute__((aligned(16))) char smem[];
  cg::grid_group grid = cg::this_grid();
  __shared__ uint4 xb_words;
  if (threadIdx.x == 0) xb_words = make_uint4(0u, 0u, 0u, 0u);
  __syncthreads();
  XcdBarrier xb = xcd_barrier_post(p.bar, (volatile LAS unsigned*)&xb_words);
  for (int ph = p.ph_lo; ph < p.ph_hi; ++ph) {
    if (ph > p.ph_lo) {
      if (ph == p.ph_lo + 1) grid.sync();
      else xcd_barrier(xb);
    }
    run_phase(p, ph, smem);
  }
}

extern "C" void kernel_launch(void* const* d_in, const int* in_sizes, int n_in, void* d_out, int out_size, void* d_ws,
                              size_t ws_size, hipStream_t stream) {
  static int grid_blocks = 0;
  if (!grid_blocks) {
    int dev = 0, cus = 0, per_cu = 0;
    hipGetDevice(&dev);
    hipDeviceGetAttribute(&cus, hipDeviceAttributeMultiprocessorCount, dev);
    hipFuncSetAttribute((const void*)mega_kernel, hipFuncAttributeMaxDynamicSharedMemorySize, LDS_BYTES);
    hipOccupancyMaxActiveBlocksPerMultiprocessor(&per_cu, (const void*)mega_kernel, 256, LDS_BYTES);
    if (per_cu < 1) per_cu = 1;
    if (per_cu > 2) per_cu = 2;
    grid_blocks = cus * per_cu;
    fprintf(stderr, "kernel_launch: cus %d per_cu %d grid %d ws %zu\n", cus, per_cu, grid_blocks, ws_size);
  }
  Params p{};
  const float** pin = (const float**)&p;
  for (int i = 0; i < 19; ++i) pin[i] = (const float*)d_in[i];
  p.out = (float*)d_out;
  char* ws = (char*)d_ws;
  size_t off = 0;
  auto take = [&](size_t bytes) { char* r = ws + off; off += (bytes + 255) & ~(size_t)255; return r; };
  p.WinE = (bf16_t*)take((size_t)2 * NE_PAD * DM * 2);
  p.WinO = (bf16_t*)take((size_t)2 * NO_PAD * DM * 2);
  p.WoutE = (bf16_t*)take((size_t)2 * DM * 1536 * 2);
  p.WoutO = (bf16_t*)take((size_t)2 * DM * 1024 * 2);
  p.QupT = (bf16_t*)take((size_t)2 * 768 * 384 * 2);
  p.KVupT = (bf16_t*)take((size_t)2 * 1024 * 256 * 2);
  p.PoolWT = (bf16_t*)take((size_t)2 * 4 * 128 * 128 * 2);
  p.AupT = (bf16_t*)take((size_t)2 * 2 * 512 * 32 * 2);
  p.counters = (int*)take(256);
  p.bar = (unsigned*)take((size_t)XCD_BAR_WORDS * 4);
  p.SSQ = (float*)take((size_t)T_TOK * 8 * 4);
  const size_t act0 = off;
  const size_t T = T_TOK;
  p.Gb = (bf16_t*)take(T * 1024 * 2);
  p.PGb = (bf16_t*)take(T * 512 * 2);
  p.Qb = (bf16_t*)take(T * 512 * 2);
  p.Kt = (bf16_t*)take(T * 512 * 2);
  p.QEb = (bf16_t*)take(T * 512 * 2);
  p.KdTb = (bf16_t*)take(T * 512 * 2);
  p.EB = (float*)take((size_t)2 * 1280 * 512 * 4);
  p.VtE = (bf16_t*)take(T * 1024 * 2);
  p.LRb = (bf16_t*)take(T * 32 * 2);
  p.PUb = (bf16_t*)take(T * 512 * 2);
  p.TMP = (bf16_t*)take(T * 1024 * 2);
  const size_t even_end = off;
  off = act0;
  p.MGb = (bf16_t*)take(T * 512 * 2);
  p.MLGb = (bf16_t*)take(T * 512 * 2);
  p.CQb = (bf16_t*)take(T * 384 * 2);
  p.CKVb = (bf16_t*)take(T * 256 * 2);
  p.KRb = (bf16_t*)take(T * 32 * 2);
  const size_t r2 = off;
  p.MQb = (bf16_t*)take(T * 512 * 2);
  p.MKb = (bf16_t*)take(T * 512 * 2);
  p.MKt = (bf16_t*)take(T * 512 * 2);
  p.MVt = (bf16_t*)take(T * 512 * 2);
  p.MOb = (bf16_t*)take(T * 512 * 2);
  p.NUMIf = (bf16_t*)take(T * 512 * 2);
  p.NUMIb = (bf16_t*)take(T * 512 * 2);
  p.MIF = (float*)take(T * 16 * 4);
  p.EBI = (float*)take(T * 8 * 4);
  p.WKg = (float*)take(T * 8 * 4);
  p.DENI = (float*)take(T * 8 * 4);
  p.DEC = (float*)take((size_t)8 * 1280 * 4);
  const size_t r2_end = off;
  off = r2;
  p.Qa = (bf16_t*)take(T * 768 * 2);
  p.KNb = (bf16_t*)take(T * 512 * 2);
  p.VtA = (bf16_t*)take(T * 512 * 2);
  if (off < r2_end) off = r2_end;
  const size_t odd_end = off;
  const size_t need = even_end > odd_end ? even_end : odd_end;
  if (need > ws_size) {
    fprintf(stderr, "kernel_launch: workspace too small: need %zu have %zu\n", need, ws_size);
    return;
  }
  hipMemsetAsync(p.bar, 0, (size_t)XCD_BAR_WORDS * 4, stream);
#if SINGLE_LAUNCH
  p.ph_lo = 0;
  p.ph_hi = NPHASE;
  void* args[] = {&p};
  hipError_t e = hipLaunchCooperativeKernel((const void*)mega_kernel, dim3(grid_blocks), dim3(256), args, LDS_BYTES, stream);
  if (e != hipSuccess) fprintf(stderr, "cooperative launch failed: %s (grid %d)\n", hipGetErrorString(e), grid_blocks);
#else
  for (int ph = 0; ph < NPHASE; ++ph) {
    p.ph_lo = ph;
    p.ph_hi = ph + 1;
    hipLaunchKernelGGL(mega_kernel, dim3(grid_blocks), dim3(256), LDS_BYTES, stream, p);
  }
#endif
}
```

```cpp
#include <hip/hip_runtime.h>
#include <hip/hip_cooperative_groups.h>
#include <cstdio>
namespace cg = cooperative_groups;

#ifndef SINGLE_LAUNCH
#define SINGLE_LAUNCH 1
#endif
#ifndef PHMASK
#define PHMASK 0xFFFF
#endif
#define PH_ON(b) ((PHMASK >> (b)) & 1)
#ifndef PROBE_GEMM
#define PROBE_GEMM 0
#endif
#ifndef PROBE_ATTN
#define PROBE_ATTN 0
#endif
#ifndef PROBE_CHAIN
#define PROBE_CHAIN 0
#endif
#ifndef PROBE_A
#define PROBE_A 0
#endif
#ifndef PROBE_B
#define PROBE_B 0
#endif
#ifndef PROBE_MLCHAIN
#define PROBE_MLCHAIN 0
#endif

typedef unsigned short bf16_t;
typedef __attribute__((ext_vector_type(8))) short bf16x8;
typedef __attribute__((ext_vector_type(4))) float f32x4;
typedef __attribute__((ext_vector_type(4))) unsigned short us4;

constexpr int T_TOK = 81920;
constexpr int T_P = 16384;
constexpr int DM = 1024;
constexpr int NE = 4128, NE_PAD = 4352;
constexpr int NO = 4272, NO_PAD = 4352;
constexpr float EPS = 1e-6f;
constexpr int NPHASE = 26;
constexpr int LDS_BYTES = 72 * 1024;

struct Params {
  const float *x_prompt, *x_sample, *norm_g, *final_norm_g, *e_w_in, *e_a_up, *e_a_bias, *e_gla_norm_g,
      *e_pool_w, *e_pool_scale, *e_w_out, *o_w_in, *o_q_norm_g, *o_q_up, *o_kv_norm_g, *o_kv_up, *o_if_bias,
      *o_ml_norm_g, *o_w_out;
  float* out;
  bf16_t *WinE, *WinO, *WoutE, *WoutO, *QupT, *KVupT, *PoolWT, *AupT;
  int* counters;
  unsigned* bar;
  float* SSQ;
  bf16_t *Qb, *Kt, *VtE, *Gb, *LRb, *PUb, *PGb, *TMP, *QEb, *KdTb;
  float* EB;
  bf16_t *CQb, *CKVb, *KRb, *MGb, *MQb, *MKb, *MKt, *MVt, *MOb, *MLGb, *NUMIf, *NUMIb, *Qa, *KNb, *VtA;
  float *MIF, *EBI, *WKg, *DENI, *DEC;
  int ph_lo, ph_hi;
};

typedef __bf16 hbf2 __attribute__((ext_vector_type(2)));
typedef float hf2 __attribute__((ext_vector_type(2)));
__device__ __forceinline__ bf16_t f2bf(float f) {
  __bf16 b = (__bf16)f;
  return __builtin_bit_cast(bf16_t, b);
}
__device__ __forceinline__ unsigned pk2bf(float a, float b) {
  hf2 v = {a, b};
  hbf2 r = __builtin_convertvector(v, hbf2);
  return __builtin_bit_cast(unsigned, r);
}
__device__ __forceinline__ float bf2f(bf16_t b) { return __uint_as_float(((unsigned)b) << 16); }
__device__ __forceinline__ f32x4 mfma16(bf16x8 a, bf16x8 b, f32x4 c) {
  return __builtin_amdgcn_mfma_f32_16x16x32_bf16(a, b, c, 0, 0, 0);
}
__device__ __forceinline__ float logsigmoidf_(float x) { return fminf(x, 0.f) - log1pf(__expf(-fabsf(x))); }
__device__ __forceinline__ float siluf_(float x) { return x / (1.f + __expf(-x)); }
__device__ __forceinline__ float sigmoidf_(float x) { return 1.f / (1.f + __expf(-x)); }
__device__ __forceinline__ int otid() { int t = threadIdx.x; asm volatile("" : "+v"(t)); return t; }
__device__ __forceinline__ float bperm(int srclane, float v) { return __int_as_float(__builtin_amdgcn_ds_bpermute(srclane << 2, __float_as_int(v))); }
__device__ __forceinline__ float sxor(float v, int m, int lane) { return bperm(lane ^ m, v); }
typedef unsigned u32x2_t __attribute__((ext_vector_type(2)));
__device__ __forceinline__ float rowmax4(float v) {
  u32x2_t r = __builtin_amdgcn_permlane16_swap(__float_as_uint(v), __float_as_uint(v), false, false);
  v = fmaxf(__uint_as_float(r[0]), __uint_as_float(r[1]));
  r = __builtin_amdgcn_permlane32_swap(__float_as_uint(v), __float_as_uint(v), false, false);
  return fmaxf(__uint_as_float(r[0]), __uint_as_float(r[1]));
}
__device__ __forceinline__ bf16x8 zero8() { bf16x8 z = {0, 0, 0, 0, 0, 0, 0, 0}; return z; }
__device__ __forceinline__ f32x4 zero4() { f32x4 z = {0.f, 0.f, 0.f, 0.f}; return z; }

__device__ __forceinline__ int seq_pos(int tok) { return tok < T_P ? (tok & 4095) : ((tok - T_P) & 8191); }
__device__ __forceinline__ const float* xrow(const float* xa, const float* xb, int tok) {
  return tok < T_P ? xa + (long)tok * DM : xb + (long)(tok - T_P) * DM;
}


#define XB_TMO      128
#define XB_XCNT(j)  (256  + 64 * (j))
#define XB_XSUB(j)  (1280 + 64 * (j))
#define XB_XGEN(j)  (2304 + 64 * (j))
#define XB_TOP      3328
#define XB_TOPGEN   3392
#define XCD_BAR_WORDS 3456
#define XB_SPIN_CAP (1u << 22)
#define LAS __attribute__((address_space(3)))
__device__ __forceinline__ unsigned xb_ld(unsigned* p) { return __hip_atomic_load(p, __ATOMIC_RELAXED, __HIP_MEMORY_SCOPE_AGENT); }
__device__ __forceinline__ unsigned xb_add(unsigned* p, unsigned v) { return __hip_atomic_fetch_add(p, v, __ATOMIC_RELAXED, __HIP_MEMORY_SCOPE_AGENT); }
__device__ __forceinline__ unsigned xb_xcc_id() { return (unsigned)__builtin_amdgcn_s_getreg((3 << 11) | 20) & 0xFu; }
#define XB_SPIN(cond, bar) do { unsigned _sp = 0; while (cond) { __builtin_amdgcn_s_sleep(1); \
    if ((++_sp & 255u) == 0u) { if (xb_ld(&(bar)[XB_TMO])) break; if (_sp > XB_SPIN_CAP) { atomicAdd(&(bar)[XB_TMO], 1u); break; } } } } while (0)
struct XcdBarrier { unsigned* bar; unsigned x; volatile LAS unsigned* st; };
__device__ __forceinline__ XcdBarrier xcd_barrier_post(unsigned* bar, volatile LAS unsigned* st) {
  XcdBarrier b; b.bar = bar; b.x = xb_xcc_id(); b.st = st;
  if (threadIdx.x == 0) (void)xb_add(&bar[XB_XCNT(b.x)], 1u);
  return b;
}
__device__ __forceinline__ void xcd_barrier_complete(unsigned* bar, unsigned x, unsigned& nloc, unsigned& nx) {
  const unsigned G = gridDim.x * gridDim.y * gridDim.z;
  unsigned sum, cnt, mine, sp = 0u;
  for (;;) {
    sum = 0u; cnt = 0u; mine = 0u;
#pragma unroll
    for (unsigned j = 0; j < 16; ++j) { const unsigned cc = xb_ld(&bar[XB_XCNT(j)]); sum += cc; cnt += (cc > 0u) ? 1u : 0u; mine = (j == x) ? cc : mine; }
    if (sum == G) break;
    __builtin_amdgcn_s_sleep(1);
    if ((++sp & 255u) == 0u) { if (xb_ld(&bar[XB_TMO])) break; if (sp > XB_SPIN_CAP) { atomicAdd(&bar[XB_TMO], 1u); break; } }
  }
  nloc = mine > 0u ? mine : 1u; nx = cnt > 0u ? cnt : 1u;
}
__device__ __forceinline__ void xcd_barrier(const XcdBarrier& b) {
  asm volatile("s_waitcnt vmcnt(0)" ::: "memory");
  __syncthreads();
  if (threadIdx.x == 0) {
    unsigned* bar = b.bar;
    __builtin_amdgcn_s_waitcnt(0);
    unsigned nloc = b.st[0], nx = b.st[1];
    if (nloc == 0u) { xcd_barrier_complete(bar, b.x, nloc, nx); b.st[0] = nloc; b.st[1] = nx; }
    const unsigned old = xb_add(&bar[XB_XSUB(b.x)], 1u);
    const unsigned gen = old / nloc;
    if (old + 1u == (gen + 1u) * nloc) {
      __builtin_amdgcn_fence(__ATOMIC_RELEASE, "agent");
      asm volatile("s_waitcnt vmcnt(0)" ::: "memory");
      const unsigned og = xb_add(&bar[XB_TOP], 1u);
      const unsigned tg = og / nx;
      if (og + 1u == (tg + 1u) * nx) xb_add(&bar[XB_TOPGEN], 1u);
      else XB_SPIN(xb_ld(&bar[XB_TOPGEN]) == tg, bar);
      __builtin_amdgcn_fence(__ATOMIC_ACQUIRE, "agent");
      xb_add(&bar[XB_XGEN(b.x)], 1u);
      asm volatile("s_waitcnt vmcnt(0)" ::: "memory");
    } else {
      XB_SPIN(xb_ld(&bar[XB_XGEN(b.x)]) == gen, bar);
      __builtin_amdgcn_fence(__ATOMIC_ACQUIRE, "agent");
      asm volatile("s_waitcnt vmcnt(0)" ::: "memory");
    }
  }
  __syncthreads();
}

__device__ __forceinline__ int colmap(int mode, int n) {
  if (mode == 1) {
    if (n < 512) return 2208 + n;
    if (n < 1024) return 1696 + (n - 512);
    if (n < 1408) return n - 1024;
    if (n < 1664) return 384 + (n - 1408);
    if (n < 2176) return 672 + (n - 1664);
    if (n < 2688) return 1184 + (n - 2176);
    if (n < 3200) return 1696 + (n - 2688);
    if (n < 3712) return 2720 + (n - 3200);
    if (n < 4224) return 3248 + (n - 3712);
    if (n < 4256) return 640 + (n - 4224);
    return 3232 + (n - 4256);
  }
  if (mode == 2) {
    if (n < 512) return (n >> 6) * 96 + (n & 63);
    const int r = n - 512;
    return (r >> 5) * 96 + 64 + (r & 31);
  }
  if (mode == 3) {
    if (n < 512) return (n >> 6) * 128 + (n & 63);
    const int r = n - 512;
    return (r >> 6) * 128 + 64 + (r & 63);
  }
  return n;
}

__device__ void prep_weight(const float* __restrict__ W, int K, int N, int Npad, const float* __restrict__ gsc,
                            bf16_t* __restrict__ out, char* smem, int mode = 0, int Nsrc_ = 0) {
  const int Nsrc = Nsrc_ ? Nsrc_ : N;
  const int tid = otid();
  float* sT = (float*)smem;
  const int tn = Npad >> 6, tk = K >> 6;
  for (int tile = blockIdx.x; tile < tn * tk; tile += gridDim.x) {
    const int n0 = (tile / tk) << 6, k0 = (tile % tk) << 6;
    __syncthreads();
#pragma unroll 4
    for (int i = 0; i < 16; ++i) {
      const int idx = tid + 256 * i;
      const int kk = idx >> 6, nn = idx & 63;
      float v = 0.f;
      if (n0 + nn < N) {
        v = W[(size_t)(k0 + kk) * Nsrc + colmap(mode, n0 + nn)];
        if (gsc) v *= gsc[k0 + kk];
      }
      sT[nn * 65 + kk] = v;
    }
    __syncthreads();
#pragma unroll 4
    for (int i = 0; i < 16; ++i) {
      const int idx = tid + 256 * i;
      const int nn = idx >> 6, kk = idx & 63;
      out[(size_t)(n0 + nn) * K + k0 + kk] = f2bf(sT[nn * 65 + kk]);
    }
  }
}

__device__ void phase_prep(const Params& p, char* smem) {
  long gtid = (long)blockIdx.x * 256 + otid();
  long gsize = (long)gridDim.x * 256;
  for (int l = 0; l < 2; ++l) {
    prep_weight(p.e_w_in + (long)l * DM * NE, DM, NE, NE_PAD, p.norm_g + (2 * l) * DM, p.WinE + (long)l * NE_PAD * DM, smem);
    prep_weight(p.o_w_in + (long)l * DM * 3760, DM, NO, NO_PAD, p.norm_g + (2 * l + 1) * DM, p.WinO + (long)l * NO_PAD * DM, smem, 1, 3760);
    prep_weight(p.e_w_out + (long)l * 1536 * DM, 1536, DM, DM, nullptr, p.WoutE + (long)l * DM * 1536, smem);
    prep_weight(p.o_w_out + (long)l * 1024 * DM, 1024, DM, DM, nullptr, p.WoutO + (long)l * DM * 1024, smem);
    prep_weight(p.o_q_up + (long)l * 384 * 768, 384, 768, 768, p.o_q_norm_g + l * 384, p.QupT + (long)l * 768 * 384, smem, 2);
    prep_weight(p.o_kv_up + (long)l * 256 * 1024, 256, 1024, 1024, p.o_kv_norm_g + l * 256, p.KVupT + (long)l * 1024 * 256, smem, 3);
    for (int gi = 0; gi < 4; ++gi)
      prep_weight(p.e_pool_w + (long)(l * 4 + gi) * 128 * 128, 128, 128, 128, nullptr, p.PoolWT + (long)(l * 4 + gi) * 128 * 128, smem);
    for (long idx = gtid; idx < 2 * 512 * 32; idx += gsize) {
      int r = (int)(idx & 31);
      int d = (int)((idx >> 5) & 511);
      int dir = (int)(idx >> 14);
      float v = (r < 16) ? p.e_a_up[((long)(l * 2 + dir) * 16 + r) * 512 + d] : 0.f;
      p.AupT[((long)(l * 2 + dir) * 512 + d) * 32 + r] = f2bf(v);
    }
  }
  if (gtid < 32) p.counters[gtid] = 0;
  {
    const int tid_ = otid();
    const int lane = tid_ & 63, w = tid_ >> 6;
    for (int tok = blockIdx.x * 4 + w; tok < T_TOK; tok += gridDim.x * 4) {
      const float* xp = xrow(p.x_prompt, p.x_sample, tok) + 16 * lane;
      float ssv = 0.f;
      unsigned pk[8];
#pragma unroll
      for (int i = 0; i < 4; ++i) {
        const f32x4 v = *(const f32x4*)(xp + 4 * i);
        ssv += v[0] * v[0] + v[1] * v[1] + v[2] * v[2] + v[3] * v[3];
        pk[2 * i] = pk2bf(v[0], v[1]);
        pk[2 * i + 1] = pk2bf(v[2], v[3]);
      }
      uint4 o0, o1;
      o0.x = pk[0]; o0.y = pk[1]; o0.z = pk[2]; o0.w = pk[3];
      o1.x = pk[4]; o1.y = pk[5]; o1.z = pk[6]; o1.w = pk[7];
      *(uint4*)(p.TMP + (size_t)tok * DM + 16 * lane) = o0;
      *(uint4*)(p.TMP + (size_t)tok * DM + 16 * lane + 8) = o1;
#pragma unroll
      for (int d = 1; d < 64; d <<= 1) ssv += sxor(ssv, d, lane);
      if (lane < 8) p.SSQ[(size_t)tok * 8 + lane] = (lane == 0) ? ssv : 0.f;
    }
  }
}

constexpr int G_LD = 40;
constexpr int G_BUF = (128 + 256) * G_LD;

template <int AMODE, int NI, class Epi>
__device__ __forceinline__ void gemm_phase(int Mtiles, int Ntiles, int K, const bf16_t* __restrict__ Bt, const float* ssq, const float* unused_,
                           const bf16_t* A1, int ld1, int K1, const bf16_t* A2, int ld2, const Epi& epi, char* smem) {
  bf16_t* sbase = (bf16_t*)smem;
  float* sR = (float*)(smem + 70144);
  const int tid = otid(), lane = tid & 63, w = tid >> 6, c = lane & 15, g = lane >> 4;
  const int wm = w >> 1, wn = w & 1;
  const int nk = K / 32;
  const int xcd = blockIdx.x & 7, lb0 = blockIdx.x >> 3, nlb = gridDim.x >> 3;
  const int mper = Mtiles >> 3;
  for (int lt = lb0; lt < mper * Ntiles; lt += nlb) {
    const int mt = xcd * mper + lt / Ntiles, nt = lt % Ntiles;
    constexpr int BN = 32 * NI;
    const int m0 = mt * 128, n0 = nt * BN;
    f32x4 acc[4][NI];
#pragma unroll
    for (int i = 0; i < 4; ++i)
#pragma unroll
      for (int j = 0; j < NI; ++j) acc[i][j] = zero4();
    float ss[2] = {0.f, 0.f};
    bf16x8 ra0[2], ra1[2];
    bf16x8 rb0[NI / 2], rb1[NI / 2];
    const unsigned boff = (unsigned)(tid >> 2) * K + 8 * (tid & 3);
    const bf16_t* bbase = Bt + (size_t)n0 * K;
#define G_LOAD(RA, RB, KT)                                                                          \
  {                                                                                                 \
    const int k0_ = (KT) * 32;                                                                      \
    const bf16_t* base_;                                                                            \
    int ld_;                                                                                        \
    if (k0_ < K1) { base_ = A1 + (size_t)m0 * ld1 + k0_; ld_ = ld1; }                               \
    else { base_ = A2 + (size_t)m0 * ld2 + (k0_ - K1); ld_ = ld2; }                                 \
    _Pragma("unroll") for (int i = 0; i < 2; ++i)                                                   \
      RA[i] = *(const bf16x8*)(base_ + (unsigned)((tid >> 2) + 64 * i) * ld_ + 8 * (tid & 3));      \
    _Pragma("unroll") for (int i = 0; i < NI / 2; ++i)                                              \
      RB[i] = *(const bf16x8*)(bbase + k0_ + boff + (unsigned)(64 * i) * K);                        \
  }
#define G_STORE(RA, RB, BUF)                                                                        \
  {                                                                                                 \
    bf16_t* sA_ = sbase + (BUF) * G_BUF;                                                            \
    bf16_t* sB_ = sA_ + 128 * G_LD;                                                                 \
    _Pragma("unroll") for (int i = 0; i < 2; ++i) {                                                 \
      bf16x8 v = RA[i];                                                                             \
      if constexpr (AMODE == 2) {                                                                   \
        _Pragma("unroll") for (int e = 0; e < 8; ++e) {                                             \
          float f = bf2f((bf16_t)v[e]);                                                             \
          ss[i] += f * f;                                                                           \
        }                                                                                           \
      }                                                                                             \
      *(bf16x8*)(sA_ + ((tid >> 2) + 64 * i) * G_LD + 8 * (tid & 3)) = v;                           \
    }                                                                                               \
    _Pragma("unroll") for (int i = 0; i < NI / 2; ++i)                                              \
      *(bf16x8*)(sB_ + ((tid >> 2) + 64 * i) * G_LD + 8 * (tid & 3)) = RB[i];                       \
  }
#define G_COMPUTE(BUF)                                                                              \
  {                                                                                                 \
    const bf16_t* sA_ = sbase + (BUF) * G_BUF;                                                      \
    const bf16_t* sB_ = sA_ + 128 * G_LD;                                                           \
    bf16x8 af[4];                                                                                   \
    _Pragma("unroll") for (int mi = 0; mi < 4; ++mi)                                                \
      af[mi] = *(const bf16x8*)(sA_ + (wm * 64 + mi * 16 + c) * G_LD + g * 8);                      \
    bf16x8 bq[2];                                                                                   \
    bq[0] = *(const bf16x8*)(sB_ + (wn * (16 * NI) + c) * G_LD + g * 8);                            \
    _Pragma("unroll") for (int ni = 0; ni < NI; ++ni) {                                             \
      if (ni + 1 < NI)                                                                              \
        bq[(ni + 1) & 1] = *(const bf16x8*)(sB_ + (wn * (16 * NI) + (ni + 1) * 16 + c) * G_LD + g * 8); \
      _Pragma("unroll") for (int mi = 0; mi < 4; ++mi) acc[mi][ni] = mfma16(af[mi], bq[ni & 1], acc[mi][ni]); \
    }                                                                                               \
  }
    __syncthreads();
    if constexpr (AMODE == 3) {
      if (tid < 128) {
        const f32x4 p0 = *(const f32x4*)(ssq + (size_t)(m0 + tid) * 8);
        const f32x4 p1 = *(const f32x4*)(ssq + (size_t)(m0 + tid) * 8 + 4);
        const float sv = (p0[0] + p0[1]) + (p0[2] + p0[3]) + (p1[0] + p1[1]) + (p1[2] + p1[3]);
        sR[tid] = rsqrtf(sv * (1.f / 1024.f) + EPS);
      }
    }
    G_LOAD(ra0, rb0, 0)
    G_LOAD(ra1, rb1, 1)
    G_STORE(ra0, rb0, 0)
    __syncthreads();
    for (int kt = 0; kt < nk; kt += 2) {
      G_LOAD(ra0, rb0, min(kt + 2, nk - 1))
      G_COMPUTE(0)
      G_STORE(ra1, rb1, 1)
      __syncthreads();
      G_LOAD(ra1, rb1, min(kt + 3, nk - 1))
      G_COMPUTE(1)
      if (kt + 2 < nk) G_STORE(ra0, rb0, 0)
      __syncthreads();
    }
    if constexpr (AMODE == 2) {
#pragma unroll
      for (int i = 0; i < 2; ++i) {
        float sv = ss[i];
        sv += sxor(sv, 1, lane); sv += sxor(sv, 2, lane);
        if ((tid & 3) == 0) sR[(tid >> 2) + 64 * i] = rsqrtf(sv / (float)K + EPS);
      }
      __syncthreads();
    }
    if constexpr (Epi::staged) {
      bf16_t* sT = sbase;
      const float esc = epi.scale();
      const bool tr = epi.transposed(n0);
      if (tr) {
#pragma unroll
        for (int mi = 0; mi < 4; ++mi) {
          const int row = wm * 64 + mi * 16 + 4 * g;
          const float r0 = sR[row] * esc, r1 = sR[row + 1] * esc, r2 = sR[row + 2] * esc, r3 = sR[row + 3] * esc;
#pragma unroll
          for (int ni = 0; ni < NI; ++ni) {
            uint2 o;
            o.x = pk2bf(acc[mi][ni][0] * r0, acc[mi][ni][1] * r1);
            o.y = pk2bf(acc[mi][ni][2] * r2, acc[mi][ni][3] * r3);
            *(uint2*)(sT + (wn * (16 * NI) + ni * 16 + c) * 136 + row) = o;
          }
        }
      } else {
#pragma unroll
        for (int mi = 0; mi < 4; ++mi) {
          const int row = wm * 64 + mi * 16 + 4 * g;
          const float r0 = sR[row] * esc, r1 = sR[row + 1] * esc, r2 = sR[row + 2] * esc, r3 = sR[row + 3] * esc;
#pragma unroll
          for (int ni = 0; ni < NI; ++ni) {
            bf16_t* d = sT + row * (BN + 8) + wn * (16 * NI) + ni * 16 + c;
            d[0] = f2bf(acc[mi][ni][0] * r0);
            d[BN + 8] = f2bf(acc[mi][ni][1] * r1);
            d[2 * (BN + 8)] = f2bf(acc[mi][ni][2] * r2);
            d[3 * (BN + 8)] = f2bf(acc[mi][ni][3] * r3);
          }
        }
      }
      epi.template direct<NI>(m0, n0, wm, wn, g, c, acc, sR);
      __syncthreads();
      if (tr) {
#pragma unroll 4
        for (int i = 0; i < 2 * NI; ++i) {
          const int id = tid + 256 * i;
          const int col = id >> 4, rc = id & 15;
          bf16x8 v = *(const bf16x8*)(sT + col * 136 + 8 * rc);
          epi.store_t(m0 + 8 * rc, n0 + col, v);
        }
      } else {
#pragma unroll 4
        for (int i = 0; i < 2 * NI; ++i) {
          const int id = tid + 256 * i;
          const int row = id / (4 * NI), cc = id % (4 * NI);
          const bf16_t* sp = sT + row * (BN + 8) + 8 * cc;
          bf16x8 v = *(const bf16x8*)sp;
          epi.store_n(m0 + row, n0 + 8 * cc, v, sp);
        }
      }
    } else {
      float* sF = (float*)smem;
#pragma unroll 1
      for (int half = 0; half < 2; ++half) {
        if (half) __syncthreads();
        if (wm == half) {
#pragma unroll
          for (int mi = 0; mi < 4; ++mi)
#pragma unroll
            for (int ni = 0; ni < NI; ++ni)
#pragma unroll
              for (int j = 0; j < 4; ++j) sF[(mi * 16 + 4 * g + j) * 260 + wn * (16 * NI) + ni * 16 + c] = acc[mi][ni][j];
        }
        __syncthreads();
#pragma unroll 4
        for (int i = 0; i < 16; ++i) {
          const int row = w * 16 + i;
          const int tok = m0 + half * 64 + row;
          const int col = n0 + 4 * lane;
          const f32x4 a = *(const f32x4*)(sF + row * 260 + 4 * lane);
          const f32x4 xo = *(const f32x4*)(xrow(epi.xa, epi.xb, tok) + col);
          f32x4 xn;
          xn[0] = xo[0] + a[0]; xn[1] = xo[1] + a[1]; xn[2] = xo[2] + a[2]; xn[3] = xo[3] + a[3];
          float sv = xn[0] * xn[0] + xn[1] * xn[1] + xn[2] * xn[2] + xn[3] * xn[3];
#pragma unroll
          for (int d = 1; d < 64; d <<= 1) sv += sxor(sv, d, lane);
          if (!epi.dry) {
            *(f32x4*)(epi.out + (size_t)tok * DM + col) = xn;
            if (epi.hb) {
              uint2 o;
              o.x = pk2bf(xn[0], xn[1]);
              o.y = pk2bf(xn[2], xn[3]);
              *(uint2*)(epi.hb + (size_t)tok * DM + col) = o;
            }
            if (lane == 0) epi.ssq[(size_t)tok * 8 + (n0 >> 8)] = sv;
          }
        }
      }
    }
  }
#undef G_LOAD
#undef G_STORE
#undef G_COMPUTE
}

__device__ __forceinline__ void rope_cs(int pos, int i, float& co, float& si) {
  float inv = exp2f(-(float)i * (13.287712379549449f / 16.f));
  float ang = (float)pos * inv;
  float n = rintf(ang * 0.15915494309189535f);
  float r = fmaf(-n, 6.28125f, ang);
  r = fmaf(-n, 0.0019353071795864769f, r);
  float rf = r * 0.15915494309189535f;
  si = __builtin_amdgcn_sinf(rf);
  co = __builtin_amdgcn_cosf(rf);
}

__device__ __forceinline__ void rope_chunk(int pos, int i0, bf16x8 x1, bf16x8 x2, bf16x8& o1, bf16x8& o2) {
#pragma unroll
  for (int e = 0; e < 8; ++e) {
    float co, si;
    rope_cs(pos, i0 + e, co, si);
    float a = bf2f((bf16_t)x1[e]), b = bf2f((bf16_t)x2[e]);
    o1[e] = (short)f2bf(a * co - b * si);
    o2[e] = (short)f2bf(b * co + a * si);
  }
}

struct EpiEvenIn {
  static constexpr bool staged = true;
  bf16_t *Qb, *Kt, *VtE, *Gb, *LRb, *PUb, *PGb;
  __device__ float scale() const { return 1.f; }
  __device__ bool transposed(int n0) const { return n0 >= 512 && n0 < 2048; }
  template <int NI> __device__ void direct(int m0, int n0, int wm, int wn, int g, int c, f32x4 (&acc)[4][NI], const float* sR) const {}
  __device__ void store_t(int tok8, int col, bf16x8 v) const {
    if (col < 1024) *(bf16x8*)(Kt + (size_t)(col - 512) * T_TOK + tok8) = v;
    else *(bf16x8*)(VtE + (size_t)(col - 1024) * T_TOK + tok8) = v;
  }
  __device__ void store_n(int tok, int col, bf16x8 v, const bf16_t* sp) const {
    bf16_t* d;
    if (col < 512) d = Qb + (size_t)tok * 512 + col;
    else if (col < 3072) d = Gb + (size_t)tok * 1024 + (col - 2048);
    else if (col < 3104) d = LRb + (size_t)tok * 32 + (col - 3072);
    else if (col < 3616) d = PUb + (size_t)tok * 512 + (col - 3104);
    else if (col < 4128) d = PGb + (size_t)tok * 512 + (col - 3616);
    else return;
    *(bf16x8*)d = v;
  }
};

struct EpiOddIn {
  static constexpr bool staged = true;
  bf16_t *CQb, *CKVb, *KRb, *MGb, *MQb, *MKb, *MKt, *MVt, *MOb, *MLGb;
  float* MIF;
  __device__ float scale() const { return 1.f; }
  __device__ bool transposed(int n0) const { return n0 < 1024; }
  template <int NI> __device__ void direct(int m0, int n0, int wm, int wn, int g, int c, f32x4 (&acc)[4][NI], const float* sR) const {
    if (n0 == 4096 && wn == 1) {
#pragma unroll
      for (int mi = 0; mi < 4; ++mi)
#pragma unroll
        for (int j = 0; j < 4; ++j) {
          const int row = wm * 64 + mi * 16 + 4 * g + j;
          MIF[(size_t)(m0 + row) * 16 + c] = acc[mi][2][j] * sR[row];
        }
    }
  }
  __device__ void store_t(int tok8, int col, bf16x8 v) const {
    if (col < 512) *(bf16x8*)(MVt + (size_t)col * T_TOK + tok8) = v;
    else *(bf16x8*)(MKt + (size_t)(col - 512) * T_TOK + tok8) = v;
  }
  __device__ void store_n(int tok, int col, bf16x8 v, const bf16_t* sp) const {
    bf16_t* d;
    if (col < 1408) d = CQb + (size_t)tok * 384 + (col - 1024);
    else if (col < 1664) d = CKVb + (size_t)tok * 256 + (col - 1408);
    else if (col < 2176) d = MGb + (size_t)tok * 512 + (col - 1664);
    else if (col < 2688) d = MQb + (size_t)tok * 512 + (col - 2176);
    else if (col < 3200) d = MKb + (size_t)tok * 512 + (col - 2688);
    else if (col < 3712) d = MOb + (size_t)tok * 512 + (col - 3200);
    else if (col < 4224) d = MLGb + (size_t)tok * 512 + (col - 3712);
    else if (col < 4240) {
      bf16x8 x2 = *(const bf16x8*)(sp + 16);
      bf16x8 o1, o2;
      rope_chunk(seq_pos(tok), col - 4224, v, x2, o1, o2);
      *(bf16x8*)(KRb + (size_t)tok * 32 + (col - 4224)) = o1;
      *(bf16x8*)(KRb + (size_t)tok * 32 + 16 + (col - 4224)) = o2;
      return;
    } else return;
    *(bf16x8*)d = v;
  }
};

struct EpiQUp {
  static constexpr bool staged = true;
  bf16_t* Qa;
  __device__ float scale() const { return 0.10206207261596575f * 1.4426950408889634f; }
  __device__ bool transposed(int n0) const { return false; }
  template <int NI> __device__ void direct(int m0, int n0, int wm, int wn, int g, int c, f32x4 (&acc)[4][NI], const float* sR) const {}
  __device__ void store_t(int tok8, int col, bf16x8 v) const {}
  __device__ void store_n(int tok, int col, bf16x8 v, const bf16_t* sp) const {
    if (col < 512) {
      *(bf16x8*)(Qa + (size_t)tok * 768 + (col >> 6) * 96 + (col & 63)) = v;
    } else {
      const int r = col - 512, head = r >> 5, rr = r & 31;
      if (rr < 16) {
        bf16x8 x2 = *(const bf16x8*)(sp + 16);
        bf16x8 o1, o2;
        rope_chunk(seq_pos(tok), rr, v, x2, o1, o2);
        *(bf16x8*)(Qa + (size_t)tok * 768 + head * 96 + 64 + rr) = o1;
        *(bf16x8*)(Qa + (size_t)tok * 768 + head * 96 + 80 + rr) = o2;
      }
    }
  }
};

struct EpiKVUp {
  static constexpr bool staged = true;
  bf16_t *KNb, *VtA;
  __device__ float scale() const { return 1.f; }
  __device__ bool transposed(int n0) const { return n0 >= 512; }
  template <int NI> __device__ void direct(int m0, int n0, int wm, int wn, int g, int c, f32x4 (&acc)[4][NI], const float* sR) const {}
  __device__ void store_t(int tok8, int col, bf16x8 v) const { *(bf16x8*)(VtA + (size_t)(col - 512) * T_TOK + tok8) = v; }
  __device__ void store_n(int tok, int col, bf16x8 v, const bf16_t* sp) const { *(bf16x8*)(KNb + (size_t)tok * 512 + col) = v; }
};

struct EpiOut {
  static constexpr bool staged = false;
  const float *xa, *xb;
  float* out;
  bool dry;
  bf16_t* hb;
  float* ssq;
};

__device__ __forceinline__ float scan16(float v, int c, int lane) {
  float t;
  t = bperm(lane - 1, v); if (c >= 1) v += t;
  t = bperm(lane - 2, v); if (c >= 2) v += t;
  t = bperm(lane - 4, v); if (c >= 4) v += t;
  t = bperm(lane - 8, v); if (c >= 8) v += t;
  return v;
}

__device__ __forceinline__ float logsig_fast(float x) { return fminf(x, 0.f) - __logf(1.f + __expf(-fabsf(x))); }

__device__ void gla_intra_item(const Params& p, int li, int item, char* smem, bool dry = false) {
  const int tid = otid(), lane = tid & 63, w = tid >> 6, c = lane & 15, g = lane >> 4;
  const int ci = item >> 2, h = item & 3;
  const int tokc = ci * 64;
  const float qscale = 0.08838834764831845f;
  bf16_t* sQe = (bf16_t*)smem;
  bf16_t* sKd = sQe + 64 * 136;
  bf16_t* sA = sKd + 64 * 136;
  us4 q4[2][4];
  bf16_t kk[2][4][4];
#pragma unroll
  for (int dt = 0; dt < 2; ++dt)
#pragma unroll
    for (int tt = 0; tt < 4; ++tt) {
      q4[dt][tt] = *(const us4*)(p.Qb + (size_t)(tokc + 16 * tt + c) * 512 + h * 128 + 32 * w + 16 * dt + 4 * g);
#pragma unroll
      for (int j = 0; j < 4; ++j)
        kk[dt][tt][j] = p.Kt[(size_t)(h * 128 + 32 * w + 16 * dt + 4 * g + j) * T_TOK + tokc + 16 * tt + c];
    }
  __syncthreads();
#pragma unroll
  for (int dir = 0; dir < 2; ++dir) {
    bf16_t* QEd = (dir || dry) ? p.QEb : p.Qb;
    bf16_t* KdTd = (dir || dry) ? p.KdTb : p.Kt;
    bf16x8 aup[2];
    float bias[2][4];
#pragma unroll
    for (int dt = 0; dt < 2; ++dt) {
      aup[dt] = zero8();
      if (g < 2) aup[dt] = *(const bf16x8*)(p.AupT + ((size_t)(li * 2 + dir) * 512 + h * 128 + 32 * w + 16 * dt + c) * 32 + 8 * g);
#pragma unroll
      for (int j = 0; j < 4; ++j) bias[dt][j] = p.e_a_bias[(li * 2 + dir) * 512 + h * 128 + 32 * w + 16 * dt + 4 * g + j];
    }
    f32x4 la[2][4];
#pragma unroll
    for (int tt = 0; tt < 4; ++tt) {
      bf16x8 lrf = zero8();
      if (g < 2) lrf = *(const bf16x8*)(p.LRb + (size_t)(tokc + 16 * tt + c) * 32 + dir * 16 + 8 * g);
#pragma unroll
      for (int dt = 0; dt < 2; ++dt) la[dt][tt] = mfma16(aup[dt], lrf, zero4());
    }
#pragma unroll
    for (int dt = 0; dt < 2; ++dt)
#pragma unroll
      for (int tt = 0; tt < 4; ++tt)
#pragma unroll
        for (int j = 0; j < 4; ++j) la[dt][tt][j] = logsig_fast(la[dt][tt][j] + bias[dt][j]) * (1.f / 16.f);
    f32x4 P[2][4];
    float tot[2][4];
#pragma unroll
    for (int dt = 0; dt < 2; ++dt)
#pragma unroll
      for (int j = 0; j < 4; ++j) {
        float carry = 0.f;
#pragma unroll
        for (int tt = 0; tt < 4; ++tt) {
          float v = scan16(la[dt][tt][j], c, lane) + carry;
          P[dt][tt][j] = v;
          carry = bperm(lane | 15, v);
        }
        tot[dt][j] = carry;
      }
#pragma unroll
    for (int dt = 0; dt < 2; ++dt)
#pragma unroll
      for (int tt = 0; tt < 4; ++tt) {
        us4 qo, ko;
#pragma unroll
        for (int j = 0; j < 4; ++j) {
          const float b = (dir == 0) ? P[dt][tt][j] : (tot[dt][j] - P[dt][tt][j] + la[dt][tt][j]);
          qo[j] = f2bf(bf2f(q4[dt][tt][j]) * __expf(b) * qscale);
          ko[j] = f2bf(bf2f(kk[dt][tt][j]) * __expf(-b));
        }
        *(us4*)(QEd + (size_t)(tokc + 16 * tt + c) * 512 + h * 128 + 32 * w + 16 * dt + 4 * g) = qo;
        *(us4*)(sQe + (16 * tt + c) * 136 + 32 * w + 16 * dt + 4 * g) = qo;
        *(us4*)(sKd + (16 * tt + c) * 136 + 32 * w + 16 * dt + 4 * g) = ko;
      }
    if (c == 0) {
#pragma unroll
      for (int dt = 0; dt < 2; ++dt)
#pragma unroll
        for (int j = 0; j < 4; ++j)
          p.EB[(size_t)(dir * 1280 + ci) * 512 + h * 128 + 32 * w + 16 * dt + 4 * g + j] = __expf(tot[dt][j]);
    }
    __syncthreads();
#pragma unroll
    for (int i = 0; i < 4; ++i) {
      const int id = tid + 256 * i;
      const int d = id & 127, c8 = id >> 7;
      bf16x8 v;
#pragma unroll
      for (int e = 0; e < 8; ++e) v[e] = (short)sKd[(8 * c8 + e) * 136 + d];
      *(bf16x8*)(KdTd + (size_t)(h * 128 + d) * T_TOK + tokc + 8 * c8) = v;
    }
    f32x4 accA[4];
#pragma unroll
    for (int jt = 0; jt < 4; ++jt) accA[jt] = zero4();
#pragma unroll
    for (int ks = 0; ks < 4; ++ks) {
      bf16x8 aq = *(const bf16x8*)(sQe + (16 * w + c) * 136 + 32 * ks + 8 * g);
#pragma unroll
      for (int jt = 0; jt < 4; ++jt) {
        bf16x8 bk = *(const bf16x8*)(sKd + (16 * jt + c) * 136 + 32 * ks + 8 * g);
        accA[jt] = mfma16(aq, bk, accA[jt]);
      }
    }
#pragma unroll
    for (int jt = 0; jt < 4; ++jt)
#pragma unroll
      for (int j = 0; j < 4; ++j) {
        const int i = 16 * w + 4 * g + j, jj = 16 * jt + c;
        const bool keep = (dir == 0) ? (jj <= i) : (jj > i);
        sA[dir * 64 * 72 + i * 72 + jj] = f2bf(keep ? accA[jt][j] : 0.f);
      }
    __syncthreads();
  }
  bf16x8 af[2][2];
#pragma unroll
  for (int dir = 0; dir < 2; ++dir)
#pragma unroll
    for (int k2 = 0; k2 < 2; ++k2) af[dir][k2] = *(const bf16x8*)(sA + dir * 64 * 72 + (16 * w + c) * 72 + 32 * k2 + 8 * g);
  bf16_t* sO = (bf16_t*)smem;
#pragma unroll 4
  for (int vt = 0; vt < 16; ++vt) {
    f32x4 a = zero4();
#pragma unroll
    for (int k2 = 0; k2 < 2; ++k2) {
      bf16x8 vfr = *(const bf16x8*)(p.VtE + (size_t)(h * 256 + 16 * vt + c) * T_TOK + tokc + 32 * k2 + 8 * g);
      a = mfma16(af[0][k2], vfr, a);
      a = mfma16(af[1][k2], vfr, a);
    }
#pragma unroll
    for (int j = 0; j < 4; ++j) sO[(16 * w + 4 * g + j) * 264 + 16 * vt + c] = f2bf(a[j]);
  }
  __syncthreads();
#pragma unroll
  for (int i = 0; i < 8; ++i) {
    const int id = tid + 256 * i;
    const int row = id >> 5, c8 = id & 31;
    *(bf16x8*)(p.TMP + (size_t)(tokc + row) * 1024 + h * 256 + 8 * c8) = *(const bf16x8*)(sO + row * 264 + 8 * c8);
  }
}

__device__ __forceinline__ void lds_barrier() { asm volatile("s_waitcnt lgkmcnt(0)\n\ts_barrier" ::: "memory"); }

struct GlaRegs {
  bf16x8 aq[4];
  bf16x8 vf[2][2];
  bf16x8 kf[2][2];
  float eb[2];
  unsigned told[2][4];
};

template <int DIR>
__device__ __forceinline__ void gla_chain_load(const Params& p, int h, int sl, int tokc, int w, int c, int g, GlaRegs& r) {
  const bf16_t* QE = DIR ? p.QEb : p.Qb;
  const bf16_t* KdT = DIR ? p.KdTb : p.Kt;
#pragma unroll
  for (int ks = 0; ks < 4; ++ks) r.aq[ks] = *(const bf16x8*)(QE + (size_t)(tokc + 16 * w + c) * 512 + h * 128 + 32 * ks + 8 * g);
#pragma unroll
  for (int vt = 0; vt < 2; ++vt)
#pragma unroll
    for (int k2 = 0; k2 < 2; ++k2)
      r.vf[vt][k2] = *(const bf16x8*)(p.VtE + (size_t)(h * 256 + sl * 32 + 16 * vt + c) * T_TOK + tokc + 32 * k2 + 8 * g);
#pragma unroll
  for (int dt = 0; dt < 2; ++dt) {
#pragma unroll
    for (int k2 = 0; k2 < 2; ++k2)
      r.kf[dt][k2] = *(const bf16x8*)(KdT + (size_t)(h * 128 + 32 * w + 16 * dt + c) * T_TOK + tokc + 32 * k2 + 8 * g);
    r.eb[dt] = p.EB[(size_t)(DIR * 1280 + (tokc >> 6)) * 512 + h * 128 + 32 * w + 16 * dt + c];
  }
#pragma unroll
  for (int vt = 0; vt < 2; ++vt)
#pragma unroll
    for (int j = 0; j < 4; ++j) r.told[vt][j] = p.TMP[(size_t)(tokc + 16 * w + 4 * g + j) * 1024 + h * 256 + sl * 32 + 16 * vt + c];
}

__device__ __forceinline__ void gla_chain_compute(const Params& p, int h, int sl, int tokc, int w, int c, int g, const GlaRegs& r,
                                                  f32x4 (&S)[2][2], bf16_t* sSt, bool dry, bool reload) {
  unsigned told[2][4];
#pragma unroll
  for (int vt = 0; vt < 2; ++vt)
#pragma unroll
    for (int j = 0; j < 4; ++j) told[vt][j] = r.told[vt][j];
  if (reload) {
#pragma unroll
    for (int vt = 0; vt < 2; ++vt)
#pragma unroll
      for (int j = 0; j < 4; ++j) told[vt][j] = p.TMP[(size_t)(tokc + 16 * w + 4 * g + j) * 1024 + h * 256 + sl * 32 + 16 * vt + c];
  }
#pragma unroll
  for (int vt = 0; vt < 2; ++vt)
#pragma unroll
    for (int dt = 0; dt < 2; ++dt)
#pragma unroll
      for (int j = 0; j < 4; ++j) sSt[(16 * vt + 4 * g + j) * 136 + 32 * w + 16 * dt + c] = f2bf(S[vt][dt][j]);
  lds_barrier();
  f32x4 o[2];
  o[0] = zero4(); o[1] = zero4();
#pragma unroll
  for (int ks = 0; ks < 4; ++ks)
#pragma unroll
    for (int vt = 0; vt < 2; ++vt) {
      bf16x8 sf = *(const bf16x8*)(sSt + (16 * vt + c) * 136 + 32 * ks + 8 * g);
      o[vt] = mfma16(r.aq[ks], sf, o[vt]);
    }
#pragma unroll
  for (int dt = 0; dt < 2; ++dt)
#pragma unroll
    for (int vt = 0; vt < 2; ++vt) {
      f32x4 a = S[vt][dt];
#pragma unroll
      for (int k2 = 0; k2 < 2; ++k2) a = mfma16(r.vf[vt][k2], r.kf[dt][k2], a);
      S[vt][dt] = a * r.eb[dt];
    }
#pragma unroll
  for (int vt = 0; vt < 2; ++vt)
#pragma unroll
    for (int j = 0; j < 4; ++j)
      if (!dry) p.TMP[(size_t)(tokc + 16 * w + 4 * g + j) * 1024 + h * 256 + sl * 32 + 16 * vt + c] = f2bf(bf2f((bf16_t)told[vt][j]) + o[vt][j]);
}

__device__ void gla_chain_item(const Params& p, int li, int item, char* smem, bool dry = false) {
  const int tid = otid(), lane = tid & 63, w = tid >> 6, c = lane & 15, g = lane >> 4;
  const int xr = item >> 3;
  const int pair = (item & 7) + 8 * (xr >> 3), sl = xr & 7;
  const int s = pair < 32 ? 4 + (pair >> 2) : ((pair - 32) >> 2);
  const int h = pair & 3;
  const int tok0 = s < 4 ? s * 4096 : T_P + (s - 4) * 8192;
  const int len = s < 4 ? 4096 : 8192;
  const int N = len / 64;
  bf16_t* sSt0 = (bf16_t*)smem;
  bf16_t* sSt1 = sSt0 + 32 * 136;
  f32x4 Sf[2][2], Sb[2][2];
#pragma unroll
  for (int a = 0; a < 2; ++a)
#pragma unroll
    for (int b = 0; b < 2; ++b) { Sf[a][b] = zero4(); Sb[a][b] = zero4(); }
  GlaRegs rf, rb;
  __syncthreads();
  gla_chain_load<0>(p, h, sl, tok0, w, c, g, rf);
  for (int step = 0; step < N; ++step) {
    const int tf = tok0 + step * 64, tb = tok0 + (N - 1 - step) * 64;
    gla_chain_load<1>(p, h, sl, tb, w, c, g, rb);
    gla_chain_compute(p, h, sl, tf, w, c, g, rf, Sf, sSt0, dry, step == (N >> 1));
    if (step + 1 < N) gla_chain_load<0>(p, h, sl, tf + 64, w, c, g, rf);
    gla_chain_compute(p, h, sl, tb, w, c, g, rb, Sb, sSt1, dry, false);
  }
}

__device__ void pool_item(const Params& p, int li, int item, char* smem, bool dry = false) {
  const int tid = otid(), lane = tid & 63, w = tid >> 6, c = lane & 15, g = lane >> 4;
  const int gi = item & 3;
  const int tile = item >> 2;
  const int tokc = tile * 64;
  const int pos0 = seq_pos(tokc);
  const int len = tokc < T_P ? 4096 : 8192;
  float* sU = (float*)smem;
  bf16_t* sP = (bf16_t*)(sU + 80 * 128);
  __syncthreads();
  for (int idx = tid; idx < 80 * 128; idx += 256) {
    int r = idx >> 7, ch = idx & 127;
    int pos = pos0 - 8 + r;
    float v = 0.f;
    if (pos >= 0 && pos < len) v = bf2f(p.PUb[(long)(tokc - 8 + r) * 512 + gi * 128 + ch]);
    sU[idx] = v;
  }
  __syncthreads();
  {
    const int ch = tid & 127, th = tid >> 7;
    const int half = 1 << gi;
    for (int t = th * 32; t < th * 32 + 32; ++t) {
      int pos = pos0 + t;
      int lo = max(pos - half, 0), hi = min(pos + half, len);
      float s = 0.f;
      for (int q = lo; q < hi; ++q) s += sU[(q - pos0 + 8) * 128 + ch];
      float pooled = s / (float)(hi - lo) - sU[(t + 8) * 128 + ch];
      sP[t * 136 + ch] = f2bf(pooled);
    }
  }
  __syncthreads();
  f32x4 acc[8];
#pragma unroll
  for (int dt = 0; dt < 8; ++dt) acc[dt] = zero4();
  const bf16_t* PW = p.PoolWT + (long)(li * 4 + gi) * 128 * 128;
#pragma unroll
  for (int ks = 0; ks < 4; ++ks) {
    bf16x8 af = *(const bf16x8*)(sP + (16 * w + c) * 136 + 32 * ks + 8 * g);
#pragma unroll
    for (int dt = 0; dt < 8; ++dt) {
      bf16x8 bw = *(const bf16x8*)(PW + (long)(16 * dt + c) * 128 + 32 * ks + 8 * g);
      acc[dt] = mfma16(af, bw, acc[dt]);
    }
  }
#pragma unroll
  for (int dt = 0; dt < 8; ++dt) {
    const int d = gi * 128 + 16 * dt + c;
    const float sc = p.e_pool_scale[li * 512 + d];
#pragma unroll
    for (int j = 0; j < 4; ++j) {
      const long addr = (long)(tokc + 16 * w + 4 * g + j) * 512 + d;
      float gt = bf2f(p.PGb[addr]);
      if (!dry) p.PGb[addr] = f2bf(acc[dt][j] * sc * siluf_(gt));
    }
  }
}

__device__ void ml_intra_item(const Params& p, int li, int item, char* smem) {
  const int tid = otid(), lane = tid & 63, w = tid >> 6, c = lane & 15, g = lane >> 4;
  const int ci = item >> 2, h = item & 3;
  const int tokc = ci * 64;
  const float kscale = 0.08838834764831845f;
  bf16_t* sA = (bf16_t*)smem;
  float* sBv = (float*)(sA + 2 * 64 * 72);
  float* sCB = sBv + 128;
  __syncthreads();
  if (w < 2) {
    const int dir = w;
    const float bi = p.o_if_bias[li * 16 + dir * 4 + h];
    const float bff = p.o_if_bias[li * 16 + 8 + dir * 4 + h];
    const float* mf = p.MIF + (size_t)(tokc + lane) * 16;
    const float liv = mf[dir * 4 + h] + bi;
    const float lfv = logsig_fast(mf[8 + dir * 4 + h] + bff);
    float ps = lfv;
#pragma unroll
    for (int d = 1; d < 64; d <<= 1) {
      float t = bperm(lane - d, ps);
      if (lane >= d) ps += t;
    }
    const float total = __int_as_float(__builtin_amdgcn_readlane(__float_as_int(ps), 63));
    const float b = (dir == 0) ? ps : (total - ps + lfv);
    const float cB = liv - b;
    sBv[dir * 64 + lane] = b;
    sCB[dir * 64 + lane] = cB;
    const size_t so = (size_t)(dir * 4 + h) * T_TOK + tokc + lane;
    p.EBI[so] = __expf(b);
    p.WKg[so] = __expf(total + cB) * kscale;
    if (lane == 0) p.DEC[(dir * 4 + h) * 1280 + ci] = __expf(total);
  }
  f32x4 accA[4];
#pragma unroll
  for (int jt = 0; jt < 4; ++jt) accA[jt] = zero4();
#pragma unroll
  for (int ks = 0; ks < 4; ++ks) {
    bf16x8 aq = *(const bf16x8*)(p.MQb + (size_t)(tokc + 16 * w + c) * 512 + h * 128 + 32 * ks + 8 * g);
#pragma unroll
    for (int jt = 0; jt < 4; ++jt) {
      bf16x8 bk = *(const bf16x8*)(p.MKb + (size_t)(tokc + 16 * jt + c) * 512 + h * 128 + 32 * ks + 8 * g);
      accA[jt] = mfma16(aq, bk, accA[jt]);
    }
  }
  __syncthreads();
#pragma unroll
  for (int dir = 0; dir < 2; ++dir)
#pragma unroll
    for (int jt = 0; jt < 4; ++jt)
#pragma unroll
      for (int j = 0; j < 4; ++j) {
        const int i = 16 * w + 4 * g + j, jj = 16 * jt + c;
        const bool keep = (dir == 0) ? (jj <= i) : (jj > i);
        const float sv = keep ? accA[jt][j] * kscale * __expf(sBv[dir * 64 + i] + sCB[dir * 64 + jj]) : 0.f;
        sA[dir * 64 * 72 + i * 72 + jj] = f2bf(sv);
      }
  __syncthreads();
  bf16x8 ones = zero8();
  if (c == 0) {
#pragma unroll
    for (int e = 0; e < 8; ++e) ones[e] = (short)0x3F80;
  }
#pragma unroll
  for (int dir = 0; dir < 2; ++dir) {
    bf16_t* NUMI = dir ? p.NUMIb : p.NUMIf;
    bf16x8 af[2];
#pragma unroll
    for (int k2 = 0; k2 < 2; ++k2) af[k2] = *(const bf16x8*)(sA + dir * 64 * 72 + (16 * w + c) * 72 + 32 * k2 + 8 * g);
    f32x4 dn = zero4();
    dn = mfma16(af[0], ones, dn);
    dn = mfma16(af[1], ones, dn);
    if (c == 0) {
#pragma unroll
      for (int j = 0; j < 4; ++j) p.DENI[(size_t)(dir * 4 + h) * T_TOK + tokc + 16 * w + 4 * g + j] = dn[j];
    }
    bf16_t* sO = sA + 2 * 64 * 72 + 512;
#pragma unroll 4
    for (int vt = 0; vt < 8; ++vt) {
      f32x4 a = zero4();
#pragma unroll
      for (int k2 = 0; k2 < 2; ++k2) {
        bf16x8 vfr = *(const bf16x8*)(p.MVt + (size_t)(h * 128 + 16 * vt + c) * T_TOK + tokc + 32 * k2 + 8 * g);
        a = mfma16(af[k2], vfr, a);
      }
#pragma unroll
      for (int j = 0; j < 4; ++j) sO[(16 * w + 4 * g + j) * 136 + 16 * vt + c] = f2bf(a[j]);
    }
    __syncthreads();
#pragma unroll
    for (int i = 0; i < 4; ++i) {
      const int id = tid + 256 * i;
      const int row = id >> 4, c8 = id & 15;
      *(bf16x8*)(NUMI + (size_t)(tokc + row) * 512 + h * 128 + 8 * c8) = *(const bf16x8*)(sO + row * 136 + 8 * c8);
    }
    __syncthreads();
  }
}

struct MlRegs {
  bf16x8 aq[4];
  bf16x8 vf[2];
  bf16x8 kf[2][2];
  f32x4 wk[2][2];
  f32x4 ebi, deni;
  float dec;
  unsigned numi[4];
};

template <int DIR>
__device__ __forceinline__ void ml_chain_load(const Params& p, int h, int sl, int tokc, int w, int c, int g, MlRegs& r) {
#pragma unroll
  for (int ks = 0; ks < 4; ++ks) r.aq[ks] = *(const bf16x8*)(p.MQb + (size_t)(tokc + 16 * w + c) * 512 + h * 128 + 32 * ks + 8 * g);
#pragma unroll
  for (int k2 = 0; k2 < 2; ++k2)
    r.vf[k2] = *(const bf16x8*)(p.MVt + (size_t)(h * 128 + sl * 16 + c) * T_TOK + tokc + 32 * k2 + 8 * g);
#pragma unroll
  for (int dt = 0; dt < 2; ++dt)
#pragma unroll
    for (int k2 = 0; k2 < 2; ++k2)
      r.kf[dt][k2] = *(const bf16x8*)(p.MKt + (size_t)(h * 128 + 32 * w + 16 * dt + c) * T_TOK + tokc + 32 * k2 + 8 * g);
  const size_t so = (size_t)(DIR * 4 + h) * T_TOK + tokc;
#pragma unroll
  for (int k2 = 0; k2 < 2; ++k2) {
    r.wk[k2][0] = *(const f32x4*)(p.WKg + so + 32 * k2 + 8 * g);
    r.wk[k2][1] = *(const f32x4*)(p.WKg + so + 32 * k2 + 8 * g + 4);
  }
  r.ebi = *(const f32x4*)(p.EBI + so + 16 * w + 4 * g);
  r.deni = *(const f32x4*)(p.DENI + so + 16 * w + 4 * g);
  r.dec = p.DEC[(DIR * 4 + h) * 1280 + (tokc >> 6)];
  const bf16_t* NUMI = DIR ? p.NUMIb : p.NUMIf;
#pragma unroll
  for (int j = 0; j < 4; ++j) r.numi[j] = NUMI[(size_t)(tokc + 16 * w + 4 * g + j) * 512 + h * 128 + sl * 16 + c];
}

template <int DIR>
__device__ __forceinline__ void ml_chain_compute(const Params& p, int h, int sl, int tokc, int lane, int w, int c, int g, const MlRegs& r,
                                                 f32x4 (&C)[2][2], bf16_t* sCt, bool dry) {
  bf16_t* NUMI = DIR ? p.NUMIb : p.NUMIf;
  unsigned numi[4];
#pragma unroll
  for (int j = 0; j < 4; ++j) numi[j] = r.numi[j];
#pragma unroll
  for (int vt = 0; vt < 2; ++vt)
#pragma unroll
    for (int dt = 0; dt < 2; ++dt)
#pragma unroll
      for (int j = 0; j < 4; ++j) sCt[(16 * vt + 4 * g + j) * 136 + 32 * w + 16 * dt + c] = f2bf(C[vt][dt][j]);
  bf16x8 vfw[2][2];
#pragma unroll
  for (int k2 = 0; k2 < 2; ++k2) {
    float wv[8];
#pragma unroll
    for (int e = 0; e < 4; ++e) { wv[e] = r.wk[k2][0][e]; wv[4 + e] = r.wk[k2][1][e]; }
#pragma unroll
    for (int e = 0; e < 8; ++e) vfw[0][k2][e] = (short)f2bf(bf2f((bf16_t)r.vf[k2][e]) * wv[e]);
#pragma unroll
    for (int e = 0; e < 8; ++e) vfw[1][k2][e] = (c == 0) ? (short)f2bf(wv[e]) : (short)0;
  }
  lds_barrier();
  f32x4 o2[2];
  o2[0] = zero4(); o2[1] = zero4();
#pragma unroll
  for (int ks = 0; ks < 4; ++ks)
#pragma unroll
    for (int vt = 0; vt < 2; ++vt) {
      bf16x8 cf = *(const bf16x8*)(sCt + (16 * vt + c) * 136 + 32 * ks + 8 * g);
      o2[vt] = mfma16(r.aq[ks], cf, o2[vt]);
    }
#pragma unroll
  for (int dt = 0; dt < 2; ++dt)
#pragma unroll
    for (int vt = 0; vt < 2; ++vt) {
      f32x4 a = C[vt][dt] * r.dec;
#pragma unroll
      for (int k2 = 0; k2 < 2; ++k2) a = mfma16(vfw[vt][k2], r.kf[dt][k2], a);
      C[vt][dt] = a;
    }
#pragma unroll
  for (int j = 0; j < 4; ++j) {
    const float e = r.ebi[j];
    float den = e * o2[1][j];
    den = bperm(lane & 48, den) + r.deni[j];
    const float inv = 1.f / fmaxf(fabsf(den), 1.f);
    const float hv = (bf2f((bf16_t)numi[j]) + e * o2[0][j]) * inv;
    if (!dry) NUMI[(size_t)(tokc + 16 * w + 4 * g + j) * 512 + h * 128 + sl * 16 + c] = f2bf(hv);
  }
}

template <int DIR>
__device__ __forceinline__ void ml_chain_run(const Params& p, int h, int sl, int tok0, int N, int lane, int w, int c, int g, bf16_t* sCt0, bool dry) {
  bf16_t* sCt1 = sCt0 + 32 * 136;
  f32x4 C[2][2];
#pragma unroll
  for (int a = 0; a < 2; ++a)
#pragma unroll
    for (int b = 0; b < 2; ++b) C[a][b] = zero4();
  MlRegs r0, r1;
  ml_chain_load<DIR>(p, h, sl, tok0 + (DIR ? N - 1 : 0) * 64, w, c, g, r0);
  for (int n = 0; n < N; n += 2) {
    const int c0 = DIR ? N - 1 - n : n;
    const int c1 = DIR ? N - 2 - n : n + 1;
    const int n2 = min(n + 2, N - 1);
    const int c2 = DIR ? N - 1 - n2 : n2;
    ml_chain_load<DIR>(p, h, sl, tok0 + c1 * 64, w, c, g, r1);
    ml_chain_compute<DIR>(p, h, sl, tok0 + c0 * 64, lane, w, c, g, r0, C, sCt0, dry);
    ml_chain_load<DIR>(p, h, sl, tok0 + c2 * 64, w, c, g, r0);
    ml_chain_compute<DIR>(p, h, sl, tok0 + c1 * 64, lane, w, c, g, r1, C, sCt1, dry);
  }
}

__device__ void ml_chain_item(const Params& p, int li, int item, char* smem, bool dry = false) {
  const int tid = otid(), lane = tid & 63, w = tid >> 6, c = lane & 15, g = lane >> 4;
  int pair, within;
  if (item < 512) { const int r = item >> 3; pair = (item & 7) + 8 * (r >> 4); within = r & 15; }
  else { const int it = item - 512; const int r = it >> 3; pair = 32 + (it & 7) + 8 * (r >> 4); within = r & 15; }
  const int sl = within & 7, dir = within >> 3;
  const int s = pair < 32 ? 4 + (pair >> 2) : ((pair - 32) >> 2);
  const int h = pair & 3;
  const int tok0 = s < 4 ? s * 4096 : T_P + (s - 4) * 8192;
  const int N = (s < 4 ? 4096 : 8192) / 64;
  bf16_t* sCt0 = (bf16_t*)smem;
  __syncthreads();
  if (dir == 0) ml_chain_run<0>(p, h, sl, tok0, N, lane, w, c, g, sCt0, dry);
  else ml_chain_run<1>(p, h, sl, tok0, N, lane, w, c, g, sCt0, dry);
}

#define ATTN_GLOAD(KT)                                                                              \
  {                                                                                                 \
    const long kb = tok0 + (KT) * 64;                                                               \
    rk0 = *(const bf16x8*)(p.KNb + (kb + (tid >> 3)) * 512 + head * 64 + 8 * (tid & 7));            \
    rk1 = *(const bf16x8*)(p.KNb + (kb + 32 + (tid >> 3)) * 512 + head * 64 + 8 * (tid & 7));       \
    rkr = *(const bf16x8*)(p.KRb + (kb + (tid >> 2)) * 32 + 8 * (tid & 3));                          \
    rv0 = *(const bf16x8*)(p.VtA + (long)(head * 64 + (tid >> 3)) * T_TOK + kb + 8 * (tid & 7));     \
    rv1 = *(const bf16x8*)(p.VtA + (long)(head * 64 + 32 + (tid >> 3)) * T_TOK + kb + 8 * (tid & 7)); \
  }
__device__ void attn_item(const Params& p, int item, char* smem, bool dry = false) {
  const int tid = otid(), lane = tid & 63, w = tid >> 6, c = lane & 15, g = lane >> 4;
  int s, head, qb;
  {
    const int x = item / 320, t = item % 320;
    if (t < 256) { const int pair = x + 8 * (t >> 5); qb = t & 31; s = 4 + (pair >> 3); head = pair & 7; }
    else { const int t2 = t - 256; const int pair = x + 8 * (t2 >> 4); qb = t2 & 15; s = pair >> 3; head = pair & 7; }
  }
  const int tok0 = s < 4 ? s * 4096 : T_P + (s - 4) * 8192;
  const int len = s < 4 ? 4096 : 8192;
  const int nkv = len / 64;
  bf16_t* sK = (bf16_t*)smem;
  bf16_t* sVt = sK + 64 * 104;
  const int qrow0 = tok0 + qb * 256 + 64 * w;
  bf16_t* sQr = sVt + 64 * 72;
  bf16x8 qf[4][2];
#pragma unroll
  for (int nt = 0; nt < 4; ++nt) {
#pragma unroll
    for (int ks = 0; ks < 2; ++ks)
      qf[nt][ks] = *(const bf16x8*)(p.Qa + (long)(qrow0 + 16 * nt + c) * 768 + head * 96 + 32 * ks + 8 * g);
    bf16x8 qr = *(const bf16x8*)(p.Qa + (long)(qrow0 + 16 * nt + c) * 768 + head * 96 + 64 + 8 * g);
    *(bf16x8*)(sQr + ((w * 4 + nt) * 64 + lane) * 8) = qr;
  }
  f32x4 ot[4][4];
#pragma unroll
  for (int vt = 0; vt < 4; ++vt)
#pragma unroll
    for (int nt = 0; nt < 4; ++nt) ot[vt][nt] = zero4();
  float mrun[4] = {-1e30f, -1e30f, -1e30f, -1e30f}, lrun[4] = {0.f, 0.f, 0.f, 0.f};
  bf16x8 rk0, rk1, rkr, rv0, rv1;
  ATTN_GLOAD(0)
  for (int kt = 0; kt < nkv; ++kt) {
    __syncthreads();
    *(bf16x8*)(sK + (tid >> 3) * 104 + 8 * (tid & 7)) = rk0;
    *(bf16x8*)(sK + (32 + (tid >> 3)) * 104 + 8 * (tid & 7)) = rk1;
    *(bf16x8*)(sK + (tid >> 2) * 104 + 64 + 8 * (tid & 3)) = rkr;
    *(bf16x8*)(sVt + (tid >> 3) * 72 + 8 * (tid & 7)) = rv0;
    *(bf16x8*)(sVt + (32 + (tid >> 3)) * 72 + 8 * (tid & 7)) = rv1;
    __syncthreads();
    if (kt + 1 < nkv) ATTN_GLOAD(kt + 1)
#pragma unroll 1
    for (int half = 0; half < 2; ++half) {
      f32x4 st[2][4];
#pragma unroll
      for (int k4 = 0; k4 < 2; ++k4)
#pragma unroll
        for (int nt = 0; nt < 4; ++nt) st[k4][nt] = zero4();
#pragma unroll
      for (int ks = 0; ks < 2; ++ks)
#pragma unroll
        for (int k4 = 0; k4 < 2; ++k4) {
          bf16x8 kf = *(const bf16x8*)(sK + (32 * half + 16 * k4 + c) * 104 + 32 * ks + 8 * g);
#pragma unroll
          for (int nt = 0; nt < 4; ++nt) st[k4][nt] = mfma16(kf, qf[nt][ks], st[k4][nt]);
        }
      {
        bf16x8 kr0 = *(const bf16x8*)(sK + (32 * half + c) * 104 + 64 + 8 * g);
        bf16x8 kr1 = *(const bf16x8*)(sK + (32 * half + 16 + c) * 104 + 64 + 8 * g);
#pragma unroll
        for (int nt = 0; nt < 4; ++nt) {
          bf16x8 qr = *(const bf16x8*)(sQr + ((w * 4 + nt) * 64 + lane) * 8);
          st[0][nt] = mfma16(kr0, qr, st[0][nt]);
          st[1][nt] = mfma16(kr1, qr, st[1][nt]);
        }
      }
      __builtin_amdgcn_sched_barrier(0);
      bf16x8 pb[4];
#pragma unroll
      for (int nt = 0; nt < 4; ++nt) {
        float mx = -1e30f;
#pragma unroll
        for (int k4 = 0; k4 < 2; ++k4)
#pragma unroll
          for (int j = 0; j < 4; ++j) mx = fmaxf(mx, st[k4][nt][j]);
        mx = rowmax4(mx);
        const float mn = fmaxf(mrun[nt], mx);
        const float alpha = __builtin_amdgcn_exp2f(mrun[nt] - mn);
        mrun[nt] = mn;
        float psum = 0.f;
#pragma unroll
        for (int k4 = 0; k4 < 2; ++k4)
#pragma unroll
          for (int j = 0; j < 4; ++j) {
            float pv = __builtin_amdgcn_exp2f(st[k4][nt][j] - mn);
            st[k4][nt][j] = pv;
            psum += pv;
          }
        lrun[nt] = lrun[nt] * alpha + psum;
#pragma unroll
        for (int vt = 0; vt < 4; ++vt) ot[vt][nt] = ot[vt][nt] * alpha;
        typedef __attribute__((ext_vector_type(4))) unsigned u32x4;
        u32x4 pk;
        pk[0] = pk2bf(st[0][nt][0], st[0][nt][1]);
        pk[1] = pk2bf(st[0][nt][2], st[0][nt][3]);
        pk[2] = pk2bf(st[1][nt][0], st[1][nt][1]);
        pk[3] = pk2bf(st[1][nt][2], st[1][nt][3]);
        pb[nt] = __builtin_bit_cast(bf16x8, pk);
      }
      __builtin_amdgcn_sched_barrier(0);
#pragma unroll
      for (int vt = 0; vt < 4; ++vt) {
        us4 lo = *(const us4*)(sVt + (16 * vt + c) * 72 + 32 * half + 4 * g);
        us4 hi = *(const us4*)(sVt + (16 * vt + c) * 72 + 32 * half + 16 + 4 * g);
        bf16x8 av;
#pragma unroll
        for (int e = 0; e < 4; ++e) { av[e] = (short)lo[e]; av[4 + e] = (short)hi[e]; }
#pragma unroll
        for (int nt = 0; nt < 4; ++nt) ot[vt][nt] = mfma16(av, pb[nt], ot[vt][nt]);
      }
    }
  }
#pragma unroll
  for (int nt = 0; nt < 4; ++nt) {
    float lt = lrun[nt];
    lt += sxor(lt, 16, lane);
    lt += sxor(lt, 32, lane);
    const float inv = 1.f / lt;
    const long tok = qrow0 + 16 * nt + c;
#pragma unroll
    for (int vt = 0; vt < 4; ++vt) {
      bf16_t* gp = p.MGb + tok * 512 + head * 64 + 16 * vt + 4 * g;
      us4 gt = *(const us4*)gp;
      us4 o;
#pragma unroll
      for (int j = 0; j < 4; ++j) o[j] = f2bf(ot[vt][nt][j] * inv * siluf_(bf2f(gt[j])));
      if (!dry) *(us4*)gp = o;
    }
  }
}

__device__ void phase_gla_combine(const Params& p, int li, bool dry = false) {
  const int tid_ = otid(); const int lane = tid_ & 63, w = tid_ >> 6;
  for (int tok = blockIdx.x * 4 + w; tok < T_TOK; tok += gridDim.x * 4) {
    const bf16_t* tp = p.TMP + (long)tok * 1024 + 16 * lane;
    bf16_t* gp = p.Gb + (long)tok * 1024 + 16 * lane;
    bf16x8 o0 = *(const bf16x8*)tp, o1 = *(const bf16x8*)(tp + 8);
    bf16x8 g0 = *(const bf16x8*)gp, g1 = *(const bf16x8*)(gp + 8);
    float ov[16], gv[16];
#pragma unroll
    for (int e = 0; e < 8; ++e) {
      ov[e] = bf2f((bf16_t)o0[e]); ov[8 + e] = bf2f((bf16_t)o1[e]);
      gv[e] = bf2f((bf16_t)g0[e]); gv[8 + e] = bf2f((bf16_t)g1[e]);
    }
    float ss = 0.f;
#pragma unroll
    for (int e = 0; e < 16; ++e) ss += ov[e] * ov[e];
    ss += sxor(ss, 1, lane); ss += sxor(ss, 2, lane); ss += sxor(ss, 4, lane); ss += sxor(ss, 8, lane);
    const float rs = rsqrtf(ss * (1.f / 256.f) + EPS);
    const float* ng = p.e_gla_norm_g + li * 256 + ((16 * lane) & 255);
    bf16x8 r0, r1;
#pragma unroll
    for (int e = 0; e < 8; ++e) {
      r0[e] = (short)f2bf(ov[e] * rs * ng[e] * siluf_(gv[e]));
      r1[e] = (short)f2bf(ov[8 + e] * rs * ng[8 + e] * siluf_(gv[8 + e]));
    }
    if (!dry) { *(bf16x8*)gp = r0;
    *(bf16x8*)(gp + 8) = r1; }
  }
}

__device__ void phase_ml_combine(const Params& p, int li, bool dry = false) {
  const int tid_ = otid(); const int lane = tid_ & 63, w = tid_ >> 6;
  for (int tok = blockIdx.x * 4 + w; tok < T_TOK; tok += gridDim.x * 4) {
    const long off = (long)tok * 512 + 8 * lane;
    bf16x8 hv = *(const bf16x8*)(p.NUMIf + off);
    bf16x8 hb = *(const bf16x8*)(p.NUMIb + off);
    bf16x8 mo = *(const bf16x8*)(p.MOb + off);
    bf16x8 mg = *(const bf16x8*)(p.MLGb + off);
    float hf[8];
    float ss = 0.f;
#pragma unroll
    for (int e = 0; e < 8; ++e) { hf[e] = bf2f((bf16_t)hv[e]) + bf2f((bf16_t)hb[e]); ss += hf[e] * hf[e]; }
    ss += sxor(ss, 1, lane); ss += sxor(ss, 2, lane); ss += sxor(ss, 4, lane); ss += sxor(ss, 8, lane);
    const float rs = rsqrtf(ss * (1.f / 128.f) + EPS);
    const float* ng = p.o_ml_norm_g + li * 128 + ((8 * lane) & 127);
    bf16x8 r;
#pragma unroll
    for (int e = 0; e < 8; ++e)
      r[e] = (short)f2bf(hf[e] * rs * ng[e] * sigmoidf_(bf2f((bf16_t)mo[e])) * siluf_(bf2f((bf16_t)mg[e])));
    if (!dry) *(bf16x8*)(p.MLGb + off) = r;
  }
}

__device__ void phase_final(const Params& p, bool dry = false) {
  const int tid_ = otid(); const int lane = tid_ & 63, w = tid_ >> 6;
  for (int tok = blockIdx.x * 4 + w; tok < T_TOK; tok += gridDim.x * 4) {
    float* xp = p.out + (long)tok * DM;
    float4 v[4];
    float ss = 0.f;
#pragma unroll
    for (int i = 0; i < 4; ++i) {
      v[i] = *(const float4*)(xp + 4 * lane + 256 * i);
      ss += v[i].x * v[i].x + v[i].y * v[i].y + v[i].z * v[i].z + v[i].w * v[i].w;
    }
#pragma unroll
    for (int d = 1; d < 64; d <<= 1) ss += sxor(ss, d, lane);
    const float rs = rsqrtf(ss * (1.f / 1024.f) + EPS);
#pragma unroll
    for (int i = 0; i < 4; ++i) {
      float4 gq = *(const float4*)(p.final_norm_g + 4 * lane + 256 * i);
      float4 o;
      o.x = v[i].x * rs * gq.x; o.y = v[i].y * rs * gq.y; o.z = v[i].z * rs * gq.z; o.w = v[i].w * rs * gq.w;
      if (!dry) *(float4*)(xp + 4 * lane + 256 * i) = o;
    }
  }
}

__device__ void run_phase(const Params& p, int ph, char* smem) {
  if (ph == 0) { if (PH_ON(0)) phase_prep(p, smem); return; }
  if (ph == NPHASE - 1) { if (PROBE_B) phase_final(p, true); if (PH_ON(11)) phase_final(p); return; }
  const int q = ph - 1;
  const int layer = (q < 5) ? 0 : (q < 12) ? 1 : (q < 17) ? 2 : 3;
  const int sub = (q < 5) ? q : (q < 12) ? q - 5 : (q < 17) ? q - 12 : q - 17;
  const int li = layer >> 1;
  const float* xa = (layer == 0) ? p.x_prompt : p.out;
  const float* xb = (layer == 0) ? p.x_sample : p.out + (long)T_P * DM;
  if ((layer & 1) == 0) {
    if (sub == 0) {
      EpiEvenIn e{p.Qb, p.Kt, p.VtE, p.Gb, p.LRb, p.PUb, p.PGb};
      if (PH_ON(1)) gemm_phase<3, 8>(T_TOK / 128, NE_PAD / 256, DM, p.WinE + (long)li * NE_PAD * DM, p.SSQ, nullptr, p.TMP, DM, DM, p.TMP, DM, e, smem);
    } else if (sub == 1) {
      for (int item = blockIdx.x; item < 5120; item += gridDim.x)
        if (PH_ON(2)) gla_intra_item(p, li, item, smem);
    } else if (sub == 2) {
      __shared__ int s_pitem;
      for (int item = blockIdx.x; item < 384; item += gridDim.x) { if (PH_ON(2)) gla_chain_item(p, li, item, smem, false); }
      for (;;) {
        __syncthreads();
        if (threadIdx.x == 0) s_pitem = atomicAdd(p.counters + 16 + li, 1);
        __syncthreads();
        const int item = s_pitem;
        if (item >= 5120) break;
        if (PH_ON(3)) pool_item(p, li, item, smem);
      }
    } else if (sub == 3) {
      if (PROBE_B) phase_gla_combine(p, li, true);
      if (PH_ON(4)) phase_gla_combine(p, li);
    } else {
      EpiOut e{xa, xb, p.out, false, p.NUMIf, p.SSQ};
      if (PH_ON(5)) gemm_phase<1, 8>(T_TOK / 128, DM / 256, 1536, p.WoutE + (long)li * DM * 1536, nullptr, nullptr, p.Gb, 1024, 1024, p.PGb, 512, e, smem);
    }
  } else {
    if (sub == 0) {
      EpiOddIn e{p.CQb, p.CKVb, p.KRb, p.MGb, p.MQb, p.MKb, p.MKt, p.MVt, p.MOb, p.MLGb, p.MIF};
      if (PH_ON(6)) gemm_phase<3, 8>(T_TOK / 128, NO_PAD / 256, DM, p.WinO + (long)li * NO_PAD * DM, p.SSQ, nullptr, p.NUMIf, DM, DM, p.NUMIf, DM, e, smem);
    } else if (sub == 1) {
      for (int rep = 0; rep < 1 + PROBE_A; ++rep)
      for (int item = blockIdx.x; item < 5120; item += gridDim.x)
        if (PH_ON(8)) ml_intra_item(p, li, item, smem);
    } else if (sub == 2) {
      for (int item = blockIdx.x; item < 768; item += gridDim.x)
        if (PH_ON(8)) ml_chain_item(p, li, item, smem, false);
    } else if (sub == 3) {
      if (PROBE_B) phase_ml_combine(p, li, true);
      if (PH_ON(10)) phase_ml_combine(p, li);
    } else if (sub == 4) {
      EpiQUp eq{p.Qa};
      if (PH_ON(7)) gemm_phase<2, 4>(T_TOK / 128, 768 / 128, 384, p.QupT + (long)li * 768 * 384, nullptr, nullptr, p.CQb, 384, 384, p.CQb, 384, eq, smem);
      EpiKVUp ek{p.KNb, p.VtA};
      if (PH_ON(7)) gemm_phase<2, 4>(T_TOK / 128, 1024 / 128, 256, p.KVupT + (long)li * 1024 * 256, nullptr, nullptr, p.CKVb, 256, 256, p.CKVb, 256, ek, smem);
    } else if (sub == 5) {
      __shared__ int s_item;
      for (;;) {
        __syncthreads();
        if (threadIdx.x == 0) s_item = atomicAdd(p.counters + li * 8 + (blockIdx.x & 7), 1);
        __syncthreads();
        const int item = s_item;
        if (item >= 320) break;
        if (PH_ON(9)) attn_item(p, (blockIdx.x & 7) * 320 + item, smem);
      }
    } else {
      EpiOut e{xa, xb, p.out, false, (layer == 3) ? nullptr : p.TMP, p.SSQ};
      if (PH_ON(5)) gemm_phase<1, 8>(T_TOK / 128, DM / 256, 1024, p.WoutO + (long)li * DM * 1024, nullptr, nullptr, p.MGb, 512, 512, p.MLGb, 512, e, smem);
    }
  }
}

__global__ void __launch_bounds__(256, 2) mega_kernel(Params p) {
  extern __shared__ __attribute__((aligned(16))) char smem[];
  cg::grid_group grid = cg::this_grid();
  __shared__ uint4 xb_words;
  if (threadIdx.x == 0) xb_words = make_uint4(0u, 0u, 0u, 0u);
  __syncthreads();
  XcdBarrier xb = xcd_barrier_post(p.bar, (volatile LAS unsigned*)&xb_words);
  for (int ph = p.ph_lo; ph < p.ph_hi; ++ph) {
    if (ph > p.ph_lo) {
      if (ph == p.ph_lo + 1) grid.sync();
      else xcd_barrier(xb);
    }
    run_phase(p, ph, smem);
  }
}

extern "C" void kernel_launch(void* const* d_in, const int* in_sizes, int n_in, void* d_out, int out_size, void* d_ws,
                              size_t ws_size, hipStream_t stream) {
  static int grid_blocks = 0;
  if (!grid_blocks) {
    int dev = 0, cus = 0, per_cu = 0;
    hipGetDevice(&dev);
    hipDeviceGetAttribute(&cus, hipDeviceAttributeMultiprocessorCount, dev);
    hipFuncSetAttribute((const void*)mega_kernel, hipFuncAttributeMaxDynamicSharedMemorySize, LDS_BYTES);
    hipOccupancyMaxActiveBlocksPerMultiprocessor(&per_cu, (const void*)mega_kernel, 256, LDS_BYTES);
    if (per_cu < 1) per_cu = 1;
    if (per_cu > 2) per_cu = 2;
    grid_blocks = cus * per_cu;
    fprintf(stderr, "kernel_launch: cus %d per_cu %d grid %d ws %zu\n", cus, per_cu, grid_blocks, ws_size);
  }
  Params p{};
  const float** pin = (const float**)&p;
  for (int i = 0; i < 19; ++i) pin[i] = (const float*)d_in[i];
  p.out = (float*)d_out;
  char* ws = (char*)d_ws;
  size_t off = 0;
  auto take = [&](size_t bytes) { char* r = ws + off; off += (bytes + 255) & ~(size_t)255; return r; };
  p.WinE = (bf16_t*)take((size_t)2 * NE_PAD * DM * 2);
  p.WinO = (bf16_t*)take((size_t)2 * NO_PAD * DM * 2);
  p.WoutE = (bf16_t*)take((size_t)2 * DM * 1536 * 2);
  p.WoutO = (bf16_t*)take((size_t)2 * DM * 1024 * 2);
  p.QupT = (bf16_t*)take((size_t)2 * 768 * 384 * 2);
  p.KVupT = (bf16_t*)take((size_t)2 * 1024 * 256 * 2);
  p.PoolWT = (bf16_t*)take((size_t)2 * 4 * 128 * 128 * 2);
  p.AupT = (bf16_t*)take((size_t)2 * 2 * 512 * 32 * 2);
  p.counters = (int*)take(256);
  p.bar = (unsigned*)take((size_t)XCD_BAR_WORDS * 4);
  p.SSQ = (float*)take((size_t)T_TOK * 8 * 4);
  const size_t act0 = off;
  const size_t T = T_TOK;
  p.Gb = (bf16_t*)take(T * 1024 * 2);
  p.PGb = (bf16_t*)take(T * 512 * 2);
  p.Qb = (bf16_t*)take(T * 512 * 2);
  p.Kt = (bf16_t*)take(T * 512 * 2);
  p.QEb = (bf16_t*)take(T * 512 * 2);
  p.KdTb = (bf16_t*)take(T * 512 * 2);
  p.EB = (float*)take((size_t)2 * 1280 * 512 * 4);
  p.VtE = (bf16_t*)take(T * 1024 * 2);
  p.LRb = (bf16_t*)take(T * 32 * 2);
  p.PUb = (bf16_t*)take(T * 512 * 2);
  p.TMP = (bf16_t*)take(T * 1024 * 2);
  const size_t even_end = off;
  off = act0;
  p.MGb = (bf16_t*)take(T * 512 * 2);
  p.MLGb = (bf16_t*)take(T * 512 * 2);
  p.CQb = (bf16_t*)take(T * 384 * 2);
  p.CKVb = (bf16_t*)take(T * 256 * 2);
  p.KRb = (bf16_t*)take(T * 32 * 2);
  const size_t r2 = off;
  p.MQb = (bf16_t*)take(T * 512 * 2);
  p.MKb = (bf16_t*)take(T * 512 * 2);
  p.MKt = (bf16_t*)take(T * 512 * 2);
  p.MVt = (bf16_t*)take(T * 512 * 2);
  p.MOb = (bf16_t*)take(T * 512 * 2);
  p.NUMIf = (bf16_t*)take(T * 512 * 2);
  p.NUMIb = (bf16_t*)take(T * 512 * 2);
  p.MIF = (float*)take(T * 16 * 4);
  p.EBI = (float*)take(T * 8 * 4);
  p.WKg = (float*)take(T * 8 * 4);
  p.DENI = (float*)take(T * 8 * 4);
  p.DEC = (float*)take((size_t)8 * 1280 * 4);
  const size_t r2_end = off;
  off = r2;
  p.Qa = (bf16_t*)take(T * 768 * 2);
  p.KNb = (bf16_t*)take(T * 512 * 2);
  p.VtA = (bf16_t*)take(T * 512 * 2);
  if (off < r2_end) off = r2_end;
  const size_t odd_end = off;
  const size_t need = even_end > odd_end ? even_end : odd_end;
  if (need > ws_size) {
    fprintf(stderr, "kernel_launch: workspace too small: need %zu have %zu\n", need, ws_size);
    return;
  }
  hipMemsetAsync(p.bar, 0, (size_t)XCD_BAR_WORDS * 4, stream);
#if SINGLE_LAUNCH
  p.ph_lo = 0;
  p.ph_hi = NPHASE;
  void* args[] = {&p};
  hipError_t e = hipLaunchCooperativeKernel((const void*)mega_kernel, dim3(grid_blocks), dim3(256), args, LDS_BYTES, stream);
  if (e != hipSuccess) fprintf(stderr, "cooperative launch failed: %s (grid %d)\n", hipGetErrorString(e), grid_blocks);
#else
  for (int ph = 0; ph < NPHASE; ++ph) {
    p.ph_lo = ph;
    p.ph_hi = ph + 1;
    hipLaunchKernelGGL(mega_kernel, dim3(grid_blocks), dim3(256), LDS_BYTES, stream, p);
  }
#endif
}
```

```cpp
#include <hip/hip_runtime.h>
#include <hip/hip_cooperative_groups.h>
#include <cstdio>
namespace cg = cooperative_groups;

#ifndef SINGLE_LAUNCH
#define SINGLE_LAUNCH 1
#endif
#ifndef PHMASK
#define PHMASK 0xFFFF
#endif
#define PH_ON(b) ((PHMASK >> (b)) & 1)
#ifndef PROBE_GEMM
#define PROBE_GEMM 0
#endif
#ifndef PROBE_ATTN
#define PROBE_ATTN 0
#endif
#ifndef PROBE_CHAIN
#define PROBE_CHAIN 0
#endif
#ifndef PROBE_A
#define PROBE_A 0
#endif
#ifndef PROBE_B
#define PROBE_B 0
#endif
#ifndef PROBE_MLCHAIN
#define PROBE_MLCHAIN 0
#endif

typedef unsigned short bf16_t;
typedef __attribute__((ext_vector_type(8))) short bf16x8;
typedef __attribute__((ext_vector_type(4))) float f32x4;
typedef __attribute__((ext_vector_type(4))) unsigned short us4;

constexpr int T_TOK = 81920;
constexpr int T_P = 16384;
constexpr int DM = 1024;
constexpr int NE = 4128, NE_PAD = 4352;
constexpr int NO = 3760, NO_PAD = 3840;
constexpr float EPS = 1e-6f;
constexpr int NPHASE = 26;
constexpr int LDS_BYTES = 72 * 1024;

struct Params {
  const float *x_prompt, *x_sample, *norm_g, *final_norm_g, *e_w_in, *e_a_up, *e_a_bias, *e_gla_norm_g,
      *e_pool_w, *e_pool_scale, *e_w_out, *o_w_in, *o_q_norm_g, *o_q_up, *o_kv_norm_g, *o_kv_up, *o_if_bias,
      *o_ml_norm_g, *o_w_out;
  float* out;
  bf16_t *WinE, *WinO, *WoutE, *WoutO, *QupT, *KVupT, *PoolWT, *AupT;
  int* counters;
  unsigned* bar;
  float* SSQ;
  bf16_t *Qb, *Kt, *VtE, *Gb, *LRb, *PUb, *PGb, *TMP, *QEb, *KdTb;
  float* EB;
  bf16_t *CQb, *CKVb, *KRb, *MGb, *MQb, *MKb, *MKt, *MVt, *MOb, *MLGb, *NUMIf, *NUMIb, *Qa, *KNb, *VtA;
  float *MIF, *EBI, *WKg, *DENI, *DEC;
  int ph_lo, ph_hi;
};

typedef __bf16 hbf2 __attribute__((ext_vector_type(2)));
typedef float hf2 __attribute__((ext_vector_type(2)));
__device__ __forceinline__ bf16_t f2bf(float f) {
  __bf16 b = (__bf16)f;
  return __builtin_bit_cast(bf16_t, b);
}
__device__ __forceinline__ unsigned pk2bf(float a, float b) {
  hf2 v = {a, b};
  hbf2 r = __builtin_convertvector(v, hbf2);
  return __builtin_bit_cast(unsigned, r);
}
__device__ __forceinline__ float bf2f(bf16_t b) { return __uint_as_float(((unsigned)b) << 16); }
__device__ __forceinline__ f32x4 mfma16(bf16x8 a, bf16x8 b, f32x4 c) {
  return __builtin_amdgcn_mfma_f32_16x16x32_bf16(a, b, c, 0, 0, 0);
}
__device__ __forceinline__ float logsigmoidf_(float x) { return fminf(x, 0.f) - log1pf(__expf(-fabsf(x))); }
__device__ __forceinline__ float siluf_(float x) { return x / (1.f + __expf(-x)); }
__device__ __forceinline__ float sigmoidf_(float x) { return 1.f / (1.f + __expf(-x)); }
__device__ __forceinline__ int otid() { int t = threadIdx.x; asm volatile("" : "+v"(t)); return t; }
__device__ __forceinline__ float bperm(int srclane, float v) { return __int_as_float(__builtin_amdgcn_ds_bpermute(srclane << 2, __float_as_int(v))); }
__device__ __forceinline__ float sxor(float v, int m, int lane) { return bperm(lane ^ m, v); }
typedef unsigned u32x2_t __attribute__((ext_vector_type(2)));
__device__ __forceinline__ float rowmax4(float v) {
  u32x2_t r = __builtin_amdgcn_permlane16_swap(__float_as_uint(v), __float_as_uint(v), false, false);
  v = fmaxf(__uint_as_float(r[0]), __uint_as_float(r[1]));
  r = __builtin_amdgcn_permlane32_swap(__float_as_uint(v), __float_as_uint(v), false, false);
  return fmaxf(__uint_as_float(r[0]), __uint_as_float(r[1]));
}
__device__ __forceinline__ bf16x8 zero8() { bf16x8 z = {0, 0, 0, 0, 0, 0, 0, 0}; return z; }
__device__ __forceinline__ f32x4 zero4() { f32x4 z = {0.f, 0.f, 0.f, 0.f}; return z; }

__device__ __forceinline__ int seq_pos(int tok) { return tok < T_P ? (tok & 4095) : ((tok - T_P) & 8191); }
__device__ __forceinline__ const float* xrow(const float* xa, const float* xb, int tok) {
  return tok < T_P ? xa + (long)tok * DM : xb + (long)(tok - T_P) * DM;
}


#define XB_TMO      128
#define XB_XCNT(j)  (256  + 64 * (j))
#define XB_XSUB(j)  (1280 + 64 * (j))
#define XB_XGEN(j)  (2304 + 64 * (j))
#define XB_TOP      3328
#define XB_TOPGEN   3392
#define XCD_BAR_WORDS 3456
#define XB_SPIN_CAP (1u << 22)
#define LAS __attribute__((address_space(3)))
__device__ __forceinline__ unsigned xb_ld(unsigned* p) { return __hip_atomic_load(p, __ATOMIC_RELAXED, __HIP_MEMORY_SCOPE_AGENT); }
__device__ __forceinline__ unsigned xb_add(unsigned* p, unsigned v) { return __hip_atomic_fetch_add(p, v, __ATOMIC_RELAXED, __HIP_MEMORY_SCOPE_AGENT); }
__device__ __forceinline__ unsigned xb_xcc_id() { return (unsigned)__builtin_amdgcn_s_getreg((3 << 11) | 20) & 0xFu; }
#define XB_SPIN(cond, bar) do { unsigned _sp = 0; while (cond) { __builtin_amdgcn_s_sleep(1); \
    if ((++_sp & 255u) == 0u) { if (xb_ld(&(bar)[XB_TMO])) break; if (_sp > XB_SPIN_CAP) { atomicAdd(&(bar)[XB_TMO], 1u); break; } } } } while (0)
struct XcdBarrier { unsigned* bar; unsigned x; volatile LAS unsigned* st; };
__device__ __forceinline__ XcdBarrier xcd_barrier_post(unsigned* bar, volatile LAS unsigned* st) {
  XcdBarrier b; b.bar = bar; b.x = xb_xcc_id(); b.st = st;
  if (threadIdx.x == 0) (void)xb_add(&bar[XB_XCNT(b.x)], 1u);
  return b;
}
__device__ __forceinline__ void xcd_barrier_complete(unsigned* bar, unsigned x, unsigned& nloc, unsigned& nx) {
  const unsigned G = gridDim.x * gridDim.y * gridDim.z;
  unsigned sum, cnt, mine, sp = 0u;
  for (;;) {
    sum = 0u; cnt = 0u; mine = 0u;
#pragma unroll
    for (unsigned j = 0; j < 16; ++j) { const unsigned cc = xb_ld(&bar[XB_XCNT(j)]); sum += cc; cnt += (cc > 0u) ? 1u : 0u; mine = (j == x) ? cc : mine; }
    if (sum == G) break;
    __builtin_amdgcn_s_sleep(1);
    if ((++sp & 255u) == 0u) { if (xb_ld(&bar[XB_TMO])) break; if (sp > XB_SPIN_CAP) { atomicAdd(&bar[XB_TMO], 1u); break; } }
  }
  nloc = mine > 0u ? mine : 1u; nx = cnt > 0u ? cnt : 1u;
}
__device__ __forceinline__ void xcd_barrier(const XcdBarrier& b) {
  asm volatile("s_waitcnt vmcnt(0)" ::: "memory");
  __syncthreads();
  if (threadIdx.x == 0) {
    unsigned* bar = b.bar;
    __builtin_amdgcn_s_waitcnt(0);
    unsigned nloc = b.st[0], nx = b.st[1];
    if (nloc == 0u) { xcd_barrier_complete(bar, b.x, nloc, nx); b.st[0] = nloc; b.st[1] = nx; }
    const unsigned old = xb_add(&bar[XB_XSUB(b.x)], 1u);
    const unsigned gen = old / nloc;
    if (old + 1u == (gen + 1u) * nloc) {
      __builtin_amdgcn_fence(__ATOMIC_RELEASE, "agent");
      asm volatile("s_waitcnt vmcnt(0)" ::: "memory");
      const unsigned og = xb_add(&bar[XB_TOP], 1u);
      const unsigned tg = og / nx;
      if (og + 1u == (tg + 1u) * nx) xb_add(&bar[XB_TOPGEN], 1u);
      else XB_SPIN(xb_ld(&bar[XB_TOPGEN]) == tg, bar);
      __builtin_amdgcn_fence(__ATOMIC_ACQUIRE, "agent");
      xb_add(&bar[XB_XGEN(b.x)], 1u);
      asm volatile("s_waitcnt vmcnt(0)" ::: "memory");
    } else {
      XB_SPIN(xb_ld(&bar[XB_XGEN(b.x)]) == gen, bar);
      __builtin_amdgcn_fence(__ATOMIC_ACQUIRE, "agent");
      asm volatile("s_waitcnt vmcnt(0)" ::: "memory");
    }
  }
  __syncthreads();
}

__device__ __forceinline__ int colmap(int mode, int n) {
  if (mode == 1) {
    if (n < 512) return 2208 + n;
    if (n < 1024) return 1696 + (n - 512);
    if (n < 1408) return n - 1024;
    if (n < 1664) return 384 + (n - 1408);
    if (n < 2176) return 672 + (n - 1664);
    if (n < 2688) return 1184 + (n - 2176);
    if (n < 3200) return 2720 + (n - 2688);
    if (n < 3712) return 3248 + (n - 3200);
    if (n < 3744) return 640 + (n - 3712);
    return 3232 + (n - 3744);
  }
  if (mode == 2) {
    if (n < 512) return (n >> 6) * 96 + (n & 63);
    const int r = n - 512;
    return (r >> 5) * 96 + 64 + (r & 31);
  }
  if (mode == 3) {
    if (n < 512) return (n >> 6) * 128 + (n & 63);
    const int r = n - 512;
    return (r >> 6) * 128 + 64 + (r & 63);
  }
  return n;
}

__device__ void prep_weight(const float* __restrict__ W, int K, int N, int Npad, const float* __restrict__ gsc,
                            bf16_t* __restrict__ out, char* smem, int mode = 0, int Nsrc_ = 0) {
  const int Nsrc = Nsrc_ ? Nsrc_ : N;
  const int tid = otid();
  float* sT = (float*)smem;
  const int tn = Npad >> 6, tk = K >> 6;
  for (int tile = blockIdx.x; tile < tn * tk; tile += gridDim.x) {
    const int n0 = (tile / tk) << 6, k0 = (tile % tk) << 6;
    __syncthreads();
#pragma unroll 4
    for (int i = 0; i < 16; ++i) {
      const int idx = tid + 256 * i;
      const int kk = idx >> 6, nn = idx & 63;
      float v = 0.f;
      if (n0 + nn < N) {
        v = W[(size_t)(k0 + kk) * Nsrc + colmap(mode, n0 + nn)];
        if (gsc) v *= gsc[k0 + kk];
      }
      sT[nn * 65 + kk] = v;
    }
    __syncthreads();
#pragma unroll 4
    for (int i = 0; i < 16; ++i) {
      const int idx = tid + 256 * i;
      const int nn = idx >> 6, kk = idx & 63;
      out[(size_t)(n0 + nn) * K + k0 + kk] = f2bf(sT[nn * 65 + kk]);
    }
  }
}

__device__ void phase_prep(const Params& p, char* smem) {
  long gtid = (long)blockIdx.x * 256 + otid();
  long gsize = (long)gridDim.x * 256;
  for (int l = 0; l < 2; ++l) {
    prep_weight(p.e_w_in + (long)l * DM * NE, DM, NE, NE_PAD, p.norm_g + (2 * l) * DM, p.WinE + (long)l * NE_PAD * DM, smem);
    prep_weight(p.o_w_in + (long)l * DM * 3760, DM, NO, NO_PAD, p.norm_g + (2 * l + 1) * DM, p.WinO + (long)l * NO_PAD * DM, smem, 1, 3760);
    prep_weight(p.e_w_out + (long)l * 1536 * DM, 1536, DM, DM, nullptr, p.WoutE + (long)l * DM * 1536, smem);
    prep_weight(p.o_w_out + (long)l * 1024 * DM, 1024, DM, DM, nullptr, p.WoutO + (long)l * DM * 1024, smem);
    prep_weight(p.o_q_up + (long)l * 384 * 768, 384, 768, 768, p.o_q_norm_g + l * 384, p.QupT + (long)l * 768 * 384, smem, 2);
    prep_weight(p.o_kv_up + (long)l * 256 * 1024, 256, 1024, 1024, p.o_kv_norm_g + l * 256, p.KVupT + (long)l * 1024 * 256, smem, 3);
    for (int gi = 0; gi < 4; ++gi)
      prep_weight(p.e_pool_w + (long)(l * 4 + gi) * 128 * 128, 128, 128, 128, nullptr, p.PoolWT + (long)(l * 4 + gi) * 128 * 128, smem);
    for (long idx = gtid; idx < 2 * 512 * 32; idx += gsize) {
      int r = (int)(idx & 31);
      int d = (int)((idx >> 5) & 511);
      int dir = (int)(idx >> 14);
      float v = (r < 16) ? p.e_a_up[((long)(l * 2 + dir) * 16 + r) * 512 + d] : 0.f;
      p.AupT[((long)(l * 2 + dir) * 512 + d) * 32 + r] = f2bf(v);
    }
  }
  if (gtid < 32) p.counters[gtid] = 0;
  {
    const int tid_ = otid();
    const int lane = tid_ & 63, w = tid_ >> 6;
    for (int tok = blockIdx.x * 4 + w; tok < T_TOK; tok += gridDim.x * 4) {
      const float* xp = xrow(p.x_prompt, p.x_sample, tok) + 16 * lane;
      float ssv = 0.f;
      unsigned pk[8];
#pragma unroll
      for (int i = 0; i < 4; ++i) {
        const f32x4 v = *(const f32x4*)(xp + 4 * i);
        ssv += v[0] * v[0] + v[1] * v[1] + v[2] * v[2] + v[3] * v[3];
        pk[2 * i] = pk2bf(v[0], v[1]);
        pk[2 * i + 1] = pk2bf(v[2], v[3]);
      }
      uint4 o0, o1;
      o0.x = pk[0]; o0.y = pk[1]; o0.z = pk[2]; o0.w = pk[3];
      o1.x = pk[4]; o1.y = pk[5]; o1.z = pk[6]; o1.w = pk[7];
      *(uint4*)(p.TMP + (size_t)tok * DM + 16 * lane) = o0;
      *(uint4*)(p.TMP + (size_t)tok * DM + 16 * lane + 8) = o1;
#pragma unroll
      for (int d = 1; d < 64; d <<= 1) ssv += sxor(ssv, d, lane);
      if (lane < 8) p.SSQ[(size_t)tok * 8 + lane] = (lane == 0) ? ssv : 0.f;
    }
  }
}

constexpr int G_LD = 40;
constexpr int G_BUF = (128 + 256) * G_LD;

template <int AMODE, int NI, class Epi>
__device__ __forceinline__ void gemm_phase(int Mtiles, int Ntiles, int K, const bf16_t* __restrict__ Bt, const float* ssq, const float* unused_,
                           const bf16_t* A1, int ld1, int K1, const bf16_t* A2, int ld2, const Epi& epi, char* smem) {
  bf16_t* sbase = (bf16_t*)smem;
  float* sR = (float*)(smem + 70144);
  const int tid = otid(), lane = tid & 63, w = tid >> 6, c = lane & 15, g = lane >> 4;
  const int wm = w >> 1, wn = w & 1;
  const int nk = K / 32;
  const int xcd = blockIdx.x & 7, lb0 = blockIdx.x >> 3, nlb = gridDim.x >> 3;
  const int mper = Mtiles >> 3;
  for (int lt = lb0; lt < mper * Ntiles; lt += nlb) {
    const int mt = xcd * mper + lt / Ntiles, nt = lt % Ntiles;
    constexpr int BN = 32 * NI;
    const int m0 = mt * 128, n0 = nt * BN;
    f32x4 acc[4][NI];
#pragma unroll
    for (int i = 0; i < 4; ++i)
#pragma unroll
      for (int j = 0; j < NI; ++j) acc[i][j] = zero4();
    float ss[2] = {0.f, 0.f};
    bf16x8 ra0[2], ra1[2];
    bf16x8 rb0[NI / 2], rb1[NI / 2];
    const unsigned boff = (unsigned)(tid >> 2) * K + 8 * (tid & 3);
    const bf16_t* bbase = Bt + (size_t)n0 * K;
#define G_LOAD(RA, RB, KT)                                                                          \
  {                                                                                                 \
    const int k0_ = (KT) * 32;                                                                      \
    const bf16_t* base_;                                                                            \
    int ld_;                                                                                        \
    if (k0_ < K1) { base_ = A1 + (size_t)m0 * ld1 + k0_; ld_ = ld1; }                               \
    else { base_ = A2 + (size_t)m0 * ld2 + (k0_ - K1); ld_ = ld2; }                                 \
    _Pragma("unroll") for (int i = 0; i < 2; ++i)                                                   \
      RA[i] = *(const bf16x8*)(base_ + (unsigned)((tid >> 2) + 64 * i) * ld_ + 8 * (tid & 3));      \
    _Pragma("unroll") for (int i = 0; i < NI / 2; ++i)                                              \
      RB[i] = *(const bf16x8*)(bbase + k0_ + boff + (unsigned)(64 * i) * K);                        \
  }
#define G_STORE(RA, RB, BUF)                                                                        \
  {                                                                                                 \
    bf16_t* sA_ = sbase + (BUF) * G_BUF;                                                            \
    bf16_t* sB_ = sA_ + 128 * G_LD;                                                                 \
    _Pragma("unroll") for (int i = 0; i < 2; ++i) {                                                 \
      bf16x8 v = RA[i];                                                                             \
      if constexpr (AMODE == 2) {                                                                   \
        _Pragma("unroll") for (int e = 0; e < 8; ++e) {                                             \
          float f = bf2f((bf16_t)v[e]);                                                             \
          ss[i] += f * f;                                                                           \
        }                                                                                           \
      }                                                                                             \
      *(bf16x8*)(sA_ + ((tid >> 2) + 64 * i) * G_LD + 8 * (tid & 3)) = v;                           \
    }                                                                                               \
    _Pragma("unroll") for (int i = 0; i < NI / 2; ++i)                                              \
      *(bf16x8*)(sB_ + ((tid >> 2) + 64 * i) * G_LD + 8 * (tid & 3)) = RB[i];                       \
  }
#define G_COMPUTE(BUF)                                                                              \
  {                                                                                                 \
    const bf16_t* sA_ = sbase + (BUF) * G_BUF;                                                      \
    const bf16_t* sB_ = sA_ + 128 * G_LD;                                                           \
    bf16x8 af[4];                                                                                   \
    _Pragma("unroll") for (int mi = 0; mi < 4; ++mi)                                                \
      af[mi] = *(const bf16x8*)(sA_ + (wm * 64 + mi * 16 + c) * G_LD + g * 8);                      \
    bf16x8 bq[2];                                                                                   \
    bq[0] = *(const bf16x8*)(sB_ + (wn * (16 * NI) + c) * G_LD + g * 8);                            \
    _Pragma("unroll") for (int ni = 0; ni < NI; ++ni) {                                             \
      if (ni + 1 < NI)                                                                              \
        bq[(ni + 1) & 1] = *(const bf16x8*)(sB_ + (wn * (16 * NI) + (ni + 1) * 16 + c) * G_LD + g * 8); \
      _Pragma("unroll") for (int mi = 0; mi < 4; ++mi) acc[mi][ni] = mfma16(af[mi], bq[ni & 1], acc[mi][ni]); \
    }                                                                                               \
  }
    __syncthreads();
    if constexpr (AMODE == 3) {
      if (tid < 128) {
        const f32x4 p0 = *(const f32x4*)(ssq + (size_t)(m0 + tid) * 8);
        const f32x4 p1 = *(const f32x4*)(ssq + (size_t)(m0 + tid) * 8 + 4);
        const float sv = (p0[0] + p0[1]) + (p0[2] + p0[3]) + (p1[0] + p1[1]) + (p1[2] + p1[3]);
        sR[tid] = rsqrtf(sv * (1.f / 1024.f) + EPS);
      }
    }
    G_LOAD(ra0, rb0, 0)
    G_LOAD(ra1, rb1, 1)
    G_STORE(ra0, rb0, 0)
    __syncthreads();
    for (int kt = 0; kt < nk; kt += 2) {
      G_LOAD(ra0, rb0, min(kt + 2, nk - 1))
      G_COMPUTE(0)
      G_STORE(ra1, rb1, 1)
      __syncthreads();
      G_LOAD(ra1, rb1, min(kt + 3, nk - 1))
      G_COMPUTE(1)
      if (kt + 2 < nk) G_STORE(ra0, rb0, 0)
      __syncthreads();
    }
    if constexpr (AMODE == 2) {
#pragma unroll
      for (int i = 0; i < 2; ++i) {
        float sv = ss[i];
        sv += sxor(sv, 1, lane); sv += sxor(sv, 2, lane);
        if ((tid & 3) == 0) sR[(tid >> 2) + 64 * i] = rsqrtf(sv / (float)K + EPS);
      }
      __syncthreads();
    }
    if constexpr (Epi::staged) {
      bf16_t* sT = sbase;
      const float esc = epi.scale();
      const bool both = epi.both(n0);
#pragma unroll 1
      for (int pass = 0; pass < (both ? 2 : 1); ++pass) {
      const bool tr = both ? (pass == 1) : epi.transposed(n0);
      if (pass) __syncthreads();
      if (tr) {
#pragma unroll
        for (int mi = 0; mi < 4; ++mi) {
          const int row = wm * 64 + mi * 16 + 4 * g;
          const float r0 = sR[row] * esc, r1 = sR[row + 1] * esc, r2 = sR[row + 2] * esc, r3 = sR[row + 3] * esc;
#pragma unroll
          for (int ni = 0; ni < NI; ++ni) {
            uint2 o;
            o.x = pk2bf(acc[mi][ni][0] * r0, acc[mi][ni][1] * r1);
            o.y = pk2bf(acc[mi][ni][2] * r2, acc[mi][ni][3] * r3);
            *(uint2*)(sT + (wn * (16 * NI) + ni * 16 + c) * 136 + row) = o;
          }
        }
      } else {
#pragma unroll
        for (int mi = 0; mi < 4; ++mi) {
          const int row = wm * 64 + mi * 16 + 4 * g;
          const float r0 = sR[row] * esc, r1 = sR[row + 1] * esc, r2 = sR[row + 2] * esc, r3 = sR[row + 3] * esc;
#pragma unroll
          for (int ni = 0; ni < NI; ++ni) {
            bf16_t* d = sT + row * (BN + 8) + wn * (16 * NI) + ni * 16 + c;
            d[0] = f2bf(acc[mi][ni][0] * r0);
            d[BN + 8] = f2bf(acc[mi][ni][1] * r1);
            d[2 * (BN + 8)] = f2bf(acc[mi][ni][2] * r2);
            d[3 * (BN + 8)] = f2bf(acc[mi][ni][3] * r3);
          }
        }
      }
      if (pass == 0) epi.template direct<NI>(m0, n0, wm, wn, g, c, acc, sR);
      __syncthreads();
      if (tr) {
#pragma unroll 4
        for (int i = 0; i < 2 * NI; ++i) {
          const int id = tid + 256 * i;
          const int col = id >> 4, rc = id & 15;
          bf16x8 v = *(const bf16x8*)(sT + col * 136 + 8 * rc);
          epi.store_t(m0 + 8 * rc, n0 + col, v);
        }
      } else {
#pragma unroll 4
        for (int i = 0; i < 2 * NI; ++i) {
          const int id = tid + 256 * i;
          const int row = id / (4 * NI), cc = id % (4 * NI);
          const bf16_t* sp = sT + row * (BN + 8) + 8 * cc;
          bf16x8 v = *(const bf16x8*)sp;
          epi.store_n(m0 + row, n0 + 8 * cc, v, sp);
        }
      }
      }
    } else {
      float* sF = (float*)smem;
#pragma unroll 1
      for (int half = 0; half < 2; ++half) {
        if (half) __syncthreads();
        if (wm == half) {
#pragma unroll
          for (int mi = 0; mi < 4; ++mi)
#pragma unroll
            for (int ni = 0; ni < NI; ++ni)
#pragma unroll
              for (int j = 0; j < 4; ++j) sF[(mi * 16 + 4 * g + j) * 260 + wn * (16 * NI) + ni * 16 + c] = acc[mi][ni][j];
        }
        __syncthreads();
#pragma unroll 4
        for (int i = 0; i < 16; ++i) {
          const int row = w * 16 + i;
          const int tok = m0 + half * 64 + row;
          const int col = n0 + 4 * lane;
          const f32x4 a = *(const f32x4*)(sF + row * 260 + 4 * lane);
          const f32x4 xo = *(const f32x4*)(xrow(epi.xa, epi.xb, tok) + col);
          f32x4 xn;
          xn[0] = xo[0] + a[0]; xn[1] = xo[1] + a[1]; xn[2] = xo[2] + a[2]; xn[3] = xo[3] + a[3];
          float sv = xn[0] * xn[0] + xn[1] * xn[1] + xn[2] * xn[2] + xn[3] * xn[3];
#pragma unroll
          for (int d = 1; d < 64; d <<= 1) sv += sxor(sv, d, lane);
          if (!epi.dry) {
            *(f32x4*)(epi.out + (size_t)tok * DM + col) = xn;
            if (epi.hb) {
              uint2 o;
              o.x = pk2bf(xn[0], xn[1]);
              o.y = pk2bf(xn[2], xn[3]);
              *(uint2*)(epi.hb + (size_t)tok * DM + col) = o;
            }
            if (lane == 0) epi.ssq[(size_t)tok * 8 + (n0 >> 8)] = sv;
          }
        }
      }
    }
  }
#undef G_LOAD
#undef G_STORE
#undef G_COMPUTE
}

__device__ __forceinline__ void rope_cs(int pos, int i, float& co, float& si) {
  float inv = exp2f(-(float)i * (13.287712379549449f / 16.f));
  float ang = (float)pos * inv;
  float n = rintf(ang * 0.15915494309189535f);
  float r = fmaf(-n, 6.28125f, ang);
  r = fmaf(-n, 0.0019353071795864769f, r);
  float rf = r * 0.15915494309189535f;
  si = __builtin_amdgcn_sinf(rf);
  co = __builtin_amdgcn_cosf(rf);
}

__device__ __forceinline__ void rope_chunk(int pos, int i0, bf16x8 x1, bf16x8 x2, bf16x8& o1, bf16x8& o2) {
#pragma unroll
  for (int e = 0; e < 8; ++e) {
    float co, si;
    rope_cs(pos, i0 + e, co, si);
    float a = bf2f((bf16_t)x1[e]), b = bf2f((bf16_t)x2[e]);
    o1[e] = (short)f2bf(a * co - b * si);
    o2[e] = (short)f2bf(b * co + a * si);
  }
}

struct EpiEvenIn {
  static constexpr bool staged = true;
  bf16_t *Qb, *Kt, *VtE, *Gb, *LRb, *PUb, *PGb;
  __device__ float scale() const { return 1.f; }
  __device__ bool transposed(int n0) const { return n0 >= 512 && n0 < 2048; }
  __device__ bool both(int n0) const { return false; }
  template <int NI> __device__ void direct(int m0, int n0, int wm, int wn, int g, int c, f32x4 (&acc)[4][NI], const float* sR) const {}
  __device__ void store_t(int tok8, int col, bf16x8 v) const {
    if (col < 1024) *(bf16x8*)(Kt + (size_t)(col - 512) * T_TOK + tok8) = v;
    else *(bf16x8*)(VtE + (size_t)(col - 1024) * T_TOK + tok8) = v;
  }
  __device__ void store_n(int tok, int col, bf16x8 v, const bf16_t* sp) const {
    bf16_t* d;
    if (col < 512) d = Qb + (size_t)tok * 512 + col;
    else if (col < 3072) d = Gb + (size_t)tok * 1024 + (col - 2048);
    else if (col < 3104) d = LRb + (size_t)tok * 32 + (col - 3072);
    else if (col < 3616) d = PUb + (size_t)tok * 512 + (col - 3104);
    else if (col < 4128) d = PGb + (size_t)tok * 512 + (col - 3616);
    else return;
    *(bf16x8*)d = v;
  }
};

struct EpiOddIn {
  static constexpr bool staged = true;
  bf16_t *CQb, *CKVb, *KRb, *MGb, *MQb, *MKb, *MKt, *MVt, *MOb, *MLGb;
  float* MIF;
  __device__ float scale() const { return 1.f; }
  __device__ bool transposed(int n0) const { return n0 < 512; }
  __device__ bool both(int n0) const { return n0 >= 512 && n0 < 1024; }
  template <int NI> __device__ void direct(int m0, int n0, int wm, int wn, int g, int c, f32x4 (&acc)[4][NI], const float* sR) const {
    if (n0 == 3584 && wn == 1) {
#pragma unroll
      for (int mi = 0; mi < 4; ++mi)
#pragma unroll
        for (int j = 0; j < 4; ++j) {
          const int row = wm * 64 + mi * 16 + 4 * g + j;
          MIF[(size_t)(m0 + row) * 16 + c] = acc[mi][2][j] * sR[row];
        }
    }
  }
  __device__ void store_t(int tok8, int col, bf16x8 v) const {
    if (col < 512) *(bf16x8*)(MVt + (size_t)col * T_TOK + tok8) = v;
    else *(bf16x8*)(MKt + (size_t)(col - 512) * T_TOK + tok8) = v;
  }
  __device__ void store_n(int tok, int col, bf16x8 v, const bf16_t* sp) const {
    bf16_t* d;
    if (col < 1024) d = MKb + (size_t)tok * 512 + (col - 512);
    else if (col < 1408) d = CQb + (size_t)tok * 384 + (col - 1024);
    else if (col < 1664) d = CKVb + (size_t)tok * 256 + (col - 1408);
    else if (col < 2176) d = MGb + (size_t)tok * 512 + (col - 1664);
    else if (col < 2688) d = MQb + (size_t)tok * 512 + (col - 2176);
    else if (col < 3200) d = MOb + (size_t)tok * 512 + (col - 2688);
    else if (col < 3712) d = MLGb + (size_t)tok * 512 + (col - 3200);
    else if (col < 3728) {
      bf16x8 x2 = *(const bf16x8*)(sp + 16);
      bf16x8 o1, o2;
      rope_chunk(seq_pos(tok), col - 3712, v, x2, o1, o2);
      *(bf16x8*)(KRb + (size_t)tok * 32 + (col - 3712)) = o1;
      *(bf16x8*)(KRb + (size_t)tok * 32 + 16 + (col - 3712)) = o2;
      return;
    } else return;
    *(bf16x8*)d = v;
  }
};

struct EpiQUp {
  static constexpr bool staged = true;
  bf16_t* Qa;
  __device__ float scale() const { return 0.10206207261596575f * 1.4426950408889634f; }
  __device__ bool transposed(int n0) const { return false; }
  __device__ bool both(int n0) const { return false; }
  template <int NI> __device__ void direct(int m0, int n0, int wm, int wn, int g, int c, f32x4 (&acc)[4][NI], const float* sR) const {}
  __device__ void store_t(int tok8, int col, bf16x8 v) const {}
  __device__ void store_n(int tok, int col, bf16x8 v, const bf16_t* sp) const {
    if (col < 512) {
      *(bf16x8*)(Qa + (size_t)tok * 768 + (col >> 6) * 96 + (col & 63)) = v;
    } else {
      const int r = col - 512, head = r >> 5, rr = r & 31;
      if (rr < 16) {
        bf16x8 x2 = *(const bf16x8*)(sp + 16);
        bf16x8 o1, o2;
        rope_chunk(seq_pos(tok), rr, v, x2, o1, o2);
        *(bf16x8*)(Qa + (size_t)tok * 768 + head * 96 + 64 + rr) = o1;
        *(bf16x8*)(Qa + (size_t)tok * 768 + head * 96 + 80 + rr) = o2;
      }
    }
  }
};

struct EpiKVUp {
  static constexpr bool staged = true;
  bf16_t *KNb, *VtA;
  __device__ float scale() const { return 1.f; }
  __device__ bool transposed(int n0) const { return n0 >= 512; }
  __device__ bool both(int n0) const { return false; }
  template <int NI> __device__ void direct(int m0, int n0, int wm, int wn, int g, int c, f32x4 (&acc)[4][NI], const float* sR) const {}
  __device__ void store_t(int tok8, int col, bf16x8 v) const { *(bf16x8*)(VtA + (size_t)(col - 512) * T_TOK + tok8) = v; }
  __device__ void store_n(int tok, int col, bf16x8 v, const bf16_t* sp) const { *(bf16x8*)(KNb + (size_t)tok * 512 + col) = v; }
};

struct EpiOut {
  static constexpr bool staged = false;
  const float *xa, *xb;
  float* out;
  bool dry;
  bf16_t* hb;
  float* ssq;
};

__device__ __forceinline__ float scan16(float v, int c, int lane) {
  float t;
  t = bperm(lane - 1, v); if (c >= 1) v += t;
  t = bperm(lane - 2, v); if (c >= 2) v += t;
  t = bperm(lane - 4, v); if (c >= 4) v += t;
  t = bperm(lane - 8, v); if (c >= 8) v += t;
  return v;
}

__device__ __forceinline__ float logsig_fast(float x) { return fminf(x, 0.f) - __logf(1.f + __expf(-fabsf(x))); }

__device__ void gla_intra_item(const Params& p, int li, int item, char* smem, bool dry = false) {
  const int tid = otid(), lane = tid & 63, w = tid >> 6, c = lane & 15, g = lane >> 4;
  const int ci = item >> 2, h = item & 3;
  const int tokc = ci * 64;
  const float qscale = 0.08838834764831845f;
  bf16_t* sQe = (bf16_t*)smem;
  bf16_t* sKd = sQe + 64 * 136;
  bf16_t* sA = sKd + 64 * 136;
  us4 q4[2][4];
  bf16_t kk[2][4][4];
#pragma unroll
  for (int dt = 0; dt < 2; ++dt)
#pragma unroll
    for (int tt = 0; tt < 4; ++tt) {
      q4[dt][tt] = *(const us4*)(p.Qb + (size_t)(tokc + 16 * tt + c) * 512 + h * 128 + 32 * w + 16 * dt + 4 * g);
#pragma unroll
      for (int j = 0; j < 4; ++j)
        kk[dt][tt][j] = p.Kt[(size_t)(h * 128 + 32 * w + 16 * dt + 4 * g + j) * T_TOK + tokc + 16 * tt + c];
    }
  __syncthreads();
#pragma unroll
  for (int dir = 0; dir < 2; ++dir) {
    bf16_t* QEd = (dir || dry) ? p.QEb : p.Qb;
    bf16_t* KdTd = (dir || dry) ? p.KdTb : p.Kt;
    bf16x8 aup[2];
    float bias[2][4];
#pragma unroll
    for (int dt = 0; dt < 2; ++dt) {
      aup[dt] = zero8();
      if (g < 2) aup[dt] = *(const bf16x8*)(p.AupT + ((size_t)(li * 2 + dir) * 512 + h * 128 + 32 * w + 16 * dt + c) * 32 + 8 * g);
#pragma unroll
      for (int j = 0; j < 4; ++j) bias[dt][j] = p.e_a_bias[(li * 2 + dir) * 512 + h * 128 + 32 * w + 16 * dt + 4 * g + j];
    }
    f32x4 la[2][4];
#pragma unroll
    for (int tt = 0; tt < 4; ++tt) {
      bf16x8 lrf = zero8();
      if (g < 2) lrf = *(const bf16x8*)(p.LRb + (size_t)(tokc + 16 * tt + c) * 32 + dir * 16 + 8 * g);
#pragma unroll
      for (int dt = 0; dt < 2; ++dt) la[dt][tt] = mfma16(aup[dt], lrf, zero4());
    }
#pragma unroll
    for (int dt = 0; dt < 2; ++dt)
#pragma unroll
      for (int tt = 0; tt < 4; ++tt)
#pragma unroll
        for (int j = 0; j < 4; ++j) la[dt][tt][j] = logsig_fast(la[dt][tt][j] + bias[dt][j]) * (1.f / 16.f);
    f32x4 P[2][4];
    float tot[2][4];
#pragma unroll
    for (int dt = 0; dt < 2; ++dt)
#pragma unroll
      for (int j = 0; j < 4; ++j) {
        float carry = 0.f;
#pragma unroll
        for (int tt = 0; tt < 4; ++tt) {
          float v = scan16(la[dt][tt][j], c, lane) + carry;
          P[dt][tt][j] = v;
          carry = bperm(lane | 15, v);
        }
        tot[dt][j] = carry;
      }
#pragma unroll
    for (int dt = 0; dt < 2; ++dt)
#pragma unroll
      for (int tt = 0; tt < 4; ++tt) {
        us4 qo, ko;
#pragma unroll
        for (int j = 0; j < 4; ++j) {
          const float b = (dir == 0) ? P[dt][tt][j] : (tot[dt][j] - P[dt][tt][j] + la[dt][tt][j]);
          qo[j] = f2bf(bf2f(q4[dt][tt][j]) * __expf(b) * qscale);
          ko[j] = f2bf(bf2f(kk[dt][tt][j]) * __expf(-b));
        }
        *(us4*)(QEd + (size_t)(tokc + 16 * tt + c) * 512 + h * 128 + 32 * w + 16 * dt + 4 * g) = qo;
        *(us4*)(sQe + (16 * tt + c) * 136 + 32 * w + 16 * dt + 4 * g) = qo;
        *(us4*)(sKd + (16 * tt + c) * 136 + 32 * w + 16 * dt + 4 * g) = ko;
      }
    if (c == 0) {
#pragma unroll
      for (int dt = 0; dt < 2; ++dt)
#pragma unroll
        for (int j = 0; j < 4; ++j)
          p.EB[(size_t)(dir * 1280 + ci) * 512 + h * 128 + 32 * w + 16 * dt + 4 * g + j] = __expf(tot[dt][j]);
    }
    __syncthreads();
#pragma unroll
    for (int i = 0; i < 4; ++i) {
      const int id = tid + 256 * i;
      const int d = id & 127, c8 = id >> 7;
      bf16x8 v;
#pragma unroll
      for (int e = 0; e < 8; ++e) v[e] = (short)sKd[(8 * c8 + e) * 136 + d];
      *(bf16x8*)(KdTd + (size_t)(h * 128 + d) * T_TOK + tokc + 8 * c8) = v;
    }
    f32x4 accA[4];
#pragma unroll
    for (int jt = 0; jt < 4; ++jt) accA[jt] = zero4();
#pragma unroll
    for (int ks = 0; ks < 4; ++ks) {
      bf16x8 aq = *(const bf16x8*)(sQe + (16 * w + c) * 136 + 32 * ks + 8 * g);
#pragma unroll
      for (int jt = 0; jt < 4; ++jt) {
        bf16x8 bk = *(const bf16x8*)(sKd + (16 * jt + c) * 136 + 32 * ks + 8 * g);
        accA[jt] = mfma16(aq, bk, accA[jt]);
      }
    }
#pragma unroll
    for (int jt = 0; jt < 4; ++jt)
#pragma unroll
      for (int j = 0; j < 4; ++j) {
        const int i = 16 * w + 4 * g + j, jj = 16 * jt + c;
        const bool keep = (dir == 0) ? (jj <= i) : (jj > i);
        sA[dir * 64 * 72 + i * 72 + jj] = f2bf(keep ? accA[jt][j] : 0.f);
      }
    __syncthreads();
  }
  bf16x8 af[2][2];
#pragma unroll
  for (int dir = 0; dir < 2; ++dir)
#pragma unroll
    for (int k2 = 0; k2 < 2; ++k2) af[dir][k2] = *(const bf16x8*)(sA + dir * 64 * 72 + (16 * w + c) * 72 + 32 * k2 + 8 * g);
  bf16_t* sO = (bf16_t*)smem;
#pragma unroll 4
  for (int vt = 0; vt < 16; ++vt) {
    f32x4 a = zero4();
#pragma unroll
    for (int k2 = 0; k2 < 2; ++k2) {
      bf16x8 vfr = *(const bf16x8*)(p.VtE + (size_t)(h * 256 + 16 * vt + c) * T_TOK + tokc + 32 * k2 + 8 * g);
      a = mfma16(af[0][k2], vfr, a);
      a = mfma16(af[1][k2], vfr, a);
    }
#pragma unroll
    for (int j = 0; j < 4; ++j) sO[(16 * w + 4 * g + j) * 264 + 16 * vt + c] = f2bf(a[j]);
  }
  __syncthreads();
#pragma unroll
  for (int i = 0; i < 8; ++i) {
    const int id = tid + 256 * i;
    const int row = id >> 5, c8 = id & 31;
    *(bf16x8*)(p.TMP + (size_t)(tokc + row) * 1024 + h * 256 + 8 * c8) = *(const bf16x8*)(sO + row * 264 + 8 * c8);
  }
}

__device__ __forceinline__ void lds_barrier() { asm volatile("s_waitcnt lgkmcnt(0)\n\ts_barrier" ::: "memory"); }

struct GlaRegs {
  bf16x8 aq[4];
  bf16x8 vf[2][2];
  bf16x8 kf[2][2];
  float eb[2];
  unsigned told[2][4];
};

template <int DIR>
__device__ __forceinline__ void gla_chain_load(const Params& p, int h, int sl, int tokc, int w, int c, int g, GlaRegs& r) {
  const bf16_t* QE = DIR ? p.QEb : p.Qb;
  const bf16_t* KdT = DIR ? p.KdTb : p.Kt;
#pragma unroll
  for (int ks = 0; ks < 4; ++ks) r.aq[ks] = *(const bf16x8*)(QE + (size_t)(tokc + 16 * w + c) * 512 + h * 128 + 32 * ks + 8 * g);
#pragma unroll
  for (int vt = 0; vt < 2; ++vt)
#pragma unroll
    for (int k2 = 0; k2 < 2; ++k2)
      r.vf[vt][k2] = *(const bf16x8*)(p.VtE + (size_t)(h * 256 + sl * 32 + 16 * vt + c) * T_TOK + tokc + 32 * k2 + 8 * g);
#pragma unroll
  for (int dt = 0; dt < 2; ++dt) {
#pragma unroll
    for (int k2 = 0; k2 < 2; ++k2)
      r.kf[dt][k2] = *(const bf16x8*)(KdT + (size_t)(h * 128 + 32 * w + 16 * dt + c) * T_TOK + tokc + 32 * k2 + 8 * g);
    r.eb[dt] = p.EB[(size_t)(DIR * 1280 + (tokc >> 6)) * 512 + h * 128 + 32 * w + 16 * dt + c];
  }
#pragma unroll
  for (int vt = 0; vt < 2; ++vt)
#pragma unroll
    for (int j = 0; j < 4; ++j) r.told[vt][j] = p.TMP[(size_t)(tokc + 16 * w + 4 * g + j) * 1024 + h * 256 + sl * 32 + 16 * vt + c];
}

__device__ __forceinline__ void gla_chain_compute(const Params& p, int h, int sl, int tokc, int w, int c, int g, const GlaRegs& r,
                                                  f32x4 (&S)[2][2], bf16_t* sSt, bool dry, bool reload) {
  unsigned told[2][4];
#pragma unroll
  for (int vt = 0; vt < 2; ++vt)
#pragma unroll
    for (int j = 0; j < 4; ++j) told[vt][j] = r.told[vt][j];
  if (reload) {
#pragma unroll
    for (int vt = 0; vt < 2; ++vt)
#pragma unroll
      for (int j = 0; j < 4; ++j) told[vt][j] = p.TMP[(size_t)(tokc + 16 * w + 4 * g + j) * 1024 + h * 256 + sl * 32 + 16 * vt + c];
  }
#pragma unroll
  for (int vt = 0; vt < 2; ++vt)
#pragma unroll
    for (int dt = 0; dt < 2; ++dt)
#pragma unroll
      for (int j = 0; j < 4; ++j) sSt[(16 * vt + 4 * g + j) * 136 + 32 * w + 16 * dt + c] = f2bf(S[vt][dt][j]);
  lds_barrier();
  f32x4 o[2];
  o[0] = zero4(); o[1] = zero4();
#pragma unroll
  for (int ks = 0; ks < 4; ++ks)
#pragma unroll
    for (int vt = 0; vt < 2; ++vt) {
      bf16x8 sf = *(const bf16x8*)(sSt + (16 * vt + c) * 136 + 32 * ks + 8 * g);
      o[vt] = mfma16(r.aq[ks], sf, o[vt]);
    }
#pragma unroll
  for (int dt = 0; dt < 2; ++dt)
#pragma unroll
    for (int vt = 0; vt < 2; ++vt) {
      f32x4 a = S[vt][dt];
#pragma unroll
      for (int k2 = 0; k2 < 2; ++k2) a = mfma16(r.vf[vt][k2], r.kf[dt][k2], a);
      S[vt][dt] = a * r.eb[dt];
    }
#pragma unroll
  for (int vt = 0; vt < 2; ++vt)
#pragma unroll
    for (int j = 0; j < 4; ++j)
      if (!dry) p.TMP[(size_t)(tokc + 16 * w + 4 * g + j) * 1024 + h * 256 + sl * 32 + 16 * vt + c] = f2bf(bf2f((bf16_t)told[vt][j]) + o[vt][j]);
}

__device__ void gla_chain_item(const Params& p, int li, int item, char* smem, bool dry = false) {
  const int tid = otid(), lane = tid & 63, w = tid >> 6, c = lane & 15, g = lane >> 4;
  const int xr = item >> 3;
  const int pair = (item & 7) + 8 * (xr >> 3), sl = xr & 7;
  const int s = pair < 32 ? 4 + (pair >> 2) : ((pair - 32) >> 2);
  const int h = pair & 3;
  const int tok0 = s < 4 ? s * 4096 : T_P + (s - 4) * 8192;
  const int len = s < 4 ? 4096 : 8192;
  const int N = len / 64;
  bf16_t* sSt0 = (bf16_t*)smem;
  bf16_t* sSt1 = sSt0 + 32 * 136;
  f32x4 Sf[2][2], Sb[2][2];
#pragma unroll
  for (int a = 0; a < 2; ++a)
#pragma unroll
    for (int b = 0; b < 2; ++b) { Sf[a][b] = zero4(); Sb[a][b] = zero4(); }
  GlaRegs rf, rb;
  __syncthreads();
  gla_chain_load<0>(p, h, sl, tok0, w, c, g, rf);
  for (int step = 0; step < N; ++step) {
    const int tf = tok0 + step * 64, tb = tok0 + (N - 1 - step) * 64;
    gla_chain_load<1>(p, h, sl, tb, w, c, g, rb);
    gla_chain_compute(p, h, sl, tf, w, c, g, rf, Sf, sSt0, dry, step == (N >> 1));
    if (step + 1 < N) gla_chain_load<0>(p, h, sl, tf + 64, w, c, g, rf);
    gla_chain_compute(p, h, sl, tb, w, c, g, rb, Sb, sSt1, dry, false);
  }
}

__device__ void pool_item(const Params& p, int li, int item, char* smem, bool dry = false) {
  const int tid = otid(), lane = tid & 63, w = tid >> 6, c = lane & 15, g = lane >> 4;
  const int gi = item & 3;
  const int tile = item >> 2;
  const int tokc = tile * 64;
  const int pos0 = seq_pos(tokc);
  const int len = tokc < T_P ? 4096 : 8192;
  float* sU = (float*)smem;
  bf16_t* sP = (bf16_t*)(sU + 80 * 128);
  __syncthreads();
  for (int idx = tid; idx < 80 * 128; idx += 256) {
    int r = idx >> 7, ch = idx & 127;
    int pos = pos0 - 8 + r;
    float v = 0.f;
    if (pos >= 0 && pos < len) v = bf2f(p.PUb[(long)(tokc - 8 + r) * 512 + gi * 128 + ch]);
    sU[idx] = v;
  }
  __syncthreads();
  {
    const int ch = tid & 127, th = tid >> 7;
    const int half = 1 << gi;
    for (int t = th * 32; t < th * 32 + 32; ++t) {
      int pos = pos0 + t;
      int lo = max(pos - half, 0), hi = min(pos + half, len);
      float s = 0.f;
      for (int q = lo; q < hi; ++q) s += sU[(q - pos0 + 8) * 128 + ch];
      float pooled = s / (float)(hi - lo) - sU[(t + 8) * 128 + ch];
      sP[t * 136 + ch] = f2bf(pooled);
    }
  }
  __syncthreads();
  f32x4 acc[8];
#pragma unroll
  for (int dt = 0; dt < 8; ++dt) acc[dt] = zero4();
  const bf16_t* PW = p.PoolWT + (long)(li * 4 + gi) * 128 * 128;
#pragma unroll
  for (int ks = 0; ks < 4; ++ks) {
    bf16x8 af = *(const bf16x8*)(sP + (16 * w + c) * 136 + 32 * ks + 8 * g);
#pragma unroll
    for (int dt = 0; dt < 8; ++dt) {
      bf16x8 bw = *(const bf16x8*)(PW + (long)(16 * dt + c) * 128 + 32 * ks + 8 * g);
      acc[dt] = mfma16(af, bw, acc[dt]);
    }
  }
#pragma unroll
  for (int dt = 0; dt < 8; ++dt) {
    const int d = gi * 128 + 16 * dt + c;
    const float sc = p.e_pool_scale[li * 512 + d];
#pragma unroll
    for (int j = 0; j < 4; ++j) {
      const long addr = (long)(tokc + 16 * w + 4 * g + j) * 512 + d;
      float gt = bf2f(p.PGb[addr]);
      if (!dry) p.PGb[addr] = f2bf(acc[dt][j] * sc * siluf_(gt));
    }
  }
}

__device__ void ml_intra_item(const Params& p, int li, int item, char* smem) {
  const int tid = otid(), lane = tid & 63, w = tid >> 6, c = lane & 15, g = lane >> 4;
  const int ci = item >> 2, h = item & 3;
  const int tokc = ci * 64;
  const float kscale = 0.08838834764831845f;
  bf16_t* sA = (bf16_t*)smem;
  float* sBv = (float*)(sA + 2 * 64 * 72);
  float* sCB = sBv + 128;
  __syncthreads();
  if (w < 2) {
    const int dir = w;
    const float bi = p.o_if_bias[li * 16 + dir * 4 + h];
    const float bff = p.o_if_bias[li * 16 + 8 + dir * 4 + h];
    const float* mf = p.MIF + (size_t)(tokc + lane) * 16;
    const float liv = mf[dir * 4 + h] + bi;
    const float lfv = logsig_fast(mf[8 + dir * 4 + h] + bff);
    float ps = lfv;
#pragma unroll
    for (int d = 1; d < 64; d <<= 1) {
      float t = bperm(lane - d, ps);
      if (lane >= d) ps += t;
    }
    const float total = __int_as_float(__builtin_amdgcn_readlane(__float_as_int(ps), 63));
    const float b = (dir == 0) ? ps : (total - ps + lfv);
    const float cB = liv - b;
    sBv[dir * 64 + lane] = b;
    sCB[dir * 64 + lane] = cB;
    const size_t so = (size_t)(dir * 4 + h) * T_TOK + tokc + lane;
    p.EBI[so] = __expf(b);
    p.WKg[so] = __expf(total + cB) * kscale;
    if (lane == 0) p.DEC[(dir * 4 + h) * 1280 + ci] = __expf(total);
  }
  f32x4 accA[4];
#pragma unroll
  for (int jt = 0; jt < 4; ++jt) accA[jt] = zero4();
#pragma unroll
  for (int ks = 0; ks < 4; ++ks) {
    bf16x8 aq = *(const bf16x8*)(p.MQb + (size_t)(tokc + 16 * w + c) * 512 + h * 128 + 32 * ks + 8 * g);
#pragma unroll
    for (int jt = 0; jt < 4; ++jt) {
      bf16x8 bk = *(const bf16x8*)(p.MKb + (size_t)(tokc + 16 * jt + c) * 512 + h * 128 + 32 * ks + 8 * g);
      accA[jt] = mfma16(aq, bk, accA[jt]);
    }
  }
  __syncthreads();
#pragma unroll
  for (int dir = 0; dir < 2; ++dir)
#pragma unroll
    for (int jt = 0; jt < 4; ++jt)
#pragma unroll
      for (int j = 0; j < 4; ++j) {
        const int i = 16 * w + 4 * g + j, jj = 16 * jt + c;
        const bool keep = (dir == 0) ? (jj <= i) : (jj > i);
        const float sv = keep ? accA[jt][j] * kscale * __expf(sBv[dir * 64 + i] + sCB[dir * 64 + jj]) : 0.f;
        sA[dir * 64 * 72 + i * 72 + jj] = f2bf(sv);
      }
  __syncthreads();
  bf16x8 ones = zero8();
  if (c == 0) {
#pragma unroll
    for (int e = 0; e < 8; ++e) ones[e] = (short)0x3F80;
  }
#pragma unroll
  for (int dir = 0; dir < 2; ++dir) {
    bf16_t* NUMI = dir ? p.NUMIb : p.NUMIf;
    bf16x8 af[2];
#pragma unroll
    for (int k2 = 0; k2 < 2; ++k2) af[k2] = *(const bf16x8*)(sA + dir * 64 * 72 + (16 * w + c) * 72 + 32 * k2 + 8 * g);
    f32x4 dn = zero4();
    dn = mfma16(af[0], ones, dn);
    dn = mfma16(af[1], ones, dn);
    if (c == 0) {
#pragma unroll
      for (int j = 0; j < 4; ++j) p.DENI[(size_t)(dir * 4 + h) * T_TOK + tokc + 16 * w + 4 * g + j] = dn[j];
    }
    bf16_t* sO = sA + 2 * 64 * 72 + 512;
#pragma unroll 4
    for (int vt = 0; vt < 8; ++vt) {
      f32x4 a = zero4();
#pragma unroll
      for (int k2 = 0; k2 < 2; ++k2) {
        bf16x8 vfr = *(const bf16x8*)(p.MVt + (size_t)(h * 128 + 16 * vt + c) * T_TOK + tokc + 32 * k2 + 8 * g);
        a = mfma16(af[k2], vfr, a);
      }
#pragma unroll
      for (int j = 0; j < 4; ++j) sO[(16 * w + 4 * g + j) * 136 + 16 * vt + c] = f2bf(a[j]);
    }
    __syncthreads();
#pragma unroll
    for (int i = 0; i < 4; ++i) {
      const int id = tid + 256 * i;
      const int row = id >> 4, c8 = id & 15;
      *(bf16x8*)(NUMI + (size_t)(tokc + row) * 512 + h * 128 + 8 * c8) = *(const bf16x8*)(sO + row * 136 + 8 * c8);
    }
    __syncthreads();
  }
}

struct MlRegs {
  bf16x8 aq[4];
  bf16x8 vf[2];
  bf16x8 kf[2][2];
  f32x4 wk[2][2];
  f32x4 ebi, deni;
  float dec;
  unsigned numi[4];
};

template <int DIR>
__device__ __forceinline__ void ml_chain_load(const Params& p, int h, int sl, int tokc, int w, int c, int g, MlRegs& r) {
#pragma unroll
  for (int ks = 0; ks < 4; ++ks) r.aq[ks] = *(const bf16x8*)(p.MQb + (size_t)(tokc + 16 * w + c) * 512 + h * 128 + 32 * ks + 8 * g);
#pragma unroll
  for (int k2 = 0; k2 < 2; ++k2)
    r.vf[k2] = *(const bf16x8*)(p.MVt + (size_t)(h * 128 + sl * 16 + c) * T_TOK + tokc + 32 * k2 + 8 * g);
#pragma unroll
  for (int dt = 0; dt < 2; ++dt)
#pragma unroll
    for (int k2 = 0; k2 < 2; ++k2)
      r.kf[dt][k2] = *(const bf16x8*)(p.MKt + (size_t)(h * 128 + 32 * w + 16 * dt + c) * T_TOK + tokc + 32 * k2 + 8 * g);
  const size_t so = (size_t)(DIR * 4 + h) * T_TOK + tokc;
#pragma unroll
  for (int k2 = 0; k2 < 2; ++k2) {
    r.wk[k2][0] = *(const f32x4*)(p.WKg + so + 32 * k2 + 8 * g);
    r.wk[k2][1] = *(const f32x4*)(p.WKg + so + 32 * k2 + 8 * g + 4);
  }
  r.ebi = *(const f32x4*)(p.EBI + so + 16 * w + 4 * g);
  r.deni = *(const f32x4*)(p.DENI + so + 16 * w + 4 * g);
  r.dec = p.DEC[(DIR * 4 + h) * 1280 + (tokc >> 6)];
  const bf16_t* NUMI = DIR ? p.NUMIb : p.NUMIf;
#pragma unroll
  for (int j = 0; j < 4; ++j) r.numi[j] = NUMI[(size_t)(tokc + 16 * w + 4 * g + j) * 512 + h * 128 + sl * 16 + c];
}

template <int DIR>
__device__ __forceinline__ void ml_chain_compute(const Params& p, int h, int sl, int tokc, int lane, int w, int c, int g, const MlRegs& r,
                                                 f32x4 (&C)[2][2], bf16_t* sCt, bool dry) {
  bf16_t* NUMI = DIR ? p.NUMIb : p.NUMIf;
  unsigned numi[4];
#pragma unroll
  for (int j = 0; j < 4; ++j) numi[j] = r.numi[j];
#pragma unroll
  for (int vt = 0; vt < 2; ++vt)
#pragma unroll
    for (int dt = 0; dt < 2; ++dt)
#pragma unroll
      for (int j = 0; j < 4; ++j) sCt[(16 * vt + 4 * g + j) * 136 + 32 * w + 16 * dt + c] = f2bf(C[vt][dt][j]);
  bf16x8 vfw[2][2];
#pragma unroll
  for (int k2 = 0; k2 < 2; ++k2) {
    float wv[8];
#pragma unroll
    for (int e = 0; e < 4; ++e) { wv[e] = r.wk[k2][0][e]; wv[4 + e] = r.wk[k2][1][e]; }
#pragma unroll
    for (int e = 0; e < 8; ++e) vfw[0][k2][e] = (short)f2bf(bf2f((bf16_t)r.vf[k2][e]) * wv[e]);
#pragma unroll
    for (int e = 0; e < 8; ++e) vfw[1][k2][e] = (c == 0) ? (short)f2bf(wv[e]) : (short)0;
  }
  lds_barrier();
  f32x4 o2[2];
  o2[0] = zero4(); o2[1] = zero4();
#pragma unroll
  for (int ks = 0; ks < 4; ++ks)
#pragma unroll
    for (int vt = 0; vt < 2; ++vt) {
      bf16x8 cf = *(const bf16x8*)(sCt + (16 * vt + c) * 136 + 32 * ks + 8 * g);
      o2[vt] = mfma16(r.aq[ks], cf, o2[vt]);
    }
#pragma unroll
  for (int dt = 0; dt < 2; ++dt)
#pragma unroll
    for (int vt = 0; vt < 2; ++vt) {
      f32x4 a = C[vt][dt] * r.dec;
#pragma unroll
      for (int k2 = 0; k2 < 2; ++k2) a = mfma16(vfw[vt][k2], r.kf[dt][k2], a);
      C[vt][dt] = a;
    }
#pragma unroll
  for (int j = 0; j < 4; ++j) {
    const float e = r.ebi[j];
    float den = e * o2[1][j];
    den = bperm(lane & 48, den) + r.deni[j];
    const float inv = 1.f / fmaxf(fabsf(den), 1.f);
    const float hv = (bf2f((bf16_t)numi[j]) + e * o2[0][j]) * inv;
    if (!dry) NUMI[(size_t)(tokc + 16 * w + 4 * g + j) * 512 + h * 128 + sl * 16 + c] = f2bf(hv);
  }
}

template <int DIR>
__device__ __forceinline__ void ml_chain_run(const Params& p, int h, int sl, int tok0, int N, int lane, int w, int c, int g, bf16_t* sCt0, bool dry) {
  bf16_t* sCt1 = sCt0 + 32 * 136;
  f32x4 C[2][2];
#pragma unroll
  for (int a = 0; a < 2; ++a)
#pragma unroll
    for (int b = 0; b < 2; ++b) C[a][b] = zero4();
  MlRegs r0, r1;
  ml_chain_load<DIR>(p, h, sl, tok0 + (DIR ? N - 1 : 0) * 64, w, c, g, r0);
  for (int n = 0; n < N; n += 2) {
    const int c0 = DIR ? N - 1 - n : n;
    const int c1 = DIR ? N - 2 - n : n + 1;
    const int n2 = min(n + 2, N - 1);
    const int c2 = DIR ? N - 1 - n2 : n2;
    ml_chain_load<DIR>(p, h, sl, tok0 + c1 * 64, w, c, g, r1);
    ml_chain_compute<DIR>(p, h, sl, tok0 + c0 * 64, lane, w, c, g, r0, C, sCt0, dry);
    ml_chain_load<DIR>(p, h, sl, tok0 + c2 * 64, w, c, g, r0);
    ml_chain_compute<DIR>(p, h, sl, tok0 + c1 * 64, lane, w, c, g, r1, C, sCt1, dry);
  }
}

__device__ void ml_chain_item(const Params& p, int li, int item, char* smem, bool dry = false) {
  const int tid = otid(), lane = tid & 63, w = tid >> 6, c = lane & 15, g = lane >> 4;
  int pair, within;
  if (item < 512) { const int r = item >> 3; pair = (item & 7) + 8 * (r >> 4); within = r & 15; }
  else { const int it = item - 512; const int r = it >> 3; pair = 32 + (it & 7) + 8 * (r >> 4); within = r & 15; }
  const int sl = within & 7, dir = within >> 3;
  const int s = pair < 32 ? 4 + (pair >> 2) : ((pair - 32) >> 2);
  const int h = pair & 3;
  const int tok0 = s < 4 ? s * 4096 : T_P + (s - 4) * 8192;
  const int N = (s < 4 ? 4096 : 8192) / 64;
  bf16_t* sCt0 = (bf16_t*)smem;
  __syncthreads();
  if (dir == 0) ml_chain_run<0>(p, h, sl, tok0, N, lane, w, c, g, sCt0, dry);
  else ml_chain_run<1>(p, h, sl, tok0, N, lane, w, c, g, sCt0, dry);
}

#define ATTN_GLOAD(KT)                                                                              \
  {                                                                                                 \
    const long kb = tok0 + (KT) * 64;                                                               \
    rk0 = *(const bf16x8*)(p.KNb + (kb + (tid >> 3)) * 512 + head * 64 + 8 * (tid & 7));            \
    rk1 = *(const bf16x8*)(p.KNb + (kb + 32 + (tid >> 3)) * 512 + head * 64 + 8 * (tid & 7));       \
    rkr = *(const bf16x8*)(p.KRb + (kb + (tid >> 2)) * 32 + 8 * (tid & 3));                          \
    rv0 = *(const bf16x8*)(p.VtA + (long)(head * 64 + (tid >> 3)) * T_TOK + kb + 8 * (tid & 7));     \
    rv1 = *(const bf16x8*)(p.VtA + (long)(head * 64 + 32 + (tid >> 3)) * T_TOK + kb + 8 * (tid & 7)); \
  }
__device__ void attn_item(const Params& p, int item, char* smem, bool dry = false) {
  const int tid = otid(), lane = tid & 63, w = tid >> 6, c = lane & 15, g = lane >> 4;
  int s, head, qb;
  {
    const int x = item / 320, t = item % 320;
    if (t < 256) { const int pair = x + 8 * (t >> 5); qb = t & 31; s = 4 + (pair >> 3); head = pair & 7; }
    else { const int t2 = t - 256; const int pair = x + 8 * (t2 >> 4); qb = t2 & 15; s = pair >> 3; head = pair & 7; }
  }
  const int tok0 = s < 4 ? s * 4096 : T_P + (s - 4) * 8192;
  const int len = s < 4 ? 4096 : 8192;
  const int nkv = len / 64;
  bf16_t* sK = (bf16_t*)smem;
  bf16_t* sVt = sK + 64 * 104;
  const int qrow0 = tok0 + qb * 256 + 64 * w;
  bf16_t* sQr = sVt + 64 * 72;
  bf16x8 qf[4][2];
#pragma unroll
  for (int nt = 0; nt < 4; ++nt) {
#pragma unroll
    for (int ks = 0; ks < 2; ++ks)
      qf[nt][ks] = *(const bf16x8*)(p.Qa + (long)(qrow0 + 16 * nt + c) * 768 + head * 96 + 32 * ks + 8 * g);
    bf16x8 qr = *(const bf16x8*)(p.Qa + (long)(qrow0 + 16 * nt + c) * 768 + head * 96 + 64 + 8 * g);
    *(bf16x8*)(sQr + ((w * 4 + nt) * 64 + lane) * 8) = qr;
  }
  f32x4 ot[4][4];
#pragma unroll
  for (int vt = 0; vt < 4; ++vt)
#pragma unroll
    for (int nt = 0; nt < 4; ++nt) ot[vt][nt] = zero4();
  float mrun[4] = {-1e30f, -1e30f, -1e30f, -1e30f}, lrun[4] = {0.f, 0.f, 0.f, 0.f};
  bf16x8 rk0, rk1, rkr, rv0, rv1;
  ATTN_GLOAD(0)
  for (int kt = 0; kt < nkv; ++kt) {
    __syncthreads();
    *(bf16x8*)(sK + (tid >> 3) * 104 + 8 * (tid & 7)) = rk0;
    *(bf16x8*)(sK + (32 + (tid >> 3)) * 104 + 8 * (tid & 7)) = rk1;
    *(bf16x8*)(sK + (tid >> 2) * 104 + 64 + 8 * (tid & 3)) = rkr;
    *(bf16x8*)(sVt + (tid >> 3) * 72 + 8 * (tid & 7)) = rv0;
    *(bf16x8*)(sVt + (32 + (tid >> 3)) * 72 + 8 * (tid & 7)) = rv1;
    __syncthreads();
    if (kt + 1 < nkv) ATTN_GLOAD(kt + 1)
#pragma unroll 1
    for (int half = 0; half < 2; ++half) {
      f32x4 st[2][4];
#pragma unroll
      for (int k4 = 0; k4 < 2; ++k4)
#pragma unroll
        for (int nt = 0; nt < 4; ++nt) st[k4][nt] = zero4();
#pragma unroll
      for (int ks = 0; ks < 2; ++ks)
#pragma unroll
        for (int k4 = 0; k4 < 2; ++k4) {
          bf16x8 kf = *(const bf16x8*)(sK + (32 * half + 16 * k4 + c) * 104 + 32 * ks + 8 * g);
#pragma unroll
          for (int nt = 0; nt < 4; ++nt) st[k4][nt] = mfma16(kf, qf[nt][ks], st[k4][nt]);
        }
      {
        bf16x8 kr0 = *(const bf16x8*)(sK + (32 * half + c) * 104 + 64 + 8 * g);
        bf16x8 kr1 = *(const bf16x8*)(sK + (32 * half + 16 + c) * 104 + 64 + 8 * g);
#pragma unroll
        for (int nt = 0; nt < 4; ++nt) {
          bf16x8 qr = *(const bf16x8*)(sQr + ((w * 4 + nt) * 64 + lane) * 8);
          st[0][nt] = mfma16(kr0, qr, st[0][nt]);
          st[1][nt] = mfma16(kr1, qr, st[1][nt]);
        }
      }
      __builtin_amdgcn_sched_barrier(0);
      bf16x8 pb[4];
#pragma unroll
      for (int nt = 0; nt < 4; ++nt) {
        float mx = -1e30f;
#pragma unroll
        for (int k4 = 0; k4 < 2; ++k4)
#pragma unroll
          for (int j = 0; j < 4; ++j) mx = fmaxf(mx, st[k4][nt][j]);
        mx = rowmax4(mx);
        if (__builtin_amdgcn_ballot_w64(mx > mrun[nt]) != 0ull) {
          const float mn0 = fmaxf(mrun[nt], mx);
          const float alpha = __builtin_amdgcn_exp2f(mrun[nt] - mn0);
          mrun[nt] = mn0;
          lrun[nt] *= alpha;
#pragma unroll
          for (int vt = 0; vt < 4; ++vt) ot[vt][nt] = ot[vt][nt] * alpha;
        }
        const float mn = mrun[nt];
        float psum = 0.f;
#pragma unroll
        for (int k4 = 0; k4 < 2; ++k4)
#pragma unroll
          for (int j = 0; j < 4; ++j) {
            float pv = __builtin_amdgcn_exp2f(st[k4][nt][j] - mn);
            st[k4][nt][j] = pv;
            psum += pv;
          }
        lrun[nt] += psum;
        typedef __attribute__((ext_vector_type(4))) unsigned u32x4;
        u32x4 pk;
        pk[0] = pk2bf(st[0][nt][0], st[0][nt][1]);
        pk[1] = pk2bf(st[0][nt][2], st[0][nt][3]);
        pk[2] = pk2bf(st[1][nt][0], st[1][nt][1]);
        pk[3] = pk2bf(st[1][nt][2], st[1][nt][3]);
        pb[nt] = __builtin_bit_cast(bf16x8, pk);
      }
      __builtin_amdgcn_sched_barrier(0);
#pragma unroll
      for (int vt = 0; vt < 4; ++vt) {
        us4 lo = *(const us4*)(sVt + (16 * vt + c) * 72 + 32 * half + 4 * g);
        us4 hi = *(const us4*)(sVt + (16 * vt + c) * 72 + 32 * half + 16 + 4 * g);
        bf16x8 av;
#pragma unroll
        for (int e = 0; e < 4; ++e) { av[e] = (short)lo[e]; av[4 + e] = (short)hi[e]; }
#pragma unroll
        for (int nt = 0; nt < 4; ++nt) ot[vt][nt] = mfma16(av, pb[nt], ot[vt][nt]);
      }
    }
  }
#pragma unroll
  for (int nt = 0; nt < 4; ++nt) {
    float lt = lrun[nt];
    lt += sxor(lt, 16, lane);
    lt += sxor(lt, 32, lane);
    const float inv = 1.f / lt;
    const long tok = qrow0 + 16 * nt + c;
#pragma unroll
    for (int vt = 0; vt < 4; ++vt) {
      bf16_t* gp = p.MGb + tok * 512 + head * 64 + 16 * vt + 4 * g;
      us4 gt = *(const us4*)gp;
      us4 o;
#pragma unroll
      for (int j = 0; j < 4; ++j) o[j] = f2bf(ot[vt][nt][j] * inv * siluf_(bf2f(gt[j])));
      if (!dry) *(us4*)gp = o;
    }
  }
}

__device__ void phase_gla_combine(const Params& p, int li, bool dry = false) {
  const int tid_ = otid(); const int lane = tid_ & 63, w = tid_ >> 6;
  for (int tok = blockIdx.x * 4 + w; tok < T_TOK; tok += gridDim.x * 4) {
    const bf16_t* tp = p.TMP + (long)tok * 1024 + 16 * lane;
    bf16_t* gp = p.Gb + (long)tok * 1024 + 16 * lane;
    bf16x8 o0 = *(const bf16x8*)tp, o1 = *(const bf16x8*)(tp + 8);
    bf16x8 g0 = *(const bf16x8*)gp, g1 = *(const bf16x8*)(gp + 8);
    float ov[16], gv[16];
#pragma unroll
    for (int e = 0; e < 8; ++e) {
      ov[e] = bf2f((bf16_t)o0[e]); ov[8 + e] = bf2f((bf16_t)o1[e]);
      gv[e] = bf2f((bf16_t)g0[e]); gv[8 + e] = bf2f((bf16_t)g1[e]);
    }
    float ss = 0.f;
#pragma unroll
    for (int e = 0; e < 16; ++e) ss += ov[e] * ov[e];
    ss += sxor(ss, 1, lane); ss += sxor(ss, 2, lane); ss += sxor(ss, 4, lane); ss += sxor(ss, 8, lane);
    const float rs = rsqrtf(ss * (1.f / 256.f) + EPS);
    const float* ng = p.e_gla_norm_g + li * 256 + ((16 * lane) & 255);
    bf16x8 r0, r1;
#pragma unroll
    for (int e = 0; e < 8; ++e) {
      r0[e] = (short)f2bf(ov[e] * rs * ng[e] * siluf_(gv[e]));
      r1[e] = (short)f2bf(ov[8 + e] * rs * ng[8 + e] * siluf_(gv[8 + e]));
    }
    if (!dry) { *(bf16x8*)gp = r0;
    *(bf16x8*)(gp + 8) = r1; }
  }
}

__device__ void phase_ml_combine(const Params& p, int li, bool dry = false) {
  const int tid_ = otid(); const int lane = tid_ & 63, w = tid_ >> 6;
  for (int tok = blockIdx.x * 4 + w; tok < T_TOK; tok += gridDim.x * 4) {
    const long off = (long)tok * 512 + 8 * lane;
    bf16x8 hv = *(const bf16x8*)(p.NUMIf + off);
    bf16x8 hb = *(const bf16x8*)(p.NUMIb + off);
    bf16x8 mo = *(const bf16x8*)(p.MOb + off);
    bf16x8 mg = *(const bf16x8*)(p.MLGb + off);
    float hf[8];
    float ss = 0.f;
#pragma unroll
    for (int e = 0; e < 8; ++e) { hf[e] = bf2f((bf16_t)hv[e]) + bf2f((bf16_t)hb[e]); ss += hf[e] * hf[e]; }
    ss += sxor(ss, 1, lane); ss += sxor(ss, 2, lane); ss += sxor(ss, 4, lane); ss += sxor(ss, 8, lane);
    const float rs = rsqrtf(ss * (1.f / 128.f) + EPS);
    const float* ng = p.o_ml_norm_g + li * 128 + ((8 * lane) & 127);
    bf16x8 r;
#pragma unroll
    for (int e = 0; e < 8; ++e)
      r[e] = (short)f2bf(hf[e] * rs * ng[e] * sigmoidf_(bf2f((bf16_t)mo[e])) * siluf_(bf2f((bf16_t)mg[e])));
    if (!dry) *(bf16x8*)(p.MLGb + off) = r;
  }
}

__device__ void phase_final(const Params& p, bool dry = false) {
  const int tid_ = otid(); const int lane = tid_ & 63, w = tid_ >> 6;
  for (int tok = blockIdx.x * 4 + w; tok < T_TOK; tok += gridDim.x * 4) {
    float* xp = p.out + (long)tok * DM;
    float4 v[4];
    float ss = 0.f;
#pragma unroll
    for (int i = 0; i < 4; ++i) {
      v[i] = *(const float4*)(xp + 4 * lane + 256 * i);
      ss += v[i].x * v[i].x + v[i].y * v[i].y + v[i].z * v[i].z + v[i].w * v[i].w;
    }
#pragma unroll
    for (int d = 1; d < 64; d <<= 1) ss += sxor(ss, d, lane);
    const float rs = rsqrtf(ss * (1.f / 1024.f) + EPS);
#pragma unroll
    for (int i = 0; i < 4; ++i) {
      float4 gq = *(const float4*)(p.final_norm_g + 4 * lane + 256 * i);
      float4 o;
      o.x = v[i].x * rs * gq.x; o.y = v[i].y * rs * gq.y; o.z = v[i].z * rs * gq.z; o.w = v[i].w * rs * gq.w;
      if (!dry) *(float4*)(xp + 4 * lane + 256 * i) = o;
    }
  }
}

__device__ void run_phase(const Params& p, int ph, char* smem) {
  if (ph == 0) { if (PH_ON(0)) phase_prep(p, smem); return; }
  if (ph == NPHASE - 1) { if (PROBE_B) phase_final(p, true); if (PH_ON(11)) phase_final(p); return; }
  const int q = ph - 1;
  const int layer = (q < 5) ? 0 : (q < 12) ? 1 : (q < 17) ? 2 : 3;
  const int sub = (q < 5) ? q : (q < 12) ? q - 5 : (q < 17) ? q - 12 : q - 17;
  const int li = layer >> 1;
  const float* xa = (layer == 0) ? p.x_prompt : p.out;
  const float* xb = (layer == 0) ? p.x_sample : p.out + (long)T_P * DM;
  if ((layer & 1) == 0) {
    if (sub == 0) {
      EpiEvenIn e{p.Qb, p.Kt, p.VtE, p.Gb, p.LRb, p.PUb, p.PGb};
      if (PH_ON(1)) gemm_phase<3, 8>(T_TOK / 128, NE_PAD / 256, DM, p.WinE + (long)li * NE_PAD * DM, p.SSQ, nullptr, p.TMP, DM, DM, p.TMP, DM, e, smem);
    } else if (sub == 1) {
      for (int item = blockIdx.x; item < 5120; item += gridDim.x)
        if (PH_ON(2)) gla_intra_item(p, li, item, smem);
    } else if (sub == 2) {
      __shared__ int s_pitem;
      for (int item = blockIdx.x; item < 384; item += gridDim.x) { if (PH_ON(2)) gla_chain_item(p, li, item, smem, false); }
      for (;;) {
        __syncthreads();
        if (threadIdx.x == 0) s_pitem = atomicAdd(p.counters + 16 + li, 1);
        __syncthreads();
        const int item = s_pitem;
        if (item >= 5120) break;
        if (PH_ON(3)) pool_item(p, li, item, smem);
      }
    } else if (sub == 3) {
      if (PROBE_B) phase_gla_combine(p, li, true);
      if (PH_ON(4)) phase_gla_combine(p, li);
    } else {
      EpiOut e{xa, xb, p.out, false, p.NUMIf, p.SSQ};
      if (PH_ON(5)) gemm_phase<1, 8>(T_TOK / 128, DM / 256, 1536, p.WoutE + (long)li * DM * 1536, nullptr, nullptr, p.Gb, 1024, 1024, p.PGb, 512, e, smem);
    }
  } else {
    if (sub == 0) {
      EpiOddIn e{p.CQb, p.CKVb, p.KRb, p.MGb, p.MQb, p.MKb, p.MKt, p.MVt, p.MOb, p.MLGb, p.MIF};
      if (PH_ON(6)) gemm_phase<3, 8>(T_TOK / 128, NO_PAD / 256, DM, p.WinO + (long)li * NO_PAD * DM, p.SSQ, nullptr, p.NUMIf, DM, DM, p.NUMIf, DM, e, smem);
    } else if (sub == 1) {
      for (int rep = 0; rep < 1 + PROBE_A; ++rep)
      for (int item = blockIdx.x; item < 5120; item += gridDim.x)
        if (PH_ON(8)) ml_intra_item(p, li, item, smem);
    } else if (sub == 2) {
      for (int item = blockIdx.x; item < 768; item += gridDim.x)
        if (PH_ON(8)) ml_chain_item(p, li, item, smem, false);
    } else if (sub == 3) {
      if (PROBE_B) phase_ml_combine(p, li, true);
      if (PH_ON(10)) phase_ml_combine(p, li);
    } else if (sub == 4) {
      EpiQUp eq{p.Qa};
      if (PH_ON(7)) gemm_phase<2, 4>(T_TOK / 128, 768 / 128, 384, p.QupT + (long)li * 768 * 384, nullptr, nullptr, p.CQb, 384, 384, p.CQb, 384, eq, smem);
      EpiKVUp ek{p.KNb, p.VtA};
      if (PH_ON(7)) gemm_phase<2, 4>(T_TOK / 128, 1024 / 128, 256, p.KVupT + (long)li * 1024 * 256, nullptr, nullptr, p.CKVb, 256, 256, p.CKVb, 256, ek, smem);
    } else if (sub == 5) {
      __shared__ int s_item;
      for (;;) {
        __syncthreads();
        if (threadIdx.x == 0) s_item = atomicAdd(p.counters + li * 8 + (blockIdx.x & 7), 1);
        __syncthreads();
        const int item = s_item;
        if (item >= 320) break;
        if (PH_ON(9)) attn_item(p, (blockIdx.x & 7) * 320 + item, smem);
      }
    } else {
      EpiOut e{xa, xb, p.out, false, (layer == 3) ? nullptr : p.TMP, p.SSQ};
      if (PH_ON(5)) gemm_phase<1, 8>(T_TOK / 128, DM / 256, 1024, p.WoutO + (long)li * DM * 1024, nullptr, nullptr, p.MGb, 512, 512, p.MLGb, 512, e, smem);
    }
  }
}

__global__ void __launch_bounds__(256, 2) mega_kernel(Params p) {
  extern __shared__ __attribute__((aligned(16))) char smem[];
  cg::grid_group grid = cg::this_grid();
  __shared__ uint4 xb_words;
  if (threadIdx.x == 0) xb_words = make_uint4(0u, 0u, 0u, 0u);
  __syncthreads();
  XcdBarrier xb = xcd_barrier_post(p.bar, (volatile LAS unsigned*)&xb_words);
  for (int ph = p.ph_lo; ph < p.ph_hi; ++ph) {
    if (ph > p.ph_lo) {
      if (ph == p.ph_lo + 1) grid.sync();
      else xcd_barrier(xb);
    }
    run_phase(p, ph, smem);
  }
}

extern "C" void kernel_launch(void* const* d_in, const int* in_sizes, int n_in, void* d_out, int out_size, void* d_ws,
                              size_t ws_size, hipStream_t stream) {
  static int grid_blocks = 0;
  if (!grid_blocks) {
    int dev = 0, cus = 0, per_cu = 0;
    hipGetDevice(&dev);
    hipDeviceGetAttribute(&cus, hipDeviceAttributeMultiprocessorCount, dev);
    hipFuncSetAttribute((const void*)mega_kernel, hipFuncAttributeMaxDynamicSharedMemorySize, LDS_BYTES);
    hipOccupancyMaxActiveBlocksPerMultiprocessor(&per_cu, (const void*)mega_kernel, 256, LDS_BYTES);
    if (per_cu < 1) per_cu = 1;
    if (per_cu > 2) per_cu = 2;
    grid_blocks = cus * per_cu;
    fprintf(stderr, "kernel_launch: cus %d per_cu %d grid %d ws %zu\n", cus, per_cu, grid_blocks, ws_size);
  }
  Params p{};
  const float** pin = (const float**)&p;
  for (int i = 0; i < 19; ++i) pin[i] = (const float*)d_in[i];
  p.out = (float*)d_out;
  char* ws = (char*)d_ws;
  size_t off = 0;
  auto take = [&](size_t bytes) { char* r = ws + off; off += (bytes + 255) & ~(size_t)255; return r; };
  p.WinE = (bf16_t*)take((size_t)2 * NE_PAD * DM * 2);
  p.WinO = (bf16_t*)take((size_t)2 * NO_PAD * DM * 2);
  p.WoutE = (bf16_t*)take((size_t)2 * DM * 1536 * 2);
  p.WoutO = (bf16_t*)take((size_t)2 * DM * 1024 * 2);
  p.QupT = (bf16_t*)take((size_t)2 * 768 * 384 * 2);
  p.KVupT = (bf16_t*)take((size_t)2 * 1024 * 256 * 2);
  p.PoolWT = (bf16_t*)take((size_t)2 * 4 * 128 * 128 * 2);
  p.AupT = (bf16_t*)take((size_t)2 * 2 * 512 * 32 * 2);
  p.counters = (int*)take(256);
  p.bar = (unsigned*)take((size_t)XCD_BAR_WORDS * 4);
  p.SSQ = (float*)take((size_t)T_TOK * 8 * 4);
  const size_t act0 = off;
  const size_t T = T_TOK;
  p.Gb = (bf16_t*)take(T * 1024 * 2);
  p.PGb = (bf16_t*)take(T * 512 * 2);
  p.Qb = (bf16_t*)take(T * 512 * 2);
  p.Kt = (bf16_t*)take(T * 512 * 2);
  p.QEb = (bf16_t*)take(T * 512 * 2);
  p.KdTb = (bf16_t*)take(T * 512 * 2);
  p.EB = (float*)take((size_t)2 * 1280 * 512 * 4);
  p.VtE = (bf16_t*)take(T * 1024 * 2);
  p.LRb = (bf16_t*)take(T * 32 * 2);
  p.PUb = (bf16_t*)take(T * 512 * 2);
  p.TMP = (bf16_t*)take(T * 1024 * 2);
  const size_t even_end = off;
  off = act0;
  p.MGb = (bf16_t*)take(T * 512 * 2);
  p.MLGb = (bf16_t*)take(T * 512 * 2);
  p.CQb = (bf16_t*)take(T * 384 * 2);
  p.CKVb = (bf16_t*)take(T * 256 * 2);
  p.KRb = (bf16_t*)take(T * 32 * 2);
  const size_t r2 = off;
  p.MQb = (bf16_t*)take(T * 512 * 2);
  p.MKb = (bf16_t*)take(T * 512 * 2);
  p.MKt = (bf16_t*)take(T * 512 * 2);
  p.MVt = (bf16_t*)take(T * 512 * 2);
  p.MOb = (bf16_t*)take(T * 512 * 2);
  p.NUMIf = (bf16_t*)take(T * 512 * 2);
  p.NUMIb = (bf16_t*)take(T * 512 * 2);
  p.MIF = (float*)take(T * 16 * 4);
  p.EBI = (float*)take(T * 8 * 4);
  p.WKg = (float*)take(T * 8 * 4);
  p.DENI = (float*)take(T * 8 * 4);
  p.DEC = (float*)take((size_t)8 * 1280 * 4);
  const size_t r2_end = off;
  off = r2;
  p.Qa = (bf16_t*)take(T * 768 * 2);
  p.KNb = (bf16_t*)take(T * 512 * 2);
  p.VtA = (bf16_t*)take(T * 512 * 2);
  if (off < r2_end) off = r2_end;
  const size_t odd_end = off;
  const size_t need = even_end > odd_end ? even_end : odd_end;
  if (need > ws_size) {
    fprintf(stderr, "kernel_launch: workspace too small: need %zu have %zu\n", need, ws_size);
    return;
  }
  hipMemsetAsync(p.bar, 0, (size_t)XCD_BAR_WORDS * 4, stream);
#if SINGLE_LAUNCH
  p.ph_lo = 0;
  p.ph_hi = NPHASE;
  void* args[] = {&p};
  hipError_t e = hipLaunchCooperativeKernel((const void*)mega_kernel, dim3(grid_blocks), dim3(256), args, LDS_BYTES, stream);
  if (e != hipSuccess) fprintf(stderr, "cooperative launch failed: %s (grid %d)\n", hipGetErrorString(e), grid_blocks);
#else
  for (int ph = 0; ph < NPHASE; ++ph) {
    p.ph_lo = ph;
    p.ph_hi = ph + 1;
    hipLaunchKernelGGL(mega_kernel, dim3(grid_blocks), dim3(256), LDS_BYTES, stream, p);
  }
#endif
}
```

```cpp
#include <hip/hip_runtime.h>
#include <hip/hip_cooperative_groups.h>
#include <cstdio>
namespace cg = cooperative_groups;

#ifndef SINGLE_LAUNCH
#define SINGLE_LAUNCH 1
#endif
#ifndef PHMASK
#define PHMASK 0xFFFF
#endif
#define PH_ON(b) ((PHMASK >> (b)) & 1)
#ifndef PROBE_GEMM
#define PROBE_GEMM 0
#endif
#ifndef PROBE_ATTN
#define PROBE_ATTN 0
#endif
#ifndef PROBE_CHAIN
#define PROBE_CHAIN 0
#endif
#ifndef PROBE_A
#define PROBE_A 0
#endif
#ifndef PROBE_B
#define PROBE_B 0
#endif
#ifndef PROBE_MLCHAIN
#define PROBE_MLCHAIN 0
#endif

typedef unsigned short bf16_t;
typedef __attribute__((ext_vector_type(8))) short bf16x8;
typedef __attribute__((ext_vector_type(4))) float f32x4;
typedef __attribute__((ext_vector_type(4))) unsigned short us4;

constexpr int T_TOK = 81920;
constexpr int T_P = 16384;
constexpr int DM = 1024;
constexpr int NE = 4128, NE_PAD = 4352;
constexpr int NO = 3760, NO_PAD = 3840;
constexpr float EPS = 1e-6f;
constexpr int NPHASE = 26;
constexpr int LDS_BYTES = 72 * 1024;

struct Params {
  const float *x_prompt, *x_sample, *norm_g, *final_norm_g, *e_w_in, *e_a_up, *e_a_bias, *e_gla_norm_g,
      *e_pool_w, *e_pool_scale, *e_w_out, *o_w_in, *o_q_norm_g, *o_q_up, *o_kv_norm_g, *o_kv_up, *o_if_bias,
      *o_ml_norm_g, *o_w_out;
  float* out;
  bf16_t *WinE, *WinO, *WoutE, *WoutO, *QupT, *KVupT, *PoolWT, *AupT;
  int* counters;
  unsigned* bar;
  float* SSQ;
  bf16_t *Qb, *Kt, *VtE, *Gb, *LRb, *PUb, *PGb, *TMP, *QEb, *KdTb;
  float* EB;
  bf16_t *CQb, *CKVb, *KRb, *MGb, *MQb, *MKb, *MKt, *MVt, *MOb, *MLGb, *NUMIf, *NUMIb, *Qa, *KNb, *VtA;
  float *MIF, *EBI, *WKg, *DENI, *DEC;
  int ph_lo, ph_hi;
};

typedef __bf16 hbf2 __attribute__((ext_vector_type(2)));
typedef float hf2 __attribute__((ext_vector_type(2)));
__device__ __forceinline__ bf16_t f2bf(float f) {
  __bf16 b = (__bf16)f;
  return __builtin_bit_cast(bf16_t, b);
}
__device__ __forceinline__ unsigned pk2bf(float a, float b) {
  hf2 v = {a, b};
  hbf2 r = __builtin_convertvector(v, hbf2);
  return __builtin_bit_cast(unsigned, r);
}
__device__ __forceinline__ float bf2f(bf16_t b) { return __uint_as_float(((unsigned)b) << 16); }
__device__ __forceinline__ f32x4 mfma16(bf16x8 a, bf16x8 b, f32x4 c) {
  return __builtin_amdgcn_mfma_f32_16x16x32_bf16(a, b, c, 0, 0, 0);
}
__device__ __forceinline__ float logsigmoidf_(float x) { return fminf(x, 0.f) - log1pf(__expf(-fabsf(x))); }
__device__ __forceinline__ float siluf_(float x) { return x / (1.f + __expf(-x)); }
__device__ __forceinline__ float sigmoidf_(float x) { return 1.f / (1.f + __expf(-x)); }
__device__ __forceinline__ int otid() { int t = threadIdx.x; asm volatile("" : "+v"(t)); return t; }
__device__ __forceinline__ float bperm(int srclane, float v) { return __int_as_float(__builtin_amdgcn_ds_bpermute(srclane << 2, __float_as_int(v))); }
__device__ __forceinline__ float sxor(float v, int m, int lane) { return bperm(lane ^ m, v); }
typedef unsigned u32x2_t __attribute__((ext_vector_type(2)));
__device__ __forceinline__ float rowmax4(float v) {
  u32x2_t r = __builtin_amdgcn_permlane16_swap(__float_as_uint(v), __float_as_uint(v), false, false);
  v = fmaxf(__uint_as_float(r[0]), __uint_as_float(r[1]));
  r = __builtin_amdgcn_permlane32_swap(__float_as_uint(v), __float_as_uint(v), false, false);
  return fmaxf(__uint_as_float(r[0]), __uint_as_float(r[1]));
}
template <int CTRL> __device__ __forceinline__ float dpp_f(float v) {
  return __int_as_float(__builtin_amdgcn_update_dpp(0, __float_as_int(v), CTRL, 0xf, 0xf, false));
}
__device__ __forceinline__ float wave_sum(float v) {
  v += dpp_f<0x128>(v);
  v += dpp_f<0x124>(v);
  v += dpp_f<0x122>(v);
  v += dpp_f<0x121>(v);
  u32x2_t r = __builtin_amdgcn_permlane16_swap(__float_as_uint(v), __float_as_uint(v), false, false);
  v = __uint_as_float(r[0]) + __uint_as_float(r[1]);
  r = __builtin_amdgcn_permlane32_swap(__float_as_uint(v), __float_as_uint(v), false, false);
  return __uint_as_float(r[0]) + __uint_as_float(r[1]);
}
__device__ __forceinline__ bf16x8 zero8() { bf16x8 z = {0, 0, 0, 0, 0, 0, 0, 0}; return z; }
__device__ __forceinline__ f32x4 zero4() { f32x4 z = {0.f, 0.f, 0.f, 0.f}; return z; }

__device__ __forceinline__ int seq_pos(int tok) { return tok < T_P ? (tok & 4095) : ((tok - T_P) & 8191); }
__device__ __forceinline__ const float* xrow(const float* xa, const float* xb, int tok) {
  return tok < T_P ? xa + (long)tok * DM : xb + (long)(tok - T_P) * DM;
}


#define XB_TMO      128
#define XB_XCNT(j)  (256  + 64 * (j))
#define XB_XSUB(j)  (1280 + 64 * (j))
#define XB_XGEN(j)  (2304 + 64 * (j))
#define XB_TOP      3328
#define XB_TOPGEN   3392
#define XCD_BAR_WORDS 3456
#define XB_SPIN_CAP (1u << 22)
#define LAS __attribute__((address_space(3)))
__device__ __forceinline__ unsigned xb_ld(unsigned* p) { return __hip_atomic_load(p, __ATOMIC_RELAXED, __HIP_MEMORY_SCOPE_AGENT); }
__device__ __forceinline__ unsigned xb_add(unsigned* p, unsigned v) { return __hip_atomic_fetch_add(p, v, __ATOMIC_RELAXED, __HIP_MEMORY_SCOPE_AGENT); }
__device__ __forceinline__ unsigned xb_xcc_id() { return (unsigned)__builtin_amdgcn_s_getreg((3 << 11) | 20) & 0xFu; }
#define XB_SPIN(cond, bar) do { unsigned _sp = 0; while (cond) { __builtin_amdgcn_s_sleep(1); \
    if ((++_sp & 255u) == 0u) { if (xb_ld(&(bar)[XB_TMO])) break; if (_sp > XB_SPIN_CAP) { atomicAdd(&(bar)[XB_TMO], 1u); break; } } } } while (0)
struct XcdBarrier { unsigned* bar; unsigned x; volatile LAS unsigned* st; };
__device__ __forceinline__ XcdBarrier xcd_barrier_post(unsigned* bar, volatile LAS unsigned* st) {
  XcdBarrier b; b.bar = bar; b.x = xb_xcc_id(); b.st = st;
  if (threadIdx.x == 0) (void)xb_add(&bar[XB_XCNT(b.x)], 1u);
  return b;
}
__device__ __forceinline__ void xcd_barrier_complete(unsigned* bar, unsigned x, unsigned& nloc, unsigned& nx) {
  const unsigned G = gridDim.x * gridDim.y * gridDim.z;
  unsigned sum, cnt, mine, sp = 0u;
  for (;;) {
    sum = 0u; cnt = 0u; mine = 0u;
#pragma unroll
    for (unsigned j = 0; j < 16; ++j) { const unsigned cc = xb_ld(&bar[XB_XCNT(j)]); sum += cc; cnt += (cc > 0u) ? 1u : 0u; mine = (j == x) ? cc : mine; }
    if (sum == G) break;
    __builtin_amdgcn_s_sleep(1);
    if ((++sp & 255u) == 0u) { if (xb_ld(&bar[XB_TMO])) break; if (sp > XB_SPIN_CAP) { atomicAdd(&bar[XB_TMO], 1u); break; } }
  }
  nloc = mine > 0u ? mine : 1u; nx = cnt > 0u ? cnt : 1u;
}
__device__ __forceinline__ void xcd_barrier(const XcdBarrier& b) {
  asm volatile("s_waitcnt vmcnt(0)" ::: "memory");
  __syncthreads();
  if (threadIdx.x == 0) {
    unsigned* bar = b.bar;
    __builtin_amdgcn_s_waitcnt(0);
    unsigned nloc = b.st[0], nx = b.st[1];
    if (nloc == 0u) { xcd_barrier_complete(bar, b.x, nloc, nx); b.st[0] = nloc; b.st[1] = nx; }
    const unsigned old = xb_add(&bar[XB_XSUB(b.x)], 1u);
    const unsigned gen = old / nloc;
    if (old + 1u == (gen + 1u) * nloc) {
      __builtin_amdgcn_fence(__ATOMIC_RELEASE, "agent");
      asm volatile("s_waitcnt vmcnt(0)" ::: "memory");
      const unsigned og = xb_add(&bar[XB_TOP], 1u);
      const unsigned tg = og / nx;
      if (og + 1u == (tg + 1u) * nx) xb_add(&bar[XB_TOPGEN], 1u);
      else XB_SPIN(xb_ld(&bar[XB_TOPGEN]) == tg, bar);
      __builtin_amdgcn_fence(__ATOMIC_ACQUIRE, "agent");
      xb_add(&bar[XB_XGEN(b.x)], 1u);
      asm volatile("s_waitcnt vmcnt(0)" ::: "memory");
    } else {
      XB_SPIN(xb_ld(&bar[XB_XGEN(b.x)]) == gen, bar);
      __builtin_amdgcn_fence(__ATOMIC_ACQUIRE, "agent");
      asm volatile("s_waitcnt vmcnt(0)" ::: "memory");
    }
  }
  __syncthreads();
}

__device__ __forceinline__ int colmap(int mode, int n) {
  if (mode == 1) {
    if (n < 512) return 2208 + n;
    if (n < 1024) return 1696 + (n - 512);
    if (n < 1408) return n - 1024;
    if (n < 1664) return 384 + (n - 1408);
    if (n < 2176) return 672 + (n - 1664);
    if (n < 2688) return 1184 + (n - 2176);
    if (n < 3200) return 2720 + (n - 2688);
    if (n < 3712) return 3248 + (n - 3200);
    if (n < 3744) return 640 + (n - 3712);
    return 3232 + (n - 3744);
  }
  if (mode == 2) {
    if (n < 512) return (n >> 6) * 96 + (n & 63);
    const int r = n - 512;
    return (r >> 5) * 96 + 64 + (r & 31);
  }
  if (mode == 3) {
    if (n < 512) return (n >> 6) * 128 + (n & 63);
    const int r = n - 512;
    return (r >> 6) * 128 + 64 + (r & 63);
  }
  return n;
}

__device__ void prep_weight(const float* __restrict__ W, int K, int N, int Npad, const float* __restrict__ gsc,
                            bf16_t* __restrict__ out, char* smem, int mode = 0, int Nsrc_ = 0) {
  const int Nsrc = Nsrc_ ? Nsrc_ : N;
  const int tid = otid();
  float* sT = (float*)smem;
  const int tn = Npad >> 6, tk = K >> 6;
  for (int tile = blockIdx.x; tile < tn * tk; tile += gridDim.x) {
    const int n0 = (tile / tk) << 6, k0 = (tile % tk) << 6;
    __syncthreads();
#pragma unroll 4
    for (int i = 0; i < 16; ++i) {
      const int idx = tid + 256 * i;
      const int kk = idx >> 6, nn = idx & 63;
      float v = 0.f;
      if (n0 + nn < N) {
        v = W[(size_t)(k0 + kk) * Nsrc + colmap(mode, n0 + nn)];
        if (gsc) v *= gsc[k0 + kk];
      }
      sT[nn * 65 + kk] = v;
    }
    __syncthreads();
#pragma unroll 4
    for (int i = 0; i < 16; ++i) {
      const int idx = tid + 256 * i;
      const int nn = idx >> 6, kk = idx & 63;
      out[(size_t)(n0 + nn) * K + k0 + kk] = f2bf(sT[nn * 65 + kk]);
    }
  }
}

__device__ void phase_prep(const Params& p, char* smem) {
  long gtid = (long)blockIdx.x * 256 + otid();
  long gsize = (long)gridDim.x * 256;
  for (int l = 0; l < 2; ++l) {
    prep_weight(p.e_w_in + (long)l * DM * NE, DM, NE, NE_PAD, p.norm_g + (2 * l) * DM, p.WinE + (long)l * NE_PAD * DM, smem);
    prep_weight(p.o_w_in + (long)l * DM * 3760, DM, NO, NO_PAD, p.norm_g + (2 * l + 1) * DM, p.WinO + (long)l * NO_PAD * DM, smem, 1, 3760);
    prep_weight(p.e_w_out + (long)l * 1536 * DM, 1536, DM, DM, nullptr, p.WoutE + (long)l * DM * 1536, smem);
    prep_weight(p.o_w_out + (long)l * 1024 * DM, 1024, DM, DM, nullptr, p.WoutO + (long)l * DM * 1024, smem);
    prep_weight(p.o_q_up + (long)l * 384 * 768, 384, 768, 768, p.o_q_norm_g + l * 384, p.QupT + (long)l * 768 * 384, smem, 2);
    prep_weight(p.o_kv_up + (long)l * 256 * 1024, 256, 1024, 1024, p.o_kv_norm_g + l * 256, p.KVupT + (long)l * 1024 * 256, smem, 3);
    for (int gi = 0; gi < 4; ++gi)
      prep_weight(p.e_pool_w + (long)(l * 4 + gi) * 128 * 128, 128, 128, 128, nullptr, p.PoolWT + (long)(l * 4 + gi) * 128 * 128, smem);
    for (long idx = gtid; idx < 2 * 512 * 32; idx += gsize) {
      int r = (int)(idx & 31);
      int d = (int)((idx >> 5) & 511);
      int dir = (int)(idx >> 14);
      float v = (r < 16) ? p.e_a_up[((long)(l * 2 + dir) * 16 + r) * 512 + d] : 0.f;
      p.AupT[((long)(l * 2 + dir) * 512 + d) * 32 + r] = f2bf(v);
    }
  }
  if (gtid < 32) p.counters[gtid] = 0;
  {
    const int tid_ = otid();
    const int lane = tid_ & 63, w = tid_ >> 6;
    for (int tok = blockIdx.x * 4 + w; tok < T_TOK; tok += gridDim.x * 4) {
      const float* xp = xrow(p.x_prompt, p.x_sample, tok) + 16 * lane;
      float ssv = 0.f;
      unsigned pk[8];
#pragma unroll
      for (int i = 0; i < 4; ++i) {
        const f32x4 v = *(const f32x4*)(xp + 4 * i);
        ssv += v[0] * v[0] + v[1] * v[1] + v[2] * v[2] + v[3] * v[3];
        pk[2 * i] = pk2bf(v[0], v[1]);
        pk[2 * i + 1] = pk2bf(v[2], v[3]);
      }
      uint4 o0, o1;
      o0.x = pk[0]; o0.y = pk[1]; o0.z = pk[2]; o0.w = pk[3];
      o1.x = pk[4]; o1.y = pk[5]; o1.z = pk[6]; o1.w = pk[7];
      *(uint4*)(p.TMP + (size_t)tok * DM + 16 * lane) = o0;
      *(uint4*)(p.TMP + (size_t)tok * DM + 16 * lane + 8) = o1;
      ssv = wave_sum(ssv);
      if (lane < 8) p.SSQ[(size_t)tok * 8 + lane] = (lane == 0) ? ssv : 0.f;
    }
  }
}

constexpr int G_LD = 40;
constexpr int G_BUF = (128 + 256) * G_LD;

template <int AMODE, int NI, class Epi>
__device__ __forceinline__ void gemm_phase(int Mtiles, int Ntiles, int K, const bf16_t* __restrict__ Bt, const float* ssq, const float* unused_,
                           const bf16_t* A1, int ld1, int K1, const bf16_t* A2, int ld2, const Epi& epi, char* smem) {
  bf16_t* sbase = (bf16_t*)smem;
  float* sR = (float*)(smem + 70144);
  const int tid = otid(), lane = tid & 63, w = tid >> 6, c = lane & 15, g = lane >> 4;
  const int wm = w >> 1, wn = w & 1;
  const int nk = K / 32;
  const int xcd = blockIdx.x & 7, lb0 = blockIdx.x >> 3, nlb = gridDim.x >> 3;
  const int mper = Mtiles >> 3;
  for (int lt = lb0; lt < mper * Ntiles; lt += nlb) {
    const int mt = xcd * mper + lt / Ntiles, nt = lt % Ntiles;
    constexpr int BN = 32 * NI;
    const int m0 = mt * 128, n0 = nt * BN;
    f32x4 acc[4][NI];
#pragma unroll
    for (int i = 0; i < 4; ++i)
#pragma unroll
      for (int j = 0; j < NI; ++j) acc[i][j] = zero4();
    float ss[2] = {0.f, 0.f};
    bf16x8 ra0[2], ra1[2];
    bf16x8 rb0[NI / 2], rb1[NI / 2];
    const unsigned boff = (unsigned)(tid >> 2) * K + 8 * (tid & 3);
    const bf16_t* bbase = Bt + (size_t)n0 * K;
#define G_LOAD(RA, RB, KT)                                                                          \
  {                                                                                                 \
    const int k0_ = (KT) * 32;                                                                      \
    const bf16_t* base_;                                                                            \
    int ld_;                                                                                        \
    if (k0_ < K1) { base_ = A1 + (size_t)m0 * ld1 + k0_; ld_ = ld1; }                               \
    else { base_ = A2 + (size_t)m0 * ld2 + (k0_ - K1); ld_ = ld2; }                                 \
    _Pragma("unroll") for (int i = 0; i < 2; ++i)                                                   \
      RA[i] = *(const bf16x8*)(base_ + (unsigned)((tid >> 2) + 64 * i) * ld_ + 8 * (tid & 3));      \
    _Pragma("unroll") for (int i = 0; i < NI / 2; ++i)                                              \
      RB[i] = *(const bf16x8*)(bbase + k0_ + boff + (unsigned)(64 * i) * K);                        \
  }
#define G_STORE(RA, RB, BUF)                                                                        \
  {                                                                                                 \
    bf16_t* sA_ = sbase + (BUF) * G_BUF;                                                            \
    bf16_t* sB_ = sA_ + 128 * G_LD;                                                                 \
    _Pragma("unroll") for (int i = 0; i < 2; ++i) {                                                 \
      bf16x8 v = RA[i];                                                                             \
      if constexpr (AMODE == 2) {                                                                   \
        _Pragma("unroll") for (int e = 0; e < 8; ++e) {                                             \
          float f = bf2f((bf16_t)v[e]);                                                             \
          ss[i] += f * f;                                                                           \
        }                                                                                           \
      }                                                                                             \
      *(bf16x8*)(sA_ + ((tid >> 2) + 64 * i) * G_LD + 8 * (tid & 3)) = v;                           \
    }                                                                                               \
    _Pragma("unroll") for (int i = 0; i < NI / 2; ++i)                                              \
      *(bf16x8*)(sB_ + ((tid >> 2) + 64 * i) * G_LD + 8 * (tid & 3)) = RB[i];                       \
  }
#define G_COMPUTE(BUF)                                                                              \
  {                                                                                                 \
    const bf16_t* sA_ = sbase + (BUF) * G_BUF;                                                      \
    const bf16_t* sB_ = sA_ + 128 * G_LD;                                                           \
    bf16x8 af[4];                                                                                   \
    _Pragma("unroll") for (int mi = 0; mi < 4; ++mi)                                                \
      af[mi] = *(const bf16x8*)(sA_ + (wm * 64 + mi * 16 + c) * G_LD + g * 8);                      \
    bf16x8 bq[2];                                                                                   \
    bq[0] = *(const bf16x8*)(sB_ + (wn * (16 * NI) + c) * G_LD + g * 8);                            \
    _Pragma("unroll") for (int ni = 0; ni < NI; ++ni) {                                             \
      if (ni + 1 < NI)                                                                              \
        bq[(ni + 1) & 1] = *(const bf16x8*)(sB_ + (wn * (16 * NI) + (ni + 1) * 16 + c) * G_LD + g * 8); \
      _Pragma("unroll") for (int mi = 0; mi < 4; ++mi) acc[mi][ni] = mfma16(af[mi], bq[ni & 1], acc[mi][ni]); \
    }                                                                                               \
  }
    __syncthreads();
    if constexpr (AMODE == 3) {
      if (tid < 128) {
        const f32x4 p0 = *(const f32x4*)(ssq + (size_t)(m0 + tid) * 8);
        const f32x4 p1 = *(const f32x4*)(ssq + (size_t)(m0 + tid) * 8 + 4);
        const float sv = (p0[0] + p0[1]) + (p0[2] + p0[3]) + (p1[0] + p1[1]) + (p1[2] + p1[3]);
        sR[tid] = rsqrtf(sv * (1.f / 1024.f) + EPS);
      }
    }
    G_LOAD(ra0, rb0, 0)
    G_LOAD(ra1, rb1, 1)
    G_STORE(ra0, rb0, 0)
    __syncthreads();
    for (int kt = 0; kt < nk; kt += 2) {
      G_LOAD(ra0, rb0, min(kt + 2, nk - 1))
      G_COMPUTE(0)
      G_STORE(ra1, rb1, 1)
      __syncthreads();
      G_LOAD(ra1, rb1, min(kt + 3, nk - 1))
      G_COMPUTE(1)
      if (kt + 2 < nk) G_STORE(ra0, rb0, 0)
      __syncthreads();
    }
    if constexpr (AMODE == 2) {
#pragma unroll
      for (int i = 0; i < 2; ++i) {
        float sv = ss[i];
        sv += sxor(sv, 1, lane); sv += sxor(sv, 2, lane);
        if ((tid & 3) == 0) sR[(tid >> 2) + 64 * i] = rsqrtf(sv / (float)K + EPS);
      }
      __syncthreads();
    }
    if constexpr (Epi::staged) {
      bf16_t* sT = sbase;
      const float esc = epi.scale();
      const bool both = epi.both(n0);
#pragma unroll 1
      for (int pass = 0; pass < (both ? 2 : 1); ++pass) {
      const bool tr = both ? (pass == 1) : epi.transposed(n0);
      if (pass) __syncthreads();
      if (tr) {
#pragma unroll
        for (int mi = 0; mi < 4; ++mi) {
          const int row = wm * 64 + mi * 16 + 4 * g;
          const float r0 = sR[row] * esc, r1 = sR[row + 1] * esc, r2 = sR[row + 2] * esc, r3 = sR[row + 3] * esc;
#pragma unroll
          for (int ni = 0; ni < NI; ++ni) {
            uint2 o;
            o.x = pk2bf(acc[mi][ni][0] * r0, acc[mi][ni][1] * r1);
            o.y = pk2bf(acc[mi][ni][2] * r2, acc[mi][ni][3] * r3);
            *(uint2*)(sT + (wn * (16 * NI) + ni * 16 + c) * 136 + row) = o;
          }
        }
      } else {
#pragma unroll
        for (int mi = 0; mi < 4; ++mi) {
          const int row = wm * 64 + mi * 16 + 4 * g;
          const float r0 = sR[row] * esc, r1 = sR[row + 1] * esc, r2 = sR[row + 2] * esc, r3 = sR[row + 3] * esc;
#pragma unroll
          for (int ni = 0; ni < NI; ++ni) {
            bf16_t* d = sT + row * (BN + 8) + wn * (16 * NI) + ni * 16 + c;
            d[0] = f2bf(acc[mi][ni][0] * r0);
            d[BN + 8] = f2bf(acc[mi][ni][1] * r1);
            d[2 * (BN + 8)] = f2bf(acc[mi][ni][2] * r2);
            d[3 * (BN + 8)] = f2bf(acc[mi][ni][3] * r3);
          }
        }
      }
      if (pass == 0) epi.template direct<NI>(m0, n0, wm, wn, g, c, acc, sR);
      __syncthreads();
      if (tr) {
#pragma unroll 4
        for (int i = 0; i < 2 * NI; ++i) {
          const int id = tid + 256 * i;
          const int col = id >> 4, rc = id & 15;
          bf16x8 v = *(const bf16x8*)(sT + col * 136 + 8 * rc);
          epi.store_t(m0 + 8 * rc, n0 + col, v);
        }
      } else {
#pragma unroll 4
        for (int i = 0; i < 2 * NI; ++i) {
          const int id = tid + 256 * i;
          const int row = id / (4 * NI), cc = id % (4 * NI);
          const bf16_t* sp = sT + row * (BN + 8) + 8 * cc;
          bf16x8 v = *(const bf16x8*)sp;
          epi.store_n(m0 + row, n0 + 8 * cc, v, sp);
        }
      }
      }
    } else {
      float* sF = (float*)smem;
#pragma unroll 1
      for (int half = 0; half < 2; ++half) {
        if (half) __syncthreads();
        if (wm == half) {
#pragma unroll
          for (int mi = 0; mi < 4; ++mi)
#pragma unroll
            for (int ni = 0; ni < NI; ++ni)
#pragma unroll
              for (int j = 0; j < 4; ++j) sF[(mi * 16 + 4 * g + j) * 260 + wn * (16 * NI) + ni * 16 + c] = acc[mi][ni][j];
        }
        __syncthreads();
#pragma unroll 4
        for (int i = 0; i < 16; ++i) {
          const int row = w * 16 + i;
          const int tok = m0 + half * 64 + row;
          const int col = n0 + 4 * lane;
          const f32x4 a = *(const f32x4*)(sF + row * 260 + 4 * lane);
          const f32x4 xo = *(const f32x4*)(xrow(epi.xa, epi.xb, tok) + col);
          f32x4 xn;
          xn[0] = xo[0] + a[0]; xn[1] = xo[1] + a[1]; xn[2] = xo[2] + a[2]; xn[3] = xo[3] + a[3];
          float sv = xn[0] * xn[0] + xn[1] * xn[1] + xn[2] * xn[2] + xn[3] * xn[3];
          sv = wave_sum(sv);
          if (!epi.dry) {
            *(f32x4*)(epi.out + (size_t)tok * DM + col) = xn;
            if (epi.hb) {
              uint2 o;
              o.x = pk2bf(xn[0], xn[1]);
              o.y = pk2bf(xn[2], xn[3]);
              *(uint2*)(epi.hb + (size_t)tok * DM + col) = o;
            }
            if (lane == 0) epi.ssq[(size_t)tok * 8 + (n0 >> 8)] = sv;
          }
        }
      }
    }
  }
#undef G_LOAD
#undef G_STORE
#undef G_COMPUTE
}

__device__ __forceinline__ void rope_cs(int pos, int i, float& co, float& si) {
  float inv = exp2f(-(float)i * (13.287712379549449f / 16.f));
  float ang = (float)pos * inv;
  float n = rintf(ang * 0.15915494309189535f);
  float r = fmaf(-n, 6.28125f, ang);
  r = fmaf(-n, 0.0019353071795864769f, r);
  float rf = r * 0.15915494309189535f;
  si = __builtin_amdgcn_sinf(rf);
  co = __builtin_amdgcn_cosf(rf);
}

__device__ __forceinline__ void rope_chunk(int pos, int i0, bf16x8 x1, bf16x8 x2, bf16x8& o1, bf16x8& o2) {
#pragma unroll
  for (int e = 0; e < 8; ++e) {
    float co, si;
    rope_cs(pos, i0 + e, co, si);
    float a = bf2f((bf16_t)x1[e]), b = bf2f((bf16_t)x2[e]);
    o1[e] = (short)f2bf(a * co - b * si);
    o2[e] = (short)f2bf(b * co + a * si);
  }
}

struct EpiEvenIn {
  static constexpr bool staged = true;
  bf16_t *Qb, *Kt, *VtE, *Gb, *LRb, *PUb, *PGb;
  __device__ float scale() const { return 1.f; }
  __device__ bool transposed(int n0) const { return n0 >= 512 && n0 < 2048; }
  __device__ bool both(int n0) const { return false; }
  template <int NI> __device__ void direct(int m0, int n0, int wm, int wn, int g, int c, f32x4 (&acc)[4][NI], const float* sR) const {}
  __device__ void store_t(int tok8, int col, bf16x8 v) const {
    if (col < 1024) *(bf16x8*)(Kt + (size_t)(col - 512) * T_TOK + tok8) = v;
    else *(bf16x8*)(VtE + (size_t)(col - 1024) * T_TOK + tok8) = v;
  }
  __device__ void store_n(int tok, int col, bf16x8 v, const bf16_t* sp) const {
    bf16_t* d;
    if (col < 512) d = Qb + (size_t)tok * 512 + col;
    else if (col < 3072) d = Gb + (size_t)tok * 1024 + (col - 2048);
    else if (col < 3104) d = LRb + (size_t)tok * 32 + (col - 3072);
    else if (col < 3616) d = PUb + (size_t)tok * 512 + (col - 3104);
    else if (col < 4128) d = PGb + (size_t)tok * 512 + (col - 3616);
    else return;
    *(bf16x8*)d = v;
  }
};

struct EpiOddIn {
  static constexpr bool staged = true;
  bf16_t *CQb, *CKVb, *KRb, *MGb, *MQb, *MKb, *MKt, *MVt, *MOb, *MLGb;
  float* MIF;
  __device__ float scale() const { return 1.f; }
  __device__ bool transposed(int n0) const { return n0 < 512; }
  __device__ bool both(int n0) const { return n0 >= 512 && n0 < 1024; }
  template <int NI> __device__ void direct(int m0, int n0, int wm, int wn, int g, int c, f32x4 (&acc)[4][NI], const float* sR) const {
    if (n0 == 3584 && wn == 1) {
#pragma unroll
      for (int mi = 0; mi < 4; ++mi)
#pragma unroll
        for (int j = 0; j < 4; ++j) {
          const int row = wm * 64 + mi * 16 + 4 * g + j;
          MIF[(size_t)(m0 + row) * 16 + c] = acc[mi][2][j] * sR[row];
        }
    }
  }
  __device__ void store_t(int tok8, int col, bf16x8 v) const {
    if (col < 512) *(bf16x8*)(MVt + (size_t)col * T_TOK + tok8) = v;
    else *(bf16x8*)(MKt + (size_t)(col - 512) * T_TOK + tok8) = v;
  }
  __device__ void store_n(int tok, int col, bf16x8 v, const bf16_t* sp) const {
    bf16_t* d;
    if (col < 1024) d = MKb + (size_t)tok * 512 + (col - 512);
    else if (col < 1408) d = CQb + (size_t)tok * 384 + (col - 1024);
    else if (col < 1664) d = CKVb + (size_t)tok * 256 + (col - 1408);
    else if (col < 2176) d = MGb + (size_t)tok * 512 + (col - 1664);
    else if (col < 2688) d = MQb + (size_t)tok * 512 + (col - 2176);
    else if (col < 3200) d = MOb + (size_t)tok * 512 + (col - 2688);
    else if (col < 3712) d = MLGb + (size_t)tok * 512 + (col - 3200);
    else if (col < 3728) {
      bf16x8 x2 = *(const bf16x8*)(sp + 16);
      bf16x8 o1, o2;
      rope_chunk(seq_pos(tok), col - 3712, v, x2, o1, o2);
      *(bf16x8*)(KRb + (size_t)tok * 32 + (col - 3712)) = o1;
      *(bf16x8*)(KRb + (size_t)tok * 32 + 16 + (col - 3712)) = o2;
      return;
    } else return;
    *(bf16x8*)d = v;
  }
};

struct EpiQUp {
  static constexpr bool staged = true;
  bf16_t* Qa;
  __device__ float scale() const { return 0.10206207261596575f * 1.4426950408889634f; }
  __device__ bool transposed(int n0) const { return false; }
  __device__ bool both(int n0) const { return false; }
  template <int NI> __device__ void direct(int m0, int n0, int wm, int wn, int g, int c, f32x4 (&acc)[4][NI], const float* sR) const {}
  __device__ void store_t(int tok8, int col, bf16x8 v) const {}
  __device__ void store_n(int tok, int col, bf16x8 v, const bf16_t* sp) const {
    if (col < 512) {
      *(bf16x8*)(Qa + (size_t)tok * 768 + (col >> 6) * 96 + (col & 63)) = v;
    } else {
      const int r = col - 512, head = r >> 5, rr = r & 31;
      if (rr < 16) {
        bf16x8 x2 = *(const bf16x8*)(sp + 16);
        bf16x8 o1, o2;
        rope_chunk(seq_pos(tok), rr, v, x2, o1, o2);
        *(bf16x8*)(Qa + (size_t)tok * 768 + head * 96 + 64 + rr) = o1;
        *(bf16x8*)(Qa + (size_t)tok * 768 + head * 96 + 80 + rr) = o2;
      }
    }
  }
};

struct EpiKVUp {
  static constexpr bool staged = true;
  bf16_t *KNb, *VtA;
  __device__ float scale() const { return 1.f; }
  __device__ bool transposed(int n0) const { return n0 >= 512; }
  __device__ bool both(int n0) const { return false; }
  template <int NI> __device__ void direct(int m0, int n0, int wm, int wn, int g, int c, f32x4 (&acc)[4][NI], const float* sR) const {}
  __device__ void store_t(int tok8, int col, bf16x8 v) const { *(bf16x8*)(VtA + (size_t)(col - 512) * T_TOK + tok8) = v; }
  __device__ void store_n(int tok, int col, bf16x8 v, const bf16_t* sp) const { *(bf16x8*)(KNb + (size_t)tok * 512 + col) = v; }
};

struct EpiOut {
  static constexpr bool staged = false;
  const float *xa, *xb;
  float* out;
  bool dry;
  bf16_t* hb;
  float* ssq;
};

template <int CTRL> __device__ __forceinline__ float dpp_z(float v) {
  return __int_as_float(__builtin_amdgcn_update_dpp(0, __float_as_int(v), CTRL, 0xf, 0xf, true));
}
__device__ __forceinline__ float scan16(float v, int c, int lane) {
  v += dpp_z<0x111>(v);
  v += dpp_z<0x112>(v);
  v += dpp_z<0x114>(v);
  v += dpp_z<0x118>(v);
  return v;
}

__device__ __forceinline__ float logsig_fast(float x) { return fminf(x, 0.f) - __logf(1.f + __expf(-fabsf(x))); }

__device__ void gla_intra_item(const Params& p, int li, int item, char* smem, bool dry = false) {
  const int tid = otid(), lane = tid & 63, w = tid >> 6, c = lane & 15, g = lane >> 4;
  const int ci = item >> 2, h = item & 3;
  const int tokc = ci * 64;
  const float qscale = 0.08838834764831845f;
  bf16_t* sQe = (bf16_t*)smem;
  bf16_t* sKd = sQe + 64 * 136;
  bf16_t* sA = sKd + 64 * 136;
  us4 q4[2][4];
  bf16_t kk[2][4][4];
#pragma unroll
  for (int dt = 0; dt < 2; ++dt)
#pragma unroll
    for (int tt = 0; tt < 4; ++tt) {
      q4[dt][tt] = *(const us4*)(p.Qb + (size_t)(tokc + 16 * tt + c) * 512 + h * 128 + 32 * w + 16 * dt + 4 * g);
#pragma unroll
      for (int j = 0; j < 4; ++j)
        kk[dt][tt][j] = p.Kt[(size_t)(h * 128 + 32 * w + 16 * dt + 4 * g + j) * T_TOK + tokc + 16 * tt + c];
    }
  __syncthreads();
#pragma unroll
  for (int dir = 0; dir < 2; ++dir) {
    bf16_t* QEd = (dir || dry) ? p.QEb : p.Qb;
    bf16_t* KdTd = (dir || dry) ? p.KdTb : p.Kt;
    bf16x8 aup[2];
    float bias[2][4];
#pragma unroll
    for (int dt = 0; dt < 2; ++dt) {
      aup[dt] = zero8();
      if (g < 2) aup[dt] = *(const bf16x8*)(p.AupT + ((size_t)(li * 2 + dir) * 512 + h * 128 + 32 * w + 16 * dt + c) * 32 + 8 * g);
#pragma unroll
      for (int j = 0; j < 4; ++j) bias[dt][j] = p.e_a_bias[(li * 2 + dir) * 512 + h * 128 + 32 * w + 16 * dt + 4 * g + j];
    }
    f32x4 la[2][4];
#pragma unroll
    for (int tt = 0; tt < 4; ++tt) {
      bf16x8 lrf = zero8();
      if (g < 2) lrf = *(const bf16x8*)(p.LRb + (size_t)(tokc + 16 * tt + c) * 32 + dir * 16 + 8 * g);
#pragma unroll
      for (int dt = 0; dt < 2; ++dt) la[dt][tt] = mfma16(aup[dt], lrf, zero4());
    }
#pragma unroll
    for (int dt = 0; dt < 2; ++dt)
#pragma unroll
      for (int tt = 0; tt < 4; ++tt)
#pragma unroll
        for (int j = 0; j < 4; ++j) la[dt][tt][j] = logsig_fast(la[dt][tt][j] + bias[dt][j]) * (1.f / 16.f);
    f32x4 P[2][4];
    float tot[2][4];
#pragma unroll
    for (int dt = 0; dt < 2; ++dt)
#pragma unroll
      for (int j = 0; j < 4; ++j) {
        float carry = 0.f;
#pragma unroll
        for (int tt = 0; tt < 4; ++tt) {
          float v = scan16(la[dt][tt][j], c, lane) + carry;
          P[dt][tt][j] = v;
          carry = dpp_f<0x15F>(v);
        }
        tot[dt][j] = carry;
      }
#pragma unroll
    for (int dt = 0; dt < 2; ++dt)
#pragma unroll
      for (int tt = 0; tt < 4; ++tt) {
        us4 qo, ko;
#pragma unroll
        for (int j = 0; j < 4; ++j) {
          const float b = (dir == 0) ? P[dt][tt][j] : (tot[dt][j] - P[dt][tt][j] + la[dt][tt][j]);
          qo[j] = f2bf(bf2f(q4[dt][tt][j]) * __expf(b) * qscale);
          ko[j] = f2bf(bf2f(kk[dt][tt][j]) * __expf(-b));
        }
        *(us4*)(QEd + (size_t)(tokc + 16 * tt + c) * 512 + h * 128 + 32 * w + 16 * dt + 4 * g) = qo;
        *(us4*)(sQe + (16 * tt + c) * 136 + 32 * w + 16 * dt + 4 * g) = qo;
        *(us4*)(sKd + (16 * tt + c) * 136 + 32 * w + 16 * dt + 4 * g) = ko;
      }
    if (c == 0) {
#pragma unroll
      for (int dt = 0; dt < 2; ++dt)
#pragma unroll
        for (int j = 0; j < 4; ++j)
          p.EB[(size_t)(dir * 1280 + ci) * 512 + h * 128 + 32 * w + 16 * dt + 4 * g + j] = __expf(tot[dt][j]);
    }
    __syncthreads();
#pragma unroll
    for (int i = 0; i < 4; ++i) {
      const int id = tid + 256 * i;
      const int d = id & 127, c8 = id >> 7;
      bf16x8 v;
#pragma unroll
      for (int e = 0; e < 8; ++e) v[e] = (short)sKd[(8 * c8 + e) * 136 + d];
      *(bf16x8*)(KdTd + (size_t)(h * 128 + d) * T_TOK + tokc + 8 * c8) = v;
    }
    f32x4 accA[4];
#pragma unroll
    for (int jt = 0; jt < 4; ++jt) accA[jt] = zero4();
#pragma unroll
    for (int ks = 0; ks < 4; ++ks) {
      bf16x8 aq = *(const bf16x8*)(sQe + (16 * w + c) * 136 + 32 * ks + 8 * g);
#pragma unroll
      for (int jt = 0; jt < 4; ++jt) {
        bf16x8 bk = *(const bf16x8*)(sKd + (16 * jt + c) * 136 + 32 * ks + 8 * g);
        accA[jt] = mfma16(aq, bk, accA[jt]);
      }
    }
#pragma unroll
    for (int jt = 0; jt < 4; ++jt)
#pragma unroll
      for (int j = 0; j < 4; ++j) {
        const int i = 16 * w + 4 * g + j, jj = 16 * jt + c;
        const bool keep = (dir == 0) ? (jj <= i) : (jj > i);
        sA[dir * 64 * 72 + i * 72 + jj] = f2bf(keep ? accA[jt][j] : 0.f);
      }
    __syncthreads();
  }
  bf16x8 af[2][2];
#pragma unroll
  for (int dir = 0; dir < 2; ++dir)
#pragma unroll
    for (int k2 = 0; k2 < 2; ++k2) af[dir][k2] = *(const bf16x8*)(sA + dir * 64 * 72 + (16 * w + c) * 72 + 32 * k2 + 8 * g);
  bf16_t* sO = (bf16_t*)smem;
#pragma unroll 4
  for (int vt = 0; vt < 16; ++vt) {
    f32x4 a = zero4();
#pragma unroll
    for (int k2 = 0; k2 < 2; ++k2) {
      bf16x8 vfr = *(const bf16x8*)(p.VtE + (size_t)(h * 256 + 16 * vt + c) * T_TOK + tokc + 32 * k2 + 8 * g);
      a = mfma16(af[0][k2], vfr, a);
      a = mfma16(af[1][k2], vfr, a);
    }
#pragma unroll
    for (int j = 0; j < 4; ++j) sO[(16 * w + 4 * g + j) * 264 + 16 * vt + c] = f2bf(a[j]);
  }
  __syncthreads();
#pragma unroll
  for (int i = 0; i < 8; ++i) {
    const int id = tid + 256 * i;
    const int row = id >> 5, c8 = id & 31;
    *(bf16x8*)(p.TMP + (size_t)(tokc + row) * 1024 + h * 256 + 8 * c8) = *(const bf16x8*)(sO + row * 264 + 8 * c8);
  }
}

__device__ __forceinline__ void lds_barrier() { asm volatile("s_waitcnt lgkmcnt(0)\n\ts_barrier" ::: "memory"); }

struct GlaRegs {
  bf16x8 aq[4];
  bf16x8 vf[2][2];
  bf16x8 kf[2][2];
  float eb[2];
  unsigned told[2][4];
};

template <int DIR>
__device__ __forceinline__ void gla_chain_load(const Params& p, int h, int sl, int tokc, int w, int c, int g, GlaRegs& r) {
  const bf16_t* QE = DIR ? p.QEb : p.Qb;
  const bf16_t* KdT = DIR ? p.KdTb : p.Kt;
#pragma unroll
  for (int ks = 0; ks < 4; ++ks) r.aq[ks] = *(const bf16x8*)(QE + (size_t)(tokc + 16 * w + c) * 512 + h * 128 + 32 * ks + 8 * g);
#pragma unroll
  for (int vt = 0; vt < 2; ++vt)
#pragma unroll
    for (int k2 = 0; k2 < 2; ++k2)
      r.vf[vt][k2] = *(const bf16x8*)(p.VtE + (size_t)(h * 256 + sl * 32 + 16 * vt + c) * T_TOK + tokc + 32 * k2 + 8 * g);
#pragma unroll
  for (int dt = 0; dt < 2; ++dt) {
#pragma unroll
    for (int k2 = 0; k2 < 2; ++k2)
      r.kf[dt][k2] = *(const bf16x8*)(KdT + (size_t)(h * 128 + 32 * w + 16 * dt + c) * T_TOK + tokc + 32 * k2 + 8 * g);
    r.eb[dt] = p.EB[(size_t)(DIR * 1280 + (tokc >> 6)) * 512 + h * 128 + 32 * w + 16 * dt + c];
  }
#pragma unroll
  for (int vt = 0; vt < 2; ++vt)
#pragma unroll
    for (int j = 0; j < 4; ++j) r.told[vt][j] = p.TMP[(size_t)(tokc + 16 * w + 4 * g + j) * 1024 + h * 256 + sl * 32 + 16 * vt + c];
}

__device__ __forceinline__ void gla_chain_compute(const Params& p, int h, int sl, int tokc, int w, int c, int g, const GlaRegs& r,
                                                  f32x4 (&S)[2][2], bf16_t* sSt, bool dry, bool reload) {
  unsigned told[2][4];
#pragma unroll
  for (int vt = 0; vt < 2; ++vt)
#pragma unroll
    for (int j = 0; j < 4; ++j) told[vt][j] = r.told[vt][j];
  if (reload) {
#pragma unroll
    for (int vt = 0; vt < 2; ++vt)
#pragma unroll
      for (int j = 0; j < 4; ++j) told[vt][j] = p.TMP[(size_t)(tokc + 16 * w + 4 * g + j) * 1024 + h * 256 + sl * 32 + 16 * vt + c];
  }
#pragma unroll
  for (int vt = 0; vt < 2; ++vt)
#pragma unroll
    for (int dt = 0; dt < 2; ++dt)
#pragma unroll
      for (int j = 0; j < 4; ++j) sSt[(16 * vt + 4 * g + j) * 136 + 32 * w + 16 * dt + c] = f2bf(S[vt][dt][j]);
  lds_barrier();
  f32x4 o[2];
  o[0] = zero4(); o[1] = zero4();
#pragma unroll
  for (int ks = 0; ks < 4; ++ks)
#pragma unroll
    for (int vt = 0; vt < 2; ++vt) {
      bf16x8 sf = *(const bf16x8*)(sSt + (16 * vt + c) * 136 + 32 * ks + 8 * g);
      o[vt] = mfma16(r.aq[ks], sf, o[vt]);
    }
#pragma unroll
  for (int dt = 0; dt < 2; ++dt)
#pragma unroll
    for (int vt = 0; vt < 2; ++vt) {
      f32x4 a = S[vt][dt];
#pragma unroll
      for (int k2 = 0; k2 < 2; ++k2) a = mfma16(r.vf[vt][k2], r.kf[dt][k2], a);
      S[vt][dt] = a * r.eb[dt];
    }
#pragma unroll
  for (int vt = 0; vt < 2; ++vt)
#pragma unroll
    for (int j = 0; j < 4; ++j)
      if (!dry) p.TMP[(size_t)(tokc + 16 * w + 4 * g + j) * 1024 + h * 256 + sl * 32 + 16 * vt + c] = f2bf(bf2f((bf16_t)told[vt][j]) + o[vt][j]);
}

__device__ void gla_chain_item(const Params& p, int li, int item, char* smem, bool dry = false) {
  const int tid = otid(), lane = tid & 63, w = tid >> 6, c = lane & 15, g = lane >> 4;
  const int xr = item >> 3;
  const int pair = (item & 7) + 8 * (xr >> 3), sl = xr & 7;
  const int s = pair < 32 ? 4 + (pair >> 2) : ((pair - 32) >> 2);
  const int h = pair & 3;
  const int tok0 = s < 4 ? s * 4096 : T_P + (s - 4) * 8192;
  const int len = s < 4 ? 4096 : 8192;
  const int N = len / 64;
  bf16_t* sSt0 = (bf16_t*)smem;
  bf16_t* sSt1 = sSt0 + 32 * 136;
  f32x4 Sf[2][2], Sb[2][2];
#pragma unroll
  for (int a = 0; a < 2; ++a)
#pragma unroll
    for (int b = 0; b < 2; ++b) { Sf[a][b] = zero4(); Sb[a][b] = zero4(); }
  GlaRegs rf, rb;
  __syncthreads();
  gla_chain_load<0>(p, h, sl, tok0, w, c, g, rf);
  for (int step = 0; step < N; ++step) {
    const int tf = tok0 + step * 64, tb = tok0 + (N - 1 - step) * 64;
    gla_chain_load<1>(p, h, sl, tb, w, c, g, rb);
    gla_chain_compute(p, h, sl, tf, w, c, g, rf, Sf, sSt0, dry, step == (N >> 1));
    if (step + 1 < N) gla_chain_load<0>(p, h, sl, tf + 64, w, c, g, rf);
    gla_chain_compute(p, h, sl, tb, w, c, g, rb, Sb, sSt1, dry, false);
  }
}

__device__ void pool_item(const Params& p, int li, int item, char* smem, bool dry = false) {
  const int tid = otid(), lane = tid & 63, w = tid >> 6, c = lane & 15, g = lane >> 4;
  const int gi = item & 3;
  const int tile = item >> 2;
  const int tokc = tile * 64;
  const int pos0 = seq_pos(tokc);
  const int len = tokc < T_P ? 4096 : 8192;
  float* sU = (float*)smem;
  bf16_t* sP = (bf16_t*)(sU + 80 * 128);
  __syncthreads();
  for (int idx = tid; idx < 80 * 128; idx += 256) {
    int r = idx >> 7, ch = idx & 127;
    int pos = pos0 - 8 + r;
    float v = 0.f;
    if (pos >= 0 && pos < len) v = bf2f(p.PUb[(long)(tokc - 8 + r) * 512 + gi * 128 + ch]);
    sU[idx] = v;
  }
  __syncthreads();
  {
    const int ch = tid & 127, th = tid >> 7;
    const int half = 1 << gi;
    for (int t = th * 32; t < th * 32 + 32; ++t) {
      int pos = pos0 + t;
      int lo = max(pos - half, 0), hi = min(pos + half, len);
      float s = 0.f;
      for (int q = lo; q < hi; ++q) s += sU[(q - pos0 + 8) * 128 + ch];
      float pooled = s / (float)(hi - lo) - sU[(t + 8) * 128 + ch];
      sP[t * 136 + ch] = f2bf(pooled);
    }
  }
  __syncthreads();
  f32x4 acc[8];
#pragma unroll
  for (int dt = 0; dt < 8; ++dt) acc[dt] = zero4();
  const bf16_t* PW = p.PoolWT + (long)(li * 4 + gi) * 128 * 128;
#pragma unroll
  for (int ks = 0; ks < 4; ++ks) {
    bf16x8 af = *(const bf16x8*)(sP + (16 * w + c) * 136 + 32 * ks + 8 * g);
#pragma unroll
    for (int dt = 0; dt < 8; ++dt) {
      bf16x8 bw = *(const bf16x8*)(PW + (long)(16 * dt + c) * 128 + 32 * ks + 8 * g);
      acc[dt] = mfma16(af, bw, acc[dt]);
    }
  }
#pragma unroll
  for (int dt = 0; dt < 8; ++dt) {
    const int d = gi * 128 + 16 * dt + c;
    const float sc = p.e_pool_scale[li * 512 + d];
#pragma unroll
    for (int j = 0; j < 4; ++j) {
      const long addr = (long)(tokc + 16 * w + 4 * g + j) * 512 + d;
      float gt = bf2f(p.PGb[addr]);
      if (!dry) p.PGb[addr] = f2bf(acc[dt][j] * sc * siluf_(gt));
    }
  }
}

__device__ void ml_intra_item(const Params& p, int li, int item, char* smem) {
  const int tid = otid(), lane = tid & 63, w = tid >> 6, c = lane & 15, g = lane >> 4;
  const int ci = item >> 2, h = item & 3;
  const int tokc = ci * 64;
  const float kscale = 0.08838834764831845f;
  bf16_t* sA = (bf16_t*)smem;
  float* sBv = (float*)(sA + 2 * 64 * 72);
  float* sCB = sBv + 128;
  __syncthreads();
  if (w < 2) {
    const int dir = w;
    const float bi = p.o_if_bias[li * 16 + dir * 4 + h];
    const float bff = p.o_if_bias[li * 16 + 8 + dir * 4 + h];
    const float* mf = p.MIF + (size_t)(tokc + lane) * 16;
    const float liv = mf[dir * 4 + h] + bi;
    const float lfv = logsig_fast(mf[8 + dir * 4 + h] + bff);
    float ps = lfv;
#pragma unroll
    for (int d = 1; d < 64; d <<= 1) {
      float t = bperm(lane - d, ps);
      if (lane >= d) ps += t;
    }
    const float total = __int_as_float(__builtin_amdgcn_readlane(__float_as_int(ps), 63));
    const float b = (dir == 0) ? ps : (total - ps + lfv);
    const float cB = liv - b;
    sBv[dir * 64 + lane] = b;
    sCB[dir * 64 + lane] = cB;
    const size_t so = (size_t)(dir * 4 + h) * T_TOK + tokc + lane;
    p.EBI[so] = __expf(b);
    p.WKg[so] = __expf(total + cB) * kscale;
    if (lane == 0) p.DEC[(dir * 4 + h) * 1280 + ci] = __expf(total);
  }
  f32x4 accA[4];
#pragma unroll
  for (int jt = 0; jt < 4; ++jt) accA[jt] = zero4();
#pragma unroll
  for (int ks = 0; ks < 4; ++ks) {
    bf16x8 aq = *(const bf16x8*)(p.MQb + (size_t)(tokc + 16 * w + c) * 512 + h * 128 + 32 * ks + 8 * g);
#pragma unroll
    for (int jt = 0; jt < 4; ++jt) {
      bf16x8 bk = *(const bf16x8*)(p.MKb + (size_t)(tokc + 16 * jt + c) * 512 + h * 128 + 32 * ks + 8 * g);
      accA[jt] = mfma16(aq, bk, accA[jt]);
    }
  }
  __syncthreads();
#pragma unroll
  for (int dir = 0; dir < 2; ++dir)
#pragma unroll
    for (int jt = 0; jt < 4; ++jt)
#pragma unroll
      for (int j = 0; j < 4; ++j) {
        const int i = 16 * w + 4 * g + j, jj = 16 * jt + c;
        const bool keep = (dir == 0) ? (jj <= i) : (jj > i);
        const float sv = keep ? accA[jt][j] * kscale * __expf(sBv[dir * 64 + i] + sCB[dir * 64 + jj]) : 0.f;
        sA[dir * 64 * 72 + i * 72 + jj] = f2bf(sv);
      }
  __syncthreads();
  bf16x8 ones = zero8();
  if (c == 0) {
#pragma unroll
    for (int e = 0; e < 8; ++e) ones[e] = (short)0x3F80;
  }
#pragma unroll
  for (int dir = 0; dir < 2; ++dir) {
    bf16_t* NUMI = dir ? p.NUMIb : p.NUMIf;
    bf16x8 af[2];
#pragma unroll
    for (int k2 = 0; k2 < 2; ++k2) af[k2] = *(const bf16x8*)(sA + dir * 64 * 72 + (16 * w + c) * 72 + 32 * k2 + 8 * g);
    f32x4 dn = zero4();
    dn = mfma16(af[0], ones, dn);
    dn = mfma16(af[1], ones, dn);
    if (c == 0) {
#pragma unroll
      for (int j = 0; j < 4; ++j) p.DENI[(size_t)(dir * 4 + h) * T_TOK + tokc + 16 * w + 4 * g + j] = dn[j];
    }
    bf16_t* sO = sA + 2 * 64 * 72 + 512;
#pragma unroll 4
    for (int vt = 0; vt < 8; ++vt) {
      f32x4 a = zero4();
#pragma unroll
      for (int k2 = 0; k2 < 2; ++k2) {
        bf16x8 vfr = *(const bf16x8*)(p.MVt + (size_t)(h * 128 + 16 * vt + c) * T_TOK + tokc + 32 * k2 + 8 * g);
        a = mfma16(af[k2], vfr, a);
      }
#pragma unroll
      for (int j = 0; j < 4; ++j) sO[(16 * w + 4 * g + j) * 136 + 16 * vt + c] = f2bf(a[j]);
    }
    __syncthreads();
#pragma unroll
    for (int i = 0; i < 4; ++i) {
      const int id = tid + 256 * i;
      const int row = id >> 4, c8 = id & 15;
      *(bf16x8*)(NUMI + (size_t)(tokc + row) * 512 + h * 128 + 8 * c8) = *(const bf16x8*)(sO + row * 136 + 8 * c8);
    }
    __syncthreads();
  }
}

struct MlRegs {
  bf16x8 aq[4];
  bf16x8 vf[2];
  bf16x8 kf[2][2];
  f32x4 wk[2][2];
  f32x4 ebi, deni;
  float dec;
  unsigned numi[4];
};

template <int DIR>
__device__ __forceinline__ void ml_chain_load(const Params& p, int h, int sl, int tokc, int w, int c, int g, MlRegs& r) {
#pragma unroll
  for (int ks = 0; ks < 4; ++ks) r.aq[ks] = *(const bf16x8*)(p.MQb + (size_t)(tokc + 16 * w + c) * 512 + h * 128 + 32 * ks + 8 * g);
#pragma unroll
  for (int k2 = 0; k2 < 2; ++k2)
    r.vf[k2] = *(const bf16x8*)(p.MVt + (size_t)(h * 128 + sl * 16 + c) * T_TOK + tokc + 32 * k2 + 8 * g);
#pragma unroll
  for (int dt = 0; dt < 2; ++dt)
#pragma unroll
    for (int k2 = 0; k2 < 2; ++k2)
      r.kf[dt][k2] = *(const bf16x8*)(p.MKt + (size_t)(h * 128 + 32 * w + 16 * dt + c) * T_TOK + tokc + 32 * k2 + 8 * g);
  const size_t so = (size_t)(DIR * 4 + h) * T_TOK + tokc;
#pragma unroll
  for (int k2 = 0; k2 < 2; ++k2) {
    r.wk[k2][0] = *(const f32x4*)(p.WKg + so + 32 * k2 + 8 * g);
    r.wk[k2][1] = *(const f32x4*)(p.WKg + so + 32 * k2 + 8 * g + 4);
  }
  r.ebi = *(const f32x4*)(p.EBI + so + 16 * w + 4 * g);
  r.deni = *(const f32x4*)(p.DENI + so + 16 * w + 4 * g);
  r.dec = p.DEC[(DIR * 4 + h) * 1280 + (tokc >> 6)];
  const bf16_t* NUMI = DIR ? p.NUMIb : p.NUMIf;
#pragma unroll
  for (int j = 0; j < 4; ++j) r.numi[j] = NUMI[(size_t)(tokc + 16 * w + 4 * g + j) * 512 + h * 128 + sl * 16 + c];
}

template <int DIR>
__device__ __forceinline__ void ml_chain_compute(const Params& p, int h, int sl, int tokc, int lane, int w, int c, int g, const MlRegs& r,
                                                 f32x4 (&C)[2][2], bf16_t* sCt, bool dry) {
  bf16_t* NUMI = DIR ? p.NUMIb : p.NUMIf;
  unsigned numi[4];
#pragma unroll
  for (int j = 0; j < 4; ++j) numi[j] = r.numi[j];
#pragma unroll
  for (int vt = 0; vt < 2; ++vt)
#pragma unroll
    for (int dt = 0; dt < 2; ++dt)
#pragma unroll
      for (int j = 0; j < 4; ++j) sCt[(16 * vt + 4 * g + j) * 136 + 32 * w + 16 * dt + c] = f2bf(C[vt][dt][j]);
  bf16x8 vfw[2][2];
#pragma unroll
  for (int k2 = 0; k2 < 2; ++k2) {
    float wv[8];
#pragma unroll
    for (int e = 0; e < 4; ++e) { wv[e] = r.wk[k2][0][e]; wv[4 + e] = r.wk[k2][1][e]; }
#pragma unroll
    for (int e = 0; e < 8; ++e) vfw[0][k2][e] = (short)f2bf(bf2f((bf16_t)r.vf[k2][e]) * wv[e]);
#pragma unroll
    for (int e = 0; e < 8; ++e) vfw[1][k2][e] = (c == 0) ? (short)f2bf(wv[e]) : (short)0;
  }
  lds_barrier();
  f32x4 o2[2];
  o2[0] = zero4(); o2[1] = zero4();
#pragma unroll
  for (int ks = 0; ks < 4; ++ks)
#pragma unroll
    for (int vt = 0; vt < 2; ++vt) {
      bf16x8 cf = *(const bf16x8*)(sCt + (16 * vt + c) * 136 + 32 * ks + 8 * g);
      o2[vt] = mfma16(r.aq[ks], cf, o2[vt]);
    }
#pragma unroll
  for (int dt = 0; dt < 2; ++dt)
#pragma unroll
    for (int vt = 0; vt < 2; ++vt) {
      f32x4 a = C[vt][dt] * r.dec;
#pragma unroll
      for (int k2 = 0; k2 < 2; ++k2) a = mfma16(vfw[vt][k2], r.kf[dt][k2], a);
      C[vt][dt] = a;
    }
#pragma unroll
  for (int j = 0; j < 4; ++j) {
    const float e = r.ebi[j];
    float den = e * o2[1][j];
    den = dpp_f<0x150>(den) + r.deni[j];
    const float inv = 1.f / fmaxf(fabsf(den), 1.f);
    const float hv = (bf2f((bf16_t)numi[j]) + e * o2[0][j]) * inv;
    if (!dry) NUMI[(size_t)(tokc + 16 * w + 4 * g + j) * 512 + h * 128 + sl * 16 + c] = f2bf(hv);
  }
}

template <int DIR>
__device__ __forceinline__ void ml_chain_run(const Params& p, int h, int sl, int tok0, int N, int lane, int w, int c, int g, bf16_t* sCt0, bool dry) {
  bf16_t* sCt1 = sCt0 + 32 * 136;
  f32x4 C[2][2];
#pragma unroll
  for (int a = 0; a < 2; ++a)
#pragma unroll
    for (int b = 0; b < 2; ++b) C[a][b] = zero4();
  MlRegs r0, r1;
  ml_chain_load<DIR>(p, h, sl, tok0 + (DIR ? N - 1 : 0) * 64, w, c, g, r0);
  for (int n = 0; n < N; n += 2) {
    const int c0 = DIR ? N - 1 - n : n;
    const int c1 = DIR ? N - 2 - n : n + 1;
    const int n2 = min(n + 2, N - 1);
    const int c2 = DIR ? N - 1 - n2 : n2;
    ml_chain_load<DIR>(p, h, sl, tok0 + c1 * 64, w, c, g, r1);
    ml_chain_compute<DIR>(p, h, sl, tok0 + c0 * 64, lane, w, c, g, r0, C, sCt0, dry);
    ml_chain_load<DIR>(p, h, sl, tok0 + c2 * 64, w, c, g, r0);
    ml_chain_compute<DIR>(p, h, sl, tok0 + c1 * 64, lane, w, c, g, r1, C, sCt1, dry);
  }
}

__device__ void ml_chain_item(const Params& p, int li, int item, char* smem, bool dry = false) {
  const int tid = otid(), lane = tid & 63, w = tid >> 6, c = lane & 15, g = lane >> 4;
  int pair, within;
  if (item < 512) { const int r = item >> 3; pair = (item & 7) + 8 * (r >> 4); within = r & 15; }
  else { const int it = item - 512; const int r = it >> 3; pair = 32 + (it & 7) + 8 * (r >> 4); within = r & 15; }
  const int sl = within & 7, dir = within >> 3;
  const int s = pair < 32 ? 4 + (pair >> 2) : ((pair - 32) >> 2);
  const int h = pair & 3;
  const int tok0 = s < 4 ? s * 4096 : T_P + (s - 4) * 8192;
  const int N = (s < 4 ? 4096 : 8192) / 64;
  bf16_t* sCt0 = (bf16_t*)smem;
  __syncthreads();
  if (dir == 0) ml_chain_run<0>(p, h, sl, tok0, N, lane, w, c, g, sCt0, dry);
  else ml_chain_run<1>(p, h, sl, tok0, N, lane, w, c, g, sCt0, dry);
}

#define ATTN_GLOAD(KT)                                                                              \
  {                                                                                                 \
    const long kb = tok0 + (KT) * 64;                                                               \
    rk0 = *(const bf16x8*)(p.KNb + (kb + (tid >> 3)) * 512 + head * 64 + 8 * (tid & 7));            \
    rk1 = *(const bf16x8*)(p.KNb + (kb + 32 + (tid >> 3)) * 512 + head * 64 + 8 * (tid & 7));       \
    rkr = *(const bf16x8*)(p.KRb + (kb + (tid >> 2)) * 32 + 8 * (tid & 3));                          \
    rv0 = *(const bf16x8*)(p.VtA + (long)(head * 64 + (tid >> 3)) * T_TOK + kb + 8 * (tid & 7));     \
    rv1 = *(const bf16x8*)(p.VtA + (long)(head * 64 + 32 + (tid >> 3)) * T_TOK + kb + 8 * (tid & 7)); \
  }
__device__ void attn_item(const Params& p, int item, char* smem, bool dry = false) {
  const int tid = otid(), lane = tid & 63, w = tid >> 6, c = lane & 15, g = lane >> 4;
  int s, head, qb;
  {
    const int x = item / 320, t = item % 320;
    if (t < 256) { const int pair = x + 8 * (t >> 5); qb = t & 31; s = 4 + (pair >> 3); head = pair & 7; }
    else { const int t2 = t - 256; const int pair = x + 8 * (t2 >> 4); qb = t2 & 15; s = pair >> 3; head = pair & 7; }
  }
  const int tok0 = s < 4 ? s * 4096 : T_P + (s - 4) * 8192;
  const int len = s < 4 ? 4096 : 8192;
  const int nkv = len / 64;
  bf16_t* sK = (bf16_t*)smem;
  bf16_t* sVt = sK + 64 * 104;
  const int qrow0 = tok0 + qb * 256 + 64 * w;
  bf16_t* sQr = sVt + 64 * 72;
  bf16x8 qf[4][2];
#pragma unroll
  for (int nt = 0; nt < 4; ++nt) {
#pragma unroll
    for (int ks = 0; ks < 2; ++ks)
      qf[nt][ks] = *(const bf16x8*)(p.Qa + (long)(qrow0 + 16 * nt + c) * 768 + head * 96 + 32 * ks + 8 * g);
    bf16x8 qr = *(const bf16x8*)(p.Qa + (long)(qrow0 + 16 * nt + c) * 768 + head * 96 + 64 + 8 * g);
    *(bf16x8*)(sQr + ((w * 4 + nt) * 64 + lane) * 8) = qr;
  }
  f32x4 ot[4][4];
#pragma unroll
  for (int vt = 0; vt < 4; ++vt)
#pragma unroll
    for (int nt = 0; nt < 4; ++nt) ot[vt][nt] = zero4();
  float mrun[4] = {-64.f, -64.f, -64.f, -64.f}, lrun[4] = {0.f, 0.f, 0.f, 0.f};
  bf16x8 rk0, rk1, rkr, rv0, rv1;
  ATTN_GLOAD(0)
  for (int kt = 0; kt < nkv; ++kt) {
    __syncthreads();
    *(bf16x8*)(sK + (tid >> 3) * 104 + 8 * (tid & 7)) = rk0;
    *(bf16x8*)(sK + (32 + (tid >> 3)) * 104 + 8 * (tid & 7)) = rk1;
    *(bf16x8*)(sK + (tid >> 2) * 104 + 64 + 8 * (tid & 3)) = rkr;
    *(bf16x8*)(sVt + (tid >> 3) * 72 + 8 * (tid & 7)) = rv0;
    *(bf16x8*)(sVt + (32 + (tid >> 3)) * 72 + 8 * (tid & 7)) = rv1;
    __syncthreads();
    if (kt + 1 < nkv) ATTN_GLOAD(kt + 1)
#pragma unroll 1
    for (int half = 0; half < 2; ++half) {
      f32x4 st[2][4];
#pragma unroll
      for (int k4 = 0; k4 < 2; ++k4)
#pragma unroll
        for (int nt = 0; nt < 4; ++nt) {
          const float nm = -mrun[nt];
          f32x4 iv = {nm, nm, nm, nm};
          st[k4][nt] = iv;
        }
#pragma unroll
      for (int ks = 0; ks < 2; ++ks)
#pragma unroll
        for (int k4 = 0; k4 < 2; ++k4) {
          bf16x8 kf = *(const bf16x8*)(sK + (32 * half + 16 * k4 + c) * 104 + 32 * ks + 8 * g);
#pragma unroll
          for (int nt = 0; nt < 4; ++nt) st[k4][nt] = mfma16(kf, qf[nt][ks], st[k4][nt]);
        }
      {
        bf16x8 kr0 = *(const bf16x8*)(sK + (32 * half + c) * 104 + 64 + 8 * g);
        bf16x8 kr1 = *(const bf16x8*)(sK + (32 * half + 16 + c) * 104 + 64 + 8 * g);
#pragma unroll
        for (int nt = 0; nt < 4; ++nt) {
          bf16x8 qr = *(const bf16x8*)(sQr + ((w * 4 + nt) * 64 + lane) * 8);
          st[0][nt] = mfma16(kr0, qr, st[0][nt]);
          st[1][nt] = mfma16(kr1, qr, st[1][nt]);
        }
      }
      __builtin_amdgcn_sched_barrier(0);
      bf16x8 pb[4];
#pragma unroll
      for (int nt = 0; nt < 4; ++nt) {
        float mx = -1e30f;
#pragma unroll
        for (int k4 = 0; k4 < 2; ++k4)
#pragma unroll
          for (int j = 0; j < 4; ++j) mx = fmaxf(mx, st[k4][nt][j]);
        mx = rowmax4(mx);
        if (__builtin_amdgcn_ballot_w64(mx > 0.f) != 0ull) {
          const float d = fmaxf(mx, 0.f);
          const float alpha = __builtin_amdgcn_exp2f(-d);
          mrun[nt] += d;
          lrun[nt] *= alpha;
#pragma unroll
          for (int vt = 0; vt < 4; ++vt) ot[vt][nt] = ot[vt][nt] * alpha;
#pragma unroll
          for (int k4 = 0; k4 < 2; ++k4)
#pragma unroll
            for (int j = 0; j < 4; ++j) st[k4][nt][j] -= d;
        }
        float psum = 0.f;
#pragma unroll
        for (int k4 = 0; k4 < 2; ++k4)
#pragma unroll
          for (int j = 0; j < 4; ++j) {
            float pv = __builtin_amdgcn_exp2f(st[k4][nt][j]);
            st[k4][nt][j] = pv;
            psum += pv;
          }
        lrun[nt] += psum;
        typedef __attribute__((ext_vector_type(4))) unsigned u32x4;
        u32x4 pk;
        pk[0] = pk2bf(st[0][nt][0], st[0][nt][1]);
        pk[1] = pk2bf(st[0][nt][2], st[0][nt][3]);
        pk[2] = pk2bf(st[1][nt][0], st[1][nt][1]);
        pk[3] = pk2bf(st[1][nt][2], st[1][nt][3]);
        pb[nt] = __builtin_bit_cast(bf16x8, pk);
      }
      __builtin_amdgcn_sched_barrier(0);
#pragma unroll
      for (int vt = 0; vt < 4; ++vt) {
        us4 lo = *(const us4*)(sVt + (16 * vt + c) * 72 + 32 * half + 4 * g);
        us4 hi = *(const us4*)(sVt + (16 * vt + c) * 72 + 32 * half + 16 + 4 * g);
        bf16x8 av;
#pragma unroll
        for (int e = 0; e < 4; ++e) { av[e] = (short)lo[e]; av[4 + e] = (short)hi[e]; }
#pragma unroll
        for (int nt = 0; nt < 4; ++nt) ot[vt][nt] = mfma16(av, pb[nt], ot[vt][nt]);
      }
    }
  }
#pragma unroll
  for (int nt = 0; nt < 4; ++nt) {
    float lt = lrun[nt];
    lt += sxor(lt, 16, lane);
    lt += sxor(lt, 32, lane);
    const float inv = 1.f / lt;
    const long tok = qrow0 + 16 * nt + c;
#pragma unroll
    for (int vt = 0; vt < 4; ++vt) {
      bf16_t* gp = p.MGb + tok * 512 + head * 64 + 16 * vt + 4 * g;
      us4 gt = *(const us4*)gp;
      us4 o;
#pragma unroll
      for (int j = 0; j < 4; ++j) o[j] = f2bf(ot[vt][nt][j] * inv * siluf_(bf2f(gt[j])));
      if (!dry) *(us4*)gp = o;
    }
  }
}

__device__ void phase_gla_combine(const Params& p, int li, bool dry = false) {
  const int tid_ = otid(); const int lane = tid_ & 63, w = tid_ >> 6;
  for (int tok = blockIdx.x * 4 + w; tok < T_TOK; tok += gridDim.x * 4) {
    const bf16_t* tp = p.TMP + (long)tok * 1024 + 16 * lane;
    bf16_t* gp = p.Gb + (long)tok * 1024 + 16 * lane;
    bf16x8 o0 = *(const bf16x8*)tp, o1 = *(const bf16x8*)(tp + 8);
    bf16x8 g0 = *(const bf16x8*)gp, g1 = *(const bf16x8*)(gp + 8);
    float ov[16], gv[16];
#pragma unroll
    for (int e = 0; e < 8; ++e) {
      ov[e] = bf2f((bf16_t)o0[e]); ov[8 + e] = bf2f((bf16_t)o1[e]);
      gv[e] = bf2f((bf16_t)g0[e]); gv[8 + e] = bf2f((bf16_t)g1[e]);
    }
    float ss = 0.f;
#pragma unroll
    for (int e = 0; e < 16; ++e) ss += ov[e] * ov[e];
    ss += sxor(ss, 1, lane); ss += sxor(ss, 2, lane); ss += sxor(ss, 4, lane); ss += sxor(ss, 8, lane);
    const float rs = rsqrtf(ss * (1.f / 256.f) + EPS);
    const float* ng = p.e_gla_norm_g + li * 256 + ((16 * lane) & 255);
    bf16x8 r0, r1;
#pragma unroll
    for (int e = 0; e < 8; ++e) {
      r0[e] = (short)f2bf(ov[e] * rs * ng[e] * siluf_(gv[e]));
      r1[e] = (short)f2bf(ov[8 + e] * rs * ng[8 + e] * siluf_(gv[8 + e]));
    }
    if (!dry) { *(bf16x8*)gp = r0;
    *(bf16x8*)(gp + 8) = r1; }
  }
}

__device__ void phase_ml_combine(const Params& p, int li, bool dry = false) {
  const int tid_ = otid(); const int lane = tid_ & 63, w = tid_ >> 6;
  for (int tok = blockIdx.x * 4 + w; tok < T_TOK; tok += gridDim.x * 4) {
    const long off = (long)tok * 512 + 8 * lane;
    bf16x8 hv = *(const bf16x8*)(p.NUMIf + off);
    bf16x8 hb = *(const bf16x8*)(p.NUMIb + off);
    bf16x8 mo = *(const bf16x8*)(p.MOb + off);
    bf16x8 mg = *(const bf16x8*)(p.MLGb + off);
    float hf[8];
    float ss = 0.f;
#pragma unroll
    for (int e = 0; e < 8; ++e) { hf[e] = bf2f((bf16_t)hv[e]) + bf2f((bf16_t)hb[e]); ss += hf[e] * hf[e]; }
    ss += sxor(ss, 1, lane); ss += sxor(ss, 2, lane); ss += sxor(ss, 4, lane); ss += sxor(ss, 8, lane);
    const float rs = rsqrtf(ss * (1.f / 128.f) + EPS);
    const float* ng = p.o_ml_norm_g + li * 128 + ((8 * lane) & 127);
    bf16x8 r;
#pragma unroll
    for (int e = 0; e < 8; ++e)
      r[e] = (short)f2bf(hf[e] * rs * ng[e] * sigmoidf_(bf2f((bf16_t)mo[e])) * siluf_(bf2f((bf16_t)mg[e])));
    if (!dry) *(bf16x8*)(p.MLGb + off) = r;
  }
}

__device__ void phase_final(const Params& p, bool dry = false) {
  const int tid_ = otid(); const int lane = tid_ & 63, w = tid_ >> 6;
  for (int tok = blockIdx.x * 4 + w; tok < T_TOK; tok += gridDim.x * 4) {
    float* xp = p.out + (long)tok * DM;
    float4 v[4];
    float ss = 0.f;
#pragma unroll
    for (int i = 0; i < 4; ++i) {
      v[i] = *(const float4*)(xp + 4 * lane + 256 * i);
      ss += v[i].x * v[i].x + v[i].y * v[i].y + v[i].z * v[i].z + v[i].w * v[i].w;
    }
    ss = wave_sum(ss);
    const float rs = rsqrtf(ss * (1.f / 1024.f) + EPS);
#pragma unroll
    for (int i = 0; i < 4; ++i) {
      float4 gq = *(const float4*)(p.final_norm_g + 4 * lane + 256 * i);
      float4 o;
      o.x = v[i].x * rs * gq.x; o.y = v[i].y * rs * gq.y; o.z = v[i].z * rs * gq.z; o.w = v[i].w * rs * gq.w;
      if (!dry) *(float4*)(xp + 4 * lane + 256 * i) = o;
    }
  }
}

__device__ void run_phase(const Params& p, int ph, char* smem) {
  if (ph == 0) { if (PH_ON(0)) phase_prep(p, smem); return; }
  if (ph == NPHASE - 1) { if (PROBE_B) phase_final(p, true); if (PH_ON(11)) phase_final(p); return; }
  const int q = ph - 1;
  const int layer = (q < 5) ? 0 : (q < 12) ? 1 : (q < 17) ? 2 : 3;
  const int sub = (q < 5) ? q : (q < 12) ? q - 5 : (q < 17) ? q - 12 : q - 17;
  const int li = layer >> 1;
  const float* xa = (layer == 0) ? p.x_prompt : p.out;
  const float* xb = (layer == 0) ? p.x_sample : p.out + (long)T_P * DM;
  if ((layer & 1) == 0) {
    if (sub == 0) {
      EpiEvenIn e{p.Qb, p.Kt, p.VtE, p.Gb, p.LRb, p.PUb, p.PGb};
      if (PH_ON(1)) gemm_phase<3, 8>(T_TOK / 128, NE_PAD / 256, DM, p.WinE + (long)li * NE_PAD * DM, p.SSQ, nullptr, p.TMP, DM, DM, p.TMP, DM, e, smem);
    } else if (sub == 1) {
      for (int item = blockIdx.x; item < 5120; item += gridDim.x)
        if (PH_ON(2)) gla_intra_item(p, li, item, smem);
    } else if (sub == 2) {
      __shared__ int s_pitem;
      for (int item = blockIdx.x; item < 384; item += gridDim.x) { if (PH_ON(2)) gla_chain_item(p, li, item, smem, false); }
      for (;;) {
        __syncthreads();
        if (threadIdx.x == 0) s_pitem = atomicAdd(p.counters + 16 + li, 1);
        __syncthreads();
        const int item = s_pitem;
        if (item >= 5120) break;
        if (PH_ON(3)) pool_item(p, li, item, smem);
      }
    } else if (sub == 3) {
      if (PROBE_B) phase_gla_combine(p, li, true);
      if (PH_ON(4)) phase_gla_combine(p, li);
    } else {
      EpiOut e{xa, xb, p.out, false, p.NUMIf, p.SSQ};
      if (PH_ON(5)) gemm_phase<1, 8>(T_TOK / 128, DM / 256, 1536, p.WoutE + (long)li * DM * 1536, nullptr, nullptr, p.Gb, 1024, 1024, p.PGb, 512, e, smem);
    }
  } else {
    if (sub == 0) {
      EpiOddIn e{p.CQb, p.CKVb, p.KRb, p.MGb, p.MQb, p.MKb, p.MKt, p.MVt, p.MOb, p.MLGb, p.MIF};
      if (PH_ON(6)) gemm_phase<3, 8>(T_TOK / 128, NO_PAD / 256, DM, p.WinO + (long)li * NO_PAD * DM, p.SSQ, nullptr, p.NUMIf, DM, DM, p.NUMIf, DM, e, smem);
    } else if (sub == 1) {
      for (int rep = 0; rep < 1 + PROBE_A; ++rep)
      for (int item = blockIdx.x; item < 5120; item += gridDim.x)
        if (PH_ON(8)) ml_intra_item(p, li, item, smem);
    } else if (sub == 2) {
      for (int item = blockIdx.x; item < 768; item += gridDim.x)
        if (PH_ON(8)) ml_chain_item(p, li, item, smem, false);
    } else if (sub == 3) {
      if (PROBE_B) phase_ml_combine(p, li, true);
      if (PH_ON(10)) phase_ml_combine(p, li);
    } else if (sub == 4) {
      EpiQUp eq{p.Qa};
      if (PH_ON(7)) gemm_phase<2, 4>(T_TOK / 128, 768 / 128, 384, p.QupT + (long)li * 768 * 384, nullptr, nullptr, p.CQb, 384, 384, p.CQb, 384, eq, smem);
      EpiKVUp ek{p.KNb, p.VtA};
      if (PH_ON(7)) gemm_phase<2, 4>(T_TOK / 128, 1024 / 128, 256, p.KVupT + (long)li * 1024 * 256, nullptr, nullptr, p.CKVb, 256, 256, p.CKVb, 256, ek, smem);
    } else if (sub == 5) {
      __shared__ int s_item;
      for (;;) {
        __syncthreads();
        if (threadIdx.x == 0) s_item = atomicAdd(p.counters + li * 8 + (blockIdx.x & 7), 1);
        __syncthreads();
        const int item = s_item;
        if (item >= 320) break;
        if (PH_ON(9)) attn_item(p, (blockIdx.x & 7) * 320 + item, smem);
      }
    } else {
      EpiOut e{xa, xb, p.out, false, (layer == 3) ? nullptr : p.TMP, p.SSQ};
      if (PH_ON(5)) gemm_phase<1, 8>(T_TOK / 128, DM / 256, 1024, p.WoutO + (long)li * DM * 1024, nullptr, nullptr, p.MGb, 512, 512, p.MLGb, 512, e, smem);
    }
  }
}

__global__ void __launch_bounds__(256, 2) mega_kernel(Params p) {
  extern __shared__ __attribute__((aligned(16))) char smem[];
  cg::grid_group grid = cg::this_grid();
  __shared__ uint4 xb_words;
  if (threadIdx.x == 0) xb_words = make_uint4(0u, 0u, 0u, 0u);
  __syncthreads();
  XcdBarrier xb = xcd_barrier_post(p.bar, (volatile LAS unsigned*)&xb_words);
  for (int ph = p.ph_lo; ph < p.ph_hi; ++ph) {
    if (ph > p.ph_lo) {
      if (ph == p.ph_lo + 1) grid.sync();
      else xcd_barrier(xb);
    }
    run_phase(p, ph, smem);
  }
}

extern "C" void kernel_launch(void* const* d_in, const int* in_sizes, int n_in, void* d_out, int out_size, void* d_ws,
                              size_t ws_size, hipStream_t stream) {
  static int grid_blocks = 0;
  if (!grid_blocks) {
    int dev = 0, cus = 0, per_cu = 0;
    hipGetDevice(&dev);
    hipDeviceGetAttribute(&cus, hipDeviceAttributeMultiprocessorCount, dev);
    hipFuncSetAttribute((const void*)mega_kernel, hipFuncAttributeMaxDynamicSharedMemorySize, LDS_BYTES);
    hipOccupancyMaxActiveBlocksPerMultiprocessor(&per_cu, (const void*)mega_kernel, 256, LDS_BYTES);
    if (per_cu < 1) per_cu = 1;
    if (per_cu > 2) per_cu = 2;
    grid_blocks = cus * per_cu;
    fprintf(stderr, "kernel_launch: cus %d per_cu %d grid %d ws %zu\n", cus, per_cu, grid_blocks, ws_size);
  }
  Params p{};
  const float** pin = (const float**)&p;
  for (int i = 0; i < 19; ++i) pin[i] = (const float*)d_in[i];
  p.out = (float*)d_out;
  char* ws = (char*)d_ws;
  size_t off = 0;
  auto take = [&](size_t bytes) { char* r = ws + off; off += (bytes + 255) & ~(size_t)255; return r; };
  p.WinE = (bf16_t*)take((size_t)2 * NE_PAD * DM * 2);
  p.WinO = (bf16_t*)take((size_t)2 * NO_PAD * DM * 2);
  p.WoutE = (bf16_t*)take((size_t)2 * DM * 1536 * 2);
  p.WoutO = (bf16_t*)take((size_t)2 * DM * 1024 * 2);
  p.QupT = (bf16_t*)take((size_t)2 * 768 * 384 * 2);
  p.KVupT = (bf16_t*)take((size_t)2 * 1024 * 256 * 2);
  p.PoolWT = (bf16_t*)take((size_t)2 * 4 * 128 * 128 * 2);
  p.AupT = (bf16_t*)take((size_t)2 * 2 * 512 * 32 * 2);
  p.counters = (int*)take(256);
  p.bar = (unsigned*)take((size_t)XCD_BAR_WORDS * 4);
  p.SSQ = (float*)take((size_t)T_TOK * 8 * 4);
  const size_t act0 = off;
  const size_t T = T_TOK;
  p.Gb = (bf16_t*)take(T * 1024 * 2);
  p.PGb = (bf16_t*)take(T * 512 * 2);
  p.Qb = (bf16_t*)take(T * 512 * 2);
  p.Kt = (bf16_t*)take(T * 512 * 2);
  p.QEb = (bf16_t*)take(T * 512 * 2);
  p.KdTb = (bf16_t*)take(T * 512 * 2);
  p.EB = (float*)take((size_t)2 * 1280 * 512 * 4);
  p.VtE = (bf16_t*)take(T * 1024 * 2);
  p.LRb = (bf16_t*)take(T * 32 * 2);
  p.PUb = (bf16_t*)take(T * 512 * 2);
  p.TMP = (bf16_t*)take(T * 1024 * 2);
  const size_t even_end = off;
  off = act0;
  p.MGb = (bf16_t*)take(T * 512 * 2);
  p.MLGb = (bf16_t*)take(T * 512 * 2);
  p.CQb = (bf16_t*)take(T * 384 * 2);
  p.CKVb = (bf16_t*)take(T * 256 * 2);
  p.KRb = (bf16_t*)take(T * 32 * 2);
  const size_t r2 = off;
  p.MQb = (bf16_t*)take(T * 512 * 2);
  p.MKb = (bf16_t*)take(T * 512 * 2);
  p.MKt = (bf16_t*)take(T * 512 * 2);
  p.MVt = (bf16_t*)take(T * 512 * 2);
  p.MOb = (bf16_t*)take(T * 512 * 2);
  p.NUMIf = (bf16_t*)take(T * 512 * 2);
  p.NUMIb = (bf16_t*)take(T * 512 * 2);
  p.MIF = (float*)take(T * 16 * 4);
  p.EBI = (float*)take(T * 8 * 4);
  p.WKg = (float*)take(T * 8 * 4);
  p.DENI = (float*)take(T * 8 * 4);
  p.DEC = (float*)take((size_t)8 * 1280 * 4);
  const size_t r2_end = off;
  off = r2;
  p.Qa = (bf16_t*)take(T * 768 * 2);
  p.KNb = (bf16_t*)take(T * 512 * 2);
  p.VtA = (bf16_t*)take(T * 512 * 2);
  if (off < r2_end) off = r2_end;
  const size_t odd_end = off;
  const size_t need = even_end > odd_end ? even_end : odd_end;
  if (need > ws_size) {
    fprintf(stderr, "kernel_launch: workspace too small: need %zu have %zu\n", need, ws_size);
    return;
  }
  hipMemsetAsync(p.bar, 0, (size_t)XCD_BAR_WORDS * 4, stream);
#if SINGLE_LAUNCH
  p.ph_lo = 0;
  p.ph_hi = NPHASE;
  void* args[] = {&p};
  hipError_t e = hipLaunchCooperativeKernel((const void*)mega_kernel, dim3(grid_blocks), dim3(256), args, LDS_BYTES, stream);
  if (e != hipSuccess) fprintf(stderr, "cooperative launch failed: %s (grid %d)\n", hipGetErrorString(e), grid_blocks);
#else
  for (int ph = 0; ph < NPHASE; ++ph) {
    p.ph_lo = ph;
    p.ph_hi = ph + 1;
    hipLaunchKernelGGL(mega_kernel, dim3(grid_blocks), dim3(256), LDS_BYTES, stream, p);
  }
#endif
}
```

```cpp
#include <hip/hip_runtime.h>
#include <hip/hip_cooperative_groups.h>
#include <cstdio>
namespace cg = cooperative_groups;

#ifndef SINGLE_LAUNCH
#define SINGLE_LAUNCH 1
#endif
#ifndef PHMASK
#define PHMASK 0xFFFF
#endif
#define PH_ON(b) ((PHMASK >> (b)) & 1)
#ifndef PROBE_GEMM
#define PROBE_GEMM 0
#endif
#ifndef PROBE_ATTN
#define PROBE_ATTN 0
#endif
#ifndef PROBE_CHAIN
#define PROBE_CHAIN 0
#endif
#ifndef PROBE_A
#define PROBE_A 0
#endif
#ifndef PROBE_B
#define PROBE_B 0
#endif
#ifndef PROBE_MLCHAIN
#define PROBE_MLCHAIN 0
#endif

typedef unsigned short bf16_t;
typedef __attribute__((ext_vector_type(8))) short bf16x8;
typedef __attribute__((ext_vector_type(4))) float f32x4;
typedef __attribute__((ext_vector_type(4))) unsigned short us4;

constexpr int T_TOK = 81920;
constexpr int T_P = 16384;
constexpr int DM = 1024;
constexpr int NE = 4128, NE_PAD = 4352;
constexpr int NO = 3760, NO_PAD = 3840;
constexpr float EPS = 1e-6f;
constexpr int NPHASE = 26;
constexpr int LDS_BYTES = 72 * 1024;

struct Params {
  const float *x_prompt, *x_sample, *norm_g, *final_norm_g, *e_w_in, *e_a_up, *e_a_bias, *e_gla_norm_g,
      *e_pool_w, *e_pool_scale, *e_w_out, *o_w_in, *o_q_norm_g, *o_q_up, *o_kv_norm_g, *o_kv_up, *o_if_bias,
      *o_ml_norm_g, *o_w_out;
  float* out;
  bf16_t *WinE, *WinO, *WoutE, *WoutO, *QupT, *KVupT, *PoolWT, *AupT;
  int* counters;
  unsigned* bar;
  float* SSQ;
  bf16_t *Qb, *Kt, *VtE, *Gb, *LRb, *PUb, *PGb, *TMP, *QEb, *KdTb;
  float* EB;
  bf16_t *CQb, *CKVb, *KRb, *MGb, *MQb, *MKb, *MKt, *MVt, *MOb, *MLGb, *NUMIf, *NUMIb, *Qa, *KNb, *VtA;
  float *MIF, *EBI, *WKg, *DENI, *DEC;
  int ph_lo, ph_hi;
};

typedef __bf16 hbf2 __attribute__((ext_vector_type(2)));
typedef float hf2 __attribute__((ext_vector_type(2)));
__device__ __forceinline__ bf16_t f2bf(float f) {
  __bf16 b = (__bf16)f;
  return __builtin_bit_cast(bf16_t, b);
}
__device__ __forceinline__ unsigned pk2bf(float a, float b) {
  hf2 v = {a, b};
  hbf2 r = __builtin_convertvector(v, hbf2);
  return __builtin_bit_cast(unsigned, r);
}
__device__ __forceinline__ float bf2f(bf16_t b) { return __uint_as_float(((unsigned)b) << 16); }
__device__ __forceinline__ f32x4 mfma16(bf16x8 a, bf16x8 b, f32x4 c) {
  return __builtin_amdgcn_mfma_f32_16x16x32_bf16(a, b, c, 0, 0, 0);
}
__device__ __forceinline__ float logsigmoidf_(float x) { return fminf(x, 0.f) - log1pf(__expf(-fabsf(x))); }
__device__ __forceinline__ float siluf_(float x) { return x / (1.f + __expf(-x)); }
__device__ __forceinline__ float sigmoidf_(float x) { return 1.f / (1.f + __expf(-x)); }
__device__ __forceinline__ int otid() { int t = threadIdx.x; asm volatile("" : "+v"(t)); return t; }
__device__ __forceinline__ float bperm(int srclane, float v) { return __int_as_float(__builtin_amdgcn_ds_bpermute(srclane << 2, __float_as_int(v))); }
__device__ __forceinline__ float sxor(float v, int m, int lane) { return bperm(lane ^ m, v); }
typedef unsigned u32x2_t __attribute__((ext_vector_type(2)));
__device__ __forceinline__ float rowmax4(float v) {
  u32x2_t r = __builtin_amdgcn_permlane16_swap(__float_as_uint(v), __float_as_uint(v), false, false);
  v = fmaxf(__uint_as_float(r[0]), __uint_as_float(r[1]));
  r = __builtin_amdgcn_permlane32_swap(__float_as_uint(v), __float_as_uint(v), false, false);
  return fmaxf(__uint_as_float(r[0]), __uint_as_float(r[1]));
}
template <int CTRL> __device__ __forceinline__ float dpp_f(float v) {
  return __int_as_float(__builtin_amdgcn_update_dpp(0, __float_as_int(v), CTRL, 0xf, 0xf, false));
}
__device__ __forceinline__ float wave_sum(float v) {
  v += dpp_f<0x128>(v);
  v += dpp_f<0x124>(v);
  v += dpp_f<0x122>(v);
  v += dpp_f<0x121>(v);
  u32x2_t r = __builtin_amdgcn_permlane16_swap(__float_as_uint(v), __float_as_uint(v), false, false);
  v = __uint_as_float(r[0]) + __uint_as_float(r[1]);
  r = __builtin_amdgcn_permlane32_swap(__float_as_uint(v), __float_as_uint(v), false, false);
  return __uint_as_float(r[0]) + __uint_as_float(r[1]);
}
__device__ __forceinline__ bf16x8 zero8() { bf16x8 z = {0, 0, 0, 0, 0, 0, 0, 0}; return z; }
__device__ __forceinline__ f32x4 zero4() { f32x4 z = {0.f, 0.f, 0.f, 0.f}; return z; }

__device__ __forceinline__ int seq_pos(int tok) { return tok < T_P ? (tok & 4095) : ((tok - T_P) & 8191); }
__device__ __forceinline__ const float* xrow(const float* xa, const float* xb, int tok) {
  return tok < T_P ? xa + (long)tok * DM : xb + (long)(tok - T_P) * DM;
}


#define XB_TMO      128
#define XB_XCNT(j)  (256  + 64 * (j))
#define XB_XSUB(j)  (1280 + 64 * (j))
#define XB_XGEN(j)  (2304 + 64 * (j))
#define XB_TOP      3328
#define XB_TOPGEN   3392
#define XCD_BAR_WORDS 3456
#define XB_SPIN_CAP (1u << 22)
#define LAS __attribute__((address_space(3)))
__device__ __forceinline__ unsigned xb_ld(unsigned* p) { return __hip_atomic_load(p, __ATOMIC_RELAXED, __HIP_MEMORY_SCOPE_AGENT); }
__device__ __forceinline__ unsigned xb_add(unsigned* p, unsigned v) { return __hip_atomic_fetch_add(p, v, __ATOMIC_RELAXED, __HIP_MEMORY_SCOPE_AGENT); }
__device__ __forceinline__ unsigned xb_xcc_id() { return (unsigned)__builtin_amdgcn_s_getreg((3 << 11) | 20) & 0xFu; }
#define XB_SPIN(cond, bar) do { unsigned _sp = 0; while (cond) { __builtin_amdgcn_s_sleep(1); \
    if ((++_sp & 255u) == 0u) { if (xb_ld(&(bar)[XB_TMO])) break; if (_sp > XB_SPIN_CAP) { atomicAdd(&(bar)[XB_TMO], 1u); break; } } } } while (0)
struct XcdBarrier { unsigned* bar; unsigned x; volatile LAS unsigned* st; };
__device__ __forceinline__ XcdBarrier xcd_barrier_post(unsigned* bar, volatile LAS unsigned* st) {
  XcdBarrier b; b.bar = bar; b.x = xb_xcc_id(); b.st = st;
  if (threadIdx.x == 0) (void)xb_add(&bar[XB_XCNT(b.x)], 1u);
  return b;
}
__device__ __forceinline__ void xcd_barrier_complete(unsigned* bar, unsigned x, unsigned& nloc, unsigned& nx) {
  const unsigned G = gridDim.x * gridDim.y * gridDim.z;
  unsigned sum, cnt, mine, sp = 0u;
  for (;;) {
    sum = 0u; cnt = 0u; mine = 0u;
#pragma unroll
    for (unsigned j = 0; j < 16; ++j) { const unsigned cc = xb_ld(&bar[XB_XCNT(j)]); sum += cc; cnt += (cc > 0u) ? 1u : 0u; mine = (j == x) ? cc : mine; }
    if (sum == G) break;
    __builtin_amdgcn_s_sleep(1);
    if ((++sp & 255u) == 0u) { if (xb_ld(&bar[XB_TMO])) break; if (sp > XB_SPIN_CAP) { atomicAdd(&bar[XB_TMO], 1u); break; } }
  }
  nloc = mine > 0u ? mine : 1u; nx = cnt > 0u ? cnt : 1u;
}
__device__ __forceinline__ void xcd_barrier(const XcdBarrier& b) {
  asm volatile("s_waitcnt vmcnt(0)" ::: "memory");
  __syncthreads();
  if (threadIdx.x == 0) {
    unsigned* bar = b.bar;
    __builtin_amdgcn_s_waitcnt(0);
    unsigned nloc = b.st[0], nx = b.st[1];
    if (nloc == 0u) { xcd_barrier_complete(bar, b.x, nloc, nx); b.st[0] = nloc; b.st[1] = nx; }
    const unsigned old = xb_add(&bar[XB_XSUB(b.x)], 1u);
    const unsigned gen = old / nloc;
    if (old + 1u == (gen + 1u) * nloc) {
      __builtin_amdgcn_fence(__ATOMIC_RELEASE, "agent");
      asm volatile("s_waitcnt vmcnt(0)" ::: "memory");
      const unsigned og = xb_add(&bar[XB_TOP], 1u);
      const unsigned tg = og / nx;
      if (og + 1u == (tg + 1u) * nx) xb_add(&bar[XB_TOPGEN], 1u);
      else XB_SPIN(xb_ld(&bar[XB_TOPGEN]) == tg, bar);
      __builtin_amdgcn_fence(__ATOMIC_ACQUIRE, "agent");
      xb_add(&bar[XB_XGEN(b.x)], 1u);
      asm volatile("s_waitcnt vmcnt(0)" ::: "memory");
    } else {
      XB_SPIN(xb_ld(&bar[XB_XGEN(b.x)]) == gen, bar);
      __builtin_amdgcn_fence(__ATOMIC_ACQUIRE, "agent");
      asm volatile("s_waitcnt vmcnt(0)" ::: "memory");
    }
  }
  __syncthreads();
}

__device__ __forceinline__ int colmap(int mode, int n) {
  if (mode == 1) {
    if (n < 512) return 2208 + n;
    if (n < 1024) return 1696 + (n - 512);
    if (n < 1408) return n - 1024;
    if (n < 1664) return 384 + (n - 1408);
    if (n < 2176) return 672 + (n - 1664);
    if (n < 2688) return 1184 + (n - 2176);
    if (n < 3200) return 2720 + (n - 2688);
    if (n < 3712) return 3248 + (n - 3200);
    if (n < 3744) return 640 + (n - 3712);
    return 3232 + (n - 3744);
  }
  if (mode == 2) {
    if (n < 512) return (n >> 6) * 96 + (n & 63);
    const int r = n - 512;
    return (r >> 5) * 96 + 64 + (r & 31);
  }
  if (mode == 3) {
    if (n < 512) return (n >> 6) * 128 + (n & 63);
    const int r = n - 512;
    return (r >> 6) * 128 + 64 + (r & 63);
  }
  return n;
}

__device__ void prep_weight(const float* __restrict__ W, int K, int N, int Npad, const float* __restrict__ gsc,
                            bf16_t* __restrict__ out, char* smem, int mode = 0, int Nsrc_ = 0) {
  const int Nsrc = Nsrc_ ? Nsrc_ : N;
  const int tid = otid();
  float* sT = (float*)smem;
  const int tn = Npad >> 6, tk = K >> 6;
  for (int tile = blockIdx.x; tile < tn * tk; tile += gridDim.x) {
    const int n0 = (tile / tk) << 6, k0 = (tile % tk) << 6;
    __syncthreads();
#pragma unroll 4
    for (int i = 0; i < 16; ++i) {
      const int idx = tid + 256 * i;
      const int kk = idx >> 6, nn = idx & 63;
      float v = 0.f;
      if (n0 + nn < N) {
        v = W[(size_t)(k0 + kk) * Nsrc + colmap(mode, n0 + nn)];
        if (gsc) v *= gsc[k0 + kk];
      }
      sT[nn * 65 + kk] = v;
    }
    __syncthreads();
#pragma unroll 4
    for (int i = 0; i < 16; ++i) {
      const int idx = tid + 256 * i;
      const int nn = idx >> 6, kk = idx & 63;
      out[(size_t)(n0 + nn) * K + k0 + kk] = f2bf(sT[nn * 65 + kk]);
    }
  }
}

__device__ void phase_prep(const Params& p, char* smem) {
  long gtid = (long)blockIdx.x * 256 + otid();
  long gsize = (long)gridDim.x * 256;
  for (int l = 0; l < 2; ++l) {
    prep_weight(p.e_w_in + (long)l * DM * NE, DM, NE, NE_PAD, p.norm_g + (2 * l) * DM, p.WinE + (long)l * NE_PAD * DM, smem);
    prep_weight(p.o_w_in + (long)l * DM * 3760, DM, NO, NO_PAD, p.norm_g + (2 * l + 1) * DM, p.WinO + (long)l * NO_PAD * DM, smem, 1, 3760);
    prep_weight(p.e_w_out + (long)l * 1536 * DM, 1536, DM, DM, nullptr, p.WoutE + (long)l * DM * 1536, smem);
    prep_weight(p.o_w_out + (long)l * 1024 * DM, 1024, DM, DM, nullptr, p.WoutO + (long)l * DM * 1024, smem);
    prep_weight(p.o_q_up + (long)l * 384 * 768, 384, 768, 768, p.o_q_norm_g + l * 384, p.QupT + (long)l * 768 * 384, smem, 2);
    prep_weight(p.o_kv_up + (long)l * 256 * 1024, 256, 1024, 1024, p.o_kv_norm_g + l * 256, p.KVupT + (long)l * 1024 * 256, smem, 3);
    for (int gi = 0; gi < 4; ++gi)
      prep_weight(p.e_pool_w + (long)(l * 4 + gi) * 128 * 128, 128, 128, 128, nullptr, p.PoolWT + (long)(l * 4 + gi) * 128 * 128, smem);
    for (long idx = gtid; idx < 2 * 512 * 32; idx += gsize) {
      int r = (int)(idx & 31);
      int d = (int)((idx >> 5) & 511);
      int dir = (int)(idx >> 14);
      float v = (r < 16) ? p.e_a_up[((long)(l * 2 + dir) * 16 + r) * 512 + d] : 0.f;
      p.AupT[((long)(l * 2 + dir) * 512 + d) * 32 + r] = f2bf(v);
    }
  }
  if (gtid < 32) p.counters[gtid] = 0;
  {
    const int tid_ = otid();
    const int lane = tid_ & 63, w = tid_ >> 6;
    for (int tok = blockIdx.x * 4 + w; tok < T_TOK; tok += gridDim.x * 4) {
      const float* xp = xrow(p.x_prompt, p.x_sample, tok) + 16 * lane;
      float ssv = 0.f;
      unsigned pk[8];
#pragma unroll
      for (int i = 0; i < 4; ++i) {
        const f32x4 v = *(const f32x4*)(xp + 4 * i);
        ssv += v[0] * v[0] + v[1] * v[1] + v[2] * v[2] + v[3] * v[3];
        pk[2 * i] = pk2bf(v[0], v[1]);
        pk[2 * i + 1] = pk2bf(v[2], v[3]);
      }
      uint4 o0, o1;
      o0.x = pk[0]; o0.y = pk[1]; o0.z = pk[2]; o0.w = pk[3];
      o1.x = pk[4]; o1.y = pk[5]; o1.z = pk[6]; o1.w = pk[7];
      *(uint4*)(p.TMP + (size_t)tok * DM + 16 * lane) = o0;
      *(uint4*)(p.TMP + (size_t)tok * DM + 16 * lane + 8) = o1;
      ssv = wave_sum(ssv);
      if (lane < 8) p.SSQ[(size_t)tok * 8 + lane] = (lane == 0) ? ssv : 0.f;
    }
  }
}

constexpr int G_LD = 40;
constexpr int G_BUF = (128 + 256) * G_LD;

template <int AMODE, int NI, class Epi>
__device__ __forceinline__ void gemm_phase(int Mtiles, int Ntiles, int K, const bf16_t* __restrict__ Bt, const float* ssq, const float* unused_,
                           const bf16_t* A1, int ld1, int K1, const bf16_t* A2, int ld2, const Epi& epi, char* smem) {
  bf16_t* sbase = (bf16_t*)smem;
  float* sR = (float*)(smem + 70144);
  const int tid = otid(), lane = tid & 63, w = tid >> 6, c = lane & 15, g = lane >> 4;
  const int wm = w >> 1, wn = w & 1;
  const int nk = K / 32;
  const int xcd = blockIdx.x & 7, lb0 = blockIdx.x >> 3, nlb = gridDim.x >> 3;
  const int mper = Mtiles >> 3;
  for (int lt = lb0; lt < mper * Ntiles; lt += nlb) {
    const int mt = xcd * mper + lt / Ntiles, nt = lt % Ntiles;
    constexpr int BN = 32 * NI;
    const int m0 = mt * 128, n0 = nt * BN;
    f32x4 acc[4][NI];
#pragma unroll
    for (int i = 0; i < 4; ++i)
#pragma unroll
      for (int j = 0; j < NI; ++j) acc[i][j] = zero4();
    float ss[2] = {0.f, 0.f};
    bf16x8 ra0[2], ra1[2];
    bf16x8 rb0[NI / 2], rb1[NI / 2];
    const unsigned boff = (unsigned)(tid >> 2) * K + 8 * (tid & 3);
    const bf16_t* bbase = Bt + (size_t)n0 * K;
#define G_LOAD(RA, RB, KT)                                                                          \
  {                                                                                                 \
    const int k0_ = (KT) * 32;                                                                      \
    const bf16_t* base_;                                                                            \
    int ld_;                                                                                        \
    if (k0_ < K1) { base_ = A1 + (size_t)m0 * ld1 + k0_; ld_ = ld1; }                               \
    else { base_ = A2 + (size_t)m0 * ld2 + (k0_ - K1); ld_ = ld2; }                                 \
    _Pragma("unroll") for (int i = 0; i < 2; ++i)                                                   \
      RA[i] = *(const bf16x8*)(base_ + (unsigned)((tid >> 2) + 64 * i) * ld_ + 8 * (tid & 3));      \
    _Pragma("unroll") for (int i = 0; i < NI / 2; ++i)                                              \
      RB[i] = *(const bf16x8*)(bbase + k0_ + boff + (unsigned)(64 * i) * K);                        \
  }
#define G_STORE(RA, RB, BUF)                                                                        \
  {                                                                                                 \
    bf16_t* sA_ = sbase + (BUF) * G_BUF;                                                            \
    bf16_t* sB_ = sA_ + 128 * G_LD;                                                                 \
    _Pragma("unroll") for (int i = 0; i < 2; ++i) {                                                 \
      bf16x8 v = RA[i];                                                                             \
      if constexpr (AMODE == 2) {                                                                   \
        _Pragma("unroll") for (int e = 0; e < 8; ++e) {                                             \
          float f = bf2f((bf16_t)v[e]);                                                             \
          ss[i] += f * f;                                                                           \
        }                                                                                           \
      }                                                                                             \
      *(bf16x8*)(sA_ + ((tid >> 2) + 64 * i) * G_LD + 8 * (tid & 3)) = v;                           \
    }                                                                                               \
    _Pragma("unroll") for (int i = 0; i < NI / 2; ++i)                                              \
      *(bf16x8*)(sB_ + ((tid >> 2) + 64 * i) * G_LD + 8 * (tid & 3)) = RB[i];                       \
  }
#define G_COMPUTE(BUF)     \
  {                                                                                                 \
    const bf16_t* sA_ = sbase + (BUF) * G_BUF;                                                      \
    const bf16_t* sB_ = sA_ + 128 * G_LD;                                                           \
    bf16x8 af[4];                                                                                   \
    _Pragma("unroll") for (int mi = 0; mi < 4; ++mi)                                                \
      af[mi] = *(const bf16x8*)(sA_ + (wm * 64 + mi * 16 + c) * G_LD + g * 8);                      \
    bf16x8 bq[2];                                                                                   \
    bq[0] = *(const bf16x8*)(sB_ + (wn * (16 * NI) + c) * G_LD + g * 8);                            \
    _Pragma("unroll") for (int ni = 0; ni < NI; ++ni) {                                             \
      if (ni + 1 < NI)                                                                              \
        bq[(ni + 1) & 1] = *(const bf16x8*)(sB_ + (wn * (16 * NI) + (ni + 1) * 16 + c) * G_LD + g * 8); \
      _Pragma("unroll") for (int mi = 0; mi < 4; ++mi)                                              \
        acc[mi][ni] = (!Epi::staged) ? mfma16(bq[ni & 1], af[mi], acc[mi][ni]) : mfma16(af[mi], bq[ni & 1], acc[mi][ni]); \
    }                                                                                               \
  }
    __syncthreads();
    if constexpr (AMODE == 3) {
      if (tid < 128) {
        const f32x4 p0 = *(const f32x4*)(ssq + (size_t)(m0 + tid) * 8);
        const f32x4 p1 = *(const f32x4*)(ssq + (size_t)(m0 + tid) * 8 + 4);
        const float sv = (p0[0] + p0[1]) + (p0[2] + p0[3]) + (p1[0] + p1[1]) + (p1[2] + p1[3]);
        sR[tid] = rsqrtf(sv * (1.f / 1024.f) + EPS);
      }
    }
    G_LOAD(ra0, rb0, 0)
    G_LOAD(ra1, rb1, 1)
    G_STORE(ra0, rb0, 0)
    __syncthreads();
    for (int kt = 0; kt < nk; kt += 2) {
      G_LOAD(ra0, rb0, min(kt + 2, nk - 1))
      G_COMPUTE(0)
      G_STORE(ra1, rb1, 1)
      __syncthreads();
      G_LOAD(ra1, rb1, min(kt + 3, nk - 1))
      G_COMPUTE(1)
      if (kt + 2 < nk) G_STORE(ra0, rb0, 0)
      __syncthreads();
    }
    if constexpr (AMODE == 2) {
#pragma unroll
      for (int i = 0; i < 2; ++i) {
        float sv = ss[i];
        sv += sxor(sv, 1, lane); sv += sxor(sv, 2, lane);
        if ((tid & 3) == 0) sR[(tid >> 2) + 64 * i] = rsqrtf(sv / (float)K + EPS);
      }
      __syncthreads();
    }
    if constexpr (Epi::staged) {
      bf16_t* sT = sbase;
      const float esc = epi.scale();
      const bool both = epi.both(n0);
#pragma unroll 1
      for (int pass = 0; pass < (both ? 2 : 1); ++pass) {
      const bool tr = both ? (pass == 1) : epi.transposed(n0);
      if (pass) __syncthreads();
      if (tr) {
#pragma unroll
        for (int mi = 0; mi < 4; ++mi) {
          const int row = wm * 64 + mi * 16 + 4 * g;
          const float r0 = sR[row] * esc, r1 = sR[row + 1] * esc, r2 = sR[row + 2] * esc, r3 = sR[row + 3] * esc;
#pragma unroll
          for (int ni = 0; ni < NI; ++ni) {
            uint2 o;
            o.x = pk2bf(acc[mi][ni][0] * r0, acc[mi][ni][1] * r1);
            o.y = pk2bf(acc[mi][ni][2] * r2, acc[mi][ni][3] * r3);
            *(uint2*)(sT + (wn * (16 * NI) + ni * 16 + c) * 136 + row) = o;
          }
        }
      } else {
#pragma unroll
        for (int mi = 0; mi < 4; ++mi) {
          const int row = wm * 64 + mi * 16 + 4 * g;
          const float r0 = sR[row] * esc, r1 = sR[row + 1] * esc, r2 = sR[row + 2] * esc, r3 = sR[row + 3] * esc;
#pragma unroll
          for (int ni = 0; ni < NI; ++ni) {
            bf16_t* d = sT + row * (BN + 8) + wn * (16 * NI) + ni * 16 + c;
            d[0] = f2bf(acc[mi][ni][0] * r0);
            d[BN + 8] = f2bf(acc[mi][ni][1] * r1);
            d[2 * (BN + 8)] = f2bf(acc[mi][ni][2] * r2);
            d[3 * (BN + 8)] = f2bf(acc[mi][ni][3] * r3);
          }
        }
      }
      if (pass == 0) epi.template direct<NI>(m0, n0, wm, wn, g, c, acc, sR);
      __syncthreads();
      if (tr) {
#pragma unroll 4
        for (int i = 0; i < 2 * NI; ++i) {
          const int id = tid + 256 * i;
          const int col = id >> 4, rc = id & 15;
          bf16x8 v = *(const bf16x8*)(sT + col * 136 + 8 * rc);
          epi.store_t(m0 + 8 * rc, n0 + col, v);
        }
      } else {
#pragma unroll 4
        for (int i = 0; i < 2 * NI; ++i) {
          const int id = tid + 256 * i;
          const int row = id / (4 * NI), cc = id % (4 * NI);
          const bf16_t* sp = sT + row * (BN + 8) + 8 * cc;
          bf16x8 v = *(const bf16x8*)sp;
          epi.store_n(m0 + row, n0 + 8 * cc, v, sp);
        }
      }
      }
    } else {
      float* sF = (float*)smem;
#pragma unroll 1
      for (int half = 0; half < 2; ++half) {
        if (half) __syncthreads();
        if (wm == half) {
#pragma unroll
          for (int mi = 0; mi < 4; ++mi)
#pragma unroll
            for (int ni = 0; ni < NI; ++ni) *(f32x4*)(sF + (mi * 16 + c) * 260 + wn * (16 * NI) + ni * 16 + 4 * g) = acc[mi][ni];
        }
        __syncthreads();
#pragma unroll 4
        for (int i = 0; i < 16; ++i) {
          const int row = w * 16 + i;
          const int tok = m0 + half * 64 + row;
          const int col = n0 + 4 * lane;
          const f32x4 a = *(const f32x4*)(sF + row * 260 + 4 * lane);
          const f32x4 xo = *(const f32x4*)(xrow(epi.xa, epi.xb, tok) + col);
          f32x4 xn;
          xn[0] = xo[0] + a[0]; xn[1] = xo[1] + a[1]; xn[2] = xo[2] + a[2]; xn[3] = xo[3] + a[3];
          float sv = xn[0] * xn[0] + xn[1] * xn[1] + xn[2] * xn[2] + xn[3] * xn[3];
          sv = wave_sum(sv);
          if (!epi.dry) {
            *(f32x4*)(epi.out + (size_t)tok * DM + col) = xn;
            if (epi.hb) {
              uint2 o;
              o.x = pk2bf(xn[0], xn[1]);
              o.y = pk2bf(xn[2], xn[3]);
              *(uint2*)(epi.hb + (size_t)tok * DM + col) = o;
            }
            if (lane == 0) epi.ssq[(size_t)tok * 8 + (n0 >> 8)] = sv;
          }
        }
      }
    }
  }
#undef G_LOAD
#undef G_STORE
#undef G_COMPUTE
}

__device__ __forceinline__ void rope_cs(int pos, int i, float& co, float& si) {
  float inv = exp2f(-(float)i * (13.287712379549449f / 16.f));
  float ang = (float)pos * inv;
  float n = rintf(ang * 0.15915494309189535f);
  float r = fmaf(-n, 6.28125f, ang);
  r = fmaf(-n, 0.0019353071795864769f, r);
  float rf = r * 0.15915494309189535f;
  si = __builtin_amdgcn_sinf(rf);
  co = __builtin_amdgcn_cosf(rf);
}

__device__ __forceinline__ void rope_chunk(int pos, int i0, bf16x8 x1, bf16x8 x2, bf16x8& o1, bf16x8& o2) {
#pragma unroll
  for (int e = 0; e < 8; ++e) {
    float co, si;
    rope_cs(pos, i0 + e, co, si);
    float a = bf2f((bf16_t)x1[e]), b = bf2f((bf16_t)x2[e]);
    o1[e] = (short)f2bf(a * co - b * si);
    o2[e] = (short)f2bf(b * co + a * si);
  }
}

struct EpiEvenIn {
  static constexpr bool staged = true;
  bf16_t *Qb, *Kt, *VtE, *Gb, *LRb, *PUb, *PGb;
  __device__ float scale() const { return 1.f; }
  __device__ bool transposed(int n0) const { return n0 >= 512 && n0 < 2048; }
  __device__ bool both(int n0) const { return false; }
  template <int NI> __device__ void direct(int m0, int n0, int wm, int wn, int g, int c, f32x4 (&acc)[4][NI], const float* sR) const {}
  __device__ void store_t(int tok8, int col, bf16x8 v) const {
    if (col < 1024) *(bf16x8*)(Kt + (size_t)(col - 512) * T_TOK + tok8) = v;
    else *(bf16x8*)(VtE + (size_t)(col - 1024) * T_TOK + tok8) = v;
  }
  __device__ void store_n(int tok, int col, bf16x8 v, const bf16_t* sp) const {
    bf16_t* d;
    if (col < 512) d = Qb + (size_t)tok * 512 + col;
    else if (col < 3072) d = Gb + (size_t)tok * 1024 + (col - 2048);
    else if (col < 3104) d = LRb + (size_t)tok * 32 + (col - 3072);
    else if (col < 3616) d = PUb + (size_t)tok * 512 + (col - 3104);
    else if (col < 4128) d = PGb + (size_t)tok * 512 + (col - 3616);
    else return;
    *(bf16x8*)d = v;
  }
};

struct EpiOddIn {
  static constexpr bool staged = true;
  bf16_t *CQb, *CKVb, *KRb, *MGb, *MQb, *MKb, *MKt, *MVt, *MOb, *MLGb;
  float* MIF;
  __device__ float scale() const { return 1.f; }
  __device__ bool transposed(int n0) const { return n0 < 512; }
  __device__ bool both(int n0) const { return n0 >= 512 && n0 < 1024; }
  template <int NI> __device__ void direct(int m0, int n0, int wm, int wn, int g, int c, f32x4 (&acc)[4][NI], const float* sR) const {
    if (n0 == 3584 && wn == 1) {
#pragma unroll
      for (int mi = 0; mi < 4; ++mi)
#pragma unroll
        for (int j = 0; j < 4; ++j) {
          const int row = wm * 64 + mi * 16 + 4 * g + j;
          MIF[(size_t)(m0 + row) * 16 + c] = acc[mi][2][j] * sR[row];
        }
    }
  }
  __device__ void store_t(int tok8, int col, bf16x8 v) const {
    if (col < 512) *(bf16x8*)(MVt + (size_t)col * T_TOK + tok8) = v;
    else *(bf16x8*)(MKt + (size_t)(col - 512) * T_TOK + tok8) = v;
  }
  __device__ void store_n(int tok, int col, bf16x8 v, const bf16_t* sp) const {
    bf16_t* d;
    if (col < 1024) d = MKb + (size_t)tok * 512 + (col - 512);
    else if (col < 1408) d = CQb + (size_t)tok * 384 + (col - 1024);
    else if (col < 1664) d = CKVb + (size_t)tok * 256 + (col - 1408);
    else if (col < 2176) d = MGb + (size_t)tok * 512 + (col - 1664);
    else if (col < 2688) d = MQb + (size_t)tok * 512 + (col - 2176);
    else if (col < 3200) d = MOb + (size_t)tok * 512 + (col - 2688);
    else if (col < 3712) d = MLGb + (size_t)tok * 512 + (col - 3200);
    else if (col < 3728) {
      bf16x8 x2 = *(const bf16x8*)(sp + 16);
      bf16x8 o1, o2;
      rope_chunk(seq_pos(tok), col - 3712, v, x2, o1, o2);
      *(bf16x8*)(KRb + (size_t)tok * 32 + (col - 3712)) = o1;
      *(bf16x8*)(KRb + (size_t)tok * 32 + 16 + (col - 3712)) = o2;
      return;
    } else return;
    *(bf16x8*)d = v;
  }
};

struct EpiQUp {
  static constexpr bool staged = true;
  bf16_t* Qa;
  __device__ float scale() const { return 0.10206207261596575f * 1.4426950408889634f; }
  __device__ bool transposed(int n0) const { return false; }
  __device__ bool both(int n0) const { return false; }
  template <int NI> __device__ void direct(int m0, int n0, int wm, int wn, int g, int c, f32x4 (&acc)[4][NI], const float* sR) const {}
  __device__ void store_t(int tok8, int col, bf16x8 v) const {}
  __device__ void store_n(int tok, int col, bf16x8 v, const bf16_t* sp) const {
    if (col < 512) {
      *(bf16x8*)(Qa + (size_t)tok * 768 + (col >> 6) * 96 + (col & 63)) = v;
    } else {
      const int r = col - 512, head = r >> 5, rr = r & 31;
      if (rr < 16) {
        bf16x8 x2 = *(const bf16x8*)(sp + 16);
        bf16x8 o1, o2;
        rope_chunk(seq_pos(tok), rr, v, x2, o1, o2);
        *(bf16x8*)(Qa + (size_t)tok * 768 + head * 96 + 64 + rr) = o1;
        *(bf16x8*)(Qa + (size_t)tok * 768 + head * 96 + 80 + rr) = o2;
      }
    }
  }
};

struct EpiKVUp {
  static constexpr bool staged = true;
  bf16_t *KNb, *VtA;
  __device__ float scale() const { return 1.f; }
  __device__ bool transposed(int n0) const { return n0 >= 512; }
  __device__ bool both(int n0) const { return false; }
  template <int NI> __device__ void direct(int m0, int n0, int wm, int wn, int g, int c, f32x4 (&acc)[4][NI], const float* sR) const {}
  __device__ void store_t(int tok8, int col, bf16x8 v) const { *(bf16x8*)(VtA + (size_t)(col - 512) * T_TOK + tok8) = v; }
  __device__ void store_n(int tok, int col, bf16x8 v, const bf16_t* sp) const { *(bf16x8*)(KNb + (size_t)tok * 512 + col) = v; }
};

struct EpiOut {
  static constexpr bool staged = false;
  const float *xa, *xb;
  float* out;
  bool dry;
  bf16_t* hb;
  float* ssq;
};

template <int CTRL> __device__ __forceinline__ float dpp_z(float v) {
  return __int_as_float(__builtin_amdgcn_update_dpp(0, __float_as_int(v), CTRL, 0xf, 0xf, true));
}
__device__ __forceinline__ float scan16(float v, int c, int lane) {
  v += dpp_z<0x111>(v);
  v += dpp_z<0x112>(v);
  v += dpp_z<0x114>(v);
  v += dpp_z<0x118>(v);
  return v;
}

__device__ __forceinline__ float logsig_fast(float x) { return fminf(x, 0.f) - __logf(1.f + __expf(-fabsf(x))); }

__device__ void gla_intra_item(const Params& p, int li, int item, char* smem, bool dry = false) {
  const int tid = otid(), lane = tid & 63, w = tid >> 6, c = lane & 15, g = lane >> 4;
  const int ci = item >> 2, h = item & 3;
  const int tokc = ci * 64;
  const float qscale = 0.08838834764831845f;
  bf16_t* sQe = (bf16_t*)smem;
  bf16_t* sKd = sQe + 64 * 136;
  bf16_t* sA = sKd + 64 * 136;
  us4 q4[2][4];
  bf16_t kk[2][4][4];
#pragma unroll
  for (int dt = 0; dt < 2; ++dt)
#pragma unroll
    for (int tt = 0; tt < 4; ++tt) {
      q4[dt][tt] = *(const us4*)(p.Qb + (size_t)(tokc + 16 * tt + c) * 512 + h * 128 + 32 * w + 16 * dt + 4 * g);
#pragma unroll
      for (int j = 0; j < 4; ++j)
        kk[dt][tt][j] = p.Kt[(size_t)(h * 128 + 32 * w + 16 * dt + 4 * g + j) * T_TOK + tokc + 16 * tt + c];
    }
  __syncthreads();
#pragma unroll
  for (int dir = 0; dir < 2; ++dir) {
    bf16_t* QEd = (dir || dry) ? p.QEb : p.Qb;
    bf16_t* KdTd = (dir || dry) ? p.KdTb : p.Kt;
    bf16x8 aup[2];
    float bias[2][4];
#pragma unroll
    for (int dt = 0; dt < 2; ++dt) {
      aup[dt] = zero8();
      if (g < 2) aup[dt] = *(const bf16x8*)(p.AupT + ((size_t)(li * 2 + dir) * 512 + h * 128 + 32 * w + 16 * dt + c) * 32 + 8 * g);
#pragma unroll
      for (int j = 0; j < 4; ++j) bias[dt][j] = p.e_a_bias[(li * 2 + dir) * 512 + h * 128 + 32 * w + 16 * dt + 4 * g + j];
    }
    f32x4 la[2][4];
#pragma unroll
    for (int tt = 0; tt < 4; ++tt) {
      bf16x8 lrf = zero8();
      if (g < 2) lrf = *(const bf16x8*)(p.LRb + (size_t)(tokc + 16 * tt + c) * 32 + dir * 16 + 8 * g);
#pragma unroll
      for (int dt = 0; dt < 2; ++dt) la[dt][tt] = mfma16(aup[dt], lrf, zero4());
    }
#pragma unroll
    for (int dt = 0; dt < 2; ++dt)
#pragma unroll
      for (int tt = 0; tt < 4; ++tt)
#pragma unroll
        for (int j = 0; j < 4; ++j) la[dt][tt][j] = logsig_fast(la[dt][tt][j] + bias[dt][j]) * (1.f / 16.f);
    f32x4 P[2][4];
    float tot[2][4];
#pragma unroll
    for (int dt = 0; dt < 2; ++dt)
#pragma unroll
      for (int j = 0; j < 4; ++j) {
        float carry = 0.f;
#pragma unroll
        for (int tt = 0; tt < 4; ++tt) {
          float v = scan16(la[dt][tt][j], c, lane) + carry;
          P[dt][tt][j] = v;
          carry = dpp_f<0x15F>(v);
        }
        tot[dt][j] = carry;
      }
#pragma unroll
    for (int dt = 0; dt < 2; ++dt)
#pragma unroll
      for (int tt = 0; tt < 4; ++tt) {
        us4 qo, ko;
#pragma unroll
        for (int j = 0; j < 4; ++j) {
          const float b = (dir == 0) ? P[dt][tt][j] : (tot[dt][j] - P[dt][tt][j] + la[dt][tt][j]);
          qo[j] = f2bf(bf2f(q4[dt][tt][j]) * __expf(b) * qscale);
          ko[j] = f2bf(bf2f(kk[dt][tt][j]) * __expf(-b));
        }
        *(us4*)(QEd + (size_t)(tokc + 16 * tt + c) * 512 + h * 128 + 32 * w + 16 * dt + 4 * g) = qo;
        *(us4*)(sQe + (16 * tt + c) * 136 + 32 * w + 16 * dt + 4 * g) = qo;
        *(us4*)(sKd + (16 * tt + c) * 136 + 32 * w + 16 * dt + 4 * g) = ko;
      }
    if (c == 0) {
#pragma unroll
      for (int dt = 0; dt < 2; ++dt)
#pragma unroll
        for (int j = 0; j < 4; ++j)
          p.EB[(size_t)(dir * 1280 + ci) * 512 + h * 128 + 32 * w + 16 * dt + 4 * g + j] = __expf(tot[dt][j]);
    }
    __syncthreads();
#pragma unroll
    for (int i = 0; i < 4; ++i) {
      const int id = tid + 256 * i;
      const int d = id & 127, c8 = id >> 7;
      bf16x8 v;
#pragma unroll
      for (int e = 0; e < 8; ++e) v[e] = (short)sKd[(8 * c8 + e) * 136 + d];
      *(bf16x8*)(KdTd + (size_t)(h * 128 + d) * T_TOK + tokc + 8 * c8) = v;
    }
    f32x4 accA[4];
#pragma unroll
    for (int jt = 0; jt < 4; ++jt) accA[jt] = zero4();
#pragma unroll
    for (int ks = 0; ks < 4; ++ks) {
      bf16x8 aq = *(const bf16x8*)(sQe + (16 * w + c) * 136 + 32 * ks + 8 * g);
#pragma unroll
      for (int jt = 0; jt < 4; ++jt) {
        bf16x8 bk = *(const bf16x8*)(sKd + (16 * jt + c) * 136 + 32 * ks + 8 * g);
        accA[jt] = mfma16(aq, bk, accA[jt]);
      }
    }
#pragma unroll
    for (int jt = 0; jt < 4; ++jt)
#pragma unroll
      for (int j = 0; j < 4; ++j) {
        const int i = 16 * w + 4 * g + j, jj = 16 * jt + c;
        const bool keep = (dir == 0) ? (jj <= i) : (jj > i);
        sA[dir * 64 * 72 + i * 72 + jj] = f2bf(keep ? accA[jt][j] : 0.f);
      }
    __syncthreads();
  }
  bf16x8 af[2][2];
#pragma unroll
  for (int dir = 0; dir < 2; ++dir)
#pragma unroll
    for (int k2 = 0; k2 < 2; ++k2) af[dir][k2] = *(const bf16x8*)(sA + dir * 64 * 72 + (16 * w + c) * 72 + 32 * k2 + 8 * g);
  bf16_t* sO = (bf16_t*)smem;
#pragma unroll 4
  for (int vt = 0; vt < 16; ++vt) {
    f32x4 a = zero4();
#pragma unroll
    for (int k2 = 0; k2 < 2; ++k2) {
      bf16x8 vfr = *(const bf16x8*)(p.VtE + (size_t)(h * 256 + 16 * vt + c) * T_TOK + tokc + 32 * k2 + 8 * g);
      a = mfma16(af[0][k2], vfr, a);
      a = mfma16(af[1][k2], vfr, a);
    }
#pragma unroll
    for (int j = 0; j < 4; ++j) sO[(16 * w + 4 * g + j) * 264 + 16 * vt + c] = f2bf(a[j]);
  }
  __syncthreads();
#pragma unroll
  for (int i = 0; i < 8; ++i) {
    const int id = tid + 256 * i;
    const int row = id >> 5, c8 = id & 31;
    *(bf16x8*)(p.TMP + (size_t)(tokc + row) * 1024 + h * 256 + 8 * c8) = *(const bf16x8*)(sO + row * 264 + 8 * c8);
  }
}

__device__ __forceinline__ void lds_barrier() { asm volatile("s_waitcnt lgkmcnt(0)\n\ts_barrier" ::: "memory"); }

struct GlaRegs {
  bf16x8 aq[4];
  bf16x8 vf[2][2];
  bf16x8 kf[2][2];
  float eb[2];
  unsigned told[2][4];
};

template <int DIR>
__device__ __forceinline__ void gla_chain_load(const Params& p, int h, int sl, int tokc, int w, int c, int g, GlaRegs& r) {
  const bf16_t* QE = DIR ? p.QEb : p.Qb;
  const bf16_t* KdT = DIR ? p.KdTb : p.Kt;
#pragma unroll
  for (int ks = 0; ks < 4; ++ks) r.aq[ks] = *(const bf16x8*)(QE + (size_t)(tokc + 16 * w + c) * 512 + h * 128 + 32 * ks + 8 * g);
#pragma unroll
  for (int vt = 0; vt < 2; ++vt)
#pragma unroll
    for (int k2 = 0; k2 < 2; ++k2)
      r.vf[vt][k2] = *(const bf16x8*)(p.VtE + (size_t)(h * 256 + sl * 32 + 16 * vt + c) * T_TOK + tokc + 32 * k2 + 8 * g);
#pragma unroll
  for (int dt = 0; dt < 2; ++dt) {
#pragma unroll
    for (int k2 = 0; k2 < 2; ++k2)
      r.kf[dt][k2] = *(const bf16x8*)(KdT + (size_t)(h * 128 + 32 * w + 16 * dt + c) * T_TOK + tokc + 32 * k2 + 8 * g);
    r.eb[dt] = p.EB[(size_t)(DIR * 1280 + (tokc >> 6)) * 512 + h * 128 + 32 * w + 16 * dt + c];
  }
#pragma unroll
  for (int vt = 0; vt < 2; ++vt)
#pragma unroll
    for (int j = 0; j < 4; ++j) r.told[vt][j] = p.TMP[(size_t)(tokc + 16 * w + 4 * g + j) * 1024 + h * 256 + sl * 32 + 16 * vt + c];
}

__device__ __forceinline__ void gla_chain_compute(const Params& p, int h, int sl, int tokc, int w, int c, int g, const GlaRegs& r,
                                                  f32x4 (&S)[2][2], bf16_t* sSt, bool dry, bool reload) {
  unsigned told[2][4];
#pragma unroll
  for (int vt = 0; vt < 2; ++vt)
#pragma unroll
    for (int j = 0; j < 4; ++j) told[vt][j] = r.told[vt][j];
  if (reload) {
#pragma unroll
    for (int vt = 0; vt < 2; ++vt)
#pragma unroll
      for (int j = 0; j < 4; ++j) told[vt][j] = p.TMP[(size_t)(tokc + 16 * w + 4 * g + j) * 1024 + h * 256 + sl * 32 + 16 * vt + c];
  }
#pragma unroll
  for (int vt = 0; vt < 2; ++vt)
#pragma unroll
    for (int dt = 0; dt < 2; ++dt)
#pragma unroll
      for (int j = 0; j < 4; ++j) sSt[(16 * vt + 4 * g + j) * 136 + 32 * w + 16 * dt + c] = f2bf(S[vt][dt][j]);
  lds_barrier();
  f32x4 o[2];
  o[0] = zero4(); o[1] = zero4();
#pragma unroll
  for (int ks = 0; ks < 4; ++ks)
#pragma unroll
    for (int vt = 0; vt < 2; ++vt) {
      bf16x8 sf = *(const bf16x8*)(sSt + (16 * vt + c) * 136 + 32 * ks + 8 * g);
      o[vt] = mfma16(r.aq[ks], sf, o[vt]);
    }
#pragma unroll
  for (int dt = 0; dt < 2; ++dt)
#pragma unroll
    for (int vt = 0; vt < 2; ++vt) {
      f32x4 a = S[vt][dt];
#pragma unroll
      for (int k2 = 0; k2 < 2; ++k2) a = mfma16(r.vf[vt][k2], r.kf[dt][k2], a);
      S[vt][dt] = a * r.eb[dt];
    }
#pragma unroll
  for (int vt = 0; vt < 2; ++vt)
#pragma unroll
    for (int j = 0; j < 4; ++j)
      if (!dry) p.TMP[(size_t)(tokc + 16 * w + 4 * g + j) * 1024 + h * 256 + sl * 32 + 16 * vt + c] = f2bf(bf2f((bf16_t)told[vt][j]) + o[vt][j]);
}

__device__ void gla_chain_item(const Params& p, int li, int item, char* smem, bool dry = false) {
  const int tid = otid(), lane = tid & 63, w = tid >> 6, c = lane & 15, g = lane >> 4;
  const int xr = item >> 3;
  const int pair = (item & 7) + 8 * (xr >> 3), sl = xr & 7;
  const int s = pair < 32 ? 4 + (pair >> 2) : ((pair - 32) >> 2);
  const int h = pair & 3;
  const int tok0 = s < 4 ? s * 4096 : T_P + (s - 4) * 8192;
  const int len = s < 4 ? 4096 : 8192;
  const int N = len / 64;
  bf16_t* sSt0 = (bf16_t*)smem;
  bf16_t* sSt1 = sSt0 + 32 * 136;
  f32x4 Sf[2][2], Sb[2][2];
#pragma unroll
  for (int a = 0; a < 2; ++a)
#pragma unroll
    for (int b = 0; b < 2; ++b) { Sf[a][b] = zero4(); Sb[a][b] = zero4(); }
  GlaRegs rf, rb;
  __syncthreads();
  gla_chain_load<0>(p, h, sl, tok0, w, c, g, rf);
  for (int step = 0; step < N; ++step) {
    const int tf = tok0 + step * 64, tb = tok0 + (N - 1 - step) * 64;
    gla_chain_load<1>(p, h, sl, tb, w, c, g, rb);
    gla_chain_compute(p, h, sl, tf, w, c, g, rf, Sf, sSt0, dry, step == (N >> 1));
    if (step + 1 < N) gla_chain_load<0>(p, h, sl, tf + 64, w, c, g, rf);
    gla_chain_compute(p, h, sl, tb, w, c, g, rb, Sb, sSt1, dry, false);
  }
}

__device__ void pool_item(const Params& p, int li, int item, char* smem, bool dry = false) {
  const int tid = otid(), lane = tid & 63, w = tid >> 6, c = lane & 15, g = lane >> 4;
  const int gi = item & 3;
  const int tile = item >> 2;
  const int tokc = tile * 64;
  const int pos0 = seq_pos(tokc);
  const int len = tokc < T_P ? 4096 : 8192;
  float* sU = (float*)smem;
  bf16_t* sP = (bf16_t*)(sU + 80 * 128);
  __syncthreads();
  for (int idx = tid; idx < 80 * 128; idx += 256) {
    int r = idx >> 7, ch = idx & 127;
    int pos = pos0 - 8 + r;
    float v = 0.f;
    if (pos >= 0 && pos < len) v = bf2f(p.PUb[(long)(tokc - 8 + r) * 512 + gi * 128 + ch]);
    sU[idx] = v;
  }
  __syncthreads();
  {
    const int ch = tid & 127, th = tid >> 7;
    const int half = 1 << gi;
    for (int t = th * 32; t < th * 32 + 32; ++t) {
      int pos = pos0 + t;
      int lo = max(pos - half, 0), hi = min(pos + half, len);
      float s = 0.f;
      for (int q = lo; q < hi; ++q) s += sU[(q - pos0 + 8) * 128 + ch];
      float pooled = s / (float)(hi - lo) - sU[(t + 8) * 128 + ch];
      sP[t * 136 + ch] = f2bf(pooled);
    }
  }
  __syncthreads();
  f32x4 acc[8];
#pragma unroll
  for (int dt = 0; dt < 8; ++dt) acc[dt] = zero4();
  const bf16_t* PW = p.PoolWT + (long)(li * 4 + gi) * 128 * 128;
#pragma unroll
  for (int ks = 0; ks < 4; ++ks) {
    bf16x8 af = *(const bf16x8*)(sP + (16 * w + c) * 136 + 32 * ks + 8 * g);
#pragma unroll
    for (int dt = 0; dt < 8; ++dt) {
      bf16x8 bw = *(const bf16x8*)(PW + (long)(16 * dt + c) * 128 + 32 * ks + 8 * g);
      acc[dt] = mfma16(af, bw, acc[dt]);
    }
  }
#pragma unroll
  for (int dt = 0; dt < 8; ++dt) {
    const int d = gi * 128 + 16 * dt + c;
    const float sc = p.e_pool_scale[li * 512 + d];
#pragma unroll
    for (int j = 0; j < 4; ++j) {
      const long addr = (long)(tokc + 16 * w + 4 * g + j) * 512 + d;
      float gt = bf2f(p.PGb[addr]);
      if (!dry) p.PGb[addr] = f2bf(acc[dt][j] * sc * siluf_(gt));
    }
  }
}

__device__ void ml_intra_item(const Params& p, int li, int item, char* smem) {
  const int tid = otid(), lane = tid & 63, w = tid >> 6, c = lane & 15, g = lane >> 4;
  const int ci = item >> 2, h = item & 3;
  const int tokc = ci * 64;
  const float kscale = 0.08838834764831845f;
  bf16_t* sA = (bf16_t*)smem;
  float* sBv = (float*)(sA + 2 * 64 * 72);
  float* sCB = sBv + 128;
  __syncthreads();
  if (w < 2) {
    const int dir = w;
    const float bi = p.o_if_bias[li * 16 + dir * 4 + h];
    const float bff = p.o_if_bias[li * 16 + 8 + dir * 4 + h];
    const float* mf = p.MIF + (size_t)(tokc + lane) * 16;
    const float liv = mf[dir * 4 + h] + bi;
    const float lfv = logsig_fast(mf[8 + dir * 4 + h] + bff);
    float ps = lfv;
#pragma unroll
    for (int d = 1; d < 64; d <<= 1) {
      float t = bperm(lane - d, ps);
      if (lane >= d) ps += t;
    }
    const float total = __int_as_float(__builtin_amdgcn_readlane(__float_as_int(ps), 63));
    const float b = (dir == 0) ? ps : (total - ps + lfv);
    const float cB = liv - b;
    sBv[dir * 64 + lane] = b;
    sCB[dir * 64 + lane] = cB;
    const size_t so = (size_t)(dir * 4 + h) * T_TOK + tokc + lane;
    p.EBI[so] = __expf(b);
    p.WKg[so] = __expf(total + cB) * kscale;
    if (lane == 0) p.DEC[(dir * 4 + h) * 1280 + ci] = __expf(total);
  }
  f32x4 accA[4];
#pragma unroll
  for (int jt = 0; jt < 4; ++jt) accA[jt] = zero4();
#pragma unroll
  for (int ks = 0; ks < 4; ++ks) {
    bf16x8 aq = *(const bf16x8*)(p.MQb + (size_t)(tokc + 16 * w + c) * 512 + h * 128 + 32 * ks + 8 * g);
#pragma unroll
    for (int jt = 0; jt < 4; ++jt) {
      bf16x8 bk = *(const bf16x8*)(p.MKb + (size_t)(tokc + 16 * jt + c) * 512 + h * 128 + 32 * ks + 8 * g);
      accA[jt] = mfma16(aq, bk, accA[jt]);
    }
  }
  __syncthreads();
#pragma unroll
  for (int dir = 0; dir < 2; ++dir)
#pragma unroll
    for (int jt = 0; jt < 4; ++jt)
#pragma unroll
      for (int j = 0; j < 4; ++j) {
        const int i = 16 * w + 4 * g + j, jj = 16 * jt + c;
        const bool keep = (dir == 0) ? (jj <= i) : (jj > i);
        const float sv = keep ? accA[jt][j] * kscale * __expf(sBv[dir * 64 + i] + sCB[dir * 64 + jj]) : 0.f;
        sA[dir * 64 * 72 + i * 72 + jj] = f2bf(sv);
      }
  __syncthreads();
  bf16x8 ones = zero8();
  if (c == 0) {
#pragma unroll
    for (int e = 0; e < 8; ++e) ones[e] = (short)0x3F80;
  }
#pragma unroll
  for (int dir = 0; dir < 2; ++dir) {
    bf16_t* NUMI = dir ? p.NUMIb : p.NUMIf;
    bf16x8 af[2];
#pragma unroll
    for (int k2 = 0; k2 < 2; ++k2) af[k2] = *(const bf16x8*)(sA + dir * 64 * 72 + (16 * w + c) * 72 + 32 * k2 + 8 * g);
    f32x4 dn = zero4();
    dn = mfma16(af[0], ones, dn);
    dn = mfma16(af[1], ones, dn);
    if (c == 0) {
#pragma unroll
      for (int j = 0; j < 4; ++j) p.DENI[(size_t)(dir * 4 + h) * T_TOK + tokc + 16 * w + 4 * g + j] = dn[j];
    }
    bf16_t* sO = sA + 2 * 64 * 72 + 512;
#pragma unroll 4
    for (int vt = 0; vt < 8; ++vt) {
      f32x4 a = zero4();
#pragma unroll
      for (int k2 = 0; k2 < 2; ++k2) {
        bf16x8 vfr = *(const bf16x8*)(p.MVt + (size_t)(h * 128 + 16 * vt + c) * T_TOK + tokc + 32 * k2 + 8 * g);
        a = mfma16(af[k2], vfr, a);
      }
#pragma unroll
      for (int j = 0; j < 4; ++j) sO[(16 * w + 4 * g + j) * 136 + 16 * vt + c] = f2bf(a[j]);
    }
    __syncthreads();
#pragma unroll
    for (int i = 0; i < 4; ++i) {
      const int id = tid + 256 * i;
      const int row = id >> 4, c8 = id & 15;
      *(bf16x8*)(NUMI + (size_t)(tokc + row) * 512 + h * 128 + 8 * c8) = *(const bf16x8*)(sO + row * 136 + 8 * c8);
    }
    __syncthreads();
  }
}

struct MlRegs {
  bf16x8 aq[4];
  bf16x8 vf[2];
  bf16x8 kf[2][2];
  f32x4 wk[2][2];
  f32x4 ebi, deni;
  float dec;
  unsigned numi[4];
};

template <int DIR>
__device__ __forceinline__ void ml_chain_load(const Params& p, int h, int sl, int tokc, int w, int c, int g, MlRegs& r) {
#pragma unroll
  for (int ks = 0; ks < 4; ++ks) r.aq[ks] = *(const bf16x8*)(p.MQb + (size_t)(tokc + 16 * w + c) * 512 + h * 128 + 32 * ks + 8 * g);
#pragma unroll
  for (int k2 = 0; k2 < 2; ++k2)
    r.vf[k2] = *(const bf16x8*)(p.MVt + (size_t)(h * 128 + sl * 16 + c) * T_TOK + tokc + 32 * k2 + 8 * g);
#pragma unroll
  for (int dt = 0; dt < 2; ++dt)
#pragma unroll
    for (int k2 = 0; k2 < 2; ++k2)
      r.kf[dt][k2] = *(const bf16x8*)(p.MKt + (size_t)(h * 128 + 32 * w + 16 * dt + c) * T_TOK + tokc + 32 * k2 + 8 * g);
  const size_t so = (size_t)(DIR * 4 + h) * T_TOK + tokc;
#pragma unroll
  for (int k2 = 0; k2 < 2; ++k2) {
    r.wk[k2][0] = *(const f32x4*)(p.WKg + so + 32 * k2 + 8 * g);
    r.wk[k2][1] = *(const f32x4*)(p.WKg + so + 32 * k2 + 8 * g + 4);
  }
  r.ebi = *(const f32x4*)(p.EBI + so + 16 * w + 4 * g);
  r.deni = *(const f32x4*)(p.DENI + so + 16 * w + 4 * g);
  r.dec = p.DEC[(DIR * 4 + h) * 1280 + (tokc >> 6)];
  const bf16_t* NUMI = DIR ? p.NUMIb : p.NUMIf;
#pragma unroll
  for (int j = 0; j < 4; ++j) r.numi[j] = NUMI[(size_t)(tokc + 16 * w + 4 * g + j) * 512 + h * 128 + sl * 16 + c];
}

template <int DIR>
__device__ __forceinline__ void ml_chain_compute(const Params& p, int h, int sl, int tokc, int lane, int w, int c, int g, const MlRegs& r,
                                                 f32x4 (&C)[2][2], bf16_t* sCt, bool dry) {
  bf16_t* NUMI = DIR ? p.NUMIb : p.NUMIf;
  unsigned numi[4];
#pragma unroll
  for (int j = 0; j < 4; ++j) numi[j] = r.numi[j];
#pragma unroll
  for (int vt = 0; vt < 2; ++vt)
#pragma unroll
    for (int dt = 0; dt < 2; ++dt)
#pragma unroll
      for (int j = 0; j < 4; ++j) sCt[(16 * vt + 4 * g + j) * 136 + 32 * w + 16 * dt + c] = f2bf(C[vt][dt][j]);
  bf16x8 vfw[2][2];
#pragma unroll
  for (int k2 = 0; k2 < 2; ++k2) {
    float wv[8];
#pragma unroll
    for (int e = 0; e < 4; ++e) { wv[e] = r.wk[k2][0][e]; wv[4 + e] = r.wk[k2][1][e]; }
#pragma unroll
    for (int e = 0; e < 8; ++e) vfw[0][k2][e] = (short)f2bf(bf2f((bf16_t)r.vf[k2][e]) * wv[e]);
#pragma unroll
    for (int e = 0; e < 8; ++e) vfw[1][k2][e] = (c == 0) ? (short)f2bf(wv[e]) : (short)0;
  }
  lds_barrier();
  f32x4 o2[2];
  o2[0] = zero4(); o2[1] = zero4();
#pragma unroll
  for (int ks = 0; ks < 4; ++ks)
#pragma unroll
    for (int vt = 0; vt < 2; ++vt) {
      bf16x8 cf = *(const bf16x8*)(sCt + (16 * vt + c) * 136 + 32 * ks + 8 * g);
      o2[vt] = mfma16(r.aq[ks], cf, o2[vt]);
    }
#pragma unroll
  for (int dt = 0; dt < 2; ++dt)
#pragma unroll
    for (int vt = 0; vt < 2; ++vt) {
      f32x4 a = C[vt][dt] * r.dec;
#pragma unroll
      for (int k2 = 0; k2 < 2; ++k2) a = mfma16(vfw[vt][k2], r.kf[dt][k2], a);
      C[vt][dt] = a;
    }
#pragma unroll
  for (int j = 0; j < 4; ++j) {
    const float e = r.ebi[j];
    float den = e * o2[1][j];
    den = dpp_f<0x150>(den) + r.deni[j];
    const float inv = 1.f / fmaxf(fabsf(den), 1.f);
    const float hv = (bf2f((bf16_t)numi[j]) + e * o2[0][j]) * inv;
    if (!dry) NUMI[(size_t)(tokc + 16 * w + 4 * g + j) * 512 + h * 128 + sl * 16 + c] = f2bf(hv);
  }
}

template <int DIR>
__device__ __forceinline__ void ml_chain_run(const Params& p, int h, int sl, int tok0, int N, int lane, int w, int c, int g, bf16_t* sCt0, bool dry) {
  bf16_t* sCt1 = sCt0 + 32 * 136;
  f32x4 C[2][2];
#pragma unroll
  for (int a = 0; a < 2; ++a)
#pragma unroll
    for (int b = 0; b < 2; ++b) C[a][b] = zero4();
  MlRegs r0, r1;
  ml_chain_load<DIR>(p, h, sl, tok0 + (DIR ? N - 1 : 0) * 64, w, c, g, r0);
  for (int n = 0; n < N; n += 2) {
    const int c0 = DIR ? N - 1 - n : n;
    const int c1 = DIR ? N - 2 - n : n + 1;
    const int n2 = min(n + 2, N - 1);
    const int c2 = DIR ? N - 1 - n2 : n2;
    ml_chain_load<DIR>(p, h, sl, tok0 + c1 * 64, w, c, g, r1);
    ml_chain_compute<DIR>(p, h, sl, tok0 + c0 * 64, lane, w, c, g, r0, C, sCt0, dry);
    ml_chain_load<DIR>(p, h, sl, tok0 + c2 * 64, w, c, g, r0);
    ml_chain_compute<DIR>(p, h, sl, tok0 + c1 * 64, lane, w, c, g, r1, C, sCt1, dry);
  }
}

__device__ void ml_chain_item(const Params& p, int li, int item, char* smem, bool dry = false) {
  const int tid = otid(), lane = tid & 63, w = tid >> 6, c = lane & 15, g = lane >> 4;
  int pair, within;
  if (item < 512) { const int r = item >> 3; pair = (item & 7) + 8 * (r >> 4); within = r & 15; }
  else { const int it = item - 512; const int r = it >> 3; pair = 32 + (it & 7) + 8 * (r >> 4); within = r & 15; }
  const int sl = within & 7, dir = within >> 3;
  const int s = pair < 32 ? 4 + (pair >> 2) : ((pair - 32) >> 2);
  const int h = pair & 3;
  const int tok0 = s < 4 ? s * 4096 : T_P + (s - 4) * 8192;
  const int N = (s < 4 ? 4096 : 8192) / 64;
  bf16_t* sCt0 = (bf16_t*)smem;
  __syncthreads();
  if (dir == 0) ml_chain_run<0>(p, h, sl, tok0, N, lane, w, c, g, sCt0, dry);
  else ml_chain_run<1>(p, h, sl, tok0, N, lane, w, c, g, sCt0, dry);
}

#define ATTN_GLOAD(KT)                                                                              \
  {                                                                                                 \
    const long kb = tok0 + (KT) * 64;                                                               \
    rk0 = *(const bf16x8*)(p.KNb + (kb + (tid >> 3)) * 512 + head * 64 + 8 * (tid & 7));            \
    rk1 = *(const bf16x8*)(p.KNb + (kb + 32 + (tid >> 3)) * 512 + head * 64 + 8 * (tid & 7));       \
    rkr = *(const bf16x8*)(p.KRb + (kb + (tid >> 2)) * 32 + 8 * (tid & 3));                          \
    rv0 = *(const bf16x8*)(p.VtA + (long)(head * 64 + (tid >> 3)) * T_TOK + kb + 8 * (tid & 7));     \
    rv1 = *(const bf16x8*)(p.VtA + (long)(head * 64 + 32 + (tid >> 3)) * T_TOK + kb + 8 * (tid & 7)); \
  }
__device__ void attn_item(const Params& p, int item, char* smem, bool dry = false) {
  const int tid = otid(), lane = tid & 63, w = tid >> 6, c = lane & 15, g = lane >> 4;
  int s, head, qb;
  {
    const int x = item / 320, t = item % 320;
    if (t < 256) { const int pair = x + 8 * (t >> 5); qb = t & 31; s = 4 + (pair >> 3); head = pair & 7; }
    else { const int t2 = t - 256; const int pair = x + 8 * (t2 >> 4); qb = t2 & 15; s = pair >> 3; head = pair & 7; }
  }
  const int tok0 = s < 4 ? s * 4096 : T_P + (s - 4) * 8192;
  const int len = s < 4 ? 4096 : 8192;
  const int nkv = len / 64;
  constexpr int KV_STAGE = 64 * 104 + 64 * 72;
  bf16_t* sKV = (bf16_t*)smem;
  const int qrow0 = tok0 + qb * 256 + 64 * w;
  bf16_t* sQr = sKV + 2 * KV_STAGE;
  bf16x8 qf[4][2];
#pragma unroll
  for (int nt = 0; nt < 4; ++nt) {
#pragma unroll
    for (int ks = 0; ks < 2; ++ks)
      qf[nt][ks] = *(const bf16x8*)(p.Qa + (long)(qrow0 + 16 * nt + c) * 768 + head * 96 + 32 * ks + 8 * g);
    bf16x8 qr = *(const bf16x8*)(p.Qa + (long)(qrow0 + 16 * nt + c) * 768 + head * 96 + 64 + 8 * g);
    *(bf16x8*)(sQr + ((w * 4 + nt) * 64 + lane) * 8) = qr;
  }
  f32x4 ot[4][4];
#pragma unroll
  for (int vt = 0; vt < 4; ++vt)
#pragma unroll
    for (int nt = 0; nt < 4; ++nt) ot[vt][nt] = zero4();
  float mrun[4] = {-64.f, -64.f, -64.f, -64.f}, lrun[4] = {0.f, 0.f, 0.f, 0.f};
  bf16x8 rk0, rk1, rkr, rv0, rv1;
#define ATTN_LSTORE(STG)                                                                    \
  {                                                                                         \
    bf16_t* sK_ = sKV + (STG) * KV_STAGE;                                                   \
    bf16_t* sVt_ = sK_ + 64 * 104;                                                          \
    *(bf16x8*)(sK_ + (tid >> 3) * 104 + 8 * (tid & 7)) = rk0;                               \
    *(bf16x8*)(sK_ + (32 + (tid >> 3)) * 104 + 8 * (tid & 7)) = rk1;                        \
    *(bf16x8*)(sK_ + (tid >> 2) * 104 + 64 + 8 * (tid & 3)) = rkr;                          \
    *(bf16x8*)(sVt_ + (tid >> 3) * 72 + 8 * (tid & 7)) = rv0;                               \
    *(bf16x8*)(sVt_ + (32 + (tid >> 3)) * 72 + 8 * (tid & 7)) = rv1;                        \
  }
  ATTN_GLOAD(0)
  __syncthreads();
  ATTN_LSTORE(0)
  __syncthreads();
  for (int kt = 0; kt < nkv; ++kt) {
    const bf16_t* sK = sKV + (kt & 1) * KV_STAGE;
    const bf16_t* sVt = sK + 64 * 104;
    ATTN_GLOAD(min(kt + 1, nkv - 1))
#pragma unroll 1
    for (int half = 0; half < 2; ++half) {
      f32x4 st[2][4];
#pragma unroll
      for (int k4 = 0; k4 < 2; ++k4)
#pragma unroll
        for (int nt = 0; nt < 4; ++nt) {
          const float nm = -mrun[nt];
          f32x4 iv = {nm, nm, nm, nm};
          st[k4][nt] = iv;
        }
#pragma unroll
      for (int ks = 0; ks < 2; ++ks)
#pragma unroll
        for (int k4 = 0; k4 < 2; ++k4) {
          bf16x8 kf = *(const bf16x8*)(sK + (32 * half + 16 * k4 + c) * 104 + 32 * ks + 8 * g);
#pragma unroll
          for (int nt = 0; nt < 4; ++nt) st[k4][nt] = mfma16(kf, qf[nt][ks], st[k4][nt]);
        }
      {
        bf16x8 kr0 = *(const bf16x8*)(sK + (32 * half + c) * 104 + 64 + 8 * g);
        bf16x8 kr1 = *(const bf16x8*)(sK + (32 * half + 16 + c) * 104 + 64 + 8 * g);
#pragma unroll
        for (int nt = 0; nt < 4; ++nt) {
          bf16x8 qr = *(const bf16x8*)(sQr + ((w * 4 + nt) * 64 + lane) * 8);
          st[0][nt] = mfma16(kr0, qr, st[0][nt]);
          st[1][nt] = mfma16(kr1, qr, st[1][nt]);
        }
      }
      __builtin_amdgcn_sched_barrier(0);
      bf16x8 pb[4];
#pragma unroll
      for (int nt = 0; nt < 4; ++nt) {
        float mx = -1e30f;
#pragma unroll
        for (int k4 = 0; k4 < 2; ++k4)
#pragma unroll
          for (int j = 0; j < 4; ++j) mx = fmaxf(mx, st[k4][nt][j]);
        mx = rowmax4(mx);
        if (__builtin_amdgcn_ballot_w64(mx > 0.f) != 0ull) {
          const float d = fmaxf(mx, 0.f);
          const float alpha = __builtin_amdgcn_exp2f(-d);
          mrun[nt] += d;
          lrun[nt] *= alpha;
#pragma unroll
          for (int vt = 0; vt < 4; ++vt) ot[vt][nt] = ot[vt][nt] * alpha;
#pragma unroll
          for (int k4 = 0; k4 < 2; ++k4)
#pragma unroll
            for (int j = 0; j < 4; ++j) st[k4][nt][j] -= d;
        }
        float psum = 0.f;
#pragma unroll
        for (int k4 = 0; k4 < 2; ++k4)
#pragma unroll
          for (int j = 0; j < 4; ++j) {
            float pv = __builtin_amdgcn_exp2f(st[k4][nt][j]);
            st[k4][nt][j] = pv;
            psum += pv;
          }
        lrun[nt] += psum;
        typedef __attribute__((ext_vector_type(4))) unsigned u32x4;
        u32x4 pk;
        pk[0] = pk2bf(st[0][nt][0], st[0][nt][1]);
        pk[1] = pk2bf(st[0][nt][2], st[0][nt][3]);
        pk[2] = pk2bf(st[1][nt][0], st[1][nt][1]);
        pk[3] = pk2bf(st[1][nt][2], st[1][nt][3]);
        pb[nt] = __builtin_bit_cast(bf16x8, pk);
      }
      __builtin_amdgcn_sched_barrier(0);
#pragma unroll
      for (int vt = 0; vt < 4; ++vt) {
        us4 lo = *(const us4*)(sVt + (16 * vt + c) * 72 + 32 * half + 4 * g);
        us4 hi = *(const us4*)(sVt + (16 * vt + c) * 72 + 32 * half + 16 + 4 * g);
        bf16x8 av;
#pragma unroll
        for (int e = 0; e < 4; ++e) { av[e] = (short)lo[e]; av[4 + e] = (short)hi[e]; }
#pragma unroll
        for (int nt = 0; nt < 4; ++nt) ot[vt][nt] = mfma16(av, pb[nt], ot[vt][nt]);
      }
    }
    if (kt + 1 < nkv) ATTN_LSTORE((kt + 1) & 1)
    __syncthreads();
  }
#undef ATTN_LSTORE
#pragma unroll
  for (int nt = 0; nt < 4; ++nt) {
    float lt = lrun[nt];
    lt += sxor(lt, 16, lane);
    lt += sxor(lt, 32, lane);
    const float inv = 1.f / lt;
    const long tok = qrow0 + 16 * nt + c;
#pragma unroll
    for (int vt = 0; vt < 4; ++vt) {
      bf16_t* gp = p.MGb + tok * 512 + head * 64 + 16 * vt + 4 * g;
      us4 gt = *(const us4*)gp;
      us4 o;
#pragma unroll
      for (int j = 0; j < 4; ++j) o[j] = f2bf(ot[vt][nt][j] * inv * siluf_(bf2f(gt[j])));
      if (!dry) *(us4*)gp = o;
    }
  }
}

__device__ void phase_gla_combine(const Params& p, int li, bool dry = false) {
  const int tid_ = otid(); const int lane = tid_ & 63, w = tid_ >> 6;
  for (int tok = blockIdx.x * 4 + w; tok < T_TOK; tok += gridDim.x * 4) {
    const bf16_t* tp = p.TMP + (long)tok * 1024 + 16 * lane;
    bf16_t* gp = p.Gb + (long)tok * 1024 + 16 * lane;
    bf16x8 o0 = *(const bf16x8*)tp, o1 = *(const bf16x8*)(tp + 8);
    bf16x8 g0 = *(const bf16x8*)gp, g1 = *(const bf16x8*)(gp + 8);
    float ov[16], gv[16];
#pragma unroll
    for (int e = 0; e < 8; ++e) {
      ov[e] = bf2f((bf16_t)o0[e]); ov[8 + e] = bf2f((bf16_t)o1[e]);
      gv[e] = bf2f((bf16_t)g0[e]); gv[8 + e] = bf2f((bf16_t)g1[e]);
    }
    float ss = 0.f;
#pragma unroll
    for (int e = 0; e < 16; ++e) ss += ov[e] * ov[e];
    ss += sxor(ss, 1, lane); ss += sxor(ss, 2, lane); ss += sxor(ss, 4, lane); ss += sxor(ss, 8, lane);
    const float rs = rsqrtf(ss * (1.f / 256.f) + EPS);
    const float* ng = p.e_gla_norm_g + li * 256 + ((16 * lane) & 255);
    bf16x8 r0, r1;
#pragma unroll
    for (int e = 0; e < 8; ++e) {
      r0[e] = (short)f2bf(ov[e] * rs * ng[e] * siluf_(gv[e]));
      r1[e] = (short)f2bf(ov[8 + e] * rs * ng[8 + e] * siluf_(gv[8 + e]));
    }
    if (!dry) { *(bf16x8*)gp = r0;
    *(bf16x8*)(gp + 8) = r1; }
  }
}

__device__ void phase_ml_combine(const Params& p, int li, bool dry = false) {
  const int tid_ = otid(); const int lane = tid_ & 63, w = tid_ >> 6;
  for (int tok = blockIdx.x * 4 + w; tok < T_TOK; tok += gridDim.x * 4) {
    const long off = (long)tok * 512 + 8 * lane;
    bf16x8 hv = *(const bf16x8*)(p.NUMIf + off);
    bf16x8 hb = *(const bf16x8*)(p.NUMIb + off);
    bf16x8 mo = *(const bf16x8*)(p.MOb + off);
    bf16x8 mg = *(const bf16x8*)(p.MLGb + off);
    float hf[8];
    float ss = 0.f;
#pragma unroll
    for (int e = 0; e < 8; ++e) { hf[e] = bf2f((bf16_t)hv[e]) + bf2f((bf16_t)hb[e]); ss += hf[e] * hf[e]; }
    ss += sxor(ss, 1, lane); ss += sxor(ss, 2, lane); ss += sxor(ss, 4, lane); ss += sxor(ss, 8, lane);
    const float rs = rsqrtf(ss * (1.f / 128.f) + EPS);
    const float* ng = p.o_ml_norm_g + li * 128 + ((8 * lane) & 127);
    bf16x8 r;
#pragma unroll
    for (int e = 0; e < 8; ++e)
      r[e] = (short)f2bf(hf[e] * rs * ng[e] * sigmoidf_(bf2f((bf16_t)mo[e])) * siluf_(bf2f((bf16_t)mg[e])));
    if (!dry) *(bf16x8*)(p.MLGb + off) = r;
  }
}

__device__ void phase_final(const Params& p, bool dry = false) {
  const int tid_ = otid(); const int lane = tid_ & 63, w = tid_ >> 6;
  for (int tok = blockIdx.x * 4 + w; tok < T_TOK; tok += gridDim.x * 4) {
    float* xp = p.out + (long)tok * DM;
    float4 v[4];
    float ss = 0.f;
#pragma unroll
    for (int i = 0; i < 4; ++i) {
      v[i] = *(const float4*)(xp + 4 * lane + 256 * i);
      ss += v[i].x * v[i].x + v[i].y * v[i].y + v[i].z * v[i].z + v[i].w * v[i].w;
    }
    ss = wave_sum(ss);
    const float rs = rsqrtf(ss * (1.f / 1024.f) + EPS);
#pragma unroll
    for (int i = 0; i < 4; ++i) {
      float4 gq = *(const float4*)(p.final_norm_g + 4 * lane + 256 * i);
      float4 o;
      o.x = v[i].x * rs * gq.x; o.y = v[i].y * rs * gq.y; o.z = v[i].z * rs * gq.z; o.w = v[i].w * rs * gq.w;
      if (!dry) *(float4*)(xp + 4 * lane + 256 * i) = o;
    }
  }
}

__device__ void run_phase(const Params& p, int ph, char* smem) {
  if (ph == 0) { if (PH_ON(0)) phase_prep(p, smem); return; }
  if (ph == NPHASE - 1) { if (PROBE_B) phase_final(p, true); if (PH_ON(11)) phase_final(p); return; }
  const int q = ph - 1;
  const int layer = (q < 5) ? 0 : (q < 12) ? 1 : (q < 17) ? 2 : 3;
  const int sub = (q < 5) ? q : (q < 12) ? q - 5 : (q < 17) ? q - 12 : q - 17;
  const int li = layer >> 1;
  const float* xa = (layer == 0) ? p.x_prompt : p.out;
  const float* xb = (layer == 0) ? p.x_sample : p.out + (long)T_P * DM;
  if ((layer & 1) == 0) {
    if (sub == 0) {
      EpiEvenIn e{p.Qb, p.Kt, p.VtE, p.Gb, p.LRb, p.PUb, p.PGb};
      if (PH_ON(1)) gemm_phase<3, 8>(T_TOK / 128, NE_PAD / 256, DM, p.WinE + (long)li * NE_PAD * DM, p.SSQ, nullptr, p.TMP, DM, DM, p.TMP, DM, e, smem);
    } else if (sub == 1) {
      for (int item = blockIdx.x; item < 5120; item += gridDim.x)
        if (PH_ON(2)) gla_intra_item(p, li, item, smem);
    } else if (sub == 2) {
      __shared__ int s_pitem;
      for (int item = blockIdx.x; item < 384; item += gridDim.x) { if (PH_ON(2)) gla_chain_item(p, li, item, smem, false); }
      for (;;) {
        __syncthreads();
        if (threadIdx.x == 0) s_pitem = atomicAdd(p.counters + 16 + li, 1);
        __syncthreads();
        const int item = s_pitem;
        if (item >= 5120) break;
        if (PH_ON(3)) pool_item(p, li, item, smem);
      }
    } else if (sub == 3) {
      if (PROBE_B) phase_gla_combine(p, li, true);
      if (PH_ON(4)) phase_gla_combine(p, li);
    } else {
      EpiOut e{xa, xb, p.out, false, p.NUMIf, p.SSQ};
      if (PH_ON(5)) gemm_phase<1, 8>(T_TOK / 128, DM / 256, 1536, p.WoutE + (long)li * DM * 1536, nullptr, nullptr, p.Gb, 1024, 1024, p.PGb, 512, e, smem);
    }
  } else {
    if (sub == 0) {
      EpiOddIn e{p.CQb, p.CKVb, p.KRb, p.MGb, p.MQb, p.MKb, p.MKt, p.MVt, p.MOb, p.MLGb, p.MIF};
      if (PH_ON(6)) gemm_phase<3, 8>(T_TOK / 128, NO_PAD / 256, DM, p.WinO + (long)li * NO_PAD * DM, p.SSQ, nullptr, p.NUMIf, DM, DM, p.NUMIf, DM, e, smem);
    } else if (sub == 1) {
      for (int rep = 0; rep < 1 + PROBE_A; ++rep)
      for (int item = blockIdx.x; item < 5120; item += gridDim.x)
        if (PH_ON(8)) ml_intra_item(p, li, item, smem);
    } else if (sub == 2) {
      for (int item = blockIdx.x; item < 768; item += gridDim.x)
        if (PH_ON(8)) ml_chain_item(p, li, item, smem, false);
    } else if (sub == 3) {
      if (PROBE_B) phase_ml_combine(p, li, true);
      if (PH_ON(10)) phase_ml_combine(p, li);
    } else if (sub == 4) {
      EpiQUp eq{p.Qa};
      if (PH_ON(7)) gemm_phase<2, 4>(T_TOK / 128, 768 / 128, 384, p.QupT + (long)li * 768 * 384, nullptr, nullptr, p.CQb, 384, 384, p.CQb, 384, eq, smem);
      EpiKVUp ek{p.KNb, p.VtA};
      if (PH_ON(7)) gemm_phase<2, 4>(T_TOK / 128, 1024 / 128, 256, p.KVupT + (long)li * 1024 * 256, nullptr, nullptr, p.CKVb, 256, 256, p.CKVb, 256, ek, smem);
    } else if (sub == 5) {
      __shared__ int s_item;
      for (;;) {
        __syncthreads();
        if (threadIdx.x == 0) s_item = atomicAdd(p.counters + li * 8 + (blockIdx.x & 7), 1);
        __syncthreads();
        const int item = s_item;
        if (item >= 320) break;
        if (PH_ON(9)) attn_item(p, (blockIdx.x & 7) * 320 + item, smem);
      }
    } else {
      EpiOut e{xa, xb, p.out, false, (layer == 3) ? nullptr : p.TMP, p.SSQ};
      if (PH_ON(5)) gemm_phase<1, 8>(T_TOK / 128, DM / 256, 1024, p.WoutO + (long)li * DM * 1024, nullptr, nullptr, p.MGb, 512, 512, p.MLGb, 512, e, smem);
    }
  }
}

__global__ void __launch_bounds__(256, 2) mega_kernel(Params p) {
  extern __shared__ __attribute__((aligned(16))) char smem[];
  cg::grid_group grid = cg::this_grid();
  __shared__ uint4 xb_words;
  if (threadIdx.x == 0) xb_words = make_uint4(0u, 0u, 0u, 0u);
  __syncthreads();
  XcdBarrier xb = xcd_barrier_post(p.bar, (volatile LAS unsigned*)&xb_words);
  for (int ph = p.ph_lo; ph < p.ph_hi; ++ph) {
    if (ph > p.ph_lo) {
      if (ph == p.ph_lo + 1) grid.sync();
      else xcd_barrier(xb);
    }
    run_phase(p, ph, smem);
  }
}

extern "C" void kernel_launch(void* const* d_in, const int* in_sizes, int n_in, void* d_out, int out_size, void* d_ws,
                              size_t ws_size, hipStream_t stream) {
  static int grid_blocks = 0;
  if (!grid_blocks) {
    int dev = 0, cus = 0, per_cu = 0;
    hipGetDevice(&dev);
    hipDeviceGetAttribute(&cus, hipDeviceAttributeMultiprocessorCount, dev);
    hipFuncSetAttribute((const void*)mega_kernel, hipFuncAttributeMaxDynamicSharedMemorySize, LDS_BYTES);
    hipOccupancyMaxActiveBlocksPerMultiprocessor(&per_cu, (const void*)mega_kernel, 256, LDS_BYTES);
    if (per_cu < 1) per_cu = 1;
    if (per_cu > 2) per_cu = 2;
    grid_blocks = cus * per_cu;
    fprintf(stderr, "kernel_launch: cus %d per_cu %d grid %d ws %zu\n", cus, per_cu, grid_blocks, ws_size);
  }
  Params p{};
  const float** pin = (const float**)&p;
  for (int i = 0; i < 19; ++i) pin[i] = (const float*)d_in[i];
  p.out = (float*)d_out;
  char* ws = (char*)d_ws;
  size_t off = 0;
  auto take = [&](size_t bytes) { char* r = ws + off; off += (bytes + 255) & ~(size_t)255; return r; };
  p.WinE = (bf16_t*)take((size_t)2 * NE_PAD * DM * 2);
  p.WinO = (bf16_t*)take((size_t)2 * NO_PAD * DM * 2);
  p.WoutE = (bf16_t*)take((size_t)2 * DM * 1536 * 2);
  p.WoutO = (bf16_t*)take((size_t)2 * DM * 1024 * 2);
  p.QupT = (bf16_t*)take((size_t)2 * 768 * 384 * 2);
  p.KVupT = (bf16_t*)take((size_t)2 * 1024 * 256 * 2);
  p.PoolWT = (bf16_t*)take((size_t)2 * 4 * 128 * 128 * 2);
  p.AupT = (bf16_t*)take((size_t)2 * 2 * 512 * 32 * 2);
  p.counters = (int*)take(256);
  p.bar = (unsigned*)take((size_t)XCD_BAR_WORDS * 4);
  p.SSQ = (float*)take((size_t)T_TOK * 8 * 4);
  const size_t act0 = off;
  const size_t T = T_TOK;
  p.Gb = (bf16_t*)take(T * 1024 * 2);
  p.PGb = (bf16_t*)take(T * 512 * 2);
  p.Qb = (bf16_t*)take(T * 512 * 2);
  p.Kt = (bf16_t*)take(T * 512 * 2);
  p.QEb = (bf16_t*)take(T * 512 * 2);
  p.KdTb = (bf16_t*)take(T * 512 * 2);
  p.EB = (float*)take((size_t)2 * 1280 * 512 * 4);
  p.VtE = (bf16_t*)take(T * 1024 * 2);
  p.LRb = (bf16_t*)take(T * 32 * 2);
  p.PUb = (bf16_t*)take(T * 512 * 2);
  p.TMP = (bf16_t*)take(T * 1024 * 2);
  const size_t even_end = off;
  off = act0;
  p.MGb = (bf16_t*)take(T * 512 * 2);
  p.MLGb = (bf16_t*)take(T * 512 * 2);
  p.CQb = (bf16_t*)take(T * 384 * 2);
  p.CKVb = (bf16_t*)take(T * 256 * 2);
  p.KRb = (bf16_t*)take(T * 32 * 2);
  const size_t r2 = off;
  p.MQb = (bf16_t*)take(T * 512 * 2);
  p.MKb = (bf16_t*)take(T * 512 * 2);
  p.MKt = (bf16_t*)take(T * 512 * 2);
  p.MVt = (bf16_t*)take(T * 512 * 2);
  p.MOb = (bf16_t*)take(T * 512 * 2);
  p.NUMIf = (bf16_t*)take(T * 512 * 2);
  p.NUMIb = (bf16_t*)take(T * 512 * 2);
  p.MIF = (float*)take(T * 16 * 4);
  p.EBI = (float*)take(T * 8 * 4);
  p.WKg = (float*)take(T * 8 * 4);
  p.DENI = (float*)take(T * 8 * 4);
  p.DEC = (float*)take((size_t)8 * 1280 * 4);
  const size_t r2_end = off;
  off = r2;
  p.Qa = (bf16_t*)take(T * 768 * 2);
  p.KNb = (bf16_t*)take(T * 512 * 2);
  p.VtA = (bf16_t*)take(T * 512 * 2);
  if (off < r2_end) off = r2_end;
  const size_t odd_end = off;
  const size_t need = even_end > odd_end ? even_end : odd_end;
  if (need > ws_size) {
    fprintf(stderr, "kernel_launch: workspace too small: need %zu have %zu\n", need, ws_size);
    return;
  }
  hipMemsetAsync(p.bar, 0, (size_t)XCD_BAR_WORDS * 4, stream);
#if SINGLE_LAUNCH
  p.ph_lo = 0;
  p.ph_hi = NPHASE;
  void* args[] = {&p};
  hipError_t e = hipLaunchCooperativeKernel((const void*)mega_kernel, dim3(grid_blocks), dim3(256), args, LDS_BYTES, stream);
  if (e != hipSuccess) fprintf(stderr, "cooperative launch failed: %s (grid %d)\n", hipGetErrorString(e), grid_blocks);
#else
  for (int ph = 0; ph < NPHASE; ++ph) {
    p.ph_lo = ph;
    p.ph_hi = ph + 1;
    hipLaunchKernelGGL(mega_kernel, dim3(grid_blocks), dim3(256), LDS_BYTES, stream, p);
  }
#endif
}
```

```cpp
#include <hip/hip_runtime.h>
#include <hip/hip_cooperative_groups.h>
#include <cstdio>
namespace cg = cooperative_groups;

#ifndef SINGLE_LAUNCH
#define SINGLE_LAUNCH 1
#endif
#ifndef PHMASK
#define PHMASK 0xFFFF
#endif
#define PH_ON(b) ((PHMASK >> (b)) & 1)
#ifndef PROBE_GEMM
#define PROBE_GEMM 0
#endif
#ifndef PROBE_ATTN
#define PROBE_ATTN 0
#endif
#ifndef PROBE_CHAIN
#define PROBE_CHAIN 0
#endif
#ifndef PROBE_A
#define PROBE_A 0
#endif
#ifndef PROBE_B
#define PROBE_B 0
#endif
#ifndef PROBE_MLCHAIN
#define PROBE_MLCHAIN 0
#endif

typedef unsigned short bf16_t;
typedef __attribute__((ext_vector_type(8))) short bf16x8;
typedef __attribute__((ext_vector_type(4))) float f32x4;
typedef __attribute__((ext_vector_type(4))) unsigned short us4;

constexpr int T_TOK = 81920;
constexpr int T_P = 16384;
constexpr int DM = 1024;
constexpr int NE = 4128, NE_PAD = 4352;
constexpr int NO = 3760, NO_PAD = 3840;
constexpr float EPS = 1e-6f;
constexpr int NPHASE = 24;
constexpr int LDS_BYTES = 72 * 1024;

struct Params {
  const float *x_prompt, *x_sample, *norm_g, *final_norm_g, *e_w_in, *e_a_up, *e_a_bias, *e_gla_norm_g,
      *e_pool_w, *e_pool_scale, *e_w_out, *o_w_in, *o_q_norm_g, *o_q_up, *o_kv_norm_g, *o_kv_up, *o_if_bias,
      *o_ml_norm_g, *o_w_out;
  float* out;
  bf16_t *WinE, *WinO, *WoutE, *WoutO, *QupT, *KVupT, *PoolWT, *AupT;
  int* counters;
  unsigned* bar;
  float* SSQ;
  bf16_t *Qb, *Kt, *VtE, *Gb, *LRb, *PUb, *PGb, *TMP, *QEb, *KdTb;
  float* EB;
  bf16_t *CQb, *CKVb, *KRb, *MGb, *MQb, *MKb, *MKt, *MVt, *MOb, *MLGb, *NUMIf, *NUMIb, *Qa, *KNb, *VtA;
  float *MIF, *EBI, *WKg, *DENI, *DEC;
  int ph_lo, ph_hi;
};

typedef __bf16 hbf2 __attribute__((ext_vector_type(2)));
typedef float hf2 __attribute__((ext_vector_type(2)));
__device__ __forceinline__ bf16_t f2bf(float f) {
  __bf16 b = (__bf16)f;
  return __builtin_bit_cast(bf16_t, b);
}
__device__ __forceinline__ unsigned pk2bf(float a, float b) {
  hf2 v = {a, b};
  hbf2 r = __builtin_convertvector(v, hbf2);
  return __builtin_bit_cast(unsigned, r);
}
__device__ __forceinline__ float bf2f(bf16_t b) { return __uint_as_float(((unsigned)b) << 16); }
__device__ __forceinline__ f32x4 mfma16(bf16x8 a, bf16x8 b, f32x4 c) {
  return __builtin_amdgcn_mfma_f32_16x16x32_bf16(a, b, c, 0, 0, 0);
}
__device__ __forceinline__ float logsigmoidf_(float x) { return fminf(x, 0.f) - log1pf(__expf(-fabsf(x))); }
__device__ __forceinline__ float siluf_(float x) { return x / (1.f + __expf(-x)); }
__device__ __forceinline__ float sigmoidf_(float x) { return 1.f / (1.f + __expf(-x)); }
__device__ __forceinline__ int otid() { int t = threadIdx.x; asm volatile("" : "+v"(t)); return t; }
__device__ __forceinline__ float bperm(int srclane, float v) { return __int_as_float(__builtin_amdgcn_ds_bpermute(srclane << 2, __float_as_int(v))); }
__device__ __forceinline__ float sxor(float v, int m, int lane) { return bperm(lane ^ m, v); }
typedef unsigned u32x2_t __attribute__((ext_vector_type(2)));
__device__ __forceinline__ float rowmax4(float v) {
  u32x2_t r = __builtin_amdgcn_permlane16_swap(__float_as_uint(v), __float_as_uint(v), false, false);
  v = fmaxf(__uint_as_float(r[0]), __uint_as_float(r[1]));
  r = __builtin_amdgcn_permlane32_swap(__float_as_uint(v), __float_as_uint(v), false, false);
  return fmaxf(__uint_as_float(r[0]), __uint_as_float(r[1]));
}
template <int CTRL> __device__ __forceinline__ float dpp_f(float v) {
  return __int_as_float(__builtin_amdgcn_update_dpp(0, __float_as_int(v), CTRL, 0xf, 0xf, false));
}
__device__ __forceinline__ float wave_sum(float v) {
  v += dpp_f<0x128>(v);
  v += dpp_f<0x124>(v);
  v += dpp_f<0x122>(v);
  v += dpp_f<0x121>(v);
  u32x2_t r = __builtin_amdgcn_permlane16_swap(__float_as_uint(v), __float_as_uint(v), false, false);
  v = __uint_as_float(r[0]) + __uint_as_float(r[1]);
  r = __builtin_amdgcn_permlane32_swap(__float_as_uint(v), __float_as_uint(v), false, false);
  return __uint_as_float(r[0]) + __uint_as_float(r[1]);
}
__device__ __forceinline__ bf16x8 zero8() { bf16x8 z = {0, 0, 0, 0, 0, 0, 0, 0}; return z; }
__device__ __forceinline__ f32x4 zero4() { f32x4 z = {0.f, 0.f, 0.f, 0.f}; return z; }

__device__ __forceinline__ int seq_pos(int tok) { return tok < T_P ? (tok & 4095) : ((tok - T_P) & 8191); }
__device__ __forceinline__ const float* xrow(const float* xa, const float* xb, int tok) {
  return tok < T_P ? xa + (long)tok * DM : xb + (long)(tok - T_P) * DM;
}


#define XB_TMO      128
#define XB_XCNT(j)  (256  + 64 * (j))
#define XB_XSUB(j)  (1280 + 64 * (j))
#define XB_XGEN(j)  (2304 + 64 * (j))
#define XB_TOP      3328
#define XB_TOPGEN   3392
#define XCD_BAR_WORDS 3456
#define XB_SPIN_CAP (1u << 22)
#define LAS __attribute__((address_space(3)))
__device__ __forceinline__ unsigned xb_ld(unsigned* p) { return __hip_atomic_load(p, __ATOMIC_RELAXED, __HIP_MEMORY_SCOPE_AGENT); }
__device__ __forceinline__ unsigned xb_add(unsigned* p, unsigned v) { return __hip_atomic_fetch_add(p, v, __ATOMIC_RELAXED, __HIP_MEMORY_SCOPE_AGENT); }
__device__ __forceinline__ unsigned xb_xcc_id() { return (unsigned)__builtin_amdgcn_s_getreg((3 << 11) | 20) & 0xFu; }
#define XB_SPIN(cond, bar) do { unsigned _sp = 0; while (cond) { __builtin_amdgcn_s_sleep(1); \
    if ((++_sp & 255u) == 0u) { if (xb_ld(&(bar)[XB_TMO])) break; if (_sp > XB_SPIN_CAP) { atomicAdd(&(bar)[XB_TMO], 1u); break; } } } } while (0)
struct XcdBarrier { unsigned* bar; unsigned x; volatile LAS unsigned* st; };
__device__ __forceinline__ XcdBarrier xcd_barrier_post(unsigned* bar, volatile LAS unsigned* st) {
  XcdBarrier b; b.bar = bar; b.x = xb_xcc_id(); b.st = st;
  if (threadIdx.x == 0) (void)xb_add(&bar[XB_XCNT(b.x)], 1u);
  return b;
}
__device__ __forceinline__ void xcd_barrier_complete(unsigned* bar, unsigned x, unsigned& nloc, unsigned& nx) {
  const unsigned G = gridDim.x * gridDim.y * gridDim.z;
  unsigned sum, cnt, mine, sp = 0u;
  for (;;) {
    sum = 0u; cnt = 0u; mine = 0u;
#pragma unroll
    for (unsigned j = 0; j < 16; ++j) { const unsigned cc = xb_ld(&bar[XB_XCNT(j)]); sum += cc; cnt += (cc > 0u) ? 1u : 0u; mine = (j == x) ? cc : mine; }
    if (sum == G) break;
    __builtin_amdgcn_s_sleep(1);
    if ((++sp & 255u) == 0u) { if (xb_ld(&bar[XB_TMO])) break; if (sp > XB_SPIN_CAP) { atomicAdd(&bar[XB_TMO], 1u); break; } }
  }
  nloc = mine > 0u ? mine : 1u; nx = cnt > 0u ? cnt : 1u;
}
__device__ __forceinline__ void xcd_barrier(const XcdBarrier& b) {
  asm volatile("s_waitcnt vmcnt(0)" ::: "memory");
  __syncthreads();
  if (threadIdx.x == 0) {
    unsigned* bar = b.bar;
    __builtin_amdgcn_s_waitcnt(0);
    unsigned nloc = b.st[0], nx = b.st[1];
    if (nloc == 0u) { xcd_barrier_complete(bar, b.x, nloc, nx); b.st[0] = nloc; b.st[1] = nx; }
    const unsigned old = xb_add(&bar[XB_XSUB(b.x)], 1u);
    const unsigned gen = old / nloc;
    if (old + 1u == (gen + 1u) * nloc) {
      __builtin_amdgcn_fence(__ATOMIC_RELEASE, "agent");
      asm volatile("s_waitcnt vmcnt(0)" ::: "memory");
      const unsigned og = xb_add(&bar[XB_TOP], 1u);
      const unsigned tg = og / nx;
      if (og + 1u == (tg + 1u) * nx) xb_add(&bar[XB_TOPGEN], 1u);
      else XB_SPIN(xb_ld(&bar[XB_TOPGEN]) == tg, bar);
      __builtin_amdgcn_fence(__ATOMIC_ACQUIRE, "agent");
      xb_add(&bar[XB_XGEN(b.x)], 1u);
      asm volatile("s_waitcnt vmcnt(0)" ::: "memory");
    } else {
      XB_SPIN(xb_ld(&bar[XB_XGEN(b.x)]) == gen, bar);
      __builtin_amdgcn_fence(__ATOMIC_ACQUIRE, "agent");
      asm volatile("s_waitcnt vmcnt(0)" ::: "memory");
    }
  }
  __syncthreads();
}

__device__ __forceinline__ int colmap(int mode, int n) {
  if (mode == 1) {
    if (n < 512) return 2208 + n;
    if (n < 1024) return 1696 + (n - 512);
    if (n < 1408) return n - 1024;
    if (n < 1664) return 384 + (n - 1408);
    if (n < 2176) return 672 + (n - 1664);
    if (n < 2688) return 1184 + (n - 2176);
    if (n < 3200) return 2720 + (n - 2688);
    if (n < 3712) return 3248 + (n - 3200);
    if (n < 3744) return 640 + (n - 3712);
    return 3232 + (n - 3744);
  }
  if (mode == 2) {
    if (n < 512) return (n >> 6) * 96 + (n & 63);
    const int r = n - 512;
    return (r >> 5) * 96 + 64 + (r & 31);
  }
  if (mode == 3) {
    if (n < 512) return (n >> 6) * 128 + (n & 63);
    const int r = n - 512;
    return (r >> 6) * 128 + 64 + (r & 63);
  }
  return n;
}

__device__ void prep_weight(const float* __restrict__ W, int K, int N, int Npad, const float* __restrict__ gsc,
                            bf16_t* __restrict__ out, char* smem, int mode = 0, int Nsrc_ = 0) {
  const int Nsrc = Nsrc_ ? Nsrc_ : N;
  const int tid = otid();
  float* sT = (float*)smem;
  const int tn = Npad >> 6, tk = K >> 6;
  for (int tile = blockIdx.x; tile < tn * tk; tile += gridDim.x) {
    const int n0 = (tile / tk) << 6, k0 = (tile % tk) << 6;
    __syncthreads();
#pragma unroll 4
    for (int i = 0; i < 16; ++i) {
      const int idx = tid + 256 * i;
      const int kk = idx >> 6, nn = idx & 63;
      float v = 0.f;
      if (n0 + nn < N) {
        v = W[(size_t)(k0 + kk) * Nsrc + colmap(mode, n0 + nn)];
        if (gsc) v *= gsc[k0 + kk];
      }
      sT[nn * 65 + kk] = v;
    }
    __syncthreads();
#pragma unroll 4
    for (int i = 0; i < 16; ++i) {
      const int idx = tid + 256 * i;
      const int nn = idx >> 6, kk = idx & 63;
      out[(size_t)(n0 + nn) * K + k0 + kk] = f2bf(sT[nn * 65 + kk]);
    }
  }
}

__device__ void phase_prep(const Params& p, char* smem) {
  long gtid = (long)blockIdx.x * 256 + otid();
  long gsize = (long)gridDim.x * 256;
  for (int l = 0; l < 2; ++l) {
    prep_weight(p.e_w_in + (long)l * DM * NE, DM, NE, NE_PAD, p.norm_g + (2 * l) * DM, p.WinE + (long)l * NE_PAD * DM, smem);
    prep_weight(p.o_w_in + (long)l * DM * 3760, DM, NO, NO_PAD, p.norm_g + (2 * l + 1) * DM, p.WinO + (long)l * NO_PAD * DM, smem, 1, 3760);
    prep_weight(p.e_w_out + (long)l * 1536 * DM, 1536, DM, DM, nullptr, p.WoutE + (long)l * DM * 1536, smem);
    prep_weight(p.o_w_out + (long)l * 1024 * DM, 1024, DM, DM, nullptr, p.WoutO + (long)l * DM * 1024, smem);
    prep_weight(p.o_q_up + (long)l * 384 * 768, 384, 768, 768, p.o_q_norm_g + l * 384, p.QupT + (long)l * 768 * 384, smem, 2);
    prep_weight(p.o_kv_up + (long)l * 256 * 1024, 256, 1024, 1024, p.o_kv_norm_g + l * 256, p.KVupT + (long)l * 1024 * 256, smem, 3);
    for (int gi = 0; gi < 4; ++gi)
      prep_weight(p.e_pool_w + (long)(l * 4 + gi) * 128 * 128, 128, 128, 128, nullptr, p.PoolWT + (long)(l * 4 + gi) * 128 * 128, smem);
    for (long idx = gtid; idx < 2 * 512 * 32; idx += gsize) {
      int r = (int)(idx & 31);
      int d = (int)((idx >> 5) & 511);
      int dir = (int)(idx >> 14);
      float v = (r < 16) ? p.e_a_up[((long)(l * 2 + dir) * 16 + r) * 512 + d] : 0.f;
      p.AupT[((long)(l * 2 + dir) * 512 + d) * 32 + r] = f2bf(v);
    }
  }
  if (gtid < 32) p.counters[gtid] = 0;
  {
    const int tid_ = otid();
    const int lane = tid_ & 63, w = tid_ >> 6;
    for (int tok = blockIdx.x * 4 + w; tok < T_TOK; tok += gridDim.x * 4) {
      const float* xp = xrow(p.x_prompt, p.x_sample, tok) + 16 * lane;
      float ssv = 0.f;
      unsigned pk[8];
#pragma unroll
      for (int i = 0; i < 4; ++i) {
        const f32x4 v = *(const f32x4*)(xp + 4 * i);
        ssv += v[0] * v[0] + v[1] * v[1] + v[2] * v[2] + v[3] * v[3];
        pk[2 * i] = pk2bf(v[0], v[1]);
        pk[2 * i + 1] = pk2bf(v[2], v[3]);
      }
      uint4 o0, o1;
      o0.x = pk[0]; o0.y = pk[1]; o0.z = pk[2]; o0.w = pk[3];
      o1.x = pk[4]; o1.y = pk[5]; o1.z = pk[6]; o1.w = pk[7];
      *(uint4*)(p.TMP + (size_t)tok * DM + 16 * lane) = o0;
      *(uint4*)(p.TMP + (size_t)tok * DM + 16 * lane + 8) = o1;
      ssv = wave_sum(ssv);
      if (lane < 8) p.SSQ[(size_t)tok * 8 + lane] = (lane == 0) ? ssv : 0.f;
    }
  }
}

constexpr int G_LD = 40;
constexpr int G_BUF = (128 + 256) * G_LD;

template <int AMODE, int NI, class Epi>
__device__ __forceinline__ void gemm_phase(int Mtiles, int Ntiles, int K, const bf16_t* __restrict__ Bt, const float* ssq, const float* unused_,
                           const bf16_t* A1, int ld1, int K1, const bf16_t* A2, int ld2, const Epi& epi, char* smem) {
  bf16_t* sbase = (bf16_t*)smem;
  float* sR = (float*)(smem + 70144);
  const int tid = otid(), lane = tid & 63, w = tid >> 6, c = lane & 15, g = lane >> 4;
  const int wm = w >> 1, wn = w & 1;
  const int nk = K / 32;
  const int xcd = blockIdx.x & 7, lb0 = blockIdx.x >> 3, nlb = gridDim.x >> 3;
  const int mper = Mtiles >> 3;
  for (int lt = lb0; lt < mper * Ntiles; lt += nlb) {
    const int mt = xcd * mper + lt / Ntiles, nt = lt % Ntiles;
    constexpr int BN = 32 * NI;
    const int m0 = mt * 128, n0 = nt * BN;
    f32x4 acc[4][NI];
#pragma unroll
    for (int i = 0; i < 4; ++i)
#pragma unroll
      for (int j = 0; j < NI; ++j) acc[i][j] = zero4();
    float ss[2] = {0.f, 0.f};
    bf16x8 ra0[2], ra1[2];
    bf16x8 rb0[NI / 2], rb1[NI / 2];
    const unsigned boff = (unsigned)(tid >> 2) * K + 8 * (tid & 3);
    const bf16_t* bbase = Bt + (size_t)n0 * K;
#define G_LOAD(RA, RB, KT)                                                                          \
  {                                                                                                 \
    const int k0_ = (KT) * 32;                                                                      \
    const bf16_t* base_;                                                                            \
    int ld_;                                                                                        \
    if (k0_ < K1) { base_ = A1 + (size_t)m0 * ld1 + k0_; ld_ = ld1; }                               \
    else { base_ = A2 + (size_t)m0 * ld2 + (k0_ - K1); ld_ = ld2; }                                 \
    _Pragma("unroll") for (int i = 0; i < 2; ++i)                                                   \
      RA[i] = *(const bf16x8*)(base_ + (unsigned)((tid >> 2) + 64 * i) * ld_ + 8 * (tid & 3));      \
    _Pragma("unroll") for (int i = 0; i < NI / 2; ++i)                                              \
      RB[i] = *(const bf16x8*)(bbase + k0_ + boff + (unsigned)(64 * i) * K);                        \
  }
#define G_STORE(RA, RB, BUF)                                                                        \
  {                                                                                                 \
    bf16_t* sA_ = sbase + (BUF) * G_BUF;                                                            \
    bf16_t* sB_ = sA_ + 128 * G_LD;                                                                 \
    _Pragma("unroll") for (int i = 0; i < 2; ++i) {                                                 \
      bf16x8 v = RA[i];                                                                             \
      if constexpr (AMODE == 2) {                                                                   \
        _Pragma("unroll") for (int e = 0; e < 8; ++e) {                                             \
          float f = bf2f((bf16_t)v[e]);                                                             \
          ss[i] += f * f;                                                                           \
        }                                                                                           \
      }                                                                                             \
      *(bf16x8*)(sA_ + ((tid >> 2) + 64 * i) * G_LD + 8 * (tid & 3)) = v;                           \
    }                                                                                               \
    _Pragma("unroll") for (int i = 0; i < NI / 2; ++i)                                              \
      *(bf16x8*)(sB_ + ((tid >> 2) + 64 * i) * G_LD + 8 * (tid & 3)) = RB[i];                       \
  }
#define G_COMPUTE(BUF)     \
  {                                                                                                 \
    const bf16_t* sA_ = sbase + (BUF) * G_BUF;                                                      \
    const bf16_t* sB_ = sA_ + 128 * G_LD;                                                           \
    bf16x8 af[4];                                                                                   \
    _Pragma("unroll") for (int mi = 0; mi < 4; ++mi)                                                \
      af[mi] = *(const bf16x8*)(sA_ + (wm * 64 + mi * 16 + c) * G_LD + g * 8);                      \
    bf16x8 bq[2];                                                                                   \
    bq[0] = *(const bf16x8*)(sB_ + (wn * (16 * NI) + c) * G_LD + g * 8);                            \
    _Pragma("unroll") for (int ni = 0; ni < NI; ++ni) {                                             \
      if (ni + 1 < NI)                                                                              \
        bq[(ni + 1) & 1] = *(const bf16x8*)(sB_ + (wn * (16 * NI) + (ni + 1) * 16 + c) * G_LD + g * 8); \
      _Pragma("unroll") for (int mi = 0; mi < 4; ++mi)                                              \
        acc[mi][ni] = (!Epi::staged) ? mfma16(bq[ni & 1], af[mi], acc[mi][ni]) : mfma16(af[mi], bq[ni & 1], acc[mi][ni]); \
    }                                                                                               \
  }
    __syncthreads();
    if constexpr (AMODE == 3) {
      if (tid < 128) {
        const f32x4 p0 = *(const f32x4*)(ssq + (size_t)(m0 + tid) * 8);
        const f32x4 p1 = *(const f32x4*)(ssq + (size_t)(m0 + tid) * 8 + 4);
        const float sv = (p0[0] + p0[1]) + (p0[2] + p0[3]) + (p1[0] + p1[1]) + (p1[2] + p1[3]);
        sR[tid] = rsqrtf(sv * (1.f / 1024.f) + EPS);
      }
    }
    G_LOAD(ra0, rb0, 0)
    G_LOAD(ra1, rb1, 1)
    G_STORE(ra0, rb0, 0)
    __syncthreads();
    for (int kt = 0; kt < nk; kt += 2) {
      G_LOAD(ra0, rb0, min(kt + 2, nk - 1))
      G_COMPUTE(0)
      G_STORE(ra1, rb1, 1)
      __syncthreads();
      G_LOAD(ra1, rb1, min(kt + 3, nk - 1))
      G_COMPUTE(1)
      if (kt + 2 < nk) G_STORE(ra0, rb0, 0)
      __syncthreads();
    }
    if constexpr (AMODE == 2) {
#pragma unroll
      for (int i = 0; i < 2; ++i) {
        float sv = ss[i];
        sv += sxor(sv, 1, lane); sv += sxor(sv, 2, lane);
        if ((tid & 3) == 0) sR[(tid >> 2) + 64 * i] = rsqrtf(sv / (float)K + EPS);
      }
      __syncthreads();
    }
    if constexpr (Epi::staged) {
      bf16_t* sT = sbase;
      const float esc = epi.scale();
      const bool both = epi.both(n0);
#pragma unroll 1
      for (int pass = 0; pass < (both ? 2 : 1); ++pass) {
      const bool tr = both ? (pass == 1) : epi.transposed(n0);
      if (pass) __syncthreads();
      if (tr) {
#pragma unroll
        for (int mi = 0; mi < 4; ++mi) {
          const int row = wm * 64 + mi * 16 + 4 * g;
          const float r0 = sR[row] * esc, r1 = sR[row + 1] * esc, r2 = sR[row + 2] * esc, r3 = sR[row + 3] * esc;
#pragma unroll
          for (int ni = 0; ni < NI; ++ni) {
            uint2 o;
            o.x = pk2bf(acc[mi][ni][0] * r0, acc[mi][ni][1] * r1);
            o.y = pk2bf(acc[mi][ni][2] * r2, acc[mi][ni][3] * r3);
            *(uint2*)(sT + (wn * (16 * NI) + ni * 16 + c) * 136 + row) = o;
          }
        }
      } else {
#pragma unroll
        for (int mi = 0; mi < 4; ++mi) {
          const int row = wm * 64 + mi * 16 + 4 * g;
          const float r0 = sR[row] * esc, r1 = sR[row + 1] * esc, r2 = sR[row + 2] * esc, r3 = sR[row + 3] * esc;
#pragma unroll
          for (int ni = 0; ni < NI; ++ni) {
            bf16_t* d = sT + row * (BN + 8) + wn * (16 * NI) + ni * 16 + c;
            d[0] = f2bf(acc[mi][ni][0] * r0);
            d[BN + 8] = f2bf(acc[mi][ni][1] * r1);
            d[2 * (BN + 8)] = f2bf(acc[mi][ni][2] * r2);
            d[3 * (BN + 8)] = f2bf(acc[mi][ni][3] * r3);
          }
        }
      }
      if (pass == 0) epi.template direct<NI>(m0, n0, wm, wn, g, c, acc, sR);
      __syncthreads();
      if (tr) {
#pragma unroll 4
        for (int i = 0; i < 2 * NI; ++i) {
          const int id = tid + 256 * i;
          const int col = id >> 4, rc = id & 15;
          bf16x8 v = *(const bf16x8*)(sT + col * 136 + 8 * rc);
          epi.store_t(m0 + 8 * rc, n0 + col, v);
        }
      } else {
#pragma unroll 4
        for (int i = 0; i < 2 * NI; ++i) {
          const int id = tid + 256 * i;
          const int row = id / (4 * NI), cc = id % (4 * NI);
          const bf16_t* sp = sT + row * (BN + 8) + 8 * cc;
          bf16x8 v = *(const bf16x8*)sp;
          epi.store_n(m0 + row, n0 + 8 * cc, v, sp);
        }
      }
      }
    } else {
      float* sF = (float*)smem;
#pragma unroll 1
      for (int half = 0; half < 2; ++half) {
        if (half) __syncthreads();
        if (wm == half) {
#pragma unroll
          for (int mi = 0; mi < 4; ++mi)
#pragma unroll
            for (int ni = 0; ni < NI; ++ni) *(f32x4*)(sF + (mi * 16 + c) * 260 + wn * (16 * NI) + ni * 16 + 4 * g) = acc[mi][ni];
        }
        __syncthreads();
#pragma unroll 4
        for (int i = 0; i < 16; ++i) {
          const int row = w * 16 + i;
          const int tok = m0 + half * 64 + row;
          const int col = n0 + 4 * lane;
          const f32x4 a = *(const f32x4*)(sF + row * 260 + 4 * lane);
          const f32x4 xo = *(const f32x4*)(xrow(epi.xa, epi.xb, tok) + col);
          f32x4 xn;
          xn[0] = xo[0] + a[0]; xn[1] = xo[1] + a[1]; xn[2] = xo[2] + a[2]; xn[3] = xo[3] + a[3];
          float sv = xn[0] * xn[0] + xn[1] * xn[1] + xn[2] * xn[2] + xn[3] * xn[3];
          sv = wave_sum(sv);
          if (!epi.dry) {
            *(f32x4*)(epi.out + (size_t)tok * DM + col) = xn;
            if (epi.hb) {
              uint2 o;
              o.x = pk2bf(xn[0], xn[1]);
              o.y = pk2bf(xn[2], xn[3]);
              *(uint2*)(epi.hb + (size_t)tok * DM + col) = o;
            }
            if (lane == 0) epi.ssq[(size_t)tok * 8 + (n0 >> 8)] = sv;
          }
        }
      }
    }
  }
#undef G_LOAD
#undef G_STORE
#undef G_COMPUTE
}

__device__ __forceinline__ void rope_cs(int pos, int i, float& co, float& si) {
  float inv = exp2f(-(float)i * (13.287712379549449f / 16.f));
  float ang = (float)pos * inv;
  float n = rintf(ang * 0.15915494309189535f);
  float r = fmaf(-n, 6.28125f, ang);
  r = fmaf(-n, 0.0019353071795864769f, r);
  float rf = r * 0.15915494309189535f;
  si = __builtin_amdgcn_sinf(rf);
  co = __builtin_amdgcn_cosf(rf);
}

__device__ __forceinline__ void rope_chunk(int pos, int i0, bf16x8 x1, bf16x8 x2, bf16x8& o1, bf16x8& o2) {
#pragma unroll
  for (int e = 0; e < 8; ++e) {
    float co, si;
    rope_cs(pos, i0 + e, co, si);
    float a = bf2f((bf16_t)x1[e]), b = bf2f((bf16_t)x2[e]);
    o1[e] = (short)f2bf(a * co - b * si);
    o2[e] = (short)f2bf(b * co + a * si);
  }
}

struct EpiEvenIn {
  static constexpr bool staged = true;
  bf16_t *Qb, *Kt, *VtE, *Gb, *LRb, *PUb, *PGb;
  __device__ float scale() const { return 1.f; }
  __device__ bool transposed(int n0) const { return n0 >= 512 && n0 < 2048; }
  __device__ bool both(int n0) const { return false; }
  template <int NI> __device__ void direct(int m0, int n0, int wm, int wn, int g, int c, f32x4 (&acc)[4][NI], const float* sR) const {}
  __device__ void store_t(int tok8, int col, bf16x8 v) const {
    if (col < 1024) *(bf16x8*)(Kt + (size_t)(col - 512) * T_TOK + tok8) = v;
    else *(bf16x8*)(VtE + (size_t)(col - 1024) * T_TOK + tok8) = v;
  }
  __device__ void store_n(int tok, int col, bf16x8 v, const bf16_t* sp) const {
    bf16_t* d;
    if (col < 512) d = Qb + (size_t)tok * 512 + col;
    else if (col < 3072) d = Gb + (size_t)tok * 1024 + (col - 2048);
    else if (col < 3104) d = LRb + (size_t)tok * 32 + (col - 3072);
    else if (col < 3616) d = PUb + (size_t)tok * 512 + (col - 3104);
    else if (col < 4128) d = PGb + (size_t)tok * 512 + (col - 3616);
    else return;
    *(bf16x8*)d = v;
  }
};

struct EpiOddIn {
  static constexpr bool staged = true;
  bf16_t *CQb, *CKVb, *KRb, *MGb, *MQb, *MKb, *MKt, *MVt, *MOb, *MLGb;
  float* MIF;
  __device__ float scale() const { return 1.f; }
  __device__ bool transposed(int n0) const { return n0 < 512; }
  __device__ bool both(int n0) const { return n0 >= 512 && n0 < 1024; }
  template <int NI> __device__ void direct(int m0, int n0, int wm, int wn, int g, int c, f32x4 (&acc)[4][NI], const float* sR) const {
    if (n0 == 3584 && wn == 1) {
#pragma unroll
      for (int mi = 0; mi < 4; ++mi)
#pragma unroll
        for (int j = 0; j < 4; ++j) {
          const int row = wm * 64 + mi * 16 + 4 * g + j;
          MIF[(size_t)(m0 + row) * 16 + c] = acc[mi][2][j] * sR[row];
        }
    }
  }
  __device__ void store_t(int tok8, int col, bf16x8 v) const {
    if (col < 512) *(bf16x8*)(MVt + (size_t)col * T_TOK + tok8) = v;
    else *(bf16x8*)(MKt + (size_t)(col - 512) * T_TOK + tok8) = v;
  }
  __device__ void store_n(int tok, int col, bf16x8 v, const bf16_t* sp) const {
    bf16_t* d;
    if (col < 1024) d = MKb + (size_t)tok * 512 + (col - 512);
    else if (col < 1408) d = CQb + (size_t)tok * 384 + (col - 1024);
    else if (col < 1664) d = CKVb + (size_t)tok * 256 + (col - 1408);
    else if (col < 2176) d = MGb + (size_t)tok * 512 + (col - 1664);
    else if (col < 2688) d = MQb + (size_t)tok * 512 + (col - 2176);
    else if (col < 3200) d = MOb + (size_t)tok * 512 + (col - 2688);
    else if (col < 3712) d = MLGb + (size_t)tok * 512 + (col - 3200);
    else if (col < 3728) {
      bf16x8 x2 = *(const bf16x8*)(sp + 16);
      bf16x8 o1, o2;
      rope_chunk(seq_pos(tok), col - 3712, v, x2, o1, o2);
      *(bf16x8*)(KRb + (size_t)tok * 32 + (col - 3712)) = o1;
      *(bf16x8*)(KRb + (size_t)tok * 32 + 16 + (col - 3712)) = o2;
      return;
    } else return;
    *(bf16x8*)d = v;
  }
};

struct EpiQUp {
  static constexpr bool staged = true;
  bf16_t* Qa;
  __device__ float scale() const { return 0.10206207261596575f * 1.4426950408889634f; }
  __device__ bool transposed(int n0) const { return false; }
  __device__ bool both(int n0) const { return false; }
  template <int NI> __device__ void direct(int m0, int n0, int wm, int wn, int g, int c, f32x4 (&acc)[4][NI], const float* sR) const {}
  __device__ void store_t(int tok8, int col, bf16x8 v) const {}
  __device__ void store_n(int tok, int col, bf16x8 v, const bf16_t* sp) const {
    if (col < 512) {
      *(bf16x8*)(Qa + (size_t)tok * 768 + (col >> 6) * 96 + (col & 63)) = v;
    } else {
      const int r = col - 512, head = r >> 5, rr = r & 31;
      if (rr < 16) {
        bf16x8 x2 = *(const bf16x8*)(sp + 16);
        bf16x8 o1, o2;
        rope_chunk(seq_pos(tok), rr, v, x2, o1, o2);
        *(bf16x8*)(Qa + (size_t)tok * 768 + head * 96 + 64 + rr) = o1;
        *(bf16x8*)(Qa + (size_t)tok * 768 + head * 96 + 80 + rr) = o2;
      }
    }
  }
};

struct EpiKVUp {
  static constexpr bool staged = true;
  bf16_t *KNb, *VtA;
  __device__ float scale() const { return 1.f; }
  __device__ bool transposed(int n0) const { return n0 >= 512; }
  __device__ bool both(int n0) const { return false; }
  template <int NI> __device__ void direct(int m0, int n0, int wm, int wn, int g, int c, f32x4 (&acc)[4][NI], const float* sR) const {}
  __device__ void store_t(int tok8, int col, bf16x8 v) const { *(bf16x8*)(VtA + (size_t)(col - 512) * T_TOK + tok8) = v; }
  __device__ void store_n(int tok, int col, bf16x8 v, const bf16_t* sp) const { *(bf16x8*)(KNb + (size_t)tok * 512 + col) = v; }
};

struct EpiOut {
  static constexpr bool staged = false;
  const float *xa, *xb;
  float* out;
  bool dry;
  bf16_t* hb;
  float* ssq;
};

template <int CTRL> __device__ __forceinline__ float dpp_z(float v) {
  return __int_as_float(__builtin_amdgcn_update_dpp(0, __float_as_int(v), CTRL, 0xf, 0xf, true));
}
__device__ __forceinline__ float scan16(float v, int c, int lane) {
  v += dpp_z<0x111>(v);
  v += dpp_z<0x112>(v);
  v += dpp_z<0x114>(v);
  v += dpp_z<0x118>(v);
  return v;
}

__device__ __forceinline__ float logsig_fast(float x) { return fminf(x, 0.f) - __logf(1.f + __expf(-fabsf(x))); }

__device__ void gla_intra_item(const Params& p, int li, int item, char* smem, bool dry = false) {
  const int tid = otid(), lane = tid & 63, w = tid >> 6, c = lane & 15, g = lane >> 4;
  const int ci = item >> 2, h = item & 3;
  const int tokc = ci * 64;
  const float qscale = 0.08838834764831845f;
  bf16_t* sQe = (bf16_t*)smem;
  bf16_t* sKd = sQe + 64 * 136;
  bf16_t* sA = sKd + 64 * 136;
  us4 q4[2][4];
  bf16_t kk[2][4][4];
#pragma unroll
  for (int dt = 0; dt < 2; ++dt)
#pragma unroll
    for (int tt = 0; tt < 4; ++tt) {
      q4[dt][tt] = *(const us4*)(p.Qb + (size_t)(tokc + 16 * tt + c) * 512 + h * 128 + 32 * w + 16 * dt + 4 * g);
#pragma unroll
      for (int j = 0; j < 4; ++j)
        kk[dt][tt][j] = p.Kt[(size_t)(h * 128 + 32 * w + 16 * dt + 4 * g + j) * T_TOK + tokc + 16 * tt + c];
    }
  __syncthreads();
#pragma unroll
  for (int dir = 0; dir < 2; ++dir) {
    bf16_t* QEd = (dir || dry) ? p.QEb : p.Qb;
    bf16_t* KdTd = (dir || dry) ? p.KdTb : p.Kt;
    bf16x8 aup[2];
    float bias[2][4];
#pragma unroll
    for (int dt = 0; dt < 2; ++dt) {
      aup[dt] = zero8();
      if (g < 2) aup[dt] = *(const bf16x8*)(p.AupT + ((size_t)(li * 2 + dir) * 512 + h * 128 + 32 * w + 16 * dt + c) * 32 + 8 * g);
#pragma unroll
      for (int j = 0; j < 4; ++j) bias[dt][j] = p.e_a_bias[(li * 2 + dir) * 512 + h * 128 + 32 * w + 16 * dt + 4 * g + j];
    }
    f32x4 la[2][4];
#pragma unroll
    for (int tt = 0; tt < 4; ++tt) {
      bf16x8 lrf = zero8();
      if (g < 2) lrf = *(const bf16x8*)(p.LRb + (size_t)(tokc + 16 * tt + c) * 32 + dir * 16 + 8 * g);
#pragma unroll
      for (int dt = 0; dt < 2; ++dt) la[dt][tt] = mfma16(aup[dt], lrf, zero4());
    }
#pragma unroll
    for (int dt = 0; dt < 2; ++dt)
#pragma unroll
      for (int tt = 0; tt < 4; ++tt)
#pragma unroll
        for (int j = 0; j < 4; ++j) la[dt][tt][j] = logsig_fast(la[dt][tt][j] + bias[dt][j]) * (1.f / 16.f);
    f32x4 P[2][4];
    float tot[2][4];
#pragma unroll
    for (int dt = 0; dt < 2; ++dt)
#pragma unroll
      for (int j = 0; j < 4; ++j) {
        float carry = 0.f;
#pragma unroll
        for (int tt = 0; tt < 4; ++tt) {
          float v = scan16(la[dt][tt][j], c, lane) + carry;
          P[dt][tt][j] = v;
          carry = dpp_f<0x15F>(v);
        }
        tot[dt][j] = carry;
      }
#pragma unroll
    for (int dt = 0; dt < 2; ++dt)
#pragma unroll
      for (int tt = 0; tt < 4; ++tt) {
        us4 qo, ko;
#pragma unroll
        for (int j = 0; j < 4; ++j) {
          const float b = (dir == 0) ? P[dt][tt][j] : (tot[dt][j] - P[dt][tt][j] + la[dt][tt][j]);
          qo[j] = f2bf(bf2f(q4[dt][tt][j]) * __expf(b) * qscale);
          ko[j] = f2bf(bf2f(kk[dt][tt][j]) * __expf(-b));
        }
        *(us4*)(QEd + (size_t)(tokc + 16 * tt + c) * 512 + h * 128 + 32 * w + 16 * dt + 4 * g) = qo;
        *(us4*)(sQe + (16 * tt + c) * 136 + 32 * w + 16 * dt + 4 * g) = qo;
        *(us4*)(sKd + (16 * tt + c) * 136 + 32 * w + 16 * dt + 4 * g) = ko;
      }
    if (c == 0) {
#pragma unroll
      for (int dt = 0; dt < 2; ++dt)
#pragma unroll
        for (int j = 0; j < 4; ++j)
          p.EB[(size_t)(dir * 1280 + ci) * 512 + h * 128 + 32 * w + 16 * dt + 4 * g + j] = __expf(tot[dt][j]);
    }
    __syncthreads();
#pragma unroll
    for (int i = 0; i < 4; ++i) {
      const int id = tid + 256 * i;
      const int d = id & 127, c8 = id >> 7;
      bf16x8 v;
#pragma unroll
      for (int e = 0; e < 8; ++e) v[e] = (short)sKd[(8 * c8 + e) * 136 + d];
      *(bf16x8*)(KdTd + (size_t)(h * 128 + d) * T_TOK + tokc + 8 * c8) = v;
    }
    f32x4 accA[4];
#pragma unroll
    for (int jt = 0; jt < 4; ++jt) accA[jt] = zero4();
#pragma unroll
    for (int ks = 0; ks < 4; ++ks) {
      bf16x8 aq = *(const bf16x8*)(sQe + (16 * w + c) * 136 + 32 * ks + 8 * g);
#pragma unroll
      for (int jt = 0; jt < 4; ++jt) {
        bf16x8 bk = *(const bf16x8*)(sKd + (16 * jt + c) * 136 + 32 * ks + 8 * g);
        accA[jt] = mfma16(aq, bk, accA[jt]);
      }
    }
#pragma unroll
    for (int jt = 0; jt < 4; ++jt)
#pragma unroll
      for (int j = 0; j < 4; ++j) {
        const int i = 16 * w + 4 * g + j, jj = 16 * jt + c;
        const bool keep = (dir == 0) ? (jj <= i) : (jj > i);
        sA[dir * 64 * 72 + i * 72 + jj] = f2bf(keep ? accA[jt][j] : 0.f);
      }
    __syncthreads();
  }
  bf16x8 af[2][2];
#pragma unroll
  for (int dir = 0; dir < 2; ++dir)
#pragma unroll
    for (int k2 = 0; k2 < 2; ++k2) af[dir][k2] = *(const bf16x8*)(sA + dir * 64 * 72 + (16 * w + c) * 72 + 32 * k2 + 8 * g);
  bf16_t* sO = (bf16_t*)smem;
#pragma unroll 4
  for (int vt = 0; vt < 16; ++vt) {
    f32x4 a = zero4();
#pragma unroll
    for (int k2 = 0; k2 < 2; ++k2) {
      bf16x8 vfr = *(const bf16x8*)(p.VtE + (size_t)(h * 256 + 16 * vt + c) * T_TOK + tokc + 32 * k2 + 8 * g);
      a = mfma16(af[0][k2], vfr, a);
      a = mfma16(af[1][k2], vfr, a);
    }
#pragma unroll
    for (int j = 0; j < 4; ++j) sO[(16 * w + 4 * g + j) * 264 + 16 * vt + c] = f2bf(a[j]);
  }
  __syncthreads();
#pragma unroll
  for (int i = 0; i < 8; ++i) {
    const int id = tid + 256 * i;
    const int row = id >> 5, c8 = id & 31;
    *(bf16x8*)(p.TMP + (size_t)(tokc + row) * 1024 + h * 256 + 8 * c8) = *(const bf16x8*)(sO + row * 264 + 8 * c8);
  }
}

__device__ __forceinline__ void lds_barrier() { asm volatile("s_waitcnt lgkmcnt(0)\n\ts_barrier" ::: "memory"); }

struct GlaRegs {
  bf16x8 aq[4];
  bf16x8 vf[2][2];
  bf16x8 kf[2][2];
  float eb[2];
  unsigned told[2][4];
};

template <int DIR>
__device__ __forceinline__ void gla_chain_load(const Params& p, int h, int sl, int tokc, int w, int c, int g, GlaRegs& r) {
  const bf16_t* QE = DIR ? p.QEb : p.Qb;
  const bf16_t* KdT = DIR ? p.KdTb : p.Kt;
#pragma unroll
  for (int ks = 0; ks < 4; ++ks) r.aq[ks] = *(const bf16x8*)(QE + (size_t)(tokc + 16 * w + c) * 512 + h * 128 + 32 * ks + 8 * g);
#pragma unroll
  for (int vt = 0; vt < 2; ++vt)
#pragma unroll
    for (int k2 = 0; k2 < 2; ++k2)
      r.vf[vt][k2] = *(const bf16x8*)(p.VtE + (size_t)(h * 256 + sl * 32 + 16 * vt + c) * T_TOK + tokc + 32 * k2 + 8 * g);
#pragma unroll
  for (int dt = 0; dt < 2; ++dt) {
#pragma unroll
    for (int k2 = 0; k2 < 2; ++k2)
      r.kf[dt][k2] = *(const bf16x8*)(KdT + (size_t)(h * 128 + 32 * w + 16 * dt + c) * T_TOK + tokc + 32 * k2 + 8 * g);
    r.eb[dt] = p.EB[(size_t)(DIR * 1280 + (tokc >> 6)) * 512 + h * 128 + 32 * w + 16 * dt + c];
  }
#pragma unroll
  for (int vt = 0; vt < 2; ++vt)
#pragma unroll
    for (int j = 0; j < 4; ++j) r.told[vt][j] = p.TMP[(size_t)(tokc + 16 * w + 4 * g + j) * 1024 + h * 256 + sl * 32 + 16 * vt + c];
}

__device__ __forceinline__ void gla_chain_compute(const Params& p, int h, int sl, int tokc, int w, int c, int g, const GlaRegs& r,
                                                  f32x4 (&S)[2][2], bf16_t* sSt, bool dry, bool reload) {
  unsigned told[2][4];
#pragma unroll
  for (int vt = 0; vt < 2; ++vt)
#pragma unroll
    for (int j = 0; j < 4; ++j) told[vt][j] = r.told[vt][j];
  if (reload) {
#pragma unroll
    for (int vt = 0; vt < 2; ++vt)
#pragma unroll
      for (int j = 0; j < 4; ++j) told[vt][j] = p.TMP[(size_t)(tokc + 16 * w + 4 * g + j) * 1024 + h * 256 + sl * 32 + 16 * vt + c];
  }
#pragma unroll
  for (int vt = 0; vt < 2; ++vt)
#pragma unroll
    for (int dt = 0; dt < 2; ++dt)
#pragma unroll
      for (int j = 0; j < 4; ++j) sSt[(16 * vt + 4 * g + j) * 136 + 32 * w + 16 * dt + c] = f2bf(S[vt][dt][j]);
  lds_barrier();
  f32x4 o[2];
  o[0] = zero4(); o[1] = zero4();
#pragma unroll
  for (int ks = 0; ks < 4; ++ks)
#pragma unroll
    for (int vt = 0; vt < 2; ++vt) {
      bf16x8 sf = *(const bf16x8*)(sSt + (16 * vt + c) * 136 + 32 * ks + 8 * g);
      o[vt] = mfma16(r.aq[ks], sf, o[vt]);
    }
#pragma unroll
  for (int dt = 0; dt < 2; ++dt)
#pragma unroll
    for (int vt = 0; vt < 2; ++vt) {
      f32x4 a = S[vt][dt];
#pragma unroll
      for (int k2 = 0; k2 < 2; ++k2) a = mfma16(r.vf[vt][k2], r.kf[dt][k2], a);
      S[vt][dt] = a * r.eb[dt];
    }
#pragma unroll
  for (int vt = 0; vt < 2; ++vt)
#pragma unroll
    for (int j = 0; j < 4; ++j)
      if (!dry) p.TMP[(size_t)(tokc + 16 * w + 4 * g + j) * 1024 + h * 256 + sl * 32 + 16 * vt + c] = f2bf(bf2f((bf16_t)told[vt][j]) + o[vt][j]);
}

__device__ void gla_chain_item(const Params& p, int li, int item, char* smem, bool dry = false) {
  const int tid = otid(), lane = tid & 63, w = tid >> 6, c = lane & 15, g = lane >> 4;
  const int xr = item >> 3;
  const int pair = (item & 7) + 8 * (xr >> 3), sl = xr & 7;
  const int s = pair < 32 ? 4 + (pair >> 2) : ((pair - 32) >> 2);
  const int h = pair & 3;
  const int tok0 = s < 4 ? s * 4096 : T_P + (s - 4) * 8192;
  const int len = s < 4 ? 4096 : 8192;
  const int N = len / 64;
  bf16_t* sSt0 = (bf16_t*)smem;
  bf16_t* sSt1 = sSt0 + 32 * 136;
  f32x4 Sf[2][2], Sb[2][2];
#pragma unroll
  for (int a = 0; a < 2; ++a)
#pragma unroll
    for (int b = 0; b < 2; ++b) { Sf[a][b] = zero4(); Sb[a][b] = zero4(); }
  GlaRegs rf, rb;
  __syncthreads();
  gla_chain_load<0>(p, h, sl, tok0, w, c, g, rf);
  for (int step = 0; step < N; ++step) {
    const int tf = tok0 + step * 64, tb = tok0 + (N - 1 - step) * 64;
    gla_chain_load<1>(p, h, sl, tb, w, c, g, rb);
    gla_chain_compute(p, h, sl, tf, w, c, g, rf, Sf, sSt0, dry, step == (N >> 1));
    if (step + 1 < N) gla_chain_load<0>(p, h, sl, tf + 64, w, c, g, rf);
    gla_chain_compute(p, h, sl, tb, w, c, g, rb, Sb, sSt1, dry, false);
  }
}

__device__ void pool_item(const Params& p, int li, int item, char* smem, bool dry = false) {
  const int tid = otid(), lane = tid & 63, w = tid >> 6, c = lane & 15, g = lane >> 4;
  const int gi = item & 3;
  const int tile = item >> 2;
  const int tokc = tile * 64;
  const int pos0 = seq_pos(tokc);
  const int len = tokc < T_P ? 4096 : 8192;
  float* sU = (float*)smem;
  bf16_t* sP = (bf16_t*)(sU + 80 * 128);
  __syncthreads();
  for (int idx = tid; idx < 80 * 128; idx += 256) {
    int r = idx >> 7, ch = idx & 127;
    int pos = pos0 - 8 + r;
    float v = 0.f;
    if (pos >= 0 && pos < len) v = bf2f(p.PUb[(long)(tokc - 8 + r) * 512 + gi * 128 + ch]);
    sU[idx] = v;
  }
  __syncthreads();
  {
    const int ch = tid & 127, th = tid >> 7;
    const int half = 1 << gi;
    for (int t = th * 32; t < th * 32 + 32; ++t) {
      int pos = pos0 + t;
      int lo = max(pos - half, 0), hi = min(pos + half, len);
      float s = 0.f;
      for (int q = lo; q < hi; ++q) s += sU[(q - pos0 + 8) * 128 + ch];
      float pooled = s / (float)(hi - lo) - sU[(t + 8) * 128 + ch];
      sP[t * 136 + ch] = f2bf(pooled);
    }
  }
  __syncthreads();
  f32x4 acc[8];
#pragma unroll
  for (int dt = 0; dt < 8; ++dt) acc[dt] = zero4();
  const bf16_t* PW = p.PoolWT + (long)(li * 4 + gi) * 128 * 128;
#pragma unroll
  for (int ks = 0; ks < 4; ++ks) {
    bf16x8 af = *(const bf16x8*)(sP + (16 * w + c) * 136 + 32 * ks + 8 * g);
#pragma unroll
    for (int dt = 0; dt < 8; ++dt) {
      bf16x8 bw = *(const bf16x8*)(PW + (long)(16 * dt + c) * 128 + 32 * ks + 8 * g);
      acc[dt] = mfma16(af, bw, acc[dt]);
    }
  }
#pragma unroll
  for (int dt = 0; dt < 8; ++dt) {
    const int d = gi * 128 + 16 * dt + c;
    const float sc = p.e_pool_scale[li * 512 + d];
#pragma unroll
    for (int j = 0; j < 4; ++j) {
      const long addr = (long)(tokc + 16 * w + 4 * g + j) * 512 + d;
      float gt = bf2f(p.PGb[addr]);
      if (!dry) p.PGb[addr] = f2bf(acc[dt][j] * sc * siluf_(gt));
    }
  }
}

__device__ void ml_intra_item(const Params& p, int li, int item, char* smem) {
  const int tid = otid(), lane = tid & 63, w = tid >> 6, c = lane & 15, g = lane >> 4;
  const int ci = item >> 2, h = item & 3;
  const int tokc = ci * 64;
  const float kscale = 0.08838834764831845f;
  bf16_t* sA = (bf16_t*)smem;
  float* sBv = (float*)(sA + 2 * 64 * 72);
  float* sCB = sBv + 128;
  __syncthreads();
  if (w < 2) {
    const int dir = w;
    const float bi = p.o_if_bias[li * 16 + dir * 4 + h];
    const float bff = p.o_if_bias[li * 16 + 8 + dir * 4 + h];
    const float* mf = p.MIF + (size_t)(tokc + lane) * 16;
    const float liv = mf[dir * 4 + h] + bi;
    const float lfv = logsig_fast(mf[8 + dir * 4 + h] + bff);
    float ps = lfv;
#pragma unroll
    for (int d = 1; d < 64; d <<= 1) {
      float t = bperm(lane - d, ps);
      if (lane >= d) ps += t;
    }
    const float total = __int_as_float(__builtin_amdgcn_readlane(__float_as_int(ps), 63));
    const float b = (dir == 0) ? ps : (total - ps + lfv);
    const float cB = liv - b;
    sBv[dir * 64 + lane] = b;
    sCB[dir * 64 + lane] = cB;
    const size_t so = (size_t)(dir * 4 + h) * T_TOK + tokc + lane;
    p.EBI[so] = __expf(b);
    p.WKg[so] = __expf(total + cB) * kscale;
    if (lane == 0) p.DEC[(dir * 4 + h) * 1280 + ci] = __expf(total);
  }
  f32x4 accA[4];
#pragma unroll
  for (int jt = 0; jt < 4; ++jt) accA[jt] = zero4();
#pragma unroll
  for (int ks = 0; ks < 4; ++ks) {
    bf16x8 aq = *(const bf16x8*)(p.MQb + (size_t)(tokc + 16 * w + c) * 512 + h * 128 + 32 * ks + 8 * g);
#pragma unroll
    for (int jt = 0; jt < 4; ++jt) {
      bf16x8 bk = *(const bf16x8*)(p.MKb + (size_t)(tokc + 16 * jt + c) * 512 + h * 128 + 32 * ks + 8 * g);
      accA[jt] = mfma16(aq, bk, accA[jt]);
    }
  }
  __syncthreads();
#pragma unroll
  for (int dir = 0; dir < 2; ++dir)
#pragma unroll
    for (int jt = 0; jt < 4; ++jt)
#pragma unroll
      for (int j = 0; j < 4; ++j) {
        const int i = 16 * w + 4 * g + j, jj = 16 * jt + c;
        const bool keep = (dir == 0) ? (jj <= i) : (jj > i);
        const float sv = keep ? accA[jt][j] * kscale * __expf(sBv[dir * 64 + i] + sCB[dir * 64 + jj]) : 0.f;
        sA[dir * 64 * 72 + i * 72 + jj] = f2bf(sv);
      }
  __syncthreads();
  bf16x8 ones = zero8();
  if (c == 0) {
#pragma unroll
    for (int e = 0; e < 8; ++e) ones[e] = (short)0x3F80;
  }
#pragma unroll
  for (int dir = 0; dir < 2; ++dir) {
    bf16_t* NUMI = dir ? p.NUMIb : p.NUMIf;
    bf16x8 af[2];
#pragma unroll
    for (int k2 = 0; k2 < 2; ++k2) af[k2] = *(const bf16x8*)(sA + dir * 64 * 72 + (16 * w + c) * 72 + 32 * k2 + 8 * g);
    f32x4 dn = zero4();
    dn = mfma16(af[0], ones, dn);
    dn = mfma16(af[1], ones, dn);
    if (c == 0) {
#pragma unroll
      for (int j = 0; j < 4; ++j) p.DENI[(size_t)(dir * 4 + h) * T_TOK + tokc + 16 * w + 4 * g + j] = dn[j];
    }
    bf16_t* sO = sA + 2 * 64 * 72 + 512;
#pragma unroll 4
    for (int vt = 0; vt < 8; ++vt) {
      f32x4 a = zero4();
#pragma unroll
      for (int k2 = 0; k2 < 2; ++k2) {
        bf16x8 vfr = *(const bf16x8*)(p.MVt + (size_t)(h * 128 + 16 * vt + c) * T_TOK + tokc + 32 * k2 + 8 * g);
        a = mfma16(af[k2], vfr, a);
      }
#pragma unroll
      for (int j = 0; j < 4; ++j) sO[(16 * w + 4 * g + j) * 136 + 16 * vt + c] = f2bf(a[j]);
    }
    __syncthreads();
#pragma unroll
    for (int i = 0; i < 4; ++i) {
      const int id = tid + 256 * i;
      const int row = id >> 4, c8 = id & 15;
      *(bf16x8*)(NUMI + (size_t)(tokc + row) * 512 + h * 128 + 8 * c8) = *(const bf16x8*)(sO + row * 136 + 8 * c8);
    }
    __syncthreads();
  }
}

struct MlRegs {
  bf16x8 aq[4];
  bf16x8 vf[2];
  bf16x8 kf[2][2];
  f32x4 wk[2][2];
  f32x4 ebi, deni;
  float dec;
  unsigned numi[4];
};

template <int DIR>
__device__ __forceinline__ void ml_chain_load(const Params& p, int h, int sl, int tokc, int w, int c, int g, MlRegs& r) {
#pragma unroll
  for (int ks = 0; ks < 4; ++ks) r.aq[ks] = *(const bf16x8*)(p.MQb + (size_t)(tokc + 16 * w + c) * 512 + h * 128 + 32 * ks + 8 * g);
#pragma unroll
  for (int k2 = 0; k2 < 2; ++k2)
    r.vf[k2] = *(const bf16x8*)(p.MVt + (size_t)(h * 128 + sl * 16 + c) * T_TOK + tokc + 32 * k2 + 8 * g);
#pragma unroll
  for (int dt = 0; dt < 2; ++dt)
#pragma unroll
    for (int k2 = 0; k2 < 2; ++k2)
      r.kf[dt][k2] = *(const bf16x8*)(p.MKt + (size_t)(h * 128 + 32 * w + 16 * dt + c) * T_TOK + tokc + 32 * k2 + 8 * g);
  const size_t so = (size_t)(DIR * 4 + h) * T_TOK + tokc;
#pragma unroll
  for (int k2 = 0; k2 < 2; ++k2) {
    r.wk[k2][0] = *(const f32x4*)(p.WKg + so + 32 * k2 + 8 * g);
    r.wk[k2][1] = *(const f32x4*)(p.WKg + so + 32 * k2 + 8 * g + 4);
  }
  r.ebi = *(const f32x4*)(p.EBI + so + 16 * w + 4 * g);
  r.deni = *(const f32x4*)(p.DENI + so + 16 * w + 4 * g);
  r.dec = p.DEC[(DIR * 4 + h) * 1280 + (tokc >> 6)];
  const bf16_t* NUMI = DIR ? p.NUMIb : p.NUMIf;
#pragma unroll
  for (int j = 0; j < 4; ++j) r.numi[j] = NUMI[(size_t)(tokc + 16 * w + 4 * g + j) * 512 + h * 128 + sl * 16 + c];
}

template <int DIR>
__device__ __forceinline__ void ml_chain_compute(const Params& p, int h, int sl, int tokc, int lane, int w, int c, int g, const MlRegs& r,
                                                 f32x4 (&C)[2][2], bf16_t* sCt, bool dry) {
  bf16_t* NUMI = DIR ? p.NUMIb : p.NUMIf;
  unsigned numi[4];
#pragma unroll
  for (int j = 0; j < 4; ++j) numi[j] = r.numi[j];
#pragma unroll
  for (int vt = 0; vt < 2; ++vt)
#pragma unroll
    for (int dt = 0; dt < 2; ++dt)
#pragma unroll
      for (int j = 0; j < 4; ++j) sCt[(16 * vt + 4 * g + j) * 136 + 32 * w + 16 * dt + c] = f2bf(C[vt][dt][j]);
  bf16x8 vfw[2][2];
#pragma unroll
  for (int k2 = 0; k2 < 2; ++k2) {
    float wv[8];
#pragma unroll
    for (int e = 0; e < 4; ++e) { wv[e] = r.wk[k2][0][e]; wv[4 + e] = r.wk[k2][1][e]; }
#pragma unroll
    for (int e = 0; e < 8; ++e) vfw[0][k2][e] = (short)f2bf(bf2f((bf16_t)r.vf[k2][e]) * wv[e]);
#pragma unroll
    for (int e = 0; e < 8; ++e) vfw[1][k2][e] = (c == 0) ? (short)f2bf(wv[e]) : (short)0;
  }
  lds_barrier();
  f32x4 o2[2];
  o2[0] = zero4(); o2[1] = zero4();
#pragma unroll
  for (int ks = 0; ks < 4; ++ks)
#pragma unroll
    for (int vt = 0; vt < 2; ++vt) {
      bf16x8 cf = *(const bf16x8*)(sCt + (16 * vt + c) * 136 + 32 * ks + 8 * g);
      o2[vt] = mfma16(r.aq[ks], cf, o2[vt]);
    }
#pragma unroll
  for (int dt = 0; dt < 2; ++dt)
#pragma unroll
    for (int vt = 0; vt < 2; ++vt) {
      f32x4 a = C[vt][dt] * r.dec;
#pragma unroll
      for (int k2 = 0; k2 < 2; ++k2) a = mfma16(vfw[vt][k2], r.kf[dt][k2], a);
      C[vt][dt] = a;
    }
#pragma unroll
  for (int j = 0; j < 4; ++j) {
    const float e = r.ebi[j];
    float den = e * o2[1][j];
    den = dpp_f<0x150>(den) + r.deni[j];
    const float inv = 1.f / fmaxf(fabsf(den), 1.f);
    const float hv = (bf2f((bf16_t)numi[j]) + e * o2[0][j]) * inv;
    if (!dry) NUMI[(size_t)(tokc + 16 * w + 4 * g + j) * 512 + h * 128 + sl * 16 + c] = f2bf(hv);
  }
}

template <int DIR>
__device__ __forceinline__ void ml_chain_run(const Params& p, int h, int sl, int tok0, int N, int lane, int w, int c, int g, bf16_t* sCt0, bool dry) {
  bf16_t* sCt1 = sCt0 + 32 * 136;
  f32x4 C[2][2];
#pragma unroll
  for (int a = 0; a < 2; ++a)
#pragma unroll
    for (int b = 0; b < 2; ++b) C[a][b] = zero4();
  MlRegs r0, r1;
  ml_chain_load<DIR>(p, h, sl, tok0 + (DIR ? N - 1 : 0) * 64, w, c, g, r0);
  for (int n = 0; n < N; n += 2) {
    const int c0 = DIR ? N - 1 - n : n;
    const int c1 = DIR ? N - 2 - n : n + 1;
    const int n2 = min(n + 2, N - 1);
    const int c2 = DIR ? N - 1 - n2 : n2;
    ml_chain_load<DIR>(p, h, sl, tok0 + c1 * 64, w, c, g, r1);
    ml_chain_compute<DIR>(p, h, sl, tok0 + c0 * 64, lane, w, c, g, r0, C, sCt0, dry);
    ml_chain_load<DIR>(p, h, sl, tok0 + c2 * 64, w, c, g, r0);
    ml_chain_compute<DIR>(p, h, sl, tok0 + c1 * 64, lane, w, c, g, r1, C, sCt1, dry);
  }
}

__device__ void ml_chain_item(const Params& p, int li, int item, char* smem, bool dry = false) {
  const int tid = otid(), lane = tid & 63, w = tid >> 6, c = lane & 15, g = lane >> 4;
  int pair, within;
  if (item < 512) { const int r = item >> 3; pair = (item & 7) + 8 * (r >> 4); within = r & 15; }
  else { const int it = item - 512; const int r = it >> 3; pair = 32 + (it & 7) + 8 * (r >> 4); within = r & 15; }
  const int sl = within & 7, dir = within >> 3;
  const int s = pair < 32 ? 4 + (pair >> 2) : ((pair - 32) >> 2);
  const int h = pair & 3;
  const int tok0 = s < 4 ? s * 4096 : T_P + (s - 4) * 8192;
  const int N = (s < 4 ? 4096 : 8192) / 64;
  bf16_t* sCt0 = (bf16_t*)smem;
  __syncthreads();
  if (dir == 0) ml_chain_run<0>(p, h, sl, tok0, N, lane, w, c, g, sCt0, dry);
  else ml_chain_run<1>(p, h, sl, tok0, N, lane, w, c, g, sCt0, dry);
}

#define ATTN_GLOAD(KT)                                                                              \
  {                                                                                                 \
    const long kb = tok0 + (KT) * 64;                                                               \
    rk0 = *(const bf16x8*)(p.KNb + (kb + (tid >> 3)) * 512 + head * 64 + 8 * (tid & 7));            \
    rk1 = *(const bf16x8*)(p.KNb + (kb + 32 + (tid >> 3)) * 512 + head * 64 + 8 * (tid & 7));       \
    rkr = *(const bf16x8*)(p.KRb + (kb + (tid >> 2)) * 32 + 8 * (tid & 3));                          \
    rv0 = *(const bf16x8*)(p.VtA + (long)(head * 64 + (tid >> 3)) * T_TOK + kb + 8 * (tid & 7));     \
    rv1 = *(const bf16x8*)(p.VtA + (long)(head * 64 + 32 + (tid >> 3)) * T_TOK + kb + 8 * (tid & 7)); \
  }
__device__ void attn_item(const Params& p, int item, char* smem, bool dry = false) {
  const int tid = otid(), lane = tid & 63, w = tid >> 6, c = lane & 15, g = lane >> 4;
  int s, head, qb;
  {
    const int x = item / 320, t = item % 320;
    if (t < 256) { const int pair = x + 8 * (t >> 5); qb = t & 31; s = 4 + (pair >> 3); head = pair & 7; }
    else { const int t2 = t - 256; const int pair = x + 8 * (t2 >> 4); qb = t2 & 15; s = pair >> 3; head = pair & 7; }
  }
  const int tok0 = s < 4 ? s * 4096 : T_P + (s - 4) * 8192;
  const int len = s < 4 ? 4096 : 8192;
  const int nkv = len / 64;
  constexpr int KV_STAGE = 64 * 104 + 64 * 72;
  bf16_t* sKV = (bf16_t*)smem;
  const int qrow0 = tok0 + qb * 256 + 64 * w;
  bf16_t* sQr = sKV + 2 * KV_STAGE;
  bf16x8 qf[4][2];
#pragma unroll
  for (int nt = 0; nt < 4; ++nt) {
#pragma unroll
    for (int ks = 0; ks < 2; ++ks)
      qf[nt][ks] = *(const bf16x8*)(p.Qa + (long)(qrow0 + 16 * nt + c) * 768 + head * 96 + 32 * ks + 8 * g);
    bf16x8 qr = *(const bf16x8*)(p.Qa + (long)(qrow0 + 16 * nt + c) * 768 + head * 96 + 64 + 8 * g);
    *(bf16x8*)(sQr + ((w * 4 + nt) * 64 + lane) * 8) = qr;
  }
  f32x4 ot[4][4];
#pragma unroll
  for (int vt = 0; vt < 4; ++vt)
#pragma unroll
    for (int nt = 0; nt < 4; ++nt) ot[vt][nt] = zero4();
  float mrun[4] = {-64.f, -64.f, -64.f, -64.f}, lrun[4] = {0.f, 0.f, 0.f, 0.f};
  bf16x8 rk0, rk1, rkr, rv0, rv1;
#define ATTN_LSTORE(STG)                                                                    \
  {                                                                                         \
    bf16_t* sK_ = sKV + (STG) * KV_STAGE;                                                   \
    bf16_t* sVt_ = sK_ + 64 * 104;                                                          \
    *(bf16x8*)(sK_ + (tid >> 3) * 104 + 8 * (tid & 7)) = rk0;                               \
    *(bf16x8*)(sK_ + (32 + (tid >> 3)) * 104 + 8 * (tid & 7)) = rk1;                        \
    *(bf16x8*)(sK_ + (tid >> 2) * 104 + 64 + 8 * (tid & 3)) = rkr;                          \
    *(bf16x8*)(sVt_ + (tid >> 3) * 72 + 8 * (tid & 7)) = rv0;                               \
    *(bf16x8*)(sVt_ + (32 + (tid >> 3)) * 72 + 8 * (tid & 7)) = rv1;                        \
  }
  ATTN_GLOAD(0)
  __syncthreads();
  ATTN_LSTORE(0)
  __syncthreads();
  for (int kt = 0; kt < nkv; ++kt) {
    const bf16_t* sK = sKV + (kt & 1) * KV_STAGE;
    const bf16_t* sVt = sK + 64 * 104;
    ATTN_GLOAD(min(kt + 1, nkv - 1))
#pragma unroll 1
    for (int half = 0; half < 2; ++half) {
      f32x4 st[2][4];
#pragma unroll
      for (int k4 = 0; k4 < 2; ++k4)
#pragma unroll
        for (int nt = 0; nt < 4; ++nt) {
          const float nm = -mrun[nt];
          f32x4 iv = {nm, nm, nm, nm};
          st[k4][nt] = iv;
        }
#pragma unroll
      for (int ks = 0; ks < 2; ++ks)
#pragma unroll
        for (int k4 = 0; k4 < 2; ++k4) {
          bf16x8 kf = *(const bf16x8*)(sK + (32 * half + 16 * k4 + c) * 104 + 32 * ks + 8 * g);
#pragma unroll
          for (int nt = 0; nt < 4; ++nt) st[k4][nt] = mfma16(kf, qf[nt][ks], st[k4][nt]);
        }
      {
        bf16x8 kr0 = *(const bf16x8*)(sK + (32 * half + c) * 104 + 64 + 8 * g);
        bf16x8 kr1 = *(const bf16x8*)(sK + (32 * half + 16 + c) * 104 + 64 + 8 * g);
#pragma unroll
        for (int nt = 0; nt < 4; ++nt) {
          bf16x8 qr = *(const bf16x8*)(sQr + ((w * 4 + nt) * 64 + lane) * 8);
          st[0][nt] = mfma16(kr0, qr, st[0][nt]);
          st[1][nt] = mfma16(kr1, qr, st[1][nt]);
        }
      }
      __builtin_amdgcn_sched_barrier(0);
      bf16x8 pb[4];
#pragma unroll
      for (int nt = 0; nt < 4; ++nt) {
        float mx = -1e30f;
#pragma unroll
        for (int k4 = 0; k4 < 2; ++k4)
#pragma unroll
          for (int j = 0; j < 4; ++j) mx = fmaxf(mx, st[k4][nt][j]);
        mx = rowmax4(mx);
        if (__builtin_amdgcn_ballot_w64(mx > 0.f) != 0ull) {
          const float d = fmaxf(mx, 0.f);
          const float alpha = __builtin_amdgcn_exp2f(-d);
          mrun[nt] += d;
          lrun[nt] *= alpha;
#pragma unroll
          for (int vt = 0; vt < 4; ++vt) ot[vt][nt] = ot[vt][nt] * alpha;
#pragma unroll
          for (int k4 = 0; k4 < 2; ++k4)
#pragma unroll
            for (int j = 0; j < 4; ++j) st[k4][nt][j] -= d;
        }
        float psum = 0.f;
#pragma unroll
        for (int k4 = 0; k4 < 2; ++k4)
#pragma unroll
          for (int j = 0; j < 4; ++j) {
            float pv = __builtin_amdgcn_exp2f(st[k4][nt][j]);
            st[k4][nt][j] = pv;
            psum += pv;
          }
        lrun[nt] += psum;
        typedef __attribute__((ext_vector_type(4))) unsigned u32x4;
        u32x4 pk;
        pk[0] = pk2bf(st[0][nt][0], st[0][nt][1]);
        pk[1] = pk2bf(st[0][nt][2], st[0][nt][3]);
        pk[2] = pk2bf(st[1][nt][0], st[1][nt][1]);
        pk[3] = pk2bf(st[1][nt][2], st[1][nt][3]);
        pb[nt] = __builtin_bit_cast(bf16x8, pk);
      }
      __builtin_amdgcn_sched_barrier(0);
#pragma unroll
      for (int vt = 0; vt < 4; ++vt) {
        us4 lo = *(const us4*)(sVt + (16 * vt + c) * 72 + 32 * half + 4 * g);
        us4 hi = *(const us4*)(sVt + (16 * vt + c) * 72 + 32 * half + 16 + 4 * g);
        bf16x8 av;
#pragma unroll
        for (int e = 0; e < 4; ++e) { av[e] = (short)lo[e]; av[4 + e] = (short)hi[e]; }
#pragma unroll
        for (int nt = 0; nt < 4; ++nt) ot[vt][nt] = mfma16(av, pb[nt], ot[vt][nt]);
      }
    }
    if (kt + 1 < nkv) ATTN_LSTORE((kt + 1) & 1)
    __syncthreads();
  }
#undef ATTN_LSTORE
#pragma unroll
  for (int nt = 0; nt < 4; ++nt) {
    float lt = lrun[nt];
    lt += sxor(lt, 16, lane);
    lt += sxor(lt, 32, lane);
    const float inv = 1.f / lt;
    const long tok = qrow0 + 16 * nt + c;
#pragma unroll
    for (int vt = 0; vt < 4; ++vt) {
      bf16_t* gp = p.MGb + tok * 512 + head * 64 + 16 * vt + 4 * g;
      us4 gt = *(const us4*)gp;
      us4 o;
#pragma unroll
      for (int j = 0; j < 4; ++j) o[j] = f2bf(ot[vt][nt][j] * inv * siluf_(bf2f(gt[j])));
      if (!dry) *(us4*)gp = o;
    }
  }
}

__device__ void phase_gla_combine(const Params& p, int li, bool dry = false) {
  const int tid_ = otid(); const int lane = tid_ & 63, w = tid_ >> 6;
  for (int tok = blockIdx.x * 4 + w; tok < T_TOK; tok += gridDim.x * 4) {
    const bf16_t* tp = p.TMP + (long)tok * 1024 + 16 * lane;
    bf16_t* gp = p.Gb + (long)tok * 1024 + 16 * lane;
    bf16x8 o0 = *(const bf16x8*)tp, o1 = *(const bf16x8*)(tp + 8);
    bf16x8 g0 = *(const bf16x8*)gp, g1 = *(const bf16x8*)(gp + 8);
    float ov[16], gv[16];
#pragma unroll
    for (int e = 0; e < 8; ++e) {
      ov[e] = bf2f((bf16_t)o0[e]); ov[8 + e] = bf2f((bf16_t)o1[e]);
      gv[e] = bf2f((bf16_t)g0[e]); gv[8 + e] = bf2f((bf16_t)g1[e]);
    }
    float ss = 0.f;
#pragma unroll
    for (int e = 0; e < 16; ++e) ss += ov[e] * ov[e];
    ss += sxor(ss, 1, lane); ss += sxor(ss, 2, lane); ss += sxor(ss, 4, lane); ss += sxor(ss, 8, lane);
    const float rs = rsqrtf(ss * (1.f / 256.f) + EPS);
    const float* ng = p.e_gla_norm_g + li * 256 + ((16 * lane) & 255);
    bf16x8 r0, r1;
#pragma unroll
    for (int e = 0; e < 8; ++e) {
      r0[e] = (short)f2bf(ov[e] * rs * ng[e] * siluf_(gv[e]));
      r1[e] = (short)f2bf(ov[8 + e] * rs * ng[8 + e] * siluf_(gv[8 + e]));
    }
    if (!dry) { *(bf16x8*)gp = r0;
    *(bf16x8*)(gp + 8) = r1; }
  }
}

__device__ void phase_ml_combine(const Params& p, int li, bool dry = false) {
  const int tid_ = otid(); const int lane = tid_ & 63, w = tid_ >> 6;
  for (int tok = blockIdx.x * 4 + w; tok < T_TOK; tok += gridDim.x * 4) {
    const long off = (long)tok * 512 + 8 * lane;
    bf16x8 hv = *(const bf16x8*)(p.NUMIf + off);
    bf16x8 hb = *(const bf16x8*)(p.NUMIb + off);
    bf16x8 mo = *(const bf16x8*)(p.MOb + off);
    bf16x8 mg = *(const bf16x8*)(p.MLGb + off);
    float hf[8];
    float ss = 0.f;
#pragma unroll
    for (int e = 0; e < 8; ++e) { hf[e] = bf2f((bf16_t)hv[e]) + bf2f((bf16_t)hb[e]); ss += hf[e] * hf[e]; }
    ss += sxor(ss, 1, lane); ss += sxor(ss, 2, lane); ss += sxor(ss, 4, lane); ss += sxor(ss, 8, lane);
    const float rs = rsqrtf(ss * (1.f / 128.f) + EPS);
    const float* ng = p.o_ml_norm_g + li * 128 + ((8 * lane) & 127);
    bf16x8 r;
#pragma unroll
    for (int e = 0; e < 8; ++e)
      r[e] = (short)f2bf(hf[e] * rs * ng[e] * sigmoidf_(bf2f((bf16_t)mo[e])) * siluf_(bf2f((bf16_t)mg[e])));
    if (!dry) *(bf16x8*)(p.MLGb + off) = r;
  }
}

__device__ void phase_final(const Params& p, bool dry = false) {
  const int tid_ = otid(); const int lane = tid_ & 63, w = tid_ >> 6;
  for (int tok = blockIdx.x * 4 + w; tok < T_TOK; tok += gridDim.x * 4) {
    float* xp = p.out + (long)tok * DM;
    float4 v[4];
    float ss = 0.f;
#pragma unroll
    for (int i = 0; i < 4; ++i) {
      v[i] = *(const float4*)(xp + 4 * lane + 256 * i);
      ss += v[i].x * v[i].x + v[i].y * v[i].y + v[i].z * v[i].z + v[i].w * v[i].w;
    }
    ss = wave_sum(ss);
    const float rs = rsqrtf(ss * (1.f / 1024.f) + EPS);
#pragma unroll
    for (int i = 0; i < 4; ++i) {
      float4 gq = *(const float4*)(p.final_norm_g + 4 * lane + 256 * i);
      float4 o;
      o.x = v[i].x * rs * gq.x; o.y = v[i].y * rs * gq.y; o.z = v[i].z * rs * gq.z; o.w = v[i].w * rs * gq.w;
      if (!dry) *(float4*)(xp + 4 * lane + 256 * i) = o;
    }
  }
}

__device__ void run_phase(const Params& p, int ph, char* smem) {
  if (ph == 0) { if (PH_ON(0)) phase_prep(p, smem); return; }
  if (ph == NPHASE - 1) { if (PROBE_B) phase_final(p, true); if (PH_ON(11)) phase_final(p); return; }
  const int q = ph - 1;
  const int layer = (q < 5) ? 0 : (q < 11) ? 1 : (q < 16) ? 2 : 3;
  const int sub = (q < 5) ? q : (q < 11) ? q - 5 : (q < 16) ? q - 11 : q - 16;
  const int li = layer >> 1;
  const float* xa = (layer == 0) ? p.x_prompt : p.out;
  const float* xb = (layer == 0) ? p.x_sample : p.out + (long)T_P * DM;
  if ((layer & 1) == 0) {
    if (sub == 0) {
      EpiEvenIn e{p.Qb, p.Kt, p.VtE, p.Gb, p.LRb, p.PUb, p.PGb};
      if (PH_ON(1)) gemm_phase<3, 8>(T_TOK / 128, NE_PAD / 256, DM, p.WinE + (long)li * NE_PAD * DM, p.SSQ, nullptr, p.TMP, DM, DM, p.TMP, DM, e, smem);
    } else if (sub == 1) {
      for (int item = blockIdx.x; item < 5120; item += gridDim.x)
        if (PH_ON(2)) gla_intra_item(p, li, item, smem);
    } else if (sub == 2) {
      __shared__ int s_pitem;
      for (int item = blockIdx.x; item < 384; item += gridDim.x) { if (PH_ON(2)) gla_chain_item(p, li, item, smem, false); }
      for (;;) {
        __syncthreads();
        if (threadIdx.x == 0) s_pitem = atomicAdd(p.counters + 16 + li, 1);
        __syncthreads();
        const int item = s_pitem;
        if (item >= 5120) break;
        if (PH_ON(3)) pool_item(p, li, item, smem);
      }
    } else if (sub == 3) {
      if (PROBE_B) phase_gla_combine(p, li, true);
      if (PH_ON(4)) phase_gla_combine(p, li);
    } else {
      EpiOut e{xa, xb, p.out, false, p.NUMIf, p.SSQ};
      if (PH_ON(5)) gemm_phase<1, 8>(T_TOK / 128, DM / 256, 1536, p.WoutE + (long)li * DM * 1536, nullptr, nullptr, p.Gb, 1024, 1024, p.PGb, 512, e, smem);
    }
  } else {
    if (sub == 0) {
      EpiOddIn e{p.CQb, p.CKVb, p.KRb, p.MGb, p.MQb, p.MKb, p.MKt, p.MVt, p.MOb, p.MLGb, p.MIF};
      if (PH_ON(6)) gemm_phase<3, 8>(T_TOK / 128, NO_PAD / 256, DM, p.WinO + (long)li * NO_PAD * DM, p.SSQ, nullptr, p.NUMIf, DM, DM, p.NUMIf, DM, e, smem);
    } else if (sub == 1) {
      for (int rep = 0; rep < 1 + PROBE_A; ++rep)
      for (int item = blockIdx.x; item < 5120; item += gridDim.x)
        if (PH_ON(8)) ml_intra_item(p, li, item, smem);
    } else if (sub == 2) {
      for (int item = blockIdx.x; item < 768; item += gridDim.x)
        if (PH_ON(8)) ml_chain_item(p, li, item, smem, false);
    } else if (sub == 3) {
      if (PH_ON(10)) phase_ml_combine(p, li);
      EpiQUp eq{p.Qa};
      if (PH_ON(7)) gemm_phase<2, 4>(T_TOK / 128, 768 / 128, 384, p.QupT + (long)li * 768 * 384, nullptr, nullptr, p.CQb, 384, 384, p.CQb, 384, eq, smem);
      EpiKVUp ek{p.KNb, p.VtA};
      if (PH_ON(7)) gemm_phase<2, 4>(T_TOK / 128, 1024 / 128, 256, p.KVupT + (long)li * 1024 * 256, nullptr, nullptr, p.CKVb, 256, 256, p.CKVb, 256, ek, smem);
    } else if (sub == 4) {
      __shared__ int s_item;
      for (;;) {
        __syncthreads();
        if (threadIdx.x == 0) s_item = atomicAdd(p.counters + li * 8 + (blockIdx.x & 7), 1);
        __syncthreads();
        const int item = s_item;
        if (item >= 320) break;
        if (PH_ON(9)) attn_item(p, (blockIdx.x & 7) * 320 + item, smem);
      }
    } else {
      EpiOut e{xa, xb, p.out, false, (layer == 3) ? nullptr : p.TMP, p.SSQ};
      if (PH_ON(5)) gemm_phase<1, 8>(T_TOK / 128, DM / 256, 1024, p.WoutO + (long)li * DM * 1024, nullptr, nullptr, p.MGb, 512, 512, p.MLGb, 512, e, smem);
    }
  }
}

__global__ void __launch_bounds__(256, 2) mega_kernel(Params p) {
  extern __shared__ __attribute__((aligned(16))) char smem[];
  cg::grid_group grid = cg::this_grid();
  __shared__ uint4 xb_words;
  if (threadIdx.x == 0) xb_words = make_uint4(0u, 0u, 0u, 0u);
  __syncthreads();
  XcdBarrier xb = xcd_barrier_post(p.bar, (volatile LAS unsigned*)&xb_words);
  for (int ph = p.ph_lo; ph < p.ph_hi; ++ph) {
    if (ph > p.ph_lo) {
      if (ph == p.ph_lo + 1) grid.sync();
      else xcd_barrier(xb);
    }
    run_phase(p, ph, smem);
  }
}

extern "C" void kernel_launch(void* const* d_in, const int* in_sizes, int n_in, void* d_out, int out_size, void* d_ws,
                              size_t ws_size, hipStream_t stream) {
  static int grid_blocks = 0;
  if (!grid_blocks) {
    int dev = 0, cus = 0, per_cu = 0;
    hipGetDevice(&dev);
    hipDeviceGetAttribute(&cus, hipDeviceAttributeMultiprocessorCount, dev);
    hipFuncSetAttribute((const void*)mega_kernel, hipFuncAttributeMaxDynamicSharedMemorySize, LDS_BYTES);
    hipOccupancyMaxActiveBlocksPerMultiprocessor(&per_cu, (const void*)mega_kernel, 256, LDS_BYTES);
    if (per_cu < 1) per_cu = 1;
    if (per_cu > 2) per_cu = 2;
    grid_blocks = cus * per_cu;
    fprintf(stderr, "kernel_launch: cus %d per_cu %d grid %d ws %zu\n", cus, per_cu, grid_blocks, ws_size);
  }
  Params p{};
  const float** pin = (const float**)&p;
  for (int i = 0; i < 19; ++i) pin[i] = (const float*)d_in[i];
  p.out = (float*)d_out;
  char* ws = (char*)d_ws;
  size_t off = 0;
  auto take = [&](size_t bytes) { char* r = ws + off; off += (bytes + 255) & ~(size_t)255; return r; };
  p.WinE = (bf16_t*)take((size_t)2 * NE_PAD * DM * 2);
  p.WinO = (bf16_t*)take((size_t)2 * NO_PAD * DM * 2);
  p.WoutE = (bf16_t*)take((size_t)2 * DM * 1536 * 2);
  p.WoutO = (bf16_t*)take((size_t)2 * DM * 1024 * 2);
  p.QupT = (bf16_t*)take((size_t)2 * 768 * 384 * 2);
  p.KVupT = (bf16_t*)take((size_t)2 * 1024 * 256 * 2);
  p.PoolWT = (bf16_t*)take((size_t)2 * 4 * 128 * 128 * 2);
  p.AupT = (bf16_t*)take((size_t)2 * 2 * 512 * 32 * 2);
  p.counters = (int*)take(256);
  p.bar = (unsigned*)take((size_t)XCD_BAR_WORDS * 4);
  p.SSQ = (float*)take((size_t)T_TOK * 8 * 4);
  const size_t act0 = off;
  const size_t T = T_TOK;
  p.Gb = (bf16_t*)take(T * 1024 * 2);
  p.PGb = (bf16_t*)take(T * 512 * 2);
  p.Qb = (bf16_t*)take(T * 512 * 2);
  p.Kt = (bf16_t*)take(T * 512 * 2);
  p.QEb = (bf16_t*)take(T * 512 * 2);
  p.KdTb = (bf16_t*)take(T * 512 * 2);
  p.EB = (float*)take((size_t)2 * 1280 * 512 * 4);
  p.VtE = (bf16_t*)take(T * 1024 * 2);
  p.LRb = (bf16_t*)take(T * 32 * 2);
  p.PUb = (bf16_t*)take(T * 512 * 2);
  p.TMP = (bf16_t*)take(T * 1024 * 2);
  const size_t even_end = off;
  off = act0;
  p.MGb = (bf16_t*)take(T * 512 * 2);
  p.MLGb = (bf16_t*)take(T * 512 * 2);
  p.CQb = (bf16_t*)take(T * 384 * 2);
  p.CKVb = (bf16_t*)take(T * 256 * 2);
  p.KRb = (bf16_t*)take(T * 32 * 2);
  const size_t r2 = off;
  p.MQb = (bf16_t*)take(T * 512 * 2);
  p.MKb = (bf16_t*)take(T * 512 * 2);
  p.MKt = (bf16_t*)take(T * 512 * 2);
  p.MVt = (bf16_t*)take(T * 512 * 2);
  p.MOb = (bf16_t*)take(T * 512 * 2);
  p.NUMIf = (bf16_t*)take(T * 512 * 2);
  p.NUMIb = (bf16_t*)take(T * 512 * 2);
  p.MIF = (float*)take(T * 16 * 4);
  p.EBI = (float*)take(T * 8 * 4);
  p.WKg = (float*)take(T * 8 * 4);
  p.DENI = (float*)take(T * 8 * 4);
  p.DEC = (float*)take((size_t)8 * 1280 * 4);
  const size_t r2_end = off;
  off = r2;
  p.Qa = (bf16_t*)take(T * 768 * 2);
  p.KNb = (bf16_t*)take(T * 512 * 2);
  p.VtA = (bf16_t*)take(T * 512 * 2);
  if (off < r2_end) off = r2_end;
  const size_t odd_end = off;
  const size_t need = even_end > odd_end ? even_end : odd_end;
  if (need > ws_size) {
    fprintf(stderr, "kernel_launch: workspace too small: need %zu have %zu\n", need, ws_size);
    return;
  }
  hipMemsetAsync(p.bar, 0, (size_t)XCD_BAR_WORDS * 4, stream);
#if SINGLE_LAUNCH
  p.ph_lo = 0;
  p.ph_hi = NPHASE;
  void* args[] = {&p};
  hipError_t e = hipLaunchCooperativeKernel((const void*)mega_kernel, dim3(grid_blocks), dim3(256), args, LDS_BYTES, stream);
  if (e != hipSuccess) fprintf(stderr, "cooperative launch failed: %s (grid %d)\n", hipGetErrorString(e), grid_blocks);
#else
  for (int ph = 0; ph < NPHASE; ++ph) {
    p.ph_lo = ph;
    p.ph_hi = ph + 1;
    hipLaunchKernelGGL(mega_kernel, dim3(grid_blocks), dim3(256), LDS_BYTES, stream, p);
  }
#endif
}
```

```cpp
#include <hip/hip_runtime.h>
#include <hip/hip_cooperative_groups.h>
#include <cstdio>
namespace cg = cooperative_groups;

#ifndef SINGLE_LAUNCH
#define SINGLE_LAUNCH 1
#endif
#ifndef PHMASK
#define PHMASK 0xFFFF
#endif
#define PH_ON(b) ((PHMASK >> (b)) & 1)
#ifndef PROBE_GEMM
#define PROBE_GEMM 0
#endif
#ifndef PROBE_ATTN
#define PROBE_ATTN 0
#endif
#ifndef PROBE_CHAIN
#define PROBE_CHAIN 0
#endif
#ifndef PROBE_A
#define PROBE_A 0
#endif
#ifndef PROBE_B
#define PROBE_B 0
#endif
#ifndef PROBE_MLCHAIN
#define PROBE_MLCHAIN 0
#endif

typedef unsigned short bf16_t;
typedef __attribute__((ext_vector_type(8))) short bf16x8;
typedef __attribute__((ext_vector_type(4))) float f32x4;
typedef __attribute__((ext_vector_type(4))) unsigned short us4;

constexpr int T_TOK = 81920;
constexpr int T_P = 16384;
constexpr int DM = 1024;
constexpr int NE = 4128, NE_PAD = 4352;
constexpr int NO = 3760, NO_PAD = 3840;
constexpr float EPS = 1e-6f;
constexpr int NPHASE = 24;
constexpr int LDS_BYTES = 72 * 1024;

struct Params {
  const float *x_prompt, *x_sample, *norm_g, *final_norm_g, *e_w_in, *e_a_up, *e_a_bias, *e_gla_norm_g,
      *e_pool_w, *e_pool_scale, *e_w_out, *o_w_in, *o_q_norm_g, *o_q_up, *o_kv_norm_g, *o_kv_up, *o_if_bias,
      *o_ml_norm_g, *o_w_out;
  float* out;
  bf16_t *WinE, *WinO, *WoutE, *WoutO, *QupT, *KVupT, *PoolWT, *AupT;
  int* counters;
  unsigned* bar;
  float* SSQ;
  bf16_t *Qb, *Kt, *VtE, *Gb, *LRb, *PUb, *PGb, *TMP, *QEb, *KdTb;
  float* EB;
  bf16_t *CQb, *CKVb, *KRb, *MGb, *MQb, *MKb, *MKt, *MVt, *MOb, *MLGb, *NUMIf, *NUMIb, *Qa, *KNb, *VtA;
  float *MIF, *EBI, *WKg, *DENI, *DEC;
  int ph_lo, ph_hi;
};

typedef __bf16 hbf2 __attribute__((ext_vector_type(2)));
typedef float hf2 __attribute__((ext_vector_type(2)));
__device__ __forceinline__ bf16_t f2bf(float f) {
  __bf16 b = (__bf16)f;
  return __builtin_bit_cast(bf16_t, b);
}
__device__ __forceinline__ unsigned pk2bf(float a, float b) {
  hf2 v = {a, b};
  hbf2 r = __builtin_convertvector(v, hbf2);
  return __builtin_bit_cast(unsigned, r);
}
__device__ __forceinline__ float bf2f(bf16_t b) { return __uint_as_float(((unsigned)b) << 16); }
__device__ __forceinline__ f32x4 mfma16(bf16x8 a, bf16x8 b, f32x4 c) {
  return __builtin_amdgcn_mfma_f32_16x16x32_bf16(a, b, c, 0, 0, 0);
}
__device__ __forceinline__ float logsigmoidf_(float x) { return fminf(x, 0.f) - log1pf(__expf(-fabsf(x))); }
__device__ __forceinline__ float siluf_(float x) { return x / (1.f + __expf(-x)); }
__device__ __forceinline__ float sigmoidf_(float x) { return 1.f / (1.f + __expf(-x)); }
__device__ __forceinline__ int otid() { int t = threadIdx.x; asm volatile("" : "+v"(t)); return t; }
__device__ __forceinline__ float bperm(int srclane, float v) { return __int_as_float(__builtin_amdgcn_ds_bpermute(srclane << 2, __float_as_int(v))); }
__device__ __forceinline__ float sxor(float v, int m, int lane) { return bperm(lane ^ m, v); }
typedef unsigned u32x2_t __attribute__((ext_vector_type(2)));
__device__ __forceinline__ float rowmax4(float v) {
  u32x2_t r = __builtin_amdgcn_permlane16_swap(__float_as_uint(v), __float_as_uint(v), false, false);
  v = fmaxf(__uint_as_float(r[0]), __uint_as_float(r[1]));
  r = __builtin_amdgcn_permlane32_swap(__float_as_uint(v), __float_as_uint(v), false, false);
  return fmaxf(__uint_as_float(r[0]), __uint_as_float(r[1]));
}
template <int CTRL> __device__ __forceinline__ float dpp_f(float v) {
  return __int_as_float(__builtin_amdgcn_update_dpp(0, __float_as_int(v), CTRL, 0xf, 0xf, false));
}
__device__ __forceinline__ float row_sum16(float v) {
  v += dpp_f<0x128>(v);
  v += dpp_f<0x124>(v);
  v += dpp_f<0x122>(v);
  v += dpp_f<0x121>(v);
  return v;
}
__device__ __forceinline__ float wave_sum(float v) {
  v += dpp_f<0x128>(v);
  v += dpp_f<0x124>(v);
  v += dpp_f<0x122>(v);
  v += dpp_f<0x121>(v);
  u32x2_t r = __builtin_amdgcn_permlane16_swap(__float_as_uint(v), __float_as_uint(v), false, false);
  v = __uint_as_float(r[0]) + __uint_as_float(r[1]);
  r = __builtin_amdgcn_permlane32_swap(__float_as_uint(v), __float_as_uint(v), false, false);
  return __uint_as_float(r[0]) + __uint_as_float(r[1]);
}
__device__ __forceinline__ bf16x8 zero8() { bf16x8 z = {0, 0, 0, 0, 0, 0, 0, 0}; return z; }
__device__ __forceinline__ f32x4 zero4() { f32x4 z = {0.f, 0.f, 0.f, 0.f}; return z; }

__device__ __forceinline__ int seq_pos(int tok) { return tok < T_P ? (tok & 4095) : ((tok - T_P) & 8191); }
__device__ __forceinline__ const float* xrow(const float* xa, const float* xb, int tok) {
  return tok < T_P ? xa + (long)tok * DM : xb + (long)(tok - T_P) * DM;
}


#define XB_TMO      128
#define XB_XCNT(j)  (256  + 64 * (j))
#define XB_XSUB(j)  (1280 + 64 * (j))
#define XB_XGEN(j)  (2304 + 64 * (j))
#define XB_TOP      3328
#define XB_TOPGEN   3392
#define XCD_BAR_WORDS 3456
#define XB_SPIN_CAP (1u << 22)
#define LAS __attribute__((address_space(3)))
__device__ __forceinline__ unsigned xb_ld(unsigned* p) { return __hip_atomic_load(p, __ATOMIC_RELAXED, __HIP_MEMORY_SCOPE_AGENT); }
__device__ __forceinline__ unsigned xb_add(unsigned* p, unsigned v) { return __hip_atomic_fetch_add(p, v, __ATOMIC_RELAXED, __HIP_MEMORY_SCOPE_AGENT); }
__device__ __forceinline__ unsigned xb_xcc_id() { return (unsigned)__builtin_amdgcn_s_getreg((3 << 11) | 20) & 0xFu; }
#define XB_SPIN(cond, bar) do { unsigned _sp = 0; while (cond) { __builtin_amdgcn_s_sleep(1); \
    if ((++_sp & 255u) == 0u) { if (xb_ld(&(bar)[XB_TMO])) break; if (_sp > XB_SPIN_CAP) { atomicAdd(&(bar)[XB_TMO], 1u); break; } } } } while (0)
struct XcdBarrier { unsigned* bar; unsigned x; volatile LAS unsigned* st; };
__device__ __forceinline__ XcdBarrier xcd_barrier_post(unsigned* bar, volatile LAS unsigned* st) {
  XcdBarrier b; b.bar = bar; b.x = xb_xcc_id(); b.st = st;
  if (threadIdx.x == 0) (void)xb_add(&bar[XB_XCNT(b.x)], 1u);
  return b;
}
__device__ __forceinline__ void xcd_barrier_complete(unsigned* bar, unsigned x, unsigned& nloc, unsigned& nx) {
  const unsigned G = gridDim.x * gridDim.y * gridDim.z;
  unsigned sum, cnt, mine, sp = 0u;
  for (;;) {
    sum = 0u; cnt = 0u; mine = 0u;
#pragma unroll
    for (unsigned j = 0; j < 16; ++j) { const unsigned cc = xb_ld(&bar[XB_XCNT(j)]); sum += cc; cnt += (cc > 0u) ? 1u : 0u; mine = (j == x) ? cc : mine; }
    if (sum == G) break;
    __builtin_amdgcn_s_sleep(1);
    if ((++sp & 255u) == 0u) { if (xb_ld(&bar[XB_TMO])) break; if (sp > XB_SPIN_CAP) { atomicAdd(&bar[XB_TMO], 1u); break; } }
  }
  nloc = mine > 0u ? mine : 1u; nx = cnt > 0u ? cnt : 1u;
}
__device__ __forceinline__ void xcd_barrier(const XcdBarrier& b) {
  asm volatile("s_waitcnt vmcnt(0)" ::: "memory");
  __syncthreads();
  if (threadIdx.x == 0) {
    unsigned* bar = b.bar;
    __builtin_amdgcn_s_waitcnt(0);
    unsigned nloc = b.st[0], nx = b.st[1];
    if (nloc == 0u) { xcd_barrier_complete(bar, b.x, nloc, nx); b.st[0] = nloc; b.st[1] = nx; }
    const unsigned old = xb_add(&bar[XB_XSUB(b.x)], 1u);
    const unsigned gen = old / nloc;
    if (old + 1u == (gen + 1u) * nloc) {
      __builtin_amdgcn_fence(__ATOMIC_RELEASE, "agent");
      asm volatile("s_waitcnt vmcnt(0)" ::: "memory");
      const unsigned og = xb_add(&bar[XB_TOP], 1u);
      const unsigned tg = og / nx;
      if (og + 1u == (tg + 1u) * nx) xb_add(&bar[XB_TOPGEN], 1u);
      else XB_SPIN(xb_ld(&bar[XB_TOPGEN]) == tg, bar);
      __builtin_amdgcn_fence(__ATOMIC_ACQUIRE, "agent");
      xb_add(&bar[XB_XGEN(b.x)], 1u);
      asm volatile("s_waitcnt vmcnt(0)" ::: "memory");
    } else {
      XB_SPIN(xb_ld(&bar[XB_XGEN(b.x)]) == gen, bar);
      __builtin_amdgcn_fence(__ATOMIC_ACQUIRE, "agent");
      asm volatile("s_waitcnt vmcnt(0)" ::: "memory");
    }
  }
  __syncthreads();
}

__device__ __forceinline__ int colmap(int mode, int n) {
  if (mode == 1) {
    if (n < 512) return 2208 + n;
    if (n < 1024) return 1696 + (n - 512);
    if (n < 1408) return n - 1024;
    if (n < 1664) return 384 + (n - 1408);
    if (n < 2176) return 672 + (n - 1664);
    if (n < 2688) return 1184 + (n - 2176);
    if (n < 3200) return 2720 + (n - 2688);
    if (n < 3712) return 3248 + (n - 3200);
    if (n < 3744) return 640 + (n - 3712);
    return 3232 + (n - 3744);
  }
  if (mode == 2) {
    if (n < 512) return (n >> 6) * 96 + (n & 63);
    const int r = n - 512;
    return (r >> 5) * 96 + 64 + (r & 31);
  }
  if (mode == 3) {
    if (n < 512) return (n >> 6) * 128 + (n & 63);
    const int r = n - 512;
    return (r >> 6) * 128 + 64 + (r & 63);
  }
  return n;
}

__device__ void prep_weight(const float* __restrict__ W, int K, int N, int Npad, const float* __restrict__ gsc,
                            bf16_t* __restrict__ out, char* smem, int mode = 0, int Nsrc_ = 0) {
  const int Nsrc = Nsrc_ ? Nsrc_ : N;
  const int tid = otid();
  float* sT = (float*)smem;
  const int tn = Npad >> 6, tk = K >> 6;
  for (int tile = blockIdx.x; tile < tn * tk; tile += gridDim.x) {
    const int n0 = (tile / tk) << 6, k0 = (tile % tk) << 6;
    __syncthreads();
#pragma unroll 4
    for (int i = 0; i < 16; ++i) {
      const int idx = tid + 256 * i;
      const int kk = idx >> 6, nn = idx & 63;
      float v = 0.f;
      if (n0 + nn < N) {
        v = W[(size_t)(k0 + kk) * Nsrc + colmap(mode, n0 + nn)];
        if (gsc) v *= gsc[k0 + kk];
      }
      sT[nn * 65 + kk] = v;
    }
    __syncthreads();
#pragma unroll 4
    for (int i = 0; i < 16; ++i) {
      const int idx = tid + 256 * i;
      const int nn = idx >> 6, kk = idx & 63;
      out[(size_t)(n0 + nn) * K + k0 + kk] = f2bf(sT[nn * 65 + kk]);
    }
  }
}

__device__ void phase_prep(const Params& p, char* smem) {
  long gtid = (long)blockIdx.x * 256 + otid();
  long gsize = (long)gridDim.x * 256;
  for (int l = 0; l < 2; ++l) {
    prep_weight(p.e_w_in + (long)l * DM * NE, DM, NE, NE_PAD, p.norm_g + (2 * l) * DM, p.WinE + (long)l * NE_PAD * DM, smem);
    prep_weight(p.o_w_in + (long)l * DM * 3760, DM, NO, NO_PAD, p.norm_g + (2 * l + 1) * DM, p.WinO + (long)l * NO_PAD * DM, smem, 1, 3760);
    prep_weight(p.e_w_out + (long)l * 1536 * DM, 1536, DM, DM, nullptr, p.WoutE + (long)l * DM * 1536, smem);
    prep_weight(p.o_w_out + (long)l * 1024 * DM, 1024, DM, DM, nullptr, p.WoutO + (long)l * DM * 1024, smem);
    prep_weight(p.o_q_up + (long)l * 384 * 768, 384, 768, 768, p.o_q_norm_g + l * 384, p.QupT + (long)l * 768 * 384, smem, 2);
    prep_weight(p.o_kv_up + (long)l * 256 * 1024, 256, 1024, 1024, p.o_kv_norm_g + l * 256, p.KVupT + (long)l * 1024 * 256, smem, 3);
    for (int gi = 0; gi < 4; ++gi)
      prep_weight(p.e_pool_w + (long)(l * 4 + gi) * 128 * 128, 128, 128, 128, nullptr, p.PoolWT + (long)(l * 4 + gi) * 128 * 128, smem);
    for (long idx = gtid; idx < 2 * 512 * 32; idx += gsize) {
      int r = (int)(idx & 31);
      int d = (int)((idx >> 5) & 511);
      int dir = (int)(idx >> 14);
      float v = (r < 16) ? p.e_a_up[((long)(l * 2 + dir) * 16 + r) * 512 + d] : 0.f;
      p.AupT[((long)(l * 2 + dir) * 512 + d) * 32 + r] = f2bf(v);
    }
  }
  if (gtid < 32) p.counters[gtid] = 0;
  {
    const int tid_ = otid();
    const int lane = tid_ & 63, w = tid_ >> 6;
  #pragma unroll 2
  for (int tok = blockIdx.x * 4 + w; tok < T_TOK; tok += gridDim.x * 4) {
      const float* xp = xrow(p.x_prompt, p.x_sample, tok) + 16 * lane;
      float ssv = 0.f;
      unsigned pk[8];
#pragma unroll
      for (int i = 0; i < 4; ++i) {
        const f32x4 v = *(const f32x4*)(xp + 4 * i);
        ssv += v[0] * v[0] + v[1] * v[1] + v[2] * v[2] + v[3] * v[3];
        pk[2 * i] = pk2bf(v[0], v[1]);
        pk[2 * i + 1] = pk2bf(v[2], v[3]);
      }
      uint4 o0, o1;
      o0.x = pk[0]; o0.y = pk[1]; o0.z = pk[2]; o0.w = pk[3];
      o1.x = pk[4]; o1.y = pk[5]; o1.z = pk[6]; o1.w = pk[7];
      *(uint4*)(p.TMP + (size_t)tok * DM + 16 * lane) = o0;
      *(uint4*)(p.TMP + (size_t)tok * DM + 16 * lane + 8) = o1;
      ssv = wave_sum(ssv);
      if (lane < 8) p.SSQ[(size_t)tok * 8 + lane] = (lane == 0) ? ssv : 0.f;
    }
  }
}

constexpr int G_LD = 40;
constexpr int G_BUF = (128 + 256) * G_LD;

template <int AMODE, int NI, class Epi>
__device__ __forceinline__ void gemm_phase(int Mtiles, int Ntiles, int K, const bf16_t* __restrict__ Bt, const float* ssq, const float* unused_,
                           const bf16_t* A1, int ld1, int K1, const bf16_t* A2, int ld2, const Epi& epi, char* smem) {
  bf16_t* sbase = (bf16_t*)smem;
  float* sR = (float*)(smem + 70144);
  const int tid = otid(), lane = tid & 63, w = tid >> 6, c = lane & 15, g = lane >> 4;
  const int wm = w >> 1, wn = w & 1;
  const int nk = K / 32;
  const int xcd = blockIdx.x & 7, lb0 = blockIdx.x >> 3, nlb = gridDim.x >> 3;
  const int mper = Mtiles >> 3;
  for (int lt = lb0; lt < mper * Ntiles; lt += nlb) {
    const int mt = xcd * mper + lt / Ntiles, nt = lt % Ntiles;
    constexpr int BN = 32 * NI;
    const int m0 = mt * 128, n0 = nt * BN;
    f32x4 acc[4][NI];
#pragma unroll
    for (int i = 0; i < 4; ++i)
#pragma unroll
      for (int j = 0; j < NI; ++j) acc[i][j] = zero4();
    float ss[2] = {0.f, 0.f};
    bf16x8 ra0[2], ra1[2];
    bf16x8 rb0[NI / 2], rb1[NI / 2];
    const unsigned boff = (unsigned)(tid >> 2) * K + 8 * (tid & 3);
    const bf16_t* bbase = Bt + (size_t)n0 * K;
#define G_LOAD(RA, RB, KT)                                                                          \
  {                                                                                                 \
    const int k0_ = (KT) * 32;                                                                      \
    const bf16_t* base_;                                                                            \
    int ld_;                                                                                        \
    if (k0_ < K1) { base_ = A1 + (size_t)m0 * ld1 + k0_; ld_ = ld1; }                               \
    else { base_ = A2 + (size_t)m0 * ld2 + (k0_ - K1); ld_ = ld2; }                                 \
    _Pragma("unroll") for (int i = 0; i < 2; ++i)                                                   \
      RA[i] = *(const bf16x8*)(base_ + (unsigned)((tid >> 2) + 64 * i) * ld_ + 8 * (tid & 3));      \
    _Pragma("unroll") for (int i = 0; i < NI / 2; ++i)                                              \
      RB[i] = *(const bf16x8*)(bbase + k0_ + boff + (unsigned)(64 * i) * K);                        \
  }
#define G_STORE(RA, RB, BUF)                                                                        \
  {                                                                                                 \
    bf16_t* sA_ = sbase + (BUF) * G_BUF;                                                            \
    bf16_t* sB_ = sA_ + 128 * G_LD;                                                                 \
    _Pragma("unroll") for (int i = 0; i < 2; ++i) {                                                 \
      bf16x8 v = RA[i];                                                                             \
      if constexpr (AMODE == 2) {                                                                   \
        _Pragma("unroll") for (int e = 0; e < 8; ++e) {                                             \
          float f = bf2f((bf16_t)v[e]);                                                             \
          ss[i] += f * f;                                                                           \
        }                                                                                           \
      }                                                                                             \
      *(bf16x8*)(sA_ + ((tid >> 2) + 64 * i) * G_LD + 8 * (tid & 3)) = v;                           \
    }                                                                                               \
    _Pragma("unroll") for (int i = 0; i < NI / 2; ++i)                                              \
      *(bf16x8*)(sB_ + ((tid >> 2) + 64 * i) * G_LD + 8 * (tid & 3)) = RB[i];                       \
  }
#define G_COMPUTE(BUF)     \
  {                                                                                                 \
    const bf16_t* sA_ = sbase + (BUF) * G_BUF;                                                      \
    const bf16_t* sB_ = sA_ + 128 * G_LD;                                                           \
    bf16x8 af[4];                                                                                   \
    _Pragma("unroll") for (int mi = 0; mi < 4; ++mi)                                                \
      af[mi] = *(const bf16x8*)(sA_ + (wm * 64 + mi * 16 + c) * G_LD + g * 8);                      \
    bf16x8 bq[2];                                                                                   \
    bq[0] = *(const bf16x8*)(sB_ + (wn * (16 * NI) + c) * G_LD + g * 8);                            \
    _Pragma("unroll") for (int ni = 0; ni < NI; ++ni) {                                             \
      if (ni + 1 < NI)                                                                              \
        bq[(ni + 1) & 1] = *(const bf16x8*)(sB_ + (wn * (16 * NI) + (ni + 1) * 16 + c) * G_LD + g * 8); \
      _Pragma("unroll") for (int mi = 0; mi < 4; ++mi)                                              \
        acc[mi][ni] = (!Epi::staged) ? mfma16(bq[ni & 1], af[mi], acc[mi][ni]) : mfma16(af[mi], bq[ni & 1], acc[mi][ni]); \
    }                                                                                               \
  }
    __syncthreads();
    if constexpr (AMODE == 3) {
      if (tid < 128) {
        const f32x4 p0 = *(const f32x4*)(ssq + (size_t)(m0 + tid) * 8);
        const f32x4 p1 = *(const f32x4*)(ssq + (size_t)(m0 + tid) * 8 + 4);
        const float sv = (p0[0] + p0[1]) + (p0[2] + p0[3]) + (p1[0] + p1[1]) + (p1[2] + p1[3]);
        sR[tid] = rsqrtf(sv * (1.f / 1024.f) + EPS);
      }
    }
    G_LOAD(ra0, rb0, 0)
    G_LOAD(ra1, rb1, 1)
    G_STORE(ra0, rb0, 0)
    __syncthreads();
    for (int kt = 0; kt < nk; kt += 2) {
      G_LOAD(ra0, rb0, min(kt + 2, nk - 1))
      G_COMPUTE(0)
      G_STORE(ra1, rb1, 1)
      __syncthreads();
      G_LOAD(ra1, rb1, min(kt + 3, nk - 1))
      G_COMPUTE(1)
      if (kt + 2 < nk) G_STORE(ra0, rb0, 0)
      __syncthreads();
    }
    if constexpr (AMODE == 2) {
#pragma unroll
      for (int i = 0; i < 2; ++i) {
        float sv = ss[i];
        sv += sxor(sv, 1, lane); sv += sxor(sv, 2, lane);
        if ((tid & 3) == 0) sR[(tid >> 2) + 64 * i] = rsqrtf(sv / (float)K + EPS);
      }
      __syncthreads();
    }
    if constexpr (Epi::staged) {
      bf16_t* sT = sbase;
      const float esc = epi.scale();
      const bool both = epi.both(n0);
#pragma unroll 1
      for (int pass = 0; pass < (both ? 2 : 1); ++pass) {
      const bool tr = both ? (pass == 1) : epi.transposed(n0);
      if (pass) __syncthreads();
      if (tr) {
#pragma unroll
        for (int mi = 0; mi < 4; ++mi) {
          const int row = wm * 64 + mi * 16 + 4 * g;
          const float r0 = sR[row] * esc, r1 = sR[row + 1] * esc, r2 = sR[row + 2] * esc, r3 = sR[row + 3] * esc;
#pragma unroll
          for (int ni = 0; ni < NI; ++ni) {
            uint2 o;
            o.x = pk2bf(acc[mi][ni][0] * r0, acc[mi][ni][1] * r1);
            o.y = pk2bf(acc[mi][ni][2] * r2, acc[mi][ni][3] * r3);
            *(uint2*)(sT + (wn * (16 * NI) + ni * 16 + c) * 136 + row) = o;
          }
        }
      } else {
#pragma unroll
        for (int mi = 0; mi < 4; ++mi) {
          const int row = wm * 64 + mi * 16 + 4 * g;
          const float r0 = sR[row] * esc, r1 = sR[row + 1] * esc, r2 = sR[row + 2] * esc, r3 = sR[row + 3] * esc;
#pragma unroll
          for (int ni = 0; ni < NI; ++ni) {
            bf16_t* d = sT + row * (BN + 8) + wn * (16 * NI) + ni * 16 + c;
            d[0] = f2bf(acc[mi][ni][0] * r0);
            d[BN + 8] = f2bf(acc[mi][ni][1] * r1);
            d[2 * (BN + 8)] = f2bf(acc[mi][ni][2] * r2);
            d[3 * (BN + 8)] = f2bf(acc[mi][ni][3] * r3);
          }
        }
      }
      if (pass == 0) epi.template direct<NI>(m0, n0, wm, wn, g, c, acc, sR);
      __syncthreads();
      if (tr) {
#pragma unroll 4
        for (int i = 0; i < 2 * NI; ++i) {
          const int id = tid + 256 * i;
          const int col = id >> 4, rc = id & 15;
          bf16x8 v = *(const bf16x8*)(sT + col * 136 + 8 * rc);
          epi.store_t(m0 + 8 * rc, n0 + col, v);
        }
      } else {
#pragma unroll 4
        for (int i = 0; i < 2 * NI; ++i) {
          const int id = tid + 256 * i;
          const int row = id / (4 * NI), cc = id % (4 * NI);
          const bf16_t* sp = sT + row * (BN + 8) + 8 * cc;
          bf16x8 v = *(const bf16x8*)sp;
          epi.store_n(m0 + row, n0 + 8 * cc, v, sp);
        }
      }
      }
    } else {
      float* sF = (float*)smem;
#pragma unroll 1
      for (int half = 0; half < 2; ++half) {
        if (half) __syncthreads();
        if (wm == half) {
#pragma unroll
          for (int mi = 0; mi < 4; ++mi)
#pragma unroll
            for (int ni = 0; ni < NI; ++ni) *(f32x4*)(sF + (mi * 16 + c) * 260 + wn * (16 * NI) + ni * 16 + 4 * g) = acc[mi][ni];
        }
        __syncthreads();
#pragma unroll 4
        for (int i = 0; i < 16; ++i) {
          const int row = w * 16 + i;
          const int tok = m0 + half * 64 + row;
          const int col = n0 + 4 * lane;
          const f32x4 a = *(const f32x4*)(sF + row * 260 + 4 * lane);
          const f32x4 xo = *(const f32x4*)(xrow(epi.xa, epi.xb, tok) + col);
          f32x4 xn;
          xn[0] = xo[0] + a[0]; xn[1] = xo[1] + a[1]; xn[2] = xo[2] + a[2]; xn[3] = xo[3] + a[3];
          float sv = xn[0] * xn[0] + xn[1] * xn[1] + xn[2] * xn[2] + xn[3] * xn[3];
          sv = wave_sum(sv);
          if (!epi.dry) {
            *(f32x4*)(epi.out + (size_t)tok * DM + col) = xn;
            if (epi.hb) {
              uint2 o;
              o.x = pk2bf(xn[0], xn[1]);
              o.y = pk2bf(xn[2], xn[3]);
              *(uint2*)(epi.hb + (size_t)tok * DM + col) = o;
            }
            if (lane == 0) epi.ssq[(size_t)tok * 8 + (n0 >> 8)] = sv;
          }
        }
      }
    }
  }
#undef G_LOAD
#undef G_STORE
#undef G_COMPUTE
}

__device__ __forceinline__ void rope_cs(int pos, int i, float& co, float& si) {
  float inv = exp2f(-(float)i * (13.287712379549449f / 16.f));
  float ang = (float)pos * inv;
  float n = rintf(ang * 0.15915494309189535f);
  float r = fmaf(-n, 6.28125f, ang);
  r = fmaf(-n, 0.0019353071795864769f, r);
  float rf = r * 0.15915494309189535f;
  si = __builtin_amdgcn_sinf(rf);
  co = __builtin_amdgcn_cosf(rf);
}

__device__ __forceinline__ void rope_chunk(int pos, int i0, bf16x8 x1, bf16x8 x2, bf16x8& o1, bf16x8& o2) {
#pragma unroll
  for (int e = 0; e < 8; ++e) {
    float co, si;
    rope_cs(pos, i0 + e, co, si);
    float a = bf2f((bf16_t)x1[e]), b = bf2f((bf16_t)x2[e]);
    o1[e] = (short)f2bf(a * co - b * si);
    o2[e] = (short)f2bf(b * co + a * si);
  }
}

struct EpiEvenIn {
  static constexpr bool staged = true;
  bf16_t *Qb, *Kt, *VtE, *Gb, *LRb, *PUb, *PGb;
  __device__ float scale() const { return 1.f; }
  __device__ bool transposed(int n0) const { return n0 >= 512 && n0 < 2048; }
  __device__ bool both(int n0) const { return false; }
  template <int NI> __device__ void direct(int m0, int n0, int wm, int wn, int g, int c, f32x4 (&acc)[4][NI], const float* sR) const {}
  __device__ void store_t(int tok8, int col, bf16x8 v) const {
    if (col < 1024) *(bf16x8*)(Kt + (size_t)(col - 512) * T_TOK + tok8) = v;
    else *(bf16x8*)(VtE + (size_t)(col - 1024) * T_TOK + tok8) = v;
  }
  __device__ void store_n(int tok, int col, bf16x8 v, const bf16_t* sp) const {
    bf16_t* d;
    if (col < 512) d = Qb + (size_t)tok * 512 + col;
    else if (col < 3072) d = Gb + (size_t)tok * 1024 + (col - 2048);
    else if (col < 3104) d = LRb + (size_t)tok * 32 + (col - 3072);
    else if (col < 3616) d = PUb + (size_t)tok * 512 + (col - 3104);
    else if (col < 4128) d = PGb + (size_t)tok * 512 + (col - 3616);
    else return;
    *(bf16x8*)d = v;
  }
};

struct EpiOddIn {
  static constexpr bool staged = true;
  bf16_t *CQb, *CKVb, *KRb, *MGb, *MQb, *MKb, *MKt, *MVt, *MOb, *MLGb;
  float* MIF;
  __device__ float scale() const { return 1.f; }
  __device__ bool transposed(int n0) const { return n0 < 512; }
  __device__ bool both(int n0) const { return n0 >= 512 && n0 < 1024; }
  template <int NI> __device__ void direct(int m0, int n0, int wm, int wn, int g, int c, f32x4 (&acc)[4][NI], const float* sR) const {
    if (n0 == 3584 && wn == 1) {
#pragma unroll
      for (int mi = 0; mi < 4; ++mi)
#pragma unroll
        for (int j = 0; j < 4; ++j) {
          const int row = wm * 64 + mi * 16 + 4 * g + j;
          MIF[(size_t)(m0 + row) * 16 + c] = acc[mi][2][j] * sR[row];
        }
    }
  }
  __device__ void store_t(int tok8, int col, bf16x8 v) const {
    if (col < 512) *(bf16x8*)(MVt + (size_t)col * T_TOK + tok8) = v;
    else *(bf16x8*)(MKt + (size_t)(col - 512) * T_TOK + tok8) = v;
  }
  __device__ void store_n(int tok, int col, bf16x8 v, const bf16_t* sp) const {
    bf16_t* d;
    if (col < 1024) d = MKb + (size_t)tok * 512 + (col - 512);
    else if (col < 1408) d = CQb + (size_t)tok * 384 + (col - 1024);
    else if (col < 1664) d = CKVb + (size_t)tok * 256 + (col - 1408);
    else if (col < 2176) d = MGb + (size_t)tok * 512 + (col - 1664);
    else if (col < 2688) d = MQb + (size_t)tok * 512 + (col - 2176);
    else if (col < 3200) d = MOb + (size_t)tok * 512 + (col - 2688);
    else if (col < 3712) d = MLGb + (size_t)tok * 512 + (col - 3200);
    else if (col < 3728) {
      bf16x8 x2 = *(const bf16x8*)(sp + 16);
      bf16x8 o1, o2;
      rope_chunk(seq_pos(tok), col - 3712, v, x2, o1, o2);
      *(bf16x8*)(KRb + (size_t)tok * 32 + (col - 3712)) = o1;
      *(bf16x8*)(KRb + (size_t)tok * 32 + 16 + (col - 3712)) = o2;
      return;
    } else return;
    *(bf16x8*)d = v;
  }
};

struct EpiQUp {
  static constexpr bool staged = true;
  bf16_t* Qa;
  __device__ float scale() const { return 0.10206207261596575f * 1.4426950408889634f; }
  __device__ bool transposed(int n0) const { return false; }
  __device__ bool both(int n0) const { return false; }
  template <int NI> __device__ void direct(int m0, int n0, int wm, int wn, int g, int c, f32x4 (&acc)[4][NI], const float* sR) const {}
  __device__ void store_t(int tok8, int col, bf16x8 v) const {}
  __device__ void store_n(int tok, int col, bf16x8 v, const bf16_t* sp) const {
    if (col < 512) {
      *(bf16x8*)(Qa + (size_t)tok * 768 + (col >> 6) * 96 + (col & 63)) = v;
    } else {
      const int r = col - 512, head = r >> 5, rr = r & 31;
      if (rr < 16) {
        bf16x8 x2 = *(const bf16x8*)(sp + 16);
        bf16x8 o1, o2;
        rope_chunk(seq_pos(tok), rr, v, x2, o1, o2);
        *(bf16x8*)(Qa + (size_t)tok * 768 + head * 96 + 64 + rr) = o1;
        *(bf16x8*)(Qa + (size_t)tok * 768 + head * 96 + 80 + rr) = o2;
      }
    }
  }
};

struct EpiKVUp {
  static constexpr bool staged = true;
  bf16_t *KNb, *VtA;
  __device__ float scale() const { return 1.f; }
  __device__ bool transposed(int n0) const { return n0 >= 512; }
  __device__ bool both(int n0) const { return false; }
  template <int NI> __device__ void direct(int m0, int n0, int wm, int wn, int g, int c, f32x4 (&acc)[4][NI], const float* sR) const {}
  __device__ void store_t(int tok8, int col, bf16x8 v) const { *(bf16x8*)(VtA + (size_t)(col - 512) * T_TOK + tok8) = v; }
  __device__ void store_n(int tok, int col, bf16x8 v, const bf16_t* sp) const { *(bf16x8*)(KNb + (size_t)tok * 512 + col) = v; }
};

struct EpiOut {
  static constexpr bool staged = false;
  const float *xa, *xb;
  float* out;
  bool dry;
  bf16_t* hb;
  float* ssq;
};

template <int CTRL> __device__ __forceinline__ float dpp_z(float v) {
  return __int_as_float(__builtin_amdgcn_update_dpp(0, __float_as_int(v), CTRL, 0xf, 0xf, true));
}
__device__ __forceinline__ float scan16(float v, int c, int lane) {
  v += dpp_z<0x111>(v);
  v += dpp_z<0x112>(v);
  v += dpp_z<0x114>(v);
  v += dpp_z<0x118>(v);
  return v;
}

__device__ __forceinline__ float logsig_fast(float x) { return fminf(x, 0.f) - __logf(1.f + __expf(-fabsf(x))); }

__device__ void gla_intra_item(const Params& p, int li, int item, char* smem, bool dry = false) {
  const int tid = otid(), lane = tid & 63, w = tid >> 6, c = lane & 15, g = lane >> 4;
  const int ci = item >> 2, h = item & 3;
  const int tokc = ci * 64;
  const float qscale = 0.08838834764831845f;
  bf16_t* sQe = (bf16_t*)smem;
  bf16_t* sKd = sQe + 64 * 136;
  bf16_t* sA = sKd + 64 * 136;
  us4 q4[2][4];
  bf16_t kk[2][4][4];
#pragma unroll
  for (int dt = 0; dt < 2; ++dt)
#pragma unroll
    for (int tt = 0; tt < 4; ++tt) {
      q4[dt][tt] = *(const us4*)(p.Qb + (size_t)(tokc + 16 * tt + c) * 512 + h * 128 + 32 * w + 16 * dt + 4 * g);
#pragma unroll
      for (int j = 0; j < 4; ++j)
        kk[dt][tt][j] = p.Kt[(size_t)(h * 128 + 32 * w + 16 * dt + 4 * g + j) * T_TOK + tokc + 16 * tt + c];
    }
  __syncthreads();
#pragma unroll
  for (int dir = 0; dir < 2; ++dir) {
    bf16_t* QEd = (dir || dry) ? p.QEb : p.Qb;
    bf16_t* KdTd = (dir || dry) ? p.KdTb : p.Kt;
    bf16x8 aup[2];
    float bias[2][4];
#pragma unroll
    for (int dt = 0; dt < 2; ++dt) {
      aup[dt] = zero8();
      if (g < 2) aup[dt] = *(const bf16x8*)(p.AupT + ((size_t)(li * 2 + dir) * 512 + h * 128 + 32 * w + 16 * dt + c) * 32 + 8 * g);
#pragma unroll
      for (int j = 0; j < 4; ++j) bias[dt][j] = p.e_a_bias[(li * 2 + dir) * 512 + h * 128 + 32 * w + 16 * dt + 4 * g + j];
    }
    f32x4 la[2][4];
#pragma unroll
    for (int tt = 0; tt < 4; ++tt) {
      bf16x8 lrf = zero8();
      if (g < 2) lrf = *(const bf16x8*)(p.LRb + (size_t)(tokc + 16 * tt + c) * 32 + dir * 16 + 8 * g);
#pragma unroll
      for (int dt = 0; dt < 2; ++dt) la[dt][tt] = mfma16(aup[dt], lrf, zero4());
    }
#pragma unroll
    for (int dt = 0; dt < 2; ++dt)
#pragma unroll
      for (int tt = 0; tt < 4; ++tt)
#pragma unroll
        for (int j = 0; j < 4; ++j) la[dt][tt][j] = logsig_fast(la[dt][tt][j] + bias[dt][j]) * (1.f / 16.f);
    f32x4 P[2][4];
    float tot[2][4];
#pragma unroll
    for (int dt = 0; dt < 2; ++dt)
#pragma unroll
      for (int j = 0; j < 4; ++j) {
        float carry = 0.f;
#pragma unroll
        for (int tt = 0; tt < 4; ++tt) {
          float v = scan16(la[dt][tt][j], c, lane) + carry;
          P[dt][tt][j] = v;
          carry = dpp_f<0x15F>(v);
        }
        tot[dt][j] = carry;
      }
#pragma unroll
    for (int dt = 0; dt < 2; ++dt)
#pragma unroll
      for (int tt = 0; tt < 4; ++tt) {
        us4 qo, ko;
#pragma unroll
        for (int j = 0; j < 4; ++j) {
          const float b = (dir == 0) ? P[dt][tt][j] : (tot[dt][j] - P[dt][tt][j] + la[dt][tt][j]);
          qo[j] = f2bf(bf2f(q4[dt][tt][j]) * __expf(b) * qscale);
          ko[j] = f2bf(bf2f(kk[dt][tt][j]) * __expf(-b));
        }
        *(us4*)(QEd + (size_t)(tokc + 16 * tt + c) * 512 + h * 128 + 32 * w + 16 * dt + 4 * g) = qo;
        *(us4*)(sQe + (16 * tt + c) * 136 + 32 * w + 16 * dt + 4 * g) = qo;
        *(us4*)(sKd + (16 * tt + c) * 136 + 32 * w + 16 * dt + 4 * g) = ko;
      }
    if (c == 0) {
#pragma unroll
      for (int dt = 0; dt < 2; ++dt)
#pragma unroll
        for (int j = 0; j < 4; ++j)
          p.EB[(size_t)(dir * 1280 + ci) * 512 + h * 128 + 32 * w + 16 * dt + 4 * g + j] = __expf(tot[dt][j]);
    }
    __syncthreads();
#pragma unroll
    for (int i = 0; i < 4; ++i) {
      const int id = tid + 256 * i;
      const int d = id & 127, c8 = id >> 7;
      bf16x8 v;
#pragma unroll
      for (int e = 0; e < 8; ++e) v[e] = (short)sKd[(8 * c8 + e) * 136 + d];
      *(bf16x8*)(KdTd + (size_t)(h * 128 + d) * T_TOK + tokc + 8 * c8) = v;
    }
    f32x4 accA[4];
#pragma unroll
    for (int jt = 0; jt < 4; ++jt) accA[jt] = zero4();
#pragma unroll
    for (int ks = 0; ks < 4; ++ks) {
      bf16x8 aq = *(const bf16x8*)(sQe + (16 * w + c) * 136 + 32 * ks + 8 * g);
#pragma unroll
      for (int jt = 0; jt < 4; ++jt) {
        bf16x8 bk = *(const bf16x8*)(sKd + (16 * jt + c) * 136 + 32 * ks + 8 * g);
        accA[jt] = mfma16(aq, bk, accA[jt]);
      }
    }
#pragma unroll
    for (int jt = 0; jt < 4; ++jt)
#pragma unroll
      for (int j = 0; j < 4; ++j) {
        const int i = 16 * w + 4 * g + j, jj = 16 * jt + c;
        const bool keep = (dir == 0) ? (jj <= i) : (jj > i);
        sA[dir * 64 * 72 + i * 72 + jj] = f2bf(keep ? accA[jt][j] : 0.f);
      }
    __syncthreads();
  }
  bf16x8 af[2][2];
#pragma unroll
  for (int dir = 0; dir < 2; ++dir)
#pragma unroll
    for (int k2 = 0; k2 < 2; ++k2) af[dir][k2] = *(const bf16x8*)(sA + dir * 64 * 72 + (16 * w + c) * 72 + 32 * k2 + 8 * g);
  bf16_t* sO = (bf16_t*)smem;
#pragma unroll 4
  for (int vt = 0; vt < 16; ++vt) {
    f32x4 a = zero4();
#pragma unroll
    for (int k2 = 0; k2 < 2; ++k2) {
      bf16x8 vfr = *(const bf16x8*)(p.VtE + (size_t)(h * 256 + 16 * vt + c) * T_TOK + tokc + 32 * k2 + 8 * g);
      a = mfma16(af[0][k2], vfr, a);
      a = mfma16(af[1][k2], vfr, a);
    }
#pragma unroll
    for (int j = 0; j < 4; ++j) sO[(16 * w + 4 * g + j) * 264 + 16 * vt + c] = f2bf(a[j]);
  }
  __syncthreads();
#pragma unroll
  for (int i = 0; i < 8; ++i) {
    const int id = tid + 256 * i;
    const int row = id >> 5, c8 = id & 31;
    *(bf16x8*)(p.TMP + (size_t)(tokc + row) * 1024 + h * 256 + 8 * c8) = *(const bf16x8*)(sO + row * 264 + 8 * c8);
  }
}

__device__ __forceinline__ void lds_barrier() { asm volatile("s_waitcnt lgkmcnt(0)\n\ts_barrier" ::: "memory"); }

struct GlaRegs {
  bf16x8 aq[4];
  bf16x8 vf[2][2];
  bf16x8 kf[2][2];
  float eb[2];
  unsigned told[2][4];
};

template <int DIR>
__device__ __forceinline__ void gla_chain_load(const Params& p, int h, int sl, int tokc, int w, int c, int g, GlaRegs& r) {
  const bf16_t* QE = DIR ? p.QEb : p.Qb;
  const bf16_t* KdT = DIR ? p.KdTb : p.Kt;
#pragma unroll
  for (int ks = 0; ks < 4; ++ks) r.aq[ks] = *(const bf16x8*)(QE + (size_t)(tokc + 16 * w + c) * 512 + h * 128 + 32 * ks + 8 * g);
#pragma unroll
  for (int vt = 0; vt < 2; ++vt)
#pragma unroll
    for (int k2 = 0; k2 < 2; ++k2)
      r.vf[vt][k2] = *(const bf16x8*)(p.VtE + (size_t)(h * 256 + sl * 32 + 16 * vt + c) * T_TOK + tokc + 32 * k2 + 8 * g);
#pragma unroll
  for (int dt = 0; dt < 2; ++dt) {
#pragma unroll
    for (int k2 = 0; k2 < 2; ++k2)
      r.kf[dt][k2] = *(const bf16x8*)(KdT + (size_t)(h * 128 + 32 * w + 16 * dt + c) * T_TOK + tokc + 32 * k2 + 8 * g);
    r.eb[dt] = p.EB[(size_t)(DIR * 1280 + (tokc >> 6)) * 512 + h * 128 + 32 * w + 16 * dt + c];
  }
#pragma unroll
  for (int vt = 0; vt < 2; ++vt)
#pragma unroll
    for (int j = 0; j < 4; ++j) r.told[vt][j] = p.TMP[(size_t)(tokc + 16 * w + 4 * g + j) * 1024 + h * 256 + sl * 32 + 16 * vt + c];
}

__device__ __forceinline__ void gla_chain_compute(const Params& p, int h, int sl, int tokc, int w, int c, int g, const GlaRegs& r,
                                                  f32x4 (&S)[2][2], bf16_t* sSt, bool dry, bool reload) {
  unsigned told[2][4];
#pragma unroll
  for (int vt = 0; vt < 2; ++vt)
#pragma unroll
    for (int j = 0; j < 4; ++j) told[vt][j] = r.told[vt][j];
  if (reload) {
#pragma unroll
    for (int vt = 0; vt < 2; ++vt)
#pragma unroll
      for (int j = 0; j < 4; ++j) told[vt][j] = p.TMP[(size_t)(tokc + 16 * w + 4 * g + j) * 1024 + h * 256 + sl * 32 + 16 * vt + c];
  }
#pragma unroll
  for (int vt = 0; vt < 2; ++vt)
#pragma unroll
    for (int dt = 0; dt < 2; ++dt)
#pragma unroll
      for (int j = 0; j < 4; ++j) sSt[(16 * vt + 4 * g + j) * 136 + 32 * w + 16 * dt + c] = f2bf(S[vt][dt][j]);
  lds_barrier();
  f32x4 o[2];
  o[0] = zero4(); o[1] = zero4();
#pragma unroll
  for (int ks = 0; ks < 4; ++ks)
#pragma unroll
    for (int vt = 0; vt < 2; ++vt) {
      bf16x8 sf = *(const bf16x8*)(sSt + (16 * vt + c) * 136 + 32 * ks + 8 * g);
      o[vt] = mfma16(r.aq[ks], sf, o[vt]);
    }
#pragma unroll
  for (int dt = 0; dt < 2; ++dt)
#pragma unroll
    for (int vt = 0; vt < 2; ++vt) {
      f32x4 a = S[vt][dt];
#pragma unroll
      for (int k2 = 0; k2 < 2; ++k2) a = mfma16(r.vf[vt][k2], r.kf[dt][k2], a);
      S[vt][dt] = a * r.eb[dt];
    }
#pragma unroll
  for (int vt = 0; vt < 2; ++vt)
#pragma unroll
    for (int j = 0; j < 4; ++j)
      if (!dry) p.TMP[(size_t)(tokc + 16 * w + 4 * g + j) * 1024 + h * 256 + sl * 32 + 16 * vt + c] = f2bf(bf2f((bf16_t)told[vt][j]) + o[vt][j]);
}

__device__ void gla_chain_item(const Params& p, int li, int item, char* smem, bool dry = false) {
  const int tid = otid(), lane = tid & 63, w = tid >> 6, c = lane & 15, g = lane >> 4;
  const int xr = item >> 3;
  const int pair = (item & 7) + 8 * (xr >> 3), sl = xr & 7;
  const int s = pair < 32 ? 4 + (pair >> 2) : ((pair - 32) >> 2);
  const int h = pair & 3;
  const int tok0 = s < 4 ? s * 4096 : T_P + (s - 4) * 8192;
  const int len = s < 4 ? 4096 : 8192;
  const int N = len / 64;
  bf16_t* sSt0 = (bf16_t*)smem;
  bf16_t* sSt1 = sSt0 + 32 * 136;
  f32x4 Sf[2][2], Sb[2][2];
#pragma unroll
  for (int a = 0; a < 2; ++a)
#pragma unroll
    for (int b = 0; b < 2; ++b) { Sf[a][b] = zero4(); Sb[a][b] = zero4(); }
  GlaRegs rf, rb;
  __syncthreads();
  gla_chain_load<0>(p, h, sl, tok0, w, c, g, rf);
  for (int step = 0; step < N; ++step) {
    const int tf = tok0 + step * 64, tb = tok0 + (N - 1 - step) * 64;
    gla_chain_load<1>(p, h, sl, tb, w, c, g, rb);
    gla_chain_compute(p, h, sl, tf, w, c, g, rf, Sf, sSt0, dry, step == (N >> 1));
    if (step + 1 < N) gla_chain_load<0>(p, h, sl, tf + 64, w, c, g, rf);
    gla_chain_compute(p, h, sl, tb, w, c, g, rb, Sb, sSt1, dry, false);
  }
}

__device__ void pool_item(const Params& p, int li, int item, char* smem, bool dry = false) {
  const int tid = otid(), lane = tid & 63, w = tid >> 6, c = lane & 15, g = lane >> 4;
  const int gi = item & 3;
  const int tile = item >> 2;
  const int tokc = tile * 64;
  const int pos0 = seq_pos(tokc);
  const int len = tokc < T_P ? 4096 : 8192;
  float* sU = (float*)smem;
  bf16_t* sP = (bf16_t*)(sU + 80 * 128);
  __syncthreads();
  for (int idx = tid; idx < 80 * 128; idx += 256) {
    int r = idx >> 7, ch = idx & 127;
    int pos = pos0 - 8 + r;
    float v = 0.f;
    if (pos >= 0 && pos < len) v = bf2f(p.PUb[(long)(tokc - 8 + r) * 512 + gi * 128 + ch]);
    sU[idx] = v;
  }
  __syncthreads();
  {
    const int ch = tid & 127, th = tid >> 7;
    const int half = 1 << gi;
    for (int t = th * 32; t < th * 32 + 32; ++t) {
      int pos = pos0 + t;
      int lo = max(pos - half, 0), hi = min(pos + half, len);
      float s = 0.f;
      for (int q = lo; q < hi; ++q) s += sU[(q - pos0 + 8) * 128 + ch];
      float pooled = s / (float)(hi - lo) - sU[(t + 8) * 128 + ch];
      sP[t * 136 + ch] = f2bf(pooled);
    }
  }
  __syncthreads();
  f32x4 acc[8];
#pragma unroll
  for (int dt = 0; dt < 8; ++dt) acc[dt] = zero4();
  const bf16_t* PW = p.PoolWT + (long)(li * 4 + gi) * 128 * 128;
#pragma unroll
  for (int ks = 0; ks < 4; ++ks) {
    bf16x8 af = *(const bf16x8*)(sP + (16 * w + c) * 136 + 32 * ks + 8 * g);
#pragma unroll
    for (int dt = 0; dt < 8; ++dt) {
      bf16x8 bw = *(const bf16x8*)(PW + (long)(16 * dt + c) * 128 + 32 * ks + 8 * g);
      acc[dt] = mfma16(af, bw, acc[dt]);
    }
  }
#pragma unroll
  for (int dt = 0; dt < 8; ++dt) {
    const int d = gi * 128 + 16 * dt + c;
    const float sc = p.e_pool_scale[li * 512 + d];
#pragma unroll
    for (int j = 0; j < 4; ++j) {
      const long addr = (long)(tokc + 16 * w + 4 * g + j) * 512 + d;
      float gt = bf2f(p.PGb[addr]);
      if (!dry) p.PGb[addr] = f2bf(acc[dt][j] * sc * siluf_(gt));
    }
  }
}

__device__ void ml_intra_item(const Params& p, int li, int item, char* smem) {
  const int tid = otid(), lane = tid & 63, w = tid >> 6, c = lane & 15, g = lane >> 4;
  const int ci = item >> 2, h = item & 3;
  const int tokc = ci * 64;
  const float kscale = 0.08838834764831845f;
  bf16_t* sA = (bf16_t*)smem;
  float* sBv = (float*)(sA + 2 * 64 * 72);
  float* sCB = sBv + 128;
  __syncthreads();
  if (w < 2) {
    const int dir = w;
    const float bi = p.o_if_bias[li * 16 + dir * 4 + h];
    const float bff = p.o_if_bias[li * 16 + 8 + dir * 4 + h];
    const float* mf = p.MIF + (size_t)(tokc + lane) * 16;
    const float liv = mf[dir * 4 + h] + bi;
    const float lfv = logsig_fast(mf[8 + dir * 4 + h] + bff);
    float ps = lfv;
#pragma unroll
    for (int d = 1; d < 64; d <<= 1) {
      float t = bperm(lane - d, ps);
      if (lane >= d) ps += t;
    }
    const float total = __int_as_float(__builtin_amdgcn_readlane(__float_as_int(ps), 63));
    const float b = (dir == 0) ? ps : (total - ps + lfv);
    const float cB = liv - b;
    sBv[dir * 64 + lane] = b;
    sCB[dir * 64 + lane] = cB;
    const size_t so = (size_t)(dir * 4 + h) * T_TOK + tokc + lane;
    p.EBI[so] = __expf(b);
    p.WKg[so] = __expf(total + cB) * kscale;
    if (lane == 0) p.DEC[(dir * 4 + h) * 1280 + ci] = __expf(total);
  }
  f32x4 accA[4];
#pragma unroll
  for (int jt = 0; jt < 4; ++jt) accA[jt] = zero4();
#pragma unroll
  for (int ks = 0; ks < 4; ++ks) {
    bf16x8 aq = *(const bf16x8*)(p.MQb + (size_t)(tokc + 16 * w + c) * 512 + h * 128 + 32 * ks + 8 * g);
#pragma unroll
    for (int jt = 0; jt < 4; ++jt) {
      bf16x8 bk = *(const bf16x8*)(p.MKb + (size_t)(tokc + 16 * jt + c) * 512 + h * 128 + 32 * ks + 8 * g);
      accA[jt] = mfma16(aq, bk, accA[jt]);
    }
  }
  __syncthreads();
#pragma unroll
  for (int dir = 0; dir < 2; ++dir)
#pragma unroll
    for (int jt = 0; jt < 4; ++jt)
#pragma unroll
      for (int j = 0; j < 4; ++j) {
        const int i = 16 * w + 4 * g + j, jj = 16 * jt + c;
        const bool keep = (dir == 0) ? (jj <= i) : (jj > i);
        const float sv = keep ? accA[jt][j] * kscale * __expf(sBv[dir * 64 + i] + sCB[dir * 64 + jj]) : 0.f;
        sA[dir * 64 * 72 + i * 72 + jj] = f2bf(sv);
      }
  __syncthreads();
  bf16x8 ones = zero8();
  if (c == 0) {
#pragma unroll
    for (int e = 0; e < 8; ++e) ones[e] = (short)0x3F80;
  }
#pragma unroll
  for (int dir = 0; dir < 2; ++dir) {
    bf16_t* NUMI = dir ? p.NUMIb : p.NUMIf;
    bf16x8 af[2];
#pragma unroll
    for (int k2 = 0; k2 < 2; ++k2) af[k2] = *(const bf16x8*)(sA + dir * 64 * 72 + (16 * w + c) * 72 + 32 * k2 + 8 * g);
    f32x4 dn = zero4();
    dn = mfma16(af[0], ones, dn);
    dn = mfma16(af[1], ones, dn);
    if (c == 0) {
#pragma unroll
      for (int j = 0; j < 4; ++j) p.DENI[(size_t)(dir * 4 + h) * T_TOK + tokc + 16 * w + 4 * g + j] = dn[j];
    }
    bf16_t* sO = sA + 2 * 64 * 72 + 512;
#pragma unroll 4
    for (int vt = 0; vt < 8; ++vt) {
      f32x4 a = zero4();
#pragma unroll
      for (int k2 = 0; k2 < 2; ++k2) {
        bf16x8 vfr = *(const bf16x8*)(p.MVt + (size_t)(h * 128 + 16 * vt + c) * T_TOK + tokc + 32 * k2 + 8 * g);
        a = mfma16(af[k2], vfr, a);
      }
#pragma unroll
      for (int j = 0; j < 4; ++j) sO[(16 * w + 4 * g + j) * 136 + 16 * vt + c] = f2bf(a[j]);
    }
    __syncthreads();
#pragma unroll
    for (int i = 0; i < 4; ++i) {
      const int id = tid + 256 * i;
      const int row = id >> 4, c8 = id & 15;
      *(bf16x8*)(NUMI + (size_t)(tokc + row) * 512 + h * 128 + 8 * c8) = *(const bf16x8*)(sO + row * 136 + 8 * c8);
    }
    __syncthreads();
  }
}

struct MlRegs {
  bf16x8 aq[4];
  bf16x8 vf[2];
  bf16x8 kf[2][2];
  f32x4 wk[2][2];
  f32x4 ebi, deni;
  float dec;
  unsigned numi[4];
};

template <int DIR>
__device__ __forceinline__ void ml_chain_load(const Params& p, int h, int sl, int tokc, int w, int c, int g, MlRegs& r) {
#pragma unroll
  for (int ks = 0; ks < 4; ++ks) r.aq[ks] = *(const bf16x8*)(p.MQb + (size_t)(tokc + 16 * w + c) * 512 + h * 128 + 32 * ks + 8 * g);
#pragma unroll
  for (int k2 = 0; k2 < 2; ++k2)
    r.vf[k2] = *(const bf16x8*)(p.MVt + (size_t)(h * 128 + sl * 16 + c) * T_TOK + tokc + 32 * k2 + 8 * g);
#pragma unroll
  for (int dt = 0; dt < 2; ++dt)
#pragma unroll
    for (int k2 = 0; k2 < 2; ++k2)
      r.kf[dt][k2] = *(const bf16x8*)(p.MKt + (size_t)(h * 128 + 32 * w + 16 * dt + c) * T_TOK + tokc + 32 * k2 + 8 * g);
  const size_t so = (size_t)(DIR * 4 + h) * T_TOK + tokc;
#pragma unroll
  for (int k2 = 0; k2 < 2; ++k2) {
    r.wk[k2][0] = *(const f32x4*)(p.WKg + so + 32 * k2 + 8 * g);
    r.wk[k2][1] = *(const f32x4*)(p.WKg + so + 32 * k2 + 8 * g + 4);
  }
  r.ebi = *(const f32x4*)(p.EBI + so + 16 * w + 4 * g);
  r.deni = *(const f32x4*)(p.DENI + so + 16 * w + 4 * g);
  r.dec = p.DEC[(DIR * 4 + h) * 1280 + (tokc >> 6)];
  const bf16_t* NUMI = DIR ? p.NUMIb : p.NUMIf;
#pragma unroll
  for (int j = 0; j < 4; ++j) r.numi[j] = NUMI[(size_t)(tokc + 16 * w + 4 * g + j) * 512 + h * 128 + sl * 16 + c];
}

template <int DIR>
__device__ __forceinline__ void ml_chain_compute(const Params& p, int h, int sl, int tokc, int lane, int w, int c, int g, const MlRegs& r,
                                                 f32x4 (&C)[2][2], bf16_t* sCt, bool dry) {
  bf16_t* NUMI = DIR ? p.NUMIb : p.NUMIf;
  unsigned numi[4];
#pragma unroll
  for (int j = 0; j < 4; ++j) numi[j] = r.numi[j];
#pragma unroll
  for (int vt = 0; vt < 2; ++vt)
#pragma unroll
    for (int dt = 0; dt < 2; ++dt)
#pragma unroll
      for (int j = 0; j < 4; ++j) sCt[(16 * vt + 4 * g + j) * 136 + 32 * w + 16 * dt + c] = f2bf(C[vt][dt][j]);
  bf16x8 vfw[2][2];
#pragma unroll
  for (int k2 = 0; k2 < 2; ++k2) {
    float wv[8];
#pragma unroll
    for (int e = 0; e < 4; ++e) { wv[e] = r.wk[k2][0][e]; wv[4 + e] = r.wk[k2][1][e]; }
#pragma unroll
    for (int e = 0; e < 8; ++e) vfw[0][k2][e] = (short)f2bf(bf2f((bf16_t)r.vf[k2][e]) * wv[e]);
#pragma unroll
    for (int e = 0; e < 8; ++e) vfw[1][k2][e] = (c == 0) ? (short)f2bf(wv[e]) : (short)0;
  }
  lds_barrier();
  f32x4 o2[2];
  o2[0] = zero4(); o2[1] = zero4();
#pragma unroll
  for (int ks = 0; ks < 4; ++ks)
#pragma unroll
    for (int vt = 0; vt < 2; ++vt) {
      bf16x8 cf = *(const bf16x8*)(sCt + (16 * vt + c) * 136 + 32 * ks + 8 * g);
      o2[vt] = mfma16(r.aq[ks], cf, o2[vt]);
    }
#pragma unroll
  for (int dt = 0; dt < 2; ++dt)
#pragma unroll
    for (int vt = 0; vt < 2; ++vt) {
      f32x4 a = C[vt][dt] * r.dec;
#pragma unroll
      for (int k2 = 0; k2 < 2; ++k2) a = mfma16(vfw[vt][k2], r.kf[dt][k2], a);
      C[vt][dt] = a;
    }
#pragma unroll
  for (int j = 0; j < 4; ++j) {
    const float e = r.ebi[j];
    float den = e * o2[1][j];
    den = dpp_f<0x150>(den) + r.deni[j];
    const float inv = 1.f / fmaxf(fabsf(den), 1.f);
    const float hv = (bf2f((bf16_t)numi[j]) + e * o2[0][j]) * inv;
    if (!dry) NUMI[(size_t)(tokc + 16 * w + 4 * g + j) * 512 + h * 128 + sl * 16 + c] = f2bf(hv);
  }
}

template <int DIR>
__device__ __forceinline__ void ml_chain_run(const Params& p, int h, int sl, int tok0, int N, int lane, int w, int c, int g, bf16_t* sCt0, bool dry) {
  bf16_t* sCt1 = sCt0 + 32 * 136;
  f32x4 C[2][2];
#pragma unroll
  for (int a = 0; a < 2; ++a)
#pragma unroll
    for (int b = 0; b < 2; ++b) C[a][b] = zero4();
  MlRegs r0, r1;
  ml_chain_load<DIR>(p, h, sl, tok0 + (DIR ? N - 1 : 0) * 64, w, c, g, r0);
  for (int n = 0; n < N; n += 2) {
    const int c0 = DIR ? N - 1 - n : n;
    const int c1 = DIR ? N - 2 - n : n + 1;
    const int n2 = min(n + 2, N - 1);
    const int c2 = DIR ? N - 1 - n2 : n2;
    ml_chain_load<DIR>(p, h, sl, tok0 + c1 * 64, w, c, g, r1);
    ml_chain_compute<DIR>(p, h, sl, tok0 + c0 * 64, lane, w, c, g, r0, C, sCt0, dry);
    ml_chain_load<DIR>(p, h, sl, tok0 + c2 * 64, w, c, g, r0);
    ml_chain_compute<DIR>(p, h, sl, tok0 + c1 * 64, lane, w, c, g, r1, C, sCt1, dry);
  }
}

__device__ void ml_chain_item(const Params& p, int li, int item, char* smem, bool dry = false) {
  const int tid = otid(), lane = tid & 63, w = tid >> 6, c = lane & 15, g = lane >> 4;
  int pair, within;
  if (item < 512) { const int r = item >> 3; pair = (item & 7) + 8 * (r >> 4); within = r & 15; }
  else { const int it = item - 512; const int r = it >> 3; pair = 32 + (it & 7) + 8 * (r >> 4); within = r & 15; }
  const int sl = within & 7, dir = within >> 3;
  const int s = pair < 32 ? 4 + (pair >> 2) : ((pair - 32) >> 2);
  const int h = pair & 3;
  const int tok0 = s < 4 ? s * 4096 : T_P + (s - 4) * 8192;
  const int N = (s < 4 ? 4096 : 8192) / 64;
  bf16_t* sCt0 = (bf16_t*)smem;
  __syncthreads();
  if (dir == 0) ml_chain_run<0>(p, h, sl, tok0, N, lane, w, c, g, sCt0, dry);
  else ml_chain_run<1>(p, h, sl, tok0, N, lane, w, c, g, sCt0, dry);
}

#define ATTN_GLOAD(KT)                                                                              \
  {                                                                                                 \
    const long kb = tok0 + (KT) * 64;                                                               \
    rk0 = *(const bf16x8*)(p.KNb + (kb + (tid >> 3)) * 512 + head * 64 + 8 * (tid & 7));            \
    rk1 = *(const bf16x8*)(p.KNb + (kb + 32 + (tid >> 3)) * 512 + head * 64 + 8 * (tid & 7));       \
    rkr = *(const bf16x8*)(p.KRb + (kb + (tid >> 2)) * 32 + 8 * (tid & 3));                          \
    rv0 = *(const bf16x8*)(p.VtA + (long)(head * 64 + (tid >> 3)) * T_TOK + kb + 8 * (tid & 7));     \
    rv1 = *(const bf16x8*)(p.VtA + (long)(head * 64 + 32 + (tid >> 3)) * T_TOK + kb + 8 * (tid & 7)); \
  }
__device__ void attn_item(const Params& p, int item, char* smem, bool dry = false) {
  const int tid = otid(), lane = tid & 63, w = tid >> 6, c = lane & 15, g = lane >> 4;
  int s, head, qb;
  {
    const int x = item / 320, t = item % 320;
    if (t < 256) { const int pair = x + 8 * (t >> 5); qb = t & 31; s = 4 + (pair >> 3); head = pair & 7; }
    else { const int t2 = t - 256; const int pair = x + 8 * (t2 >> 4); qb = t2 & 15; s = pair >> 3; head = pair & 7; }
  }
  const int tok0 = s < 4 ? s * 4096 : T_P + (s - 4) * 8192;
  const int len = s < 4 ? 4096 : 8192;
  const int nkv = len / 64;
  constexpr int KV_STAGE = 64 * 104 + 64 * 72;
  bf16_t* sKV = (bf16_t*)smem;
  const int qrow0 = tok0 + qb * 256 + 64 * w;
  bf16_t* sQr = sKV + 2 * KV_STAGE;
  bf16x8 qf[4][2];
#pragma unroll
  for (int nt = 0; nt < 4; ++nt) {
#pragma unroll
    for (int ks = 0; ks < 2; ++ks)
      qf[nt][ks] = *(const bf16x8*)(p.Qa + (long)(qrow0 + 16 * nt + c) * 768 + head * 96 + 32 * ks + 8 * g);
    bf16x8 qr = *(const bf16x8*)(p.Qa + (long)(qrow0 + 16 * nt + c) * 768 + head * 96 + 64 + 8 * g);
    *(bf16x8*)(sQr + ((w * 4 + nt) * 64 + lane) * 8) = qr;
  }
  f32x4 ot[4][4];
#pragma unroll
  for (int vt = 0; vt < 4; ++vt)
#pragma unroll
    for (int nt = 0; nt < 4; ++nt) ot[vt][nt] = zero4();
  float mrun[4] = {-64.f, -64.f, -64.f, -64.f}, lrun[4] = {0.f, 0.f, 0.f, 0.f};
  bf16x8 rk0, rk1, rkr, rv0, rv1;
#define ATTN_LSTORE(STG)                                                                    \
  {                                                                                         \
    bf16_t* sK_ = sKV + (STG) * KV_STAGE;                                                   \
    bf16_t* sVt_ = sK_ + 64 * 104;                                                          \
    *(bf16x8*)(sK_ + (tid >> 3) * 104 + 8 * (tid & 7)) = rk0;                               \
    *(bf16x8*)(sK_ + (32 + (tid >> 3)) * 104 + 8 * (tid & 7)) = rk1;                        \
    *(bf16x8*)(sK_ + (tid >> 2) * 104 + 64 + 8 * (tid & 3)) = rkr;                          \
    *(bf16x8*)(sVt_ + (tid >> 3) * 72 + 8 * (tid & 7)) = rv0;                               \
    *(bf16x8*)(sVt_ + (32 + (tid >> 3)) * 72 + 8 * (tid & 7)) = rv1;                        \
  }
  ATTN_GLOAD(0)
  __syncthreads();
  ATTN_LSTORE(0)
  __syncthreads();
  for (int kt = 0; kt < nkv; ++kt) {
    const bf16_t* sK = sKV + (kt & 1) * KV_STAGE;
    const bf16_t* sVt = sK + 64 * 104;
    ATTN_GLOAD(min(kt + 1, nkv - 1))
#pragma unroll 1
    for (int half = 0; half < 2; ++half) {
      f32x4 st[2][4];
#pragma unroll
      for (int k4 = 0; k4 < 2; ++k4)
#pragma unroll
        for (int nt = 0; nt < 4; ++nt) {
          const float nm = -mrun[nt];
          f32x4 iv = {nm, nm, nm, nm};
          st[k4][nt] = iv;
        }
#pragma unroll
      for (int ks = 0; ks < 2; ++ks)
#pragma unroll
        for (int k4 = 0; k4 < 2; ++k4) {
          bf16x8 kf = *(const bf16x8*)(sK + (32 * half + 16 * k4 + c) * 104 + 32 * ks + 8 * g);
#pragma unroll
          for (int nt = 0; nt < 4; ++nt) st[k4][nt] = mfma16(kf, qf[nt][ks], st[k4][nt]);
        }
      {
        bf16x8 kr0 = *(const bf16x8*)(sK + (32 * half + c) * 104 + 64 + 8 * g);
        bf16x8 kr1 = *(const bf16x8*)(sK + (32 * half + 16 + c) * 104 + 64 + 8 * g);
#pragma unroll
        for (int nt = 0; nt < 4; ++nt) {
          bf16x8 qr = *(const bf16x8*)(sQr + ((w * 4 + nt) * 64 + lane) * 8);
          st[0][nt] = mfma16(kr0, qr, st[0][nt]);
          st[1][nt] = mfma16(kr1, qr, st[1][nt]);
        }
      }
      __builtin_amdgcn_sched_barrier(0);
      bf16x8 pb[4];
#pragma unroll
      for (int nt = 0; nt < 4; ++nt) {
        float mx = -1e30f;
#pragma unroll
        for (int k4 = 0; k4 < 2; ++k4)
#pragma unroll
          for (int j = 0; j < 4; ++j) mx = fmaxf(mx, st[k4][nt][j]);
        mx = rowmax4(mx);
        if (__builtin_amdgcn_ballot_w64(mx > 0.f) != 0ull) {
          const float d = fmaxf(mx, 0.f);
          const float alpha = __builtin_amdgcn_exp2f(-d);
          mrun[nt] += d;
          lrun[nt] *= alpha;
#pragma unroll
          for (int vt = 0; vt < 4; ++vt) ot[vt][nt] = ot[vt][nt] * alpha;
#pragma unroll
          for (int k4 = 0; k4 < 2; ++k4)
#pragma unroll
            for (int j = 0; j < 4; ++j) st[k4][nt][j] -= d;
        }
        float psum = 0.f;
#pragma unroll
        for (int k4 = 0; k4 < 2; ++k4)
#pragma unroll
          for (int j = 0; j < 4; ++j) {
            float pv = __builtin_amdgcn_exp2f(st[k4][nt][j]);
            st[k4][nt][j] = pv;
            psum += pv;
          }
        lrun[nt] += psum;
        typedef __attribute__((ext_vector_type(4))) unsigned u32x4;
        u32x4 pk;
        pk[0] = pk2bf(st[0][nt][0], st[0][nt][1]);
        pk[1] = pk2bf(st[0][nt][2], st[0][nt][3]);
        pk[2] = pk2bf(st[1][nt][0], st[1][nt][1]);
        pk[3] = pk2bf(st[1][nt][2], st[1][nt][3]);
        pb[nt] = __builtin_bit_cast(bf16x8, pk);
      }
      __builtin_amdgcn_sched_barrier(0);
#pragma unroll
      for (int vt = 0; vt < 4; ++vt) {
        us4 lo = *(const us4*)(sVt + (16 * vt + c) * 72 + 32 * half + 4 * g);
        us4 hi = *(const us4*)(sVt + (16 * vt + c) * 72 + 32 * half + 16 + 4 * g);
        bf16x8 av;
#pragma unroll
        for (int e = 0; e < 4; ++e) { av[e] = (short)lo[e]; av[4 + e] = (short)hi[e]; }
#pragma unroll
        for (int nt = 0; nt < 4; ++nt) ot[vt][nt] = mfma16(av, pb[nt], ot[vt][nt]);
      }
    }
    if (kt + 1 < nkv) ATTN_LSTORE((kt + 1) & 1)
    __syncthreads();
  }
#undef ATTN_LSTORE
#pragma unroll
  for (int nt = 0; nt < 4; ++nt) {
    float lt = lrun[nt];
    lt += sxor(lt, 16, lane);
    lt += sxor(lt, 32, lane);
    const float inv = 1.f / lt;
    const long tok = qrow0 + 16 * nt + c;
#pragma unroll
    for (int vt = 0; vt < 4; ++vt) {
      bf16_t* gp = p.MGb + tok * 512 + head * 64 + 16 * vt + 4 * g;
      us4 gt = *(const us4*)gp;
      us4 o;
#pragma unroll
      for (int j = 0; j < 4; ++j) o[j] = f2bf(ot[vt][nt][j] * inv * siluf_(bf2f(gt[j])));
      if (!dry) *(us4*)gp = o;
    }
  }
}

__device__ void phase_gla_combine(const Params& p, int li, bool dry = false) {
  const int tid_ = otid(); const int lane = tid_ & 63, w = tid_ >> 6;
#pragma unroll 2
  for (int tok = blockIdx.x * 4 + w; tok < T_TOK; tok += gridDim.x * 4) {
    const bf16_t* tp = p.TMP + (long)tok * 1024 + 16 * lane;
    bf16_t* gp = p.Gb + (long)tok * 1024 + 16 * lane;
    bf16x8 o0 = *(const bf16x8*)tp, o1 = *(const bf16x8*)(tp + 8);
    bf16x8 g0 = *(const bf16x8*)gp, g1 = *(const bf16x8*)(gp + 8);
    float ov[16], gv[16];
#pragma unroll
    for (int e = 0; e < 8; ++e) {
      ov[e] = bf2f((bf16_t)o0[e]); ov[8 + e] = bf2f((bf16_t)o1[e]);
      gv[e] = bf2f((bf16_t)g0[e]); gv[8 + e] = bf2f((bf16_t)g1[e]);
    }
    float ss = 0.f;
#pragma unroll
    for (int e = 0; e < 16; ++e) ss += ov[e] * ov[e];
    ss = row_sum16(ss);
    const float rs = rsqrtf(ss * (1.f / 256.f) + EPS);
    const float* ng = p.e_gla_norm_g + li * 256 + ((16 * lane) & 255);
    bf16x8 r0, r1;
#pragma unroll
    for (int e = 0; e < 8; ++e) {
      r0[e] = (short)f2bf(ov[e] * rs * ng[e] * siluf_(gv[e]));
      r1[e] = (short)f2bf(ov[8 + e] * rs * ng[8 + e] * siluf_(gv[8 + e]));
    }
    if (!dry) { *(bf16x8*)gp = r0;
    *(bf16x8*)(gp + 8) = r1; }
  }
}

__device__ void phase_ml_combine(const Params& p, int li, bool dry = false) {
  const int tid_ = otid(); const int lane = tid_ & 63, w = tid_ >> 6;
#pragma unroll 2
  for (int tok = blockIdx.x * 4 + w; tok < T_TOK; tok += gridDim.x * 4) {
    const long off = (long)tok * 512 + 8 * lane;
    bf16x8 hv = *(const bf16x8*)(p.NUMIf + off);
    bf16x8 hb = *(const bf16x8*)(p.NUMIb + off);
    bf16x8 mo = *(const bf16x8*)(p.MOb + off);
    bf16x8 mg = *(const bf16x8*)(p.MLGb + off);
    float hf[8];
    float ss = 0.f;
#pragma unroll
    for (int e = 0; e < 8; ++e) { hf[e] = bf2f((bf16_t)hv[e]) + bf2f((bf16_t)hb[e]); ss += hf[e] * hf[e]; }
    ss = row_sum16(ss);
    const float rs = rsqrtf(ss * (1.f / 128.f) + EPS);
    const float* ng = p.o_ml_norm_g + li * 128 + ((8 * lane) & 127);
    bf16x8 r;
#pragma unroll
    for (int e = 0; e < 8; ++e)
      r[e] = (short)f2bf(hf[e] * rs * ng[e] * sigmoidf_(bf2f((bf16_t)mo[e])) * siluf_(bf2f((bf16_t)mg[e])));
    if (!dry) *(bf16x8*)(p.MLGb + off) = r;
  }
}

__device__ void phase_final(const Params& p, bool dry = false) {
  const int tid_ = otid(); const int lane = tid_ & 63, w = tid_ >> 6;
#pragma unroll 2
  for (int tok = blockIdx.x * 4 + w; tok < T_TOK; tok += gridDim.x * 4) {
    float* xp = p.out + (long)tok * DM;
    float4 v[4];
    float ss = 0.f;
#pragma unroll
    for (int i = 0; i < 4; ++i) {
      v[i] = *(const float4*)(xp + 4 * lane + 256 * i);
      ss += v[i].x * v[i].x + v[i].y * v[i].y + v[i].z * v[i].z + v[i].w * v[i].w;
    }
    ss = wave_sum(ss);
    const float rs = rsqrtf(ss * (1.f / 1024.f) + EPS);
#pragma unroll
    for (int i = 0; i < 4; ++i) {
      float4 gq = *(const float4*)(p.final_norm_g + 4 * lane + 256 * i);
      float4 o;
      o.x = v[i].x * rs * gq.x; o.y = v[i].y * rs * gq.y; o.z = v[i].z * rs * gq.z; o.w = v[i].w * rs * gq.w;
      if (!dry) *(float4*)(xp + 4 * lane + 256 * i) = o;
    }
  }
}

__device__ void run_phase(const Params& p, int ph, char* smem) {
  if (ph == 0) { if (PH_ON(0)) phase_prep(p, smem); return; }
  if (ph == NPHASE - 1) { if (PROBE_B) phase_final(p, true); if (PH_ON(11)) phase_final(p); return; }
  const int q = ph - 1;
  const int layer = (q < 5) ? 0 : (q < 11) ? 1 : (q < 16) ? 2 : 3;
  const int sub = (q < 5) ? q : (q < 11) ? q - 5 : (q < 16) ? q - 11 : q - 16;
  const int li = layer >> 1;
  const float* xa = (layer == 0) ? p.x_prompt : p.out;
  const float* xb = (layer == 0) ? p.x_sample : p.out + (long)T_P * DM;
  if ((layer & 1) == 0) {
    if (sub == 0) {
      EpiEvenIn e{p.Qb, p.Kt, p.VtE, p.Gb, p.LRb, p.PUb, p.PGb};
      if (PH_ON(1)) gemm_phase<3, 8>(T_TOK / 128, NE_PAD / 256, DM, p.WinE + (long)li * NE_PAD * DM, p.SSQ, nullptr, p.TMP, DM, DM, p.TMP, DM, e, smem);
    } else if (sub == 1) {
      for (int item = blockIdx.x; item < 5120; item += gridDim.x)
        if (PH_ON(2)) gla_intra_item(p, li, item, smem);
    } else if (sub == 2) {
      __shared__ int s_pitem;
      for (int item = blockIdx.x; item < 384; item += gridDim.x) { if (PH_ON(2)) gla_chain_item(p, li, item, smem, false); }
      for (;;) {
        __syncthreads();
        if (threadIdx.x == 0) s_pitem = atomicAdd(p.counters + 16 + li, 1);
        __syncthreads();
        const int item = s_pitem;
        if (item >= 5120) break;
        if (PH_ON(3)) pool_item(p, li, item, smem);
      }
    } else if (sub == 3) {
      if (PROBE_B) phase_gla_combine(p, li, true);
      if (PH_ON(4)) phase_gla_combine(p, li);
    } else {
      EpiOut e{xa, xb, p.out, false, p.NUMIf, p.SSQ};
      if (PH_ON(5)) gemm_phase<1, 8>(T_TOK / 128, DM / 256, 1536, p.WoutE + (long)li * DM * 1536, nullptr, nullptr, p.Gb, 1024, 1024, p.PGb, 512, e, smem);
    }
  } else {
    if (sub == 0) {
      EpiOddIn e{p.CQb, p.CKVb, p.KRb, p.MGb, p.MQb, p.MKb, p.MKt, p.MVt, p.MOb, p.MLGb, p.MIF};
      if (PH_ON(6)) gemm_phase<3, 8>(T_TOK / 128, NO_PAD / 256, DM, p.WinO + (long)li * NO_PAD * DM, p.SSQ, nullptr, p.NUMIf, DM, DM, p.NUMIf, DM, e, smem);
    } else if (sub == 1) {
      for (int rep = 0; rep < 1 + PROBE_A; ++rep)
      for (int item = blockIdx.x; item < 5120; item += gridDim.x)
        if (PH_ON(8)) ml_intra_item(p, li, item, smem);
    } else if (sub == 2) {
      for (int item = blockIdx.x; item < 768; item += gridDim.x)
        if (PH_ON(8)) ml_chain_item(p, li, item, smem, false);
    } else if (sub == 3) {
      if (PH_ON(10)) phase_ml_combine(p, li);
      EpiQUp eq{p.Qa};
      if (PH_ON(7)) gemm_phase<2, 4>(T_TOK / 128, 768 / 128, 384, p.QupT + (long)li * 768 * 384, nullptr, nullptr, p.CQb, 384, 384, p.CQb, 384, eq, smem);
      EpiKVUp ek{p.KNb, p.VtA};
      if (PH_ON(7)) gemm_phase<2, 4>(T_TOK / 128, 1024 / 128, 256, p.KVupT + (long)li * 1024 * 256, nullptr, nullptr, p.CKVb, 256, 256, p.CKVb, 256, ek, smem);
    } else if (sub == 4) {
      __shared__ int s_item;
      for (;;) {
        __syncthreads();
        if (threadIdx.x == 0) s_item = atomicAdd(p.counters + li * 8 + (blockIdx.x & 7), 1);
        __syncthreads();
        const int item = s_item;
        if (item >= 320) break;
        if (PH_ON(9)) attn_item(p, (blockIdx.x & 7) * 320 + item, smem);
      }
    } else {
      EpiOut e{xa, xb, p.out, false, (layer == 3) ? nullptr : p.TMP, p.SSQ};
      if (PH_ON(5)) gemm_phase<1, 8>(T_TOK / 128, DM / 256, 1024, p.WoutO + (long)li * DM * 1024, nullptr, nullptr, p.MGb, 512, 512, p.MLGb, 512, e, smem);
    }
  }
}

__global__ void __launch_bounds__(256, 2) mega_kernel(Params p) {
  extern __shared__ __attribute__((aligned(16))) char smem[];
  cg::grid_group grid = cg::this_grid();
  __shared__ uint4 xb_words;
  if (threadIdx.x == 0) xb_words = make_uint4(0u, 0u, 0u, 0u);
  __syncthreads();
  XcdBarrier xb = xcd_barrier_post(p.bar, (volatile LAS unsigned*)&xb_words);
  for (int ph = p.ph_lo; ph < p.ph_hi; ++ph) {
    if (ph > p.ph_lo) {
      if (ph == p.ph_lo + 1) grid.sync();
      else xcd_barrier(xb);
    }
    run_phase(p, ph, smem);
  }
}

extern "C" void kernel_launch(void* const* d_in, const int* in_sizes, int n_in, void* d_out, int out_size, void* d_ws,
                              size_t ws_size, hipStream_t stream) {
  static int grid_blocks = 0;
  if (!grid_blocks) {
    int dev = 0, cus = 0, per_cu = 0;
    hipGetDevice(&dev);
    hipDeviceGetAttribute(&cus, hipDeviceAttributeMultiprocessorCount, dev);
    hipFuncSetAttribute((const void*)mega_kernel, hipFuncAttributeMaxDynamicSharedMemorySize, LDS_BYTES);
    hipOccupancyMaxActiveBlocksPerMultiprocessor(&per_cu, (const void*)mega_kernel, 256, LDS_BYTES);
    if (per_cu < 1) per_cu = 1;
    if (per_cu > 2) per_cu = 2;
    grid_blocks = cus * per_cu;
    fprintf(stderr, "kernel_launch: cus %d per_cu %d grid %d ws %zu\n", cus, per_cu, grid_blocks, ws_size);
  }
  Params p{};
  const float** pin = (const float**)&p;
  for (int i = 0; i < 19; ++i) pin[i] = (const float*)d_in[i];
  p.out = (float*)d_out;
  char* ws = (char*)d_ws;
  size_t off = 0;
  auto take = [&](size_t bytes) { char* r = ws + off; off += (bytes + 255) & ~(size_t)255; return r; };
  p.WinE = (bf16_t*)take((size_t)2 * NE_PAD * DM * 2);
  p.WinO = (bf16_t*)take((size_t)2 * NO_PAD * DM * 2);
  p.WoutE = (bf16_t*)take((size_t)2 * DM * 1536 * 2);
  p.WoutO = (bf16_t*)take((size_t)2 * DM * 1024 * 2);
  p.QupT = (bf16_t*)take((size_t)2 * 768 * 384 * 2);
  p.KVupT = (bf16_t*)take((size_t)2 * 1024 * 256 * 2);
  p.PoolWT = (bf16_t*)take((size_t)2 * 4 * 128 * 128 * 2);
  p.AupT = (bf16_t*)take((size_t)2 * 2 * 512 * 32 * 2);
  p.counters = (int*)take(256);
  p.bar = (unsigned*)take((size_t)XCD_BAR_WORDS * 4);
  p.SSQ = (float*)take((size_t)T_TOK * 8 * 4);
  const size_t act0 = off;
  const size_t T = T_TOK;
  p.Gb = (bf16_t*)take(T * 1024 * 2);
  p.PGb = (bf16_t*)take(T * 512 * 2);
  p.Qb = (bf16_t*)take(T * 512 * 2);
  p.Kt = (bf16_t*)take(T * 512 * 2);
  p.QEb = (bf16_t*)take(T * 512 * 2);
  p.KdTb = (bf16_t*)take(T * 512 * 2);
  p.EB = (float*)take((size_t)2 * 1280 * 512 * 4);
  p.VtE = (bf16_t*)take(T * 1024 * 2);
  p.LRb = (bf16_t*)take(T * 32 * 2);
  p.PUb = (bf16_t*)take(T * 512 * 2);
  p.TMP = (bf16_t*)take(T * 1024 * 2);
  const size_t even_end = off;
  off = act0;
  p.MGb = (bf16_t*)take(T * 512 * 2);
  p.MLGb = (bf16_t*)take(T * 512 * 2);
  p.CQb = (bf16_t*)take(T * 384 * 2);
  p.CKVb = (bf16_t*)take(T * 256 * 2);
  p.KRb = (bf16_t*)take(T * 32 * 2);
  const size_t r2 = off;
  p.MQb = (bf16_t*)take(T * 512 * 2);
  p.MKb = (bf16_t*)take(T * 512 * 2);
  p.MKt = (bf16_t*)take(T * 512 * 2);
  p.MVt = (bf16_t*)take(T * 512 * 2);
  p.MOb = (bf16_t*)take(T * 512 * 2);
  p.NUMIf = (bf16_t*)take(T * 512 * 2);
  p.NUMIb = (bf16_t*)take(T * 512 * 2);
  p.MIF = (float*)take(T * 16 * 4);
  p.EBI = (float*)take(T * 8 * 4);
  p.WKg = (float*)take(T * 8 * 4);
  p.DENI = (float*)take(T * 8 * 4);
  p.DEC = (float*)take((size_t)8 * 1280 * 4);
  const size_t r2_end = off;
  off = r2;
  p.Qa = (bf16_t*)take(T * 768 * 2);
  p.KNb = (bf16_t*)take(T * 512 * 2);
  p.VtA = (bf16_t*)take(T * 512 * 2);
  if (off < r2_end) off = r2_end;
  const size_t odd_end = off;
  const size_t need = even_end > odd_end ? even_end : odd_end;
  if (need > ws_size) {
    fprintf(stderr, "kernel_launch: workspace too small: need %zu have %zu\n", need, ws_size);
    return;
  }
  hipMemsetAsync(p.bar, 0, (size_t)XCD_BAR_WORDS * 4, stream);
#if SINGLE_LAUNCH
  p.ph_lo = 0;
  p.ph_hi = NPHASE;
  void* args[] = {&p};
  hipError_t e = hipLaunchCooperativeKernel((const void*)mega_kernel, dim3(grid_blocks), dim3(256), args, LDS_BYTES, stream);
  if (e != hipSuccess) fprintf(stderr, "cooperative launch failed: %s (grid %d)\n", hipGetErrorString(e), grid_blocks);
#else
  for (int ph = 0; ph < NPHASE; ++ph) {
    p.ph_lo = ph;
    p.ph_hi = ph + 1;
    hipLaunchKernelGGL(mega_kernel, dim3(grid_blocks), dim3(256), LDS_BYTES, stream, p);
  }
#endif
}
```

```cpp
#include <hip/hip_runtime.h>
#include <hip/hip_cooperative_groups.h>
#include <cstdio>
namespace cg = cooperative_groups;

#ifndef SINGLE_LAUNCH
#define SINGLE_LAUNCH 1
#endif
#ifndef PHMASK
#define PHMASK 0xFFFF
#endif
#define PH_ON(b) ((PHMASK >> (b)) & 1)
#ifndef PROBE_GEMM
#define PROBE_GEMM 0
#endif
#ifndef PROBE_ATTN
#define PROBE_ATTN 0
#endif
#ifndef PROBE_CHAIN
#define PROBE_CHAIN 0
#endif
#ifndef PROBE_A
#define PROBE_A 0
#endif
#ifndef PROBE_B
#define PROBE_B 0
#endif
#ifndef PROBE_MLCHAIN
#define PROBE_MLCHAIN 0
#endif

typedef unsigned short bf16_t;
typedef __attribute__((ext_vector_type(8))) short bf16x8;
typedef __attribute__((ext_vector_type(4))) float f32x4;
typedef __attribute__((ext_vector_type(4))) unsigned short us4;

constexpr int T_TOK = 81920;
constexpr int T_P = 16384;
constexpr int DM = 1024;
constexpr int NE = 4128, NE_PAD = 4352;
constexpr int NO = 3760, NO_PAD = 3840;
constexpr float EPS = 1e-6f;
constexpr int NPHASE = 24;
constexpr int LDS_BYTES = 72 * 1024;

struct Params {
  const float *x_prompt, *x_sample, *norm_g, *final_norm_g, *e_w_in, *e_a_up, *e_a_bias, *e_gla_norm_g,
      *e_pool_w, *e_pool_scale, *e_w_out, *o_w_in, *o_q_norm_g, *o_q_up, *o_kv_norm_g, *o_kv_up, *o_if_bias,
      *o_ml_norm_g, *o_w_out;
  float* out;
  bf16_t *WinE, *WinO, *WoutE, *WoutO, *QupT, *KVupT, *PoolWT, *AupT;
  int* counters;
  unsigned* bar;
  float* SSQ;
  bf16_t *Qb, *Kt, *VtE, *Gb, *LRb, *PUb, *PGb, *TMP, *QEb, *KdTb;
  float* EB;
  bf16_t *CQb, *CKVb, *KRb, *MGb, *MQb, *MKb, *MKt, *MVt, *MOb, *MLGb, *NUMIf, *NUMIb, *Qa, *KNb, *VtA;
  float *MIF, *EBI, *WKg, *DENI, *DEC;
  int ph_lo, ph_hi;
};

typedef __bf16 hbf2 __attribute__((ext_vector_type(2)));
typedef float hf2 __attribute__((ext_vector_type(2)));
__device__ __forceinline__ bf16_t f2bf(float f) {
  __bf16 b = (__bf16)f;
  return __builtin_bit_cast(bf16_t, b);
}
__device__ __forceinline__ unsigned pk2bf(float a, float b) {
  hf2 v = {a, b};
  hbf2 r = __builtin_convertvector(v, hbf2);
  return __builtin_bit_cast(unsigned, r);
}
__device__ __forceinline__ float bf2f(bf16_t b) { return __uint_as_float(((unsigned)b) << 16); }
__device__ __forceinline__ f32x4 mfma16(bf16x8 a, bf16x8 b, f32x4 c) {
  return __builtin_amdgcn_mfma_f32_16x16x32_bf16(a, b, c, 0, 0, 0);
}
__device__ __forceinline__ float logsigmoidf_(float x) { return fminf(x, 0.f) - log1pf(__expf(-fabsf(x))); }
__device__ __forceinline__ float siluf_(float x) { return x / (1.f + __expf(-x)); }
__device__ __forceinline__ float sigmoidf_(float x) { return 1.f / (1.f + __expf(-x)); }
__device__ __forceinline__ int otid() { int t = threadIdx.x; asm volatile("" : "+v"(t)); return t; }
__device__ __forceinline__ float bperm(int srclane, float v) { return __int_as_float(__builtin_amdgcn_ds_bpermute(srclane << 2, __float_as_int(v))); }
__device__ __forceinline__ float sxor(float v, int m, int lane) { return bperm(lane ^ m, v); }
typedef unsigned u32x2_t __attribute__((ext_vector_type(2)));
__device__ __forceinline__ float rowmax4(float v) {
  u32x2_t r = __builtin_amdgcn_permlane16_swap(__float_as_uint(v), __float_as_uint(v), false, false);
  v = fmaxf(__uint_as_float(r[0]), __uint_as_float(r[1]));
  r = __builtin_amdgcn_permlane32_swap(__float_as_uint(v), __float_as_uint(v), false, false);
  return fmaxf(__uint_as_float(r[0]), __uint_as_float(r[1]));
}
template <int CTRL> __device__ __forceinline__ float dpp_f(float v) {
  return __int_as_float(__builtin_amdgcn_update_dpp(0, __float_as_int(v), CTRL, 0xf, 0xf, false));
}
__device__ __forceinline__ float row_sum16(float v) {
  v += dpp_f<0x128>(v);
  v += dpp_f<0x124>(v);
  v += dpp_f<0x122>(v);
  v += dpp_f<0x121>(v);
  return v;
}
__device__ __forceinline__ float wave_sum(float v) {
  v += dpp_f<0x128>(v);
  v += dpp_f<0x124>(v);
  v += dpp_f<0x122>(v);
  v += dpp_f<0x121>(v);
  u32x2_t r = __builtin_amdgcn_permlane16_swap(__float_as_uint(v), __float_as_uint(v), false, false);
  v = __uint_as_float(r[0]) + __uint_as_float(r[1]);
  r = __builtin_amdgcn_permlane32_swap(__float_as_uint(v), __float_as_uint(v), false, false);
  return __uint_as_float(r[0]) + __uint_as_float(r[1]);
}
__device__ __forceinline__ bf16x8 zero8() { bf16x8 z = {0, 0, 0, 0, 0, 0, 0, 0}; return z; }
__device__ __forceinline__ f32x4 zero4() { f32x4 z = {0.f, 0.f, 0.f, 0.f}; return z; }

__device__ __forceinline__ int seq_pos(int tok) { return tok < T_P ? (tok & 4095) : ((tok - T_P) & 8191); }
__device__ __forceinline__ const float* xrow(const float* xa, const float* xb, int tok) {
  return tok < T_P ? xa + (long)tok * DM : xb + (long)(tok - T_P) * DM;
}


#define XB_TMO      128
#define XB_XCNT(j)  (256  + 64 * (j))
#define XB_XSUB(j)  (1280 + 64 * (j))
#define XB_XGEN(j)  (2304 + 64 * (j))
#define XB_TOP      3328
#define XB_TOPGEN   3392
#define XCD_BAR_WORDS 3456
#define XB_SPIN_CAP (1u << 22)
#define LAS __attribute__((address_space(3)))
__device__ __forceinline__ unsigned xb_ld(unsigned* p) { return __hip_atomic_load(p, __ATOMIC_RELAXED, __HIP_MEMORY_SCOPE_AGENT); }
__device__ __forceinline__ unsigned xb_add(unsigned* p, unsigned v) { return __hip_atomic_fetch_add(p, v, __ATOMIC_RELAXED, __HIP_MEMORY_SCOPE_AGENT); }
__device__ __forceinline__ unsigned xb_xcc_id() { return (unsigned)__builtin_amdgcn_s_getreg((3 << 11) | 20) & 0xFu; }
#define XB_SPIN(cond, bar) do { unsigned _sp = 0; while (cond) { __builtin_amdgcn_s_sleep(1); \
    if ((++_sp & 255u) == 0u) { if (xb_ld(&(bar)[XB_TMO])) break; if (_sp > XB_SPIN_CAP) { atomicAdd(&(bar)[XB_TMO], 1u); break; } } } } while (0)
struct XcdBarrier { unsigned* bar; unsigned x; volatile LAS unsigned* st; };
__device__ __forceinline__ XcdBarrier xcd_barrier_post(unsigned* bar, volatile LAS unsigned* st) {
  XcdBarrier b; b.bar = bar; b.x = xb_xcc_id(); b.st = st;
  if (threadIdx.x == 0) (void)xb_add(&bar[XB_XCNT(b.x)], 1u);
  return b;
}
__device__ __forceinline__ void xcd_barrier_complete(unsigned* bar, unsigned x, unsigned& nloc, unsigned& nx) {
  const unsigned G = gridDim.x * gridDim.y * gridDim.z;
  unsigned sum, cnt, mine, sp = 0u;
  for (;;) {
    sum = 0u; cnt = 0u; mine = 0u;
#pragma unroll
    for (unsigned j = 0; j < 16; ++j) { const unsigned cc = xb_ld(&bar[XB_XCNT(j)]); sum += cc; cnt += (cc > 0u) ? 1u : 0u; mine = (j == x) ? cc : mine; }
    if (sum == G) break;
    __builtin_amdgcn_s_sleep(1);
    if ((++sp & 255u) == 0u) { if (xb_ld(&bar[XB_TMO])) break; if (sp > XB_SPIN_CAP) { atomicAdd(&bar[XB_TMO], 1u); break; } }
  }
  nloc = mine > 0u ? mine : 1u; nx = cnt > 0u ? cnt : 1u;
}
__device__ __forceinline__ void xcd_barrier(const XcdBarrier& b) {
  asm volatile("s_waitcnt vmcnt(0)" ::: "memory");
  __syncthreads();
  if (threadIdx.x == 0) {
    unsigned* bar = b.bar;
    __builtin_amdgcn_s_waitcnt(0);
    unsigned nloc = b.st[0], nx = b.st[1];
    if (nloc == 0u) { xcd_barrier_complete(bar, b.x, nloc, nx); b.st[0] = nloc; b.st[1] = nx; }
    const unsigned old = xb_add(&bar[XB_XSUB(b.x)], 1u);
    const unsigned gen = old / nloc;
    if (old + 1u == (gen + 1u) * nloc) {
      __builtin_amdgcn_fence(__ATOMIC_RELEASE, "agent");
      asm volatile("s_waitcnt vmcnt(0)" ::: "memory");
      const unsigned og = xb_add(&bar[XB_TOP], 1u);
      const unsigned tg = og / nx;
      if (og + 1u == (tg + 1u) * nx) xb_add(&bar[XB_TOPGEN], 1u);
      else XB_SPIN(xb_ld(&bar[XB_TOPGEN]) == tg, bar);
      __builtin_amdgcn_fence(__ATOMIC_ACQUIRE, "agent");
      xb_add(&bar[XB_XGEN(b.x)], 1u);
      asm volatile("s_waitcnt vmcnt(0)" ::: "memory");
    } else {
      XB_SPIN(xb_ld(&bar[XB_XGEN(b.x)]) == gen, bar);
      __builtin_amdgcn_fence(__ATOMIC_ACQUIRE, "agent");
      asm volatile("s_waitcnt vmcnt(0)" ::: "memory");
    }
  }
  __syncthreads();
}

__device__ __forceinline__ int colmap(int mode, int n) {
  if (mode == 1) {
    if (n < 512) return 2208 + n;
    if (n < 1024) return 1696 + (n - 512);
    if (n < 1408) return n - 1024;
    if (n < 1664) return 384 + (n - 1408);
    if (n < 2176) return 672 + (n - 1664);
    if (n < 2688) return 1184 + (n - 2176);
    if (n < 3200) return 2720 + (n - 2688);
    if (n < 3712) return 3248 + (n - 3200);
    if (n < 3744) return 640 + (n - 3712);
    return 3232 + (n - 3744);
  }
  if (mode == 2) {
    if (n < 512) return (n >> 6) * 96 + (n & 63);
    const int r = n - 512;
    return (r >> 5) * 96 + 64 + (r & 31);
  }
  if (mode == 3) {
    if (n < 512) return (n >> 6) * 128 + (n & 63);
    const int r = n - 512;
    return (r >> 6) * 128 + 64 + (r & 63);
  }
  return n;
}

__device__ void prep_weight(const float* __restrict__ W, int K, int N, int Npad, const float* __restrict__ gsc,
                            bf16_t* __restrict__ out, char* smem, int mode = 0, int Nsrc_ = 0) {
  const int Nsrc = Nsrc_ ? Nsrc_ : N;
  const int tid = otid();
  float* sT = (float*)smem;
  const int tn = Npad >> 6, tk = K >> 6;
  for (int tile = blockIdx.x; tile < tn * tk; tile += gridDim.x) {
    const int n0 = (tile / tk) << 6, k0 = (tile % tk) << 6;
    __syncthreads();
#pragma unroll 4
    for (int i = 0; i < 16; ++i) {
      const int idx = tid + 256 * i;
      const int kk = idx >> 6, nn = idx & 63;
      float v = 0.f;
      if (n0 + nn < N) {
        v = W[(size_t)(k0 + kk) * Nsrc + colmap(mode, n0 + nn)];
        if (gsc) v *= gsc[k0 + kk];
      }
      sT[nn * 65 + kk] = v;
    }
    __syncthreads();
#pragma unroll 4
    for (int i = 0; i < 16; ++i) {
      const int idx = tid + 256 * i;
      const int nn = idx >> 6, kk = idx & 63;
      out[(size_t)(n0 + nn) * K + k0 + kk] = f2bf(sT[nn * 65 + kk]);
    }
  }
}

__device__ void phase_prep(const Params& p, char* smem) {
  long gtid = (long)blockIdx.x * 256 + otid();
  long gsize = (long)gridDim.x * 256;
  for (int l = 0; l < 2; ++l) {
    prep_weight(p.e_w_in + (long)l * DM * NE, DM, NE, NE_PAD, p.norm_g + (2 * l) * DM, p.WinE + (long)l * NE_PAD * DM, smem);
    prep_weight(p.o_w_in + (long)l * DM * 3760, DM, NO, NO_PAD, p.norm_g + (2 * l + 1) * DM, p.WinO + (long)l * NO_PAD * DM, smem, 1, 3760);
    prep_weight(p.e_w_out + (long)l * 1536 * DM, 1536, DM, DM, nullptr, p.WoutE + (long)l * DM * 1536, smem);
    prep_weight(p.o_w_out + (long)l * 1024 * DM, 1024, DM, DM, nullptr, p.WoutO + (long)l * DM * 1024, smem);
    prep_weight(p.o_q_up + (long)l * 384 * 768, 384, 768, 768, p.o_q_norm_g + l * 384, p.QupT + (long)l * 768 * 384, smem, 2);
    prep_weight(p.o_kv_up + (long)l * 256 * 1024, 256, 1024, 1024, p.o_kv_norm_g + l * 256, p.KVupT + (long)l * 1024 * 256, smem, 3);
    for (int gi = 0; gi < 4; ++gi)
      prep_weight(p.e_pool_w + (long)(l * 4 + gi) * 128 * 128, 128, 128, 128, nullptr, p.PoolWT + (long)(l * 4 + gi) * 128 * 128, smem);
    for (long idx = gtid; idx < 2 * 512 * 32; idx += gsize) {
      int r = (int)(idx & 31);
      int d = (int)((idx >> 5) & 511);
      int dir = (int)(idx >> 14);
      float v = (r < 16) ? p.e_a_up[((long)(l * 2 + dir) * 16 + r) * 512 + d] : 0.f;
      p.AupT[((long)(l * 2 + dir) * 512 + d) * 32 + r] = f2bf(v);
    }
  }
  if (gtid < 32) p.counters[gtid] = 0;
  {
    const int tid_ = otid();
    const int lane = tid_ & 63, w = tid_ >> 6;
  #pragma unroll 2
  for (int tok = blockIdx.x * 4 + w; tok < T_TOK; tok += gridDim.x * 4) {
      const float* xp = xrow(p.x_prompt, p.x_sample, tok) + 16 * lane;
      float ssv = 0.f;
      unsigned pk[8];
#pragma unroll
      for (int i = 0; i < 4; ++i) {
        const f32x4 v = *(const f32x4*)(xp + 4 * i);
        ssv += v[0] * v[0] + v[1] * v[1] + v[2] * v[2] + v[3] * v[3];
        pk[2 * i] = pk2bf(v[0], v[1]);
        pk[2 * i + 1] = pk2bf(v[2], v[3]);
      }
      uint4 o0, o1;
      o0.x = pk[0]; o0.y = pk[1]; o0.z = pk[2]; o0.w = pk[3];
      o1.x = pk[4]; o1.y = pk[5]; o1.z = pk[6]; o1.w = pk[7];
      *(uint4*)(p.TMP + (size_t)tok * DM + 16 * lane) = o0;
      *(uint4*)(p.TMP + (size_t)tok * DM + 16 * lane + 8) = o1;
      ssv = wave_sum(ssv);
      if (lane < 8) p.SSQ[(size_t)tok * 8 + lane] = (lane == 0) ? ssv : 0.f;
    }
  }
}

constexpr int G_LD = 40;
constexpr int G_BUF = (128 + 256) * G_LD;

template <int AMODE, int NI, class Epi>
__device__ __forceinline__ void gemm_phase(int Mtiles, int Ntiles, int K, const bf16_t* __restrict__ Bt, const float* ssq, const float* unused_,
                           const bf16_t* A1, int ld1, int K1, const bf16_t* A2, int ld2, const Epi& epi, char* smem) {
  bf16_t* sbase = (bf16_t*)smem;
  float* sR = (float*)(smem + 70144);
  const int tid = otid(), lane = tid & 63, w = tid >> 6, c = lane & 15, g = lane >> 4;
  const int wm = w >> 1, wn = w & 1;
  const int nk = K / 32;
  const int xcd = blockIdx.x & 7, lb0 = blockIdx.x >> 3, nlb = gridDim.x >> 3;
  const int mper = Mtiles >> 3;
  for (int lt = lb0; lt < mper * Ntiles; lt += nlb) {
    const int mt = xcd * mper + lt / Ntiles, nt = lt % Ntiles;
    constexpr int BN = 32 * NI;
    const int m0 = mt * 128, n0 = nt * BN;
    f32x4 acc[4][NI];
#pragma unroll
    for (int i = 0; i < 4; ++i)
#pragma unroll
      for (int j = 0; j < NI; ++j) acc[i][j] = zero4();
    float ss[2] = {0.f, 0.f};
    bf16x8 ra0[2], ra1[2];
    bf16x8 rb0[NI / 2], rb1[NI / 2];
    const unsigned boff = (unsigned)(tid >> 2) * K + 8 * (tid & 3);
    const bf16_t* bbase = Bt + (size_t)n0 * K;
#define G_LOAD(RA, RB, KT)                                                                          \
  {                                                                                                 \
    const int k0_ = (KT) * 32;                                                                      \
    const bf16_t* base_;                                                                            \
    int ld_;                                                                                        \
    if (k0_ < K1) { base_ = A1 + (size_t)m0 * ld1 + k0_; ld_ = ld1; }                               \
    else { base_ = A2 + (size_t)m0 * ld2 + (k0_ - K1); ld_ = ld2; }                                 \
    _Pragma("unroll") for (int i = 0; i < 2; ++i)                                                   \
      RA[i] = *(const bf16x8*)(base_ + (unsigned)((tid >> 2) + 64 * i) * ld_ + 8 * (tid & 3));      \
    _Pragma("unroll") for (int i = 0; i < NI / 2; ++i)                                              \
      RB[i] = *(const bf16x8*)(bbase + k0_ + boff + (unsigned)(64 * i) * K);                        \
  }
#define G_STORE(RA, RB, BUF)                                                                        \
  {                                                                                                 \
    bf16_t* sA_ = sbase + (BUF) * G_BUF;                                                            \
    bf16_t* sB_ = sA_ + 128 * G_LD;                                                                 \
    _Pragma("unroll") for (int i = 0; i < 2; ++i) {                                                 \
      bf16x8 v = RA[i];                                                                             \
      if constexpr (AMODE == 2) {                                                                   \
        _Pragma("unroll") for (int e = 0; e < 8; ++e) {                                             \
          float f = bf2f((bf16_t)v[e]);                                                             \
          ss[i] += f * f;                                                                           \
        }                                                                                           \
      }                                                                                             \
      *(bf16x8*)(sA_ + ((tid >> 2) + 64 * i) * G_LD + 8 * (tid & 3)) = v;                           \
    }                                                                                               \
    _Pragma("unroll") for (int i = 0; i < NI / 2; ++i)                                              \
      *(bf16x8*)(sB_ + ((tid >> 2) + 64 * i) * G_LD + 8 * (tid & 3)) = RB[i];                       \
  }
#define G_COMPUTE(BUF)     \
  {                                                                                                 \
    const bf16_t* sA_ = sbase + (BUF) * G_BUF;                                                      \
    const bf16_t* sB_ = sA_ + 128 * G_LD;                                                           \
    bf16x8 af[4];                                                                                   \
    _Pragma("unroll") for (int mi = 0; mi < 4; ++mi)                                                \
      af[mi] = *(const bf16x8*)(sA_ + (wm * 64 + mi * 16 + c) * G_LD + g * 8);                      \
    bf16x8 bq[2];                                                                                   \
    bq[0] = *(const bf16x8*)(sB_ + (wn * (16 * NI) + c) * G_LD + g * 8);                            \
    _Pragma("unroll") for (int ni = 0; ni < NI; ++ni) {                                             \
      if (ni + 1 < NI)                                                                              \
        bq[(ni + 1) & 1] = *(const bf16x8*)(sB_ + (wn * (16 * NI) + (ni + 1) * 16 + c) * G_LD + g * 8); \
      _Pragma("unroll") for (int mi = 0; mi < 4; ++mi)                                              \
        acc[mi][ni] = (!Epi::staged) ? mfma16(bq[ni & 1], af[mi], acc[mi][ni]) : mfma16(af[mi], bq[ni & 1], acc[mi][ni]); \
    }                                                                                               \
  }
    __syncthreads();
    if constexpr (AMODE == 3) {
      if (tid < 128) {
        const f32x4 p0 = *(const f32x4*)(ssq + (size_t)(m0 + tid) * 8);
        const f32x4 p1 = *(const f32x4*)(ssq + (size_t)(m0 + tid) * 8 + 4);
        const float sv = (p0[0] + p0[1]) + (p0[2] + p0[3]) + (p1[0] + p1[1]) + (p1[2] + p1[3]);
        sR[tid] = rsqrtf(sv * (1.f / 1024.f) + EPS);
      }
    }
    G_LOAD(ra0, rb0, 0)
    G_LOAD(ra1, rb1, 1)
    G_STORE(ra0, rb0, 0)
    __syncthreads();
    for (int kt = 0; kt < nk; kt += 2) {
      G_LOAD(ra0, rb0, min(kt + 2, nk - 1))
      G_COMPUTE(0)
      G_STORE(ra1, rb1, 1)
      __syncthreads();
      G_LOAD(ra1, rb1, min(kt + 3, nk - 1))
      G_COMPUTE(1)
      if (kt + 2 < nk) G_STORE(ra0, rb0, 0)
      __syncthreads();
    }
    if constexpr (AMODE == 2) {
#pragma unroll
      for (int i = 0; i < 2; ++i) {
        float sv = ss[i];
        sv += sxor(sv, 1, lane); sv += sxor(sv, 2, lane);
        if ((tid & 3) == 0) sR[(tid >> 2) + 64 * i] = rsqrtf(sv / (float)K + EPS);
      }
      __syncthreads();
    }
    if constexpr (Epi::staged) {
      bf16_t* sT = sbase;
      const float esc = epi.scale();
      const bool both = epi.both(n0);
#pragma unroll 1
      for (int pass = 0; pass < (both ? 2 : 1); ++pass) {
      const bool tr = both ? (pass == 1) : epi.transposed(n0);
      if (pass) __syncthreads();
      if (tr) {
#pragma unroll
        for (int mi = 0; mi < 4; ++mi) {
          const int row = wm * 64 + mi * 16 + 4 * g;
          const float r0 = sR[row] * esc, r1 = sR[row + 1] * esc, r2 = sR[row + 2] * esc, r3 = sR[row + 3] * esc;
#pragma unroll
          for (int ni = 0; ni < NI; ++ni) {
            uint2 o;
            o.x = pk2bf(acc[mi][ni][0] * r0, acc[mi][ni][1] * r1);
            o.y = pk2bf(acc[mi][ni][2] * r2, acc[mi][ni][3] * r3);
            *(uint2*)(sT + (wn * (16 * NI) + ni * 16 + c) * 136 + row) = o;
          }
        }
      } else {
#pragma unroll
        for (int mi = 0; mi < 4; ++mi) {
          const int row = wm * 64 + mi * 16 + 4 * g;
          const float r0 = sR[row] * esc, r1 = sR[row + 1] * esc, r2 = sR[row + 2] * esc, r3 = sR[row + 3] * esc;
#pragma unroll
          for (int ni = 0; ni < NI; ++ni) {
            bf16_t* d = sT + row * (BN + 8) + wn * (16 * NI) + ni * 16 + c;
            d[0] = f2bf(acc[mi][ni][0] * r0);
            d[BN + 8] = f2bf(acc[mi][ni][1] * r1);
            d[2 * (BN + 8)] = f2bf(acc[mi][ni][2] * r2);
            d[3 * (BN + 8)] = f2bf(acc[mi][ni][3] * r3);
          }
        }
      }
      if (pass == 0) epi.template direct<NI>(m0, n0, wm, wn, g, c, acc, sR);
      __syncthreads();
      if (tr) {
#pragma unroll 4
        for (int i = 0; i < 2 * NI; ++i) {
          const int id = tid + 256 * i;
          const int col = id >> 4, rc = id & 15;
          bf16x8 v = *(const bf16x8*)(sT + col * 136 + 8 * rc);
          epi.store_t(m0 + 8 * rc, n0 + col, v);
        }
      } else {
#pragma unroll 4
        for (int i = 0; i < 2 * NI; ++i) {
          const int id = tid + 256 * i;
          const int row = id / (4 * NI), cc = id % (4 * NI);
          const bf16_t* sp = sT + row * (BN + 8) + 8 * cc;
          bf16x8 v = *(const bf16x8*)sp;
          epi.store_n(m0 + row, n0 + 8 * cc, v, sp);
        }
      }
      }
    } else {
      float* sF = (float*)smem;
#pragma unroll 1
      for (int half = 0; half < 2; ++half) {
        if (half) __syncthreads();
        if (wm == half) {
#pragma unroll
          for (int mi = 0; mi < 4; ++mi)
#pragma unroll
            for (int ni = 0; ni < NI; ++ni) *(f32x4*)(sF + (mi * 16 + c) * 260 + wn * (16 * NI) + ni * 16 + 4 * g) = acc[mi][ni];
        }
        __syncthreads();
#pragma unroll 4
        for (int i = 0; i < 16; ++i) {
          const int row = w * 16 + i;
          const int tok = m0 + half * 64 + row;
          const int col = n0 + 4 * lane;
          const f32x4 a = *(const f32x4*)(sF + row * 260 + 4 * lane);
          const f32x4 xo = *(const f32x4*)(xrow(epi.xa, epi.xb, tok) + col);
          f32x4 xn;
          xn[0] = xo[0] + a[0]; xn[1] = xo[1] + a[1]; xn[2] = xo[2] + a[2]; xn[3] = xo[3] + a[3];
          float sv = xn[0] * xn[0] + xn[1] * xn[1] + xn[2] * xn[2] + xn[3] * xn[3];
          sv = wave_sum(sv);
          if (!epi.dry) {
            *(f32x4*)(epi.out + (size_t)tok * DM + col) = xn;
            if (epi.hb) {
              uint2 o;
              o.x = pk2bf(xn[0], xn[1]);
              o.y = pk2bf(xn[2], xn[3]);
              *(uint2*)(epi.hb + (size_t)tok * DM + col) = o;
            }
            if (lane == 0) epi.ssq[(size_t)tok * 8 + (n0 >> 8)] = sv;
          }
        }
      }
    }
  }
#undef G_LOAD
#undef G_STORE
#undef G_COMPUTE
}

__device__ __forceinline__ void rope_cs(int pos, int i, float& co, float& si) {
  float inv = exp2f(-(float)i * (13.287712379549449f / 16.f));
  float ang = (float)pos * inv;
  float n = rintf(ang * 0.15915494309189535f);
  float r = fmaf(-n, 6.28125f, ang);
  r = fmaf(-n, 0.0019353071795864769f, r);
  float rf = r * 0.15915494309189535f;
  si = __builtin_amdgcn_sinf(rf);
  co = __builtin_amdgcn_cosf(rf);
}

__device__ __forceinline__ void rope_chunk(int pos, int i0, bf16x8 x1, bf16x8 x2, bf16x8& o1, bf16x8& o2) {
#pragma unroll
  for (int e = 0; e < 8; ++e) {
    float co, si;
    rope_cs(pos, i0 + e, co, si);
    float a = bf2f((bf16_t)x1[e]), b = bf2f((bf16_t)x2[e]);
    o1[e] = (short)f2bf(a * co - b * si);
    o2[e] = (short)f2bf(b * co + a * si);
  }
}

struct EpiEvenIn {
  static constexpr bool staged = true;
  bf16_t *Qb, *Kt, *VtE, *Gb, *LRb, *PUb, *PGb;
  __device__ float scale() const { return 1.f; }
  __device__ bool transposed(int n0) const { return n0 >= 512 && n0 < 2048; }
  __device__ bool both(int n0) const { return false; }
  template <int NI> __device__ void direct(int m0, int n0, int wm, int wn, int g, int c, f32x4 (&acc)[4][NI], const float* sR) const {}
  __device__ void store_t(int tok8, int col, bf16x8 v) const {
    if (col < 1024) *(bf16x8*)(Kt + (size_t)(col - 512) * T_TOK + tok8) = v;
    else *(bf16x8*)(VtE + (size_t)(col - 1024) * T_TOK + tok8) = v;
  }
  __device__ void store_n(int tok, int col, bf16x8 v, const bf16_t* sp) const {
    bf16_t* d;
    if (col < 512) d = Qb + (size_t)tok * 512 + col;
    else if (col < 3072) d = Gb + (size_t)tok * 1024 + (col - 2048);
    else if (col < 3104) d = LRb + (size_t)tok * 32 + (col - 3072);
    else if (col < 3616) d = PUb + (size_t)tok * 512 + (col - 3104);
    else if (col < 4128) d = PGb + (size_t)tok * 512 + (col - 3616);
    else return;
    *(bf16x8*)d = v;
  }
};

struct EpiOddIn {
  static constexpr bool staged = true;
  bf16_t *CQb, *CKVb, *KRb, *MGb, *MQb, *MKb, *MKt, *MVt, *MOb, *MLGb;
  float* MIF;
  __device__ float scale() const { return 1.f; }
  __device__ bool transposed(int n0) const { return n0 < 512; }
  __device__ bool both(int n0) const { return n0 >= 512 && n0 < 1024; }
  template <int NI> __device__ void direct(int m0, int n0, int wm, int wn, int g, int c, f32x4 (&acc)[4][NI], const float* sR) const {
    if (n0 == 3584 && wn == 1) {
#pragma unroll
      for (int mi = 0; mi < 4; ++mi)
#pragma unroll
        for (int j = 0; j < 4; ++j) {
          const int row = wm * 64 + mi * 16 + 4 * g + j;
          MIF[(size_t)(m0 + row) * 16 + c] = acc[mi][2][j] * sR[row];
        }
    }
  }
  __device__ void store_t(int tok8, int col, bf16x8 v) const {
    if (col < 512) *(bf16x8*)(MVt + (size_t)col * T_TOK + tok8) = v;
    else *(bf16x8*)(MKt + (size_t)(col - 512) * T_TOK + tok8) = v;
  }
  __device__ void store_n(int tok, int col, bf16x8 v, const bf16_t* sp) const {
    bf16_t* d;
    if (col < 1024) d = MKb + (size_t)tok * 512 + (col - 512);
    else if (col < 1408) d = CQb + (size_t)tok * 384 + (col - 1024);
    else if (col < 1664) d = CKVb + (size_t)tok * 256 + (col - 1408);
    else if (col < 2176) d = MGb + (size_t)tok * 512 + (col - 1664);
    else if (col < 2688) d = MQb + (size_t)tok * 512 + (col - 2176);
    else if (col < 3200) d = MOb + (size_t)tok * 512 + (col - 2688);
    else if (col < 3712) d = MLGb + (size_t)tok * 512 + (col - 3200);
    else if (col < 3728) {
      bf16x8 x2 = *(const bf16x8*)(sp + 16);
      bf16x8 o1, o2;
      rope_chunk(seq_pos(tok), col - 3712, v, x2, o1, o2);
      *(bf16x8*)(KRb + (size_t)tok * 32 + (col - 3712)) = o1;
      *(bf16x8*)(KRb + (size_t)tok * 32 + 16 + (col - 3712)) = o2;
      return;
    } else return;
    *(bf16x8*)d = v;
  }
};

struct EpiQUp {
  static constexpr bool staged = true;
  bf16_t* Qa;
  __device__ float scale() const { return 0.10206207261596575f * 1.4426950408889634f; }
  __device__ bool transposed(int n0) const { return false; }
  __device__ bool both(int n0) const { return false; }
  template <int NI> __device__ void direct(int m0, int n0, int wm, int wn, int g, int c, f32x4 (&acc)[4][NI], const float* sR) const {}
  __device__ void store_t(int tok8, int col, bf16x8 v) const {}
  __device__ void store_n(int tok, int col, bf16x8 v, const bf16_t* sp) const {
    if (col < 512) {
      *(bf16x8*)(Qa + (size_t)tok * 768 + (col >> 6) * 96 + (col & 63)) = v;
    } else {
      const int r = col - 512, head = r >> 5, rr = r & 31;
      if (rr < 16) {
        bf16x8 x2 = *(const bf16x8*)(sp + 16);
        bf16x8 o1, o2;
        rope_chunk(seq_pos(tok), rr, v, x2, o1, o2);
        *(bf16x8*)(Qa + (size_t)tok * 768 + head * 96 + 64 + rr) = o1;
        *(bf16x8*)(Qa + (size_t)tok * 768 + head * 96 + 80 + rr) = o2;
      }
    }
  }
};

struct EpiKVUp {
  static constexpr bool staged = true;
  bf16_t *KNb, *VtA;
  __device__ float scale() const { return 1.f; }
  __device__ bool transposed(int n0) const { return n0 >= 512; }
  __device__ bool both(int n0) const { return false; }
  template <int NI> __device__ void direct(int m0, int n0, int wm, int wn, int g, int c, f32x4 (&acc)[4][NI], const float* sR) const {}
  __device__ void store_t(int tok8, int col, bf16x8 v) const { *(bf16x8*)(VtA + (size_t)(col - 512) * T_TOK + tok8) = v; }
  __device__ void store_n(int tok, int col, bf16x8 v, const bf16_t* sp) const { *(bf16x8*)(KNb + (size_t)tok * 512 + col) = v; }
};

struct EpiOut {
  static constexpr bool staged = false;
  const float *xa, *xb;
  float* out;
  bool dry;
  bf16_t* hb;
  float* ssq;
};

template <int CTRL> __device__ __forceinline__ float dpp_z(float v) {
  return __int_as_float(__builtin_amdgcn_update_dpp(0, __float_as_int(v), CTRL, 0xf, 0xf, true));
}
__device__ __forceinline__ float scan16(float v, int c, int lane) {
  v += dpp_z<0x111>(v);
  v += dpp_z<0x112>(v);
  v += dpp_z<0x114>(v);
  v += dpp_z<0x118>(v);
  return v;
}

__device__ __forceinline__ float logsig_fast(float x) { return fminf(x, 0.f) - __logf(1.f + __expf(-fabsf(x))); }

__device__ void gla_intra_item(const Params& p, int li, int item, char* smem, bool dry = false) {
  const int tid = otid(), lane = tid & 63, w = tid >> 6, c = lane & 15, g = lane >> 4;
  const int ci = item >> 2, h = item & 3;
  const int tokc = ci * 64;
  const float qscale = 0.08838834764831845f;
  bf16_t* sQe = (bf16_t*)smem;
  bf16_t* sKd = sQe + 64 * 136;
  bf16_t* sA = sKd + 64 * 136;
  us4 q4[2][4];
  bf16_t kk[2][4][4];
#pragma unroll
  for (int dt = 0; dt < 2; ++dt)
#pragma unroll
    for (int tt = 0; tt < 4; ++tt) {
      q4[dt][tt] = *(const us4*)(p.Qb + (size_t)(tokc + 16 * tt + c) * 512 + h * 128 + 32 * w + 16 * dt + 4 * g);
#pragma unroll
      for (int j = 0; j < 4; ++j)
        kk[dt][tt][j] = p.Kt[(size_t)(h * 128 + 32 * w + 16 * dt + 4 * g + j) * T_TOK + tokc + 16 * tt + c];
    }
  __syncthreads();
#pragma unroll
  for (int dir = 0; dir < 2; ++dir) {
    bf16_t* QEd = (dir || dry) ? p.QEb : p.Qb;
    bf16_t* KdTd = (dir || dry) ? p.KdTb : p.Kt;
    bf16x8 aup[2];
    float bias[2][4];
#pragma unroll
    for (int dt = 0; dt < 2; ++dt) {
      aup[dt] = zero8();
      if (g < 2) aup[dt] = *(const bf16x8*)(p.AupT + ((size_t)(li * 2 + dir) * 512 + h * 128 + 32 * w + 16 * dt + c) * 32 + 8 * g);
#pragma unroll
      for (int j = 0; j < 4; ++j) bias[dt][j] = p.e_a_bias[(li * 2 + dir) * 512 + h * 128 + 32 * w + 16 * dt + 4 * g + j];
    }
    f32x4 la[2][4];
#pragma unroll
    for (int tt = 0; tt < 4; ++tt) {
      bf16x8 lrf = zero8();
      if (g < 2) lrf = *(const bf16x8*)(p.LRb + (size_t)(tokc + 16 * tt + c) * 32 + dir * 16 + 8 * g);
#pragma unroll
      for (int dt = 0; dt < 2; ++dt) la[dt][tt] = mfma16(aup[dt], lrf, zero4());
    }
#pragma unroll
    for (int dt = 0; dt < 2; ++dt)
#pragma unroll
      for (int tt = 0; tt < 4; ++tt)
#pragma unroll
        for (int j = 0; j < 4; ++j) la[dt][tt][j] = logsig_fast(la[dt][tt][j] + bias[dt][j]) * (1.f / 16.f);
    f32x4 P[2][4];
    float tot[2][4];
#pragma unroll
    for (int dt = 0; dt < 2; ++dt)
#pragma unroll
      for (int j = 0; j < 4; ++j) {
        float carry = 0.f;
#pragma unroll
        for (int tt = 0; tt < 4; ++tt) {
          float v = scan16(la[dt][tt][j], c, lane) + carry;
          P[dt][tt][j] = v;
          carry = dpp_f<0x15F>(v);
        }
        tot[dt][j] = carry;
      }
#pragma unroll
    for (int dt = 0; dt < 2; ++dt)
#pragma unroll
      for (int tt = 0; tt < 4; ++tt) {
        us4 qo, ko;
#pragma unroll
        for (int j = 0; j < 4; ++j) {
          const float b = (dir == 0) ? P[dt][tt][j] : (tot[dt][j] - P[dt][tt][j] + la[dt][tt][j]);
          qo[j] = f2bf(bf2f(q4[dt][tt][j]) * __expf(b) * qscale);
          ko[j] = f2bf(bf2f(kk[dt][tt][j]) * __expf(-b));
        }
        *(us4*)(QEd + (size_t)(tokc + 16 * tt + c) * 512 + h * 128 + 32 * w + 16 * dt + 4 * g) = qo;
        *(us4*)(sQe + (16 * tt + c) * 136 + 32 * w + 16 * dt + 4 * g) = qo;
        *(us4*)(sKd + (16 * tt + c) * 136 + 32 * w + 16 * dt + 4 * g) = ko;
      }
    if (c == 0) {
#pragma unroll
      for (int dt = 0; dt < 2; ++dt)
#pragma unroll
        for (int j = 0; j < 4; ++j)
          p.EB[(size_t)(dir * 1280 + ci) * 512 + h * 128 + 32 * w + 16 * dt + 4 * g + j] = __expf(tot[dt][j]);
    }
    __syncthreads();
#pragma unroll
    for (int i = 0; i < 4; ++i) {
      const int id = tid + 256 * i;
      const int d = id & 127, c8 = id >> 7;
      bf16x8 v;
#pragma unroll
      for (int e = 0; e < 8; ++e) v[e] = (short)sKd[(8 * c8 + e) * 136 + d];
      *(bf16x8*)(KdTd + (size_t)(h * 128 + d) * T_TOK + tokc + 8 * c8) = v;
    }
    f32x4 accA[4];
#pragma unroll
    for (int jt = 0; jt < 4; ++jt) accA[jt] = zero4();
#pragma unroll
    for (int ks = 0; ks < 4; ++ks) {
      bf16x8 aq = *(const bf16x8*)(sQe + (16 * w + c) * 136 + 32 * ks + 8 * g);
#pragma unroll
      for (int jt = 0; jt < 4; ++jt) {
        bf16x8 bk = *(const bf16x8*)(sKd + (16 * jt + c) * 136 + 32 * ks + 8 * g);
        accA[jt] = mfma16(aq, bk, accA[jt]);
      }
    }
#pragma unroll
    for (int jt = 0; jt < 4; ++jt)
#pragma unroll
      for (int j = 0; j < 4; ++j) {
        const int i = 16 * w + 4 * g + j, jj = 16 * jt + c;
        const bool keep = (dir == 0) ? (jj <= i) : (jj > i);
        sA[dir * 64 * 72 + i * 72 + jj] = f2bf(keep ? accA[jt][j] : 0.f);
      }
    __syncthreads();
  }
  bf16x8 af[2][2];
#pragma unroll
  for (int dir = 0; dir < 2; ++dir)
#pragma unroll
    for (int k2 = 0; k2 < 2; ++k2) af[dir][k2] = *(const bf16x8*)(sA + dir * 64 * 72 + (16 * w + c) * 72 + 32 * k2 + 8 * g);
  bf16_t* sO = (bf16_t*)smem;
#pragma unroll 4
  for (int vt = 0; vt < 16; ++vt) {
    f32x4 a = zero4();
#pragma unroll
    for (int k2 = 0; k2 < 2; ++k2) {
      bf16x8 vfr = *(const bf16x8*)(p.VtE + (size_t)(h * 256 + 16 * vt + c) * T_TOK + tokc + 32 * k2 + 8 * g);
      a = mfma16(af[0][k2], vfr, a);
      a = mfma16(af[1][k2], vfr, a);
    }
#pragma unroll
    for (int j = 0; j < 4; ++j) sO[(16 * w + 4 * g + j) * 264 + 16 * vt + c] = f2bf(a[j]);
  }
  __syncthreads();
#pragma unroll
  for (int i = 0; i < 8; ++i) {
    const int id = tid + 256 * i;
    const int row = id >> 5, c8 = id & 31;
    *(bf16x8*)(p.TMP + (size_t)(tokc + row) * 1024 + h * 256 + 8 * c8) = *(const bf16x8*)(sO + row * 264 + 8 * c8);
  }
}

__device__ __forceinline__ void lds_barrier() { asm volatile("s_waitcnt lgkmcnt(0)\n\ts_barrier" ::: "memory"); }

struct GlaRegs {
  bf16x8 aq[4];
  bf16x8 vf[2][2];
  bf16x8 kf[2][2];
  float eb[2];
  unsigned told[2][4];
};

template <int DIR>
__device__ __forceinline__ void gla_chain_load(const Params& p, int h, int sl, int tokc, int w, int c, int g, GlaRegs& r) {
  const bf16_t* QE = DIR ? p.QEb : p.Qb;
  const bf16_t* KdT = DIR ? p.KdTb : p.Kt;
#pragma unroll
  for (int ks = 0; ks < 4; ++ks) r.aq[ks] = *(const bf16x8*)(QE + (size_t)(tokc + 16 * w + c) * 512 + h * 128 + 32 * ks + 8 * g);
#pragma unroll
  for (int vt = 0; vt < 2; ++vt)
#pragma unroll
    for (int k2 = 0; k2 < 2; ++k2)
      r.vf[vt][k2] = *(const bf16x8*)(p.VtE + (size_t)(h * 256 + sl * 32 + 16 * vt + c) * T_TOK + tokc + 32 * k2 + 8 * g);
#pragma unroll
  for (int dt = 0; dt < 2; ++dt) {
#pragma unroll
    for (int k2 = 0; k2 < 2; ++k2)
      r.kf[dt][k2] = *(const bf16x8*)(KdT + (size_t)(h * 128 + 32 * w + 16 * dt + c) * T_TOK + tokc + 32 * k2 + 8 * g);
    r.eb[dt] = p.EB[(size_t)(DIR * 1280 + (tokc >> 6)) * 512 + h * 128 + 32 * w + 16 * dt + c];
  }
#pragma unroll
  for (int vt = 0; vt < 2; ++vt)
#pragma unroll
    for (int j = 0; j < 4; ++j) r.told[vt][j] = p.TMP[(size_t)(tokc + 16 * w + 4 * g + j) * 1024 + h * 256 + sl * 32 + 16 * vt + c];
}

__device__ __forceinline__ void gla_chain_compute(const Params& p, int h, int sl, int tokc, int w, int c, int g, const GlaRegs& r,
                                                  f32x4 (&S)[2][2], bf16_t* sSt, bool dry, bool reload) {
  unsigned told[2][4];
#pragma unroll
  for (int vt = 0; vt < 2; ++vt)
#pragma unroll
    for (int j = 0; j < 4; ++j) told[vt][j] = r.told[vt][j];
  if (reload) {
#pragma unroll
    for (int vt = 0; vt < 2; ++vt)
#pragma unroll
      for (int j = 0; j < 4; ++j) told[vt][j] = p.TMP[(size_t)(tokc + 16 * w + 4 * g + j) * 1024 + h * 256 + sl * 32 + 16 * vt + c];
  }
#pragma unroll
  for (int vt = 0; vt < 2; ++vt)
#pragma unroll
    for (int dt = 0; dt < 2; ++dt)
#pragma unroll
      for (int j = 0; j < 4; ++j) sSt[(16 * vt + 4 * g + j) * 136 + 32 * w + 16 * dt + c] = f2bf(S[vt][dt][j]);
  lds_barrier();
  f32x4 o[2];
  o[0] = zero4(); o[1] = zero4();
#pragma unroll
  for (int ks = 0; ks < 4; ++ks)
#pragma unroll
    for (int vt = 0; vt < 2; ++vt) {
      bf16x8 sf = *(const bf16x8*)(sSt + (16 * vt + c) * 136 + 32 * ks + 8 * g);
      o[vt] = mfma16(r.aq[ks], sf, o[vt]);
    }
#pragma unroll
  for (int dt = 0; dt < 2; ++dt)
#pragma unroll
    for (int vt = 0; vt < 2; ++vt) {
      f32x4 a = S[vt][dt];
#pragma unroll
      for (int k2 = 0; k2 < 2; ++k2) a = mfma16(r.vf[vt][k2], r.kf[dt][k2], a);
      S[vt][dt] = a * r.eb[dt];
    }
#pragma unroll
  for (int vt = 0; vt < 2; ++vt)
#pragma unroll
    for (int j = 0; j < 4; ++j)
      if (!dry) p.TMP[(size_t)(tokc + 16 * w + 4 * g + j) * 1024 + h * 256 + sl * 32 + 16 * vt + c] = f2bf(bf2f((bf16_t)told[vt][j]) + o[vt][j]);
}

__device__ void gla_chain_item(const Params& p, int li, int item, char* smem, bool dry = false) {
  const int tid = otid(), lane = tid & 63, w = tid >> 6, c = lane & 15, g = lane >> 4;
  const int xr = item >> 3;
  const int pair = (item & 7) + 8 * (xr >> 3), sl = xr & 7;
  const int s = pair < 32 ? 4 + (pair >> 2) : ((pair - 32) >> 2);
  const int h = pair & 3;
  const int tok0 = s < 4 ? s * 4096 : T_P + (s - 4) * 8192;
  const int len = s < 4 ? 4096 : 8192;
  const int N = len / 64;
  bf16_t* sSt0 = (bf16_t*)smem;
  bf16_t* sSt1 = sSt0 + 32 * 136;
  f32x4 Sf[2][2], Sb[2][2];
#pragma unroll
  for (int a = 0; a < 2; ++a)
#pragma unroll
    for (int b = 0; b < 2; ++b) { Sf[a][b] = zero4(); Sb[a][b] = zero4(); }
  GlaRegs rf, rb;
  __syncthreads();
  gla_chain_load<0>(p, h, sl, tok0, w, c, g, rf);
  for (int step = 0; step < N; ++step) {
    const int tf = tok0 + step * 64, tb = tok0 + (N - 1 - step) * 64;
    gla_chain_load<1>(p, h, sl, tb, w, c, g, rb);
    gla_chain_compute(p, h, sl, tf, w, c, g, rf, Sf, sSt0, dry, step == (N >> 1));
    if (step + 1 < N) gla_chain_load<0>(p, h, sl, tf + 64, w, c, g, rf);
    gla_chain_compute(p, h, sl, tb, w, c, g, rb, Sb, sSt1, dry, false);
  }
}

__device__ void pool_item(const Params& p, int li, int item, char* smem, bool dry = false) {
  const int tid = otid(), lane = tid & 63, w = tid >> 6, c = lane & 15, g = lane >> 4;
  const int gi = item & 3;
  const int tile = item >> 2;
  const int tokc = tile * 64;
  const int pos0 = seq_pos(tokc);
  const int len = tokc < T_P ? 4096 : 8192;
  float* sU = (float*)smem;
  bf16_t* sP = (bf16_t*)(sU + 80 * 128);
  __syncthreads();
  for (int idx = tid; idx < 80 * 128; idx += 256) {
    int r = idx >> 7, ch = idx & 127;
    int pos = pos0 - 8 + r;
    float v = 0.f;
    if (pos >= 0 && pos < len) v = bf2f(p.PUb[(long)(tokc - 8 + r) * 512 + gi * 128 + ch]);
    sU[idx] = v;
  }
  __syncthreads();
  {
    const int ch = tid & 127, th = tid >> 7;
    const int half = 1 << gi;
    for (int t = th * 32; t < th * 32 + 32; ++t) {
      int pos = pos0 + t;
      int lo = max(pos - half, 0), hi = min(pos + half, len);
      float s = 0.f;
      for (int q = lo; q < hi; ++q) s += sU[(q - pos0 + 8) * 128 + ch];
      float pooled = s / (float)(hi - lo) - sU[(t + 8) * 128 + ch];
      sP[t * 136 + ch] = f2bf(pooled);
    }
  }
  __syncthreads();
  f32x4 acc[8];
#pragma unroll
  for (int dt = 0; dt < 8; ++dt) acc[dt] = zero4();
  const bf16_t* PW = p.PoolWT + (long)(li * 4 + gi) * 128 * 128;
#pragma unroll
  for (int ks = 0; ks < 4; ++ks) {
    bf16x8 af = *(const bf16x8*)(sP + (16 * w + c) * 136 + 32 * ks + 8 * g);
#pragma unroll
    for (int dt = 0; dt < 8; ++dt) {
      bf16x8 bw = *(const bf16x8*)(PW + (long)(16 * dt + c) * 128 + 32 * ks + 8 * g);
      acc[dt] = mfma16(af, bw, acc[dt]);
    }
  }
#pragma unroll
  for (int dt = 0; dt < 8; ++dt) {
    const int d = gi * 128 + 16 * dt + c;
    const float sc = p.e_pool_scale[li * 512 + d];
#pragma unroll
    for (int j = 0; j < 4; ++j) {
      const long addr = (long)(tokc + 16 * w + 4 * g + j) * 512 + d;
      float gt = bf2f(p.PGb[addr]);
      if (!dry) p.PGb[addr] = f2bf(acc[dt][j] * sc * siluf_(gt));
    }
  }
}

__device__ void ml_intra_item(const Params& p, int li, int item, char* smem) {
  const int tid = otid(), lane = tid & 63, w = tid >> 6, c = lane & 15, g = lane >> 4;
  const int ci = item >> 2, h = item & 3;
  const int tokc = ci * 64;
  const float kscale = 0.08838834764831845f;
  bf16_t* sA = (bf16_t*)smem;
  float* sBv = (float*)(sA + 2 * 64 * 72);
  float* sCB = sBv + 128;
  __syncthreads();
  if (w < 2) {
    const int dir = w;
    const float bi = p.o_if_bias[li * 16 + dir * 4 + h];
    const float bff = p.o_if_bias[li * 16 + 8 + dir * 4 + h];
    const float* mf = p.MIF + (size_t)(tokc + lane) * 16;
    const float liv = mf[dir * 4 + h] + bi;
    const float lfv = logsig_fast(mf[8 + dir * 4 + h] + bff);
    float ps = lfv;
#pragma unroll
    for (int d = 1; d < 64; d <<= 1) {
      float t = bperm(lane - d, ps);
      if (lane >= d) ps += t;
    }
    const float total = __int_as_float(__builtin_amdgcn_readlane(__float_as_int(ps), 63));
    const float b = (dir == 0) ? ps : (total - ps + lfv);
    const float cB = liv - b;
    sBv[dir * 64 + lane] = b;
    sCB[dir * 64 + lane] = cB;
    const size_t so = (size_t)(dir * 4 + h) * T_TOK + tokc + lane;
    p.EBI[so] = __expf(b);
    p.WKg[so] = __expf(total + cB) * kscale;
    if (lane == 0) p.DEC[(dir * 4 + h) * 1280 + ci] = __expf(total);
  }
  f32x4 accA[4];
#pragma unroll
  for (int jt = 0; jt < 4; ++jt) accA[jt] = zero4();
#pragma unroll
  for (int ks = 0; ks < 4; ++ks) {
    bf16x8 aq = *(const bf16x8*)(p.MQb + (size_t)(tokc + 16 * w + c) * 512 + h * 128 + 32 * ks + 8 * g);
#pragma unroll
    for (int jt = 0; jt < 4; ++jt) {
      bf16x8 bk = *(const bf16x8*)(p.MKb + (size_t)(tokc + 16 * jt + c) * 512 + h * 128 + 32 * ks + 8 * g);
      accA[jt] = mfma16(aq, bk, accA[jt]);
    }
  }
  __syncthreads();
#pragma unroll
  for (int dir = 0; dir < 2; ++dir)
#pragma unroll
    for (int jt = 0; jt < 4; ++jt)
#pragma unroll
      for (int j = 0; j < 4; ++j) {
        const int i = 16 * w + 4 * g + j, jj = 16 * jt + c;
        const bool keep = (dir == 0) ? (jj <= i) : (jj > i);
        const float sv = keep ? accA[jt][j] * kscale * __expf(sBv[dir * 64 + i] + sCB[dir * 64 + jj]) : 0.f;
        sA[dir * 64 * 72 + i * 72 + jj] = f2bf(sv);
      }
  __syncthreads();
  bf16x8 ones = zero8();
  if (c == 0) {
#pragma unroll
    for (int e = 0; e < 8; ++e) ones[e] = (short)0x3F80;
  }
#pragma unroll
  for (int dir = 0; dir < 2; ++dir) {
    bf16_t* NUMI = dir ? p.NUMIb : p.NUMIf;
    bf16x8 af[2];
#pragma unroll
    for (int k2 = 0; k2 < 2; ++k2) af[k2] = *(const bf16x8*)(sA + dir * 64 * 72 + (16 * w + c) * 72 + 32 * k2 + 8 * g);
    f32x4 dn = zero4();
    dn = mfma16(af[0], ones, dn);
    dn = mfma16(af[1], ones, dn);
    if (c == 0) {
#pragma unroll
      for (int j = 0; j < 4; ++j) p.DENI[(size_t)(dir * 4 + h) * T_TOK + tokc + 16 * w + 4 * g + j] = dn[j];
    }
    bf16_t* sO = sA + 2 * 64 * 72 + 512;
#pragma unroll 4
    for (int vt = 0; vt < 8; ++vt) {
      f32x4 a = zero4();
#pragma unroll
      for (int k2 = 0; k2 < 2; ++k2) {
        bf16x8 vfr = *(const bf16x8*)(p.MVt + (size_t)(h * 128 + 16 * vt + c) * T_TOK + tokc + 32 * k2 + 8 * g);
        a = mfma16(af[k2], vfr, a);
      }
#pragma unroll
      for (int j = 0; j < 4; ++j) sO[(16 * w + 4 * g + j) * 136 + 16 * vt + c] = f2bf(a[j]);
    }
    __syncthreads();
#pragma unroll
    for (int i = 0; i < 4; ++i) {
      const int id = tid + 256 * i;
      const int row = id >> 4, c8 = id & 15;
      *(bf16x8*)(NUMI + (size_t)(tokc + row) * 512 + h * 128 + 8 * c8) = *(const bf16x8*)(sO + row * 136 + 8 * c8);
    }
    __syncthreads();
  }
}

struct MlRegs {
  bf16x8 aq[4];
  bf16x8 vf[2];
  bf16x8 kf[2][2];
  f32x4 wk[2][2];
  f32x4 ebi, deni;
  float dec;
  unsigned numi[4];
};

template <int DIR>
__device__ __forceinline__ void ml_chain_load(const Params& p, int h, int sl, int tokc, int w, int c, int g, MlRegs& r) {
#pragma unroll
  for (int ks = 0; ks < 4; ++ks) r.aq[ks] = *(const bf16x8*)(p.MQb + (size_t)(tokc + 16 * w + c) * 512 + h * 128 + 32 * ks + 8 * g);
#pragma unroll
  for (int k2 = 0; k2 < 2; ++k2)
    r.vf[k2] = *(const bf16x8*)(p.MVt + (size_t)(h * 128 + sl * 16 + c) * T_TOK + tokc + 32 * k2 + 8 * g);
#pragma unroll
  for (int dt = 0; dt < 2; ++dt)
#pragma unroll
    for (int k2 = 0; k2 < 2; ++k2)
      r.kf[dt][k2] = *(const bf16x8*)(p.MKt + (size_t)(h * 128 + 32 * w + 16 * dt + c) * T_TOK + tokc + 32 * k2 + 8 * g);
  const size_t so = (size_t)(DIR * 4 + h) * T_TOK + tokc;
#pragma unroll
  for (int k2 = 0; k2 < 2; ++k2) {
    r.wk[k2][0] = *(const f32x4*)(p.WKg + so + 32 * k2 + 8 * g);
    r.wk[k2][1] = *(const f32x4*)(p.WKg + so + 32 * k2 + 8 * g + 4);
  }
  r.ebi = *(const f32x4*)(p.EBI + so + 16 * w + 4 * g);
  r.deni = *(const f32x4*)(p.DENI + so + 16 * w + 4 * g);
  r.dec = p.DEC[(DIR * 4 + h) * 1280 + (tokc >> 6)];
  const bf16_t* NUMI = DIR ? p.NUMIb : p.NUMIf;
#pragma unroll
  for (int j = 0; j < 4; ++j) r.numi[j] = NUMI[(size_t)(tokc + 16 * w + 4 * g + j) * 512 + h * 128 + sl * 16 + c];
}

template <int DIR>
__device__ __forceinline__ void ml_chain_compute(const Params& p, int h, int sl, int tokc, int lane, int w, int c, int g, const MlRegs& r,
                                                 f32x4 (&C)[2][2], bf16_t* sCt, bool dry) {
  bf16_t* NUMI = DIR ? p.NUMIb : p.NUMIf;
  unsigned numi[4];
#pragma unroll
  for (int j = 0; j < 4; ++j) numi[j] = r.numi[j];
#pragma unroll
  for (int vt = 0; vt < 2; ++vt)
#pragma unroll
    for (int dt = 0; dt < 2; ++dt)
#pragma unroll
      for (int j = 0; j < 4; ++j) sCt[(16 * vt + 4 * g + j) * 136 + 32 * w + 16 * dt + c] = f2bf(C[vt][dt][j]);
  bf16x8 vfw[2][2];
#pragma unroll
  for (int k2 = 0; k2 < 2; ++k2) {
    float wv[8];
#pragma unroll
    for (int e = 0; e < 4; ++e) { wv[e] = r.wk[k2][0][e]; wv[4 + e] = r.wk[k2][1][e]; }
#pragma unroll
    for (int e = 0; e < 8; ++e) vfw[0][k2][e] = (short)f2bf(bf2f((bf16_t)r.vf[k2][e]) * wv[e]);
#pragma unroll
    for (int e = 0; e < 8; ++e) vfw[1][k2][e] = (c == 0) ? (short)f2bf(wv[e]) : (short)0;
  }
  lds_barrier();
  f32x4 o2[2];
  o2[0] = zero4(); o2[1] = zero4();
#pragma unroll
  for (int ks = 0; ks < 4; ++ks)
#pragma unroll
    for (int vt = 0; vt < 2; ++vt) {
      bf16x8 cf = *(const bf16x8*)(sCt + (16 * vt + c) * 136 + 32 * ks + 8 * g);
      o2[vt] = mfma16(r.aq[ks], cf, o2[vt]);
    }
#pragma unroll
  for (int dt = 0; dt < 2; ++dt)
#pragma unroll
    for (int vt = 0; vt < 2; ++vt) {
      f32x4 a = C[vt][dt] * r.dec;
#pragma unroll
      for (int k2 = 0; k2 < 2; ++k2) a = mfma16(vfw[vt][k2], r.kf[dt][k2], a);
      C[vt][dt] = a;
    }
#pragma unroll
  for (int j = 0; j < 4; ++j) {
    const float e = r.ebi[j];
    float den = e * o2[1][j];
    den = dpp_f<0x150>(den) + r.deni[j];
    const float inv = 1.f / fmaxf(fabsf(den), 1.f);
    const float hv = (bf2f((bf16_t)numi[j]) + e * o2[0][j]) * inv;
    if (!dry) NUMI[(size_t)(tokc + 16 * w + 4 * g + j) * 512 + h * 128 + sl * 16 + c] = f2bf(hv);
  }
}

template <int DIR>
__device__ __forceinline__ void ml_chain_run(const Params& p, int h, int sl, int tok0, int N, int lane, int w, int c, int g, bf16_t* sCt0, bool dry) {
  bf16_t* sCt1 = sCt0 + 32 * 136;
  f32x4 C[2][2];
#pragma unroll
  for (int a = 0; a < 2; ++a)
#pragma unroll
    for (int b = 0; b < 2; ++b) C[a][b] = zero4();
  MlRegs r0, r1;
  ml_chain_load<DIR>(p, h, sl, tok0 + (DIR ? N - 1 : 0) * 64, w, c, g, r0);
  for (int n = 0; n < N; n += 2) {
    const int c0 = DIR ? N - 1 - n : n;
    const int c1 = DIR ? N - 2 - n : n + 1;
    const int n2 = min(n + 2, N - 1);
    const int c2 = DIR ? N - 1 - n2 : n2;
    ml_chain_load<DIR>(p, h, sl, tok0 + c1 * 64, w, c, g, r1);
    ml_chain_compute<DIR>(p, h, sl, tok0 + c0 * 64, lane, w, c, g, r0, C, sCt0, dry);
    ml_chain_load<DIR>(p, h, sl, tok0 + c2 * 64, w, c, g, r0);
    ml_chain_compute<DIR>(p, h, sl, tok0 + c1 * 64, lane, w, c, g, r1, C, sCt1, dry);
  }
}

__device__ void ml_chain_item(const Params& p, int li, int item, char* smem, bool dry = false) {
  const int tid = otid(), lane = tid & 63, w = tid >> 6, c = lane & 15, g = lane >> 4;
  int pair, within;
  if (item < 512) { const int r = item >> 3; pair = (item & 7) + 8 * (r >> 4); within = r & 15; }
  else { const int it = item - 512; const int r = it >> 3; pair = 32 + (it & 7) + 8 * (r >> 4); within = r & 15; }
  const int sl = within & 7, dir = within >> 3;
  const int s = pair < 32 ? 4 + (pair >> 2) : ((pair - 32) >> 2);
  const int h = pair & 3;
  const int tok0 = s < 4 ? s * 4096 : T_P + (s - 4) * 8192;
  const int N = (s < 4 ? 4096 : 8192) / 64;
  bf16_t* sCt0 = (bf16_t*)smem;
  __syncthreads();
  if (dir == 0) ml_chain_run<0>(p, h, sl, tok0, N, lane, w, c, g, sCt0, dry);
  else ml_chain_run<1>(p, h, sl, tok0, N, lane, w, c, g, sCt0, dry);
}

#define ATTN_GLOAD(KT)                                                                              \
  {                                                                                                 \
    const long kb = tok0 + (KT) * 64;                                                               \
    rk0 = *(const bf16x8*)(p.KNb + (kb + (tid >> 3)) * 512 + head * 64 + 8 * (tid & 7));            \
    rk1 = *(const bf16x8*)(p.KNb + (kb + 32 + (tid >> 3)) * 512 + head * 64 + 8 * (tid & 7));       \
    rkr = *(const bf16x8*)(p.KRb + (kb + (tid >> 2)) * 32 + 8 * (tid & 3));                          \
    rv0 = *(const bf16x8*)(p.VtA + (long)(head * 64 + (tid >> 3)) * T_TOK + kb + 8 * (tid & 7));     \
    rv1 = *(const bf16x8*)(p.VtA + (long)(head * 64 + 32 + (tid >> 3)) * T_TOK + kb + 8 * (tid & 7)); \
  }
__device__ void attn_item(const Params& p, int item, char* smem, bool dry = false) {
  const int tid = otid(), lane = tid & 63, w = tid >> 6, c = lane & 15, g = lane >> 4;
  int s, head, qb;
  {
    const int x = item / 320, t = item % 320;
    if (t < 256) { const int pair = x + 8 * (t >> 5); qb = t & 31; s = 4 + (pair >> 3); head = pair & 7; }
    else { const int t2 = t - 256; const int pair = x + 8 * (t2 >> 4); qb = t2 & 15; s = pair >> 3; head = pair & 7; }
  }
  const int tok0 = s < 4 ? s * 4096 : T_P + (s - 4) * 8192;
  const int len = s < 4 ? 4096 : 8192;
  const int nkv = len / 64;
  constexpr int KV_STAGE = 64 * 104 + 64 * 72;
  bf16_t* sKV = (bf16_t*)smem;
  const int qrow0 = tok0 + qb * 256 + 64 * w;
  bf16_t* sQr = sKV + 2 * KV_STAGE;
  bf16x8 qf[4][2];
#pragma unroll
  for (int nt = 0; nt < 4; ++nt) {
#pragma unroll
    for (int ks = 0; ks < 2; ++ks)
      qf[nt][ks] = *(const bf16x8*)(p.Qa + (long)(qrow0 + 16 * nt + c) * 768 + head * 96 + 32 * ks + 8 * g);
    bf16x8 qr = *(const bf16x8*)(p.Qa + (long)(qrow0 + 16 * nt + c) * 768 + head * 96 + 64 + 8 * g);
    *(bf16x8*)(sQr + ((w * 4 + nt) * 64 + lane) * 8) = qr;
  }
  f32x4 ot[4][4];
#pragma unroll
  for (int vt = 0; vt < 4; ++vt)
#pragma unroll
    for (int nt = 0; nt < 4; ++nt) ot[vt][nt] = zero4();
  float mrun[4] = {-64.f, -64.f, -64.f, -64.f}, lrun[4] = {0.f, 0.f, 0.f, 0.f};
  bf16x8 rk0, rk1, rkr, rv0, rv1;
#define ATTN_LSTORE(STG)                                                                    \
  {                                                                                         \
    bf16_t* sK_ = sKV + (STG) * KV_STAGE;                                                   \
    bf16_t* sVt_ = sK_ + 64 * 104;                                                          \
    *(bf16x8*)(sK_ + (tid >> 3) * 104 + 8 * (tid & 7)) = rk0;                               \
    *(bf16x8*)(sK_ + (32 + (tid >> 3)) * 104 + 8 * (tid & 7)) = rk1;                        \
    *(bf16x8*)(sK_ + (tid >> 2) * 104 + 64 + 8 * (tid & 3)) = rkr;                          \
    *(bf16x8*)(sVt_ + (tid >> 3) * 72 + 8 * (tid & 7)) = rv0;                               \
    *(bf16x8*)(sVt_ + (32 + (tid >> 3)) * 72 + 8 * (tid & 7)) = rv1;                        \
  }
  ATTN_GLOAD(0)
  __syncthreads();
  ATTN_LSTORE(0)
  __syncthreads();
  for (int kt = 0; kt < nkv; ++kt) {
    const bf16_t* sK = sKV + (kt & 1) * KV_STAGE;
    const bf16_t* sVt = sK + 64 * 104;
    ATTN_GLOAD(min(kt + 1, nkv - 1))
#pragma unroll 1
    for (int half = 0; half < 2; ++half) {
      f32x4 st[2][4];
#pragma unroll
      for (int k4 = 0; k4 < 2; ++k4)
#pragma unroll
        for (int nt = 0; nt < 4; ++nt) {
          const float nm = -mrun[nt];
          f32x4 iv = {nm, nm, nm, nm};
          st[k4][nt] = iv;
        }
#pragma unroll
      for (int ks = 0; ks < 2; ++ks)
#pragma unroll
        for (int k4 = 0; k4 < 2; ++k4) {
          bf16x8 kf = *(const bf16x8*)(sK + (32 * half + 16 * k4 + c) * 104 + 32 * ks + 8 * g);
#pragma unroll
          for (int nt = 0; nt < 4; ++nt) st[k4][nt] = mfma16(kf, qf[nt][ks], st[k4][nt]);
        }
      {
        bf16x8 kr0 = *(const bf16x8*)(sK + (32 * half + c) * 104 + 64 + 8 * g);
        bf16x8 kr1 = *(const bf16x8*)(sK + (32 * half + 16 + c) * 104 + 64 + 8 * g);
#pragma unroll
        for (int nt = 0; nt < 4; ++nt) {
          bf16x8 qr = *(const bf16x8*)(sQr + ((w * 4 + nt) * 64 + lane) * 8);
          st[0][nt] = mfma16(kr0, qr, st[0][nt]);
          st[1][nt] = mfma16(kr1, qr, st[1][nt]);
        }
      }
      bf16x8 pb[4];
#pragma unroll
      for (int nt = 0; nt < 4; ++nt) {
        float mx = -1e30f;
#pragma unroll
        for (int k4 = 0; k4 < 2; ++k4)
#pragma unroll
          for (int j = 0; j < 4; ++j) mx = fmaxf(mx, st[k4][nt][j]);
        mx = rowmax4(mx);
        if (__builtin_amdgcn_ballot_w64(mx > 0.f) != 0ull) {
          const float d = fmaxf(mx, 0.f);
          const float alpha = __builtin_amdgcn_exp2f(-d);
          mrun[nt] += d;
          lrun[nt] *= alpha;
#pragma unroll
          for (int vt = 0; vt < 4; ++vt) ot[vt][nt] = ot[vt][nt] * alpha;
#pragma unroll
          for (int k4 = 0; k4 < 2; ++k4)
#pragma unroll
            for (int j = 0; j < 4; ++j) st[k4][nt][j] -= d;
        }
        float psum = 0.f;
#pragma unroll
        for (int k4 = 0; k4 < 2; ++k4)
#pragma unroll
          for (int j = 0; j < 4; ++j) {
            float pv = __builtin_amdgcn_exp2f(st[k4][nt][j]);
            st[k4][nt][j] = pv;
            psum += pv;
          }
        lrun[nt] += psum;
        typedef __attribute__((ext_vector_type(4))) unsigned u32x4;
        u32x4 pk;
        pk[0] = pk2bf(st[0][nt][0], st[0][nt][1]);
        pk[1] = pk2bf(st[0][nt][2], st[0][nt][3]);
        pk[2] = pk2bf(st[1][nt][0], st[1][nt][1]);
        pk[3] = pk2bf(st[1][nt][2], st[1][nt][3]);
        pb[nt] = __builtin_bit_cast(bf16x8, pk);
      }
#pragma unroll
      for (int vt = 0; vt < 4; ++vt) {
        us4 lo = *(const us4*)(sVt + (16 * vt + c) * 72 + 32 * half + 4 * g);
        us4 hi = *(const us4*)(sVt + (16 * vt + c) * 72 + 32 * half + 16 + 4 * g);
        bf16x8 av;
#pragma unroll
        for (int e = 0; e < 4; ++e) { av[e] = (short)lo[e]; av[4 + e] = (short)hi[e]; }
#pragma unroll
        for (int nt = 0; nt < 4; ++nt) ot[vt][nt] = mfma16(av, pb[nt], ot[vt][nt]);
      }
    }
    if (kt + 1 < nkv) ATTN_LSTORE((kt + 1) & 1)
    __syncthreads();
  }
#undef ATTN_LSTORE
#pragma unroll
  for (int nt = 0; nt < 4; ++nt) {
    float lt = lrun[nt];
    lt += sxor(lt, 16, lane);
    lt += sxor(lt, 32, lane);
    const float inv = 1.f / lt;
    const long tok = qrow0 + 16 * nt + c;
#pragma unroll
    for (int vt = 0; vt < 4; ++vt) {
      bf16_t* gp = p.MGb + tok * 512 + head * 64 + 16 * vt + 4 * g;
      us4 gt = *(const us4*)gp;
      us4 o;
#pragma unroll
      for (int j = 0; j < 4; ++j) o[j] = f2bf(ot[vt][nt][j] * inv * siluf_(bf2f(gt[j])));
      if (!dry) *(us4*)gp = o;
    }
  }
}

__device__ void phase_gla_combine(const Params& p, int li, bool dry = false) {
  const int tid_ = otid(); const int lane = tid_ & 63, w = tid_ >> 6;
#pragma unroll 2
  for (int tok = blockIdx.x * 4 + w; tok < T_TOK; tok += gridDim.x * 4) {
    const bf16_t* tp = p.TMP + (long)tok * 1024 + 16 * lane;
    bf16_t* gp = p.Gb + (long)tok * 1024 + 16 * lane;
    bf16x8 o0 = *(const bf16x8*)tp, o1 = *(const bf16x8*)(tp + 8);
    bf16x8 g0 = *(const bf16x8*)gp, g1 = *(const bf16x8*)(gp + 8);
    float ov[16], gv[16];
#pragma unroll
    for (int e = 0; e < 8; ++e) {
      ov[e] = bf2f((bf16_t)o0[e]); ov[8 + e] = bf2f((bf16_t)o1[e]);
      gv[e] = bf2f((bf16_t)g0[e]); gv[8 + e] = bf2f((bf16_t)g1[e]);
    }
    float ss = 0.f;
#pragma unroll
    for (int e = 0; e < 16; ++e) ss += ov[e] * ov[e];
    ss = row_sum16(ss);
    const float rs = rsqrtf(ss * (1.f / 256.f) + EPS);
    const float* ng = p.e_gla_norm_g + li * 256 + ((16 * lane) & 255);
    bf16x8 r0, r1;
#pragma unroll
    for (int e = 0; e < 8; ++e) {
      r0[e] = (short)f2bf(ov[e] * rs * ng[e] * siluf_(gv[e]));
      r1[e] = (short)f2bf(ov[8 + e] * rs * ng[8 + e] * siluf_(gv[8 + e]));
    }
    if (!dry) { *(bf16x8*)gp = r0;
    *(bf16x8*)(gp + 8) = r1; }
  }
}

__device__ void phase_ml_combine(const Params& p, int li, bool dry = false) {
  const int tid_ = otid(); const int lane = tid_ & 63, w = tid_ >> 6;
#pragma unroll 2
  for (int tok = blockIdx.x * 4 + w; tok < T_TOK; tok += gridDim.x * 4) {
    const long off = (long)tok * 512 + 8 * lane;
    bf16x8 hv = *(const bf16x8*)(p.NUMIf + off);
    bf16x8 hb = *(const bf16x8*)(p.NUMIb + off);
    bf16x8 mo = *(const bf16x8*)(p.MOb + off);
    bf16x8 mg = *(const bf16x8*)(p.MLGb + off);
    float hf[8];
    float ss = 0.f;
#pragma unroll
    for (int e = 0; e < 8; ++e) { hf[e] = bf2f((bf16_t)hv[e]) + bf2f((bf16_t)hb[e]); ss += hf[e] * hf[e]; }
    ss = row_sum16(ss);
    const float rs = rsqrtf(ss * (1.f / 128.f) + EPS);
    const float* ng = p.o_ml_norm_g + li * 128 + ((8 * lane) & 127);
    bf16x8 r;
#pragma unroll
    for (int e = 0; e < 8; ++e)
      r[e] = (short)f2bf(hf[e] * rs * ng[e] * sigmoidf_(bf2f((bf16_t)mo[e])) * siluf_(bf2f((bf16_t)mg[e])));
    if (!dry) *(bf16x8*)(p.MLGb + off) = r;
  }
}

__device__ void phase_final(const Params& p, bool dry = false) {
  const int tid_ = otid(); const int lane = tid_ & 63, w = tid_ >> 6;
#pragma unroll 2
  for (int tok = blockIdx.x * 4 + w; tok < T_TOK; tok += gridDim.x * 4) {
    float* xp = p.out + (long)tok * DM;
    float4 v[4];
    float ss = 0.f;
#pragma unroll
    for (int i = 0; i < 4; ++i) {
      v[i] = *(const float4*)(xp + 4 * lane + 256 * i);
      ss += v[i].x * v[i].x + v[i].y * v[i].y + v[i].z * v[i].z + v[i].w * v[i].w;
    }
    ss = wave_sum(ss);
    const float rs = rsqrtf(ss * (1.f / 1024.f) + EPS);
#pragma unroll
    for (int i = 0; i < 4; ++i) {
      float4 gq = *(const float4*)(p.final_norm_g + 4 * lane + 256 * i);
      float4 o;
      o.x = v[i].x * rs * gq.x; o.y = v[i].y * rs * gq.y; o.z = v[i].z * rs * gq.z; o.w = v[i].w * rs * gq.w;
      if (!dry) *(float4*)(xp + 4 * lane + 256 * i) = o;
    }
  }
}

__device__ void run_phase(const Params& p, int ph, char* smem) {
  if (ph == 0) { if (PH_ON(0)) phase_prep(p, smem); return; }
  if (ph == NPHASE - 1) { if (PROBE_B) phase_final(p, true); if (PH_ON(11)) phase_final(p); return; }
  const int q = ph - 1;
  const int layer = (q < 5) ? 0 : (q < 11) ? 1 : (q < 16) ? 2 : 3;
  const int sub = (q < 5) ? q : (q < 11) ? q - 5 : (q < 16) ? q - 11 : q - 16;
  const int li = layer >> 1;
  const float* xa = (layer == 0) ? p.x_prompt : p.out;
  const float* xb = (layer == 0) ? p.x_sample : p.out + (long)T_P * DM;
  if ((layer & 1) == 0) {
    if (sub == 0) {
      EpiEvenIn e{p.Qb, p.Kt, p.VtE, p.Gb, p.LRb, p.PUb, p.PGb};
      if (PH_ON(1)) gemm_phase<3, 8>(T_TOK / 128, NE_PAD / 256, DM, p.WinE + (long)li * NE_PAD * DM, p.SSQ, nullptr, p.TMP, DM, DM, p.TMP, DM, e, smem);
    } else if (sub == 1) {
      for (int item = blockIdx.x; item < 5120; item += gridDim.x)
        if (PH_ON(2)) gla_intra_item(p, li, item, smem);
    } else if (sub == 2) {
      __shared__ int s_pitem;
      for (int item = blockIdx.x; item < 384; item += gridDim.x) { if (PH_ON(2)) gla_chain_item(p, li, item, smem, false); }
      for (;;) {
        __syncthreads();
        if (threadIdx.x == 0) s_pitem = atomicAdd(p.counters + 16 + li, 1);
        __syncthreads();
        const int item = s_pitem;
        if (item >= 5120) break;
        if (PH_ON(3)) pool_item(p, li, item, smem);
      }
    } else if (sub == 3) {
      if (PROBE_B) phase_gla_combine(p, li, true);
      if (PH_ON(4)) phase_gla_combine(p, li);
    } else {
      EpiOut e{xa, xb, p.out, false, p.NUMIf, p.SSQ};
      if (PH_ON(5)) gemm_phase<1, 8>(T_TOK / 128, DM / 256, 1536, p.WoutE + (long)li * DM * 1536, nullptr, nullptr, p.Gb, 1024, 1024, p.PGb, 512, e, smem);
    }
  } else {
    if (sub == 0) {
      EpiOddIn e{p.CQb, p.CKVb, p.KRb, p.MGb, p.MQb, p.MKb, p.MKt, p.MVt, p.MOb, p.MLGb, p.MIF};
      if (PH_ON(6)) gemm_phase<3, 8>(T_TOK / 128, NO_PAD / 256, DM, p.WinO + (long)li * NO_PAD * DM, p.SSQ, nullptr, p.NUMIf, DM, DM, p.NUMIf, DM, e, smem);
    } else if (sub == 1) {
      for (int rep = 0; rep < 1 + PROBE_A; ++rep)
      for (int item = blockIdx.x; item < 5120; item += gridDim.x)
        if (PH_ON(8)) ml_intra_item(p, li, item, smem);
    } else if (sub == 2) {
      for (int item = blockIdx.x; item < 768; item += gridDim.x)
        if (PH_ON(8)) ml_chain_item(p, li, item, smem, false);
    } else if (sub == 3) {
      if (PH_ON(10)) phase_ml_combine(p, li);
      EpiQUp eq{p.Qa};
      if (PH_ON(7)) gemm_phase<2, 4>(T_TOK / 128, 768 / 128, 384, p.QupT + (long)li * 768 * 384, nullptr, nullptr, p.CQb, 384, 384, p.CQb, 384, eq, smem);
      EpiKVUp ek{p.KNb, p.VtA};
      if (PH_ON(7)) gemm_phase<2, 4>(T_TOK / 128, 1024 / 128, 256, p.KVupT + (long)li * 1024 * 256, nullptr, nullptr, p.CKVb, 256, 256, p.CKVb, 256, ek, smem);
    } else if (sub == 4) {
      __shared__ int s_item;
      for (;;) {
        __syncthreads();
        if (threadIdx.x == 0) s_item = atomicAdd(p.counters + li * 8 + (blockIdx.x & 7), 1);
        __syncthreads();
        const int item = s_item;
        if (item >= 320) break;
        if (PH_ON(9)) attn_item(p, (blockIdx.x & 7) * 320 + item, smem);
      }
    } else {
      EpiOut e{xa, xb, p.out, false, (layer == 3) ? nullptr : p.TMP, p.SSQ};
      if (PH_ON(5)) gemm_phase<1, 8>(T_TOK / 128, DM / 256, 1024, p.WoutO + (long)li * DM * 1024, nullptr, nullptr, p.MGb, 512, 512, p.MLGb, 512, e, smem);
    }
  }
}

__global__ void __launch_bounds__(256, 2) mega_kernel(Params p) {
  extern __shared__ __attribute__((aligned(16))) char smem[];
  cg::grid_group grid = cg::this_grid();
  __shared__ uint4 xb_words;
  if (threadIdx.x == 0) xb_words = make_uint4(0u, 0u, 0u, 0u);
  __syncthreads();
  XcdBarrier xb = xcd_barrier_post(p.bar, (volatile LAS unsigned*)&xb_words);
  for (int ph = p.ph_lo; ph < p.ph_hi; ++ph) {
    if (ph > p.ph_lo) {
      if (ph == p.ph_lo + 1) grid.sync();
      else xcd_barrier(xb);
    }
    run_phase(p, ph, smem);
  }
}

extern "C" void kernel_launch(void* const* d_in, const int* in_sizes, int n_in, void* d_out, int out_size, void* d_ws,
                              size_t ws_size, hipStream_t stream) {
  static int grid_blocks = 0;
  if (!grid_blocks) {
    int dev = 0, cus = 0, per_cu = 0;
    hipGetDevice(&dev);
    hipDeviceGetAttribute(&cus, hipDeviceAttributeMultiprocessorCount, dev);
    hipFuncSetAttribute((const void*)mega_kernel, hipFuncAttributeMaxDynamicSharedMemorySize, LDS_BYTES);
    hipOccupancyMaxActiveBlocksPerMultiprocessor(&per_cu, (const void*)mega_kernel, 256, LDS_BYTES);
    if (per_cu < 1) per_cu = 1;
    if (per_cu > 2) per_cu = 2;
    grid_blocks = cus * per_cu;
    fprintf(stderr, "kernel_launch: cus %d per_cu %d grid %d ws %zu\n", cus, per_cu, grid_blocks, ws_size);
  }
  Params p{};
  const float** pin = (const float**)&p;
  for (int i = 0; i < 19; ++i) pin[i] = (const float*)d_in[i];
  p.out = (float*)d_out;
  char* ws = (char*)d_ws;
  size_t off = 0;
  auto take = [&](size_t bytes) { char* r = ws + off; off += (bytes + 255) & ~(size_t)255; return r; };
  p.WinE = (bf16_t*)take((size_t)2 * NE_PAD * DM * 2);
  p.WinO = (bf16_t*)take((size_t)2 * NO_PAD * DM * 2);
  p.WoutE = (bf16_t*)take((size_t)2 * DM * 1536 * 2);
  p.WoutO = (bf16_t*)take((size_t)2 * DM * 1024 * 2);
  p.QupT = (bf16_t*)take((size_t)2 * 768 * 384 * 2);
  p.KVupT = (bf16_t*)take((size_t)2 * 1024 * 256 * 2);
  p.PoolWT = (bf16_t*)take((size_t)2 * 4 * 128 * 128 * 2);
  p.AupT = (bf16_t*)take((size_t)2 * 2 * 512 * 32 * 2);
  p.counters = (int*)take(256);
  p.bar = (unsigned*)take((size_t)XCD_BAR_WORDS * 4);
  p.SSQ = (float*)take((size_t)T_TOK * 8 * 4);
  const size_t act0 = off;
  const size_t T = T_TOK;
  p.Gb = (bf16_t*)take(T * 1024 * 2);
  p.PGb = (bf16_t*)take(T * 512 * 2);
  p.Qb = (bf16_t*)take(T * 512 * 2);
  p.Kt = (bf16_t*)take(T * 512 * 2);
  p.QEb = (bf16_t*)take(T * 512 * 2);
  p.KdTb = (bf16_t*)take(T * 512 * 2);
  p.EB = (float*)take((size_t)2 * 1280 * 512 * 4);
  p.VtE = (bf16_t*)take(T * 1024 * 2);
  p.LRb = (bf16_t*)take(T * 32 * 2);
  p.PUb = (bf16_t*)take(T * 512 * 2);
  p.TMP = (bf16_t*)take(T * 1024 * 2);
  const size_t even_end = off;
  off = act0;
  p.MGb = (bf16_t*)take(T * 512 * 2);
  p.MLGb = (bf16_t*)take(T * 512 * 2);
  p.CQb = (bf16_t*)take(T * 384 * 2);
  p.CKVb = (bf16_t*)take(T * 256 * 2);
  p.KRb = (bf16_t*)take(T * 32 * 2);
  const size_t r2 = off;
  p.MQb = (bf16_t*)take(T * 512 * 2);
  p.MKb = (bf16_t*)take(T * 512 * 2);
  p.MKt = (bf16_t*)take(T * 512 * 2);
  p.MVt = (bf16_t*)take(T * 512 * 2);
  p.MOb = (bf16_t*)take(T * 512 * 2);
  p.NUMIf = (bf16_t*)take(T * 512 * 2);
  p.NUMIb = (bf16_t*)take(T * 512 * 2);
  p.MIF = (float*)take(T * 16 * 4);
  p.EBI = (float*)take(T * 8 * 4);
  p.WKg = (float*)take(T * 8 * 4);
  p.DENI = (float*)take(T * 8 * 4);
  p.DEC = (float*)take((size_t)8 * 1280 * 4);
  const size_t r2_end = off;
  off = r2;
  p.Qa = (bf16_t*)take(T * 768 * 2);
  p.KNb = (bf16_t*)take(T * 512 * 2);
  p.VtA = (bf16_t*)take(T * 512 * 2);
  if (off < r2_end) off = r2_end;
  const size_t odd_end = off;
  const size_t need = even_end > odd_end ? even_end : odd_end;
  if (need > ws_size) {
    fprintf(stderr, "kernel_launch: workspace too small: need %zu have %zu\n", need, ws_size);
    return;
  }
  hipMemsetAsync(p.bar, 0, (size_t)XCD_BAR_WORDS * 4, stream);
#if SINGLE_LAUNCH
  p.ph_lo = 0;
  p.ph_hi = NPHASE;
  void* args[] = {&p};
  hipError_t e = hipLaunchCooperativeKernel((const void*)mega_kernel, dim3(grid_blocks), dim3(256), args, LDS_BYTES, stream);
  if (e != hipSuccess) fprintf(stderr, "cooperative launch failed: %s (grid %d)\n", hipGetErrorString(e), grid_blocks);
#else
  for (int ph = 0; ph < NPHASE; ++ph) {
    p.ph_lo = ph;
    p.ph_hi = ph + 1;
    hipLaunchKernelGGL(mega_kernel, dim3(grid_blocks), dim3(256), LDS_BYTES, stream, p);
  }
#endif
}
```

```cpp
#include <hip/hip_runtime.h>
#include <hip/hip_cooperative_groups.h>
#include <cstdio>
namespace cg = cooperative_groups;

#ifndef SINGLE_LAUNCH
#define SINGLE_LAUNCH 1
#endif
#ifndef PHMASK
#define PHMASK 0xFFFF
#endif
#define PH_ON(b) ((PHMASK >> (b)) & 1)
#ifndef PROBE_GEMM
#define PROBE_GEMM 0
#endif
#ifndef PROBE_ATTN
#define PROBE_ATTN 0
#endif
#ifndef PROBE_CHAIN
#define PROBE_CHAIN 0
#endif
#ifndef PROBE_A
#define PROBE_A 0
#endif
#ifndef PROBE_B
#define PROBE_B 0
#endif
#ifndef PROBE_MLCHAIN
#define PROBE_MLCHAIN 0
#endif

typedef unsigned short bf16_t;
typedef __attribute__((ext_vector_type(8))) short bf16x8;
typedef __attribute__((ext_vector_type(4))) float f32x4;
typedef __attribute__((ext_vector_type(4))) unsigned short us4;

constexpr int T_TOK = 81920;
constexpr int T_P = 16384;
constexpr int DM = 1024;
constexpr int NE = 4128, NE_PAD = 4352;
constexpr int NO = 3760, NO_PAD = 3840;
constexpr float EPS = 1e-6f;
constexpr int NPHASE = 24;
constexpr int LDS_BYTES = 72 * 1024;

struct Params {
  const float *x_prompt, *x_sample, *norm_g, *final_norm_g, *e_w_in, *e_a_up, *e_a_bias, *e_gla_norm_g,
      *e_pool_w, *e_pool_scale, *e_w_out, *o_w_in, *o_q_norm_g, *o_q_up, *o_kv_norm_g, *o_kv_up, *o_if_bias,
      *o_ml_norm_g, *o_w_out;
  float* out;
  bf16_t *WinE, *WinO, *WoutE, *WoutO, *QupT, *KVupT, *PoolWT, *AupT;
  int* counters;
  unsigned* bar;
  float* SSQ;
  bf16_t *Qb, *Kt, *VtE, *Gb, *LRb, *PUb, *PGb, *TMP, *QEb, *KdTb;
  float* EB;
  bf16_t *CQb, *CKVb, *KRb, *MGb, *MQb, *MKb, *MKt, *MVt, *MOb, *MLGb, *NUMIf, *NUMIb, *Qa, *KNb, *VtA;
  float *MIF, *EBI, *WKg, *DENI, *DEC;
  int ph_lo, ph_hi;
};

typedef __bf16 hbf2 __attribute__((ext_vector_type(2)));
typedef float hf2 __attribute__((ext_vector_type(2)));
__device__ __forceinline__ bf16_t f2bf(float f) {
  __bf16 b = (__bf16)f;
  return __builtin_bit_cast(bf16_t, b);
}
__device__ __forceinline__ unsigned pk2bf(float a, float b) {
  hf2 v = {a, b};
  hbf2 r = __builtin_convertvector(v, hbf2);
  return __builtin_bit_cast(unsigned, r);
}
__device__ __forceinline__ float bf2f(bf16_t b) { return __uint_as_float(((unsigned)b) << 16); }
__device__ __forceinline__ f32x4 mfma16(bf16x8 a, bf16x8 b, f32x4 c) {
  return __builtin_amdgcn_mfma_f32_16x16x32_bf16(a, b, c, 0, 0, 0);
}
__device__ __forceinline__ float logsigmoidf_(float x) { return fminf(x, 0.f) - log1pf(__expf(-fabsf(x))); }
__device__ __forceinline__ float siluf_(float x) { return x / (1.f + __expf(-x)); }
__device__ __forceinline__ float sigmoidf_(float x) { return 1.f / (1.f + __expf(-x)); }
__device__ __forceinline__ int otid() { int t = threadIdx.x; asm volatile("" : "+v"(t)); return t; }
__device__ __forceinline__ float bperm(int srclane, float v) { return __int_as_float(__builtin_amdgcn_ds_bpermute(srclane << 2, __float_as_int(v))); }
__device__ __forceinline__ float sxor(float v, int m, int lane) { return bperm(lane ^ m, v); }
typedef unsigned u32x2_t __attribute__((ext_vector_type(2)));
__device__ __forceinline__ float rowmax4(float v) {
  u32x2_t r = __builtin_amdgcn_permlane16_swap(__float_as_uint(v), __float_as_uint(v), false, false);
  v = fmaxf(__uint_as_float(r[0]), __uint_as_float(r[1]));
  r = __builtin_amdgcn_permlane32_swap(__float_as_uint(v), __float_as_uint(v), false, false);
  return fmaxf(__uint_as_float(r[0]), __uint_as_float(r[1]));
}
template <int CTRL> __device__ __forceinline__ float dpp_f(float v) {
  return __int_as_float(__builtin_amdgcn_update_dpp(0, __float_as_int(v), CTRL, 0xf, 0xf, false));
}
__device__ __forceinline__ float row_sum16(float v) {
  v += dpp_f<0x128>(v);
  v += dpp_f<0x124>(v);
  v += dpp_f<0x122>(v);
  v += dpp_f<0x121>(v);
  return v;
}
__device__ __forceinline__ float wave_sum(float v) {
  v += dpp_f<0x128>(v);
  v += dpp_f<0x124>(v);
  v += dpp_f<0x122>(v);
  v += dpp_f<0x121>(v);
  u32x2_t r = __builtin_amdgcn_permlane16_swap(__float_as_uint(v), __float_as_uint(v), false, false);
  v = __uint_as_float(r[0]) + __uint_as_float(r[1]);
  r = __builtin_amdgcn_permlane32_swap(__float_as_uint(v), __float_as_uint(v), false, false);
  return __uint_as_float(r[0]) + __uint_as_float(r[1]);
}
__device__ __forceinline__ bf16x8 zero8() { bf16x8 z = {0, 0, 0, 0, 0, 0, 0, 0}; return z; }
__device__ __forceinline__ f32x4 zero4() { f32x4 z = {0.f, 0.f, 0.f, 0.f}; return z; }

__device__ __forceinline__ int seq_pos(int tok) { return tok < T_P ? (tok & 4095) : ((tok - T_P) & 8191); }
__device__ __forceinline__ const float* xrow(const float* xa, const float* xb, int tok) {
  return tok < T_P ? xa + (long)tok * DM : xb + (long)(tok - T_P) * DM;
}


#define XB_TMO      128
#define XB_XCNT(j)  (256  + 64 * (j))
#define XB_XSUB(j)  (1280 + 64 * (j))
#define XB_XGEN(j)  (2304 + 64 * (j))
#define XB_TOP      3328
#define XB_TOPGEN   3392
#define XCD_BAR_WORDS 3456
#define XB_SPIN_CAP (1u << 22)
#define LAS __attribute__((address_space(3)))
__device__ __forceinline__ unsigned xb_ld(unsigned* p) { return __hip_atomic_load(p, __ATOMIC_RELAXED, __HIP_MEMORY_SCOPE_AGENT); }
__device__ __forceinline__ unsigned xb_add(unsigned* p, unsigned v) { return __hip_atomic_fetch_add(p, v, __ATOMIC_RELAXED, __HIP_MEMORY_SCOPE_AGENT); }
__device__ __forceinline__ unsigned xb_xcc_id() { return (unsigned)__builtin_amdgcn_s_getreg((3 << 11) | 20) & 0xFu; }
#define XB_SPIN(cond, bar) do { unsigned _sp = 0; while (cond) { __builtin_amdgcn_s_sleep(1); \
    if ((++_sp & 255u) == 0u) { if (xb_ld(&(bar)[XB_TMO])) break; if (_sp > XB_SPIN_CAP) { atomicAdd(&(bar)[XB_TMO], 1u); break; } } } } while (0)
struct XcdBarrier { unsigned* bar; unsigned x; volatile LAS unsigned* st; };
__device__ __forceinline__ XcdBarrier xcd_barrier_post(unsigned* bar, volatile LAS unsigned* st) {
  XcdBarrier b; b.bar = bar; b.x = xb_xcc_id(); b.st = st;
  if (threadIdx.x == 0) (void)xb_add(&bar[XB_XCNT(b.x)], 1u);
  return b;
}
__device__ __forceinline__ void xcd_barrier_complete(unsigned* bar, unsigned x, unsigned& nloc, unsigned& nx) {
  const unsigned G = gridDim.x * gridDim.y * gridDim.z;
  unsigned sum, cnt, mine, sp = 0u;
  for (;;) {
    sum = 0u; cnt = 0u; mine = 0u;
#pragma unroll
    for (unsigned j = 0; j < 16; ++j) { const unsigned cc = xb_ld(&bar[XB_XCNT(j)]); sum += cc; cnt += (cc > 0u) ? 1u : 0u; mine = (j == x) ? cc : mine; }
    if (sum == G) break;
    __builtin_amdgcn_s_sleep(1);
    if ((++sp & 255u) == 0u) { if (xb_ld(&bar[XB_TMO])) break; if (sp > XB_SPIN_CAP) { atomicAdd(&bar[XB_TMO], 1u); break; } }
  }
  nloc = mine > 0u ? mine : 1u; nx = cnt > 0u ? cnt : 1u;
}
__device__ __forceinline__ void xcd_barrier(const XcdBarrier& b) {
  asm volatile("s_waitcnt vmcnt(0)" ::: "memory");
  __syncthreads();
  if (threadIdx.x == 0) {
    unsigned* bar = b.bar;
    __builtin_amdgcn_s_waitcnt(0);
    unsigned nloc = b.st[0], nx = b.st[1];
    if (nloc == 0u) { xcd_barrier_complete(bar, b.x, nloc, nx); b.st[0] = nloc; b.st[1] = nx; }
    const unsigned old = xb_add(&bar[XB_XSUB(b.x)], 1u);
    const unsigned gen = old / nloc;
    if (old + 1u == (gen + 1u) * nloc) {
      __builtin_amdgcn_fence(__ATOMIC_RELEASE, "agent");
      asm volatile("s_waitcnt vmcnt(0)" ::: "memory");
      const unsigned og = xb_add(&bar[XB_TOP], 1u);
      const unsigned tg = og / nx;
      if (og + 1u == (tg + 1u) * nx) xb_add(&bar[XB_TOPGEN], 1u);
      else XB_SPIN(xb_ld(&bar[XB_TOPGEN]) == tg, bar);
      __builtin_amdgcn_fence(__ATOMIC_ACQUIRE, "agent");
      xb_add(&bar[XB_XGEN(b.x)], 1u);
      asm volatile("s_waitcnt vmcnt(0)" ::: "memory");
    } else {
      XB_SPIN(xb_ld(&bar[XB_XGEN(b.x)]) == gen, bar);
      __builtin_amdgcn_fence(__ATOMIC_ACQUIRE, "agent");
      asm volatile("s_waitcnt vmcnt(0)" ::: "memory");
    }
  }
  __syncthreads();
}

__device__ __forceinline__ int colmap(int mode, int n) {
  if (mode == 1) {
    if (n < 512) return 2208 + n;
    if (n < 1024) return 1696 + (n - 512);
    if (n < 1408) return n - 1024;
    if (n < 1664) return 384 + (n - 1408);
    if (n < 2176) return 672 + (n - 1664);
    if (n < 2688) return 1184 + (n - 2176);
    if (n < 3200) return 2720 + (n - 2688);
    if (n < 3712) return 3248 + (n - 3200);
    if (n < 3744) return 640 + (n - 3712);
    return 3232 + (n - 3744);
  }
  if (mode == 2) {
    if (n < 512) return (n >> 6) * 96 + (n & 63);
    const int r = n - 512;
    return (r >> 5) * 96 + 64 + (r & 31);
  }
  if (mode == 3) {
    if (n < 512) return (n >> 6) * 128 + (n & 63);
    const int r = n - 512;
    return (r >> 6) * 128 + 64 + (r & 63);
  }
  return n;
}

__device__ void prep_weight(const float* __restrict__ W, int K, int N, int Npad, const float* __restrict__ gsc,
                            bf16_t* __restrict__ out, char* smem, int mode = 0, int Nsrc_ = 0) {
  const int Nsrc = Nsrc_ ? Nsrc_ : N;
  const int tid = otid();
  float* sT = (float*)smem;
  const int tn = Npad >> 6, tk = K >> 6;
  for (int tile = blockIdx.x; tile < tn * tk; tile += gridDim.x) {
    const int n0 = (tile / tk) << 6, k0 = (tile % tk) << 6;
    __syncthreads();
#pragma unroll 4
    for (int i = 0; i < 16; ++i) {
      const int idx = tid + 256 * i;
      const int kk = idx >> 6, nn = idx & 63;
      float v = 0.f;
      if (n0 + nn < N) {
        v = W[(size_t)(k0 + kk) * Nsrc + colmap(mode, n0 + nn)];
        if (gsc) v *= gsc[k0 + kk];
      }
      sT[nn * 65 + kk] = v;
    }
    __syncthreads();
#pragma unroll 4
    for (int i = 0; i < 16; ++i) {
      const int idx = tid + 256 * i;
      const int nn = idx >> 6, kk = idx & 63;
      out[(size_t)(n0 + nn) * K + k0 + kk] = f2bf(sT[nn * 65 + kk]);
    }
  }
}

__device__ void phase_prep(const Params& p, char* smem) {
  long gtid = (long)blockIdx.x * 256 + otid();
  long gsize = (long)gridDim.x * 256;
  for (int l = 0; l < 2; ++l) {
    prep_weight(p.e_w_in + (long)l * DM * NE, DM, NE, NE_PAD, p.norm_g + (2 * l) * DM, p.WinE + (long)l * NE_PAD * DM, smem);
    prep_weight(p.o_w_in + (long)l * DM * 3760, DM, NO, NO_PAD, p.norm_g + (2 * l + 1) * DM, p.WinO + (long)l * NO_PAD * DM, smem, 1, 3760);
    prep_weight(p.e_w_out + (long)l * 1536 * DM, 1536, DM, DM, nullptr, p.WoutE + (long)l * DM * 1536, smem);
    prep_weight(p.o_w_out + (long)l * 1024 * DM, 1024, DM, DM, nullptr, p.WoutO + (long)l * DM * 1024, smem);
    prep_weight(p.o_q_up + (long)l * 384 * 768, 384, 768, 768, p.o_q_norm_g + l * 384, p.QupT + (long)l * 768 * 384, smem, 2);
    prep_weight(p.o_kv_up + (long)l * 256 * 1024, 256, 1024, 1024, p.o_kv_norm_g + l * 256, p.KVupT + (long)l * 1024 * 256, smem, 3);
    for (int gi = 0; gi < 4; ++gi)
      prep_weight(p.e_pool_w + (long)(l * 4 + gi) * 128 * 128, 128, 128, 128, nullptr, p.PoolWT + (long)(l * 4 + gi) * 128 * 128, smem);
    for (long idx = gtid; idx < 2 * 512 * 32; idx += gsize) {
      int r = (int)(idx & 31);
      int d = (int)((idx >> 5) & 511);
      int dir = (int)(idx >> 14);
      float v = (r < 16) ? p.e_a_up[((long)(l * 2 + dir) * 16 + r) * 512 + d] : 0.f;
      p.AupT[((long)(l * 2 + dir) * 512 + d) * 32 + r] = f2bf(v);
    }
  }
  if (gtid < 32) p.counters[gtid] = 0;
  {
    const int tid_ = otid();
    const int lane = tid_ & 63, w = tid_ >> 6;
  #pragma unroll 2
  for (int tok = blockIdx.x * 4 + w; tok < T_TOK; tok += gridDim.x * 4) {
      const float* xp = xrow(p.x_prompt, p.x_sample, tok) + 16 * lane;
      float ssv = 0.f;
      unsigned pk[8];
#pragma unroll
      for (int i = 0; i < 4; ++i) {
        const f32x4 v = *(const f32x4*)(xp + 4 * i);
        ssv += v[0] * v[0] + v[1] * v[1] + v[2] * v[2] + v[3] * v[3];
        pk[2 * i] = pk2bf(v[0], v[1]);
        pk[2 * i + 1] = pk2bf(v[2], v[3]);
      }
      uint4 o0, o1;
      o0.x = pk[0]; o0.y = pk[1]; o0.z = pk[2]; o0.w = pk[3];
      o1.x = pk[4]; o1.y = pk[5]; o1.z = pk[6]; o1.w = pk[7];
      *(uint4*)(p.TMP + (size_t)tok * DM + 16 * lane) = o0;
      *(uint4*)(p.TMP + (size_t)tok * DM + 16 * lane + 8) = o1;
      ssv = wave_sum(ssv);
      if (lane < 8) p.SSQ[(size_t)tok * 8 + lane] = (lane == 0) ? ssv : 0.f;
    }
  }
}

constexpr int G_LD = 40;
constexpr int G_BUF = (128 + 256) * G_LD;

template <int AMODE, int NI, class Epi>
__device__ __forceinline__ void gemm_phase(int Mtiles, int Ntiles, int K, const bf16_t* __restrict__ Bt, const float* ssq, const float* unused_,
                           const bf16_t* A1, int ld1, int K1, const bf16_t* A2, int ld2, const Epi& epi, char* smem) {
  bf16_t* sbase = (bf16_t*)smem;
  float* sR = (float*)(smem + 70144);
  const int tid = otid(), lane = tid & 63, w = tid >> 6, c = lane & 15, g = lane >> 4;
  const int wm = w >> 1, wn = w & 1;
  const int nk = K / 32;
  const int xcd = blockIdx.x & 7, lb0 = blockIdx.x >> 3, nlb = gridDim.x >> 3;
  const int mper = Mtiles >> 3;
  for (int lt = lb0; lt < mper * Ntiles; lt += nlb) {
    const int mt = xcd * mper + lt / Ntiles, nt = lt % Ntiles;
    constexpr int BN = 32 * NI;
    const int m0 = mt * 128, n0 = nt * BN;
    f32x4 acc[4][NI];
#pragma unroll
    for (int i = 0; i < 4; ++i)
#pragma unroll
      for (int j = 0; j < NI; ++j) acc[i][j] = zero4();
    float ss[2] = {0.f, 0.f};
    bf16x8 ra0[2], ra1[2];
    bf16x8 rb0[NI / 2], rb1[NI / 2];
    const unsigned boff = (unsigned)(tid >> 2) * K + 8 * (tid & 3);
    const bf16_t* bbase = Bt + (size_t)n0 * K;
#define G_LOAD(RA, RB, KT)                                                                          \
  {                                                                                                 \
    const int k0_ = (KT) * 32;                                                                      \
    const bf16_t* base_;                                                                            \
    int ld_;                                                                                        \
    if (k0_ < K1) { base_ = A1 + (size_t)m0 * ld1 + k0_; ld_ = ld1; }                               \
    else { base_ = A2 + (size_t)m0 * ld2 + (k0_ - K1); ld_ = ld2; }                                 \
    _Pragma("unroll") for (int i = 0; i < 2; ++i)                                                   \
      RA[i] = *(const bf16x8*)(base_ + (unsigned)((tid >> 2) + 64 * i) * ld_ + 8 * (tid & 3));      \
    _Pragma("unroll") for (int i = 0; i < NI / 2; ++i)                                              \
      RB[i] = *(const bf16x8*)(bbase + k0_ + boff + (unsigned)(64 * i) * K);                        \
  }
#define G_STORE(RA, RB, BUF)                                                                        \
  {                                                                                                 \
    bf16_t* sA_ = sbase + (BUF) * G_BUF;                                                            \
    bf16_t* sB_ = sA_ + 128 * G_LD;                                                                 \
    _Pragma("unroll") for (int i = 0; i < 2; ++i) {                                                 \
      bf16x8 v = RA[i];                                                                             \
      if constexpr (AMODE == 2) {                                                                   \
        _Pragma("unroll") for (int e = 0; e < 8; ++e) {                                             \
          float f = bf2f((bf16_t)v[e]);                                                             \
          ss[i] += f * f;                                                                           \
        }                                                                                           \
      }                                                                                             \
      *(bf16x8*)(sA_ + ((tid >> 2) + 64 * i) * G_LD + 8 * (tid & 3)) = v;                           \
    }                                                                                               \
    _Pragma("unroll") for (int i = 0; i < NI / 2; ++i)                                              \
      *(bf16x8*)(sB_ + ((tid >> 2) + 64 * i) * G_LD + 8 * (tid & 3)) = RB[i];                       \
  }
#define G_COMPUTE(BUF)     \
  {                                                                                                 \
    const bf16_t* sA_ = sbase + (BUF) * G_BUF;                                                      \
    const bf16_t* sB_ = sA_ + 128 * G_LD;                                                           \
    bf16x8 af[4];                                                                                   \
    _Pragma("unroll") for (int mi = 0; mi < 4; ++mi)                                                \
      af[mi] = *(const bf16x8*)(sA_ + (wm * 64 + mi * 16 + c) * G_LD + g * 8);                      \
    bf16x8 bq[2];                                                                                   \
    bq[0] = *(const bf16x8*)(sB_ + (wn * (16 * NI) + c) * G_LD + g * 8);                            \
    _Pragma("unroll") for (int ni = 0; ni < NI; ++ni) {                                             \
      if (ni + 1 < NI)                                                                              \
        bq[(ni + 1) & 1] = *(const bf16x8*)(sB_ + (wn * (16 * NI) + (ni + 1) * 16 + c) * G_LD + g * 8); \
      _Pragma("unroll") for (int mi = 0; mi < 4; ++mi)                                              \
        acc[mi][ni] = (!Epi::staged) ? mfma16(bq[ni & 1], af[mi], acc[mi][ni]) : mfma16(af[mi], bq[ni & 1], acc[mi][ni]); \
    }                                                                                               \
  }
    __syncthreads();
    if constexpr (AMODE == 3) {
      if (tid < 128) {
        const f32x4 p0 = *(const f32x4*)(ssq + (size_t)(m0 + tid) * 8);
        const f32x4 p1 = *(const f32x4*)(ssq + (size_t)(m0 + tid) * 8 + 4);
        const float sv = (p0[0] + p0[1]) + (p0[2] + p0[3]) + (p1[0] + p1[1]) + (p1[2] + p1[3]);
        sR[tid] = rsqrtf(sv * (1.f / 1024.f) + EPS);
      }
    }
    G_LOAD(ra0, rb0, 0)
    G_LOAD(ra1, rb1, 1)
    G_STORE(ra0, rb0, 0)
    __syncthreads();
    for (int kt = 0; kt < nk; kt += 2) {
      G_LOAD(ra0, rb0, min(kt + 2, nk - 1))
      G_COMPUTE(0)
      G_STORE(ra1, rb1, 1)
      __syncthreads();
      G_LOAD(ra1, rb1, min(kt + 3, nk - 1))
      G_COMPUTE(1)
      if (kt + 2 < nk) G_STORE(ra0, rb0, 0)
      __syncthreads();
    }
    if constexpr (AMODE == 2) {
#pragma unroll
      for (int i = 0; i < 2; ++i) {
        float sv = ss[i];
        sv += sxor(sv, 1, lane); sv += sxor(sv, 2, lane);
        if ((tid & 3) == 0) sR[(tid >> 2) + 64 * i] = rsqrtf(sv / (float)K + EPS);
      }
      __syncthreads();
    }
    if constexpr (Epi::staged) {
      bf16_t* sT = sbase;
      const float esc = epi.scale();
      const bool both = epi.both(n0);
#pragma unroll 1
      for (int pass = 0; pass < (both ? 2 : 1); ++pass) {
      const bool tr = both ? (pass == 1) : epi.transposed(n0);
      if (pass) __syncthreads();
      if (tr) {
#pragma unroll
        for (int mi = 0; mi < 4; ++mi) {
          const int row = wm * 64 + mi * 16 + 4 * g;
          const float r0 = sR[row] * esc, r1 = sR[row + 1] * esc, r2 = sR[row + 2] * esc, r3 = sR[row + 3] * esc;
#pragma unroll
          for (int ni = 0; ni < NI; ++ni) {
            uint2 o;
            o.x = pk2bf(acc[mi][ni][0] * r0, acc[mi][ni][1] * r1);
            o.y = pk2bf(acc[mi][ni][2] * r2, acc[mi][ni][3] * r3);
            *(uint2*)(sT + (wn * (16 * NI) + ni * 16 + c) * 136 + row) = o;
          }
        }
      } else {
#pragma unroll
        for (int mi = 0; mi < 4; ++mi) {
          const int row = wm * 64 + mi * 16 + 4 * g;
          const float r0 = sR[row] * esc, r1 = sR[row + 1] * esc, r2 = sR[row + 2] * esc, r3 = sR[row + 3] * esc;
#pragma unroll
          for (int ni = 0; ni < NI; ++ni) {
            bf16_t* d = sT + row * (BN + 8) + wn * (16 * NI) + ni * 16 + c;
            d[0] = f2bf(acc[mi][ni][0] * r0);
            d[BN + 8] = f2bf(acc[mi][ni][1] * r1);
            d[2 * (BN + 8)] = f2bf(acc[mi][ni][2] * r2);
            d[3 * (BN + 8)] = f2bf(acc[mi][ni][3] * r3);
          }
        }
      }
      if (pass == 0) epi.template direct<NI>(m0, n0, wm, wn, g, c, acc, sR);
      __syncthreads();
      if (tr) {
#pragma unroll 4
        for (int i = 0; i < 2 * NI; ++i) {
          const int id = tid + 256 * i;
          const int col = id >> 4, rc = id & 15;
          bf16x8 v = *(const bf16x8*)(sT + col * 136 + 8 * rc);
          epi.store_t(m0 + 8 * rc, n0 + col, v);
        }
      } else {
#pragma unroll 4
        for (int i = 0; i < 2 * NI; ++i) {
          const int id = tid + 256 * i;
          const int row = id / (4 * NI), cc = id % (4 * NI);
          const bf16_t* sp = sT + row * (BN + 8) + 8 * cc;
          bf16x8 v = *(const bf16x8*)sp;
          epi.store_n(m0 + row, n0 + 8 * cc, v, sp);
        }
      }
      }
    } else {
      float* sF = (float*)smem;
#pragma unroll 1
      for (int half = 0; half < 2; ++half) {
        if (half) __syncthreads();
        if (wm == half) {
#pragma unroll
          for (int mi = 0; mi < 4; ++mi)
#pragma unroll
            for (int ni = 0; ni < NI; ++ni) *(f32x4*)(sF + (mi * 16 + c) * 260 + wn * (16 * NI) + ni * 16 + 4 * g) = acc[mi][ni];
        }
        __syncthreads();
#pragma unroll 4
        for (int i = 0; i < 16; ++i) {
          const int row = w * 16 + i;
          const int tok = m0 + half * 64 + row;
          const int col = n0 + 4 * lane;
          const f32x4 a = *(const f32x4*)(sF + row * 260 + 4 * lane);
          const f32x4 xo = *(const f32x4*)(xrow(epi.xa, epi.xb, tok) + col);
          f32x4 xn;
          xn[0] = xo[0] + a[0]; xn[1] = xo[1] + a[1]; xn[2] = xo[2] + a[2]; xn[3] = xo[3] + a[3];
          float sv = xn[0] * xn[0] + xn[1] * xn[1] + xn[2] * xn[2] + xn[3] * xn[3];
          sv = wave_sum(sv);
          if (!epi.dry) {
            *(f32x4*)(epi.out + (size_t)tok * DM + col) = xn;
            if (epi.hb) {
              uint2 o;
              o.x = pk2bf(xn[0], xn[1]);
              o.y = pk2bf(xn[2], xn[3]);
              *(uint2*)(epi.hb + (size_t)tok * DM + col) = o;
            }
            if (lane == 0) epi.ssq[(size_t)tok * 8 + (n0 >> 8)] = sv;
          }
        }
      }
    }
  }
#undef G_LOAD
#undef G_STORE
#undef G_COMPUTE
}

__device__ __forceinline__ void rope_cs(int pos, int i, float& co, float& si) {
  float inv = exp2f(-(float)i * (13.287712379549449f / 16.f));
  float ang = (float)pos * inv;
  float n = rintf(ang * 0.15915494309189535f);
  float r = fmaf(-n, 6.28125f, ang);
  r = fmaf(-n, 0.0019353071795864769f, r);
  float rf = r * 0.15915494309189535f;
  si = __builtin_amdgcn_sinf(rf);
  co = __builtin_amdgcn_cosf(rf);
}

__device__ __forceinline__ void rope_chunk(int pos, int i0, bf16x8 x1, bf16x8 x2, bf16x8& o1, bf16x8& o2) {
#pragma unroll
  for (int e = 0; e < 8; ++e) {
    float co, si;
    rope_cs(pos, i0 + e, co, si);
    float a = bf2f((bf16_t)x1[e]), b = bf2f((bf16_t)x2[e]);
    o1[e] = (short)f2bf(a * co - b * si);
    o2[e] = (short)f2bf(b * co + a * si);
  }
}

struct EpiEvenIn {
  static constexpr bool staged = true;
  bf16_t *Qb, *Kt, *VtE, *Gb, *LRb, *PUb, *PGb;
  __device__ float scale() const { return 1.f; }
  __device__ bool transposed(int n0) const { return n0 >= 512 && n0 < 2048; }
  __device__ bool both(int n0) const { return false; }
  template <int NI> __device__ void direct(int m0, int n0, int wm, int wn, int g, int c, f32x4 (&acc)[4][NI], const float* sR) const {}
  __device__ void store_t(int tok8, int col, bf16x8 v) const {
    if (col < 1024) *(bf16x8*)(Kt + (size_t)(col - 512) * T_TOK + tok8) = v;
    else *(bf16x8*)(VtE + (size_t)(col - 1024) * T_TOK + tok8) = v;
  }
  __device__ void store_n(int tok, int col, bf16x8 v, const bf16_t* sp) const {
    bf16_t* d;
    if (col < 512) d = Qb + (size_t)tok * 512 + col;
    else if (col < 3072) d = Gb + (size_t)tok * 1024 + (col - 2048);
    else if (col < 3104) d = LRb + (size_t)tok * 32 + (col - 3072);
    else if (col < 3616) d = PUb + (size_t)tok * 512 + (col - 3104);
    else if (col < 4128) d = PGb + (size_t)tok * 512 + (col - 3616);
    else return;
    *(bf16x8*)d = v;
  }
};

struct EpiOddIn {
  static constexpr bool staged = true;
  bf16_t *CQb, *CKVb, *KRb, *MGb, *MQb, *MKb, *MKt, *MVt, *MOb, *MLGb;
  float* MIF;
  __device__ float scale() const { return 1.f; }
  __device__ bool transposed(int n0) const { return n0 < 512; }
  __device__ bool both(int n0) const { return n0 >= 512 && n0 < 1024; }
  template <int NI> __device__ void direct(int m0, int n0, int wm, int wn, int g, int c, f32x4 (&acc)[4][NI], const float* sR) const {
    if (n0 == 3584 && wn == 1) {
#pragma unroll
      for (int mi = 0; mi < 4; ++mi)
#pragma unroll
        for (int j = 0; j < 4; ++j) {
          const int row = wm * 64 + mi * 16 + 4 * g + j;
          MIF[(size_t)(m0 + row) * 16 + c] = acc[mi][2][j] * sR[row];
        }
    }
  }
  __device__ void store_t(int tok8, int col, bf16x8 v) const {
    if (col < 512) *(bf16x8*)(MVt + (size_t)col * T_TOK + tok8) = v;
    else *(bf16x8*)(MKt + (size_t)(col - 512) * T_TOK + tok8) = v;
  }
  __device__ void store_n(int tok, int col, bf16x8 v, const bf16_t* sp) const {
    bf16_t* d;
    if (col < 1024) d = MKb + (size_t)tok * 512 + (col - 512);
    else if (col < 1408) d = CQb + (size_t)tok * 384 + (col - 1024);
    else if (col < 1664) d = CKVb + (size_t)tok * 256 + (col - 1408);
    else if (col < 2176) d = MGb + (size_t)tok * 512 + (col - 1664);
    else if (col < 2688) d = MQb + (size_t)tok * 512 + (col - 2176);
    else if (col < 3200) d = MOb + (size_t)tok * 512 + (col - 2688);
    else if (col < 3712) d = MLGb + (size_t)tok * 512 + (col - 3200);
    else if (col < 3728) {
      bf16x8 x2 = *(const bf16x8*)(sp + 16);
      bf16x8 o1, o2;
      rope_chunk(seq_pos(tok), col - 3712, v, x2, o1, o2);
      *(bf16x8*)(KRb + (size_t)tok * 32 + (col - 3712)) = o1;
      *(bf16x8*)(KRb + (size_t)tok * 32 + 16 + (col - 3712)) = o2;
      return;
    } else return;
    *(bf16x8*)d = v;
  }
};

struct EpiQUp {
  static constexpr bool staged = true;
  bf16_t* Qa;
  __device__ float scale() const { return 0.10206207261596575f * 1.4426950408889634f; }
  __device__ bool transposed(int n0) const { return false; }
  __device__ bool both(int n0) const { return false; }
  template <int NI> __device__ void direct(int m0, int n0, int wm, int wn, int g, int c, f32x4 (&acc)[4][NI], const float* sR) const {}
  __device__ void store_t(int tok8, int col, bf16x8 v) const {}
  __device__ void store_n(int tok, int col, bf16x8 v, const bf16_t* sp) const {
    if (col < 512) {
      *(bf16x8*)(Qa + (size_t)tok * 768 + (col >> 6) * 96 + (col & 63)) = v;
    } else {
      const int r = col - 512, head = r >> 5, rr = r & 31;
      if (rr < 16) {
        bf16x8 x2 = *(const bf16x8*)(sp + 16);
        bf16x8 o1, o2;
        rope_chunk(seq_pos(tok), rr, v, x2, o1, o2);
        *(bf16x8*)(Qa + (size_t)tok * 768 + head * 96 + 64 + rr) = o1;
        *(bf16x8*)(Qa + (size_t)tok * 768 + head * 96 + 80 + rr) = o2;
      }
    }
  }
};

struct EpiKVUp {
  static constexpr bool staged = true;
  bf16_t *KNb, *VtA;
  __device__ float scale() const { return 1.f; }
  __device__ bool transposed(int n0) const { return n0 >= 512; }
  __device__ bool both(int n0) const { return false; }
  template <int NI> __device__ void direct(int m0, int n0, int wm, int wn, int g, int c, f32x4 (&acc)[4][NI], const float* sR) const {}
  __device__ void store_t(int tok8, int col, bf16x8 v) const { *(bf16x8*)(VtA + (size_t)(col - 512) * T_TOK + tok8) = v; }
  __device__ void store_n(int tok, int col, bf16x8 v, const bf16_t* sp) const { *(bf16x8*)(KNb + (size_t)tok * 512 + col) = v; }
};

struct EpiOut {
  static constexpr bool staged = false;
  const float *xa, *xb;
  float* out;
  bool dry;
  bf16_t* hb;
  float* ssq;
};

template <int CTRL> __device__ __forceinline__ float dpp_z(float v) {
  return __int_as_float(__builtin_amdgcn_update_dpp(0, __float_as_int(v), CTRL, 0xf, 0xf, true));
}
__device__ __forceinline__ float scan16(float v, int c, int lane) {
  v += dpp_z<0x111>(v);
  v += dpp_z<0x112>(v);
  v += dpp_z<0x114>(v);
  v += dpp_z<0x118>(v);
  return v;
}

__device__ __forceinline__ float logsig_fast(float x) { return fminf(x, 0.f) - __logf(1.f + __expf(-fabsf(x))); }

__device__ void gla_intra_item(const Params& p, int li, int item, char* smem, bool dry = false) {
  const int tid = otid(), lane = tid & 63, w = tid >> 6, c = lane & 15, g = lane >> 4;
  const int ci = item >> 2, h = item & 3;
  const int tokc = ci * 64;
  const float qscale = 0.08838834764831845f;
  bf16_t* sQe = (bf16_t*)smem;
  bf16_t* sKd = sQe + 64 * 136;
  bf16_t* sA = sKd + 64 * 136;
  us4 q4[2][4];
  bf16_t kk[2][4][4];
#pragma unroll
  for (int dt = 0; dt < 2; ++dt)
#pragma unroll
    for (int tt = 0; tt < 4; ++tt) {
      q4[dt][tt] = *(const us4*)(p.Qb + (size_t)(tokc + 16 * tt + c) * 512 + h * 128 + 32 * w + 16 * dt + 4 * g);
#pragma unroll
      for (int j = 0; j < 4; ++j)
        kk[dt][tt][j] = p.Kt[(size_t)(h * 128 + 32 * w + 16 * dt + 4 * g + j) * T_TOK + tokc + 16 * tt + c];
    }
  __syncthreads();
#pragma unroll
  for (int dir = 0; dir < 2; ++dir) {
    bf16_t* QEd = (dir || dry) ? p.QEb : p.Qb;
    bf16_t* KdTd = (dir || dry) ? p.KdTb : p.Kt;
    bf16x8 aup[2];
    float bias[2][4];
#pragma unroll
    for (int dt = 0; dt < 2; ++dt) {
      aup[dt] = zero8();
      if (g < 2) aup[dt] = *(const bf16x8*)(p.AupT + ((size_t)(li * 2 + dir) * 512 + h * 128 + 32 * w + 16 * dt + c) * 32 + 8 * g);
#pragma unroll
      for (int j = 0; j < 4; ++j) bias[dt][j] = p.e_a_bias[(li * 2 + dir) * 512 + h * 128 + 32 * w + 16 * dt + 4 * g + j];
    }
    f32x4 la[2][4];
#pragma unroll
    for (int tt = 0; tt < 4; ++tt) {
      bf16x8 lrf = zero8();
      if (g < 2) lrf = *(const bf16x8*)(p.LRb + (size_t)(tokc + 16 * tt + c) * 32 + dir * 16 + 8 * g);
#pragma unroll
      for (int dt = 0; dt < 2; ++dt) la[dt][tt] = mfma16(aup[dt], lrf, zero4());
    }
#pragma unroll
    for (int dt = 0; dt < 2; ++dt)
#pragma unroll
      for (int tt = 0; tt < 4; ++tt)
#pragma unroll
        for (int j = 0; j < 4; ++j) la[dt][tt][j] = logsig_fast(la[dt][tt][j] + bias[dt][j]) * (1.f / 16.f);
    f32x4 P[2][4];
    float tot[2][4];
#pragma unroll
    for (int dt = 0; dt < 2; ++dt)
#pragma unroll
      for (int j = 0; j < 4; ++j) {
        float carry = 0.f;
#pragma unroll
        for (int tt = 0; tt < 4; ++tt) {
          float v = scan16(la[dt][tt][j], c, lane) + carry;
          P[dt][tt][j] = v;
          carry = dpp_f<0x15F>(v);
        }
        tot[dt][j] = carry;
      }
#pragma unroll
    for (int dt = 0; dt < 2; ++dt)
#pragma unroll
      for (int tt = 0; tt < 4; ++tt) {
        us4 qo, ko;
#pragma unroll
        for (int j = 0; j < 4; ++j) {
          const float b = (dir == 0) ? P[dt][tt][j] : (tot[dt][j] - P[dt][tt][j] + la[dt][tt][j]);
          qo[j] = f2bf(bf2f(q4[dt][tt][j]) * __expf(b) * qscale);
          ko[j] = f2bf(bf2f(kk[dt][tt][j]) * __expf(-b));
        }
        *(us4*)(QEd + (size_t)(tokc + 16 * tt + c) * 512 + h * 128 + 32 * w + 16 * dt + 4 * g) = qo;
        *(us4*)(sQe + (16 * tt + c) * 136 + 32 * w + 16 * dt + 4 * g) = qo;
        *(us4*)(sKd + (16 * tt + c) * 136 + 32 * w + 16 * dt + 4 * g) = ko;
      }
    if (c == 0) {
#pragma unroll
      for (int dt = 0; dt < 2; ++dt)
#pragma unroll
        for (int j = 0; j < 4; ++j)
          p.EB[(size_t)(dir * 1280 + ci) * 512 + h * 128 + 32 * w + 16 * dt + 4 * g + j] = __expf(tot[dt][j]);
    }
    __syncthreads();
#pragma unroll
    for (int i = 0; i < 4; ++i) {
      const int id = tid + 256 * i;
      const int d = id & 127, c8 = id >> 7;
      bf16x8 v;
#pragma unroll
      for (int e = 0; e < 8; ++e) v[e] = (short)sKd[(8 * c8 + e) * 136 + d];
      *(bf16x8*)(KdTd + (size_t)(h * 128 + d) * T_TOK + tokc + 8 * c8) = v;
    }
    f32x4 accA[4];
#pragma unroll
    for (int jt = 0; jt < 4; ++jt) accA[jt] = zero4();
#pragma unroll
    for (int ks = 0; ks < 4; ++ks) {
      bf16x8 aq = *(const bf16x8*)(sQe + (16 * w + c) * 136 + 32 * ks + 8 * g);
#pragma unroll
      for (int jt = 0; jt < 4; ++jt) {
        bf16x8 bk = *(const bf16x8*)(sKd + (16 * jt + c) * 136 + 32 * ks + 8 * g);
        accA[jt] = mfma16(aq, bk, accA[jt]);
      }
    }
#pragma unroll
    for (int jt = 0; jt < 4; ++jt)
#pragma unroll
      for (int j = 0; j < 4; ++j) {
        const int i = 16 * w + 4 * g + j, jj = 16 * jt + c;
        const bool keep = (dir == 0) ? (jj <= i) : (jj > i);
        sA[dir * 64 * 72 + i * 72 + jj] = f2bf(keep ? accA[jt][j] : 0.f);
      }
    __syncthreads();
  }
  bf16x8 af[2][2];
#pragma unroll
  for (int dir = 0; dir < 2; ++dir)
#pragma unroll
    for (int k2 = 0; k2 < 2; ++k2) af[dir][k2] = *(const bf16x8*)(sA + dir * 64 * 72 + (16 * w + c) * 72 + 32 * k2 + 8 * g);
  bf16_t* sO = (bf16_t*)smem;
#pragma unroll 4
  for (int vt = 0; vt < 16; ++vt) {
    f32x4 a = zero4();
#pragma unroll
    for (int k2 = 0; k2 < 2; ++k2) {
      bf16x8 vfr = *(const bf16x8*)(p.VtE + (size_t)(h * 256 + 16 * vt + c) * T_TOK + tokc + 32 * k2 + 8 * g);
      a = mfma16(af[0][k2], vfr, a);
      a = mfma16(af[1][k2], vfr, a);
    }
#pragma unroll
    for (int j = 0; j < 4; ++j) sO[(16 * w + 4 * g + j) * 264 + 16 * vt + c] = f2bf(a[j]);
  }
  __syncthreads();
#pragma unroll
  for (int i = 0; i < 8; ++i) {
    const int id = tid + 256 * i;
    const int row = id >> 5, c8 = id & 31;
    *(bf16x8*)(p.TMP + (size_t)(tokc + row) * 1024 + h * 256 + 8 * c8) = *(const bf16x8*)(sO + row * 264 + 8 * c8);
  }
}

__device__ __forceinline__ void lds_barrier() { asm volatile("s_waitcnt lgkmcnt(0)\n\ts_barrier" ::: "memory"); }

struct GlaRegs {
  bf16x8 aq[4];
  bf16x8 vf[2][2];
  bf16x8 kf[2][2];
  float eb[2];
  unsigned told[2][4];
};

template <int DIR>
__device__ __forceinline__ void gla_chain_load(const Params& p, int h, int sl, int tokc, int w, int c, int g, GlaRegs& r) {
  const bf16_t* QE = DIR ? p.QEb : p.Qb;
  const bf16_t* KdT = DIR ? p.KdTb : p.Kt;
#pragma unroll
  for (int ks = 0; ks < 4; ++ks) r.aq[ks] = *(const bf16x8*)(QE + (size_t)(tokc + 16 * w + c) * 512 + h * 128 + 32 * ks + 8 * g);
#pragma unroll
  for (int vt = 0; vt < 2; ++vt)
#pragma unroll
    for (int k2 = 0; k2 < 2; ++k2)
      r.vf[vt][k2] = *(const bf16x8*)(p.VtE + (size_t)(h * 256 + sl * 32 + 16 * vt + c) * T_TOK + tokc + 32 * k2 + 8 * g);
#pragma unroll
  for (int dt = 0; dt < 2; ++dt) {
#pragma unroll
    for (int k2 = 0; k2 < 2; ++k2)
      r.kf[dt][k2] = *(const bf16x8*)(KdT + (size_t)(h * 128 + 32 * w + 16 * dt + c) * T_TOK + tokc + 32 * k2 + 8 * g);
    r.eb[dt] = p.EB[(size_t)(DIR * 1280 + (tokc >> 6)) * 512 + h * 128 + 32 * w + 16 * dt + c];
  }
#pragma unroll
  for (int vt = 0; vt < 2; ++vt)
#pragma unroll
    for (int j = 0; j < 4; ++j) r.told[vt][j] = p.TMP[(size_t)(tokc + 16 * w + 4 * g + j) * 1024 + h * 256 + sl * 32 + 16 * vt + c];
}

__device__ __forceinline__ void gla_chain_compute(const Params& p, int h, int sl, int tokc, int w, int c, int g, const GlaRegs& r,
                                                  f32x4 (&S)[2][2], bf16_t* sSt, bool dry, bool reload) {
  unsigned told[2][4];
#pragma unroll
  for (int vt = 0; vt < 2; ++vt)
#pragma unroll
    for (int j = 0; j < 4; ++j) told[vt][j] = r.told[vt][j];
  if (reload) {
#pragma unroll
    for (int vt = 0; vt < 2; ++vt)
#pragma unroll
      for (int j = 0; j < 4; ++j) told[vt][j] = p.TMP[(size_t)(tokc + 16 * w + 4 * g + j) * 1024 + h * 256 + sl * 32 + 16 * vt + c];
  }
#pragma unroll
  for (int vt = 0; vt < 2; ++vt)
#pragma unroll
    for (int dt = 0; dt < 2; ++dt)
#pragma unroll
      for (int j = 0; j < 4; ++j) sSt[(16 * vt + 4 * g + j) * 136 + 32 * w + 16 * dt + c] = f2bf(S[vt][dt][j]);
  lds_barrier();
  f32x4 o[2];
  o[0] = zero4(); o[1] = zero4();
#pragma unroll
  for (int ks = 0; ks < 4; ++ks)
#pragma unroll
    for (int vt = 0; vt < 2; ++vt) {
      bf16x8 sf = *(const bf16x8*)(sSt + (16 * vt + c) * 136 + 32 * ks + 8 * g);
      o[vt] = mfma16(r.aq[ks], sf, o[vt]);
    }
#pragma unroll
  for (int dt = 0; dt < 2; ++dt)
#pragma unroll
    for (int vt = 0; vt < 2; ++vt) {
      f32x4 a = S[vt][dt];
#pragma unroll
      for (int k2 = 0; k2 < 2; ++k2) a = mfma16(r.vf[vt][k2], r.kf[dt][k2], a);
      S[vt][dt] = a * r.eb[dt];
    }
#pragma unroll
  for (int vt = 0; vt < 2; ++vt)
#pragma unroll
    for (int j = 0; j < 4; ++j)
      if (!dry) p.TMP[(size_t)(tokc + 16 * w + 4 * g + j) * 1024 + h * 256 + sl * 32 + 16 * vt + c] = f2bf(bf2f((bf16_t)told[vt][j]) + o[vt][j]);
}

__device__ void gla_chain_item(const Params& p, int li, int item, char* smem, bool dry = false) {
  const int tid = otid(), lane = tid & 63, w = tid >> 6, c = lane & 15, g = lane >> 4;
  const int xr = item >> 3;
  const int pair = (item & 7) + 8 * (xr >> 3), sl = xr & 7;
  const int s = pair < 32 ? 4 + (pair >> 2) : ((pair - 32) >> 2);
  const int h = pair & 3;
  const int tok0 = s < 4 ? s * 4096 : T_P + (s - 4) * 8192;
  const int len = s < 4 ? 4096 : 8192;
  const int N = len / 64;
  bf16_t* sSt0 = (bf16_t*)smem;
  bf16_t* sSt1 = sSt0 + 32 * 136;
  f32x4 Sf[2][2], Sb[2][2];
#pragma unroll
  for (int a = 0; a < 2; ++a)
#pragma unroll
    for (int b = 0; b < 2; ++b) { Sf[a][b] = zero4(); Sb[a][b] = zero4(); }
  GlaRegs rf, rb;
  __syncthreads();
  gla_chain_load<0>(p, h, sl, tok0, w, c, g, rf);
  for (int step = 0; step < N; ++step) {
    const int tf = tok0 + step * 64, tb = tok0 + (N - 1 - step) * 64;
    gla_chain_load<1>(p, h, sl, tb, w, c, g, rb);
    gla_chain_compute(p, h, sl, tf, w, c, g, rf, Sf, sSt0, dry, step == (N >> 1));
    if (step + 1 < N) gla_chain_load<0>(p, h, sl, tf + 64, w, c, g, rf);
    gla_chain_compute(p, h, sl, tb, w, c, g, rb, Sb, sSt1, dry, false);
  }
}

__device__ void pool_item(const Params& p, int li, int item, char* smem, bool dry = false) {
  const int tid = otid(), lane = tid & 63, w = tid >> 6, c = lane & 15, g = lane >> 4;
  const int gi = item & 3;
  const int tile = item >> 2;
  const int tokc = tile * 64;
  const int pos0 = seq_pos(tokc);
  const int len = tokc < T_P ? 4096 : 8192;
  float* sU = (float*)smem;
  bf16_t* sP = (bf16_t*)(sU + 80 * 128);
  __syncthreads();
  for (int idx = tid; idx < 80 * 128; idx += 256) {
    int r = idx >> 7, ch = idx & 127;
    int pos = pos0 - 8 + r;
    float v = 0.f;
    if (pos >= 0 && pos < len) v = bf2f(p.PUb[(long)(tokc - 8 + r) * 512 + gi * 128 + ch]);
    sU[idx] = v;
  }
  __syncthreads();
  {
    const int ch = tid & 127, th = tid >> 7;
    const int half = 1 << gi;
    for (int t = th * 32; t < th * 32 + 32; ++t) {
      int pos = pos0 + t;
      int lo = max(pos - half, 0), hi = min(pos + half, len);
      float s = 0.f;
      for (int q = lo; q < hi; ++q) s += sU[(q - pos0 + 8) * 128 + ch];
      float pooled = s / (float)(hi - lo) - sU[(t + 8) * 128 + ch];
      sP[t * 136 + ch] = f2bf(pooled);
    }
  }
  __syncthreads();
  f32x4 acc[8];
#pragma unroll
  for (int dt = 0; dt < 8; ++dt) acc[dt] = zero4();
  const bf16_t* PW = p.PoolWT + (long)(li * 4 + gi) * 128 * 128;
#pragma unroll
  for (int ks = 0; ks < 4; ++ks) {
    bf16x8 af = *(const bf16x8*)(sP + (16 * w + c) * 136 + 32 * ks + 8 * g);
#pragma unroll
    for (int dt = 0; dt < 8; ++dt) {
      bf16x8 bw = *(const bf16x8*)(PW + (long)(16 * dt + c) * 128 + 32 * ks + 8 * g);
      acc[dt] = mfma16(af, bw, acc[dt]);
    }
  }
#pragma unroll
  for (int dt = 0; dt < 8; ++dt) {
    const int d = gi * 128 + 16 * dt + c;
    const float sc = p.e_pool_scale[li * 512 + d];
#pragma unroll
    for (int j = 0; j < 4; ++j) {
      const long addr = (long)(tokc + 16 * w + 4 * g + j) * 512 + d;
      float gt = bf2f(p.PGb[addr]);
      if (!dry) p.PGb[addr] = f2bf(acc[dt][j] * sc * siluf_(gt));
    }
  }
}

__device__ void ml_intra_item(const Params& p, int li, int item, char* smem) {
  const int tid = otid(), lane = tid & 63, w = tid >> 6, c = lane & 15, g = lane >> 4;
  const int ci = item >> 2, h = item & 3;
  const int tokc = ci * 64;
  const float kscale = 0.08838834764831845f;
  bf16_t* sA = (bf16_t*)smem;
  float* sBv = (float*)(sA + 2 * 64 * 72);
  float* sCB = sBv + 128;
  __syncthreads();
  if (w < 2) {
    const int dir = w;
    const float bi = p.o_if_bias[li * 16 + dir * 4 + h];
    const float bff = p.o_if_bias[li * 16 + 8 + dir * 4 + h];
    const float* mf = p.MIF + (size_t)(tokc + lane) * 16;
    const float liv = mf[dir * 4 + h] + bi;
    const float lfv = logsig_fast(mf[8 + dir * 4 + h] + bff);
    float ps = lfv;
#pragma unroll
    for (int d = 1; d < 64; d <<= 1) {
      float t = bperm(lane - d, ps);
      if (lane >= d) ps += t;
    }
    const float total = __int_as_float(__builtin_amdgcn_readlane(__float_as_int(ps), 63));
    const float b = (dir == 0) ? ps : (total - ps + lfv);
    const float cB = liv - b;
    sBv[dir * 64 + lane] = b;
    sCB[dir * 64 + lane] = cB;
    const size_t so = (size_t)(dir * 4 + h) * T_TOK + tokc + lane;
    p.EBI[so] = __expf(b);
    p.WKg[so] = __expf(total + cB) * kscale;
    if (lane == 0) p.DEC[(dir * 4 + h) * 1280 + ci] = __expf(total);
  }
  f32x4 accA[4];
#pragma unroll
  for (int jt = 0; jt < 4; ++jt) accA[jt] = zero4();
#pragma unroll
  for (int ks = 0; ks < 4; ++ks) {
    bf16x8 aq = *(const bf16x8*)(p.MQb + (size_t)(tokc + 16 * w + c) * 512 + h * 128 + 32 * ks + 8 * g);
#pragma unroll
    for (int jt = 0; jt < 4; ++jt) {
      bf16x8 bk = *(const bf16x8*)(p.MKb + (size_t)(tokc + 16 * jt + c) * 512 + h * 128 + 32 * ks + 8 * g);
      accA[jt] = mfma16(aq, bk, accA[jt]);
    }
  }
  __syncthreads();
#pragma unroll
  for (int dir = 0; dir < 2; ++dir)
#pragma unroll
    for (int jt = 0; jt < 4; ++jt)
#pragma unroll
      for (int j = 0; j < 4; ++j) {
        const int i = 16 * w + 4 * g + j, jj = 16 * jt + c;
        const bool keep = (dir == 0) ? (jj <= i) : (jj > i);
        const float sv = keep ? accA[jt][j] * kscale * __expf(sBv[dir * 64 + i] + sCB[dir * 64 + jj]) : 0.f;
        sA[dir * 64 * 72 + i * 72 + jj] = f2bf(sv);
      }
  __syncthreads();
  bf16x8 ones = zero8();
  if (c == 0) {
#pragma unroll
    for (int e = 0; e < 8; ++e) ones[e] = (short)0x3F80;
  }
#pragma unroll
  for (int dir = 0; dir < 2; ++dir) {
    bf16_t* NUMI = dir ? p.NUMIb : p.NUMIf;
    bf16x8 af[2];
#pragma unroll
    for (int k2 = 0; k2 < 2; ++k2) af[k2] = *(const bf16x8*)(sA + dir * 64 * 72 + (16 * w + c) * 72 + 32 * k2 + 8 * g);
    f32x4 dn = zero4();
    dn = mfma16(af[0], ones, dn);
    dn = mfma16(af[1], ones, dn);
    if (c == 0) {
#pragma unroll
      for (int j = 0; j < 4; ++j) p.DENI[(size_t)(dir * 4 + h) * T_TOK + tokc + 16 * w + 4 * g + j] = dn[j];
    }
    bf16_t* sO = sA + 2 * 64 * 72 + 512;
#pragma unroll 4
    for (int vt = 0; vt < 8; ++vt) {
      f32x4 a = zero4();
#pragma unroll
      for (int k2 = 0; k2 < 2; ++k2) {
        bf16x8 vfr = *(const bf16x8*)(p.MVt + (size_t)(h * 128 + 16 * vt + c) * T_TOK + tokc + 32 * k2 + 8 * g);
        a = mfma16(af[k2], vfr, a);
      }
#pragma unroll
      for (int j = 0; j < 4; ++j) sO[(16 * w + 4 * g + j) * 136 + 16 * vt + c] = f2bf(a[j]);
    }
    __syncthreads();
#pragma unroll
    for (int i = 0; i < 4; ++i) {
      const int id = tid + 256 * i;
      const int row = id >> 4, c8 = id & 15;
      *(bf16x8*)(NUMI + (size_t)(tokc + row) * 512 + h * 128 + 8 * c8) = *(const bf16x8*)(sO + row * 136 + 8 * c8);
    }
    __syncthreads();
  }
}

struct MlRegs {
  bf16x8 aq[4];
  bf16x8 vf[2];
  bf16x8 kf[2][2];
  f32x4 wk[2][2];
  f32x4 ebi, deni;
  float dec;
  unsigned numi[4];
};

template <int DIR>
__device__ __forceinline__ void ml_chain_load(const Params& p, int h, int sl, int tokc, int w, int c, int g, MlRegs& r) {
#pragma unroll
  for (int ks = 0; ks < 4; ++ks) r.aq[ks] = *(const bf16x8*)(p.MQb + (size_t)(tokc + 16 * w + c) * 512 + h * 128 + 32 * ks + 8 * g);
#pragma unroll
  for (int k2 = 0; k2 < 2; ++k2)
    r.vf[k2] = *(const bf16x8*)(p.MVt + (size_t)(h * 128 + sl * 16 + c) * T_TOK + tokc + 32 * k2 + 8 * g);
#pragma unroll
  for (int dt = 0; dt < 2; ++dt)
#pragma unroll
    for (int k2 = 0; k2 < 2; ++k2)
      r.kf[dt][k2] = *(const bf16x8*)(p.MKt + (size_t)(h * 128 + 32 * w + 16 * dt + c) * T_TOK + tokc + 32 * k2 + 8 * g);
  const size_t so = (size_t)(DIR * 4 + h) * T_TOK + tokc;
#pragma unroll
  for (int k2 = 0; k2 < 2; ++k2) {
    r.wk[k2][0] = *(const f32x4*)(p.WKg + so + 32 * k2 + 8 * g);
    r.wk[k2][1] = *(const f32x4*)(p.WKg + so + 32 * k2 + 8 * g + 4);
  }
  r.ebi = *(const f32x4*)(p.EBI + so + 16 * w + 4 * g);
  r.deni = *(const f32x4*)(p.DENI + so + 16 * w + 4 * g);
  r.dec = p.DEC[(DIR * 4 + h) * 1280 + (tokc >> 6)];
  const bf16_t* NUMI = DIR ? p.NUMIb : p.NUMIf;
#pragma unroll
  for (int j = 0; j < 4; ++j) r.numi[j] = NUMI[(size_t)(tokc + 16 * w + 4 * g + j) * 512 + h * 128 + sl * 16 + c];
}

template <int DIR>
__device__ __forceinline__ void ml_chain_compute(const Params& p, int h, int sl, int tokc, int lane, int w, int c, int g, const MlRegs& r,
                                                 f32x4 (&C)[2][2], bf16_t* sCt, bool dry) {
  bf16_t* NUMI = DIR ? p.NUMIb : p.NUMIf;
  unsigned numi[4];
#pragma unroll
  for (int j = 0; j < 4; ++j) numi[j] = r.numi[j];
#pragma unroll
  for (int vt = 0; vt < 2; ++vt)
#pragma unroll
    for (int dt = 0; dt < 2; ++dt)
#pragma unroll
      for (int j = 0; j < 4; ++j) sCt[(16 * vt + 4 * g + j) * 136 + 32 * w + 16 * dt + c] = f2bf(C[vt][dt][j]);
  bf16x8 vfw[2][2];
#pragma unroll
  for (int k2 = 0; k2 < 2; ++k2) {
    float wv[8];
#pragma unroll
    for (int e = 0; e < 4; ++e) { wv[e] = r.wk[k2][0][e]; wv[4 + e] = r.wk[k2][1][e]; }
#pragma unroll
    for (int e = 0; e < 8; ++e) vfw[0][k2][e] = (short)f2bf(bf2f((bf16_t)r.vf[k2][e]) * wv[e]);
#pragma unroll
    for (int e = 0; e < 8; ++e) vfw[1][k2][e] = (c == 0) ? (short)f2bf(wv[e]) : (short)0;
  }
  lds_barrier();
  f32x4 o2[2];
  o2[0] = zero4(); o2[1] = zero4();
#pragma unroll
  for (int ks = 0; ks < 4; ++ks)
#pragma unroll
    for (int vt = 0; vt < 2; ++vt) {
      bf16x8 cf = *(const bf16x8*)(sCt + (16 * vt + c) * 136 + 32 * ks + 8 * g);
      o2[vt] = mfma16(r.aq[ks], cf, o2[vt]);
    }
#pragma unroll
  for (int dt = 0; dt < 2; ++dt)
#pragma unroll
    for (int vt = 0; vt < 2; ++vt) {
      f32x4 a = C[vt][dt] * r.dec;
#pragma unroll
      for (int k2 = 0; k2 < 2; ++k2) a = mfma16(vfw[vt][k2], r.kf[dt][k2], a);
      C[vt][dt] = a;
    }
#pragma unroll
  for (int j = 0; j < 4; ++j) {
    const float e = r.ebi[j];
    float den = e * o2[1][j];
    den = dpp_f<0x150>(den) + r.deni[j];
    const float inv = 1.f / fmaxf(fabsf(den), 1.f);
    const float hv = (bf2f((bf16_t)numi[j]) + e * o2[0][j]) * inv;
    if (!dry) NUMI[(size_t)(tokc + 16 * w + 4 * g + j) * 512 + h * 128 + sl * 16 + c] = f2bf(hv);
  }
}

template <int DIR>
__device__ __forceinline__ void ml_chain_run(const Params& p, int h, int sl, int tok0, int N, int lane, int w, int c, int g, bf16_t* sCt0, bool dry) {
  bf16_t* sCt1 = sCt0 + 32 * 136;
  f32x4 C[2][2];
#pragma unroll
  for (int a = 0; a < 2; ++a)
#pragma unroll
    for (int b = 0; b < 2; ++b) C[a][b] = zero4();
  MlRegs r0, r1;
  ml_chain_load<DIR>(p, h, sl, tok0 + (DIR ? N - 1 : 0) * 64, w, c, g, r0);
  for (int n = 0; n < N; n += 2) {
    const int c0 = DIR ? N - 1 - n : n;
    const int c1 = DIR ? N - 2 - n : n + 1;
    const int n2 = min(n + 2, N - 1);
    const int c2 = DIR ? N - 1 - n2 : n2;
    ml_chain_load<DIR>(p, h, sl, tok0 + c1 * 64, w, c, g, r1);
    ml_chain_compute<DIR>(p, h, sl, tok0 + c0 * 64, lane, w, c, g, r0, C, sCt0, dry);
    ml_chain_load<DIR>(p, h, sl, tok0 + c2 * 64, w, c, g, r0);
    ml_chain_compute<DIR>(p, h, sl, tok0 + c1 * 64, lane, w, c, g, r1, C, sCt1, dry);
  }
}

__device__ void ml_chain_item(const Params& p, int li, int item, char* smem, bool dry = false) {
  const int tid = otid(), lane = tid & 63, w = tid >> 6, c = lane & 15, g = lane >> 4;
  int pair, within;
  if (item < 512) { const int r = item >> 3; pair = (item & 7) + 8 * (r >> 4); within = r & 15; }
  else { const int it = item - 512; const int r = it >> 3; pair = 32 + (it & 7) + 8 * (r >> 4); within = r & 15; }
  const int sl = within & 7, dir = within >> 3;
  const int s = pair < 32 ? 4 + (pair >> 2) : ((pair - 32) >> 2);
  const int h = pair & 3;
  const int tok0 = s < 4 ? s * 4096 : T_P + (s - 4) * 8192;
  const int N = (s < 4 ? 4096 : 8192) / 64;
  bf16_t* sCt0 = (bf16_t*)smem;
  __syncthreads();
  if (dir == 0) ml_chain_run<0>(p, h, sl, tok0, N, lane, w, c, g, sCt0, dry);
  else ml_chain_run<1>(p, h, sl, tok0, N, lane, w, c, g, sCt0, dry);
}

#define ATTN_GLOAD(KT)                                                                              \
  {                                                                                                 \
    const long kb = tok0 + (KT) * 64;                                                               \
    rk0 = *(const bf16x8*)(p.KNb + (kb + (tid >> 3)) * 512 + head * 64 + 8 * (tid & 7));            \
    rk1 = *(const bf16x8*)(p.KNb + (kb + 32 + (tid >> 3)) * 512 + head * 64 + 8 * (tid & 7));       \
    rkr = *(const bf16x8*)(p.KRb + (kb + (tid >> 2)) * 32 + 8 * (tid & 3));                          \
    rv0 = *(const bf16x8*)(p.VtA + (long)(head * 64 + (tid >> 3)) * T_TOK + kb + 8 * (tid & 7));     \
    rv1 = *(const bf16x8*)(p.VtA + (long)(head * 64 + 32 + (tid >> 3)) * T_TOK + kb + 8 * (tid & 7)); \
  }
__device__ void attn_item(const Params& p, int item, char* smem, bool dry = false) {
  const int tid = otid(), lane = tid & 63, w = tid >> 6, c = lane & 15, g = lane >> 4;
  int s, head, qb;
  {
    const int x = item / 320, t = item % 320;
    if (t < 256) { const int pair = x + 8 * (t >> 5); qb = t & 31; s = 4 + (pair >> 3); head = pair & 7; }
    else { const int t2 = t - 256; const int pair = x + 8 * (t2 >> 4); qb = t2 & 15; s = pair >> 3; head = pair & 7; }
  }
  const int tok0 = s < 4 ? s * 4096 : T_P + (s - 4) * 8192;
  const int len = s < 4 ? 4096 : 8192;
  const int nkv = len / 64;
  constexpr int KV_STAGE = 64 * 104 + 64 * 72;
  bf16_t* sKV = (bf16_t*)smem;
  const int qrow0 = tok0 + qb * 256 + 64 * w;
  bf16_t* sQr = sKV + 2 * KV_STAGE;
  bf16x8 qf[4][3];
#pragma unroll
  for (int nt = 0; nt < 4; ++nt)
#pragma unroll
    for (int ks = 0; ks < 3; ++ks)
      qf[nt][ks] = *(const bf16x8*)(p.Qa + (long)(qrow0 + 16 * nt + c) * 768 + head * 96 + 32 * ks + 8 * g);
  f32x4 ot[4][4];
#pragma unroll
  for (int vt = 0; vt < 4; ++vt)
#pragma unroll
    for (int nt = 0; nt < 4; ++nt) ot[vt][nt] = zero4();
  float mrun[4] = {-64.f, -64.f, -64.f, -64.f}, lrun[4] = {0.f, 0.f, 0.f, 0.f};
  bf16x8 rk0, rk1, rkr, rv0, rv1;
#define ATTN_LSTORE(STG)                                                                    \
  {                                                                                         \
    bf16_t* sK_ = sKV + (STG) * KV_STAGE;                                                   \
    bf16_t* sVt_ = sK_ + 64 * 104;                                                          \
    *(bf16x8*)(sK_ + (tid >> 3) * 104 + 8 * (tid & 7)) = rk0;                               \
    *(bf16x8*)(sK_ + (32 + (tid >> 3)) * 104 + 8 * (tid & 7)) = rk1;                        \
    *(bf16x8*)(sK_ + (tid >> 2) * 104 + 64 + 8 * (tid & 3)) = rkr;                          \
    *(bf16x8*)(sVt_ + (tid >> 3) * 72 + 8 * (tid & 7)) = rv0;                               \
    *(bf16x8*)(sVt_ + (32 + (tid >> 3)) * 72 + 8 * (tid & 7)) = rv1;                        \
  }
  ATTN_GLOAD(0)
  __syncthreads();
  ATTN_LSTORE(0)
  __syncthreads();
  for (int kt = 0; kt < nkv; ++kt) {
    const bf16_t* sK = sKV + (kt & 1) * KV_STAGE;
    const bf16_t* sVt = sK + 64 * 104;
    ATTN_GLOAD(min(kt + 1, nkv - 1))
#pragma unroll 1
    for (int half = 0; half < 2; ++half) {
      f32x4 st[2][4];
#pragma unroll
      for (int k4 = 0; k4 < 2; ++k4)
#pragma unroll
        for (int nt = 0; nt < 4; ++nt) {
          const float nm = -mrun[nt];
          f32x4 iv = {nm, nm, nm, nm};
          st[k4][nt] = iv;
        }
#pragma unroll
      for (int ks = 0; ks < 2; ++ks)
#pragma unroll
        for (int k4 = 0; k4 < 2; ++k4) {
          bf16x8 kf = *(const bf16x8*)(sK + (32 * half + 16 * k4 + c) * 104 + 32 * ks + 8 * g);
#pragma unroll
          for (int nt = 0; nt < 4; ++nt) st[k4][nt] = mfma16(kf, qf[nt][ks], st[k4][nt]);
        }
      {
        bf16x8 kr0 = *(const bf16x8*)(sK + (32 * half + c) * 104 + 64 + 8 * g);
        bf16x8 kr1 = *(const bf16x8*)(sK + (32 * half + 16 + c) * 104 + 64 + 8 * g);
#pragma unroll
        for (int nt = 0; nt < 4; ++nt) {
          st[0][nt] = mfma16(kr0, qf[nt][2], st[0][nt]);
          st[1][nt] = mfma16(kr1, qf[nt][2], st[1][nt]);
        }
      }
      bf16x8 pb[4];
#pragma unroll
      for (int nt = 0; nt < 4; ++nt) {
        float mx = -1e30f;
#pragma unroll
        for (int k4 = 0; k4 < 2; ++k4)
#pragma unroll
          for (int j = 0; j < 4; ++j) mx = fmaxf(mx, st[k4][nt][j]);
        mx = rowmax4(mx);
        if (__builtin_amdgcn_ballot_w64(mx > 0.f) != 0ull) {
          const float d = fmaxf(mx, 0.f);
          const float alpha = __builtin_amdgcn_exp2f(-d);
          mrun[nt] += d;
          lrun[nt] *= alpha;
#pragma unroll
          for (int vt = 0; vt < 4; ++vt) ot[vt][nt] = ot[vt][nt] * alpha;
#pragma unroll
          for (int k4 = 0; k4 < 2; ++k4)
#pragma unroll
            for (int j = 0; j < 4; ++j) st[k4][nt][j] -= d;
        }
        float psum = 0.f;
#pragma unroll
        for (int k4 = 0; k4 < 2; ++k4)
#pragma unroll
          for (int j = 0; j < 4; ++j) {
            float pv = __builtin_amdgcn_exp2f(st[k4][nt][j]);
            st[k4][nt][j] = pv;
            psum += pv;
          }
        lrun[nt] += psum;
        typedef __attribute__((ext_vector_type(4))) unsigned u32x4;
        u32x4 pk;
        pk[0] = pk2bf(st[0][nt][0], st[0][nt][1]);
        pk[1] = pk2bf(st[0][nt][2], st[0][nt][3]);
        pk[2] = pk2bf(st[1][nt][0], st[1][nt][1]);
        pk[3] = pk2bf(st[1][nt][2], st[1][nt][3]);
        pb[nt] = __builtin_bit_cast(bf16x8, pk);
      }
#pragma unroll
      for (int vt = 0; vt < 4; ++vt) {
        us4 lo = *(const us4*)(sVt + (16 * vt + c) * 72 + 32 * half + 4 * g);
        us4 hi = *(const us4*)(sVt + (16 * vt + c) * 72 + 32 * half + 16 + 4 * g);
        bf16x8 av;
#pragma unroll
        for (int e = 0; e < 4; ++e) { av[e] = (short)lo[e]; av[4 + e] = (short)hi[e]; }
#pragma unroll
        for (int nt = 0; nt < 4; ++nt) ot[vt][nt] = mfma16(av, pb[nt], ot[vt][nt]);
      }
    }
    if (kt + 1 < nkv) ATTN_LSTORE((kt + 1) & 1)
    __syncthreads();
  }
#undef ATTN_LSTORE
#pragma unroll
  for (int nt = 0; nt < 4; ++nt) {
    float lt = lrun[nt];
    lt += sxor(lt, 16, lane);
    lt += sxor(lt, 32, lane);
    const float inv = 1.f / lt;
    const long tok = qrow0 + 16 * nt + c;
#pragma unroll
    for (int vt = 0; vt < 4; ++vt) {
      bf16_t* gp = p.MGb + tok * 512 + head * 64 + 16 * vt + 4 * g;
      us4 gt = *(const us4*)gp;
      us4 o;
#pragma unroll
      for (int j = 0; j < 4; ++j) o[j] = f2bf(ot[vt][nt][j] * inv * siluf_(bf2f(gt[j])));
      if (!dry) *(us4*)gp = o;
    }
  }
}

__device__ void phase_gla_combine(const Params& p, int li, bool dry = false) {
  const int tid_ = otid(); const int lane = tid_ & 63, w = tid_ >> 6;
#pragma unroll 2
  for (int tok = blockIdx.x * 4 + w; tok < T_TOK; tok += gridDim.x * 4) {
    const bf16_t* tp = p.TMP + (long)tok * 1024 + 16 * lane;
    bf16_t* gp = p.Gb + (long)tok * 1024 + 16 * lane;
    bf16x8 o0 = *(const bf16x8*)tp, o1 = *(const bf16x8*)(tp + 8);
    bf16x8 g0 = *(const bf16x8*)gp, g1 = *(const bf16x8*)(gp + 8);
    float ov[16], gv[16];
#pragma unroll
    for (int e = 0; e < 8; ++e) {
      ov[e] = bf2f((bf16_t)o0[e]); ov[8 + e] = bf2f((bf16_t)o1[e]);
      gv[e] = bf2f((bf16_t)g0[e]); gv[8 + e] = bf2f((bf16_t)g1[e]);
    }
    float ss = 0.f;
#pragma unroll
    for (int e = 0; e < 16; ++e) ss += ov[e] * ov[e];
    ss = row_sum16(ss);
    const float rs = rsqrtf(ss * (1.f / 256.f) + EPS);
    const float* ng = p.e_gla_norm_g + li * 256 + ((16 * lane) & 255);
    bf16x8 r0, r1;
#pragma unroll
    for (int e = 0; e < 8; ++e) {
      r0[e] = (short)f2bf(ov[e] * rs * ng[e] * siluf_(gv[e]));
      r1[e] = (short)f2bf(ov[8 + e] * rs * ng[8 + e] * siluf_(gv[8 + e]));
    }
    if (!dry) { *(bf16x8*)gp = r0;
    *(bf16x8*)(gp + 8) = r1; }
  }
}

__device__ void phase_ml_combine(const Params& p, int li, bool dry = false) {
  const int tid_ = otid(); const int lane = tid_ & 63, w = tid_ >> 6;
#pragma unroll 2
  for (int tok = blockIdx.x * 4 + w; tok < T_TOK; tok += gridDim.x * 4) {
    const long off = (long)tok * 512 + 8 * lane;
    bf16x8 hv = *(const bf16x8*)(p.NUMIf + off);
    bf16x8 hb = *(const bf16x8*)(p.NUMIb + off);
    bf16x8 mo = *(const bf16x8*)(p.MOb + off);
    bf16x8 mg = *(const bf16x8*)(p.MLGb + off);
    float hf[8];
    float ss = 0.f;
#pragma unroll
    for (int e = 0; e < 8; ++e) { hf[e] = bf2f((bf16_t)hv[e]) + bf2f((bf16_t)hb[e]); ss += hf[e] * hf[e]; }
    ss = row_sum16(ss);
    const float rs = rsqrtf(ss * (1.f / 128.f) + EPS);
    const float* ng = p.o_ml_norm_g + li * 128 + ((8 * lane) & 127);
    bf16x8 r;
#pragma unroll
    for (int e = 0; e < 8; ++e)
      r[e] = (short)f2bf(hf[e] * rs * ng[e] * sigmoidf_(bf2f((bf16_t)mo[e])) * siluf_(bf2f((bf16_t)mg[e])));
    if (!dry) *(bf16x8*)(p.MLGb + off) = r;
  }
}

__device__ void phase_final(const Params& p, bool dry = false) {
  const int tid_ = otid(); const int lane = tid_ & 63, w = tid_ >> 6;
#pragma unroll 2
  for (int tok = blockIdx.x * 4 + w; tok < T_TOK; tok += gridDim.x * 4) {
    float* xp = p.out + (long)tok * DM;
    float4 v[4];
    float ss = 0.f;
#pragma unroll
    for (int i = 0; i < 4; ++i) {
      v[i] = *(const float4*)(xp + 4 * lane + 256 * i);
      ss += v[i].x * v[i].x + v[i].y * v[i].y + v[i].z * v[i].z + v[i].w * v[i].w;
    }
    ss = wave_sum(ss);
    const float rs = rsqrtf(ss * (1.f / 1024.f) + EPS);
#pragma unroll
    for (int i = 0; i < 4; ++i) {
      float4 gq = *(const float4*)(p.final_norm_g + 4 * lane + 256 * i);
      float4 o;
      o.x = v[i].x * rs * gq.x; o.y = v[i].y * rs * gq.y; o.z = v[i].z * rs * gq.z; o.w = v[i].w * rs * gq.w;
      if (!dry) *(float4*)(xp + 4 * lane + 256 * i) = o;
    }
  }
}

__device__ void run_phase(const Params& p, int ph, char* smem) {
  if (ph == 0) { if (PH_ON(0)) phase_prep(p, smem); return; }
  if (ph == NPHASE - 1) { if (PROBE_B) phase_final(p, true); if (PH_ON(11)) phase_final(p); return; }
  const int q = ph - 1;
  const int layer = (q < 5) ? 0 : (q < 11) ? 1 : (q < 16) ? 2 : 3;
  const int sub = (q < 5) ? q : (q < 11) ? q - 5 : (q < 16) ? q - 11 : q - 16;
  const int li = layer >> 1;
  const float* xa = (layer == 0) ? p.x_prompt : p.out;
  const float* xb = (layer == 0) ? p.x_sample : p.out + (long)T_P * DM;
  if ((layer & 1) == 0) {
    if (sub == 0) {
      EpiEvenIn e{p.Qb, p.Kt, p.VtE, p.Gb, p.LRb, p.PUb, p.PGb};
      if (PH_ON(1)) gemm_phase<3, 8>(T_TOK / 128, NE_PAD / 256, DM, p.WinE + (long)li * NE_PAD * DM, p.SSQ, nullptr, p.TMP, DM, DM, p.TMP, DM, e, smem);
    } else if (sub == 1) {
      for (int item = blockIdx.x; item < 5120; item += gridDim.x)
        if (PH_ON(2)) gla_intra_item(p, li, item, smem);
    } else if (sub == 2) {
      __shared__ int s_pitem;
      for (int item = blockIdx.x; item < 384; item += gridDim.x) { if (PH_ON(2)) gla_chain_item(p, li, item, smem, false); }
      for (;;) {
        __syncthreads();
        if (threadIdx.x == 0) s_pitem = atomicAdd(p.counters + 16 + li, 1);
        __syncthreads();
        const int item = s_pitem;
        if (item >= 5120) break;
        if (PH_ON(3)) pool_item(p, li, item, smem);
      }
    } else if (sub == 3) {
      if (PROBE_B) phase_gla_combine(p, li, true);
      if (PH_ON(4)) phase_gla_combine(p, li);
    } else {
      EpiOut e{xa, xb, p.out, false, p.NUMIf, p.SSQ};
      if (PH_ON(5)) gemm_phase<1, 8>(T_TOK / 128, DM / 256, 1536, p.WoutE + (long)li * DM * 1536, nullptr, nullptr, p.Gb, 1024, 1024, p.PGb, 512, e, smem);
    }
  } else {
    if (sub == 0) {
      EpiOddIn e{p.CQb, p.CKVb, p.KRb, p.MGb, p.MQb, p.MKb, p.MKt, p.MVt, p.MOb, p.MLGb, p.MIF};
      if (PH_ON(6)) gemm_phase<3, 8>(T_TOK / 128, NO_PAD / 256, DM, p.WinO + (long)li * NO_PAD * DM, p.SSQ, nullptr, p.NUMIf, DM, DM, p.NUMIf, DM, e, smem);
    } else if (sub == 1) {
      for (int rep = 0; rep < 1 + PROBE_A; ++rep)
      for (int item = blockIdx.x; item < 5120; item += gridDim.x)
        if (PH_ON(8)) ml_intra_item(p, li, item, smem);
    } else if (sub == 2) {
      for (int item = blockIdx.x; item < 768; item += gridDim.x)
        if (PH_ON(8)) ml_chain_item(p, li, item, smem, false);
    } else if (sub == 3) {
      if (PH_ON(10)) phase_ml_combine(p, li);
      EpiQUp eq{p.Qa};
      if (PH_ON(7)) gemm_phase<2, 4>(T_TOK / 128, 768 / 128, 384, p.QupT + (long)li * 768 * 384, nullptr, nullptr, p.CQb, 384, 384, p.CQb, 384, eq, smem);
      EpiKVUp ek{p.KNb, p.VtA};
      if (PH_ON(7)) gemm_phase<2, 4>(T_TOK / 128, 1024 / 128, 256, p.KVupT + (long)li * 1024 * 256, nullptr, nullptr, p.CKVb, 256, 256, p.CKVb, 256, ek, smem);
    } else if (sub == 4) {
      __shared__ int s_item;
      for (;;) {
        __syncthreads();
        if (threadIdx.x == 0) s_item = atomicAdd(p.counters + li * 8 + (blockIdx.x & 7), 1);
        __syncthreads();
        const int item = s_item;
        if (item >= 320) break;
        if (PH_ON(9)) attn_item(p, (blockIdx.x & 7) * 320 + item, smem);
      }
    } else {
      EpiOut e{xa, xb, p.out, false, (layer == 3) ? nullptr : p.TMP, p.SSQ};
      if (PH_ON(5)) gemm_phase<1, 8>(T_TOK / 128, DM / 256, 1024, p.WoutO + (long)li * DM * 1024, nullptr, nullptr, p.MGb, 512, 512, p.MLGb, 512, e, smem);
    }
  }
}

__global__ void __launch_bounds__(256, 2) mega_kernel(Params p) {
  extern __shared__ __attribute__((aligned(16))) char smem[];
  cg::grid_group grid = cg::this_grid();
  __shared__ uint4 xb_words;
  if (threadIdx.x == 0) xb_words = make_uint4(0u, 0u, 0u, 0u);
  __syncthreads();
  XcdBarrier xb = xcd_barrier_post(p.bar, (volatile LAS unsigned*)&xb_words);
  for (int ph = p.ph_lo; ph < p.ph_hi; ++ph) {
    if (ph > p.ph_lo) {
      if (ph == p.ph_lo + 1) grid.sync();
      else xcd_barrier(xb);
    }
    run_phase(p, ph, smem);
  }
}

extern "C" void kernel_launch(void* const* d_in, const int* in_sizes, int n_in, void* d_out, int out_size, void* d_ws,
                              size_t ws_size, hipStream_t stream) {
  static int grid_blocks = 0;
  if (!grid_blocks) {
    int dev = 0, cus = 0, per_cu = 0;
    hipGetDevice(&dev);
    hipDeviceGetAttribute(&cus, hipDeviceAttributeMultiprocessorCount, dev);
    hipFuncSetAttribute((const void*)mega_kernel, hipFuncAttributeMaxDynamicSharedMemorySize, LDS_BYTES);
    hipOccupancyMaxActiveBlocksPerMultiprocessor(&per_cu, (const void*)mega_kernel, 256, LDS_BYTES);
    if (per_cu < 1) per_cu = 1;
    if (per_cu > 2) per_cu = 2;
    grid_blocks = cus * per_cu;
    fprintf(stderr, "kernel_launch: cus %d per_cu %d grid %d ws %zu\n", cus, per_cu, grid_blocks, ws_size);
  }
  Params p{};
  const float** pin = (const float**)&p;
  for (int i = 0; i < 19; ++i) pin[i] = (const float*)d_in[i];
  p.out = (float*)d_out;
  char* ws = (char*)d_ws;
  size_t off = 0;
  auto take = [&](size_t bytes) { char* r = ws + off; off += (bytes + 255) & ~(size_t)255; return r; };
  p.WinE = (bf16_t*)take((size_t)2 * NE_PAD * DM * 2);
  p.WinO = (bf16_t*)take((size_t)2 * NO_PAD * DM * 2);
  p.WoutE = (bf16_t*)take((size_t)2 * DM * 1536 * 2);
  p.WoutO = (bf16_t*)take((size_t)2 * DM * 1024 * 2);
  p.QupT = (bf16_t*)take((size_t)2 * 768 * 384 * 2);
  p.KVupT = (bf16_t*)take((size_t)2 * 1024 * 256 * 2);
  p.PoolWT = (bf16_t*)take((size_t)2 * 4 * 128 * 128 * 2);
  p.AupT = (bf16_t*)take((size_t)2 * 2 * 512 * 32 * 2);
  p.counters = (int*)take(256);
  p.bar = (unsigned*)take((size_t)XCD_BAR_WORDS * 4);
  p.SSQ = (float*)take((size_t)T_TOK * 8 * 4);
  const size_t act0 = off;
  const size_t T = T_TOK;
  p.Gb = (bf16_t*)take(T * 1024 * 2);
  p.PGb = (bf16_t*)take(T * 512 * 2);
  p.Qb = (bf16_t*)take(T * 512 * 2);
  p.Kt = (bf16_t*)take(T * 512 * 2);
  p.QEb = (bf16_t*)take(T * 512 * 2);
  p.KdTb = (bf16_t*)take(T * 512 * 2);
  p.EB = (float*)take((size_t)2 * 1280 * 512 * 4);
  p.VtE = (bf16_t*)take(T * 1024 * 2);
  p.LRb = (bf16_t*)take(T * 32 * 2);
  p.PUb = (bf16_t*)take(T * 512 * 2);
  p.TMP = (bf16_t*)take(T * 1024 * 2);
  const size_t even_end = off;
  off = act0;
  p.MGb = (bf16_t*)take(T * 512 * 2);
  p.MLGb = (bf16_t*)take(T * 512 * 2);
  p.CQb = (bf16_t*)take(T * 384 * 2);
  p.CKVb = (bf16_t*)take(T * 256 * 2);
  p.KRb = (bf16_t*)take(T * 32 * 2);
  const size_t r2 = off;
  p.MQb = (bf16_t*)take(T * 512 * 2);
  p.MKb = (bf16_t*)take(T * 512 * 2);
  p.MKt = (bf16_t*)take(T * 512 * 2);
  p.MVt = (bf16_t*)take(T * 512 * 2);
  p.MOb = (bf16_t*)take(T * 512 * 2);
  p.NUMIf = (bf16_t*)take(T * 512 * 2);
  p.NUMIb = (bf16_t*)take(T * 512 * 2);
  p.MIF = (float*)take(T * 16 * 4);
  p.EBI = (float*)take(T * 8 * 4);
  p.WKg = (float*)take(T * 8 * 4);
  p.DENI = (float*)take(T * 8 * 4);
  p.DEC = (float*)take((size_t)8 * 1280 * 4);
  const size_t r2_end = off;
  off = r2;
  p.Qa = (bf16_t*)take(T * 768 * 2);
  p.KNb = (bf16_t*)take(T * 512 * 2);
  p.VtA = (bf16_t*)take(T * 512 * 2);
  if (off < r2_end) off = r2_end;
  const size_t odd_end = off;
  const size_t need = even_end > odd_end ? even_end : odd_end;
  if (need > ws_size) {
    fprintf(stderr, "kernel_launch: workspace too small: need %zu have %zu\n", need, ws_size);
    return;
  }
  hipMemsetAsync(p.bar, 0, (size_t)XCD_BAR_WORDS * 4, stream);
#if SINGLE_LAUNCH
  p.ph_lo = 0;
  p.ph_hi = NPHASE;
  void* args[] = {&p};
  hipError_t e = hipLaunchCooperativeKernel((const void*)mega_kernel, dim3(grid_blocks), dim3(256), args, LDS_BYTES, stream);
  if (e != hipSuccess) fprintf(stderr, "cooperative launch failed: %s (grid %d)\n", hipGetErrorString(e), grid_blocks);
#else
  for (int ph = 0; ph < NPHASE; ++ph) {
    p.ph_lo = ph;
    p.ph_hi = ph + 1;
    hipLaunchKernelGGL(mega_kernel, dim3(grid_blocks), dim3(256), LDS_BYTES, stream, p);
  }
#endif
}
```

```cpp
#include <hip/hip_runtime.h>
#include <hip/hip_cooperative_groups.h>
#include <cstdio>
namespace cg = cooperative_groups;

#ifndef SINGLE_LAUNCH
#define SINGLE_LAUNCH 1
#endif
#ifndef PHMASK
#define PHMASK 0xFFFF
#endif
#define PH_ON(b) ((PHMASK >> (b)) & 1)
#ifndef PROBE_GEMM
#define PROBE_GEMM 0
#endif
#ifndef PROBE_ATTN
#define PROBE_ATTN 0
#endif
#ifndef PROBE_CHAIN
#define PROBE_CHAIN 0
#endif
#ifndef PROBE_A
#define PROBE_A 0
#endif
#ifndef PROBE_B
#define PROBE_B 0
#endif
#ifndef PROBE_MLCHAIN
#define PROBE_MLCHAIN 0
#endif

typedef unsigned short bf16_t;
typedef __attribute__((ext_vector_type(8))) short bf16x8;
typedef __attribute__((ext_vector_type(4))) float f32x4;
typedef __attribute__((ext_vector_type(4))) unsigned short us4;

constexpr int T_TOK = 81920;
constexpr int T_P = 16384;
constexpr int DM = 1024;
constexpr int NE = 4128, NE_PAD = 4352;
constexpr int NO = 3760, NO_PAD = 3840;
constexpr float EPS = 1e-6f;
constexpr int NPHASE = 24;
constexpr int LDS_BYTES = 72 * 1024;

struct Params {
  const float *x_prompt, *x_sample, *norm_g, *final_norm_g, *e_w_in, *e_a_up, *e_a_bias, *e_gla_norm_g,
      *e_pool_w, *e_pool_scale, *e_w_out, *o_w_in, *o_q_norm_g, *o_q_up, *o_kv_norm_g, *o_kv_up, *o_if_bias,
      *o_ml_norm_g, *o_w_out;
  float* out;
  bf16_t *WinE, *WinO, *WoutE, *WoutO, *QupT, *KVupT, *PoolWT, *AupT;
  int* counters;
  unsigned* bar;
  float* SSQ;
  bf16_t *Qb, *Kt, *VtE, *Gb, *LRb, *PUb, *PGb, *TMP, *QEb, *KdTb;
  float* EB;
  bf16_t *CQb, *CKVb, *KRb, *MGb, *MQb, *MKb, *MKt, *MVt, *MOb, *MLGb, *NUMIf, *NUMIb, *Qa, *KNb, *VtA;
  float *MIF, *EBI, *WKg, *DENI, *DEC;
  int ph_lo, ph_hi;
};

typedef __bf16 hbf2 __attribute__((ext_vector_type(2)));
typedef float hf2 __attribute__((ext_vector_type(2)));
__device__ __forceinline__ bf16_t f2bf(float f) {
  __bf16 b = (__bf16)f;
  return __builtin_bit_cast(bf16_t, b);
}
__device__ __forceinline__ unsigned pk2bf(float a, float b) {
  hf2 v = {a, b};
  hbf2 r = __builtin_convertvector(v, hbf2);
  return __builtin_bit_cast(unsigned, r);
}
__device__ __forceinline__ float bf2f(bf16_t b) { return __uint_as_float(((unsigned)b) << 16); }
__device__ __forceinline__ f32x4 mfma16(bf16x8 a, bf16x8 b, f32x4 c) {
  return __builtin_amdgcn_mfma_f32_16x16x32_bf16(a, b, c, 0, 0, 0);
}
__device__ __forceinline__ float logsigmoidf_(float x) { return fminf(x, 0.f) - log1pf(__expf(-fabsf(x))); }
__device__ __forceinline__ float siluf_(float x) { return x / (1.f + __expf(-x)); }
__device__ __forceinline__ float sigmoidf_(float x) { return 1.f / (1.f + __expf(-x)); }
__device__ __forceinline__ int otid() { int t = threadIdx.x; asm volatile("" : "+v"(t)); return t; }
__device__ __forceinline__ float bperm(int srclane, float v) { return __int_as_float(__builtin_amdgcn_ds_bpermute(srclane << 2, __float_as_int(v))); }
__device__ __forceinline__ float sxor(float v, int m, int lane) { return bperm(lane ^ m, v); }
typedef unsigned u32x2_t __attribute__((ext_vector_type(2)));
__device__ __forceinline__ float rowmax4(float v) {
  u32x2_t r = __builtin_amdgcn_permlane16_swap(__float_as_uint(v), __float_as_uint(v), false, false);
  v = fmaxf(__uint_as_float(r[0]), __uint_as_float(r[1]));
  r = __builtin_amdgcn_permlane32_swap(__float_as_uint(v), __float_as_uint(v), false, false);
  return fmaxf(__uint_as_float(r[0]), __uint_as_float(r[1]));
}
template <int CTRL> __device__ __forceinline__ float dpp_f(float v) {
  return __int_as_float(__builtin_amdgcn_update_dpp(0, __float_as_int(v), CTRL, 0xf, 0xf, false));
}
__device__ __forceinline__ float row_sum16(float v) {
  v += dpp_f<0x128>(v);
  v += dpp_f<0x124>(v);
  v += dpp_f<0x122>(v);
  v += dpp_f<0x121>(v);
  return v;
}
__device__ __forceinline__ float wave_sum(float v) {
  v += dpp_f<0x128>(v);
  v += dpp_f<0x124>(v);
  v += dpp_f<0x122>(v);
  v += dpp_f<0x121>(v);
  u32x2_t r = __builtin_amdgcn_permlane16_swap(__float_as_uint(v), __float_as_uint(v), false, false);
  v = __uint_as_float(r[0]) + __uint_as_float(r[1]);
  r = __builtin_amdgcn_permlane32_swap(__float_as_uint(v), __float_as_uint(v), false, false);
  return __uint_as_float(r[0]) + __uint_as_float(r[1]);
}
__device__ __forceinline__ bf16x8 zero8() { bf16x8 z = {0, 0, 0, 0, 0, 0, 0, 0}; return z; }
__device__ __forceinline__ f32x4 zero4() { f32x4 z = {0.f, 0.f, 0.f, 0.f}; return z; }

__device__ __forceinline__ int seq_pos(int tok) { return tok < T_P ? (tok & 4095) : ((tok - T_P) & 8191); }
__device__ __forceinline__ const float* xrow(const float* xa, const float* xb, int tok) {
  return tok < T_P ? xa + (long)tok * DM : xb + (long)(tok - T_P) * DM;
}


#define XB_TMO      128
#define XB_XCNT(j)  (256  + 64 * (j))
#define XB_XSUB(j)  (1280 + 64 * (j))
#define XB_XGEN(j)  (2304 + 64 * (j))
#define XB_TOP      3328
#define XB_TOPGEN   3392
#define XCD_BAR_WORDS 3456
#define XB_SPIN_CAP (1u << 22)
#define LAS __attribute__((address_space(3)))
__device__ __forceinline__ unsigned xb_ld(unsigned* p) { return __hip_atomic_load(p, __ATOMIC_RELAXED, __HIP_MEMORY_SCOPE_AGENT); }
__device__ __forceinline__ unsigned xb_add(unsigned* p, unsigned v) { return __hip_atomic_fetch_add(p, v, __ATOMIC_RELAXED, __HIP_MEMORY_SCOPE_AGENT); }
__device__ __forceinline__ unsigned xb_xcc_id() { return (unsigned)__builtin_amdgcn_s_getreg((3 << 11) | 20) & 0xFu; }
#define XB_SPIN(cond, bar) do { unsigned _sp = 0; while (cond) { __builtin_amdgcn_s_sleep(1); \
    if ((++_sp & 255u) == 0u) { if (xb_ld(&(bar)[XB_TMO])) break; if (_sp > XB_SPIN_CAP) { atomicAdd(&(bar)[XB_TMO], 1u); break; } } } } while (0)
struct XcdBarrier { unsigned* bar; unsigned x; volatile LAS unsigned* st; };
__device__ __forceinline__ XcdBarrier xcd_barrier_post(unsigned* bar, volatile LAS unsigned* st) {
  XcdBarrier b; b.bar = bar; b.x = xb_xcc_id(); b.st = st;
  if (threadIdx.x == 0) (void)xb_add(&bar[XB_XCNT(b.x)], 1u);
  return b;
}
__device__ __forceinline__ void xcd_barrier_complete(unsigned* bar, unsigned x, unsigned& nloc, unsigned& nx) {
  const unsigned G = gridDim.x * gridDim.y * gridDim.z;
  unsigned sum, cnt, mine, sp = 0u;
  for (;;) {
    sum = 0u; cnt = 0u; mine = 0u;
#pragma unroll
    for (unsigned j = 0; j < 16; ++j) { const unsigned cc = xb_ld(&bar[XB_XCNT(j)]); sum += cc; cnt += (cc > 0u) ? 1u : 0u; mine = (j == x) ? cc : mine; }
    if (sum == G) break;
    __builtin_amdgcn_s_sleep(1);
    if ((++sp & 255u) == 0u) { if (xb_ld(&bar[XB_TMO])) break; if (sp > XB_SPIN_CAP) { atomicAdd(&bar[XB_TMO], 1u); break; } }
  }
  nloc = mine > 0u ? mine : 1u; nx = cnt > 0u ? cnt : 1u;
}
__device__ __forceinline__ void xcd_barrier(const XcdBarrier& b) {
  asm volatile("s_waitcnt vmcnt(0)" ::: "memory");
  __syncthreads();
  if (threadIdx.x == 0) {
    unsigned* bar = b.bar;
    __builtin_amdgcn_s_waitcnt(0);
    unsigned nloc = b.st[0], nx = b.st[1];
    if (nloc == 0u) { xcd_barrier_complete(bar, b.x, nloc, nx); b.st[0] = nloc; b.st[1] = nx; }
    const unsigned old = xb_add(&bar[XB_XSUB(b.x)], 1u);
    const unsigned gen = old / nloc;
    if (old + 1u == (gen + 1u) * nloc) {
      __builtin_amdgcn_fence(__ATOMIC_RELEASE, "agent");
      asm volatile("s_waitcnt vmcnt(0)" ::: "memory");
      const unsigned og = xb_add(&bar[XB_TOP], 1u);
      const unsigned tg = og / nx;
      if (og + 1u == (tg + 1u) * nx) xb_add(&bar[XB_TOPGEN], 1u);
      else XB_SPIN(xb_ld(&bar[XB_TOPGEN]) == tg, bar);
      __builtin_amdgcn_fence(__ATOMIC_ACQUIRE, "agent");
      xb_add(&bar[XB_XGEN(b.x)], 1u);
      asm volatile("s_waitcnt vmcnt(0)" ::: "memory");
    } else {
      XB_SPIN(xb_ld(&bar[XB_XGEN(b.x)]) == gen, bar);
      __builtin_amdgcn_fence(__ATOMIC_ACQUIRE, "agent");
      asm volatile("s_waitcnt vmcnt(0)" ::: "memory");
    }
  }
  __syncthreads();
}

__device__ __forceinline__ int colmap(int mode, int n) {
  if (mode == 1) {
    if (n < 512) return 2208 + n;
    if (n < 1024) return 1696 + (n - 512);
    if (n < 1408) return n - 1024;
    if (n < 1664) return 384 + (n - 1408);
    if (n < 2176) return 672 + (n - 1664);
    if (n < 2688) return 1184 + (n - 2176);
    if (n < 3200) return 2720 + (n - 2688);
    if (n < 3712) return 3248 + (n - 3200);
    if (n < 3744) return 640 + (n - 3712);
    return 3232 + (n - 3744);
  }
  if (mode == 2) {
    if (n < 512) return (n >> 6) * 96 + (n & 63);
    const int r = n - 512;
    return (r >> 5) * 96 + 64 + (r & 31);
  }
  if (mode == 3) {
    if (n < 512) return (n >> 6) * 128 + (n & 63);
    const int r = n - 512;
    return (r >> 6) * 128 + 64 + (r & 63);
  }
  return n;
}

__device__ void prep_weight(const float* __restrict__ W, int K, int N, int Npad, const float* __restrict__ gsc,
                            bf16_t* __restrict__ out, char* smem, int mode = 0, int Nsrc_ = 0) {
  const int Nsrc = Nsrc_ ? Nsrc_ : N;
  const int tid = otid();
  float* sT = (float*)smem;
  const int tn = Npad >> 6, tk = K >> 6;
  for (int tile = blockIdx.x; tile < tn * tk; tile += gridDim.x) {
    const int n0 = (tile / tk) << 6, k0 = (tile % tk) << 6;
    __syncthreads();
#pragma unroll 4
    for (int i = 0; i < 16; ++i) {
      const int idx = tid + 256 * i;
      const int kk = idx >> 6, nn = idx & 63;
      float v = 0.f;
      if (n0 + nn < N) {
        v = W[(size_t)(k0 + kk) * Nsrc + colmap(mode, n0 + nn)];
        if (gsc) v *= gsc[k0 + kk];
      }
      sT[nn * 65 + kk] = v;
    }
    __syncthreads();
#pragma unroll 4
    for (int i = 0; i < 16; ++i) {
      const int idx = tid + 256 * i;
      const int nn = idx >> 6, kk = idx & 63;
      out[(size_t)(n0 + nn) * K + k0 + kk] = f2bf(sT[nn * 65 + kk]);
    }
  }
}

__device__ void phase_prep(const Params& p, char* smem) {
  long gtid = (long)blockIdx.x * 256 + otid();
  long gsize = (long)gridDim.x * 256;
  for (int l = 0; l < 2; ++l) {
    prep_weight(p.e_w_in + (long)l * DM * NE, DM, NE, NE_PAD, p.norm_g + (2 * l) * DM, p.WinE + (long)l * NE_PAD * DM, smem);
    prep_weight(p.o_w_in + (long)l * DM * 3760, DM, NO, NO_PAD, p.norm_g + (2 * l + 1) * DM, p.WinO + (long)l * NO_PAD * DM, smem, 1, 3760);
    prep_weight(p.e_w_out + (long)l * 1536 * DM, 1536, DM, DM, nullptr, p.WoutE + (long)l * DM * 1536, smem);
    prep_weight(p.o_w_out + (long)l * 1024 * DM, 1024, DM, DM, nullptr, p.WoutO + (long)l * DM * 1024, smem);
    prep_weight(p.o_q_up + (long)l * 384 * 768, 384, 768, 768, p.o_q_norm_g + l * 384, p.QupT + (long)l * 768 * 384, smem, 2);
    prep_weight(p.o_kv_up + (long)l * 256 * 1024, 256, 1024, 1024, p.o_kv_norm_g + l * 256, p.KVupT + (long)l * 1024 * 256, smem, 3);
    for (int gi = 0; gi < 4; ++gi)
      prep_weight(p.e_pool_w + (long)(l * 4 + gi) * 128 * 128, 128, 128, 128, nullptr, p.PoolWT + (long)(l * 4 + gi) * 128 * 128, smem);
    for (long idx = gtid; idx < 2 * 512 * 32; idx += gsize) {
      int r = (int)(idx & 31);
      int d = (int)((idx >> 5) & 511);
      int dir = (int)(idx >> 14);
      float v = (r < 16) ? p.e_a_up[((long)(l * 2 + dir) * 16 + r) * 512 + d] : 0.f;
      p.AupT[((long)(l * 2 + dir) * 512 + d) * 32 + r] = f2bf(v);
    }
  }
  if (gtid < 32) p.counters[gtid] = 0;
  {
    const int tid_ = otid();
    const int lane = tid_ & 63, w = tid_ >> 6;
  #pragma unroll 2
  for (int tok = blockIdx.x * 4 + w; tok < T_TOK; tok += gridDim.x * 4) {
      const float* xp = xrow(p.x_prompt, p.x_sample, tok) + 16 * lane;
      float ssv = 0.f;
      unsigned pk[8];
#pragma unroll
      for (int i = 0; i < 4; ++i) {
        const f32x4 v = *(const f32x4*)(xp + 4 * i);
        ssv += v[0] * v[0] + v[1] * v[1] + v[2] * v[2] + v[3] * v[3];
        pk[2 * i] = pk2bf(v[0], v[1]);
        pk[2 * i + 1] = pk2bf(v[2], v[3]);
      }
      uint4 o0, o1;
      o0.x = pk[0]; o0.y = pk[1]; o0.z = pk[2]; o0.w = pk[3];
      o1.x = pk[4]; o1.y = pk[5]; o1.z = pk[6]; o1.w = pk[7];
      *(uint4*)(p.TMP + (size_t)tok * DM + 16 * lane) = o0;
      *(uint4*)(p.TMP + (size_t)tok * DM + 16 * lane + 8) = o1;
      ssv = wave_sum(ssv);
      if (lane < 8) p.SSQ[(size_t)tok * 8 + lane] = (lane == 0) ? ssv : 0.f;
    }
  }
}

constexpr int G_LD = 40;
constexpr int G_BUF = (128 + 256) * G_LD;

template <int AMODE, int NI, class Epi>
__device__ __forceinline__ void gemm_phase(int Mtiles, int Ntiles, int K, const bf16_t* __restrict__ Bt, const float* ssq, const float* unused_,
                           const bf16_t* A1, int ld1, int K1, const bf16_t* A2, int ld2, const Epi& epi, char* smem) {
  bf16_t* sbase = (bf16_t*)smem;
  float* sR = (float*)(smem + 70144);
  const int tid = otid(), lane = tid & 63, w = tid >> 6, c = lane & 15, g = lane >> 4;
  const int wm = w >> 1, wn = w & 1;
  const int nk = K / 32;
  const int xcd = blockIdx.x & 7, lb0 = blockIdx.x >> 3, nlb = gridDim.x >> 3;
  const int mper = Mtiles >> 3;
  for (int lt = lb0; lt < mper * Ntiles; lt += nlb) {
    const int mt = xcd * mper + lt / Ntiles, nt = lt % Ntiles;
    constexpr int BN = 32 * NI;
    const int m0 = mt * 128, n0 = nt * BN;
    f32x4 acc[4][NI];
#pragma unroll
    for (int i = 0; i < 4; ++i)
#pragma unroll
      for (int j = 0; j < NI; ++j) acc[i][j] = zero4();
    float ss[2] = {0.f, 0.f};
    bf16x8 ra0[2], ra1[2];
    bf16x8 rb0[NI / 2], rb1[NI / 2];
    const unsigned boff = (unsigned)(tid >> 2) * K + 8 * (tid & 3);
    const bf16_t* bbase = Bt + (size_t)n0 * K;
#define G_LOAD(RA, RB, KT)                                                                          \
  {                                                                                                 \
    const int k0_ = (KT) * 32;                                                                      \
    const bf16_t* base_;                                                                            \
    int ld_;                                                                                        \
    if (k0_ < K1) { base_ = A1 + (size_t)m0 * ld1 + k0_; ld_ = ld1; }                               \
    else { base_ = A2 + (size_t)m0 * ld2 + (k0_ - K1); ld_ = ld2; }                                 \
    _Pragma("unroll") for (int i = 0; i < 2; ++i)                                                   \
      RA[i] = *(const bf16x8*)(base_ + (unsigned)((tid >> 2) + 64 * i) * ld_ + 8 * (tid & 3));      \
    _Pragma("unroll") for (int i = 0; i < NI / 2; ++i)                                              \
      RB[i] = *(const bf16x8*)(bbase + k0_ + boff + (unsigned)(64 * i) * K);                        \
  }
#define G_STORE(RA, RB, BUF)                                                                        \
  {                                                                                                 \
    bf16_t* sA_ = sbase + (BUF) * G_BUF;                                                            \
    bf16_t* sB_ = sA_ + 128 * G_LD;                                                                 \
    _Pragma("unroll") for (int i = 0; i < 2; ++i) {                                                 \
      bf16x8 v = RA[i];                                                                             \
      if constexpr (AMODE == 2) {                                                                   \
        _Pragma("unroll") for (int e = 0; e < 8; ++e) {                                             \
          float f = bf2f((bf16_t)v[e]);                                                             \
          ss[i] += f * f;                                                                           \
        }                                                                                           \
      }                                                                                             \
      *(bf16x8*)(sA_ + ((tid >> 2) + 64 * i) * G_LD + 8 * (tid & 3)) = v;                           \
    }                                                                                               \
    _Pragma("unroll") for (int i = 0; i < NI / 2; ++i)                                              \
      *(bf16x8*)(sB_ + ((tid >> 2) + 64 * i) * G_LD + 8 * (tid & 3)) = RB[i];                       \
  }
#define G_COMPUTE(BUF)     \
  {                                                                                                 \
    const bf16_t* sA_ = sbase + (BUF) * G_BUF;                                                      \
    const bf16_t* sB_ = sA_ + 128 * G_LD;                                                           \
    bf16x8 af[4];                                                                                   \
    _Pragma("unroll") for (int mi = 0; mi < 4; ++mi)                                                \
      af[mi] = *(const bf16x8*)(sA_ + (wm * 64 + mi * 16 + c) * G_LD + g * 8);                      \
    bf16x8 bq[2];                                                                                   \
    bq[0] = *(const bf16x8*)(sB_ + (wn * (16 * NI) + c) * G_LD + g * 8);                            \
    _Pragma("unroll") for (int ni = 0; ni < NI; ++ni) {                                             \
      if (ni + 1 < NI)                                                                              \
        bq[(ni + 1) & 1] = *(const bf16x8*)(sB_ + (wn * (16 * NI) + (ni + 1) * 16 + c) * G_LD + g * 8); \
      _Pragma("unroll") for (int mi = 0; mi < 4; ++mi)                                              \
        acc[mi][ni] = (!Epi::staged) ? mfma16(bq[ni & 1], af[mi], acc[mi][ni]) : mfma16(af[mi], bq[ni & 1], acc[mi][ni]); \
    }                                                                                               \
  }
    __syncthreads();
    if constexpr (AMODE == 3) {
      if (tid < 128) {
        const f32x4 p0 = *(const f32x4*)(ssq + (size_t)(m0 + tid) * 8);
        const f32x4 p1 = *(const f32x4*)(ssq + (size_t)(m0 + tid) * 8 + 4);
        const float sv = (p0[0] + p0[1]) + (p0[2] + p0[3]) + (p1[0] + p1[1]) + (p1[2] + p1[3]);
        sR[tid] = rsqrtf(sv * (1.f / 1024.f) + EPS);
      }
    }
    G_LOAD(ra0, rb0, 0)
    G_LOAD(ra1, rb1, 1)
    G_STORE(ra0, rb0, 0)
    __syncthreads();
    for (int kt = 0; kt < nk; kt += 2) {
      G_LOAD(ra0, rb0, min(kt + 2, nk - 1))
      G_COMPUTE(0)
      G_STORE(ra1, rb1, 1)
      __syncthreads();
      G_LOAD(ra1, rb1, min(kt + 3, nk - 1))
      G_COMPUTE(1)
      if (kt + 2 < nk) G_STORE(ra0, rb0, 0)
      __syncthreads();
    }
    if constexpr (AMODE == 2) {
#pragma unroll
      for (int i = 0; i < 2; ++i) {
        float sv = ss[i];
        sv += sxor(sv, 1, lane); sv += sxor(sv, 2, lane);
        if ((tid & 3) == 0) sR[(tid >> 2) + 64 * i] = rsqrtf(sv / (float)K + EPS);
      }
      __syncthreads();
    }
    if constexpr (Epi::staged) {
      bf16_t* sT = sbase;
      const float esc = epi.scale();
      const bool both = epi.both(n0);
#pragma unroll 1
      for (int pass = 0; pass < (both ? 2 : 1); ++pass) {
      const bool tr = both ? (pass == 1) : epi.transposed(n0);
      if (pass) __syncthreads();
      if (tr) {
#pragma unroll
        for (int mi = 0; mi < 4; ++mi) {
          const int row = wm * 64 + mi * 16 + 4 * g;
          const float r0 = sR[row] * esc, r1 = sR[row + 1] * esc, r2 = sR[row + 2] * esc, r3 = sR[row + 3] * esc;
#pragma unroll
          for (int ni = 0; ni < NI; ++ni) {
            uint2 o;
            o.x = pk2bf(acc[mi][ni][0] * r0, acc[mi][ni][1] * r1);
            o.y = pk2bf(acc[mi][ni][2] * r2, acc[mi][ni][3] * r3);
            *(uint2*)(sT + (wn * (16 * NI) + ni * 16 + c) * 136 + row) = o;
          }
        }
      } else {
#pragma unroll
        for (int mi = 0; mi < 4; ++mi) {
          const int row = wm * 64 + mi * 16 + 4 * g;
          const float r0 = sR[row] * esc, r1 = sR[row + 1] * esc, r2 = sR[row + 2] * esc, r3 = sR[row + 3] * esc;
#pragma unroll
          for (int ni = 0; ni < NI; ++ni) {
            bf16_t* d = sT + row * (BN + 8) + wn * (16 * NI) + ni * 16 + c;
            d[0] = f2bf(acc[mi][ni][0] * r0);
            d[BN + 8] = f2bf(acc[mi][ni][1] * r1);
            d[2 * (BN + 8)] = f2bf(acc[mi][ni][2] * r2);
            d[3 * (BN + 8)] = f2bf(acc[mi][ni][3] * r3);
          }
        }
      }
      if (pass == 0) epi.template direct<NI>(m0, n0, wm, wn, g, c, acc, sR);
      __syncthreads();
      if (tr) {
#pragma unroll 4
        for (int i = 0; i < 2 * NI; ++i) {
          const int id = tid + 256 * i;
          const int col = id >> 4, rc = id & 15;
          bf16x8 v = *(const bf16x8*)(sT + col * 136 + 8 * rc);
          epi.store_t(m0 + 8 * rc, n0 + col, v);
        }
      } else {
#pragma unroll 4
        for (int i = 0; i < 2 * NI; ++i) {
          const int id = tid + 256 * i;
          const int row = id / (4 * NI), cc = id % (4 * NI);
          const bf16_t* sp = sT + row * (BN + 8) + 8 * cc;
          bf16x8 v = *(const bf16x8*)sp;
          epi.store_n(m0 + row, n0 + 8 * cc, v, sp);
        }
      }
      }
    } else {
      float* sF = (float*)smem;
#pragma unroll 1
      for (int half = 0; half < 2; ++half) {
        if (half) __syncthreads();
        if (wm == half) {
#pragma unroll
          for (int mi = 0; mi < 4; ++mi)
#pragma unroll
            for (int ni = 0; ni < NI; ++ni) *(f32x4*)(sF + (mi * 16 + c) * 260 + wn * (16 * NI) + ni * 16 + 4 * g) = acc[mi][ni];
        }
        __syncthreads();
#pragma unroll 4
        for (int i = 0; i < 16; ++i) {
          const int row = w * 16 + i;
          const int tok = m0 + half * 64 + row;
          const int col = n0 + 4 * lane;
          const f32x4 a = *(const f32x4*)(sF + row * 260 + 4 * lane);
          const f32x4 xo = *(const f32x4*)(xrow(epi.xa, epi.xb, tok) + col);
          f32x4 xn;
          xn[0] = xo[0] + a[0]; xn[1] = xo[1] + a[1]; xn[2] = xo[2] + a[2]; xn[3] = xo[3] + a[3];
          float sv = xn[0] * xn[0] + xn[1] * xn[1] + xn[2] * xn[2] + xn[3] * xn[3];
          sv = wave_sum(sv);
          if (!epi.dry) {
            *(f32x4*)(epi.out + (size_t)tok * DM + col) = xn;
            if (epi.hb) {
              uint2 o;
              o.x = pk2bf(xn[0], xn[1]);
              o.y = pk2bf(xn[2], xn[3]);
              *(uint2*)(epi.hb + (size_t)tok * DM + col) = o;
            }
            if (lane == 0) epi.ssq[(size_t)tok * 8 + (n0 >> 8)] = sv;
          }
        }
      }
    }
  }
#undef G_LOAD
#undef G_STORE
#undef G_COMPUTE
}

__device__ __forceinline__ void rope_cs(int pos, int i, float& co, float& si) {
  float inv = exp2f(-(float)i * (13.287712379549449f / 16.f));
  float ang = (float)pos * inv;
  float n = rintf(ang * 0.15915494309189535f);
  float r = fmaf(-n, 6.28125f, ang);
  r = fmaf(-n, 0.0019353071795864769f, r);
  float rf = r * 0.15915494309189535f;
  si = __builtin_amdgcn_sinf(rf);
  co = __builtin_amdgcn_cosf(rf);
}

__device__ __forceinline__ void rope_chunk(int pos, int i0, bf16x8 x1, bf16x8 x2, bf16x8& o1, bf16x8& o2) {
#pragma unroll
  for (int e = 0; e < 8; ++e) {
    float co, si;
    rope_cs(pos, i0 + e, co, si);
    float a = bf2f((bf16_t)x1[e]), b = bf2f((bf16_t)x2[e]);
    o1[e] = (short)f2bf(a * co - b * si);
    o2[e] = (short)f2bf(b * co + a * si);
  }
}

struct EpiEvenIn {
  static constexpr bool staged = true;
  bf16_t *Qb, *Kt, *VtE, *Gb, *LRb, *PUb, *PGb;
  __device__ float scale() const { return 1.f; }
  __device__ bool transposed(int n0) const { return n0 >= 512 && n0 < 2048; }
  __device__ bool both(int n0) const { return false; }
  template <int NI> __device__ void direct(int m0, int n0, int wm, int wn, int g, int c, f32x4 (&acc)[4][NI], const float* sR) const {}
  __device__ void store_t(int tok8, int col, bf16x8 v) const {
    if (col < 1024) *(bf16x8*)(Kt + (size_t)(col - 512) * T_TOK + tok8) = v;
    else *(bf16x8*)(VtE + (size_t)(col - 1024) * T_TOK + tok8) = v;
  }
  __device__ void store_n(int tok, int col, bf16x8 v, const bf16_t* sp) const {
    bf16_t* d;
    if (col < 512) d = Qb + (size_t)tok * 512 + col;
    else if (col < 3072) d = Gb + (size_t)tok * 1024 + (col - 2048);
    else if (col < 3104) d = LRb + (size_t)tok * 32 + (col - 3072);
    else if (col < 3616) d = PUb + (size_t)tok * 512 + (col - 3104);
    else if (col < 4128) d = PGb + (size_t)tok * 512 + (col - 3616);
    else return;
    *(bf16x8*)d = v;
  }
};

struct EpiOddIn {
  static constexpr bool staged = true;
  bf16_t *CQb, *CKVb, *KRb, *MGb, *MQb, *MKb, *MKt, *MVt, *MOb, *MLGb;
  float* MIF;
  __device__ float scale() const { return 1.f; }
  __device__ bool transposed(int n0) const { return n0 < 512; }
  __device__ bool both(int n0) const { return n0 >= 512 && n0 < 1024; }
  template <int NI> __device__ void direct(int m0, int n0, int wm, int wn, int g, int c, f32x4 (&acc)[4][NI], const float* sR) const {
    if (n0 == 3584 && wn == 1) {
#pragma unroll
      for (int mi = 0; mi < 4; ++mi)
#pragma unroll
        for (int j = 0; j < 4; ++j) {
          const int row = wm * 64 + mi * 16 + 4 * g + j;
          MIF[(size_t)(m0 + row) * 16 + c] = acc[mi][2][j] * sR[row];
        }
    }
  }
  __device__ void store_t(int tok8, int col, bf16x8 v) const {
    if (col < 512) *(bf16x8*)(MVt + (size_t)col * T_TOK + tok8) = v;
    else *(bf16x8*)(MKt + (size_t)(col - 512) * T_TOK + tok8) = v;
  }
  __device__ void store_n(int tok, int col, bf16x8 v, const bf16_t* sp) const {
    bf16_t* d;
    if (col < 1024) d = MKb + (size_t)tok * 512 + (col - 512);
    else if (col < 1408) d = CQb + (size_t)tok * 384 + (col - 1024);
    else if (col < 1664) d = CKVb + (size_t)tok * 256 + (col - 1408);
    else if (col < 2176) d = MGb + (size_t)tok * 512 + (col - 1664);
    else if (col < 2688) d = MQb + (size_t)tok * 512 + (col - 2176);
    else if (col < 3200) d = MOb + (size_t)tok * 512 + (col - 2688);
    else if (col < 3712) d = MLGb + (size_t)tok * 512 + (col - 3200);
    else if (col < 3728) {
      bf16x8 x2 = *(const bf16x8*)(sp + 16);
      bf16x8 o1, o2;
      rope_chunk(seq_pos(tok), col - 3712, v, x2, o1, o2);
      *(bf16x8*)(KRb + (size_t)tok * 32 + (col - 3712)) = o1;
      *(bf16x8*)(KRb + (size_t)tok * 32 + 16 + (col - 3712)) = o2;
      return;
    } else return;
    *(bf16x8*)d = v;
  }
};

struct EpiQUp {
  static constexpr bool staged = true;
  bf16_t* Qa;
  __device__ float scale() const { return 0.10206207261596575f * 1.4426950408889634f; }
  __device__ bool transposed(int n0) const { return false; }
  __device__ bool both(int n0) const { return false; }
  template <int NI> __device__ void direct(int m0, int n0, int wm, int wn, int g, int c, f32x4 (&acc)[4][NI], const float* sR) const {}
  __device__ void store_t(int tok8, int col, bf16x8 v) const {}
  __device__ void store_n(int tok, int col, bf16x8 v, const bf16_t* sp) const {
    if (col < 512) {
      *(bf16x8*)(Qa + (size_t)tok * 768 + (col >> 6) * 96 + (col & 63)) = v;
    } else {
      const int r = col - 512, head = r >> 5, rr = r & 31;
      if (rr < 16) {
        bf16x8 x2 = *(const bf16x8*)(sp + 16);
        bf16x8 o1, o2;
        rope_chunk(seq_pos(tok), rr, v, x2, o1, o2);
        *(bf16x8*)(Qa + (size_t)tok * 768 + head * 96 + 64 + rr) = o1;
        *(bf16x8*)(Qa + (size_t)tok * 768 + head * 96 + 80 + rr) = o2;
      }
    }
  }
};

struct EpiKVUp {
  static constexpr bool staged = true;
  bf16_t *KNb, *VtA;
  __device__ float scale() const { return 1.f; }
  __device__ bool transposed(int n0) const { return n0 >= 512; }
  __device__ bool both(int n0) const { return false; }
  template <int NI> __device__ void direct(int m0, int n0, int wm, int wn, int g, int c, f32x4 (&acc)[4][NI], const float* sR) const {}
  __device__ void store_t(int tok8, int col, bf16x8 v) const { *(bf16x8*)(VtA + (size_t)(col - 512) * T_TOK + tok8) = v; }
  __device__ void store_n(int tok, int col, bf16x8 v, const bf16_t* sp) const { *(bf16x8*)(KNb + (size_t)tok * 512 + col) = v; }
};

struct EpiOut {
  static constexpr bool staged = false;
  const float *xa, *xb;
  float* out;
  bool dry;
  bf16_t* hb;
  float* ssq;
};

template <int CTRL> __device__ __forceinline__ float dpp_z(float v) {
  return __int_as_float(__builtin_amdgcn_update_dpp(0, __float_as_int(v), CTRL, 0xf, 0xf, true));
}
__device__ __forceinline__ float scan16(float v, int c, int lane) {
  v += dpp_z<0x111>(v);
  v += dpp_z<0x112>(v);
  v += dpp_z<0x114>(v);
  v += dpp_z<0x118>(v);
  return v;
}

__device__ __forceinline__ float logsig_fast(float x) { return fminf(x, 0.f) - __logf(1.f + __expf(-fabsf(x))); }

__device__ void gla_intra_item(const Params& p, int li, int item, char* smem, bool dry = false) {
  const int tid = otid(), lane = tid & 63, w = tid >> 6, c = lane & 15, g = lane >> 4;
  const int ci = item >> 2, h = item & 3;
  const int tokc = ci * 64;
  const float qscale = 0.08838834764831845f;
  bf16_t* sQe = (bf16_t*)smem;
  bf16_t* sKd = sQe + 64 * 136;
  bf16_t* sA = sKd + 64 * 136;
  us4 q4[2][4];
  bf16_t kk[2][4][4];
#pragma unroll
  for (int dt = 0; dt < 2; ++dt)
#pragma unroll
    for (int tt = 0; tt < 4; ++tt) {
      q4[dt][tt] = *(const us4*)(p.Qb + (size_t)(tokc + 16 * tt + c) * 512 + h * 128 + 32 * w + 16 * dt + 4 * g);
#pragma unroll
      for (int j = 0; j < 4; ++j)
        kk[dt][tt][j] = p.Kt[(size_t)(h * 128 + 32 * w + 16 * dt + 4 * g + j) * T_TOK + tokc + 16 * tt + c];
    }
  __syncthreads();
#pragma unroll
  for (int dir = 0; dir < 2; ++dir) {
    bf16_t* QEd = (dir || dry) ? p.QEb : p.Qb;
    bf16_t* KdTd = (dir || dry) ? p.KdTb : p.Kt;
    bf16x8 aup[2];
    float bias[2][4];
#pragma unroll
    for (int dt = 0; dt < 2; ++dt) {
      aup[dt] = zero8();
      if (g < 2) aup[dt] = *(const bf16x8*)(p.AupT + ((size_t)(li * 2 + dir) * 512 + h * 128 + 32 * w + 16 * dt + c) * 32 + 8 * g);
#pragma unroll
      for (int j = 0; j < 4; ++j) bias[dt][j] = p.e_a_bias[(li * 2 + dir) * 512 + h * 128 + 32 * w + 16 * dt + 4 * g + j];
    }
    f32x4 la[2][4];
#pragma unroll
    for (int tt = 0; tt < 4; ++tt) {
      bf16x8 lrf = zero8();
      if (g < 2) lrf = *(const bf16x8*)(p.LRb + (size_t)(tokc + 16 * tt + c) * 32 + dir * 16 + 8 * g);
#pragma unroll
      for (int dt = 0; dt < 2; ++dt) la[dt][tt] = mfma16(aup[dt], lrf, zero4());
    }
#pragma unroll
    for (int dt = 0; dt < 2; ++dt)
#pragma unroll
      for (int tt = 0; tt < 4; ++tt)
#pragma unroll
        for (int j = 0; j < 4; ++j) la[dt][tt][j] = logsig_fast(la[dt][tt][j] + bias[dt][j]) * (1.f / 16.f);
    f32x4 P[2][4];
    float tot[2][4];
#pragma unroll
    for (int dt = 0; dt < 2; ++dt)
#pragma unroll
      for (int j = 0; j < 4; ++j) {
        float carry = 0.f;
#pragma unroll
        for (int tt = 0; tt < 4; ++tt) {
          float v = scan16(la[dt][tt][j], c, lane) + carry;
          P[dt][tt][j] = v;
          carry = dpp_f<0x15F>(v);
        }
        tot[dt][j] = carry;
      }
#pragma unroll
    for (int dt = 0; dt < 2; ++dt)
#pragma unroll
      for (int tt = 0; tt < 4; ++tt) {
        us4 qo, ko;
#pragma unroll
        for (int j = 0; j < 4; ++j) {
          const float b = (dir == 0) ? P[dt][tt][j] : (tot[dt][j] - P[dt][tt][j] + la[dt][tt][j]);
          qo[j] = f2bf(bf2f(q4[dt][tt][j]) * __expf(b) * qscale);
          ko[j] = f2bf(bf2f(kk[dt][tt][j]) * __expf(-b));
        }
        *(us4*)(QEd + (size_t)(tokc + 16 * tt + c) * 512 + h * 128 + 32 * w + 16 * dt + 4 * g) = qo;
        *(us4*)(sQe + (16 * tt + c) * 136 + 32 * w + 16 * dt + 4 * g) = qo;
        *(us4*)(sKd + (16 * tt + c) * 136 + 32 * w + 16 * dt + 4 * g) = ko;
      }
    if (c == 0) {
#pragma unroll
      for (int dt = 0; dt < 2; ++dt)
#pragma unroll
        for (int j = 0; j < 4; ++j)
          p.EB[(size_t)(dir * 1280 + ci) * 512 + h * 128 + 32 * w + 16 * dt + 4 * g + j] = __expf(tot[dt][j]);
    }
    __syncthreads();
#pragma unroll
    for (int i = 0; i < 4; ++i) {
      const int id = tid + 256 * i;
      const int d = id & 127, c8 = id >> 7;
      bf16x8 v;
#pragma unroll
      for (int e = 0; e < 8; ++e) v[e] = (short)sKd[(8 * c8 + e) * 136 + d];
      *(bf16x8*)(KdTd + (size_t)(h * 128 + d) * T_TOK + tokc + 8 * c8) = v;
    }
    f32x4 accA[4];
#pragma unroll
    for (int jt = 0; jt < 4; ++jt) accA[jt] = zero4();
#pragma unroll
    for (int ks = 0; ks < 4; ++ks) {
      bf16x8 aq = *(const bf16x8*)(sQe + (16 * w + c) * 136 + 32 * ks + 8 * g);
#pragma unroll
      for (int jt = 0; jt < 4; ++jt) {
        bf16x8 bk = *(const bf16x8*)(sKd + (16 * jt + c) * 136 + 32 * ks + 8 * g);
        accA[jt] = mfma16(aq, bk, accA[jt]);
      }
    }
#pragma unroll
    for (int jt = 0; jt < 4; ++jt)
#pragma unroll
      for (int j = 0; j < 4; ++j) {
        const int i = 16 * w + 4 * g + j, jj = 16 * jt + c;
        const bool keep = (dir == 0) ? (jj <= i) : (jj > i);
        sA[dir * 64 * 72 + i * 72 + jj] = f2bf(keep ? accA[jt][j] : 0.f);
      }
    __syncthreads();
  }
  bf16x8 af[2][2];
#pragma unroll
  for (int dir = 0; dir < 2; ++dir)
#pragma unroll
    for (int k2 = 0; k2 < 2; ++k2) af[dir][k2] = *(const bf16x8*)(sA + dir * 64 * 72 + (16 * w + c) * 72 + 32 * k2 + 8 * g);
  bf16_t* sO = (bf16_t*)smem;
#pragma unroll 4
  for (int vt = 0; vt < 16; ++vt) {
    f32x4 a = zero4();
#pragma unroll
    for (int k2 = 0; k2 < 2; ++k2) {
      bf16x8 vfr = *(const bf16x8*)(p.VtE + (size_t)(h * 256 + 16 * vt + c) * T_TOK + tokc + 32 * k2 + 8 * g);
      a = mfma16(af[0][k2], vfr, a);
      a = mfma16(af[1][k2], vfr, a);
    }
#pragma unroll
    for (int j = 0; j < 4; ++j) sO[(16 * w + 4 * g + j) * 264 + 16 * vt + c] = f2bf(a[j]);
  }
  __syncthreads();
#pragma unroll
  for (int i = 0; i < 8; ++i) {
    const int id = tid + 256 * i;
    const int row = id >> 5, c8 = id & 31;
    *(bf16x8*)(p.TMP + (size_t)(tokc + row) * 1024 + h * 256 + 8 * c8) = *(const bf16x8*)(sO + row * 264 + 8 * c8);
  }
}

__device__ __forceinline__ void lds_barrier() { asm volatile("s_waitcnt lgkmcnt(0)\n\ts_barrier" ::: "memory"); }

struct GlaRegs {
  bf16x8 aq[4];
  bf16x8 vf[2][2];
  bf16x8 kf[2][2];
  float eb[2];
  unsigned told[2][4];
};

template <int DIR>
__device__ __forceinline__ void gla_chain_load(const Params& p, int h, int sl, int tokc, int w, int c, int g, GlaRegs& r) {
  const bf16_t* QE = DIR ? p.QEb : p.Qb;
  const bf16_t* KdT = DIR ? p.KdTb : p.Kt;
#pragma unroll
  for (int ks = 0; ks < 4; ++ks) r.aq[ks] = *(const bf16x8*)(QE + (size_t)(tokc + 16 * w + c) * 512 + h * 128 + 32 * ks + 8 * g);
#pragma unroll
  for (int vt = 0; vt < 2; ++vt)
#pragma unroll
    for (int k2 = 0; k2 < 2; ++k2)
      r.vf[vt][k2] = *(const bf16x8*)(p.VtE + (size_t)(h * 256 + sl * 32 + 16 * vt + c) * T_TOK + tokc + 32 * k2 + 8 * g);
#pragma unroll
  for (int dt = 0; dt < 2; ++dt) {
#pragma unroll
    for (int k2 = 0; k2 < 2; ++k2)
      r.kf[dt][k2] = *(const bf16x8*)(KdT + (size_t)(h * 128 + 32 * w + 16 * dt + c) * T_TOK + tokc + 32 * k2 + 8 * g);
    r.eb[dt] = p.EB[(size_t)(DIR * 1280 + (tokc >> 6)) * 512 + h * 128 + 32 * w + 16 * dt + c];
  }
#pragma unroll
  for (int vt = 0; vt < 2; ++vt)
#pragma unroll
    for (int j = 0; j < 4; ++j) r.told[vt][j] = p.TMP[(size_t)(tokc + 16 * w + 4 * g + j) * 1024 + h * 256 + sl * 32 + 16 * vt + c];
}

__device__ __forceinline__ void gla_chain_compute(const Params& p, int h, int sl, int tokc, int w, int c, int g, const GlaRegs& r,
                                                  f32x4 (&S)[2][2], bf16_t* sSt, bool dry, bool reload) {
  unsigned told[2][4];
#pragma unroll
  for (int vt = 0; vt < 2; ++vt)
#pragma unroll
    for (int j = 0; j < 4; ++j) told[vt][j] = r.told[vt][j];
  if (reload) {
#pragma unroll
    for (int vt = 0; vt < 2; ++vt)
#pragma unroll
      for (int j = 0; j < 4; ++j) told[vt][j] = p.TMP[(size_t)(tokc + 16 * w + 4 * g + j) * 1024 + h * 256 + sl * 32 + 16 * vt + c];
  }
#pragma unroll
  for (int vt = 0; vt < 2; ++vt)
#pragma unroll
    for (int dt = 0; dt < 2; ++dt)
#pragma unroll
      for (int j = 0; j < 4; ++j) sSt[(16 * vt + 4 * g + j) * 136 + 32 * w + 16 * dt + c] = f2bf(S[vt][dt][j]);
  lds_barrier();
  f32x4 o[2];
  o[0] = zero4(); o[1] = zero4();
#pragma unroll
  for (int ks = 0; ks < 4; ++ks)
#pragma unroll
    for (int vt = 0; vt < 2; ++vt) {
      bf16x8 sf = *(const bf16x8*)(sSt + (16 * vt + c) * 136 + 32 * ks + 8 * g);
      o[vt] = mfma16(r.aq[ks], sf, o[vt]);
    }
#pragma unroll
  for (int dt = 0; dt < 2; ++dt)
#pragma unroll
    for (int vt = 0; vt < 2; ++vt) {
      f32x4 a = S[vt][dt];
#pragma unroll
      for (int k2 = 0; k2 < 2; ++k2) a = mfma16(r.vf[vt][k2], r.kf[dt][k2], a);
      S[vt][dt] = a * r.eb[dt];
    }
#pragma unroll
  for (int vt = 0; vt < 2; ++vt)
#pragma unroll
    for (int j = 0; j < 4; ++j)
      if (!dry) p.TMP[(size_t)(tokc + 16 * w + 4 * g + j) * 1024 + h * 256 + sl * 32 + 16 * vt + c] = f2bf(bf2f((bf16_t)told[vt][j]) + o[vt][j]);
}

__device__ void gla_chain_item(const Params& p, int li, int item, char* smem, bool dry = false) {
  const int tid = otid(), lane = tid & 63, w = tid >> 6, c = lane & 15, g = lane >> 4;
  const int xr = item >> 3;
  const int pair = (item & 7) + 8 * (xr >> 3), sl = xr & 7;
  const int s = pair < 32 ? 4 + (pair >> 2) : ((pair - 32) >> 2);
  const int h = pair & 3;
  const int tok0 = s < 4 ? s * 4096 : T_P + (s - 4) * 8192;
  const int len = s < 4 ? 4096 : 8192;
  const int N = len / 64;
  bf16_t* sSt0 = (bf16_t*)smem;
  bf16_t* sSt1 = sSt0 + 32 * 136;
  f32x4 Sf[2][2], Sb[2][2];
#pragma unroll
  for (int a = 0; a < 2; ++a)
#pragma unroll
    for (int b = 0; b < 2; ++b) { Sf[a][b] = zero4(); Sb[a][b] = zero4(); }
  GlaRegs rf, rb;
  __syncthreads();
  gla_chain_load<0>(p, h, sl, tok0, w, c, g, rf);
  for (int step = 0; step < N; ++step) {
    const int tf = tok0 + step * 64, tb = tok0 + (N - 1 - step) * 64;
    gla_chain_load<1>(p, h, sl, tb, w, c, g, rb);
    gla_chain_compute(p, h, sl, tf, w, c, g, rf, Sf, sSt0, dry, step == (N >> 1));
    if (step + 1 < N) gla_chain_load<0>(p, h, sl, tf + 64, w, c, g, rf);
    gla_chain_compute(p, h, sl, tb, w, c, g, rb, Sb, sSt1, dry, false);
  }
}

__device__ void pool_item(const Params& p, int li, int item, char* smem, bool dry = false) {
  const int tid = otid(), lane = tid & 63, w = tid >> 6, c = lane & 15, g = lane >> 4;
  const int gi = item & 3;
  const int tile = item >> 2;
  const int tokc = tile * 64;
  const int pos0 = seq_pos(tokc);
  const int len = tokc < T_P ? 4096 : 8192;
  float* sU = (float*)smem;
  bf16_t* sP = (bf16_t*)(sU + 80 * 128);
  __syncthreads();
  for (int idx = tid; idx < 80 * 128; idx += 256) {
    int r = idx >> 7, ch = idx & 127;
    int pos = pos0 - 8 + r;
    float v = 0.f;
    if (pos >= 0 && pos < len) v = bf2f(p.PUb[(long)(tokc - 8 + r) * 512 + gi * 128 + ch]);
    sU[idx] = v;
  }
  __syncthreads();
  {
    const int ch = tid & 127, th = tid >> 7;
    const int half = 1 << gi;
    for (int t = th * 32; t < th * 32 + 32; ++t) {
      int pos = pos0 + t;
      int lo = max(pos - half, 0), hi = min(pos + half, len);
      float s = 0.f;
      for (int q = lo; q < hi; ++q) s += sU[(q - pos0 + 8) * 128 + ch];
      float pooled = s / (float)(hi - lo) - sU[(t + 8) * 128 + ch];
      sP[t * 136 + ch] = f2bf(pooled);
    }
  }
  __syncthreads();
  f32x4 acc[8];
#pragma unroll
  for (int dt = 0; dt < 8; ++dt) acc[dt] = zero4();
  const bf16_t* PW = p.PoolWT + (long)(li * 4 + gi) * 128 * 128;
#pragma unroll
  for (int ks = 0; ks < 4; ++ks) {
    bf16x8 af = *(const bf16x8*)(sP + (16 * w + c) * 136 + 32 * ks + 8 * g);
#pragma unroll
    for (int dt = 0; dt < 8; ++dt) {
      bf16x8 bw = *(const bf16x8*)(PW + (long)(16 * dt + c) * 128 + 32 * ks + 8 * g);
      acc[dt] = mfma16(af, bw, acc[dt]);
    }
  }
#pragma unroll
  for (int dt = 0; dt < 8; ++dt) {
    const int d = gi * 128 + 16 * dt + c;
    const float sc = p.e_pool_scale[li * 512 + d];
#pragma unroll
    for (int j = 0; j < 4; ++j) {
      const long addr = (long)(tokc + 16 * w + 4 * g + j) * 512 + d;
      float gt = bf2f(p.PGb[addr]);
      if (!dry) p.PGb[addr] = f2bf(acc[dt][j] * sc * siluf_(gt));
    }
  }
}

__device__ void ml_intra_item(const Params& p, int li, int item, char* smem) {
  const int tid = otid(), lane = tid & 63, w = tid >> 6, c = lane & 15, g = lane >> 4;
  const int ci = item >> 2, h = item & 3;
  const int tokc = ci * 64;
  const float kscale = 0.08838834764831845f;
  bf16_t* sA = (bf16_t*)smem;
  float* sBv = (float*)(sA + 2 * 64 * 72);
  float* sCB = sBv + 128;
  __syncthreads();
  if (w < 2) {
    const int dir = w;
    const float bi = p.o_if_bias[li * 16 + dir * 4 + h];
    const float bff = p.o_if_bias[li * 16 + 8 + dir * 4 + h];
    const float* mf = p.MIF + (size_t)(tokc + lane) * 16;
    const float liv = mf[dir * 4 + h] + bi;
    const float lfv = logsig_fast(mf[8 + dir * 4 + h] + bff);
    float ps = lfv;
#pragma unroll
    for (int d = 1; d < 64; d <<= 1) {
      float t = bperm(lane - d, ps);
      if (lane >= d) ps += t;
    }
    const float total = __int_as_float(__builtin_amdgcn_readlane(__float_as_int(ps), 63));
    const float b = (dir == 0) ? ps : (total - ps + lfv);
    const float cB = liv - b;
    sBv[dir * 64 + lane] = b;
    sCB[dir * 64 + lane] = cB;
    const size_t so = (size_t)(dir * 4 + h) * T_TOK + tokc + lane;
    p.EBI[so] = __expf(b);
    p.WKg[so] = __expf(total + cB) * kscale;
    if (lane == 0) p.DEC[(dir * 4 + h) * 1280 + ci] = __expf(total);
  }
  f32x4 accA[4];
#pragma unroll
  for (int jt = 0; jt < 4; ++jt) accA[jt] = zero4();
#pragma unroll
  for (int ks = 0; ks < 4; ++ks) {
    bf16x8 aq = *(const bf16x8*)(p.MQb + (size_t)(tokc + 16 * w + c) * 512 + h * 128 + 32 * ks + 8 * g);
#pragma unroll
    for (int jt = 0; jt < 4; ++jt) {
      bf16x8 bk = *(const bf16x8*)(p.MKb + (size_t)(tokc + 16 * jt + c) * 512 + h * 128 + 32 * ks + 8 * g);
      accA[jt] = mfma16(aq, bk, accA[jt]);
    }
  }
  __syncthreads();
#pragma unroll
  for (int dir = 0; dir < 2; ++dir)
#pragma unroll
    for (int jt = 0; jt < 4; ++jt)
#pragma unroll
      for (int j = 0; j < 4; ++j) {
        const int i = 16 * w + 4 * g + j, jj = 16 * jt + c;
        const bool keep = (dir == 0) ? (jj <= i) : (jj > i);
        const float sv = keep ? accA[jt][j] * kscale * __expf(sBv[dir * 64 + i] + sCB[dir * 64 + jj]) : 0.f;
        sA[dir * 64 * 72 + i * 72 + jj] = f2bf(sv);
      }
  __syncthreads();
  bf16x8 ones = zero8();
  if (c == 0) {
#pragma unroll
    for (int e = 0; e < 8; ++e) ones[e] = (short)0x3F80;
  }
#pragma unroll
  for (int dir = 0; dir < 2; ++dir) {
    bf16_t* NUMI = dir ? p.NUMIb : p.NUMIf;
    bf16x8 af[2];
#pragma unroll
    for (int k2 = 0; k2 < 2; ++k2) af[k2] = *(const bf16x8*)(sA + dir * 64 * 72 + (16 * w + c) * 72 + 32 * k2 + 8 * g);
    f32x4 dn = zero4();
    dn = mfma16(af[0], ones, dn);
    dn = mfma16(af[1], ones, dn);
    if (c == 0) {
#pragma unroll
      for (int j = 0; j < 4; ++j) p.DENI[(size_t)(dir * 4 + h) * T_TOK + tokc + 16 * w + 4 * g + j] = dn[j];
    }
    bf16_t* sO = sA + 2 * 64 * 72 + 512;
#pragma unroll 4
    for (int vt = 0; vt < 8; ++vt) {
      f32x4 a = zero4();
#pragma unroll
      for (int k2 = 0; k2 < 2; ++k2) {
        bf16x8 vfr = *(const bf16x8*)(p.MVt + (size_t)(h * 128 + 16 * vt + c) * T_TOK + tokc + 32 * k2 + 8 * g);
        a = mfma16(af[k2], vfr, a);
      }
#pragma unroll
      for (int j = 0; j < 4; ++j) sO[(16 * w + 4 * g + j) * 136 + 16 * vt + c] = f2bf(a[j]);
    }
    __syncthreads();
#pragma unroll
    for (int i = 0; i < 4; ++i) {
      const int id = tid + 256 * i;
      const int row = id >> 4, c8 = id & 15;
      *(bf16x8*)(NUMI + (size_t)(tokc + row) * 512 + h * 128 + 8 * c8) = *(const bf16x8*)(sO + row * 136 + 8 * c8);
    }
    __syncthreads();
  }
}

struct MlRegs {
  bf16x8 aq[4];
  bf16x8 vf[2];
  bf16x8 kf[2][2];
  f32x4 wk[2][2];
  f32x4 ebi, deni;
  float dec;
  unsigned numi[4];
};

template <int DIR>
__device__ __forceinline__ void ml_chain_load(const Params& p, int h, int sl, int tokc, int w, int c, int g, MlRegs& r) {
#pragma unroll
  for (int ks = 0; ks < 4; ++ks) r.aq[ks] = *(const bf16x8*)(p.MQb + (size_t)(tokc + 16 * w + c) * 512 + h * 128 + 32 * ks + 8 * g);
#pragma unroll
  for (int k2 = 0; k2 < 2; ++k2)
    r.vf[k2] = *(const bf16x8*)(p.MVt + (size_t)(h * 128 + sl * 16 + c) * T_TOK + tokc + 32 * k2 + 8 * g);
#pragma unroll
  for (int dt = 0; dt < 2; ++dt)
#pragma unroll
    for (int k2 = 0; k2 < 2; ++k2)
      r.kf[dt][k2] = *(const bf16x8*)(p.MKt + (size_t)(h * 128 + 32 * w + 16 * dt + c) * T_TOK + tokc + 32 * k2 + 8 * g);
  const size_t so = (size_t)(DIR * 4 + h) * T_TOK + tokc;
#pragma unroll
  for (int k2 = 0; k2 < 2; ++k2) {
    r.wk[k2][0] = *(const f32x4*)(p.WKg + so + 32 * k2 + 8 * g);
    r.wk[k2][1] = *(const f32x4*)(p.WKg + so + 32 * k2 + 8 * g + 4);
  }
  r.ebi = *(const f32x4*)(p.EBI + so + 16 * w + 4 * g);
  r.deni = *(const f32x4*)(p.DENI + so + 16 * w + 4 * g);
  r.dec = p.DEC[(DIR * 4 + h) * 1280 + (tokc >> 6)];
  const bf16_t* NUMI = DIR ? p.NUMIb : p.NUMIf;
#pragma unroll
  for (int j = 0; j < 4; ++j) r.numi[j] = NUMI[(size_t)(tokc + 16 * w + 4 * g + j) * 512 + h * 128 + sl * 16 + c];
}

template <int DIR>
__device__ __forceinline__ void ml_chain_compute(const Params& p, int h, int sl, int tokc, int lane, int w, int c, int g, const MlRegs& r,
                                                 f32x4 (&C)[2][2], bf16_t* sCt, bool dry) {
  bf16_t* NUMI = DIR ? p.NUMIb : p.NUMIf;
  unsigned numi[4];
#pragma unroll
  for (int j = 0; j < 4; ++j) numi[j] = r.numi[j];
#pragma unroll
  for (int vt = 0; vt < 2; ++vt)
#pragma unroll
    for (int dt = 0; dt < 2; ++dt)
#pragma unroll
      for (int j = 0; j < 4; ++j) sCt[(16 * vt + 4 * g + j) * 136 + 32 * w + 16 * dt + c] = f2bf(C[vt][dt][j]);
  bf16x8 vfw[2][2];
#pragma unroll
  for (int k2 = 0; k2 < 2; ++k2) {
    float wv[8];
#pragma unroll
    for (int e = 0; e < 4; ++e) { wv[e] = r.wk[k2][0][e]; wv[4 + e] = r.wk[k2][1][e]; }
#pragma unroll
    for (int e = 0; e < 8; ++e) vfw[0][k2][e] = (short)f2bf(bf2f((bf16_t)r.vf[k2][e]) * wv[e]);
#pragma unroll
    for (int e = 0; e < 8; ++e) vfw[1][k2][e] = (c == 0) ? (short)f2bf(wv[e]) : (short)0;
  }
  lds_barrier();
  f32x4 o2[2];
  o2[0] = zero4(); o2[1] = zero4();
#pragma unroll
  for (int ks = 0; ks < 4; ++ks)
#pragma unroll
    for (int vt = 0; vt < 2; ++vt) {
      bf16x8 cf = *(const bf16x8*)(sCt + (16 * vt + c) * 136 + 32 * ks + 8 * g);
      o2[vt] = mfma16(r.aq[ks], cf, o2[vt]);
    }
#pragma unroll
  for (int dt = 0; dt < 2; ++dt)
#pragma unroll
    for (int vt = 0; vt < 2; ++vt) {
      f32x4 a = C[vt][dt] * r.dec;
#pragma unroll
      for (int k2 = 0; k2 < 2; ++k2) a = mfma16(vfw[vt][k2], r.kf[dt][k2], a);
      C[vt][dt] = a;
    }
#pragma unroll
  for (int j = 0; j < 4; ++j) {
    const float e = r.ebi[j];
    float den = e * o2[1][j];
    den = dpp_f<0x150>(den) + r.deni[j];
    const float inv = 1.f / fmaxf(fabsf(den), 1.f);
    const float hv = (bf2f((bf16_t)numi[j]) + e * o2[0][j]) * inv;
    if (!dry) NUMI[(size_t)(tokc + 16 * w + 4 * g + j) * 512 + h * 128 + sl * 16 + c] = f2bf(hv);
  }
}

template <int DIR>
__device__ __forceinline__ void ml_chain_run(const Params& p, int h, int sl, int tok0, int N, int lane, int w, int c, int g, bf16_t* sCt0, bool dry) {
  bf16_t* sCt1 = sCt0 + 32 * 136;
  f32x4 C[2][2];
#pragma unroll
  for (int a = 0; a < 2; ++a)
#pragma unroll
    for (int b = 0; b < 2; ++b) C[a][b] = zero4();
  MlRegs r0, r1;
  ml_chain_load<DIR>(p, h, sl, tok0 + (DIR ? N - 1 : 0) * 64, w, c, g, r0);
  for (int n = 0; n < N; n += 2) {
    const int c0 = DIR ? N - 1 - n : n;
    const int c1 = DIR ? N - 2 - n : n + 1;
    const int n2 = min(n + 2, N - 1);
    const int c2 = DIR ? N - 1 - n2 : n2;
    ml_chain_load<DIR>(p, h, sl, tok0 + c1 * 64, w, c, g, r1);
    ml_chain_compute<DIR>(p, h, sl, tok0 + c0 * 64, lane, w, c, g, r0, C, sCt0, dry);
    ml_chain_load<DIR>(p, h, sl, tok0 + c2 * 64, w, c, g, r0);
    ml_chain_compute<DIR>(p, h, sl, tok0 + c1 * 64, lane, w, c, g, r1, C, sCt1, dry);
  }
}

__device__ void ml_chain_item(const Params& p, int li, int item, char* smem, bool dry = false) {
  const int tid = otid(), lane = tid & 63, w = tid >> 6, c = lane & 15, g = lane >> 4;
  int pair, within;
  if (item < 512) { const int r = item >> 3; pair = (item & 7) + 8 * (r >> 4); within = r & 15; }
  else { const int it = item - 512; const int r = it >> 3; pair = 32 + (it & 7) + 8 * (r >> 4); within = r & 15; }
  const int sl = within & 7, dir = within >> 3;
  const int s = pair < 32 ? 4 + (pair >> 2) : ((pair - 32) >> 2);
  const int h = pair & 3;
  const int tok0 = s < 4 ? s * 4096 : T_P + (s - 4) * 8192;
  const int N = (s < 4 ? 4096 : 8192) / 64;
  bf16_t* sCt0 = (bf16_t*)smem;
  __syncthreads();
  if (dir == 0) ml_chain_run<0>(p, h, sl, tok0, N, lane, w, c, g, sCt0, dry);
  else ml_chain_run<1>(p, h, sl, tok0, N, lane, w, c, g, sCt0, dry);
}

#define ATTN_GLOAD(KT)                                                                              \
  {                                                                                                 \
    const long kb = tok0 + (KT) * 64;                                                               \
    rk0 = *(const bf16x8*)(p.KNb + (kb + (tid >> 3)) * 512 + head * 64 + 8 * (tid & 7));            \
    rk1 = *(const bf16x8*)(p.KNb + (kb + 32 + (tid >> 3)) * 512 + head * 64 + 8 * (tid & 7));       \
    rkr = *(const bf16x8*)(p.KRb + (kb + (tid >> 2)) * 32 + 8 * (tid & 3));                          \
    rv0 = *(const bf16x8*)(p.VtA + (long)(head * 64 + (tid >> 3)) * T_TOK + kb + 8 * (tid & 7));     \
    rv1 = *(const bf16x8*)(p.VtA + (long)(head * 64 + 32 + (tid >> 3)) * T_TOK + kb + 8 * (tid & 7)); \
  }
__device__ void attn_item(const Params& p, int item, char* smem, bool dry = false) {
  const int tid = otid(), lane = tid & 63, w = tid >> 6, c = lane & 15, g = lane >> 4;
  int s, head, qb;
  {
    const int x = item / 320, t = item % 320;
    if (t < 256) { const int pair = x + 8 * (t >> 5); qb = t & 31; s = 4 + (pair >> 3); head = pair & 7; }
    else { const int t2 = t - 256; const int pair = x + 8 * (t2 >> 4); qb = t2 & 15; s = pair >> 3; head = pair & 7; }
  }
  const int tok0 = s < 4 ? s * 4096 : T_P + (s - 4) * 8192;
  const int len = s < 4 ? 4096 : 8192;
  const int nkv = len / 64;
  constexpr int KV_STAGE = 64 * 104 + 64 * 72;
  bf16_t* sKV = (bf16_t*)smem;
  const int qrow0 = tok0 + qb * 256 + 64 * w;
  bf16_t* sQr = sKV + 2 * KV_STAGE;
  bf16x8 qf[4][3];
#pragma unroll
  for (int nt = 0; nt < 4; ++nt)
#pragma unroll
    for (int ks = 0; ks < 3; ++ks)
      qf[nt][ks] = *(const bf16x8*)(p.Qa + (long)(qrow0 + 16 * nt + c) * 768 + head * 96 + 32 * ks + 8 * g);
  f32x4 ot[4][4];
#pragma unroll
  for (int vt = 0; vt < 4; ++vt)
#pragma unroll
    for (int nt = 0; nt < 4; ++nt) ot[vt][nt] = zero4();
  float mrun[4] = {-64.f, -64.f, -64.f, -64.f}, lrun[4] = {0.f, 0.f, 0.f, 0.f};
  bf16x8 rk0, rk1, rkr, rv0, rv1;
#define ATTN_LSTORE(STG)                                                                    \
  {                                                                                         \
    bf16_t* sK_ = sKV + (STG) * KV_STAGE;                                                   \
    bf16_t* sVt_ = sK_ + 64 * 104;                                                          \
    *(bf16x8*)(sK_ + (tid >> 3) * 104 + 8 * (tid & 7)) = rk0;                               \
    *(bf16x8*)(sK_ + (32 + (tid >> 3)) * 104 + 8 * (tid & 7)) = rk1;                        \
    *(bf16x8*)(sK_ + (tid >> 2) * 104 + 64 + 8 * (tid & 3)) = rkr;                          \
    *(bf16x8*)(sVt_ + (tid >> 3) * 72 + 8 * (tid & 7)) = rv0;                               \
    *(bf16x8*)(sVt_ + (32 + (tid >> 3)) * 72 + 8 * (tid & 7)) = rv1;                        \
  }
  ATTN_GLOAD(0)
  __syncthreads();
  ATTN_LSTORE(0)
  __syncthreads();
#pragma unroll 2
  for (int kt = 0; kt < nkv; ++kt) {
    const bf16_t* sK = sKV + (kt & 1) * KV_STAGE;
    const bf16_t* sVt = sK + 64 * 104;
    ATTN_GLOAD(min(kt + 1, nkv - 1))
#pragma unroll 1
    for (int half = 0; half < 2; ++half) {
      f32x4 st[2][4];
#pragma unroll
      for (int k4 = 0; k4 < 2; ++k4)
#pragma unroll
        for (int nt = 0; nt < 4; ++nt) {
          const float nm = -mrun[nt];
          f32x4 iv = {nm, nm, nm, nm};
          st[k4][nt] = iv;
        }
#pragma unroll
      for (int ks = 0; ks < 2; ++ks)
#pragma unroll
        for (int k4 = 0; k4 < 2; ++k4) {
          bf16x8 kf = *(const bf16x8*)(sK + (32 * half + 16 * k4 + c) * 104 + 32 * ks + 8 * g);
#pragma unroll
          for (int nt = 0; nt < 4; ++nt) st[k4][nt] = mfma16(kf, qf[nt][ks], st[k4][nt]);
        }
      {
        bf16x8 kr0 = *(const bf16x8*)(sK + (32 * half + c) * 104 + 64 + 8 * g);
        bf16x8 kr1 = *(const bf16x8*)(sK + (32 * half + 16 + c) * 104 + 64 + 8 * g);
#pragma unroll
        for (int nt = 0; nt < 4; ++nt) {
          st[0][nt] = mfma16(kr0, qf[nt][2], st[0][nt]);
          st[1][nt] = mfma16(kr1, qf[nt][2], st[1][nt]);
        }
      }
      bf16x8 pb[4];
#pragma unroll
      for (int nt = 0; nt < 4; ++nt) {
        float mx = -1e30f;
#pragma unroll
        for (int k4 = 0; k4 < 2; ++k4)
#pragma unroll
          for (int j = 0; j < 4; ++j) mx = fmaxf(mx, st[k4][nt][j]);
        mx = rowmax4(mx);
        if (__builtin_amdgcn_ballot_w64(mx > 0.f) != 0ull) {
          const float d = fmaxf(mx, 0.f);
          const float alpha = __builtin_amdgcn_exp2f(-d);
          mrun[nt] += d;
          lrun[nt] *= alpha;
#pragma unroll
          for (int vt = 0; vt < 4; ++vt) ot[vt][nt] = ot[vt][nt] * alpha;
#pragma unroll
          for (int k4 = 0; k4 < 2; ++k4)
#pragma unroll
            for (int j = 0; j < 4; ++j) st[k4][nt][j] -= d;
        }
        float psum = 0.f;
#pragma unroll
        for (int k4 = 0; k4 < 2; ++k4)
#pragma unroll
          for (int j = 0; j < 4; ++j) {
            float pv = __builtin_amdgcn_exp2f(st[k4][nt][j]);
            st[k4][nt][j] = pv;
            psum += pv;
          }
        lrun[nt] += psum;
        typedef __attribute__((ext_vector_type(4))) unsigned u32x4;
        u32x4 pk;
        pk[0] = pk2bf(st[0][nt][0], st[0][nt][1]);
        pk[1] = pk2bf(st[0][nt][2], st[0][nt][3]);
        pk[2] = pk2bf(st[1][nt][0], st[1][nt][1]);
        pk[3] = pk2bf(st[1][nt][2], st[1][nt][3]);
        pb[nt] = __builtin_bit_cast(bf16x8, pk);
      }
#pragma unroll
      for (int vt = 0; vt < 4; ++vt) {
        us4 lo = *(const us4*)(sVt + (16 * vt + c) * 72 + 32 * half + 4 * g);
        us4 hi = *(const us4*)(sVt + (16 * vt + c) * 72 + 32 * half + 16 + 4 * g);
        bf16x8 av;
#pragma unroll
        for (int e = 0; e < 4; ++e) { av[e] = (short)lo[e]; av[4 + e] = (short)hi[e]; }
#pragma unroll
        for (int nt = 0; nt < 4; ++nt) ot[vt][nt] = mfma16(av, pb[nt], ot[vt][nt]);
      }
    }
    if (kt + 1 < nkv) ATTN_LSTORE((kt + 1) & 1)
    __syncthreads();
  }
#undef ATTN_LSTORE
#pragma unroll
  for (int nt = 0; nt < 4; ++nt) {
    float lt = lrun[nt];
    lt += sxor(lt, 16, lane);
    lt += sxor(lt, 32, lane);
    const float inv = 1.f / lt;
    const long tok = qrow0 + 16 * nt + c;
#pragma unroll
    for (int vt = 0; vt < 4; ++vt) {
      bf16_t* gp = p.MGb + tok * 512 + head * 64 + 16 * vt + 4 * g;
      us4 gt = *(const us4*)gp;
      us4 o;
#pragma unroll
      for (int j = 0; j < 4; ++j) o[j] = f2bf(ot[vt][nt][j] * inv * siluf_(bf2f(gt[j])));
      if (!dry) *(us4*)gp = o;
    }
  }
}

__device__ void phase_gla_combine(const Params& p, int li, bool dry = false) {
  const int tid_ = otid(); const int lane = tid_ & 63, w = tid_ >> 6;
#pragma unroll 2
  for (int tok = blockIdx.x * 4 + w; tok < T_TOK; tok += gridDim.x * 4) {
    const bf16_t* tp = p.TMP + (long)tok * 1024 + 16 * lane;
    bf16_t* gp = p.Gb + (long)tok * 1024 + 16 * lane;
    bf16x8 o0 = *(const bf16x8*)tp, o1 = *(const bf16x8*)(tp + 8);
    bf16x8 g0 = *(const bf16x8*)gp, g1 = *(const bf16x8*)(gp + 8);
    float ov[16], gv[16];
#pragma unroll
    for (int e = 0; e < 8; ++e) {
      ov[e] = bf2f((bf16_t)o0[e]); ov[8 + e] = bf2f((bf16_t)o1[e]);
      gv[e] = bf2f((bf16_t)g0[e]); gv[8 + e] = bf2f((bf16_t)g1[e]);
    }
    float ss = 0.f;
#pragma unroll
    for (int e = 0; e < 16; ++e) ss += ov[e] * ov[e];
    ss = row_sum16(ss);
    const float rs = rsqrtf(ss * (1.f / 256.f) + EPS);
    const float* ng = p.e_gla_norm_g + li * 256 + ((16 * lane) & 255);
    bf16x8 r0, r1;
#pragma unroll
    for (int e = 0; e < 8; ++e) {
      r0[e] = (short)f2bf(ov[e] * rs * ng[e] * siluf_(gv[e]));
      r1[e] = (short)f2bf(ov[8 + e] * rs * ng[8 + e] * siluf_(gv[8 + e]));
    }
    if (!dry) { *(bf16x8*)gp = r0;
    *(bf16x8*)(gp + 8) = r1; }
  }
}

__device__ void phase_ml_combine(const Params& p, int li, bool dry = false) {
  const int tid_ = otid(); const int lane = tid_ & 63, w = tid_ >> 6;
#pragma unroll 2
  for (int tok = blockIdx.x * 4 + w; tok < T_TOK; tok += gridDim.x * 4) {
    const long off = (long)tok * 512 + 8 * lane;
    bf16x8 hv = *(const bf16x8*)(p.NUMIf + off);
    bf16x8 hb = *(const bf16x8*)(p.NUMIb + off);
    bf16x8 mo = *(const bf16x8*)(p.MOb + off);
    bf16x8 mg = *(const bf16x8*)(p.MLGb + off);
    float hf[8];
    float ss = 0.f;
#pragma unroll
    for (int e = 0; e < 8; ++e) { hf[e] = bf2f((bf16_t)hv[e]) + bf2f((bf16_t)hb[e]); ss += hf[e] * hf[e]; }
    ss = row_sum16(ss);
    const float rs = rsqrtf(ss * (1.f / 128.f) + EPS);
    const float* ng = p.o_ml_norm_g + li * 128 + ((8 * lane) & 127);
    bf16x8 r;
#pragma unroll
    for (int e = 0; e < 8; ++e)
      r[e] = (short)f2bf(hf[e] * rs * ng[e] * sigmoidf_(bf2f((bf16_t)mo[e])) * siluf_(bf2f((bf16_t)mg[e])));
    if (!dry) *(bf16x8*)(p.MLGb + off) = r;
  }
}

__device__ void phase_final(const Params& p, bool dry = false) {
  const int tid_ = otid(); const int lane = tid_ & 63, w = tid_ >> 6;
#pragma unroll 2
  for (int tok = blockIdx.x * 4 + w; tok < T_TOK; tok += gridDim.x * 4) {
    float* xp = p.out + (long)tok * DM;
    float4 v[4];
    float ss = 0.f;
#pragma unroll
    for (int i = 0; i < 4; ++i) {
      v[i] = *(const float4*)(xp + 4 * lane + 256 * i);
      ss += v[i].x * v[i].x + v[i].y * v[i].y + v[i].z * v[i].z + v[i].w * v[i].w;
    }
    ss = wave_sum(ss);
    const float rs = rsqrtf(ss * (1.f / 1024.f) + EPS);
#pragma unroll
    for (int i = 0; i < 4; ++i) {
      float4 gq = *(const float4*)(p.final_norm_g + 4 * lane + 256 * i);
      float4 o;
      o.x = v[i].x * rs * gq.x; o.y = v[i].y * rs * gq.y; o.z = v[i].z * rs * gq.z; o.w = v[i].w * rs * gq.w;
      if (!dry) *(float4*)(xp + 4 * lane + 256 * i) = o;
    }
  }
}

__device__ void run_phase(const Params& p, int ph, char* smem) {
  if (ph == 0) { if (PH_ON(0)) phase_prep(p, smem); return; }
  if (ph == NPHASE - 1) { if (PROBE_B) phase_final(p, true); if (PH_ON(11)) phase_final(p); return; }
  const int q = ph - 1;
  const int layer = (q < 5) ? 0 : (q < 11) ? 1 : (q < 16) ? 2 : 3;
  const int sub = (q < 5) ? q : (q < 11) ? q - 5 : (q < 16) ? q - 11 : q - 16;
  const int li = layer >> 1;
  const float* xa = (layer == 0) ? p.x_prompt : p.out;
  const float* xb = (layer == 0) ? p.x_sample : p.out + (long)T_P * DM;
  if ((layer & 1) == 0) {
    if (sub == 0) {
      EpiEvenIn e{p.Qb, p.Kt, p.VtE, p.Gb, p.LRb, p.PUb, p.PGb};
      if (PH_ON(1)) gemm_phase<3, 8>(T_TOK / 128, NE_PAD / 256, DM, p.WinE + (long)li * NE_PAD * DM, p.SSQ, nullptr, p.TMP, DM, DM, p.TMP, DM, e, smem);
    } else if (sub == 1) {
      for (int item = blockIdx.x; item < 5120; item += gridDim.x)
        if (PH_ON(2)) gla_intra_item(p, li, item, smem);
    } else if (sub == 2) {
      __shared__ int s_pitem;
      for (int item = blockIdx.x; item < 384; item += gridDim.x) { if (PH_ON(2)) gla_chain_item(p, li, item, smem, false); }
      for (;;) {
        __syncthreads();
        if (threadIdx.x == 0) s_pitem = atomicAdd(p.counters + 16 + li, 1);
        __syncthreads();
        const int item = s_pitem;
        if (item >= 5120) break;
        if (PH_ON(3)) pool_item(p, li, item, smem);
      }
    } else if (sub == 3) {
      if (PROBE_B) phase_gla_combine(p, li, true);
      if (PH_ON(4)) phase_gla_combine(p, li);
    } else {
      EpiOut e{xa, xb, p.out, false, p.NUMIf, p.SSQ};
      if (PH_ON(5)) gemm_phase<1, 8>(T_TOK / 128, DM / 256, 1536, p.WoutE + (long)li * DM * 1536, nullptr, nullptr, p.Gb, 1024, 1024, p.PGb, 512, e, smem);
    }
  } else {
    if (sub == 0) {
      EpiOddIn e{p.CQb, p.CKVb, p.KRb, p.MGb, p.MQb, p.MKb, p.MKt, p.MVt, p.MOb, p.MLGb, p.MIF};
      if (PH_ON(6)) gemm_phase<3, 8>(T_TOK / 128, NO_PAD / 256, DM, p.WinO + (long)li * NO_PAD * DM, p.SSQ, nullptr, p.NUMIf, DM, DM, p.NUMIf, DM, e, smem);
    } else if (sub == 1) {
      for (int rep = 0; rep < 1 + PROBE_A; ++rep)
      for (int item = blockIdx.x; item < 5120; item += gridDim.x)
        if (PH_ON(8)) ml_intra_item(p, li, item, smem);
    } else if (sub == 2) {
      for (int item = blockIdx.x; item < 768; item += gridDim.x)
        if (PH_ON(8)) ml_chain_item(p, li, item, smem, false);
    } else if (sub == 3) {
      if (PH_ON(10)) phase_ml_combine(p, li);
      EpiQUp eq{p.Qa};
      if (PH_ON(7)) gemm_phase<2, 4>(T_TOK / 128, 768 / 128, 384, p.QupT + (long)li * 768 * 384, nullptr, nullptr, p.CQb, 384, 384, p.CQb, 384, eq, smem);
      EpiKVUp ek{p.KNb, p.VtA};
      if (PH_ON(7)) gemm_phase<2, 4>(T_TOK / 128, 1024 / 128, 256, p.KVupT + (long)li * 1024 * 256, nullptr, nullptr, p.CKVb, 256, 256, p.CKVb, 256, ek, smem);
    } else if (sub == 4) {
      __shared__ int s_item;
      for (;;) {
        __syncthreads();
        if (threadIdx.x == 0) s_item = atomicAdd(p.counters + li * 8 + (blockIdx.x & 7), 1);
        __syncthreads();
        const int item = s_item;
        if (item >= 320) break;
        if (PH_ON(9)) attn_item(p, (blockIdx.x & 7) * 320 + item, smem);
      }
    } else {
      EpiOut e{xa, xb, p.out, false, (layer == 3) ? nullptr : p.TMP, p.SSQ};
      if (PH_ON(5)) gemm_phase<1, 8>(T_TOK / 128, DM / 256, 1024, p.WoutO + (long)li * DM * 1024, nullptr, nullptr, p.MGb, 512, 512, p.MLGb, 512, e, smem);
    }
  }
}

__global__ void __launch_bounds__(256, 2) mega_kernel(Params p) {
  extern __shared__ __attribute__((aligned(16))) char smem[];
  cg::grid_group grid = cg::this_grid();
  __shared__ uint4 xb_words;
  if (threadIdx.x == 0) xb_words = make_uint4(0u, 0u, 0u, 0u);
  __syncthreads();
  XcdBarrier xb = xcd_barrier_post(p.bar, (volatile LAS unsigned*)&xb_words);
  for (int ph = p.ph_lo; ph < p.ph_hi; ++ph) {
    if (ph > p.ph_lo) {
      if (ph == p.ph_lo + 1) grid.sync();
      else xcd_barrier(xb);
    }
    run_phase(p, ph, smem);
  }
}

extern "C" void kernel_launch(void* const* d_in, const int* in_sizes, int n_in, void* d_out, int out_size, void* d_ws,
                              size_t ws_size, hipStream_t stream) {
  static int grid_blocks = 0;
  if (!grid_blocks) {
    int dev = 0, cus = 0, per_cu = 0;
    hipGetDevice(&dev);
    hipDeviceGetAttribute(&cus, hipDeviceAttributeMultiprocessorCount, dev);
    hipFuncSetAttribute((const void*)mega_kernel, hipFuncAttributeMaxDynamicSharedMemorySize, LDS_BYTES);
    hipOccupancyMaxActiveBlocksPerMultiprocessor(&per_cu, (const void*)mega_kernel, 256, LDS_BYTES);
    if (per_cu < 1) per_cu = 1;
    if (per_cu > 2) per_cu = 2;
    grid_blocks = cus * per_cu;
    fprintf(stderr, "kernel_launch: cus %d per_cu %d grid %d ws %zu\n", cus, per_cu, grid_blocks, ws_size);
  }
  Params p{};
  const float** pin = (const float**)&p;
  for (int i = 0; i < 19; ++i) pin[i] = (const float*)d_in[i];
  p.out = (float*)d_out;
  char* ws = (char*)d_ws;
  size_t off = 0;
  auto take = [&](size_t bytes) { char* r = ws + off; off += (bytes + 255) & ~(size_t)255; return r; };
  p.WinE = (bf16_t*)take((size_t)2 * NE_PAD * DM * 2);
  p.WinO = (bf16_t*)take((size_t)2 * NO_PAD * DM * 2);
  p.WoutE = (bf16_t*)take((size_t)2 * DM * 1536 * 2);
  p.WoutO = (bf16_t*)take((size_t)2 * DM * 1024 * 2);
  p.QupT = (bf16_t*)take((size_t)2 * 768 * 384 * 2);
  p.KVupT = (bf16_t*)take((size_t)2 * 1024 * 256 * 2);
  p.PoolWT = (bf16_t*)take((size_t)2 * 4 * 128 * 128 * 2);
  p.AupT = (bf16_t*)take((size_t)2 * 2 * 512 * 32 * 2);
  p.counters = (int*)take(256);
  p.bar = (unsigned*)take((size_t)XCD_BAR_WORDS * 4);
  p.SSQ = (float*)take((size_t)T_TOK * 8 * 4);
  const size_t act0 = off;
  const size_t T = T_TOK;
  p.Gb = (bf16_t*)take(T * 1024 * 2);
  p.PGb = (bf16_t*)take(T * 512 * 2);
  p.Qb = (bf16_t*)take(T * 512 * 2);
  p.Kt = (bf16_t*)take(T * 512 * 2);
  p.QEb = (bf16_t*)take(T * 512 * 2);
  p.KdTb = (bf16_t*)take(T * 512 * 2);
  p.EB = (float*)take((size_t)2 * 1280 * 512 * 4);
  p.VtE = (bf16_t*)take(T * 1024 * 2);
  p.LRb = (bf16_t*)take(T * 32 * 2);
  p.PUb = (bf16_t*)take(T * 512 * 2);
  p.TMP = (bf16_t*)take(T * 1024 * 2);
  const size_t even_end = off;
  off = act0;
  p.MGb = (bf16_t*)take(T * 512 * 2);
  p.MLGb = (bf16_t*)take(T * 512 * 2);
  p.CQb = (bf16_t*)take(T * 384 * 2);
  p.CKVb = (bf16_t*)take(T * 256 * 2);
  p.KRb = (bf16_t*)take(T * 32 * 2);
  const size_t r2 = off;
  p.MQb = (bf16_t*)take(T * 512 * 2);
  p.MKb = (bf16_t*)take(T * 512 * 2);
  p.MKt = (bf16_t*)take(T * 512 * 2);
  p.MVt = (bf16_t*)take(T * 512 * 2);
  p.MOb = (bf16_t*)take(T * 512 * 2);
  p.NUMIf = (bf16_t*)take(T * 512 * 2);
  p.NUMIb = (bf16_t*)take(T * 512 * 2);
  p.MIF = (float*)take(T * 16 * 4);
  p.EBI = (float*)take(T * 8 * 4);
  p.WKg = (float*)take(T * 8 * 4);
  p.DENI = (float*)take(T * 8 * 4);
  p.DEC = (float*)take((size_t)8 * 1280 * 4);
  const size_t r2_end = off;
  off = r2;
  p.Qa = (bf16_t*)take(T * 768 * 2);
  p.KNb = (bf16_t*)take(T * 512 * 2);
  p.VtA = (bf16_t*)take(T * 512 * 2);
  if (off < r2_end) off = r2_end;
  const size_t odd_end = off;
  const size_t need = even_end > odd_end ? even_end : odd_end;
  if (need > ws_size) {
    fprintf(stderr, "kernel_launch: workspace too small: need %zu have %zu\n", need, ws_size);
    return;
  }
  hipMemsetAsync(p.bar, 0, (size_t)XCD_BAR_WORDS * 4, stream);
#if SINGLE_LAUNCH
  p.ph_lo = 0;
  p.ph_hi = NPHASE;
  void* args[] = {&p};
  hipError_t e = hipLaunchCooperativeKernel((const void*)mega_kernel, dim3(grid_blocks), dim3(256), args, LDS_BYTES, stream);
  if (e != hipSuccess) fprintf(stderr, "cooperative launch failed: %s (grid %d)\n", hipGetErrorString(e), grid_blocks);
#else
  for (int ph = 0; ph < NPHASE; ++ph) {
    p.ph_lo = ph;
    p.ph_hi = ph + 1;
    hipLaunchKernelGGL(mega_kernel, dim3(grid_blocks), dim3(256), LDS_BYTES, stream, p);
  }
#endif
}
```

```cpp
#include <hip/hip_runtime.h>
#include <hip/hip_cooperative_groups.h>
#include <cstdio>
namespace cg = cooperative_groups;

#ifndef SINGLE_LAUNCH
#define SINGLE_LAUNCH 1
#endif
#ifndef PHMASK
#define PHMASK 0xFFFF
#endif
#define PH_ON(b) ((PHMASK >> (b)) & 1)
#ifndef PROBE_GEMM
#define PROBE_GEMM 0
#endif
#ifndef PROBE_ATTN
#define PROBE_ATTN 0
#endif
#ifndef PROBE_CHAIN
#define PROBE_CHAIN 0
#endif
#ifndef PROBE_A
#define PROBE_A 0
#endif
#ifndef PROBE_B
#define PROBE_B 0
#endif
#ifndef PROBE_MLCHAIN
#define PROBE_MLCHAIN 0
#endif

typedef unsigned short bf16_t;
typedef __attribute__((ext_vector_type(8))) short bf16x8;
typedef __attribute__((ext_vector_type(4))) float f32x4;
typedef __attribute__((ext_vector_type(4))) unsigned short us4;

constexpr int T_TOK = 81920;
constexpr int T_P = 16384;
constexpr int DM = 1024;
constexpr int NE = 4128, NE_PAD = 4352;
constexpr int NO = 3760, NO_PAD = 3840;
constexpr float EPS = 1e-6f;
constexpr int NPHASE = 24;
constexpr int LDS_BYTES = 72 * 1024;

struct Params {
  const float *x_prompt, *x_sample, *norm_g, *final_norm_g, *e_w_in, *e_a_up, *e_a_bias, *e_gla_norm_g,
      *e_pool_w, *e_pool_scale, *e_w_out, *o_w_in, *o_q_norm_g, *o_q_up, *o_kv_norm_g, *o_kv_up, *o_if_bias,
      *o_ml_norm_g, *o_w_out;
  float* out;
  bf16_t *WinE, *WinO, *WoutE, *WoutO, *QupT, *KVupT, *PoolWT, *AupT;
  int* counters;
  unsigned* bar;
  float* SSQ;
  bf16_t *Qb, *Kt, *VtE, *Gb, *LRb, *PUb, *PGb, *TMP, *QEb, *KdTb;
  float* EB;
  bf16_t *CQb, *CKVb, *KRb, *MGb, *MQb, *MKb, *MKt, *MVt, *MOb, *MLGb, *NUMIf, *NUMIb, *Qa, *KNb, *VtA;
  float *MIF, *EBI, *WKg, *DENI, *DEC;
  int ph_lo, ph_hi;
};

typedef __bf16 hbf2 __attribute__((ext_vector_type(2)));
typedef float hf2 __attribute__((ext_vector_type(2)));
__device__ __forceinline__ bf16_t f2bf(float f) {
  __bf16 b = (__bf16)f;
  return __builtin_bit_cast(bf16_t, b);
}
__device__ __forceinline__ unsigned pk2bf(float a, float b) {
  hf2 v = {a, b};
  hbf2 r = __builtin_convertvector(v, hbf2);
  return __builtin_bit_cast(unsigned, r);
}
__device__ __forceinline__ float bf2f(bf16_t b) { return __uint_as_float(((unsigned)b) << 16); }
__device__ __forceinline__ f32x4 mfma16(bf16x8 a, bf16x8 b, f32x4 c) {
  return __builtin_amdgcn_mfma_f32_16x16x32_bf16(a, b, c, 0, 0, 0);
}
__device__ __forceinline__ float logsigmoidf_(float x) { return fminf(x, 0.f) - log1pf(__expf(-fabsf(x))); }
__device__ __forceinline__ float siluf_(float x) { return x / (1.f + __expf(-x)); }
__device__ __forceinline__ float sigmoidf_(float x) { return 1.f / (1.f + __expf(-x)); }
__device__ __forceinline__ int otid() { int t = threadIdx.x; asm volatile("" : "+v"(t)); return t; }
__device__ __forceinline__ float bperm(int srclane, float v) { return __int_as_float(__builtin_amdgcn_ds_bpermute(srclane << 2, __float_as_int(v))); }
__device__ __forceinline__ float sxor(float v, int m, int lane) { return bperm(lane ^ m, v); }
typedef unsigned u32x2_t __attribute__((ext_vector_type(2)));
__device__ __forceinline__ float rowmax4(float v) {
  u32x2_t r = __builtin_amdgcn_permlane16_swap(__float_as_uint(v), __float_as_uint(v), false, false);
  v = fmaxf(__uint_as_float(r[0]), __uint_as_float(r[1]));
  r = __builtin_amdgcn_permlane32_swap(__float_as_uint(v), __float_as_uint(v), false, false);
  return fmaxf(__uint_as_float(r[0]), __uint_as_float(r[1]));
}
template <int CTRL> __device__ __forceinline__ float dpp_f(float v) {
  return __int_as_float(__builtin_amdgcn_update_dpp(0, __float_as_int(v), CTRL, 0xf, 0xf, false));
}
__device__ __forceinline__ float row_sum16(float v) {
  v += dpp_f<0x128>(v);
  v += dpp_f<0x124>(v);
  v += dpp_f<0x122>(v);
  v += dpp_f<0x121>(v);
  return v;
}
__device__ __forceinline__ float wave_sum(float v) {
  v += dpp_f<0x128>(v);
  v += dpp_f<0x124>(v);
  v += dpp_f<0x122>(v);
  v += dpp_f<0x121>(v);
  u32x2_t r = __builtin_amdgcn_permlane16_swap(__float_as_uint(v), __float_as_uint(v), false, false);
  v = __uint_as_float(r[0]) + __uint_as_float(r[1]);
  r = __builtin_amdgcn_permlane32_swap(__float_as_uint(v), __float_as_uint(v), false, false);
  return __uint_as_float(r[0]) + __uint_as_float(r[1]);
}
__device__ __forceinline__ bf16x8 zero8() { bf16x8 z = {0, 0, 0, 0, 0, 0, 0, 0}; return z; }
__device__ __forceinline__ f32x4 zero4() { f32x4 z = {0.f, 0.f, 0.f, 0.f}; return z; }

__device__ __forceinline__ int seq_pos(int tok) { return tok < T_P ? (tok & 4095) : ((tok - T_P) & 8191); }
__device__ __forceinline__ const float* xrow(const float* xa, const float* xb, int tok) {
  return tok < T_P ? xa + (long)tok * DM : xb + (long)(tok - T_P) * DM;
}


#define XB_TMO      128
#define XB_XCNT(j)  (256  + 64 * (j))
#define XB_XSUB(j)  (1280 + 64 * (j))
#define XB_XGEN(j)  (2304 + 64 * (j))
#define XB_TOP      3328
#define XB_TOPGEN   3392
#define XCD_BAR_WORDS 3456
#define XB_SPIN_CAP (1u << 22)
#define LAS __attribute__((address_space(3)))
__device__ __forceinline__ unsigned xb_ld(unsigned* p) { return __hip_atomic_load(p, __ATOMIC_RELAXED, __HIP_MEMORY_SCOPE_AGENT); }
__device__ __forceinline__ unsigned xb_add(unsigned* p, unsigned v) { return __hip_atomic_fetch_add(p, v, __ATOMIC_RELAXED, __HIP_MEMORY_SCOPE_AGENT); }
__device__ __forceinline__ unsigned xb_xcc_id() { return (unsigned)__builtin_amdgcn_s_getreg((3 << 11) | 20) & 0xFu; }
#define XB_SPIN(cond, bar) do { unsigned _sp = 0; while (cond) { __builtin_amdgcn_s_sleep(1); \
    if ((++_sp & 255u) == 0u) { if (xb_ld(&(bar)[XB_TMO])) break; if (_sp > XB_SPIN_CAP) { atomicAdd(&(bar)[XB_TMO], 1u); break; } } } } while (0)
struct XcdBarrier { unsigned* bar; unsigned x; volatile LAS unsigned* st; };
__device__ __forceinline__ XcdBarrier xcd_barrier_post(unsigned* bar, volatile LAS unsigned* st) {
  XcdBarrier b; b.bar = bar; b.x = xb_xcc_id(); b.st = st;
  if (threadIdx.x == 0) (void)xb_add(&bar[XB_XCNT(b.x)], 1u);
  return b;
}
__device__ __forceinline__ void xcd_barrier_complete(unsigned* bar, unsigned x, unsigned& nloc, unsigned& nx) {
  const unsigned G = gridDim.x * gridDim.y * gridDim.z;
  unsigned sum, cnt, mine, sp = 0u;
  for (;;) {
    sum = 0u; cnt = 0u; mine = 0u;
#pragma unroll
    for (unsigned j = 0; j < 16; ++j) { const unsigned cc = xb_ld(&bar[XB_XCNT(j)]); sum += cc; cnt += (cc > 0u) ? 1u : 0u; mine = (j == x) ? cc : mine; }
    if (sum == G) break;
    __builtin_amdgcn_s_sleep(1);
    if ((++sp & 255u) == 0u) { if (xb_ld(&bar[XB_TMO])) break; if (sp > XB_SPIN_CAP) { atomicAdd(&bar[XB_TMO], 1u); break; } }
  }
  nloc = mine > 0u ? mine : 1u; nx = cnt > 0u ? cnt : 1u;
}
__device__ __forceinline__ void xcd_barrier(const XcdBarrier& b) {
  asm volatile("s_waitcnt vmcnt(0)" ::: "memory");
  __syncthreads();
  if (threadIdx.x == 0) {
    unsigned* bar = b.bar;
    __builtin_amdgcn_s_waitcnt(0);
    unsigned nloc = b.st[0], nx = b.st[1];
    if (nloc == 0u) { xcd_barrier_complete(bar, b.x, nloc, nx); b.st[0] = nloc; b.st[1] = nx; }
    const unsigned old = xb_add(&bar[XB_XSUB(b.x)], 1u);
    const unsigned gen = old / nloc;
    if (old + 1u == (gen + 1u) * nloc) {
      __builtin_amdgcn_fence(__ATOMIC_RELEASE, "agent");
      asm volatile("s_waitcnt vmcnt(0)" ::: "memory");
      const unsigned og = xb_add(&bar[XB_TOP], 1u);
      const unsigned tg = og / nx;
      if (og + 1u == (tg + 1u) * nx) xb_add(&bar[XB_TOPGEN], 1u);
      else XB_SPIN(xb_ld(&bar[XB_TOPGEN]) == tg, bar);
      __builtin_amdgcn_fence(__ATOMIC_ACQUIRE, "agent");
      xb_add(&bar[XB_XGEN(b.x)], 1u);
      asm volatile("s_waitcnt vmcnt(0)" ::: "memory");
    } else {
      XB_SPIN(xb_ld(&bar[XB_XGEN(b.x)]) == gen, bar);
      __builtin_amdgcn_fence(__ATOMIC_ACQUIRE, "agent");
      asm volatile("s_waitcnt vmcnt(0)" ::: "memory");
    }
  }
  __syncthreads();
}

__device__ __forceinline__ int colmap(int mode, int n) {
  if (mode == 1) {
    if (n < 512) return 2208 + n;
    if (n < 1024) return 1696 + (n - 512);
    if (n < 1408) return n - 1024;
    if (n < 1664) return 384 + (n - 1408);
    if (n < 2176) return 672 + (n - 1664);
    if (n < 2688) return 1184 + (n - 2176);
    if (n < 3200) return 2720 + (n - 2688);
    if (n < 3712) return 3248 + (n - 3200);
    if (n < 3744) return 640 + (n - 3712);
    return 3232 + (n - 3744);
  }
  if (mode == 2) {
    if (n < 512) return (n >> 6) * 96 + (n & 63);
    const int r = n - 512;
    return (r >> 5) * 96 + 64 + (r & 31);
  }
  if (mode == 3) {
    if (n < 512) return (n >> 6) * 128 + (n & 63);
    const int r = n - 512;
    return (r >> 6) * 128 + 64 + (r & 63);
  }
  return n;
}

__device__ void prep_weight(const float* __restrict__ W, int K, int N, int Npad, const float* __restrict__ gsc,
                            bf16_t* __restrict__ out, char* smem, int mode = 0, int Nsrc_ = 0) {
  const int Nsrc = Nsrc_ ? Nsrc_ : N;
  const int tid = otid();
  float* sT = (float*)smem;
  const int tn = Npad >> 6, tk = K >> 6;
  for (int tile = blockIdx.x; tile < tn * tk; tile += gridDim.x) {
    const int n0 = (tile / tk) << 6, k0 = (tile % tk) << 6;
    __syncthreads();
#pragma unroll 4
    for (int i = 0; i < 16; ++i) {
      const int idx = tid + 256 * i;
      const int kk = idx >> 6, nn = idx & 63;
      float v = 0.f;
      if (n0 + nn < N) {
        v = W[(size_t)(k0 + kk) * Nsrc + colmap(mode, n0 + nn)];
        if (gsc) v *= gsc[k0 + kk];
      }
      sT[nn * 65 + kk] = v;
    }
    __syncthreads();
#pragma unroll 4
    for (int i = 0; i < 16; ++i) {
      const int idx = tid + 256 * i;
      const int nn = idx >> 6, kk = idx & 63;
      out[(size_t)(n0 + nn) * K + k0 + kk] = f2bf(sT[nn * 65 + kk]);
    }
  }
}

__device__ void phase_prep(const Params& p, char* smem) {
  long gtid = (long)blockIdx.x * 256 + otid();
  long gsize = (long)gridDim.x * 256;
  for (int l = 0; l < 2; ++l) {
    prep_weight(p.e_w_in + (long)l * DM * NE, DM, NE, NE_PAD, p.norm_g + (2 * l) * DM, p.WinE + (long)l * NE_PAD * DM, smem);
    prep_weight(p.o_w_in + (long)l * DM * 3760, DM, NO, NO_PAD, p.norm_g + (2 * l + 1) * DM, p.WinO + (long)l * NO_PAD * DM, smem, 1, 3760);
    prep_weight(p.e_w_out + (long)l * 1536 * DM, 1536, DM, DM, nullptr, p.WoutE + (long)l * DM * 1536, smem);
    prep_weight(p.o_w_out + (long)l * 1024 * DM, 1024, DM, DM, nullptr, p.WoutO + (long)l * DM * 1024, smem);
    prep_weight(p.o_q_up + (long)l * 384 * 768, 384, 768, 768, p.o_q_norm_g + l * 384, p.QupT + (long)l * 768 * 384, smem, 2);
    prep_weight(p.o_kv_up + (long)l * 256 * 1024, 256, 1024, 1024, p.o_kv_norm_g + l * 256, p.KVupT + (long)l * 1024 * 256, smem, 3);
    for (int gi = 0; gi < 4; ++gi)
      prep_weight(p.e_pool_w + (long)(l * 4 + gi) * 128 * 128, 128, 128, 128, nullptr, p.PoolWT + (long)(l * 4 + gi) * 128 * 128, smem);
    for (long idx = gtid; idx < 2 * 512 * 32; idx += gsize) {
      int r = (int)(idx & 31);
      int d = (int)((idx >> 5) & 511);
      int dir = (int)(idx >> 14);
      float v = (r < 16) ? p.e_a_up[((long)(l * 2 + dir) * 16 + r) * 512 + d] : 0.f;
      p.AupT[((long)(l * 2 + dir) * 512 + d) * 32 + r] = f2bf(v);
    }
  }
  if (gtid < 32) p.counters[gtid] = 0;
  {
    const int tid_ = otid();
    const int lane = tid_ & 63, w = tid_ >> 6;
  #pragma unroll 2
  for (int tok = blockIdx.x * 4 + w; tok < T_TOK; tok += gridDim.x * 4) {
      const float* xp = xrow(p.x_prompt, p.x_sample, tok) + 16 * lane;
      float ssv = 0.f;
      unsigned pk[8];
#pragma unroll
      for (int i = 0; i < 4; ++i) {
        const f32x4 v = *(const f32x4*)(xp + 4 * i);
        ssv += v[0] * v[0] + v[1] * v[1] + v[2] * v[2] + v[3] * v[3];
        pk[2 * i] = pk2bf(v[0], v[1]);
        pk[2 * i + 1] = pk2bf(v[2], v[3]);
      }
      uint4 o0, o1;
      o0.x = pk[0]; o0.y = pk[1]; o0.z = pk[2]; o0.w = pk[3];
      o1.x = pk[4]; o1.y = pk[5]; o1.z = pk[6]; o1.w = pk[7];
      *(uint4*)(p.TMP + (size_t)tok * DM + 16 * lane) = o0;
      *(uint4*)(p.TMP + (size_t)tok * DM + 16 * lane + 8) = o1;
      ssv = wave_sum(ssv);
      if (lane < 8) p.SSQ[(size_t)tok * 8 + lane] = (lane == 0) ? ssv : 0.f;
    }
  }
}

constexpr int G_LD = 40;
constexpr int G_BUF = (128 + 256) * G_LD;

template <int AMODE, int NI, class Epi>
__device__ __forceinline__ void gemm_phase(int Mtiles, int Ntiles, int K, const bf16_t* __restrict__ Bt, const float* ssq, const float* unused_,
                           const bf16_t* A1, int ld1, int K1, const bf16_t* A2, int ld2, const Epi& epi, char* smem) {
  bf16_t* sbase = (bf16_t*)smem;
  float* sR = (float*)(smem + 70144);
  const int tid = otid(), lane = tid & 63, w = tid >> 6, c = lane & 15, g = lane >> 4;
  const int wm = w >> 1, wn = w & 1;
  const int nk = K / 32;
  const int xcd = blockIdx.x & 7, lb0 = blockIdx.x >> 3, nlb = gridDim.x >> 3;
  const int mper = Mtiles >> 3;
  for (int lt = lb0; lt < mper * Ntiles; lt += nlb) {
    const int mt = xcd * mper + lt / Ntiles, nt = lt % Ntiles;
    constexpr int BN = 32 * NI;
    const int m0 = mt * 128, n0 = nt * BN;
    f32x4 acc[4][NI];
#pragma unroll
    for (int i = 0; i < 4; ++i)
#pragma unroll
      for (int j = 0; j < NI; ++j) acc[i][j] = zero4();
    float ss[2] = {0.f, 0.f};
    bf16x8 ra0[2], ra1[2];
    bf16x8 rb0[NI / 2], rb1[NI / 2];
    const unsigned boff = (unsigned)(tid >> 2) * K + 8 * (tid & 3);
    const bf16_t* bbase = Bt + (size_t)n0 * K;
#define G_LOAD(RA, RB, KT)                                                                          \
  {                                                                                                 \
    const int k0_ = (KT) * 32;                                                                      \
    const bf16_t* base_;                                                                            \
    int ld_;                                                                                        \
    if (k0_ < K1) { base_ = A1 + (size_t)m0 * ld1 + k0_; ld_ = ld1; }                               \
    else { base_ = A2 + (size_t)m0 * ld2 + (k0_ - K1); ld_ = ld2; }                                 \
    _Pragma("unroll") for (int i = 0; i < 2; ++i)                                                   \
      RA[i] = *(const bf16x8*)(base_ + (unsigned)((tid >> 2) + 64 * i) * ld_ + 8 * (tid & 3));      \
    _Pragma("unroll") for (int i = 0; i < NI / 2; ++i)                                              \
      RB[i] = *(const bf16x8*)(bbase + k0_ + boff + (unsigned)(64 * i) * K);                        \
  }
#define G_STORE(RA, RB, BUF)                                                                        \
  {                                                                                                 \
    bf16_t* sA_ = sbase + (BUF) * G_BUF;                                                            \
    bf16_t* sB_ = sA_ + 128 * G_LD;                                                                 \
    _Pragma("unroll") for (int i = 0; i < 2; ++i) {                                                 \
      bf16x8 v = RA[i];                                                                             \
      if constexpr (AMODE == 2) {                                                                   \
        _Pragma("unroll") for (int e = 0; e < 8; ++e) {                                             \
          float f = bf2f((bf16_t)v[e]);                                                             \
          ss[i] += f * f;                                                                           \
        }                                                                                           \
      }                                                                                             \
      *(bf16x8*)(sA_ + ((tid >> 2) + 64 * i) * G_LD + 8 * (tid & 3)) = v;                           \
    }                                                                                               \
    _Pragma("unroll") for (int i = 0; i < NI / 2; ++i)                                              \
      *(bf16x8*)(sB_ + ((tid >> 2) + 64 * i) * G_LD + 8 * (tid & 3)) = RB[i];                       \
  }
#define G_COMPUTE(BUF)     \
  {                                                                                                 \
    const bf16_t* sA_ = sbase + (BUF) * G_BUF;                                                      \
    const bf16_t* sB_ = sA_ + 128 * G_LD;                                                           \
    bf16x8 af[4];                                                                                   \
    _Pragma("unroll") for (int mi = 0; mi < 4; ++mi)                                                \
      af[mi] = *(const bf16x8*)(sA_ + (wm * 64 + mi * 16 + c) * G_LD + g * 8);                      \
    bf16x8 bq[2];                                                                                   \
    bq[0] = *(const bf16x8*)(sB_ + (wn * (16 * NI) + c) * G_LD + g * 8);                            \
    _Pragma("unroll") for (int ni = 0; ni < NI; ++ni) {                                             \
      if (ni + 1 < NI)                                                                              \
        bq[(ni + 1) & 1] = *(const bf16x8*)(sB_ + (wn * (16 * NI) + (ni + 1) * 16 + c) * G_LD + g * 8); \
      _Pragma("unroll") for (int mi = 0; mi < 4; ++mi)                                              \
        acc[mi][ni] = (!Epi::staged) ? mfma16(bq[ni & 1], af[mi], acc[mi][ni]) : mfma16(af[mi], bq[ni & 1], acc[mi][ni]); \
    }                                                                                               \
  }
    __syncthreads();
    if constexpr (AMODE == 3) {
      if (tid < 128) {
        const f32x4 p0 = *(const f32x4*)(ssq + (size_t)(m0 + tid) * 8);
        const f32x4 p1 = *(const f32x4*)(ssq + (size_t)(m0 + tid) * 8 + 4);
        const float sv = (p0[0] + p0[1]) + (p0[2] + p0[3]) + (p1[0] + p1[1]) + (p1[2] + p1[3]);
        sR[tid] = rsqrtf(sv * (1.f / 1024.f) + EPS);
      }
    }
    G_LOAD(ra0, rb0, 0)
    G_LOAD(ra1, rb1, 1)
    G_STORE(ra0, rb0, 0)
    __syncthreads();
    for (int kt = 0; kt < nk; kt += 2) {
      G_LOAD(ra0, rb0, min(kt + 2, nk - 1))
      G_COMPUTE(0)
      G_STORE(ra1, rb1, 1)
      __syncthreads();
      G_LOAD(ra1, rb1, min(kt + 3, nk - 1))
      G_COMPUTE(1)
      if (kt + 2 < nk) G_STORE(ra0, rb0, 0)
      __syncthreads();
    }
    if constexpr (AMODE == 2) {
#pragma unroll
      for (int i = 0; i < 2; ++i) {
        float sv = ss[i];
        sv += sxor(sv, 1, lane); sv += sxor(sv, 2, lane);
        if ((tid & 3) == 0) sR[(tid >> 2) + 64 * i] = rsqrtf(sv / (float)K + EPS);
      }
      __syncthreads();
    }
    if constexpr (Epi::staged) {
      bf16_t* sT = sbase;
      const float esc = epi.scale();
      const bool both = epi.both(n0);
#pragma unroll 1
      for (int pass = 0; pass < (both ? 2 : 1); ++pass) {
      const bool tr = both ? (pass == 1) : epi.transposed(n0);
      if (pass) __syncthreads();
      if (tr) {
#pragma unroll
        for (int mi = 0; mi < 4; ++mi) {
          const int row = wm * 64 + mi * 16 + 4 * g;
          const float r0 = sR[row] * esc, r1 = sR[row + 1] * esc, r2 = sR[row + 2] * esc, r3 = sR[row + 3] * esc;
#pragma unroll
          for (int ni = 0; ni < NI; ++ni) {
            uint2 o;
            o.x = pk2bf(acc[mi][ni][0] * r0, acc[mi][ni][1] * r1);
            o.y = pk2bf(acc[mi][ni][2] * r2, acc[mi][ni][3] * r3);
            *(uint2*)(sT + (wn * (16 * NI) + ni * 16 + c) * 136 + row) = o;
          }
        }
      } else {
#pragma unroll
        for (int mi = 0; mi < 4; ++mi) {
          const int row = wm * 64 + mi * 16 + 4 * g;
          const float r0 = sR[row] * esc, r1 = sR[row + 1] * esc, r2 = sR[row + 2] * esc, r3 = sR[row + 3] * esc;
#pragma unroll
          for (int ni = 0; ni < NI; ++ni) {
            bf16_t* d = sT + row * (BN + 8) + wn * (16 * NI) + ni * 16 + c;
            d[0] = f2bf(acc[mi][ni][0] * r0);
            d[BN + 8] = f2bf(acc[mi][ni][1] * r1);
            d[2 * (BN + 8)] = f2bf(acc[mi][ni][2] * r2);
            d[3 * (BN + 8)] = f2bf(acc[mi][ni][3] * r3);
          }
        }
      }
      if (pass == 0) epi.template direct<NI>(m0, n0, wm, wn, g, c, acc, sR);
      __syncthreads();
      if (tr) {
#pragma unroll 4
        for (int i = 0; i < 2 * NI; ++i) {
          const int id = tid + 256 * i;
          const int col = id >> 4, rc = id & 15;
          bf16x8 v = *(const bf16x8*)(sT + col * 136 + 8 * rc);
          epi.store_t(m0 + 8 * rc, n0 + col, v);
        }
      } else {
#pragma unroll 4
        for (int i = 0; i < 2 * NI; ++i) {
          const int id = tid + 256 * i;
          const int row = id / (4 * NI), cc = id % (4 * NI);
          const bf16_t* sp = sT + row * (BN + 8) + 8 * cc;
          bf16x8 v = *(const bf16x8*)sp;
          epi.store_n(m0 + row, n0 + 8 * cc, v, sp);
        }
      }
      }
    } else {
      float* sF = (float*)smem;
#pragma unroll 1
      for (int half = 0; half < 2; ++half) {
        if (half) __syncthreads();
        if (wm == half) {
#pragma unroll
          for (int mi = 0; mi < 4; ++mi)
#pragma unroll
            for (int ni = 0; ni < NI; ++ni) *(f32x4*)(sF + (mi * 16 + c) * 260 + wn * (16 * NI) + ni * 16 + 4 * g) = acc[mi][ni];
        }
        __syncthreads();
#pragma unroll 16
        for (int i = 0; i < 16; ++i) {
          const int row = w * 16 + i;
          const int tok = m0 + half * 64 + row;
          const int col = n0 + 4 * lane;
          const f32x4 a = *(const f32x4*)(sF + row * 260 + 4 * lane);
          const f32x4 xo = *(const f32x4*)(xrow(epi.xa, epi.xb, tok) + col);
          f32x4 xn;
          xn[0] = xo[0] + a[0]; xn[1] = xo[1] + a[1]; xn[2] = xo[2] + a[2]; xn[3] = xo[3] + a[3];
          float sv = xn[0] * xn[0] + xn[1] * xn[1] + xn[2] * xn[2] + xn[3] * xn[3];
          sv = wave_sum(sv);
          if (!epi.dry) {
            *(f32x4*)(epi.out + (size_t)tok * DM + col) = xn;
            if (epi.hb) {
              uint2 o;
              o.x = pk2bf(xn[0], xn[1]);
              o.y = pk2bf(xn[2], xn[3]);
              *(uint2*)(epi.hb + (size_t)tok * DM + col) = o;
            }
            if (lane == 0) epi.ssq[(size_t)tok * 8 + (n0 >> 8)] = sv;
          }
        }
      }
    }
  }
#undef G_LOAD
#undef G_STORE
#undef G_COMPUTE
}

__device__ __forceinline__ void rope_cs(int pos, int i, float& co, float& si) {
  float inv = exp2f(-(float)i * (13.287712379549449f / 16.f));
  float ang = (float)pos * inv;
  float n = rintf(ang * 0.15915494309189535f);
  float r = fmaf(-n, 6.28125f, ang);
  r = fmaf(-n, 0.0019353071795864769f, r);
  float rf = r * 0.15915494309189535f;
  si = __builtin_amdgcn_sinf(rf);
  co = __builtin_amdgcn_cosf(rf);
}

__device__ __forceinline__ void rope_chunk(int pos, int i0, bf16x8 x1, bf16x8 x2, bf16x8& o1, bf16x8& o2) {
#pragma unroll
  for (int e = 0; e < 8; ++e) {
    float co, si;
    rope_cs(pos, i0 + e, co, si);
    float a = bf2f((bf16_t)x1[e]), b = bf2f((bf16_t)x2[e]);
    o1[e] = (short)f2bf(a * co - b * si);
    o2[e] = (short)f2bf(b * co + a * si);
  }
}

struct EpiEvenIn {
  static constexpr bool staged = true;
  bf16_t *Qb, *Kt, *VtE, *Gb, *LRb, *PUb, *PGb;
  __device__ float scale() const { return 1.f; }
  __device__ bool transposed(int n0) const { return n0 >= 512 && n0 < 2048; }
  __device__ bool both(int n0) const { return false; }
  template <int NI> __device__ void direct(int m0, int n0, int wm, int wn, int g, int c, f32x4 (&acc)[4][NI], const float* sR) const {}
  __device__ void store_t(int tok8, int col, bf16x8 v) const {
    if (col < 1024) *(bf16x8*)(Kt + (size_t)(col - 512) * T_TOK + tok8) = v;
    else *(bf16x8*)(VtE + (size_t)(col - 1024) * T_TOK + tok8) = v;
  }
  __device__ void store_n(int tok, int col, bf16x8 v, const bf16_t* sp) const {
    bf16_t* d;
    if (col < 512) d = Qb + (size_t)tok * 512 + col;
    else if (col < 3072) d = Gb + (size_t)tok * 1024 + (col - 2048);
    else if (col < 3104) d = LRb + (size_t)tok * 32 + (col - 3072);
    else if (col < 3616) d = PUb + (size_t)tok * 512 + (col - 3104);
    else if (col < 4128) d = PGb + (size_t)tok * 512 + (col - 3616);
    else return;
    *(bf16x8*)d = v;
  }
};

struct EpiOddIn {
  static constexpr bool staged = true;
  bf16_t *CQb, *CKVb, *KRb, *MGb, *MQb, *MKb, *MKt, *MVt, *MOb, *MLGb;
  float* MIF;
  __device__ float scale() const { return 1.f; }
  __device__ bool transposed(int n0) const { return n0 < 512; }
  __device__ bool both(int n0) const { return n0 >= 512 && n0 < 1024; }
  template <int NI> __device__ void direct(int m0, int n0, int wm, int wn, int g, int c, f32x4 (&acc)[4][NI], const float* sR) const {
    if (n0 == 3584 && wn == 1) {
#pragma unroll
      for (int mi = 0; mi < 4; ++mi)
#pragma unroll
        for (int j = 0; j < 4; ++j) {
          const int row = wm * 64 + mi * 16 + 4 * g + j;
          MIF[(size_t)(m0 + row) * 16 + c] = acc[mi][2][j] * sR[row];
        }
    }
  }
  __device__ void store_t(int tok8, int col, bf16x8 v) const {
    if (col < 512) *(bf16x8*)(MVt + (size_t)col * T_TOK + tok8) = v;
    else *(bf16x8*)(MKt + (size_t)(col - 512) * T_TOK + tok8) = v;
  }
  __device__ void store_n(int tok, int col, bf16x8 v, const bf16_t* sp) const {
    bf16_t* d;
    if (col < 1024) d = MKb + (size_t)tok * 512 + (col - 512);
    else if (col < 1408) d = CQb + (size_t)tok * 384 + (col - 1024);
    else if (col < 1664) d = CKVb + (size_t)tok * 256 + (col - 1408);
    else if (col < 2176) d = MGb + (size_t)tok * 512 + (col - 1664);
    else if (col < 2688) d = MQb + (size_t)tok * 512 + (col - 2176);
    else if (col < 3200) d = MOb + (size_t)tok * 512 + (col - 2688);
    else if (col < 3712) d = MLGb + (size_t)tok * 512 + (col - 3200);
    else if (col < 3728) {
      bf16x8 x2 = *(const bf16x8*)(sp + 16);
      bf16x8 o1, o2;
      rope_chunk(seq_pos(tok), col - 3712, v, x2, o1, o2);
      *(bf16x8*)(KRb + (size_t)tok * 32 + (col - 3712)) = o1;
      *(bf16x8*)(KRb + (size_t)tok * 32 + 16 + (col - 3712)) = o2;
      return;
    } else return;
    *(bf16x8*)d = v;
  }
};

struct EpiQUp {
  static constexpr bool staged = true;
  bf16_t* Qa;
  __device__ float scale() const { return 0.10206207261596575f * 1.4426950408889634f; }
  __device__ bool transposed(int n0) const { return false; }
  __device__ bool both(int n0) const { return false; }
  template <int NI> __device__ void direct(int m0, int n0, int wm, int wn, int g, int c, f32x4 (&acc)[4][NI], const float* sR) const {}
  __device__ void store_t(int tok8, int col, bf16x8 v) const {}
  __device__ void store_n(int tok, int col, bf16x8 v, const bf16_t* sp) const {
    if (col < 512) {
      *(bf16x8*)(Qa + (size_t)tok * 768 + (col >> 6) * 96 + (col & 63)) = v;
    } else {
      const int r = col - 512, head = r >> 5, rr = r & 31;
      if (rr < 16) {
        bf16x8 x2 = *(const bf16x8*)(sp + 16);
        bf16x8 o1, o2;
        rope_chunk(seq_pos(tok), rr, v, x2, o1, o2);
        *(bf16x8*)(Qa + (size_t)tok * 768 + head * 96 + 64 + rr) = o1;
        *(bf16x8*)(Qa + (size_t)tok * 768 + head * 96 + 80 + rr) = o2;
      }
    }
  }
};

struct EpiKVUp {
  static constexpr bool staged = true;
  bf16_t *KNb, *VtA;
  __device__ float scale() const { return 1.f; }
  __device__ bool transposed(int n0) const { return n0 >= 512; }
  __device__ bool both(int n0) const { return false; }
  template <int NI> __device__ void direct(int m0, int n0, int wm, int wn, int g, int c, f32x4 (&acc)[4][NI], const float* sR) const {}
  __device__ void store_t(int tok8, int col, bf16x8 v) const { *(bf16x8*)(VtA + (size_t)(col - 512) * T_TOK + tok8) = v; }
  __device__ void store_n(int tok, int col, bf16x8 v, const bf16_t* sp) const { *(bf16x8*)(KNb + (size_t)tok * 512 + col) = v; }
};

struct EpiOut {
  static constexpr bool staged = false;
  const float *xa, *xb;
  float* out;
  bool dry;
  bf16_t* hb;
  float* ssq;
};

template <int CTRL> __device__ __forceinline__ float dpp_z(float v) {
  return __int_as_float(__builtin_amdgcn_update_dpp(0, __float_as_int(v), CTRL, 0xf, 0xf, true));
}
__device__ __forceinline__ float scan16(float v, int c, int lane) {
  v += dpp_z<0x111>(v);
  v += dpp_z<0x112>(v);
  v += dpp_z<0x114>(v);
  v += dpp_z<0x118>(v);
  return v;
}

__device__ __forceinline__ float logsig_fast(float x) { return fminf(x, 0.f) - __logf(1.f + __expf(-fabsf(x))); }

__device__ void gla_intra_item(const Params& p, int li, int item, char* smem, bool dry = false) {
  const int tid = otid(), lane = tid & 63, w = tid >> 6, c = lane & 15, g = lane >> 4;
  const int ci = item >> 2, h = item & 3;
  const int tokc = ci * 64;
  const float qscale = 0.08838834764831845f;
  bf16_t* sQe = (bf16_t*)smem;
  bf16_t* sKd = sQe + 64 * 136;
  bf16_t* sA = sKd + 64 * 136;
  us4 q4[2][4];
  bf16_t kk[2][4][4];
#pragma unroll
  for (int dt = 0; dt < 2; ++dt)
#pragma unroll
    for (int tt = 0; tt < 4; ++tt) {
      q4[dt][tt] = *(const us4*)(p.Qb + (size_t)(tokc + 16 * tt + c) * 512 + h * 128 + 32 * w + 16 * dt + 4 * g);
#pragma unroll
      for (int j = 0; j < 4; ++j)
        kk[dt][tt][j] = p.Kt[(size_t)(h * 128 + 32 * w + 16 * dt + 4 * g + j) * T_TOK + tokc + 16 * tt + c];
    }
  __syncthreads();
#pragma unroll
  for (int dir = 0; dir < 2; ++dir) {
    bf16_t* QEd = (dir || dry) ? p.QEb : p.Qb;
    bf16_t* KdTd = (dir || dry) ? p.KdTb : p.Kt;
    bf16x8 aup[2];
    float bias[2][4];
#pragma unroll
    for (int dt = 0; dt < 2; ++dt) {
      aup[dt] = zero8();
      if (g < 2) aup[dt] = *(const bf16x8*)(p.AupT + ((size_t)(li * 2 + dir) * 512 + h * 128 + 32 * w + 16 * dt + c) * 32 + 8 * g);
#pragma unroll
      for (int j = 0; j < 4; ++j) bias[dt][j] = p.e_a_bias[(li * 2 + dir) * 512 + h * 128 + 32 * w + 16 * dt + 4 * g + j];
    }
    f32x4 la[2][4];
#pragma unroll
    for (int tt = 0; tt < 4; ++tt) {
      bf16x8 lrf = zero8();
      if (g < 2) lrf = *(const bf16x8*)(p.LRb + (size_t)(tokc + 16 * tt + c) * 32 + dir * 16 + 8 * g);
#pragma unroll
      for (int dt = 0; dt < 2; ++dt) la[dt][tt] = mfma16(aup[dt], lrf, zero4());
    }
#pragma unroll
    for (int dt = 0; dt < 2; ++dt)
#pragma unroll
      for (int tt = 0; tt < 4; ++tt)
#pragma unroll
        for (int j = 0; j < 4; ++j) la[dt][tt][j] = logsig_fast(la[dt][tt][j] + bias[dt][j]) * (1.f / 16.f);
    f32x4 P[2][4];
    float tot[2][4];
#pragma unroll
    for (int dt = 0; dt < 2; ++dt)
#pragma unroll
      for (int j = 0; j < 4; ++j) {
        float carry = 0.f;
#pragma unroll
        for (int tt = 0; tt < 4; ++tt) {
          float v = scan16(la[dt][tt][j], c, lane) + carry;
          P[dt][tt][j] = v;
          carry = dpp_f<0x15F>(v);
        }
        tot[dt][j] = carry;
      }
#pragma unroll
    for (int dt = 0; dt < 2; ++dt)
#pragma unroll
      for (int tt = 0; tt < 4; ++tt) {
        us4 qo, ko;
#pragma unroll
        for (int j = 0; j < 4; ++j) {
          const float b = (dir == 0) ? P[dt][tt][j] : (tot[dt][j] - P[dt][tt][j] + la[dt][tt][j]);
          qo[j] = f2bf(bf2f(q4[dt][tt][j]) * __expf(b) * qscale);
          ko[j] = f2bf(bf2f(kk[dt][tt][j]) * __expf(-b));
        }
        *(us4*)(QEd + (size_t)(tokc + 16 * tt + c) * 512 + h * 128 + 32 * w + 16 * dt + 4 * g) = qo;
        *(us4*)(sQe + (16 * tt + c) * 136 + 32 * w + 16 * dt + 4 * g) = qo;
        *(us4*)(sKd + (16 * tt + c) * 136 + 32 * w + 16 * dt + 4 * g) = ko;
      }
    if (c == 0) {
#pragma unroll
      for (int dt = 0; dt < 2; ++dt)
#pragma unroll
        for (int j = 0; j < 4; ++j)
          p.EB[(size_t)(dir * 1280 + ci) * 512 + h * 128 + 32 * w + 16 * dt + 4 * g + j] = __expf(tot[dt][j]);
    }
    __syncthreads();
#pragma unroll
    for (int i = 0; i < 4; ++i) {
      const int id = tid + 256 * i;
      const int d = id & 127, c8 = id >> 7;
      bf16x8 v;
#pragma unroll
      for (int e = 0; e < 8; ++e) v[e] = (short)sKd[(8 * c8 + e) * 136 + d];
      *(bf16x8*)(KdTd + (size_t)(h * 128 + d) * T_TOK + tokc + 8 * c8) = v;
    }
    f32x4 accA[4];
#pragma unroll
    for (int jt = 0; jt < 4; ++jt) accA[jt] = zero4();
#pragma unroll
    for (int ks = 0; ks < 4; ++ks) {
      bf16x8 aq = *(const bf16x8*)(sQe + (16 * w + c) * 136 + 32 * ks + 8 * g);
#pragma unroll
      for (int jt = 0; jt < 4; ++jt) {
        bf16x8 bk = *(const bf16x8*)(sKd + (16 * jt + c) * 136 + 32 * ks + 8 * g);
        accA[jt] = mfma16(aq, bk, accA[jt]);
      }
    }
#pragma unroll
    for (int jt = 0; jt < 4; ++jt)
#pragma unroll
      for (int j = 0; j < 4; ++j) {
        const int i = 16 * w + 4 * g + j, jj = 16 * jt + c;
        const bool keep = (dir == 0) ? (jj <= i) : (jj > i);
        sA[dir * 64 * 72 + i * 72 + jj] = f2bf(keep ? accA[jt][j] : 0.f);
      }
    __syncthreads();
  }
  bf16x8 af[2][2];
#pragma unroll
  for (int dir = 0; dir < 2; ++dir)
#pragma unroll
    for (int k2 = 0; k2 < 2; ++k2) af[dir][k2] = *(const bf16x8*)(sA + dir * 64 * 72 + (16 * w + c) * 72 + 32 * k2 + 8 * g);
  bf16_t* sO = (bf16_t*)smem;
#pragma unroll 4
  for (int vt = 0; vt < 16; ++vt) {
    f32x4 a = zero4();
#pragma unroll
    for (int k2 = 0; k2 < 2; ++k2) {
      bf16x8 vfr = *(const bf16x8*)(p.VtE + (size_t)(h * 256 + 16 * vt + c) * T_TOK + tokc + 32 * k2 + 8 * g);
      a = mfma16(af[0][k2], vfr, a);
      a = mfma16(af[1][k2], vfr, a);
    }
#pragma unroll
    for (int j = 0; j < 4; ++j) sO[(16 * w + 4 * g + j) * 264 + 16 * vt + c] = f2bf(a[j]);
  }
  __syncthreads();
#pragma unroll
  for (int i = 0; i < 8; ++i) {
    const int id = tid + 256 * i;
    const int row = id >> 5, c8 = id & 31;
    *(bf16x8*)(p.TMP + (size_t)(tokc + row) * 1024 + h * 256 + 8 * c8) = *(const bf16x8*)(sO + row * 264 + 8 * c8);
  }
}

__device__ __forceinline__ void lds_barrier() { asm volatile("s_waitcnt lgkmcnt(0)\n\ts_barrier" ::: "memory"); }

struct GlaRegs {
  bf16x8 aq[4];
  bf16x8 vf[2][2];
  bf16x8 kf[2][2];
  float eb[2];
  unsigned told[2][4];
};

template <int DIR>
__device__ __forceinline__ void gla_chain_load(const Params& p, int h, int sl, int tokc, int w, int c, int g, GlaRegs& r) {
  const bf16_t* QE = DIR ? p.QEb : p.Qb;
  const bf16_t* KdT = DIR ? p.KdTb : p.Kt;
#pragma unroll
  for (int ks = 0; ks < 4; ++ks) r.aq[ks] = *(const bf16x8*)(QE + (size_t)(tokc + 16 * w + c) * 512 + h * 128 + 32 * ks + 8 * g);
#pragma unroll
  for (int vt = 0; vt < 2; ++vt)
#pragma unroll
    for (int k2 = 0; k2 < 2; ++k2)
      r.vf[vt][k2] = *(const bf16x8*)(p.VtE + (size_t)(h * 256 + sl * 32 + 16 * vt + c) * T_TOK + tokc + 32 * k2 + 8 * g);
#pragma unroll
  for (int dt = 0; dt < 2; ++dt) {
#pragma unroll
    for (int k2 = 0; k2 < 2; ++k2)
      r.kf[dt][k2] = *(const bf16x8*)(KdT + (size_t)(h * 128 + 32 * w + 16 * dt + c) * T_TOK + tokc + 32 * k2 + 8 * g);
    r.eb[dt] = p.EB[(size_t)(DIR * 1280 + (tokc >> 6)) * 512 + h * 128 + 32 * w + 16 * dt + c];
  }
#pragma unroll
  for (int vt = 0; vt < 2; ++vt)
#pragma unroll
    for (int j = 0; j < 4; ++j) r.told[vt][j] = p.TMP[(size_t)(tokc + 16 * w + 4 * g + j) * 1024 + h * 256 + sl * 32 + 16 * vt + c];
}

__device__ __forceinline__ void gla_chain_compute(const Params& p, int h, int sl, int tokc, int w, int c, int g, const GlaRegs& r,
                                                  f32x4 (&S)[2][2], bf16_t* sSt, bool dry, bool reload) {
  unsigned told[2][4];
#pragma unroll
  for (int vt = 0; vt < 2; ++vt)
#pragma unroll
    for (int j = 0; j < 4; ++j) told[vt][j] = r.told[vt][j];
  if (reload) {
#pragma unroll
    for (int vt = 0; vt < 2; ++vt)
#pragma unroll
      for (int j = 0; j < 4; ++j) told[vt][j] = p.TMP[(size_t)(tokc + 16 * w + 4 * g + j) * 1024 + h * 256 + sl * 32 + 16 * vt + c];
  }
#pragma unroll
  for (int vt = 0; vt < 2; ++vt)
#pragma unroll
    for (int dt = 0; dt < 2; ++dt)
#pragma unroll
      for (int j = 0; j < 4; ++j) sSt[(16 * vt + 4 * g + j) * 136 + 32 * w + 16 * dt + c] = f2bf(S[vt][dt][j]);
  lds_barrier();
  f32x4 o[2];
  o[0] = zero4(); o[1] = zero4();
#pragma unroll
  for (int ks = 0; ks < 4; ++ks)
#pragma unroll
    for (int vt = 0; vt < 2; ++vt) {
      bf16x8 sf = *(const bf16x8*)(sSt + (16 * vt + c) * 136 + 32 * ks + 8 * g);
      o[vt] = mfma16(r.aq[ks], sf, o[vt]);
    }
#pragma unroll
  for (int dt = 0; dt < 2; ++dt)
#pragma unroll
    for (int vt = 0; vt < 2; ++vt) {
      f32x4 a = S[vt][dt];
#pragma unroll
      for (int k2 = 0; k2 < 2; ++k2) a = mfma16(r.vf[vt][k2], r.kf[dt][k2], a);
      S[vt][dt] = a * r.eb[dt];
    }
#pragma unroll
  for (int vt = 0; vt < 2; ++vt)
#pragma unroll
    for (int j = 0; j < 4; ++j)
      if (!dry) p.TMP[(size_t)(tokc + 16 * w + 4 * g + j) * 1024 + h * 256 + sl * 32 + 16 * vt + c] = f2bf(bf2f((bf16_t)told[vt][j]) + o[vt][j]);
}

__device__ void gla_chain_item(const Params& p, int li, int item, char* smem, bool dry = false) {
  const int tid = otid(), lane = tid & 63, w = tid >> 6, c = lane & 15, g = lane >> 4;
  const int xr = item >> 3;
  const int pair = (item & 7) + 8 * (xr >> 3), sl = xr & 7;
  const int s = pair < 32 ? 4 + (pair >> 2) : ((pair - 32) >> 2);
  const int h = pair & 3;
  const int tok0 = s < 4 ? s * 4096 : T_P + (s - 4) * 8192;
  const int len = s < 4 ? 4096 : 8192;
  const int N = len / 64;
  bf16_t* sSt0 = (bf16_t*)smem;
  bf16_t* sSt1 = sSt0 + 32 * 136;
  f32x4 Sf[2][2], Sb[2][2];
#pragma unroll
  for (int a = 0; a < 2; ++a)
#pragma unroll
    for (int b = 0; b < 2; ++b) { Sf[a][b] = zero4(); Sb[a][b] = zero4(); }
  GlaRegs rf, rb;
  __syncthreads();
  gla_chain_load<0>(p, h, sl, tok0, w, c, g, rf);
  for (int step = 0; step < N; ++step) {
    const int tf = tok0 + step * 64, tb = tok0 + (N - 1 - step) * 64;
    gla_chain_load<1>(p, h, sl, tb, w, c, g, rb);
    gla_chain_compute(p, h, sl, tf, w, c, g, rf, Sf, sSt0, dry, step == (N >> 1));
    if (step + 1 < N) gla_chain_load<0>(p, h, sl, tf + 64, w, c, g, rf);
    gla_chain_compute(p, h, sl, tb, w, c, g, rb, Sb, sSt1, dry, false);
  }
}

__device__ void pool_item(const Params& p, int li, int item, char* smem, bool dry = false) {
  const int tid = otid(), lane = tid & 63, w = tid >> 6, c = lane & 15, g = lane >> 4;
  const int gi = item & 3;
  const int tile = item >> 2;
  const int tokc = tile * 64;
  const int pos0 = seq_pos(tokc);
  const int len = tokc < T_P ? 4096 : 8192;
  float* sU = (float*)smem;
  bf16_t* sP = (bf16_t*)(sU + 80 * 128);
  __syncthreads();
  for (int idx = tid; idx < 80 * 128; idx += 256) {
    int r = idx >> 7, ch = idx & 127;
    int pos = pos0 - 8 + r;
    float v = 0.f;
    if (pos >= 0 && pos < len) v = bf2f(p.PUb[(long)(tokc - 8 + r) * 512 + gi * 128 + ch]);
    sU[idx] = v;
  }
  __syncthreads();
  {
    const int ch = tid & 127, th = tid >> 7;
    const int half = 1 << gi;
    for (int t = th * 32; t < th * 32 + 32; ++t) {
      int pos = pos0 + t;
      int lo = max(pos - half, 0), hi = min(pos + half, len);
      float s = 0.f;
      for (int q = lo; q < hi; ++q) s += sU[(q - pos0 + 8) * 128 + ch];
      float pooled = s / (float)(hi - lo) - sU[(t + 8) * 128 + ch];
      sP[t * 136 + ch] = f2bf(pooled);
    }
  }
  __syncthreads();
  f32x4 acc[8];
#pragma unroll
  for (int dt = 0; dt < 8; ++dt) acc[dt] = zero4();
  const bf16_t* PW = p.PoolWT + (long)(li * 4 + gi) * 128 * 128;
#pragma unroll
  for (int ks = 0; ks < 4; ++ks) {
    bf16x8 af = *(const bf16x8*)(sP + (16 * w + c) * 136 + 32 * ks + 8 * g);
#pragma unroll
    for (int dt = 0; dt < 8; ++dt) {
      bf16x8 bw = *(const bf16x8*)(PW + (long)(16 * dt + c) * 128 + 32 * ks + 8 * g);
      acc[dt] = mfma16(af, bw, acc[dt]);
    }
  }
#pragma unroll
  for (int dt = 0; dt < 8; ++dt) {
    const int d = gi * 128 + 16 * dt + c;
    const float sc = p.e_pool_scale[li * 512 + d];
#pragma unroll
    for (int j = 0; j < 4; ++j) {
      const long addr = (long)(tokc + 16 * w + 4 * g + j) * 512 + d;
      float gt = bf2f(p.PGb[addr]);
      if (!dry) p.PGb[addr] = f2bf(acc[dt][j] * sc * siluf_(gt));
    }
  }
}

__device__ void ml_intra_item(const Params& p, int li, int item, char* smem) {
  const int tid = otid(), lane = tid & 63, w = tid >> 6, c = lane & 15, g = lane >> 4;
  const int ci = item >> 2, h = item & 3;
  const int tokc = ci * 64;
  const float kscale = 0.08838834764831845f;
  bf16_t* sA = (bf16_t*)smem;
  float* sBv = (float*)(sA + 2 * 64 * 72);
  float* sCB = sBv + 128;
  __syncthreads();
  if (w < 2) {
    const int dir = w;
    const float bi = p.o_if_bias[li * 16 + dir * 4 + h];
    const float bff = p.o_if_bias[li * 16 + 8 + dir * 4 + h];
    const float* mf = p.MIF + (size_t)(tokc + lane) * 16;
    const float liv = mf[dir * 4 + h] + bi;
    const float lfv = logsig_fast(mf[8 + dir * 4 + h] + bff);
    float ps = lfv;
#pragma unroll
    for (int d = 1; d < 64; d <<= 1) {
      float t = bperm(lane - d, ps);
      if (lane >= d) ps += t;
    }
    const float total = __int_as_float(__builtin_amdgcn_readlane(__float_as_int(ps), 63));
    const float b = (dir == 0) ? ps : (total - ps + lfv);
    const float cB = liv - b;
    sBv[dir * 64 + lane] = b;
    sCB[dir * 64 + lane] = cB;
    const size_t so = (size_t)(dir * 4 + h) * T_TOK + tokc + lane;
    p.EBI[so] = __expf(b);
    p.WKg[so] = __expf(total + cB) * kscale;
    if (lane == 0) p.DEC[(dir * 4 + h) * 1280 + ci] = __expf(total);
  }
  f32x4 accA[4];
#pragma unroll
  for (int jt = 0; jt < 4; ++jt) accA[jt] = zero4();
#pragma unroll
  for (int ks = 0; ks < 4; ++ks) {
    bf16x8 aq = *(const bf16x8*)(p.MQb + (size_t)(tokc + 16 * w + c) * 512 + h * 128 + 32 * ks + 8 * g);
#pragma unroll
    for (int jt = 0; jt < 4; ++jt) {
      bf16x8 bk = *(const bf16x8*)(p.MKb + (size_t)(tokc + 16 * jt + c) * 512 + h * 128 + 32 * ks + 8 * g);
      accA[jt] = mfma16(aq, bk, accA[jt]);
    }
  }
  __syncthreads();
#pragma unroll
  for (int dir = 0; dir < 2; ++dir)
#pragma unroll
    for (int jt = 0; jt < 4; ++jt)
#pragma unroll
      for (int j = 0; j < 4; ++j) {
        const int i = 16 * w + 4 * g + j, jj = 16 * jt + c;
        const bool keep = (dir == 0) ? (jj <= i) : (jj > i);
        const float sv = keep ? accA[jt][j] * kscale * __expf(sBv[dir * 64 + i] + sCB[dir * 64 + jj]) : 0.f;
        sA[dir * 64 * 72 + i * 72 + jj] = f2bf(sv);
      }
  __syncthreads();
  bf16x8 ones = zero8();
  if (c == 0) {
#pragma unroll
    for (int e = 0; e < 8; ++e) ones[e] = (short)0x3F80;
  }
#pragma unroll
  for (int dir = 0; dir < 2; ++dir) {
    bf16_t* NUMI = dir ? p.NUMIb : p.NUMIf;
    bf16x8 af[2];
#pragma unroll
    for (int k2 = 0; k2 < 2; ++k2) af[k2] = *(const bf16x8*)(sA + dir * 64 * 72 + (16 * w + c) * 72 + 32 * k2 + 8 * g);
    f32x4 dn = zero4();
    dn = mfma16(af[0], ones, dn);
    dn = mfma16(af[1], ones, dn);
    if (c == 0) {
#pragma unroll
      for (int j = 0; j < 4; ++j) p.DENI[(size_t)(dir * 4 + h) * T_TOK + tokc + 16 * w + 4 * g + j] = dn[j];
    }
    bf16_t* sO = sA + 2 * 64 * 72 + 512;
#pragma unroll 4
    for (int vt = 0; vt < 8; ++vt) {
      f32x4 a = zero4();
#pragma unroll
      for (int k2 = 0; k2 < 2; ++k2) {
        bf16x8 vfr = *(const bf16x8*)(p.MVt + (size_t)(h * 128 + 16 * vt + c) * T_TOK + tokc + 32 * k2 + 8 * g);
        a = mfma16(af[k2], vfr, a);
      }
#pragma unroll
      for (int j = 0; j < 4; ++j) sO[(16 * w + 4 * g + j) * 136 + 16 * vt + c] = f2bf(a[j]);
    }
    __syncthreads();
#pragma unroll
    for (int i = 0; i < 4; ++i) {
      const int id = tid + 256 * i;
      const int row = id >> 4, c8 = id & 15;
      *(bf16x8*)(NUMI + (size_t)(tokc + row) * 512 + h * 128 + 8 * c8) = *(const bf16x8*)(sO + row * 136 + 8 * c8);
    }
    __syncthreads();
  }
}

struct MlRegs {
  bf16x8 aq[4];
  bf16x8 vf[2];
  bf16x8 kf[2][2];
  f32x4 wk[2][2];
  f32x4 ebi, deni;
  float dec;
  unsigned numi[4];
};

template <int DIR>
__device__ __forceinline__ void ml_chain_load(const Params& p, int h, int sl, int tokc, int w, int c, int g, MlRegs& r) {
#pragma unroll
  for (int ks = 0; ks < 4; ++ks) r.aq[ks] = *(const bf16x8*)(p.MQb + (size_t)(tokc + 16 * w + c) * 512 + h * 128 + 32 * ks + 8 * g);
#pragma unroll
  for (int k2 = 0; k2 < 2; ++k2)
    r.vf[k2] = *(const bf16x8*)(p.MVt + (size_t)(h * 128 + sl * 16 + c) * T_TOK + tokc + 32 * k2 + 8 * g);
#pragma unroll
  for (int dt = 0; dt < 2; ++dt)
#pragma unroll
    for (int k2 = 0; k2 < 2; ++k2)
      r.kf[dt][k2] = *(const bf16x8*)(p.MKt + (size_t)(h * 128 + 32 * w + 16 * dt + c) * T_TOK + tokc + 32 * k2 + 8 * g);
  const size_t so = (size_t)(DIR * 4 + h) * T_TOK + tokc;
#pragma unroll
  for (int k2 = 0; k2 < 2; ++k2) {
    r.wk[k2][0] = *(const f32x4*)(p.WKg + so + 32 * k2 + 8 * g);
    r.wk[k2][1] = *(const f32x4*)(p.WKg + so + 32 * k2 + 8 * g + 4);
  }
  r.ebi = *(const f32x4*)(p.EBI + so + 16 * w + 4 * g);
  r.deni = *(const f32x4*)(p.DENI + so + 16 * w + 4 * g);
  r.dec = p.DEC[(DIR * 4 + h) * 1280 + (tokc >> 6)];
  const bf16_t* NUMI = DIR ? p.NUMIb : p.NUMIf;
#pragma unroll
  for (int j = 0; j < 4; ++j) r.numi[j] = NUMI[(size_t)(tokc + 16 * w + 4 * g + j) * 512 + h * 128 + sl * 16 + c];
}

template <int DIR>
__device__ __forceinline__ void ml_chain_compute(const Params& p, int h, int sl, int tokc, int lane, int w, int c, int g, const MlRegs& r,
                                                 f32x4 (&C)[2][2], bf16_t* sCt, bool dry) {
  bf16_t* NUMI = DIR ? p.NUMIb : p.NUMIf;
  unsigned numi[4];
#pragma unroll
  for (int j = 0; j < 4; ++j) numi[j] = r.numi[j];
#pragma unroll
  for (int vt = 0; vt < 2; ++vt)
#pragma unroll
    for (int dt = 0; dt < 2; ++dt)
#pragma unroll
      for (int j = 0; j < 4; ++j) sCt[(16 * vt + 4 * g + j) * 136 + 32 * w + 16 * dt + c] = f2bf(C[vt][dt][j]);
  bf16x8 vfw[2][2];
#pragma unroll
  for (int k2 = 0; k2 < 2; ++k2) {
    float wv[8];
#pragma unroll
    for (int e = 0; e < 4; ++e) { wv[e] = r.wk[k2][0][e]; wv[4 + e] = r.wk[k2][1][e]; }
#pragma unroll
    for (int e = 0; e < 8; ++e) vfw[0][k2][e] = (short)f2bf(bf2f((bf16_t)r.vf[k2][e]) * wv[e]);
#pragma unroll
    for (int e = 0; e < 8; ++e) vfw[1][k2][e] = (c == 0) ? (short)f2bf(wv[e]) : (short)0;
  }
  lds_barrier();
  f32x4 o2[2];
  o2[0] = zero4(); o2[1] = zero4();
#pragma unroll
  for (int ks = 0; ks < 4; ++ks)
#pragma unroll
    for (int vt = 0; vt < 2; ++vt) {
      bf16x8 cf = *(const bf16x8*)(sCt + (16 * vt + c) * 136 + 32 * ks + 8 * g);
      o2[vt] = mfma16(r.aq[ks], cf, o2[vt]);
    }
#pragma unroll
  for (int dt = 0; dt < 2; ++dt)
#pragma unroll
    for (int vt = 0; vt < 2; ++vt) {
      f32x4 a = C[vt][dt] * r.dec;
#pragma unroll
      for (int k2 = 0; k2 < 2; ++k2) a = mfma16(vfw[vt][k2], r.kf[dt][k2], a);
      C[vt][dt] = a;
    }
#pragma unroll
  for (int j = 0; j < 4; ++j) {
    const float e = r.ebi[j];
    float den = e * o2[1][j];
    den = dpp_f<0x150>(den) + r.deni[j];
    const float inv = 1.f / fmaxf(fabsf(den), 1.f);
    const float hv = (bf2f((bf16_t)numi[j]) + e * o2[0][j]) * inv;
    if (!dry) NUMI[(size_t)(tokc + 16 * w + 4 * g + j) * 512 + h * 128 + sl * 16 + c] = f2bf(hv);
  }
}

template <int DIR>
__device__ __forceinline__ void ml_chain_run(const Params& p, int h, int sl, int tok0, int N, int lane, int w, int c, int g, bf16_t* sCt0, bool dry) {
  bf16_t* sCt1 = sCt0 + 32 * 136;
  f32x4 C[2][2];
#pragma unroll
  for (int a = 0; a < 2; ++a)
#pragma unroll
    for (int b = 0; b < 2; ++b) C[a][b] = zero4();
  MlRegs r0, r1;
  ml_chain_load<DIR>(p, h, sl, tok0 + (DIR ? N - 1 : 0) * 64, w, c, g, r0);
  for (int n = 0; n < N; n += 2) {
    const int c0 = DIR ? N - 1 - n : n;
    const int c1 = DIR ? N - 2 - n : n + 1;
    const int n2 = min(n + 2, N - 1);
    const int c2 = DIR ? N - 1 - n2 : n2;
    ml_chain_load<DIR>(p, h, sl, tok0 + c1 * 64, w, c, g, r1);
    ml_chain_compute<DIR>(p, h, sl, tok0 + c0 * 64, lane, w, c, g, r0, C, sCt0, dry);
    ml_chain_load<DIR>(p, h, sl, tok0 + c2 * 64, w, c, g, r0);
    ml_chain_compute<DIR>(p, h, sl, tok0 + c1 * 64, lane, w, c, g, r1, C, sCt1, dry);
  }
}

__device__ void ml_chain_item(const Params& p, int li, int item, char* smem, bool dry = false) {
  const int tid = otid(), lane = tid & 63, w = tid >> 6, c = lane & 15, g = lane >> 4;
  int pair, within;
  if (item < 512) { const int r = item >> 3; pair = (item & 7) + 8 * (r >> 4); within = r & 15; }
  else { const int it = item - 512; const int r = it >> 3; pair = 32 + (it & 7) + 8 * (r >> 4); within = r & 15; }
  const int sl = within & 7, dir = within >> 3;
  const int s = pair < 32 ? 4 + (pair >> 2) : ((pair - 32) >> 2);
  const int h = pair & 3;
  const int tok0 = s < 4 ? s * 4096 : T_P + (s - 4) * 8192;
  const int N = (s < 4 ? 4096 : 8192) / 64;
  bf16_t* sCt0 = (bf16_t*)smem;
  __syncthreads();
  if (dir == 0) ml_chain_run<0>(p, h, sl, tok0, N, lane, w, c, g, sCt0, dry);
  else ml_chain_run<1>(p, h, sl, tok0, N, lane, w, c, g, sCt0, dry);
}

#define ATTN_GLOAD(KT)                                                                              \
  {                                                                                                 \
    const long kb = tok0 + (KT) * 64;                                                               \
    rk0 = *(const bf16x8*)(p.KNb + (kb + (tid >> 3)) * 512 + head * 64 + 8 * (tid & 7));            \
    rk1 = *(const bf16x8*)(p.KNb + (kb + 32 + (tid >> 3)) * 512 + head * 64 + 8 * (tid & 7));       \
    rkr = *(const bf16x8*)(p.KRb + (kb + (tid >> 2)) * 32 + 8 * (tid & 3));                          \
    rv0 = *(const bf16x8*)(p.VtA + (long)(head * 64 + (tid >> 3)) * T_TOK + kb + 8 * (tid & 7));     \
    rv1 = *(const bf16x8*)(p.VtA + (long)(head * 64 + 32 + (tid >> 3)) * T_TOK + kb + 8 * (tid & 7)); \
  }
__device__ void attn_item(const Params& p, int item, char* smem, bool dry = false) {
  const int tid = otid(), lane = tid & 63, w = tid >> 6, c = lane & 15, g = lane >> 4;
  int s, head, qb;
  {
    const int x = item / 320, t = item % 320;
    if (t < 256) { const int pair = x + 8 * (t >> 5); qb = t & 31; s = 4 + (pair >> 3); head = pair & 7; }
    else { const int t2 = t - 256; const int pair = x + 8 * (t2 >> 4); qb = t2 & 15; s = pair >> 3; head = pair & 7; }
  }
  const int tok0 = s < 4 ? s * 4096 : T_P + (s - 4) * 8192;
  const int len = s < 4 ? 4096 : 8192;
  const int nkv = len / 64;
  constexpr int KV_STAGE = 64 * 104 + 64 * 72;
  bf16_t* sKV = (bf16_t*)smem;
  const int qrow0 = tok0 + qb * 256 + 64 * w;
  bf16_t* sQr = sKV + 2 * KV_STAGE;
  bf16x8 qf[4][3];
#pragma unroll
  for (int nt = 0; nt < 4; ++nt)
#pragma unroll
    for (int ks = 0; ks < 3; ++ks)
      qf[nt][ks] = *(const bf16x8*)(p.Qa + (long)(qrow0 + 16 * nt + c) * 768 + head * 96 + 32 * ks + 8 * g);
  f32x4 ot[4][4];
#pragma unroll
  for (int vt = 0; vt < 4; ++vt)
#pragma unroll
    for (int nt = 0; nt < 4; ++nt) ot[vt][nt] = zero4();
  float mrun[4] = {-64.f, -64.f, -64.f, -64.f}, lrun[4] = {0.f, 0.f, 0.f, 0.f};
  bf16x8 rk0, rk1, rkr, rv0, rv1;
#define ATTN_LSTORE(STG)                                                                    \
  {                                                                                         \
    bf16_t* sK_ = sKV + (STG) * KV_STAGE;                                                   \
    bf16_t* sVt_ = sK_ + 64 * 104;                                                          \
    *(bf16x8*)(sK_ + (tid >> 3) * 104 + 8 * (tid & 7)) = rk0;                               \
    *(bf16x8*)(sK_ + (32 + (tid >> 3)) * 104 + 8 * (tid & 7)) = rk1;                        \
    *(bf16x8*)(sK_ + (tid >> 2) * 104 + 64 + 8 * (tid & 3)) = rkr;                          \
    *(bf16x8*)(sVt_ + (tid >> 3) * 72 + 8 * (tid & 7)) = rv0;                               \
    *(bf16x8*)(sVt_ + (32 + (tid >> 3)) * 72 + 8 * (tid & 7)) = rv1;                        \
  }
  ATTN_GLOAD(0)
  __syncthreads();
  ATTN_LSTORE(0)
  __syncthreads();
#pragma unroll 2
  for (int kt = 0; kt < nkv; ++kt) {
    const bf16_t* sK = sKV + (kt & 1) * KV_STAGE;
    const bf16_t* sVt = sK + 64 * 104;
    ATTN_GLOAD(min(kt + 1, nkv - 1))
#pragma unroll 1
    for (int half = 0; half < 2; ++half) {
      f32x4 st[2][4];
#pragma unroll
      for (int k4 = 0; k4 < 2; ++k4)
#pragma unroll
        for (int nt = 0; nt < 4; ++nt) {
          const float nm = -mrun[nt];
          f32x4 iv = {nm, nm, nm, nm};
          st[k4][nt] = iv;
        }
#pragma unroll
      for (int ks = 0; ks < 2; ++ks)
#pragma unroll
        for (int k4 = 0; k4 < 2; ++k4) {
          bf16x8 kf = *(const bf16x8*)(sK + (32 * half + 16 * k4 + c) * 104 + 32 * ks + 8 * g);
#pragma unroll
          for (int nt = 0; nt < 4; ++nt) st[k4][nt] = mfma16(kf, qf[nt][ks], st[k4][nt]);
        }
      {
        bf16x8 kr0 = *(const bf16x8*)(sK + (32 * half + c) * 104 + 64 + 8 * g);
        bf16x8 kr1 = *(const bf16x8*)(sK + (32 * half + 16 + c) * 104 + 64 + 8 * g);
#pragma unroll
        for (int nt = 0; nt < 4; ++nt) {
          st[0][nt] = mfma16(kr0, qf[nt][2], st[0][nt]);
          st[1][nt] = mfma16(kr1, qf[nt][2], st[1][nt]);
        }
      }
      bf16x8 pb[4];
#pragma unroll
      for (int nt = 0; nt < 4; ++nt) {
        float mx = -1e30f;
#pragma unroll
        for (int k4 = 0; k4 < 2; ++k4)
#pragma unroll
          for (int j = 0; j < 4; ++j) mx = fmaxf(mx, st[k4][nt][j]);
        mx = rowmax4(mx);
        if (__builtin_amdgcn_ballot_w64(mx > 0.f) != 0ull) {
          const float d = fmaxf(mx, 0.f);
          const float alpha = __builtin_amdgcn_exp2f(-d);
          mrun[nt] += d;
          lrun[nt] *= alpha;
#pragma unroll
          for (int vt = 0; vt < 4; ++vt) ot[vt][nt] = ot[vt][nt] * alpha;
#pragma unroll
          for (int k4 = 0; k4 < 2; ++k4)
#pragma unroll
            for (int j = 0; j < 4; ++j) st[k4][nt][j] -= d;
        }
        float psum = 0.f;
#pragma unroll
        for (int k4 = 0; k4 < 2; ++k4)
#pragma unroll
          for (int j = 0; j < 4; ++j) {
            float pv = __builtin_amdgcn_exp2f(st[k4][nt][j]);
            st[k4][nt][j] = pv;
            psum += pv;
          }
        lrun[nt] += psum;
        typedef __attribute__((ext_vector_type(4))) unsigned u32x4;
        u32x4 pk;
        pk[0] = pk2bf(st[0][nt][0], st[0][nt][1]);
        pk[1] = pk2bf(st[0][nt][2], st[0][nt][3]);
        pk[2] = pk2bf(st[1][nt][0], st[1][nt][1]);
        pk[3] = pk2bf(st[1][nt][2], st[1][nt][3]);
        pb[nt] = __builtin_bit_cast(bf16x8, pk);
      }
#pragma unroll
      for (int vt = 0; vt < 4; ++vt) {
        us4 lo = *(const us4*)(sVt + (16 * vt + c) * 72 + 32 * half + 4 * g);
        us4 hi = *(const us4*)(sVt + (16 * vt + c) * 72 + 32 * half + 16 + 4 * g);
        bf16x8 av;
#pragma unroll
        for (int e = 0; e < 4; ++e) { av[e] = (short)lo[e]; av[4 + e] = (short)hi[e]; }
#pragma unroll
        for (int nt = 0; nt < 4; ++nt) ot[vt][nt] = mfma16(av, pb[nt], ot[vt][nt]);
      }
    }
    if (kt + 1 < nkv) ATTN_LSTORE((kt + 1) & 1)
    __syncthreads();
  }
#undef ATTN_LSTORE
#pragma unroll
  for (int nt = 0; nt < 4; ++nt) {
    float lt = lrun[nt];
    lt += sxor(lt, 16, lane);
    lt += sxor(lt, 32, lane);
    const float inv = 1.f / lt;
    const long tok = qrow0 + 16 * nt + c;
#pragma unroll
    for (int vt = 0; vt < 4; ++vt) {
      bf16_t* gp = p.MGb + tok * 512 + head * 64 + 16 * vt + 4 * g;
      us4 gt = *(const us4*)gp;
      us4 o;
#pragma unroll
      for (int j = 0; j < 4; ++j) o[j] = f2bf(ot[vt][nt][j] * inv * siluf_(bf2f(gt[j])));
      if (!dry) *(us4*)gp = o;
    }
  }
}

__device__ void phase_gla_combine(const Params& p, int li, bool dry = false) {
  const int tid_ = otid(); const int lane = tid_ & 63, w = tid_ >> 6;
#pragma unroll 2
  for (int tok = blockIdx.x * 4 + w; tok < T_TOK; tok += gridDim.x * 4) {
    const bf16_t* tp = p.TMP + (long)tok * 1024 + 16 * lane;
    bf16_t* gp = p.Gb + (long)tok * 1024 + 16 * lane;
    bf16x8 o0 = *(const bf16x8*)tp, o1 = *(const bf16x8*)(tp + 8);
    bf16x8 g0 = *(const bf16x8*)gp, g1 = *(const bf16x8*)(gp + 8);
    float ov[16], gv[16];
#pragma unroll
    for (int e = 0; e < 8; ++e) {
      ov[e] = bf2f((bf16_t)o0[e]); ov[8 + e] = bf2f((bf16_t)o1[e]);
      gv[e] = bf2f((bf16_t)g0[e]); gv[8 + e] = bf2f((bf16_t)g1[e]);
    }
    float ss = 0.f;
#pragma unroll
    for (int e = 0; e < 16; ++e) ss += ov[e] * ov[e];
    ss = row_sum16(ss);
    const float rs = rsqrtf(ss * (1.f / 256.f) + EPS);
    const float* ng = p.e_gla_norm_g + li * 256 + ((16 * lane) & 255);
    bf16x8 r0, r1;
#pragma unroll
    for (int e = 0; e < 8; ++e) {
      r0[e] = (short)f2bf(ov[e] * rs * ng[e] * siluf_(gv[e]));
      r1[e] = (short)f2bf(ov[8 + e] * rs * ng[8 + e] * siluf_(gv[8 + e]));
    }
    if (!dry) { *(bf16x8*)gp = r0;
    *(bf16x8*)(gp + 8) = r1; }
  }
}

__device__ void phase_ml_combine(const Params& p, int li, bool dry = false) {
  const int tid_ = otid(); const int lane = tid_ & 63, w = tid_ >> 6;
#pragma unroll 2
  for (int tok = blockIdx.x * 4 + w; tok < T_TOK; tok += gridDim.x * 4) {
    const long off = (long)tok * 512 + 8 * lane;
    bf16x8 hv = *(const bf16x8*)(p.NUMIf + off);
    bf16x8 hb = *(const bf16x8*)(p.NUMIb + off);
    bf16x8 mo = *(const bf16x8*)(p.MOb + off);
    bf16x8 mg = *(const bf16x8*)(p.MLGb + off);
    float hf[8];
    float ss = 0.f;
#pragma unroll
    for (int e = 0; e < 8; ++e) { hf[e] = bf2f((bf16_t)hv[e]) + bf2f((bf16_t)hb[e]); ss += hf[e] * hf[e]; }
    ss = row_sum16(ss);
    const float rs = rsqrtf(ss * (1.f / 128.f) + EPS);
    const float* ng = p.o_ml_norm_g + li * 128 + ((8 * lane) & 127);
    bf16x8 r;
#pragma unroll
    for (int e = 0; e < 8; ++e)
      r[e] = (short)f2bf(hf[e] * rs * ng[e] * sigmoidf_(bf2f((bf16_t)mo[e])) * siluf_(bf2f((bf16_t)mg[e])));
    if (!dry) *(bf16x8*)(p.MLGb + off) = r;
  }
}

__device__ void phase_final(const Params& p, bool dry = false) {
  const int tid_ = otid(); const int lane = tid_ & 63, w = tid_ >> 6;
#pragma unroll 2
  for (int tok = blockIdx.x * 4 + w; tok < T_TOK; tok += gridDim.x * 4) {
    float* xp = p.out + (long)tok * DM;
    float4 v[4];
    float ss = 0.f;
#pragma unroll
    for (int i = 0; i < 4; ++i) {
      v[i] = *(const float4*)(xp + 4 * lane + 256 * i);
      ss += v[i].x * v[i].x + v[i].y * v[i].y + v[i].z * v[i].z + v[i].w * v[i].w;
    }
    ss = wave_sum(ss);
    const float rs = rsqrtf(ss * (1.f / 1024.f) + EPS);
#pragma unroll
    for (int i = 0; i < 4; ++i) {
      float4 gq = *(const float4*)(p.final_norm_g + 4 * lane + 256 * i);
      float4 o;
      o.x = v[i].x * rs * gq.x; o.y = v[i].y * rs * gq.y; o.z = v[i].z * rs * gq.z; o.w = v[i].w * rs * gq.w;
      if (!dry) *(float4*)(xp + 4 * lane + 256 * i) = o;
    }
  }
}

__device__ void run_phase(const Params& p, int ph, char* smem) {
  if (ph == 0) { if (PH_ON(0)) phase_prep(p, smem); return; }
  if (ph == NPHASE - 1) { if (PROBE_B) phase_final(p, true); if (PH_ON(11)) phase_final(p); return; }
  const int q = ph - 1;
  const int layer = (q < 5) ? 0 : (q < 11) ? 1 : (q < 16) ? 2 : 3;
  const int sub = (q < 5) ? q : (q < 11) ? q - 5 : (q < 16) ? q - 11 : q - 16;
  const int li = layer >> 1;
  const float* xa = (layer == 0) ? p.x_prompt : p.out;
  const float* xb = (layer == 0) ? p.x_sample : p.out + (long)T_P * DM;
  if ((layer & 1) == 0) {
    if (sub == 0) {
      EpiEvenIn e{p.Qb, p.Kt, p.VtE, p.Gb, p.LRb, p.PUb, p.PGb};
      if (PH_ON(1)) gemm_phase<3, 8>(T_TOK / 128, NE_PAD / 256, DM, p.WinE + (long)li * NE_PAD * DM, p.SSQ, nullptr, p.TMP, DM, DM, p.TMP, DM, e, smem);
    } else if (sub == 1) {
      for (int item = blockIdx.x; item < 5120; item += gridDim.x)
        if (PH_ON(2)) gla_intra_item(p, li, item, smem);
    } else if (sub == 2) {
      __shared__ int s_pitem;
      for (int item = blockIdx.x; item < 384; item += gridDim.x) { if (PH_ON(2)) gla_chain_item(p, li, item, smem, false); }
      for (;;) {
        __syncthreads();
        if (threadIdx.x == 0) s_pitem = atomicAdd(p.counters + 16 + li, 1);
        __syncthreads();
        const int item = s_pitem;
        if (item >= 5120) break;
        if (PH_ON(3)) pool_item(p, li, item, smem);
      }
    } else if (sub == 3) {
      if (PROBE_B) phase_gla_combine(p, li, true);
      if (PH_ON(4)) phase_gla_combine(p, li);
    } else {
      EpiOut e{xa, xb, p.out, false, p.NUMIf, p.SSQ};
      if (PH_ON(5)) gemm_phase<1, 8>(T_TOK / 128, DM / 256, 1536, p.WoutE + (long)li * DM * 1536, nullptr, nullptr, p.Gb, 1024, 1024, p.PGb, 512, e, smem);
    }
  } else {
    if (sub == 0) {
      EpiOddIn e{p.CQb, p.CKVb, p.KRb, p.MGb, p.MQb, p.MKb, p.MKt, p.MVt, p.MOb, p.MLGb, p.MIF};
      if (PH_ON(6)) gemm_phase<3, 8>(T_TOK / 128, NO_PAD / 256, DM, p.WinO + (long)li * NO_PAD * DM, p.SSQ, nullptr, p.NUMIf, DM, DM, p.NUMIf, DM, e, smem);
    } else if (sub == 1) {
      for (int rep = 0; rep < 1 + PROBE_A; ++rep)
      for (int item = blockIdx.x; item < 5120; item += gridDim.x)
        if (PH_ON(8)) ml_intra_item(p, li, item, smem);
    } else if (sub == 2) {
      for (int item = blockIdx.x; item < 768; item += gridDim.x)
        if (PH_ON(8)) ml_chain_item(p, li, item, smem, false);
    } else if (sub == 3) {
      if (PH_ON(10)) phase_ml_combine(p, li);
      EpiQUp eq{p.Qa};
      if (PH_ON(7)) gemm_phase<2, 4>(T_TOK / 128, 768 / 128, 384, p.QupT + (long)li * 768 * 384, nullptr, nullptr, p.CQb, 384, 384, p.CQb, 384, eq, smem);
      EpiKVUp ek{p.KNb, p.VtA};
      if (PH_ON(7)) gemm_phase<2, 4>(T_TOK / 128, 1024 / 128, 256, p.KVupT + (long)li * 1024 * 256, nullptr, nullptr, p.CKVb, 256, 256, p.CKVb, 256, ek, smem);
    } else if (sub == 4) {
      __shared__ int s_item;
      for (;;) {
        __syncthreads();
        if (threadIdx.x == 0) s_item = atomicAdd(p.counters + li * 8 + (blockIdx.x & 7), 1);
        __syncthreads();
        const int item = s_item;
        if (item >= 320) break;
        if (PH_ON(9)) attn_item(p, (blockIdx.x & 7) * 320 + item, smem);
      }
    } else {
      EpiOut e{xa, xb, p.out, false, (layer == 3) ? nullptr : p.TMP, p.SSQ};
      if (PH_ON(5)) gemm_phase<1, 8>(T_TOK / 128, DM / 256, 1024, p.WoutO + (long)li * DM * 1024, nullptr, nullptr, p.MGb, 512, 512, p.MLGb, 512, e, smem);
    }
  }
}

__global__ void __launch_bounds__(256, 2) mega_kernel(Params p) {
  extern __shared__ __attribute__((aligned(16))) char smem[];
  cg::grid_group grid = cg::this_grid();
  __shared__ uint4 xb_words;
  if (threadIdx.x == 0) xb_words = make_uint4(0u, 0u, 0u, 0u);
  __syncthreads();
  XcdBarrier xb = xcd_barrier_post(p.bar, (volatile LAS unsigned*)&xb_words);
  for (int ph = p.ph_lo; ph < p.ph_hi; ++ph) {
    if (ph > p.ph_lo) {
      if (ph == p.ph_lo + 1) grid.sync();
      else xcd_barrier(xb);
    }
    run_phase(p, ph, smem);
  }
}

extern "C" void kernel_launch(void* const* d_in, const int* in_sizes, int n_in, void* d_out, int out_size, void* d_ws,
                              size_t ws_size, hipStream_t stream) {
  static int grid_blocks = 0;
  if (!grid_blocks) {
    int dev = 0, cus = 0, per_cu = 0;
    hipGetDevice(&dev);
    hipDeviceGetAttribute(&cus, hipDeviceAttributeMultiprocessorCount, dev);
    hipFuncSetAttribute((const void*)mega_kernel, hipFuncAttributeMaxDynamicSharedMemorySize, LDS_BYTES);
    hipOccupancyMaxActiveBlocksPerMultiprocessor(&per_cu, (const void*)mega_kernel, 256, LDS_BYTES);
    if (per_cu < 1) per_cu = 1;
    if (per_cu > 2) per_cu = 2;
    grid_blocks = cus * per_cu;
    fprintf(stderr, "kernel_launch: cus %d per_cu %d grid %d ws %zu\n", cus, per_cu, grid_blocks, ws_size);
  }
  Params p{};
  const float** pin = (const float**)&p;
  for (int i = 0; i < 19; ++i) pin[i] = (const float*)d_in[i];
  p.out = (float*)d_out;
  char* ws = (char*)d_ws;
  size_t off = 0;
  auto take = [&](size_t bytes) { char* r = ws + off; off += (bytes + 255) & ~(size_t)255; return r; };
  p.WinE = (bf16_t*)take((size_t)2 * NE_PAD * DM * 2);
  p.WinO = (bf16_t*)take((size_t)2 * NO_PAD * DM * 2);
  p.WoutE = (bf16_t*)take((size_t)2 * DM * 1536 * 2);
  p.WoutO = (bf16_t*)take((size_t)2 * DM * 1024 * 2);
  p.QupT = (bf16_t*)take((size_t)2 * 768 * 384 * 2);
  p.KVupT = (bf16_t*)take((size_t)2 * 1024 * 256 * 2);
  p.PoolWT = (bf16_t*)take((size_t)2 * 4 * 128 * 128 * 2);
  p.AupT = (bf16_t*)take((size_t)2 * 2 * 512 * 32 * 2);
  p.counters = (int*)take(256);
  p.bar = (unsigned*)take((size_t)XCD_BAR_WORDS * 4);
  p.SSQ = (float*)take((size_t)T_TOK * 8 * 4);
  const size_t act0 = off;
  const size_t T = T_TOK;
  p.Gb = (bf16_t*)take(T * 1024 * 2);
  p.PGb = (bf16_t*)take(T * 512 * 2);
  p.Qb = (bf16_t*)take(T * 512 * 2);
  p.Kt = (bf16_t*)take(T * 512 * 2);
  p.QEb = (bf16_t*)take(T * 512 * 2);
  p.KdTb = (bf16_t*)take(T * 512 * 2);
  p.EB = (float*)take((size_t)2 * 1280 * 512 * 4);
  p.VtE = (bf16_t*)take(T * 1024 * 2);
  p.LRb = (bf16_t*)take(T * 32 * 2);
  p.PUb = (bf16_t*)take(T * 512 * 2);
  p.TMP = (bf16_t*)take(T * 1024 * 2);
  const size_t even_end = off;
  off = act0;
  p.MGb = (bf16_t*)take(T * 512 * 2);
  p.MLGb = (bf16_t*)take(T * 512 * 2);
  p.CQb = (bf16_t*)take(T * 384 * 2);
  p.CKVb = (bf16_t*)take(T * 256 * 2);
  p.KRb = (bf16_t*)take(T * 32 * 2);
  const size_t r2 = off;
  p.MQb = (bf16_t*)take(T * 512 * 2);
  p.MKb = (bf16_t*)take(T * 512 * 2);
  p.MKt = (bf16_t*)take(T * 512 * 2);
  p.MVt = (bf16_t*)take(T * 512 * 2);
  p.MOb = (bf16_t*)take(T * 512 * 2);
  p.NUMIf = (bf16_t*)take(T * 512 * 2);
  p.NUMIb = (bf16_t*)take(T * 512 * 2);
  p.MIF = (float*)take(T * 16 * 4);
  p.EBI = (float*)take(T * 8 * 4);
  p.WKg = (float*)take(T * 8 * 4);
  p.DENI = (float*)take(T * 8 * 4);
  p.DEC = (float*)take((size_t)8 * 1280 * 4);
  const size_t r2_end = off;
  off = r2;
  p.Qa = (bf16_t*)take(T * 768 * 2);
  p.KNb = (bf16_t*)take(T * 512 * 2);
  p.VtA = (bf16_t*)take(T * 512 * 2);
  if (off < r2_end) off = r2_end;
  const size_t odd_end = off;
  const size_t need = even_end > odd_end ? even_end : odd_end;
  if (need > ws_size) {
    fprintf(stderr, "kernel_launch: workspace too small: need %zu have %zu\n", need, ws_size);
    return;
  }
  hipMemsetAsync(p.bar, 0, (size_t)XCD_BAR_WORDS * 4, stream);
#if SINGLE_LAUNCH
  p.ph_lo = 0;
  p.ph_hi = NPHASE;
  void* args[] = {&p};
  hipError_t e = hipLaunchCooperativeKernel((const void*)mega_kernel, dim3(grid_blocks), dim3(256), args, LDS_BYTES, stream);
  if (e != hipSuccess) fprintf(stderr, "cooperative launch failed: %s (grid %d)\n", hipGetErrorString(e), grid_blocks);
#else
  for (int ph = 0; ph < NPHASE; ++ph) {
    p.ph_lo = ph;
    p.ph_hi = ph + 1;
    hipLaunchKernelGGL(mega_kernel, dim3(grid_blocks), dim3(256), LDS_BYTES, stream, p);
  }
#endif
}
```
